# Optimizing an MI355X kernel written in HIP

```python
import jax, jax.numpy as jnp
from jax import lax
import numpy as np

D_MODEL = 1024
BATCH = 2
SEQ = 8192
DEPTH = 1

EPS = 1e-6
HEAD_DIM = 64
ATTN_WIDTH = D_MODEL // 2
N_Q_HEADS = ATTN_WIDTH // HEAD_DIM
N_KV_HEADS = 2
Q_PER_KV = N_Q_HEADS // N_KV_HEADS
KV_WIDTH = N_KV_HEADS * HEAD_DIM
WINDOW = 128
SSM_INNER = D_MODEL // 2
SSM_HEAD_DIM = 64
SSM_HEADS = SSM_INNER // SSM_HEAD_DIM
SSM_GROUPS = 2
HEADS_PER_GROUP = SSM_HEADS // SSM_GROUPS
D_STATE = 128
BC_WIDTH = SSM_GROUPS * D_STATE
CONV_K = 4
CONV_DIM = SSM_INNER + 2 * BC_WIDTH
CHUNK = 128
MIX_WIDTH = ATTN_WIDTH + SSM_INNER
PROJ_WIDTH = ATTN_WIDTH + 2 * KV_WIDTH + SSM_INNER + CONV_DIM + SSM_HEADS
SPLIT_OFFSETS = [ATTN_WIDTH,
                 ATTN_WIDTH + KV_WIDTH,
                 ATTN_WIDTH + 2 * KV_WIDTH,
                 ATTN_WIDTH + 2 * KV_WIDTH + SSM_INNER,
                 ATTN_WIDTH + 2 * KV_WIDTH + SSM_INNER + CONV_DIM]
PEER_HEADS = 8
D_KEY = 128
HALF_KEY = D_KEY // 2
N_KEYS = 128
N_EXPERTS = N_KEYS * N_KEYS
PEER_TOPK = 16
PEER_BLOCK = 128

kernel_name = 'hymba_swa_ssd_peer_layer'


def rmsnorm(x, g):
    xf = x.astype(jnp.float32)
    y = xf * lax.rsqrt(jnp.mean(xf * xf, axis=-1, keepdims=True) + EPS)
    return (y * g.astype(jnp.float32)).astype(x.dtype)


def alibi_slopes():
    return jnp.exp2(-(8.0 / N_Q_HEADS) * jnp.arange(1, N_Q_HEADS + 1, dtype=jnp.float32))


def sliding_window_attention(q, k, v, sinks):
    b, s = q.shape[0], q.shape[1]
    nb = s // WINDOW
    qb = q.reshape(b, nb, WINDOW, N_KV_HEADS, Q_PER_KV, HEAD_DIM)
    kb = k.reshape(b, nb, WINDOW, N_KV_HEADS, HEAD_DIM)
    vb = v.reshape(b, nb, WINDOW, N_KV_HEADS, HEAD_DIM)
    pad = ((0, 0), (1, 0), (0, 0), (0, 0), (0, 0))
    kk = jnp.concatenate([jnp.pad(kb[:, :-1], pad), kb], axis=2)
    vv = jnp.concatenate([jnp.pad(vb[:, :-1], pad), vb], axis=2)
    logits = jnp.einsum('bnqhgd,bnkhd->bnhgqk', qb, kk).astype(jnp.float32) * (HEAD_DIM ** -0.5)
    qi = jnp.arange(WINDOW)[:, None]
    ki = jnp.arange(2 * WINDOW)[None, :]
    dist = WINDOW + qi - ki
    band = (dist >= 0) & (dist < WINDOW)
    not_first = jnp.arange(nb)[:, None, None] > 0
    valid = band[None] & (not_first | (ki >= WINDOW)[None])
    alibi = -alibi_slopes()[:, None, None] * dist.astype(jnp.float32)[None]
    logits = logits + alibi.reshape(N_KV_HEADS, Q_PER_KV, WINDOW, 2 * WINDOW)[None, None]
    logits = jnp.where(valid[None, :, None, None], logits, -jnp.inf)
    sink = sinks.astype(jnp.float32).reshape(N_KV_HEADS, Q_PER_KV)[None, None, :, :, None, None]
    m = jnp.maximum(jnp.max(logits, axis=-1, keepdims=True), sink)
    p = jnp.exp(logits - m)
    p = p / (jnp.sum(p, axis=-1, keepdims=True) + jnp.exp(sink - m))
    out = jnp.einsum('bnhgqk,bnkhd->bnqhgd', p.astype(vv.dtype), vv)
    return out.reshape(b, s, ATTN_WIDTH)


def ssd_chunked(xh, dt, a_log, bm, cm):
    b, s = xh.shape[0], xh.shape[1]
    nc = s // CHUNK
    a_dt = dt * (-jnp.exp(a_log.astype(jnp.float32)))
    xd = xh.astype(jnp.float32) * dt[..., None]
    X = xd.reshape(b, nc, CHUNK, SSM_GROUPS, HEADS_PER_GROUP, SSM_HEAD_DIM)
    A = a_dt.reshape(b, nc, CHUNK, SSM_GROUPS, HEADS_PER_GROUP).transpose(0, 3, 4, 1, 2)
    Bc = bm.astype(jnp.float32).reshape(b, nc, CHUNK, SSM_GROUPS, D_STATE)
    Cc = cm.astype(jnp.float32).reshape(b, nc, CHUNK, SSM_GROUPS, D_STATE)
    a_cs = jnp.cumsum(A, axis=-1)
    causal = jnp.tril(jnp.ones((CHUNK, CHUNK), dtype=bool))
    l_mat = jnp.exp(jnp.where(causal, a_cs[..., :, None] - a_cs[..., None, :], -jnp.inf))
    cb = jnp.einsum('bclgn,bcsgn->bcgls', Cc, Bc)
    y_diag = jnp.einsum('bcgls,bgrcls,bcsgrp->bclgrp', cb, l_mat, X)
    decay_states = jnp.exp(a_cs[..., -1:] - a_cs)
    states = jnp.einsum('bcsgn,bgrcs,bcsgrp->bcgrpn', Bc, decay_states, X)
    chunk_decay = jnp.exp(a_cs[..., -1])

    def step(state, inp):
        st, dec = inp
        return dec[..., None, None] * state + st, state

    _, prev = lax.scan(step, jnp.zeros_like(states[:, 0]),
                       (jnp.moveaxis(states, 1, 0), jnp.moveaxis(chunk_decay, -1, 0)))
    prev = jnp.moveaxis(prev, 0, 1)
    y_off = jnp.einsum('bclgn,bcgrpn,bgrcl->bclgrp', Cc, prev, jnp.exp(a_cs))
    return (y_diag + y_off).reshape(b, s, SSM_HEADS, SSM_HEAD_DIM)


def token_mixer(xn, w_in, attn_sinks, attn_out_g, conv_w, conv_b, dt_bias, a_log, d_skip, ssm_norm_g, w_out):
    b, s, _ = xn.shape
    proj = xn @ w_in
    q, k, v, z, xbc, dt_raw = jnp.split(proj, SPLIT_OFFSETS, axis=-1)
    attn = sliding_window_attention(q.reshape(b, s, N_Q_HEADS, HEAD_DIM),
                                    k.reshape(b, s, N_KV_HEADS, HEAD_DIM),
                                    v.reshape(b, s, N_KV_HEADS, HEAD_DIM), attn_sinks)
    attn = rmsnorm(attn, attn_out_g)
    xbc = lax.conv_general_dilated(xbc, conv_w.astype(xbc.dtype)[:, None, :], window_strides=(1,),
                                   padding=[(CONV_K - 1, 0)], dimension_numbers=('NWC', 'WIO', 'NWC'),
                                   feature_group_count=CONV_DIM) + conv_b
    xbc = jax.nn.silu(xbc)
    xs, bm, cm = jnp.split(xbc, [SSM_INNER, SSM_INNER + BC_WIDTH], axis=-1)
    dt = jax.nn.softplus(dt_raw.astype(jnp.float32) + dt_bias.astype(jnp.float32))
    xh = xs.reshape(b, s, SSM_HEADS, SSM_HEAD_DIM)
    y = ssd_chunked(xh, dt, a_log, bm.reshape(b, s, SSM_GROUPS, D_STATE), cm.reshape(b, s, SSM_GROUPS, D_STATE))
    y = y + d_skip.astype(jnp.float32)[:, None] * xh.astype(jnp.float32)
    y = y.reshape(b, s, SSM_INNER) * jax.nn.silu(z.astype(jnp.float32))
    yg = y.reshape(b, s, SSM_GROUPS, SSM_INNER // SSM_GROUPS)
    yg = yg * lax.rsqrt(jnp.mean(yg * yg, axis=-1, keepdims=True) + EPS)
    y = (yg.reshape(b, s, SSM_INNER) * ssm_norm_g.astype(jnp.float32)).astype(xn.dtype)
    mix = jnp.concatenate([attn, y], axis=-1)
    return mix @ w_out


def peer_ffn(xn, peer_wq, peer_sub_keys, peer_u, peer_v):
    b, s, d = xn.shape
    t = xn.reshape(b * s, d)
    n_tok = b * s
    q = (t @ peer_wq).reshape(n_tok, PEER_HEADS, 2, HALF_KEY)
    s1 = jnp.einsum('thd,kd->thk', q[:, :, 0], peer_sub_keys[0]).astype(jnp.float32)
    s2 = jnp.einsum('thd,kd->thk', q[:, :, 1], peer_sub_keys[1]).astype(jnp.float32)
    v1, i1 = lax.top_k(s1, PEER_TOPK)
    v2, i2 = lax.top_k(s2, PEER_TOPK)
    cand = (v1[..., :, None] + v2[..., None, :]).reshape(n_tok, PEER_HEADS, PEER_TOPK * PEER_TOPK)
    cand_idx = (i1[..., :, None] * N_KEYS + i2[..., None, :]).reshape(n_tok, PEER_HEADS, PEER_TOPK * PEER_TOPK)
    top_s, pos = lax.top_k(cand, PEER_TOPK)
    idx = jnp.take_along_axis(cand_idx, pos, axis=-1)
    gate = jax.nn.softmax(top_s, axis=-1)
    nblk = n_tok // PEER_BLOCK
    hk = PEER_HEADS * PEER_TOPK
    tb = t.reshape(nblk, PEER_BLOCK, d)
    ib = idx.reshape(nblk, PEER_BLOCK, hk)
    gb = gate.reshape(nblk, PEER_BLOCK, hk).astype(xn.dtype)

    def expert_block(args):
        xb, ibk, gbk = args
        u = jnp.take(peer_u, ibk, axis=0)
        act = gbk * jax.nn.gelu(jnp.einsum('tkd,td->tk', u, xb), approximate=False)
        vv = jnp.take(peer_v, ibk, axis=0)
        return jnp.einsum('tk,tkd->td', act, vv)

    out = lax.map(expert_block, (tb, ib, gb))
    return out.reshape(b, s, d)


def setup_inputs(seed: int = 0) -> dict:
    key = jax.random.key(seed)
    ks = jax.random.split(key, 20)
    L, D = DEPTH, D_MODEL
    f32 = jnp.float32
    nrm = lambda k, shape, sc: jax.random.normal(k, shape, f32) * sc
    dt0 = jnp.exp(jax.random.uniform(ks[7], (L, SSM_HEADS), f32, np.log(1e-3), np.log(1e-1)))
    return {
        'x': nrm(ks[0], (BATCH, SEQ, D), 1.0),
        'norm_mix_g': 1.0 + nrm(ks[1], (L, D), 0.02),
        'w_in': nrm(ks[2], (L, D, PROJ_WIDTH), D ** -0.5),
        'attn_sinks': nrm(ks[3], (L, N_Q_HEADS), 0.5),
        'attn_out_g': 1.0 + nrm(ks[4], (L, ATTN_WIDTH), 0.02),
        'conv_w': nrm(ks[5], (L, CONV_K, CONV_DIM), CONV_K ** -0.5),
        'conv_b': nrm(ks[6], (L, CONV_DIM), 0.02),
        'dt_bias': dt0 + jnp.log(-jnp.expm1(-dt0)),
        'a_log': jnp.log(jax.random.uniform(ks[8], (L, SSM_HEADS), f32, 1.0, 16.0)),
        'd_skip': 1.0 + nrm(ks[9], (L, SSM_HEADS), 0.1),
        'ssm_norm_g': 1.0 + nrm(ks[10], (L, SSM_INNER), 0.02),
        'w_out': nrm(ks[11], (L, MIX_WIDTH, D), MIX_WIDTH ** -0.5),
        'norm_ffn_g': 1.0 + nrm(ks[12], (L, D), 0.02),
        'peer_wq': nrm(ks[13], (L, D, PEER_HEADS * D_KEY), D ** -0.5),
        'peer_sub_keys': nrm(ks[14], (L, 2, N_KEYS, HALF_KEY), HALF_KEY ** -0.5),
        'peer_u': nrm(ks[15], (L, N_EXPERTS, D), D ** -0.5),
        'peer_v': nrm(ks[16], (L, N_EXPERTS, D), PEER_TOPK ** -0.5),
        'final_norm_g': 1.0 + nrm(ks[17], (D,), 0.02),
    }


def reference(x, norm_mix_g, w_in, attn_sinks, attn_out_g, conv_w, conv_b, dt_bias, a_log, d_skip,
              ssm_norm_g, w_out, norm_ffn_g, peer_wq, peer_sub_keys, peer_u, peer_v, final_norm_g):
    h = x
    for l in range(DEPTH):
        xn = rmsnorm(h, norm_mix_g[l])
        h = h + token_mixer(xn, w_in[l], attn_sinks[l], attn_out_g[l], conv_w[l], conv_b[l], dt_bias[l],
                            a_log[l], d_skip[l], ssm_norm_g[l], w_out[l])
        xn = rmsnorm(h, norm_ffn_g[l])
        h = h + peer_ffn(xn, peer_wq[l], peer_sub_keys[l], peer_u[l], peer_v[l])
    return rmsnorm(h, final_norm_g)
```

```cpp
#include <hip/hip_runtime.h>
#include <cstdio>
#include <cstdint>

namespace {
constexpr int D = 1024, BATCH = 2, SEQ = 8192, T = BATCH * SEQ;
constexpr int PW = 2312;
constexpr int OQ = 0, OKK = 512, OV = 640, OZ = 768, OXBC = 1280, ODT = 2304;
constexpr float EPS = 1e-6f;
constexpr int NTHR = 512;
typedef unsigned short bf16;

constexpr size_t MiB = 1u << 20;
constexpr size_t WS_PROJ = 1 * MiB;
constexpr size_t WS_XN = 74 * MiB;
constexpr size_t WS_XACT = 138 * MiB;
constexpr size_t WS_DTRAW = 170 * MiB;
constexpr size_t WS_DT = WS_DTRAW + 512 * 1024;
constexpr size_t WS_ACS = WS_DT + 512 * 1024;
constexpr size_t WS_CDEC = WS_ACS + 512 * 1024;
constexpr size_t WS_CB = 172 * MiB;
constexpr size_t WS_STATES = 188 * MiB;
constexpr size_t WS_PREV = 220 * MiB;
constexpr size_t WS_QP = 1 * MiB;
constexpr size_t WS_IDX = 65 * MiB;
constexpr size_t WS_GATE = 138 * MiB;
constexpr size_t WS_TOPV = 146 * MiB;
constexpr size_t WS_TOPI = 162 * MiB;
constexpr size_t WS_END = 252 * MiB;

struct Args {
    const float* x; const float* norm_mix_g; const float* w_in; const float* attn_sinks; const float* attn_out_g;
    const float* conv_w; const float* conv_b; const float* dt_bias; const float* a_log; const float* d_skip;
    const float* ssm_norm_g; const float* w_out; const float* norm_ffn_g; const float* peer_wq; const float* peer_sub_keys;
    const float* peer_u; const float* peer_v; const float* final_norm_g;
    float* out; unsigned char* ws;
    int ph_lo, ph_hi;
};

__device__ __forceinline__ float bf2f(bf16 v) { return __uint_as_float(((unsigned)v) << 16); }
__device__ __forceinline__ bf16 f2bf(float f) { unsigned u = __float_as_uint(f); return (bf16)((u + 0x7fffu + ((u >> 16) & 1u)) >> 16); }
__device__ __forceinline__ float wave_sum(float v) {
#pragma unroll
    for (int o = 1; o < 64; o <<= 1) v += __shfl_xor(v, o);
    return v;
}
__device__ __forceinline__ float silu_f(float v) { return v / (1.f + __expf(-v)); }

template <class Epi>
__device__ __forceinline__ void gemm_naive(const float* __restrict__ A, const float* __restrict__ B, int M, int N, int K, int ldb,
                                           const Epi& epi, float* lds, int bid, int nb) {
    float* As = lds;
    float* Bs = lds + 16 * 132;
    const int tid = threadIdx.x, ty = tid >> 4, tx = tid & 15;
    const int tilesN = (N + 63) / 64, tilesM = M / 128, ntiles = tilesM * tilesN;
    for (int tile = bid; tile < ntiles; tile += nb) {
        const int tm = tile / tilesN, tn = tile - tm * tilesN;
        const int m0 = tm * 128, n0 = tn * 64;
        float acc[4][4];
#pragma unroll
        for (int i = 0; i < 4; ++i)
#pragma unroll
            for (int j = 0; j < 4; ++j) acc[i][j] = 0.f;
        for (int k0 = 0; k0 < K; k0 += 16) {
            {
                const int r = tid >> 2, kq = tid & 3;
                const float4 a = *(const float4*)(A + (size_t)(m0 + r) * K + k0 + kq * 4);
                As[(kq * 4 + 0) * 132 + r] = a.x; As[(kq * 4 + 1) * 132 + r] = a.y; As[(kq * 4 + 2) * 132 + r] = a.z; As[(kq * 4 + 3) * 132 + r] = a.w;
            }
            {
                const int kk = tid >> 5, nn = (tid & 31) * 2; const int col = n0 + nn;
                float2 bv = make_float2(0.f, 0.f);
                if (col < N) bv = *(const float2*)(B + (size_t)(k0 + kk) * ldb + col);
                *(float2*)(Bs + kk * 64 + nn) = bv;
            }
            __syncthreads();
#pragma unroll
            for (int k = 0; k < 16; ++k) {
                const float4 a = *(const float4*)(As + k * 132 + ty * 4);
                const float4 b = *(const float4*)(Bs + k * 64 + tx * 4);
                const float av[4] = {a.x, a.y, a.z, a.w}, bv[4] = {b.x, b.y, b.z, b.w};
#pragma unroll
                for (int i = 0; i < 4; ++i)
#pragma unroll
                    for (int j = 0; j < 4; ++j) acc[i][j] += av[i] * bv[j];
            }
            __syncthreads();
        }
#pragma unroll
        for (int i = 0; i < 4; ++i)
#pragma unroll
            for (int j = 0; j < 4; ++j) { const int row = m0 + ty * 4 + i, col = n0 + tx * 4 + j; if (col < N) epi(row, col, acc[i][j]); }
    }
}

__device__ __forceinline__ void rmsnorm_rows(const float* in, const float* g, float* outp, int gwave, int nwaves, int lane) {
    for (int row = gwave; row < T; row += nwaves) {
        const float4* xr = (const float4*)(in + (size_t)row * D) + lane;
        float4 v[4]; float ss = 0.f;
#pragma unroll
        for (int j = 0; j < 4; ++j) { v[j] = xr[64 * j]; ss += v[j].x * v[j].x + v[j].y * v[j].y + v[j].z * v[j].z + v[j].w * v[j].w; }
        ss = wave_sum(ss);
        const float r = rsqrtf(ss * (1.f / D) + EPS);
        float4* o = (float4*)(outp + (size_t)row * D) + lane;
#pragma unroll
        for (int j = 0; j < 4; ++j) { const float4 gv = ((const float4*)g)[lane + 64 * j]; o[64 * j] = make_float4(v[j].x * r * gv.x, v[j].y * r * gv.y, v[j].z * r * gv.z, v[j].w * r * gv.w); }
    }
}

struct EpiProj { bf16* proj; float* dtraw;
    __device__ __forceinline__ void operator()(int row, int col, float v) const { proj[(size_t)row * PW + col] = f2bf(v); if (col >= ODT) dtraw[row * 8 + (col - ODT)] = v; } };
struct EpiResid { const float* x; float* out;
    __device__ __forceinline__ void operator()(int row, int col, float v) const { out[(size_t)row * D + col] = x[(size_t)row * D + col] + v; } };
struct EpiPlain { float* out;
    __device__ __forceinline__ void operator()(int row, int col, float v) const { out[(size_t)row * D + col] = v; } };

constexpr int NPHASES = 12;

__global__ void __launch_bounds__(NTHR) k_main(Args a) {
    extern __shared__ __attribute__((aligned(16))) unsigned char lds_raw[];
    float* lds = (float*)lds_raw;
    const int tid = threadIdx.x, lane = tid & 63, bid = blockIdx.x, nb = gridDim.x;
    const int gtid = bid * NTHR + tid, gthreads = nb * NTHR, gwave = gtid >> 6, nwaves = gthreads >> 6;
    unsigned char* ws = a.ws;
    bf16* PROJ = (bf16*)(ws + WS_PROJ);
    float* XN = (float*)(ws + WS_XN);
    bf16* XACT = (bf16*)(ws + WS_XACT);
    float* DTRAW = (float*)(ws + WS_DTRAW); float* DT = (float*)(ws + WS_DT); float* ACS = (float*)(ws + WS_ACS); float* CDEC = (float*)(ws + WS_CDEC);
    float* CB = (float*)(ws + WS_CB); float* STATES = (float*)(ws + WS_STATES); float* PREV = (float*)(ws + WS_PREV);
    float* QP = (float*)(ws + WS_QP); int* IDX = (int*)(ws + WS_IDX); float* GATE = (float*)(ws + WS_GATE);
    float* TOPV = (float*)(ws + WS_TOPV); int* TOPI = (int*)(ws + WS_TOPI);
    float* MIX = XN; float* XN2 = XN;
#define IN(k) (a.ph_lo <= (k) && (k) < a.ph_hi)

    if (IN(0)) rmsnorm_rows(a.x, a.norm_mix_g, XN, gwave, nwaves, lane);

    if (IN(1)) { EpiProj e{PROJ, DTRAW}; gemm_naive(XN, a.w_in, T, PW, D, PW, e, lds, bid, nb); }

    if (IN(2)) {
        for (int idx = gtid; idx < T * 1024; idx += gthreads) {
            const int t = idx >> 10, c = idx & 1023, s = t & (SEQ - 1);
            float acc = a.conv_b[c];
#pragma unroll
            for (int k = 0; k < 4; ++k) { const int sp = s + k - 3; if (sp >= 0) acc += a.conv_w[k * 1024 + c] * bf2f(PROJ[(size_t)(t + k - 3) * PW + OXBC + c]); }
            XACT[idx] = f2bf(silu_f(acc));
        }
        if (gtid < 1024) {
            const int h = gtid & 7, bc = gtid >> 3;
            const float A = -__expf(a.a_log[h]), bias = a.dt_bias[h];
            float run = 0.f;
            for (int l = 0; l < 128; ++l) {
                const int t = bc * 128 + l;
                const float raw = DTRAW[t * 8 + h] + bias;
                const float dt = fmaxf(raw, 0.f) + log1pf(__expf(-fabsf(raw)));
                DT[t * 8 + h] = dt; run += dt * A; ACS[t * 8 + h] = run;
            }
            CDEC[gtid] = __expf(run);
        }
    }

    if (IN(3)) {
        for (int task = gwave; task < 8 * (T / 64); task += nwaves) {
            const int tg = task >> 3, hq = task & 7, t = tg * 64 + lane, b = t / SEQ, s = t - b * SEQ, hkv = hq >> 2;
            float q[64], o[64];
            {
                const uint4* qp = (const uint4*)(PROJ + (size_t)t * PW + OQ + hq * 64);
#pragma unroll
                for (int i = 0; i < 8; ++i) { const uint4 w = qp[i]; const unsigned ww[4] = {w.x, w.y, w.z, w.w};
#pragma unroll
                    for (int j = 0; j < 4; ++j) { q[i * 8 + j * 2] = __uint_as_float(ww[j] << 16) * 0.125f; q[i * 8 + j * 2 + 1] = __uint_as_float(ww[j] & 0xffff0000u) * 0.125f; } }
            }
#pragma unroll
            for (int d = 0; d < 64; ++d) o[d] = 0.f;
            const float slope = exp2f(-(float)(hq + 1));
            float m = a.attn_sinks[hq], l = 1.f;
            for (int j = 0; j < 128; ++j) {
                const int ks = s - 127 + j;
                if (ks >= 0) {
                    const uint4* kp = (const uint4*)(PROJ + (size_t)(b * SEQ + ks) * PW + OKK + hkv * 64);
                    float dot = 0.f;
#pragma unroll
                    for (int i = 0; i < 8; ++i) { const uint4 w = kp[i]; const unsigned ww[4] = {w.x, w.y, w.z, w.w};
#pragma unroll
                        for (int jj = 0; jj < 4; ++jj) { dot += q[i * 8 + jj * 2] * __uint_as_float(ww[jj] << 16); dot += q[i * 8 + jj * 2 + 1] * __uint_as_float(ww[jj] & 0xffff0000u); } }
                    const float logit = dot - slope * (float)(127 - j);
                    if (logit > m) { const float sc = __expf(m - logit); l *= sc;
#pragma unroll
                        for (int d = 0; d < 64; ++d) o[d] *= sc;
                        m = logit; }
                    const float pe = __expf(logit - m); l += pe;
                    const uint4* vp = (const uint4*)(PROJ + (size_t)(b * SEQ + ks) * PW + OV + hkv * 64);
#pragma unroll
                    for (int i = 0; i < 8; ++i) { const uint4 w = vp[i]; const unsigned ww[4] = {w.x, w.y, w.z, w.w};
#pragma unroll
                        for (int jj = 0; jj < 4; ++jj) { o[i * 8 + jj * 2] += pe * __uint_as_float(ww[jj] << 16); o[i * 8 + jj * 2 + 1] += pe * __uint_as_float(ww[jj] & 0xffff0000u); } }
                }
            }
            const float inv = 1.f / l;
            float4* op = (float4*)(MIX + (size_t)t * D + hq * 64);
#pragma unroll
            for (int i = 0; i < 16; ++i) op[i] = make_float4(o[i * 4] * inv, o[i * 4 + 1] * inv, o[i * 4 + 2] * inv, o[i * 4 + 3] * inv);
        }
        for (int idx = gtid; idx < 256 * 128 * 128; idx += gthreads) {
            const int s = idx & 127, l = (idx >> 7) & 127, unit = idx >> 14, g = unit & 1, tok0 = (unit >> 1) * 128;
            float acc = 0.f;
            if (s <= l) {
                const bf16* cp = XACT + (size_t)(tok0 + l) * 1024 + 768 + g * 128;
                const bf16* bp = XACT + (size_t)(tok0 + s) * 1024 + 512 + g * 128;
                for (int n = 0; n < 128; ++n) acc += bf2f(cp[n]) * bf2f(bp[n]);
            }
            CB[idx] = acc;
        }
    }

    if (IN(4)) {
        for (int idx = gtid; idx < T * 512; idx += gthreads) {
            const int p = idx & 63, h = (idx >> 6) & 7, t = idx >> 9, l = t & 127, tok0 = t - l, unit = (t >> 7) * 2 + (h >> 2);
            const float acs_l = ACS[t * 8 + h];
            const float* cbrow = CB + ((size_t)unit * 128 + l) * 128;
            float acc = 0.f;
            for (int s = 0; s <= l; ++s) {
                const int ts = tok0 + s;
                const float w = cbrow[s] * __expf(acs_l - ACS[ts * 8 + h]) * DT[ts * 8 + h];
                acc += w * bf2f(XACT[(size_t)ts * 1024 + h * 64 + p]);
            }
            MIX[(size_t)t * D + 512 + h * 64 + p] = acc;
        }
        for (int idx = gtid; idx < 1024 * 8192; idx += gthreads) {
            const int p = idx & 63, n = (idx >> 6) & 127, bch = idx >> 13, h = bch & 7, g = h >> 2, tok0 = (bch >> 3) * 128;
            const float acs_last = ACS[(tok0 + 127) * 8 + h];
            float acc = 0.f;
            for (int s = 0; s < 128; ++s) {
                const int ts = tok0 + s;
                const float w = __expf(acs_last - ACS[ts * 8 + h]) * DT[ts * 8 + h];
                acc += bf2f(XACT[(size_t)ts * 1024 + 512 + g * 128 + n]) * w * bf2f(XACT[(size_t)ts * 1024 + h * 64 + p]);
            }
            STATES[idx] = acc;
        }
    }

    if (IN(5)) {
        for (int idx = gtid; idx < 2 * 8 * 8192; idx += gthreads) {
            const int pn = idx & 8191, h = (idx >> 13) & 7, b = idx >> 16;
            float run = 0.f;
            for (int c = 0; c < 64; ++c) {
                const int bch = (b * 64 + c) * 8 + h; const size_t o = (size_t)bch * 8192 + pn;
                PREV[o] = run; run = CDEC[bch] * run + STATES[o];
            }
        }
    }

    if (IN(6)) {
        for (int t = gwave; t < T; t += nwaves) {
            const int p = lane, bc = t >> 7;
            float yv[8];
#pragma unroll
            for (int h = 0; h < 8; ++h) {
                const int g = h >> 2; const float ea = __expf(ACS[t * 8 + h]);
                const float* pv = PREV + (size_t)(bc * 8 + h) * 8192 + p;
                const bf16* cp = XACT + (size_t)t * 1024 + 768 + g * 128;
                float acc = 0.f;
                for (int n = 0; n < 128; ++n) acc += bf2f(cp[n]) * pv[n * 64];
                float y = MIX[(size_t)t * D + 512 + h * 64 + p] + ea * acc + a.d_skip[h] * bf2f(XACT[(size_t)t * 1024 + h * 64 + p]);
                const float z = bf2f(PROJ[(size_t)t * PW + OZ + h * 64 + p]);
                yv[h] = y * silu_f(z);
            }
#pragma unroll
            for (int g = 0; g < 2; ++g) {
                float ss = 0.f;
#pragma unroll
                for (int r = 0; r < 4; ++r) ss += yv[g * 4 + r] * yv[g * 4 + r];
                ss = wave_sum(ss);
                const float rr = rsqrtf(ss * (1.f / 256.f) + EPS);
#pragma unroll
                for (int r = 0; r < 4; ++r) { const int h = g * 4 + r; MIX[(size_t)t * D + 512 + h * 64 + p] = yv[h] * rr * a.ssm_norm_g[h * 64 + p]; }
            }
            float av[8], ss = 0.f;
#pragma unroll
            for (int h = 0; h < 8; ++h) { av[h] = MIX[(size_t)t * D + h * 64 + p]; ss += av[h] * av[h]; }
            ss = wave_sum(ss);
            const float rr = rsqrtf(ss * (1.f / 512.f) + EPS);
#pragma unroll
            for (int h = 0; h < 8; ++h) MIX[(size_t)t * D + h * 64 + p] = av[h] * rr * a.attn_out_g[h * 64 + p];
        }
    }

    if (IN(7)) { EpiResid e{a.x, a.out}; gemm_naive(MIX, a.w_out, T, D, D, D, e, lds, bid, nb); }

    if (IN(8)) rmsnorm_rows(a.out, a.norm_ffn_g, XN2, gwave, nwaves, lane);
    if (IN(9)) { EpiPlain e{QP}; gemm_naive(XN2, a.peer_wq, T, D, D, D, e, lds, bid, nb); }

    if (IN(10)) {
        for (int item = gtid; item < 16 * T; item += gthreads) {
            const int t = item & (T - 1), hh = item >> 14, half = hh & 1;
            float q[64];
            const float4* qp = (const float4*)(QP + (size_t)t * D + hh * 64);
#pragma unroll
            for (int i = 0; i < 16; ++i) { const float4 w = qp[i]; q[i * 4] = w.x; q[i * 4 + 1] = w.y; q[i * 4 + 2] = w.z; q[i * 4 + 3] = w.w; }
            float bv[16]; int bi[16];
#pragma unroll
            for (int r = 0; r < 16; ++r) { bv[r] = -INFINITY; bi[r] = 0; }
            const float* kbase = a.peer_sub_keys + (size_t)half * 128 * 64;
            for (int k = 0; k < 128; ++k) {
                const float4* kp = (const float4*)(kbase + k * 64);
                float sc = 0.f;
#pragma unroll
                for (int i = 0; i < 16; ++i) { const float4 w = kp[i]; sc += q[i * 4] * w.x + q[i * 4 + 1] * w.y + q[i * 4 + 2] * w.z + q[i * 4 + 3] * w.w; }
                float cv = sc; int ci = k;
#pragma unroll
                for (int r = 0; r < 16; ++r) { const bool gt = cv > bv[r]; const float tv = gt ? bv[r] : cv; const int ti = gt ? bi[r] : ci; bv[r] = gt ? cv : bv[r]; bi[r] = gt ? ci : bi[r]; cv = tv; ci = ti; }
            }
            float* tv = TOPV + ((size_t)t * 16 + hh) * 16; int* ti = TOPI + ((size_t)t * 16 + hh) * 16;
#pragma unroll
            for (int r = 0; r < 16; ++r) { tv[r] = bv[r]; ti[r] = bi[r]; }
        }
    }
    if (IN(11)) {
        for (int item = gtid; item < 8 * T; item += gthreads) {
            const int t = item & (T - 1), hd = item >> 14;
            const float* v1 = TOPV + ((size_t)t * 16 + hd * 2) * 16; const float* v2 = v1 + 16;
            const int* i1 = TOPI + ((size_t)t * 16 + hd * 2) * 16; const int* i2 = i1 + 16;
            float bv[16]; int bi[16];
#pragma unroll
            for (int r = 0; r < 16; ++r) { bv[r] = -INFINITY; bi[r] = 0; }
#pragma unroll 1
            for (int aa = 0; aa < 16; ++aa) {
                const float va = v1[aa]; const int ia = i1[aa];
#pragma unroll 1
                for (int bb = 0; bb < 16; ++bb) {
                    float cv = va + v2[bb]; int ci = ia * 128 + i2[bb];
#pragma unroll
                    for (int r = 0; r < 16; ++r) { const bool gt = cv > bv[r]; const float tv = gt ? bv[r] : cv; const int ti = gt ? bi[r] : ci; bv[r] = gt ? cv : bv[r]; bi[r] = gt ? ci : bi[r]; cv = tv; ci = ti; }
                }
            }
            float e[16], se = 0.f;
#pragma unroll
            for (int r = 0; r < 16; ++r) { e[r] = __expf(bv[r] - bv[0]); se += e[r]; }
            const float inv = 1.f / se;
            float* gp = GATE + (size_t)t * 128 + hd * 16; int* ip = IDX + (size_t)t * 128 + hd * 16;
#pragma unroll
            for (int r = 0; r < 16; ++r) { gp[r] = e[r] * inv; ip[r] = bi[r]; }
        }
    }

    if (IN(12)) {
        for (int t = gwave; t < T; t += nwaves) {
            const float4* hr = (const float4*)(a.out + (size_t)t * D) + lane;
            float4 hv[4], xv[4], ov[4]; float ss = 0.f;
#pragma unroll
            for (int j = 0; j < 4; ++j) { hv[j] = hr[64 * j]; ss += hv[j].x * hv[j].x + hv[j].y * hv[j].y + hv[j].z * hv[j].z + hv[j].w * hv[j].w; ov[j] = make_float4(0.f, 0.f, 0.f, 0.f); }
            ss = wave_sum(ss);
            const float r2 = rsqrtf(ss * (1.f / D) + EPS);
#pragma unroll
            for (int j = 0; j < 4; ++j) { const float4 gv = ((const float4*)a.norm_ffn_g)[lane + 64 * j]; xv[j] = make_float4(hv[j].x * r2 * gv.x, hv[j].y * r2 * gv.y, hv[j].z * r2 * gv.z, hv[j].w * r2 * gv.w); }
            for (int k = 0; k < 128; ++k) {
                const int e = IDX[(size_t)t * 128 + k]; const float gk = GATE[(size_t)t * 128 + k];
                const float4* ur = (const float4*)(a.peer_u + (size_t)e * D) + lane;
                float dot = 0.f;
#pragma unroll
                for (int j = 0; j < 4; ++j) { const float4 u = ur[64 * j]; dot += u.x * xv[j].x + u.y * xv[j].y + u.z * xv[j].z + u.w * xv[j].w; }
                dot = wave_sum(dot);
                const float act = gk * 0.5f * dot * (1.f + erff(dot * 0.70710678118654752f));
                const float4* vr = (const float4*)(a.peer_v + (size_t)e * D) + lane;
#pragma unroll
                for (int j = 0; j < 4; ++j) { const float4 v = vr[64 * j]; ov[j].x += act * v.x; ov[j].y += act * v.y; ov[j].z += act * v.z; ov[j].w += act * v.w; }
            }
            float s2 = 0.f;
#pragma unroll
            for (int j = 0; j < 4; ++j) { ov[j].x += hv[j].x; ov[j].y += hv[j].y; ov[j].z += hv[j].z; ov[j].w += hv[j].w; s2 += ov[j].x * ov[j].x + ov[j].y * ov[j].y + ov[j].z * ov[j].z + ov[j].w * ov[j].w; }
            s2 = wave_sum(s2);
            const float r3 = rsqrtf(s2 * (1.f / D) + EPS);
            float4* op = (float4*)(a.out + (size_t)t * D) + lane;
#pragma unroll
            for (int j = 0; j < 4; ++j) { const float4 gv = ((const float4*)a.final_norm_g)[lane + 64 * j]; op[64 * j] = make_float4(ov[j].x * r3 * gv.x, ov[j].y * r3 * gv.y, ov[j].z * r3 * gv.z, ov[j].w * r3 * gv.w); }
        }
    }
#undef IN
}
}

extern "C" void kernel_launch(void* const* d_in, const int* in_sizes, int n_in, void* d_out, int out_size, void* d_ws, size_t ws_size, hipStream_t stream) {
    if (n_in != 18 || out_size != T * D || ws_size < WS_END) { fprintf(stderr, "kernel_launch: unexpected shapes n_in=%d out=%d ws=%zu\n", n_in, out_size, ws_size); return; }
    Args a{};
    const float** ap = (const float**)&a;
    for (int i = 0; i < 18; ++i) ap[i] = (const float*)d_in[i];
    a.out = (float*)d_out; a.ws = (unsigned char*)d_ws;
    constexpr int LDSB = 16384;
    for (int ph = 0; ph <= 12; ++ph) {
        a.ph_lo = ph; a.ph_hi = ph + 1;
        hipLaunchKernelGGL(k_main, dim3(1024), dim3(NTHR), LDSB, stream, a);
    }
}
```

```cpp
#include <hip/hip_runtime.h>
#include <cstdio>
#include <cstdint>

namespace {
constexpr int D = 1024, BATCH = 2, SEQ = 8192, T = BATCH * SEQ;
constexpr int PW = 2312;
constexpr int OQ = 0, OKK = 512, OV = 640, OZ = 768, OXBC = 1280, ODT = 2304;
constexpr float EPS = 1e-6f;
constexpr int NTHR = 512;
typedef unsigned short bf16;

constexpr size_t MiB = 1u << 20;
constexpr size_t WS_PROJ = 1 * MiB;
constexpr size_t WS_XN = 74 * MiB;
constexpr size_t WS_XACT = 138 * MiB;
constexpr size_t WS_DTRAW = 170 * MiB;
constexpr size_t WS_DT = WS_DTRAW + 512 * 1024;
constexpr size_t WS_ACS = WS_DT + 512 * 1024;
constexpr size_t WS_CDEC = WS_ACS + 512 * 1024;
constexpr size_t WS_CB = 172 * MiB;
constexpr size_t WS_STATES = 188 * MiB;
constexpr size_t WS_PREV = 220 * MiB;
constexpr size_t WS_QP = 1 * MiB;
constexpr size_t WS_IDX = 65 * MiB;
constexpr size_t WS_GATE = 138 * MiB;
constexpr size_t WS_TOPV = 146 * MiB;
constexpr size_t WS_TOPI = 162 * MiB;
constexpr size_t WS_END = 252 * MiB;

struct Args {
    const float* x; const float* norm_mix_g; const float* w_in; const float* attn_sinks; const float* attn_out_g;
    const float* conv_w; const float* conv_b; const float* dt_bias; const float* a_log; const float* d_skip;
    const float* ssm_norm_g; const float* w_out; const float* norm_ffn_g; const float* peer_wq; const float* peer_sub_keys;
    const float* peer_u; const float* peer_v; const float* final_norm_g;
    float* out; unsigned char* ws;
    int ph_lo, ph_hi;
};

__device__ __forceinline__ float bf2f(bf16 v) { return __uint_as_float(((unsigned)v) << 16); }
__device__ __forceinline__ bf16 f2bf(float f) { unsigned u = __float_as_uint(f); return (bf16)((u + 0x7fffu + ((u >> 16) & 1u)) >> 16); }
__device__ __forceinline__ float wave_sum(float v) {
#pragma unroll
    for (int o = 1; o < 64; o <<= 1) v += __shfl_xor(v, o);
    return v;
}
__device__ __forceinline__ float silu_f(float v) { return v / (1.f + __expf(-v)); }

template <class Epi>
__device__ __forceinline__ void gemm_naive(const float* __restrict__ A, const float* __restrict__ B, int M, int N, int K, int ldb,
                                           const Epi& epi, float* lds, int bid, int nb) {
    float* As = lds;
    float* Bs = lds + 16 * 132;
    const int tid = threadIdx.x, ty = tid >> 4, tx = tid & 15;
    const int tilesN = (N + 63) / 64, tilesM = M / 128, ntiles = tilesM * tilesN;
    for (int tile = bid; tile < ntiles; tile += nb) {
        const int tm = tile / tilesN, tn = tile - tm * tilesN;
        const int m0 = tm * 128, n0 = tn * 64;
        float acc[4][4];
#pragma unroll
        for (int i = 0; i < 4; ++i)
#pragma unroll
            for (int j = 0; j < 4; ++j) acc[i][j] = 0.f;
        for (int k0 = 0; k0 < K; k0 += 16) {
            {
                const int r = tid >> 2, kq = tid & 3;
                const float4 a = *(const float4*)(A + (size_t)(m0 + r) * K + k0 + kq * 4);
                As[(kq * 4 + 0) * 132 + r] = a.x; As[(kq * 4 + 1) * 132 + r] = a.y; As[(kq * 4 + 2) * 132 + r] = a.z; As[(kq * 4 + 3) * 132 + r] = a.w;
            }
            {
                const int kk = tid >> 5, nn = (tid & 31) * 2; const int col = n0 + nn;
                float2 bv = make_float2(0.f, 0.f);
                if (col < N) bv = *(const float2*)(B + (size_t)(k0 + kk) * ldb + col);
                *(float2*)(Bs + kk * 64 + nn) = bv;
            }
            __syncthreads();
#pragma unroll
            for (int k = 0; k < 16; ++k) {
                const float4 a = *(const float4*)(As + k * 132 + ty * 4);
                const float4 b = *(const float4*)(Bs + k * 64 + tx * 4);
                const float av[4] = {a.x, a.y, a.z, a.w}, bv[4] = {b.x, b.y, b.z, b.w};
#pragma unroll
                for (int i = 0; i < 4; ++i)
#pragma unroll
                    for (int j = 0; j < 4; ++j) acc[i][j] += av[i] * bv[j];
            }
            __syncthreads();
        }
#pragma unroll
        for (int i = 0; i < 4; ++i)
#pragma unroll
            for (int j = 0; j < 4; ++j) { const int row = m0 + ty * 4 + i, col = n0 + tx * 4 + j; if (col < N) epi(row, col, acc[i][j]); }
    }
}

__device__ __forceinline__ void rmsnorm_rows(const float* in, const float* g, float* outp, int gwave, int nwaves, int lane) {
    for (int row = gwave; row < T; row += nwaves) {
        const float4* xr = (const float4*)(in + (size_t)row * D) + lane;
        float4 v[4]; float ss = 0.f;
#pragma unroll
        for (int j = 0; j < 4; ++j) { v[j] = xr[64 * j]; ss += v[j].x * v[j].x + v[j].y * v[j].y + v[j].z * v[j].z + v[j].w * v[j].w; }
        ss = wave_sum(ss);
        const float r = rsqrtf(ss * (1.f / D) + EPS);
        float4* o = (float4*)(outp + (size_t)row * D) + lane;
#pragma unroll
        for (int j = 0; j < 4; ++j) { const float4 gv = ((const float4*)g)[lane + 64 * j]; o[64 * j] = make_float4(v[j].x * r * gv.x, v[j].y * r * gv.y, v[j].z * r * gv.z, v[j].w * r * gv.w); }
    }
}

struct EpiProj { bf16* proj; float* dtraw;
    __device__ __forceinline__ void operator()(int row, int col, float v) const { proj[(size_t)row * PW + col] = f2bf(v); if (col >= ODT) dtraw[row * 8 + (col - ODT)] = v; } };
struct EpiResid { const float* x; float* out;
    __device__ __forceinline__ void operator()(int row, int col, float v) const { out[(size_t)row * D + col] = x[(size_t)row * D + col] + v; } };
struct EpiPlain { float* out;
    __device__ __forceinline__ void operator()(int row, int col, float v) const { out[(size_t)row * D + col] = v; } };


#define LAS __attribute__((address_space(3)))
#define XB_TMO      128
#define XB_XCNT(j)  (256  + 64 * (j))
#define XB_XSUB(j)  (1280 + 64 * (j))
#define XB_XGEN(j)  (2304 + 64 * (j))
#define XB_TOP      3328
#define XB_TOPGEN   3392
#define XCD_BAR_WORDS 3456
#define XB_SPIN_CAP (1u << 22)
__device__ __forceinline__ unsigned xb_ld(unsigned* p)              { return __hip_atomic_load(p, __ATOMIC_RELAXED, __HIP_MEMORY_SCOPE_AGENT); }
__device__ __forceinline__ unsigned xb_add(unsigned* p, unsigned v) { return __hip_atomic_fetch_add(p, v, __ATOMIC_RELAXED, __HIP_MEMORY_SCOPE_AGENT); }
__device__ __forceinline__ unsigned xb_xcc_id() { return (unsigned)__builtin_amdgcn_s_getreg((3 << 11) | 20) & 0xFu; }
#define XB_SPIN(cond, bar) do { unsigned _sp = 0; while (cond) { __builtin_amdgcn_s_sleep(1); \
    if ((++_sp & 255u) == 0u) { if (xb_ld(&(bar)[XB_TMO])) break; if (_sp > XB_SPIN_CAP) { atomicAdd(&(bar)[XB_TMO], 1u); break; } } } } while (0)
struct XcdBarrier { unsigned* bar; unsigned x; volatile LAS unsigned* st; };
__device__ __forceinline__ XcdBarrier xcd_barrier_post(unsigned* bar, volatile LAS unsigned* st) {
    XcdBarrier b; b.bar = bar; b.x = xb_xcc_id(); b.st = st;
    if (threadIdx.x == 0) (void)xb_add(&bar[XB_XCNT(b.x)], 1u);
    return b;
}
__device__ __forceinline__ void xcd_barrier_complete(unsigned* bar, unsigned x, unsigned& nloc, unsigned& nx) {
    const unsigned G = gridDim.x * gridDim.y * gridDim.z;
    unsigned sum, cnt, mine, sp = 0u;
    for (;;) {
        sum = 0u; cnt = 0u; mine = 0u;
#pragma unroll
        for (unsigned j = 0; j < 16; ++j) { const unsigned c = xb_ld(&bar[XB_XCNT(j)]); sum += c; cnt += (c > 0u) ? 1u : 0u; mine = (j == x) ? c : mine; }
        if (sum == G) break;
        __builtin_amdgcn_s_sleep(1);
        if ((++sp & 255u) == 0u) { if (xb_ld(&bar[XB_TMO])) break; if (sp > XB_SPIN_CAP) { atomicAdd(&bar[XB_TMO], 1u); break; } }
    }
    nloc = mine > 0u ? mine : 1u; nx = cnt > 0u ? cnt : 1u;
}
__device__ __forceinline__ void xcd_barrier(const XcdBarrier& b) {
    asm volatile("s_waitcnt vmcnt(0)" ::: "memory");
    __syncthreads();
    if (threadIdx.x == 0) {
        unsigned* bar = b.bar;
        __builtin_amdgcn_s_waitcnt(0);
        unsigned nloc = b.st[0], nx = b.st[1];
        if (nloc == 0u) { xcd_barrier_complete(bar, b.x, nloc, nx); b.st[0] = nloc; b.st[1] = nx; }
        const unsigned old = xb_add(&bar[XB_XSUB(b.x)], 1u);
        const unsigned gen = old / nloc;
        if (old + 1u == (gen + 1u) * nloc) {
            __builtin_amdgcn_fence(__ATOMIC_RELEASE, "agent");
            asm volatile("s_waitcnt vmcnt(0)" ::: "memory");
            const unsigned og = xb_add(&bar[XB_TOP], 1u);
            const unsigned tg = og / nx;
            if (og + 1u == (tg + 1u) * nx) xb_add(&bar[XB_TOPGEN], 1u);
            else XB_SPIN(xb_ld(&bar[XB_TOPGEN]) == tg, bar);
            __builtin_amdgcn_fence(__ATOMIC_ACQUIRE, "agent");
            xb_add(&bar[XB_XGEN(b.x)], 1u);
            asm volatile("s_waitcnt vmcnt(0)" ::: "memory");
        } else {
            XB_SPIN(xb_ld(&bar[XB_XGEN(b.x)]) == gen, bar);
            __builtin_amdgcn_fence(__ATOMIC_ACQUIRE, "agent");
            asm volatile("s_waitcnt vmcnt(0)" ::: "memory");
        }
    }
    __syncthreads();
}
constexpr int LDS_BYTES = 147456;
constexpr int MISC_OFF = 131072 + 320;


__global__ void __launch_bounds__(NTHR) k_main(Args a) {
    extern __shared__ __attribute__((aligned(16))) unsigned char lds_raw[];
    float* lds = (float*)lds_raw;
    const int tid = threadIdx.x, lane = tid & 63, bid = blockIdx.x, nb = gridDim.x;
    const int gtid = bid * NTHR + tid, gthreads = nb * NTHR, gwave = gtid >> 6, nwaves = gthreads >> 6;
    unsigned char* ws = a.ws;
    bf16* PROJ = (bf16*)(ws + WS_PROJ);
    float* XN = (float*)(ws + WS_XN);
    bf16* XACT = (bf16*)(ws + WS_XACT);
    float* DTRAW = (float*)(ws + WS_DTRAW); float* DT = (float*)(ws + WS_DT); float* ACS = (float*)(ws + WS_ACS); float* CDEC = (float*)(ws + WS_CDEC);
    float* CB = (float*)(ws + WS_CB); float* STATES = (float*)(ws + WS_STATES); float* PREV = (float*)(ws + WS_PREV);
    float* QP = (float*)(ws + WS_QP); int* IDX = (int*)(ws + WS_IDX); float* GATE = (float*)(ws + WS_GATE);
    float* TOPV = (float*)(ws + WS_TOPV); int* TOPI = (int*)(ws + WS_TOPI);
    float* MIX = XN; float* XN2 = XN;
    volatile LAS unsigned* MISC = (volatile LAS unsigned*)((LAS unsigned char*)lds_raw + MISC_OFF);
    if (tid < 32) MISC[tid] = 0u;
    __syncthreads();
    XcdBarrier bar = xcd_barrier_post((unsigned*)ws, MISC + 8);
#define IN(k) (a.ph_lo <= (k) && (k) < a.ph_hi)
#define GRID_BAR() xcd_barrier(bar)

    if (IN(0)) rmsnorm_rows(a.x, a.norm_mix_g, XN, gwave, nwaves, lane);

    GRID_BAR();
    if (IN(1)) { EpiProj e{PROJ, DTRAW}; gemm_naive(XN, a.w_in, T, PW, D, PW, e, lds, bid, nb); }

    GRID_BAR();
    if (IN(2)) {
        for (int idx = gtid; idx < T * 1024; idx += gthreads) {
            const int t = idx >> 10, c = idx & 1023, s = t & (SEQ - 1);
            float acc = a.conv_b[c];
#pragma unroll
            for (int k = 0; k < 4; ++k) { const int sp = s + k - 3; if (sp >= 0) acc += a.conv_w[k * 1024 + c] * bf2f(PROJ[(size_t)(t + k - 3) * PW + OXBC + c]); }
            XACT[idx] = f2bf(silu_f(acc));
        }
        if (gtid < 1024) {
            const int h = gtid & 7, bc = gtid >> 3;
            const float A = -__expf(a.a_log[h]), bias = a.dt_bias[h];
            float run = 0.f;
            for (int l = 0; l < 128; ++l) {
                const int t = bc * 128 + l;
                const float raw = DTRAW[t * 8 + h] + bias;
                const float dt = fmaxf(raw, 0.f) + log1pf(__expf(-fabsf(raw)));
                DT[t * 8 + h] = dt; run += dt * A; ACS[t * 8 + h] = run;
            }
            CDEC[gtid] = __expf(run);
        }
    }

    GRID_BAR();
    if (IN(3)) {
        for (int task = gwave; task < 8 * (T / 64); task += nwaves) {
            const int tg = task >> 3, hq = task & 7, t = tg * 64 + lane, b = t / SEQ, s = t - b * SEQ, hkv = hq >> 2;
            float q[64], o[64];
            {
                const uint4* qp = (const uint4*)(PROJ + (size_t)t * PW + OQ + hq * 64);
#pragma unroll
                for (int i = 0; i < 8; ++i) { const uint4 w = qp[i]; const unsigned ww[4] = {w.x, w.y, w.z, w.w};
#pragma unroll
                    for (int j = 0; j < 4; ++j) { q[i * 8 + j * 2] = __uint_as_float(ww[j] << 16) * 0.125f; q[i * 8 + j * 2 + 1] = __uint_as_float(ww[j] & 0xffff0000u) * 0.125f; } }
            }
#pragma unroll
            for (int d = 0; d < 64; ++d) o[d] = 0.f;
            const float slope = exp2f(-(float)(hq + 1));
            float m = a.attn_sinks[hq], l = 1.f;
            for (int j = 0; j < 128; ++j) {
                const int ks = s - 127 + j;
                if (ks >= 0) {
                    const uint4* kp = (const uint4*)(PROJ + (size_t)(b * SEQ + ks) * PW + OKK + hkv * 64);
                    float dot = 0.f;
#pragma unroll
                    for (int i = 0; i < 8; ++i) { const uint4 w = kp[i]; const unsigned ww[4] = {w.x, w.y, w.z, w.w};
#pragma unroll
                        for (int jj = 0; jj < 4; ++jj) { dot += q[i * 8 + jj * 2] * __uint_as_float(ww[jj] << 16); dot += q[i * 8 + jj * 2 + 1] * __uint_as_float(ww[jj] & 0xffff0000u); } }
                    const float logit = dot - slope * (float)(127 - j);
                    if (logit > m) { const float sc = __expf(m - logit); l *= sc;
#pragma unroll
                        for (int d = 0; d < 64; ++d) o[d] *= sc;
                        m = logit; }
                    const float pe = __expf(logit - m); l += pe;
                    const uint4* vp = (const uint4*)(PROJ + (size_t)(b * SEQ + ks) * PW + OV + hkv * 64);
#pragma unroll
                    for (int i = 0; i < 8; ++i) { const uint4 w = vp[i]; const unsigned ww[4] = {w.x, w.y, w.z, w.w};
#pragma unroll
                        for (int jj = 0; jj < 4; ++jj) { o[i * 8 + jj * 2] += pe * __uint_as_float(ww[jj] << 16); o[i * 8 + jj * 2 + 1] += pe * __uint_as_float(ww[jj] & 0xffff0000u); } }
                }
            }
            const float inv = 1.f / l;
            float4* op = (float4*)(MIX + (size_t)t * D + hq * 64);
#pragma unroll
            for (int i = 0; i < 16; ++i) op[i] = make_float4(o[i * 4] * inv, o[i * 4 + 1] * inv, o[i * 4 + 2] * inv, o[i * 4 + 3] * inv);
        }
        for (int idx = gtid; idx < 256 * 128 * 128; idx += gthreads) {
            const int s = idx & 127, l = (idx >> 7) & 127, unit = idx >> 14, g = unit & 1, tok0 = (unit >> 1) * 128;
            float acc = 0.f;
            if (s <= l) {
                const bf16* cp = XACT + (size_t)(tok0 + l) * 1024 + 768 + g * 128;
                const bf16* bp = XACT + (size_t)(tok0 + s) * 1024 + 512 + g * 128;
                for (int n = 0; n < 128; ++n) acc += bf2f(cp[n]) * bf2f(bp[n]);
            }
            CB[idx] = acc;
        }
    }

    GRID_BAR();
    if (IN(4)) {
        for (int idx = gtid; idx < T * 512; idx += gthreads) {
            const int p = idx & 63, h = (idx >> 6) & 7, t = idx >> 9, l = t & 127, tok0 = t - l, unit = (t >> 7) * 2 + (h >> 2);
            const float acs_l = ACS[t * 8 + h];
            const float* cbrow = CB + ((size_t)unit * 128 + l) * 128;
            float acc = 0.f;
            for (int s = 0; s <= l; ++s) {
                const int ts = tok0 + s;
                const float w = cbrow[s] * __expf(acs_l - ACS[ts * 8 + h]) * DT[ts * 8 + h];
                acc += w * bf2f(XACT[(size_t)ts * 1024 + h * 64 + p]);
            }
            MIX[(size_t)t * D + 512 + h * 64 + p] = acc;
        }
        for (int idx = gtid; idx < 1024 * 8192; idx += gthreads) {
            const int p = idx & 63, n = (idx >> 6) & 127, bch = idx >> 13, h = bch & 7, g = h >> 2, tok0 = (bch >> 3) * 128;
            const float acs_last = ACS[(tok0 + 127) * 8 + h];
            float acc = 0.f;
            for (int s = 0; s < 128; ++s) {
                const int ts = tok0 + s;
                const float w = __expf(acs_last - ACS[ts * 8 + h]) * DT[ts * 8 + h];
                acc += bf2f(XACT[(size_t)ts * 1024 + 512 + g * 128 + n]) * w * bf2f(XACT[(size_t)ts * 1024 + h * 64 + p]);
            }
            STATES[idx] = acc;
        }
    }

    GRID_BAR();
    if (IN(5)) {
        for (int idx = gtid; idx < 2 * 8 * 8192; idx += gthreads) {
            const int pn = idx & 8191, h = (idx >> 13) & 7, b = idx >> 16;
            float run = 0.f;
            for (int c = 0; c < 64; ++c) {
                const int bch = (b * 64 + c) * 8 + h; const size_t o = (size_t)bch * 8192 + pn;
                PREV[o] = run; run = CDEC[bch] * run + STATES[o];
            }
        }
    }

    GRID_BAR();
    if (IN(6)) {
        for (int t = gwave; t < T; t += nwaves) {
            const int p = lane, bc = t >> 7;
            float yv[8];
#pragma unroll
            for (int h = 0; h < 8; ++h) {
                const int g = h >> 2; const float ea = __expf(ACS[t * 8 + h]);
                const float* pv = PREV + (size_t)(bc * 8 + h) * 8192 + p;
                const bf16* cp = XACT + (size_t)t * 1024 + 768 + g * 128;
                float acc = 0.f;
                for (int n = 0; n < 128; ++n) acc += bf2f(cp[n]) * pv[n * 64];
                float y = MIX[(size_t)t * D + 512 + h * 64 + p] + ea * acc + a.d_skip[h] * bf2f(XACT[(size_t)t * 1024 + h * 64 + p]);
                const float z = bf2f(PROJ[(size_t)t * PW + OZ + h * 64 + p]);
                yv[h] = y * silu_f(z);
            }
#pragma unroll
            for (int g = 0; g < 2; ++g) {
                float ss = 0.f;
#pragma unroll
                for (int r = 0; r < 4; ++r) ss += yv[g * 4 + r] * yv[g * 4 + r];
                ss = wave_sum(ss);
                const float rr = rsqrtf(ss * (1.f / 256.f) + EPS);
#pragma unroll
                for (int r = 0; r < 4; ++r) { const int h = g * 4 + r; MIX[(size_t)t * D + 512 + h * 64 + p] = yv[h] * rr * a.ssm_norm_g[h * 64 + p]; }
            }
            float av[8], ss = 0.f;
#pragma unroll
            for (int h = 0; h < 8; ++h) { av[h] = MIX[(size_t)t * D + h * 64 + p]; ss += av[h] * av[h]; }
            ss = wave_sum(ss);
            const float rr = rsqrtf(ss * (1.f / 512.f) + EPS);
#pragma unroll
            for (int h = 0; h < 8; ++h) MIX[(size_t)t * D + h * 64 + p] = av[h] * rr * a.attn_out_g[h * 64 + p];
        }
    }

    GRID_BAR();
    if (IN(7)) { EpiResid e{a.x, a.out}; gemm_naive(MIX, a.w_out, T, D, D, D, e, lds, bid, nb); }

    GRID_BAR();
    if (IN(8)) rmsnorm_rows(a.out, a.norm_ffn_g, XN2, gwave, nwaves, lane);
    GRID_BAR();
    if (IN(9)) { EpiPlain e{QP}; gemm_naive(XN2, a.peer_wq, T, D, D, D, e, lds, bid, nb); }

    GRID_BAR();
    if (IN(10)) {
        for (int item = gtid; item < 16 * T; item += gthreads) {
            const int t = item & (T - 1), hh = item >> 14, half = hh & 1;
            float q[64];
            const float4* qp = (const float4*)(QP + (size_t)t * D + hh * 64);
#pragma unroll
            for (int i = 0; i < 16; ++i) { const float4 w = qp[i]; q[i * 4] = w.x; q[i * 4 + 1] = w.y; q[i * 4 + 2] = w.z; q[i * 4 + 3] = w.w; }
            float bv[16]; int bi[16];
#pragma unroll
            for (int r = 0; r < 16; ++r) { bv[r] = -INFINITY; bi[r] = 0; }
            const float* kbase = a.peer_sub_keys + (size_t)half * 128 * 64;
            for (int k = 0; k < 128; ++k) {
                const float4* kp = (const float4*)(kbase + k * 64);
                float sc = 0.f;
#pragma unroll
                for (int i = 0; i < 16; ++i) { const float4 w = kp[i]; sc += q[i * 4] * w.x + q[i * 4 + 1] * w.y + q[i * 4 + 2] * w.z + q[i * 4 + 3] * w.w; }
                float cv = sc; int ci = k;
#pragma unroll
                for (int r = 0; r < 16; ++r) { const bool gt = cv > bv[r]; const float tv = gt ? bv[r] : cv; const int ti = gt ? bi[r] : ci; bv[r] = gt ? cv : bv[r]; bi[r] = gt ? ci : bi[r]; cv = tv; ci = ti; }
            }
            float* tv = TOPV + ((size_t)t * 16 + hh) * 16; int* ti = TOPI + ((size_t)t * 16 + hh) * 16;
#pragma unroll
            for (int r = 0; r < 16; ++r) { tv[r] = bv[r]; ti[r] = bi[r]; }
        }
    }
    GRID_BAR();
    if (IN(11)) {
        for (int item = gtid; item < 8 * T; item += gthreads) {
            const int t = item & (T - 1), hd = item >> 14;
            const float* v1 = TOPV + ((size_t)t * 16 + hd * 2) * 16; const float* v2 = v1 + 16;
            const int* i1 = TOPI + ((size_t)t * 16 + hd * 2) * 16; const int* i2 = i1 + 16;
            float bv[16]; int bi[16];
#pragma unroll
            for (int r = 0; r < 16; ++r) { bv[r] = -INFINITY; bi[r] = 0; }
#pragma unroll 1
            for (int aa = 0; aa < 16; ++aa) {
                const float va = v1[aa]; const int ia = i1[aa];
#pragma unroll 1
                for (int bb = 0; bb < 16; ++bb) {
                    float cv = va + v2[bb]; int ci = ia * 128 + i2[bb];
#pragma unroll
                    for (int r = 0; r < 16; ++r) { const bool gt = cv > bv[r]; const float tv = gt ? bv[r] : cv; const int ti = gt ? bi[r] : ci; bv[r] = gt ? cv : bv[r]; bi[r] = gt ? ci : bi[r]; cv = tv; ci = ti; }
                }
            }
            float e[16], se = 0.f;
#pragma unroll
            for (int r = 0; r < 16; ++r) { e[r] = __expf(bv[r] - bv[0]); se += e[r]; }
            const float inv = 1.f / se;
            float* gp = GATE + (size_t)t * 128 + hd * 16; int* ip = IDX + (size_t)t * 128 + hd * 16;
#pragma unroll
            for (int r = 0; r < 16; ++r) { gp[r] = e[r] * inv; ip[r] = bi[r]; }
        }
    }

    GRID_BAR();
    if (IN(12)) {
        for (int t = gwave; t < T; t += nwaves) {
            const float4* hr = (const float4*)(a.out + (size_t)t * D) + lane;
            float4 hv[4], xv[4], ov[4]; float ss = 0.f;
#pragma unroll
            for (int j = 0; j < 4; ++j) { hv[j] = hr[64 * j]; ss += hv[j].x * hv[j].x + hv[j].y * hv[j].y + hv[j].z * hv[j].z + hv[j].w * hv[j].w; ov[j] = make_float4(0.f, 0.f, 0.f, 0.f); }
            ss = wave_sum(ss);
            const float r2 = rsqrtf(ss * (1.f / D) + EPS);
#pragma unroll
            for (int j = 0; j < 4; ++j) { const float4 gv = ((const float4*)a.norm_ffn_g)[lane + 64 * j]; xv[j] = make_float4(hv[j].x * r2 * gv.x, hv[j].y * r2 * gv.y, hv[j].z * r2 * gv.z, hv[j].w * r2 * gv.w); }
            for (int k = 0; k < 128; ++k) {
                const int e = IDX[(size_t)t * 128 + k]; const float gk = GATE[(size_t)t * 128 + k];
                const float4* ur = (const float4*)(a.peer_u + (size_t)e * D) + lane;
                float dot = 0.f;
#pragma unroll
                for (int j = 0; j < 4; ++j) { const float4 u = ur[64 * j]; dot += u.x * xv[j].x + u.y * xv[j].y + u.z * xv[j].z + u.w * xv[j].w; }
                dot = wave_sum(dot);
                const float act = gk * 0.5f * dot * (1.f + erff(dot * 0.70710678118654752f));
                const float4* vr = (const float4*)(a.peer_v + (size_t)e * D) + lane;
#pragma unroll
                for (int j = 0; j < 4; ++j) { const float4 v = vr[64 * j]; ov[j].x += act * v.x; ov[j].y += act * v.y; ov[j].z += act * v.z; ov[j].w += act * v.w; }
            }
            float s2 = 0.f;
#pragma unroll
            for (int j = 0; j < 4; ++j) { ov[j].x += hv[j].x; ov[j].y += hv[j].y; ov[j].z += hv[j].z; ov[j].w += hv[j].w; s2 += ov[j].x * ov[j].x + ov[j].y * ov[j].y + ov[j].z * ov[j].z + ov[j].w * ov[j].w; }
            s2 = wave_sum(s2);
            const float r3 = rsqrtf(s2 * (1.f / D) + EPS);
            float4* op = (float4*)(a.out + (size_t)t * D) + lane;
#pragma unroll
            for (int j = 0; j < 4; ++j) { const float4 gv = ((const float4*)a.final_norm_g)[lane + 64 * j]; op[64 * j] = make_float4(ov[j].x * r3 * gv.x, ov[j].y * r3 * gv.y, ov[j].z * r3 * gv.z, ov[j].w * r3 * gv.w); }
        }
    }
#undef IN
}
}

extern "C" void kernel_launch(void* const* d_in, const int* in_sizes, int n_in, void* d_out, int out_size, void* d_ws, size_t ws_size, hipStream_t stream) {
    if (n_in != 18 || out_size != T * D || ws_size < WS_END) { fprintf(stderr, "kernel_launch: unexpected shapes n_in=%d out=%d ws=%zu\n", n_in, out_size, ws_size); return; }
    Args a{};
    const float** ap = (const float**)&a;
    for (int i = 0; i < 18; ++i) ap[i] = (const float*)d_in[i];
    a.out = (float*)d_out; a.ws = (unsigned char*)d_ws;
    static int grid = 0;
    if (grid == 0) {
        int dev = 0, cus = 0, per_cu = 0;
        if (hipGetDevice(&dev) != hipSuccess || hipDeviceGetAttribute(&cus, hipDeviceAttributeMultiprocessorCount, dev) != hipSuccess) { fprintf(stderr, "kernel_launch: device query failed\n"); grid = -1; return; }
        if (hipFuncSetAttribute((const void*)k_main, hipFuncAttributeMaxDynamicSharedMemorySize, LDS_BYTES) != hipSuccess) { fprintf(stderr, "kernel_launch: hipFuncSetAttribute failed\n"); grid = -1; return; }
        if (hipOccupancyMaxActiveBlocksPerMultiprocessor(&per_cu, (const void*)k_main, NTHR, LDS_BYTES) != hipSuccess || per_cu < 1) { fprintf(stderr, "kernel_launch: occupancy query says %d blocks/CU\n", per_cu); (void)hipGetLastError(); grid = -1; return; }
        grid = cus;
    }
    if (grid < 0) return;
    if (hipMemsetAsync(d_ws, 0, 65536, stream) != hipSuccess) { fprintf(stderr, "kernel_launch: memset failed\n"); return; }
    a.ph_lo = 0; a.ph_hi = 13;
    hipLaunchKernelGGL(k_main, dim3(grid), dim3(NTHR), LDS_BYTES, stream, a);
}
```

```cpp
#include <hip/hip_runtime.h>
#include <cstdio>
#include <cstdint>

namespace pg8 {
#define PG8_LAS __attribute__((address_space(3)))
typedef unsigned short bf16_t;
typedef short bf16x8 __attribute__((ext_vector_type(8)));
typedef float f32x4 __attribute__((ext_vector_type(4)));
typedef unsigned u32x4 __attribute__((ext_vector_type(4)));
constexpr int BM = 256, BK = 64, HALF = 128, HTB = HALF * BK * 2  , STAGE_BYTES = 8 * HTB, NXCD = 8, WGM = 8;

__host__ __device__ __forceinline__ int lds_byte(int r, int c) { const int st = (r >> 4) * 2 + (c >> 5), rr = r & 15, cc = c & 31, ob = rr * 64 + cc * 2; return st * 1024 + (ob ^ (((ob >> 9) & 1) << 5)); }
__host__ __device__ __forceinline__ void stage_rc(int b, int& R, int& C) { const int st = b / 1024, sb = b % 1024, swz = sb ^ (((sb >> 9) & 1) << 5); R = (st >> 1) * 16 + swz / 64; C = (st & 1) * 32 + (swz % 64) / 2; }
__host__ __device__ __forceinline__ int perm32(int rho) { const int n = rho >> 4, i = rho & 15; return 8 * (i >> 2) + 4 * n + (i & 3); }

struct Unit { int pm, pn; };
struct Gemm { const bf16_t* A; const bf16_t* Bt; int M, N, K; };

struct StaticOrder {
    int nM, nN, nwg, G, c;
    __host__ __device__ void init(int M, int N, int G_, int c_) { nM = M / BM; nN = N / BM; nwg = nM * nN; G = G_; c = c_; }
    __host__ __device__ bool next(int i, Unit& u) const {
        const long L = (long)i * G + c; if (L >= nwg) return false;
        int wgid = (int)L; { const int q = nwg / NXCD, r = nwg % NXCD, xcd = wgid % NXCD, off = wgid / NXCD; wgid = (xcd < r ? xcd * (q + 1) : r * (q + 1) + (xcd - r) * q) + off; }
        const int nig = WGM * nN, gid = wgid / nig, fm = gid * WGM, gsz = (nM - fm) < WGM ? (nM - fm) : WGM;
        u.pm = fm + ((wgid % nig) % gsz); u.pn = (wgid % nig) / gsz; return true;
    }
    __device__ __forceinline__ void a_ready(const Unit&) const {}
    __device__ __forceinline__ void done(const Unit&) const {}
};
__device__ __forceinline__ unsigned cvt_pk_bf16(float lo, float hi) { unsigned r; asm volatile("v_cvt_pk_bf16_f32 %0, %1, %2" : "=v"(r) : "v"(lo), "v"(hi)); return r; }
typedef float f32x2 __attribute__((ext_vector_type(2)));
struct EpiBf16Plain {
    static constexpr bool PERM = true, AFTER_DRAIN = false;
    bf16_t* O; int ldc;
    __device__ __forceinline__ void operator()(const f32x4 (&acc)[2][2][4][2], const Unit& u, int wr, int wc, int fr, int fq) const {
        const int row0 = u.pm * BM + wr * 64 + fr, col0 = u.pn * BM + wc * 32 + 8 * fq;
#pragma unroll
        for (int ai = 0; ai < 2; ++ai)
#pragma unroll
            for (int m = 0; m < 4; ++m) { bf16_t* rowp = O + (size_t)(row0 + ai * HALF + m * 16) * ldc + col0;
#pragma unroll
                for (int bj = 0; bj < 2; ++bj) { const f32x4 v0 = acc[ai][bj][m][0], v1 = acc[ai][bj][m][1];
                    u32x4 w; w.x = cvt_pk_bf16(v0[0], v0[1]); w.y = cvt_pk_bf16(v0[2], v0[3]); w.z = cvt_pk_bf16(v1[0], v1[1]); w.w = cvt_pk_bf16(v1[2], v1[3]);
                    *(u32x4*)(rowp + bj * HALF) = w; } }
    }
};
struct EpiF32Resid {
    static constexpr bool PERM = false, AFTER_DRAIN = false;
    float* C; const float* R; int ldc;
    __device__ __forceinline__ void operator()(const f32x4 (&acc)[2][2][4][2], const Unit& u, int wr, int wc, int fr, int fq) const {
        const int row0 = u.pm * BM + wr * 64 + fr, col0 = u.pn * BM + wc * 32 + 4 * fq;
#pragma unroll
        for (int ai = 0; ai < 2; ++ai)
#pragma unroll
            for (int m = 0; m < 4; ++m) { const size_t off = (size_t)(row0 + ai * HALF + m * 16) * ldc + col0;
#pragma unroll
                for (int bj = 0; bj < 2; ++bj)
#pragma unroll
                    for (int n = 0; n < 2; ++n) { f32x4 v = acc[ai][bj][m][n]; if (R) v += *(const f32x4*)(R + off + bj * HALF + n * 16); *(f32x4*)(C + off + bj * HALF + n * 16) = v; }
                asm volatile("" ::: "memory"); }
    }
};
template <class Epi, class Sched, bool STAMP = false>
__device__ __forceinline__ void gemm_phase(PG8_LAS unsigned char* lds, const Gemm g, const Sched& S, const Epi& E, unsigned long long* stamps) {
    const int tid = threadIdx.x, wid = __builtin_amdgcn_readfirstlane(tid >> 6), lane = tid & 63, wr = wid >> 2, wc = wid & 3, fr = lane & 15, fq = lane >> 4;
    const int K = g.K, nt = K / BK;
    int ts_lo = 0, ts_hi = 0, nts = 0; const unsigned long long rt_entry = STAMP ? (unsigned long long)0ull : 0ull;
#define PG8_STAMP() do { if (STAMP && wid == 0 && nts < 64) { const unsigned long long _c = (unsigned long long)clock64(); \
        ts_lo = (lane == nts) ? (int)(unsigned)_c : ts_lo; ts_hi = (lane == nts) ? (int)(unsigned)(_c >> 32) : ts_hi; ++nts; } } while (0)
    PG8_STAMP();
    unsigned voffA[2], voffB[2];
#pragma unroll
    for (int i = 0; i < 2; ++i) { int R, C; stage_rc(tid * 16 + i * 8192, R, C); const int Rb = Epi::PERM ? ((R & ~31) + perm32(R & 31)) : R;
        voffA[i] = (unsigned)(R * K + C) * 2u; voffB[i] = (unsigned)(Rb * K + C) * 2u; }
    const size_t kstep = (size_t)(BK * 2);
    const size_t hstep = (size_t)HALF * K * 2;
    const size_t tstep = 2 * hstep;
    const unsigned ldsw = (unsigned)wid * 1024u;
    const int aoff = lds_byte(wr * 64 + fr, fq * 8), boff = lds_byte(wc * 32 + fr, fq * 8);
#define PG8_SA(b, h) (((b) * 2 + (h)) * HTB)
#define PG8_SB(b, h) ((4 + (b) * 2 + (h)) * HTB)
#define PG8_STAGE(bufoff, gbase, voff) do { _Pragma("unroll") for (int _i = 0; _i < 2; ++_i) \
        __builtin_amdgcn_global_load_lds((const unsigned*)((const char*)(gbase) + (voff)[_i]), (PG8_LAS unsigned*)(lds + (bufoff) + ldsw + _i * 8192), 16, 0, 0); } while (0)
#define PG8_LDA(dst, b, h) do { _Pragma("unroll") for (int m = 0; m < 4; ++m) _Pragma("unroll") for (int k = 0; k < 2; ++k) dst[m][k] = *(const PG8_LAS bf16x8*)(lds + PG8_SA(b, h) + aoff + m * 2048 + k * 1024); } while (0)
#define PG8_LDB(dst, b, h) do { _Pragma("unroll") for (int n = 0; n < 2; ++n) _Pragma("unroll") for (int k = 0; k < 2; ++k) dst[n][k] = *(const PG8_LAS bf16x8*)(lds + PG8_SB(b, h) + boff + n * 2048 + k * 1024); } while (0)
#define PG8_MMA(ai, bj, At, Bt) do { __builtin_amdgcn_s_setprio(1); _Pragma("unroll") for (int m = 0; m < 4; ++m) _Pragma("unroll") for (int n = 0; n < 2; ++n) _Pragma("unroll") for (int k = 0; k < 2; ++k) \
        acc[ai][bj][m][n] = __builtin_amdgcn_mfma_f32_16x16x32_bf16(Bt[n][k], At[m][k], acc[ai][bj][m][n], 0, 0, 0); __builtin_amdgcn_s_setprio(0); } while (0)
#define PG8_WAIT_V(n) asm volatile("s_waitcnt vmcnt(" #n ")" ::: "memory")
#define PG8_WAIT_L(n) asm volatile("s_waitcnt lgkmcnt(" #n ")" ::: "memory")
#define PG8_BAR __builtin_amdgcn_s_barrier()
#define PG8_SCHED __builtin_amdgcn_sched_barrier(0)
    Unit cur, nxt; int ui = 0;
    if (!S.next(0, cur)) return;
    f32x4 acc[2][2][4][2];
#pragma unroll
    for (int a = 0; a < 2; ++a)
#pragma unroll
        for (int b = 0; b < 2; ++b)
#pragma unroll
            for (int m = 0; m < 4; ++m)
#pragma unroll
                for (int n = 0; n < 2; ++n) acc[a][b][m][n] = (f32x4){0.f, 0.f, 0.f, 0.f};
    bf16x8 At[4][2], B0[2][2], B1[2][2];
    const char* cA = (const char*)g.A + (size_t)cur.pm * tstep; const char* cB = (const char*)g.Bt + (size_t)cur.pn * tstep;
    S.a_ready(cur);
    PG8_STAGE(PG8_SB(0, 0), cB, voffB); PG8_STAGE(PG8_SA(0, 0), cA, voffA); PG8_STAGE(PG8_SB(0, 1), cB + hstep, voffB); PG8_STAGE(PG8_SA(0, 1), cA + hstep, voffA);
    if (wr == 1) PG8_BAR;
    PG8_WAIT_V(4); PG8_BAR;
    PG8_STAGE(PG8_SB(1, 0), cB + kstep, voffB); PG8_STAGE(PG8_SA(1, 0), cA + kstep, voffA); PG8_STAGE(PG8_SB(1, 1), cB + hstep + kstep, voffB);
    PG8_WAIT_V(6); PG8_BAR;
    PG8_STAMP();
    for (;;) {
        const bool has_next = S.next(ui + 1, nxt);
        const char* nA = has_next ? (const char*)g.A + (size_t)nxt.pm * tstep : cA; const char* nB = has_next ? (const char*)g.Bt + (size_t)nxt.pn * tstep : cB;
        for (int t = 0; t < nt; t += 2) {
            const bool last = (t == nt - 2);
            const char* a1 = cA + (size_t)(t + 1) * kstep;
            const char* a2 = last ? nA : cA + (size_t)(t + 2) * kstep; const char* b2 = last ? nB : cB + (size_t)(t + 2) * kstep;
            const char* a3 = a2 + kstep; const char* b3 = b2 + kstep;
            if (last && has_next) S.a_ready(nxt);
            PG8_LDB(B0, 0, 0); PG8_SCHED; PG8_LDA(At, 0, 0); PG8_STAGE(PG8_SA(1, 1), a1 + hstep, voffA);
            PG8_WAIT_L(8); PG8_BAR; PG8_WAIT_L(0); PG8_MMA(0, 0, At, B0); PG8_BAR; PG8_SCHED;
            PG8_LDB(B1, 0, 1); PG8_STAGE(PG8_SB(0, 0), b2, voffB);
            PG8_BAR; PG8_WAIT_L(0); PG8_MMA(0, 1, At, B1); PG8_BAR;
            PG8_LDA(At, 0, 1); PG8_STAGE(PG8_SA(0, 0), a2, voffA);
            PG8_BAR; PG8_WAIT_L(0); PG8_MMA(1, 0, At, B0); PG8_BAR; PG8_SCHED;
            PG8_STAGE(PG8_SB(0, 1), b2 + hstep, voffB);
            PG8_WAIT_V(6); PG8_BAR; PG8_MMA(1, 1, At, B1); PG8_BAR;
            PG8_LDB(B0, 1, 0); PG8_SCHED; PG8_LDA(At, 1, 0); PG8_STAGE(PG8_SA(0, 1), a2 + hstep, voffA);
            PG8_WAIT_L(8); PG8_BAR; PG8_WAIT_L(0); PG8_MMA(0, 0, At, B0); PG8_BAR; PG8_SCHED;
            PG8_LDB(B1, 1, 1); PG8_STAGE(PG8_SB(1, 0), b3, voffB);
            PG8_BAR; PG8_WAIT_L(0); PG8_MMA(0, 1, At, B1); PG8_BAR;
            PG8_LDA(At, 1, 1); PG8_STAGE(PG8_SA(1, 0), a3, voffA);
            PG8_BAR; PG8_WAIT_L(0); PG8_MMA(1, 0, At, B0); PG8_BAR; PG8_SCHED;
            PG8_STAGE(PG8_SB(1, 1), b3 + hstep, voffB);
            PG8_WAIT_V(6); PG8_BAR; PG8_MMA(1, 1, At, B1); PG8_BAR;
        }
        PG8_STAMP();
        if constexpr (!Epi::AFTER_DRAIN) { E(acc, cur, wr, wc, fr, fq); S.done(cur); }
        PG8_STAMP();
        if (!has_next) break;
#pragma unroll
        for (int a = 0; a < 2; ++a)
#pragma unroll
            for (int b = 0; b < 2; ++b)
#pragma unroll
                for (int m = 0; m < 4; ++m)
#pragma unroll
                    for (int n = 0; n < 2; ++n) acc[a][b][m][n] = (f32x4){0.f, 0.f, 0.f, 0.f};
        cur = nxt; cA = nA; cB = nB; ++ui;
    }
    PG8_WAIT_V(0);
    if (wr == 0) PG8_BAR;
    PG8_BAR;
    if constexpr (Epi::AFTER_DRAIN) { E.fused(acc, cur, wr, wc, fr, fq, lds, wid, lane); S.done(cur); }
    PG8_STAMP();
    if (STAMP && wid == 0) { stamps[lane] = lane < nts ? (((unsigned long long)(unsigned)ts_hi << 32) | (unsigned)ts_lo) : 0ull;
        if (lane == 62) stamps[62] = rt_entry; if (lane == 63) stamps[63] = (unsigned long long)0ull; }
#undef PG8_STAMP
#undef PG8_SA
#undef PG8_SB
#undef PG8_STAGE
#undef PG8_LDA
#undef PG8_LDB
#undef PG8_MMA
#undef PG8_WAIT_V
#undef PG8_WAIT_L
#undef PG8_BAR
#undef PG8_SCHED
}
}

namespace {
constexpr int D = 1024, BATCH = 2, SEQ = 8192, T = BATCH * SEQ;
constexpr int PW = 2312;
constexpr int PS = 2304;
constexpr int OQ = 0, OKK = 512, OV = 640, OZ = 768, OXBC = 1280, ODT = 2304;
constexpr float EPS = 1e-6f;
constexpr int NTHR = 512;
typedef unsigned short bf16;
typedef unsigned v4u __attribute__((ext_vector_type(4)));

constexpr size_t MiB = 1u << 20;
constexpr size_t WS_WIN = 1 * MiB;
constexpr size_t WS_WO = 6 * MiB;
constexpr size_t WS_WQ = 8 * MiB;
constexpr size_t WS_PROJ = 10 * MiB;
constexpr size_t WS_XNB = 82 * MiB;
constexpr size_t WS_XACT = 114 * MiB;
constexpr size_t WS_DTRAW = 146 * MiB;
constexpr size_t WS_DT = WS_DTRAW + 512 * 1024;
constexpr size_t WS_ACS = WS_DT + 512 * 1024;
constexpr size_t WS_CDEC = WS_ACS + 512 * 1024;
constexpr size_t WS_STATES = 164 * MiB;
constexpr size_t WS_PREV = 196 * MiB;
constexpr size_t WS_QP = 10 * MiB;
constexpr size_t WS_IDX = 74 * MiB;
constexpr size_t WS_GATE = 114 * MiB;
constexpr size_t WS_TOPV = 122 * MiB;
constexpr size_t WS_TOPI = 138 * MiB;
constexpr size_t WS_UB = 164 * MiB;
constexpr size_t WS_VB = 196 * MiB;
constexpr size_t WS_END = 228 * MiB;

struct Args {
    const float* x; const float* norm_mix_g; const float* w_in; const float* attn_sinks; const float* attn_out_g;
    const float* conv_w; const float* conv_b; const float* dt_bias; const float* a_log; const float* d_skip;
    const float* ssm_norm_g; const float* w_out; const float* norm_ffn_g; const float* peer_wq; const float* peer_sub_keys;
    const float* peer_u; const float* peer_v; const float* final_norm_g;
    float* out; unsigned char* ws;
    int ph_lo, ph_hi;
};

#define LAS __attribute__((address_space(3)))
#define LDS_WAIT() asm volatile("s_waitcnt lgkmcnt(0)" ::: "memory")
__device__ __forceinline__ float bf2f(bf16 v) { return __uint_as_float(((unsigned)v) << 16); }
__device__ __forceinline__ unsigned f2bfu(float f) { unsigned u = __float_as_uint(f); return (u + 0x7fffu + ((u >> 16) & 1u)) >> 16; }
__device__ __forceinline__ bf16 f2bf(float f) { return (bf16)f2bfu(f); }
__device__ __forceinline__ unsigned pk2(float lo, float hi) { return f2bfu(lo) | (f2bfu(hi) << 16); }
__device__ __forceinline__ float wave_sum(float v) {
#pragma unroll
    for (int o = 1; o < 64; o <<= 1) v += __shfl_xor(v, o);
    return v;
}
__device__ __forceinline__ float silu_f(float v) { return v / (1.f + __expf(-v)); }

__device__ __forceinline__ void transpose_item(const float* W, int ldw, int K, bf16* WT, LAS float* scr, int kb, int nbk, int lane) {
    const int k0 = 64 * kb, n0 = 32 * nbk;
#pragma unroll 8
    for (int i = 0; i < 32; ++i) { const int kk = 2 * i + (lane >> 5); scr[kk * 33 + (lane & 31)] = W[(size_t)(k0 + kk) * ldw + n0 + (lane & 31)]; }
    LDS_WAIT();
    const int c = lane & 7;
#pragma unroll
    for (int j = 0; j < 4; ++j) { const int n = (lane >> 3) + 8 * j; const LAS float* s = scr + (8 * c) * 33 + n;
        v4u o; o.x = pk2(s[0 * 33], s[1 * 33]); o.y = pk2(s[2 * 33], s[3 * 33]); o.z = pk2(s[4 * 33], s[5 * 33]); o.w = pk2(s[6 * 33], s[7 * 33]);
        *(v4u*)(WT + (size_t)(n0 + n) * K + k0 + 8 * c) = o; }
    LDS_WAIT();
}

template <bool WITH_DT>
__device__ __forceinline__ void rmsnorm_rows_bf16(const float* in, const float* g, bf16* outp, const float* w_in, float* dtraw, int gwave, int nwaves, int lane) {
    for (int row = gwave; row < T; row += nwaves) {
        const float4* xr = (const float4*)(in + (size_t)row * D) + lane;
        float4 v[4]; float ss = 0.f;
#pragma unroll
        for (int j = 0; j < 4; ++j) { v[j] = xr[64 * j]; ss += v[j].x * v[j].x + v[j].y * v[j].y + v[j].z * v[j].z + v[j].w * v[j].w; }
        ss = wave_sum(ss);
        const float r = rsqrtf(ss * (1.f / D) + EPS);
        unsigned long long* o8 = (unsigned long long*)(outp + (size_t)row * D) + lane;
        float dacc[8];
#pragma unroll
        for (int h = 0; h < 8; ++h) dacc[h] = 0.f;
#pragma unroll
        for (int j = 0; j < 4; ++j) {
            const float4 gv = ((const float4*)g)[lane + 64 * j];
            const float y[4] = {v[j].x * r * gv.x, v[j].y * r * gv.y, v[j].z * r * gv.z, v[j].w * r * gv.w};
            o8[64 * j] = (unsigned long long)pk2(y[0], y[1]) | ((unsigned long long)pk2(y[2], y[3]) << 32);
            if (WITH_DT) {
#pragma unroll
                for (int e = 0; e < 4; ++e) {
                    const float4* wp = (const float4*)(w_in + (size_t)(256 * j + 4 * lane + e) * PW + ODT);
                    const float4 w0 = wp[0], w1 = wp[1];
                    dacc[0] += y[e] * w0.x; dacc[1] += y[e] * w0.y; dacc[2] += y[e] * w0.z; dacc[3] += y[e] * w0.w;
                    dacc[4] += y[e] * w1.x; dacc[5] += y[e] * w1.y; dacc[6] += y[e] * w1.z; dacc[7] += y[e] * w1.w;
                }
            }
        }
        if (WITH_DT) {
#pragma unroll
            for (int h = 0; h < 8; ++h) dacc[h] = wave_sum(dacc[h]);
            if (lane == 0) { float4* dp = (float4*)(dtraw + (size_t)row * 8); dp[0] = make_float4(dacc[0], dacc[1], dacc[2], dacc[3]); dp[1] = make_float4(dacc[4], dacc[5], dacc[6], dacc[7]); }
        }
    }
}


typedef short bf16x8 __attribute__((ext_vector_type(8)));
typedef short bf16x4 __attribute__((ext_vector_type(4)));
typedef float f32x16 __attribute__((ext_vector_type(16)));
typedef __bf16 bf2_t __attribute__((ext_vector_type(2)));
#define MFMA32(a, b, c) __builtin_amdgcn_mfma_f32_32x32x16_bf16((a), (b), (c), 0, 0, 0)
__device__ __forceinline__ unsigned pkbf(float lo, float hi) { bf2_t v = {(__bf16)lo, (__bf16)hi}; return __builtin_bit_cast(unsigned, v); }
__device__ __forceinline__ short bfs(float f) { return __builtin_bit_cast(short, (__bf16)f); }
__device__ __forceinline__ float sbf2f(short v) { return __uint_as_float(((unsigned)(unsigned short)v) << 16); }
__device__ __forceinline__ int crow(int i, int hi) { return (i & 3) + 8 * (i >> 2) + 4 * hi; }
template <int S> __device__ __forceinline__ bf16x8 pack8(const f32x16& x) {
    v4u p; p.x = pkbf(x[8 * S], x[8 * S + 1]); p.y = pkbf(x[8 * S + 2], x[8 * S + 3]); p.z = pkbf(x[8 * S + 4], x[8 * S + 5]); p.w = pkbf(x[8 * S + 6], x[8 * S + 7]);
    return __builtin_bit_cast(bf16x8, p);
}
__device__ __forceinline__ bf16x8 ldg8(const bf16* p) { return *(const bf16x8*)p; }
__device__ __forceinline__ bf16x8 lds8(const LAS bf16* p) { return *(const LAS bf16x8*)p; }
__device__ __forceinline__ bf16x8 lds4x2(const LAS bf16* p) { const bf16x4 a = *(const LAS bf16x4*)p, b = *(const LAS bf16x4*)(p + 8); return __builtin_shufflevector(a, b, 0, 1, 2, 3, 4, 5, 6, 7); }
__device__ __forceinline__ f32x16 zero16() { f32x16 z;
#pragma unroll
    for (int i = 0; i < 16; ++i) z[i] = 0.f;
    return z; }

__device__ __forceinline__ void attn_unit(const float* sinks, LAS unsigned char* ldsb, int unit, const bf16* PROJ, float* MIXF, int tid, int lane, int wave) {
    const int hkv = unit & 1, blk = unit >> 1, nbk = blk & 63;
    const int tokblk = blk * 128, wbase = tokblk - 128;
    LAS bf16* VT = (LAS bf16*)ldsb;
#pragma unroll
    for (int i = 0; i < 4; ++i) {
        const int c = tid + 512 * i, key = c >> 3, d0 = (c & 7) * 8; const bool valid = (nbk > 0) || (key >= 128);
        bf16x8 v;
#pragma unroll
        for (int e = 0; e < 8; ++e) v[e] = 0;
        if (valid) v = ldg8(PROJ + (size_t)(wbase + key) * PS + OV + hkv * 64 + d0);
#pragma unroll
        for (int e = 0; e < 8; ++e) VT[(d0 + e) * 264 + key] = (bf16)v[e];
    }
    __syncthreads();
    const int r = lane & 31, hi = lane >> 5;
    const int hq = hkv * 4 + (wave & 3);
    const float slope = exp2f(-(float)(hq + 1)), sink = sinks[hq];
#pragma unroll 1
    for (int qq = 0; qq < 2; ++qq) {
        const int qt = (wave >> 2) + 2 * qq;
        const int tq = tokblk + 32 * qt + r;
        bf16x8 qf[4];
#pragma unroll
        for (int ks = 0; ks < 4; ++ks) qf[ks] = ldg8(PROJ + (size_t)tq * PS + OQ + hq * 64 + 16 * ks + 8 * hi);
        f32x16 X[5];
#pragma unroll
        for (int kt = 0; kt < 5; ++kt) {
            const int key = 32 * (qt + kt) + r; const bool valid = (nbk > 0) || (key >= 128);
            const int row = valid ? (wbase + key) : tokblk;
            X[kt] = zero16();
#pragma unroll
            for (int ks = 0; ks < 4; ++ks) { const bf16x8 kf = ldg8(PROJ + (size_t)row * PS + OKK + hkv * 64 + 16 * ks + 8 * hi); X[kt] = MFMA32(kf, qf[ks], X[kt]); }
        }
        const int qi = 32 * qt + r;
        float m = -1e30f;
#pragma unroll
        for (int kt = 0; kt < 5; ++kt)
#pragma unroll
            for (int i = 0; i < 16; ++i) {
                const int ki = 32 * (qt + kt) + crow(i, hi), dist = 128 + qi - ki;
                const bool valid = (dist >= 0) && (dist < 128) && ((nbk > 0) || (ki >= 128));
                const float lg = valid ? (X[kt][i] * 0.125f - slope * (float)dist) : -1e30f;
                X[kt][i] = lg; m = fmaxf(m, lg);
            }
        m = fmaxf(m, __shfl_xor(m, 32)); m = fmaxf(m, sink);
        float lsum = 0.f;
#pragma unroll
        for (int kt = 0; kt < 5; ++kt)
#pragma unroll
            for (int i = 0; i < 16; ++i) { const float p = __expf(X[kt][i] - m); X[kt][i] = p; lsum += p; }
        lsum += __shfl_xor(lsum, 32); lsum += __expf(sink - m);
        f32x16 O0 = zero16(), O1 = zero16();
#pragma unroll
        for (int kt = 0; kt < 5; ++kt) {
            const int kb = 32 * (qt + kt) + 4 * hi;
            { const bf16x8 xs = pack8<0>(X[kt]); const bf16x8 a0 = lds4x2(VT + r * 264 + kb), a1 = lds4x2(VT + (32 + r) * 264 + kb); O0 = MFMA32(a0, xs, O0); O1 = MFMA32(a1, xs, O1); }
            { const bf16x8 xs = pack8<1>(X[kt]); const bf16x8 a0 = lds4x2(VT + r * 264 + kb + 16), a1 = lds4x2(VT + (32 + r) * 264 + kb + 16); O0 = MFMA32(a0, xs, O0); O1 = MFMA32(a1, xs, O1); }
        }
        const float inv = 1.f / lsum;
        float* orow = MIXF + (size_t)tq * D + hq * 64 + 4 * hi;
#pragma unroll
        for (int q4 = 0; q4 < 4; ++q4) {
            *(float4*)(orow + 8 * q4) = make_float4(O0[4 * q4] * inv, O0[4 * q4 + 1] * inv, O0[4 * q4 + 2] * inv, O0[4 * q4 + 3] * inv);
            *(float4*)(orow + 32 + 8 * q4) = make_float4(O1[4 * q4] * inv, O1[4 * q4 + 1] * inv, O1[4 * q4 + 2] * inv, O1[4 * q4 + 3] * inv);
        }
    }
    __syncthreads();
}

__device__ __forceinline__ void ssd_chunk_unit(LAS unsigned char* ldsb, int unit, const bf16* XACT, const float* DT, const float* ACS, float* MIXF, float* STATES, int tid, int lane, int wave) {
    const int g = unit & 1, bc = unit >> 1, tok0 = bc * 128;
    LAS bf16* BT = (LAS bf16*)ldsb;
    LAS bf16* XD = (LAS bf16*)(ldsb + 34816);
    LAS bf16* XW = (LAS bf16*)(ldsb + 34816 + 34816);
    LAS float* ACST = (LAS float*)(ldsb + 34816 * 3);
    const int r = lane & 31, hi = lane >> 5;
#pragma unroll
    for (int i = 0; i < 4; ++i) {
        const int c = tid + 512 * i, s = c >> 4, n0 = (c & 15) * 8;
        const bf16x8 v = ldg8(XACT + (size_t)(tok0 + s) * 1024 + 512 + g * 128 + n0);
#pragma unroll
        for (int e = 0; e < 8; ++e) BT[(n0 + e) * 136 + s] = (bf16)v[e];
    }
    ACST[tid] = ACS[(size_t)(tok0 + (tid >> 2)) * 8 + g * 4 + (tid & 3)];
#pragma unroll 1
    for (int hp = 0; hp < 2; ++hp) {
        if (hp) __syncthreads();
#pragma unroll
        for (int i = 0; i < 4; ++i) {
            const int c = tid + 512 * i, hsel = c >> 10, s = (c >> 3) & 127, p0 = (c & 7) * 8, H = g * 4 + 2 * hp + hsel;
            const bf16x8 v = ldg8(XACT + (size_t)(tok0 + s) * 1024 + H * 64 + p0);
            const float dtv = DT[(size_t)(tok0 + s) * 8 + H];
            const float w = __expf(ACS[(size_t)(tok0 + 127) * 8 + H] - ACS[(size_t)(tok0 + s) * 8 + H]);
#pragma unroll
            for (int e = 0; e < 8; ++e) { const float xd = sbf2f(v[e]) * dtv; XD[hsel * 8704 + (p0 + e) * 136 + s] = (bf16)bfs(xd); XW[hsel * 8704 + (p0 + e) * 136 + s] = (bf16)bfs(xd * w); }
        }
        __syncthreads();
        {
            const int lt = wave & 3, hsel = wave >> 2, hh = 2 * hp + hsel, H = g * 4 + hh;
            const int l = 32 * lt + r; const float acs_l = ACST[l * 4 + hh];
            bf16x8 cf[8];
#pragma unroll
            for (int ks = 0; ks < 8; ++ks) cf[ks] = ldg8(XACT + (size_t)(tok0 + l) * 1024 + 768 + g * 128 + 16 * ks + 8 * hi);
            f32x16 Z0 = zero16(), Z1 = zero16();
#pragma unroll 1
            for (int st = 0; st <= lt; ++st) {
                f32x16 X = zero16();
#pragma unroll
                for (int ks = 0; ks < 8; ++ks) { const bf16x8 bfr = ldg8(XACT + (size_t)(tok0 + 32 * st + r) * 1024 + 512 + g * 128 + 16 * ks + 8 * hi); X = MFMA32(bfr, cf[ks], X); }
#pragma unroll
                for (int i = 0; i < 16; ++i) { const int s = 32 * st + crow(i, hi); const float f = (s <= l) ? __expf(acs_l - ACST[s * 4 + hh]) : 0.f; X[i] *= f; }
                const int sb = 32 * st + 4 * hi;
                { const bf16x8 xs = pack8<0>(X); const bf16x8 b0 = lds4x2(XD + hsel * 8704 + r * 136 + sb), b1 = lds4x2(XD + hsel * 8704 + (32 + r) * 136 + sb); Z0 = MFMA32(xs, b0, Z0); Z1 = MFMA32(xs, b1, Z1); }
                { const bf16x8 xs = pack8<1>(X); const bf16x8 b0 = lds4x2(XD + hsel * 8704 + r * 136 + sb + 16), b1 = lds4x2(XD + hsel * 8704 + (32 + r) * 136 + sb + 16); Z0 = MFMA32(xs, b0, Z0); Z1 = MFMA32(xs, b1, Z1); }
            }
#pragma unroll
            for (int i = 0; i < 16; ++i) { float* o = MIXF + (size_t)(tok0 + 32 * lt + crow(i, hi)) * D + 512 + H * 64 + r; o[0] = Z0[i]; o[32] = Z1[i]; }
        }
        {
            const int nt = wave & 3, hsel = wave >> 2, H = g * 4 + 2 * hp + hsel;
            f32x16 S0 = zero16(), S1 = zero16();
#pragma unroll
            for (int ks = 0; ks < 8; ++ks) {
                const bf16x8 btf = lds8(BT + (32 * nt + r) * 136 + 16 * ks + 8 * hi);
                const bf16x8 a0 = lds8(XW + hsel * 8704 + r * 136 + 16 * ks + 8 * hi), a1 = lds8(XW + hsel * 8704 + (32 + r) * 136 + 16 * ks + 8 * hi);
                S0 = MFMA32(a0, btf, S0); S1 = MFMA32(a1, btf, S1);
            }
            float* sp = STATES + (size_t)(bc * 8 + H) * 8192 + 32 * nt + r;
#pragma unroll
            for (int i = 0; i < 16; ++i) { const int p = crow(i, hi); sp[p * 128] = S0[i]; sp[(32 + p) * 128] = S1[i]; }
        }
    }
    __syncthreads();
}

__device__ __forceinline__ void yoff_unit(const float* d_skip, int unit, const bf16* XACT, const bf16* PROJ, const float* ACS, const bf16* PREVT, float* MIXF, int lane, int wave) {
    const int g = unit & 1, bc = unit >> 1, tok0 = bc * 128;
    const int r = lane & 31, hi = lane >> 5, lt = wave & 3, hpair = wave >> 2;
    bf16x8 cf[8];
#pragma unroll
    for (int ks = 0; ks < 8; ++ks) cf[ks] = ldg8(XACT + (size_t)(tok0 + 32 * lt + r) * 1024 + 768 + g * 128 + 16 * ks + 8 * hi);
#pragma unroll 1
    for (int hsel = 0; hsel < 2; ++hsel) {
        const int H = g * 4 + 2 * hpair + hsel; const bf16* pv = PREVT + (size_t)(bc * 8 + H) * 8192;
        f32x16 Y0 = zero16(), Y1 = zero16();
#pragma unroll
        for (int ks = 0; ks < 8; ++ks) {
            const bf16x8 b0 = ldg8(pv + r * 128 + 16 * ks + 8 * hi), b1 = ldg8(pv + (32 + r) * 128 + 16 * ks + 8 * hi);
            Y0 = MFMA32(cf[ks], b0, Y0); Y1 = MFMA32(cf[ks], b1, Y1);
        }
        const float dsk = d_skip[H];
#pragma unroll
        for (int i = 0; i < 16; ++i) {
            const int t = tok0 + 32 * lt + crow(i, hi); const float ea = __expf(ACS[(size_t)t * 8 + H]);
#pragma unroll
            for (int pt = 0; pt < 2; ++pt) {
                const int col = H * 64 + 32 * pt + r;
                float* yp = MIXF + (size_t)t * D + 512 + col;
                float y = yp[0] + ea * (pt ? Y1[i] : Y0[i]) + dsk * bf2f(XACT[(size_t)t * 1024 + col]);
                const float z = bf2f(PROJ[(size_t)t * PS + OZ + col]);
                yp[0] = y * silu_f(z);
            }
        }
    }
}

#define XB_TMO      128
#define XB_XCNT(j)  (256  + 64 * (j))
#define XB_XSUB(j)  (1280 + 64 * (j))
#define XB_XGEN(j)  (2304 + 64 * (j))
#define XB_TOP      3328
#define XB_TOPGEN   3392
#define XCD_BAR_WORDS 3456
#define XB_SPIN_CAP (1u << 22)
__device__ __forceinline__ unsigned xb_ld(unsigned* p)              { return __hip_atomic_load(p, __ATOMIC_RELAXED, __HIP_MEMORY_SCOPE_AGENT); }
__device__ __forceinline__ unsigned xb_add(unsigned* p, unsigned v) { return __hip_atomic_fetch_add(p, v, __ATOMIC_RELAXED, __HIP_MEMORY_SCOPE_AGENT); }
__device__ __forceinline__ unsigned xb_xcc_id() { return (unsigned)__builtin_amdgcn_s_getreg((3 << 11) | 20) & 0xFu; }
#define XB_SPIN(cond, bar) do { unsigned _sp = 0; while (cond) { __builtin_amdgcn_s_sleep(1); \
    if ((++_sp & 255u) == 0u) { if (xb_ld(&(bar)[XB_TMO])) break; if (_sp > XB_SPIN_CAP) { atomicAdd(&(bar)[XB_TMO], 1u); break; } } } } while (0)
struct XcdBarrier { unsigned* bar; unsigned x; volatile LAS unsigned* st; };
__device__ __forceinline__ XcdBarrier xcd_barrier_post(unsigned* bar, volatile LAS unsigned* st) {
    XcdBarrier b; b.bar = bar; b.x = xb_xcc_id(); b.st = st;
    if (threadIdx.x == 0) (void)xb_add(&bar[XB_XCNT(b.x)], 1u);
    return b;
}
__device__ __forceinline__ void xcd_barrier_complete(unsigned* bar, unsigned x, unsigned& nloc, unsigned& nx) {
    const unsigned G = gridDim.x * gridDim.y * gridDim.z;
    unsigned sum, cnt, mine, sp = 0u;
    for (;;) {
        sum = 0u; cnt = 0u; mine = 0u;
#pragma unroll
        for (unsigned j = 0; j < 16; ++j) { const unsigned c = xb_ld(&bar[XB_XCNT(j)]); sum += c; cnt += (c > 0u) ? 1u : 0u; mine = (j == x) ? c : mine; }
        if (sum == G) break;
        __builtin_amdgcn_s_sleep(1);
        if ((++sp & 255u) == 0u) { if (xb_ld(&bar[XB_TMO])) break; if (sp > XB_SPIN_CAP) { atomicAdd(&bar[XB_TMO], 1u); break; } }
    }
    nloc = mine > 0u ? mine : 1u; nx = cnt > 0u ? cnt : 1u;
}
__device__ __forceinline__ void xcd_barrier(const XcdBarrier& b) {
    asm volatile("s_waitcnt vmcnt(0)" ::: "memory");
    __syncthreads();
    if (threadIdx.x == 0) {
        unsigned* bar = b.bar;
        __builtin_amdgcn_s_waitcnt(0);
        unsigned nloc = b.st[0], nx = b.st[1];
        if (nloc == 0u) { xcd_barrier_complete(bar, b.x, nloc, nx); b.st[0] = nloc; b.st[1] = nx; }
        const unsigned old = xb_add(&bar[XB_XSUB(b.x)], 1u);
        const unsigned gen = old / nloc;
        if (old + 1u == (gen + 1u) * nloc) {
            __builtin_amdgcn_fence(__ATOMIC_RELEASE, "agent");
            asm volatile("s_waitcnt vmcnt(0)" ::: "memory");
            const unsigned og = xb_add(&bar[XB_TOP], 1u);
            const unsigned tg = og / nx;
            if (og + 1u == (tg + 1u) * nx) xb_add(&bar[XB_TOPGEN], 1u);
            else XB_SPIN(xb_ld(&bar[XB_TOPGEN]) == tg, bar);
            __builtin_amdgcn_fence(__ATOMIC_ACQUIRE, "agent");
            xb_add(&bar[XB_XGEN(b.x)], 1u);
            asm volatile("s_waitcnt vmcnt(0)" ::: "memory");
        } else {
            XB_SPIN(xb_ld(&bar[XB_XGEN(b.x)]) == gen, bar);
            __builtin_amdgcn_fence(__ATOMIC_ACQUIRE, "agent");
            asm volatile("s_waitcnt vmcnt(0)" ::: "memory");
        }
    }
    __syncthreads();
}
constexpr int LDS_BYTES = 147456;
constexpr int MISC_OFF = 131072 + 320;

__global__ void __launch_bounds__(NTHR, 2) k_main(Args a) {
    extern __shared__ __attribute__((aligned(16))) unsigned char lds_raw[];
    LAS unsigned char* ldsb = (LAS unsigned char*)lds_raw;
    const int tid = threadIdx.x, lane = tid & 63, bid = blockIdx.x, nb = gridDim.x;
    const int wave = __builtin_amdgcn_readfirstlane(tid >> 6);
    const int gtid = bid * NTHR + tid, gthreads = nb * NTHR, gwave = gtid >> 6, nwaves = gthreads >> 6;
    unsigned char* ws = a.ws;
    bf16* WINT = (bf16*)(ws + WS_WIN); bf16* WOT = (bf16*)(ws + WS_WO); bf16* WQT = (bf16*)(ws + WS_WQ);
    bf16* PROJ = (bf16*)(ws + WS_PROJ);
    bf16* XNB = (bf16*)(ws + WS_XNB);
    bf16* XACT = (bf16*)(ws + WS_XACT);
    float* DTRAW = (float*)(ws + WS_DTRAW); float* DT = (float*)(ws + WS_DT); float* ACS = (float*)(ws + WS_ACS); float* CDEC = (float*)(ws + WS_CDEC);
    float* STATES = (float*)(ws + WS_STATES); bf16* PREVT = (bf16*)(ws + WS_PREV);
    float* QP = (float*)(ws + WS_QP); int* IDX = (int*)(ws + WS_IDX); float* GATE = (float*)(ws + WS_GATE);
    float* TOPV = (float*)(ws + WS_TOPV); int* TOPI = (int*)(ws + WS_TOPI);
    bf16* UB = (bf16*)(ws + WS_UB); bf16* VB = (bf16*)(ws + WS_VB);
    float* MIXF = a.out;
    volatile LAS unsigned* MISC = (volatile LAS unsigned*)(ldsb + MISC_OFF);
    if (tid < 32) MISC[tid] = 0u;
    __syncthreads();
    XcdBarrier bar = xcd_barrier_post((unsigned*)ws, MISC + 8);
#define IN(k) (a.ph_lo <= (k) && (k) < a.ph_hi)
#define GRID_BAR() xcd_barrier(bar)

    if (IN(0)) {
        LAS float* scr = (LAS float*)(ldsb + wave * 16384);
        constexpr int I_IN = 16 * 72, I_O = 16 * 32, NITEMS = I_IN + 2 * I_O;
        for (int it = gwave; it < NITEMS; it += nwaves) {
            int r = it;
            if (r < I_IN) { transpose_item(a.w_in, PW, D, WINT, scr, r / 72, r % 72, lane); continue; } r -= I_IN;
            if (r < I_O) { transpose_item(a.w_out, D, D, WOT, scr, r / 32, r % 32, lane); continue; } r -= I_O;
            transpose_item(a.peer_wq, D, D, WQT, scr, r / 32, r % 32, lane);
        }
        rmsnorm_rows_bf16<true>(a.x, a.norm_mix_g, XNB, a.w_in, DTRAW, gwave, nwaves, lane);
    }
    GRID_BAR();
    if (IN(1)) {
        pg8::Gemm g{XNB, WINT, T, PS, D}; pg8::StaticOrder S; S.init(T, PS, nb, bid);
        pg8::EpiBf16Plain E{PROJ, PS};
        pg8::gemm_phase<pg8::EpiBf16Plain, pg8::StaticOrder>(ldsb, g, S, E, nullptr);
    }
    GRID_BAR();
    if (IN(2)) {
        for (int idx = gtid; idx < T * 1024; idx += gthreads) {
            const int t = idx >> 10, c = idx & 1023, s = t & (SEQ - 1);
            float acc = a.conv_b[c];
#pragma unroll
            for (int k = 0; k < 4; ++k) { const int sp = s + k - 3; if (sp >= 0) acc += a.conv_w[k * 1024 + c] * bf2f(PROJ[(size_t)(t + k - 3) * PS + OXBC + c]); }
            XACT[idx] = f2bf(silu_f(acc));
        }
        if (gwave < 1024) {
            const int h = gwave & 7, bc = gwave >> 3;
            const float A = -__expf(a.a_log[h]), bias = a.dt_bias[h];
            const int t0 = bc * 128 + lane, t1 = t0 + 64;
            const float raw0 = DTRAW[t0 * 8 + h] + bias, raw1 = DTRAW[t1 * 8 + h] + bias;
            const float dt0 = fmaxf(raw0, 0.f) + log1pf(__expf(-fabsf(raw0))), dt1 = fmaxf(raw1, 0.f) + log1pf(__expf(-fabsf(raw1)));
            DT[t0 * 8 + h] = dt0; DT[t1 * 8 + h] = dt1;
            float v0 = dt0 * A, v1 = dt1 * A;
#pragma unroll
            for (int o = 1; o < 64; o <<= 1) { const float y0 = __shfl_up(v0, o), y1 = __shfl_up(v1, o); if (lane >= o) { v0 += y0; v1 += y1; } }
            v1 += __shfl(v0, 63);
            ACS[t0 * 8 + h] = v0; ACS[t1 * 8 + h] = v1;
            if (lane == 63) CDEC[gwave] = __expf(v1);
        }
    }
    GRID_BAR();
    if (IN(3)) {
        for (int u = bid; u < 512; u += nb) {
            if (u < 256) attn_unit(a.attn_sinks, ldsb, u, PROJ, MIXF, tid, lane, wave);
            else ssd_chunk_unit(ldsb, u - 256, XACT, DT, ACS, MIXF, STATES, tid, lane, wave);
        }
    }
    GRID_BAR();
    if (IN(5)) {
        for (int idx = gtid; idx < 2 * 8 * 8192; idx += gthreads) {
            const int pn = idx & 8191, h = (idx >> 13) & 7, b = idx >> 16;
            float run = 0.f;
#pragma unroll 1
            for (int c0 = 0; c0 < 64; c0 += 8) {
                float st[8], dc[8];
#pragma unroll
                for (int j = 0; j < 8; ++j) { const int bch = (b * 64 + c0 + j) * 8 + h; st[j] = STATES[(size_t)bch * 8192 + pn]; dc[j] = CDEC[bch]; }
#pragma unroll
                for (int j = 0; j < 8; ++j) { const int bch = (b * 64 + c0 + j) * 8 + h; PREVT[(size_t)bch * 8192 + pn] = f2bf(run); run = dc[j] * run + st[j]; }
            }
        }
    }
    GRID_BAR();
    if (IN(6)) {
        for (int u = bid; u < 256; u += nb) yoff_unit(a.d_skip, u, XACT, PROJ, ACS, PREVT, MIXF, lane, wave);
    }
    GRID_BAR();
    if (IN(6)) {
        for (int t = gwave; t < T; t += nwaves) {
            const float* row = MIXF + (size_t)t * D;
            const float4 a0 = *(const float4*)(row + 8 * lane), a1 = *(const float4*)(row + 8 * lane + 4);
            const float4 s0 = *(const float4*)(row + 512 + 8 * lane), s1 = *(const float4*)(row + 512 + 8 * lane + 4);
            float ssa = a0.x * a0.x + a0.y * a0.y + a0.z * a0.z + a0.w * a0.w + a1.x * a1.x + a1.y * a1.y + a1.z * a1.z + a1.w * a1.w;
            float sss = s0.x * s0.x + s0.y * s0.y + s0.z * s0.z + s0.w * s0.w + s1.x * s1.x + s1.y * s1.y + s1.z * s1.z + s1.w * s1.w;
            ssa = wave_sum(ssa);
#pragma unroll
            for (int o = 1; o < 32; o <<= 1) sss += __shfl_xor(sss, o);
            const float ra = rsqrtf(ssa * (1.f / 512.f) + EPS), rs = rsqrtf(sss * (1.f / 256.f) + EPS);
            const float4 ga0 = *(const float4*)(a.attn_out_g + 8 * lane), ga1 = *(const float4*)(a.attn_out_g + 8 * lane + 4);
            const float4 gs0 = *(const float4*)(a.ssm_norm_g + 8 * lane), gs1 = *(const float4*)(a.ssm_norm_g + 8 * lane + 4);
            v4u oa, os;
            oa.x = pkbf(a0.x * ra * ga0.x, a0.y * ra * ga0.y); oa.y = pkbf(a0.z * ra * ga0.z, a0.w * ra * ga0.w); oa.z = pkbf(a1.x * ra * ga1.x, a1.y * ra * ga1.y); oa.w = pkbf(a1.z * ra * ga1.z, a1.w * ra * ga1.w);
            os.x = pkbf(s0.x * rs * gs0.x, s0.y * rs * gs0.y); os.y = pkbf(s0.z * rs * gs0.z, s0.w * rs * gs0.w); os.z = pkbf(s1.x * rs * gs1.x, s1.y * rs * gs1.y); os.w = pkbf(s1.z * rs * gs1.z, s1.w * rs * gs1.w);
            *(v4u*)(XNB + (size_t)t * D + 8 * lane) = oa; *(v4u*)(XNB + (size_t)t * D + 512 + 8 * lane) = os;
        }
    }
    GRID_BAR();
    if (IN(7)) {
        pg8::Gemm g{XNB, WOT, T, D, D}; pg8::StaticOrder S; S.init(T, D, nb, bid);
        pg8::EpiF32Resid E{a.out, a.x, D};
        pg8::gemm_phase<pg8::EpiF32Resid, pg8::StaticOrder>(ldsb, g, S, E, nullptr);
    }
    GRID_BAR();
    if (IN(8)) {
        rmsnorm_rows_bf16<false>(a.out, a.norm_ffn_g, XNB, nullptr, nullptr, gwave, nwaves, lane);
        for (int i = gtid; i < 2 * 16384 * 128; i += gthreads) {
            const int which = i >> 21, r = i & ((1 << 21) - 1);
            const float4* src = (const float4*)((which ? a.peer_v : a.peer_u) + (size_t)r * 8);
            const float4 f0 = src[0], f1 = src[1];
            v4u o; o.x = pk2(f0.x, f0.y); o.y = pk2(f0.z, f0.w); o.z = pk2(f1.x, f1.y); o.w = pk2(f1.z, f1.w);
            *(v4u*)((which ? VB : UB) + (size_t)r * 8) = o;
        }
    }
    GRID_BAR();
    if (IN(9)) {
        pg8::Gemm g{XNB, WQT, T, D, D}; pg8::StaticOrder S; S.init(T, D, nb, bid);
        pg8::EpiF32Resid E{QP, nullptr, D};
        pg8::gemm_phase<pg8::EpiF32Resid, pg8::StaticOrder>(ldsb, g, S, E, nullptr);
    }
    GRID_BAR();
    if (IN(10)) {
        for (int item = gtid; item < 16 * T; item += gthreads) {
            const int t = item & (T - 1), hh = item >> 14, half = hh & 1;
            float q[64];
            const float4* qp = (const float4*)(QP + (size_t)t * D + hh * 64);
#pragma unroll
            for (int i = 0; i < 16; ++i) { const float4 w = qp[i]; q[i * 4] = w.x; q[i * 4 + 1] = w.y; q[i * 4 + 2] = w.z; q[i * 4 + 3] = w.w; }
            float bv[16]; int bi[16];
#pragma unroll
            for (int r = 0; r < 16; ++r) { bv[r] = -INFINITY; bi[r] = 0; }
            const float* kbase = a.peer_sub_keys + (size_t)half * 128 * 64;
            for (int k = 0; k < 128; ++k) {
                const float4* kp = (const float4*)(kbase + k * 64);
                float sc = 0.f;
#pragma unroll
                for (int i = 0; i < 16; ++i) { const float4 w = kp[i]; sc += q[i * 4] * w.x + q[i * 4 + 1] * w.y + q[i * 4 + 2] * w.z + q[i * 4 + 3] * w.w; }
                float cv = sc; int ci = k;
#pragma unroll
                for (int r = 0; r < 16; ++r) { const bool gt = cv > bv[r]; const float tv = gt ? bv[r] : cv; const int ti = gt ? bi[r] : ci; bv[r] = gt ? cv : bv[r]; bi[r] = gt ? ci : bi[r]; cv = tv; ci = ti; }
            }
            float* tv = TOPV + ((size_t)t * 16 + hh) * 16; int* ti = TOPI + ((size_t)t * 16 + hh) * 16;
#pragma unroll
            for (int r = 0; r < 16; ++r) { tv[r] = bv[r]; ti[r] = bi[r]; }
        }
    }
    GRID_BAR();
    if (IN(11)) {
        for (int item = gtid; item < 8 * T; item += gthreads) {
            const int t = item & (T - 1), hd = item >> 14;
            const float* v1 = TOPV + ((size_t)t * 16 + hd * 2) * 16; const float* v2 = v1 + 16;
            const int* i1 = TOPI + ((size_t)t * 16 + hd * 2) * 16; const int* i2 = i1 + 16;
            float bv[16]; int bi[16];
#pragma unroll
            for (int r = 0; r < 16; ++r) { bv[r] = -INFINITY; bi[r] = 0; }
#pragma unroll 1
            for (int aa = 0; aa < 16; ++aa) {
                const float va = v1[aa]; const int ia = i1[aa];
#pragma unroll 1
                for (int bb = 0; bb < 16; ++bb) {
                    float cv = va + v2[bb]; int ci = ia * 128 + i2[bb];
#pragma unroll
                    for (int r = 0; r < 16; ++r) { const bool gt = cv > bv[r]; const float tv = gt ? bv[r] : cv; const int ti = gt ? bi[r] : ci; bv[r] = gt ? cv : bv[r]; bi[r] = gt ? ci : bi[r]; cv = tv; ci = ti; }
                }
            }
            float e[16], se = 0.f;
#pragma unroll
            for (int r = 0; r < 16; ++r) { e[r] = __expf(bv[r] - bv[0]); se += e[r]; }
            const float inv = 1.f / se;
            float* gp = GATE + (size_t)t * 128 + hd * 16; int* ip = IDX + (size_t)t * 128 + hd * 16;
#pragma unroll
            for (int r = 0; r < 16; ++r) { gp[r] = e[r] * inv; ip[r] = bi[r]; }
        }
    }
    GRID_BAR();
    if (IN(12)) {
        const int myk = 4 * (lane >> 5) + 2 * ((lane >> 4) & 1) + ((lane >> 3) & 1);
        for (int t = gwave; t < T; t += nwaves) {
            const float* hrow = a.out + (size_t)t * D;
            float hv[16], xv[16], ov[16]; float ss = 0.f;
#pragma unroll
            for (int q = 0; q < 4; ++q) { const float4 w = *(const float4*)(hrow + (q >> 1) * 512 + lane * 8 + (q & 1) * 4); hv[q * 4] = w.x; hv[q * 4 + 1] = w.y; hv[q * 4 + 2] = w.z; hv[q * 4 + 3] = w.w; }
#pragma unroll
            for (int i = 0; i < 16; ++i) { ss += hv[i] * hv[i]; ov[i] = 0.f; }
            ss = wave_sum(ss);
            const float r2 = rsqrtf(ss * (1.f / D) + EPS);
#pragma unroll
            for (int q = 0; q < 4; ++q) { const float4 gv = *(const float4*)(a.norm_ffn_g + (q >> 1) * 512 + lane * 8 + (q & 1) * 4);
                xv[q * 4] = hv[q * 4] * r2 * gv.x; xv[q * 4 + 1] = hv[q * 4 + 1] * r2 * gv.y; xv[q * 4 + 2] = hv[q * 4 + 2] * r2 * gv.z; xv[q * 4 + 3] = hv[q * 4 + 3] * r2 * gv.w; }
#pragma unroll 1
            for (int kb = 0; kb < 16; ++kb) {
                const int e_my = IDX[(size_t)t * 128 + kb * 8 + (lane & 7)];
                const float g_my = GATE[(size_t)t * 128 + kb * 8 + myk];
                uint4 ua[8][2], va[8][2];
#pragma unroll
                for (int k = 0; k < 8; ++k) { const int e = __builtin_amdgcn_readlane(e_my, k);
                    const bf16* up = UB + (size_t)e * D + lane * 8; ua[k][0] = *(const uint4*)up; ua[k][1] = *(const uint4*)(up + 512); }
#pragma unroll
                for (int k = 0; k < 8; ++k) { const int e = __builtin_amdgcn_readlane(e_my, k);
                    const bf16* vp = VB + (size_t)e * D + lane * 8; va[k][0] = *(const uint4*)vp; va[k][1] = *(const uint4*)(vp + 512); }
                float dk[8];
#pragma unroll
                for (int k = 0; k < 8; ++k) {
                    float d = 0.f;
#pragma unroll
                    for (int hf = 0; hf < 2; ++hf) { const unsigned ww[4] = {ua[k][hf].x, ua[k][hf].y, ua[k][hf].z, ua[k][hf].w};
#pragma unroll
                        for (int j = 0; j < 4; ++j) { d += xv[hf * 8 + j * 2] * __uint_as_float(ww[j] << 16); d += xv[hf * 8 + j * 2 + 1] * __uint_as_float(ww[j] & 0xffff0000u); } }
                    dk[k] = d;
                }
                float w4[4], y2[2], z;
                { const bool hi = (lane & 32) != 0;
#pragma unroll
                  for (int i = 0; i < 4; ++i) { const float send = hi ? dk[i] : dk[i + 4]; const float recv = __shfl_xor(send, 32); w4[i] = (hi ? dk[i + 4] : dk[i]) + recv; } }
                { const bool hi = (lane & 16) != 0;
#pragma unroll
                  for (int i = 0; i < 2; ++i) { const float send = hi ? w4[i] : w4[i + 2]; const float recv = __shfl_xor(send, 16); y2[i] = (hi ? w4[i + 2] : w4[i]) + recv; } }
                { const bool hi = (lane & 8) != 0; const float send = hi ? y2[0] : y2[1]; const float recv = __shfl_xor(send, 8); z = (hi ? y2[1] : y2[0]) + recv; }
                z += __shfl_xor(z, 4); z += __shfl_xor(z, 2); z += __shfl_xor(z, 1);
                const float act = g_my * 0.5f * z * (1.f + erff(z * 0.70710678118654752f));
#pragma unroll
                for (int k = 0; k < 8; ++k) {
                    const float ak = __builtin_bit_cast(float, __builtin_amdgcn_readlane(__builtin_bit_cast(int, act), ((k >> 2) & 1) * 32 + ((k >> 1) & 1) * 16 + (k & 1) * 8));
#pragma unroll
                    for (int hf = 0; hf < 2; ++hf) { const unsigned ww[4] = {va[k][hf].x, va[k][hf].y, va[k][hf].z, va[k][hf].w};
#pragma unroll
                        for (int j = 0; j < 4; ++j) { ov[hf * 8 + j * 2] += ak * __uint_as_float(ww[j] << 16); ov[hf * 8 + j * 2 + 1] += ak * __uint_as_float(ww[j] & 0xffff0000u); } }
                }
            }
            float s2 = 0.f;
#pragma unroll
            for (int i = 0; i < 16; ++i) { ov[i] += hv[i]; s2 += ov[i] * ov[i]; }
            s2 = wave_sum(s2);
            const float r3 = rsqrtf(s2 * (1.f / D) + EPS);
            float* orow = a.out + (size_t)t * D;
#pragma unroll
            for (int q = 0; q < 4; ++q) { const float4 gv = *(const float4*)(a.final_norm_g + (q >> 1) * 512 + lane * 8 + (q & 1) * 4);
                *(float4*)(orow + (q >> 1) * 512 + lane * 8 + (q & 1) * 4) = make_float4(ov[q * 4] * r3 * gv.x, ov[q * 4 + 1] * r3 * gv.y, ov[q * 4 + 2] * r3 * gv.z, ov[q * 4 + 3] * r3 * gv.w); }
        }
    }
#undef IN
}
}

extern "C" void kernel_launch(void* const* d_in, const int* in_sizes, int n_in, void* d_out, int out_size, void* d_ws, size_t ws_size, hipStream_t stream) {
    if (n_in != 18 || out_size != T * D || ws_size < WS_END) { fprintf(stderr, "kernel_launch: unexpected shapes n_in=%d out=%d ws=%zu\n", n_in, out_size, ws_size); return; }
    Args a{};
    const float** ap = (const float**)&a;
    for (int i = 0; i < 18; ++i) ap[i] = (const float*)d_in[i];
    a.out = (float*)d_out; a.ws = (unsigned char*)d_ws;
    static int grid = 0;
    if (grid == 0) {
        int dev = 0, cus = 0, per_cu = 0;
        if (hipGetDevice(&dev) != hipSuccess || hipDeviceGetAttribute(&cus, hipDeviceAttributeMultiprocessorCount, dev) != hipSuccess) { fprintf(stderr, "kernel_launch: device query failed\n"); grid = -1; return; }
        if (hipFuncSetAttribute((const void*)k_main, hipFuncAttributeMaxDynamicSharedMemorySize, LDS_BYTES) != hipSuccess) { fprintf(stderr, "kernel_launch: hipFuncSetAttribute failed\n"); grid = -1; return; }
        if (hipOccupancyMaxActiveBlocksPerMultiprocessor(&per_cu, (const void*)k_main, NTHR, LDS_BYTES) != hipSuccess || per_cu < 1) { fprintf(stderr, "kernel_launch: occupancy query says %d blocks/CU\n", per_cu); (void)hipGetLastError(); grid = -1; return; }
        grid = cus;
    }
    if (grid < 0) return;
    if (hipMemsetAsync(d_ws, 0, 65536, stream) != hipSuccess) { fprintf(stderr, "kernel_launch: memset failed\n"); return; }
    a.ph_lo = 0; a.ph_hi = 13;
    hipLaunchKernelGGL(k_main, dim3(grid), dim3(NTHR), LDS_BYTES, stream, a);
}
```

```cpp
#include <hip/hip_runtime.h>
#include <cstdio>
#include <cstdint>

namespace pg8 {
#define PG8_LAS __attribute__((address_space(3)))
typedef unsigned short bf16_t;
typedef short bf16x8 __attribute__((ext_vector_type(8)));
typedef float f32x4 __attribute__((ext_vector_type(4)));
typedef unsigned u32x4 __attribute__((ext_vector_type(4)));
constexpr int BM = 256, BK = 64, HALF = 128, HTB = HALF * BK * 2  , STAGE_BYTES = 8 * HTB, NXCD = 8, WGM = 8;

__host__ __device__ __forceinline__ int lds_byte(int r, int c) { const int st = (r >> 4) * 2 + (c >> 5), rr = r & 15, cc = c & 31, ob = rr * 64 + cc * 2; return st * 1024 + (ob ^ (((ob >> 9) & 1) << 5)); }
__host__ __device__ __forceinline__ void stage_rc(int b, int& R, int& C) { const int st = b / 1024, sb = b % 1024, swz = sb ^ (((sb >> 9) & 1) << 5); R = (st >> 1) * 16 + swz / 64; C = (st & 1) * 32 + (swz % 64) / 2; }
__host__ __device__ __forceinline__ int perm32(int rho) { const int n = rho >> 4, i = rho & 15; return 8 * (i >> 2) + 4 * n + (i & 3); }

struct Unit { int pm, pn; };
struct Gemm { const bf16_t* A; const bf16_t* Bt; int M, N, K; };

struct StaticOrder {
    int nM, nN, nwg, G, c;
    __host__ __device__ void init(int M, int N, int G_, int c_) { nM = M / BM; nN = N / BM; nwg = nM * nN; G = G_; c = c_; }
    __host__ __device__ bool next(int i, Unit& u) const {
        const long L = (long)i * G + c; if (L >= nwg) return false;
        int wgid = (int)L; { const int q = nwg / NXCD, r = nwg % NXCD, xcd = wgid % NXCD, off = wgid / NXCD; wgid = (xcd < r ? xcd * (q + 1) : r * (q + 1) + (xcd - r) * q) + off; }
        const int nig = WGM * nN, gid = wgid / nig, fm = gid * WGM, gsz = (nM - fm) < WGM ? (nM - fm) : WGM;
        u.pm = fm + ((wgid % nig) % gsz); u.pn = (wgid % nig) / gsz; return true;
    }
    __device__ __forceinline__ void a_ready(const Unit&) const {}
    __device__ __forceinline__ void done(const Unit&) const {}
};
__device__ __forceinline__ unsigned cvt_pk_bf16(float lo, float hi) { unsigned r; asm volatile("v_cvt_pk_bf16_f32 %0, %1, %2" : "=v"(r) : "v"(lo), "v"(hi)); return r; }
typedef float f32x2 __attribute__((ext_vector_type(2)));
struct EpiBf16Plain {
    static constexpr bool PERM = true, AFTER_DRAIN = false;
    bf16_t* O; int ldc;
    __device__ __forceinline__ void operator()(const f32x4 (&acc)[2][2][4][2], const Unit& u, int wr, int wc, int fr, int fq) const {
        const int row0 = u.pm * BM + wr * 64 + fr, col0 = u.pn * BM + wc * 32 + 8 * fq;
#pragma unroll
        for (int ai = 0; ai < 2; ++ai)
#pragma unroll
            for (int m = 0; m < 4; ++m) { bf16_t* rowp = O + (size_t)(row0 + ai * HALF + m * 16) * ldc + col0;
#pragma unroll
                for (int bj = 0; bj < 2; ++bj) { const f32x4 v0 = acc[ai][bj][m][0], v1 = acc[ai][bj][m][1];
                    u32x4 w; w.x = cvt_pk_bf16(v0[0], v0[1]); w.y = cvt_pk_bf16(v0[2], v0[3]); w.z = cvt_pk_bf16(v1[0], v1[1]); w.w = cvt_pk_bf16(v1[2], v1[3]);
                    *(u32x4*)(rowp + bj * HALF) = w; } }
    }
};
struct EpiF32Resid {
    static constexpr bool PERM = false, AFTER_DRAIN = false;
    float* C; const float* R; int ldc;
    __device__ __forceinline__ void operator()(const f32x4 (&acc)[2][2][4][2], const Unit& u, int wr, int wc, int fr, int fq) const {
        const int row0 = u.pm * BM + wr * 64 + fr, col0 = u.pn * BM + wc * 32 + 4 * fq;
#pragma unroll
        for (int ai = 0; ai < 2; ++ai)
#pragma unroll
            for (int m = 0; m < 4; ++m) { const size_t off = (size_t)(row0 + ai * HALF + m * 16) * ldc + col0;
#pragma unroll
                for (int bj = 0; bj < 2; ++bj)
#pragma unroll
                    for (int n = 0; n < 2; ++n) { f32x4 v = acc[ai][bj][m][n]; if (R) v += *(const f32x4*)(R + off + bj * HALF + n * 16); *(f32x4*)(C + off + bj * HALF + n * 16) = v; }
                asm volatile("" ::: "memory"); }
    }
};
template <class Epi, class Sched, bool STAMP = false>
__device__ __forceinline__ void gemm_phase(PG8_LAS unsigned char* lds, const Gemm g, const Sched& S, const Epi& E, unsigned long long* stamps) {
    const int tid = threadIdx.x, wid = __builtin_amdgcn_readfirstlane(tid >> 6), lane = tid & 63, wr = wid >> 2, wc = wid & 3, fr = lane & 15, fq = lane >> 4;
    const int K = g.K, nt = K / BK;
    int ts_lo = 0, ts_hi = 0, nts = 0; const unsigned long long rt_entry = STAMP ? (unsigned long long)0ull : 0ull;
#define PG8_STAMP() do { if (STAMP && wid == 0 && nts < 64) { const unsigned long long _c = (unsigned long long)clock64(); \
        ts_lo = (lane == nts) ? (int)(unsigned)_c : ts_lo; ts_hi = (lane == nts) ? (int)(unsigned)(_c >> 32) : ts_hi; ++nts; } } while (0)
    PG8_STAMP();
    unsigned voffA[2], voffB[2];
#pragma unroll
    for (int i = 0; i < 2; ++i) { int R, C; stage_rc(tid * 16 + i * 8192, R, C); const int Rb = Epi::PERM ? ((R & ~31) + perm32(R & 31)) : R;
        voffA[i] = (unsigned)(R * K + C) * 2u; voffB[i] = (unsigned)(Rb * K + C) * 2u; }
    const size_t kstep = (size_t)(BK * 2);
    const size_t hstep = (size_t)HALF * K * 2;
    const size_t tstep = 2 * hstep;
    const unsigned ldsw = (unsigned)wid * 1024u;
    const int aoff = lds_byte(wr * 64 + fr, fq * 8), boff = lds_byte(wc * 32 + fr, fq * 8);
#define PG8_SA(b, h) (((b) * 2 + (h)) * HTB)
#define PG8_SB(b, h) ((4 + (b) * 2 + (h)) * HTB)
#define PG8_STAGE(bufoff, gbase, voff) do { _Pragma("unroll") for (int _i = 0; _i < 2; ++_i) \
        __builtin_amdgcn_global_load_lds((const unsigned*)((const char*)(gbase) + (voff)[_i]), (PG8_LAS unsigned*)(lds + (bufoff) + ldsw + _i * 8192), 16, 0, 0); } while (0)
#define PG8_LDA(dst, b, h) do { _Pragma("unroll") for (int m = 0; m < 4; ++m) _Pragma("unroll") for (int k = 0; k < 2; ++k) dst[m][k] = *(const PG8_LAS bf16x8*)(lds + PG8_SA(b, h) + aoff + m * 2048 + k * 1024); } while (0)
#define PG8_LDB(dst, b, h) do { _Pragma("unroll") for (int n = 0; n < 2; ++n) _Pragma("unroll") for (int k = 0; k < 2; ++k) dst[n][k] = *(const PG8_LAS bf16x8*)(lds + PG8_SB(b, h) + boff + n * 2048 + k * 1024); } while (0)
#define PG8_MMA(ai, bj, At, Bt) do { __builtin_amdgcn_s_setprio(1); _Pragma("unroll") for (int m = 0; m < 4; ++m) _Pragma("unroll") for (int n = 0; n < 2; ++n) _Pragma("unroll") for (int k = 0; k < 2; ++k) \
        acc[ai][bj][m][n] = __builtin_amdgcn_mfma_f32_16x16x32_bf16(Bt[n][k], At[m][k], acc[ai][bj][m][n], 0, 0, 0); __builtin_amdgcn_s_setprio(0); } while (0)
#define PG8_WAIT_V(n) asm volatile("s_waitcnt vmcnt(" #n ")" ::: "memory")
#define PG8_WAIT_L(n) asm volatile("s_waitcnt lgkmcnt(" #n ")" ::: "memory")
#define PG8_BAR __builtin_amdgcn_s_barrier()
#define PG8_SCHED __builtin_amdgcn_sched_barrier(0)
    Unit cur, nxt; int ui = 0;
    if (!S.next(0, cur)) return;
    f32x4 acc[2][2][4][2];
#pragma unroll
    for (int a = 0; a < 2; ++a)
#pragma unroll
        for (int b = 0; b < 2; ++b)
#pragma unroll
            for (int m = 0; m < 4; ++m)
#pragma unroll
                for (int n = 0; n < 2; ++n) acc[a][b][m][n] = (f32x4){0.f, 0.f, 0.f, 0.f};
    bf16x8 At[4][2], B0[2][2], B1[2][2];
    const char* cA = (const char*)g.A + (size_t)cur.pm * tstep; const char* cB = (const char*)g.Bt + (size_t)cur.pn * tstep;
    S.a_ready(cur);
    PG8_STAGE(PG8_SB(0, 0), cB, voffB); PG8_STAGE(PG8_SA(0, 0), cA, voffA); PG8_STAGE(PG8_SB(0, 1), cB + hstep, voffB); PG8_STAGE(PG8_SA(0, 1), cA + hstep, voffA);
    if (wr == 1) PG8_BAR;
    PG8_WAIT_V(4); PG8_BAR;
    PG8_STAGE(PG8_SB(1, 0), cB + kstep, voffB); PG8_STAGE(PG8_SA(1, 0), cA + kstep, voffA); PG8_STAGE(PG8_SB(1, 1), cB + hstep + kstep, voffB);
    PG8_WAIT_V(6); PG8_BAR;
    PG8_STAMP();
    for (;;) {
        const bool has_next = S.next(ui + 1, nxt);
        const char* nA = has_next ? (const char*)g.A + (size_t)nxt.pm * tstep : cA; const char* nB = has_next ? (const char*)g.Bt + (size_t)nxt.pn * tstep : cB;
        for (int t = 0; t < nt; t += 2) {
            const bool last = (t == nt - 2);
            const char* a1 = cA + (size_t)(t + 1) * kstep;
            const char* a2 = last ? nA : cA + (size_t)(t + 2) * kstep; const char* b2 = last ? nB : cB + (size_t)(t + 2) * kstep;
            const char* a3 = a2 + kstep; const char* b3 = b2 + kstep;
            if (last && has_next) S.a_ready(nxt);
            PG8_LDB(B0, 0, 0); PG8_SCHED; PG8_LDA(At, 0, 0); PG8_STAGE(PG8_SA(1, 1), a1 + hstep, voffA);
            PG8_WAIT_L(8); PG8_BAR; PG8_WAIT_L(0); PG8_MMA(0, 0, At, B0); PG8_BAR; PG8_SCHED;
            PG8_LDB(B1, 0, 1); PG8_STAGE(PG8_SB(0, 0), b2, voffB);
            PG8_BAR; PG8_WAIT_L(0); PG8_MMA(0, 1, At, B1); PG8_BAR;
            PG8_LDA(At, 0, 1); PG8_STAGE(PG8_SA(0, 0), a2, voffA);
            PG8_BAR; PG8_WAIT_L(0); PG8_MMA(1, 0, At, B0); PG8_BAR; PG8_SCHED;
            PG8_STAGE(PG8_SB(0, 1), b2 + hstep, voffB);
            PG8_WAIT_V(6); PG8_BAR; PG8_MMA(1, 1, At, B1); PG8_BAR;
            PG8_LDB(B0, 1, 0); PG8_SCHED; PG8_LDA(At, 1, 0); PG8_STAGE(PG8_SA(0, 1), a2 + hstep, voffA);
            PG8_WAIT_L(8); PG8_BAR; PG8_WAIT_L(0); PG8_MMA(0, 0, At, B0); PG8_BAR; PG8_SCHED;
            PG8_LDB(B1, 1, 1); PG8_STAGE(PG8_SB(1, 0), b3, voffB);
            PG8_BAR; PG8_WAIT_L(0); PG8_MMA(0, 1, At, B1); PG8_BAR;
            PG8_LDA(At, 1, 1); PG8_STAGE(PG8_SA(1, 0), a3, voffA);
            PG8_BAR; PG8_WAIT_L(0); PG8_MMA(1, 0, At, B0); PG8_BAR; PG8_SCHED;
            PG8_STAGE(PG8_SB(1, 1), b3 + hstep, voffB);
            PG8_WAIT_V(6); PG8_BAR; PG8_MMA(1, 1, At, B1); PG8_BAR;
        }
        PG8_STAMP();
        if constexpr (!Epi::AFTER_DRAIN) { E(acc, cur, wr, wc, fr, fq); S.done(cur); }
        PG8_STAMP();
        if (!has_next) break;
#pragma unroll
        for (int a = 0; a < 2; ++a)
#pragma unroll
            for (int b = 0; b < 2; ++b)
#pragma unroll
                for (int m = 0; m < 4; ++m)
#pragma unroll
                    for (int n = 0; n < 2; ++n) acc[a][b][m][n] = (f32x4){0.f, 0.f, 0.f, 0.f};
        cur = nxt; cA = nA; cB = nB; ++ui;
    }
    PG8_WAIT_V(0);
    if (wr == 0) PG8_BAR;
    PG8_BAR;
    if constexpr (Epi::AFTER_DRAIN) { E.fused(acc, cur, wr, wc, fr, fq, lds, wid, lane); S.done(cur); }
    PG8_STAMP();
    if (STAMP && wid == 0) { stamps[lane] = lane < nts ? (((unsigned long long)(unsigned)ts_hi << 32) | (unsigned)ts_lo) : 0ull;
        if (lane == 62) stamps[62] = rt_entry; if (lane == 63) stamps[63] = (unsigned long long)0ull; }
#undef PG8_STAMP
#undef PG8_SA
#undef PG8_SB
#undef PG8_STAGE
#undef PG8_LDA
#undef PG8_LDB
#undef PG8_MMA
#undef PG8_WAIT_V
#undef PG8_WAIT_L
#undef PG8_BAR
#undef PG8_SCHED
}
}

namespace {
constexpr int D = 1024, BATCH = 2, SEQ = 8192, T = BATCH * SEQ;
constexpr int PW = 2312;
constexpr int PS = 2304;
constexpr int OQ = 0, OKK = 512, OV = 640, OZ = 768, OXBC = 1280, ODT = 2304;
constexpr float EPS = 1e-6f;
constexpr int NTHR = 512;
typedef unsigned short bf16;
typedef unsigned v4u __attribute__((ext_vector_type(4)));

constexpr size_t MiB = 1u << 20;
constexpr size_t WS_WIN = 1 * MiB;
constexpr size_t WS_WO = 6 * MiB;
constexpr size_t WS_WQ = 8 * MiB;
constexpr size_t WS_PROJ = 10 * MiB;
constexpr size_t WS_XNB = 82 * MiB;
constexpr size_t WS_XACT = 114 * MiB;
constexpr size_t WS_DTRAW = 146 * MiB;
constexpr size_t WS_DT = WS_DTRAW + 512 * 1024;
constexpr size_t WS_ACS = WS_DT + 512 * 1024;
constexpr size_t WS_CDEC = WS_ACS + 512 * 1024;
constexpr size_t WS_STATES = 164 * MiB;
constexpr size_t WS_PREV = 196 * MiB;
constexpr size_t WS_QP = 10 * MiB;
constexpr size_t WS_IDX = 74 * MiB;
constexpr size_t WS_GATE = 114 * MiB;
constexpr size_t WS_TOPV = 122 * MiB;
constexpr size_t WS_TOPI = 138 * MiB;
constexpr size_t WS_UB = 164 * MiB;
constexpr size_t WS_VB = 196 * MiB;
constexpr size_t WS_ACT = 154 * MiB;
constexpr size_t WS_PEERO = 10 * MiB;
constexpr size_t WS_END = 228 * MiB;
constexpr int CW_QU = 4096, CW_QV = 4096 + 64 * 16;
constexpr int NPART = 16, NCHUNK = T / 64;

struct Args {
    const float* x; const float* norm_mix_g; const float* w_in; const float* attn_sinks; const float* attn_out_g;
    const float* conv_w; const float* conv_b; const float* dt_bias; const float* a_log; const float* d_skip;
    const float* ssm_norm_g; const float* w_out; const float* norm_ffn_g; const float* peer_wq; const float* peer_sub_keys;
    const float* peer_u; const float* peer_v; const float* final_norm_g;
    float* out; unsigned char* ws;
    int ph_lo, ph_hi;
};

#define LAS __attribute__((address_space(3)))
#define LDS_WAIT() asm volatile("s_waitcnt lgkmcnt(0)" ::: "memory")
__device__ __forceinline__ float bf2f(bf16 v) { return __uint_as_float(((unsigned)v) << 16); }
__device__ __forceinline__ unsigned f2bfu(float f) { unsigned u = __float_as_uint(f); return (u + 0x7fffu + ((u >> 16) & 1u)) >> 16; }
__device__ __forceinline__ bf16 f2bf(float f) { return (bf16)f2bfu(f); }
__device__ __forceinline__ unsigned pk2(float lo, float hi) { return f2bfu(lo) | (f2bfu(hi) << 16); }
__device__ __forceinline__ float wave_sum(float v) {
#pragma unroll
    for (int o = 1; o < 64; o <<= 1) v += __shfl_xor(v, o);
    return v;
}
__device__ __forceinline__ float silu_f(float v) { return v / (1.f + __expf(-v)); }

__device__ __forceinline__ void transpose_item(const float* W, int ldw, int K, bf16* WT, LAS float* scr, int kb, int nbk, int lane) {
    const int k0 = 64 * kb, n0 = 32 * nbk;
#pragma unroll 8
    for (int i = 0; i < 32; ++i) { const int kk = 2 * i + (lane >> 5); scr[kk * 33 + (lane & 31)] = W[(size_t)(k0 + kk) * ldw + n0 + (lane & 31)]; }
    LDS_WAIT();
    const int c = lane & 7;
#pragma unroll
    for (int j = 0; j < 4; ++j) { const int n = (lane >> 3) + 8 * j; const LAS float* s = scr + (8 * c) * 33 + n;
        v4u o; o.x = pk2(s[0 * 33], s[1 * 33]); o.y = pk2(s[2 * 33], s[3 * 33]); o.z = pk2(s[4 * 33], s[5 * 33]); o.w = pk2(s[6 * 33], s[7 * 33]);
        *(v4u*)(WT + (size_t)(n0 + n) * K + k0 + 8 * c) = o; }
    LDS_WAIT();
}

template <bool WITH_DT>
__device__ __forceinline__ void rmsnorm_rows_bf16(const float* in, const float* g, bf16* outp, const float* w_in, float* dtraw, int gwave, int nwaves, int lane) {
    for (int row = gwave; row < T; row += nwaves) {
        const float4* xr = (const float4*)(in + (size_t)row * D) + lane;
        float4 v[4]; float ss = 0.f;
#pragma unroll
        for (int j = 0; j < 4; ++j) { v[j] = xr[64 * j]; ss += v[j].x * v[j].x + v[j].y * v[j].y + v[j].z * v[j].z + v[j].w * v[j].w; }
        ss = wave_sum(ss);
        const float r = rsqrtf(ss * (1.f / D) + EPS);
        unsigned long long* o8 = (unsigned long long*)(outp + (size_t)row * D) + lane;
        float dacc[8];
#pragma unroll
        for (int h = 0; h < 8; ++h) dacc[h] = 0.f;
#pragma unroll
        for (int j = 0; j < 4; ++j) {
            const float4 gv = ((const float4*)g)[lane + 64 * j];
            const float y[4] = {v[j].x * r * gv.x, v[j].y * r * gv.y, v[j].z * r * gv.z, v[j].w * r * gv.w};
            o8[64 * j] = (unsigned long long)pk2(y[0], y[1]) | ((unsigned long long)pk2(y[2], y[3]) << 32);
            if (WITH_DT) {
#pragma unroll
                for (int e = 0; e < 4; ++e) {
                    const float4* wp = (const float4*)(w_in + (size_t)(256 * j + 4 * lane + e) * PW + ODT);
                    const float4 w0 = wp[0], w1 = wp[1];
                    dacc[0] += y[e] * w0.x; dacc[1] += y[e] * w0.y; dacc[2] += y[e] * w0.z; dacc[3] += y[e] * w0.w;
                    dacc[4] += y[e] * w1.x; dacc[5] += y[e] * w1.y; dacc[6] += y[e] * w1.z; dacc[7] += y[e] * w1.w;
                }
            }
        }
        if (WITH_DT) {
#pragma unroll
            for (int h = 0; h < 8; ++h) dacc[h] = wave_sum(dacc[h]);
            if (lane == 0) { float4* dp = (float4*)(dtraw + (size_t)row * 8); dp[0] = make_float4(dacc[0], dacc[1], dacc[2], dacc[3]); dp[1] = make_float4(dacc[4], dacc[5], dacc[6], dacc[7]); }
        }
    }
}


typedef short bf16x8 __attribute__((ext_vector_type(8)));
typedef short bf16x4 __attribute__((ext_vector_type(4)));
typedef float f32x16 __attribute__((ext_vector_type(16)));
typedef __bf16 bf2_t __attribute__((ext_vector_type(2)));
#define MFMA32(a, b, c) __builtin_amdgcn_mfma_f32_32x32x16_bf16((a), (b), (c), 0, 0, 0)
__device__ __forceinline__ unsigned pkbf(float lo, float hi) { bf2_t v = {(__bf16)lo, (__bf16)hi}; return __builtin_bit_cast(unsigned, v); }
__device__ __forceinline__ short bfs(float f) { return __builtin_bit_cast(short, (__bf16)f); }
__device__ __forceinline__ float sbf2f(short v) { return __uint_as_float(((unsigned)(unsigned short)v) << 16); }
__device__ __forceinline__ int crow(int i, int hi) { return (i & 3) + 8 * (i >> 2) + 4 * hi; }
template <int S> __device__ __forceinline__ bf16x8 pack8(const f32x16& x) {
    v4u p; p.x = pkbf(x[8 * S], x[8 * S + 1]); p.y = pkbf(x[8 * S + 2], x[8 * S + 3]); p.z = pkbf(x[8 * S + 4], x[8 * S + 5]); p.w = pkbf(x[8 * S + 6], x[8 * S + 7]);
    return __builtin_bit_cast(bf16x8, p);
}
__device__ __forceinline__ bf16x8 ldg8(const bf16* p) { return *(const bf16x8*)p; }
__device__ __forceinline__ bf16x8 lds8(const LAS bf16* p) { return *(const LAS bf16x8*)p; }
__device__ __forceinline__ bf16x8 lds4x2(const LAS bf16* p) { const bf16x4 a = *(const LAS bf16x4*)p, b = *(const LAS bf16x4*)(p + 8); return __builtin_shufflevector(a, b, 0, 1, 2, 3, 4, 5, 6, 7); }
__device__ __forceinline__ f32x16 zero16() { f32x16 z;
#pragma unroll
    for (int i = 0; i < 16; ++i) z[i] = 0.f;
    return z; }

__device__ __forceinline__ void attn_unit(const float* sinks, LAS unsigned char* ldsb, int unit, const bf16* PROJ, float* MIXF, int tid, int lane, int wave) {
    const int hkv = unit & 1, blk = unit >> 1, nbk = blk & 63;
    const int tokblk = blk * 128, wbase = tokblk - 128;
    LAS bf16* VT = (LAS bf16*)ldsb;
#pragma unroll
    for (int i = 0; i < 4; ++i) {
        const int c = tid + 512 * i, key = c >> 3, d0 = (c & 7) * 8; const bool valid = (nbk > 0) || (key >= 128);
        bf16x8 v;
#pragma unroll
        for (int e = 0; e < 8; ++e) v[e] = 0;
        if (valid) v = ldg8(PROJ + (size_t)(wbase + key) * PS + OV + hkv * 64 + d0);
#pragma unroll
        for (int e = 0; e < 8; ++e) VT[(d0 + e) * 264 + key] = (bf16)v[e];
    }
    __syncthreads();
    const int r = lane & 31, hi = lane >> 5;
    const int hq = hkv * 4 + (wave & 3);
    const float slope = exp2f(-(float)(hq + 1)), sink = sinks[hq];
#pragma unroll 1
    for (int qq = 0; qq < 2; ++qq) {
        const int qt = (wave >> 2) + 2 * qq;
        const int tq = tokblk + 32 * qt + r;
        bf16x8 qf[4];
#pragma unroll
        for (int ks = 0; ks < 4; ++ks) qf[ks] = ldg8(PROJ + (size_t)tq * PS + OQ + hq * 64 + 16 * ks + 8 * hi);
        f32x16 X[5];
#pragma unroll
        for (int kt = 0; kt < 5; ++kt) {
            const int key = 32 * (qt + kt) + r; const bool valid = (nbk > 0) || (key >= 128);
            const int row = valid ? (wbase + key) : tokblk;
            X[kt] = zero16();
#pragma unroll
            for (int ks = 0; ks < 4; ++ks) { const bf16x8 kf = ldg8(PROJ + (size_t)row * PS + OKK + hkv * 64 + 16 * ks + 8 * hi); X[kt] = MFMA32(kf, qf[ks], X[kt]); }
        }
        const int qi = 32 * qt + r;
        float m = -1e30f;
#pragma unroll
        for (int kt = 0; kt < 5; ++kt)
#pragma unroll
            for (int i = 0; i < 16; ++i) {
                const int ki = 32 * (qt + kt) + crow(i, hi), dist = 128 + qi - ki;
                const bool valid = (dist >= 0) && (dist < 128) && ((nbk > 0) || (ki >= 128));
                const float lg = valid ? (X[kt][i] * 0.125f - slope * (float)dist) : -1e30f;
                X[kt][i] = lg; m = fmaxf(m, lg);
            }
        m = fmaxf(m, __shfl_xor(m, 32)); m = fmaxf(m, sink);
        float lsum = 0.f;
#pragma unroll
        for (int kt = 0; kt < 5; ++kt)
#pragma unroll
            for (int i = 0; i < 16; ++i) { const float p = __expf(X[kt][i] - m); X[kt][i] = p; lsum += p; }
        lsum += __shfl_xor(lsum, 32); lsum += __expf(sink - m);
        f32x16 O0 = zero16(), O1 = zero16();
#pragma unroll
        for (int kt = 0; kt < 5; ++kt) {
            const int kb = 32 * (qt + kt) + 4 * hi;
            { const bf16x8 xs = pack8<0>(X[kt]); const bf16x8 a0 = lds4x2(VT + r * 264 + kb), a1 = lds4x2(VT + (32 + r) * 264 + kb); O0 = MFMA32(a0, xs, O0); O1 = MFMA32(a1, xs, O1); }
            { const bf16x8 xs = pack8<1>(X[kt]); const bf16x8 a0 = lds4x2(VT + r * 264 + kb + 16), a1 = lds4x2(VT + (32 + r) * 264 + kb + 16); O0 = MFMA32(a0, xs, O0); O1 = MFMA32(a1, xs, O1); }
        }
        const float inv = 1.f / lsum;
        float* orow = MIXF + (size_t)tq * D + hq * 64 + 4 * hi;
#pragma unroll
        for (int q4 = 0; q4 < 4; ++q4) {
            *(float4*)(orow + 8 * q4) = make_float4(O0[4 * q4] * inv, O0[4 * q4 + 1] * inv, O0[4 * q4 + 2] * inv, O0[4 * q4 + 3] * inv);
            *(float4*)(orow + 32 + 8 * q4) = make_float4(O1[4 * q4] * inv, O1[4 * q4 + 1] * inv, O1[4 * q4 + 2] * inv, O1[4 * q4 + 3] * inv);
        }
    }
    __syncthreads();
}

__device__ __forceinline__ void ssd_chunk_unit(LAS unsigned char* ldsb, int unit, const bf16* XACT, const float* DT, const float* ACS, float* MIXF, float* STATES, int tid, int lane, int wave) {
    const int g = unit & 1, bc = unit >> 1, tok0 = bc * 128;
    LAS bf16* BT = (LAS bf16*)ldsb;
    LAS bf16* XD = (LAS bf16*)(ldsb + 34816);
    LAS bf16* XW = (LAS bf16*)(ldsb + 34816 + 34816);
    LAS float* ACST = (LAS float*)(ldsb + 34816 * 3);
    const int r = lane & 31, hi = lane >> 5;
#pragma unroll
    for (int i = 0; i < 4; ++i) {
        const int c = tid + 512 * i, s = c >> 4, n0 = (c & 15) * 8;
        const bf16x8 v = ldg8(XACT + (size_t)(tok0 + s) * 1024 + 512 + g * 128 + n0);
#pragma unroll
        for (int e = 0; e < 8; ++e) BT[(n0 + e) * 136 + s] = (bf16)v[e];
    }
    ACST[tid] = ACS[(size_t)(tok0 + (tid >> 2)) * 8 + g * 4 + (tid & 3)];
#pragma unroll 1
    for (int hp = 0; hp < 2; ++hp) {
        if (hp) __syncthreads();
#pragma unroll
        for (int i = 0; i < 4; ++i) {
            const int c = tid + 512 * i, hsel = c >> 10, s = (c >> 3) & 127, p0 = (c & 7) * 8, H = g * 4 + 2 * hp + hsel;
            const bf16x8 v = ldg8(XACT + (size_t)(tok0 + s) * 1024 + H * 64 + p0);
            const float dtv = DT[(size_t)(tok0 + s) * 8 + H];
            const float w = __expf(ACS[(size_t)(tok0 + 127) * 8 + H] - ACS[(size_t)(tok0 + s) * 8 + H]);
#pragma unroll
            for (int e = 0; e < 8; ++e) { const float xd = sbf2f(v[e]) * dtv; XD[hsel * 8704 + (p0 + e) * 136 + s] = (bf16)bfs(xd); XW[hsel * 8704 + (p0 + e) * 136 + s] = (bf16)bfs(xd * w); }
        }
        __syncthreads();
        {
            const int lt = wave & 3, hsel = wave >> 2, hh = 2 * hp + hsel, H = g * 4 + hh;
            const int l = 32 * lt + r; const float acs_l = ACST[l * 4 + hh];
            bf16x8 cf[8];
#pragma unroll
            for (int ks = 0; ks < 8; ++ks) cf[ks] = ldg8(XACT + (size_t)(tok0 + l) * 1024 + 768 + g * 128 + 16 * ks + 8 * hi);
            f32x16 Z0 = zero16(), Z1 = zero16();
#pragma unroll 1
            for (int st = 0; st <= lt; ++st) {
                f32x16 X = zero16();
#pragma unroll
                for (int ks = 0; ks < 8; ++ks) { const bf16x8 bfr = ldg8(XACT + (size_t)(tok0 + 32 * st + r) * 1024 + 512 + g * 128 + 16 * ks + 8 * hi); X = MFMA32(bfr, cf[ks], X); }
#pragma unroll
                for (int i = 0; i < 16; ++i) { const int s = 32 * st + crow(i, hi); const float f = (s <= l) ? __expf(acs_l - ACST[s * 4 + hh]) : 0.f; X[i] *= f; }
                const int sb = 32 * st + 4 * hi;
                { const bf16x8 xs = pack8<0>(X); const bf16x8 b0 = lds4x2(XD + hsel * 8704 + r * 136 + sb), b1 = lds4x2(XD + hsel * 8704 + (32 + r) * 136 + sb); Z0 = MFMA32(xs, b0, Z0); Z1 = MFMA32(xs, b1, Z1); }
                { const bf16x8 xs = pack8<1>(X); const bf16x8 b0 = lds4x2(XD + hsel * 8704 + r * 136 + sb + 16), b1 = lds4x2(XD + hsel * 8704 + (32 + r) * 136 + sb + 16); Z0 = MFMA32(xs, b0, Z0); Z1 = MFMA32(xs, b1, Z1); }
            }
#pragma unroll
            for (int i = 0; i < 16; ++i) { float* o = MIXF + (size_t)(tok0 + 32 * lt + crow(i, hi)) * D + 512 + H * 64 + r; o[0] = Z0[i]; o[32] = Z1[i]; }
        }
        {
            const int nt = wave & 3, hsel = wave >> 2, H = g * 4 + 2 * hp + hsel;
            f32x16 S0 = zero16(), S1 = zero16();
#pragma unroll
            for (int ks = 0; ks < 8; ++ks) {
                const bf16x8 btf = lds8(BT + (32 * nt + r) * 136 + 16 * ks + 8 * hi);
                const bf16x8 a0 = lds8(XW + hsel * 8704 + r * 136 + 16 * ks + 8 * hi), a1 = lds8(XW + hsel * 8704 + (32 + r) * 136 + 16 * ks + 8 * hi);
                S0 = MFMA32(a0, btf, S0); S1 = MFMA32(a1, btf, S1);
            }
            float* sp = STATES + (size_t)(bc * 8 + H) * 8192 + 32 * nt + r;
#pragma unroll
            for (int i = 0; i < 16; ++i) { const int p = crow(i, hi); sp[p * 128] = S0[i]; sp[(32 + p) * 128] = S1[i]; }
        }
    }
    __syncthreads();
}

__device__ __forceinline__ void yoff_unit(const float* d_skip, int unit, const bf16* XACT, const bf16* PROJ, const float* ACS, const bf16* PREVT, float* MIXF, int lane, int wave) {
    const int g = unit & 1, bc = unit >> 1, tok0 = bc * 128;
    const int r = lane & 31, hi = lane >> 5, lt = wave & 3, hpair = wave >> 2;
    bf16x8 cf[8];
#pragma unroll
    for (int ks = 0; ks < 8; ++ks) cf[ks] = ldg8(XACT + (size_t)(tok0 + 32 * lt + r) * 1024 + 768 + g * 128 + 16 * ks + 8 * hi);
#pragma unroll 1
    for (int hsel = 0; hsel < 2; ++hsel) {
        const int H = g * 4 + 2 * hpair + hsel; const bf16* pv = PREVT + (size_t)(bc * 8 + H) * 8192;
        f32x16 Y0 = zero16(), Y1 = zero16();
#pragma unroll
        for (int ks = 0; ks < 8; ++ks) {
            const bf16x8 b0 = ldg8(pv + r * 128 + 16 * ks + 8 * hi), b1 = ldg8(pv + (32 + r) * 128 + 16 * ks + 8 * hi);
            Y0 = MFMA32(cf[ks], b0, Y0); Y1 = MFMA32(cf[ks], b1, Y1);
        }
        const float dsk = d_skip[H];
#pragma unroll
        for (int i = 0; i < 16; ++i) {
            const int t = tok0 + 32 * lt + crow(i, hi); const float ea = __expf(ACS[(size_t)t * 8 + H]);
#pragma unroll
            for (int pt = 0; pt < 2; ++pt) {
                const int col = H * 64 + 32 * pt + r;
                float* yp = MIXF + (size_t)t * D + 512 + col;
                float y = yp[0] + ea * (pt ? Y1[i] : Y0[i]) + dsk * bf2f(XACT[(size_t)t * 1024 + col]);
                const float z = bf2f(PROJ[(size_t)t * PS + OZ + col]);
                yp[0] = y * silu_f(z);
            }
        }
    }
}


__device__ __forceinline__ void peer_u_item(int p, int j, const int* IDX, const float* GATE, const bf16* XN2B, const bf16* UB, float* ACT, int lane, int wave) {
    const int myk = 4 * (lane >> 5) + 2 * ((lane >> 4) & 1) + ((lane >> 3) & 1);
#pragma unroll 1
    for (int it = 0; it < 8; ++it) {
        const int t = j * 64 + it * 8 + wave;
        const int e0 = IDX[(size_t)t * 128 + lane], e1 = IDX[(size_t)t * 128 + 64 + lane];
        unsigned long long m0 = __ballot((e0 >> 10) == p), m1 = __ballot((e1 >> 10) == p);
        if ((m0 | m1) == 0ull) continue;
        float xv[16];
        { const bf16* xr = XN2B + (size_t)t * D + lane * 8; const uint4 w0 = *(const uint4*)xr, w1 = *(const uint4*)(xr + 512);
          const unsigned ww[8] = {w0.x, w0.y, w0.z, w0.w, w1.x, w1.y, w1.z, w1.w};
#pragma unroll
          for (int q = 0; q < 8; ++q) { xv[2 * q] = __uint_as_float(ww[q] << 16); xv[2 * q + 1] = __uint_as_float(ww[q] & 0xffff0000u); } }
        while ((m0 | m1) != 0ull) {
            int kk[8], ek[8];
#pragma unroll
            for (int q = 0; q < 8; ++q) {
                if (m0 != 0ull) { const int k = __builtin_amdgcn_readfirstlane(__builtin_ctzll(m0)); m0 &= m0 - 1ull; kk[q] = k; ek[q] = __builtin_amdgcn_readlane(e0, k); }
                else if (m1 != 0ull) { const int k = __builtin_amdgcn_readfirstlane(__builtin_ctzll(m1)); m1 &= m1 - 1ull; kk[q] = 64 + k; ek[q] = __builtin_amdgcn_readlane(e1, k); }
                else { kk[q] = -1; ek[q] = p * 1024; }
            }
            uint4 ua[8][2];
#pragma unroll
            for (int q = 0; q < 8; ++q) { const bf16* up = UB + (size_t)ek[q] * D + lane * 8; ua[q][0] = *(const uint4*)up; ua[q][1] = *(const uint4*)(up + 512); }
            float dk[8];
#pragma unroll
            for (int q = 0; q < 8; ++q) {
                float d = 0.f;
#pragma unroll
                for (int hf = 0; hf < 2; ++hf) { const unsigned ww[4] = {ua[q][hf].x, ua[q][hf].y, ua[q][hf].z, ua[q][hf].w};
#pragma unroll
                    for (int jj = 0; jj < 4; ++jj) { d += xv[hf * 8 + jj * 2] * __uint_as_float(ww[jj] << 16); d += xv[hf * 8 + jj * 2 + 1] * __uint_as_float(ww[jj] & 0xffff0000u); } }
                dk[q] = d;
            }
            float w4[4], y2[2], z;
            { const bool hi = (lane & 32) != 0;
#pragma unroll
              for (int i = 0; i < 4; ++i) { const float send = hi ? dk[i] : dk[i + 4]; const float recv = __shfl_xor(send, 32); w4[i] = (hi ? dk[i + 4] : dk[i]) + recv; } }
            { const bool hi = (lane & 16) != 0;
#pragma unroll
              for (int i = 0; i < 2; ++i) { const float send = hi ? w4[i] : w4[i + 2]; const float recv = __shfl_xor(send, 16); y2[i] = (hi ? w4[i + 2] : w4[i]) + recv; } }
            { const bool hi = (lane & 8) != 0; const float send = hi ? y2[0] : y2[1]; const float recv = __shfl_xor(send, 8); z = (hi ? y2[1] : y2[0]) + recv; }
            z += __shfl_xor(z, 4); z += __shfl_xor(z, 2); z += __shfl_xor(z, 1);
            int kq = kk[0];
#pragma unroll
            for (int q = 1; q < 8; ++q) kq = (myk == q) ? kk[q] : kq;
            if (kq >= 0 && (lane & 7) == 0) ACT[(size_t)t * 128 + kq] = GATE[(size_t)t * 128 + kq] * 0.5f * z * (1.f + erff(z * 0.70710678118654752f));
        }
    }
}
__device__ __forceinline__ void peer_v_item(int p, int j, const int* IDX, const float* ACT, const bf16* VB, float* PEERO, int lane, int wave) {
    const int gidx = lane >> 3, c8 = (lane & 7) * 8;
#pragma unroll 1
    for (int it = 0; it < 8; ++it) {
        const int t = j * 64 + it * 8 + wave;
        int e[16]; float ac[16];
#pragma unroll
        for (int q = 0; q < 4; ++q) {
            const int4 ev = *(const int4*)(IDX + (size_t)t * 128 + 16 * gidx + 4 * q); const float4 av = *(const float4*)(ACT + (size_t)t * 128 + 16 * gidx + 4 * q);
            e[4 * q] = ev.x; e[4 * q + 1] = ev.y; e[4 * q + 2] = ev.z; e[4 * q + 3] = ev.w; ac[4 * q] = av.x; ac[4 * q + 1] = av.y; ac[4 * q + 2] = av.z; ac[4 * q + 3] = av.w;
        }
        uint4 vv[16];
#pragma unroll
        for (int i = 0; i < 16; ++i) vv[i] = *(const uint4*)(VB + (size_t)e[i] * D + p * 64 + c8);
        float acc[8];
#pragma unroll
        for (int c = 0; c < 8; ++c) acc[c] = 0.f;
#pragma unroll
        for (int i = 0; i < 16; ++i) { const unsigned ww[4] = {vv[i].x, vv[i].y, vv[i].z, vv[i].w};
#pragma unroll
            for (int jj = 0; jj < 4; ++jj) { acc[2 * jj] += ac[i] * __uint_as_float(ww[jj] << 16); acc[2 * jj + 1] += ac[i] * __uint_as_float(ww[jj] & 0xffff0000u); } }
        float w4[4], y2[2], z;
        { const bool hi = (lane & 32) != 0;
#pragma unroll
          for (int i = 0; i < 4; ++i) { const float send = hi ? acc[i] : acc[i + 4]; const float recv = __shfl_xor(send, 32); w4[i] = (hi ? acc[i + 4] : acc[i]) + recv; } }
        { const bool hi = (lane & 16) != 0;
#pragma unroll
          for (int i = 0; i < 2; ++i) { const float send = hi ? w4[i] : w4[i + 2]; const float recv = __shfl_xor(send, 16); y2[i] = (hi ? w4[i + 2] : w4[i]) + recv; } }
        { const bool hi = (lane & 8) != 0; const float send = hi ? y2[0] : y2[1]; const float recv = __shfl_xor(send, 8); z = (hi ? y2[1] : y2[0]) + recv; }
        const int col = c8 + 4 * (lane >> 5) + 2 * ((lane >> 4) & 1) + ((lane >> 3) & 1);
        PEERO[(size_t)t * D + p * 64 + col] = z;
    }
}

#define XB_TMO      128
#define XB_XCNT(j)  (256  + 64 * (j))
#define XB_XSUB(j)  (1280 + 64 * (j))
#define XB_XGEN(j)  (2304 + 64 * (j))
#define XB_TOP      3328
#define XB_TOPGEN   3392
#define XCD_BAR_WORDS 3456
#define XB_SPIN_CAP (1u << 22)
__device__ __forceinline__ unsigned xb_ld(unsigned* p)              { return __hip_atomic_load(p, __ATOMIC_RELAXED, __HIP_MEMORY_SCOPE_AGENT); }
__device__ __forceinline__ unsigned xb_add(unsigned* p, unsigned v) { return __hip_atomic_fetch_add(p, v, __ATOMIC_RELAXED, __HIP_MEMORY_SCOPE_AGENT); }
__device__ __forceinline__ unsigned xb_xcc_id() { return (unsigned)__builtin_amdgcn_s_getreg((3 << 11) | 20) & 0xFu; }
#define XB_SPIN(cond, bar) do { unsigned _sp = 0; while (cond) { __builtin_amdgcn_s_sleep(1); \
    if ((++_sp & 255u) == 0u) { if (xb_ld(&(bar)[XB_TMO])) break; if (_sp > XB_SPIN_CAP) { atomicAdd(&(bar)[XB_TMO], 1u); break; } } } } while (0)
struct XcdBarrier { unsigned* bar; unsigned x; volatile LAS unsigned* st; };
__device__ __forceinline__ XcdBarrier xcd_barrier_post(unsigned* bar, volatile LAS unsigned* st) {
    XcdBarrier b; b.bar = bar; b.x = xb_xcc_id(); b.st = st;
    if (threadIdx.x == 0) (void)xb_add(&bar[XB_XCNT(b.x)], 1u);
    return b;
}
__device__ __forceinline__ void xcd_barrier_complete(unsigned* bar, unsigned x, unsigned& nloc, unsigned& nx) {
    const unsigned G = gridDim.x * gridDim.y * gridDim.z;
    unsigned sum, cnt, mine, sp = 0u;
    for (;;) {
        sum = 0u; cnt = 0u; mine = 0u;
#pragma unroll
        for (unsigned j = 0; j < 16; ++j) { const unsigned c = xb_ld(&bar[XB_XCNT(j)]); sum += c; cnt += (c > 0u) ? 1u : 0u; mine = (j == x) ? c : mine; }
        if (sum == G) break;
        __builtin_amdgcn_s_sleep(1);
        if ((++sp & 255u) == 0u) { if (xb_ld(&bar[XB_TMO])) break; if (sp > XB_SPIN_CAP) { atomicAdd(&bar[XB_TMO], 1u); break; } }
    }
    nloc = mine > 0u ? mine : 1u; nx = cnt > 0u ? cnt : 1u;
}
__device__ __forceinline__ void xcd_barrier(const XcdBarrier& b) {
    asm volatile("s_waitcnt vmcnt(0)" ::: "memory");
    __syncthreads();
    if (threadIdx.x == 0) {
        unsigned* bar = b.bar;
        __builtin_amdgcn_s_waitcnt(0);
        unsigned nloc = b.st[0], nx = b.st[1];
        if (nloc == 0u) { xcd_barrier_complete(bar, b.x, nloc, nx); b.st[0] = nloc; b.st[1] = nx; }
        const unsigned old = xb_add(&bar[XB_XSUB(b.x)], 1u);
        const unsigned gen = old / nloc;
        if (old + 1u == (gen + 1u) * nloc) {
            __builtin_amdgcn_fence(__ATOMIC_RELEASE, "agent");
            asm volatile("s_waitcnt vmcnt(0)" ::: "memory");
            const unsigned og = xb_add(&bar[XB_TOP], 1u);
            const unsigned tg = og / nx;
            if (og + 1u == (tg + 1u) * nx) xb_add(&bar[XB_TOPGEN], 1u);
            else XB_SPIN(xb_ld(&bar[XB_TOPGEN]) == tg, bar);
            __builtin_amdgcn_fence(__ATOMIC_ACQUIRE, "agent");
            xb_add(&bar[XB_XGEN(b.x)], 1u);
            asm volatile("s_waitcnt vmcnt(0)" ::: "memory");
        } else {
            XB_SPIN(xb_ld(&bar[XB_XGEN(b.x)]) == gen, bar);
            __builtin_amdgcn_fence(__ATOMIC_ACQUIRE, "agent");
            asm volatile("s_waitcnt vmcnt(0)" ::: "memory");
        }
    }
    __syncthreads();
}
constexpr int LDS_BYTES = 147456;
constexpr int MISC_OFF = 131072 + 320;

__global__ void __launch_bounds__(NTHR, 2) k_main(Args a) {
    extern __shared__ __attribute__((aligned(16))) unsigned char lds_raw[];
    LAS unsigned char* ldsb = (LAS unsigned char*)lds_raw;
    const int tid = threadIdx.x, lane = tid & 63, bid = blockIdx.x, nb = gridDim.x;
    const int wave = __builtin_amdgcn_readfirstlane(tid >> 6);
    const int gtid = bid * NTHR + tid, gthreads = nb * NTHR, gwave = gtid >> 6, nwaves = gthreads >> 6;
    unsigned char* ws = a.ws;
    bf16* WINT = (bf16*)(ws + WS_WIN); bf16* WOT = (bf16*)(ws + WS_WO); bf16* WQT = (bf16*)(ws + WS_WQ);
    bf16* PROJ = (bf16*)(ws + WS_PROJ);
    bf16* XNB = (bf16*)(ws + WS_XNB);
    bf16* XACT = (bf16*)(ws + WS_XACT);
    float* DTRAW = (float*)(ws + WS_DTRAW); float* DT = (float*)(ws + WS_DT); float* ACS = (float*)(ws + WS_ACS); float* CDEC = (float*)(ws + WS_CDEC);
    float* STATES = (float*)(ws + WS_STATES); bf16* PREVT = (bf16*)(ws + WS_PREV);
    float* QP = (float*)(ws + WS_QP); int* IDX = (int*)(ws + WS_IDX); float* GATE = (float*)(ws + WS_GATE);
    float* TOPV = (float*)(ws + WS_TOPV); int* TOPI = (int*)(ws + WS_TOPI);
    bf16* UB = (bf16*)(ws + WS_UB); bf16* VB = (bf16*)(ws + WS_VB);
    float* MIXF = a.out;
    volatile LAS unsigned* MISC = (volatile LAS unsigned*)(ldsb + MISC_OFF);
    if (tid < 32) MISC[tid] = 0u;
    __syncthreads();
    XcdBarrier bar = xcd_barrier_post((unsigned*)ws, MISC + 8);
#define IN(k) (a.ph_lo <= (k) && (k) < a.ph_hi)
#if defined(PROBE_LO)
    int seg_ = 0; unsigned long long tseg_ = __builtin_amdgcn_s_memrealtime();
#define PROBE_SPIN() do { if (seg_ >= PROBE_LO && seg_ <= PROBE_HI) { const unsigned long long d_ = (__builtin_amdgcn_s_memrealtime() - tseg_) * PROBE_AMP; const unsigned long long s_ = __builtin_amdgcn_s_memrealtime(); \
        while (__builtin_amdgcn_s_memrealtime() - s_ < d_) __builtin_amdgcn_s_sleep(4); } } while (0)
#define GRID_BAR() do { PROBE_SPIN(); xcd_barrier(bar); tseg_ = __builtin_amdgcn_s_memrealtime(); ++seg_; } while (0)
#else
#define PROBE_SPIN() do { } while (0)
#define GRID_BAR() xcd_barrier(bar)
#endif

    if (IN(0)) {
        LAS float* scr = (LAS float*)(ldsb + wave * 16384);
        constexpr int I_IN = 16 * 72, I_O = 16 * 32, NITEMS = I_IN + 2 * I_O;
        for (int it = gwave; it < NITEMS; it += nwaves) {
            int r = it;
            if (r < I_IN) { transpose_item(a.w_in, PW, D, WINT, scr, r / 72, r % 72, lane); continue; } r -= I_IN;
            if (r < I_O) { transpose_item(a.w_out, D, D, WOT, scr, r / 32, r % 32, lane); continue; } r -= I_O;
            transpose_item(a.peer_wq, D, D, WQT, scr, r / 32, r % 32, lane);
        }
        rmsnorm_rows_bf16<true>(a.x, a.norm_mix_g, XNB, a.w_in, DTRAW, gwave, nwaves, lane);
    }
    GRID_BAR();
    if (IN(1)) {
        pg8::Gemm g{XNB, WINT, T, PS, D}; pg8::StaticOrder S; S.init(T, PS, nb, bid);
        pg8::EpiBf16Plain E{PROJ, PS};
        pg8::gemm_phase<pg8::EpiBf16Plain, pg8::StaticOrder>(ldsb, g, S, E, nullptr);
    }
    GRID_BAR();
    if (IN(2)) {
        for (int idx = gtid; idx < T * 1024; idx += gthreads) {
            const int t = idx >> 10, c = idx & 1023, s = t & (SEQ - 1);
            float acc = a.conv_b[c];
#pragma unroll
            for (int k = 0; k < 4; ++k) { const int sp = s + k - 3; if (sp >= 0) acc += a.conv_w[k * 1024 + c] * bf2f(PROJ[(size_t)(t + k - 3) * PS + OXBC + c]); }
            XACT[idx] = f2bf(silu_f(acc));
        }
        if (gwave < 1024) {
            const int h = gwave & 7, bc = gwave >> 3;
            const float A = -__expf(a.a_log[h]), bias = a.dt_bias[h];
            const int t0 = bc * 128 + lane, t1 = t0 + 64;
            const float raw0 = DTRAW[t0 * 8 + h] + bias, raw1 = DTRAW[t1 * 8 + h] + bias;
            const float dt0 = fmaxf(raw0, 0.f) + log1pf(__expf(-fabsf(raw0))), dt1 = fmaxf(raw1, 0.f) + log1pf(__expf(-fabsf(raw1)));
            DT[t0 * 8 + h] = dt0; DT[t1 * 8 + h] = dt1;
            float v0 = dt0 * A, v1 = dt1 * A;
#pragma unroll
            for (int o = 1; o < 64; o <<= 1) { const float y0 = __shfl_up(v0, o), y1 = __shfl_up(v1, o); if (lane >= o) { v0 += y0; v1 += y1; } }
            v1 += __shfl(v0, 63);
            ACS[t0 * 8 + h] = v0; ACS[t1 * 8 + h] = v1;
            if (lane == 63) CDEC[gwave] = __expf(v1);
        }
    }
    GRID_BAR();
    if (IN(3)) {
        for (int u = bid; u < 512; u += nb) {
            if (u < 256) attn_unit(a.attn_sinks, ldsb, u, PROJ, MIXF, tid, lane, wave);
            else ssd_chunk_unit(ldsb, u - 256, XACT, DT, ACS, MIXF, STATES, tid, lane, wave);
        }
    }
    GRID_BAR();
    if (IN(5)) {
        for (int idx = gtid; idx < 2 * 8 * 8192; idx += gthreads) {
            const int pn = idx & 8191, h = (idx >> 13) & 7, b = idx >> 16;
            float run = 0.f;
#pragma unroll 1
            for (int c0 = 0; c0 < 64; c0 += 8) {
                float st[8], dc[8];
#pragma unroll
                for (int j = 0; j < 8; ++j) { const int bch = (b * 64 + c0 + j) * 8 + h; st[j] = STATES[(size_t)bch * 8192 + pn]; dc[j] = CDEC[bch]; }
#pragma unroll
                for (int j = 0; j < 8; ++j) { const int bch = (b * 64 + c0 + j) * 8 + h; PREVT[(size_t)bch * 8192 + pn] = f2bf(run); run = dc[j] * run + st[j]; }
            }
        }
    }
    GRID_BAR();
    if (IN(6)) {
        for (int u = bid; u < 256; u += nb) yoff_unit(a.d_skip, u, XACT, PROJ, ACS, PREVT, MIXF, lane, wave);
    }
    GRID_BAR();
    if (IN(6)) {
        for (int t = gwave; t < T; t += nwaves) {
            const float* row = MIXF + (size_t)t * D;
            const float4 a0 = *(const float4*)(row + 8 * lane), a1 = *(const float4*)(row + 8 * lane + 4);
            const float4 s0 = *(const float4*)(row + 512 + 8 * lane), s1 = *(const float4*)(row + 512 + 8 * lane + 4);
            float ssa = a0.x * a0.x + a0.y * a0.y + a0.z * a0.z + a0.w * a0.w + a1.x * a1.x + a1.y * a1.y + a1.z * a1.z + a1.w * a1.w;
            float sss = s0.x * s0.x + s0.y * s0.y + s0.z * s0.z + s0.w * s0.w + s1.x * s1.x + s1.y * s1.y + s1.z * s1.z + s1.w * s1.w;
            ssa = wave_sum(ssa);
#pragma unroll
            for (int o = 1; o < 32; o <<= 1) sss += __shfl_xor(sss, o);
            const float ra = rsqrtf(ssa * (1.f / 512.f) + EPS), rs = rsqrtf(sss * (1.f / 256.f) + EPS);
            const float4 ga0 = *(const float4*)(a.attn_out_g + 8 * lane), ga1 = *(const float4*)(a.attn_out_g + 8 * lane + 4);
            const float4 gs0 = *(const float4*)(a.ssm_norm_g + 8 * lane), gs1 = *(const float4*)(a.ssm_norm_g + 8 * lane + 4);
            v4u oa, os;
            oa.x = pkbf(a0.x * ra * ga0.x, a0.y * ra * ga0.y); oa.y = pkbf(a0.z * ra * ga0.z, a0.w * ra * ga0.w); oa.z = pkbf(a1.x * ra * ga1.x, a1.y * ra * ga1.y); oa.w = pkbf(a1.z * ra * ga1.z, a1.w * ra * ga1.w);
            os.x = pkbf(s0.x * rs * gs0.x, s0.y * rs * gs0.y); os.y = pkbf(s0.z * rs * gs0.z, s0.w * rs * gs0.w); os.z = pkbf(s1.x * rs * gs1.x, s1.y * rs * gs1.y); os.w = pkbf(s1.z * rs * gs1.z, s1.w * rs * gs1.w);
            *(v4u*)(XNB + (size_t)t * D + 8 * lane) = oa; *(v4u*)(XNB + (size_t)t * D + 512 + 8 * lane) = os;
        }
    }
    GRID_BAR();
    if (IN(7)) {
        pg8::Gemm g{XNB, WOT, T, D, D}; pg8::StaticOrder S; S.init(T, D, nb, bid);
        pg8::EpiF32Resid E{a.out, a.x, D};
        pg8::gemm_phase<pg8::EpiF32Resid, pg8::StaticOrder>(ldsb, g, S, E, nullptr);
    }
    GRID_BAR();
    if (IN(8)) {
        rmsnorm_rows_bf16<false>(a.out, a.norm_ffn_g, XNB, nullptr, nullptr, gwave, nwaves, lane);
        for (int i = gtid; i < 2 * 16384 * 128; i += gthreads) {
            const int which = i >> 21, r = i & ((1 << 21) - 1);
            const float4* src = (const float4*)((which ? a.peer_v : a.peer_u) + (size_t)r * 8);
            const float4 f0 = src[0], f1 = src[1];
            v4u o; o.x = pk2(f0.x, f0.y); o.y = pk2(f0.z, f0.w); o.z = pk2(f1.x, f1.y); o.w = pk2(f1.z, f1.w);
            *(v4u*)((which ? VB : UB) + (size_t)r * 8) = o;
        }
    }
    GRID_BAR();
    if (IN(9)) {
        pg8::Gemm g{XNB, WQT, T, D, D}; pg8::StaticOrder S; S.init(T, D, nb, bid);
        pg8::EpiF32Resid E{QP, nullptr, D};
        pg8::gemm_phase<pg8::EpiF32Resid, pg8::StaticOrder>(ldsb, g, S, E, nullptr);
    }
    GRID_BAR();
    if (IN(10)) {
        for (int item = gtid; item < 16 * T; item += gthreads) {
            const int t = item & (T - 1), hh = item >> 14, half = hh & 1;
            float q[64];
            const float4* qp = (const float4*)(QP + (size_t)t * D + hh * 64);
#pragma unroll
            for (int i = 0; i < 16; ++i) { const float4 w = qp[i]; q[i * 4] = w.x; q[i * 4 + 1] = w.y; q[i * 4 + 2] = w.z; q[i * 4 + 3] = w.w; }
            float bv[16]; int bi[16];
#pragma unroll
            for (int r = 0; r < 16; ++r) { bv[r] = -INFINITY; bi[r] = 0; }
            const float* kbase = a.peer_sub_keys + (size_t)half * 128 * 64;
            for (int k = 0; k < 128; ++k) {
                const float4* kp = (const float4*)(kbase + k * 64);
                float sc = 0.f;
#pragma unroll
                for (int i = 0; i < 16; ++i) { const float4 w = kp[i]; sc += q[i * 4] * w.x + q[i * 4 + 1] * w.y + q[i * 4 + 2] * w.z + q[i * 4 + 3] * w.w; }
                float cv = sc; int ci = k;
#pragma unroll
                for (int r = 0; r < 16; ++r) { const bool gt = cv > bv[r]; const float tv = gt ? bv[r] : cv; const int ti = gt ? bi[r] : ci; bv[r] = gt ? cv : bv[r]; bi[r] = gt ? ci : bi[r]; cv = tv; ci = ti; }
            }
            float* tv = TOPV + ((size_t)t * 16 + hh) * 16; int* ti = TOPI + ((size_t)t * 16 + hh) * 16;
#pragma unroll
            for (int r = 0; r < 16; ++r) { tv[r] = bv[r]; ti[r] = bi[r]; }
        }
    }
    GRID_BAR();
    if (IN(11)) {
        for (int item = gtid; item < 8 * T; item += gthreads) {
            const int t = item & (T - 1), hd = item >> 14;
            const float* v1 = TOPV + ((size_t)t * 16 + hd * 2) * 16; const float* v2 = v1 + 16;
            const int* i1 = TOPI + ((size_t)t * 16 + hd * 2) * 16; const int* i2 = i1 + 16;
            float bv[16]; int bi[16];
#pragma unroll
            for (int r = 0; r < 16; ++r) { bv[r] = -INFINITY; bi[r] = 0; }
#pragma unroll 1
            for (int aa = 0; aa < 16; ++aa) {
                const float va = v1[aa]; const int ia = i1[aa];
#pragma unroll 1
                for (int bb = 0; bb < 16; ++bb) {
                    float cv = va + v2[bb]; int ci = ia * 128 + i2[bb];
#pragma unroll
                    for (int r = 0; r < 16; ++r) { const bool gt = cv > bv[r]; const float tv = gt ? bv[r] : cv; const int ti = gt ? bi[r] : ci; bv[r] = gt ? cv : bv[r]; bi[r] = gt ? ci : bi[r]; cv = tv; ci = ti; }
                }
            }
            float e[16], se = 0.f;
#pragma unroll
            for (int r = 0; r < 16; ++r) { e[r] = __expf(bv[r] - bv[0]); se += e[r]; }
            const float inv = 1.f / se;
            float* gp = GATE + (size_t)t * 128 + hd * 16; int* ip = IDX + (size_t)t * 128 + hd * 16;
#pragma unroll
            for (int r = 0; r < 16; ++r) { gp[r] = e[r] * inv; ip[r] = bi[r]; }
        }
    }
    GRID_BAR();
    float* ACT = (float*)(ws + WS_ACT); float* PEERO = (float*)(ws + WS_PEERO);
    unsigned* ctl = (unsigned*)ws;
    const int xcc = (int)(bar.x & 7u);
    if (IN(12)) {
#pragma unroll 1
        for (int pi = 0; pi < NPART; ++pi) {
            const int p = ((xcc + (pi >> 1)) & 7) + 8 * (pi & 1);
            for (;;) {
                if (tid == 0) MISC[16] = xb_add(&ctl[CW_QU + 64 * p], 1u);
                __syncthreads();
                const int j = (int)MISC[16];
                __syncthreads();
                if (j >= NCHUNK) break;
                peer_u_item(p, j, IDX, GATE, XNB, UB, ACT, lane, wave);
            }
        }
    }
    GRID_BAR();
    if (IN(13)) {
#pragma unroll 1
        for (int pi = 0; pi < NPART; ++pi) {
            const int p = ((xcc + (pi >> 1)) & 7) + 8 * (pi & 1);
            for (;;) {
                if (tid == 0) MISC[16] = xb_add(&ctl[CW_QV + 64 * p], 1u);
                __syncthreads();
                const int j = (int)MISC[16];
                __syncthreads();
                if (j >= NCHUNK) break;
                peer_v_item(p, j, IDX, ACT, VB, PEERO, lane, wave);
            }
        }
    }
    GRID_BAR();
    if (IN(14)) {
        for (int t = gwave; t < T; t += nwaves) {
            const float4* hr = (const float4*)(a.out + (size_t)t * D) + lane; const float4* pr = (const float4*)(PEERO + (size_t)t * D) + lane;
            float4 v[4]; float ss = 0.f;
#pragma unroll
            for (int jq = 0; jq < 4; ++jq) { const float4 h4 = hr[64 * jq], p4 = pr[64 * jq]; v[jq] = make_float4(h4.x + p4.x, h4.y + p4.y, h4.z + p4.z, h4.w + p4.w); ss += v[jq].x * v[jq].x + v[jq].y * v[jq].y + v[jq].z * v[jq].z + v[jq].w * v[jq].w; }
            ss = wave_sum(ss);
            const float r3 = rsqrtf(ss * (1.f / D) + EPS);
            float4* op = (float4*)(a.out + (size_t)t * D) + lane;
#pragma unroll
            for (int jq = 0; jq < 4; ++jq) { const float4 gv = ((const float4*)a.final_norm_g)[lane + 64 * jq]; op[64 * jq] = make_float4(v[jq].x * r3 * gv.x, v[jq].y * r3 * gv.y, v[jq].z * r3 * gv.z, v[jq].w * r3 * gv.w); }
        }
    }
    PROBE_SPIN();
#undef IN
}
}

extern "C" void kernel_launch(void* const* d_in, const int* in_sizes, int n_in, void* d_out, int out_size, void* d_ws, size_t ws_size, hipStream_t stream) {
    if (n_in != 18 || out_size != T * D || ws_size < WS_END) { fprintf(stderr, "kernel_launch: unexpected shapes n_in=%d out=%d ws=%zu\n", n_in, out_size, ws_size); return; }
    Args a{};
    const float** ap = (const float**)&a;
    for (int i = 0; i < 18; ++i) ap[i] = (const float*)d_in[i];
    a.out = (float*)d_out; a.ws = (unsigned char*)d_ws;
    static int grid = 0;
    if (grid == 0) {
        int dev = 0, cus = 0, per_cu = 0;
        if (hipGetDevice(&dev) != hipSuccess || hipDeviceGetAttribute(&cus, hipDeviceAttributeMultiprocessorCount, dev) != hipSuccess) { fprintf(stderr, "kernel_launch: device query failed\n"); grid = -1; return; }
        if (hipFuncSetAttribute((const void*)k_main, hipFuncAttributeMaxDynamicSharedMemorySize, LDS_BYTES) != hipSuccess) { fprintf(stderr, "kernel_launch: hipFuncSetAttribute failed\n"); grid = -1; return; }
        if (hipOccupancyMaxActiveBlocksPerMultiprocessor(&per_cu, (const void*)k_main, NTHR, LDS_BYTES) != hipSuccess || per_cu < 1) { fprintf(stderr, "kernel_launch: occupancy query says %d blocks/CU\n", per_cu); (void)hipGetLastError(); grid = -1; return; }
        grid = cus;
    }
    if (grid < 0) return;
    if (hipMemsetAsync(d_ws, 0, 65536, stream) != hipSuccess) { fprintf(stderr, "kernel_launch: memset failed\n"); return; }
    a.ph_lo = 0; a.ph_hi = 15;
    hipLaunchKernelGGL(k_main, dim3(grid), dim3(NTHR), LDS_BYTES, stream, a);
}
```

```cpp
#include <hip/hip_runtime.h>
#include <cstdio>
#include <cstdint>

namespace pg8 {
#define PG8_LAS __attribute__((address_space(3)))
typedef unsigned short bf16_t;
typedef short bf16x8 __attribute__((ext_vector_type(8)));
typedef float f32x4 __attribute__((ext_vector_type(4)));
typedef unsigned u32x4 __attribute__((ext_vector_type(4)));
constexpr int BM = 256, BK = 64, HALF = 128, HTB = HALF * BK * 2  , STAGE_BYTES = 8 * HTB, NXCD = 8, WGM = 8;

__host__ __device__ __forceinline__ int lds_byte(int r, int c) { const int st = (r >> 4) * 2 + (c >> 5), rr = r & 15, cc = c & 31, ob = rr * 64 + cc * 2; return st * 1024 + (ob ^ (((ob >> 9) & 1) << 5)); }
__host__ __device__ __forceinline__ void stage_rc(int b, int& R, int& C) { const int st = b / 1024, sb = b % 1024, swz = sb ^ (((sb >> 9) & 1) << 5); R = (st >> 1) * 16 + swz / 64; C = (st & 1) * 32 + (swz % 64) / 2; }
__host__ __device__ __forceinline__ int perm32(int rho) { const int n = rho >> 4, i = rho & 15; return 8 * (i >> 2) + 4 * n + (i & 3); }

struct Unit { int pm, pn; };
struct Gemm { const bf16_t* A; const bf16_t* Bt; int M, N, K; };

struct StaticOrder {
    int nM, nN, nwg, G, c;
    __host__ __device__ void init(int M, int N, int G_, int c_) { nM = M / BM; nN = N / BM; nwg = nM * nN; G = G_; c = c_; }
    __host__ __device__ bool next(int i, Unit& u) const {
        const long L = (long)i * G + c; if (L >= nwg) return false;
        int wgid = (int)L; { const int q = nwg / NXCD, r = nwg % NXCD, xcd = wgid % NXCD, off = wgid / NXCD; wgid = (xcd < r ? xcd * (q + 1) : r * (q + 1) + (xcd - r) * q) + off; }
        const int nig = WGM * nN, gid = wgid / nig, fm = gid * WGM, gsz = (nM - fm) < WGM ? (nM - fm) : WGM;
        u.pm = fm + ((wgid % nig) % gsz); u.pn = (wgid % nig) / gsz; return true;
    }
    __device__ __forceinline__ void a_ready(const Unit&) const {}
    __device__ __forceinline__ void done(const Unit&) const {}
};
__device__ __forceinline__ unsigned cvt_pk_bf16(float lo, float hi) { unsigned r; asm volatile("v_cvt_pk_bf16_f32 %0, %1, %2" : "=v"(r) : "v"(lo), "v"(hi)); return r; }
typedef float f32x2 __attribute__((ext_vector_type(2)));
struct EpiBf16Plain {
    static constexpr bool PERM = true, AFTER_DRAIN = false;
    bf16_t* O; int ldc;
    __device__ __forceinline__ void operator()(const f32x4 (&acc)[2][2][4][2], const Unit& u, int wr, int wc, int fr, int fq) const {
        const int row0 = u.pm * BM + wr * 64 + fr, col0 = u.pn * BM + wc * 32 + 8 * fq;
#pragma unroll
        for (int ai = 0; ai < 2; ++ai)
#pragma unroll
            for (int m = 0; m < 4; ++m) { bf16_t* rowp = O + (size_t)(row0 + ai * HALF + m * 16) * ldc + col0;
#pragma unroll
                for (int bj = 0; bj < 2; ++bj) { const f32x4 v0 = acc[ai][bj][m][0], v1 = acc[ai][bj][m][1];
                    u32x4 w; w.x = cvt_pk_bf16(v0[0], v0[1]); w.y = cvt_pk_bf16(v0[2], v0[3]); w.z = cvt_pk_bf16(v1[0], v1[1]); w.w = cvt_pk_bf16(v1[2], v1[3]);
                    *(u32x4*)(rowp + bj * HALF) = w; } }
    }
};
struct EpiF32Resid {
    static constexpr bool PERM = false, AFTER_DRAIN = false;
    float* C; const float* R; int ldc;
    __device__ __forceinline__ void operator()(const f32x4 (&acc)[2][2][4][2], const Unit& u, int wr, int wc, int fr, int fq) const {
        const int row0 = u.pm * BM + wr * 64 + fr, col0 = u.pn * BM + wc * 32 + 4 * fq;
#pragma unroll
        for (int ai = 0; ai < 2; ++ai)
#pragma unroll
            for (int m = 0; m < 4; ++m) { const size_t off = (size_t)(row0 + ai * HALF + m * 16) * ldc + col0;
#pragma unroll
                for (int bj = 0; bj < 2; ++bj)
#pragma unroll
                    for (int n = 0; n < 2; ++n) { f32x4 v = acc[ai][bj][m][n]; if (R) v += *(const f32x4*)(R + off + bj * HALF + n * 16); *(f32x4*)(C + off + bj * HALF + n * 16) = v; }
                asm volatile("" ::: "memory"); }
    }
};
template <class Epi, class Sched, bool STAMP = false>
__device__ __forceinline__ void gemm_phase(PG8_LAS unsigned char* lds, const Gemm g, const Sched& S, const Epi& E, unsigned long long* stamps) {
    const int tid = threadIdx.x, wid = __builtin_amdgcn_readfirstlane(tid >> 6), lane = tid & 63, wr = wid >> 2, wc = wid & 3, fr = lane & 15, fq = lane >> 4;
    const int K = g.K, nt = K / BK;
    int ts_lo = 0, ts_hi = 0, nts = 0; const unsigned long long rt_entry = STAMP ? (unsigned long long)0ull : 0ull;
#define PG8_STAMP() do { if (STAMP && wid == 0 && nts < 64) { const unsigned long long _c = (unsigned long long)clock64(); \
        ts_lo = (lane == nts) ? (int)(unsigned)_c : ts_lo; ts_hi = (lane == nts) ? (int)(unsigned)(_c >> 32) : ts_hi; ++nts; } } while (0)
    PG8_STAMP();
    unsigned voffA[2], voffB[2];
#pragma unroll
    for (int i = 0; i < 2; ++i) { int R, C; stage_rc(tid * 16 + i * 8192, R, C); const int Rb = Epi::PERM ? ((R & ~31) + perm32(R & 31)) : R;
        voffA[i] = (unsigned)(R * K + C) * 2u; voffB[i] = (unsigned)(Rb * K + C) * 2u; }
    const size_t kstep = (size_t)(BK * 2);
    const size_t hstep = (size_t)HALF * K * 2;
    const size_t tstep = 2 * hstep;
    const unsigned ldsw = (unsigned)wid * 1024u;
    const int aoff = lds_byte(wr * 64 + fr, fq * 8), boff = lds_byte(wc * 32 + fr, fq * 8);
#define PG8_SA(b, h) (((b) * 2 + (h)) * HTB)
#define PG8_SB(b, h) ((4 + (b) * 2 + (h)) * HTB)
#define PG8_STAGE(bufoff, gbase, voff) do { _Pragma("unroll") for (int _i = 0; _i < 2; ++_i) \
        __builtin_amdgcn_global_load_lds((const unsigned*)((const char*)(gbase) + (voff)[_i]), (PG8_LAS unsigned*)(lds + (bufoff) + ldsw + _i * 8192), 16, 0, 0); } while (0)
#define PG8_LDA(dst, b, h) do { _Pragma("unroll") for (int m = 0; m < 4; ++m) _Pragma("unroll") for (int k = 0; k < 2; ++k) dst[m][k] = *(const PG8_LAS bf16x8*)(lds + PG8_SA(b, h) + aoff + m * 2048 + k * 1024); } while (0)
#define PG8_LDB(dst, b, h) do { _Pragma("unroll") for (int n = 0; n < 2; ++n) _Pragma("unroll") for (int k = 0; k < 2; ++k) dst[n][k] = *(const PG8_LAS bf16x8*)(lds + PG8_SB(b, h) + boff + n * 2048 + k * 1024); } while (0)
#define PG8_MMA(ai, bj, At, Bt) do { __builtin_amdgcn_s_setprio(1); _Pragma("unroll") for (int m = 0; m < 4; ++m) _Pragma("unroll") for (int n = 0; n < 2; ++n) _Pragma("unroll") for (int k = 0; k < 2; ++k) \
        acc[ai][bj][m][n] = __builtin_amdgcn_mfma_f32_16x16x32_bf16(Bt[n][k], At[m][k], acc[ai][bj][m][n], 0, 0, 0); __builtin_amdgcn_s_setprio(0); } while (0)
#define PG8_WAIT_V(n) asm volatile("s_waitcnt vmcnt(" #n ")" ::: "memory")
#define PG8_WAIT_L(n) asm volatile("s_waitcnt lgkmcnt(" #n ")" ::: "memory")
#define PG8_BAR __builtin_amdgcn_s_barrier()
#define PG8_SCHED __builtin_amdgcn_sched_barrier(0)
    Unit cur, nxt; int ui = 0;
    if (!S.next(0, cur)) return;
    f32x4 acc[2][2][4][2];
#pragma unroll
    for (int a = 0; a < 2; ++a)
#pragma unroll
        for (int b = 0; b < 2; ++b)
#pragma unroll
            for (int m = 0; m < 4; ++m)
#pragma unroll
                for (int n = 0; n < 2; ++n) acc[a][b][m][n] = (f32x4){0.f, 0.f, 0.f, 0.f};
    bf16x8 At[4][2], B0[2][2], B1[2][2];
    const char* cA = (const char*)g.A + (size_t)cur.pm * tstep; const char* cB = (const char*)g.Bt + (size_t)cur.pn * tstep;
    S.a_ready(cur);
    PG8_STAGE(PG8_SB(0, 0), cB, voffB); PG8_STAGE(PG8_SA(0, 0), cA, voffA); PG8_STAGE(PG8_SB(0, 1), cB + hstep, voffB); PG8_STAGE(PG8_SA(0, 1), cA + hstep, voffA);
    if (wr == 1) PG8_BAR;
    PG8_WAIT_V(4); PG8_BAR;
    PG8_STAGE(PG8_SB(1, 0), cB + kstep, voffB); PG8_STAGE(PG8_SA(1, 0), cA + kstep, voffA); PG8_STAGE(PG8_SB(1, 1), cB + hstep + kstep, voffB);
    PG8_WAIT_V(6); PG8_BAR;
    PG8_STAMP();
    for (;;) {
        const bool has_next = S.next(ui + 1, nxt);
        const char* nA = has_next ? (const char*)g.A + (size_t)nxt.pm * tstep : cA; const char* nB = has_next ? (const char*)g.Bt + (size_t)nxt.pn * tstep : cB;
        for (int t = 0; t < nt; t += 2) {
            const bool last = (t == nt - 2);
            const char* a1 = cA + (size_t)(t + 1) * kstep;
            const char* a2 = last ? nA : cA + (size_t)(t + 2) * kstep; const char* b2 = last ? nB : cB + (size_t)(t + 2) * kstep;
            const char* a3 = a2 + kstep; const char* b3 = b2 + kstep;
            if (last && has_next) S.a_ready(nxt);
            PG8_LDB(B0, 0, 0); PG8_SCHED; PG8_LDA(At, 0, 0); PG8_STAGE(PG8_SA(1, 1), a1 + hstep, voffA);
            PG8_WAIT_L(8); PG8_BAR; PG8_WAIT_L(0); PG8_MMA(0, 0, At, B0); PG8_BAR; PG8_SCHED;
            PG8_LDB(B1, 0, 1); PG8_STAGE(PG8_SB(0, 0), b2, voffB);
            PG8_BAR; PG8_WAIT_L(0); PG8_MMA(0, 1, At, B1); PG8_BAR;
            PG8_LDA(At, 0, 1); PG8_STAGE(PG8_SA(0, 0), a2, voffA);
            PG8_BAR; PG8_WAIT_L(0); PG8_MMA(1, 0, At, B0); PG8_BAR; PG8_SCHED;
            PG8_STAGE(PG8_SB(0, 1), b2 + hstep, voffB);
            PG8_WAIT_V(6); PG8_BAR; PG8_MMA(1, 1, At, B1); PG8_BAR;
            PG8_LDB(B0, 1, 0); PG8_SCHED; PG8_LDA(At, 1, 0); PG8_STAGE(PG8_SA(0, 1), a2 + hstep, voffA);
            PG8_WAIT_L(8); PG8_BAR; PG8_WAIT_L(0); PG8_MMA(0, 0, At, B0); PG8_BAR; PG8_SCHED;
            PG8_LDB(B1, 1, 1); PG8_STAGE(PG8_SB(1, 0), b3, voffB);
            PG8_BAR; PG8_WAIT_L(0); PG8_MMA(0, 1, At, B1); PG8_BAR;
            PG8_LDA(At, 1, 1); PG8_STAGE(PG8_SA(1, 0), a3, voffA);
            PG8_BAR; PG8_WAIT_L(0); PG8_MMA(1, 0, At, B0); PG8_BAR; PG8_SCHED;
            PG8_STAGE(PG8_SB(1, 1), b3 + hstep, voffB);
            PG8_WAIT_V(6); PG8_BAR; PG8_MMA(1, 1, At, B1); PG8_BAR;
        }
        PG8_STAMP();
        if constexpr (!Epi::AFTER_DRAIN) { E(acc, cur, wr, wc, fr, fq); S.done(cur); }
        PG8_STAMP();
        if (!has_next) break;
#pragma unroll
        for (int a = 0; a < 2; ++a)
#pragma unroll
            for (int b = 0; b < 2; ++b)
#pragma unroll
                for (int m = 0; m < 4; ++m)
#pragma unroll
                    for (int n = 0; n < 2; ++n) acc[a][b][m][n] = (f32x4){0.f, 0.f, 0.f, 0.f};
        cur = nxt; cA = nA; cB = nB; ++ui;
    }
    PG8_WAIT_V(0);
    if (wr == 0) PG8_BAR;
    PG8_BAR;
    if constexpr (Epi::AFTER_DRAIN) { E.fused(acc, cur, wr, wc, fr, fq, lds, wid, lane); S.done(cur); }
    PG8_STAMP();
    if (STAMP && wid == 0) { stamps[lane] = lane < nts ? (((unsigned long long)(unsigned)ts_hi << 32) | (unsigned)ts_lo) : 0ull;
        if (lane == 62) stamps[62] = rt_entry; if (lane == 63) stamps[63] = (unsigned long long)0ull; }
#undef PG8_STAMP
#undef PG8_SA
#undef PG8_SB
#undef PG8_STAGE
#undef PG8_LDA
#undef PG8_LDB
#undef PG8_MMA
#undef PG8_WAIT_V
#undef PG8_WAIT_L
#undef PG8_BAR
#undef PG8_SCHED
}
}

namespace {
constexpr int D = 1024, BATCH = 2, SEQ = 8192, T = BATCH * SEQ;
constexpr int PW = 2312;
constexpr int PS = 2304;
constexpr int OQ = 0, OKK = 512, OV = 640, OZ = 768, OXBC = 1280, ODT = 2304;
constexpr float EPS = 1e-6f;
constexpr int NTHR = 512;
typedef unsigned short bf16;
typedef unsigned v4u __attribute__((ext_vector_type(4)));

constexpr size_t MiB = 1u << 20;
constexpr size_t WS_WIN = 1 * MiB;
constexpr size_t WS_KH = 5 * MiB + 512 * 1024;
constexpr size_t WS_WO = 6 * MiB;
constexpr size_t WS_WQ = 8 * MiB;
constexpr size_t WS_PROJ = 10 * MiB;
constexpr size_t WS_XNB = 82 * MiB;
constexpr size_t WS_XACT = 114 * MiB;
constexpr size_t WS_DTRAW = 146 * MiB;
constexpr size_t WS_DT = WS_DTRAW + 512 * 1024;
constexpr size_t WS_ACS = WS_DT + 512 * 1024;
constexpr size_t WS_CDEC = WS_ACS + 512 * 1024;
constexpr size_t WS_STATES = 164 * MiB;
constexpr size_t WS_PREV = 196 * MiB;
constexpr size_t WS_QP = 10 * MiB;
constexpr size_t WS_IDX = 74 * MiB;
constexpr size_t WS_GATE = 114 * MiB;
constexpr size_t WS_TOPV = 122 * MiB;
constexpr size_t WS_TOPI = 138 * MiB;
constexpr size_t WS_UB = 164 * MiB;
constexpr size_t WS_VB = 196 * MiB;
constexpr size_t WS_ACT = 154 * MiB;
constexpr size_t WS_PEERO = 10 * MiB;
constexpr size_t WS_END = 228 * MiB;
constexpr int CW_QU = 4096, CW_QV = 4096 + 64 * 16;
constexpr int NPART = 16, NCHUNK = T / 64;

struct Args {
    const float* x; const float* norm_mix_g; const float* w_in; const float* attn_sinks; const float* attn_out_g;
    const float* conv_w; const float* conv_b; const float* dt_bias; const float* a_log; const float* d_skip;
    const float* ssm_norm_g; const float* w_out; const float* norm_ffn_g; const float* peer_wq; const float* peer_sub_keys;
    const float* peer_u; const float* peer_v; const float* final_norm_g;
    float* out; unsigned char* ws;
    int ph_lo, ph_hi;
};

#define LAS __attribute__((address_space(3)))
#define LDS_WAIT() asm volatile("s_waitcnt lgkmcnt(0)" ::: "memory")
__device__ __forceinline__ float bf2f(bf16 v) { return __uint_as_float(((unsigned)v) << 16); }
__device__ __forceinline__ unsigned f2bfu(float f) { unsigned u = __float_as_uint(f); return (u + 0x7fffu + ((u >> 16) & 1u)) >> 16; }
__device__ __forceinline__ bf16 f2bf(float f) { return (bf16)f2bfu(f); }
__device__ __forceinline__ unsigned pk2(float lo, float hi) { return f2bfu(lo) | (f2bfu(hi) << 16); }
__device__ __forceinline__ float wave_sum(float v) {
#pragma unroll
    for (int o = 1; o < 64; o <<= 1) v += __shfl_xor(v, o);
    return v;
}
__device__ __forceinline__ float silu_f(float v) { return v / (1.f + __expf(-v)); }

__device__ __forceinline__ void transpose_item(const float* W, int ldw, int K, bf16* WT, LAS float* scr, int kb, int nbk, int lane) {
    const int k0 = 64 * kb, n0 = 32 * nbk;
#pragma unroll 8
    for (int i = 0; i < 32; ++i) { const int kk = 2 * i + (lane >> 5); scr[kk * 33 + (lane & 31)] = W[(size_t)(k0 + kk) * ldw + n0 + (lane & 31)]; }
    LDS_WAIT();
    const int c = lane & 7;
#pragma unroll
    for (int j = 0; j < 4; ++j) { const int n = (lane >> 3) + 8 * j; const LAS float* s = scr + (8 * c) * 33 + n;
        v4u o; o.x = pk2(s[0 * 33], s[1 * 33]); o.y = pk2(s[2 * 33], s[3 * 33]); o.z = pk2(s[4 * 33], s[5 * 33]); o.w = pk2(s[6 * 33], s[7 * 33]);
        *(v4u*)(WT + (size_t)(n0 + n) * K + k0 + 8 * c) = o; }
    LDS_WAIT();
}

template <bool WITH_DT>
__device__ __forceinline__ void rmsnorm_rows_bf16(const float* in, const float* g, bf16* outp, const float* w_in, float* dtraw, int gwave, int nwaves, int lane) {
    for (int row = gwave; row < T; row += nwaves) {
        const float4* xr = (const float4*)(in + (size_t)row * D) + lane;
        float4 v[4]; float ss = 0.f;
#pragma unroll
        for (int j = 0; j < 4; ++j) { v[j] = xr[64 * j]; ss += v[j].x * v[j].x + v[j].y * v[j].y + v[j].z * v[j].z + v[j].w * v[j].w; }
        ss = wave_sum(ss);
        const float r = rsqrtf(ss * (1.f / D) + EPS);
        unsigned long long* o8 = (unsigned long long*)(outp + (size_t)row * D) + lane;
        float dacc[8];
#pragma unroll
        for (int h = 0; h < 8; ++h) dacc[h] = 0.f;
#pragma unroll
        for (int j = 0; j < 4; ++j) {
            const float4 gv = ((const float4*)g)[lane + 64 * j];
            const float y[4] = {v[j].x * r * gv.x, v[j].y * r * gv.y, v[j].z * r * gv.z, v[j].w * r * gv.w};
            o8[64 * j] = (unsigned long long)pk2(y[0], y[1]) | ((unsigned long long)pk2(y[2], y[3]) << 32);
            if (WITH_DT) {
#pragma unroll
                for (int e = 0; e < 4; ++e) {
                    const float4* wp = (const float4*)(w_in + (size_t)(256 * j + 4 * lane + e) * PW + ODT);
                    const float4 w0 = wp[0], w1 = wp[1];
                    dacc[0] += y[e] * w0.x; dacc[1] += y[e] * w0.y; dacc[2] += y[e] * w0.z; dacc[3] += y[e] * w0.w;
                    dacc[4] += y[e] * w1.x; dacc[5] += y[e] * w1.y; dacc[6] += y[e] * w1.z; dacc[7] += y[e] * w1.w;
                }
            }
        }
        if (WITH_DT) {
#pragma unroll
            for (int h = 0; h < 8; ++h) dacc[h] = wave_sum(dacc[h]);
            if (lane == 0) { float4* dp = (float4*)(dtraw + (size_t)row * 8); dp[0] = make_float4(dacc[0], dacc[1], dacc[2], dacc[3]); dp[1] = make_float4(dacc[4], dacc[5], dacc[6], dacc[7]); }
        }
    }
}


typedef short bf16x8 __attribute__((ext_vector_type(8)));
typedef short bf16x4 __attribute__((ext_vector_type(4)));
typedef float f32x16 __attribute__((ext_vector_type(16)));
typedef __bf16 bf2_t __attribute__((ext_vector_type(2)));
#define MFMA32(a, b, c) __builtin_amdgcn_mfma_f32_32x32x16_bf16((a), (b), (c), 0, 0, 0)
__device__ __forceinline__ unsigned pkbf(float lo, float hi) { bf2_t v = {(__bf16)lo, (__bf16)hi}; return __builtin_bit_cast(unsigned, v); }
__device__ __forceinline__ short bfs(float f) { return __builtin_bit_cast(short, (__bf16)f); }
__device__ __forceinline__ float sbf2f(short v) { return __uint_as_float(((unsigned)(unsigned short)v) << 16); }
__device__ __forceinline__ int crow(int i, int hi) { return (i & 3) + 8 * (i >> 2) + 4 * hi; }
template <int S> __device__ __forceinline__ bf16x8 pack8(const f32x16& x) {
    v4u p; p.x = pkbf(x[8 * S], x[8 * S + 1]); p.y = pkbf(x[8 * S + 2], x[8 * S + 3]); p.z = pkbf(x[8 * S + 4], x[8 * S + 5]); p.w = pkbf(x[8 * S + 6], x[8 * S + 7]);
    return __builtin_bit_cast(bf16x8, p);
}
__device__ __forceinline__ bf16x8 ldg8(const bf16* p) { return *(const bf16x8*)p; }
__device__ __forceinline__ bf16x8 lds8(const LAS bf16* p) { return *(const LAS bf16x8*)p; }
__device__ __forceinline__ bf16x8 lds4x2(const LAS bf16* p) { const bf16x4 a = *(const LAS bf16x4*)p, b = *(const LAS bf16x4*)(p + 8); return __builtin_shufflevector(a, b, 0, 1, 2, 3, 4, 5, 6, 7); }
__device__ __forceinline__ f32x16 zero16() { f32x16 z;
#pragma unroll
    for (int i = 0; i < 16; ++i) z[i] = 0.f;
    return z; }

__device__ __forceinline__ void attn_unit(const float* sinks, LAS unsigned char* ldsb, int unit, const bf16* PROJ, float* MIXF, int tid, int lane, int wave) {
    const int hkv = unit & 1, blk = unit >> 1, nbk = blk & 63;
    const int tokblk = blk * 128, wbase = tokblk - 128;
    LAS bf16* VT = (LAS bf16*)ldsb;
#pragma unroll
    for (int i = 0; i < 4; ++i) {
        const int c = tid + 512 * i, key = c >> 3, d0 = (c & 7) * 8; const bool valid = (nbk > 0) || (key >= 128);
        bf16x8 v;
#pragma unroll
        for (int e = 0; e < 8; ++e) v[e] = 0;
        if (valid) v = ldg8(PROJ + (size_t)(wbase + key) * PS + OV + hkv * 64 + d0);
#pragma unroll
        for (int e = 0; e < 8; ++e) VT[(d0 + e) * 264 + key] = (bf16)v[e];
    }
    __syncthreads();
    const int r = lane & 31, hi = lane >> 5;
    const int hq = hkv * 4 + (wave & 3);
    const float slope = exp2f(-(float)(hq + 1)), sink = sinks[hq];
#pragma unroll 1
    for (int qq = 0; qq < 2; ++qq) {
        const int qt = (wave >> 2) + 2 * qq;
        const int tq = tokblk + 32 * qt + r;
        bf16x8 qf[4];
#pragma unroll
        for (int ks = 0; ks < 4; ++ks) qf[ks] = ldg8(PROJ + (size_t)tq * PS + OQ + hq * 64 + 16 * ks + 8 * hi);
        f32x16 X[5];
#pragma unroll
        for (int kt = 0; kt < 5; ++kt) {
            const int key = 32 * (qt + kt) + r; const bool valid = (nbk > 0) || (key >= 128);
            const int row = valid ? (wbase + key) : tokblk;
            X[kt] = zero16();
#pragma unroll
            for (int ks = 0; ks < 4; ++ks) { const bf16x8 kf = ldg8(PROJ + (size_t)row * PS + OKK + hkv * 64 + 16 * ks + 8 * hi); X[kt] = MFMA32(kf, qf[ks], X[kt]); }
        }
        const int qi = 32 * qt + r;
        float m = -1e30f;
#pragma unroll
        for (int kt = 0; kt < 5; ++kt)
#pragma unroll
            for (int i = 0; i < 16; ++i) {
                const int ki = 32 * (qt + kt) + crow(i, hi), dist = 128 + qi - ki;
                const bool valid = (dist >= 0) && (dist < 128) && ((nbk > 0) || (ki >= 128));
                const float lg = valid ? (X[kt][i] * 0.125f - slope * (float)dist) : -1e30f;
                X[kt][i] = lg; m = fmaxf(m, lg);
            }
        m = fmaxf(m, __shfl_xor(m, 32)); m = fmaxf(m, sink);
        float lsum = 0.f;
#pragma unroll
        for (int kt = 0; kt < 5; ++kt)
#pragma unroll
            for (int i = 0; i < 16; ++i) { const float p = __expf(X[kt][i] - m); X[kt][i] = p; lsum += p; }
        lsum += __shfl_xor(lsum, 32); lsum += __expf(sink - m);
        f32x16 O0 = zero16(), O1 = zero16();
#pragma unroll
        for (int kt = 0; kt < 5; ++kt) {
            const int kb = 32 * (qt + kt) + 4 * hi;
            { const bf16x8 xs = pack8<0>(X[kt]); const bf16x8 a0 = lds4x2(VT + r * 264 + kb), a1 = lds4x2(VT + (32 + r) * 264 + kb); O0 = MFMA32(a0, xs, O0); O1 = MFMA32(a1, xs, O1); }
            { const bf16x8 xs = pack8<1>(X[kt]); const bf16x8 a0 = lds4x2(VT + r * 264 + kb + 16), a1 = lds4x2(VT + (32 + r) * 264 + kb + 16); O0 = MFMA32(a0, xs, O0); O1 = MFMA32(a1, xs, O1); }
        }
        const float inv = 1.f / lsum;
        float* orow = MIXF + (size_t)tq * D + hq * 64 + 4 * hi;
#pragma unroll
        for (int q4 = 0; q4 < 4; ++q4) {
            *(float4*)(orow + 8 * q4) = make_float4(O0[4 * q4] * inv, O0[4 * q4 + 1] * inv, O0[4 * q4 + 2] * inv, O0[4 * q4 + 3] * inv);
            *(float4*)(orow + 32 + 8 * q4) = make_float4(O1[4 * q4] * inv, O1[4 * q4 + 1] * inv, O1[4 * q4 + 2] * inv, O1[4 * q4 + 3] * inv);
        }
    }
    __syncthreads();
}

__device__ __forceinline__ void ssd_chunk_unit(LAS unsigned char* ldsb, int unit, const bf16* XACT, const float* DT, const float* ACS, float* MIXF, float* STATES, int tid, int lane, int wave) {
    const int g = unit & 1, bc = unit >> 1, tok0 = bc * 128;
    LAS bf16* BT = (LAS bf16*)ldsb;
    LAS bf16* XD = (LAS bf16*)(ldsb + 34816);
    LAS bf16* XW = (LAS bf16*)(ldsb + 34816 + 34816);
    LAS float* ACST = (LAS float*)(ldsb + 34816 * 3);
    const int r = lane & 31, hi = lane >> 5;
#pragma unroll
    for (int i = 0; i < 4; ++i) {
        const int c = tid + 512 * i, s = c >> 4, n0 = (c & 15) * 8;
        const bf16x8 v = ldg8(XACT + (size_t)(tok0 + s) * 1024 + 512 + g * 128 + n0);
#pragma unroll
        for (int e = 0; e < 8; ++e) BT[(n0 + e) * 136 + s] = (bf16)v[e];
    }
    ACST[tid] = ACS[(size_t)(tok0 + (tid >> 2)) * 8 + g * 4 + (tid & 3)];
#pragma unroll 1
    for (int hp = 0; hp < 2; ++hp) {
        if (hp) __syncthreads();
#pragma unroll
        for (int i = 0; i < 4; ++i) {
            const int c = tid + 512 * i, hsel = c >> 10, s = (c >> 3) & 127, p0 = (c & 7) * 8, H = g * 4 + 2 * hp + hsel;
            const bf16x8 v = ldg8(XACT + (size_t)(tok0 + s) * 1024 + H * 64 + p0);
            const float dtv = DT[(size_t)(tok0 + s) * 8 + H];
            const float w = __expf(ACS[(size_t)(tok0 + 127) * 8 + H] - ACS[(size_t)(tok0 + s) * 8 + H]);
#pragma unroll
            for (int e = 0; e < 8; ++e) { const float xd = sbf2f(v[e]) * dtv; XD[hsel * 8704 + (p0 + e) * 136 + s] = (bf16)bfs(xd); XW[hsel * 8704 + (p0 + e) * 136 + s] = (bf16)bfs(xd * w); }
        }
        __syncthreads();
        {
            const int lt = wave & 3, hsel = wave >> 2, hh = 2 * hp + hsel, H = g * 4 + hh;
            const int l = 32 * lt + r; const float acs_l = ACST[l * 4 + hh];
            bf16x8 cf[8];
#pragma unroll
            for (int ks = 0; ks < 8; ++ks) cf[ks] = ldg8(XACT + (size_t)(tok0 + l) * 1024 + 768 + g * 128 + 16 * ks + 8 * hi);
            f32x16 Z0 = zero16(), Z1 = zero16();
#pragma unroll 1
            for (int st = 0; st <= lt; ++st) {
                f32x16 X = zero16();
#pragma unroll
                for (int ks = 0; ks < 8; ++ks) { const bf16x8 bfr = ldg8(XACT + (size_t)(tok0 + 32 * st + r) * 1024 + 512 + g * 128 + 16 * ks + 8 * hi); X = MFMA32(bfr, cf[ks], X); }
#pragma unroll
                for (int i = 0; i < 16; ++i) { const int s = 32 * st + crow(i, hi); const float f = (s <= l) ? __expf(acs_l - ACST[s * 4 + hh]) : 0.f; X[i] *= f; }
                const int sb = 32 * st + 4 * hi;
                { const bf16x8 xs = pack8<0>(X); const bf16x8 b0 = lds4x2(XD + hsel * 8704 + r * 136 + sb), b1 = lds4x2(XD + hsel * 8704 + (32 + r) * 136 + sb); Z0 = MFMA32(xs, b0, Z0); Z1 = MFMA32(xs, b1, Z1); }
                { const bf16x8 xs = pack8<1>(X); const bf16x8 b0 = lds4x2(XD + hsel * 8704 + r * 136 + sb + 16), b1 = lds4x2(XD + hsel * 8704 + (32 + r) * 136 + sb + 16); Z0 = MFMA32(xs, b0, Z0); Z1 = MFMA32(xs, b1, Z1); }
            }
#pragma unroll
            for (int i = 0; i < 16; ++i) { float* o = MIXF + (size_t)(tok0 + 32 * lt + crow(i, hi)) * D + 512 + H * 64 + r; o[0] = Z0[i]; o[32] = Z1[i]; }
        }
        {
            const int nt = wave & 3, hsel = wave >> 2, H = g * 4 + 2 * hp + hsel;
            f32x16 S0 = zero16(), S1 = zero16();
#pragma unroll
            for (int ks = 0; ks < 8; ++ks) {
                const bf16x8 btf = lds8(BT + (32 * nt + r) * 136 + 16 * ks + 8 * hi);
                const bf16x8 a0 = lds8(XW + hsel * 8704 + r * 136 + 16 * ks + 8 * hi), a1 = lds8(XW + hsel * 8704 + (32 + r) * 136 + 16 * ks + 8 * hi);
                S0 = MFMA32(a0, btf, S0); S1 = MFMA32(a1, btf, S1);
            }
            float* sp = STATES + (size_t)(bc * 8 + H) * 8192 + 32 * nt + r;
#pragma unroll
            for (int i = 0; i < 16; ++i) { const int p = crow(i, hi); sp[p * 128] = S0[i]; sp[(32 + p) * 128] = S1[i]; }
        }
    }
    __syncthreads();
}

__device__ __forceinline__ void yoff_unit(const float* d_skip, int unit, const bf16* XACT, const bf16* PROJ, const float* ACS, const bf16* PREVT, float* MIXF, int lane, int wave) {
    const int g = unit & 1, bc = unit >> 1, tok0 = bc * 128;
    const int r = lane & 31, hi = lane >> 5, lt = wave & 3, hpair = wave >> 2;
    bf16x8 cf[8];
#pragma unroll
    for (int ks = 0; ks < 8; ++ks) cf[ks] = ldg8(XACT + (size_t)(tok0 + 32 * lt + r) * 1024 + 768 + g * 128 + 16 * ks + 8 * hi);
#pragma unroll 1
    for (int hsel = 0; hsel < 2; ++hsel) {
        const int H = g * 4 + 2 * hpair + hsel; const bf16* pv = PREVT + (size_t)(bc * 8 + H) * 8192;
        f32x16 Y0 = zero16(), Y1 = zero16();
#pragma unroll
        for (int ks = 0; ks < 8; ++ks) {
            const bf16x8 b0 = ldg8(pv + r * 128 + 16 * ks + 8 * hi), b1 = ldg8(pv + (32 + r) * 128 + 16 * ks + 8 * hi);
            Y0 = MFMA32(cf[ks], b0, Y0); Y1 = MFMA32(cf[ks], b1, Y1);
        }
        const float dsk = d_skip[H];
#pragma unroll
        for (int i = 0; i < 16; ++i) {
            const int t = tok0 + 32 * lt + crow(i, hi); const float ea = __expf(ACS[(size_t)t * 8 + H]);
#pragma unroll
            for (int pt = 0; pt < 2; ++pt) {
                const int col = H * 64 + 32 * pt + r;
                float* yp = MIXF + (size_t)t * D + 512 + col;
                float y = yp[0] + ea * (pt ? Y1[i] : Y0[i]) + dsk * bf2f(XACT[(size_t)t * 1024 + col]);
                const float z = bf2f(PROJ[(size_t)t * PS + OZ + col]);
                yp[0] = y * silu_f(z);
            }
        }
    }
}


__device__ __forceinline__ void peer_u_item(int p, int j, const int* IDX, const float* GATE, const bf16* XN2B, const bf16* UB, float* ACT, int lane, int wave) {
    const int myk = 4 * (lane >> 5) + 2 * ((lane >> 4) & 1) + ((lane >> 3) & 1);
#pragma unroll 1
    for (int it = 0; it < 8; ++it) {
        const int t = j * 64 + it * 8 + wave;
        const int e0 = IDX[(size_t)t * 128 + lane], e1 = IDX[(size_t)t * 128 + 64 + lane];
        unsigned long long m0 = __ballot((e0 >> 10) == p), m1 = __ballot((e1 >> 10) == p);
        if ((m0 | m1) == 0ull) continue;
        float xv[16];
        { const bf16* xr = XN2B + (size_t)t * D + lane * 8; const uint4 w0 = *(const uint4*)xr, w1 = *(const uint4*)(xr + 512);
          const unsigned ww[8] = {w0.x, w0.y, w0.z, w0.w, w1.x, w1.y, w1.z, w1.w};
#pragma unroll
          for (int q = 0; q < 8; ++q) { xv[2 * q] = __uint_as_float(ww[q] << 16); xv[2 * q + 1] = __uint_as_float(ww[q] & 0xffff0000u); } }
        while ((m0 | m1) != 0ull) {
            int kk[8], ek[8];
#pragma unroll
            for (int q = 0; q < 8; ++q) {
                if (m0 != 0ull) { const int k = __builtin_amdgcn_readfirstlane(__builtin_ctzll(m0)); m0 &= m0 - 1ull; kk[q] = k; ek[q] = __builtin_amdgcn_readlane(e0, k); }
                else if (m1 != 0ull) { const int k = __builtin_amdgcn_readfirstlane(__builtin_ctzll(m1)); m1 &= m1 - 1ull; kk[q] = 64 + k; ek[q] = __builtin_amdgcn_readlane(e1, k); }
                else { kk[q] = -1; ek[q] = p * 1024; }
            }
            uint4 ua[8][2];
#pragma unroll
            for (int q = 0; q < 8; ++q) { const bf16* up = UB + (size_t)ek[q] * D + lane * 8; ua[q][0] = *(const uint4*)up; ua[q][1] = *(const uint4*)(up + 512); }
            float dk[8];
#pragma unroll
            for (int q = 0; q < 8; ++q) {
                float d = 0.f;
#pragma unroll
                for (int hf = 0; hf < 2; ++hf) { const unsigned ww[4] = {ua[q][hf].x, ua[q][hf].y, ua[q][hf].z, ua[q][hf].w};
#pragma unroll
                    for (int jj = 0; jj < 4; ++jj) { d += xv[hf * 8 + jj * 2] * __uint_as_float(ww[jj] << 16); d += xv[hf * 8 + jj * 2 + 1] * __uint_as_float(ww[jj] & 0xffff0000u); } }
                dk[q] = d;
            }
            float w4[4], y2[2], z;
            { const bool hi = (lane & 32) != 0;
#pragma unroll
              for (int i = 0; i < 4; ++i) { const float send = hi ? dk[i] : dk[i + 4]; const float recv = __shfl_xor(send, 32); w4[i] = (hi ? dk[i + 4] : dk[i]) + recv; } }
            { const bool hi = (lane & 16) != 0;
#pragma unroll
              for (int i = 0; i < 2; ++i) { const float send = hi ? w4[i] : w4[i + 2]; const float recv = __shfl_xor(send, 16); y2[i] = (hi ? w4[i + 2] : w4[i]) + recv; } }
            { const bool hi = (lane & 8) != 0; const float send = hi ? y2[0] : y2[1]; const float recv = __shfl_xor(send, 8); z = (hi ? y2[1] : y2[0]) + recv; }
            z += __shfl_xor(z, 4); z += __shfl_xor(z, 2); z += __shfl_xor(z, 1);
            int kq = kk[0];
#pragma unroll
            for (int q = 1; q < 8; ++q) kq = (myk == q) ? kk[q] : kq;
            if (kq >= 0 && (lane & 7) == 0) ACT[(size_t)t * 128 + kq] = GATE[(size_t)t * 128 + kq] * 0.5f * z * (1.f + erff(z * 0.70710678118654752f));
        }
    }
}
__device__ __forceinline__ void peer_v_item(int p, int j, const int* IDX, const float* ACT, const bf16* VB, float* PEERO, int lane, int wave) {
    const int gidx = lane >> 3, c8 = (lane & 7) * 8;
#pragma unroll 1
    for (int it = 0; it < 8; ++it) {
        const int t = j * 64 + it * 8 + wave;
        int e[16]; float ac[16];
#pragma unroll
        for (int q = 0; q < 4; ++q) {
            const int4 ev = *(const int4*)(IDX + (size_t)t * 128 + 16 * gidx + 4 * q); const float4 av = *(const float4*)(ACT + (size_t)t * 128 + 16 * gidx + 4 * q);
            e[4 * q] = ev.x; e[4 * q + 1] = ev.y; e[4 * q + 2] = ev.z; e[4 * q + 3] = ev.w; ac[4 * q] = av.x; ac[4 * q + 1] = av.y; ac[4 * q + 2] = av.z; ac[4 * q + 3] = av.w;
        }
        uint4 vv[16];
#pragma unroll
        for (int i = 0; i < 16; ++i) vv[i] = *(const uint4*)(VB + (size_t)e[i] * D + p * 64 + c8);
        float acc[8];
#pragma unroll
        for (int c = 0; c < 8; ++c) acc[c] = 0.f;
#pragma unroll
        for (int i = 0; i < 16; ++i) { const unsigned ww[4] = {vv[i].x, vv[i].y, vv[i].z, vv[i].w};
#pragma unroll
            for (int jj = 0; jj < 4; ++jj) { acc[2 * jj] += ac[i] * __uint_as_float(ww[jj] << 16); acc[2 * jj + 1] += ac[i] * __uint_as_float(ww[jj] & 0xffff0000u); } }
        float w4[4], y2[2], z;
        { const bool hi = (lane & 32) != 0;
#pragma unroll
          for (int i = 0; i < 4; ++i) { const float send = hi ? acc[i] : acc[i + 4]; const float recv = __shfl_xor(send, 32); w4[i] = (hi ? acc[i + 4] : acc[i]) + recv; } }
        { const bool hi = (lane & 16) != 0;
#pragma unroll
          for (int i = 0; i < 2; ++i) { const float send = hi ? w4[i] : w4[i + 2]; const float recv = __shfl_xor(send, 16); y2[i] = (hi ? w4[i + 2] : w4[i]) + recv; } }
        { const bool hi = (lane & 8) != 0; const float send = hi ? y2[0] : y2[1]; const float recv = __shfl_xor(send, 8); z = (hi ? y2[1] : y2[0]) + recv; }
        const int col = c8 + 4 * (lane >> 5) + 2 * ((lane >> 4) & 1) + ((lane >> 3) & 1);
        PEERO[(size_t)t * D + p * 64 + col] = z;
    }
}


__device__ __forceinline__ void ce_desc(float& a, float& b) { const float hi = fmaxf(a, b), lo = fminf(a, b); a = hi; b = lo; }
__device__ __forceinline__ void sort16_desc(float (&v)[16]) {
#pragma unroll
    for (int k = 2; k <= 16; k <<= 1)
#pragma unroll
        for (int j = k >> 1; j > 0; j >>= 1)
#pragma unroll
            for (int i = 0; i < 16; ++i) { const int l = i ^ j; if (l > i) { if ((i & k) == 0) ce_desc(v[i], v[l]); else ce_desc(v[l], v[i]); } }
}
__device__ __forceinline__ void merge16_desc(float (&a)[16], const float (&b)[16]) {
#pragma unroll
    for (int i = 0; i < 16; ++i) a[i] = fmaxf(a[i], b[15 - i]);
#pragma unroll
    for (int j = 8; j > 0; j >>= 1)
#pragma unroll
        for (int i = 0; i < 16; ++i) { const int l = i ^ j; if (l > i) ce_desc(a[i], a[l]); }
}
__device__ __forceinline__ void ce_kv(float& ka, int& va, float& kb, int& vb) {
    const bool s = kb > ka; const float t0 = s ? kb : ka, t1 = s ? ka : kb; const int u0 = s ? vb : va, u1 = s ? va : vb; ka = t0; kb = t1; va = u0; vb = u1; }
__device__ __forceinline__ void sort16_kv(float (&k)[16], int (&v)[16]) {
#pragma unroll
    for (int kk = 2; kk <= 16; kk <<= 1)
#pragma unroll
        for (int j = kk >> 1; j > 0; j >>= 1)
#pragma unroll
            for (int i = 0; i < 16; ++i) { const int l = i ^ j; if (l > i) { if ((i & kk) == 0) ce_kv(k[i], v[i], k[l], v[l]); else ce_kv(k[l], v[l], k[i], v[i]); } }
}
__device__ __forceinline__ void merge16_kv(float (&ka)[16], int (&va)[16], const float (&kb)[16], const int (&vb)[16]) {
#pragma unroll
    for (int i = 0; i < 16; ++i) { const bool s = kb[15 - i] > ka[i]; ka[i] = s ? kb[15 - i] : ka[i]; va[i] = s ? vb[15 - i] : va[i]; }
#pragma unroll
    for (int j = 8; j > 0; j >>= 1)
#pragma unroll
        for (int i = 0; i < 16; ++i) { const int l = i ^ j; if (l > i) ce_kv(ka[i], va[i], ka[l], va[l]); }
}
__device__ __forceinline__ void split8(const float* p, bf16x8& hi8, bf16x8& lo8) {
    const float4 f0 = *(const float4*)p, f1 = *(const float4*)(p + 4);
    const float x[8] = {f0.x, f0.y, f0.z, f0.w, f1.x, f1.y, f1.z, f1.w};
#pragma unroll
    for (int j = 0; j < 8; ++j) { const short h = bfs(x[j]); hi8[j] = h; lo8[j] = bfs(x[j] - sbf2f(h)); }
}
__device__ __forceinline__ void route_task(int task, const float* QP, const bf16* KH, const bf16* KL, int* IDX, float* GATE, int lane) {
    const int r = lane & 31, hi = lane >> 5, t = 4 * task + (r >> 3), head = r & 7;
    float top[2][16];
#pragma unroll
    for (int half = 0; half < 2; ++half) {
        bf16x8 qh[4], ql[4];
#pragma unroll
        for (int ks = 0; ks < 4; ++ks) split8(QP + (size_t)t * D + head * 128 + half * 64 + 16 * ks + 8 * hi, qh[ks], ql[ks]);
        float cur[16];
#pragma unroll
        for (int kt = 0; kt < 4; ++kt) {
            f32x16 X = zero16();
            const bf16* khp = KH + (size_t)(half * 128 + 32 * kt + r) * 64 + 8 * hi; const bf16* klp = KL + (size_t)(half * 128 + 32 * kt + r) * 64 + 8 * hi;
            asm volatile("" : "+v"(khp), "+v"(klp));
#pragma unroll
            for (int ks = 0; ks < 4; ++ks) {
                const bf16x8 kh = ldg8(khp + 16 * ks), kl = ldg8(klp + 16 * ks);
                X = MFMA32(kh, qh[ks], X); X = MFMA32(kh, ql[ks], X); X = MFMA32(kl, qh[ks], X);
            }
            float grp[16];
#pragma unroll
            for (int i = 0; i < 16; ++i) { const unsigned key = (unsigned)(32 * kt + crow(i, hi)); grp[i] = __uint_as_float((__float_as_uint(X[i]) & ~127u) | (127u - key)); }
            sort16_desc(grp);
            if (kt == 0) {
#pragma unroll
                for (int i = 0; i < 16; ++i) cur[i] = grp[i];
            } else merge16_desc(cur, grp);
        }
        float oth[16];
#pragma unroll
        for (int i = 0; i < 16; ++i) oth[i] = __shfl_xor(cur[i], 32);
        merge16_desc(cur, oth);
#pragma unroll
        for (int i = 0; i < 16; ++i) top[half][i] = cur[i];
    }
    unsigned P1[4], P2[4];
#pragma unroll
    for (int q = 0; q < 4; ++q) { P1[q] = 0u; P2[q] = 0u;
#pragma unroll
        for (int s = 0; s < 4; ++s) { P1[q] |= (127u - (__float_as_uint(top[0][4 * q + s]) & 127u)) << (8 * s); P2[q] |= (127u - (__float_as_uint(top[1][4 * q + s]) & 127u)) << (8 * s); } }
#define CAND(a, b) __uint_as_float((__float_as_uint(top[0][a] + top[1][b]) & ~255u) | (255u - (unsigned)((a) * 16 + (b))))
    float bk[16];
    {
        float gk[16];
        gk[0] = CAND(0, 0);
        gk[1] = CAND(0, 1);
        gk[2] = CAND(0, 2);
        gk[3] = CAND(0, 3);
        gk[4] = CAND(0, 4);
        gk[5] = CAND(0, 5);
        gk[6] = CAND(0, 6);
        gk[7] = CAND(0, 7);
        gk[8] = CAND(0, 8);
        gk[9] = CAND(0, 9);
        gk[10] = CAND(0, 10);
        gk[11] = CAND(0, 11);
        gk[12] = CAND(0, 12);
        gk[13] = CAND(0, 13);
        gk[14] = CAND(0, 14);
        gk[15] = CAND(0, 15);
        sort16_desc(gk);
#pragma unroll
        for (int i = 0; i < 16; ++i) bk[i] = gk[i];
    }
    {
        float gk[16];
        gk[0] = CAND(1, 0);
        gk[1] = CAND(1, 1);
        gk[2] = CAND(1, 2);
        gk[3] = CAND(1, 3);
        gk[4] = CAND(1, 4);
        gk[5] = CAND(1, 5);
        gk[6] = CAND(1, 6);
        gk[7] = CAND(1, 7);
        gk[8] = CAND(2, 0);
        gk[9] = CAND(2, 1);
        gk[10] = CAND(2, 2);
        gk[11] = CAND(2, 3);
        gk[12] = CAND(2, 4);
        gk[13] = CAND(3, 0);
        gk[14] = CAND(3, 1);
        gk[15] = CAND(3, 2);
        sort16_desc(gk);
        merge16_desc(bk, gk);
    }
    {
        float gk[16];
        gk[0] = CAND(3, 3);
        gk[1] = CAND(4, 0);
        gk[2] = CAND(4, 1);
        gk[3] = CAND(4, 2);
        gk[4] = CAND(5, 0);
        gk[5] = CAND(5, 1);
        gk[6] = CAND(6, 0);
        gk[7] = CAND(6, 1);
        gk[8] = CAND(7, 0);
        gk[9] = CAND(7, 1);
        gk[10] = CAND(8, 0);
        gk[11] = CAND(9, 0);
        gk[12] = CAND(10, 0);
        gk[13] = CAND(11, 0);
        gk[14] = CAND(12, 0);
        gk[15] = CAND(13, 0);
        sort16_desc(gk);
        merge16_desc(bk, gk);
    }
    {
        float gk[16];
        gk[0] = CAND(14, 0);
        gk[1] = CAND(15, 0);
        gk[2] = -INFINITY;
        gk[3] = -INFINITY;
        gk[4] = -INFINITY;
        gk[5] = -INFINITY;
        gk[6] = -INFINITY;
        gk[7] = -INFINITY;
        gk[8] = -INFINITY;
        gk[9] = -INFINITY;
        gk[10] = -INFINITY;
        gk[11] = -INFINITY;
        gk[12] = -INFINITY;
        gk[13] = -INFINITY;
        gk[14] = -INFINITY;
        gk[15] = -INFINITY;
        sort16_desc(gk);
        merge16_desc(bk, gk);
    }
#undef CAND
    int bv[16];
#pragma unroll
    for (int i = 0; i < 16; ++i) {
        const unsigned cd = 255u - (__float_as_uint(bk[i]) & 255u), ca = cd >> 4, cb = cd & 15u;
        const unsigned wa = (ca >> 2) == 0u ? P1[0] : (ca >> 2) == 1u ? P1[1] : (ca >> 2) == 2u ? P1[2] : P1[3];
        const unsigned wb = (cb >> 2) == 0u ? P2[0] : (cb >> 2) == 1u ? P2[1] : (cb >> 2) == 2u ? P2[2] : P2[3];
        bv[i] = (int)((((wa >> (8u * (ca & 3u))) & 255u) << 7) | ((wb >> (8u * (cb & 3u))) & 255u));
    }
    float e[16], se = 0.f;
#pragma unroll
    for (int i = 0; i < 16; ++i) { e[i] = __expf(bk[i] - bk[0]); se += e[i]; }
    const float inv = 1.f / se;
    if (hi == 0) {
        int4* ip = (int4*)(IDX + (size_t)t * 128 + head * 16); float4* gp = (float4*)(GATE + (size_t)t * 128 + head * 16);
#pragma unroll
        for (int q = 0; q < 4; ++q) { ip[q] = make_int4(bv[4 * q], bv[4 * q + 1], bv[4 * q + 2], bv[4 * q + 3]); gp[q] = make_float4(e[4 * q] * inv, e[4 * q + 1] * inv, e[4 * q + 2] * inv, e[4 * q + 3] * inv); }
    }
}

#define XB_TMO      128
#define XB_XCNT(j)  (256  + 64 * (j))
#define XB_XSUB(j)  (1280 + 64 * (j))
#define XB_XGEN(j)  (2304 + 64 * (j))
#define XB_TOP      3328
#define XB_TOPGEN   3392
#define XCD_BAR_WORDS 3456
#define XB_SPIN_CAP (1u << 22)
__device__ __forceinline__ unsigned xb_ld(unsigned* p)              { return __hip_atomic_load(p, __ATOMIC_RELAXED, __HIP_MEMORY_SCOPE_AGENT); }
__device__ __forceinline__ unsigned xb_add(unsigned* p, unsigned v) { return __hip_atomic_fetch_add(p, v, __ATOMIC_RELAXED, __HIP_MEMORY_SCOPE_AGENT); }
__device__ __forceinline__ unsigned xb_xcc_id() { return (unsigned)__builtin_amdgcn_s_getreg((3 << 11) | 20) & 0xFu; }
#define XB_SPIN(cond, bar) do { unsigned _sp = 0; while (cond) { __builtin_amdgcn_s_sleep(1); \
    if ((++_sp & 255u) == 0u) { if (xb_ld(&(bar)[XB_TMO])) break; if (_sp > XB_SPIN_CAP) { atomicAdd(&(bar)[XB_TMO], 1u); break; } } } } while (0)
struct XcdBarrier { unsigned* bar; unsigned x; volatile LAS unsigned* st; };
__device__ __forceinline__ XcdBarrier xcd_barrier_post(unsigned* bar, volatile LAS unsigned* st) {
    XcdBarrier b; b.bar = bar; b.x = xb_xcc_id(); b.st = st;
    if (threadIdx.x == 0) (void)xb_add(&bar[XB_XCNT(b.x)], 1u);
    return b;
}
__device__ __forceinline__ void xcd_barrier_complete(unsigned* bar, unsigned x, unsigned& nloc, unsigned& nx) {
    const unsigned G = gridDim.x * gridDim.y * gridDim.z;
    unsigned sum, cnt, mine, sp = 0u;
    for (;;) {
        sum = 0u; cnt = 0u; mine = 0u;
#pragma unroll
        for (unsigned j = 0; j < 16; ++j) { const unsigned c = xb_ld(&bar[XB_XCNT(j)]); sum += c; cnt += (c > 0u) ? 1u : 0u; mine = (j == x) ? c : mine; }
        if (sum == G) break;
        __builtin_amdgcn_s_sleep(1);
        if ((++sp & 255u) == 0u) { if (xb_ld(&bar[XB_TMO])) break; if (sp > XB_SPIN_CAP) { atomicAdd(&bar[XB_TMO], 1u); break; } }
    }
    nloc = mine > 0u ? mine : 1u; nx = cnt > 0u ? cnt : 1u;
}
__device__ __forceinline__ void xcd_barrier(const XcdBarrier& b) {
    asm volatile("s_waitcnt vmcnt(0)" ::: "memory");
    __syncthreads();
    if (threadIdx.x == 0) {
        unsigned* bar = b.bar;
        __builtin_amdgcn_s_waitcnt(0);
        unsigned nloc = b.st[0], nx = b.st[1];
        if (nloc == 0u) { xcd_barrier_complete(bar, b.x, nloc, nx); b.st[0] = nloc; b.st[1] = nx; }
        const unsigned old = xb_add(&bar[XB_XSUB(b.x)], 1u);
        const unsigned gen = old / nloc;
        if (old + 1u == (gen + 1u) * nloc) {
            __builtin_amdgcn_fence(__ATOMIC_RELEASE, "agent");
            asm volatile("s_waitcnt vmcnt(0)" ::: "memory");
            const unsigned og = xb_add(&bar[XB_TOP], 1u);
            const unsigned tg = og / nx;
            if (og + 1u == (tg + 1u) * nx) xb_add(&bar[XB_TOPGEN], 1u);
            else XB_SPIN(xb_ld(&bar[XB_TOPGEN]) == tg, bar);
            __builtin_amdgcn_fence(__ATOMIC_ACQUIRE, "agent");
            xb_add(&bar[XB_XGEN(b.x)], 1u);
            asm volatile("s_waitcnt vmcnt(0)" ::: "memory");
        } else {
            XB_SPIN(xb_ld(&bar[XB_XGEN(b.x)]) == gen, bar);
            __builtin_amdgcn_fence(__ATOMIC_ACQUIRE, "agent");
            asm volatile("s_waitcnt vmcnt(0)" ::: "memory");
        }
    }
    __syncthreads();
}
constexpr int LDS_BYTES = 147456;
constexpr int MISC_OFF = 131072 + 320;

__global__ void __launch_bounds__(NTHR, 2) k_main(Args a) {
    extern __shared__ __attribute__((aligned(16))) unsigned char lds_raw[];
    LAS unsigned char* ldsb = (LAS unsigned char*)lds_raw;
    const int tid = threadIdx.x, lane = tid & 63, bid = blockIdx.x, nb = gridDim.x;
    const int wave = __builtin_amdgcn_readfirstlane(tid >> 6);
    const int gtid = bid * NTHR + tid, gthreads = nb * NTHR, gwave = gtid >> 6, nwaves = gthreads >> 6;
    unsigned char* ws = a.ws;
    bf16* WINT = (bf16*)(ws + WS_WIN); bf16* WOT = (bf16*)(ws + WS_WO); bf16* WQT = (bf16*)(ws + WS_WQ);
    bf16* PROJ = (bf16*)(ws + WS_PROJ);
    bf16* XNB = (bf16*)(ws + WS_XNB);
    bf16* XACT = (bf16*)(ws + WS_XACT);
    float* DTRAW = (float*)(ws + WS_DTRAW); float* DT = (float*)(ws + WS_DT); float* ACS = (float*)(ws + WS_ACS); float* CDEC = (float*)(ws + WS_CDEC);
    float* STATES = (float*)(ws + WS_STATES); bf16* PREVT = (bf16*)(ws + WS_PREV);
    float* QP = (float*)(ws + WS_QP); int* IDX = (int*)(ws + WS_IDX); float* GATE = (float*)(ws + WS_GATE);
    float* TOPV = (float*)(ws + WS_TOPV); int* TOPI = (int*)(ws + WS_TOPI);
    bf16* UB = (bf16*)(ws + WS_UB); bf16* VB = (bf16*)(ws + WS_VB);
    bf16* KH = (bf16*)(ws + WS_KH); bf16* KL = (bf16*)(ws + WS_KH + 65536);
    float* MIXF = a.out;
    volatile LAS unsigned* MISC = (volatile LAS unsigned*)(ldsb + MISC_OFF);
    if (tid < 32) MISC[tid] = 0u;
    __syncthreads();
    XcdBarrier bar = xcd_barrier_post((unsigned*)ws, MISC + 8);
#define IN(k) (a.ph_lo <= (k) && (k) < a.ph_hi)
#if defined(PROBE_LO)
    int seg_ = 0; unsigned long long tseg_ = __builtin_amdgcn_s_memrealtime();
#define PROBE_SPIN() do { if (seg_ >= PROBE_LO && seg_ <= PROBE_HI) { const unsigned long long d_ = (__builtin_amdgcn_s_memrealtime() - tseg_) * PROBE_AMP; const unsigned long long s_ = __builtin_amdgcn_s_memrealtime(); \
        while (__builtin_amdgcn_s_memrealtime() - s_ < d_) __builtin_amdgcn_s_sleep(4); } } while (0)
#define GRID_BAR() do { PROBE_SPIN(); xcd_barrier(bar); tseg_ = __builtin_amdgcn_s_memrealtime(); ++seg_; } while (0)
#else
#define PROBE_SPIN() do { } while (0)
#define GRID_BAR() xcd_barrier(bar)
#endif

    if (IN(0)) {
        LAS float* scr = (LAS float*)(ldsb + wave * 16384);
        constexpr int I_IN = 16 * 72, I_O = 16 * 32, NITEMS = I_IN + 2 * I_O;
        for (int it = gwave; it < NITEMS; it += nwaves) {
            int r = it;
            if (r < I_IN) { transpose_item(a.w_in, PW, D, WINT, scr, r / 72, r % 72, lane); continue; } r -= I_IN;
            if (r < I_O) { transpose_item(a.w_out, D, D, WOT, scr, r / 32, r % 32, lane); continue; } r -= I_O;
            transpose_item(a.peer_wq, D, D, WQT, scr, r / 32, r % 32, lane);
        }
        for (int i = gtid; i < 2 * 128 * 64; i += gthreads) { const float kf = a.peer_sub_keys[i]; const short h = bfs(kf); KH[i] = (bf16)h; KL[i] = (bf16)bfs(kf - sbf2f(h)); }
        rmsnorm_rows_bf16<true>(a.x, a.norm_mix_g, XNB, a.w_in, DTRAW, gwave, nwaves, lane);
    }
    GRID_BAR();
    if (IN(1)) {
        pg8::Gemm g{XNB, WINT, T, PS, D}; pg8::StaticOrder S; S.init(T, PS, nb, bid);
        pg8::EpiBf16Plain E{PROJ, PS};
        pg8::gemm_phase<pg8::EpiBf16Plain, pg8::StaticOrder>(ldsb, g, S, E, nullptr);
    }
    GRID_BAR();
    if (IN(2)) {
        for (int idx = gtid; idx < T * 1024; idx += gthreads) {
            const int t = idx >> 10, c = idx & 1023, s = t & (SEQ - 1);
            float acc = a.conv_b[c];
#pragma unroll
            for (int k = 0; k < 4; ++k) { const int sp = s + k - 3; if (sp >= 0) acc += a.conv_w[k * 1024 + c] * bf2f(PROJ[(size_t)(t + k - 3) * PS + OXBC + c]); }
            XACT[idx] = f2bf(silu_f(acc));
        }
        if (gwave < 1024) {
            const int h = gwave & 7, bc = gwave >> 3;
            const float A = -__expf(a.a_log[h]), bias = a.dt_bias[h];
            const int t0 = bc * 128 + lane, t1 = t0 + 64;
            const float raw0 = DTRAW[t0 * 8 + h] + bias, raw1 = DTRAW[t1 * 8 + h] + bias;
            const float dt0 = fmaxf(raw0, 0.f) + log1pf(__expf(-fabsf(raw0))), dt1 = fmaxf(raw1, 0.f) + log1pf(__expf(-fabsf(raw1)));
            DT[t0 * 8 + h] = dt0; DT[t1 * 8 + h] = dt1;
            float v0 = dt0 * A, v1 = dt1 * A;
#pragma unroll
            for (int o = 1; o < 64; o <<= 1) { const float y0 = __shfl_up(v0, o), y1 = __shfl_up(v1, o); if (lane >= o) { v0 += y0; v1 += y1; } }
            v1 += __shfl(v0, 63);
            ACS[t0 * 8 + h] = v0; ACS[t1 * 8 + h] = v1;
            if (lane == 63) CDEC[gwave] = __expf(v1);
        }
    }
    GRID_BAR();
    if (IN(3)) {
        for (int u = bid; u < 512; u += nb) {
            if (u < 256) attn_unit(a.attn_sinks, ldsb, u, PROJ, MIXF, tid, lane, wave);
            else ssd_chunk_unit(ldsb, u - 256, XACT, DT, ACS, MIXF, STATES, tid, lane, wave);
        }
    }
    GRID_BAR();
    if (IN(5)) {
        for (int idx = gtid; idx < 2 * 8 * 8192; idx += gthreads) {
            const int pn = idx & 8191, h = (idx >> 13) & 7, b = idx >> 16;
            float run = 0.f;
#pragma unroll 1
            for (int c0 = 0; c0 < 64; c0 += 8) {
                float st[8], dc[8];
#pragma unroll
                for (int j = 0; j < 8; ++j) { const int bch = (b * 64 + c0 + j) * 8 + h; st[j] = STATES[(size_t)bch * 8192 + pn]; dc[j] = CDEC[bch]; }
#pragma unroll
                for (int j = 0; j < 8; ++j) { const int bch = (b * 64 + c0 + j) * 8 + h; PREVT[(size_t)bch * 8192 + pn] = f2bf(run); run = dc[j] * run + st[j]; }
            }
        }
    }
    GRID_BAR();
    if (IN(6)) {
        for (int u = bid; u < 256; u += nb) yoff_unit(a.d_skip, u, XACT, PROJ, ACS, PREVT, MIXF, lane, wave);
    }
    GRID_BAR();
    if (IN(6)) {
        for (int t = gwave; t < T; t += nwaves) {
            const float* row = MIXF + (size_t)t * D;
            const float4 a0 = *(const float4*)(row + 8 * lane), a1 = *(const float4*)(row + 8 * lane + 4);
            const float4 s0 = *(const float4*)(row + 512 + 8 * lane), s1 = *(const float4*)(row + 512 + 8 * lane + 4);
            float ssa = a0.x * a0.x + a0.y * a0.y + a0.z * a0.z + a0.w * a0.w + a1.x * a1.x + a1.y * a1.y + a1.z * a1.z + a1.w * a1.w;
            float sss = s0.x * s0.x + s0.y * s0.y + s0.z * s0.z + s0.w * s0.w + s1.x * s1.x + s1.y * s1.y + s1.z * s1.z + s1.w * s1.w;
            ssa = wave_sum(ssa);
#pragma unroll
            for (int o = 1; o < 32; o <<= 1) sss += __shfl_xor(sss, o);
            const float ra = rsqrtf(ssa * (1.f / 512.f) + EPS), rs = rsqrtf(sss * (1.f / 256.f) + EPS);
            const float4 ga0 = *(const float4*)(a.attn_out_g + 8 * lane), ga1 = *(const float4*)(a.attn_out_g + 8 * lane + 4);
            const float4 gs0 = *(const float4*)(a.ssm_norm_g + 8 * lane), gs1 = *(const float4*)(a.ssm_norm_g + 8 * lane + 4);
            v4u oa, os;
            oa.x = pkbf(a0.x * ra * ga0.x, a0.y * ra * ga0.y); oa.y = pkbf(a0.z * ra * ga0.z, a0.w * ra * ga0.w); oa.z = pkbf(a1.x * ra * ga1.x, a1.y * ra * ga1.y); oa.w = pkbf(a1.z * ra * ga1.z, a1.w * ra * ga1.w);
            os.x = pkbf(s0.x * rs * gs0.x, s0.y * rs * gs0.y); os.y = pkbf(s0.z * rs * gs0.z, s0.w * rs * gs0.w); os.z = pkbf(s1.x * rs * gs1.x, s1.y * rs * gs1.y); os.w = pkbf(s1.z * rs * gs1.z, s1.w * rs * gs1.w);
            *(v4u*)(XNB + (size_t)t * D + 8 * lane) = oa; *(v4u*)(XNB + (size_t)t * D + 512 + 8 * lane) = os;
        }
    }
    GRID_BAR();
    if (IN(7)) {
        pg8::Gemm g{XNB, WOT, T, D, D}; pg8::StaticOrder S; S.init(T, D, nb, bid);
        pg8::EpiF32Resid E{a.out, a.x, D};
        pg8::gemm_phase<pg8::EpiF32Resid, pg8::StaticOrder>(ldsb, g, S, E, nullptr);
    }
    GRID_BAR();
    if (IN(8)) {
        rmsnorm_rows_bf16<false>(a.out, a.norm_ffn_g, XNB, nullptr, nullptr, gwave, nwaves, lane);
        for (int i = gtid; i < 2 * 16384 * 128; i += gthreads) {
            const int which = i >> 21, r = i & ((1 << 21) - 1);
            const float4* src = (const float4*)((which ? a.peer_v : a.peer_u) + (size_t)r * 8);
            const float4 f0 = src[0], f1 = src[1];
            v4u o; o.x = pk2(f0.x, f0.y); o.y = pk2(f0.z, f0.w); o.z = pk2(f1.x, f1.y); o.w = pk2(f1.z, f1.w);
            *(v4u*)((which ? VB : UB) + (size_t)r * 8) = o;
        }
    }
    GRID_BAR();
    if (IN(9)) {
        pg8::Gemm g{XNB, WQT, T, D, D}; pg8::StaticOrder S; S.init(T, D, nb, bid);
        pg8::EpiF32Resid E{QP, nullptr, D};
        pg8::gemm_phase<pg8::EpiF32Resid, pg8::StaticOrder>(ldsb, g, S, E, nullptr);
    }
    GRID_BAR();
    if (IN(10)) {
        for (int task = gwave; task < T / 4; task += nwaves) route_task(task, QP, KH, KL, IDX, GATE, lane);
    }
    GRID_BAR();
    float* ACT = (float*)(ws + WS_ACT); float* PEERO = (float*)(ws + WS_PEERO);
    unsigned* ctl = (unsigned*)ws;
    const int xcc = (int)(bar.x & 7u);
    if (IN(12)) {
#pragma unroll 1
        for (int pi = 0; pi < NPART; ++pi) {
            const int p = ((xcc + (pi >> 1)) & 7) + 8 * (pi & 1);
            for (;;) {
                if (tid == 0) MISC[16] = xb_add(&ctl[CW_QU + 64 * p], 1u);
                __syncthreads();
                const int j = (int)MISC[16];
                __syncthreads();
                if (j >= NCHUNK) break;
                peer_u_item(p, j, IDX, GATE, XNB, UB, ACT, lane, wave);
            }
        }
    }
    GRID_BAR();
    if (IN(13)) {
#pragma unroll 1
        for (int pi = 0; pi < NPART; ++pi) {
            const int p = ((xcc + (pi >> 1)) & 7) + 8 * (pi & 1);
            for (;;) {
                if (tid == 0) MISC[16] = xb_add(&ctl[CW_QV + 64 * p], 1u);
                __syncthreads();
                const int j = (int)MISC[16];
                __syncthreads();
                if (j >= NCHUNK) break;
                peer_v_item(p, j, IDX, ACT, VB, PEERO, lane, wave);
            }
        }
    }
    GRID_BAR();
    if (IN(14)) {
        for (int t = gwave; t < T; t += nwaves) {
            const float4* hr = (const float4*)(a.out + (size_t)t * D) + lane; const float4* pr = (const float4*)(PEERO + (size_t)t * D) + lane;
            float4 v[4]; float ss = 0.f;
#pragma unroll
            for (int jq = 0; jq < 4; ++jq) { const float4 h4 = hr[64 * jq], p4 = pr[64 * jq]; v[jq] = make_float4(h4.x + p4.x, h4.y + p4.y, h4.z + p4.z, h4.w + p4.w); ss += v[jq].x * v[jq].x + v[jq].y * v[jq].y + v[jq].z * v[jq].z + v[jq].w * v[jq].w; }
            ss = wave_sum(ss);
            const float r3 = rsqrtf(ss * (1.f / D) + EPS);
            float4* op = (float4*)(a.out + (size_t)t * D) + lane;
#pragma unroll
            for (int jq = 0; jq < 4; ++jq) { const float4 gv = ((const float4*)a.final_norm_g)[lane + 64 * jq]; op[64 * jq] = make_float4(v[jq].x * r3 * gv.x, v[jq].y * r3 * gv.y, v[jq].z * r3 * gv.z, v[jq].w * r3 * gv.w); }
        }
    }
    PROBE_SPIN();
#undef IN
}
}

extern "C" void kernel_launch(void* const* d_in, const int* in_sizes, int n_in, void* d_out, int out_size, void* d_ws, size_t ws_size, hipStream_t stream) {
    if (n_in != 18 || out_size != T * D || ws_size < WS_END) { fprintf(stderr, "kernel_launch: unexpected shapes n_in=%d out=%d ws=%zu\n", n_in, out_size, ws_size); return; }
    Args a{};
    const float** ap = (const float**)&a;
    for (int i = 0; i < 18; ++i) ap[i] = (const float*)d_in[i];
    a.out = (float*)d_out; a.ws = (unsigned char*)d_ws;
    static int grid = 0;
    if (grid == 0) {
        int dev = 0, cus = 0, per_cu = 0;
        if (hipGetDevice(&dev) != hipSuccess || hipDeviceGetAttribute(&cus, hipDeviceAttributeMultiprocessorCount, dev) != hipSuccess) { fprintf(stderr, "kernel_launch: device query failed\n"); grid = -1; return; }
        if (hipFuncSetAttribute((const void*)k_main, hipFuncAttributeMaxDynamicSharedMemorySize, LDS_BYTES) != hipSuccess) { fprintf(stderr, "kernel_launch: hipFuncSetAttribute failed\n"); grid = -1; return; }
        if (hipOccupancyMaxActiveBlocksPerMultiprocessor(&per_cu, (const void*)k_main, NTHR, LDS_BYTES) != hipSuccess || per_cu < 1) { fprintf(stderr, "kernel_launch: occupancy query says %d blocks/CU\n", per_cu); (void)hipGetLastError(); grid = -1; return; }
        grid = cus;
    }
    if (grid < 0) return;
    if (hipMemsetAsync(d_ws, 0, 65536, stream) != hipSuccess) { fprintf(stderr, "kernel_launch: memset failed\n"); return; }
    a.ph_lo = 0; a.ph_hi = 15;
    hipLaunchKernelGGL(k_main, dim3(grid), dim3(NTHR), LDS_BYTES, stream, a);
}
```

```cpp
#include <hip/hip_runtime.h>
#include <cstdio>
#include <cstdint>

namespace pg8 {
#define PG8_LAS __attribute__((address_space(3)))
typedef unsigned short bf16_t;
typedef short bf16x8 __attribute__((ext_vector_type(8)));
typedef float f32x4 __attribute__((ext_vector_type(4)));
typedef unsigned u32x4 __attribute__((ext_vector_type(4)));
constexpr int BM = 256, BK = 64, HALF = 128, HTB = HALF * BK * 2  , STAGE_BYTES = 8 * HTB, NXCD = 8, WGM = 8;

__host__ __device__ __forceinline__ int lds_byte(int r, int c) { const int st = (r >> 4) * 2 + (c >> 5), rr = r & 15, cc = c & 31, ob = rr * 64 + cc * 2; return st * 1024 + (ob ^ (((ob >> 9) & 1) << 5)); }
__host__ __device__ __forceinline__ void stage_rc(int b, int& R, int& C) { const int st = b / 1024, sb = b % 1024, swz = sb ^ (((sb >> 9) & 1) << 5); R = (st >> 1) * 16 + swz / 64; C = (st & 1) * 32 + (swz % 64) / 2; }
__host__ __device__ __forceinline__ int perm32(int rho) { const int n = rho >> 4, i = rho & 15; return 8 * (i >> 2) + 4 * n + (i & 3); }

struct Unit { int pm, pn; };
struct Gemm { const bf16_t* A; const bf16_t* Bt; int M, N, K; };

struct StaticOrder {
    int nM, nN, nwg, G, c;
    __host__ __device__ void init(int M, int N, int G_, int c_) { nM = M / BM; nN = N / BM; nwg = nM * nN; G = G_; c = c_; }
    __host__ __device__ bool next(int i, Unit& u) const {
        const long L = (long)i * G + c; if (L >= nwg) return false;
        int wgid = (int)L; { const int q = nwg / NXCD, r = nwg % NXCD, xcd = wgid % NXCD, off = wgid / NXCD; wgid = (xcd < r ? xcd * (q + 1) : r * (q + 1) + (xcd - r) * q) + off; }
        const int nig = WGM * nN, gid = wgid / nig, fm = gid * WGM, gsz = (nM - fm) < WGM ? (nM - fm) : WGM;
        u.pm = fm + ((wgid % nig) % gsz); u.pn = (wgid % nig) / gsz; return true;
    }
    __device__ __forceinline__ void a_ready(const Unit&) const {}
    __device__ __forceinline__ void done(const Unit&) const {}
};
__device__ __forceinline__ unsigned cvt_pk_bf16(float lo, float hi) { unsigned r; asm volatile("v_cvt_pk_bf16_f32 %0, %1, %2" : "=v"(r) : "v"(lo), "v"(hi)); return r; }
typedef float f32x2 __attribute__((ext_vector_type(2)));
struct EpiBf16Plain {
    static constexpr bool PERM = true, AFTER_DRAIN = false;
    bf16_t* O; int ldc;
    __device__ __forceinline__ void operator()(const f32x4 (&acc)[2][2][4][2], const Unit& u, int wr, int wc, int fr, int fq) const {
        const int row0 = u.pm * BM + wr * 64 + fr, col0 = u.pn * BM + wc * 32 + 8 * fq;
#pragma unroll
        for (int ai = 0; ai < 2; ++ai)
#pragma unroll
            for (int m = 0; m < 4; ++m) { bf16_t* rowp = O + (size_t)(row0 + ai * HALF + m * 16) * ldc + col0;
#pragma unroll
                for (int bj = 0; bj < 2; ++bj) { const f32x4 v0 = acc[ai][bj][m][0], v1 = acc[ai][bj][m][1];
                    u32x4 w; w.x = cvt_pk_bf16(v0[0], v0[1]); w.y = cvt_pk_bf16(v0[2], v0[3]); w.z = cvt_pk_bf16(v1[0], v1[1]); w.w = cvt_pk_bf16(v1[2], v1[3]);
                    *(u32x4*)(rowp + bj * HALF) = w; } }
    }
};
struct EpiF32Resid {
    static constexpr bool PERM = false, AFTER_DRAIN = false;
    float* C; const float* R; int ldc;
    __device__ __forceinline__ void operator()(const f32x4 (&acc)[2][2][4][2], const Unit& u, int wr, int wc, int fr, int fq) const {
        const int row0 = u.pm * BM + wr * 64 + fr, col0 = u.pn * BM + wc * 32 + 4 * fq;
#pragma unroll
        for (int ai = 0; ai < 2; ++ai)
#pragma unroll
            for (int m = 0; m < 4; ++m) { const size_t off = (size_t)(row0 + ai * HALF + m * 16) * ldc + col0;
#pragma unroll
                for (int bj = 0; bj < 2; ++bj)
#pragma unroll
                    for (int n = 0; n < 2; ++n) { f32x4 v = acc[ai][bj][m][n]; if (R) v += *(const f32x4*)(R + off + bj * HALF + n * 16); *(f32x4*)(C + off + bj * HALF + n * 16) = v; }
                asm volatile("" ::: "memory"); }
    }
};
template <class Epi, class Sched, bool STAMP = false>
__device__ __forceinline__ void gemm_phase(PG8_LAS unsigned char* lds, const Gemm g, const Sched& S, const Epi& E, unsigned long long* stamps) {
    const int tid = threadIdx.x, wid = __builtin_amdgcn_readfirstlane(tid >> 6), lane = tid & 63, wr = wid >> 2, wc = wid & 3, fr = lane & 15, fq = lane >> 4;
    const int K = g.K, nt = K / BK;
    int ts_lo = 0, ts_hi = 0, nts = 0; const unsigned long long rt_entry = STAMP ? (unsigned long long)0ull : 0ull;
#define PG8_STAMP() do { if (STAMP && wid == 0 && nts < 64) { const unsigned long long _c = (unsigned long long)clock64(); \
        ts_lo = (lane == nts) ? (int)(unsigned)_c : ts_lo; ts_hi = (lane == nts) ? (int)(unsigned)(_c >> 32) : ts_hi; ++nts; } } while (0)
    PG8_STAMP();
    unsigned voffA[2], voffB[2];
#pragma unroll
    for (int i = 0; i < 2; ++i) { int R, C; stage_rc(tid * 16 + i * 8192, R, C); const int Rb = Epi::PERM ? ((R & ~31) + perm32(R & 31)) : R;
        voffA[i] = (unsigned)(R * K + C) * 2u; voffB[i] = (unsigned)(Rb * K + C) * 2u; }
    const size_t kstep = (size_t)(BK * 2);
    const size_t hstep = (size_t)HALF * K * 2;
    const size_t tstep = 2 * hstep;
    const unsigned ldsw = (unsigned)wid * 1024u;
    const int aoff = lds_byte(wr * 64 + fr, fq * 8), boff = lds_byte(wc * 32 + fr, fq * 8);
#define PG8_SA(b, h) (((b) * 2 + (h)) * HTB)
#define PG8_SB(b, h) ((4 + (b) * 2 + (h)) * HTB)
#define PG8_STAGE(bufoff, gbase, voff) do { _Pragma("unroll") for (int _i = 0; _i < 2; ++_i) \
        __builtin_amdgcn_global_load_lds((const unsigned*)((const char*)(gbase) + (voff)[_i]), (PG8_LAS unsigned*)(lds + (bufoff) + ldsw + _i * 8192), 16, 0, 0); } while (0)
#define PG8_LDA(dst, b, h) do { _Pragma("unroll") for (int m = 0; m < 4; ++m) _Pragma("unroll") for (int k = 0; k < 2; ++k) dst[m][k] = *(const PG8_LAS bf16x8*)(lds + PG8_SA(b, h) + aoff + m * 2048 + k * 1024); } while (0)
#define PG8_LDB(dst, b, h) do { _Pragma("unroll") for (int n = 0; n < 2; ++n) _Pragma("unroll") for (int k = 0; k < 2; ++k) dst[n][k] = *(const PG8_LAS bf16x8*)(lds + PG8_SB(b, h) + boff + n * 2048 + k * 1024); } while (0)
#define PG8_MMA(ai, bj, At, Bt) do { __builtin_amdgcn_s_setprio(1); _Pragma("unroll") for (int m = 0; m < 4; ++m) _Pragma("unroll") for (int n = 0; n < 2; ++n) _Pragma("unroll") for (int k = 0; k < 2; ++k) \
        acc[ai][bj][m][n] = __builtin_amdgcn_mfma_f32_16x16x32_bf16(Bt[n][k], At[m][k], acc[ai][bj][m][n], 0, 0, 0); __builtin_amdgcn_s_setprio(0); } while (0)
#define PG8_WAIT_V(n) asm volatile("s_waitcnt vmcnt(" #n ")" ::: "memory")
#define PG8_WAIT_L(n) asm volatile("s_waitcnt lgkmcnt(" #n ")" ::: "memory")
#define PG8_BAR __builtin_amdgcn_s_barrier()
#define PG8_SCHED __builtin_amdgcn_sched_barrier(0)
    Unit cur, nxt; int ui = 0;
    if (!S.next(0, cur)) return;
    f32x4 acc[2][2][4][2];
#pragma unroll
    for (int a = 0; a < 2; ++a)
#pragma unroll
        for (int b = 0; b < 2; ++b)
#pragma unroll
            for (int m = 0; m < 4; ++m)
#pragma unroll
                for (int n = 0; n < 2; ++n) acc[a][b][m][n] = (f32x4){0.f, 0.f, 0.f, 0.f};
    bf16x8 At[4][2], B0[2][2], B1[2][2];
    const char* cA = (const char*)g.A + (size_t)cur.pm * tstep; const char* cB = (const char*)g.Bt + (size_t)cur.pn * tstep;
    S.a_ready(cur);
    PG8_STAGE(PG8_SB(0, 0), cB, voffB); PG8_STAGE(PG8_SA(0, 0), cA, voffA); PG8_STAGE(PG8_SB(0, 1), cB + hstep, voffB); PG8_STAGE(PG8_SA(0, 1), cA + hstep, voffA);
    if (wr == 1) PG8_BAR;
    PG8_WAIT_V(4); PG8_BAR;
    PG8_STAGE(PG8_SB(1, 0), cB + kstep, voffB); PG8_STAGE(PG8_SA(1, 0), cA + kstep, voffA); PG8_STAGE(PG8_SB(1, 1), cB + hstep + kstep, voffB);
    PG8_WAIT_V(6); PG8_BAR;
    PG8_STAMP();
    for (;;) {
        const bool has_next = S.next(ui + 1, nxt);
        const char* nA = has_next ? (const char*)g.A + (size_t)nxt.pm * tstep : cA; const char* nB = has_next ? (const char*)g.Bt + (size_t)nxt.pn * tstep : cB;
        for (int t = 0; t < nt; t += 2) {
            const bool last = (t == nt - 2);
            const char* a1 = cA + (size_t)(t + 1) * kstep;
            const char* a2 = last ? nA : cA + (size_t)(t + 2) * kstep; const char* b2 = last ? nB : cB + (size_t)(t + 2) * kstep;
            const char* a3 = a2 + kstep; const char* b3 = b2 + kstep;
            if (last && has_next) S.a_ready(nxt);
            PG8_LDB(B0, 0, 0); PG8_SCHED; PG8_LDA(At, 0, 0); PG8_STAGE(PG8_SA(1, 1), a1 + hstep, voffA);
            PG8_WAIT_L(8); PG8_BAR; PG8_WAIT_L(0); PG8_MMA(0, 0, At, B0); PG8_BAR; PG8_SCHED;
            PG8_LDB(B1, 0, 1); PG8_STAGE(PG8_SB(0, 0), b2, voffB);
            PG8_BAR; PG8_WAIT_L(0); PG8_MMA(0, 1, At, B1); PG8_BAR;
            PG8_LDA(At, 0, 1); PG8_STAGE(PG8_SA(0, 0), a2, voffA);
            PG8_BAR; PG8_WAIT_L(0); PG8_MMA(1, 0, At, B0); PG8_BAR; PG8_SCHED;
            PG8_STAGE(PG8_SB(0, 1), b2 + hstep, voffB);
            PG8_WAIT_V(6); PG8_BAR; PG8_MMA(1, 1, At, B1); PG8_BAR;
            PG8_LDB(B0, 1, 0); PG8_SCHED; PG8_LDA(At, 1, 0); PG8_STAGE(PG8_SA(0, 1), a2 + hstep, voffA);
            PG8_WAIT_L(8); PG8_BAR; PG8_WAIT_L(0); PG8_MMA(0, 0, At, B0); PG8_BAR; PG8_SCHED;
            PG8_LDB(B1, 1, 1); PG8_STAGE(PG8_SB(1, 0), b3, voffB);
            PG8_BAR; PG8_WAIT_L(0); PG8_MMA(0, 1, At, B1); PG8_BAR;
            PG8_LDA(At, 1, 1); PG8_STAGE(PG8_SA(1, 0), a3, voffA);
            PG8_BAR; PG8_WAIT_L(0); PG8_MMA(1, 0, At, B0); PG8_BAR; PG8_SCHED;
            PG8_STAGE(PG8_SB(1, 1), b3 + hstep, voffB);
            PG8_WAIT_V(6); PG8_BAR; PG8_MMA(1, 1, At, B1); PG8_BAR;
        }
        PG8_STAMP();
        if constexpr (!Epi::AFTER_DRAIN) { E(acc, cur, wr, wc, fr, fq); S.done(cur); }
        PG8_STAMP();
        if (!has_next) break;
#pragma unroll
        for (int a = 0; a < 2; ++a)
#pragma unroll
            for (int b = 0; b < 2; ++b)
#pragma unroll
                for (int m = 0; m < 4; ++m)
#pragma unroll
                    for (int n = 0; n < 2; ++n) acc[a][b][m][n] = (f32x4){0.f, 0.f, 0.f, 0.f};
        cur = nxt; cA = nA; cB = nB; ++ui;
    }
    PG8_WAIT_V(0);
    if (wr == 0) PG8_BAR;
    PG8_BAR;
    if constexpr (Epi::AFTER_DRAIN) { E.fused(acc, cur, wr, wc, fr, fq, lds, wid, lane); S.done(cur); }
    PG8_STAMP();
    if (STAMP && wid == 0) { stamps[lane] = lane < nts ? (((unsigned long long)(unsigned)ts_hi << 32) | (unsigned)ts_lo) : 0ull;
        if (lane == 62) stamps[62] = rt_entry; if (lane == 63) stamps[63] = (unsigned long long)0ull; }
#undef PG8_STAMP
#undef PG8_SA
#undef PG8_SB
#undef PG8_STAGE
#undef PG8_LDA
#undef PG8_LDB
#undef PG8_MMA
#undef PG8_WAIT_V
#undef PG8_WAIT_L
#undef PG8_BAR
#undef PG8_SCHED
}
}

namespace {
constexpr int D = 1024, BATCH = 2, SEQ = 8192, T = BATCH * SEQ;
constexpr int PW = 2312;
constexpr int PS = 2304;
constexpr int OQ = 0, OKK = 512, OV = 640, OZ = 768, OXBC = 1280, ODT = 2304;
constexpr float EPS = 1e-6f;
constexpr int NTHR = 512;
typedef unsigned short bf16;
typedef unsigned v4u __attribute__((ext_vector_type(4)));

constexpr size_t MiB = 1u << 20;
constexpr size_t WS_WIN = 1 * MiB;
constexpr size_t WS_KH = 5 * MiB + 512 * 1024;
constexpr size_t WS_WO = 6 * MiB;
constexpr size_t WS_WQ = 8 * MiB;
constexpr size_t WS_PROJ = 10 * MiB;
constexpr size_t WS_XNB = 82 * MiB;
constexpr size_t WS_XACT = 114 * MiB;
constexpr size_t WS_DTRAW = 146 * MiB;
constexpr size_t WS_DT = WS_DTRAW + 512 * 1024;
constexpr size_t WS_ACS = WS_DT + 512 * 1024;
constexpr size_t WS_CDEC = WS_ACS + 512 * 1024;
constexpr size_t WS_STATES = 164 * MiB;
constexpr size_t WS_PREV = 196 * MiB;
constexpr size_t WS_QP = 10 * MiB;
constexpr size_t WS_IDX = 74 * MiB;
constexpr size_t WS_GATE = 114 * MiB;
constexpr size_t WS_TOPV = 122 * MiB;
constexpr size_t WS_TOPI = 138 * MiB;
constexpr size_t WS_ACT = 122 * MiB;
constexpr size_t WS_SU = 130 * MiB;
constexpr size_t WS_U8 = 132 * MiB;
constexpr size_t WS_V8 = 148 * MiB;
constexpr size_t WS_PART = 164 * MiB;
constexpr size_t WS_PEERO = 10 * MiB;
constexpr size_t WS_END = 228 * MiB;
constexpr int CW_QU = 4096, CW_QV = 4096 + 64 * 16;
constexpr int NPART = 8, NCHUNK = T / 64;

struct Args {
    const float* x; const float* norm_mix_g; const float* w_in; const float* attn_sinks; const float* attn_out_g;
    const float* conv_w; const float* conv_b; const float* dt_bias; const float* a_log; const float* d_skip;
    const float* ssm_norm_g; const float* w_out; const float* norm_ffn_g; const float* peer_wq; const float* peer_sub_keys;
    const float* peer_u; const float* peer_v; const float* final_norm_g;
    float* out; unsigned char* ws;
    int ph_lo, ph_hi;
};

#define LAS __attribute__((address_space(3)))
#define LDS_WAIT() asm volatile("s_waitcnt lgkmcnt(0)" ::: "memory")
__device__ __forceinline__ float bf2f(bf16 v) { return __uint_as_float(((unsigned)v) << 16); }
__device__ __forceinline__ unsigned f2bfu(float f) { unsigned u = __float_as_uint(f); return (u + 0x7fffu + ((u >> 16) & 1u)) >> 16; }
__device__ __forceinline__ bf16 f2bf(float f) { return (bf16)f2bfu(f); }
__device__ __forceinline__ unsigned pk2(float lo, float hi) { return f2bfu(lo) | (f2bfu(hi) << 16); }
__device__ __forceinline__ float wave_sum(float v) {
#pragma unroll
    for (int o = 1; o < 64; o <<= 1) v += __shfl_xor(v, o);
    return v;
}
__device__ __forceinline__ float silu_f(float v) { return v / (1.f + __expf(-v)); }

__device__ __forceinline__ void transpose_item(const float* W, int ldw, int K, bf16* WT, LAS float* scr, int kb, int nbk, int lane) {
    const int k0 = 64 * kb, n0 = 32 * nbk;
#pragma unroll 8
    for (int i = 0; i < 32; ++i) { const int kk = 2 * i + (lane >> 5); scr[kk * 33 + (lane & 31)] = W[(size_t)(k0 + kk) * ldw + n0 + (lane & 31)]; }
    LDS_WAIT();
    const int c = lane & 7;
#pragma unroll
    for (int j = 0; j < 4; ++j) { const int n = (lane >> 3) + 8 * j; const LAS float* s = scr + (8 * c) * 33 + n;
        v4u o; o.x = pk2(s[0 * 33], s[1 * 33]); o.y = pk2(s[2 * 33], s[3 * 33]); o.z = pk2(s[4 * 33], s[5 * 33]); o.w = pk2(s[6 * 33], s[7 * 33]);
        *(v4u*)(WT + (size_t)(n0 + n) * K + k0 + 8 * c) = o; }
    LDS_WAIT();
}

template <bool WITH_DT>
__device__ __forceinline__ void rmsnorm_rows_bf16(const float* in, const float* g, bf16* outp, const float* w_in, float* dtraw, int gwave, int nwaves, int lane) {
    for (int row = gwave; row < T; row += nwaves) {
        const float4* xr = (const float4*)(in + (size_t)row * D) + lane;
        float4 v[4]; float ss = 0.f;
#pragma unroll
        for (int j = 0; j < 4; ++j) { v[j] = xr[64 * j]; ss += v[j].x * v[j].x + v[j].y * v[j].y + v[j].z * v[j].z + v[j].w * v[j].w; }
        ss = wave_sum(ss);
        const float r = rsqrtf(ss * (1.f / D) + EPS);
        unsigned long long* o8 = (unsigned long long*)(outp + (size_t)row * D) + lane;
        float dacc[8];
#pragma unroll
        for (int h = 0; h < 8; ++h) dacc[h] = 0.f;
#pragma unroll
        for (int j = 0; j < 4; ++j) {
            const float4 gv = ((const float4*)g)[lane + 64 * j];
            const float y[4] = {v[j].x * r * gv.x, v[j].y * r * gv.y, v[j].z * r * gv.z, v[j].w * r * gv.w};
            o8[64 * j] = (unsigned long long)pk2(y[0], y[1]) | ((unsigned long long)pk2(y[2], y[3]) << 32);
            if (WITH_DT) {
#pragma unroll
                for (int e = 0; e < 4; ++e) {
                    const float4* wp = (const float4*)(w_in + (size_t)(256 * j + 4 * lane + e) * PW + ODT);
                    const float4 w0 = wp[0], w1 = wp[1];
                    dacc[0] += y[e] * w0.x; dacc[1] += y[e] * w0.y; dacc[2] += y[e] * w0.z; dacc[3] += y[e] * w0.w;
                    dacc[4] += y[e] * w1.x; dacc[5] += y[e] * w1.y; dacc[6] += y[e] * w1.z; dacc[7] += y[e] * w1.w;
                }
            }
        }
        if (WITH_DT) {
#pragma unroll
            for (int h = 0; h < 8; ++h) dacc[h] = wave_sum(dacc[h]);
            if (lane == 0) { float4* dp = (float4*)(dtraw + (size_t)row * 8); dp[0] = make_float4(dacc[0], dacc[1], dacc[2], dacc[3]); dp[1] = make_float4(dacc[4], dacc[5], dacc[6], dacc[7]); }
        }
    }
}


typedef short bf16x8 __attribute__((ext_vector_type(8)));
typedef short bf16x4 __attribute__((ext_vector_type(4)));
typedef float f32x16 __attribute__((ext_vector_type(16)));
typedef __bf16 bf2_t __attribute__((ext_vector_type(2)));
#define MFMA32(a, b, c) __builtin_amdgcn_mfma_f32_32x32x16_bf16((a), (b), (c), 0, 0, 0)
__device__ __forceinline__ unsigned pkbf(float lo, float hi) { bf2_t v = {(__bf16)lo, (__bf16)hi}; return __builtin_bit_cast(unsigned, v); }
__device__ __forceinline__ short bfs(float f) { return __builtin_bit_cast(short, (__bf16)f); }
__device__ __forceinline__ float sbf2f(short v) { return __uint_as_float(((unsigned)(unsigned short)v) << 16); }
__device__ __forceinline__ int crow(int i, int hi) { return (i & 3) + 8 * (i >> 2) + 4 * hi; }
template <int S> __device__ __forceinline__ bf16x8 pack8(const f32x16& x) {
    v4u p; p.x = pkbf(x[8 * S], x[8 * S + 1]); p.y = pkbf(x[8 * S + 2], x[8 * S + 3]); p.z = pkbf(x[8 * S + 4], x[8 * S + 5]); p.w = pkbf(x[8 * S + 6], x[8 * S + 7]);
    return __builtin_bit_cast(bf16x8, p);
}
__device__ __forceinline__ bf16x8 ldg8(const bf16* p) { return *(const bf16x8*)p; }
__device__ __forceinline__ bf16x8 lds8(const LAS bf16* p) { return *(const LAS bf16x8*)p; }
__device__ __forceinline__ bf16x8 lds4x2(const LAS bf16* p) { const bf16x4 a = *(const LAS bf16x4*)p, b = *(const LAS bf16x4*)(p + 8); return __builtin_shufflevector(a, b, 0, 1, 2, 3, 4, 5, 6, 7); }
__device__ __forceinline__ f32x16 zero16() { f32x16 z;
#pragma unroll
    for (int i = 0; i < 16; ++i) z[i] = 0.f;
    return z; }

__device__ __forceinline__ void attn_unit(const float* sinks, LAS unsigned char* ldsb, int unit, const bf16* PROJ, float* MIXF, int tid, int lane, int wave) {
    const int hkv = unit & 1, blk = unit >> 1, nbk = blk & 63;
    const int tokblk = blk * 128, wbase = tokblk - 128;
    LAS bf16* VT = (LAS bf16*)ldsb;
#pragma unroll
    for (int i = 0; i < 4; ++i) {
        const int c = tid + 512 * i, key = c >> 3, d0 = (c & 7) * 8; const bool valid = (nbk > 0) || (key >= 128);
        bf16x8 v;
#pragma unroll
        for (int e = 0; e < 8; ++e) v[e] = 0;
        if (valid) v = ldg8(PROJ + (size_t)(wbase + key) * PS + OV + hkv * 64 + d0);
#pragma unroll
        for (int e = 0; e < 8; ++e) VT[(d0 + e) * 264 + key] = (bf16)v[e];
    }
    __syncthreads();
    const int r = lane & 31, hi = lane >> 5;
    const int hq = hkv * 4 + (wave & 3);
    const float slope = exp2f(-(float)(hq + 1)), sink = sinks[hq];
#pragma unroll 1
    for (int qq = 0; qq < 2; ++qq) {
        const int qt = (wave >> 2) + 2 * qq;
        const int tq = tokblk + 32 * qt + r;
        bf16x8 qf[4];
#pragma unroll
        for (int ks = 0; ks < 4; ++ks) qf[ks] = ldg8(PROJ + (size_t)tq * PS + OQ + hq * 64 + 16 * ks + 8 * hi);
        f32x16 X[5];
#pragma unroll
        for (int kt = 0; kt < 5; ++kt) {
            const int key = 32 * (qt + kt) + r; const bool valid = (nbk > 0) || (key >= 128);
            const int row = valid ? (wbase + key) : tokblk;
            X[kt] = zero16();
#pragma unroll
            for (int ks = 0; ks < 4; ++ks) { const bf16x8 kf = ldg8(PROJ + (size_t)row * PS + OKK + hkv * 64 + 16 * ks + 8 * hi); X[kt] = MFMA32(kf, qf[ks], X[kt]); }
        }
        const int qi = 32 * qt + r;
        float m = -1e30f;
#pragma unroll
        for (int kt = 0; kt < 5; ++kt)
#pragma unroll
            for (int i = 0; i < 16; ++i) {
                const int ki = 32 * (qt + kt) + crow(i, hi), dist = 128 + qi - ki;
                const bool valid = (dist >= 0) && (dist < 128) && ((nbk > 0) || (ki >= 128));
                const float lg = valid ? (X[kt][i] * 0.125f - slope * (float)dist) : -1e30f;
                X[kt][i] = lg; m = fmaxf(m, lg);
            }
        m = fmaxf(m, __shfl_xor(m, 32)); m = fmaxf(m, sink);
        float lsum = 0.f;
#pragma unroll
        for (int kt = 0; kt < 5; ++kt)
#pragma unroll
            for (int i = 0; i < 16; ++i) { const float p = __expf(X[kt][i] - m); X[kt][i] = p; lsum += p; }
        lsum += __shfl_xor(lsum, 32); lsum += __expf(sink - m);
        f32x16 O0 = zero16(), O1 = zero16();
#pragma unroll
        for (int kt = 0; kt < 5; ++kt) {
            const int kb = 32 * (qt + kt) + 4 * hi;
            { const bf16x8 xs = pack8<0>(X[kt]); const bf16x8 a0 = lds4x2(VT + r * 264 + kb), a1 = lds4x2(VT + (32 + r) * 264 + kb); O0 = MFMA32(a0, xs, O0); O1 = MFMA32(a1, xs, O1); }
            { const bf16x8 xs = pack8<1>(X[kt]); const bf16x8 a0 = lds4x2(VT + r * 264 + kb + 16), a1 = lds4x2(VT + (32 + r) * 264 + kb + 16); O0 = MFMA32(a0, xs, O0); O1 = MFMA32(a1, xs, O1); }
        }
        const float inv = 1.f / lsum;
        float* orow = MIXF + (size_t)tq * D + hq * 64 + 4 * hi;
#pragma unroll
        for (int q4 = 0; q4 < 4; ++q4) {
            *(float4*)(orow + 8 * q4) = make_float4(O0[4 * q4] * inv, O0[4 * q4 + 1] * inv, O0[4 * q4 + 2] * inv, O0[4 * q4 + 3] * inv);
            *(float4*)(orow + 32 + 8 * q4) = make_float4(O1[4 * q4] * inv, O1[4 * q4 + 1] * inv, O1[4 * q4 + 2] * inv, O1[4 * q4 + 3] * inv);
        }
    }
    __syncthreads();
}

__device__ __forceinline__ void ssd_chunk_unit(LAS unsigned char* ldsb, int unit, const bf16* XACT, const float* DT, const float* ACS, float* MIXF, float* STATES, int tid, int lane, int wave) {
    const int g = unit & 1, bc = unit >> 1, tok0 = bc * 128;
    LAS bf16* BT = (LAS bf16*)ldsb;
    LAS bf16* XD = (LAS bf16*)(ldsb + 34816);
    LAS bf16* XW = (LAS bf16*)(ldsb + 34816 + 34816);
    LAS float* ACST = (LAS float*)(ldsb + 34816 * 3);
    const int r = lane & 31, hi = lane >> 5;
#pragma unroll
    for (int i = 0; i < 4; ++i) {
        const int c = tid + 512 * i, s = c >> 4, n0 = (c & 15) * 8;
        const bf16x8 v = ldg8(XACT + (size_t)(tok0 + s) * 1024 + 512 + g * 128 + n0);
#pragma unroll
        for (int e = 0; e < 8; ++e) BT[(n0 + e) * 136 + s] = (bf16)v[e];
    }
    ACST[tid] = ACS[(size_t)(tok0 + (tid >> 2)) * 8 + g * 4 + (tid & 3)];
#pragma unroll 1
    for (int hp = 0; hp < 2; ++hp) {
        if (hp) __syncthreads();
#pragma unroll
        for (int i = 0; i < 4; ++i) {
            const int c = tid + 512 * i, hsel = c >> 10, s = (c >> 3) & 127, p0 = (c & 7) * 8, H = g * 4 + 2 * hp + hsel;
            const bf16x8 v = ldg8(XACT + (size_t)(tok0 + s) * 1024 + H * 64 + p0);
            const float dtv = DT[(size_t)(tok0 + s) * 8 + H];
            const float w = __expf(ACS[(size_t)(tok0 + 127) * 8 + H] - ACS[(size_t)(tok0 + s) * 8 + H]);
#pragma unroll
            for (int e = 0; e < 8; ++e) { const float xd = sbf2f(v[e]) * dtv; XD[hsel * 8704 + (p0 + e) * 136 + s] = (bf16)bfs(xd); XW[hsel * 8704 + (p0 + e) * 136 + s] = (bf16)bfs(xd * w); }
        }
        __syncthreads();
        {
            const int lt = wave & 3, hsel = wave >> 2, hh = 2 * hp + hsel, H = g * 4 + hh;
            const int l = 32 * lt + r; const float acs_l = ACST[l * 4 + hh];
            bf16x8 cf[8];
#pragma unroll
            for (int ks = 0; ks < 8; ++ks) cf[ks] = ldg8(XACT + (size_t)(tok0 + l) * 1024 + 768 + g * 128 + 16 * ks + 8 * hi);
            f32x16 Z0 = zero16(), Z1 = zero16();
#pragma unroll 1
            for (int st = 0; st <= lt; ++st) {
                f32x16 X = zero16();
#pragma unroll
                for (int ks = 0; ks < 8; ++ks) { const bf16x8 bfr = ldg8(XACT + (size_t)(tok0 + 32 * st + r) * 1024 + 512 + g * 128 + 16 * ks + 8 * hi); X = MFMA32(bfr, cf[ks], X); }
#pragma unroll
                for (int i = 0; i < 16; ++i) { const int s = 32 * st + crow(i, hi); const float f = (s <= l) ? __expf(acs_l - ACST[s * 4 + hh]) : 0.f; X[i] *= f; }
                const int sb = 32 * st + 4 * hi;
                { const bf16x8 xs = pack8<0>(X); const bf16x8 b0 = lds4x2(XD + hsel * 8704 + r * 136 + sb), b1 = lds4x2(XD + hsel * 8704 + (32 + r) * 136 + sb); Z0 = MFMA32(xs, b0, Z0); Z1 = MFMA32(xs, b1, Z1); }
                { const bf16x8 xs = pack8<1>(X); const bf16x8 b0 = lds4x2(XD + hsel * 8704 + r * 136 + sb + 16), b1 = lds4x2(XD + hsel * 8704 + (32 + r) * 136 + sb + 16); Z0 = MFMA32(xs, b0, Z0); Z1 = MFMA32(xs, b1, Z1); }
            }
#pragma unroll
            for (int i = 0; i < 16; ++i) { float* o = MIXF + (size_t)(tok0 + 32 * lt + crow(i, hi)) * D + 512 + H * 64 + r; o[0] = Z0[i]; o[32] = Z1[i]; }
        }
        {
            const int nt = wave & 3, hsel = wave >> 2, H = g * 4 + 2 * hp + hsel;
            f32x16 S0 = zero16(), S1 = zero16();
#pragma unroll
            for (int ks = 0; ks < 8; ++ks) {
                const bf16x8 btf = lds8(BT + (32 * nt + r) * 136 + 16 * ks + 8 * hi);
                const bf16x8 a0 = lds8(XW + hsel * 8704 + r * 136 + 16 * ks + 8 * hi), a1 = lds8(XW + hsel * 8704 + (32 + r) * 136 + 16 * ks + 8 * hi);
                S0 = MFMA32(a0, btf, S0); S1 = MFMA32(a1, btf, S1);
            }
            float* sp = STATES + (size_t)(bc * 8 + H) * 8192 + 32 * nt + r;
#pragma unroll
            for (int i = 0; i < 16; ++i) { const int p = crow(i, hi); sp[p * 128] = S0[i]; sp[(32 + p) * 128] = S1[i]; }
        }
    }
    __syncthreads();
}

__device__ __forceinline__ void yoff_unit(const float* d_skip, int unit, const bf16* XACT, const bf16* PROJ, const float* ACS, const bf16* PREVT, float* MIXF, int lane, int wave) {
    const int g = unit & 1, bc = unit >> 1, tok0 = bc * 128;
    const int r = lane & 31, hi = lane >> 5, lt = wave & 3, hpair = wave >> 2;
    bf16x8 cf[8];
#pragma unroll
    for (int ks = 0; ks < 8; ++ks) cf[ks] = ldg8(XACT + (size_t)(tok0 + 32 * lt + r) * 1024 + 768 + g * 128 + 16 * ks + 8 * hi);
#pragma unroll 1
    for (int hsel = 0; hsel < 2; ++hsel) {
        const int H = g * 4 + 2 * hpair + hsel; const bf16* pv = PREVT + (size_t)(bc * 8 + H) * 8192;
        f32x16 Y0 = zero16(), Y1 = zero16();
#pragma unroll
        for (int ks = 0; ks < 8; ++ks) {
            const bf16x8 b0 = ldg8(pv + r * 128 + 16 * ks + 8 * hi), b1 = ldg8(pv + (32 + r) * 128 + 16 * ks + 8 * hi);
            Y0 = MFMA32(cf[ks], b0, Y0); Y1 = MFMA32(cf[ks], b1, Y1);
        }
        const float dsk = d_skip[H];
#pragma unroll
        for (int i = 0; i < 16; ++i) {
            const int t = tok0 + 32 * lt + crow(i, hi); const float ea = __expf(ACS[(size_t)t * 8 + H]);
#pragma unroll
            for (int pt = 0; pt < 2; ++pt) {
                const int col = H * 64 + 32 * pt + r;
                float* yp = MIXF + (size_t)t * D + 512 + col;
                float y = yp[0] + ea * (pt ? Y1[i] : Y0[i]) + dsk * bf2f(XACT[(size_t)t * 1024 + col]);
                const float z = bf2f(PROJ[(size_t)t * PS + OZ + col]);
                yp[0] = y * silu_f(z);
            }
        }
    }
}


typedef float f32x2 __attribute__((ext_vector_type(2)));
__device__ __forceinline__ void fp8x16_to_f32(const uint4 w, float (&f)[16]) {
    const int ww[4] = {(int)w.x, (int)w.y, (int)w.z, (int)w.w};
#pragma unroll
    for (int q = 0; q < 4; ++q) { const f32x2 a = __builtin_amdgcn_cvt_pk_f32_fp8(ww[q], false), b = __builtin_amdgcn_cvt_pk_f32_fp8(ww[q], true); f[4 * q] = a.x; f[4 * q + 1] = a.y; f[4 * q + 2] = b.x; f[4 * q + 3] = b.y; }
}
template <int M4, int M2, int M1> __device__ __forceinline__ void treduce16(const float (&a)[16], int lane, float& r0, float& r1) {
    float b[8], c[4];
    { const bool hi = (lane & M4) != 0;
#pragma unroll
      for (int i = 0; i < 8; ++i) { const float send = hi ? a[i] : a[i + 8]; const float recv = __shfl_xor(send, M4); b[i] = (hi ? a[i + 8] : a[i]) + recv; } }
    { const bool hi = (lane & M2) != 0;
#pragma unroll
      for (int i = 0; i < 4; ++i) { const float send = hi ? b[i] : b[i + 4]; const float recv = __shfl_xor(send, M2); c[i] = (hi ? b[i + 4] : b[i]) + recv; } }
    { const bool hi = (lane & M1) != 0;
      { const float send = hi ? c[0] : c[2]; const float recv = __shfl_xor(send, M1); r0 = (hi ? c[2] : c[0]) + recv; }
      { const float send = hi ? c[1] : c[3]; const float recv = __shfl_xor(send, M1); r1 = (hi ? c[3] : c[1]) + recv; } }
}
__device__ __forceinline__ void peer_u_item(int p, int j, const int* IDX, const bf16* XN2B, const unsigned char* U8, float* PART, int lane, int wave) {
    const int gidx = lane >> 3, c16 = (lane & 7) * 16;
#pragma unroll 1
    for (int it = 0; it < 8; ++it) {
        const int t = j * 64 + it * 8 + wave;
        int e[16];
#pragma unroll
        for (int q = 0; q < 4; ++q) { const int4 ev = *(const int4*)(IDX + (size_t)t * 128 + 16 * gidx + 4 * q); e[4 * q] = ev.x; e[4 * q + 1] = ev.y; e[4 * q + 2] = ev.z; e[4 * q + 3] = ev.w; }
        uint4 uu[16];
#pragma unroll
        for (int i = 0; i < 16; ++i) uu[i] = *(const uint4*)(U8 + (size_t)e[i] * D + p * 128 + c16);
        float xv[16];
        { const bf16* xr = XN2B + (size_t)t * D + p * 128 + c16; const uint4 w0 = *(const uint4*)xr, w1 = *(const uint4*)(xr + 8);
          const unsigned ww[8] = {w0.x, w0.y, w0.z, w0.w, w1.x, w1.y, w1.z, w1.w};
#pragma unroll
          for (int q = 0; q < 8; ++q) { xv[2 * q] = __uint_as_float(ww[q] << 16); xv[2 * q + 1] = __uint_as_float(ww[q] & 0xffff0000u); } }
        float d[16];
#pragma unroll
        for (int i = 0; i < 16; ++i) { float f[16]; fp8x16_to_f32(uu[i], f); float s = 0.f;
#pragma unroll
            for (int c = 0; c < 16; ++c) s += f[c] * xv[c];
            d[i] = s; }
        float r0, r1; treduce16<4, 2, 1>(d, lane, r0, r1);
        *(float2*)(PART + ((size_t)p * T + t) * 128 + 2 * lane) = make_float2(r0, r1);
    }
}
__device__ __forceinline__ void peer_v_item(int p, int j, const int* IDX, const float* ACT, const unsigned char* V8, float* PEERO, int lane, int wave) {
    const int gidx = lane >> 3, c16 = (lane & 7) * 16;
#pragma unroll 1
    for (int it = 0; it < 8; ++it) {
        const int t = j * 64 + it * 8 + wave;
        int e[16]; float ac[16];
#pragma unroll
        for (int q = 0; q < 4; ++q) {
            const int4 ev = *(const int4*)(IDX + (size_t)t * 128 + 16 * gidx + 4 * q); const float4 av = *(const float4*)(ACT + (size_t)t * 128 + 16 * gidx + 4 * q);
            e[4 * q] = ev.x; e[4 * q + 1] = ev.y; e[4 * q + 2] = ev.z; e[4 * q + 3] = ev.w; ac[4 * q] = av.x; ac[4 * q + 1] = av.y; ac[4 * q + 2] = av.z; ac[4 * q + 3] = av.w;
        }
        uint4 vv[16];
#pragma unroll
        for (int i = 0; i < 16; ++i) vv[i] = *(const uint4*)(V8 + (size_t)e[i] * D + p * 128 + c16);
        float acc[16];
#pragma unroll
        for (int c = 0; c < 16; ++c) acc[c] = 0.f;
#pragma unroll
        for (int i = 0; i < 16; ++i) { float f[16]; fp8x16_to_f32(vv[i], f);
#pragma unroll
            for (int c = 0; c < 16; ++c) acc[c] += ac[i] * f[c]; }
        float r0, r1; treduce16<32, 16, 8>(acc, lane, r0, r1);
        *(float2*)(PEERO + (size_t)t * D + p * 128 + c16 + 2 * gidx) = make_float2(r0, r1);
    }
}

__device__ __forceinline__ void ce_desc(float& a, float& b) { const float hi = fmaxf(a, b), lo = fminf(a, b); a = hi; b = lo; }
__device__ __forceinline__ void sort16_desc(float (&v)[16]) {
#pragma unroll
    for (int k = 2; k <= 16; k <<= 1)
#pragma unroll
        for (int j = k >> 1; j > 0; j >>= 1)
#pragma unroll
            for (int i = 0; i < 16; ++i) { const int l = i ^ j; if (l > i) { if ((i & k) == 0) ce_desc(v[i], v[l]); else ce_desc(v[l], v[i]); } }
}
__device__ __forceinline__ void merge16_desc(float (&a)[16], const float (&b)[16]) {
#pragma unroll
    for (int i = 0; i < 16; ++i) a[i] = fmaxf(a[i], b[15 - i]);
#pragma unroll
    for (int j = 8; j > 0; j >>= 1)
#pragma unroll
        for (int i = 0; i < 16; ++i) { const int l = i ^ j; if (l > i) ce_desc(a[i], a[l]); }
}
__device__ __forceinline__ void ce_kv(float& ka, int& va, float& kb, int& vb) {
    const bool s = kb > ka; const float t0 = s ? kb : ka, t1 = s ? ka : kb; const int u0 = s ? vb : va, u1 = s ? va : vb; ka = t0; kb = t1; va = u0; vb = u1; }
__device__ __forceinline__ void sort16_kv(float (&k)[16], int (&v)[16]) {
#pragma unroll
    for (int kk = 2; kk <= 16; kk <<= 1)
#pragma unroll
        for (int j = kk >> 1; j > 0; j >>= 1)
#pragma unroll
            for (int i = 0; i < 16; ++i) { const int l = i ^ j; if (l > i) { if ((i & kk) == 0) ce_kv(k[i], v[i], k[l], v[l]); else ce_kv(k[l], v[l], k[i], v[i]); } }
}
__device__ __forceinline__ void merge16_kv(float (&ka)[16], int (&va)[16], const float (&kb)[16], const int (&vb)[16]) {
#pragma unroll
    for (int i = 0; i < 16; ++i) { const bool s = kb[15 - i] > ka[i]; ka[i] = s ? kb[15 - i] : ka[i]; va[i] = s ? vb[15 - i] : va[i]; }
#pragma unroll
    for (int j = 8; j > 0; j >>= 1)
#pragma unroll
        for (int i = 0; i < 16; ++i) { const int l = i ^ j; if (l > i) ce_kv(ka[i], va[i], ka[l], va[l]); }
}
__device__ __forceinline__ void split8(const float* p, bf16x8& hi8, bf16x8& lo8) {
    const float4 f0 = *(const float4*)p, f1 = *(const float4*)(p + 4);
    const float x[8] = {f0.x, f0.y, f0.z, f0.w, f1.x, f1.y, f1.z, f1.w};
#pragma unroll
    for (int j = 0; j < 8; ++j) { const short h = bfs(x[j]); hi8[j] = h; lo8[j] = bfs(x[j] - sbf2f(h)); }
}
__device__ __forceinline__ void route_task(int task, const float* QP, const bf16* KH, const bf16* KL, int* IDX, float* GATE, int lane) {
    const int r = lane & 31, hi = lane >> 5, t = 4 * task + (r >> 3), head = r & 7;
    float top[2][16];
#pragma unroll
    for (int half = 0; half < 2; ++half) {
        bf16x8 qh[4], ql[4];
#pragma unroll
        for (int ks = 0; ks < 4; ++ks) split8(QP + (size_t)t * D + head * 128 + half * 64 + 16 * ks + 8 * hi, qh[ks], ql[ks]);
        float cur[16];
#pragma unroll
        for (int kt = 0; kt < 4; ++kt) {
            f32x16 X = zero16();
            const bf16* khp = KH + (size_t)(half * 128 + 32 * kt + r) * 64 + 8 * hi; const bf16* klp = KL + (size_t)(half * 128 + 32 * kt + r) * 64 + 8 * hi;
            asm volatile("" : "+v"(khp), "+v"(klp));
#pragma unroll
            for (int ks = 0; ks < 4; ++ks) {
                const bf16x8 kh = ldg8(khp + 16 * ks), kl = ldg8(klp + 16 * ks);
                X = MFMA32(kh, qh[ks], X); X = MFMA32(kh, ql[ks], X); X = MFMA32(kl, qh[ks], X);
            }
            float grp[16];
#pragma unroll
            for (int i = 0; i < 16; ++i) { const unsigned key = (unsigned)(32 * kt + crow(i, hi)); grp[i] = __uint_as_float((__float_as_uint(X[i]) & ~127u) | (127u - key)); }
            sort16_desc(grp);
            if (kt == 0) {
#pragma unroll
                for (int i = 0; i < 16; ++i) cur[i] = grp[i];
            } else merge16_desc(cur, grp);
        }
        float oth[16];
#pragma unroll
        for (int i = 0; i < 16; ++i) oth[i] = __shfl_xor(cur[i], 32);
        merge16_desc(cur, oth);
#pragma unroll
        for (int i = 0; i < 16; ++i) top[half][i] = cur[i];
    }
    unsigned P1[4], P2[4];
#pragma unroll
    for (int q = 0; q < 4; ++q) { P1[q] = 0u; P2[q] = 0u;
#pragma unroll
        for (int s = 0; s < 4; ++s) { P1[q] |= (127u - (__float_as_uint(top[0][4 * q + s]) & 127u)) << (8 * s); P2[q] |= (127u - (__float_as_uint(top[1][4 * q + s]) & 127u)) << (8 * s); } }
#define CAND(a, b) __uint_as_float((__float_as_uint(top[0][a] + top[1][b]) & ~255u) | (255u - (unsigned)((a) * 16 + (b))))
    float bk[16];
    {
        float gk[16];
        gk[0] = CAND(0, 0);
        gk[1] = CAND(0, 1);
        gk[2] = CAND(0, 2);
        gk[3] = CAND(0, 3);
        gk[4] = CAND(0, 4);
        gk[5] = CAND(0, 5);
        gk[6] = CAND(0, 6);
        gk[7] = CAND(0, 7);
        gk[8] = CAND(0, 8);
        gk[9] = CAND(0, 9);
        gk[10] = CAND(0, 10);
        gk[11] = CAND(0, 11);
        gk[12] = CAND(0, 12);
        gk[13] = CAND(0, 13);
        gk[14] = CAND(0, 14);
        gk[15] = CAND(0, 15);
        sort16_desc(gk);
#pragma unroll
        for (int i = 0; i < 16; ++i) bk[i] = gk[i];
    }
    {
        float gk[16];
        gk[0] = CAND(1, 0);
        gk[1] = CAND(1, 1);
        gk[2] = CAND(1, 2);
        gk[3] = CAND(1, 3);
        gk[4] = CAND(1, 4);
        gk[5] = CAND(1, 5);
        gk[6] = CAND(1, 6);
        gk[7] = CAND(1, 7);
        gk[8] = CAND(2, 0);
        gk[9] = CAND(2, 1);
        gk[10] = CAND(2, 2);
        gk[11] = CAND(2, 3);
        gk[12] = CAND(2, 4);
        gk[13] = CAND(3, 0);
        gk[14] = CAND(3, 1);
        gk[15] = CAND(3, 2);
        sort16_desc(gk);
        merge16_desc(bk, gk);
    }
    {
        float gk[16];
        gk[0] = CAND(3, 3);
        gk[1] = CAND(4, 0);
        gk[2] = CAND(4, 1);
        gk[3] = CAND(4, 2);
        gk[4] = CAND(5, 0);
        gk[5] = CAND(5, 1);
        gk[6] = CAND(6, 0);
        gk[7] = CAND(6, 1);
        gk[8] = CAND(7, 0);
        gk[9] = CAND(7, 1);
        gk[10] = CAND(8, 0);
        gk[11] = CAND(9, 0);
        gk[12] = CAND(10, 0);
        gk[13] = CAND(11, 0);
        gk[14] = CAND(12, 0);
        gk[15] = CAND(13, 0);
        sort16_desc(gk);
        merge16_desc(bk, gk);
    }
    {
        float gk[16];
        gk[0] = CAND(14, 0);
        gk[1] = CAND(15, 0);
        gk[2] = -INFINITY;
        gk[3] = -INFINITY;
        gk[4] = -INFINITY;
        gk[5] = -INFINITY;
        gk[6] = -INFINITY;
        gk[7] = -INFINITY;
        gk[8] = -INFINITY;
        gk[9] = -INFINITY;
        gk[10] = -INFINITY;
        gk[11] = -INFINITY;
        gk[12] = -INFINITY;
        gk[13] = -INFINITY;
        gk[14] = -INFINITY;
        gk[15] = -INFINITY;
        sort16_desc(gk);
        merge16_desc(bk, gk);
    }
#undef CAND
    int bv[16];
#pragma unroll
    for (int i = 0; i < 16; ++i) {
        const unsigned cd = 255u - (__float_as_uint(bk[i]) & 255u), ca = cd >> 4, cb = cd & 15u;
        const unsigned wa = (ca >> 2) == 0u ? P1[0] : (ca >> 2) == 1u ? P1[1] : (ca >> 2) == 2u ? P1[2] : P1[3];
        const unsigned wb = (cb >> 2) == 0u ? P2[0] : (cb >> 2) == 1u ? P2[1] : (cb >> 2) == 2u ? P2[2] : P2[3];
        bv[i] = (int)((((wa >> (8u * (ca & 3u))) & 255u) << 7) | ((wb >> (8u * (cb & 3u))) & 255u));
    }
    float e[16], se = 0.f;
#pragma unroll
    for (int i = 0; i < 16; ++i) { e[i] = __expf(bk[i] - bk[0]); se += e[i]; }
    const float inv = 1.f / se;
    if (hi == 0) {
        int4* ip = (int4*)(IDX + (size_t)t * 128 + head * 16); float4* gp = (float4*)(GATE + (size_t)t * 128 + head * 16);
#pragma unroll
        for (int q = 0; q < 4; ++q) { ip[q] = make_int4(bv[4 * q], bv[4 * q + 1], bv[4 * q + 2], bv[4 * q + 3]); gp[q] = make_float4(e[4 * q] * inv, e[4 * q + 1] * inv, e[4 * q + 2] * inv, e[4 * q + 3] * inv); }
    }
}

#define XB_TMO      128
#define XB_XCNT(j)  (256  + 64 * (j))
#define XB_XSUB(j)  (1280 + 64 * (j))
#define XB_XGEN(j)  (2304 + 64 * (j))
#define XB_TOP      3328
#define XB_TOPGEN   3392
#define XCD_BAR_WORDS 3456
#define XB_SPIN_CAP (1u << 22)
__device__ __forceinline__ unsigned xb_ld(unsigned* p)              { return __hip_atomic_load(p, __ATOMIC_RELAXED, __HIP_MEMORY_SCOPE_AGENT); }
__device__ __forceinline__ unsigned xb_add(unsigned* p, unsigned v) { return __hip_atomic_fetch_add(p, v, __ATOMIC_RELAXED, __HIP_MEMORY_SCOPE_AGENT); }
__device__ __forceinline__ unsigned xb_xcc_id() { return (unsigned)__builtin_amdgcn_s_getreg((3 << 11) | 20) & 0xFu; }
#define XB_SPIN(cond, bar) do { unsigned _sp = 0; while (cond) { __builtin_amdgcn_s_sleep(1); \
    if ((++_sp & 255u) == 0u) { if (xb_ld(&(bar)[XB_TMO])) break; if (_sp > XB_SPIN_CAP) { atomicAdd(&(bar)[XB_TMO], 1u); break; } } } } while (0)
struct XcdBarrier { unsigned* bar; unsigned x; volatile LAS unsigned* st; };
__device__ __forceinline__ XcdBarrier xcd_barrier_post(unsigned* bar, volatile LAS unsigned* st) {
    XcdBarrier b; b.bar = bar; b.x = xb_xcc_id(); b.st = st;
    if (threadIdx.x == 0) (void)xb_add(&bar[XB_XCNT(b.x)], 1u);
    return b;
}
__device__ __forceinline__ void xcd_barrier_complete(unsigned* bar, unsigned x, unsigned& nloc, unsigned& nx) {
    const unsigned G = gridDim.x * gridDim.y * gridDim.z;
    unsigned sum, cnt, mine, sp = 0u;
    for (;;) {
        sum = 0u; cnt = 0u; mine = 0u;
#pragma unroll
        for (unsigned j = 0; j < 16; ++j) { const unsigned c = xb_ld(&bar[XB_XCNT(j)]); sum += c; cnt += (c > 0u) ? 1u : 0u; mine = (j == x) ? c : mine; }
        if (sum == G) break;
        __builtin_amdgcn_s_sleep(1);
        if ((++sp & 255u) == 0u) { if (xb_ld(&bar[XB_TMO])) break; if (sp > XB_SPIN_CAP) { atomicAdd(&bar[XB_TMO], 1u); break; } }
    }
    nloc = mine > 0u ? mine : 1u; nx = cnt > 0u ? cnt : 1u;
}
__device__ __forceinline__ void xcd_barrier(const XcdBarrier& b) {
    asm volatile("s_waitcnt vmcnt(0)" ::: "memory");
    __syncthreads();
    if (threadIdx.x == 0) {
        unsigned* bar = b.bar;
        __builtin_amdgcn_s_waitcnt(0);
        unsigned nloc = b.st[0], nx = b.st[1];
        if (nloc == 0u) { xcd_barrier_complete(bar, b.x, nloc, nx); b.st[0] = nloc; b.st[1] = nx; }
        const unsigned old = xb_add(&bar[XB_XSUB(b.x)], 1u);
        const unsigned gen = old / nloc;
        if (old + 1u == (gen + 1u) * nloc) {
            __builtin_amdgcn_fence(__ATOMIC_RELEASE, "agent");
            asm volatile("s_waitcnt vmcnt(0)" ::: "memory");
            const unsigned og = xb_add(&bar[XB_TOP], 1u);
            const unsigned tg = og / nx;
            if (og + 1u == (tg + 1u) * nx) xb_add(&bar[XB_TOPGEN], 1u);
            else XB_SPIN(xb_ld(&bar[XB_TOPGEN]) == tg, bar);
            __builtin_amdgcn_fence(__ATOMIC_ACQUIRE, "agent");
            xb_add(&bar[XB_XGEN(b.x)], 1u);
            asm volatile("s_waitcnt vmcnt(0)" ::: "memory");
        } else {
            XB_SPIN(xb_ld(&bar[XB_XGEN(b.x)]) == gen, bar);
            __builtin_amdgcn_fence(__ATOMIC_ACQUIRE, "agent");
            asm volatile("s_waitcnt vmcnt(0)" ::: "memory");
        }
    }
    __syncthreads();
}
constexpr int LDS_BYTES = 147456;
constexpr int MISC_OFF = 131072 + 320;

__global__ void __launch_bounds__(NTHR, 2) k_main(Args a) {
    extern __shared__ __attribute__((aligned(16))) unsigned char lds_raw[];
    LAS unsigned char* ldsb = (LAS unsigned char*)lds_raw;
    const int tid = threadIdx.x, lane = tid & 63, bid = blockIdx.x, nb = gridDim.x;
    const int wave = __builtin_amdgcn_readfirstlane(tid >> 6);
    const int gtid = bid * NTHR + tid, gthreads = nb * NTHR, gwave = gtid >> 6, nwaves = gthreads >> 6;
    unsigned char* ws = a.ws;
    bf16* WINT = (bf16*)(ws + WS_WIN); bf16* WOT = (bf16*)(ws + WS_WO); bf16* WQT = (bf16*)(ws + WS_WQ);
    bf16* PROJ = (bf16*)(ws + WS_PROJ);
    bf16* XNB = (bf16*)(ws + WS_XNB);
    bf16* XACT = (bf16*)(ws + WS_XACT);
    float* DTRAW = (float*)(ws + WS_DTRAW); float* DT = (float*)(ws + WS_DT); float* ACS = (float*)(ws + WS_ACS); float* CDEC = (float*)(ws + WS_CDEC);
    float* STATES = (float*)(ws + WS_STATES); bf16* PREVT = (bf16*)(ws + WS_PREV);
    float* QP = (float*)(ws + WS_QP); int* IDX = (int*)(ws + WS_IDX); float* GATE = (float*)(ws + WS_GATE);
    float* TOPV = (float*)(ws + WS_TOPV); int* TOPI = (int*)(ws + WS_TOPI);
    unsigned char* U8 = ws + WS_U8; unsigned char* V8 = ws + WS_V8; float* SU = (float*)(ws + WS_SU); float* SV = SU + 16384; float* PART = (float*)(ws + WS_PART);
    bf16* KH = (bf16*)(ws + WS_KH); bf16* KL = (bf16*)(ws + WS_KH + 65536);
    float* MIXF = a.out;
    volatile LAS unsigned* MISC = (volatile LAS unsigned*)(ldsb + MISC_OFF);
    if (tid < 32) MISC[tid] = 0u;
    __syncthreads();
    XcdBarrier bar = xcd_barrier_post((unsigned*)ws, MISC + 8);
#define IN(k) (a.ph_lo <= (k) && (k) < a.ph_hi)
#if defined(PROBE_LO)
    int seg_ = 0; unsigned long long tseg_ = __builtin_amdgcn_s_memrealtime();
#define PROBE_SPIN() do { if (seg_ >= PROBE_LO && seg_ <= PROBE_HI) { const unsigned long long d_ = (__builtin_amdgcn_s_memrealtime() - tseg_) * PROBE_AMP; const unsigned long long s_ = __builtin_amdgcn_s_memrealtime(); \
        while (__builtin_amdgcn_s_memrealtime() - s_ < d_) __builtin_amdgcn_s_sleep(4); } } while (0)
#define GRID_BAR() do { PROBE_SPIN(); xcd_barrier(bar); tseg_ = __builtin_amdgcn_s_memrealtime(); ++seg_; } while (0)
#else
#define PROBE_SPIN() do { } while (0)
#define GRID_BAR() xcd_barrier(bar)
#endif

    if (IN(0)) {
        LAS float* scr = (LAS float*)(ldsb + wave * 16384);
        constexpr int I_IN = 16 * 72, I_O = 16 * 32, NITEMS = I_IN + 2 * I_O;
        for (int it = gwave; it < NITEMS; it += nwaves) {
            int r = it;
            if (r < I_IN) { transpose_item(a.w_in, PW, D, WINT, scr, r / 72, r % 72, lane); continue; } r -= I_IN;
            if (r < I_O) { transpose_item(a.w_out, D, D, WOT, scr, r / 32, r % 32, lane); continue; } r -= I_O;
            transpose_item(a.peer_wq, D, D, WQT, scr, r / 32, r % 32, lane);
        }
        for (int i = gtid; i < 2 * 128 * 64; i += gthreads) { const float kf = a.peer_sub_keys[i]; const short h = bfs(kf); KH[i] = (bf16)h; KL[i] = (bf16)bfs(kf - sbf2f(h)); }
        rmsnorm_rows_bf16<true>(a.x, a.norm_mix_g, XNB, a.w_in, DTRAW, gwave, nwaves, lane);
    }
    GRID_BAR();
    if (IN(1)) {
        pg8::Gemm g{XNB, WINT, T, PS, D}; pg8::StaticOrder S; S.init(T, PS, nb, bid);
        pg8::EpiBf16Plain E{PROJ, PS};
        pg8::gemm_phase<pg8::EpiBf16Plain, pg8::StaticOrder>(ldsb, g, S, E, nullptr);
    }
    GRID_BAR();
    if (IN(2)) {
        for (int idx = gtid; idx < T * 1024; idx += gthreads) {
            const int t = idx >> 10, c = idx & 1023, s = t & (SEQ - 1);
            float acc = a.conv_b[c];
#pragma unroll
            for (int k = 0; k < 4; ++k) { const int sp = s + k - 3; if (sp >= 0) acc += a.conv_w[k * 1024 + c] * bf2f(PROJ[(size_t)(t + k - 3) * PS + OXBC + c]); }
            XACT[idx] = f2bf(silu_f(acc));
        }
        if (gwave < 1024) {
            const int h = gwave & 7, bc = gwave >> 3;
            const float A = -__expf(a.a_log[h]), bias = a.dt_bias[h];
            const int t0 = bc * 128 + lane, t1 = t0 + 64;
            const float raw0 = DTRAW[t0 * 8 + h] + bias, raw1 = DTRAW[t1 * 8 + h] + bias;
            const float dt0 = fmaxf(raw0, 0.f) + log1pf(__expf(-fabsf(raw0))), dt1 = fmaxf(raw1, 0.f) + log1pf(__expf(-fabsf(raw1)));
            DT[t0 * 8 + h] = dt0; DT[t1 * 8 + h] = dt1;
            float v0 = dt0 * A, v1 = dt1 * A;
#pragma unroll
            for (int o = 1; o < 64; o <<= 1) { const float y0 = __shfl_up(v0, o), y1 = __shfl_up(v1, o); if (lane >= o) { v0 += y0; v1 += y1; } }
            v1 += __shfl(v0, 63);
            ACS[t0 * 8 + h] = v0; ACS[t1 * 8 + h] = v1;
            if (lane == 63) CDEC[gwave] = __expf(v1);
        }
    }
    GRID_BAR();
    if (IN(3)) {
        for (int u = bid; u < 512; u += nb) {
            if (u < 256) attn_unit(a.attn_sinks, ldsb, u, PROJ, MIXF, tid, lane, wave);
            else ssd_chunk_unit(ldsb, u - 256, XACT, DT, ACS, MIXF, STATES, tid, lane, wave);
        }
    }
    GRID_BAR();
    if (IN(5)) {
        for (int idx = gtid; idx < 2 * 8 * 8192; idx += gthreads) {
            const int pn = idx & 8191, h = (idx >> 13) & 7, b = idx >> 16;
            float run = 0.f;
#pragma unroll 1
            for (int c0 = 0; c0 < 64; c0 += 8) {
                float st[8], dc[8];
#pragma unroll
                for (int j = 0; j < 8; ++j) { const int bch = (b * 64 + c0 + j) * 8 + h; st[j] = STATES[(size_t)bch * 8192 + pn]; dc[j] = CDEC[bch]; }
#pragma unroll
                for (int j = 0; j < 8; ++j) { const int bch = (b * 64 + c0 + j) * 8 + h; PREVT[(size_t)bch * 8192 + pn] = f2bf(run); run = dc[j] * run + st[j]; }
            }
        }
    }
    GRID_BAR();
    if (IN(6)) {
        for (int u = bid; u < 256; u += nb) yoff_unit(a.d_skip, u, XACT, PROJ, ACS, PREVT, MIXF, lane, wave);
    }
    GRID_BAR();
    if (IN(6)) {
        for (int t = gwave; t < T; t += nwaves) {
            const float* row = MIXF + (size_t)t * D;
            const float4 a0 = *(const float4*)(row + 8 * lane), a1 = *(const float4*)(row + 8 * lane + 4);
            const float4 s0 = *(const float4*)(row + 512 + 8 * lane), s1 = *(const float4*)(row + 512 + 8 * lane + 4);
            float ssa = a0.x * a0.x + a0.y * a0.y + a0.z * a0.z + a0.w * a0.w + a1.x * a1.x + a1.y * a1.y + a1.z * a1.z + a1.w * a1.w;
            float sss = s0.x * s0.x + s0.y * s0.y + s0.z * s0.z + s0.w * s0.w + s1.x * s1.x + s1.y * s1.y + s1.z * s1.z + s1.w * s1.w;
            ssa = wave_sum(ssa);
#pragma unroll
            for (int o = 1; o < 32; o <<= 1) sss += __shfl_xor(sss, o);
            const float ra = rsqrtf(ssa * (1.f / 512.f) + EPS), rs = rsqrtf(sss * (1.f / 256.f) + EPS);
            const float4 ga0 = *(const float4*)(a.attn_out_g + 8 * lane), ga1 = *(const float4*)(a.attn_out_g + 8 * lane + 4);
            const float4 gs0 = *(const float4*)(a.ssm_norm_g + 8 * lane), gs1 = *(const float4*)(a.ssm_norm_g + 8 * lane + 4);
            v4u oa, os;
            oa.x = pkbf(a0.x * ra * ga0.x, a0.y * ra * ga0.y); oa.y = pkbf(a0.z * ra * ga0.z, a0.w * ra * ga0.w); oa.z = pkbf(a1.x * ra * ga1.x, a1.y * ra * ga1.y); oa.w = pkbf(a1.z * ra * ga1.z, a1.w * ra * ga1.w);
            os.x = pkbf(s0.x * rs * gs0.x, s0.y * rs * gs0.y); os.y = pkbf(s0.z * rs * gs0.z, s0.w * rs * gs0.w); os.z = pkbf(s1.x * rs * gs1.x, s1.y * rs * gs1.y); os.w = pkbf(s1.z * rs * gs1.z, s1.w * rs * gs1.w);
            *(v4u*)(XNB + (size_t)t * D + 8 * lane) = oa; *(v4u*)(XNB + (size_t)t * D + 512 + 8 * lane) = os;
        }
    }
    GRID_BAR();
    if (IN(7)) {
        pg8::Gemm g{XNB, WOT, T, D, D}; pg8::StaticOrder S; S.init(T, D, nb, bid);
        pg8::EpiF32Resid E{a.out, a.x, D};
        pg8::gemm_phase<pg8::EpiF32Resid, pg8::StaticOrder>(ldsb, g, S, E, nullptr);
    }
    GRID_BAR();
    if (IN(8)) {
        rmsnorm_rows_bf16<false>(a.out, a.norm_ffn_g, XNB, nullptr, nullptr, gwave, nwaves, lane);
        for (int rr = gwave; rr < 2 * 16384; rr += nwaves) {
            const int which = rr >> 14, row = rr & 16383;
            const float4* src4 = (const float4*)((which ? a.peer_v : a.peer_u) + (size_t)row * D) + lane;
            float4 v[4]; float mx = 0.f;
#pragma unroll
            for (int jq = 0; jq < 4; ++jq) { v[jq] = src4[64 * jq]; mx = fmaxf(mx, fmaxf(fmaxf(fabsf(v[jq].x), fabsf(v[jq].y)), fmaxf(fabsf(v[jq].z), fabsf(v[jq].w)))); }
#pragma unroll
            for (int o = 1; o < 64; o <<= 1) mx = fmaxf(mx, __shfl_xor(mx, o));
            const float sc = mx > 0.f ? mx * (1.f / 240.f) : 1.f, inv = 1.f / sc;
            unsigned* dst = (unsigned*)((which ? V8 : U8) + (size_t)row * D) + lane;
#pragma unroll
            for (int jq = 0; jq < 4; ++jq) { int w = __builtin_amdgcn_cvt_pk_fp8_f32(v[jq].x * inv, v[jq].y * inv, 0, false); w = __builtin_amdgcn_cvt_pk_fp8_f32(v[jq].z * inv, v[jq].w * inv, w, true); dst[64 * jq] = (unsigned)w; }
            if (lane == 0) (which ? SV : SU)[row] = sc;
        }
    }
    GRID_BAR();
    if (IN(9)) {
        pg8::Gemm g{XNB, WQT, T, D, D}; pg8::StaticOrder S; S.init(T, D, nb, bid);
        pg8::EpiF32Resid E{QP, nullptr, D};
        pg8::gemm_phase<pg8::EpiF32Resid, pg8::StaticOrder>(ldsb, g, S, E, nullptr);
    }
    GRID_BAR();
    if (IN(10)) {
        for (int task = gwave; task < T / 4; task += nwaves) route_task(task, QP, KH, KL, IDX, GATE, lane);
    }
    GRID_BAR();
    float* ACT = (float*)(ws + WS_ACT); float* PEERO = (float*)(ws + WS_PEERO);
    unsigned* ctl = (unsigned*)ws;
    const int xcc = (int)(bar.x & 7u);
    if (IN(12)) {
#pragma unroll 1
        for (int pi = 0; pi < NPART; ++pi) {
            const int p = (xcc + pi) & 7;
            for (;;) {
                if (tid == 0) MISC[16] = xb_add(&ctl[CW_QU + 64 * p], 1u);
                __syncthreads();
                const int j = (int)MISC[16];
                __syncthreads();
                if (j >= NCHUNK) break;
                peer_u_item(p, j, IDX, XNB, U8, PART, lane, wave);
            }
        }
    }
    GRID_BAR();
    if (IN(12)) {
        for (int i = gtid; i < T * 128; i += gthreads) {
            float s = 0.f;
#pragma unroll
            for (int pp = 0; pp < NPART; ++pp) s += PART[(size_t)pp * T * 128 + i];
            const int e = IDX[i]; const float z = s * SU[e];
            ACT[i] = GATE[i] * 0.5f * z * (1.f + erff(z * 0.70710678118654752f)) * SV[e];
        }
    }
    GRID_BAR();
    if (IN(13)) {
#pragma unroll 1
        for (int pi = 0; pi < NPART; ++pi) {
            const int p = (xcc + pi) & 7;
            for (;;) {
                if (tid == 0) MISC[16] = xb_add(&ctl[CW_QV + 64 * p], 1u);
                __syncthreads();
                const int j = (int)MISC[16];
                __syncthreads();
                if (j >= NCHUNK) break;
                peer_v_item(p, j, IDX, ACT, V8, PEERO, lane, wave);
            }
        }
    }
    GRID_BAR();
    if (IN(14)) {
        for (int t = gwave; t < T; t += nwaves) {
            const float4* hr = (const float4*)(a.out + (size_t)t * D) + lane; const float4* pr = (const float4*)(PEERO + (size_t)t * D) + lane;
            float4 v[4]; float ss = 0.f;
#pragma unroll
            for (int jq = 0; jq < 4; ++jq) { const float4 h4 = hr[64 * jq], p4 = pr[64 * jq]; v[jq] = make_float4(h4.x + p4.x, h4.y + p4.y, h4.z + p4.z, h4.w + p4.w); ss += v[jq].x * v[jq].x + v[jq].y * v[jq].y + v[jq].z * v[jq].z + v[jq].w * v[jq].w; }
            ss = wave_sum(ss);
            const float r3 = rsqrtf(ss * (1.f / D) + EPS);
            float4* op = (float4*)(a.out + (size_t)t * D) + lane;
#pragma unroll
            for (int jq = 0; jq < 4; ++jq) { const float4 gv = ((const float4*)a.final_norm_g)[lane + 64 * jq]; op[64 * jq] = make_float4(v[jq].x * r3 * gv.x, v[jq].y * r3 * gv.y, v[jq].z * r3 * gv.z, v[jq].w * r3 * gv.w); }
        }
    }
    PROBE_SPIN();
#undef IN
}
}

extern "C" void kernel_launch(void* const* d_in, const int* in_sizes, int n_in, void* d_out, int out_size, void* d_ws, size_t ws_size, hipStream_t stream) {
    if (n_in != 18 || out_size != T * D || ws_size < WS_END) { fprintf(stderr, "kernel_launch: unexpected shapes n_in=%d out=%d ws=%zu\n", n_in, out_size, ws_size); return; }
    Args a{};
    const float** ap = (const float**)&a;
    for (int i = 0; i < 18; ++i) ap[i] = (const float*)d_in[i];
    a.out = (float*)d_out; a.ws = (unsigned char*)d_ws;
    static int grid = 0;
    if (grid == 0) {
        int dev = 0, cus = 0, per_cu = 0;
        if (hipGetDevice(&dev) != hipSuccess || hipDeviceGetAttribute(&cus, hipDeviceAttributeMultiprocessorCount, dev) != hipSuccess) { fprintf(stderr, "kernel_launch: device query failed\n"); grid = -1; return; }
        if (hipFuncSetAttribute((const void*)k_main, hipFuncAttributeMaxDynamicSharedMemorySize, LDS_BYTES) != hipSuccess) { fprintf(stderr, "kernel_launch: hipFuncSetAttribute failed\n"); grid = -1; return; }
        if (hipOccupancyMaxActiveBlocksPerMultiprocessor(&per_cu, (const void*)k_main, NTHR, LDS_BYTES) != hipSuccess || per_cu < 1) { fprintf(stderr, "kernel_launch: occupancy query says %d blocks/CU\n", per_cu); (void)hipGetLastError(); grid = -1; return; }
        grid = cus;
    }
    if (grid < 0) return;
    if (hipMemsetAsync(d_ws, 0, 65536, stream) != hipSuccess) { fprintf(stderr, "kernel_launch: memset failed\n"); return; }
    a.ph_lo = 0; a.ph_hi = 15;
    hipLaunchKernelGGL(k_main, dim3(grid), dim3(NTHR), LDS_BYTES, stream, a);
}
```

```cpp
#include <hip/hip_runtime.h>
#include <cstdio>
#include <cstdint>

namespace pg8 {
#define PG8_LAS __attribute__((address_space(3)))
typedef unsigned short bf16_t;
typedef short bf16x8 __attribute__((ext_vector_type(8)));
typedef float f32x4 __attribute__((ext_vector_type(4)));
typedef unsigned u32x4 __attribute__((ext_vector_type(4)));
constexpr int BM = 256, BK = 64, HALF = 128, HTB = HALF * BK * 2  , STAGE_BYTES = 8 * HTB, NXCD = 8, WGM = 8;

__host__ __device__ __forceinline__ int lds_byte(int r, int c) { const int st = (r >> 4) * 2 + (c >> 5), rr = r & 15, cc = c & 31, ob = rr * 64 + cc * 2; return st * 1024 + (ob ^ (((ob >> 9) & 1) << 5)); }
__host__ __device__ __forceinline__ void stage_rc(int b, int& R, int& C) { const int st = b / 1024, sb = b % 1024, swz = sb ^ (((sb >> 9) & 1) << 5); R = (st >> 1) * 16 + swz / 64; C = (st & 1) * 32 + (swz % 64) / 2; }
__host__ __device__ __forceinline__ int perm32(int rho) { const int n = rho >> 4, i = rho & 15; return 8 * (i >> 2) + 4 * n + (i & 3); }

struct Unit { int pm, pn; };
struct Gemm { const bf16_t* A; const bf16_t* Bt; int M, N, K; };

struct StaticOrder {
    int nM, nN, nwg, G, c;
    __host__ __device__ void init(int M, int N, int G_, int c_) { nM = M / BM; nN = N / BM; nwg = nM * nN; G = G_; c = c_; }
    __host__ __device__ bool next(int i, Unit& u) const {
        const long L = (long)i * G + c; if (L >= nwg) return false;
        int wgid = (int)L; { const int q = nwg / NXCD, r = nwg % NXCD, xcd = wgid % NXCD, off = wgid / NXCD; wgid = (xcd < r ? xcd * (q + 1) : r * (q + 1) + (xcd - r) * q) + off; }
        const int nig = WGM * nN, gid = wgid / nig, fm = gid * WGM, gsz = (nM - fm) < WGM ? (nM - fm) : WGM;
        u.pm = fm + ((wgid % nig) % gsz); u.pn = (wgid % nig) / gsz; return true;
    }
    __device__ __forceinline__ void a_ready(const Unit&) const {}
    __device__ __forceinline__ void done(const Unit&) const {}
};
__device__ __forceinline__ unsigned cvt_pk_bf16(float lo, float hi) { unsigned r; asm volatile("v_cvt_pk_bf16_f32 %0, %1, %2" : "=v"(r) : "v"(lo), "v"(hi)); return r; }
typedef float f32x2 __attribute__((ext_vector_type(2)));
struct EpiBf16Plain {
    static constexpr bool PERM = true, AFTER_DRAIN = false;
    bf16_t* O; int ldc;
    __device__ __forceinline__ void operator()(const f32x4 (&acc)[2][2][4][2], const Unit& u, int wr, int wc, int fr, int fq) const {
        const int row0 = u.pm * BM + wr * 64 + fr, col0 = u.pn * BM + wc * 32 + 8 * fq;
#pragma unroll
        for (int ai = 0; ai < 2; ++ai)
#pragma unroll
            for (int m = 0; m < 4; ++m) { bf16_t* rowp = O + (size_t)(row0 + ai * HALF + m * 16) * ldc + col0;
#pragma unroll
                for (int bj = 0; bj < 2; ++bj) { const f32x4 v0 = acc[ai][bj][m][0], v1 = acc[ai][bj][m][1];
                    u32x4 w; w.x = cvt_pk_bf16(v0[0], v0[1]); w.y = cvt_pk_bf16(v0[2], v0[3]); w.z = cvt_pk_bf16(v1[0], v1[1]); w.w = cvt_pk_bf16(v1[2], v1[3]);
                    *(u32x4*)(rowp + bj * HALF) = w; } }
    }
};
struct EpiF32Resid {
    static constexpr bool PERM = false, AFTER_DRAIN = false;
    float* C; const float* R; int ldc;
    __device__ __forceinline__ void operator()(const f32x4 (&acc)[2][2][4][2], const Unit& u, int wr, int wc, int fr, int fq) const {
        const int row0 = u.pm * BM + wr * 64 + fr, col0 = u.pn * BM + wc * 32 + 4 * fq;
#pragma unroll
        for (int ai = 0; ai < 2; ++ai)
#pragma unroll
            for (int m = 0; m < 4; ++m) { const size_t off = (size_t)(row0 + ai * HALF + m * 16) * ldc + col0;
#pragma unroll
                for (int bj = 0; bj < 2; ++bj)
#pragma unroll
                    for (int n = 0; n < 2; ++n) { f32x4 v = acc[ai][bj][m][n]; if (R) v += *(const f32x4*)(R + off + bj * HALF + n * 16); *(f32x4*)(C + off + bj * HALF + n * 16) = v; }
                asm volatile("" ::: "memory"); }
    }
};
template <class Epi, class Sched, bool STAMP = false>
__device__ __forceinline__ void gemm_phase(PG8_LAS unsigned char* lds, const Gemm g, const Sched& S, const Epi& E, unsigned long long* stamps) {
    const int tid = threadIdx.x, wid = __builtin_amdgcn_readfirstlane(tid >> 6), lane = tid & 63, wr = wid >> 2, wc = wid & 3, fr = lane & 15, fq = lane >> 4;
    const int K = g.K, nt = K / BK;
    int ts_lo = 0, ts_hi = 0, nts = 0; const unsigned long long rt_entry = STAMP ? (unsigned long long)0ull : 0ull;
#define PG8_STAMP() do { if (STAMP && wid == 0 && nts < 64) { const unsigned long long _c = (unsigned long long)clock64(); \
        ts_lo = (lane == nts) ? (int)(unsigned)_c : ts_lo; ts_hi = (lane == nts) ? (int)(unsigned)(_c >> 32) : ts_hi; ++nts; } } while (0)
    PG8_STAMP();
    unsigned voffA[2], voffB[2];
#pragma unroll
    for (int i = 0; i < 2; ++i) { int R, C; stage_rc(tid * 16 + i * 8192, R, C); const int Rb = Epi::PERM ? ((R & ~31) + perm32(R & 31)) : R;
        voffA[i] = (unsigned)(R * K + C) * 2u; voffB[i] = (unsigned)(Rb * K + C) * 2u; }
    const size_t kstep = (size_t)(BK * 2);
    const size_t hstep = (size_t)HALF * K * 2;
    const size_t tstep = 2 * hstep;
    const unsigned ldsw = (unsigned)wid * 1024u;
    const int aoff = lds_byte(wr * 64 + fr, fq * 8), boff = lds_byte(wc * 32 + fr, fq * 8);
#define PG8_SA(b, h) (((b) * 2 + (h)) * HTB)
#define PG8_SB(b, h) ((4 + (b) * 2 + (h)) * HTB)
#define PG8_STAGE(bufoff, gbase, voff) do { _Pragma("unroll") for (int _i = 0; _i < 2; ++_i) \
        __builtin_amdgcn_global_load_lds((const unsigned*)((const char*)(gbase) + (voff)[_i]), (PG8_LAS unsigned*)(lds + (bufoff) + ldsw + _i * 8192), 16, 0, 0); } while (0)
#define PG8_LDA(dst, b, h) do { _Pragma("unroll") for (int m = 0; m < 4; ++m) _Pragma("unroll") for (int k = 0; k < 2; ++k) dst[m][k] = *(const PG8_LAS bf16x8*)(lds + PG8_SA(b, h) + aoff + m * 2048 + k * 1024); } while (0)
#define PG8_LDB(dst, b, h) do { _Pragma("unroll") for (int n = 0; n < 2; ++n) _Pragma("unroll") for (int k = 0; k < 2; ++k) dst[n][k] = *(const PG8_LAS bf16x8*)(lds + PG8_SB(b, h) + boff + n * 2048 + k * 1024); } while (0)
#define PG8_MMA(ai, bj, At, Bt) do { __builtin_amdgcn_s_setprio(1); _Pragma("unroll") for (int m = 0; m < 4; ++m) _Pragma("unroll") for (int n = 0; n < 2; ++n) _Pragma("unroll") for (int k = 0; k < 2; ++k) \
        acc[ai][bj][m][n] = __builtin_amdgcn_mfma_f32_16x16x32_bf16(Bt[n][k], At[m][k], acc[ai][bj][m][n], 0, 0, 0); __builtin_amdgcn_s_setprio(0); } while (0)
#define PG8_WAIT_V(n) asm volatile("s_waitcnt vmcnt(" #n ")" ::: "memory")
#define PG8_WAIT_L(n) asm volatile("s_waitcnt lgkmcnt(" #n ")" ::: "memory")
#define PG8_BAR __builtin_amdgcn_s_barrier()
#define PG8_SCHED __builtin_amdgcn_sched_barrier(0)
    Unit cur, nxt; int ui = 0;
    if (!S.next(0, cur)) return;
    f32x4 acc[2][2][4][2];
#pragma unroll
    for (int a = 0; a < 2; ++a)
#pragma unroll
        for (int b = 0; b < 2; ++b)
#pragma unroll
            for (int m = 0; m < 4; ++m)
#pragma unroll
                for (int n = 0; n < 2; ++n) acc[a][b][m][n] = (f32x4){0.f, 0.f, 0.f, 0.f};
    bf16x8 At[4][2], B0[2][2], B1[2][2];
    const char* cA = (const char*)g.A + (size_t)cur.pm * tstep; const char* cB = (const char*)g.Bt + (size_t)cur.pn * tstep;
    S.a_ready(cur);
    PG8_STAGE(PG8_SB(0, 0), cB, voffB); PG8_STAGE(PG8_SA(0, 0), cA, voffA); PG8_STAGE(PG8_SB(0, 1), cB + hstep, voffB); PG8_STAGE(PG8_SA(0, 1), cA + hstep, voffA);
    if (wr == 1) PG8_BAR;
    PG8_WAIT_V(4); PG8_BAR;
    PG8_STAGE(PG8_SB(1, 0), cB + kstep, voffB); PG8_STAGE(PG8_SA(1, 0), cA + kstep, voffA); PG8_STAGE(PG8_SB(1, 1), cB + hstep + kstep, voffB);
    PG8_WAIT_V(6); PG8_BAR;
    PG8_STAMP();
    for (;;) {
        const bool has_next = S.next(ui + 1, nxt);
        const char* nA = has_next ? (const char*)g.A + (size_t)nxt.pm * tstep : cA; const char* nB = has_next ? (const char*)g.Bt + (size_t)nxt.pn * tstep : cB;
        for (int t = 0; t < nt; t += 2) {
            const bool last = (t == nt - 2);
            const char* a1 = cA + (size_t)(t + 1) * kstep;
            const char* a2 = last ? nA : cA + (size_t)(t + 2) * kstep; const char* b2 = last ? nB : cB + (size_t)(t + 2) * kstep;
            const char* a3 = a2 + kstep; const char* b3 = b2 + kstep;
            if (last && has_next) S.a_ready(nxt);
            PG8_LDB(B0, 0, 0); PG8_SCHED; PG8_LDA(At, 0, 0); PG8_STAGE(PG8_SA(1, 1), a1 + hstep, voffA);
            PG8_WAIT_L(8); PG8_BAR; PG8_WAIT_L(0); PG8_MMA(0, 0, At, B0); PG8_BAR; PG8_SCHED;
            PG8_LDB(B1, 0, 1); PG8_STAGE(PG8_SB(0, 0), b2, voffB);
            PG8_BAR; PG8_WAIT_L(0); PG8_MMA(0, 1, At, B1); PG8_BAR;
            PG8_LDA(At, 0, 1); PG8_STAGE(PG8_SA(0, 0), a2, voffA);
            PG8_BAR; PG8_WAIT_L(0); PG8_MMA(1, 0, At, B0); PG8_BAR; PG8_SCHED;
            PG8_STAGE(PG8_SB(0, 1), b2 + hstep, voffB);
            PG8_WAIT_V(6); PG8_BAR; PG8_MMA(1, 1, At, B1); PG8_BAR;
            PG8_LDB(B0, 1, 0); PG8_SCHED; PG8_LDA(At, 1, 0); PG8_STAGE(PG8_SA(0, 1), a2 + hstep, voffA);
            PG8_WAIT_L(8); PG8_BAR; PG8_WAIT_L(0); PG8_MMA(0, 0, At, B0); PG8_BAR; PG8_SCHED;
            PG8_LDB(B1, 1, 1); PG8_STAGE(PG8_SB(1, 0), b3, voffB);
            PG8_BAR; PG8_WAIT_L(0); PG8_MMA(0, 1, At, B1); PG8_BAR;
            PG8_LDA(At, 1, 1); PG8_STAGE(PG8_SA(1, 0), a3, voffA);
            PG8_BAR; PG8_WAIT_L(0); PG8_MMA(1, 0, At, B0); PG8_BAR; PG8_SCHED;
            PG8_STAGE(PG8_SB(1, 1), b3 + hstep, voffB);
            PG8_WAIT_V(6); PG8_BAR; PG8_MMA(1, 1, At, B1); PG8_BAR;
        }
        PG8_STAMP();
        if constexpr (!Epi::AFTER_DRAIN) { E(acc, cur, wr, wc, fr, fq); S.done(cur); }
        PG8_STAMP();
        if (!has_next) break;
#pragma unroll
        for (int a = 0; a < 2; ++a)
#pragma unroll
            for (int b = 0; b < 2; ++b)
#pragma unroll
                for (int m = 0; m < 4; ++m)
#pragma unroll
                    for (int n = 0; n < 2; ++n) acc[a][b][m][n] = (f32x4){0.f, 0.f, 0.f, 0.f};
        cur = nxt; cA = nA; cB = nB; ++ui;
    }
    PG8_WAIT_V(0);
    if (wr == 0) PG8_BAR;
    PG8_BAR;
    if constexpr (Epi::AFTER_DRAIN) { E.fused(acc, cur, wr, wc, fr, fq, lds, wid, lane); S.done(cur); }
    PG8_STAMP();
    if (STAMP && wid == 0) { stamps[lane] = lane < nts ? (((unsigned long long)(unsigned)ts_hi << 32) | (unsigned)ts_lo) : 0ull;
        if (lane == 62) stamps[62] = rt_entry; if (lane == 63) stamps[63] = (unsigned long long)0ull; }
#undef PG8_STAMP
#undef PG8_SA
#undef PG8_SB
#undef PG8_STAGE
#undef PG8_LDA
#undef PG8_LDB
#undef PG8_MMA
#undef PG8_WAIT_V
#undef PG8_WAIT_L
#undef PG8_BAR
#undef PG8_SCHED
}
}

namespace {
constexpr int D = 1024, BATCH = 2, SEQ = 8192, T = BATCH * SEQ;
constexpr int PW = 2312;
constexpr int PS = 2304;
constexpr int OQ = 0, OKK = 512, OV = 640, OZ = 768, OXBC = 1280, ODT = 2304;
constexpr float EPS = 1e-6f;
constexpr int NTHR = 512;
typedef unsigned short bf16;
typedef unsigned v4u __attribute__((ext_vector_type(4)));

constexpr size_t MiB = 1u << 20;
constexpr size_t WS_WIN = 1 * MiB;
constexpr size_t WS_KH = 5 * MiB + 512 * 1024;
constexpr size_t WS_WO = 6 * MiB;
constexpr size_t WS_WQ = 8 * MiB;
constexpr size_t WS_PROJ = 10 * MiB;
constexpr size_t WS_XNB = 82 * MiB;
constexpr size_t WS_XACT = 114 * MiB;
constexpr size_t WS_DTRAW = 146 * MiB;
constexpr size_t WS_DT = WS_DTRAW + 512 * 1024;
constexpr size_t WS_ACS = WS_DT + 512 * 1024;
constexpr size_t WS_CDEC = WS_ACS + 512 * 1024;
constexpr size_t WS_STATES = 164 * MiB;
constexpr size_t WS_PREV = 196 * MiB;
constexpr size_t WS_QP = 10 * MiB;
constexpr size_t WS_IDX = 74 * MiB;
constexpr size_t WS_GATE = 114 * MiB;
constexpr size_t WS_TOPV = 122 * MiB;
constexpr size_t WS_TOPI = 138 * MiB;
constexpr size_t WS_ACT = 122 * MiB;
constexpr size_t WS_SU = 130 * MiB;
constexpr size_t WS_U8 = 132 * MiB;
constexpr size_t WS_V8 = 148 * MiB;
constexpr size_t WS_PART = 164 * MiB;
constexpr size_t WS_PEERO = 10 * MiB;
constexpr size_t WS_END = 228 * MiB;
constexpr int CW_QU = 4096, CW_QV = 4096 + 64 * 16;
constexpr int NPART = 8, NCHUNK = T / 64;

struct Args {
    const float* x; const float* norm_mix_g; const float* w_in; const float* attn_sinks; const float* attn_out_g;
    const float* conv_w; const float* conv_b; const float* dt_bias; const float* a_log; const float* d_skip;
    const float* ssm_norm_g; const float* w_out; const float* norm_ffn_g; const float* peer_wq; const float* peer_sub_keys;
    const float* peer_u; const float* peer_v; const float* final_norm_g;
    float* out; unsigned char* ws;
    int ph_lo, ph_hi;
};

#define LAS __attribute__((address_space(3)))
#define LDS_WAIT() asm volatile("s_waitcnt lgkmcnt(0)" ::: "memory")
__device__ __forceinline__ float bf2f(bf16 v) { return __uint_as_float(((unsigned)v) << 16); }
__device__ __forceinline__ unsigned f2bfu(float f) { unsigned u = __float_as_uint(f); return (u + 0x7fffu + ((u >> 16) & 1u)) >> 16; }
__device__ __forceinline__ bf16 f2bf(float f) { return (bf16)f2bfu(f); }
__device__ __forceinline__ unsigned pk2(float lo, float hi) { return f2bfu(lo) | (f2bfu(hi) << 16); }
__device__ __forceinline__ float wave_sum(float v) {
#pragma unroll
    for (int o = 1; o < 64; o <<= 1) v += __shfl_xor(v, o);
    return v;
}
__device__ __forceinline__ float silu_f(float v) { return v / (1.f + __expf(-v)); }

__device__ __forceinline__ void transpose_item(const float* W, int ldw, int K, bf16* WT, LAS float* scr, int kb, int nbk, int lane) {
    const int k0 = 64 * kb, n0 = 32 * nbk;
#pragma unroll 8
    for (int i = 0; i < 32; ++i) { const int kk = 2 * i + (lane >> 5); scr[kk * 33 + (lane & 31)] = W[(size_t)(k0 + kk) * ldw + n0 + (lane & 31)]; }
    LDS_WAIT();
    const int c = lane & 7;
#pragma unroll
    for (int j = 0; j < 4; ++j) { const int n = (lane >> 3) + 8 * j; const LAS float* s = scr + (8 * c) * 33 + n;
        v4u o; o.x = pk2(s[0 * 33], s[1 * 33]); o.y = pk2(s[2 * 33], s[3 * 33]); o.z = pk2(s[4 * 33], s[5 * 33]); o.w = pk2(s[6 * 33], s[7 * 33]);
        *(v4u*)(WT + (size_t)(n0 + n) * K + k0 + 8 * c) = o; }
    LDS_WAIT();
}

template <bool WITH_DT>
__device__ __forceinline__ void rmsnorm_rows_bf16(const float* in, const float* g, bf16* outp, const LAS unsigned char* ldsb, float* dtraw, int gwave, int nwaves, int lane) {
    for (int row = gwave; row < T; row += nwaves) {
        const float4* xr = (const float4*)(in + (size_t)row * D) + lane;
        float4 v[4]; float ss = 0.f;
#pragma unroll
        for (int j = 0; j < 4; ++j) { v[j] = xr[64 * j]; ss += v[j].x * v[j].x + v[j].y * v[j].y + v[j].z * v[j].z + v[j].w * v[j].w; }
        ss = wave_sum(ss);
        const float r = rsqrtf(ss * (1.f / D) + EPS);
        unsigned long long* o8 = (unsigned long long*)(outp + (size_t)row * D) + lane;
        float dacc[8];
#pragma unroll
        for (int h = 0; h < 8; ++h) dacc[h] = 0.f;
#pragma unroll
        for (int j = 0; j < 4; ++j) {
            const float4 gv = ((const float4*)g)[lane + 64 * j];
            const float y[4] = {v[j].x * r * gv.x, v[j].y * r * gv.y, v[j].z * r * gv.z, v[j].w * r * gv.w};
            o8[64 * j] = (unsigned long long)pk2(y[0], y[1]) | ((unsigned long long)pk2(y[2], y[3]) << 32);
            if (WITH_DT) {
#pragma unroll
                for (int h = 0; h < 8; ++h) {
                    typedef float f4v __attribute__((ext_vector_type(4)));
                    const f4v wv = *(const LAS f4v*)(ldsb + h * 16384 + 8448 + (256 * j + 4 * lane) * 4);
                    dacc[h] += y[0] * wv.x + y[1] * wv.y + y[2] * wv.z + y[3] * wv.w;
                }
            }
        }
        if (WITH_DT) {
#pragma unroll
            for (int h = 0; h < 8; ++h) dacc[h] = wave_sum(dacc[h]);
            if (lane == 0) { float4* dp = (float4*)(dtraw + (size_t)row * 8); dp[0] = make_float4(dacc[0], dacc[1], dacc[2], dacc[3]); dp[1] = make_float4(dacc[4], dacc[5], dacc[6], dacc[7]); }
        }
    }
}

typedef short bf16x8 __attribute__((ext_vector_type(8)));
typedef short bf16x4 __attribute__((ext_vector_type(4)));
typedef float f32x16 __attribute__((ext_vector_type(16)));
typedef __bf16 bf2_t __attribute__((ext_vector_type(2)));
#define MFMA32(a, b, c) __builtin_amdgcn_mfma_f32_32x32x16_bf16((a), (b), (c), 0, 0, 0)
__device__ __forceinline__ unsigned pkbf(float lo, float hi) { bf2_t v = {(__bf16)lo, (__bf16)hi}; return __builtin_bit_cast(unsigned, v); }
__device__ __forceinline__ short bfs(float f) { return __builtin_bit_cast(short, (__bf16)f); }
__device__ __forceinline__ float sbf2f(short v) { return __uint_as_float(((unsigned)(unsigned short)v) << 16); }
__device__ __forceinline__ int crow(int i, int hi) { return (i & 3) + 8 * (i >> 2) + 4 * hi; }
template <int S> __device__ __forceinline__ bf16x8 pack8(const f32x16& x) {
    v4u p; p.x = pkbf(x[8 * S], x[8 * S + 1]); p.y = pkbf(x[8 * S + 2], x[8 * S + 3]); p.z = pkbf(x[8 * S + 4], x[8 * S + 5]); p.w = pkbf(x[8 * S + 6], x[8 * S + 7]);
    return __builtin_bit_cast(bf16x8, p);
}
__device__ __forceinline__ bf16x8 ldg8(const bf16* p) { return *(const bf16x8*)p; }
__device__ __forceinline__ bf16x8 lds8(const LAS bf16* p) { return *(const LAS bf16x8*)p; }
__device__ __forceinline__ bf16x8 lds4x2(const LAS bf16* p) { const bf16x4 a = *(const LAS bf16x4*)p, b = *(const LAS bf16x4*)(p + 8); return __builtin_shufflevector(a, b, 0, 1, 2, 3, 4, 5, 6, 7); }
__device__ __forceinline__ f32x16 zero16() { f32x16 z;
#pragma unroll
    for (int i = 0; i < 16; ++i) z[i] = 0.f;
    return z; }

__device__ __forceinline__ void attn_unit(const float* sinks, LAS unsigned char* ldsb, int unit, const bf16* PROJ, float* MIXF, int tid, int lane, int wave) {
    const int hkv = unit & 1, blk = unit >> 1, nbk = blk & 63;
    const int tokblk = blk * 128, wbase = tokblk - 128;
    LAS bf16* VT = (LAS bf16*)ldsb;
#pragma unroll
    for (int i = 0; i < 4; ++i) {
        const int c = tid + 512 * i, key = c >> 3, d0 = (c & 7) * 8; const bool valid = (nbk > 0) || (key >= 128);
        bf16x8 v;
#pragma unroll
        for (int e = 0; e < 8; ++e) v[e] = 0;
        if (valid) v = ldg8(PROJ + (size_t)(wbase + key) * PS + OV + hkv * 64 + d0);
#pragma unroll
        for (int e = 0; e < 8; ++e) VT[(d0 + e) * 264 + key] = (bf16)v[e];
    }
    __syncthreads();
    const int r = lane & 31, hi = lane >> 5;
    const int hq = hkv * 4 + (wave & 3);
    const float slope = exp2f(-(float)(hq + 1)), sink = sinks[hq];
#pragma unroll 1
    for (int qq = 0; qq < 2; ++qq) {
        const int qt = (wave >> 2) + 2 * qq;
        const int tq = tokblk + 32 * qt + r;
        bf16x8 qf[4];
#pragma unroll
        for (int ks = 0; ks < 4; ++ks) qf[ks] = ldg8(PROJ + (size_t)tq * PS + OQ + hq * 64 + 16 * ks + 8 * hi);
        f32x16 X[5];
#pragma unroll
        for (int kt = 0; kt < 5; ++kt) {
            const int key = 32 * (qt + kt) + r; const bool valid = (nbk > 0) || (key >= 128);
            const int row = valid ? (wbase + key) : tokblk;
            X[kt] = zero16();
#pragma unroll
            for (int ks = 0; ks < 4; ++ks) { const bf16x8 kf = ldg8(PROJ + (size_t)row * PS + OKK + hkv * 64 + 16 * ks + 8 * hi); X[kt] = MFMA32(kf, qf[ks], X[kt]); }
        }
        const int qi = 32 * qt + r;
        float m = -1e30f;
#pragma unroll
        for (int kt = 0; kt < 5; ++kt)
#pragma unroll
            for (int i = 0; i < 16; ++i) {
                const int ki = 32 * (qt + kt) + crow(i, hi), dist = 128 + qi - ki;
                const bool valid = (dist >= 0) && (dist < 128) && ((nbk > 0) || (ki >= 128));
                const float lg = valid ? (X[kt][i] * 0.125f - slope * (float)dist) : -1e30f;
                X[kt][i] = lg; m = fmaxf(m, lg);
            }
        m = fmaxf(m, __shfl_xor(m, 32)); m = fmaxf(m, sink);
        float lsum = 0.f;
#pragma unroll
        for (int kt = 0; kt < 5; ++kt)
#pragma unroll
            for (int i = 0; i < 16; ++i) { const float p = __expf(X[kt][i] - m); X[kt][i] = p; lsum += p; }
        lsum += __shfl_xor(lsum, 32); lsum += __expf(sink - m);
        f32x16 O0 = zero16(), O1 = zero16();
#pragma unroll
        for (int kt = 0; kt < 5; ++kt) {
            const int kb = 32 * (qt + kt) + 4 * hi;
            { const bf16x8 xs = pack8<0>(X[kt]); const bf16x8 a0 = lds4x2(VT + r * 264 + kb), a1 = lds4x2(VT + (32 + r) * 264 + kb); O0 = MFMA32(a0, xs, O0); O1 = MFMA32(a1, xs, O1); }
            { const bf16x8 xs = pack8<1>(X[kt]); const bf16x8 a0 = lds4x2(VT + r * 264 + kb + 16), a1 = lds4x2(VT + (32 + r) * 264 + kb + 16); O0 = MFMA32(a0, xs, O0); O1 = MFMA32(a1, xs, O1); }
        }
        const float inv = 1.f / lsum;
        float* orow = MIXF + (size_t)tq * D + hq * 64 + 4 * hi;
#pragma unroll
        for (int q4 = 0; q4 < 4; ++q4) {
            *(float4*)(orow + 8 * q4) = make_float4(O0[4 * q4] * inv, O0[4 * q4 + 1] * inv, O0[4 * q4 + 2] * inv, O0[4 * q4 + 3] * inv);
            *(float4*)(orow + 32 + 8 * q4) = make_float4(O1[4 * q4] * inv, O1[4 * q4 + 1] * inv, O1[4 * q4 + 2] * inv, O1[4 * q4 + 3] * inv);
        }
    }
    __syncthreads();
}

__device__ __forceinline__ void ssd_chunk_unit(LAS unsigned char* ldsb, int unit, const bf16* XACT, const float* DT, const float* ACS, float* MIXF, float* STATES, int tid, int lane, int wave) {
    const int g = unit & 1, bc = unit >> 1, tok0 = bc * 128;
    LAS bf16* BT = (LAS bf16*)ldsb;
    LAS bf16* XD = (LAS bf16*)(ldsb + 34816);
    LAS bf16* XW = (LAS bf16*)(ldsb + 34816 + 34816);
    LAS float* ACST = (LAS float*)(ldsb + 34816 * 3);
    const int r = lane & 31, hi = lane >> 5;
#pragma unroll
    for (int i = 0; i < 4; ++i) {
        const int c = tid + 512 * i, s = c >> 4, n0 = (c & 15) * 8;
        const bf16x8 v = ldg8(XACT + (size_t)(tok0 + s) * 1024 + 512 + g * 128 + n0);
#pragma unroll
        for (int e = 0; e < 8; ++e) BT[(n0 + e) * 136 + s] = (bf16)v[e];
    }
    ACST[tid] = ACS[(size_t)(tok0 + (tid >> 2)) * 8 + g * 4 + (tid & 3)];
#pragma unroll 1
    for (int hp = 0; hp < 2; ++hp) {
        if (hp) __syncthreads();
#pragma unroll
        for (int i = 0; i < 4; ++i) {
            const int c = tid + 512 * i, hsel = c >> 10, s = (c >> 3) & 127, p0 = (c & 7) * 8, H = g * 4 + 2 * hp + hsel;
            const bf16x8 v = ldg8(XACT + (size_t)(tok0 + s) * 1024 + H * 64 + p0);
            const float dtv = DT[(size_t)(tok0 + s) * 8 + H];
            const float w = __expf(ACS[(size_t)(tok0 + 127) * 8 + H] - ACS[(size_t)(tok0 + s) * 8 + H]);
#pragma unroll
            for (int e = 0; e < 8; ++e) { const float xd = sbf2f(v[e]) * dtv; XD[hsel * 8704 + (p0 + e) * 136 + s] = (bf16)bfs(xd); XW[hsel * 8704 + (p0 + e) * 136 + s] = (bf16)bfs(xd * w); }
        }
        __syncthreads();
        {
            const int lt = wave & 3, hsel = wave >> 2, hh = 2 * hp + hsel, H = g * 4 + hh;
            const int l = 32 * lt + r; const float acs_l = ACST[l * 4 + hh];
            bf16x8 cf[8];
#pragma unroll
            for (int ks = 0; ks < 8; ++ks) cf[ks] = ldg8(XACT + (size_t)(tok0 + l) * 1024 + 768 + g * 128 + 16 * ks + 8 * hi);
            f32x16 Z0 = zero16(), Z1 = zero16();
#pragma unroll 1
            for (int st = 0; st <= lt; ++st) {
                f32x16 X = zero16();
#pragma unroll
                for (int ks = 0; ks < 8; ++ks) { const bf16x8 bfr = ldg8(XACT + (size_t)(tok0 + 32 * st + r) * 1024 + 512 + g * 128 + 16 * ks + 8 * hi); X = MFMA32(bfr, cf[ks], X); }
#pragma unroll
                for (int i = 0; i < 16; ++i) { const int s = 32 * st + crow(i, hi); const float f = (s <= l) ? __expf(acs_l - ACST[s * 4 + hh]) : 0.f; X[i] *= f; }
                const int sb = 32 * st + 4 * hi;
                { const bf16x8 xs = pack8<0>(X); const bf16x8 b0 = lds4x2(XD + hsel * 8704 + r * 136 + sb), b1 = lds4x2(XD + hsel * 8704 + (32 + r) * 136 + sb); Z0 = MFMA32(xs, b0, Z0); Z1 = MFMA32(xs, b1, Z1); }
                { const bf16x8 xs = pack8<1>(X); const bf16x8 b0 = lds4x2(XD + hsel * 8704 + r * 136 + sb + 16), b1 = lds4x2(XD + hsel * 8704 + (32 + r) * 136 + sb + 16); Z0 = MFMA32(xs, b0, Z0); Z1 = MFMA32(xs, b1, Z1); }
            }
#pragma unroll
            for (int i = 0; i < 16; ++i) { float* o = MIXF + (size_t)(tok0 + 32 * lt + crow(i, hi)) * D + 512 + H * 64 + r; o[0] = Z0[i]; o[32] = Z1[i]; }
        }
        {
            const int nt = wave & 3, hsel = wave >> 2, H = g * 4 + 2 * hp + hsel;
            f32x16 S0 = zero16(), S1 = zero16();
#pragma unroll
            for (int ks = 0; ks < 8; ++ks) {
                const bf16x8 btf = lds8(BT + (32 * nt + r) * 136 + 16 * ks + 8 * hi);
                const bf16x8 a0 = lds8(XW + hsel * 8704 + r * 136 + 16 * ks + 8 * hi), a1 = lds8(XW + hsel * 8704 + (32 + r) * 136 + 16 * ks + 8 * hi);
                S0 = MFMA32(a0, btf, S0); S1 = MFMA32(a1, btf, S1);
            }
            float* sp = STATES + (size_t)(bc * 8 + H) * 8192 + 32 * nt + r;
#pragma unroll
            for (int i = 0; i < 16; ++i) { const int p = crow(i, hi); sp[p * 128] = S0[i]; sp[(32 + p) * 128] = S1[i]; }
        }
    }
    __syncthreads();
}

__device__ __forceinline__ void yoff_unit(const float* d_skip, int unit, const bf16* XACT, const bf16* PROJ, const float* ACS, const bf16* PREVT, float* MIXF, int lane, int wave) {
    const int g = unit & 1, bc = unit >> 1, tok0 = bc * 128;
    const int r = lane & 31, hi = lane >> 5, lt = wave & 3, hpair = wave >> 2;
    bf16x8 cf[8];
#pragma unroll
    for (int ks = 0; ks < 8; ++ks) cf[ks] = ldg8(XACT + (size_t)(tok0 + 32 * lt + r) * 1024 + 768 + g * 128 + 16 * ks + 8 * hi);
#pragma unroll 1
    for (int hsel = 0; hsel < 2; ++hsel) {
        const int H = g * 4 + 2 * hpair + hsel; const bf16* pv = PREVT + (size_t)(bc * 8 + H) * 8192;
        f32x16 Y0 = zero16(), Y1 = zero16();
#pragma unroll
        for (int ks = 0; ks < 8; ++ks) {
            const bf16x8 b0 = ldg8(pv + r * 128 + 16 * ks + 8 * hi), b1 = ldg8(pv + (32 + r) * 128 + 16 * ks + 8 * hi);
            Y0 = MFMA32(cf[ks], b0, Y0); Y1 = MFMA32(cf[ks], b1, Y1);
        }
        const float dsk = d_skip[H];
#pragma unroll
        for (int i = 0; i < 16; ++i) {
            const int t = tok0 + 32 * lt + crow(i, hi); const float ea = __expf(ACS[(size_t)t * 8 + H]);
#pragma unroll
            for (int pt = 0; pt < 2; ++pt) {
                const int col = H * 64 + 32 * pt + r;
                float* yp = MIXF + (size_t)t * D + 512 + col;
                float y = yp[0] + ea * (pt ? Y1[i] : Y0[i]) + dsk * bf2f(XACT[(size_t)t * 1024 + col]);
                const float z = bf2f(PROJ[(size_t)t * PS + OZ + col]);
                yp[0] = y * silu_f(z);
            }
        }
    }
}


typedef float f32x2 __attribute__((ext_vector_type(2)));
__device__ __forceinline__ void fp8x16_to_f32(const uint4 w, float (&f)[16]) {
    const int ww[4] = {(int)w.x, (int)w.y, (int)w.z, (int)w.w};
#pragma unroll
    for (int q = 0; q < 4; ++q) { const f32x2 a = __builtin_amdgcn_cvt_pk_f32_fp8(ww[q], false), b = __builtin_amdgcn_cvt_pk_f32_fp8(ww[q], true); f[4 * q] = a.x; f[4 * q + 1] = a.y; f[4 * q + 2] = b.x; f[4 * q + 3] = b.y; }
}
template <int M4, int M2, int M1> __device__ __forceinline__ void treduce16(const float (&a)[16], int lane, float& r0, float& r1) {
    float b[8], c[4];
    { const bool hi = (lane & M4) != 0;
#pragma unroll
      for (int i = 0; i < 8; ++i) { const float send = hi ? a[i] : a[i + 8]; const float recv = __shfl_xor(send, M4); b[i] = (hi ? a[i + 8] : a[i]) + recv; } }
    { const bool hi = (lane & M2) != 0;
#pragma unroll
      for (int i = 0; i < 4; ++i) { const float send = hi ? b[i] : b[i + 4]; const float recv = __shfl_xor(send, M2); c[i] = (hi ? b[i + 4] : b[i]) + recv; } }
    { const bool hi = (lane & M1) != 0;
      { const float send = hi ? c[0] : c[2]; const float recv = __shfl_xor(send, M1); r0 = (hi ? c[2] : c[0]) + recv; }
      { const float send = hi ? c[1] : c[3]; const float recv = __shfl_xor(send, M1); r1 = (hi ? c[3] : c[1]) + recv; } }
}
__device__ __forceinline__ void peer_u_item(int p, int j, const int* IDX, const bf16* XN2B, const unsigned char* U8, float* PART, int lane, int wave) {
    const int gidx = lane >> 3, c16 = (lane & 7) * 16;
#pragma unroll 1
    for (int it = 0; it < 8; ++it) {
        const int t = j * 64 + it * 8 + wave;
        int e[16];
#pragma unroll
        for (int q = 0; q < 4; ++q) { const int4 ev = *(const int4*)(IDX + (size_t)t * 128 + 16 * gidx + 4 * q); e[4 * q] = ev.x; e[4 * q + 1] = ev.y; e[4 * q + 2] = ev.z; e[4 * q + 3] = ev.w; }
        uint4 uu[16];
#pragma unroll
        for (int i = 0; i < 16; ++i) uu[i] = *(const uint4*)(U8 + (size_t)e[i] * D + p * 128 + c16);
        float xv[16];
        { const bf16* xr = XN2B + (size_t)t * D + p * 128 + c16; const uint4 w0 = *(const uint4*)xr, w1 = *(const uint4*)(xr + 8);
          const unsigned ww[8] = {w0.x, w0.y, w0.z, w0.w, w1.x, w1.y, w1.z, w1.w};
#pragma unroll
          for (int q = 0; q < 8; ++q) { xv[2 * q] = __uint_as_float(ww[q] << 16); xv[2 * q + 1] = __uint_as_float(ww[q] & 0xffff0000u); } }
        float d[16];
#pragma unroll
        for (int i = 0; i < 16; ++i) { float f[16]; fp8x16_to_f32(uu[i], f); float s = 0.f;
#pragma unroll
            for (int c = 0; c < 16; ++c) s += f[c] * xv[c];
            d[i] = s; }
        float r0, r1; treduce16<4, 2, 1>(d, lane, r0, r1);
        *(float2*)(PART + ((size_t)p * T + t) * 128 + 2 * lane) = make_float2(r0, r1);
    }
}
__device__ __forceinline__ void peer_v_item(int p, int j, const int* IDX, const float* ACT, const unsigned char* V8, float* PEERO, int lane, int wave) {
    const int gidx = lane >> 3, c16 = (lane & 7) * 16;
#pragma unroll 1
    for (int it = 0; it < 8; ++it) {
        const int t = j * 64 + it * 8 + wave;
        int e[16]; float ac[16];
#pragma unroll
        for (int q = 0; q < 4; ++q) {
            const int4 ev = *(const int4*)(IDX + (size_t)t * 128 + 16 * gidx + 4 * q); const float4 av = *(const float4*)(ACT + (size_t)t * 128 + 16 * gidx + 4 * q);
            e[4 * q] = ev.x; e[4 * q + 1] = ev.y; e[4 * q + 2] = ev.z; e[4 * q + 3] = ev.w; ac[4 * q] = av.x; ac[4 * q + 1] = av.y; ac[4 * q + 2] = av.z; ac[4 * q + 3] = av.w;
        }
        uint4 vv[16];
#pragma unroll
        for (int i = 0; i < 16; ++i) vv[i] = *(const uint4*)(V8 + (size_t)e[i] * D + p * 128 + c16);
        float acc[16];
#pragma unroll
        for (int c = 0; c < 16; ++c) acc[c] = 0.f;
#pragma unroll
        for (int i = 0; i < 16; ++i) { float f[16]; fp8x16_to_f32(vv[i], f);
#pragma unroll
            for (int c = 0; c < 16; ++c) acc[c] += ac[i] * f[c]; }
        float r0, r1; treduce16<32, 16, 8>(acc, lane, r0, r1);
        *(float2*)(PEERO + (size_t)t * D + p * 128 + c16 + 2 * gidx) = make_float2(r0, r1);
    }
}

__device__ __forceinline__ void ce_desc(float& a, float& b) { const float hi = fmaxf(a, b), lo = fminf(a, b); a = hi; b = lo; }
__device__ __forceinline__ void sort16_desc(float (&v)[16]) {
#pragma unroll
    for (int k = 2; k <= 16; k <<= 1)
#pragma unroll
        for (int j = k >> 1; j > 0; j >>= 1)
#pragma unroll
            for (int i = 0; i < 16; ++i) { const int l = i ^ j; if (l > i) { if ((i & k) == 0) ce_desc(v[i], v[l]); else ce_desc(v[l], v[i]); } }
}
__device__ __forceinline__ void merge16_desc(float (&a)[16], const float (&b)[16]) {
#pragma unroll
    for (int i = 0; i < 16; ++i) a[i] = fmaxf(a[i], b[15 - i]);
#pragma unroll
    for (int j = 8; j > 0; j >>= 1)
#pragma unroll
        for (int i = 0; i < 16; ++i) { const int l = i ^ j; if (l > i) ce_desc(a[i], a[l]); }
}
__device__ __forceinline__ void ce_kv(float& ka, int& va, float& kb, int& vb) {
    const bool s = kb > ka; const float t0 = s ? kb : ka, t1 = s ? ka : kb; const int u0 = s ? vb : va, u1 = s ? va : vb; ka = t0; kb = t1; va = u0; vb = u1; }
__device__ __forceinline__ void sort16_kv(float (&k)[16], int (&v)[16]) {
#pragma unroll
    for (int kk = 2; kk <= 16; kk <<= 1)
#pragma unroll
        for (int j = kk >> 1; j > 0; j >>= 1)
#pragma unroll
            for (int i = 0; i < 16; ++i) { const int l = i ^ j; if (l > i) { if ((i & kk) == 0) ce_kv(k[i], v[i], k[l], v[l]); else ce_kv(k[l], v[l], k[i], v[i]); } }
}
__device__ __forceinline__ void merge16_kv(float (&ka)[16], int (&va)[16], const float (&kb)[16], const int (&vb)[16]) {
#pragma unroll
    for (int i = 0; i < 16; ++i) { const bool s = kb[15 - i] > ka[i]; ka[i] = s ? kb[15 - i] : ka[i]; va[i] = s ? vb[15 - i] : va[i]; }
#pragma unroll
    for (int j = 8; j > 0; j >>= 1)
#pragma unroll
        for (int i = 0; i < 16; ++i) { const int l = i ^ j; if (l > i) ce_kv(ka[i], va[i], ka[l], va[l]); }
}
__device__ __forceinline__ void split8(const float* p, bf16x8& hi8, bf16x8& lo8) {
    const float4 f0 = *(const float4*)p, f1 = *(const float4*)(p + 4);
    const float x[8] = {f0.x, f0.y, f0.z, f0.w, f1.x, f1.y, f1.z, f1.w};
#pragma unroll
    for (int j = 0; j < 8; ++j) { const short h = bfs(x[j]); hi8[j] = h; lo8[j] = bfs(x[j] - sbf2f(h)); }
}
__device__ __forceinline__ void route_task(int task, const float* QP, const bf16* KH, const bf16* KL, int* IDX, float* GATE, int lane) {
    const int r = lane & 31, hi = lane >> 5, t = 4 * task + (r >> 3), head = r & 7;
    float top[2][16];
#pragma unroll
    for (int half = 0; half < 2; ++half) {
        bf16x8 qh[4], ql[4];
#pragma unroll
        for (int ks = 0; ks < 4; ++ks) split8(QP + (size_t)t * D + head * 128 + half * 64 + 16 * ks + 8 * hi, qh[ks], ql[ks]);
        float cur[16];
#pragma unroll
        for (int kt = 0; kt < 4; ++kt) {
            f32x16 X = zero16();
            const bf16* khp = KH + (size_t)(half * 128 + 32 * kt + r) * 64 + 8 * hi; const bf16* klp = KL + (size_t)(half * 128 + 32 * kt + r) * 64 + 8 * hi;
            asm volatile("" : "+v"(khp), "+v"(klp));
#pragma unroll
            for (int ks = 0; ks < 4; ++ks) {
                const bf16x8 kh = ldg8(khp + 16 * ks), kl = ldg8(klp + 16 * ks);
                X = MFMA32(kh, qh[ks], X); X = MFMA32(kh, ql[ks], X); X = MFMA32(kl, qh[ks], X);
            }
            float grp[16];
#pragma unroll
            for (int i = 0; i < 16; ++i) { const unsigned key = (unsigned)(32 * kt + crow(i, hi)); grp[i] = __uint_as_float((__float_as_uint(X[i]) & ~127u) | (127u - key)); }
            sort16_desc(grp);
            if (kt == 0) {
#pragma unroll
                for (int i = 0; i < 16; ++i) cur[i] = grp[i];
            } else merge16_desc(cur, grp);
        }
        float oth[16];
#pragma unroll
        for (int i = 0; i < 16; ++i) oth[i] = __shfl_xor(cur[i], 32);
        merge16_desc(cur, oth);
#pragma unroll
        for (int i = 0; i < 16; ++i) top[half][i] = cur[i];
    }
    unsigned P1[4], P2[4];
#pragma unroll
    for (int q = 0; q < 4; ++q) { P1[q] = 0u; P2[q] = 0u;
#pragma unroll
        for (int s = 0; s < 4; ++s) { P1[q] |= (127u - (__float_as_uint(top[0][4 * q + s]) & 127u)) << (8 * s); P2[q] |= (127u - (__float_as_uint(top[1][4 * q + s]) & 127u)) << (8 * s); } }
#define CAND(a, b) __uint_as_float((__float_as_uint(top[0][a] + top[1][b]) & ~255u) | (255u - (unsigned)((a) * 16 + (b))))
    float bk[16];
    {
        float gk[16];
        gk[0] = CAND(0, 0);
        gk[1] = CAND(0, 1);
        gk[2] = CAND(0, 2);
        gk[3] = CAND(0, 3);
        gk[4] = CAND(0, 4);
        gk[5] = CAND(0, 5);
        gk[6] = CAND(0, 6);
        gk[7] = CAND(0, 7);
        gk[8] = CAND(0, 8);
        gk[9] = CAND(0, 9);
        gk[10] = CAND(0, 10);
        gk[11] = CAND(0, 11);
        gk[12] = CAND(0, 12);
        gk[13] = CAND(0, 13);
        gk[14] = CAND(0, 14);
        gk[15] = CAND(0, 15);
        sort16_desc(gk);
#pragma unroll
        for (int i = 0; i < 16; ++i) bk[i] = gk[i];
    }
    {
        float gk[16];
        gk[0] = CAND(1, 0);
        gk[1] = CAND(1, 1);
        gk[2] = CAND(1, 2);
        gk[3] = CAND(1, 3);
        gk[4] = CAND(1, 4);
        gk[5] = CAND(1, 5);
        gk[6] = CAND(1, 6);
        gk[7] = CAND(1, 7);
        gk[8] = CAND(2, 0);
        gk[9] = CAND(2, 1);
        gk[10] = CAND(2, 2);
        gk[11] = CAND(2, 3);
        gk[12] = CAND(2, 4);
        gk[13] = CAND(3, 0);
        gk[14] = CAND(3, 1);
        gk[15] = CAND(3, 2);
        sort16_desc(gk);
        merge16_desc(bk, gk);
    }
    {
        float gk[16];
        gk[0] = CAND(3, 3);
        gk[1] = CAND(4, 0);
        gk[2] = CAND(4, 1);
        gk[3] = CAND(4, 2);
        gk[4] = CAND(5, 0);
        gk[5] = CAND(5, 1);
        gk[6] = CAND(6, 0);
        gk[7] = CAND(6, 1);
        gk[8] = CAND(7, 0);
        gk[9] = CAND(7, 1);
        gk[10] = CAND(8, 0);
        gk[11] = CAND(9, 0);
        gk[12] = CAND(10, 0);
        gk[13] = CAND(11, 0);
        gk[14] = CAND(12, 0);
        gk[15] = CAND(13, 0);
        sort16_desc(gk);
        merge16_desc(bk, gk);
    }
    {
        float gk[16];
        gk[0] = CAND(14, 0);
        gk[1] = CAND(15, 0);
        gk[2] = -INFINITY;
        gk[3] = -INFINITY;
        gk[4] = -INFINITY;
        gk[5] = -INFINITY;
        gk[6] = -INFINITY;
        gk[7] = -INFINITY;
        gk[8] = -INFINITY;
        gk[9] = -INFINITY;
        gk[10] = -INFINITY;
        gk[11] = -INFINITY;
        gk[12] = -INFINITY;
        gk[13] = -INFINITY;
        gk[14] = -INFINITY;
        gk[15] = -INFINITY;
        sort16_desc(gk);
        merge16_desc(bk, gk);
    }
#undef CAND
    int bv[16];
#pragma unroll
    for (int i = 0; i < 16; ++i) {
        const unsigned cd = 255u - (__float_as_uint(bk[i]) & 255u), ca = cd >> 4, cb = cd & 15u;
        const unsigned wa = (ca >> 2) == 0u ? P1[0] : (ca >> 2) == 1u ? P1[1] : (ca >> 2) == 2u ? P1[2] : P1[3];
        const unsigned wb = (cb >> 2) == 0u ? P2[0] : (cb >> 2) == 1u ? P2[1] : (cb >> 2) == 2u ? P2[2] : P2[3];
        bv[i] = (int)((((wa >> (8u * (ca & 3u))) & 255u) << 7) | ((wb >> (8u * (cb & 3u))) & 255u));
    }
    float e[16], se = 0.f;
#pragma unroll
    for (int i = 0; i < 16; ++i) { e[i] = __expf(bk[i] - bk[0]); se += e[i]; }
    const float inv = 1.f / se;
    if (hi == 0) {
        int4* ip = (int4*)(IDX + (size_t)t * 128 + head * 16); float4* gp = (float4*)(GATE + (size_t)t * 128 + head * 16);
#pragma unroll
        for (int q = 0; q < 4; ++q) { ip[q] = make_int4(bv[4 * q], bv[4 * q + 1], bv[4 * q + 2], bv[4 * q + 3]); gp[q] = make_float4(e[4 * q] * inv, e[4 * q + 1] * inv, e[4 * q + 2] * inv, e[4 * q + 3] * inv); }
    }
}

#define XB_TMO      128
#define XB_XCNT(j)  (256  + 64 * (j))
#define XB_XSUB(j)  (1280 + 64 * (j))
#define XB_XGEN(j)  (2304 + 64 * (j))
#define XB_TOP      3328
#define XB_TOPGEN   3392
#define XCD_BAR_WORDS 3456
#define XB_SPIN_CAP (1u << 22)
__device__ __forceinline__ unsigned xb_ld(unsigned* p)              { return __hip_atomic_load(p, __ATOMIC_RELAXED, __HIP_MEMORY_SCOPE_AGENT); }
__device__ __forceinline__ unsigned xb_add(unsigned* p, unsigned v) { return __hip_atomic_fetch_add(p, v, __ATOMIC_RELAXED, __HIP_MEMORY_SCOPE_AGENT); }
__device__ __forceinline__ unsigned xb_xcc_id() { return (unsigned)__builtin_amdgcn_s_getreg((3 << 11) | 20) & 0xFu; }
#define XB_SPIN(cond, bar) do { unsigned _sp = 0; while (cond) { __builtin_amdgcn_s_sleep(1); \
    if ((++_sp & 255u) == 0u) { if (xb_ld(&(bar)[XB_TMO])) break; if (_sp > XB_SPIN_CAP) { atomicAdd(&(bar)[XB_TMO], 1u); break; } } } } while (0)
struct XcdBarrier { unsigned* bar; unsigned x; volatile LAS unsigned* st; };
__device__ __forceinline__ XcdBarrier xcd_barrier_post(unsigned* bar, volatile LAS unsigned* st) {
    XcdBarrier b; b.bar = bar; b.x = xb_xcc_id(); b.st = st;
    if (threadIdx.x == 0) (void)xb_add(&bar[XB_XCNT(b.x)], 1u);
    return b;
}
__device__ __forceinline__ void xcd_barrier_complete(unsigned* bar, unsigned x, unsigned& nloc, unsigned& nx) {
    const unsigned G = gridDim.x * gridDim.y * gridDim.z;
    unsigned sum, cnt, mine, sp = 0u;
    for (;;) {
        sum = 0u; cnt = 0u; mine = 0u;
#pragma unroll
        for (unsigned j = 0; j < 16; ++j) { const unsigned c = xb_ld(&bar[XB_XCNT(j)]); sum += c; cnt += (c > 0u) ? 1u : 0u; mine = (j == x) ? c : mine; }
        if (sum == G) break;
        __builtin_amdgcn_s_sleep(1);
        if ((++sp & 255u) == 0u) { if (xb_ld(&bar[XB_TMO])) break; if (sp > XB_SPIN_CAP) { atomicAdd(&bar[XB_TMO], 1u); break; } }
    }
    nloc = mine > 0u ? mine : 1u; nx = cnt > 0u ? cnt : 1u;
}
__device__ __forceinline__ void xcd_barrier(const XcdBarrier& b) {
    asm volatile("s_waitcnt vmcnt(0)" ::: "memory");
    __syncthreads();
    if (threadIdx.x == 0) {
        unsigned* bar = b.bar;
        __builtin_amdgcn_s_waitcnt(0);
        unsigned nloc = b.st[0], nx = b.st[1];
        if (nloc == 0u) { xcd_barrier_complete(bar, b.x, nloc, nx); b.st[0] = nloc; b.st[1] = nx; }
        const unsigned old = xb_add(&bar[XB_XSUB(b.x)], 1u);
        const unsigned gen = old / nloc;
        if (old + 1u == (gen + 1u) * nloc) {
            __builtin_amdgcn_fence(__ATOMIC_RELEASE, "agent");
            asm volatile("s_waitcnt vmcnt(0)" ::: "memory");
            const unsigned og = xb_add(&bar[XB_TOP], 1u);
            const unsigned tg = og / nx;
            if (og + 1u == (tg + 1u) * nx) xb_add(&bar[XB_TOPGEN], 1u);
            else XB_SPIN(xb_ld(&bar[XB_TOPGEN]) == tg, bar);
            __builtin_amdgcn_fence(__ATOMIC_ACQUIRE, "agent");
            xb_add(&bar[XB_XGEN(b.x)], 1u);
            asm volatile("s_waitcnt vmcnt(0)" ::: "memory");
        } else {
            XB_SPIN(xb_ld(&bar[XB_XGEN(b.x)]) == gen, bar);
            __builtin_amdgcn_fence(__ATOMIC_ACQUIRE, "agent");
            asm volatile("s_waitcnt vmcnt(0)" ::: "memory");
        }
    }
    __syncthreads();
}
constexpr int LDS_BYTES = 147456;
constexpr int MISC_OFF = 131072 + 320;

__global__ void __launch_bounds__(NTHR, 2) k_main(Args a) {
    extern __shared__ __attribute__((aligned(16))) unsigned char lds_raw[];
    LAS unsigned char* ldsb = (LAS unsigned char*)lds_raw;
    const int tid = threadIdx.x, lane = tid & 63, bid = blockIdx.x, nb = gridDim.x;
    const int wave = __builtin_amdgcn_readfirstlane(tid >> 6);
    const int gtid = bid * NTHR + tid, gthreads = nb * NTHR, gwave = gtid >> 6, nwaves = gthreads >> 6;
    unsigned char* ws = a.ws;
    bf16* WINT = (bf16*)(ws + WS_WIN); bf16* WOT = (bf16*)(ws + WS_WO); bf16* WQT = (bf16*)(ws + WS_WQ);
    bf16* PROJ = (bf16*)(ws + WS_PROJ);
    bf16* XNB = (bf16*)(ws + WS_XNB);
    bf16* XACT = (bf16*)(ws + WS_XACT);
    float* DTRAW = (float*)(ws + WS_DTRAW); float* DT = (float*)(ws + WS_DT); float* ACS = (float*)(ws + WS_ACS); float* CDEC = (float*)(ws + WS_CDEC);
    float* STATES = (float*)(ws + WS_STATES); bf16* PREVT = (bf16*)(ws + WS_PREV);
    float* QP = (float*)(ws + WS_QP); int* IDX = (int*)(ws + WS_IDX); float* GATE = (float*)(ws + WS_GATE);
    float* TOPV = (float*)(ws + WS_TOPV); int* TOPI = (int*)(ws + WS_TOPI);
    unsigned char* U8 = ws + WS_U8; unsigned char* V8 = ws + WS_V8; float* SU = (float*)(ws + WS_SU); float* SV = SU + 16384; float* PART = (float*)(ws + WS_PART);
    bf16* KH = (bf16*)(ws + WS_KH); bf16* KL = (bf16*)(ws + WS_KH + 65536);
    float* MIXF = a.out;
    volatile LAS unsigned* MISC = (volatile LAS unsigned*)(ldsb + MISC_OFF);
    if (tid < 32) MISC[tid] = 0u;
    __syncthreads();
    XcdBarrier bar = xcd_barrier_post((unsigned*)ws, MISC + 8);
#define IN(k) (a.ph_lo <= (k) && (k) < a.ph_hi)
#if defined(PROBE_LO)
    int seg_ = 0; unsigned long long tseg_ = __builtin_amdgcn_s_memrealtime();
#define PROBE_SPIN() do { if (seg_ >= PROBE_LO && seg_ <= PROBE_HI) { const unsigned long long d_ = (__builtin_amdgcn_s_memrealtime() - tseg_) * PROBE_AMP; const unsigned long long s_ = __builtin_amdgcn_s_memrealtime(); \
        while (__builtin_amdgcn_s_memrealtime() - s_ < d_) __builtin_amdgcn_s_sleep(4); } } while (0)
#define GRID_BAR() do { PROBE_SPIN(); xcd_barrier(bar); tseg_ = __builtin_amdgcn_s_memrealtime(); ++seg_; } while (0)
#else
#define PROBE_SPIN() do { } while (0)
#define GRID_BAR() xcd_barrier(bar)
#endif

    if (IN(0)) {
        LAS float* scr = (LAS float*)(ldsb + wave * 16384);
        constexpr int I_IN = 16 * 72, I_O = 16 * 32, NITEMS = I_IN + 2 * I_O;
        for (int it = gwave; it < NITEMS; it += nwaves) {
            int r = it;
            if (r < I_IN) { transpose_item(a.w_in, PW, D, WINT, scr, r / 72, r % 72, lane); continue; } r -= I_IN;
            if (r < I_O) { transpose_item(a.w_out, D, D, WOT, scr, r / 32, r % 32, lane); continue; } r -= I_O;
            transpose_item(a.peer_wq, D, D, WQT, scr, r / 32, r % 32, lane);
        }
        for (int i = gtid; i < 2 * 128 * 64; i += gthreads) { const float kf = a.peer_sub_keys[i]; const short h = bfs(kf); KH[i] = (bf16)h; KL[i] = (bf16)bfs(kf - sbf2f(h)); }
        for (int i = tid; i < 8 * 1024; i += NTHR) { const int h = i & 7, c = i >> 3; *(LAS float*)(ldsb + h * 16384 + 8448 + c * 4) = a.w_in[(size_t)c * PW + ODT + h]; }
        __syncthreads();
        rmsnorm_rows_bf16<true>(a.x, a.norm_mix_g, XNB, ldsb, DTRAW, gwave, nwaves, lane);
    }
    GRID_BAR();
    if (IN(1)) {
        pg8::Gemm g{XNB, WINT, T, PS, D}; pg8::StaticOrder S; S.init(T, PS, nb, bid);
        pg8::EpiBf16Plain E{PROJ, PS};
        pg8::gemm_phase<pg8::EpiBf16Plain, pg8::StaticOrder>(ldsb, g, S, E, nullptr);
    }
    GRID_BAR();
    if (IN(2)) {
        for (int task = gtid; task < (T / 16) * 128; task += gthreads) {
            const int cg = task & 127, t0 = (task >> 7) * 16, c0 = cg * 8;
            float w[4][8], bs[8];
#pragma unroll
            for (int k = 0; k < 4; ++k) { const float4 a0 = *(const float4*)(a.conv_w + k * 1024 + c0), a1 = *(const float4*)(a.conv_w + k * 1024 + c0 + 4);
                w[k][0] = a0.x; w[k][1] = a0.y; w[k][2] = a0.z; w[k][3] = a0.w; w[k][4] = a1.x; w[k][5] = a1.y; w[k][6] = a1.z; w[k][7] = a1.w; }
            { const float4 a0 = *(const float4*)(a.conv_b + c0), a1 = *(const float4*)(a.conv_b + c0 + 4); bs[0] = a0.x; bs[1] = a0.y; bs[2] = a0.z; bs[3] = a0.w; bs[4] = a1.x; bs[5] = a1.y; bs[6] = a1.z; bs[7] = a1.w; }
            const bool has_halo = (t0 & (SEQ - 1)) != 0;
            bf16x8 rows[19];
#pragma unroll
            for (int i = 0; i < 19; ++i) {
                if (i < 3 && !has_halo) {
#pragma unroll
                    for (int e = 0; e < 8; ++e) rows[i][e] = 0;
                } else rows[i] = ldg8(PROJ + (size_t)(t0 + i - 3) * PS + OXBC + c0);
            }
#pragma unroll
            for (int i = 0; i < 16; ++i) {
                float o[8];
#pragma unroll
                for (int e = 0; e < 8; ++e) o[e] = silu_f(bs[e] + w[0][e] * sbf2f(rows[i][e]) + w[1][e] * sbf2f(rows[i + 1][e]) + w[2][e] * sbf2f(rows[i + 2][e]) + w[3][e] * sbf2f(rows[i + 3][e]));
                v4u ov; ov.x = pkbf(o[0], o[1]); ov.y = pkbf(o[2], o[3]); ov.z = pkbf(o[4], o[5]); ov.w = pkbf(o[6], o[7]);
                *(v4u*)(XACT + (size_t)(t0 + i) * 1024 + c0) = ov;
            }
        }
        if (gwave < 1024) {
            const int h = gwave & 7, bc = gwave >> 3;
            const float A = -__expf(a.a_log[h]), bias = a.dt_bias[h];
            const int t0 = bc * 128 + lane, t1 = t0 + 64;
            const float raw0 = DTRAW[t0 * 8 + h] + bias, raw1 = DTRAW[t1 * 8 + h] + bias;
            const float dt0 = fmaxf(raw0, 0.f) + log1pf(__expf(-fabsf(raw0))), dt1 = fmaxf(raw1, 0.f) + log1pf(__expf(-fabsf(raw1)));
            DT[t0 * 8 + h] = dt0; DT[t1 * 8 + h] = dt1;
            float v0 = dt0 * A, v1 = dt1 * A;
#pragma unroll
            for (int o = 1; o < 64; o <<= 1) { const float y0 = __shfl_up(v0, o), y1 = __shfl_up(v1, o); if (lane >= o) { v0 += y0; v1 += y1; } }
            v1 += __shfl(v0, 63);
            ACS[t0 * 8 + h] = v0; ACS[t1 * 8 + h] = v1;
            if (lane == 63) CDEC[gwave] = __expf(v1);
        }
    }
    GRID_BAR();
    if (IN(3)) {
        for (int u = bid; u < 512; u += nb) {
            if (u < 256) attn_unit(a.attn_sinks, ldsb, u, PROJ, MIXF, tid, lane, wave);
            else ssd_chunk_unit(ldsb, u - 256, XACT, DT, ACS, MIXF, STATES, tid, lane, wave);
        }
    }
    GRID_BAR();
    if (IN(5)) {
        for (int idx = gtid; idx < 2 * 8 * 8192; idx += gthreads) {
            const int pn = idx & 8191, h = (idx >> 13) & 7, b = idx >> 16;
            float run = 0.f;
#pragma unroll 1
            for (int c0 = 0; c0 < 64; c0 += 8) {
                float st[8], dc[8];
#pragma unroll
                for (int j = 0; j < 8; ++j) { const int bch = (b * 64 + c0 + j) * 8 + h; st[j] = STATES[(size_t)bch * 8192 + pn]; dc[j] = CDEC[bch]; }
#pragma unroll
                for (int j = 0; j < 8; ++j) { const int bch = (b * 64 + c0 + j) * 8 + h; PREVT[(size_t)bch * 8192 + pn] = f2bf(run); run = dc[j] * run + st[j]; }
            }
        }
    }
    GRID_BAR();
    if (IN(6)) {
        for (int u = bid; u < 256; u += nb) yoff_unit(a.d_skip, u, XACT, PROJ, ACS, PREVT, MIXF, lane, wave);
    }
    GRID_BAR();
    if (IN(6)) {
        for (int t = gwave; t < T; t += nwaves) {
            const float* row = MIXF + (size_t)t * D;
            const float4 a0 = *(const float4*)(row + 8 * lane), a1 = *(const float4*)(row + 8 * lane + 4);
            const float4 s0 = *(const float4*)(row + 512 + 8 * lane), s1 = *(const float4*)(row + 512 + 8 * lane + 4);
            float ssa = a0.x * a0.x + a0.y * a0.y + a0.z * a0.z + a0.w * a0.w + a1.x * a1.x + a1.y * a1.y + a1.z * a1.z + a1.w * a1.w;
            float sss = s0.x * s0.x + s0.y * s0.y + s0.z * s0.z + s0.w * s0.w + s1.x * s1.x + s1.y * s1.y + s1.z * s1.z + s1.w * s1.w;
            ssa = wave_sum(ssa);
#pragma unroll
            for (int o = 1; o < 32; o <<= 1) sss += __shfl_xor(sss, o);
            const float ra = rsqrtf(ssa * (1.f / 512.f) + EPS), rs = rsqrtf(sss * (1.f / 256.f) + EPS);
            const float4 ga0 = *(const float4*)(a.attn_out_g + 8 * lane), ga1 = *(const float4*)(a.attn_out_g + 8 * lane + 4);
            const float4 gs0 = *(const float4*)(a.ssm_norm_g + 8 * lane), gs1 = *(const float4*)(a.ssm_norm_g + 8 * lane + 4);
            v4u oa, os;
            oa.x = pkbf(a0.x * ra * ga0.x, a0.y * ra * ga0.y); oa.y = pkbf(a0.z * ra * ga0.z, a0.w * ra * ga0.w); oa.z = pkbf(a1.x * ra * ga1.x, a1.y * ra * ga1.y); oa.w = pkbf(a1.z * ra * ga1.z, a1.w * ra * ga1.w);
            os.x = pkbf(s0.x * rs * gs0.x, s0.y * rs * gs0.y); os.y = pkbf(s0.z * rs * gs0.z, s0.w * rs * gs0.w); os.z = pkbf(s1.x * rs * gs1.x, s1.y * rs * gs1.y); os.w = pkbf(s1.z * rs * gs1.z, s1.w * rs * gs1.w);
            *(v4u*)(XNB + (size_t)t * D + 8 * lane) = oa; *(v4u*)(XNB + (size_t)t * D + 512 + 8 * lane) = os;
        }
    }
    GRID_BAR();
    if (IN(7)) {
        pg8::Gemm g{XNB, WOT, T, D, D}; pg8::StaticOrder S; S.init(T, D, nb, bid);
        pg8::EpiF32Resid E{a.out, a.x, D};
        pg8::gemm_phase<pg8::EpiF32Resid, pg8::StaticOrder>(ldsb, g, S, E, nullptr);
    }
    GRID_BAR();
    if (IN(8)) {
        rmsnorm_rows_bf16<false>(a.out, a.norm_ffn_g, XNB, ldsb, nullptr, gwave, nwaves, lane);
        for (int rr = gwave; rr < 2 * 16384; rr += nwaves) {
            const int which = rr >> 14, row = rr & 16383;
            const float4* src4 = (const float4*)((which ? a.peer_v : a.peer_u) + (size_t)row * D) + lane;
            float4 v[4]; float mx = 0.f;
#pragma unroll
            for (int jq = 0; jq < 4; ++jq) { v[jq] = src4[64 * jq]; mx = fmaxf(mx, fmaxf(fmaxf(fabsf(v[jq].x), fabsf(v[jq].y)), fmaxf(fabsf(v[jq].z), fabsf(v[jq].w)))); }
#pragma unroll
            for (int o = 1; o < 64; o <<= 1) mx = fmaxf(mx, __shfl_xor(mx, o));
            const float sc = mx > 0.f ? mx * (1.f / 240.f) : 1.f, inv = 1.f / sc;
            unsigned* dst = (unsigned*)((which ? V8 : U8) + (size_t)row * D) + lane;
#pragma unroll
            for (int jq = 0; jq < 4; ++jq) { int w = __builtin_amdgcn_cvt_pk_fp8_f32(v[jq].x * inv, v[jq].y * inv, 0, false); w = __builtin_amdgcn_cvt_pk_fp8_f32(v[jq].z * inv, v[jq].w * inv, w, true); dst[64 * jq] = (unsigned)w; }
            if (lane == 0) (which ? SV : SU)[row] = sc;
        }
    }
    GRID_BAR();
    if (IN(9)) {
        pg8::Gemm g{XNB, WQT, T, D, D}; pg8::StaticOrder S; S.init(T, D, nb, bid);
        pg8::EpiF32Resid E{QP, nullptr, D};
        pg8::gemm_phase<pg8::EpiF32Resid, pg8::StaticOrder>(ldsb, g, S, E, nullptr);
    }
    GRID_BAR();
    if (IN(10)) {
        for (int task = gwave; task < T / 4; task += nwaves) route_task(task, QP, KH, KL, IDX, GATE, lane);
    }
    GRID_BAR();
    float* ACT = (float*)(ws + WS_ACT); float* PEERO = (float*)(ws + WS_PEERO);
    unsigned* ctl = (unsigned*)ws;
    const int xcc = (int)(bar.x & 7u);
    if (IN(12)) {
#pragma unroll 1
        for (int pi = 0; pi < NPART; ++pi) {
            const int p = (xcc + pi) & 7;
            for (;;) {
                if (tid == 0) MISC[16] = xb_add(&ctl[CW_QU + 64 * p], 1u);
                __syncthreads();
                const int j = (int)MISC[16];
                __syncthreads();
                if (j >= NCHUNK) break;
                peer_u_item(p, j, IDX, XNB, U8, PART, lane, wave);
            }
        }
    }
    GRID_BAR();
    if (IN(12)) {
        for (int i = gtid; i < T * 128; i += gthreads) {
            float s = 0.f;
#pragma unroll
            for (int pp = 0; pp < NPART; ++pp) s += PART[(size_t)pp * T * 128 + i];
            const int e = IDX[i]; const float z = s * SU[e];
            ACT[i] = GATE[i] * 0.5f * z * (1.f + erff(z * 0.70710678118654752f)) * SV[e];
        }
    }
    GRID_BAR();
    if (IN(13)) {
#pragma unroll 1
        for (int pi = 0; pi < NPART; ++pi) {
            const int p = (xcc + pi) & 7;
            for (;;) {
                if (tid == 0) MISC[16] = xb_add(&ctl[CW_QV + 64 * p], 1u);
                __syncthreads();
                const int j = (int)MISC[16];
                __syncthreads();
                if (j >= NCHUNK) break;
                peer_v_item(p, j, IDX, ACT, V8, PEERO, lane, wave);
            }
        }
    }
    GRID_BAR();
    if (IN(14)) {
        for (int t = gwave; t < T; t += nwaves) {
            const float4* hr = (const float4*)(a.out + (size_t)t * D) + lane; const float4* pr = (const float4*)(PEERO + (size_t)t * D) + lane;
            float4 v[4]; float ss = 0.f;
#pragma unroll
            for (int jq = 0; jq < 4; ++jq) { const float4 h4 = hr[64 * jq], p4 = pr[64 * jq]; v[jq] = make_float4(h4.x + p4.x, h4.y + p4.y, h4.z + p4.z, h4.w + p4.w); ss += v[jq].x * v[jq].x + v[jq].y * v[jq].y + v[jq].z * v[jq].z + v[jq].w * v[jq].w; }
            ss = wave_sum(ss);
            const float r3 = rsqrtf(ss * (1.f / D) + EPS);
            float4* op = (float4*)(a.out + (size_t)t * D) + lane;
#pragma unroll
            for (int jq = 0; jq < 4; ++jq) { const float4 gv = ((const float4*)a.final_norm_g)[lane + 64 * jq]; op[64 * jq] = make_float4(v[jq].x * r3 * gv.x, v[jq].y * r3 * gv.y, v[jq].z * r3 * gv.z, v[jq].w * r3 * gv.w); }
        }
    }
    PROBE_SPIN();
#undef IN
}
}

extern "C" void kernel_launch(void* const* d_in, const int* in_sizes, int n_in, void* d_out, int out_size, void* d_ws, size_t ws_size, hipStream_t stream) {
    if (n_in != 18 || out_size != T * D || ws_size < WS_END) { fprintf(stderr, "kernel_launch: unexpected shapes n_in=%d out=%d ws=%zu\n", n_in, out_size, ws_size); return; }
    Args a{};
    const float** ap = (const float**)&a;
    for (int i = 0; i < 18; ++i) ap[i] = (const float*)d_in[i];
    a.out = (float*)d_out; a.ws = (unsigned char*)d_ws;
    static int grid = 0;
    if (grid == 0) {
        int dev = 0, cus = 0, per_cu = 0;
        if (hipGetDevice(&dev) != hipSuccess || hipDeviceGetAttribute(&cus, hipDeviceAttributeMultiprocessorCount, dev) != hipSuccess) { fprintf(stderr, "kernel_launch: device query failed\n"); grid = -1; return; }
        if (hipFuncSetAttribute((const void*)k_main, hipFuncAttributeMaxDynamicSharedMemorySize, LDS_BYTES) != hipSuccess) { fprintf(stderr, "kernel_launch: hipFuncSetAttribute failed\n"); grid = -1; return; }
        if (hipOccupancyMaxActiveBlocksPerMultiprocessor(&per_cu, (const void*)k_main, NTHR, LDS_BYTES) != hipSuccess || per_cu < 1) { fprintf(stderr, "kernel_launch: occupancy query says %d blocks/CU\n", per_cu); (void)hipGetLastError(); grid = -1; return; }
        grid = cus;
    }
    if (grid < 0) return;
    if (hipMemsetAsync(d_ws, 0, 65536, stream) != hipSuccess) { fprintf(stderr, "kernel_launch: memset failed\n"); return; }
    a.ph_lo = 0; a.ph_hi = 15;
    hipLaunchKernelGGL(k_main, dim3(grid), dim3(NTHR), LDS_BYTES, stream, a);
}
```

```cpp
#include <hip/hip_runtime.h>
#include <cstdio>
#include <cstdint>

namespace pg8 {
#define PG8_LAS __attribute__((address_space(3)))
typedef unsigned short bf16_t;
typedef short bf16x8 __attribute__((ext_vector_type(8)));
typedef float f32x4 __attribute__((ext_vector_type(4)));
typedef unsigned u32x4 __attribute__((ext_vector_type(4)));
constexpr int BM = 256, BK = 64, HALF = 128, HTB = HALF * BK * 2  , STAGE_BYTES = 8 * HTB, NXCD = 8, WGM = 8;

__host__ __device__ __forceinline__ int lds_byte(int r, int c) { const int st = (r >> 4) * 2 + (c >> 5), rr = r & 15, cc = c & 31, ob = rr * 64 + cc * 2; return st * 1024 + (ob ^ (((ob >> 9) & 1) << 5)); }
__host__ __device__ __forceinline__ void stage_rc(int b, int& R, int& C) { const int st = b / 1024, sb = b % 1024, swz = sb ^ (((sb >> 9) & 1) << 5); R = (st >> 1) * 16 + swz / 64; C = (st & 1) * 32 + (swz % 64) / 2; }
__host__ __device__ __forceinline__ int perm32(int rho) { const int n = rho >> 4, i = rho & 15; return 8 * (i >> 2) + 4 * n + (i & 3); }

struct Unit { int pm, pn; };
struct Gemm { const bf16_t* A; const bf16_t* Bt; int M, N, K; };

struct StaticOrder {
    int nM, nN, nwg, G, c;
    __host__ __device__ void init(int M, int N, int G_, int c_) { nM = M / BM; nN = N / BM; nwg = nM * nN; G = G_; c = c_; }
    __host__ __device__ bool next(int i, Unit& u) const {
        const long L = (long)i * G + c; if (L >= nwg) return false;
        int wgid = (int)L; { const int q = nwg / NXCD, r = nwg % NXCD, xcd = wgid % NXCD, off = wgid / NXCD; wgid = (xcd < r ? xcd * (q + 1) : r * (q + 1) + (xcd - r) * q) + off; }
        const int nig = WGM * nN, gid = wgid / nig, fm = gid * WGM, gsz = (nM - fm) < WGM ? (nM - fm) : WGM;
        u.pm = fm + ((wgid % nig) % gsz); u.pn = (wgid % nig) / gsz; return true;
    }
    __device__ __forceinline__ void a_ready(const Unit&) const {}
    __device__ __forceinline__ void done(const Unit&) const {}
};
__device__ __forceinline__ unsigned cvt_pk_bf16(float lo, float hi) { unsigned r; asm volatile("v_cvt_pk_bf16_f32 %0, %1, %2" : "=v"(r) : "v"(lo), "v"(hi)); return r; }
typedef float f32x2 __attribute__((ext_vector_type(2)));
struct EpiBf16Plain {
    static constexpr bool PERM = true, AFTER_DRAIN = false;
    bf16_t* O; int ldc;
    __device__ __forceinline__ void operator()(const f32x4 (&acc)[2][2][4][2], const Unit& u, int wr, int wc, int fr, int fq) const {
        const int row0 = u.pm * BM + wr * 64 + fr, col0 = u.pn * BM + wc * 32 + 8 * fq;
#pragma unroll
        for (int ai = 0; ai < 2; ++ai)
#pragma unroll
            for (int m = 0; m < 4; ++m) { bf16_t* rowp = O + (size_t)(row0 + ai * HALF + m * 16) * ldc + col0;
#pragma unroll
                for (int bj = 0; bj < 2; ++bj) { const f32x4 v0 = acc[ai][bj][m][0], v1 = acc[ai][bj][m][1];
                    u32x4 w; w.x = cvt_pk_bf16(v0[0], v0[1]); w.y = cvt_pk_bf16(v0[2], v0[3]); w.z = cvt_pk_bf16(v1[0], v1[1]); w.w = cvt_pk_bf16(v1[2], v1[3]);
                    *(u32x4*)(rowp + bj * HALF) = w; } }
    }
};
struct EpiF32Resid {
    static constexpr bool PERM = false, AFTER_DRAIN = false;
    float* C; const float* R; int ldc;
    __device__ __forceinline__ void operator()(const f32x4 (&acc)[2][2][4][2], const Unit& u, int wr, int wc, int fr, int fq) const {
        const int row0 = u.pm * BM + wr * 64 + fr, col0 = u.pn * BM + wc * 32 + 4 * fq;
#pragma unroll
        for (int ai = 0; ai < 2; ++ai)
#pragma unroll
            for (int m = 0; m < 4; ++m) { const size_t off = (size_t)(row0 + ai * HALF + m * 16) * ldc + col0;
#pragma unroll
                for (int bj = 0; bj < 2; ++bj)
#pragma unroll
                    for (int n = 0; n < 2; ++n) { f32x4 v = acc[ai][bj][m][n]; if (R) v += *(const f32x4*)(R + off + bj * HALF + n * 16); *(f32x4*)(C + off + bj * HALF + n * 16) = v; }
                asm volatile("" ::: "memory"); }
    }
};
template <class Epi, class Sched, bool STAMP = false>
__device__ __forceinline__ void gemm_phase(PG8_LAS unsigned char* lds, const Gemm g, const Sched& S, const Epi& E, unsigned long long* stamps) {
    const int tid = threadIdx.x, wid = __builtin_amdgcn_readfirstlane(tid >> 6), lane = tid & 63, wr = wid >> 2, wc = wid & 3, fr = lane & 15, fq = lane >> 4;
    const int K = g.K, nt = K / BK;
    int ts_lo = 0, ts_hi = 0, nts = 0; const unsigned long long rt_entry = STAMP ? (unsigned long long)0ull : 0ull;
#define PG8_STAMP() do { if (STAMP && wid == 0 && nts < 64) { const unsigned long long _c = (unsigned long long)clock64(); \
        ts_lo = (lane == nts) ? (int)(unsigned)_c : ts_lo; ts_hi = (lane == nts) ? (int)(unsigned)(_c >> 32) : ts_hi; ++nts; } } while (0)
    PG8_STAMP();
    unsigned voffA[2], voffB[2];
#pragma unroll
    for (int i = 0; i < 2; ++i) { int R, C; stage_rc(tid * 16 + i * 8192, R, C); const int Rb = Epi::PERM ? ((R & ~31) + perm32(R & 31)) : R;
        voffA[i] = (unsigned)(R * K + C) * 2u; voffB[i] = (unsigned)(Rb * K + C) * 2u; }
    const size_t kstep = (size_t)(BK * 2);
    const size_t hstep = (size_t)HALF * K * 2;
    const size_t tstep = 2 * hstep;
    const unsigned ldsw = (unsigned)wid * 1024u;
    const int aoff = lds_byte(wr * 64 + fr, fq * 8), boff = lds_byte(wc * 32 + fr, fq * 8);
#define PG8_SA(b, h) (((b) * 2 + (h)) * HTB)
#define PG8_SB(b, h) ((4 + (b) * 2 + (h)) * HTB)
#define PG8_STAGE(bufoff, gbase, voff) do { _Pragma("unroll") for (int _i = 0; _i < 2; ++_i) \
        __builtin_amdgcn_global_load_lds((const unsigned*)((const char*)(gbase) + (voff)[_i]), (PG8_LAS unsigned*)(lds + (bufoff) + ldsw + _i * 8192), 16, 0, 0); } while (0)
#define PG8_LDA(dst, b, h) do { _Pragma("unroll") for (int m = 0; m < 4; ++m) _Pragma("unroll") for (int k = 0; k < 2; ++k) dst[m][k] = *(const PG8_LAS bf16x8*)(lds + PG8_SA(b, h) + aoff + m * 2048 + k * 1024); } while (0)
#define PG8_LDB(dst, b, h) do { _Pragma("unroll") for (int n = 0; n < 2; ++n) _Pragma("unroll") for (int k = 0; k < 2; ++k) dst[n][k] = *(const PG8_LAS bf16x8*)(lds + PG8_SB(b, h) + boff + n * 2048 + k * 1024); } while (0)
#define PG8_MMA(ai, bj, At, Bt) do { __builtin_amdgcn_s_setprio(1); _Pragma("unroll") for (int m = 0; m < 4; ++m) _Pragma("unroll") for (int n = 0; n < 2; ++n) _Pragma("unroll") for (int k = 0; k < 2; ++k) \
        acc[ai][bj][m][n] = __builtin_amdgcn_mfma_f32_16x16x32_bf16(Bt[n][k], At[m][k], acc[ai][bj][m][n], 0, 0, 0); __builtin_amdgcn_s_setprio(0); } while (0)
#define PG8_WAIT_V(n) asm volatile("s_waitcnt vmcnt(" #n ")" ::: "memory")
#define PG8_WAIT_L(n) asm volatile("s_waitcnt lgkmcnt(" #n ")" ::: "memory")
#define PG8_BAR __builtin_amdgcn_s_barrier()
#define PG8_SCHED __builtin_amdgcn_sched_barrier(0)
    Unit cur, nxt; int ui = 0;
    if (!S.next(0, cur)) return;
    f32x4 acc[2][2][4][2];
#pragma unroll
    for (int a = 0; a < 2; ++a)
#pragma unroll
        for (int b = 0; b < 2; ++b)
#pragma unroll
            for (int m = 0; m < 4; ++m)
#pragma unroll
                for (int n = 0; n < 2; ++n) acc[a][b][m][n] = (f32x4){0.f, 0.f, 0.f, 0.f};
    bf16x8 At[4][2], B0[2][2], B1[2][2];
    const char* cA = (const char*)g.A + (size_t)cur.pm * tstep; const char* cB = (const char*)g.Bt + (size_t)cur.pn * tstep;
    S.a_ready(cur);
    PG8_STAGE(PG8_SB(0, 0), cB, voffB); PG8_STAGE(PG8_SA(0, 0), cA, voffA); PG8_STAGE(PG8_SB(0, 1), cB + hstep, voffB); PG8_STAGE(PG8_SA(0, 1), cA + hstep, voffA);
    if (wr == 1) PG8_BAR;
    PG8_WAIT_V(4); PG8_BAR;
    PG8_STAGE(PG8_SB(1, 0), cB + kstep, voffB); PG8_STAGE(PG8_SA(1, 0), cA + kstep, voffA); PG8_STAGE(PG8_SB(1, 1), cB + hstep + kstep, voffB);
    PG8_WAIT_V(6); PG8_BAR;
    PG8_STAMP();
    for (;;) {
        const bool has_next = S.next(ui + 1, nxt);
        const char* nA = has_next ? (const char*)g.A + (size_t)nxt.pm * tstep : cA; const char* nB = has_next ? (const char*)g.Bt + (size_t)nxt.pn * tstep : cB;
        for (int t = 0; t < nt; t += 2) {
            const bool last = (t == nt - 2);
            const char* a1 = cA + (size_t)(t + 1) * kstep;
            const char* a2 = last ? nA : cA + (size_t)(t + 2) * kstep; const char* b2 = last ? nB : cB + (size_t)(t + 2) * kstep;
            const char* a3 = a2 + kstep; const char* b3 = b2 + kstep;
            if (last && has_next) S.a_ready(nxt);
            PG8_LDB(B0, 0, 0); PG8_SCHED; PG8_LDA(At, 0, 0); PG8_STAGE(PG8_SA(1, 1), a1 + hstep, voffA);
            PG8_WAIT_L(8); PG8_BAR; PG8_WAIT_L(0); PG8_MMA(0, 0, At, B0); PG8_BAR; PG8_SCHED;
            PG8_LDB(B1, 0, 1); PG8_STAGE(PG8_SB(0, 0), b2, voffB);
            PG8_BAR; PG8_WAIT_L(0); PG8_MMA(0, 1, At, B1); PG8_BAR;
            PG8_LDA(At, 0, 1); PG8_STAGE(PG8_SA(0, 0), a2, voffA);
            PG8_BAR; PG8_WAIT_L(0); PG8_MMA(1, 0, At, B0); PG8_BAR; PG8_SCHED;
            PG8_STAGE(PG8_SB(0, 1), b2 + hstep, voffB);
            PG8_WAIT_V(6); PG8_BAR; PG8_MMA(1, 1, At, B1); PG8_BAR;
            PG8_LDB(B0, 1, 0); PG8_SCHED; PG8_LDA(At, 1, 0); PG8_STAGE(PG8_SA(0, 1), a2 + hstep, voffA);
            PG8_WAIT_L(8); PG8_BAR; PG8_WAIT_L(0); PG8_MMA(0, 0, At, B0); PG8_BAR; PG8_SCHED;
            PG8_LDB(B1, 1, 1); PG8_STAGE(PG8_SB(1, 0), b3, voffB);
            PG8_BAR; PG8_WAIT_L(0); PG8_MMA(0, 1, At, B1); PG8_BAR;
            PG8_LDA(At, 1, 1); PG8_STAGE(PG8_SA(1, 0), a3, voffA);
            PG8_BAR; PG8_WAIT_L(0); PG8_MMA(1, 0, At, B0); PG8_BAR; PG8_SCHED;
            PG8_STAGE(PG8_SB(1, 1), b3 + hstep, voffB);
            PG8_WAIT_V(6); PG8_BAR; PG8_MMA(1, 1, At, B1); PG8_BAR;
        }
        PG8_STAMP();
        if constexpr (!Epi::AFTER_DRAIN) { E(acc, cur, wr, wc, fr, fq); S.done(cur); }
        PG8_STAMP();
        if (!has_next) break;
#pragma unroll
        for (int a = 0; a < 2; ++a)
#pragma unroll
            for (int b = 0; b < 2; ++b)
#pragma unroll
                for (int m = 0; m < 4; ++m)
#pragma unroll
                    for (int n = 0; n < 2; ++n) acc[a][b][m][n] = (f32x4){0.f, 0.f, 0.f, 0.f};
        cur = nxt; cA = nA; cB = nB; ++ui;
    }
    PG8_WAIT_V(0);
    if (wr == 0) PG8_BAR;
    PG8_BAR;
    if constexpr (Epi::AFTER_DRAIN) { E.fused(acc, cur, wr, wc, fr, fq, lds, wid, lane); S.done(cur); }
    PG8_STAMP();
    if (STAMP && wid == 0) { stamps[lane] = lane < nts ? (((unsigned long long)(unsigned)ts_hi << 32) | (unsigned)ts_lo) : 0ull;
        if (lane == 62) stamps[62] = rt_entry; if (lane == 63) stamps[63] = (unsigned long long)0ull; }
#undef PG8_STAMP
#undef PG8_SA
#undef PG8_SB
#undef PG8_STAGE
#undef PG8_LDA
#undef PG8_LDB
#undef PG8_MMA
#undef PG8_WAIT_V
#undef PG8_WAIT_L
#undef PG8_BAR
#undef PG8_SCHED
}
}

namespace {
constexpr int D = 1024, BATCH = 2, SEQ = 8192, T = BATCH * SEQ;
constexpr int PW = 2312;
constexpr int PS = 2304;
constexpr int OQ = 0, OKK = 512, OV = 640, OZ = 768, OXBC = 1280, ODT = 2304;
constexpr float EPS = 1e-6f;
constexpr int NTHR = 512;
typedef unsigned short bf16;
typedef unsigned v4u __attribute__((ext_vector_type(4)));

constexpr size_t MiB = 1u << 20;
constexpr size_t WS_WIN = 1 * MiB;
constexpr size_t WS_KH = 5 * MiB + 512 * 1024;
constexpr size_t WS_WO = 6 * MiB;
constexpr size_t WS_WQ = 8 * MiB;
constexpr size_t WS_PROJ = 10 * MiB;
constexpr size_t WS_XNB = 82 * MiB;
constexpr size_t WS_XACT = 114 * MiB;
constexpr size_t WS_DTRAW = 146 * MiB;
constexpr size_t WS_DT = WS_DTRAW + 512 * 1024;
constexpr size_t WS_ACS = WS_DT + 512 * 1024;
constexpr size_t WS_CDEC = WS_ACS + 512 * 1024;
constexpr size_t WS_STATES = 164 * MiB;
constexpr size_t WS_PREV = 196 * MiB;
constexpr size_t WS_QP = 10 * MiB;
constexpr size_t WS_IDX = 74 * MiB;
constexpr size_t WS_GATE = 114 * MiB;
constexpr size_t WS_TOPV = 122 * MiB;
constexpr size_t WS_TOPI = 138 * MiB;
constexpr size_t WS_ACT = 122 * MiB;
constexpr size_t WS_SU = 130 * MiB;
constexpr size_t WS_U8 = 132 * MiB;
constexpr size_t WS_V8 = 148 * MiB;
constexpr size_t WS_PART = 164 * MiB;
constexpr size_t WS_XQ = 228 * MiB;
constexpr size_t WS_XS = 244 * MiB;
constexpr size_t WS_PEERO = 10 * MiB;
constexpr size_t WS_END = 245 * MiB;
constexpr int CW_QU = 4096, CW_QV = 4096 + 64 * 16;
constexpr int NPART = 8, NCHUNK = T / 64;

struct Args {
    const float* x; const float* norm_mix_g; const float* w_in; const float* attn_sinks; const float* attn_out_g;
    const float* conv_w; const float* conv_b; const float* dt_bias; const float* a_log; const float* d_skip;
    const float* ssm_norm_g; const float* w_out; const float* norm_ffn_g; const float* peer_wq; const float* peer_sub_keys;
    const float* peer_u; const float* peer_v; const float* final_norm_g;
    float* out; unsigned char* ws;
    int ph_lo, ph_hi;
};

#define LAS __attribute__((address_space(3)))
#define LDS_WAIT() asm volatile("s_waitcnt lgkmcnt(0)" ::: "memory")
__device__ __forceinline__ float bf2f(bf16 v) { return __uint_as_float(((unsigned)v) << 16); }
__device__ __forceinline__ unsigned f2bfu(float f) { unsigned u = __float_as_uint(f); return (u + 0x7fffu + ((u >> 16) & 1u)) >> 16; }
__device__ __forceinline__ bf16 f2bf(float f) { return (bf16)f2bfu(f); }
__device__ __forceinline__ unsigned pk2(float lo, float hi) { return f2bfu(lo) | (f2bfu(hi) << 16); }
__device__ __forceinline__ float wave_sum(float v) {
#pragma unroll
    for (int o = 1; o < 64; o <<= 1) v += __shfl_xor(v, o);
    return v;
}
__device__ __forceinline__ float silu_f(float v) { return v / (1.f + __expf(-v)); }

__device__ __forceinline__ void transpose_item(const float* W, int ldw, int K, bf16* WT, LAS float* scr, int kb, int nbk, int lane) {
    const int k0 = 64 * kb, n0 = 32 * nbk;
#pragma unroll 8
    for (int i = 0; i < 32; ++i) { const int kk = 2 * i + (lane >> 5); scr[kk * 33 + (lane & 31)] = W[(size_t)(k0 + kk) * ldw + n0 + (lane & 31)]; }
    LDS_WAIT();
    const int c = lane & 7;
#pragma unroll
    for (int j = 0; j < 4; ++j) { const int n = (lane >> 3) + 8 * j; const LAS float* s = scr + (8 * c) * 33 + n;
        v4u o; o.x = pk2(s[0 * 33], s[1 * 33]); o.y = pk2(s[2 * 33], s[3 * 33]); o.z = pk2(s[4 * 33], s[5 * 33]); o.w = pk2(s[6 * 33], s[7 * 33]);
        *(v4u*)(WT + (size_t)(n0 + n) * K + k0 + 8 * c) = o; }
    LDS_WAIT();
}

template <int MODE  >
__device__ __forceinline__ void rmsnorm_rows_bf16(const float* in, const float* g, bf16* outp, const LAS unsigned char* ldsb, float* dtraw, unsigned char* xq, float* xs, int gwave, int nwaves, int lane) {
    for (int row = gwave; row < T; row += nwaves) {
        const float4* xr = (const float4*)(in + (size_t)row * D) + lane;
        float4 v[4]; float ss = 0.f;
#pragma unroll
        for (int j = 0; j < 4; ++j) { v[j] = xr[64 * j]; ss += v[j].x * v[j].x + v[j].y * v[j].y + v[j].z * v[j].z + v[j].w * v[j].w; }
        ss = wave_sum(ss);
        const float r = rsqrtf(ss * (1.f / D) + EPS);
        unsigned long long* o8 = (unsigned long long*)(outp + (size_t)row * D) + lane;
        float dacc[8]; float y[4][4]; float mx = 0.f;
#pragma unroll
        for (int h = 0; h < 8; ++h) dacc[h] = 0.f;
#pragma unroll
        for (int j = 0; j < 4; ++j) {
            const float4 gv = ((const float4*)g)[lane + 64 * j];
            y[j][0] = v[j].x * r * gv.x; y[j][1] = v[j].y * r * gv.y; y[j][2] = v[j].z * r * gv.z; y[j][3] = v[j].w * r * gv.w;
            o8[64 * j] = (unsigned long long)pk2(y[j][0], y[j][1]) | ((unsigned long long)pk2(y[j][2], y[j][3]) << 32);
            if (MODE == 2) mx = fmaxf(mx, fmaxf(fmaxf(fabsf(y[j][0]), fabsf(y[j][1])), fmaxf(fabsf(y[j][2]), fabsf(y[j][3]))));
            if (MODE == 1) {
#pragma unroll
                for (int h = 0; h < 8; ++h) {
                    typedef float f4v __attribute__((ext_vector_type(4)));
                    const f4v wv = *(const LAS f4v*)(ldsb + h * 16384 + 8448 + (256 * j + 4 * lane) * 4);
                    dacc[h] += y[j][0] * wv.x + y[j][1] * wv.y + y[j][2] * wv.z + y[j][3] * wv.w;
                }
            }
        }
        if (MODE == 1) {
#pragma unroll
            for (int h = 0; h < 8; ++h) dacc[h] = wave_sum(dacc[h]);
            if (lane == 0) { float4* dp = (float4*)(dtraw + (size_t)row * 8); dp[0] = make_float4(dacc[0], dacc[1], dacc[2], dacc[3]); dp[1] = make_float4(dacc[4], dacc[5], dacc[6], dacc[7]); }
        }
        if (MODE == 2) {
#pragma unroll
            for (int o = 1; o < 64; o <<= 1) mx = fmaxf(mx, __shfl_xor(mx, o));
            const float sc = mx > 0.f ? mx * (1.f / 127.f) : 1.f, inv = 1.f / sc;
            unsigned* dq = (unsigned*)(xq + (size_t)row * D) + lane;
#pragma unroll
            for (int j = 0; j < 4; ++j) { const int q0 = (int)rintf(y[j][0] * inv), q1 = (int)rintf(y[j][1] * inv), q2 = (int)rintf(y[j][2] * inv), q3 = (int)rintf(y[j][3] * inv);
                dq[64 * j] = (unsigned)(q0 & 255) | ((unsigned)(q1 & 255) << 8) | ((unsigned)(q2 & 255) << 16) | ((unsigned)(q3 & 255) << 24); }
            if (lane == 0) xs[row] = sc;
        }
    }
}

typedef short bf16x8 __attribute__((ext_vector_type(8)));
typedef short bf16x4 __attribute__((ext_vector_type(4)));
typedef float f32x16 __attribute__((ext_vector_type(16)));
typedef __bf16 bf2_t __attribute__((ext_vector_type(2)));
#define MFMA32(a, b, c) __builtin_amdgcn_mfma_f32_32x32x16_bf16((a), (b), (c), 0, 0, 0)
__device__ __forceinline__ unsigned pkbf(float lo, float hi) { bf2_t v = {(__bf16)lo, (__bf16)hi}; return __builtin_bit_cast(unsigned, v); }
__device__ __forceinline__ short bfs(float f) { return __builtin_bit_cast(short, (__bf16)f); }
__device__ __forceinline__ float sbf2f(short v) { return __uint_as_float(((unsigned)(unsigned short)v) << 16); }
__device__ __forceinline__ int crow(int i, int hi) { return (i & 3) + 8 * (i >> 2) + 4 * hi; }
template <int S> __device__ __forceinline__ bf16x8 pack8(const f32x16& x) {
    v4u p; p.x = pkbf(x[8 * S], x[8 * S + 1]); p.y = pkbf(x[8 * S + 2], x[8 * S + 3]); p.z = pkbf(x[8 * S + 4], x[8 * S + 5]); p.w = pkbf(x[8 * S + 6], x[8 * S + 7]);
    return __builtin_bit_cast(bf16x8, p);
}
__device__ __forceinline__ bf16x8 ldg8(const bf16* p) { return *(const bf16x8*)p; }
__device__ __forceinline__ bf16x8 lds8(const LAS bf16* p) { return *(const LAS bf16x8*)p; }
__device__ __forceinline__ bf16x8 lds4x2(const LAS bf16* p) { const bf16x4 a = *(const LAS bf16x4*)p, b = *(const LAS bf16x4*)(p + 8); return __builtin_shufflevector(a, b, 0, 1, 2, 3, 4, 5, 6, 7); }
__device__ __forceinline__ f32x16 zero16() { f32x16 z;
#pragma unroll
    for (int i = 0; i < 16; ++i) z[i] = 0.f;
    return z; }

__device__ __forceinline__ void attn_unit(const float* sinks, LAS unsigned char* ldsb, int unit, const bf16* PROJ, float* MIXF, int tid, int lane, int wave) {
    const int hkv = unit & 1, blk = unit >> 1, nbk = blk & 63;
    const int tokblk = blk * 128, wbase = tokblk - 128;
    LAS bf16* VT = (LAS bf16*)ldsb;
#pragma unroll
    for (int i = 0; i < 4; ++i) {
        const int c = tid + 512 * i, key = c >> 3, d0 = (c & 7) * 8; const bool valid = (nbk > 0) || (key >= 128);
        bf16x8 v;
#pragma unroll
        for (int e = 0; e < 8; ++e) v[e] = 0;
        if (valid) v = ldg8(PROJ + (size_t)(wbase + key) * PS + OV + hkv * 64 + d0);
#pragma unroll
        for (int e = 0; e < 8; ++e) VT[(d0 + e) * 264 + key] = (bf16)v[e];
    }
    __syncthreads();
    const int r = lane & 31, hi = lane >> 5;
    const int hq = hkv * 4 + (wave & 3);
    const float slope = exp2f(-(float)(hq + 1)), sink = sinks[hq];
#pragma unroll 1
    for (int qq = 0; qq < 2; ++qq) {
        const int qt = (wave >> 2) + 2 * qq;
        const int tq = tokblk + 32 * qt + r;
        bf16x8 qf[4];
#pragma unroll
        for (int ks = 0; ks < 4; ++ks) qf[ks] = ldg8(PROJ + (size_t)tq * PS + OQ + hq * 64 + 16 * ks + 8 * hi);
        f32x16 X[5];
#pragma unroll
        for (int kt = 0; kt < 5; ++kt) {
            const int key = 32 * (qt + kt) + r; const bool valid = (nbk > 0) || (key >= 128);
            const int row = valid ? (wbase + key) : tokblk;
            X[kt] = zero16();
#pragma unroll
            for (int ks = 0; ks < 4; ++ks) { const bf16x8 kf = ldg8(PROJ + (size_t)row * PS + OKK + hkv * 64 + 16 * ks + 8 * hi); X[kt] = MFMA32(kf, qf[ks], X[kt]); }
        }
        const int qi = 32 * qt + r;
        float m = -1e30f;
#pragma unroll
        for (int kt = 0; kt < 5; ++kt)
#pragma unroll
            for (int i = 0; i < 16; ++i) {
                const int ki = 32 * (qt + kt) + crow(i, hi), dist = 128 + qi - ki;
                const bool valid = (dist >= 0) && (dist < 128) && ((nbk > 0) || (ki >= 128));
                const float lg = valid ? (X[kt][i] * 0.125f - slope * (float)dist) : -1e30f;
                X[kt][i] = lg; m = fmaxf(m, lg);
            }
        m = fmaxf(m, __shfl_xor(m, 32)); m = fmaxf(m, sink);
        float lsum = 0.f;
#pragma unroll
        for (int kt = 0; kt < 5; ++kt)
#pragma unroll
            for (int i = 0; i < 16; ++i) { const float p = __expf(X[kt][i] - m); X[kt][i] = p; lsum += p; }
        lsum += __shfl_xor(lsum, 32); lsum += __expf(sink - m);
        f32x16 O0 = zero16(), O1 = zero16();
#pragma unroll
        for (int kt = 0; kt < 5; ++kt) {
            const int kb = 32 * (qt + kt) + 4 * hi;
            { const bf16x8 xs = pack8<0>(X[kt]); const bf16x8 a0 = lds4x2(VT + r * 264 + kb), a1 = lds4x2(VT + (32 + r) * 264 + kb); O0 = MFMA32(a0, xs, O0); O1 = MFMA32(a1, xs, O1); }
            { const bf16x8 xs = pack8<1>(X[kt]); const bf16x8 a0 = lds4x2(VT + r * 264 + kb + 16), a1 = lds4x2(VT + (32 + r) * 264 + kb + 16); O0 = MFMA32(a0, xs, O0); O1 = MFMA32(a1, xs, O1); }
        }
        const float inv = 1.f / lsum;
        float* orow = MIXF + (size_t)tq * D + hq * 64 + 4 * hi;
#pragma unroll
        for (int q4 = 0; q4 < 4; ++q4) {
            *(float4*)(orow + 8 * q4) = make_float4(O0[4 * q4] * inv, O0[4 * q4 + 1] * inv, O0[4 * q4 + 2] * inv, O0[4 * q4 + 3] * inv);
            *(float4*)(orow + 32 + 8 * q4) = make_float4(O1[4 * q4] * inv, O1[4 * q4 + 1] * inv, O1[4 * q4 + 2] * inv, O1[4 * q4 + 3] * inv);
        }
    }
    __syncthreads();
}

__device__ __forceinline__ void ssd_chunk_unit(LAS unsigned char* ldsb, int unit, const bf16* XACT, const float* DT, const float* ACS, float* MIXF, float* STATES, int tid, int lane, int wave) {
    const int g = unit & 1, bc = unit >> 1, tok0 = bc * 128;
    LAS bf16* BT = (LAS bf16*)ldsb;
    LAS bf16* XD = (LAS bf16*)(ldsb + 34816);
    LAS bf16* XW = (LAS bf16*)(ldsb + 34816 + 34816);
    LAS float* ACST = (LAS float*)(ldsb + 34816 * 3);
    const int r = lane & 31, hi = lane >> 5;
#pragma unroll
    for (int i = 0; i < 4; ++i) {
        const int c = tid + 512 * i, s = c >> 4, n0 = (c & 15) * 8;
        const bf16x8 v = ldg8(XACT + (size_t)(tok0 + s) * 1024 + 512 + g * 128 + n0);
#pragma unroll
        for (int e = 0; e < 8; ++e) BT[(n0 + e) * 136 + s] = (bf16)v[e];
    }
    ACST[tid] = ACS[(size_t)(tok0 + (tid >> 2)) * 8 + g * 4 + (tid & 3)];
#pragma unroll 1
    for (int hp = 0; hp < 2; ++hp) {
        if (hp) __syncthreads();
#pragma unroll
        for (int i = 0; i < 4; ++i) {
            const int c = tid + 512 * i, hsel = c >> 10, s = (c >> 3) & 127, p0 = (c & 7) * 8, H = g * 4 + 2 * hp + hsel;
            const bf16x8 v = ldg8(XACT + (size_t)(tok0 + s) * 1024 + H * 64 + p0);
            const float dtv = DT[(size_t)(tok0 + s) * 8 + H];
            const float w = __expf(ACS[(size_t)(tok0 + 127) * 8 + H] - ACS[(size_t)(tok0 + s) * 8 + H]);
#pragma unroll
            for (int e = 0; e < 8; ++e) { const float xd = sbf2f(v[e]) * dtv; XD[hsel * 8704 + (p0 + e) * 136 + s] = (bf16)bfs(xd); XW[hsel * 8704 + (p0 + e) * 136 + s] = (bf16)bfs(xd * w); }
        }
        __syncthreads();
        {
            const int lt = wave & 3, hsel = wave >> 2, hh = 2 * hp + hsel, H = g * 4 + hh;
            const int l = 32 * lt + r; const float acs_l = ACST[l * 4 + hh];
            bf16x8 cf[8];
#pragma unroll
            for (int ks = 0; ks < 8; ++ks) cf[ks] = ldg8(XACT + (size_t)(tok0 + l) * 1024 + 768 + g * 128 + 16 * ks + 8 * hi);
            f32x16 Z0 = zero16(), Z1 = zero16();
#pragma unroll 1
            for (int st = 0; st <= lt; ++st) {
                f32x16 X = zero16();
#pragma unroll
                for (int ks = 0; ks < 8; ++ks) { const bf16x8 bfr = ldg8(XACT + (size_t)(tok0 + 32 * st + r) * 1024 + 512 + g * 128 + 16 * ks + 8 * hi); X = MFMA32(bfr, cf[ks], X); }
#pragma unroll
                for (int i = 0; i < 16; ++i) { const int s = 32 * st + crow(i, hi); const float f = (s <= l) ? __expf(acs_l - ACST[s * 4 + hh]) : 0.f; X[i] *= f; }
                const int sb = 32 * st + 4 * hi;
                { const bf16x8 xs = pack8<0>(X); const bf16x8 b0 = lds4x2(XD + hsel * 8704 + r * 136 + sb), b1 = lds4x2(XD + hsel * 8704 + (32 + r) * 136 + sb); Z0 = MFMA32(xs, b0, Z0); Z1 = MFMA32(xs, b1, Z1); }
                { const bf16x8 xs = pack8<1>(X); const bf16x8 b0 = lds4x2(XD + hsel * 8704 + r * 136 + sb + 16), b1 = lds4x2(XD + hsel * 8704 + (32 + r) * 136 + sb + 16); Z0 = MFMA32(xs, b0, Z0); Z1 = MFMA32(xs, b1, Z1); }
            }
#pragma unroll
            for (int i = 0; i < 16; ++i) { float* o = MIXF + (size_t)(tok0 + 32 * lt + crow(i, hi)) * D + 512 + H * 64 + r; o[0] = Z0[i]; o[32] = Z1[i]; }
        }
        {
            const int nt = wave & 3, hsel = wave >> 2, H = g * 4 + 2 * hp + hsel;
            f32x16 S0 = zero16(), S1 = zero16();
#pragma unroll
            for (int ks = 0; ks < 8; ++ks) {
                const bf16x8 btf = lds8(BT + (32 * nt + r) * 136 + 16 * ks + 8 * hi);
                const bf16x8 a0 = lds8(XW + hsel * 8704 + r * 136 + 16 * ks + 8 * hi), a1 = lds8(XW + hsel * 8704 + (32 + r) * 136 + 16 * ks + 8 * hi);
                S0 = MFMA32(a0, btf, S0); S1 = MFMA32(a1, btf, S1);
            }
            float* sp = STATES + (size_t)(bc * 8 + H) * 8192 + 32 * nt + r;
#pragma unroll
            for (int i = 0; i < 16; ++i) { const int p = crow(i, hi); sp[p * 128] = S0[i]; sp[(32 + p) * 128] = S1[i]; }
        }
    }
    __syncthreads();
}

__device__ __forceinline__ void yoff_unit(const float* d_skip, int unit, const bf16* XACT, const bf16* PROJ, const float* ACS, const bf16* PREVT, float* MIXF, int lane, int wave) {
    const int g = unit & 1, bc = unit >> 1, tok0 = bc * 128;
    const int r = lane & 31, hi = lane >> 5, lt = wave & 3, hpair = wave >> 2;
    bf16x8 cf[8];
#pragma unroll
    for (int ks = 0; ks < 8; ++ks) cf[ks] = ldg8(XACT + (size_t)(tok0 + 32 * lt + r) * 1024 + 768 + g * 128 + 16 * ks + 8 * hi);
#pragma unroll 1
    for (int hsel = 0; hsel < 2; ++hsel) {
        const int H = g * 4 + 2 * hpair + hsel; const bf16* pv = PREVT + (size_t)(bc * 8 + H) * 8192;
        f32x16 Y0 = zero16(), Y1 = zero16();
#pragma unroll
        for (int ks = 0; ks < 8; ++ks) {
            const bf16x8 b0 = ldg8(pv + r * 128 + 16 * ks + 8 * hi), b1 = ldg8(pv + (32 + r) * 128 + 16 * ks + 8 * hi);
            Y0 = MFMA32(cf[ks], b0, Y0); Y1 = MFMA32(cf[ks], b1, Y1);
        }
        const float dsk = d_skip[H];
        float eav[16];
#pragma unroll
        for (int i = 0; i < 16; ++i) eav[i] = ACS[(unsigned)((tok0 + 32 * lt + crow(i, hi)) * 8 + H)];
#pragma unroll
        for (int pt = 0; pt < 2; ++pt) {
            const unsigned col = (unsigned)(H * 64 + 32 * pt + r);
            float yo[16], xsv[16], zv[16];
#pragma unroll
            for (int i = 0; i < 16; ++i) { const unsigned t = (unsigned)(tok0 + 32 * lt + crow(i, hi));
                yo[i] = MIXF[t * 1024u + 512u + col]; xsv[i] = bf2f(XACT[t * 1024u + col]); zv[i] = bf2f(PROJ[t * (unsigned)PS + (unsigned)OZ + col]); }
#pragma unroll
            for (int i = 0; i < 16; ++i) { const unsigned t = (unsigned)(tok0 + 32 * lt + crow(i, hi));
                const float y = yo[i] + __expf(eav[i]) * (pt ? Y1[i] : Y0[i]) + dsk * xsv[i];
                MIXF[t * 1024u + 512u + col] = y * silu_f(zv[i]); }
        }
    }
}
typedef float f32x2 __attribute__((ext_vector_type(2)));
__device__ __forceinline__ void fp8x16_to_f32(const uint4 w, float (&f)[16]) {
    const int ww[4] = {(int)w.x, (int)w.y, (int)w.z, (int)w.w};
#pragma unroll
    for (int q = 0; q < 4; ++q) { const f32x2 a = __builtin_amdgcn_cvt_pk_f32_fp8(ww[q], false), b = __builtin_amdgcn_cvt_pk_f32_fp8(ww[q], true); f[4 * q] = a.x; f[4 * q + 1] = a.y; f[4 * q + 2] = b.x; f[4 * q + 3] = b.y; }
}
template <int M4, int M2, int M1> __device__ __forceinline__ void treduce16(const float (&a)[16], int lane, float& r0, float& r1) {
    float b[8], c[4];
    { const bool hi = (lane & M4) != 0;
#pragma unroll
      for (int i = 0; i < 8; ++i) { const float send = hi ? a[i] : a[i + 8]; const float recv = __shfl_xor(send, M4); b[i] = (hi ? a[i + 8] : a[i]) + recv; } }
    { const bool hi = (lane & M2) != 0;
#pragma unroll
      for (int i = 0; i < 4; ++i) { const float send = hi ? b[i] : b[i + 4]; const float recv = __shfl_xor(send, M2); c[i] = (hi ? b[i + 4] : b[i]) + recv; } }
    { const bool hi = (lane & M1) != 0;
      { const float send = hi ? c[0] : c[2]; const float recv = __shfl_xor(send, M1); r0 = (hi ? c[2] : c[0]) + recv; }
      { const float send = hi ? c[1] : c[3]; const float recv = __shfl_xor(send, M1); r1 = (hi ? c[3] : c[1]) + recv; } }
}
template <int M4, int M2, int M1> __device__ __forceinline__ void treduce16i(const int (&a)[16], int lane, int& r0, int& r1) {
    int b[8], c[4];
    { const bool hi = (lane & M4) != 0;
#pragma unroll
      for (int i = 0; i < 8; ++i) { const int send = hi ? a[i] : a[i + 8]; const int recv = __shfl_xor(send, M4); b[i] = (hi ? a[i + 8] : a[i]) + recv; } }
    { const bool hi = (lane & M2) != 0;
#pragma unroll
      for (int i = 0; i < 4; ++i) { const int send = hi ? b[i] : b[i + 4]; const int recv = __shfl_xor(send, M2); c[i] = (hi ? b[i + 4] : b[i]) + recv; } }
    { const bool hi = (lane & M1) != 0;
      { const int send = hi ? c[0] : c[2]; const int recv = __shfl_xor(send, M1); r0 = (hi ? c[2] : c[0]) + recv; }
      { const int send = hi ? c[1] : c[3]; const int recv = __shfl_xor(send, M1); r1 = (hi ? c[3] : c[1]) + recv; } }
}
#define PE_ID(E, i) (((i) & 1) ? (E[(i) >> 1] >> 16) : (E[(i) >> 1] & 0xffffu))
__device__ __forceinline__ void peer_u_item(int p, int j, const unsigned short* __restrict__ IDX, const unsigned char* __restrict__ XQ, const unsigned char* __restrict__ U8, int* __restrict__ PART, int lane, int wave) {
    asm volatile("" : "+v"(lane));
    const int gidx = lane >> 3; const unsigned coff = (unsigned)(p * 128 + (lane & 7) * 16);
#pragma unroll 1
    for (int it = 0; it < 8; ++it) {
        const int t = j * 64 + it * 8 + wave;
        unsigned E[8];
        { const uint4 e0 = *(const uint4*)(IDX + (size_t)t * 128 + 16 * gidx), e1 = *(const uint4*)(IDX + (size_t)t * 128 + 16 * gidx + 8);
          E[0] = e0.x; E[1] = e0.y; E[2] = e0.z; E[3] = e0.w; E[4] = e1.x; E[5] = e1.y; E[6] = e1.z; E[7] = e1.w; }
        uint4 uu[16];
#pragma unroll
        for (int i = 0; i < 16; ++i) uu[i] = *(const uint4*)(U8 + (size_t)(PE_ID(E, i) * 1024u + coff));
        const uint4 xq = *(const uint4*)(XQ + (size_t)t * D + coff);
        int d[16];
#pragma unroll
        for (int i = 0; i < 16; ++i) {
            int s = __builtin_amdgcn_sdot4((int)uu[i].x, (int)xq.x, 0, false); s = __builtin_amdgcn_sdot4((int)uu[i].y, (int)xq.y, s, false);
            s = __builtin_amdgcn_sdot4((int)uu[i].z, (int)xq.z, s, false); s = __builtin_amdgcn_sdot4((int)uu[i].w, (int)xq.w, s, false);
            d[i] = s;
        }
        int r0, r1; treduce16i<4, 2, 1>(d, lane, r0, r1);
        *(int2*)(PART + ((size_t)p * T + t) * 128 + 2 * lane) = make_int2(r0, r1);
    }
}
__device__ __forceinline__ void peer_v_item(int p, int j, const unsigned short* __restrict__ IDX, const bf16* __restrict__ ACT, const unsigned char* __restrict__ V8, float* __restrict__ PEERO, int lane, int wave) {
    asm volatile("" : "+v"(lane));
    const int gidx = lane >> 3; const unsigned coff = (unsigned)(p * 128 + (lane & 7) * 16);
#pragma unroll 1
    for (int it = 0; it < 8; ++it) {
        const int t = j * 64 + it * 8 + wave;
        unsigned E[8]; float ac[16];
        { const uint4 e0 = *(const uint4*)(IDX + (size_t)t * 128 + 16 * gidx), e1 = *(const uint4*)(IDX + (size_t)t * 128 + 16 * gidx + 8);
          E[0] = e0.x; E[1] = e0.y; E[2] = e0.z; E[3] = e0.w; E[4] = e1.x; E[5] = e1.y; E[6] = e1.z; E[7] = e1.w; }
        uint4 vv[16];
#pragma unroll
        for (int i = 0; i < 16; ++i) vv[i] = *(const uint4*)(V8 + (size_t)(PE_ID(E, i) * 1024u + coff));
        { const uint4 a0 = *(const uint4*)(ACT + (size_t)t * 128 + 16 * gidx), a1 = *(const uint4*)(ACT + (size_t)t * 128 + 16 * gidx + 8);
          const unsigned ww[8] = {a0.x, a0.y, a0.z, a0.w, a1.x, a1.y, a1.z, a1.w};
#pragma unroll
          for (int q = 0; q < 8; ++q) { ac[2 * q] = __uint_as_float(ww[q] << 16); ac[2 * q + 1] = __uint_as_float(ww[q] & 0xffff0000u); } }
        float acc[16];
#pragma unroll
        for (int c = 0; c < 16; ++c) acc[c] = 0.f;
#pragma unroll
        for (int i = 0; i < 16; ++i) { float f[16]; fp8x16_to_f32(vv[i], f);
#pragma unroll
            for (int c = 0; c < 16; ++c) acc[c] = __builtin_fmaf(ac[i], f[c], acc[c]); }
        float r0, r1; treduce16<32, 16, 8>(acc, lane, r0, r1);
        *(float2*)(PEERO + (size_t)t * D + coff + 2 * gidx) = make_float2(r0, r1);
    }
}

__device__ __forceinline__ void ce_desc(float& a, float& b) { const float hi = fmaxf(a, b), lo = fminf(a, b); a = hi; b = lo; }
__device__ __forceinline__ void sort16_desc(float (&v)[16]) {
#pragma unroll
    for (int k = 2; k <= 16; k <<= 1)
#pragma unroll
        for (int j = k >> 1; j > 0; j >>= 1)
#pragma unroll
            for (int i = 0; i < 16; ++i) { const int l = i ^ j; if (l > i) { if ((i & k) == 0) ce_desc(v[i], v[l]); else ce_desc(v[l], v[i]); } }
}
__device__ __forceinline__ void merge16_desc(float (&a)[16], const float (&b)[16]) {
#pragma unroll
    for (int i = 0; i < 16; ++i) a[i] = fmaxf(a[i], b[15 - i]);
#pragma unroll
    for (int j = 8; j > 0; j >>= 1)
#pragma unroll
        for (int i = 0; i < 16; ++i) { const int l = i ^ j; if (l > i) ce_desc(a[i], a[l]); }
}
__device__ __forceinline__ void ce_kv(float& ka, int& va, float& kb, int& vb) {
    const bool s = kb > ka; const float t0 = s ? kb : ka, t1 = s ? ka : kb; const int u0 = s ? vb : va, u1 = s ? va : vb; ka = t0; kb = t1; va = u0; vb = u1; }
__device__ __forceinline__ void sort16_kv(float (&k)[16], int (&v)[16]) {
#pragma unroll
    for (int kk = 2; kk <= 16; kk <<= 1)
#pragma unroll
        for (int j = kk >> 1; j > 0; j >>= 1)
#pragma unroll
            for (int i = 0; i < 16; ++i) { const int l = i ^ j; if (l > i) { if ((i & kk) == 0) ce_kv(k[i], v[i], k[l], v[l]); else ce_kv(k[l], v[l], k[i], v[i]); } }
}
__device__ __forceinline__ void merge16_kv(float (&ka)[16], int (&va)[16], const float (&kb)[16], const int (&vb)[16]) {
#pragma unroll
    for (int i = 0; i < 16; ++i) { const bool s = kb[15 - i] > ka[i]; ka[i] = s ? kb[15 - i] : ka[i]; va[i] = s ? vb[15 - i] : va[i]; }
#pragma unroll
    for (int j = 8; j > 0; j >>= 1)
#pragma unroll
        for (int i = 0; i < 16; ++i) { const int l = i ^ j; if (l > i) ce_kv(ka[i], va[i], ka[l], va[l]); }
}
__device__ __forceinline__ void split8(const float* p, bf16x8& hi8, bf16x8& lo8) {
    const float4 f0 = *(const float4*)p, f1 = *(const float4*)(p + 4);
    const float x[8] = {f0.x, f0.y, f0.z, f0.w, f1.x, f1.y, f1.z, f1.w};
#pragma unroll
    for (int j = 0; j < 8; ++j) { const short h = bfs(x[j]); hi8[j] = h; lo8[j] = bfs(x[j] - sbf2f(h)); }
}
__device__ __forceinline__ void route_task(int task, const float* QP, const bf16* KH, const bf16* KL, unsigned short* IDX, float* GATE, int lane) {
    const int r = lane & 31, hi = lane >> 5, t = 4 * task + (r >> 3), head = r & 7;
    float top[2][16];
#pragma unroll
    for (int half = 0; half < 2; ++half) {
        bf16x8 qh[4], ql[4];
#pragma unroll
        for (int ks = 0; ks < 4; ++ks) split8(QP + (size_t)t * D + head * 128 + half * 64 + 16 * ks + 8 * hi, qh[ks], ql[ks]);
        float cur[16];
#pragma unroll
        for (int kt = 0; kt < 4; ++kt) {
            f32x16 X = zero16();
            const bf16* khp = KH + (size_t)(half * 128 + 32 * kt + r) * 64 + 8 * hi; const bf16* klp = KL + (size_t)(half * 128 + 32 * kt + r) * 64 + 8 * hi;
            asm volatile("" : "+v"(khp), "+v"(klp));
#pragma unroll
            for (int ks = 0; ks < 4; ++ks) {
                const bf16x8 kh = ldg8(khp + 16 * ks), kl = ldg8(klp + 16 * ks);
                X = MFMA32(kh, qh[ks], X); X = MFMA32(kh, ql[ks], X); X = MFMA32(kl, qh[ks], X);
            }
            float grp[16];
#pragma unroll
            for (int i = 0; i < 16; ++i) { const unsigned key = (unsigned)(32 * kt + crow(i, hi)); grp[i] = __uint_as_float((__float_as_uint(X[i]) & ~127u) | (127u - key)); }
            sort16_desc(grp);
            if (kt == 0) {
#pragma unroll
                for (int i = 0; i < 16; ++i) cur[i] = grp[i];
            } else merge16_desc(cur, grp);
        }
        float oth[16];
#pragma unroll
        for (int i = 0; i < 16; ++i) oth[i] = __shfl_xor(cur[i], 32);
        merge16_desc(cur, oth);
#pragma unroll
        for (int i = 0; i < 16; ++i) top[half][i] = cur[i];
    }
    unsigned P1[4], P2[4];
#pragma unroll
    for (int q = 0; q < 4; ++q) { P1[q] = 0u; P2[q] = 0u;
#pragma unroll
        for (int s = 0; s < 4; ++s) { P1[q] |= (127u - (__float_as_uint(top[0][4 * q + s]) & 127u)) << (8 * s); P2[q] |= (127u - (__float_as_uint(top[1][4 * q + s]) & 127u)) << (8 * s); } }
#define CAND(a, b) __uint_as_float((__float_as_uint(top[0][a] + top[1][b]) & ~255u) | (255u - (unsigned)((a) * 16 + (b))))
    float bk[16];
    {
        float gk[16];
        gk[0] = CAND(0, 0);
        gk[1] = CAND(0, 1);
        gk[2] = CAND(0, 2);
        gk[3] = CAND(0, 3);
        gk[4] = CAND(0, 4);
        gk[5] = CAND(0, 5);
        gk[6] = CAND(0, 6);
        gk[7] = CAND(0, 7);
        gk[8] = CAND(0, 8);
        gk[9] = CAND(0, 9);
        gk[10] = CAND(0, 10);
        gk[11] = CAND(0, 11);
        gk[12] = CAND(0, 12);
        gk[13] = CAND(0, 13);
        gk[14] = CAND(0, 14);
        gk[15] = CAND(0, 15);
        sort16_desc(gk);
#pragma unroll
        for (int i = 0; i < 16; ++i) bk[i] = gk[i];
    }
    {
        float gk[16];
        gk[0] = CAND(1, 0);
        gk[1] = CAND(1, 1);
        gk[2] = CAND(1, 2);
        gk[3] = CAND(1, 3);
        gk[4] = CAND(1, 4);
        gk[5] = CAND(1, 5);
        gk[6] = CAND(1, 6);
        gk[7] = CAND(1, 7);
        gk[8] = CAND(2, 0);
        gk[9] = CAND(2, 1);
        gk[10] = CAND(2, 2);
        gk[11] = CAND(2, 3);
        gk[12] = CAND(2, 4);
        gk[13] = CAND(3, 0);
        gk[14] = CAND(3, 1);
        gk[15] = CAND(3, 2);
        sort16_desc(gk);
        merge16_desc(bk, gk);
    }
    {
        float gk[16];
        gk[0] = CAND(3, 3);
        gk[1] = CAND(4, 0);
        gk[2] = CAND(4, 1);
        gk[3] = CAND(4, 2);
        gk[4] = CAND(5, 0);
        gk[5] = CAND(5, 1);
        gk[6] = CAND(6, 0);
        gk[7] = CAND(6, 1);
        gk[8] = CAND(7, 0);
        gk[9] = CAND(7, 1);
        gk[10] = CAND(8, 0);
        gk[11] = CAND(9, 0);
        gk[12] = CAND(10, 0);
        gk[13] = CAND(11, 0);
        gk[14] = CAND(12, 0);
        gk[15] = CAND(13, 0);
        sort16_desc(gk);
        merge16_desc(bk, gk);
    }
    {
        float gk[16];
        gk[0] = CAND(14, 0);
        gk[1] = CAND(15, 0);
        gk[2] = -INFINITY;
        gk[3] = -INFINITY;
        gk[4] = -INFINITY;
        gk[5] = -INFINITY;
        gk[6] = -INFINITY;
        gk[7] = -INFINITY;
        gk[8] = -INFINITY;
        gk[9] = -INFINITY;
        gk[10] = -INFINITY;
        gk[11] = -INFINITY;
        gk[12] = -INFINITY;
        gk[13] = -INFINITY;
        gk[14] = -INFINITY;
        gk[15] = -INFINITY;
        sort16_desc(gk);
        merge16_desc(bk, gk);
    }
#undef CAND
    int bv[16];
#pragma unroll
    for (int i = 0; i < 16; ++i) {
        const unsigned cd = 255u - (__float_as_uint(bk[i]) & 255u), ca = cd >> 4, cb = cd & 15u;
        const unsigned wa = (ca >> 2) == 0u ? P1[0] : (ca >> 2) == 1u ? P1[1] : (ca >> 2) == 2u ? P1[2] : P1[3];
        const unsigned wb = (cb >> 2) == 0u ? P2[0] : (cb >> 2) == 1u ? P2[1] : (cb >> 2) == 2u ? P2[2] : P2[3];
        bv[i] = (int)((((wa >> (8u * (ca & 3u))) & 255u) << 7) | ((wb >> (8u * (cb & 3u))) & 255u));
    }
    float e[16], se = 0.f;
#pragma unroll
    for (int i = 0; i < 16; ++i) { e[i] = __expf(bk[i] - bk[0]); se += e[i]; }
    const float inv = 1.f / se;
    if (hi == 0) {
        uint4* ip = (uint4*)(IDX + (size_t)t * 128 + head * 16); float4* gp = (float4*)(GATE + (size_t)t * 128 + head * 16);
#pragma unroll
        for (int q = 0; q < 2; ++q) ip[q] = make_uint4((unsigned)bv[8 * q] | ((unsigned)bv[8 * q + 1] << 16), (unsigned)bv[8 * q + 2] | ((unsigned)bv[8 * q + 3] << 16), (unsigned)bv[8 * q + 4] | ((unsigned)bv[8 * q + 5] << 16), (unsigned)bv[8 * q + 6] | ((unsigned)bv[8 * q + 7] << 16));
#pragma unroll
        for (int q = 0; q < 4; ++q) gp[q] = make_float4(e[4 * q] * inv, e[4 * q + 1] * inv, e[4 * q + 2] * inv, e[4 * q + 3] * inv);
    }
}

#define XB_TMO      128
#define XB_XCNT(j)  (256  + 64 * (j))
#define XB_XSUB(j)  (1280 + 64 * (j))
#define XB_XGEN(j)  (2304 + 64 * (j))
#define XB_TOP      3328
#define XB_TOPGEN   3392
#define XCD_BAR_WORDS 3456
#define XB_SPIN_CAP (1u << 22)
__device__ __forceinline__ unsigned xb_ld(unsigned* p)              { return __hip_atomic_load(p, __ATOMIC_RELAXED, __HIP_MEMORY_SCOPE_AGENT); }
__device__ __forceinline__ unsigned xb_add(unsigned* p, unsigned v) { return __hip_atomic_fetch_add(p, v, __ATOMIC_RELAXED, __HIP_MEMORY_SCOPE_AGENT); }
__device__ __forceinline__ unsigned xb_xcc_id() { return (unsigned)__builtin_amdgcn_s_getreg((3 << 11) | 20) & 0xFu; }
#define XB_SPIN(cond, bar) do { unsigned _sp = 0; while (cond) { __builtin_amdgcn_s_sleep(1); \
    if ((++_sp & 255u) == 0u) { if (xb_ld(&(bar)[XB_TMO])) break; if (_sp > XB_SPIN_CAP) { atomicAdd(&(bar)[XB_TMO], 1u); break; } } } } while (0)
struct XcdBarrier { unsigned* bar; unsigned x; volatile LAS unsigned* st; };
__device__ __forceinline__ XcdBarrier xcd_barrier_post(unsigned* bar, volatile LAS unsigned* st) {
    XcdBarrier b; b.bar = bar; b.x = xb_xcc_id(); b.st = st;
    if (threadIdx.x == 0) (void)xb_add(&bar[XB_XCNT(b.x)], 1u);
    return b;
}
__device__ __forceinline__ void xcd_barrier_complete(unsigned* bar, unsigned x, unsigned& nloc, unsigned& nx) {
    const unsigned G = gridDim.x * gridDim.y * gridDim.z;
    unsigned sum, cnt, mine, sp = 0u;
    for (;;) {
        sum = 0u; cnt = 0u; mine = 0u;
#pragma unroll
        for (unsigned j = 0; j < 16; ++j) { const unsigned c = xb_ld(&bar[XB_XCNT(j)]); sum += c; cnt += (c > 0u) ? 1u : 0u; mine = (j == x) ? c : mine; }
        if (sum == G) break;
        __builtin_amdgcn_s_sleep(1);
        if ((++sp & 255u) == 0u) { if (xb_ld(&bar[XB_TMO])) break; if (sp > XB_SPIN_CAP) { atomicAdd(&bar[XB_TMO], 1u); break; } }
    }
    nloc = mine > 0u ? mine : 1u; nx = cnt > 0u ? cnt : 1u;
}
__device__ __forceinline__ void xcd_barrier(const XcdBarrier& b) {
    asm volatile("s_waitcnt vmcnt(0)" ::: "memory");
    __syncthreads();
    if (threadIdx.x == 0) {
        unsigned* bar = b.bar;
        __builtin_amdgcn_s_waitcnt(0);
        unsigned nloc = b.st[0], nx = b.st[1];
        if (nloc == 0u) { xcd_barrier_complete(bar, b.x, nloc, nx); b.st[0] = nloc; b.st[1] = nx; }
        const unsigned old = xb_add(&bar[XB_XSUB(b.x)], 1u);
        const unsigned gen = old / nloc;
        if (old + 1u == (gen + 1u) * nloc) {
            __builtin_amdgcn_fence(__ATOMIC_RELEASE, "agent");
            asm volatile("s_waitcnt vmcnt(0)" ::: "memory");
            const unsigned og = xb_add(&bar[XB_TOP], 1u);
            const unsigned tg = og / nx;
            if (og + 1u == (tg + 1u) * nx) xb_add(&bar[XB_TOPGEN], 1u);
            else XB_SPIN(xb_ld(&bar[XB_TOPGEN]) == tg, bar);
            __builtin_amdgcn_fence(__ATOMIC_ACQUIRE, "agent");
            xb_add(&bar[XB_XGEN(b.x)], 1u);
            asm volatile("s_waitcnt vmcnt(0)" ::: "memory");
        } else {
            XB_SPIN(xb_ld(&bar[XB_XGEN(b.x)]) == gen, bar);
            __builtin_amdgcn_fence(__ATOMIC_ACQUIRE, "agent");
            asm volatile("s_waitcnt vmcnt(0)" ::: "memory");
        }
    }
    __syncthreads();
}
constexpr int LDS_BYTES = 147456;
constexpr int MISC_OFF = 131072 + 320;

__global__ void __launch_bounds__(NTHR, 2) k_main(Args a) {
    extern __shared__ __attribute__((aligned(16))) unsigned char lds_raw[];
    LAS unsigned char* ldsb = (LAS unsigned char*)lds_raw;
    const int tid0 = threadIdx.x, bid = blockIdx.x, nb = gridDim.x;
    const int wave = __builtin_amdgcn_readfirstlane(tid0 >> 6);
    const int gthreads = nb * NTHR, nwaves = gthreads >> 6;
#define PHASE_VARS() int tid = tid0; asm volatile("" : "+v"(tid)); const int lane = tid & 63, gtid = bid * NTHR + tid, gwave = gtid >> 6; (void)lane; (void)gtid; (void)gwave
    unsigned char* ws = a.ws;
    bf16* WINT = (bf16*)(ws + WS_WIN); bf16* WOT = (bf16*)(ws + WS_WO); bf16* WQT = (bf16*)(ws + WS_WQ);
    bf16* PROJ = (bf16*)(ws + WS_PROJ);
    bf16* XNB = (bf16*)(ws + WS_XNB);
    bf16* XACT = (bf16*)(ws + WS_XACT);
    float* DTRAW = (float*)(ws + WS_DTRAW); float* DT = (float*)(ws + WS_DT); float* ACS = (float*)(ws + WS_ACS); float* CDEC = (float*)(ws + WS_CDEC);
    float* STATES = (float*)(ws + WS_STATES); bf16* PREVT = (bf16*)(ws + WS_PREV);
    float* QP = (float*)(ws + WS_QP); unsigned short* IDX = (unsigned short*)(ws + WS_IDX); float* GATE = (float*)(ws + WS_GATE);
    float* TOPV = (float*)(ws + WS_TOPV); int* TOPI = (int*)(ws + WS_TOPI);
    unsigned char* U8 = ws + WS_U8; unsigned char* V8 = ws + WS_V8; float* SU = (float*)(ws + WS_SU); float* SV = SU + 16384; int* PART = (int*)(ws + WS_PART); unsigned char* XQ = ws + WS_XQ; float* XS = (float*)(ws + WS_XS);
    bf16* KH = (bf16*)(ws + WS_KH); bf16* KL = (bf16*)(ws + WS_KH + 65536);
    float* MIXF = a.out;
    volatile LAS unsigned* MISC = (volatile LAS unsigned*)(ldsb + MISC_OFF);
    if (tid0 < 32) MISC[tid0] = 0u;
    __syncthreads();
    XcdBarrier bar = xcd_barrier_post((unsigned*)ws, MISC + 8);
#define IN(k) (a.ph_lo <= (k) && (k) < a.ph_hi)
#if defined(PROBE_LO)
    int seg_ = 0; unsigned long long tseg_ = __builtin_amdgcn_s_memrealtime();
#define PROBE_SPIN() do { if (seg_ >= PROBE_LO && seg_ <= PROBE_HI) { const unsigned long long d_ = (__builtin_amdgcn_s_memrealtime() - tseg_) * PROBE_AMP; const unsigned long long s_ = __builtin_amdgcn_s_memrealtime(); \
        while (__builtin_amdgcn_s_memrealtime() - s_ < d_) __builtin_amdgcn_s_sleep(4); } } while (0)
#define GRID_BAR() do { PROBE_SPIN(); xcd_barrier(bar); tseg_ = __builtin_amdgcn_s_memrealtime(); ++seg_; } while (0)
#else
#define PROBE_SPIN() do { } while (0)
#define GRID_BAR() xcd_barrier(bar)
#endif

    if (IN(0)) {
        PHASE_VARS();
        LAS float* scr = (LAS float*)(ldsb + wave * 16384);
        constexpr int I_IN = 16 * 72, I_O = 16 * 32, NITEMS = I_IN + 2 * I_O;
        for (int it = gwave; it < NITEMS; it += nwaves) {
            int r = it;
            if (r < I_IN) { transpose_item(a.w_in, PW, D, WINT, scr, r / 72, r % 72, lane); continue; } r -= I_IN;
            if (r < I_O) { transpose_item(a.w_out, D, D, WOT, scr, r / 32, r % 32, lane); continue; } r -= I_O;
            transpose_item(a.peer_wq, D, D, WQT, scr, r / 32, r % 32, lane);
        }
        for (int i = gtid; i < 2 * 128 * 64; i += gthreads) { const float kf = a.peer_sub_keys[i]; const short h = bfs(kf); KH[i] = (bf16)h; KL[i] = (bf16)bfs(kf - sbf2f(h)); }
        for (int i = tid; i < 8 * 1024; i += NTHR) { const int h = i & 7, c = i >> 3; *(LAS float*)(ldsb + h * 16384 + 8448 + c * 4) = a.w_in[(size_t)c * PW + ODT + h]; }
        __syncthreads();
        rmsnorm_rows_bf16<1>(a.x, a.norm_mix_g, XNB, ldsb, DTRAW, nullptr, nullptr, gwave, nwaves, lane);
    }
    GRID_BAR();
    if (IN(1)) {
        PHASE_VARS();
        pg8::Gemm g{XNB, WINT, T, PS, D}; pg8::StaticOrder S; S.init(T, PS, nb, bid);
        pg8::EpiBf16Plain E{PROJ, PS};
        pg8::gemm_phase<pg8::EpiBf16Plain, pg8::StaticOrder>(ldsb, g, S, E, nullptr);
    }
    GRID_BAR();
    if (IN(2)) {
        PHASE_VARS();
        for (int task = gtid; task < (T / 16) * 128; task += gthreads) {
            const int cg = task & 127, t0 = (task >> 7) * 16, c0 = cg * 8;
            float w[4][8], bs[8];
#pragma unroll
            for (int k = 0; k < 4; ++k) { const float4 a0 = *(const float4*)(a.conv_w + k * 1024 + c0), a1 = *(const float4*)(a.conv_w + k * 1024 + c0 + 4);
                w[k][0] = a0.x; w[k][1] = a0.y; w[k][2] = a0.z; w[k][3] = a0.w; w[k][4] = a1.x; w[k][5] = a1.y; w[k][6] = a1.z; w[k][7] = a1.w; }
            { const float4 a0 = *(const float4*)(a.conv_b + c0), a1 = *(const float4*)(a.conv_b + c0 + 4); bs[0] = a0.x; bs[1] = a0.y; bs[2] = a0.z; bs[3] = a0.w; bs[4] = a1.x; bs[5] = a1.y; bs[6] = a1.z; bs[7] = a1.w; }
            const bool has_halo = (t0 & (SEQ - 1)) != 0;
            bf16x8 rows[19];
#pragma unroll
            for (int i = 0; i < 19; ++i) {
                if (i < 3 && !has_halo) {
#pragma unroll
                    for (int e = 0; e < 8; ++e) rows[i][e] = 0;
                } else rows[i] = ldg8(PROJ + (size_t)(t0 + i - 3) * PS + OXBC + c0);
            }
#pragma unroll
            for (int i = 0; i < 16; ++i) {
                float o[8];
#pragma unroll
                for (int e = 0; e < 8; ++e) o[e] = silu_f(bs[e] + w[0][e] * sbf2f(rows[i][e]) + w[1][e] * sbf2f(rows[i + 1][e]) + w[2][e] * sbf2f(rows[i + 2][e]) + w[3][e] * sbf2f(rows[i + 3][e]));
                v4u ov; ov.x = pkbf(o[0], o[1]); ov.y = pkbf(o[2], o[3]); ov.z = pkbf(o[4], o[5]); ov.w = pkbf(o[6], o[7]);
                *(v4u*)(XACT + (size_t)(t0 + i) * 1024 + c0) = ov;
            }
        }
        if (gwave < 1024) {
            const int h = gwave & 7, bc = gwave >> 3;
            const float A = -__expf(a.a_log[h]), bias = a.dt_bias[h];
            const int t0 = bc * 128 + lane, t1 = t0 + 64;
            const float raw0 = DTRAW[t0 * 8 + h] + bias, raw1 = DTRAW[t1 * 8 + h] + bias;
            const float dt0 = fmaxf(raw0, 0.f) + log1pf(__expf(-fabsf(raw0))), dt1 = fmaxf(raw1, 0.f) + log1pf(__expf(-fabsf(raw1)));
            DT[t0 * 8 + h] = dt0; DT[t1 * 8 + h] = dt1;
            float v0 = dt0 * A, v1 = dt1 * A;
#pragma unroll
            for (int o = 1; o < 64; o <<= 1) { const float y0 = __shfl_up(v0, o), y1 = __shfl_up(v1, o); if (lane >= o) { v0 += y0; v1 += y1; } }
            v1 += __shfl(v0, 63);
            ACS[t0 * 8 + h] = v0; ACS[t1 * 8 + h] = v1;
            if (lane == 63) CDEC[gwave] = __expf(v1);
        }
    }
    GRID_BAR();
    if (IN(3)) {
        PHASE_VARS();
        for (int u = bid; u < 512; u += nb) {
            if (u < 256) attn_unit(a.attn_sinks, ldsb, u, PROJ, MIXF, tid, lane, wave);
            else ssd_chunk_unit(ldsb, u - 256, XACT, DT, ACS, MIXF, STATES, tid, lane, wave);
        }
    }
    GRID_BAR();
    if (IN(5)) {
        PHASE_VARS();
        for (int idx = gtid; idx < 2 * 8 * 8192; idx += gthreads) {
            const int pn = idx & 8191, h = (idx >> 13) & 7, b = idx >> 16;
            float run = 0.f;
#pragma unroll 1
            for (int c0 = 0; c0 < 64; c0 += 8) {
                float st[8], dc[8];
#pragma unroll
                for (int j = 0; j < 8; ++j) { const int bch = (b * 64 + c0 + j) * 8 + h; st[j] = STATES[(size_t)bch * 8192 + pn]; dc[j] = CDEC[bch]; }
#pragma unroll
                for (int j = 0; j < 8; ++j) { const int bch = (b * 64 + c0 + j) * 8 + h; PREVT[(size_t)bch * 8192 + pn] = f2bf(run); run = dc[j] * run + st[j]; }
            }
        }
    }
    GRID_BAR();
    if (IN(6)) {
        PHASE_VARS();
        for (int u = bid; u < 256; u += nb) yoff_unit(a.d_skip, u, XACT, PROJ, ACS, PREVT, MIXF, lane, wave);
    }
    GRID_BAR();
    if (IN(6)) {
        PHASE_VARS();
        for (int t = gwave; t < T; t += nwaves) {
            const float* row = MIXF + (size_t)t * D;
            const float4 a0 = *(const float4*)(row + 8 * lane), a1 = *(const float4*)(row + 8 * lane + 4);
            const float4 s0 = *(const float4*)(row + 512 + 8 * lane), s1 = *(const float4*)(row + 512 + 8 * lane + 4);
            float ssa = a0.x * a0.x + a0.y * a0.y + a0.z * a0.z + a0.w * a0.w + a1.x * a1.x + a1.y * a1.y + a1.z * a1.z + a1.w * a1.w;
            float sss = s0.x * s0.x + s0.y * s0.y + s0.z * s0.z + s0.w * s0.w + s1.x * s1.x + s1.y * s1.y + s1.z * s1.z + s1.w * s1.w;
            ssa = wave_sum(ssa);
#pragma unroll
            for (int o = 1; o < 32; o <<= 1) sss += __shfl_xor(sss, o);
            const float ra = rsqrtf(ssa * (1.f / 512.f) + EPS), rs = rsqrtf(sss * (1.f / 256.f) + EPS);
            const float4 ga0 = *(const float4*)(a.attn_out_g + 8 * lane), ga1 = *(const float4*)(a.attn_out_g + 8 * lane + 4);
            const float4 gs0 = *(const float4*)(a.ssm_norm_g + 8 * lane), gs1 = *(const float4*)(a.ssm_norm_g + 8 * lane + 4);
            v4u oa, os;
            oa.x = pkbf(a0.x * ra * ga0.x, a0.y * ra * ga0.y); oa.y = pkbf(a0.z * ra * ga0.z, a0.w * ra * ga0.w); oa.z = pkbf(a1.x * ra * ga1.x, a1.y * ra * ga1.y); oa.w = pkbf(a1.z * ra * ga1.z, a1.w * ra * ga1.w);
            os.x = pkbf(s0.x * rs * gs0.x, s0.y * rs * gs0.y); os.y = pkbf(s0.z * rs * gs0.z, s0.w * rs * gs0.w); os.z = pkbf(s1.x * rs * gs1.x, s1.y * rs * gs1.y); os.w = pkbf(s1.z * rs * gs1.z, s1.w * rs * gs1.w);
            *(v4u*)(XNB + (size_t)t * D + 8 * lane) = oa; *(v4u*)(XNB + (size_t)t * D + 512 + 8 * lane) = os;
        }
    }
    GRID_BAR();
    if (IN(7)) {
        PHASE_VARS();
        pg8::Gemm g{XNB, WOT, T, D, D}; pg8::StaticOrder S; S.init(T, D, nb, bid);
        pg8::EpiF32Resid E{a.out, a.x, D};
        pg8::gemm_phase<pg8::EpiF32Resid, pg8::StaticOrder>(ldsb, g, S, E, nullptr);
    }
    GRID_BAR();
    if (IN(8)) {
        PHASE_VARS();
        rmsnorm_rows_bf16<2>(a.out, a.norm_ffn_g, XNB, ldsb, nullptr, XQ, XS, gwave, nwaves, lane);
        for (int rr = gwave; rr < 2 * 16384; rr += nwaves) {
            const int which = rr >> 14, row = rr & 16383;
            const float4* src4 = (const float4*)((which ? a.peer_v : a.peer_u) + (size_t)row * D) + lane;
            float4 v[4]; float mx = 0.f;
#pragma unroll
            for (int jq = 0; jq < 4; ++jq) { v[jq] = src4[64 * jq]; mx = fmaxf(mx, fmaxf(fmaxf(fabsf(v[jq].x), fabsf(v[jq].y)), fmaxf(fabsf(v[jq].z), fabsf(v[jq].w)))); }
#pragma unroll
            for (int o = 1; o < 64; o <<= 1) mx = fmaxf(mx, __shfl_xor(mx, o));
            const float sc = mx > 0.f ? mx * (which ? (1.f / 240.f) : (1.f / 127.f)) : 1.f, inv = 1.f / sc;
            unsigned* dst = (unsigned*)((which ? V8 : U8) + (size_t)row * D) + lane;
            if (which) {
#pragma unroll
                for (int jq = 0; jq < 4; ++jq) { int w = __builtin_amdgcn_cvt_pk_fp8_f32(v[jq].x * inv, v[jq].y * inv, 0, false); w = __builtin_amdgcn_cvt_pk_fp8_f32(v[jq].z * inv, v[jq].w * inv, w, true); dst[64 * jq] = (unsigned)w; }
            } else {
#pragma unroll
                for (int jq = 0; jq < 4; ++jq) { const int q0 = (int)rintf(v[jq].x * inv), q1 = (int)rintf(v[jq].y * inv), q2 = (int)rintf(v[jq].z * inv), q3 = (int)rintf(v[jq].w * inv);
                    dst[64 * jq] = (unsigned)(q0 & 255) | ((unsigned)(q1 & 255) << 8) | ((unsigned)(q2 & 255) << 16) | ((unsigned)(q3 & 255) << 24); }
            }
            if (lane == 0) (which ? SV : SU)[row] = sc;
        }
    }
    GRID_BAR();
    if (IN(9)) {
        PHASE_VARS();
        pg8::Gemm g{XNB, WQT, T, D, D}; pg8::StaticOrder S; S.init(T, D, nb, bid);
        pg8::EpiF32Resid E{QP, nullptr, D};
        pg8::gemm_phase<pg8::EpiF32Resid, pg8::StaticOrder>(ldsb, g, S, E, nullptr);
    }
    GRID_BAR();
    if (IN(10)) {
        PHASE_VARS();
        for (int task = gwave; task < T / 4; task += nwaves) route_task(task, QP, KH, KL, IDX, GATE, lane);
    }
    GRID_BAR();
    bf16* ACT = (bf16*)(ws + WS_ACT); float* PEERO = (float*)(ws + WS_PEERO);
    unsigned* ctl = (unsigned*)ws;
    const int xcc = (int)(bar.x & 7u);
    if (IN(12)) {
        PHASE_VARS();
#pragma unroll 1
        for (int pi = 0; pi < NPART; ++pi) {
            const int p = (xcc + pi) & 7;
            for (;;) {
                if (tid == 0) MISC[16] = xb_add(&ctl[CW_QU + 64 * p], 1u);
                __syncthreads();
                const int j = (int)MISC[16];
                __syncthreads();
                if (j >= NCHUNK) break;
                peer_u_item(p, j, IDX, XQ, U8, PART, lane, wave);
            }
        }
    }
    GRID_BAR();
    if (IN(12)) {
        PHASE_VARS();
        for (int i = gtid; i < T * 128; i += gthreads) {
            int si = 0;
#pragma unroll
            for (int pp = 0; pp < NPART; ++pp) si += PART[(size_t)pp * T * 128 + i];
            const int e = IDX[i]; const float z = (float)si * SU[e] * XS[i >> 7];
            ACT[i] = f2bf(GATE[i] * 0.5f * z * (1.f + erff(z * 0.70710678118654752f)) * SV[e]);
        }
    }
    GRID_BAR();
    if (IN(13)) {
        PHASE_VARS();
#pragma unroll 1
        for (int pi = 0; pi < NPART; ++pi) {
            const int p = (xcc + pi) & 7;
            for (;;) {
                if (tid == 0) MISC[16] = xb_add(&ctl[CW_QV + 64 * p], 1u);
                __syncthreads();
                const int j = (int)MISC[16];
                __syncthreads();
                if (j >= NCHUNK) break;
                peer_v_item(p, j, IDX, ACT, V8, PEERO, lane, wave);
            }
        }
    }
    GRID_BAR();
    if (IN(14)) {
        PHASE_VARS();
        for (int t = gwave; t < T; t += nwaves) {
            const float4* hr = (const float4*)(a.out + (size_t)t * D) + lane; const float4* pr = (const float4*)(PEERO + (size_t)t * D) + lane;
            float4 v[4]; float ss = 0.f;
#pragma unroll
            for (int jq = 0; jq < 4; ++jq) { const float4 h4 = hr[64 * jq], p4 = pr[64 * jq]; v[jq] = make_float4(h4.x + p4.x, h4.y + p4.y, h4.z + p4.z, h4.w + p4.w); ss += v[jq].x * v[jq].x + v[jq].y * v[jq].y + v[jq].z * v[jq].z + v[jq].w * v[jq].w; }
            ss = wave_sum(ss);
            const float r3 = rsqrtf(ss * (1.f / D) + EPS);
            float4* op = (float4*)(a.out + (size_t)t * D) + lane;
#pragma unroll
            for (int jq = 0; jq < 4; ++jq) { const float4 gv = ((const float4*)a.final_norm_g)[lane + 64 * jq]; op[64 * jq] = make_float4(v[jq].x * r3 * gv.x, v[jq].y * r3 * gv.y, v[jq].z * r3 * gv.z, v[jq].w * r3 * gv.w); }
        }
    }
    PROBE_SPIN();
#undef IN
}
}

extern "C" void kernel_launch(void* const* d_in, const int* in_sizes, int n_in, void* d_out, int out_size, void* d_ws, size_t ws_size, hipStream_t stream) {
    if (n_in != 18 || out_size != T * D || ws_size < WS_END) { fprintf(stderr, "kernel_launch: unexpected shapes n_in=%d out=%d ws=%zu\n", n_in, out_size, ws_size); return; }
    Args a{};
    const float** ap = (const float**)&a;
    for (int i = 0; i < 18; ++i) ap[i] = (const float*)d_in[i];
    a.out = (float*)d_out; a.ws = (unsigned char*)d_ws;
    static int grid = 0;
    if (grid == 0) {
        int dev = 0, cus = 0, per_cu = 0;
        if (hipGetDevice(&dev) != hipSuccess || hipDeviceGetAttribute(&cus, hipDeviceAttributeMultiprocessorCount, dev) != hipSuccess) { fprintf(stderr, "kernel_launch: device query failed\n"); grid = -1; return; }
        if (hipFuncSetAttribute((const void*)k_main, hipFuncAttributeMaxDynamicSharedMemorySize, LDS_BYTES) != hipSuccess) { fprintf(stderr, "kernel_launch: hipFuncSetAttribute failed\n"); grid = -1; return; }
        if (hipOccupancyMaxActiveBlocksPerMultiprocessor(&per_cu, (const void*)k_main, NTHR, LDS_BYTES) != hipSuccess || per_cu < 1) { fprintf(stderr, "kernel_launch: occupancy query says %d blocks/CU\n", per_cu); (void)hipGetLastError(); grid = -1; return; }
        grid = cus;
    }
    if (grid < 0) return;
    if (hipMemsetAsync(d_ws, 0, 65536, stream) != hipSuccess) { fprintf(stderr, "kernel_launch: memset failed\n"); return; }
    a.ph_lo = 0; a.ph_hi = 15;
    hipLaunchKernelGGL(k_main, dim3(grid), dim3(NTHR), LDS_BYTES, stream, a);
}
```

```cpp
#include <hip/hip_runtime.h>
#include <cstdio>
#include <cstdint>

namespace pg8 {
#define PG8_LAS __attribute__((address_space(3)))
typedef unsigned short bf16_t;
typedef short bf16x8 __attribute__((ext_vector_type(8)));
typedef float f32x4 __attribute__((ext_vector_type(4)));
typedef unsigned u32x4 __attribute__((ext_vector_type(4)));
constexpr int BM = 256, BK = 64, HALF = 128, HTB = HALF * BK * 2  , STAGE_BYTES = 8 * HTB, NXCD = 8, WGM = 8;

__host__ __device__ __forceinline__ int lds_byte(int r, int c) { const int st = (r >> 4) * 2 + (c >> 5), rr = r & 15, cc = c & 31, ob = rr * 64 + cc * 2; return st * 1024 + (ob ^ (((ob >> 9) & 1) << 5)); }
__host__ __device__ __forceinline__ void stage_rc(int b, int& R, int& C) { const int st = b / 1024, sb = b % 1024, swz = sb ^ (((sb >> 9) & 1) << 5); R = (st >> 1) * 16 + swz / 64; C = (st & 1) * 32 + (swz % 64) / 2; }
__host__ __device__ __forceinline__ int perm32(int rho) { const int n = rho >> 4, i = rho & 15; return 8 * (i >> 2) + 4 * n + (i & 3); }

struct Unit { int pm, pn; };
struct Gemm { const bf16_t* A; const bf16_t* Bt; int M, N, K; };

struct StaticOrder {
    int nM, nN, nwg, G, c;
    __host__ __device__ void init(int M, int N, int G_, int c_) { nM = M / BM; nN = N / BM; nwg = nM * nN; G = G_; c = c_; }
    __host__ __device__ bool next(int i, Unit& u) const {
        const long L = (long)i * G + c; if (L >= nwg) return false;
        int wgid = (int)L; { const int q = nwg / NXCD, r = nwg % NXCD, xcd = wgid % NXCD, off = wgid / NXCD; wgid = (xcd < r ? xcd * (q + 1) : r * (q + 1) + (xcd - r) * q) + off; }
        const int nig = WGM * nN, gid = wgid / nig, fm = gid * WGM, gsz = (nM - fm) < WGM ? (nM - fm) : WGM;
        u.pm = fm + ((wgid % nig) % gsz); u.pn = (wgid % nig) / gsz; return true;
    }
    __device__ __forceinline__ void a_ready(const Unit&) const {}
    __device__ __forceinline__ void done(const Unit&) const {}
};
__device__ __forceinline__ unsigned cvt_pk_bf16(float lo, float hi) { unsigned r; asm volatile("v_cvt_pk_bf16_f32 %0, %1, %2" : "=v"(r) : "v"(lo), "v"(hi)); return r; }
typedef float f32x2 __attribute__((ext_vector_type(2)));
struct EpiBf16Plain {
    static constexpr bool PERM = true, AFTER_DRAIN = false;
    bf16_t* O; int ldc;
    __device__ __forceinline__ void operator()(const f32x4 (&acc)[2][2][4][2], const Unit& u, int wr, int wc, int fr, int fq) const {
        const int row0 = u.pm * BM + wr * 64 + fr, col0 = u.pn * BM + wc * 32 + 8 * fq;
#pragma unroll
        for (int ai = 0; ai < 2; ++ai)
#pragma unroll
            for (int m = 0; m < 4; ++m) { bf16_t* rowp = O + (size_t)(row0 + ai * HALF + m * 16) * ldc + col0;
#pragma unroll
                for (int bj = 0; bj < 2; ++bj) { const f32x4 v0 = acc[ai][bj][m][0], v1 = acc[ai][bj][m][1];
                    u32x4 w; w.x = cvt_pk_bf16(v0[0], v0[1]); w.y = cvt_pk_bf16(v0[2], v0[3]); w.z = cvt_pk_bf16(v1[0], v1[1]); w.w = cvt_pk_bf16(v1[2], v1[3]);
                    *(u32x4*)(rowp + bj * HALF) = w; } }
    }
};
struct EpiF32Resid {
    static constexpr bool PERM = false, AFTER_DRAIN = false;
    float* C; const float* R; int ldc;
    __device__ __forceinline__ void operator()(const f32x4 (&acc)[2][2][4][2], const Unit& u, int wr, int wc, int fr, int fq) const {
        const int row0 = u.pm * BM + wr * 64 + fr, col0 = u.pn * BM + wc * 32 + 4 * fq;
#pragma unroll
        for (int ai = 0; ai < 2; ++ai)
#pragma unroll
            for (int m = 0; m < 4; ++m) { const size_t off = (size_t)(row0 + ai * HALF + m * 16) * ldc + col0;
#pragma unroll
                for (int bj = 0; bj < 2; ++bj)
#pragma unroll
                    for (int n = 0; n < 2; ++n) { f32x4 v = acc[ai][bj][m][n]; if (R) v += *(const f32x4*)(R + off + bj * HALF + n * 16); *(f32x4*)(C + off + bj * HALF + n * 16) = v; }
                asm volatile("" ::: "memory"); }
    }
};
template <class Epi, class Sched, bool STAMP = false>
__device__ __forceinline__ void gemm_phase(PG8_LAS unsigned char* lds, const Gemm g, const Sched& S, const Epi& E, unsigned long long* stamps) {
    const int tid = threadIdx.x, wid = __builtin_amdgcn_readfirstlane(tid >> 6), lane = tid & 63, wr = wid >> 2, wc = wid & 3, fr = lane & 15, fq = lane >> 4;
    const int K = g.K, nt = K / BK;
    int ts_lo = 0, ts_hi = 0, nts = 0; const unsigned long long rt_entry = STAMP ? (unsigned long long)0ull : 0ull;
#define PG8_STAMP() do { if (STAMP && wid == 0 && nts < 64) { const unsigned long long _c = (unsigned long long)clock64(); \
        ts_lo = (lane == nts) ? (int)(unsigned)_c : ts_lo; ts_hi = (lane == nts) ? (int)(unsigned)(_c >> 32) : ts_hi; ++nts; } } while (0)
    PG8_STAMP();
    unsigned voffA[2], voffB[2];
#pragma unroll
    for (int i = 0; i < 2; ++i) { int R, C; stage_rc(tid * 16 + i * 8192, R, C); const int Rb = Epi::PERM ? ((R & ~31) + perm32(R & 31)) : R;
        voffA[i] = (unsigned)(R * K + C) * 2u; voffB[i] = (unsigned)(Rb * K + C) * 2u; }
    const size_t kstep = (size_t)(BK * 2);
    const size_t hstep = (size_t)HALF * K * 2;
    const size_t tstep = 2 * hstep;
    const unsigned ldsw = (unsigned)wid * 1024u;
    const int aoff = lds_byte(wr * 64 + fr, fq * 8), boff = lds_byte(wc * 32 + fr, fq * 8);
#define PG8_SA(b, h) (((b) * 2 + (h)) * HTB)
#define PG8_SB(b, h) ((4 + (b) * 2 + (h)) * HTB)
#define PG8_STAGE(bufoff, gbase, voff) do { _Pragma("unroll") for (int _i = 0; _i < 2; ++_i) \
        __builtin_amdgcn_global_load_lds((const unsigned*)((const char*)(gbase) + (voff)[_i]), (PG8_LAS unsigned*)(lds + (bufoff) + ldsw + _i * 8192), 16, 0, 0); } while (0)
#define PG8_LDA(dst, b, h) do { _Pragma("unroll") for (int m = 0; m < 4; ++m) _Pragma("unroll") for (int k = 0; k < 2; ++k) dst[m][k] = *(const PG8_LAS bf16x8*)(lds + PG8_SA(b, h) + aoff + m * 2048 + k * 1024); } while (0)
#define PG8_LDB(dst, b, h) do { _Pragma("unroll") for (int n = 0; n < 2; ++n) _Pragma("unroll") for (int k = 0; k < 2; ++k) dst[n][k] = *(const PG8_LAS bf16x8*)(lds + PG8_SB(b, h) + boff + n * 2048 + k * 1024); } while (0)
#define PG8_MMA(ai, bj, At, Bt) do { __builtin_amdgcn_s_setprio(1); _Pragma("unroll") for (int m = 0; m < 4; ++m) _Pragma("unroll") for (int n = 0; n < 2; ++n) _Pragma("unroll") for (int k = 0; k < 2; ++k) \
        acc[ai][bj][m][n] = __builtin_amdgcn_mfma_f32_16x16x32_bf16(Bt[n][k], At[m][k], acc[ai][bj][m][n], 0, 0, 0); __builtin_amdgcn_s_setprio(0); } while (0)
#define PG8_WAIT_V(n) asm volatile("s_waitcnt vmcnt(" #n ")" ::: "memory")
#define PG8_WAIT_L(n) asm volatile("s_waitcnt lgkmcnt(" #n ")" ::: "memory")
#define PG8_BAR __builtin_amdgcn_s_barrier()
#define PG8_SCHED __builtin_amdgcn_sched_barrier(0)
    Unit cur, nxt; int ui = 0;
    if (!S.next(0, cur)) return;
    f32x4 acc[2][2][4][2];
#pragma unroll
    for (int a = 0; a < 2; ++a)
#pragma unroll
        for (int b = 0; b < 2; ++b)
#pragma unroll
            for (int m = 0; m < 4; ++m)
#pragma unroll
                for (int n = 0; n < 2; ++n) acc[a][b][m][n] = (f32x4){0.f, 0.f, 0.f, 0.f};
    bf16x8 At[4][2], B0[2][2], B1[2][2];
    const char* cA = (const char*)g.A + (size_t)cur.pm * tstep; const char* cB = (const char*)g.Bt + (size_t)cur.pn * tstep;
    S.a_ready(cur);
    PG8_STAGE(PG8_SB(0, 0), cB, voffB); PG8_STAGE(PG8_SA(0, 0), cA, voffA); PG8_STAGE(PG8_SB(0, 1), cB + hstep, voffB); PG8_STAGE(PG8_SA(0, 1), cA + hstep, voffA);
    if (wr == 1) PG8_BAR;
    PG8_WAIT_V(4); PG8_BAR;
    PG8_STAGE(PG8_SB(1, 0), cB + kstep, voffB); PG8_STAGE(PG8_SA(1, 0), cA + kstep, voffA); PG8_STAGE(PG8_SB(1, 1), cB + hstep + kstep, voffB);
    PG8_WAIT_V(6); PG8_BAR;
    PG8_STAMP();
    for (;;) {
        const bool has_next = S.next(ui + 1, nxt);
        const char* nA = has_next ? (const char*)g.A + (size_t)nxt.pm * tstep : cA; const char* nB = has_next ? (const char*)g.Bt + (size_t)nxt.pn * tstep : cB;
        for (int t = 0; t < nt; t += 2) {
            const bool last = (t == nt - 2);
            const char* a1 = cA + (size_t)(t + 1) * kstep;
            const char* a2 = last ? nA : cA + (size_t)(t + 2) * kstep; const char* b2 = last ? nB : cB + (size_t)(t + 2) * kstep;
            const char* a3 = a2 + kstep; const char* b3 = b2 + kstep;
            if (last && has_next) S.a_ready(nxt);
            PG8_LDB(B0, 0, 0); PG8_SCHED; PG8_LDA(At, 0, 0); PG8_STAGE(PG8_SA(1, 1), a1 + hstep, voffA);
            PG8_WAIT_L(8); PG8_BAR; PG8_WAIT_L(0); PG8_MMA(0, 0, At, B0); PG8_BAR; PG8_SCHED;
            PG8_LDB(B1, 0, 1); PG8_STAGE(PG8_SB(0, 0), b2, voffB);
            PG8_BAR; PG8_WAIT_L(0); PG8_MMA(0, 1, At, B1); PG8_BAR;
            PG8_LDA(At, 0, 1); PG8_STAGE(PG8_SA(0, 0), a2, voffA);
            PG8_BAR; PG8_WAIT_L(0); PG8_MMA(1, 0, At, B0); PG8_BAR; PG8_SCHED;
            PG8_STAGE(PG8_SB(0, 1), b2 + hstep, voffB);
            PG8_WAIT_V(6); PG8_BAR; PG8_MMA(1, 1, At, B1); PG8_BAR;
            PG8_LDB(B0, 1, 0); PG8_SCHED; PG8_LDA(At, 1, 0); PG8_STAGE(PG8_SA(0, 1), a2 + hstep, voffA);
            PG8_WAIT_L(8); PG8_BAR; PG8_WAIT_L(0); PG8_MMA(0, 0, At, B0); PG8_BAR; PG8_SCHED;
            PG8_LDB(B1, 1, 1); PG8_STAGE(PG8_SB(1, 0), b3, voffB);
            PG8_BAR; PG8_WAIT_L(0); PG8_MMA(0, 1, At, B1); PG8_BAR;
            PG8_LDA(At, 1, 1); PG8_STAGE(PG8_SA(1, 0), a3, voffA);
            PG8_BAR; PG8_WAIT_L(0); PG8_MMA(1, 0, At, B0); PG8_BAR; PG8_SCHED;
            PG8_STAGE(PG8_SB(1, 1), b3 + hstep, voffB);
            PG8_WAIT_V(6); PG8_BAR; PG8_MMA(1, 1, At, B1); PG8_BAR;
        }
        PG8_STAMP();
        if constexpr (!Epi::AFTER_DRAIN) { E(acc, cur, wr, wc, fr, fq); S.done(cur); }
        PG8_STAMP();
        if (!has_next) break;
#pragma unroll
        for (int a = 0; a < 2; ++a)
#pragma unroll
            for (int b = 0; b < 2; ++b)
#pragma unroll
                for (int m = 0; m < 4; ++m)
#pragma unroll
                    for (int n = 0; n < 2; ++n) acc[a][b][m][n] = (f32x4){0.f, 0.f, 0.f, 0.f};
        cur = nxt; cA = nA; cB = nB; ++ui;
    }
    PG8_WAIT_V(0);
    if (wr == 0) PG8_BAR;
    PG8_BAR;
    if constexpr (Epi::AFTER_DRAIN) { E.fused(acc, cur, wr, wc, fr, fq, lds, wid, lane); S.done(cur); }
    PG8_STAMP();
    if (STAMP && wid == 0) { stamps[lane] = lane < nts ? (((unsigned long long)(unsigned)ts_hi << 32) | (unsigned)ts_lo) : 0ull;
        if (lane == 62) stamps[62] = rt_entry; if (lane == 63) stamps[63] = (unsigned long long)0ull; }
#undef PG8_STAMP
#undef PG8_SA
#undef PG8_SB
#undef PG8_STAGE
#undef PG8_LDA
#undef PG8_LDB
#undef PG8_MMA
#undef PG8_WAIT_V
#undef PG8_WAIT_L
#undef PG8_BAR
#undef PG8_SCHED
}
}

namespace {
constexpr int D = 1024, BATCH = 2, SEQ = 8192, T = BATCH * SEQ;
constexpr int PW = 2312;
constexpr int PS = 2304;
constexpr int OQ = 0, OKK = 512, OV = 640, OZ = 768, OXBC = 1280, ODT = 2304;
constexpr float EPS = 1e-6f;
constexpr int NTHR = 512;
typedef unsigned short bf16;
typedef unsigned v4u __attribute__((ext_vector_type(4)));

constexpr size_t MiB = 1u << 20;
constexpr size_t WS_WIN = 1 * MiB;
constexpr size_t WS_KH = 5 * MiB + 512 * 1024;
constexpr size_t WS_WO = 6 * MiB;
constexpr size_t WS_WQ = 8 * MiB;
constexpr size_t WS_PROJ = 10 * MiB;
constexpr size_t WS_XNB = 82 * MiB;
constexpr size_t WS_XACT = 114 * MiB;
constexpr size_t WS_DTRAW = 146 * MiB;
constexpr size_t WS_DT = WS_DTRAW + 512 * 1024;
constexpr size_t WS_ACS = WS_DT + 512 * 1024;
constexpr size_t WS_CDEC = WS_ACS + 512 * 1024;
constexpr size_t WS_STATES = 164 * MiB;
constexpr size_t WS_PREV = 196 * MiB;
constexpr size_t WS_QP = 10 * MiB;
constexpr size_t WS_IDX = 74 * MiB;
constexpr size_t WS_GATE = 114 * MiB;
constexpr size_t WS_TOPV = 122 * MiB;
constexpr size_t WS_TOPI = 138 * MiB;
constexpr size_t WS_ACT = 122 * MiB;
constexpr size_t WS_SU = 245 * MiB;
constexpr size_t WS_U8 = 212 * MiB;
constexpr size_t WS_V8 = 148 * MiB;
constexpr size_t WS_PART = 10 * MiB;
constexpr size_t WS_XQ = 228 * MiB;
constexpr size_t WS_XS = 244 * MiB;
constexpr size_t WS_PEERO = 10 * MiB;
constexpr size_t WS_END = 246 * MiB;
constexpr int CW_QU = 4096, CW_QV = 4096 + 64 * 16;
constexpr int NPART = 8, NCHUNK = T / 64;

struct Args {
    const float* x; const float* norm_mix_g; const float* w_in; const float* attn_sinks; const float* attn_out_g;
    const float* conv_w; const float* conv_b; const float* dt_bias; const float* a_log; const float* d_skip;
    const float* ssm_norm_g; const float* w_out; const float* norm_ffn_g; const float* peer_wq; const float* peer_sub_keys;
    const float* peer_u; const float* peer_v; const float* final_norm_g;
    float* out; unsigned char* ws;
    int ph_lo, ph_hi;
};

#define LAS __attribute__((address_space(3)))
#define LDS_WAIT() asm volatile("s_waitcnt lgkmcnt(0)" ::: "memory")
__device__ __forceinline__ float bf2f(bf16 v) { return __uint_as_float(((unsigned)v) << 16); }
__device__ __forceinline__ unsigned f2bfu(float f) { unsigned u = __float_as_uint(f); return (u + 0x7fffu + ((u >> 16) & 1u)) >> 16; }
__device__ __forceinline__ bf16 f2bf(float f) { return (bf16)f2bfu(f); }
__device__ __forceinline__ unsigned pk2(float lo, float hi) { return f2bfu(lo) | (f2bfu(hi) << 16); }
__device__ __forceinline__ float wave_sum(float v) {
#pragma unroll
    for (int o = 1; o < 64; o <<= 1) v += __shfl_xor(v, o);
    return v;
}
__device__ __forceinline__ float silu_f(float v) { return v / (1.f + __expf(-v)); }

__device__ __forceinline__ void transpose_item(const float* W, int ldw, int K, bf16* WT, LAS float* scr, int kb, int nbk, int lane) {
    const int k0 = 64 * kb, n0 = 32 * nbk;
#pragma unroll 8
    for (int i = 0; i < 32; ++i) { const int kk = 2 * i + (lane >> 5); scr[kk * 33 + (lane & 31)] = W[(size_t)(k0 + kk) * ldw + n0 + (lane & 31)]; }
    LDS_WAIT();
    const int c = lane & 7;
#pragma unroll
    for (int j = 0; j < 4; ++j) { const int n = (lane >> 3) + 8 * j; const LAS float* s = scr + (8 * c) * 33 + n;
        v4u o; o.x = pk2(s[0 * 33], s[1 * 33]); o.y = pk2(s[2 * 33], s[3 * 33]); o.z = pk2(s[4 * 33], s[5 * 33]); o.w = pk2(s[6 * 33], s[7 * 33]);
        *(v4u*)(WT + (size_t)(n0 + n) * K + k0 + 8 * c) = o; }
    LDS_WAIT();
}

template <int MODE  >
__device__ __forceinline__ void rmsnorm_rows_bf16(const float* in, const float* g, bf16* outp, const LAS unsigned char* ldsb, float* dtraw, unsigned char* xq, float* xs, int gwave, int nwaves, int lane) {
    for (int row = gwave; row < T; row += nwaves) {
        const float4* xr = (const float4*)(in + (size_t)row * D) + lane;
        float4 v[4]; float ss = 0.f;
#pragma unroll
        for (int j = 0; j < 4; ++j) { v[j] = xr[64 * j]; ss += v[j].x * v[j].x + v[j].y * v[j].y + v[j].z * v[j].z + v[j].w * v[j].w; }
        ss = wave_sum(ss);
        const float r = rsqrtf(ss * (1.f / D) + EPS);
        unsigned long long* o8 = (unsigned long long*)(outp + (size_t)row * D) + lane;
        float dacc[8]; float y[4][4]; float mx = 0.f;
#pragma unroll
        for (int h = 0; h < 8; ++h) dacc[h] = 0.f;
#pragma unroll
        for (int j = 0; j < 4; ++j) {
            const float4 gv = ((const float4*)g)[lane + 64 * j];
            y[j][0] = v[j].x * r * gv.x; y[j][1] = v[j].y * r * gv.y; y[j][2] = v[j].z * r * gv.z; y[j][3] = v[j].w * r * gv.w;
            o8[64 * j] = (unsigned long long)pk2(y[j][0], y[j][1]) | ((unsigned long long)pk2(y[j][2], y[j][3]) << 32);
            if (MODE == 2) mx = fmaxf(mx, fmaxf(fmaxf(fabsf(y[j][0]), fabsf(y[j][1])), fmaxf(fabsf(y[j][2]), fabsf(y[j][3]))));
            if (MODE == 1) {
#pragma unroll
                for (int h = 0; h < 8; ++h) {
                    typedef float f4v __attribute__((ext_vector_type(4)));
                    const f4v wv = *(const LAS f4v*)(ldsb + h * 16384 + 8448 + (256 * j + 4 * lane) * 4);
                    dacc[h] += y[j][0] * wv.x + y[j][1] * wv.y + y[j][2] * wv.z + y[j][3] * wv.w;
                }
            }
        }
        if (MODE == 1) {
#pragma unroll
            for (int h = 0; h < 8; ++h) dacc[h] = wave_sum(dacc[h]);
            if (lane == 0) { float4* dp = (float4*)(dtraw + (size_t)row * 8); dp[0] = make_float4(dacc[0], dacc[1], dacc[2], dacc[3]); dp[1] = make_float4(dacc[4], dacc[5], dacc[6], dacc[7]); }
        }
        if (MODE == 2) {
#pragma unroll
            for (int o = 1; o < 64; o <<= 1) mx = fmaxf(mx, __shfl_xor(mx, o));
            const float sc = mx > 0.f ? mx * (1.f / 127.f) : 1.f, inv = 1.f / sc;
            unsigned* dq = (unsigned*)(xq + (size_t)row * D) + lane;
#pragma unroll
            for (int j = 0; j < 4; ++j) { const int q0 = (int)rintf(y[j][0] * inv), q1 = (int)rintf(y[j][1] * inv), q2 = (int)rintf(y[j][2] * inv), q3 = (int)rintf(y[j][3] * inv);
                dq[64 * j] = (unsigned)(q0 & 255) | ((unsigned)(q1 & 255) << 8) | ((unsigned)(q2 & 255) << 16) | ((unsigned)(q3 & 255) << 24); }
            if (lane == 0) xs[row] = sc;
        }
    }
}

typedef short bf16x8 __attribute__((ext_vector_type(8)));
typedef short bf16x4 __attribute__((ext_vector_type(4)));
typedef float f32x16 __attribute__((ext_vector_type(16)));
typedef __bf16 bf2_t __attribute__((ext_vector_type(2)));
#define MFMA32(a, b, c) __builtin_amdgcn_mfma_f32_32x32x16_bf16((a), (b), (c), 0, 0, 0)
__device__ __forceinline__ unsigned pkbf(float lo, float hi) { bf2_t v = {(__bf16)lo, (__bf16)hi}; return __builtin_bit_cast(unsigned, v); }
__device__ __forceinline__ short bfs(float f) { return __builtin_bit_cast(short, (__bf16)f); }
__device__ __forceinline__ float sbf2f(short v) { return __uint_as_float(((unsigned)(unsigned short)v) << 16); }
__device__ __forceinline__ int crow(int i, int hi) { return (i & 3) + 8 * (i >> 2) + 4 * hi; }
template <int S> __device__ __forceinline__ bf16x8 pack8(const f32x16& x) {
    v4u p; p.x = pkbf(x[8 * S], x[8 * S + 1]); p.y = pkbf(x[8 * S + 2], x[8 * S + 3]); p.z = pkbf(x[8 * S + 4], x[8 * S + 5]); p.w = pkbf(x[8 * S + 6], x[8 * S + 7]);
    return __builtin_bit_cast(bf16x8, p);
}
__device__ __forceinline__ bf16x8 ldg8(const bf16* p) { return *(const bf16x8*)p; }
__device__ __forceinline__ bf16x8 lds8(const LAS bf16* p) { return *(const LAS bf16x8*)p; }
__device__ __forceinline__ bf16x8 lds4x2(const LAS bf16* p) { const bf16x4 a = *(const LAS bf16x4*)p, b = *(const LAS bf16x4*)(p + 8); return __builtin_shufflevector(a, b, 0, 1, 2, 3, 4, 5, 6, 7); }
__device__ __forceinline__ f32x16 zero16() { f32x16 z;
#pragma unroll
    for (int i = 0; i < 16; ++i) z[i] = 0.f;
    return z; }

__device__ __forceinline__ void attn_unit(const float* sinks, LAS unsigned char* ldsb, int unit, const bf16* PROJ, float* MIXF, int tid, int lane, int wave) {
    const int hkv = unit & 1, blk = unit >> 1, nbk = blk & 63;
    const int tokblk = blk * 128, wbase = tokblk - 128;
    LAS bf16* VT = (LAS bf16*)ldsb;
#pragma unroll
    for (int i = 0; i < 4; ++i) {
        const int c = tid + 512 * i, key = c >> 3, d0 = (c & 7) * 8; const bool valid = (nbk > 0) || (key >= 128);
        bf16x8 v;
#pragma unroll
        for (int e = 0; e < 8; ++e) v[e] = 0;
        if (valid) v = ldg8(PROJ + (size_t)(wbase + key) * PS + OV + hkv * 64 + d0);
#pragma unroll
        for (int e = 0; e < 8; ++e) VT[(d0 + e) * 264 + key] = (bf16)v[e];
    }
    __syncthreads();
    const int r = lane & 31, hi = lane >> 5;
    const int hq = hkv * 4 + (wave & 3);
    const float slope = exp2f(-(float)(hq + 1)), sink = sinks[hq];
#pragma unroll 1
    for (int qq = 0; qq < 2; ++qq) {
        const int qt = (wave >> 2) + 2 * qq;
        const int tq = tokblk + 32 * qt + r;
        bf16x8 qf[4];
#pragma unroll
        for (int ks = 0; ks < 4; ++ks) qf[ks] = ldg8(PROJ + (size_t)tq * PS + OQ + hq * 64 + 16 * ks + 8 * hi);
        f32x16 X[5];
#pragma unroll
        for (int kt = 0; kt < 5; ++kt) {
            const int key = 32 * (qt + kt) + r; const bool valid = (nbk > 0) || (key >= 128);
            const int row = valid ? (wbase + key) : tokblk;
            X[kt] = zero16();
#pragma unroll
            for (int ks = 0; ks < 4; ++ks) { const bf16x8 kf = ldg8(PROJ + (size_t)row * PS + OKK + hkv * 64 + 16 * ks + 8 * hi); X[kt] = MFMA32(kf, qf[ks], X[kt]); }
        }
        const int qi = 32 * qt + r;
        float m = -1e30f;
#pragma unroll
        for (int kt = 0; kt < 5; ++kt)
#pragma unroll
            for (int i = 0; i < 16; ++i) {
                const int ki = 32 * (qt + kt) + crow(i, hi), dist = 128 + qi - ki;
                const bool valid = (dist >= 0) && (dist < 128) && ((nbk > 0) || (ki >= 128));
                const float lg = valid ? (X[kt][i] * 0.125f - slope * (float)dist) : -1e30f;
                X[kt][i] = lg; m = fmaxf(m, lg);
            }
        m = fmaxf(m, __shfl_xor(m, 32)); m = fmaxf(m, sink);
        float lsum = 0.f;
#pragma unroll
        for (int kt = 0; kt < 5; ++kt)
#pragma unroll
            for (int i = 0; i < 16; ++i) { const float p = __expf(X[kt][i] - m); X[kt][i] = p; lsum += p; }
        lsum += __shfl_xor(lsum, 32); lsum += __expf(sink - m);
        f32x16 O0 = zero16(), O1 = zero16();
#pragma unroll
        for (int kt = 0; kt < 5; ++kt) {
            const int kb = 32 * (qt + kt) + 4 * hi;
            { const bf16x8 xs = pack8<0>(X[kt]); const bf16x8 a0 = lds4x2(VT + r * 264 + kb), a1 = lds4x2(VT + (32 + r) * 264 + kb); O0 = MFMA32(a0, xs, O0); O1 = MFMA32(a1, xs, O1); }
            { const bf16x8 xs = pack8<1>(X[kt]); const bf16x8 a0 = lds4x2(VT + r * 264 + kb + 16), a1 = lds4x2(VT + (32 + r) * 264 + kb + 16); O0 = MFMA32(a0, xs, O0); O1 = MFMA32(a1, xs, O1); }
        }
        const float inv = 1.f / lsum;
        float* orow = MIXF + (size_t)tq * D + hq * 64 + 4 * hi;
#pragma unroll
        for (int q4 = 0; q4 < 4; ++q4) {
            *(float4*)(orow + 8 * q4) = make_float4(O0[4 * q4] * inv, O0[4 * q4 + 1] * inv, O0[4 * q4 + 2] * inv, O0[4 * q4 + 3] * inv);
            *(float4*)(orow + 32 + 8 * q4) = make_float4(O1[4 * q4] * inv, O1[4 * q4 + 1] * inv, O1[4 * q4 + 2] * inv, O1[4 * q4 + 3] * inv);
        }
    }
    __syncthreads();
}

__device__ __forceinline__ void ssd_chunk_unit(LAS unsigned char* ldsb, int unit, const bf16* XACT, const float* DT, const float* ACS, float* MIXF, float* STATES, int tid, int lane, int wave) {
    const int g = unit & 1, bc = unit >> 1, tok0 = bc * 128;
    LAS bf16* BT = (LAS bf16*)ldsb;
    LAS bf16* XD = (LAS bf16*)(ldsb + 34816);
    LAS bf16* XW = (LAS bf16*)(ldsb + 34816 + 34816);
    LAS float* ACST = (LAS float*)(ldsb + 34816 * 3);
    const int r = lane & 31, hi = lane >> 5;
#pragma unroll
    for (int i = 0; i < 4; ++i) {
        const int c = tid + 512 * i, s = c >> 4, n0 = (c & 15) * 8;
        const bf16x8 v = ldg8(XACT + (size_t)(tok0 + s) * 1024 + 512 + g * 128 + n0);
#pragma unroll
        for (int e = 0; e < 8; ++e) BT[(n0 + e) * 136 + s] = (bf16)v[e];
    }
    ACST[tid] = ACS[(size_t)(tok0 + (tid >> 2)) * 8 + g * 4 + (tid & 3)];
#pragma unroll 1
    for (int hp = 0; hp < 2; ++hp) {
        if (hp) __syncthreads();
#pragma unroll
        for (int i = 0; i < 4; ++i) {
            const int c = tid + 512 * i, hsel = c >> 10, s = (c >> 3) & 127, p0 = (c & 7) * 8, H = g * 4 + 2 * hp + hsel;
            const bf16x8 v = ldg8(XACT + (size_t)(tok0 + s) * 1024 + H * 64 + p0);
            const float dtv = DT[(size_t)(tok0 + s) * 8 + H];
            const float w = __expf(ACS[(size_t)(tok0 + 127) * 8 + H] - ACS[(size_t)(tok0 + s) * 8 + H]);
#pragma unroll
            for (int e = 0; e < 8; ++e) { const float xd = sbf2f(v[e]) * dtv; XD[hsel * 8704 + (p0 + e) * 136 + s] = (bf16)bfs(xd); XW[hsel * 8704 + (p0 + e) * 136 + s] = (bf16)bfs(xd * w); }
        }
        __syncthreads();
        {
            const int lt = wave & 3, hsel = wave >> 2, hh = 2 * hp + hsel, H = g * 4 + hh;
            const int l = 32 * lt + r; const float acs_l = ACST[l * 4 + hh];
            bf16x8 cf[8];
#pragma unroll
            for (int ks = 0; ks < 8; ++ks) cf[ks] = ldg8(XACT + (size_t)(tok0 + l) * 1024 + 768 + g * 128 + 16 * ks + 8 * hi);
            f32x16 Z0 = zero16(), Z1 = zero16();
#pragma unroll 1
            for (int st = 0; st <= lt; ++st) {
                f32x16 X = zero16();
#pragma unroll
                for (int ks = 0; ks < 8; ++ks) { const bf16x8 bfr = ldg8(XACT + (size_t)(tok0 + 32 * st + r) * 1024 + 512 + g * 128 + 16 * ks + 8 * hi); X = MFMA32(bfr, cf[ks], X); }
#pragma unroll
                for (int i = 0; i < 16; ++i) { const int s = 32 * st + crow(i, hi); const float f = (s <= l) ? __expf(acs_l - ACST[s * 4 + hh]) : 0.f; X[i] *= f; }
                const int sb = 32 * st + 4 * hi;
                { const bf16x8 xs = pack8<0>(X); const bf16x8 b0 = lds4x2(XD + hsel * 8704 + r * 136 + sb), b1 = lds4x2(XD + hsel * 8704 + (32 + r) * 136 + sb); Z0 = MFMA32(xs, b0, Z0); Z1 = MFMA32(xs, b1, Z1); }
                { const bf16x8 xs = pack8<1>(X); const bf16x8 b0 = lds4x2(XD + hsel * 8704 + r * 136 + sb + 16), b1 = lds4x2(XD + hsel * 8704 + (32 + r) * 136 + sb + 16); Z0 = MFMA32(xs, b0, Z0); Z1 = MFMA32(xs, b1, Z1); }
            }
#pragma unroll
            for (int i = 0; i < 16; ++i) { float* o = MIXF + (size_t)(tok0 + 32 * lt + crow(i, hi)) * D + 512 + H * 64 + r; o[0] = Z0[i]; o[32] = Z1[i]; }
        }
        {
            const int nt = wave & 3, hsel = wave >> 2, H = g * 4 + 2 * hp + hsel;
            f32x16 S0 = zero16(), S1 = zero16();
#pragma unroll
            for (int ks = 0; ks < 8; ++ks) {
                const bf16x8 btf = lds8(BT + (32 * nt + r) * 136 + 16 * ks + 8 * hi);
                const bf16x8 a0 = lds8(XW + hsel * 8704 + r * 136 + 16 * ks + 8 * hi), a1 = lds8(XW + hsel * 8704 + (32 + r) * 136 + 16 * ks + 8 * hi);
                S0 = MFMA32(a0, btf, S0); S1 = MFMA32(a1, btf, S1);
            }
            float* sp = STATES + (size_t)(bc * 8 + H) * 8192 + 32 * nt + r;
#pragma unroll
            for (int i = 0; i < 16; ++i) { const int p = crow(i, hi); sp[p * 128] = S0[i]; sp[(32 + p) * 128] = S1[i]; }
        }
    }
    __syncthreads();
}

__device__ __forceinline__ void yoff_unit(const float* d_skip, int unit, const bf16* XACT, const bf16* PROJ, const float* ACS, const bf16* PREVT, float* MIXF, int lane, int wave) {
    const int g = unit & 1, bc = unit >> 1, tok0 = bc * 128;
    const int r = lane & 31, hi = lane >> 5, lt = wave & 3, hpair = wave >> 2;
    bf16x8 cf[8];
#pragma unroll
    for (int ks = 0; ks < 8; ++ks) cf[ks] = ldg8(XACT + (size_t)(tok0 + 32 * lt + r) * 1024 + 768 + g * 128 + 16 * ks + 8 * hi);
#pragma unroll 1
    for (int hsel = 0; hsel < 2; ++hsel) {
        const int H = g * 4 + 2 * hpair + hsel; const bf16* pv = PREVT + (size_t)(bc * 8 + H) * 8192;
        f32x16 Y0 = zero16(), Y1 = zero16();
#pragma unroll
        for (int ks = 0; ks < 8; ++ks) {
            const bf16x8 b0 = ldg8(pv + r * 128 + 16 * ks + 8 * hi), b1 = ldg8(pv + (32 + r) * 128 + 16 * ks + 8 * hi);
            Y0 = MFMA32(cf[ks], b0, Y0); Y1 = MFMA32(cf[ks], b1, Y1);
        }
        const float dsk = d_skip[H];
        float eav[16];
#pragma unroll
        for (int i = 0; i < 16; ++i) eav[i] = ACS[(unsigned)((tok0 + 32 * lt + crow(i, hi)) * 8 + H)];
#pragma unroll
        for (int pt = 0; pt < 2; ++pt) {
            const unsigned col = (unsigned)(H * 64 + 32 * pt + r);
            float yo[16], xsv[16], zv[16];
#pragma unroll
            for (int i = 0; i < 16; ++i) { const unsigned t = (unsigned)(tok0 + 32 * lt + crow(i, hi));
                yo[i] = MIXF[t * 1024u + 512u + col]; xsv[i] = bf2f(XACT[t * 1024u + col]); zv[i] = bf2f(PROJ[t * (unsigned)PS + (unsigned)OZ + col]); }
#pragma unroll
            for (int i = 0; i < 16; ++i) { const unsigned t = (unsigned)(tok0 + 32 * lt + crow(i, hi));
                const float y = yo[i] + __expf(eav[i]) * (pt ? Y1[i] : Y0[i]) + dsk * xsv[i];
                MIXF[t * 1024u + 512u + col] = y * silu_f(zv[i]); }
        }
    }
}
typedef float f32x2 __attribute__((ext_vector_type(2)));
__device__ __forceinline__ void fp8x16_to_f32(const uint4 w, float (&f)[16]) {
    const int ww[4] = {(int)w.x, (int)w.y, (int)w.z, (int)w.w};
#pragma unroll
    for (int q = 0; q < 4; ++q) { const f32x2 a = __builtin_amdgcn_cvt_pk_f32_fp8(ww[q], false), b = __builtin_amdgcn_cvt_pk_f32_fp8(ww[q], true); f[4 * q] = a.x; f[4 * q + 1] = a.y; f[4 * q + 2] = b.x; f[4 * q + 3] = b.y; }
}
template <int M4, int M2, int M1> __device__ __forceinline__ void treduce16(const float (&a)[16], int lane, float& r0, float& r1) {
    float b[8], c[4];
    { const bool hi = (lane & M4) != 0;
#pragma unroll
      for (int i = 0; i < 8; ++i) { const float send = hi ? a[i] : a[i + 8]; const float recv = __shfl_xor(send, M4); b[i] = (hi ? a[i + 8] : a[i]) + recv; } }
    { const bool hi = (lane & M2) != 0;
#pragma unroll
      for (int i = 0; i < 4; ++i) { const float send = hi ? b[i] : b[i + 4]; const float recv = __shfl_xor(send, M2); c[i] = (hi ? b[i + 4] : b[i]) + recv; } }
    { const bool hi = (lane & M1) != 0;
      { const float send = hi ? c[0] : c[2]; const float recv = __shfl_xor(send, M1); r0 = (hi ? c[2] : c[0]) + recv; }
      { const float send = hi ? c[1] : c[3]; const float recv = __shfl_xor(send, M1); r1 = (hi ? c[3] : c[1]) + recv; } }
}
template <int M4, int M2, int M1> __device__ __forceinline__ void treduce16i(const int (&a)[16], int lane, int& r0, int& r1) {
    int b[8], c[4];
    { const bool hi = (lane & M4) != 0;
#pragma unroll
      for (int i = 0; i < 8; ++i) { const int send = hi ? a[i] : a[i + 8]; const int recv = __shfl_xor(send, M4); b[i] = (hi ? a[i + 8] : a[i]) + recv; } }
    { const bool hi = (lane & M2) != 0;
#pragma unroll
      for (int i = 0; i < 4; ++i) { const int send = hi ? b[i] : b[i + 4]; const int recv = __shfl_xor(send, M2); c[i] = (hi ? b[i + 4] : b[i]) + recv; } }
    { const bool hi = (lane & M1) != 0;
      { const int send = hi ? c[0] : c[2]; const int recv = __shfl_xor(send, M1); r0 = (hi ? c[2] : c[0]) + recv; }
      { const int send = hi ? c[1] : c[3]; const int recv = __shfl_xor(send, M1); r1 = (hi ? c[3] : c[1]) + recv; } }
}
#define PE_ID(E, i) (((i) & 1) ? (E[(i) >> 1] >> 16) : (E[(i) >> 1] & 0xffffu))
__device__ __forceinline__ void peer_u_item(int p, int j, const unsigned short* __restrict__ IDX, const unsigned char* __restrict__ XQ, const unsigned char* __restrict__ U8, int* __restrict__ PART, int lane, int wave) {
    asm volatile("" : "+v"(lane));
    const int gidx = lane >> 3; const unsigned coff = (unsigned)(p * 128 + (lane & 7) * 16);
#pragma unroll 1
    for (int it = 0; it < 8; ++it) {
        const int t = j * 64 + it * 8 + wave;
        unsigned E[8];
        { const uint4 e0 = *(const uint4*)(IDX + (size_t)t * 128 + 16 * gidx), e1 = *(const uint4*)(IDX + (size_t)t * 128 + 16 * gidx + 8);
          E[0] = e0.x; E[1] = e0.y; E[2] = e0.z; E[3] = e0.w; E[4] = e1.x; E[5] = e1.y; E[6] = e1.z; E[7] = e1.w; }
        uint4 uu[16];
#pragma unroll
        for (int i = 0; i < 16; ++i) uu[i] = *(const uint4*)(U8 + (size_t)(PE_ID(E, i) * 1024u + coff));
        const uint4 xq = *(const uint4*)(XQ + (size_t)t * D + coff);
        int d[16];
#pragma unroll
        for (int i = 0; i < 16; ++i) {
            int s = __builtin_amdgcn_sdot4((int)uu[i].x, (int)xq.x, 0, false); s = __builtin_amdgcn_sdot4((int)uu[i].y, (int)xq.y, s, false);
            s = __builtin_amdgcn_sdot4((int)uu[i].z, (int)xq.z, s, false); s = __builtin_amdgcn_sdot4((int)uu[i].w, (int)xq.w, s, false);
            d[i] = s;
        }
        int r0, r1; treduce16i<4, 2, 1>(d, lane, r0, r1);
        *(int2*)(PART + ((size_t)p * T + t) * 128 + 2 * lane) = make_int2(r0, r1);
    }
}
__device__ __forceinline__ void peer_v_item(int p, int j, const unsigned short* __restrict__ IDX, const unsigned char* __restrict__ ACTQ, const float* __restrict__ ACTS,
                                            const unsigned char* __restrict__ V8, float* __restrict__ PEERO, int lane, int wave) {
    asm volatile("" : "+v"(lane));
    const int gidx = lane >> 3; const unsigned coff = (unsigned)(p * 128 + (lane & 7) * 16);
#pragma unroll 1
    for (int it = 0; it < 8; ++it) {
        const int t = j * 64 + it * 8 + wave;
        unsigned E[8];
        { const uint4 e0 = *(const uint4*)(IDX + (size_t)t * 128 + 16 * gidx), e1 = *(const uint4*)(IDX + (size_t)t * 128 + 16 * gidx + 8);
          E[0] = e0.x; E[1] = e0.y; E[2] = e0.z; E[3] = e0.w; E[4] = e1.x; E[5] = e1.y; E[6] = e1.z; E[7] = e1.w; }
        uint4 vv[16];
#pragma unroll
        for (int i = 0; i < 16; ++i) vv[i] = *(const uint4*)(V8 + (size_t)(PE_ID(E, i) * 1024u + coff));
        const uint4 aq = *(const uint4*)(ACTQ + (size_t)t * 128 + 16 * gidx);
        const float asc = ACTS[t];
        const unsigned a4[4] = {aq.x, aq.y, aq.z, aq.w};
        int acc[16];
#pragma unroll
        for (int c = 0; c < 16; ++c) acc[c] = 0;
#pragma unroll
        for (int m = 0; m < 4; ++m) {
            const unsigned r0[4] = {vv[4 * m].x, vv[4 * m].y, vv[4 * m].z, vv[4 * m].w}, r1[4] = {vv[4 * m + 1].x, vv[4 * m + 1].y, vv[4 * m + 1].z, vv[4 * m + 1].w};
            const unsigned r2[4] = {vv[4 * m + 2].x, vv[4 * m + 2].y, vv[4 * m + 2].z, vv[4 * m + 2].w}, r3[4] = {vv[4 * m + 3].x, vv[4 * m + 3].y, vv[4 * m + 3].z, vv[4 * m + 3].w};
#pragma unroll
            for (int dc = 0; dc < 4; ++dc) {
                const unsigned ta = __builtin_amdgcn_perm(r1[dc], r0[dc], 0x05010400u), tb = __builtin_amdgcn_perm(r3[dc], r2[dc], 0x05010400u);
                const unsigned ua = __builtin_amdgcn_perm(r1[dc], r0[dc], 0x07030602u), ub = __builtin_amdgcn_perm(r3[dc], r2[dc], 0x07030602u);
                const unsigned c0 = __builtin_amdgcn_perm(tb, ta, 0x05040100u), c1 = __builtin_amdgcn_perm(tb, ta, 0x07060302u);
                const unsigned c2 = __builtin_amdgcn_perm(ub, ua, 0x05040100u), c3 = __builtin_amdgcn_perm(ub, ua, 0x07060302u);
                acc[4 * dc + 0] = __builtin_amdgcn_sdot4((int)c0, (int)a4[m], acc[4 * dc + 0], false);
                acc[4 * dc + 1] = __builtin_amdgcn_sdot4((int)c1, (int)a4[m], acc[4 * dc + 1], false);
                acc[4 * dc + 2] = __builtin_amdgcn_sdot4((int)c2, (int)a4[m], acc[4 * dc + 2], false);
                acc[4 * dc + 3] = __builtin_amdgcn_sdot4((int)c3, (int)a4[m], acc[4 * dc + 3], false);
            }
        }
        int r0i, r1i; treduce16i<32, 16, 8>(acc, lane, r0i, r1i);
        *(float2*)(PEERO + (size_t)t * D + coff + 2 * gidx) = make_float2(asc * (float)r0i, asc * (float)r1i);
    }
}

__device__ __forceinline__ void ce_desc(float& a, float& b) { const float hi = fmaxf(a, b), lo = fminf(a, b); a = hi; b = lo; }
__device__ __forceinline__ void sort16_desc(float (&v)[16]) {
#pragma unroll
    for (int k = 2; k <= 16; k <<= 1)
#pragma unroll
        for (int j = k >> 1; j > 0; j >>= 1)
#pragma unroll
            for (int i = 0; i < 16; ++i) { const int l = i ^ j; if (l > i) { if ((i & k) == 0) ce_desc(v[i], v[l]); else ce_desc(v[l], v[i]); } }
}
__device__ __forceinline__ void merge16_desc(float (&a)[16], const float (&b)[16]) {
#pragma unroll
    for (int i = 0; i < 16; ++i) a[i] = fmaxf(a[i], b[15 - i]);
#pragma unroll
    for (int j = 8; j > 0; j >>= 1)
#pragma unroll
        for (int i = 0; i < 16; ++i) { const int l = i ^ j; if (l > i) ce_desc(a[i], a[l]); }
}
__device__ __forceinline__ void ce_kv(float& ka, int& va, float& kb, int& vb) {
    const bool s = kb > ka; const float t0 = s ? kb : ka, t1 = s ? ka : kb; const int u0 = s ? vb : va, u1 = s ? va : vb; ka = t0; kb = t1; va = u0; vb = u1; }
__device__ __forceinline__ void sort16_kv(float (&k)[16], int (&v)[16]) {
#pragma unroll
    for (int kk = 2; kk <= 16; kk <<= 1)
#pragma unroll
        for (int j = kk >> 1; j > 0; j >>= 1)
#pragma unroll
            for (int i = 0; i < 16; ++i) { const int l = i ^ j; if (l > i) { if ((i & kk) == 0) ce_kv(k[i], v[i], k[l], v[l]); else ce_kv(k[l], v[l], k[i], v[i]); } }
}
__device__ __forceinline__ void merge16_kv(float (&ka)[16], int (&va)[16], const float (&kb)[16], const int (&vb)[16]) {
#pragma unroll
    for (int i = 0; i < 16; ++i) { const bool s = kb[15 - i] > ka[i]; ka[i] = s ? kb[15 - i] : ka[i]; va[i] = s ? vb[15 - i] : va[i]; }
#pragma unroll
    for (int j = 8; j > 0; j >>= 1)
#pragma unroll
        for (int i = 0; i < 16; ++i) { const int l = i ^ j; if (l > i) ce_kv(ka[i], va[i], ka[l], va[l]); }
}
__device__ __forceinline__ void split8(const float* p, bf16x8& hi8, bf16x8& lo8) {
    const float4 f0 = *(const float4*)p, f1 = *(const float4*)(p + 4);
    const float x[8] = {f0.x, f0.y, f0.z, f0.w, f1.x, f1.y, f1.z, f1.w};
#pragma unroll
    for (int j = 0; j < 8; ++j) { const short h = bfs(x[j]); hi8[j] = h; lo8[j] = bfs(x[j] - sbf2f(h)); }
}
__device__ __forceinline__ void route_task(int task, const float* QP, const bf16* KH, const bf16* KL, unsigned short* IDX, float* GATE, int lane) {
    const int r = lane & 31, hi = lane >> 5, t = 4 * task + (r >> 3), head = r & 7;
    float top[2][16];
#pragma unroll
    for (int half = 0; half < 2; ++half) {
        bf16x8 qh[4], ql[4];
#pragma unroll
        for (int ks = 0; ks < 4; ++ks) split8(QP + (size_t)t * D + head * 128 + half * 64 + 16 * ks + 8 * hi, qh[ks], ql[ks]);
        float cur[16];
#pragma unroll
        for (int kt = 0; kt < 4; ++kt) {
            f32x16 X = zero16();
            const bf16* khp = KH + (size_t)(half * 128 + 32 * kt + r) * 64 + 8 * hi; const bf16* klp = KL + (size_t)(half * 128 + 32 * kt + r) * 64 + 8 * hi;
            asm volatile("" : "+v"(khp), "+v"(klp));
#pragma unroll
            for (int ks = 0; ks < 4; ++ks) {
                const bf16x8 kh = ldg8(khp + 16 * ks), kl = ldg8(klp + 16 * ks);
                X = MFMA32(kh, qh[ks], X); X = MFMA32(kh, ql[ks], X); X = MFMA32(kl, qh[ks], X);
            }
            float grp[16];
#pragma unroll
            for (int i = 0; i < 16; ++i) { const unsigned key = (unsigned)(32 * kt + crow(i, hi)); grp[i] = __uint_as_float((__float_as_uint(X[i]) & ~127u) | (127u - key)); }
            sort16_desc(grp);
            if (kt == 0) {
#pragma unroll
                for (int i = 0; i < 16; ++i) cur[i] = grp[i];
            } else merge16_desc(cur, grp);
        }
        float oth[16];
#pragma unroll
        for (int i = 0; i < 16; ++i) oth[i] = __shfl_xor(cur[i], 32);
        merge16_desc(cur, oth);
#pragma unroll
        for (int i = 0; i < 16; ++i) top[half][i] = cur[i];
    }
    unsigned P1[4], P2[4];
#pragma unroll
    for (int q = 0; q < 4; ++q) { P1[q] = 0u; P2[q] = 0u;
#pragma unroll
        for (int s = 0; s < 4; ++s) { P1[q] |= (127u - (__float_as_uint(top[0][4 * q + s]) & 127u)) << (8 * s); P2[q] |= (127u - (__float_as_uint(top[1][4 * q + s]) & 127u)) << (8 * s); } }
#define CAND(a, b) __uint_as_float((__float_as_uint(top[0][a] + top[1][b]) & ~255u) | (255u - (unsigned)((a) * 16 + (b))))
    float bk[16];
    {
        float gk[16];
        gk[0] = CAND(0, 0);
        gk[1] = CAND(0, 1);
        gk[2] = CAND(0, 2);
        gk[3] = CAND(0, 3);
        gk[4] = CAND(0, 4);
        gk[5] = CAND(0, 5);
        gk[6] = CAND(0, 6);
        gk[7] = CAND(0, 7);
        gk[8] = CAND(0, 8);
        gk[9] = CAND(0, 9);
        gk[10] = CAND(0, 10);
        gk[11] = CAND(0, 11);
        gk[12] = CAND(0, 12);
        gk[13] = CAND(0, 13);
        gk[14] = CAND(0, 14);
        gk[15] = CAND(0, 15);
        sort16_desc(gk);
#pragma unroll
        for (int i = 0; i < 16; ++i) bk[i] = gk[i];
    }
    {
        float gk[16];
        gk[0] = CAND(1, 0);
        gk[1] = CAND(1, 1);
        gk[2] = CAND(1, 2);
        gk[3] = CAND(1, 3);
        gk[4] = CAND(1, 4);
        gk[5] = CAND(1, 5);
        gk[6] = CAND(1, 6);
        gk[7] = CAND(1, 7);
        gk[8] = CAND(2, 0);
        gk[9] = CAND(2, 1);
        gk[10] = CAND(2, 2);
        gk[11] = CAND(2, 3);
        gk[12] = CAND(2, 4);
        gk[13] = CAND(3, 0);
        gk[14] = CAND(3, 1);
        gk[15] = CAND(3, 2);
        sort16_desc(gk);
        merge16_desc(bk, gk);
    }
    {
        float gk[16];
        gk[0] = CAND(3, 3);
        gk[1] = CAND(4, 0);
        gk[2] = CAND(4, 1);
        gk[3] = CAND(4, 2);
        gk[4] = CAND(5, 0);
        gk[5] = CAND(5, 1);
        gk[6] = CAND(6, 0);
        gk[7] = CAND(6, 1);
        gk[8] = CAND(7, 0);
        gk[9] = CAND(7, 1);
        gk[10] = CAND(8, 0);
        gk[11] = CAND(9, 0);
        gk[12] = CAND(10, 0);
        gk[13] = CAND(11, 0);
        gk[14] = CAND(12, 0);
        gk[15] = CAND(13, 0);
        sort16_desc(gk);
        merge16_desc(bk, gk);
    }
    {
        float gk[16];
        gk[0] = CAND(14, 0);
        gk[1] = CAND(15, 0);
        gk[2] = -INFINITY;
        gk[3] = -INFINITY;
        gk[4] = -INFINITY;
        gk[5] = -INFINITY;
        gk[6] = -INFINITY;
        gk[7] = -INFINITY;
        gk[8] = -INFINITY;
        gk[9] = -INFINITY;
        gk[10] = -INFINITY;
        gk[11] = -INFINITY;
        gk[12] = -INFINITY;
        gk[13] = -INFINITY;
        gk[14] = -INFINITY;
        gk[15] = -INFINITY;
        sort16_desc(gk);
        merge16_desc(bk, gk);
    }
#undef CAND
    int bv[16];
#pragma unroll
    for (int i = 0; i < 16; ++i) {
        const unsigned cd = 255u - (__float_as_uint(bk[i]) & 255u), ca = cd >> 4, cb = cd & 15u;
        const unsigned wa = (ca >> 2) == 0u ? P1[0] : (ca >> 2) == 1u ? P1[1] : (ca >> 2) == 2u ? P1[2] : P1[3];
        const unsigned wb = (cb >> 2) == 0u ? P2[0] : (cb >> 2) == 1u ? P2[1] : (cb >> 2) == 2u ? P2[2] : P2[3];
        bv[i] = (int)((((wa >> (8u * (ca & 3u))) & 255u) << 7) | ((wb >> (8u * (cb & 3u))) & 255u));
    }
    float e[16], se = 0.f;
#pragma unroll
    for (int i = 0; i < 16; ++i) { e[i] = __expf(bk[i] - bk[0]); se += e[i]; }
    const float inv = 1.f / se;
    if (hi == 0) {
        uint4* ip = (uint4*)(IDX + (size_t)t * 128 + head * 16); float4* gp = (float4*)(GATE + (size_t)t * 128 + head * 16);
#pragma unroll
        for (int q = 0; q < 2; ++q) ip[q] = make_uint4((unsigned)bv[8 * q] | ((unsigned)bv[8 * q + 1] << 16), (unsigned)bv[8 * q + 2] | ((unsigned)bv[8 * q + 3] << 16), (unsigned)bv[8 * q + 4] | ((unsigned)bv[8 * q + 5] << 16), (unsigned)bv[8 * q + 6] | ((unsigned)bv[8 * q + 7] << 16));
#pragma unroll
        for (int q = 0; q < 4; ++q) gp[q] = make_float4(e[4 * q] * inv, e[4 * q + 1] * inv, e[4 * q + 2] * inv, e[4 * q + 3] * inv);
    }
}

#define XB_TMO      128
#define XB_XCNT(j)  (256  + 64 * (j))
#define XB_XSUB(j)  (1280 + 64 * (j))
#define XB_XGEN(j)  (2304 + 64 * (j))
#define XB_TOP      3328
#define XB_TOPGEN   3392
#define XCD_BAR_WORDS 3456
#define XB_SPIN_CAP (1u << 22)
__device__ __forceinline__ unsigned xb_ld(unsigned* p)              { return __hip_atomic_load(p, __ATOMIC_RELAXED, __HIP_MEMORY_SCOPE_AGENT); }
__device__ __forceinline__ unsigned xb_add(unsigned* p, unsigned v) { return __hip_atomic_fetch_add(p, v, __ATOMIC_RELAXED, __HIP_MEMORY_SCOPE_AGENT); }
__device__ __forceinline__ unsigned xb_xcc_id() { return (unsigned)__builtin_amdgcn_s_getreg((3 << 11) | 20) & 0xFu; }
#define XB_SPIN(cond, bar) do { unsigned _sp = 0; while (cond) { __builtin_amdgcn_s_sleep(1); \
    if ((++_sp & 255u) == 0u) { if (xb_ld(&(bar)[XB_TMO])) break; if (_sp > XB_SPIN_CAP) { atomicAdd(&(bar)[XB_TMO], 1u); break; } } } } while (0)
struct XcdBarrier { unsigned* bar; unsigned x; volatile LAS unsigned* st; };
__device__ __forceinline__ XcdBarrier xcd_barrier_post(unsigned* bar, volatile LAS unsigned* st) {
    XcdBarrier b; b.bar = bar; b.x = xb_xcc_id(); b.st = st;
    if (threadIdx.x == 0) (void)xb_add(&bar[XB_XCNT(b.x)], 1u);
    return b;
}
__device__ __forceinline__ void xcd_barrier_complete(unsigned* bar, unsigned x, unsigned& nloc, unsigned& nx) {
    const unsigned G = gridDim.x * gridDim.y * gridDim.z;
    unsigned sum, cnt, mine, sp = 0u;
    for (;;) {
        sum = 0u; cnt = 0u; mine = 0u;
#pragma unroll
        for (unsigned j = 0; j < 16; ++j) { const unsigned c = xb_ld(&bar[XB_XCNT(j)]); sum += c; cnt += (c > 0u) ? 1u : 0u; mine = (j == x) ? c : mine; }
        if (sum == G) break;
        __builtin_amdgcn_s_sleep(1);
        if ((++sp & 255u) == 0u) { if (xb_ld(&bar[XB_TMO])) break; if (sp > XB_SPIN_CAP) { atomicAdd(&bar[XB_TMO], 1u); break; } }
    }
    nloc = mine > 0u ? mine : 1u; nx = cnt > 0u ? cnt : 1u;
}
__device__ __forceinline__ void xcd_barrier(const XcdBarrier& b) {
    asm volatile("s_waitcnt vmcnt(0)" ::: "memory");
    __syncthreads();
    if (threadIdx.x == 0) {
        unsigned* bar = b.bar;
        __builtin_amdgcn_s_waitcnt(0);
        unsigned nloc = b.st[0], nx = b.st[1];
        if (nloc == 0u) { xcd_barrier_complete(bar, b.x, nloc, nx); b.st[0] = nloc; b.st[1] = nx; }
        const unsigned old = xb_add(&bar[XB_XSUB(b.x)], 1u);
        const unsigned gen = old / nloc;
        if (old + 1u == (gen + 1u) * nloc) {
            __builtin_amdgcn_fence(__ATOMIC_RELEASE, "agent");
            asm volatile("s_waitcnt vmcnt(0)" ::: "memory");
            const unsigned og = xb_add(&bar[XB_TOP], 1u);
            const unsigned tg = og / nx;
            if (og + 1u == (tg + 1u) * nx) xb_add(&bar[XB_TOPGEN], 1u);
            else XB_SPIN(xb_ld(&bar[XB_TOPGEN]) == tg, bar);
            __builtin_amdgcn_fence(__ATOMIC_ACQUIRE, "agent");
            xb_add(&bar[XB_XGEN(b.x)], 1u);
            asm volatile("s_waitcnt vmcnt(0)" ::: "memory");
        } else {
            XB_SPIN(xb_ld(&bar[XB_XGEN(b.x)]) == gen, bar);
            __builtin_amdgcn_fence(__ATOMIC_ACQUIRE, "agent");
            asm volatile("s_waitcnt vmcnt(0)" ::: "memory");
        }
    }
    __syncthreads();
}
constexpr int LDS_BYTES = 147456;
constexpr int MISC_OFF = 131072 + 320;

__global__ void __launch_bounds__(NTHR, 2) k_main(Args a) {
    extern __shared__ __attribute__((aligned(16))) unsigned char lds_raw[];
    LAS unsigned char* ldsb = (LAS unsigned char*)lds_raw;
    const int tid0 = threadIdx.x, bid = blockIdx.x, nb = gridDim.x;
    const int wave = __builtin_amdgcn_readfirstlane(tid0 >> 6);
    const int gthreads = nb * NTHR, nwaves = gthreads >> 6;
#define PHASE_VARS() int tid = tid0; asm volatile("" : "+v"(tid)); const int lane = tid & 63, gtid = bid * NTHR + tid, gwave = gtid >> 6; (void)lane; (void)gtid; (void)gwave
    unsigned char* ws = a.ws;
    bf16* WINT = (bf16*)(ws + WS_WIN); bf16* WOT = (bf16*)(ws + WS_WO); bf16* WQT = (bf16*)(ws + WS_WQ);
    bf16* PROJ = (bf16*)(ws + WS_PROJ);
    bf16* XNB = (bf16*)(ws + WS_XNB);
    bf16* XACT = (bf16*)(ws + WS_XACT);
    float* DTRAW = (float*)(ws + WS_DTRAW); float* DT = (float*)(ws + WS_DT); float* ACS = (float*)(ws + WS_ACS); float* CDEC = (float*)(ws + WS_CDEC);
    float* STATES = (float*)(ws + WS_STATES); bf16* PREVT = (bf16*)(ws + WS_PREV);
    float* QP = (float*)(ws + WS_QP); unsigned short* IDX = (unsigned short*)(ws + WS_IDX); float* GATE = (float*)(ws + WS_GATE);
    float* TOPV = (float*)(ws + WS_TOPV); int* TOPI = (int*)(ws + WS_TOPI);
    unsigned char* U8 = ws + WS_U8; unsigned char* V8 = ws + WS_V8; float* SU = (float*)(ws + WS_SU); float* SV = SU + 16384; int* PART = (int*)(ws + WS_PART); unsigned char* XQ = ws + WS_XQ; float* XS = (float*)(ws + WS_XS);
    bf16* KH = (bf16*)(ws + WS_KH); bf16* KL = (bf16*)(ws + WS_KH + 65536);
    float* MIXF = a.out;
    volatile LAS unsigned* MISC = (volatile LAS unsigned*)(ldsb + MISC_OFF);
    if (tid0 < 32) MISC[tid0] = 0u;
    __syncthreads();
    XcdBarrier bar = xcd_barrier_post((unsigned*)ws, MISC + 8);
#define IN(k) (a.ph_lo <= (k) && (k) < a.ph_hi)
#if defined(PROBE_LO)
    int seg_ = 0; unsigned long long tseg_ = __builtin_amdgcn_s_memrealtime();
#define PROBE_SPIN() do { if (seg_ >= PROBE_LO && seg_ <= PROBE_HI) { const unsigned long long d_ = (__builtin_amdgcn_s_memrealtime() - tseg_) * PROBE_AMP; const unsigned long long s_ = __builtin_amdgcn_s_memrealtime(); \
        while (__builtin_amdgcn_s_memrealtime() - s_ < d_) __builtin_amdgcn_s_sleep(4); } } while (0)
#define GRID_BAR() do { PROBE_SPIN(); xcd_barrier(bar); tseg_ = __builtin_amdgcn_s_memrealtime(); ++seg_; } while (0)
#else
#define PROBE_SPIN() do { } while (0)
#define GRID_BAR() xcd_barrier(bar)
#endif

    if (IN(0)) {
        PHASE_VARS();
        LAS float* scr = (LAS float*)(ldsb + wave * 16384);
        constexpr int I_IN = 16 * 72, I_O = 16 * 32, NITEMS = I_IN + 2 * I_O;
        for (int it = gwave; it < NITEMS; it += nwaves) {
            int r = it;
            if (r < I_IN) { transpose_item(a.w_in, PW, D, WINT, scr, r / 72, r % 72, lane); continue; } r -= I_IN;
            if (r < I_O) { transpose_item(a.w_out, D, D, WOT, scr, r / 32, r % 32, lane); continue; } r -= I_O;
            transpose_item(a.peer_wq, D, D, WQT, scr, r / 32, r % 32, lane);
        }
        for (int i = gtid; i < 2 * 128 * 64; i += gthreads) { const float kf = a.peer_sub_keys[i]; const short h = bfs(kf); KH[i] = (bf16)h; KL[i] = (bf16)bfs(kf - sbf2f(h)); }
        for (int i = tid; i < 8 * 1024; i += NTHR) { const int h = i & 7, c = i >> 3; *(LAS float*)(ldsb + h * 16384 + 8448 + c * 4) = a.w_in[(size_t)c * PW + ODT + h]; }
        __syncthreads();
        rmsnorm_rows_bf16<1>(a.x, a.norm_mix_g, XNB, ldsb, DTRAW, nullptr, nullptr, gwave, nwaves, lane);
    }
    GRID_BAR();
    if (IN(1)) {
        PHASE_VARS();
        pg8::Gemm g{XNB, WINT, T, PS, D}; pg8::StaticOrder S; S.init(T, PS, nb, bid);
        pg8::EpiBf16Plain E{PROJ, PS};
        pg8::gemm_phase<pg8::EpiBf16Plain, pg8::StaticOrder>(ldsb, g, S, E, nullptr);
        if (bid >= 64) for (int rr = (bid - 64) * 8 + wave; rr < 2 * 16384; rr += (nb - 64) * 8) {
            const int which = rr >> 14, row = rr & 16383;
            const float4* src4 = (const float4*)((which ? a.peer_v : a.peer_u) + (size_t)row * D) + lane;
            float4 v[4]; float mx = 0.f;
#pragma unroll
            for (int jq = 0; jq < 4; ++jq) { v[jq] = src4[64 * jq]; mx = fmaxf(mx, fmaxf(fmaxf(fabsf(v[jq].x), fabsf(v[jq].y)), fmaxf(fabsf(v[jq].z), fabsf(v[jq].w)))); }
#pragma unroll
            for (int o = 1; o < 64; o <<= 1) mx = fmaxf(mx, __shfl_xor(mx, o));
            const float sc = mx > 0.f ? mx * (1.f / 127.f) : 1.f, inv = 1.f / sc;
            unsigned* dst = (unsigned*)((which ? V8 : U8) + (size_t)row * D) + lane;
#pragma unroll
            for (int jq = 0; jq < 4; ++jq) { const int q0 = (int)rintf(v[jq].x * inv), q1 = (int)rintf(v[jq].y * inv), q2 = (int)rintf(v[jq].z * inv), q3 = (int)rintf(v[jq].w * inv);
                dst[64 * jq] = (unsigned)(q0 & 255) | ((unsigned)(q1 & 255) << 8) | ((unsigned)(q2 & 255) << 16) | ((unsigned)(q3 & 255) << 24); }
            if (lane == 0) (which ? SV : SU)[row] = sc;
        }
    }
    GRID_BAR();
    if (IN(2)) {
        PHASE_VARS();
        for (int task = gtid; task < (T / 16) * 128; task += gthreads) {
            const int cg = task & 127, t0 = (task >> 7) * 16, c0 = cg * 8;
            float w[4][8], bs[8];
#pragma unroll
            for (int k = 0; k < 4; ++k) { const float4 a0 = *(const float4*)(a.conv_w + k * 1024 + c0), a1 = *(const float4*)(a.conv_w + k * 1024 + c0 + 4);
                w[k][0] = a0.x; w[k][1] = a0.y; w[k][2] = a0.z; w[k][3] = a0.w; w[k][4] = a1.x; w[k][5] = a1.y; w[k][6] = a1.z; w[k][7] = a1.w; }
            { const float4 a0 = *(const float4*)(a.conv_b + c0), a1 = *(const float4*)(a.conv_b + c0 + 4); bs[0] = a0.x; bs[1] = a0.y; bs[2] = a0.z; bs[3] = a0.w; bs[4] = a1.x; bs[5] = a1.y; bs[6] = a1.z; bs[7] = a1.w; }
            const bool has_halo = (t0 & (SEQ - 1)) != 0;
            bf16x8 rows[19];
#pragma unroll
            for (int i = 0; i < 19; ++i) {
                if (i < 3 && !has_halo) {
#pragma unroll
                    for (int e = 0; e < 8; ++e) rows[i][e] = 0;
                } else rows[i] = ldg8(PROJ + (size_t)(t0 + i - 3) * PS + OXBC + c0);
            }
#pragma unroll
            for (int i = 0; i < 16; ++i) {
                float o[8];
#pragma unroll
                for (int e = 0; e < 8; ++e) o[e] = silu_f(bs[e] + w[0][e] * sbf2f(rows[i][e]) + w[1][e] * sbf2f(rows[i + 1][e]) + w[2][e] * sbf2f(rows[i + 2][e]) + w[3][e] * sbf2f(rows[i + 3][e]));
                v4u ov; ov.x = pkbf(o[0], o[1]); ov.y = pkbf(o[2], o[3]); ov.z = pkbf(o[4], o[5]); ov.w = pkbf(o[6], o[7]);
                *(v4u*)(XACT + (size_t)(t0 + i) * 1024 + c0) = ov;
            }
        }
        if (gwave < 1024) {
            const int h = gwave & 7, bc = gwave >> 3;
            const float A = -__expf(a.a_log[h]), bias = a.dt_bias[h];
            const int t0 = bc * 128 + lane, t1 = t0 + 64;
            const float raw0 = DTRAW[t0 * 8 + h] + bias, raw1 = DTRAW[t1 * 8 + h] + bias;
            const float dt0 = fmaxf(raw0, 0.f) + log1pf(__expf(-fabsf(raw0))), dt1 = fmaxf(raw1, 0.f) + log1pf(__expf(-fabsf(raw1)));
            DT[t0 * 8 + h] = dt0; DT[t1 * 8 + h] = dt1;
            float v0 = dt0 * A, v1 = dt1 * A;
#pragma unroll
            for (int o = 1; o < 64; o <<= 1) { const float y0 = __shfl_up(v0, o), y1 = __shfl_up(v1, o); if (lane >= o) { v0 += y0; v1 += y1; } }
            v1 += __shfl(v0, 63);
            ACS[t0 * 8 + h] = v0; ACS[t1 * 8 + h] = v1;
            if (lane == 63) CDEC[gwave] = __expf(v1);
        }
    }
    GRID_BAR();
    if (IN(3)) {
        PHASE_VARS();
        for (int u = bid; u < 512; u += nb) {
            if (u < 256) attn_unit(a.attn_sinks, ldsb, u, PROJ, MIXF, tid, lane, wave);
            else ssd_chunk_unit(ldsb, u - 256, XACT, DT, ACS, MIXF, STATES, tid, lane, wave);
        }
    }
    GRID_BAR();
    if (IN(5)) {
        PHASE_VARS();
        for (int idx = gtid; idx < 2 * 8 * 8192; idx += gthreads) {
            const int pn = idx & 8191, h = (idx >> 13) & 7, b = idx >> 16;
            float run = 0.f;
#pragma unroll 1
            for (int c0 = 0; c0 < 64; c0 += 8) {
                float st[8], dc[8];
#pragma unroll
                for (int j = 0; j < 8; ++j) { const int bch = (b * 64 + c0 + j) * 8 + h; st[j] = STATES[(size_t)bch * 8192 + pn]; dc[j] = CDEC[bch]; }
#pragma unroll
                for (int j = 0; j < 8; ++j) { const int bch = (b * 64 + c0 + j) * 8 + h; PREVT[(size_t)bch * 8192 + pn] = f2bf(run); run = dc[j] * run + st[j]; }
            }
        }
    }
    GRID_BAR();
    if (IN(6)) {
        PHASE_VARS();
        for (int u = bid; u < 256; u += nb) yoff_unit(a.d_skip, u, XACT, PROJ, ACS, PREVT, MIXF, lane, wave);
    }
    GRID_BAR();
    if (IN(6)) {
        PHASE_VARS();
        for (int t = gwave; t < T; t += nwaves) {
            const float* row = MIXF + (size_t)t * D;
            const float4 a0 = *(const float4*)(row + 8 * lane), a1 = *(const float4*)(row + 8 * lane + 4);
            const float4 s0 = *(const float4*)(row + 512 + 8 * lane), s1 = *(const float4*)(row + 512 + 8 * lane + 4);
            float ssa = a0.x * a0.x + a0.y * a0.y + a0.z * a0.z + a0.w * a0.w + a1.x * a1.x + a1.y * a1.y + a1.z * a1.z + a1.w * a1.w;
            float sss = s0.x * s0.x + s0.y * s0.y + s0.z * s0.z + s0.w * s0.w + s1.x * s1.x + s1.y * s1.y + s1.z * s1.z + s1.w * s1.w;
            ssa = wave_sum(ssa);
#pragma unroll
            for (int o = 1; o < 32; o <<= 1) sss += __shfl_xor(sss, o);
            const float ra = rsqrtf(ssa * (1.f / 512.f) + EPS), rs = rsqrtf(sss * (1.f / 256.f) + EPS);
            const float4 ga0 = *(const float4*)(a.attn_out_g + 8 * lane), ga1 = *(const float4*)(a.attn_out_g + 8 * lane + 4);
            const float4 gs0 = *(const float4*)(a.ssm_norm_g + 8 * lane), gs1 = *(const float4*)(a.ssm_norm_g + 8 * lane + 4);
            v4u oa, os;
            oa.x = pkbf(a0.x * ra * ga0.x, a0.y * ra * ga0.y); oa.y = pkbf(a0.z * ra * ga0.z, a0.w * ra * ga0.w); oa.z = pkbf(a1.x * ra * ga1.x, a1.y * ra * ga1.y); oa.w = pkbf(a1.z * ra * ga1.z, a1.w * ra * ga1.w);
            os.x = pkbf(s0.x * rs * gs0.x, s0.y * rs * gs0.y); os.y = pkbf(s0.z * rs * gs0.z, s0.w * rs * gs0.w); os.z = pkbf(s1.x * rs * gs1.x, s1.y * rs * gs1.y); os.w = pkbf(s1.z * rs * gs1.z, s1.w * rs * gs1.w);
            *(v4u*)(XNB + (size_t)t * D + 8 * lane) = oa; *(v4u*)(XNB + (size_t)t * D + 512 + 8 * lane) = os;
        }
    }
    GRID_BAR();
    if (IN(7)) {
        PHASE_VARS();
        pg8::Gemm g{XNB, WOT, T, D, D}; pg8::StaticOrder S; S.init(T, D, nb, bid);
        pg8::EpiF32Resid E{a.out, a.x, D};
        pg8::gemm_phase<pg8::EpiF32Resid, pg8::StaticOrder>(ldsb, g, S, E, nullptr);
    }
    GRID_BAR();
    if (IN(8)) {
        PHASE_VARS();
        rmsnorm_rows_bf16<2>(a.out, a.norm_ffn_g, XNB, ldsb, nullptr, XQ, XS, gwave, nwaves, lane);
    }
    GRID_BAR();
    if (IN(9)) {
        PHASE_VARS();
        pg8::Gemm g{XNB, WQT, T, D, D}; pg8::StaticOrder S; S.init(T, D, nb, bid);
        pg8::EpiF32Resid E{QP, nullptr, D};
        pg8::gemm_phase<pg8::EpiF32Resid, pg8::StaticOrder>(ldsb, g, S, E, nullptr);
    }
    GRID_BAR();
    if (IN(10)) {
        PHASE_VARS();
        for (int task = gwave; task < T / 4; task += nwaves) route_task(task, QP, KH, KL, IDX, GATE, lane);
    }
    GRID_BAR();
    unsigned char* ACTQ = ws + WS_ACT; float* ACTS = (float*)(ws + WS_ACT + 4 * MiB); float* PEERO = (float*)(ws + WS_PEERO);
    unsigned* ctl = (unsigned*)ws;
    const int xcc = (int)(bar.x & 7u);
    if (IN(12)) {
        PHASE_VARS();
#pragma unroll 1
        for (int pi = 0; pi < NPART; ++pi) {
            const int p = (xcc + pi) & 7;
            for (;;) {
                if (tid == 0) MISC[16] = xb_add(&ctl[CW_QU + 64 * p], 1u);
                __syncthreads();
                const int j = (int)MISC[16];
                __syncthreads();
                if (j >= NCHUNK) break;
                peer_u_item(p, j, IDX, XQ, U8, PART, lane, wave);
            }
        }
    }
    GRID_BAR();
    if (IN(12)) {
        PHASE_VARS();
        for (int t = gwave; t < T; t += nwaves) {
            float av[2];
#pragma unroll
            for (int hh = 0; hh < 2; ++hh) {
                const int i = t * 128 + hh * 64 + lane;
                int si = 0;
#pragma unroll
                for (int pp = 0; pp < NPART; ++pp) si += PART[(size_t)pp * T * 128 + i];
                const int e = IDX[i]; const float z = (float)si * SU[e] * XS[t];
                av[hh] = GATE[i] * 0.5f * z * (1.f + erff(z * 0.70710678118654752f)) * SV[e];
            }
            float mx = fmaxf(fabsf(av[0]), fabsf(av[1]));
#pragma unroll
            for (int o = 1; o < 64; o <<= 1) mx = fmaxf(mx, __shfl_xor(mx, o));
            const float sc = mx > 0.f ? mx * (1.f / 127.f) : 1.f, inv = 1.f / sc;
            ACTQ[(size_t)t * 128 + lane] = (unsigned char)((int)rintf(av[0] * inv) & 255); ACTQ[(size_t)t * 128 + 64 + lane] = (unsigned char)((int)rintf(av[1] * inv) & 255);
            if (lane == 0) ACTS[t] = sc;
        }
    }
    GRID_BAR();
    if (IN(13)) {
        PHASE_VARS();
#pragma unroll 1
        for (int pi = 0; pi < NPART; ++pi) {
            const int p = (xcc + pi) & 7;
            for (;;) {
                if (tid == 0) MISC[16] = xb_add(&ctl[CW_QV + 64 * p], 1u);
                __syncthreads();
                const int j = (int)MISC[16];
                __syncthreads();
                if (j >= NCHUNK) break;
                peer_v_item(p, j, IDX, ACTQ, ACTS, V8, PEERO, lane, wave);
            }
        }
    }
    GRID_BAR();
    if (IN(14)) {
        PHASE_VARS();
        for (int t = gwave; t < T; t += nwaves) {
            const float4* hr = (const float4*)(a.out + (size_t)t * D) + lane; const float4* pr = (const float4*)(PEERO + (size_t)t * D) + lane;
            float4 v[4]; float ss = 0.f;
#pragma unroll
            for (int jq = 0; jq < 4; ++jq) { const float4 h4 = hr[64 * jq], p4 = pr[64 * jq]; v[jq] = make_float4(h4.x + p4.x, h4.y + p4.y, h4.z + p4.z, h4.w + p4.w); ss += v[jq].x * v[jq].x + v[jq].y * v[jq].y + v[jq].z * v[jq].z + v[jq].w * v[jq].w; }
            ss = wave_sum(ss);
            const float r3 = rsqrtf(ss * (1.f / D) + EPS);
            float4* op = (float4*)(a.out + (size_t)t * D) + lane;
#pragma unroll
            for (int jq = 0; jq < 4; ++jq) { const float4 gv = ((const float4*)a.final_norm_g)[lane + 64 * jq]; op[64 * jq] = make_float4(v[jq].x * r3 * gv.x, v[jq].y * r3 * gv.y, v[jq].z * r3 * gv.z, v[jq].w * r3 * gv.w); }
        }
    }
    PROBE_SPIN();
#undef IN
}
}

extern "C" void kernel_launch(void* const* d_in, const int* in_sizes, int n_in, void* d_out, int out_size, void* d_ws, size_t ws_size, hipStream_t stream) {
    if (n_in != 18 || out_size != T * D || ws_size < WS_END) { fprintf(stderr, "kernel_launch: unexpected shapes n_in=%d out=%d ws=%zu\n", n_in, out_size, ws_size); return; }
    Args a{};
    const float** ap = (const float**)&a;
    for (int i = 0; i < 18; ++i) ap[i] = (const float*)d_in[i];
    a.out = (float*)d_out; a.ws = (unsigned char*)d_ws;
    static int grid = 0;
    if (grid == 0) {
        int dev = 0, cus = 0, per_cu = 0;
        if (hipGetDevice(&dev) != hipSuccess || hipDeviceGetAttribute(&cus, hipDeviceAttributeMultiprocessorCount, dev) != hipSuccess) { fprintf(stderr, "kernel_launch: device query failed\n"); grid = -1; return; }
        if (hipFuncSetAttribute((const void*)k_main, hipFuncAttributeMaxDynamicSharedMemorySize, LDS_BYTES) != hipSuccess) { fprintf(stderr, "kernel_launch: hipFuncSetAttribute failed\n"); grid = -1; return; }
        if (hipOccupancyMaxActiveBlocksPerMultiprocessor(&per_cu, (const void*)k_main, NTHR, LDS_BYTES) != hipSuccess || per_cu < 1) { fprintf(stderr, "kernel_launch: occupancy query says %d blocks/CU\n", per_cu); (void)hipGetLastError(); grid = -1; return; }
        grid = cus;
    }
    if (grid < 0) return;
    if (hipMemsetAsync(d_ws, 0, 65536, stream) != hipSuccess) { fprintf(stderr, "kernel_launch: memset failed\n"); return; }
    a.ph_lo = 0; a.ph_hi = 15;
    hipLaunchKernelGGL(k_main, dim3(grid), dim3(NTHR), LDS_BYTES, stream, a);
}
```

```cpp
#include <hip/hip_runtime.h>
#include <cstdio>
#include <cstdint>

namespace pg8 {
#define PG8_LAS __attribute__((address_space(3)))
typedef unsigned short bf16_t;
typedef short bf16x8 __attribute__((ext_vector_type(8)));
typedef float f32x4 __attribute__((ext_vector_type(4)));
typedef unsigned u32x4 __attribute__((ext_vector_type(4)));
constexpr int BM = 256, BK = 64, HALF = 128, HTB = HALF * BK * 2  , STAGE_BYTES = 8 * HTB, NXCD = 8, WGM = 8;

__host__ __device__ __forceinline__ int lds_byte(int r, int c) { const int st = (r >> 4) * 2 + (c >> 5), rr = r & 15, cc = c & 31, ob = rr * 64 + cc * 2; return st * 1024 + (ob ^ (((ob >> 9) & 1) << 5)); }
__host__ __device__ __forceinline__ void stage_rc(int b, int& R, int& C) { const int st = b / 1024, sb = b % 1024, swz = sb ^ (((sb >> 9) & 1) << 5); R = (st >> 1) * 16 + swz / 64; C = (st & 1) * 32 + (swz % 64) / 2; }
__host__ __device__ __forceinline__ int perm32(int rho) { const int n = rho >> 4, i = rho & 15; return 8 * (i >> 2) + 4 * n + (i & 3); }

struct Unit { int pm, pn; };
struct Gemm { const bf16_t* A; const bf16_t* Bt; int M, N, K; };

struct StaticOrder {
    int nM, nN, nwg, G, c;
    __host__ __device__ void init(int M, int N, int G_, int c_) { nM = M / BM; nN = N / BM; nwg = nM * nN; G = G_; c = c_; }
    __host__ __device__ bool next(int i, Unit& u) const {
        const long L = (long)i * G + c; if (L >= nwg) return false;
        int wgid = (int)L; { const int q = nwg / NXCD, r = nwg % NXCD, xcd = wgid % NXCD, off = wgid / NXCD; wgid = (xcd < r ? xcd * (q + 1) : r * (q + 1) + (xcd - r) * q) + off; }
        const int nig = WGM * nN, gid = wgid / nig, fm = gid * WGM, gsz = (nM - fm) < WGM ? (nM - fm) : WGM;
        u.pm = fm + ((wgid % nig) % gsz); u.pn = (wgid % nig) / gsz; return true;
    }
    __device__ __forceinline__ void a_ready(const Unit&) const {}
    __device__ __forceinline__ void done(const Unit&) const {}
};
__device__ __forceinline__ unsigned cvt_pk_bf16(float lo, float hi) { unsigned r; asm volatile("v_cvt_pk_bf16_f32 %0, %1, %2" : "=v"(r) : "v"(lo), "v"(hi)); return r; }
typedef float f32x2 __attribute__((ext_vector_type(2)));
struct EpiBf16Plain {
    static constexpr bool PERM = true, AFTER_DRAIN = false;
    bf16_t* O; int ldc;
    __device__ __forceinline__ void operator()(const f32x4 (&acc)[2][2][4][2], const Unit& u, int wr, int wc, int fr, int fq) const {
        const int row0 = u.pm * BM + wr * 64 + fr, col0 = u.pn * BM + wc * 32 + 8 * fq;
#pragma unroll
        for (int ai = 0; ai < 2; ++ai)
#pragma unroll
            for (int m = 0; m < 4; ++m) { bf16_t* rowp = O + (size_t)(row0 + ai * HALF + m * 16) * ldc + col0;
#pragma unroll
                for (int bj = 0; bj < 2; ++bj) { const f32x4 v0 = acc[ai][bj][m][0], v1 = acc[ai][bj][m][1];
                    u32x4 w; w.x = cvt_pk_bf16(v0[0], v0[1]); w.y = cvt_pk_bf16(v0[2], v0[3]); w.z = cvt_pk_bf16(v1[0], v1[1]); w.w = cvt_pk_bf16(v1[2], v1[3]);
                    *(u32x4*)(rowp + bj * HALF) = w; } }
    }
};
struct EpiF32Resid {
    static constexpr bool PERM = false, AFTER_DRAIN = false;
    float* C; const float* R; int ldc;
    __device__ __forceinline__ void operator()(const f32x4 (&acc)[2][2][4][2], const Unit& u, int wr, int wc, int fr, int fq) const {
        const int row0 = u.pm * BM + wr * 64 + fr, col0 = u.pn * BM + wc * 32 + 4 * fq;
#pragma unroll
        for (int ai = 0; ai < 2; ++ai)
#pragma unroll
            for (int m = 0; m < 4; ++m) { const size_t off = (size_t)(row0 + ai * HALF + m * 16) * ldc + col0;
#pragma unroll
                for (int bj = 0; bj < 2; ++bj)
#pragma unroll
                    for (int n = 0; n < 2; ++n) { f32x4 v = acc[ai][bj][m][n]; if (R) v += *(const f32x4*)(R + off + bj * HALF + n * 16); *(f32x4*)(C + off + bj * HALF + n * 16) = v; }
                asm volatile("" ::: "memory"); }
    }
};
template <class Epi, class Sched, bool STAMP = false>
__device__ __forceinline__ void gemm_phase(PG8_LAS unsigned char* lds, const Gemm g, const Sched& S, const Epi& E, unsigned long long* stamps) {
    const int tid = threadIdx.x, wid = __builtin_amdgcn_readfirstlane(tid >> 6), lane = tid & 63, wr = wid >> 2, wc = wid & 3, fr = lane & 15, fq = lane >> 4;
    const int K = g.K, nt = K / BK;
    int ts_lo = 0, ts_hi = 0, nts = 0; const unsigned long long rt_entry = STAMP ? (unsigned long long)0ull : 0ull;
#define PG8_STAMP() do { if (STAMP && wid == 0 && nts < 64) { const unsigned long long _c = (unsigned long long)clock64(); \
        ts_lo = (lane == nts) ? (int)(unsigned)_c : ts_lo; ts_hi = (lane == nts) ? (int)(unsigned)(_c >> 32) : ts_hi; ++nts; } } while (0)
    PG8_STAMP();
    unsigned voffA[2], voffB[2];
#pragma unroll
    for (int i = 0; i < 2; ++i) { int R, C; stage_rc(tid * 16 + i * 8192, R, C); const int Rb = Epi::PERM ? ((R & ~31) + perm32(R & 31)) : R;
        voffA[i] = (unsigned)(R * K + C) * 2u; voffB[i] = (unsigned)(Rb * K + C) * 2u; }
    const size_t kstep = (size_t)(BK * 2);
    const size_t hstep = (size_t)HALF * K * 2;
    const size_t tstep = 2 * hstep;
    const unsigned ldsw = (unsigned)wid * 1024u;
    const int aoff = lds_byte(wr * 64 + fr, fq * 8), boff = lds_byte(wc * 32 + fr, fq * 8);
#define PG8_SA(b, h) (((b) * 2 + (h)) * HTB)
#define PG8_SB(b, h) ((4 + (b) * 2 + (h)) * HTB)
#define PG8_STAGE(bufoff, gbase, voff) do { _Pragma("unroll") for (int _i = 0; _i < 2; ++_i) \
        __builtin_amdgcn_global_load_lds((const unsigned*)((const char*)(gbase) + (voff)[_i]), (PG8_LAS unsigned*)(lds + (bufoff) + ldsw + _i * 8192), 16, 0, 0); } while (0)
#define PG8_LDA(dst, b, h) do { _Pragma("unroll") for (int m = 0; m < 4; ++m) _Pragma("unroll") for (int k = 0; k < 2; ++k) dst[m][k] = *(const PG8_LAS bf16x8*)(lds + PG8_SA(b, h) + aoff + m * 2048 + k * 1024); } while (0)
#define PG8_LDB(dst, b, h) do { _Pragma("unroll") for (int n = 0; n < 2; ++n) _Pragma("unroll") for (int k = 0; k < 2; ++k) dst[n][k] = *(const PG8_LAS bf16x8*)(lds + PG8_SB(b, h) + boff + n * 2048 + k * 1024); } while (0)
#define PG8_MMA(ai, bj, At, Bt) do { __builtin_amdgcn_s_setprio(1); _Pragma("unroll") for (int m = 0; m < 4; ++m) _Pragma("unroll") for (int n = 0; n < 2; ++n) _Pragma("unroll") for (int k = 0; k < 2; ++k) \
        acc[ai][bj][m][n] = __builtin_amdgcn_mfma_f32_16x16x32_bf16(Bt[n][k], At[m][k], acc[ai][bj][m][n], 0, 0, 0); __builtin_amdgcn_s_setprio(0); } while (0)
#define PG8_WAIT_V(n) asm volatile("s_waitcnt vmcnt(" #n ")" ::: "memory")
#define PG8_WAIT_L(n) asm volatile("s_waitcnt lgkmcnt(" #n ")" ::: "memory")
#define PG8_BAR __builtin_amdgcn_s_barrier()
#define PG8_SCHED __builtin_amdgcn_sched_barrier(0)
    Unit cur, nxt; int ui = 0;
    if (!S.next(0, cur)) return;
    f32x4 acc[2][2][4][2];
#pragma unroll
    for (int a = 0; a < 2; ++a)
#pragma unroll
        for (int b = 0; b < 2; ++b)
#pragma unroll
            for (int m = 0; m < 4; ++m)
#pragma unroll
                for (int n = 0; n < 2; ++n) acc[a][b][m][n] = (f32x4){0.f, 0.f, 0.f, 0.f};
    bf16x8 At[4][2], B0[2][2], B1[2][2];
    const char* cA = (const char*)g.A + (size_t)cur.pm * tstep; const char* cB = (const char*)g.Bt + (size_t)cur.pn * tstep;
    S.a_ready(cur);
    PG8_STAGE(PG8_SB(0, 0), cB, voffB); PG8_STAGE(PG8_SA(0, 0), cA, voffA); PG8_STAGE(PG8_SB(0, 1), cB + hstep, voffB); PG8_STAGE(PG8_SA(0, 1), cA + hstep, voffA);
    if (wr == 1) PG8_BAR;
    PG8_WAIT_V(4); PG8_BAR;
    PG8_STAGE(PG8_SB(1, 0), cB + kstep, voffB); PG8_STAGE(PG8_SA(1, 0), cA + kstep, voffA); PG8_STAGE(PG8_SB(1, 1), cB + hstep + kstep, voffB);
    PG8_WAIT_V(6); PG8_BAR;
    PG8_STAMP();
    for (;;) {
        const bool has_next = S.next(ui + 1, nxt);
        const char* nA = has_next ? (const char*)g.A + (size_t)nxt.pm * tstep : cA; const char* nB = has_next ? (const char*)g.Bt + (size_t)nxt.pn * tstep : cB;
        for (int t = 0; t < nt; t += 2) {
            const bool last = (t == nt - 2);
            const char* a1 = cA + (size_t)(t + 1) * kstep;
            const char* a2 = last ? nA : cA + (size_t)(t + 2) * kstep; const char* b2 = last ? nB : cB + (size_t)(t + 2) * kstep;
            const char* a3 = a2 + kstep; const char* b3 = b2 + kstep;
            if (last && has_next) S.a_ready(nxt);
            PG8_LDB(B0, 0, 0); PG8_SCHED; PG8_LDA(At, 0, 0); PG8_STAGE(PG8_SA(1, 1), a1 + hstep, voffA);
            PG8_WAIT_L(8); PG8_BAR; PG8_WAIT_L(0); PG8_MMA(0, 0, At, B0); PG8_BAR; PG8_SCHED;
            PG8_LDB(B1, 0, 1); PG8_STAGE(PG8_SB(0, 0), b2, voffB);
            PG8_BAR; PG8_WAIT_L(0); PG8_MMA(0, 1, At, B1); PG8_BAR;
            PG8_LDA(At, 0, 1); PG8_STAGE(PG8_SA(0, 0), a2, voffA);
            PG8_BAR; PG8_WAIT_L(0); PG8_MMA(1, 0, At, B0); PG8_BAR; PG8_SCHED;
            PG8_STAGE(PG8_SB(0, 1), b2 + hstep, voffB);
            PG8_WAIT_V(6); PG8_BAR; PG8_MMA(1, 1, At, B1); PG8_BAR;
            PG8_LDB(B0, 1, 0); PG8_SCHED; PG8_LDA(At, 1, 0); PG8_STAGE(PG8_SA(0, 1), a2 + hstep, voffA);
            PG8_WAIT_L(8); PG8_BAR; PG8_WAIT_L(0); PG8_MMA(0, 0, At, B0); PG8_BAR; PG8_SCHED;
            PG8_LDB(B1, 1, 1); PG8_STAGE(PG8_SB(1, 0), b3, voffB);
            PG8_BAR; PG8_WAIT_L(0); PG8_MMA(0, 1, At, B1); PG8_BAR;
            PG8_LDA(At, 1, 1); PG8_STAGE(PG8_SA(1, 0), a3, voffA);
            PG8_BAR; PG8_WAIT_L(0); PG8_MMA(1, 0, At, B0); PG8_BAR; PG8_SCHED;
            PG8_STAGE(PG8_SB(1, 1), b3 + hstep, voffB);
            PG8_WAIT_V(6); PG8_BAR; PG8_MMA(1, 1, At, B1); PG8_BAR;
        }
        PG8_STAMP();
        if constexpr (!Epi::AFTER_DRAIN) { E(acc, cur, wr, wc, fr, fq); S.done(cur); }
        PG8_STAMP();
        if (!has_next) break;
#pragma unroll
        for (int a = 0; a < 2; ++a)
#pragma unroll
            for (int b = 0; b < 2; ++b)
#pragma unroll
                for (int m = 0; m < 4; ++m)
#pragma unroll
                    for (int n = 0; n < 2; ++n) acc[a][b][m][n] = (f32x4){0.f, 0.f, 0.f, 0.f};
        cur = nxt; cA = nA; cB = nB; ++ui;
    }
    PG8_WAIT_V(0);
    if (wr == 0) PG8_BAR;
    PG8_BAR;
    if constexpr (Epi::AFTER_DRAIN) { E.fused(acc, cur, wr, wc, fr, fq, lds, wid, lane); S.done(cur); }
    PG8_STAMP();
    if (STAMP && wid == 0) { stamps[lane] = lane < nts ? (((unsigned long long)(unsigned)ts_hi << 32) | (unsigned)ts_lo) : 0ull;
        if (lane == 62) stamps[62] = rt_entry; if (lane == 63) stamps[63] = (unsigned long long)0ull; }
#undef PG8_STAMP
#undef PG8_SA
#undef PG8_SB
#undef PG8_STAGE
#undef PG8_LDA
#undef PG8_LDB
#undef PG8_MMA
#undef PG8_WAIT_V
#undef PG8_WAIT_L
#undef PG8_BAR
#undef PG8_SCHED
}
}

namespace {
constexpr int D = 1024, BATCH = 2, SEQ = 8192, T = BATCH * SEQ;
constexpr int PW = 2312;
constexpr int PS = 2304;
constexpr int OQ = 0, OKK = 512, OV = 640, OZ = 768, OXBC = 1280, ODT = 2304;
constexpr float EPS = 1e-6f;
constexpr int NTHR = 512;
typedef unsigned short bf16;
typedef unsigned v4u __attribute__((ext_vector_type(4)));

constexpr size_t MiB = 1u << 20;
constexpr size_t WS_WIN = 1 * MiB;
constexpr size_t WS_KH = 5 * MiB + 512 * 1024;
constexpr size_t WS_WO = 6 * MiB;
constexpr size_t WS_WQ = 8 * MiB;
constexpr size_t WS_PROJ = 10 * MiB;
constexpr size_t WS_XNB = 82 * MiB;
constexpr size_t WS_XACT = 114 * MiB;
constexpr size_t WS_DTRAW = 146 * MiB;
constexpr size_t WS_DT = WS_DTRAW + 512 * 1024;
constexpr size_t WS_ACS = WS_DT + 512 * 1024;
constexpr size_t WS_CDEC = WS_ACS + 512 * 1024;
constexpr size_t WS_STATES = 164 * MiB;
constexpr size_t WS_PREV = 196 * MiB;
constexpr size_t WS_QP = 10 * MiB;
constexpr size_t WS_IDX = 74 * MiB;
constexpr size_t WS_GATE = 114 * MiB;
constexpr size_t WS_TOPV = 122 * MiB;
constexpr size_t WS_TOPI = 138 * MiB;
constexpr size_t WS_ACT = 122 * MiB;
constexpr size_t WS_SU = 245 * MiB;
constexpr size_t WS_U8 = 212 * MiB;
constexpr size_t WS_V8 = 148 * MiB;
constexpr size_t WS_PART = 10 * MiB;
constexpr size_t WS_XQ = 228 * MiB;
constexpr size_t WS_XS = 244 * MiB;
constexpr size_t WS_PEERO = 10 * MiB;
constexpr size_t WS_END = 246 * MiB;
constexpr int CW_QU = 4096, CW_QV = 4096 + 64 * 16;
constexpr int NPART = 8, NCHUNK = T / 64;

struct Args {
    const float* x; const float* norm_mix_g; const float* w_in; const float* attn_sinks; const float* attn_out_g;
    const float* conv_w; const float* conv_b; const float* dt_bias; const float* a_log; const float* d_skip;
    const float* ssm_norm_g; const float* w_out; const float* norm_ffn_g; const float* peer_wq; const float* peer_sub_keys;
    const float* peer_u; const float* peer_v; const float* final_norm_g;
    float* out; unsigned char* ws;
    int ph_lo, ph_hi;
};

#define LAS __attribute__((address_space(3)))
#define LDS_WAIT() asm volatile("s_waitcnt lgkmcnt(0)" ::: "memory")
__device__ __forceinline__ float bf2f(bf16 v) { return __uint_as_float(((unsigned)v) << 16); }
__device__ __forceinline__ unsigned f2bfu(float f) { unsigned u = __float_as_uint(f); return (u + 0x7fffu + ((u >> 16) & 1u)) >> 16; }
__device__ __forceinline__ bf16 f2bf(float f) { return (bf16)f2bfu(f); }
__device__ __forceinline__ unsigned pk2(float lo, float hi) { return f2bfu(lo) | (f2bfu(hi) << 16); }
__device__ __forceinline__ float wave_sum(float v) {
#pragma unroll
    for (int o = 1; o < 64; o <<= 1) v += __shfl_xor(v, o);
    return v;
}
__device__ __forceinline__ float silu_f(float v) { return v / (1.f + __expf(-v)); }

__device__ __forceinline__ void transpose_item(const float* W, int ldw, int K, bf16* WT, LAS float* scr, int kb, int nbk, int lane) {
    const int k0 = 64 * kb, n0 = 32 * nbk;
#pragma unroll 8
    for (int i = 0; i < 32; ++i) { const int kk = 2 * i + (lane >> 5); scr[kk * 33 + (lane & 31)] = W[(size_t)(k0 + kk) * ldw + n0 + (lane & 31)]; }
    LDS_WAIT();
    const int c = lane & 7;
#pragma unroll
    for (int j = 0; j < 4; ++j) { const int n = (lane >> 3) + 8 * j; const LAS float* s = scr + (8 * c) * 33 + n;
        v4u o; o.x = pk2(s[0 * 33], s[1 * 33]); o.y = pk2(s[2 * 33], s[3 * 33]); o.z = pk2(s[4 * 33], s[5 * 33]); o.w = pk2(s[6 * 33], s[7 * 33]);
        *(v4u*)(WT + (size_t)(n0 + n) * K + k0 + 8 * c) = o; }
    LDS_WAIT();
}

template <int MODE  >
__device__ __forceinline__ void rmsnorm_rows_bf16(const float* in, const float* g, bf16* outp, const LAS unsigned char* ldsb, float* dtraw, unsigned char* xq, float* xs, int gwave, int nwaves, int lane) {
    for (int row = gwave; row < T; row += nwaves) {
        const float4* xr = (const float4*)(in + (size_t)row * D) + lane;
        float4 v[4]; float ss = 0.f;
#pragma unroll
        for (int j = 0; j < 4; ++j) { v[j] = xr[64 * j]; ss += v[j].x * v[j].x + v[j].y * v[j].y + v[j].z * v[j].z + v[j].w * v[j].w; }
        ss = wave_sum(ss);
        const float r = rsqrtf(ss * (1.f / D) + EPS);
        unsigned long long* o8 = (unsigned long long*)(outp + (size_t)row * D) + lane;
        float dacc[8]; float y[4][4]; float mx = 0.f;
#pragma unroll
        for (int h = 0; h < 8; ++h) dacc[h] = 0.f;
#pragma unroll
        for (int j = 0; j < 4; ++j) {
            const float4 gv = ((const float4*)g)[lane + 64 * j];
            y[j][0] = v[j].x * r * gv.x; y[j][1] = v[j].y * r * gv.y; y[j][2] = v[j].z * r * gv.z; y[j][3] = v[j].w * r * gv.w;
            o8[64 * j] = (unsigned long long)pk2(y[j][0], y[j][1]) | ((unsigned long long)pk2(y[j][2], y[j][3]) << 32);
            if (MODE == 2) mx = fmaxf(mx, fmaxf(fmaxf(fabsf(y[j][0]), fabsf(y[j][1])), fmaxf(fabsf(y[j][2]), fabsf(y[j][3]))));
            if (MODE == 1) {
#pragma unroll
                for (int h = 0; h < 8; ++h) {
                    typedef float f4v __attribute__((ext_vector_type(4)));
                    const f4v wv = *(const LAS f4v*)(ldsb + h * 16384 + 8448 + (256 * j + 4 * lane) * 4);
                    dacc[h] += y[j][0] * wv.x + y[j][1] * wv.y + y[j][2] * wv.z + y[j][3] * wv.w;
                }
            }
        }
        if (MODE == 1) {
#pragma unroll
            for (int h = 0; h < 8; ++h) dacc[h] = wave_sum(dacc[h]);
            if (lane == 0) { float4* dp = (float4*)(dtraw + (size_t)row * 8); dp[0] = make_float4(dacc[0], dacc[1], dacc[2], dacc[3]); dp[1] = make_float4(dacc[4], dacc[5], dacc[6], dacc[7]); }
        }
        if (MODE == 2) {
#pragma unroll
            for (int o = 1; o < 64; o <<= 1) mx = fmaxf(mx, __shfl_xor(mx, o));
            const float sc = mx > 0.f ? mx * (1.f / 127.f) : 1.f, inv = 1.f / sc;
            unsigned* dq = (unsigned*)(xq + (size_t)row * D) + lane;
#pragma unroll
            for (int j = 0; j < 4; ++j) { const int q0 = (int)rintf(y[j][0] * inv), q1 = (int)rintf(y[j][1] * inv), q2 = (int)rintf(y[j][2] * inv), q3 = (int)rintf(y[j][3] * inv);
                dq[64 * j] = (unsigned)(q0 & 255) | ((unsigned)(q1 & 255) << 8) | ((unsigned)(q2 & 255) << 16) | ((unsigned)(q3 & 255) << 24); }
            if (lane == 0) xs[row] = sc;
        }
    }
}

typedef short bf16x8 __attribute__((ext_vector_type(8)));
typedef short bf16x4 __attribute__((ext_vector_type(4)));
typedef float f32x16 __attribute__((ext_vector_type(16)));
typedef __bf16 bf2_t __attribute__((ext_vector_type(2)));
#define MFMA32(a, b, c) __builtin_amdgcn_mfma_f32_32x32x16_bf16((a), (b), (c), 0, 0, 0)
__device__ __forceinline__ unsigned pkbf(float lo, float hi) { bf2_t v = {(__bf16)lo, (__bf16)hi}; return __builtin_bit_cast(unsigned, v); }
__device__ __forceinline__ short bfs(float f) { return __builtin_bit_cast(short, (__bf16)f); }
__device__ __forceinline__ float sbf2f(short v) { return __uint_as_float(((unsigned)(unsigned short)v) << 16); }
__device__ __forceinline__ int crow(int i, int hi) { return (i & 3) + 8 * (i >> 2) + 4 * hi; }
template <int S> __device__ __forceinline__ bf16x8 pack8(const f32x16& x) {
    v4u p; p.x = pkbf(x[8 * S], x[8 * S + 1]); p.y = pkbf(x[8 * S + 2], x[8 * S + 3]); p.z = pkbf(x[8 * S + 4], x[8 * S + 5]); p.w = pkbf(x[8 * S + 6], x[8 * S + 7]);
    return __builtin_bit_cast(bf16x8, p);
}
__device__ __forceinline__ bf16x8 ldg8(const bf16* p) { return *(const bf16x8*)p; }
__device__ __forceinline__ bf16x8 lds8(const LAS bf16* p) { return *(const LAS bf16x8*)p; }
__device__ __forceinline__ bf16x8 lds4x2(const LAS bf16* p) { const bf16x4 a = *(const LAS bf16x4*)p, b = *(const LAS bf16x4*)(p + 8); return __builtin_shufflevector(a, b, 0, 1, 2, 3, 4, 5, 6, 7); }
__device__ __forceinline__ f32x16 zero16() { f32x16 z;
#pragma unroll
    for (int i = 0; i < 16; ++i) z[i] = 0.f;
    return z; }

__device__ __forceinline__ void attn_unit(const float* sinks, const float* gnorm, LAS unsigned char* ldsb, int unit, const bf16* PROJ, bf16* MIXB, int tid, int lane, int wave) {
    asm volatile("" : "+v"(tid), "+v"(lane));
    const int tok0 = unit * 64, s0 = tok0 & (SEQ - 1), kbase = tok0 - 128;
    LAS bf16* VT = (LAS bf16*)ldsb;
    const __amdgpu_buffer_rsrc_t rsP = __builtin_amdgcn_make_buffer_rsrc((void*)PROJ, 0, (unsigned)T * PS * 2u, 0x00020000);
    LAS float* SSQ = (LAS float*)(ldsb + 51200);
    LAS unsigned* OST = (LAS unsigned*)(ldsb + 53248) + wave * (2 * 17 * 64);
#pragma unroll
    for (int i = 0; i < 6; ++i) {
        const int c = tid + 512 * i, kv = c / 1536, cc = c - kv * 1536, key = cc >> 3, d0 = (cc & 7) * 8; const bool valid = (s0 - 128 + key) >= 0;
        bf16x8 v;
#pragma unroll
        for (int e = 0; e < 8; ++e) v[e] = 0;
        if (valid) v = __builtin_bit_cast(bf16x8, __builtin_amdgcn_raw_buffer_load_b128(rsP, (int)(((unsigned)(kbase + key) * (unsigned)PS + (unsigned)(OV + kv * 64 + d0)) * 2u), 0, 0));
#pragma unroll
        for (int e = 0; e < 8; ++e) VT[kv * 12800 + (d0 + e) * 200 + key] = (bf16)v[e];
    }
    __syncthreads();
    const int r = lane & 31, hi = lane >> 5;
    const int hq = wave, hkv = wave >> 2;
    const float slope = exp2f(-(float)(hq + 1)), sink = sinks[hq];
#pragma unroll 1
    for (int qt = 0; qt < 2; ++qt) {
        const int tq = tok0 + 32 * qt + r;
        bf16x8 qf[4];
        { const bf16* qp = PROJ + (size_t)tq * PS + OQ + hq * 64 + 8 * hi; asm volatile("" : "+v"(qp));
#pragma unroll
          for (int ks = 0; ks < 4; ++ks) qf[ks] = ldg8(qp + 16 * ks); }
        const int ql = 32 * qt + r;
        float m = sink, lh = 0.f;
        f32x16 O0 = zero16(), O1 = zero16();
#pragma unroll 1
        for (int kt = 0; kt < 5; ++kt) {
            const int key = 32 * (qt + kt) + r; const bool kvalid = (s0 - 128 + key) >= 0;
            const bf16* kp = PROJ + (size_t)(kvalid ? (kbase + key) : tok0) * PS + OKK + hkv * 64 + 8 * hi; asm volatile("" : "+v"(kp));
            f32x16 X = zero16();
#pragma unroll
            for (int ks = 0; ks < 4; ++ks) { const bf16x8 kf = ldg8(kp + 16 * ks); X = MFMA32(kf, qf[ks], X); }
            float tm = -1e30f;
#pragma unroll
            for (int i = 0; i < 16; ++i) {
                const int kl = 32 * (qt + kt) + crow(i, hi), dist = 128 + ql - kl;
                const bool valid = (dist >= 0) && (dist < 128) && ((s0 - 128 + kl) >= 0);
                const float lg = valid ? (X[i] * 0.125f - slope * (float)dist) : -1e30f;
                X[i] = lg; tm = fmaxf(tm, lg);
            }
            tm = fmaxf(tm, __shfl_xor(tm, 32));
            const float mn = fmaxf(m, tm), sc = __expf(m - mn);
            m = mn; lh *= sc;
#pragma unroll
            for (int i = 0; i < 16; ++i) { O0[i] *= sc; O1[i] *= sc; const float pe = __expf(X[i] - mn); X[i] = pe; lh += pe; }
            const LAS bf16* vp = VT + hkv * 12800 + r * 200 + 32 * (qt + kt) + 4 * hi;
            { const bf16x8 xs = pack8<0>(X); const bf16x8 a0 = lds4x2(vp), a1 = lds4x2(vp + 32 * 200); O0 = MFMA32(a0, xs, O0); O1 = MFMA32(a1, xs, O1); }
            { const bf16x8 xs = pack8<1>(X); const bf16x8 a0 = lds4x2(vp + 16), a1 = lds4x2(vp + 32 * 200 + 16); O0 = MFMA32(a0, xs, O0); O1 = MFMA32(a1, xs, O1); }
        }
        const float lsum = lh + __shfl_xor(lh, 32) + __expf(sink - m);
        const float iv = 1.f / lsum;
        float sq = 0.f;
#pragma unroll
        for (int i = 0; i < 16; ++i) sq += O0[i] * O0[i] + O1[i] * O1[i];
        sq *= iv * iv; sq += __shfl_xor(sq, 32);
        if (hi == 0) SSQ[hq * 64 + 32 * qt + r] = sq;
#pragma unroll
        for (int i = 0; i < 8; ++i) { OST[(qt * 17 + i) * 64 + lane] = pkbf(O0[2 * i], O0[2 * i + 1]); OST[(qt * 17 + 8 + i) * 64 + lane] = pkbf(O1[2 * i], O1[2 * i + 1]); }
        OST[(qt * 17 + 16) * 64 + lane] = __float_as_uint(iv);
    }
    __syncthreads();
#pragma unroll 1
    for (int qt = 0; qt < 2; ++qt) {
        float tot = 0.f;
#pragma unroll
        for (int h = 0; h < 8; ++h) tot += SSQ[h * 64 + 32 * qt + r];
        const float sc = __uint_as_float(OST[(qt * 17 + 16) * 64 + lane]) * rsqrtf(tot * (1.f / 512.f) + EPS);
        bf16* orow = MIXB + (size_t)(tok0 + 32 * qt + r) * D + hq * 64 + 4 * hi;
#pragma unroll
        for (int dt = 0; dt < 2; ++dt)
#pragma unroll
            for (int q4 = 0; q4 < 4; ++q4) {
                const float4 gv = *(const float4*)(gnorm + hq * 64 + 32 * dt + 8 * q4 + 4 * hi);
                const unsigned p0 = OST[(qt * 17 + 8 * dt + 2 * q4) * 64 + lane], p1 = OST[(qt * 17 + 8 * dt + 2 * q4 + 1) * 64 + lane];
                uint2 w; w.x = pkbf(__uint_as_float(p0 << 16) * sc * gv.x, __uint_as_float(p0 & 0xffff0000u) * sc * gv.y); w.y = pkbf(__uint_as_float(p1 << 16) * sc * gv.z, __uint_as_float(p1 & 0xffff0000u) * sc * gv.w);
                *(uint2*)(orow + 32 * dt + 8 * q4) = w;
            }
    }
    __syncthreads();
}

__device__ __forceinline__ void ssd_chunk_unit(LAS unsigned char* ldsb, int unit, const bf16* XACT, const float* DT, const float* ACS, float* MIXF, float* STATES, int tid, int lane, int wave) {
    asm volatile("" : "+v"(tid), "+v"(lane));
    const int g = unit & 1, bc = unit >> 1, tok0 = bc * 128;
    LAS bf16* BT = (LAS bf16*)ldsb;
    LAS bf16* XD = (LAS bf16*)(ldsb + 34816);
    LAS bf16* XW = (LAS bf16*)(ldsb + 34816 + 34816);
    LAS float* ACST = (LAS float*)(ldsb + 34816 * 3);
    const int r = lane & 31, hi = lane >> 5;
#pragma unroll
    for (int i = 0; i < 4; ++i) {
        const int c = tid + 512 * i, s = c >> 4, n0 = (c & 15) * 8;
        const bf16x8 v = ldg8(XACT + (size_t)(tok0 + s) * 1024 + 512 + g * 128 + n0);
#pragma unroll
        for (int e = 0; e < 8; ++e) BT[(n0 + e) * 136 + s] = (bf16)v[e];
    }
    ACST[tid] = ACS[(size_t)(tok0 + (tid >> 2)) * 8 + g * 4 + (tid & 3)];
#pragma unroll 1
    for (int hp = 0; hp < 2; ++hp) {
        if (hp) __syncthreads();
        int tidp = tid; asm volatile("" : "+v"(tidp));
#pragma unroll
        for (int i = 0; i < 4; ++i) {
            const int c = tidp + 512 * i, hsel = c >> 10, s = (c >> 3) & 127, p0 = (c & 7) * 8, H = g * 4 + 2 * hp + hsel;
            const bf16x8 v = ldg8(XACT + (size_t)(tok0 + s) * 1024 + H * 64 + p0);
            const float dtv = DT[(size_t)(tok0 + s) * 8 + H];
            const float w = __expf(ACS[(size_t)(tok0 + 127) * 8 + H] - ACS[(size_t)(tok0 + s) * 8 + H]);
#pragma unroll
            for (int e = 0; e < 8; ++e) { const float xd = sbf2f(v[e]) * dtv; XD[hsel * 8704 + (p0 + e) * 136 + s] = (bf16)bfs(xd); XW[hsel * 8704 + (p0 + e) * 136 + s] = (bf16)bfs(xd * w); }
        }
        __syncthreads();
        {
            const int lt = wave & 3, hsel = wave >> 2, hh = 2 * hp + hsel, H = g * 4 + hh;
            const int l = 32 * lt + r; const float acs_l = ACST[l * 4 + hh];
            bf16x8 cf[8];
            { const bf16* cp = XACT + (size_t)(tok0 + l) * 1024 + 768 + g * 128 + 8 * hi; asm volatile("" : "+v"(cp));
#pragma unroll
              for (int ks = 0; ks < 8; ++ks) cf[ks] = ldg8(cp + 16 * ks); }
            f32x16 Z0 = zero16(), Z1 = zero16();
#pragma unroll 1
            for (int st = 0; st <= lt; ++st) {
                f32x16 X = zero16();
                const bf16* bp = XACT + (size_t)(tok0 + 32 * st + r) * 1024 + 512 + g * 128 + 8 * hi; asm volatile("" : "+v"(bp));
#pragma unroll
                for (int ks = 0; ks < 8; ++ks) { const bf16x8 bfr = ldg8(bp + 16 * ks); X = MFMA32(bfr, cf[ks], X); }
#pragma unroll
                for (int i = 0; i < 16; ++i) { const int s = 32 * st + crow(i, hi); const float f = (s <= l) ? __expf(acs_l - ACST[s * 4 + hh]) : 0.f; X[i] *= f; }
                const int sb = 32 * st + 4 * hi;
                { const bf16x8 xs = pack8<0>(X); const bf16x8 b0 = lds4x2(XD + hsel * 8704 + r * 136 + sb), b1 = lds4x2(XD + hsel * 8704 + (32 + r) * 136 + sb); Z0 = MFMA32(xs, b0, Z0); Z1 = MFMA32(xs, b1, Z1); }
                { const bf16x8 xs = pack8<1>(X); const bf16x8 b0 = lds4x2(XD + hsel * 8704 + r * 136 + sb + 16), b1 = lds4x2(XD + hsel * 8704 + (32 + r) * 136 + sb + 16); Z0 = MFMA32(xs, b0, Z0); Z1 = MFMA32(xs, b1, Z1); }
            }
#pragma unroll
            for (int i = 0; i < 16; ++i) { float* o = MIXF + (size_t)(tok0 + 32 * lt + crow(i, hi)) * D + 512 + H * 64 + r; o[0] = Z0[i]; o[32] = Z1[i]; }
        }
        {
            const int nt = wave & 3, hsel = wave >> 2, H = g * 4 + 2 * hp + hsel;
            f32x16 S0 = zero16(), S1 = zero16();
#pragma unroll
            for (int ks = 0; ks < 8; ++ks) {
                const bf16x8 btf = lds8(BT + (32 * nt + r) * 136 + 16 * ks + 8 * hi);
                const bf16x8 a0 = lds8(XW + hsel * 8704 + r * 136 + 16 * ks + 8 * hi), a1 = lds8(XW + hsel * 8704 + (32 + r) * 136 + 16 * ks + 8 * hi);
                S0 = MFMA32(a0, btf, S0); S1 = MFMA32(a1, btf, S1);
            }
            float* sp = STATES + (size_t)(bc * 8 + H) * 8192 + 32 * nt + r;
#pragma unroll
            for (int i = 0; i < 16; ++i) { const int p = crow(i, hi); sp[p * 128] = S0[i]; sp[(32 + p) * 128] = S1[i]; }
        }
    }
    __syncthreads();
}

__device__ __forceinline__ __amdgpu_buffer_rsrc_t mk_rsrc(const void* p, unsigned bytes) { return __builtin_amdgcn_make_buffer_rsrc((void*)p, 0, bytes, 0x00020000); }
__device__ __forceinline__ void yoff_unit(const float* d_skip, const float* gnorm, LAS unsigned char* ldsb, int unit, const bf16* XACT, const bf16* PROJ, const float* ACS, const bf16* PREVT,
                                          const float* MIXF, bf16* MIXB, int lane, int wave) {
    const int g = unit & 1, bc = unit >> 1, tok0 = bc * 128;
    const int r = lane & 31, hi = lane >> 5, lt = wave & 3, hpair = wave >> 2;
    LAS float* TAB = (LAS float*)ldsb;
    const __amdgpu_buffer_rsrc_t rsF = mk_rsrc(MIXF, (unsigned)T * D * 4u), rsX = mk_rsrc(XACT, (unsigned)T * 1024u * 2u), rsP = mk_rsrc(PROJ, (unsigned)T * PS * 2u), rsA = mk_rsrc(ACS, (unsigned)T * 32u), rsB = mk_rsrc(MIXB, (unsigned)T * D * 2u);
    const unsigned tb = (unsigned)(tok0 + 32 * lt + 4 * hi);
    bf16x8 cf[8];
    { const bf16* cp = XACT + (size_t)(tok0 + 32 * lt + r) * 1024 + 768 + g * 128 + 8 * hi; asm volatile("" : "+v"(cp));
#pragma unroll
      for (int ks = 0; ks < 8; ++ks) cf[ks] = ldg8(cp + 16 * ks); }
    float eav[16], ssq[16];
    unsigned ypk[2][2][8];
#pragma unroll
    for (int i = 0; i < 16; ++i) ssq[i] = 0.f;
#pragma unroll
    for (int hsel = 0; hsel < 2; ++hsel) {
        const int H = g * 4 + 2 * hpair + hsel; const bf16* pv = PREVT + (size_t)(bc * 8 + H) * 8192 + 8 * hi;
        asm volatile("" : "+v"(pv));
        f32x16 Y0 = zero16(), Y1 = zero16();
#pragma unroll
        for (int ks = 0; ks < 8; ++ks) {
            const bf16x8 b0 = ldg8(pv + r * 128 + 16 * ks), b1 = ldg8(pv + (32 + r) * 128 + 16 * ks);
            Y0 = MFMA32(cf[ks], b0, Y0); Y1 = MFMA32(cf[ks], b1, Y1);
        }
        const float dsk = d_skip[H];
        { const unsigned vo = (tb * 8u + (unsigned)H) * 4u;
#pragma unroll
          for (int i = 0; i < 16; ++i) eav[i] = __expf(__builtin_bit_cast(float, __builtin_amdgcn_raw_buffer_load_b32(rsA, (int)vo, ((i & 3) + 8 * (i >> 2)) * 32, 0))); }
#pragma unroll
        for (int pt = 0; pt < 2; ++pt) {
            const unsigned col = (unsigned)(H * 64 + 32 * pt + r);
            const unsigned voF = (tb * 1024u + 512u + col) * 4u, voX = (tb * 1024u + col) * 2u, voP = (tb * (unsigned)PS + (unsigned)OZ + col) * 2u;
            float yo[16], xsv[16], zv[16];
#pragma unroll
            for (int i = 0; i < 16; ++i) { const int ro = (i & 3) + 8 * (i >> 2);
                yo[i] = __builtin_bit_cast(float, __builtin_amdgcn_raw_buffer_load_b32(rsF, (int)voF, ro * 4096, 0));
                xsv[i] = bf2f((bf16)__builtin_amdgcn_raw_buffer_load_b16(rsX, (int)voX, ro * 2048, 0));
                zv[i] = bf2f((bf16)__builtin_amdgcn_raw_buffer_load_b16(rsP, (int)voP, ro * (PS * 2), 0)); }
#pragma unroll
            for (int i = 0; i < 16; i += 2) {
                const float y0 = (yo[i] + eav[i] * (pt ? Y1[i] : Y0[i]) + dsk * xsv[i]) * silu_f(zv[i]);
                const float y1 = (yo[i + 1] + eav[i + 1] * (pt ? Y1[i + 1] : Y0[i + 1]) + dsk * xsv[i + 1]) * silu_f(zv[i + 1]);
                ssq[i] += y0 * y0; ssq[i + 1] += y1 * y1; ypk[hsel][pt][i >> 1] = pkbf(y0, y1);
            }
            __builtin_amdgcn_sched_barrier(0);
        }
    }
#pragma unroll
    for (int i = 0; i < 16; ++i) {
#pragma unroll
        for (int o = 1; o < 32; o <<= 1) ssq[i] += __shfl_xor(ssq[i], o);
    }
    if (r == 0) {
#pragma unroll
        for (int i = 0; i < 16; ++i) TAB[hpair * 128 + 32 * lt + crow(i, hi)] = ssq[i];
    }
    __syncthreads();
#pragma unroll
    for (int i = 0; i < 16; ++i) { const int l = 32 * lt + crow(i, hi); ssq[i] = rsqrtf((TAB[l] + TAB[128 + l]) * (1.f / 256.f) + EPS); }
#pragma unroll
    for (int hsel = 0; hsel < 2; ++hsel)
#pragma unroll
        for (int pt = 0; pt < 2; ++pt) {
            const unsigned col = (unsigned)((g * 4 + 2 * hpair + hsel) * 64 + 32 * pt + r); const float gn = gnorm[col];
            const unsigned voB = (tb * 1024u + 512u + col) * 2u;
#pragma unroll
            for (int i = 0; i < 16; ++i) { const unsigned w = ypk[hsel][pt][i >> 1];
                const float yf = (i & 1) ? __uint_as_float(w & 0xffff0000u) : __uint_as_float(w << 16);
                __builtin_amdgcn_raw_buffer_store_b16((short)f2bf(yf * ssq[i] * gn), rsB, (int)voB, ((i & 3) + 8 * (i >> 2)) * 2048, 0); }
        }
    __syncthreads();
}
typedef float f32x2 __attribute__((ext_vector_type(2)));
__device__ __forceinline__ void fp8x16_to_f32(const uint4 w, float (&f)[16]) {
    const int ww[4] = {(int)w.x, (int)w.y, (int)w.z, (int)w.w};
#pragma unroll
    for (int q = 0; q < 4; ++q) { const f32x2 a = __builtin_amdgcn_cvt_pk_f32_fp8(ww[q], false), b = __builtin_amdgcn_cvt_pk_f32_fp8(ww[q], true); f[4 * q] = a.x; f[4 * q + 1] = a.y; f[4 * q + 2] = b.x; f[4 * q + 3] = b.y; }
}
template <int M4, int M2, int M1> __device__ __forceinline__ void treduce16(const float (&a)[16], int lane, float& r0, float& r1) {
    float b[8], c[4];
    { const bool hi = (lane & M4) != 0;
#pragma unroll
      for (int i = 0; i < 8; ++i) { const float send = hi ? a[i] : a[i + 8]; const float recv = __shfl_xor(send, M4); b[i] = (hi ? a[i + 8] : a[i]) + recv; } }
    { const bool hi = (lane & M2) != 0;
#pragma unroll
      for (int i = 0; i < 4; ++i) { const float send = hi ? b[i] : b[i + 4]; const float recv = __shfl_xor(send, M2); c[i] = (hi ? b[i + 4] : b[i]) + recv; } }
    { const bool hi = (lane & M1) != 0;
      { const float send = hi ? c[0] : c[2]; const float recv = __shfl_xor(send, M1); r0 = (hi ? c[2] : c[0]) + recv; }
      { const float send = hi ? c[1] : c[3]; const float recv = __shfl_xor(send, M1); r1 = (hi ? c[3] : c[1]) + recv; } }
}
template <int M4, int M2, int M1> __device__ __forceinline__ void treduce16i(const int (&a)[16], int lane, int& r0, int& r1) {
    int b[8], c[4];
    { const bool hi = (lane & M4) != 0;
#pragma unroll
      for (int i = 0; i < 8; ++i) { const int send = hi ? a[i] : a[i + 8]; const int recv = __shfl_xor(send, M4); b[i] = (hi ? a[i + 8] : a[i]) + recv; } }
    { const bool hi = (lane & M2) != 0;
#pragma unroll
      for (int i = 0; i < 4; ++i) { const int send = hi ? b[i] : b[i + 4]; const int recv = __shfl_xor(send, M2); c[i] = (hi ? b[i + 4] : b[i]) + recv; } }
    { const bool hi = (lane & M1) != 0;
      { const int send = hi ? c[0] : c[2]; const int recv = __shfl_xor(send, M1); r0 = (hi ? c[2] : c[0]) + recv; }
      { const int send = hi ? c[1] : c[3]; const int recv = __shfl_xor(send, M1); r1 = (hi ? c[3] : c[1]) + recv; } }
}
#define PE_ID(E, i) (((i) & 1) ? (E[(i) >> 1] >> 16) : (E[(i) >> 1] & 0xffffu))
__device__ __forceinline__ void peer_u_item(int p, int j, const unsigned short* __restrict__ IDX, const unsigned char* __restrict__ XQ, const unsigned char* __restrict__ U8, int* __restrict__ PART, int lane, int wave) {
    asm volatile("" : "+v"(lane));
    const int gidx = lane >> 3; const unsigned coff = (unsigned)(p * 128 + (lane & 7) * 16);
#pragma unroll 1
    for (int it = 0; it < 8; ++it) {
        const int t = j * 64 + it * 8 + wave;
        unsigned E[8];
        { const uint4 e0 = *(const uint4*)(IDX + (size_t)t * 128 + 16 * gidx), e1 = *(const uint4*)(IDX + (size_t)t * 128 + 16 * gidx + 8);
          E[0] = e0.x; E[1] = e0.y; E[2] = e0.z; E[3] = e0.w; E[4] = e1.x; E[5] = e1.y; E[6] = e1.z; E[7] = e1.w; }
        uint4 uu[16];
#pragma unroll
        for (int i = 0; i < 16; ++i) uu[i] = *(const uint4*)(U8 + (size_t)(PE_ID(E, i) * 1024u + coff));
        const uint4 xq = *(const uint4*)(XQ + (size_t)t * D + coff);
        int d[16];
#pragma unroll
        for (int i = 0; i < 16; ++i) {
            int s = __builtin_amdgcn_sdot4((int)uu[i].x, (int)xq.x, 0, false); s = __builtin_amdgcn_sdot4((int)uu[i].y, (int)xq.y, s, false);
            s = __builtin_amdgcn_sdot4((int)uu[i].z, (int)xq.z, s, false); s = __builtin_amdgcn_sdot4((int)uu[i].w, (int)xq.w, s, false);
            d[i] = s;
        }
        int r0, r1; treduce16i<4, 2, 1>(d, lane, r0, r1);
        *(int2*)(PART + ((size_t)p * T + t) * 128 + 2 * lane) = make_int2(r0, r1);
    }
}
__device__ __forceinline__ void peer_v_item(int p, int j, const unsigned short* __restrict__ IDX, const unsigned char* __restrict__ ACTQ, const float* __restrict__ ACTS,
                                            const unsigned char* __restrict__ V8, float* __restrict__ PEERO, int lane, int wave) {
    asm volatile("" : "+v"(lane));
    const int gidx = lane >> 3; const unsigned coff = (unsigned)(p * 128 + (lane & 7) * 16);
#pragma unroll 1
    for (int it = 0; it < 8; ++it) {
        const int t = j * 64 + it * 8 + wave;
        unsigned E[8];
        { const uint4 e0 = *(const uint4*)(IDX + (size_t)t * 128 + 16 * gidx), e1 = *(const uint4*)(IDX + (size_t)t * 128 + 16 * gidx + 8);
          E[0] = e0.x; E[1] = e0.y; E[2] = e0.z; E[3] = e0.w; E[4] = e1.x; E[5] = e1.y; E[6] = e1.z; E[7] = e1.w; }
        uint4 vv[16];
#pragma unroll
        for (int i = 0; i < 16; ++i) vv[i] = *(const uint4*)(V8 + (size_t)(PE_ID(E, i) * 1024u + coff));
        const uint4 aq = *(const uint4*)(ACTQ + (size_t)t * 128 + 16 * gidx);
        const float asc = ACTS[t];
        const unsigned a4[4] = {aq.x, aq.y, aq.z, aq.w};
        int acc[16];
#pragma unroll
        for (int c = 0; c < 16; ++c) acc[c] = 0;
#pragma unroll
        for (int m = 0; m < 4; ++m) {
            const unsigned r0[4] = {vv[4 * m].x, vv[4 * m].y, vv[4 * m].z, vv[4 * m].w}, r1[4] = {vv[4 * m + 1].x, vv[4 * m + 1].y, vv[4 * m + 1].z, vv[4 * m + 1].w};
            const unsigned r2[4] = {vv[4 * m + 2].x, vv[4 * m + 2].y, vv[4 * m + 2].z, vv[4 * m + 2].w}, r3[4] = {vv[4 * m + 3].x, vv[4 * m + 3].y, vv[4 * m + 3].z, vv[4 * m + 3].w};
#pragma unroll
            for (int dc = 0; dc < 4; ++dc) {
                const unsigned ta = __builtin_amdgcn_perm(r1[dc], r0[dc], 0x05010400u), tb = __builtin_amdgcn_perm(r3[dc], r2[dc], 0x05010400u);
                const unsigned ua = __builtin_amdgcn_perm(r1[dc], r0[dc], 0x07030602u), ub = __builtin_amdgcn_perm(r3[dc], r2[dc], 0x07030602u);
                const unsigned c0 = __builtin_amdgcn_perm(tb, ta, 0x05040100u), c1 = __builtin_amdgcn_perm(tb, ta, 0x07060302u);
                const unsigned c2 = __builtin_amdgcn_perm(ub, ua, 0x05040100u), c3 = __builtin_amdgcn_perm(ub, ua, 0x07060302u);
                acc[4 * dc + 0] = __builtin_amdgcn_sdot4((int)c0, (int)a4[m], acc[4 * dc + 0], false);
                acc[4 * dc + 1] = __builtin_amdgcn_sdot4((int)c1, (int)a4[m], acc[4 * dc + 1], false);
                acc[4 * dc + 2] = __builtin_amdgcn_sdot4((int)c2, (int)a4[m], acc[4 * dc + 2], false);
                acc[4 * dc + 3] = __builtin_amdgcn_sdot4((int)c3, (int)a4[m], acc[4 * dc + 3], false);
            }
        }
        int r0i, r1i; treduce16i<32, 16, 8>(acc, lane, r0i, r1i);
        *(float2*)(PEERO + (size_t)t * D + coff + 2 * gidx) = make_float2(asc * (float)r0i, asc * (float)r1i);
    }
}

__device__ __forceinline__ void ce_desc(float& a, float& b) { const float hi = fmaxf(a, b), lo = fminf(a, b); a = hi; b = lo; }
__device__ __forceinline__ void sort16_desc(float (&v)[16]) {
#pragma unroll
    for (int k = 2; k <= 16; k <<= 1)
#pragma unroll
        for (int j = k >> 1; j > 0; j >>= 1)
#pragma unroll
            for (int i = 0; i < 16; ++i) { const int l = i ^ j; if (l > i) { if ((i & k) == 0) ce_desc(v[i], v[l]); else ce_desc(v[l], v[i]); } }
}
__device__ __forceinline__ void merge16_desc(float (&a)[16], const float (&b)[16]) {
#pragma unroll
    for (int i = 0; i < 16; ++i) a[i] = fmaxf(a[i], b[15 - i]);
#pragma unroll
    for (int j = 8; j > 0; j >>= 1)
#pragma unroll
        for (int i = 0; i < 16; ++i) { const int l = i ^ j; if (l > i) ce_desc(a[i], a[l]); }
}
__device__ __forceinline__ void ce_kv(float& ka, int& va, float& kb, int& vb) {
    const bool s = kb > ka; const float t0 = s ? kb : ka, t1 = s ? ka : kb; const int u0 = s ? vb : va, u1 = s ? va : vb; ka = t0; kb = t1; va = u0; vb = u1; }
__device__ __forceinline__ void sort16_kv(float (&k)[16], int (&v)[16]) {
#pragma unroll
    for (int kk = 2; kk <= 16; kk <<= 1)
#pragma unroll
        for (int j = kk >> 1; j > 0; j >>= 1)
#pragma unroll
            for (int i = 0; i < 16; ++i) { const int l = i ^ j; if (l > i) { if ((i & kk) == 0) ce_kv(k[i], v[i], k[l], v[l]); else ce_kv(k[l], v[l], k[i], v[i]); } }
}
__device__ __forceinline__ void merge16_kv(float (&ka)[16], int (&va)[16], const float (&kb)[16], const int (&vb)[16]) {
#pragma unroll
    for (int i = 0; i < 16; ++i) { const bool s = kb[15 - i] > ka[i]; ka[i] = s ? kb[15 - i] : ka[i]; va[i] = s ? vb[15 - i] : va[i]; }
#pragma unroll
    for (int j = 8; j > 0; j >>= 1)
#pragma unroll
        for (int i = 0; i < 16; ++i) { const int l = i ^ j; if (l > i) ce_kv(ka[i], va[i], ka[l], va[l]); }
}
__device__ __forceinline__ void split8(const float* p, bf16x8& hi8, bf16x8& lo8) {
    const float4 f0 = *(const float4*)p, f1 = *(const float4*)(p + 4);
    const float x[8] = {f0.x, f0.y, f0.z, f0.w, f1.x, f1.y, f1.z, f1.w};
#pragma unroll
    for (int j = 0; j < 8; ++j) { const short h = bfs(x[j]); hi8[j] = h; lo8[j] = bfs(x[j] - sbf2f(h)); }
}
__device__ __forceinline__ void route_task(int task, const float* QP, const bf16* KH, const bf16* KL, unsigned short* IDX, float* GATE, int lane) {
    const int r = lane & 31, hi = lane >> 5, t = 4 * task + (r >> 3), head = r & 7;
    float top[2][16];
#pragma unroll
    for (int half = 0; half < 2; ++half) {
        bf16x8 qh[4], ql[4];
#pragma unroll
        for (int ks = 0; ks < 4; ++ks) split8(QP + (size_t)t * D + head * 128 + half * 64 + 16 * ks + 8 * hi, qh[ks], ql[ks]);
        float cur[16];
#pragma unroll
        for (int kt = 0; kt < 4; ++kt) {
            f32x16 X = zero16();
            const bf16* khp = KH + (size_t)(half * 128 + 32 * kt + r) * 64 + 8 * hi; const bf16* klp = KL + (size_t)(half * 128 + 32 * kt + r) * 64 + 8 * hi;
            asm volatile("" : "+v"(khp), "+v"(klp));
#pragma unroll
            for (int ks = 0; ks < 4; ++ks) {
                const bf16x8 kh = ldg8(khp + 16 * ks), kl = ldg8(klp + 16 * ks);
                X = MFMA32(kh, qh[ks], X); X = MFMA32(kh, ql[ks], X); X = MFMA32(kl, qh[ks], X);
            }
            float grp[16];
#pragma unroll
            for (int i = 0; i < 16; ++i) { const unsigned key = (unsigned)(32 * kt + crow(i, hi)); grp[i] = __uint_as_float((__float_as_uint(X[i]) & ~127u) | (127u - key)); }
            sort16_desc(grp);
            if (kt == 0) {
#pragma unroll
                for (int i = 0; i < 16; ++i) cur[i] = grp[i];
            } else merge16_desc(cur, grp);
        }
        float oth[16];
#pragma unroll
        for (int i = 0; i < 16; ++i) oth[i] = __shfl_xor(cur[i], 32);
        merge16_desc(cur, oth);
#pragma unroll
        for (int i = 0; i < 16; ++i) top[half][i] = cur[i];
    }
    unsigned P1[4], P2[4];
#pragma unroll
    for (int q = 0; q < 4; ++q) { P1[q] = 0u; P2[q] = 0u;
#pragma unroll
        for (int s = 0; s < 4; ++s) { P1[q] |= (127u - (__float_as_uint(top[0][4 * q + s]) & 127u)) << (8 * s); P2[q] |= (127u - (__float_as_uint(top[1][4 * q + s]) & 127u)) << (8 * s); } }
#define CAND(a, b) __uint_as_float((__float_as_uint(top[0][a] + top[1][b]) & ~255u) | (255u - (unsigned)((a) * 16 + (b))))
    float bk[16];
    {
        float gk[16];
        gk[0] = CAND(0, 0);
        gk[1] = CAND(0, 1);
        gk[2] = CAND(0, 2);
        gk[3] = CAND(0, 3);
        gk[4] = CAND(0, 4);
        gk[5] = CAND(0, 5);
        gk[6] = CAND(0, 6);
        gk[7] = CAND(0, 7);
        gk[8] = CAND(0, 8);
        gk[9] = CAND(0, 9);
        gk[10] = CAND(0, 10);
        gk[11] = CAND(0, 11);
        gk[12] = CAND(0, 12);
        gk[13] = CAND(0, 13);
        gk[14] = CAND(0, 14);
        gk[15] = CAND(0, 15);
        sort16_desc(gk);
#pragma unroll
        for (int i = 0; i < 16; ++i) bk[i] = gk[i];
    }
    {
        float gk[16];
        gk[0] = CAND(1, 0);
        gk[1] = CAND(1, 1);
        gk[2] = CAND(1, 2);
        gk[3] = CAND(1, 3);
        gk[4] = CAND(1, 4);
        gk[5] = CAND(1, 5);
        gk[6] = CAND(1, 6);
        gk[7] = CAND(1, 7);
        gk[8] = CAND(2, 0);
        gk[9] = CAND(2, 1);
        gk[10] = CAND(2, 2);
        gk[11] = CAND(2, 3);
        gk[12] = CAND(2, 4);
        gk[13] = CAND(3, 0);
        gk[14] = CAND(3, 1);
        gk[15] = CAND(3, 2);
        sort16_desc(gk);
        merge16_desc(bk, gk);
    }
    {
        float gk[16];
        gk[0] = CAND(3, 3);
        gk[1] = CAND(4, 0);
        gk[2] = CAND(4, 1);
        gk[3] = CAND(4, 2);
        gk[4] = CAND(5, 0);
        gk[5] = CAND(5, 1);
        gk[6] = CAND(6, 0);
        gk[7] = CAND(6, 1);
        gk[8] = CAND(7, 0);
        gk[9] = CAND(7, 1);
        gk[10] = CAND(8, 0);
        gk[11] = CAND(9, 0);
        gk[12] = CAND(10, 0);
        gk[13] = CAND(11, 0);
        gk[14] = CAND(12, 0);
        gk[15] = CAND(13, 0);
        sort16_desc(gk);
        merge16_desc(bk, gk);
    }
    {
        float gk[16];
        gk[0] = CAND(14, 0);
        gk[1] = CAND(15, 0);
        gk[2] = -INFINITY;
        gk[3] = -INFINITY;
        gk[4] = -INFINITY;
        gk[5] = -INFINITY;
        gk[6] = -INFINITY;
        gk[7] = -INFINITY;
        gk[8] = -INFINITY;
        gk[9] = -INFINITY;
        gk[10] = -INFINITY;
        gk[11] = -INFINITY;
        gk[12] = -INFINITY;
        gk[13] = -INFINITY;
        gk[14] = -INFINITY;
        gk[15] = -INFINITY;
        sort16_desc(gk);
        merge16_desc(bk, gk);
    }
#undef CAND
    int bv[16];
#pragma unroll
    for (int i = 0; i < 16; ++i) {
        const unsigned cd = 255u - (__float_as_uint(bk[i]) & 255u), ca = cd >> 4, cb = cd & 15u;
        const unsigned wa = (ca >> 2) == 0u ? P1[0] : (ca >> 2) == 1u ? P1[1] : (ca >> 2) == 2u ? P1[2] : P1[3];
        const unsigned wb = (cb >> 2) == 0u ? P2[0] : (cb >> 2) == 1u ? P2[1] : (cb >> 2) == 2u ? P2[2] : P2[3];
        bv[i] = (int)((((wa >> (8u * (ca & 3u))) & 255u) << 7) | ((wb >> (8u * (cb & 3u))) & 255u));
    }
    float e[16], se = 0.f;
#pragma unroll
    for (int i = 0; i < 16; ++i) { e[i] = __expf(bk[i] - bk[0]); se += e[i]; }
    const float inv = 1.f / se;
    if (hi == 0) {
        uint4* ip = (uint4*)(IDX + (size_t)t * 128 + head * 16); float4* gp = (float4*)(GATE + (size_t)t * 128 + head * 16);
#pragma unroll
        for (int q = 0; q < 2; ++q) ip[q] = make_uint4((unsigned)bv[8 * q] | ((unsigned)bv[8 * q + 1] << 16), (unsigned)bv[8 * q + 2] | ((unsigned)bv[8 * q + 3] << 16), (unsigned)bv[8 * q + 4] | ((unsigned)bv[8 * q + 5] << 16), (unsigned)bv[8 * q + 6] | ((unsigned)bv[8 * q + 7] << 16));
#pragma unroll
        for (int q = 0; q < 4; ++q) gp[q] = make_float4(e[4 * q] * inv, e[4 * q + 1] * inv, e[4 * q + 2] * inv, e[4 * q + 3] * inv);
    }
}

#define XB_TMO      128
#define XB_XCNT(j)  (256  + 64 * (j))
#define XB_XSUB(j)  (1280 + 64 * (j))
#define XB_XGEN(j)  (2304 + 64 * (j))
#define XB_TOP      3328
#define XB_TOPGEN   3392
#define XCD_BAR_WORDS 3456
#define XB_SPIN_CAP (1u << 22)
__device__ __forceinline__ unsigned xb_ld(unsigned* p)              { return __hip_atomic_load(p, __ATOMIC_RELAXED, __HIP_MEMORY_SCOPE_AGENT); }
__device__ __forceinline__ unsigned xb_add(unsigned* p, unsigned v) { return __hip_atomic_fetch_add(p, v, __ATOMIC_RELAXED, __HIP_MEMORY_SCOPE_AGENT); }
__device__ __forceinline__ unsigned xb_xcc_id() { return (unsigned)__builtin_amdgcn_s_getreg((3 << 11) | 20) & 0xFu; }
#define XB_SPIN(cond, bar) do { unsigned _sp = 0; while (cond) { __builtin_amdgcn_s_sleep(1); \
    if ((++_sp & 255u) == 0u) { if (xb_ld(&(bar)[XB_TMO])) break; if (_sp > XB_SPIN_CAP) { atomicAdd(&(bar)[XB_TMO], 1u); break; } } } } while (0)
struct XcdBarrier { unsigned* bar; unsigned x; volatile LAS unsigned* st; };
__device__ __forceinline__ XcdBarrier xcd_barrier_post(unsigned* bar, volatile LAS unsigned* st) {
    XcdBarrier b; b.bar = bar; b.x = xb_xcc_id(); b.st = st;
    if (threadIdx.x == 0) (void)xb_add(&bar[XB_XCNT(b.x)], 1u);
    return b;
}
__device__ __forceinline__ void xcd_barrier_complete(unsigned* bar, unsigned x, unsigned& nloc, unsigned& nx) {
    const unsigned G = gridDim.x * gridDim.y * gridDim.z;
    unsigned sum, cnt, mine, sp = 0u;
    for (;;) {
        sum = 0u; cnt = 0u; mine = 0u;
#pragma unroll
        for (unsigned j = 0; j < 16; ++j) { const unsigned c = xb_ld(&bar[XB_XCNT(j)]); sum += c; cnt += (c > 0u) ? 1u : 0u; mine = (j == x) ? c : mine; }
        if (sum == G) break;
        __builtin_amdgcn_s_sleep(1);
        if ((++sp & 255u) == 0u) { if (xb_ld(&bar[XB_TMO])) break; if (sp > XB_SPIN_CAP) { atomicAdd(&bar[XB_TMO], 1u); break; } }
    }
    nloc = mine > 0u ? mine : 1u; nx = cnt > 0u ? cnt : 1u;
}
__device__ __forceinline__ void xcd_barrier(const XcdBarrier& b) {
    asm volatile("s_waitcnt vmcnt(0)" ::: "memory");
    __syncthreads();
    if (threadIdx.x == 0) {
        unsigned* bar = b.bar;
        __builtin_amdgcn_s_waitcnt(0);
        unsigned nloc = b.st[0], nx = b.st[1];
        if (nloc == 0u) { xcd_barrier_complete(bar, b.x, nloc, nx); b.st[0] = nloc; b.st[1] = nx; }
        const unsigned old = xb_add(&bar[XB_XSUB(b.x)], 1u);
        const unsigned gen = old / nloc;
        if (old + 1u == (gen + 1u) * nloc) {
            __builtin_amdgcn_fence(__ATOMIC_RELEASE, "agent");
            asm volatile("s_waitcnt vmcnt(0)" ::: "memory");
            const unsigned og = xb_add(&bar[XB_TOP], 1u);
            const unsigned tg = og / nx;
            if (og + 1u == (tg + 1u) * nx) xb_add(&bar[XB_TOPGEN], 1u);
            else XB_SPIN(xb_ld(&bar[XB_TOPGEN]) == tg, bar);
            __builtin_amdgcn_fence(__ATOMIC_ACQUIRE, "agent");
            xb_add(&bar[XB_XGEN(b.x)], 1u);
            asm volatile("s_waitcnt vmcnt(0)" ::: "memory");
        } else {
            XB_SPIN(xb_ld(&bar[XB_XGEN(b.x)]) == gen, bar);
            __builtin_amdgcn_fence(__ATOMIC_ACQUIRE, "agent");
            asm volatile("s_waitcnt vmcnt(0)" ::: "memory");
        }
    }
    __syncthreads();
}
constexpr int LDS_BYTES = 147456;
constexpr int MISC_OFF = 131072 + 320;

__global__ void __launch_bounds__(NTHR, 2) k_main(Args a) {
    extern __shared__ __attribute__((aligned(16))) unsigned char lds_raw[];
    LAS unsigned char* ldsb = (LAS unsigned char*)lds_raw;
    const int tid0 = threadIdx.x, bid = blockIdx.x, nb = gridDim.x;
    const int wave = __builtin_amdgcn_readfirstlane(tid0 >> 6);
    const int gthreads = nb * NTHR, nwaves = gthreads >> 6;
#define PHASE_VARS() int tid = tid0; asm volatile("" : "+v"(tid)); const int lane = tid & 63, gtid = bid * NTHR + tid, gwave = gtid >> 6; (void)lane; (void)gtid; (void)gwave
    unsigned char* ws = a.ws;
    bf16* WINT = (bf16*)(ws + WS_WIN); bf16* WOT = (bf16*)(ws + WS_WO); bf16* WQT = (bf16*)(ws + WS_WQ);
    bf16* PROJ = (bf16*)(ws + WS_PROJ);
    bf16* XNB = (bf16*)(ws + WS_XNB);
    bf16* XACT = (bf16*)(ws + WS_XACT);
    float* DTRAW = (float*)(ws + WS_DTRAW); float* DT = (float*)(ws + WS_DT); float* ACS = (float*)(ws + WS_ACS); float* CDEC = (float*)(ws + WS_CDEC);
    float* STATES = (float*)(ws + WS_STATES); bf16* PREVT = (bf16*)(ws + WS_PREV);
    float* QP = (float*)(ws + WS_QP); unsigned short* IDX = (unsigned short*)(ws + WS_IDX); float* GATE = (float*)(ws + WS_GATE);
    float* TOPV = (float*)(ws + WS_TOPV); int* TOPI = (int*)(ws + WS_TOPI);
    unsigned char* U8 = ws + WS_U8; unsigned char* V8 = ws + WS_V8; float* SU = (float*)(ws + WS_SU); float* SV = SU + 16384; int* PART = (int*)(ws + WS_PART); unsigned char* XQ = ws + WS_XQ; float* XS = (float*)(ws + WS_XS);
    bf16* KH = (bf16*)(ws + WS_KH); bf16* KL = (bf16*)(ws + WS_KH + 65536);
    float* MIXF = a.out;
    volatile LAS unsigned* MISC = (volatile LAS unsigned*)(ldsb + MISC_OFF);
    if (tid0 < 32) MISC[tid0] = 0u;
    __syncthreads();
    XcdBarrier bar = xcd_barrier_post((unsigned*)ws, MISC + 8);
#define IN(k) (a.ph_lo <= (k) && (k) < a.ph_hi)
#if defined(PROBE_LO)
    int seg_ = 0; unsigned long long tseg_ = __builtin_amdgcn_s_memrealtime();
#define PROBE_SPIN() do { if (seg_ >= PROBE_LO && seg_ <= PROBE_HI) { const unsigned long long d_ = (__builtin_amdgcn_s_memrealtime() - tseg_) * PROBE_AMP; const unsigned long long s_ = __builtin_amdgcn_s_memrealtime(); \
        while (__builtin_amdgcn_s_memrealtime() - s_ < d_) __builtin_amdgcn_s_sleep(4); } } while (0)
#define GRID_BAR() do { PROBE_SPIN(); xcd_barrier(bar); tseg_ = __builtin_amdgcn_s_memrealtime(); ++seg_; } while (0)
#else
#define PROBE_SPIN() do { } while (0)
#define GRID_BAR() xcd_barrier(bar)
#endif

    if (IN(0)) {
        PHASE_VARS();
        LAS float* scr = (LAS float*)(ldsb + wave * 16384);
        constexpr int I_IN = 16 * 72, I_O = 16 * 32, NITEMS = I_IN + 2 * I_O;
        for (int it = gwave; it < NITEMS; it += nwaves) {
            int r = it;
            if (r < I_IN) { transpose_item(a.w_in, PW, D, WINT, scr, r / 72, r % 72, lane); continue; } r -= I_IN;
            if (r < I_O) { transpose_item(a.w_out, D, D, WOT, scr, r / 32, r % 32, lane); continue; } r -= I_O;
            transpose_item(a.peer_wq, D, D, WQT, scr, r / 32, r % 32, lane);
        }
        for (int i = gtid; i < 2 * 128 * 64; i += gthreads) { const float kf = a.peer_sub_keys[i]; const short h = bfs(kf); KH[i] = (bf16)h; KL[i] = (bf16)bfs(kf - sbf2f(h)); }
        for (int i = tid; i < 8 * 1024; i += NTHR) { const int h = i & 7, c = i >> 3; *(LAS float*)(ldsb + h * 16384 + 8448 + c * 4) = a.w_in[(size_t)c * PW + ODT + h]; }
        __syncthreads();
        rmsnorm_rows_bf16<1>(a.x, a.norm_mix_g, XNB, ldsb, DTRAW, nullptr, nullptr, gwave, nwaves, lane);
    }
    GRID_BAR();
    if (IN(1)) {
        PHASE_VARS();
        pg8::Gemm g{XNB, WINT, T, PS, D}; pg8::StaticOrder S; S.init(T, PS, nb, bid);
        pg8::EpiBf16Plain E{PROJ, PS};
        pg8::gemm_phase<pg8::EpiBf16Plain, pg8::StaticOrder>(ldsb, g, S, E, nullptr);
        if (bid >= 64) for (int rr = (bid - 64) * 8 + wave; rr < 2 * 16384; rr += (nb - 64) * 8) {
            const int which = rr >> 14, row = rr & 16383;
            const float4* src4 = (const float4*)((which ? a.peer_v : a.peer_u) + (size_t)row * D) + lane;
            float4 v[4]; float mx = 0.f;
#pragma unroll
            for (int jq = 0; jq < 4; ++jq) { v[jq] = src4[64 * jq]; mx = fmaxf(mx, fmaxf(fmaxf(fabsf(v[jq].x), fabsf(v[jq].y)), fmaxf(fabsf(v[jq].z), fabsf(v[jq].w)))); }
#pragma unroll
            for (int o = 1; o < 64; o <<= 1) mx = fmaxf(mx, __shfl_xor(mx, o));
            const float sc = mx > 0.f ? mx * (1.f / 127.f) : 1.f, inv = 1.f / sc;
            unsigned* dst = (unsigned*)((which ? V8 : U8) + (size_t)row * D) + lane;
#pragma unroll
            for (int jq = 0; jq < 4; ++jq) { const int q0 = (int)rintf(v[jq].x * inv), q1 = (int)rintf(v[jq].y * inv), q2 = (int)rintf(v[jq].z * inv), q3 = (int)rintf(v[jq].w * inv);
                dst[64 * jq] = (unsigned)(q0 & 255) | ((unsigned)(q1 & 255) << 8) | ((unsigned)(q2 & 255) << 16) | ((unsigned)(q3 & 255) << 24); }
            if (lane == 0) (which ? SV : SU)[row] = sc;
        }
    }
    GRID_BAR();
    if (IN(2)) {
        PHASE_VARS();
        for (int task = gtid; task < (T / 16) * 128; task += gthreads) {
            const int cg = task & 127, t0 = (task >> 7) * 16, c0 = cg * 8;
            float w[4][8], bs[8];
#pragma unroll
            for (int k = 0; k < 4; ++k) { const float4 a0 = *(const float4*)(a.conv_w + k * 1024 + c0), a1 = *(const float4*)(a.conv_w + k * 1024 + c0 + 4);
                w[k][0] = a0.x; w[k][1] = a0.y; w[k][2] = a0.z; w[k][3] = a0.w; w[k][4] = a1.x; w[k][5] = a1.y; w[k][6] = a1.z; w[k][7] = a1.w; }
            { const float4 a0 = *(const float4*)(a.conv_b + c0), a1 = *(const float4*)(a.conv_b + c0 + 4); bs[0] = a0.x; bs[1] = a0.y; bs[2] = a0.z; bs[3] = a0.w; bs[4] = a1.x; bs[5] = a1.y; bs[6] = a1.z; bs[7] = a1.w; }
            const bool has_halo = (t0 & (SEQ - 1)) != 0;
            bf16x8 rows[19];
#pragma unroll
            for (int i = 0; i < 19; ++i) {
                if (i < 3 && !has_halo) {
#pragma unroll
                    for (int e = 0; e < 8; ++e) rows[i][e] = 0;
                } else rows[i] = ldg8(PROJ + (size_t)(t0 + i - 3) * PS + OXBC + c0);
            }
#pragma unroll
            for (int i = 0; i < 16; ++i) {
                float o[8];
#pragma unroll
                for (int e = 0; e < 8; ++e) o[e] = silu_f(bs[e] + w[0][e] * sbf2f(rows[i][e]) + w[1][e] * sbf2f(rows[i + 1][e]) + w[2][e] * sbf2f(rows[i + 2][e]) + w[3][e] * sbf2f(rows[i + 3][e]));
                v4u ov; ov.x = pkbf(o[0], o[1]); ov.y = pkbf(o[2], o[3]); ov.z = pkbf(o[4], o[5]); ov.w = pkbf(o[6], o[7]);
                *(v4u*)(XACT + (size_t)(t0 + i) * 1024 + c0) = ov;
            }
        }
        if (gwave < 1024) {
            const int h = gwave & 7, bc = gwave >> 3;
            const float A = -__expf(a.a_log[h]), bias = a.dt_bias[h];
            const int t0 = bc * 128 + lane, t1 = t0 + 64;
            const float raw0 = DTRAW[t0 * 8 + h] + bias, raw1 = DTRAW[t1 * 8 + h] + bias;
            const float dt0 = fmaxf(raw0, 0.f) + log1pf(__expf(-fabsf(raw0))), dt1 = fmaxf(raw1, 0.f) + log1pf(__expf(-fabsf(raw1)));
            DT[t0 * 8 + h] = dt0; DT[t1 * 8 + h] = dt1;
            float v0 = dt0 * A, v1 = dt1 * A;
#pragma unroll
            for (int o = 1; o < 64; o <<= 1) { const float y0 = __shfl_up(v0, o), y1 = __shfl_up(v1, o); if (lane >= o) { v0 += y0; v1 += y1; } }
            v1 += __shfl(v0, 63);
            ACS[t0 * 8 + h] = v0; ACS[t1 * 8 + h] = v1;
            if (lane == 63) CDEC[gwave] = __expf(v1);
        }
    }
    GRID_BAR();
    if (IN(3)) {
        PHASE_VARS();
        for (int u = bid; u < 512; u += nb) {
            if (u < 256) attn_unit(a.attn_sinks, a.attn_out_g, ldsb, u, PROJ, XNB, tid, lane, wave);
            else ssd_chunk_unit(ldsb, u - 256, XACT, DT, ACS, MIXF, STATES, tid, lane, wave);
        }
    }
    GRID_BAR();
    if (IN(5)) {
        PHASE_VARS();
        for (int idx = gtid; idx < 2 * 8 * 8192; idx += gthreads) {
            const int pn = idx & 8191, h = (idx >> 13) & 7, b = idx >> 16;
            float run = 0.f;
#pragma unroll 1
            for (int c0 = 0; c0 < 64; c0 += 8) {
                float st[8], dc[8];
#pragma unroll
                for (int j = 0; j < 8; ++j) { const int bch = (b * 64 + c0 + j) * 8 + h; st[j] = STATES[(size_t)bch * 8192 + pn]; dc[j] = CDEC[bch]; }
#pragma unroll
                for (int j = 0; j < 8; ++j) { const int bch = (b * 64 + c0 + j) * 8 + h; PREVT[(size_t)bch * 8192 + pn] = f2bf(run); run = dc[j] * run + st[j]; }
            }
        }
    }
    GRID_BAR();
    if (IN(6)) {
        PHASE_VARS();
        for (int u = bid; u < 256; u += nb) yoff_unit(a.d_skip, a.ssm_norm_g, ldsb, u, XACT, PROJ, ACS, PREVT, MIXF, XNB, lane, wave);
    }
    GRID_BAR();
    if (IN(7)) {
        PHASE_VARS();
        pg8::Gemm g{XNB, WOT, T, D, D}; pg8::StaticOrder S; S.init(T, D, nb, bid);
        pg8::EpiF32Resid E{a.out, a.x, D};
        pg8::gemm_phase<pg8::EpiF32Resid, pg8::StaticOrder>(ldsb, g, S, E, nullptr);
    }
    GRID_BAR();
    if (IN(8)) {
        PHASE_VARS();
        rmsnorm_rows_bf16<2>(a.out, a.norm_ffn_g, XNB, ldsb, nullptr, XQ, XS, gwave, nwaves, lane);
    }
    GRID_BAR();
    if (IN(9)) {
        PHASE_VARS();
        pg8::Gemm g{XNB, WQT, T, D, D}; pg8::StaticOrder S; S.init(T, D, nb, bid);
        pg8::EpiF32Resid E{QP, nullptr, D};
        pg8::gemm_phase<pg8::EpiF32Resid, pg8::StaticOrder>(ldsb, g, S, E, nullptr);
    }
    GRID_BAR();
    if (IN(10)) {
        PHASE_VARS();
        for (int task = gwave; task < T / 4; task += nwaves) route_task(task, QP, KH, KL, IDX, GATE, lane);
    }
    GRID_BAR();
    unsigned char* ACTQ = ws + WS_ACT; float* ACTS = (float*)(ws + WS_ACT + 4 * MiB); float* PEERO = (float*)(ws + WS_PEERO);
    unsigned* ctl = (unsigned*)ws;
    const int xcc = (int)(bar.x & 7u);
    if (IN(12)) {
        PHASE_VARS();
#pragma unroll 1
        for (int pi = 0; pi < NPART; ++pi) {
            const int p = (xcc + pi) & 7;
            for (;;) {
                if (tid == 0) MISC[16] = xb_add(&ctl[CW_QU + 64 * p], 1u);
                __syncthreads();
                const int j = (int)MISC[16];
                __syncthreads();
                if (j >= NCHUNK) break;
                peer_u_item(p, j, IDX, XQ, U8, PART, lane, wave);
            }
        }
    }
    GRID_BAR();
    if (IN(12)) {
        PHASE_VARS();
        for (int t = gwave; t < T; t += nwaves) {
            float av[2];
#pragma unroll
            for (int hh = 0; hh < 2; ++hh) {
                const int i = t * 128 + hh * 64 + lane;
                int si = 0;
#pragma unroll
                for (int pp = 0; pp < NPART; ++pp) si += PART[(size_t)pp * T * 128 + i];
                const int e = IDX[i]; const float z = (float)si * SU[e] * XS[t];
                av[hh] = GATE[i] * 0.5f * z * (1.f + erff(z * 0.70710678118654752f)) * SV[e];
            }
            float mx = fmaxf(fabsf(av[0]), fabsf(av[1]));
#pragma unroll
            for (int o = 1; o < 64; o <<= 1) mx = fmaxf(mx, __shfl_xor(mx, o));
            const float sc = mx > 0.f ? mx * (1.f / 127.f) : 1.f, inv = 1.f / sc;
            ACTQ[(size_t)t * 128 + lane] = (unsigned char)((int)rintf(av[0] * inv) & 255); ACTQ[(size_t)t * 128 + 64 + lane] = (unsigned char)((int)rintf(av[1] * inv) & 255);
            if (lane == 0) ACTS[t] = sc;
        }
    }
    GRID_BAR();
    if (IN(13)) {
        PHASE_VARS();
#pragma unroll 1
        for (int pi = 0; pi < NPART; ++pi) {
            const int p = (xcc + pi) & 7;
            for (;;) {
                if (tid == 0) MISC[16] = xb_add(&ctl[CW_QV + 64 * p], 1u);
                __syncthreads();
                const int j = (int)MISC[16];
                __syncthreads();
                if (j >= NCHUNK) break;
                peer_v_item(p, j, IDX, ACTQ, ACTS, V8, PEERO, lane, wave);
            }
        }
    }
    GRID_BAR();
    if (IN(14)) {
        PHASE_VARS();
        for (int t = gwave; t < T; t += nwaves) {
            const float4* hr = (const float4*)(a.out + (size_t)t * D) + lane; const float4* pr = (const float4*)(PEERO + (size_t)t * D) + lane;
            float4 v[4]; float ss = 0.f;
#pragma unroll
            for (int jq = 0; jq < 4; ++jq) { const float4 h4 = hr[64 * jq], p4 = pr[64 * jq]; v[jq] = make_float4(h4.x + p4.x, h4.y + p4.y, h4.z + p4.z, h4.w + p4.w); ss += v[jq].x * v[jq].x + v[jq].y * v[jq].y + v[jq].z * v[jq].z + v[jq].w * v[jq].w; }
            ss = wave_sum(ss);
            const float r3 = rsqrtf(ss * (1.f / D) + EPS);
            float4* op = (float4*)(a.out + (size_t)t * D) + lane;
#pragma unroll
            for (int jq = 0; jq < 4; ++jq) { const float4 gv = ((const float4*)a.final_norm_g)[lane + 64 * jq]; op[64 * jq] = make_float4(v[jq].x * r3 * gv.x, v[jq].y * r3 * gv.y, v[jq].z * r3 * gv.z, v[jq].w * r3 * gv.w); }
        }
    }
    PROBE_SPIN();
#undef IN
}
}

extern "C" void kernel_launch(void* const* d_in, const int* in_sizes, int n_in, void* d_out, int out_size, void* d_ws, size_t ws_size, hipStream_t stream) {
    if (n_in != 18 || out_size != T * D || ws_size < WS_END) { fprintf(stderr, "kernel_launch: unexpected shapes n_in=%d out=%d ws=%zu\n", n_in, out_size, ws_size); return; }
    Args a{};
    const float** ap = (const float**)&a;
    for (int i = 0; i < 18; ++i) ap[i] = (const float*)d_in[i];
    a.out = (float*)d_out; a.ws = (unsigned char*)d_ws;
    static int grid = 0;
    if (grid == 0) {
        int dev = 0, cus = 0, per_cu = 0;
        if (hipGetDevice(&dev) != hipSuccess || hipDeviceGetAttribute(&cus, hipDeviceAttributeMultiprocessorCount, dev) != hipSuccess) { fprintf(stderr, "kernel_launch: device query failed\n"); grid = -1; return; }
        if (hipFuncSetAttribute((const void*)k_main, hipFuncAttributeMaxDynamicSharedMemorySize, LDS_BYTES) != hipSuccess) { fprintf(stderr, "kernel_launch: hipFuncSetAttribute failed\n"); grid = -1; return; }
        if (hipOccupancyMaxActiveBlocksPerMultiprocessor(&per_cu, (const void*)k_main, NTHR, LDS_BYTES) != hipSuccess || per_cu < 1) { fprintf(stderr, "kernel_launch: occupancy query says %d blocks/CU\n", per_cu); (void)hipGetLastError(); grid = -1; return; }
        grid = cus;
    }
    if (grid < 0) return;
    if (hipMemsetAsync(d_ws, 0, 65536, stream) != hipSuccess) { fprintf(stderr, "kernel_launch: memset failed\n"); return; }
    a.ph_lo = 0; a.ph_hi = 15;
    hipLaunchKernelGGL(k_main, dim3(grid), dim3(NTHR), LDS_BYTES, stream, a);
}
```

```cpp
#include <hip/hip_runtime.h>
#include <cstdio>
#include <cstdint>

namespace pg8 {
#define PG8_LAS __attribute__((address_space(3)))
typedef unsigned short bf16_t;
typedef short bf16x8 __attribute__((ext_vector_type(8)));
typedef float f32x4 __attribute__((ext_vector_type(4)));
typedef unsigned u32x4 __attribute__((ext_vector_type(4)));
constexpr int BM = 256, BK = 64, HALF = 128, HTB = HALF * BK * 2  , STAGE_BYTES = 8 * HTB, NXCD = 8, WGM = 8;

__host__ __device__ __forceinline__ int lds_byte(int r, int c) { const int st = (r >> 4) * 2 + (c >> 5), rr = r & 15, cc = c & 31, ob = rr * 64 + cc * 2; return st * 1024 + (ob ^ (((ob >> 9) & 1) << 5)); }
__host__ __device__ __forceinline__ void stage_rc(int b, int& R, int& C) { const int st = b / 1024, sb = b % 1024, swz = sb ^ (((sb >> 9) & 1) << 5); R = (st >> 1) * 16 + swz / 64; C = (st & 1) * 32 + (swz % 64) / 2; }
__host__ __device__ __forceinline__ int perm32(int rho) { const int n = rho >> 4, i = rho & 15; return 8 * (i >> 2) + 4 * n + (i & 3); }

struct Unit { int pm, pn; };
struct Gemm { const bf16_t* A; const bf16_t* Bt; int M, N, K; };

struct StaticOrder {
    int nM, nN, nwg, G, c;
    __host__ __device__ void init(int M, int N, int G_, int c_) { nM = M / BM; nN = N / BM; nwg = nM * nN; G = G_; c = c_; }
    __host__ __device__ bool next(int i, Unit& u) const {
        const long L = (long)i * G + c; if (L >= nwg) return false;
        int wgid = (int)L; { const int q = nwg / NXCD, r = nwg % NXCD, xcd = wgid % NXCD, off = wgid / NXCD; wgid = (xcd < r ? xcd * (q + 1) : r * (q + 1) + (xcd - r) * q) + off; }
        const int nig = WGM * nN, gid = wgid / nig, fm = gid * WGM, gsz = (nM - fm) < WGM ? (nM - fm) : WGM;
        u.pm = fm + ((wgid % nig) % gsz); u.pn = (wgid % nig) / gsz; return true;
    }
    __device__ __forceinline__ void a_ready(const Unit&) const {}
    __device__ __forceinline__ void done(const Unit&) const {}
};
__device__ __forceinline__ unsigned cvt_pk_bf16(float lo, float hi) { unsigned r; asm volatile("v_cvt_pk_bf16_f32 %0, %1, %2" : "=v"(r) : "v"(lo), "v"(hi)); return r; }
typedef float f32x2 __attribute__((ext_vector_type(2)));
struct EpiBf16Plain {
    static constexpr bool PERM = true, AFTER_DRAIN = false;
    bf16_t* O; int ldc;
    __device__ __forceinline__ void operator()(const f32x4 (&acc)[2][2][4][2], const Unit& u, int wr, int wc, int fr, int fq) const {
        const int row0 = u.pm * BM + wr * 64 + fr, col0 = u.pn * BM + wc * 32 + 8 * fq;
#pragma unroll
        for (int ai = 0; ai < 2; ++ai)
#pragma unroll
            for (int m = 0; m < 4; ++m) { bf16_t* rowp = O + (size_t)(row0 + ai * HALF + m * 16) * ldc + col0;
#pragma unroll
                for (int bj = 0; bj < 2; ++bj) { const f32x4 v0 = acc[ai][bj][m][0], v1 = acc[ai][bj][m][1];
                    u32x4 w; w.x = cvt_pk_bf16(v0[0], v0[1]); w.y = cvt_pk_bf16(v0[2], v0[3]); w.z = cvt_pk_bf16(v1[0], v1[1]); w.w = cvt_pk_bf16(v1[2], v1[3]);
                    *(u32x4*)(rowp + bj * HALF) = w; } }
    }
};
struct EpiF32Resid {
    static constexpr bool PERM = false, AFTER_DRAIN = false;
    float* C; const float* R; int ldc;
    __device__ __forceinline__ void operator()(const f32x4 (&acc)[2][2][4][2], const Unit& u, int wr, int wc, int fr, int fq) const {
        const int row0 = u.pm * BM + wr * 64 + fr, col0 = u.pn * BM + wc * 32 + 4 * fq;
#pragma unroll
        for (int ai = 0; ai < 2; ++ai)
#pragma unroll
            for (int m = 0; m < 4; ++m) { const size_t off = (size_t)(row0 + ai * HALF + m * 16) * ldc + col0;
#pragma unroll
                for (int bj = 0; bj < 2; ++bj)
#pragma unroll
                    for (int n = 0; n < 2; ++n) { f32x4 v = acc[ai][bj][m][n]; if (R) v += *(const f32x4*)(R + off + bj * HALF + n * 16); *(f32x4*)(C + off + bj * HALF + n * 16) = v; }
                asm volatile("" ::: "memory"); }
    }
};
template <class Epi, class Sched, bool STAMP = false>
__device__ __forceinline__ void gemm_phase(PG8_LAS unsigned char* lds, const Gemm g, const Sched& S, const Epi& E, unsigned long long* stamps) {
    const int tid = threadIdx.x, wid = __builtin_amdgcn_readfirstlane(tid >> 6), lane = tid & 63, wr = wid >> 2, wc = wid & 3, fr = lane & 15, fq = lane >> 4;
    const int K = g.K, nt = K / BK;
    int ts_lo = 0, ts_hi = 0, nts = 0; const unsigned long long rt_entry = STAMP ? (unsigned long long)0ull : 0ull;
#define PG8_STAMP() do { if (STAMP && wid == 0 && nts < 64) { const unsigned long long _c = (unsigned long long)clock64(); \
        ts_lo = (lane == nts) ? (int)(unsigned)_c : ts_lo; ts_hi = (lane == nts) ? (int)(unsigned)(_c >> 32) : ts_hi; ++nts; } } while (0)
    PG8_STAMP();
    unsigned voffA[2], voffB[2];
#pragma unroll
    for (int i = 0; i < 2; ++i) { int R, C; stage_rc(tid * 16 + i * 8192, R, C); const int Rb = Epi::PERM ? ((R & ~31) + perm32(R & 31)) : R;
        voffA[i] = (unsigned)(R * K + C) * 2u; voffB[i] = (unsigned)(Rb * K + C) * 2u; }
    const size_t kstep = (size_t)(BK * 2);
    const size_t hstep = (size_t)HALF * K * 2;
    const size_t tstep = 2 * hstep;
    const unsigned ldsw = (unsigned)wid * 1024u;
    const int aoff = lds_byte(wr * 64 + fr, fq * 8), boff = lds_byte(wc * 32 + fr, fq * 8);
#define PG8_SA(b, h) (((b) * 2 + (h)) * HTB)
#define PG8_SB(b, h) ((4 + (b) * 2 + (h)) * HTB)
#define PG8_STAGE(bufoff, gbase, voff) do { _Pragma("unroll") for (int _i = 0; _i < 2; ++_i) \
        __builtin_amdgcn_global_load_lds((const unsigned*)((const char*)(gbase) + (voff)[_i]), (PG8_LAS unsigned*)(lds + (bufoff) + ldsw + _i * 8192), 16, 0, 0); } while (0)
#define PG8_LDA(dst, b, h) do { _Pragma("unroll") for (int m = 0; m < 4; ++m) _Pragma("unroll") for (int k = 0; k < 2; ++k) dst[m][k] = *(const PG8_LAS bf16x8*)(lds + PG8_SA(b, h) + aoff + m * 2048 + k * 1024); } while (0)
#define PG8_LDB(dst, b, h) do { _Pragma("unroll") for (int n = 0; n < 2; ++n) _Pragma("unroll") for (int k = 0; k < 2; ++k) dst[n][k] = *(const PG8_LAS bf16x8*)(lds + PG8_SB(b, h) + boff + n * 2048 + k * 1024); } while (0)
#define PG8_MMA(ai, bj, At, Bt) do { __builtin_amdgcn_s_setprio(1); _Pragma("unroll") for (int m = 0; m < 4; ++m) _Pragma("unroll") for (int n = 0; n < 2; ++n) _Pragma("unroll") for (int k = 0; k < 2; ++k) \
        acc[ai][bj][m][n] = __builtin_amdgcn_mfma_f32_16x16x32_bf16(Bt[n][k], At[m][k], acc[ai][bj][m][n], 0, 0, 0); __builtin_amdgcn_s_setprio(0); } while (0)
#define PG8_WAIT_V(n) asm volatile("s_waitcnt vmcnt(" #n ")" ::: "memory")
#define PG8_WAIT_L(n) asm volatile("s_waitcnt lgkmcnt(" #n ")" ::: "memory")
#define PG8_BAR __builtin_amdgcn_s_barrier()
#define PG8_SCHED __builtin_amdgcn_sched_barrier(0)
    Unit cur, nxt; int ui = 0;
    if (!S.next(0, cur)) return;
    f32x4 acc[2][2][4][2];
#pragma unroll
    for (int a = 0; a < 2; ++a)
#pragma unroll
        for (int b = 0; b < 2; ++b)
#pragma unroll
            for (int m = 0; m < 4; ++m)
#pragma unroll
                for (int n = 0; n < 2; ++n) acc[a][b][m][n] = (f32x4){0.f, 0.f, 0.f, 0.f};
    bf16x8 At[4][2], B0[2][2], B1[2][2];
    const char* cA = (const char*)g.A + (size_t)cur.pm * tstep; const char* cB = (const char*)g.Bt + (size_t)cur.pn * tstep;
    S.a_ready(cur);
    PG8_STAGE(PG8_SB(0, 0), cB, voffB); PG8_STAGE(PG8_SA(0, 0), cA, voffA); PG8_STAGE(PG8_SB(0, 1), cB + hstep, voffB); PG8_STAGE(PG8_SA(0, 1), cA + hstep, voffA);
    if (wr == 1) PG8_BAR;
    PG8_WAIT_V(4); PG8_BAR;
    PG8_STAGE(PG8_SB(1, 0), cB + kstep, voffB); PG8_STAGE(PG8_SA(1, 0), cA + kstep, voffA); PG8_STAGE(PG8_SB(1, 1), cB + hstep + kstep, voffB);
    PG8_WAIT_V(6); PG8_BAR;
    PG8_STAMP();
    for (;;) {
        const bool has_next = S.next(ui + 1, nxt);
        const char* nA = has_next ? (const char*)g.A + (size_t)nxt.pm * tstep : cA; const char* nB = has_next ? (const char*)g.Bt + (size_t)nxt.pn * tstep : cB;
        for (int t = 0; t < nt; t += 2) {
            const bool last = (t == nt - 2);
            const char* a1 = cA + (size_t)(t + 1) * kstep;
            const char* a2 = last ? nA : cA + (size_t)(t + 2) * kstep; const char* b2 = last ? nB : cB + (size_t)(t + 2) * kstep;
            const char* a3 = a2 + kstep; const char* b3 = b2 + kstep;
            if (last && has_next) S.a_ready(nxt);
            PG8_LDB(B0, 0, 0); PG8_SCHED; PG8_LDA(At, 0, 0); PG8_STAGE(PG8_SA(1, 1), a1 + hstep, voffA);
            PG8_WAIT_L(8); PG8_BAR; PG8_WAIT_L(0); PG8_MMA(0, 0, At, B0); PG8_BAR; PG8_SCHED;
            PG8_LDB(B1, 0, 1); PG8_STAGE(PG8_SB(0, 0), b2, voffB);
            PG8_BAR; PG8_WAIT_L(0); PG8_MMA(0, 1, At, B1); PG8_BAR;
            PG8_LDA(At, 0, 1); PG8_STAGE(PG8_SA(0, 0), a2, voffA);
            PG8_BAR; PG8_WAIT_L(0); PG8_MMA(1, 0, At, B0); PG8_BAR; PG8_SCHED;
            PG8_STAGE(PG8_SB(0, 1), b2 + hstep, voffB);
            PG8_WAIT_V(6); PG8_BAR; PG8_MMA(1, 1, At, B1); PG8_BAR;
            PG8_LDB(B0, 1, 0); PG8_SCHED; PG8_LDA(At, 1, 0); PG8_STAGE(PG8_SA(0, 1), a2 + hstep, voffA);
            PG8_WAIT_L(8); PG8_BAR; PG8_WAIT_L(0); PG8_MMA(0, 0, At, B0); PG8_BAR; PG8_SCHED;
            PG8_LDB(B1, 1, 1); PG8_STAGE(PG8_SB(1, 0), b3, voffB);
            PG8_BAR; PG8_WAIT_L(0); PG8_MMA(0, 1, At, B1); PG8_BAR;
            PG8_LDA(At, 1, 1); PG8_STAGE(PG8_SA(1, 0), a3, voffA);
            PG8_BAR; PG8_WAIT_L(0); PG8_MMA(1, 0, At, B0); PG8_BAR; PG8_SCHED;
            PG8_STAGE(PG8_SB(1, 1), b3 + hstep, voffB);
            PG8_WAIT_V(6); PG8_BAR; PG8_MMA(1, 1, At, B1); PG8_BAR;
        }
        PG8_STAMP();
        if constexpr (!Epi::AFTER_DRAIN) { E(acc, cur, wr, wc, fr, fq); S.done(cur); }
        PG8_STAMP();
        if (!has_next) break;
#pragma unroll
        for (int a = 0; a < 2; ++a)
#pragma unroll
            for (int b = 0; b < 2; ++b)
#pragma unroll
                for (int m = 0; m < 4; ++m)
#pragma unroll
                    for (int n = 0; n < 2; ++n) acc[a][b][m][n] = (f32x4){0.f, 0.f, 0.f, 0.f};
        cur = nxt; cA = nA; cB = nB; ++ui;
    }
    PG8_WAIT_V(0);
    if (wr == 0) PG8_BAR;
    PG8_BAR;
    if constexpr (Epi::AFTER_DRAIN) { E.fused(acc, cur, wr, wc, fr, fq, lds, wid, lane); S.done(cur); }
    PG8_STAMP();
    if (STAMP && wid == 0) { stamps[lane] = lane < nts ? (((unsigned long long)(unsigned)ts_hi << 32) | (unsigned)ts_lo) : 0ull;
        if (lane == 62) stamps[62] = rt_entry; if (lane == 63) stamps[63] = (unsigned long long)0ull; }
#undef PG8_STAMP
#undef PG8_SA
#undef PG8_SB
#undef PG8_STAGE
#undef PG8_LDA
#undef PG8_LDB
#undef PG8_MMA
#undef PG8_WAIT_V
#undef PG8_WAIT_L
#undef PG8_BAR
#undef PG8_SCHED
}
}

namespace {
constexpr int D = 1024, BATCH = 2, SEQ = 8192, T = BATCH * SEQ;
constexpr int PW = 2312;
constexpr int PS = 2304;
constexpr int OQ = 0, OKK = 512, OV = 640, OZ = 768, OXBC = 1280, ODT = 2304;
constexpr float EPS = 1e-6f;
constexpr int NTHR = 512;
typedef unsigned short bf16;
typedef unsigned v4u __attribute__((ext_vector_type(4)));

constexpr size_t MiB = 1u << 20;
constexpr size_t WS_WIN = 1 * MiB;
constexpr size_t WS_KH = 5 * MiB + 512 * 1024;
constexpr size_t WS_WO = 6 * MiB;
constexpr size_t WS_WQ = 8 * MiB;
constexpr size_t WS_PROJ = 10 * MiB;
constexpr size_t WS_XNB = 82 * MiB;
constexpr size_t WS_XACT = 114 * MiB;
constexpr size_t WS_DTRAW = 146 * MiB;
constexpr size_t WS_DT = WS_DTRAW + 512 * 1024;
constexpr size_t WS_ACS = WS_DT + 512 * 1024;
constexpr size_t WS_CDEC = WS_ACS + 512 * 1024;
constexpr size_t WS_STATES = 164 * MiB;
constexpr size_t WS_PREV = 196 * MiB;
constexpr size_t WS_QP = 10 * MiB;
constexpr size_t WS_IDX = 74 * MiB;
constexpr size_t WS_GATE = 114 * MiB;
constexpr size_t WS_TOPV = 122 * MiB;
constexpr size_t WS_TOPI = 138 * MiB;
constexpr size_t WS_ACT = 122 * MiB;
constexpr size_t WS_SU = 245 * MiB;
constexpr size_t WS_U8 = 212 * MiB;
constexpr size_t WS_V8 = 148 * MiB;
constexpr size_t WS_PART = 10 * MiB;
constexpr size_t WS_XQ = 228 * MiB;
constexpr size_t WS_XS = 244 * MiB;
constexpr size_t WS_PEERO = 10 * MiB;
constexpr size_t WS_END = 246 * MiB;
constexpr int CW_QU = 4096, CW_QV = 4096 + 64 * 16;
constexpr int NPART = 8, NCHUNK = T / 64;

struct Args {
    const float* x; const float* norm_mix_g; const float* w_in; const float* attn_sinks; const float* attn_out_g;
    const float* conv_w; const float* conv_b; const float* dt_bias; const float* a_log; const float* d_skip;
    const float* ssm_norm_g; const float* w_out; const float* norm_ffn_g; const float* peer_wq; const float* peer_sub_keys;
    const float* peer_u; const float* peer_v; const float* final_norm_g;
    float* out; unsigned char* ws;
    int ph_lo, ph_hi;
};

#define LAS __attribute__((address_space(3)))
#define LDS_WAIT() asm volatile("s_waitcnt lgkmcnt(0)" ::: "memory")
__device__ __forceinline__ float bf2f(bf16 v) { return __uint_as_float(((unsigned)v) << 16); }
__device__ __forceinline__ unsigned f2bfu(float f) { unsigned u = __float_as_uint(f); return (u + 0x7fffu + ((u >> 16) & 1u)) >> 16; }
__device__ __forceinline__ bf16 f2bf(float f) { return (bf16)f2bfu(f); }
__device__ __forceinline__ unsigned pk2(float lo, float hi) { return f2bfu(lo) | (f2bfu(hi) << 16); }
__device__ __forceinline__ float wave_sum(float v) {
#pragma unroll
    for (int o = 1; o < 64; o <<= 1) v += __shfl_xor(v, o);
    return v;
}
__device__ __forceinline__ float silu_f(float v) { return v / (1.f + __expf(-v)); }

__device__ __forceinline__ void transpose_item(const float* W, int ldw, int K, bf16* WT, LAS float* scr, int kb, int nbk, int lane) {
    const int k0 = 64 * kb, n0 = 32 * nbk;
#pragma unroll 8
    for (int i = 0; i < 32; ++i) { const int kk = 2 * i + (lane >> 5); scr[kk * 33 + (lane & 31)] = W[(size_t)(k0 + kk) * ldw + n0 + (lane & 31)]; }
    LDS_WAIT();
    const int c = lane & 7;
#pragma unroll
    for (int j = 0; j < 4; ++j) { const int n = (lane >> 3) + 8 * j; const LAS float* s = scr + (8 * c) * 33 + n;
        v4u o; o.x = pk2(s[0 * 33], s[1 * 33]); o.y = pk2(s[2 * 33], s[3 * 33]); o.z = pk2(s[4 * 33], s[5 * 33]); o.w = pk2(s[6 * 33], s[7 * 33]);
        *(v4u*)(WT + (size_t)(n0 + n) * K + k0 + 8 * c) = o; }
    LDS_WAIT();
}

template <int MODE  >
__device__ __forceinline__ void rmsnorm_rows_bf16(const float* in, const float* g, bf16* outp, const LAS unsigned char* ldsb, float* dtraw, unsigned char* xq, float* xs, int gwave, int nwaves, int lane) {
    for (int row = gwave; row < T; row += nwaves) {
        const float4* xr = (const float4*)(in + (size_t)row * D) + lane;
        float4 v[4]; float ss = 0.f;
#pragma unroll
        for (int j = 0; j < 4; ++j) { v[j] = xr[64 * j]; ss += v[j].x * v[j].x + v[j].y * v[j].y + v[j].z * v[j].z + v[j].w * v[j].w; }
        ss = wave_sum(ss);
        const float r = rsqrtf(ss * (1.f / D) + EPS);
        unsigned long long* o8 = (unsigned long long*)(outp + (size_t)row * D) + lane;
        float dacc[8]; float y[4][4]; float mx = 0.f;
#pragma unroll
        for (int h = 0; h < 8; ++h) dacc[h] = 0.f;
#pragma unroll
        for (int j = 0; j < 4; ++j) {
            const float4 gv = ((const float4*)g)[lane + 64 * j];
            y[j][0] = v[j].x * r * gv.x; y[j][1] = v[j].y * r * gv.y; y[j][2] = v[j].z * r * gv.z; y[j][3] = v[j].w * r * gv.w;
            o8[64 * j] = (unsigned long long)pk2(y[j][0], y[j][1]) | ((unsigned long long)pk2(y[j][2], y[j][3]) << 32);
            if (MODE == 2) mx = fmaxf(mx, fmaxf(fmaxf(fabsf(y[j][0]), fabsf(y[j][1])), fmaxf(fabsf(y[j][2]), fabsf(y[j][3]))));
            if (MODE == 1) {
#pragma unroll
                for (int h = 0; h < 8; ++h) {
                    typedef float f4v __attribute__((ext_vector_type(4)));
                    const f4v wv = *(const LAS f4v*)(ldsb + h * 16384 + 8448 + (256 * j + 4 * lane) * 4);
                    dacc[h] += y[j][0] * wv.x + y[j][1] * wv.y + y[j][2] * wv.z + y[j][3] * wv.w;
                }
            }
        }
        if (MODE == 1) {
#pragma unroll
            for (int h = 0; h < 8; ++h) dacc[h] = wave_sum(dacc[h]);
            if (lane == 0) { float4* dp = (float4*)(dtraw + (size_t)row * 8); dp[0] = make_float4(dacc[0], dacc[1], dacc[2], dacc[3]); dp[1] = make_float4(dacc[4], dacc[5], dacc[6], dacc[7]); }
        }
        if (MODE == 2) {
#pragma unroll
            for (int o = 1; o < 64; o <<= 1) mx = fmaxf(mx, __shfl_xor(mx, o));
            const float sc = mx > 0.f ? mx * (1.f / 127.f) : 1.f, inv = 1.f / sc;
            unsigned* dq = (unsigned*)(xq + (size_t)row * D) + lane;
#pragma unroll
            for (int j = 0; j < 4; ++j) { const int q0 = (int)rintf(y[j][0] * inv), q1 = (int)rintf(y[j][1] * inv), q2 = (int)rintf(y[j][2] * inv), q3 = (int)rintf(y[j][3] * inv);
                dq[64 * j] = (unsigned)(q0 & 255) | ((unsigned)(q1 & 255) << 8) | ((unsigned)(q2 & 255) << 16) | ((unsigned)(q3 & 255) << 24); }
            if (lane == 0) xs[row] = sc;
        }
    }
}

typedef short bf16x8 __attribute__((ext_vector_type(8)));
typedef short bf16x4 __attribute__((ext_vector_type(4)));
typedef float f32x16 __attribute__((ext_vector_type(16)));
typedef __bf16 bf2_t __attribute__((ext_vector_type(2)));
#define MFMA32(a, b, c) __builtin_amdgcn_mfma_f32_32x32x16_bf16((a), (b), (c), 0, 0, 0)
__device__ __forceinline__ unsigned pkbf(float lo, float hi) { bf2_t v = {(__bf16)lo, (__bf16)hi}; return __builtin_bit_cast(unsigned, v); }
__device__ __forceinline__ short bfs(float f) { return __builtin_bit_cast(short, (__bf16)f); }
__device__ __forceinline__ float sbf2f(short v) { return __uint_as_float(((unsigned)(unsigned short)v) << 16); }
__device__ __forceinline__ int crow(int i, int hi) { return (i & 3) + 8 * (i >> 2) + 4 * hi; }
template <int S> __device__ __forceinline__ bf16x8 pack8(const f32x16& x) {
    v4u p; p.x = pkbf(x[8 * S], x[8 * S + 1]); p.y = pkbf(x[8 * S + 2], x[8 * S + 3]); p.z = pkbf(x[8 * S + 4], x[8 * S + 5]); p.w = pkbf(x[8 * S + 6], x[8 * S + 7]);
    return __builtin_bit_cast(bf16x8, p);
}
__device__ __forceinline__ bf16x8 ldg8(const bf16* p) { return *(const bf16x8*)p; }
__device__ __forceinline__ bf16x8 lds8(const LAS bf16* p) { return *(const LAS bf16x8*)p; }
__device__ __forceinline__ bf16x8 lds4x2(const LAS bf16* p) { const bf16x4 a = *(const LAS bf16x4*)p, b = *(const LAS bf16x4*)(p + 8); return __builtin_shufflevector(a, b, 0, 1, 2, 3, 4, 5, 6, 7); }
__device__ __forceinline__ f32x16 zero16() { f32x16 z;
#pragma unroll
    for (int i = 0; i < 16; ++i) z[i] = 0.f;
    return z; }

__device__ __forceinline__ void attn_unit(const float* sinks, const float* gnorm, LAS unsigned char* ldsb, int unit, const bf16* PROJ, bf16* MIXB, int tid, int lane, int wave) {
    asm volatile("" : "+v"(tid), "+v"(lane));
    const int tok0 = unit * 64, s0 = tok0 & (SEQ - 1), kbase = tok0 - 128;
    LAS bf16* VT = (LAS bf16*)ldsb;
    const __amdgpu_buffer_rsrc_t rsP = __builtin_amdgcn_make_buffer_rsrc((void*)PROJ, 0, (unsigned)T * PS * 2u, 0x00020000);
    LAS float* SSQ = (LAS float*)(ldsb + 51200);
    LAS unsigned* OST = (LAS unsigned*)(ldsb + 53248) + wave * (2 * 17 * 64);
#pragma unroll
    for (int i = 0; i < 6; ++i) {
        const int c = tid + 512 * i, kv = c / 1536, cc = c - kv * 1536, key = cc >> 3, d0 = (cc & 7) * 8; const bool valid = (s0 - 128 + key) >= 0;
        bf16x8 v;
#pragma unroll
        for (int e = 0; e < 8; ++e) v[e] = 0;
        if (valid) v = __builtin_bit_cast(bf16x8, __builtin_amdgcn_raw_buffer_load_b128(rsP, (int)(((unsigned)(kbase + key) * (unsigned)PS + (unsigned)(OV + kv * 64 + d0)) * 2u), 0, 0));
#pragma unroll
        for (int e = 0; e < 8; ++e) VT[kv * 12800 + (d0 + e) * 200 + key] = (bf16)v[e];
    }
    __syncthreads();
    const int r = lane & 31, hi = lane >> 5;
    const int hq = wave, hkv = wave >> 2;
    const float slope = exp2f(-(float)(hq + 1)), sink = sinks[hq];
#pragma unroll 1
    for (int qt = 0; qt < 2; ++qt) {
        const int tq = tok0 + 32 * qt + r;
        bf16x8 qf[4];
        { const bf16* qp = PROJ + (size_t)tq * PS + OQ + hq * 64 + 8 * hi; asm volatile("" : "+v"(qp));
#pragma unroll
          for (int ks = 0; ks < 4; ++ks) qf[ks] = ldg8(qp + 16 * ks); }
        const int ql = 32 * qt + r;
        float m = sink, lh = 0.f;
        f32x16 O0 = zero16(), O1 = zero16();
        bf16x8 kfn[4];
        { const int key = 32 * qt + r; const bool kvalid = (s0 - 128 + key) >= 0;
          const bf16* kp = PROJ + (size_t)(kvalid ? (kbase + key) : tok0) * PS + OKK + hkv * 64 + 8 * hi; asm volatile("" : "+v"(kp));
#pragma unroll
          for (int ks = 0; ks < 4; ++ks) kfn[ks] = ldg8(kp + 16 * ks); }
#pragma unroll 1
        for (int kt = 0; kt < 5; ++kt) {
            bf16x8 kf[4];
#pragma unroll
            for (int ks = 0; ks < 4; ++ks) kf[ks] = kfn[ks];
            { const int ktn = kt < 4 ? kt + 1 : 4; const int key = 32 * (qt + ktn) + r; const bool kvalid = (s0 - 128 + key) >= 0;
              const bf16* kp = PROJ + (size_t)(kvalid ? (kbase + key) : tok0) * PS + OKK + hkv * 64 + 8 * hi; asm volatile("" : "+v"(kp));
#pragma unroll
              for (int ks = 0; ks < 4; ++ks) kfn[ks] = ldg8(kp + 16 * ks); }
            f32x16 X = zero16();
#pragma unroll
            for (int ks = 0; ks < 4; ++ks) X = MFMA32(kf[ks], qf[ks], X);
            float tm = -1e30f;
#pragma unroll
            for (int i = 0; i < 16; ++i) {
                const int kl = 32 * (qt + kt) + crow(i, hi), dist = 128 + ql - kl;
                const bool valid = (dist >= 0) && (dist < 128) && ((s0 - 128 + kl) >= 0);
                const float lg = valid ? (X[i] * 0.125f - slope * (float)dist) : -1e30f;
                X[i] = lg; tm = fmaxf(tm, lg);
            }
            tm = fmaxf(tm, __shfl_xor(tm, 32));
            const float mn = fmaxf(m, tm), sc = __expf(m - mn);
            m = mn; lh *= sc;
#pragma unroll
            for (int i = 0; i < 16; ++i) { O0[i] *= sc; O1[i] *= sc; const float pe = __expf(X[i] - mn); X[i] = pe; lh += pe; }
            const LAS bf16* vp = VT + hkv * 12800 + r * 200 + 32 * (qt + kt) + 4 * hi;
            { const bf16x8 xs = pack8<0>(X); const bf16x8 a0 = lds4x2(vp), a1 = lds4x2(vp + 32 * 200); O0 = MFMA32(a0, xs, O0); O1 = MFMA32(a1, xs, O1); }
            { const bf16x8 xs = pack8<1>(X); const bf16x8 a0 = lds4x2(vp + 16), a1 = lds4x2(vp + 32 * 200 + 16); O0 = MFMA32(a0, xs, O0); O1 = MFMA32(a1, xs, O1); }
        }
        const float lsum = lh + __shfl_xor(lh, 32) + __expf(sink - m);
        const float iv = 1.f / lsum;
        float sq = 0.f;
#pragma unroll
        for (int i = 0; i < 16; ++i) sq += O0[i] * O0[i] + O1[i] * O1[i];
        sq *= iv * iv; sq += __shfl_xor(sq, 32);
        if (hi == 0) SSQ[hq * 64 + 32 * qt + r] = sq;
#pragma unroll
        for (int i = 0; i < 8; ++i) { OST[(qt * 17 + i) * 64 + lane] = pkbf(O0[2 * i], O0[2 * i + 1]); OST[(qt * 17 + 8 + i) * 64 + lane] = pkbf(O1[2 * i], O1[2 * i + 1]); }
        OST[(qt * 17 + 16) * 64 + lane] = __float_as_uint(iv);
    }
    __syncthreads();
#pragma unroll 1
    for (int qt = 0; qt < 2; ++qt) {
        float tot = 0.f;
#pragma unroll
        for (int h = 0; h < 8; ++h) tot += SSQ[h * 64 + 32 * qt + r];
        const float sc = __uint_as_float(OST[(qt * 17 + 16) * 64 + lane]) * rsqrtf(tot * (1.f / 512.f) + EPS);
        bf16* orow = MIXB + (size_t)(tok0 + 32 * qt + r) * D + hq * 64 + 4 * hi;
#pragma unroll
        for (int dt = 0; dt < 2; ++dt)
#pragma unroll
            for (int q4 = 0; q4 < 4; ++q4) {
                const float4 gv = *(const float4*)(gnorm + hq * 64 + 32 * dt + 8 * q4 + 4 * hi);
                const unsigned p0 = OST[(qt * 17 + 8 * dt + 2 * q4) * 64 + lane], p1 = OST[(qt * 17 + 8 * dt + 2 * q4 + 1) * 64 + lane];
                uint2 w; w.x = pkbf(__uint_as_float(p0 << 16) * sc * gv.x, __uint_as_float(p0 & 0xffff0000u) * sc * gv.y); w.y = pkbf(__uint_as_float(p1 << 16) * sc * gv.z, __uint_as_float(p1 & 0xffff0000u) * sc * gv.w);
                *(uint2*)(orow + 32 * dt + 8 * q4) = w;
            }
    }
    __syncthreads();
}

__device__ __forceinline__ void ssd_chunk_unit(LAS unsigned char* ldsb, int unit, const bf16* XACT, const float* DT, const float* ACS, float* MIXF, float* STATES, int tid, int lane, int wave) {
    asm volatile("" : "+v"(tid), "+v"(lane));
    const int g = unit & 1, bc = unit >> 1, tok0 = bc * 128;
    LAS bf16* BT = (LAS bf16*)ldsb;
    LAS bf16* XD = (LAS bf16*)(ldsb + 34816);
    LAS bf16* XW = (LAS bf16*)(ldsb + 34816 + 34816);
    LAS float* ACST = (LAS float*)(ldsb + 34816 * 3);
    const int r = lane & 31, hi = lane >> 5;
#pragma unroll
    for (int i = 0; i < 4; ++i) {
        const int c = tid + 512 * i, s = c >> 4, n0 = (c & 15) * 8;
        const bf16x8 v = ldg8(XACT + (size_t)(tok0 + s) * 1024 + 512 + g * 128 + n0);
#pragma unroll
        for (int e = 0; e < 8; ++e) BT[(n0 + e) * 136 + s] = (bf16)v[e];
    }
    ACST[tid] = ACS[(size_t)(tok0 + (tid >> 2)) * 8 + g * 4 + (tid & 3)];
#pragma unroll 1
    for (int hp = 0; hp < 2; ++hp) {
        if (hp) __syncthreads();
        int tidp = tid; asm volatile("" : "+v"(tidp));
#pragma unroll
        for (int i = 0; i < 4; ++i) {
            const int c = tidp + 512 * i, hsel = c >> 10, s = (c >> 3) & 127, p0 = (c & 7) * 8, H = g * 4 + 2 * hp + hsel;
            const bf16x8 v = ldg8(XACT + (size_t)(tok0 + s) * 1024 + H * 64 + p0);
            const float dtv = DT[(size_t)(tok0 + s) * 8 + H];
            const float w = __expf(ACS[(size_t)(tok0 + 127) * 8 + H] - ACS[(size_t)(tok0 + s) * 8 + H]);
#pragma unroll
            for (int e = 0; e < 8; ++e) { const float xd = sbf2f(v[e]) * dtv; XD[hsel * 8704 + (p0 + e) * 136 + s] = (bf16)bfs(xd); XW[hsel * 8704 + (p0 + e) * 136 + s] = (bf16)bfs(xd * w); }
        }
        __syncthreads();
        {
            const int lt = wave & 3, hsel = wave >> 2, hh = 2 * hp + hsel, H = g * 4 + hh;
            const int l = 32 * lt + r; const float acs_l = ACST[l * 4 + hh];
            bf16x8 cf[8];
            { const bf16* cp = XACT + (size_t)(tok0 + l) * 1024 + 768 + g * 128 + 8 * hi; asm volatile("" : "+v"(cp));
#pragma unroll
              for (int ks = 0; ks < 8; ++ks) cf[ks] = ldg8(cp + 16 * ks); }
            f32x16 Z0 = zero16(), Z1 = zero16();
            bf16x8 bn[8];
            { const bf16* bp = XACT + (size_t)(tok0 + r) * 1024 + 512 + g * 128 + 8 * hi; asm volatile("" : "+v"(bp));
#pragma unroll
              for (int ks = 0; ks < 8; ++ks) bn[ks] = ldg8(bp + 16 * ks); }
#pragma unroll 1
            for (int st = 0; st <= lt; ++st) {
                f32x16 X = zero16();
                bf16x8 bc[8];
#pragma unroll
                for (int ks = 0; ks < 8; ++ks) bc[ks] = bn[ks];
                { const int stn = st < lt ? st + 1 : lt; const bf16* bp = XACT + (size_t)(tok0 + 32 * stn + r) * 1024 + 512 + g * 128 + 8 * hi; asm volatile("" : "+v"(bp));
#pragma unroll
                  for (int ks = 0; ks < 8; ++ks) bn[ks] = ldg8(bp + 16 * ks); }
#pragma unroll
                for (int ks = 0; ks < 8; ++ks) X = MFMA32(bc[ks], cf[ks], X);
#pragma unroll
                for (int i = 0; i < 16; ++i) { const int s = 32 * st + crow(i, hi); const float f = (s <= l) ? __expf(acs_l - ACST[s * 4 + hh]) : 0.f; X[i] *= f; }
                const int sb = 32 * st + 4 * hi;
                { const bf16x8 xs = pack8<0>(X); const bf16x8 b0 = lds4x2(XD + hsel * 8704 + r * 136 + sb), b1 = lds4x2(XD + hsel * 8704 + (32 + r) * 136 + sb); Z0 = MFMA32(xs, b0, Z0); Z1 = MFMA32(xs, b1, Z1); }
                { const bf16x8 xs = pack8<1>(X); const bf16x8 b0 = lds4x2(XD + hsel * 8704 + r * 136 + sb + 16), b1 = lds4x2(XD + hsel * 8704 + (32 + r) * 136 + sb + 16); Z0 = MFMA32(xs, b0, Z0); Z1 = MFMA32(xs, b1, Z1); }
            }
#pragma unroll
            for (int i = 0; i < 16; ++i) { float* o = MIXF + (size_t)(tok0 + 32 * lt + crow(i, hi)) * D + 512 + H * 64 + r; o[0] = Z0[i]; o[32] = Z1[i]; }
        }
        {
            const int nt = wave & 3, hsel = wave >> 2, H = g * 4 + 2 * hp + hsel;
            f32x16 S0 = zero16(), S1 = zero16();
#pragma unroll
            for (int ks = 0; ks < 8; ++ks) {
                const bf16x8 btf = lds8(BT + (32 * nt + r) * 136 + 16 * ks + 8 * hi);
                const bf16x8 a0 = lds8(XW + hsel * 8704 + r * 136 + 16 * ks + 8 * hi), a1 = lds8(XW + hsel * 8704 + (32 + r) * 136 + 16 * ks + 8 * hi);
                S0 = MFMA32(a0, btf, S0); S1 = MFMA32(a1, btf, S1);
            }
            float* sp = STATES + (size_t)(bc * 8 + H) * 8192 + 32 * nt + r;
#pragma unroll
            for (int i = 0; i < 16; ++i) { const int p = crow(i, hi); sp[p * 128] = S0[i]; sp[(32 + p) * 128] = S1[i]; }
        }
    }
    __syncthreads();
}

__device__ __forceinline__ __amdgpu_buffer_rsrc_t mk_rsrc(const void* p, unsigned bytes) { return __builtin_amdgcn_make_buffer_rsrc((void*)p, 0, bytes, 0x00020000); }
__device__ __forceinline__ void yoff_unit(const float* d_skip, const float* gnorm, LAS unsigned char* ldsb, int unit, const bf16* XACT, const bf16* PROJ, const float* ACS, const bf16* PREVT,
                                          const float* MIXF, bf16* MIXB, int lane, int wave) {
    const int g = unit & 1, bc = unit >> 1, tok0 = bc * 128;
    const int r = lane & 31, hi = lane >> 5, lt = wave & 3, hpair = wave >> 2;
    LAS float* TAB = (LAS float*)ldsb;
    const __amdgpu_buffer_rsrc_t rsF = mk_rsrc(MIXF, (unsigned)T * D * 4u), rsX = mk_rsrc(XACT, (unsigned)T * 1024u * 2u), rsP = mk_rsrc(PROJ, (unsigned)T * PS * 2u), rsA = mk_rsrc(ACS, (unsigned)T * 32u), rsB = mk_rsrc(MIXB, (unsigned)T * D * 2u);
    const unsigned tb = (unsigned)(tok0 + 32 * lt + 4 * hi);
    bf16x8 cf[8];
    { const bf16* cp = XACT + (size_t)(tok0 + 32 * lt + r) * 1024 + 768 + g * 128 + 8 * hi; asm volatile("" : "+v"(cp));
#pragma unroll
      for (int ks = 0; ks < 8; ++ks) cf[ks] = ldg8(cp + 16 * ks); }
    float eav[16], ssq[16];
    unsigned ypk[2][2][8];
#pragma unroll
    for (int i = 0; i < 16; ++i) ssq[i] = 0.f;
#pragma unroll
    for (int hsel = 0; hsel < 2; ++hsel) {
        const int H = g * 4 + 2 * hpair + hsel; const bf16* pv = PREVT + (size_t)(bc * 8 + H) * 8192 + 8 * hi;
        asm volatile("" : "+v"(pv));
        f32x16 Y0 = zero16(), Y1 = zero16();
#pragma unroll
        for (int ks = 0; ks < 8; ++ks) {
            const bf16x8 b0 = ldg8(pv + r * 128 + 16 * ks), b1 = ldg8(pv + (32 + r) * 128 + 16 * ks);
            Y0 = MFMA32(cf[ks], b0, Y0); Y1 = MFMA32(cf[ks], b1, Y1);
        }
        const float dsk = d_skip[H];
        { const unsigned vo = (tb * 8u + (unsigned)H) * 4u;
#pragma unroll
          for (int i = 0; i < 16; ++i) eav[i] = __expf(__builtin_bit_cast(float, __builtin_amdgcn_raw_buffer_load_b32(rsA, (int)vo, ((i & 3) + 8 * (i >> 2)) * 32, 0))); }
#pragma unroll
        for (int pt = 0; pt < 2; ++pt) {
            const unsigned col = (unsigned)(H * 64 + 32 * pt + r);
            const unsigned voF = (tb * 1024u + 512u + col) * 4u, voX = (tb * 1024u + col) * 2u, voP = (tb * (unsigned)PS + (unsigned)OZ + col) * 2u;
            float yo[16], xsv[16], zv[16];
#pragma unroll
            for (int i = 0; i < 16; ++i) { const int ro = (i & 3) + 8 * (i >> 2);
                yo[i] = __builtin_bit_cast(float, __builtin_amdgcn_raw_buffer_load_b32(rsF, (int)voF, ro * 4096, 0));
                xsv[i] = bf2f((bf16)__builtin_amdgcn_raw_buffer_load_b16(rsX, (int)voX, ro * 2048, 0));
                zv[i] = bf2f((bf16)__builtin_amdgcn_raw_buffer_load_b16(rsP, (int)voP, ro * (PS * 2), 0)); }
#pragma unroll
            for (int i = 0; i < 16; i += 2) {
                const float y0 = (yo[i] + eav[i] * (pt ? Y1[i] : Y0[i]) + dsk * xsv[i]) * silu_f(zv[i]);
                const float y1 = (yo[i + 1] + eav[i + 1] * (pt ? Y1[i + 1] : Y0[i + 1]) + dsk * xsv[i + 1]) * silu_f(zv[i + 1]);
                ssq[i] += y0 * y0; ssq[i + 1] += y1 * y1; ypk[hsel][pt][i >> 1] = pkbf(y0, y1);
            }
            __builtin_amdgcn_sched_barrier(0);
        }
    }
#pragma unroll
    for (int i = 0; i < 16; ++i) {
#pragma unroll
        for (int o = 1; o < 32; o <<= 1) ssq[i] += __shfl_xor(ssq[i], o);
    }
    if (r == 0) {
#pragma unroll
        for (int i = 0; i < 16; ++i) TAB[hpair * 128 + 32 * lt + crow(i, hi)] = ssq[i];
    }
    __syncthreads();
#pragma unroll
    for (int i = 0; i < 16; ++i) { const int l = 32 * lt + crow(i, hi); ssq[i] = rsqrtf((TAB[l] + TAB[128 + l]) * (1.f / 256.f) + EPS); }
#pragma unroll
    for (int hsel = 0; hsel < 2; ++hsel)
#pragma unroll
        for (int pt = 0; pt < 2; ++pt) {
            const unsigned col = (unsigned)((g * 4 + 2 * hpair + hsel) * 64 + 32 * pt + r); const float gn = gnorm[col];
            const unsigned voB = (tb * 1024u + 512u + col) * 2u;
#pragma unroll
            for (int i = 0; i < 16; ++i) { const unsigned w = ypk[hsel][pt][i >> 1];
                const float yf = (i & 1) ? __uint_as_float(w & 0xffff0000u) : __uint_as_float(w << 16);
                __builtin_amdgcn_raw_buffer_store_b16((short)f2bf(yf * ssq[i] * gn), rsB, (int)voB, ((i & 3) + 8 * (i >> 2)) * 2048, 0); }
        }
    __syncthreads();
}
typedef float f32x2 __attribute__((ext_vector_type(2)));
__device__ __forceinline__ void fp8x16_to_f32(const uint4 w, float (&f)[16]) {
    const int ww[4] = {(int)w.x, (int)w.y, (int)w.z, (int)w.w};
#pragma unroll
    for (int q = 0; q < 4; ++q) { const f32x2 a = __builtin_amdgcn_cvt_pk_f32_fp8(ww[q], false), b = __builtin_amdgcn_cvt_pk_f32_fp8(ww[q], true); f[4 * q] = a.x; f[4 * q + 1] = a.y; f[4 * q + 2] = b.x; f[4 * q + 3] = b.y; }
}
template <int M4, int M2, int M1> __device__ __forceinline__ void treduce16(const float (&a)[16], int lane, float& r0, float& r1) {
    float b[8], c[4];
    { const bool hi = (lane & M4) != 0;
#pragma unroll
      for (int i = 0; i < 8; ++i) { const float send = hi ? a[i] : a[i + 8]; const float recv = __shfl_xor(send, M4); b[i] = (hi ? a[i + 8] : a[i]) + recv; } }
    { const bool hi = (lane & M2) != 0;
#pragma unroll
      for (int i = 0; i < 4; ++i) { const float send = hi ? b[i] : b[i + 4]; const float recv = __shfl_xor(send, M2); c[i] = (hi ? b[i + 4] : b[i]) + recv; } }
    { const bool hi = (lane & M1) != 0;
      { const float send = hi ? c[0] : c[2]; const float recv = __shfl_xor(send, M1); r0 = (hi ? c[2] : c[0]) + recv; }
      { const float send = hi ? c[1] : c[3]; const float recv = __shfl_xor(send, M1); r1 = (hi ? c[3] : c[1]) + recv; } }
}
template <int M4, int M2, int M1> __device__ __forceinline__ void treduce16i(const int (&a)[16], int lane, int& r0, int& r1) {
    int b[8], c[4];
    { const bool hi = (lane & M4) != 0;
#pragma unroll
      for (int i = 0; i < 8; ++i) { const int send = hi ? a[i] : a[i + 8]; const int recv = __shfl_xor(send, M4); b[i] = (hi ? a[i + 8] : a[i]) + recv; } }
    { const bool hi = (lane & M2) != 0;
#pragma unroll
      for (int i = 0; i < 4; ++i) { const int send = hi ? b[i] : b[i + 4]; const int recv = __shfl_xor(send, M2); c[i] = (hi ? b[i + 4] : b[i]) + recv; } }
    { const bool hi = (lane & M1) != 0;
      { const int send = hi ? c[0] : c[2]; const int recv = __shfl_xor(send, M1); r0 = (hi ? c[2] : c[0]) + recv; }
      { const int send = hi ? c[1] : c[3]; const int recv = __shfl_xor(send, M1); r1 = (hi ? c[3] : c[1]) + recv; } }
}
#define PE_ID(E, i) (((i) & 1) ? (E[(i) >> 1] >> 16) : (E[(i) >> 1] & 0xffffu))
__device__ __forceinline__ void peer_u_item(int p, int j, const unsigned short* __restrict__ IDX, const unsigned char* __restrict__ XQ, const unsigned char* __restrict__ U8, int* __restrict__ PART, int lane, int wave) {
    asm volatile("" : "+v"(lane));
    const int gidx = lane >> 3; const unsigned coff = (unsigned)(p * 128 + (lane & 7) * 16);
#pragma unroll 1
    for (int it = 0; it < 8; ++it) {
        const int t = j * 64 + it * 8 + wave;
        unsigned E[8];
        { const uint4 e0 = *(const uint4*)(IDX + (size_t)t * 128 + 16 * gidx), e1 = *(const uint4*)(IDX + (size_t)t * 128 + 16 * gidx + 8);
          E[0] = e0.x; E[1] = e0.y; E[2] = e0.z; E[3] = e0.w; E[4] = e1.x; E[5] = e1.y; E[6] = e1.z; E[7] = e1.w; }
        uint4 uu[16];
#pragma unroll
        for (int i = 0; i < 16; ++i) uu[i] = *(const uint4*)(U8 + (size_t)(PE_ID(E, i) * 1024u + coff));
        const uint4 xq = *(const uint4*)(XQ + (size_t)t * D + coff);
        int d[16];
#pragma unroll
        for (int i = 0; i < 16; ++i) {
            int s = __builtin_amdgcn_sdot4((int)uu[i].x, (int)xq.x, 0, false); s = __builtin_amdgcn_sdot4((int)uu[i].y, (int)xq.y, s, false);
            s = __builtin_amdgcn_sdot4((int)uu[i].z, (int)xq.z, s, false); s = __builtin_amdgcn_sdot4((int)uu[i].w, (int)xq.w, s, false);
            d[i] = s;
        }
        int r0, r1; treduce16i<4, 2, 1>(d, lane, r0, r1);
        *(int2*)(PART + ((size_t)p * T + t) * 128 + 2 * lane) = make_int2(r0, r1);
    }
}
__device__ __forceinline__ void peer_v_item(int p, int j, const unsigned short* __restrict__ IDX, const unsigned char* __restrict__ ACTQ, const float* __restrict__ ACTS,
                                            const unsigned char* __restrict__ V8, bf16* __restrict__ PEERO, int lane, int wave) {
    asm volatile("" : "+v"(lane));
    const int gidx = lane >> 3; const unsigned coff = (unsigned)(p * 128 + (lane & 7) * 16);
#pragma unroll 1
    for (int it = 0; it < 8; ++it) {
        const int t = j * 64 + it * 8 + wave;
        unsigned E[8];
        { const uint4 e0 = *(const uint4*)(IDX + (size_t)t * 128 + 16 * gidx), e1 = *(const uint4*)(IDX + (size_t)t * 128 + 16 * gidx + 8);
          E[0] = e0.x; E[1] = e0.y; E[2] = e0.z; E[3] = e0.w; E[4] = e1.x; E[5] = e1.y; E[6] = e1.z; E[7] = e1.w; }
        uint4 vv[16];
#pragma unroll
        for (int i = 0; i < 16; ++i) vv[i] = *(const uint4*)(V8 + (size_t)(PE_ID(E, i) * 1024u + coff));
        const uint4 aq = *(const uint4*)(ACTQ + (size_t)t * 128 + 16 * gidx);
        const float asc = ACTS[t];
        const unsigned a4[4] = {aq.x, aq.y, aq.z, aq.w};
        int acc[16];
#pragma unroll
        for (int c = 0; c < 16; ++c) acc[c] = 0;
#pragma unroll
        for (int m = 0; m < 4; ++m) {
            const unsigned r0[4] = {vv[4 * m].x, vv[4 * m].y, vv[4 * m].z, vv[4 * m].w}, r1[4] = {vv[4 * m + 1].x, vv[4 * m + 1].y, vv[4 * m + 1].z, vv[4 * m + 1].w};
            const unsigned r2[4] = {vv[4 * m + 2].x, vv[4 * m + 2].y, vv[4 * m + 2].z, vv[4 * m + 2].w}, r3[4] = {vv[4 * m + 3].x, vv[4 * m + 3].y, vv[4 * m + 3].z, vv[4 * m + 3].w};
#pragma unroll
            for (int dc = 0; dc < 4; ++dc) {
                const unsigned ta = __builtin_amdgcn_perm(r1[dc], r0[dc], 0x05010400u), tb = __builtin_amdgcn_perm(r3[dc], r2[dc], 0x05010400u);
                const unsigned ua = __builtin_amdgcn_perm(r1[dc], r0[dc], 0x07030602u), ub = __builtin_amdgcn_perm(r3[dc], r2[dc], 0x07030602u);
                const unsigned c0 = __builtin_amdgcn_perm(tb, ta, 0x05040100u), c1 = __builtin_amdgcn_perm(tb, ta, 0x07060302u);
                const unsigned c2 = __builtin_amdgcn_perm(ub, ua, 0x05040100u), c3 = __builtin_amdgcn_perm(ub, ua, 0x07060302u);
                acc[4 * dc + 0] = __builtin_amdgcn_sdot4((int)c0, (int)a4[m], acc[4 * dc + 0], false);
                acc[4 * dc + 1] = __builtin_amdgcn_sdot4((int)c1, (int)a4[m], acc[4 * dc + 1], false);
                acc[4 * dc + 2] = __builtin_amdgcn_sdot4((int)c2, (int)a4[m], acc[4 * dc + 2], false);
                acc[4 * dc + 3] = __builtin_amdgcn_sdot4((int)c3, (int)a4[m], acc[4 * dc + 3], false);
            }
        }
        int r0i, r1i; treduce16i<32, 16, 8>(acc, lane, r0i, r1i);
        *(unsigned*)(PEERO + (size_t)t * D + coff + 2 * gidx) = pkbf(asc * (float)r0i, asc * (float)r1i);
    }
}

__device__ __forceinline__ void ce_desc(float& a, float& b) { const float hi = fmaxf(a, b), lo = fminf(a, b); a = hi; b = lo; }
__device__ __forceinline__ void sort16_desc(float (&v)[16]) {
#pragma unroll
    for (int k = 2; k <= 16; k <<= 1)
#pragma unroll
        for (int j = k >> 1; j > 0; j >>= 1)
#pragma unroll
            for (int i = 0; i < 16; ++i) { const int l = i ^ j; if (l > i) { if ((i & k) == 0) ce_desc(v[i], v[l]); else ce_desc(v[l], v[i]); } }
}
__device__ __forceinline__ void merge16_desc(float (&a)[16], const float (&b)[16]) {
#pragma unroll
    for (int i = 0; i < 16; ++i) a[i] = fmaxf(a[i], b[15 - i]);
#pragma unroll
    for (int j = 8; j > 0; j >>= 1)
#pragma unroll
        for (int i = 0; i < 16; ++i) { const int l = i ^ j; if (l > i) ce_desc(a[i], a[l]); }
}
__device__ __forceinline__ void ce_kv(float& ka, int& va, float& kb, int& vb) {
    const bool s = kb > ka; const float t0 = s ? kb : ka, t1 = s ? ka : kb; const int u0 = s ? vb : va, u1 = s ? va : vb; ka = t0; kb = t1; va = u0; vb = u1; }
__device__ __forceinline__ void sort16_kv(float (&k)[16], int (&v)[16]) {
#pragma unroll
    for (int kk = 2; kk <= 16; kk <<= 1)
#pragma unroll
        for (int j = kk >> 1; j > 0; j >>= 1)
#pragma unroll
            for (int i = 0; i < 16; ++i) { const int l = i ^ j; if (l > i) { if ((i & kk) == 0) ce_kv(k[i], v[i], k[l], v[l]); else ce_kv(k[l], v[l], k[i], v[i]); } }
}
__device__ __forceinline__ void merge16_kv(float (&ka)[16], int (&va)[16], const float (&kb)[16], const int (&vb)[16]) {
#pragma unroll
    for (int i = 0; i < 16; ++i) { const bool s = kb[15 - i] > ka[i]; ka[i] = s ? kb[15 - i] : ka[i]; va[i] = s ? vb[15 - i] : va[i]; }
#pragma unroll
    for (int j = 8; j > 0; j >>= 1)
#pragma unroll
        for (int i = 0; i < 16; ++i) { const int l = i ^ j; if (l > i) ce_kv(ka[i], va[i], ka[l], va[l]); }
}
__device__ __forceinline__ void split8(const float* p, bf16x8& hi8, bf16x8& lo8) {
    const float4 f0 = *(const float4*)p, f1 = *(const float4*)(p + 4);
    const float x[8] = {f0.x, f0.y, f0.z, f0.w, f1.x, f1.y, f1.z, f1.w};
#pragma unroll
    for (int j = 0; j < 8; ++j) { const short h = bfs(x[j]); hi8[j] = h; lo8[j] = bfs(x[j] - sbf2f(h)); }
}
__device__ __forceinline__ void route_task(int task, const float* QP, const bf16* KH, const bf16* KL, unsigned short* IDX, float* GATE, int lane) {
    const int r = lane & 31, hi = lane >> 5, t = 4 * task + (r >> 3), head = r & 7;
    float top[2][16];
#pragma unroll
    for (int half = 0; half < 2; ++half) {
        bf16x8 qh[4], ql[4];
#pragma unroll
        for (int ks = 0; ks < 4; ++ks) split8(QP + (size_t)t * D + head * 128 + half * 64 + 16 * ks + 8 * hi, qh[ks], ql[ks]);
        float cur[16];
#pragma unroll
        for (int kt = 0; kt < 4; ++kt) {
            f32x16 X = zero16();
            const bf16* khp = KH + (size_t)(half * 128 + 32 * kt + r) * 64 + 8 * hi; const bf16* klp = KL + (size_t)(half * 128 + 32 * kt + r) * 64 + 8 * hi;
            asm volatile("" : "+v"(khp), "+v"(klp));
#pragma unroll
            for (int ks = 0; ks < 4; ++ks) {
                const bf16x8 kh = ldg8(khp + 16 * ks), kl = ldg8(klp + 16 * ks);
                X = MFMA32(kh, qh[ks], X); X = MFMA32(kh, ql[ks], X); X = MFMA32(kl, qh[ks], X);
            }
            float grp[16];
#pragma unroll
            for (int i = 0; i < 16; ++i) { const unsigned key = (unsigned)(32 * kt + crow(i, hi)); grp[i] = __uint_as_float((__float_as_uint(X[i]) & ~127u) | (127u - key)); }
            sort16_desc(grp);
            if (kt == 0) {
#pragma unroll
                for (int i = 0; i < 16; ++i) cur[i] = grp[i];
            } else merge16_desc(cur, grp);
        }
        float oth[16];
#pragma unroll
        for (int i = 0; i < 16; ++i) oth[i] = __shfl_xor(cur[i], 32);
        merge16_desc(cur, oth);
#pragma unroll
        for (int i = 0; i < 16; ++i) top[half][i] = cur[i];
    }
    unsigned P1[4], P2[4];
#pragma unroll
    for (int q = 0; q < 4; ++q) { P1[q] = 0u; P2[q] = 0u;
#pragma unroll
        for (int s = 0; s < 4; ++s) { P1[q] |= (127u - (__float_as_uint(top[0][4 * q + s]) & 127u)) << (8 * s); P2[q] |= (127u - (__float_as_uint(top[1][4 * q + s]) & 127u)) << (8 * s); } }
#define CAND(a, b) __uint_as_float((__float_as_uint(top[0][a] + top[1][b]) & ~255u) | (255u - (unsigned)((a) * 16 + (b))))
    float bk[16];
    {
        float gk[16];
        gk[0] = CAND(0, 0);
        gk[1] = CAND(0, 1);
        gk[2] = CAND(0, 2);
        gk[3] = CAND(0, 3);
        gk[4] = CAND(0, 4);
        gk[5] = CAND(0, 5);
        gk[6] = CAND(0, 6);
        gk[7] = CAND(0, 7);
        gk[8] = CAND(0, 8);
        gk[9] = CAND(0, 9);
        gk[10] = CAND(0, 10);
        gk[11] = CAND(0, 11);
        gk[12] = CAND(0, 12);
        gk[13] = CAND(0, 13);
        gk[14] = CAND(0, 14);
        gk[15] = CAND(0, 15);
        sort16_desc(gk);
#pragma unroll
        for (int i = 0; i < 16; ++i) bk[i] = gk[i];
    }
    {
        float gk[16];
        gk[0] = CAND(1, 0);
        gk[1] = CAND(1, 1);
        gk[2] = CAND(1, 2);
        gk[3] = CAND(1, 3);
        gk[4] = CAND(1, 4);
        gk[5] = CAND(1, 5);
        gk[6] = CAND(1, 6);
        gk[7] = CAND(1, 7);
        gk[8] = CAND(2, 0);
        gk[9] = CAND(2, 1);
        gk[10] = CAND(2, 2);
        gk[11] = CAND(2, 3);
        gk[12] = CAND(2, 4);
        gk[13] = CAND(3, 0);
        gk[14] = CAND(3, 1);
        gk[15] = CAND(3, 2);
        sort16_desc(gk);
        merge16_desc(bk, gk);
    }
    {
        float gk[16];
        gk[0] = CAND(3, 3);
        gk[1] = CAND(4, 0);
        gk[2] = CAND(4, 1);
        gk[3] = CAND(4, 2);
        gk[4] = CAND(5, 0);
        gk[5] = CAND(5, 1);
        gk[6] = CAND(6, 0);
        gk[7] = CAND(6, 1);
        gk[8] = CAND(7, 0);
        gk[9] = CAND(7, 1);
        gk[10] = CAND(8, 0);
        gk[11] = CAND(9, 0);
        gk[12] = CAND(10, 0);
        gk[13] = CAND(11, 0);
        gk[14] = CAND(12, 0);
        gk[15] = CAND(13, 0);
        sort16_desc(gk);
        merge16_desc(bk, gk);
    }
    {
        float gk[16];
        gk[0] = CAND(14, 0);
        gk[1] = CAND(15, 0);
        gk[2] = -INFINITY;
        gk[3] = -INFINITY;
        gk[4] = -INFINITY;
        gk[5] = -INFINITY;
        gk[6] = -INFINITY;
        gk[7] = -INFINITY;
        gk[8] = -INFINITY;
        gk[9] = -INFINITY;
        gk[10] = -INFINITY;
        gk[11] = -INFINITY;
        gk[12] = -INFINITY;
        gk[13] = -INFINITY;
        gk[14] = -INFINITY;
        gk[15] = -INFINITY;
        sort16_desc(gk);
        merge16_desc(bk, gk);
    }
#undef CAND
    int bv[16];
#pragma unroll
    for (int i = 0; i < 16; ++i) {
        const unsigned cd = 255u - (__float_as_uint(bk[i]) & 255u), ca = cd >> 4, cb = cd & 15u;
        const unsigned wa = (ca >> 2) == 0u ? P1[0] : (ca >> 2) == 1u ? P1[1] : (ca >> 2) == 2u ? P1[2] : P1[3];
        const unsigned wb = (cb >> 2) == 0u ? P2[0] : (cb >> 2) == 1u ? P2[1] : (cb >> 2) == 2u ? P2[2] : P2[3];
        bv[i] = (int)((((wa >> (8u * (ca & 3u))) & 255u) << 7) | ((wb >> (8u * (cb & 3u))) & 255u));
    }
    float e[16], se = 0.f;
#pragma unroll
    for (int i = 0; i < 16; ++i) { e[i] = __expf(bk[i] - bk[0]); se += e[i]; }
    const float inv = 1.f / se;
    if (hi == 0) {
        uint4* ip = (uint4*)(IDX + (size_t)t * 128 + head * 16); float4* gp = (float4*)(GATE + (size_t)t * 128 + head * 16);
#pragma unroll
        for (int q = 0; q < 2; ++q) ip[q] = make_uint4((unsigned)bv[8 * q] | ((unsigned)bv[8 * q + 1] << 16), (unsigned)bv[8 * q + 2] | ((unsigned)bv[8 * q + 3] << 16), (unsigned)bv[8 * q + 4] | ((unsigned)bv[8 * q + 5] << 16), (unsigned)bv[8 * q + 6] | ((unsigned)bv[8 * q + 7] << 16));
#pragma unroll
        for (int q = 0; q < 4; ++q) gp[q] = make_float4(e[4 * q] * inv, e[4 * q + 1] * inv, e[4 * q + 2] * inv, e[4 * q + 3] * inv);
    }
}

#define XB_TMO      128
#define XB_XCNT(j)  (256  + 64 * (j))
#define XB_XSUB(j)  (1280 + 64 * (j))
#define XB_XGEN(j)  (2304 + 64 * (j))
#define XB_TOP      3328
#define XB_TOPGEN   3392
#define XCD_BAR_WORDS 3456
#define XB_SPIN_CAP (1u << 22)
__device__ __forceinline__ unsigned xb_ld(unsigned* p)              { return __hip_atomic_load(p, __ATOMIC_RELAXED, __HIP_MEMORY_SCOPE_AGENT); }
__device__ __forceinline__ unsigned xb_add(unsigned* p, unsigned v) { return __hip_atomic_fetch_add(p, v, __ATOMIC_RELAXED, __HIP_MEMORY_SCOPE_AGENT); }
__device__ __forceinline__ unsigned xb_xcc_id() { return (unsigned)__builtin_amdgcn_s_getreg((3 << 11) | 20) & 0xFu; }
#define XB_SPIN(cond, bar) do { unsigned _sp = 0; while (cond) { __builtin_amdgcn_s_sleep(1); \
    if ((++_sp & 255u) == 0u) { if (xb_ld(&(bar)[XB_TMO])) break; if (_sp > XB_SPIN_CAP) { atomicAdd(&(bar)[XB_TMO], 1u); break; } } } } while (0)
struct XcdBarrier { unsigned* bar; unsigned x; volatile LAS unsigned* st; };
__device__ __forceinline__ XcdBarrier xcd_barrier_post(unsigned* bar, volatile LAS unsigned* st) {
    XcdBarrier b; b.bar = bar; b.x = xb_xcc_id(); b.st = st;
    if (threadIdx.x == 0) (void)xb_add(&bar[XB_XCNT(b.x)], 1u);
    return b;
}
__device__ __forceinline__ void xcd_barrier_complete(unsigned* bar, unsigned x, unsigned& nloc, unsigned& nx) {
    const unsigned G = gridDim.x * gridDim.y * gridDim.z;
    unsigned sum, cnt, mine, sp = 0u;
    for (;;) {
        sum = 0u; cnt = 0u; mine = 0u;
#pragma unroll
        for (unsigned j = 0; j < 16; ++j) { const unsigned c = xb_ld(&bar[XB_XCNT(j)]); sum += c; cnt += (c > 0u) ? 1u : 0u; mine = (j == x) ? c : mine; }
        if (sum == G) break;
        __builtin_amdgcn_s_sleep(1);
        if ((++sp & 255u) == 0u) { if (xb_ld(&bar[XB_TMO])) break; if (sp > XB_SPIN_CAP) { atomicAdd(&bar[XB_TMO], 1u); break; } }
    }
    nloc = mine > 0u ? mine : 1u; nx = cnt > 0u ? cnt : 1u;
}
__device__ __forceinline__ void xcd_barrier(const XcdBarrier& b) {
    asm volatile("s_waitcnt vmcnt(0)" ::: "memory");
    __syncthreads();
    if (threadIdx.x == 0) {
        unsigned* bar = b.bar;
        __builtin_amdgcn_s_waitcnt(0);
        unsigned nloc = b.st[0], nx = b.st[1];
        if (nloc == 0u) { xcd_barrier_complete(bar, b.x, nloc, nx); b.st[0] = nloc; b.st[1] = nx; }
        const unsigned old = xb_add(&bar[XB_XSUB(b.x)], 1u);
        const unsigned gen = old / nloc;
        if (old + 1u == (gen + 1u) * nloc) {
            __builtin_amdgcn_fence(__ATOMIC_RELEASE, "agent");
            asm volatile("s_waitcnt vmcnt(0)" ::: "memory");
            const unsigned og = xb_add(&bar[XB_TOP], 1u);
            const unsigned tg = og / nx;
            if (og + 1u == (tg + 1u) * nx) xb_add(&bar[XB_TOPGEN], 1u);
            else XB_SPIN(xb_ld(&bar[XB_TOPGEN]) == tg, bar);
            __builtin_amdgcn_fence(__ATOMIC_ACQUIRE, "agent");
            xb_add(&bar[XB_XGEN(b.x)], 1u);
            asm volatile("s_waitcnt vmcnt(0)" ::: "memory");
        } else {
            XB_SPIN(xb_ld(&bar[XB_XGEN(b.x)]) == gen, bar);
            __builtin_amdgcn_fence(__ATOMIC_ACQUIRE, "agent");
            asm volatile("s_waitcnt vmcnt(0)" ::: "memory");
        }
    }
    __syncthreads();
}
constexpr int LDS_BYTES = 147456;
constexpr int MISC_OFF = 131072 + 320;

__global__ void __launch_bounds__(NTHR, 2) k_main(Args a) {
    extern __shared__ __attribute__((aligned(16))) unsigned char lds_raw[];
    LAS unsigned char* ldsb = (LAS unsigned char*)lds_raw;
    const int tid0 = threadIdx.x, bid = blockIdx.x, nb = gridDim.x;
    const int wave = __builtin_amdgcn_readfirstlane(tid0 >> 6);
    const int gthreads = nb * NTHR, nwaves = gthreads >> 6;
#define PHASE_VARS() int tid = tid0; asm volatile("" : "+v"(tid)); const int lane = tid & 63, gtid = bid * NTHR + tid, gwave = gtid >> 6; (void)lane; (void)gtid; (void)gwave
    unsigned char* ws = a.ws;
    bf16* WINT = (bf16*)(ws + WS_WIN); bf16* WOT = (bf16*)(ws + WS_WO); bf16* WQT = (bf16*)(ws + WS_WQ);
    bf16* PROJ = (bf16*)(ws + WS_PROJ);
    bf16* XNB = (bf16*)(ws + WS_XNB);
    bf16* XACT = (bf16*)(ws + WS_XACT);
    float* DTRAW = (float*)(ws + WS_DTRAW); float* DT = (float*)(ws + WS_DT); float* ACS = (float*)(ws + WS_ACS); float* CDEC = (float*)(ws + WS_CDEC);
    float* STATES = (float*)(ws + WS_STATES); bf16* PREVT = (bf16*)(ws + WS_PREV);
    float* QP = (float*)(ws + WS_QP); unsigned short* IDX = (unsigned short*)(ws + WS_IDX); float* GATE = (float*)(ws + WS_GATE);
    float* TOPV = (float*)(ws + WS_TOPV); int* TOPI = (int*)(ws + WS_TOPI);
    unsigned char* U8 = ws + WS_U8; unsigned char* V8 = ws + WS_V8; float* SU = (float*)(ws + WS_SU); float* SV = SU + 16384; int* PART = (int*)(ws + WS_PART); unsigned char* XQ = ws + WS_XQ; float* XS = (float*)(ws + WS_XS);
    bf16* KH = (bf16*)(ws + WS_KH); bf16* KL = (bf16*)(ws + WS_KH + 65536);
    float* MIXF = a.out;
    volatile LAS unsigned* MISC = (volatile LAS unsigned*)(ldsb + MISC_OFF);
    if (tid0 < 32) MISC[tid0] = 0u;
    __syncthreads();
    XcdBarrier bar = xcd_barrier_post((unsigned*)ws, MISC + 8);
#define IN(k) (a.ph_lo <= (k) && (k) < a.ph_hi)
#if defined(PROBE_LO)
    int seg_ = 0; unsigned long long tseg_ = __builtin_amdgcn_s_memrealtime();
#define PROBE_SPIN() do { if (seg_ >= PROBE_LO && seg_ <= PROBE_HI) { const unsigned long long d_ = (__builtin_amdgcn_s_memrealtime() - tseg_) * PROBE_AMP; const unsigned long long s_ = __builtin_amdgcn_s_memrealtime(); \
        while (__builtin_amdgcn_s_memrealtime() - s_ < d_) __builtin_amdgcn_s_sleep(4); } } while (0)
#define GRID_BAR() do { PROBE_SPIN(); xcd_barrier(bar); tseg_ = __builtin_amdgcn_s_memrealtime(); ++seg_; } while (0)
#else
#define PROBE_SPIN() do { } while (0)
#define GRID_BAR() xcd_barrier(bar)
#endif

    if (IN(0)) {
        PHASE_VARS();
        LAS float* scr = (LAS float*)(ldsb + wave * 16384);
        constexpr int I_IN = 16 * 72, I_O = 16 * 32, NITEMS = I_IN + 2 * I_O;
        for (int it = gwave; it < NITEMS; it += nwaves) {
            int r = it;
            if (r < I_IN) { transpose_item(a.w_in, PW, D, WINT, scr, r / 72, r % 72, lane); continue; } r -= I_IN;
            if (r < I_O) { transpose_item(a.w_out, D, D, WOT, scr, r / 32, r % 32, lane); continue; } r -= I_O;
            transpose_item(a.peer_wq, D, D, WQT, scr, r / 32, r % 32, lane);
        }
        for (int i = gtid; i < 2 * 128 * 64; i += gthreads) { const float kf = a.peer_sub_keys[i]; const short h = bfs(kf); KH[i] = (bf16)h; KL[i] = (bf16)bfs(kf - sbf2f(h)); }
        for (int i = tid; i < 8 * 1024; i += NTHR) { const int h = i & 7, c = i >> 3; *(LAS float*)(ldsb + h * 16384 + 8448 + c * 4) = a.w_in[(size_t)c * PW + ODT + h]; }
        __syncthreads();
        rmsnorm_rows_bf16<1>(a.x, a.norm_mix_g, XNB, ldsb, DTRAW, nullptr, nullptr, gwave, nwaves, lane);
    }
    GRID_BAR();
    if (IN(1)) {
        PHASE_VARS();
        pg8::Gemm g{XNB, WINT, T, PS, D}; pg8::StaticOrder S; S.init(T, PS, nb, bid);
        pg8::EpiBf16Plain E{PROJ, PS};
        pg8::gemm_phase<pg8::EpiBf16Plain, pg8::StaticOrder>(ldsb, g, S, E, nullptr);
        const int cfirst = (nb == 256) ? 64 : 0;
        if (bid >= cfirst) for (int rr = (bid - cfirst) * 8 + wave; rr < 2 * 16384; rr += (nb - cfirst) * 8) {
            const int which = rr >> 14, row = rr & 16383;
            const float4* src4 = (const float4*)((which ? a.peer_v : a.peer_u) + (size_t)row * D) + lane;
            float4 v[4]; float mx = 0.f;
#pragma unroll
            for (int jq = 0; jq < 4; ++jq) { v[jq] = src4[64 * jq]; mx = fmaxf(mx, fmaxf(fmaxf(fabsf(v[jq].x), fabsf(v[jq].y)), fmaxf(fabsf(v[jq].z), fabsf(v[jq].w)))); }
#pragma unroll
            for (int o = 1; o < 64; o <<= 1) mx = fmaxf(mx, __shfl_xor(mx, o));
            const float sc = mx > 0.f ? mx * (1.f / 127.f) : 1.f, inv = 1.f / sc;
            unsigned* dst = (unsigned*)((which ? V8 : U8) + (size_t)row * D) + lane;
#pragma unroll
            for (int jq = 0; jq < 4; ++jq) { const int q0 = (int)rintf(v[jq].x * inv), q1 = (int)rintf(v[jq].y * inv), q2 = (int)rintf(v[jq].z * inv), q3 = (int)rintf(v[jq].w * inv);
                dst[64 * jq] = (unsigned)(q0 & 255) | ((unsigned)(q1 & 255) << 8) | ((unsigned)(q2 & 255) << 16) | ((unsigned)(q3 & 255) << 24); }
            if (lane == 0) (which ? SV : SU)[row] = sc;
        }
    }
    GRID_BAR();
    if (IN(2)) {
        PHASE_VARS();
        for (int task = gtid; task < (T / 16) * 128; task += gthreads) {
            const int cg = task & 127, t0 = (task >> 7) * 16, c0 = cg * 8;
            float w[4][8], bs[8];
#pragma unroll
            for (int k = 0; k < 4; ++k) { const float4 a0 = *(const float4*)(a.conv_w + k * 1024 + c0), a1 = *(const float4*)(a.conv_w + k * 1024 + c0 + 4);
                w[k][0] = a0.x; w[k][1] = a0.y; w[k][2] = a0.z; w[k][3] = a0.w; w[k][4] = a1.x; w[k][5] = a1.y; w[k][6] = a1.z; w[k][7] = a1.w; }
            { const float4 a0 = *(const float4*)(a.conv_b + c0), a1 = *(const float4*)(a.conv_b + c0 + 4); bs[0] = a0.x; bs[1] = a0.y; bs[2] = a0.z; bs[3] = a0.w; bs[4] = a1.x; bs[5] = a1.y; bs[6] = a1.z; bs[7] = a1.w; }
            const bool has_halo = (t0 & (SEQ - 1)) != 0;
            bf16x8 rows[19];
#pragma unroll
            for (int i = 0; i < 19; ++i) {
                if (i < 3 && !has_halo) {
#pragma unroll
                    for (int e = 0; e < 8; ++e) rows[i][e] = 0;
                } else rows[i] = ldg8(PROJ + (size_t)(t0 + i - 3) * PS + OXBC + c0);
            }
#pragma unroll
            for (int i = 0; i < 16; ++i) {
                float o[8];
#pragma unroll
                for (int e = 0; e < 8; ++e) o[e] = silu_f(bs[e] + w[0][e] * sbf2f(rows[i][e]) + w[1][e] * sbf2f(rows[i + 1][e]) + w[2][e] * sbf2f(rows[i + 2][e]) + w[3][e] * sbf2f(rows[i + 3][e]));
                v4u ov; ov.x = pkbf(o[0], o[1]); ov.y = pkbf(o[2], o[3]); ov.z = pkbf(o[4], o[5]); ov.w = pkbf(o[6], o[7]);
                *(v4u*)(XACT + (size_t)(t0 + i) * 1024 + c0) = ov;
            }
        }
        if (gwave < 1024) {
            const int h = gwave & 7, bc = gwave >> 3;
            const float A = -__expf(a.a_log[h]), bias = a.dt_bias[h];
            const int t0 = bc * 128 + lane, t1 = t0 + 64;
            const float raw0 = DTRAW[t0 * 8 + h] + bias, raw1 = DTRAW[t1 * 8 + h] + bias;
            const float dt0 = fmaxf(raw0, 0.f) + log1pf(__expf(-fabsf(raw0))), dt1 = fmaxf(raw1, 0.f) + log1pf(__expf(-fabsf(raw1)));
            DT[t0 * 8 + h] = dt0; DT[t1 * 8 + h] = dt1;
            float v0 = dt0 * A, v1 = dt1 * A;
#pragma unroll
            for (int o = 1; o < 64; o <<= 1) { const float y0 = __shfl_up(v0, o), y1 = __shfl_up(v1, o); if (lane >= o) { v0 += y0; v1 += y1; } }
            v1 += __shfl(v0, 63);
            ACS[t0 * 8 + h] = v0; ACS[t1 * 8 + h] = v1;
            if (lane == 63) CDEC[gwave] = __expf(v1);
        }
    }
    GRID_BAR();
    if (IN(3)) {
        PHASE_VARS();
        for (int u = bid; u < 512; u += nb) {
            if (u < 256) attn_unit(a.attn_sinks, a.attn_out_g, ldsb, u, PROJ, XNB, tid, lane, wave);
            else ssd_chunk_unit(ldsb, u - 256, XACT, DT, ACS, MIXF, STATES, tid, lane, wave);
        }
    }
    GRID_BAR();
    if (IN(5)) {
        PHASE_VARS();
        for (int idx = gtid; idx < 2 * 8 * 8192; idx += gthreads) {
            const int pn = idx & 8191, h = (idx >> 13) & 7, b = idx >> 16;
            float run = 0.f;
#pragma unroll 1
            for (int c0 = 0; c0 < 64; c0 += 8) {
                float st[8], dc[8];
#pragma unroll
                for (int j = 0; j < 8; ++j) { const int bch = (b * 64 + c0 + j) * 8 + h; st[j] = STATES[(size_t)bch * 8192 + pn]; dc[j] = CDEC[bch]; }
#pragma unroll
                for (int j = 0; j < 8; ++j) { const int bch = (b * 64 + c0 + j) * 8 + h; PREVT[(size_t)bch * 8192 + pn] = f2bf(run); run = dc[j] * run + st[j]; }
            }
        }
    }
    GRID_BAR();
    if (IN(6)) {
        PHASE_VARS();
        for (int u = bid; u < 256; u += nb) yoff_unit(a.d_skip, a.ssm_norm_g, ldsb, u, XACT, PROJ, ACS, PREVT, MIXF, XNB, lane, wave);
    }
    GRID_BAR();
    if (IN(7)) {
        PHASE_VARS();
        pg8::Gemm g{XNB, WOT, T, D, D}; pg8::StaticOrder S; S.init(T, D, nb, bid);
        pg8::EpiF32Resid E{a.out, a.x, D};
        pg8::gemm_phase<pg8::EpiF32Resid, pg8::StaticOrder>(ldsb, g, S, E, nullptr);
    }
    GRID_BAR();
    if (IN(8)) {
        PHASE_VARS();
        rmsnorm_rows_bf16<2>(a.out, a.norm_ffn_g, XNB, ldsb, nullptr, XQ, XS, gwave, nwaves, lane);
    }
    GRID_BAR();
    if (IN(9)) {
        PHASE_VARS();
        pg8::Gemm g{XNB, WQT, T, D, D}; pg8::StaticOrder S; S.init(T, D, nb, bid);
        pg8::EpiF32Resid E{QP, nullptr, D};
        pg8::gemm_phase<pg8::EpiF32Resid, pg8::StaticOrder>(ldsb, g, S, E, nullptr);
    }
    GRID_BAR();
    if (IN(10)) {
        PHASE_VARS();
        for (int task = gwave; task < T / 4; task += nwaves) route_task(task, QP, KH, KL, IDX, GATE, lane);
    }
    GRID_BAR();
    unsigned char* ACTQ = ws + WS_ACT; float* ACTS = (float*)(ws + WS_ACT + 4 * MiB); bf16* PEERO = (bf16*)(ws + WS_PEERO);
    unsigned* ctl = (unsigned*)ws;
    const int xcc = (int)(bar.x & 7u);
    if (IN(12)) {
        PHASE_VARS();
#pragma unroll 1
        for (int pi = 0; pi < NPART; ++pi) {
            const int p = (xcc + pi) & 7;
            for (;;) {
                if (tid == 0) MISC[16] = xb_add(&ctl[CW_QU + 64 * p], 1u);
                __syncthreads();
                const int j = (int)MISC[16];
                __syncthreads();
                if (j >= NCHUNK) break;
                peer_u_item(p, j, IDX, XQ, U8, PART, lane, wave);
            }
        }
    }
    GRID_BAR();
    if (IN(12)) {
        PHASE_VARS();
        for (int t = gwave; t < T; t += nwaves) {
            float av[2];
#pragma unroll
            for (int hh = 0; hh < 2; ++hh) {
                const int i = t * 128 + hh * 64 + lane;
                int si = 0;
#pragma unroll
                for (int pp = 0; pp < NPART; ++pp) si += PART[(size_t)pp * T * 128 + i];
                const int e = IDX[i]; const float z = (float)si * SU[e] * XS[t];
                av[hh] = GATE[i] * 0.5f * z * (1.f + erff(z * 0.70710678118654752f)) * SV[e];
            }
            float mx = fmaxf(fabsf(av[0]), fabsf(av[1]));
#pragma unroll
            for (int o = 1; o < 64; o <<= 1) mx = fmaxf(mx, __shfl_xor(mx, o));
            const float sc = mx > 0.f ? mx * (1.f / 127.f) : 1.f, inv = 1.f / sc;
            ACTQ[(size_t)t * 128 + lane] = (unsigned char)((int)rintf(av[0] * inv) & 255); ACTQ[(size_t)t * 128 + 64 + lane] = (unsigned char)((int)rintf(av[1] * inv) & 255);
            if (lane == 0) ACTS[t] = sc;
        }
    }
    GRID_BAR();
    if (IN(13)) {
        PHASE_VARS();
#pragma unroll 1
        for (int pi = 0; pi < NPART; ++pi) {
            const int p = (xcc + pi) & 7;
            for (;;) {
                if (tid == 0) MISC[16] = xb_add(&ctl[CW_QV + 64 * p], 1u);
                __syncthreads();
                const int j = (int)MISC[16];
                __syncthreads();
                if (j >= NCHUNK) break;
                peer_v_item(p, j, IDX, ACTQ, ACTS, V8, PEERO, lane, wave);
            }
        }
    }
    GRID_BAR();
    if (IN(14)) {
        PHASE_VARS();
        for (int t = gwave; t < T; t += nwaves) {
            const float4* hr = (const float4*)(a.out + (size_t)t * D) + lane; const uint2* pr = (const uint2*)(PEERO + (size_t)t * D) + lane;
            float4 v[4]; float ss = 0.f;
#pragma unroll
            for (int jq = 0; jq < 4; ++jq) { const float4 h4 = hr[64 * jq]; const uint2 pw = pr[64 * jq]; v[jq] = make_float4(h4.x + __uint_as_float(pw.x << 16), h4.y + __uint_as_float(pw.x & 0xffff0000u), h4.z + __uint_as_float(pw.y << 16), h4.w + __uint_as_float(pw.y & 0xffff0000u)); ss += v[jq].x * v[jq].x + v[jq].y * v[jq].y + v[jq].z * v[jq].z + v[jq].w * v[jq].w; }
            ss = wave_sum(ss);
            const float r3 = rsqrtf(ss * (1.f / D) + EPS);
            float4* op = (float4*)(a.out + (size_t)t * D) + lane;
#pragma unroll
            for (int jq = 0; jq < 4; ++jq) { const float4 gv = ((const float4*)a.final_norm_g)[lane + 64 * jq]; op[64 * jq] = make_float4(v[jq].x * r3 * gv.x, v[jq].y * r3 * gv.y, v[jq].z * r3 * gv.z, v[jq].w * r3 * gv.w); }
        }
    }
    PROBE_SPIN();
#undef IN
}
}

extern "C" void kernel_launch(void* const* d_in, const int* in_sizes, int n_in, void* d_out, int out_size, void* d_ws, size_t ws_size, hipStream_t stream) {
    if (n_in != 18 || out_size != T * D || ws_size < WS_END) { fprintf(stderr, "kernel_launch: unexpected shapes n_in=%d out=%d ws=%zu\n", n_in, out_size, ws_size); return; }
    Args a{};
    const float** ap = (const float**)&a;
    for (int i = 0; i < 18; ++i) ap[i] = (const float*)d_in[i];
    a.out = (float*)d_out; a.ws = (unsigned char*)d_ws;
    static int grid = 0;
    if (grid == 0) {
        int dev = 0, cus = 0, per_cu = 0;
        if (hipGetDevice(&dev) != hipSuccess || hipDeviceGetAttribute(&cus, hipDeviceAttributeMultiprocessorCount, dev) != hipSuccess) { fprintf(stderr, "kernel_launch: device query failed\n"); grid = -1; return; }
        if (hipFuncSetAttribute((const void*)k_main, hipFuncAttributeMaxDynamicSharedMemorySize, LDS_BYTES) != hipSuccess) { fprintf(stderr, "kernel_launch: hipFuncSetAttribute failed\n"); grid = -1; return; }
        if (hipOccupancyMaxActiveBlocksPerMultiprocessor(&per_cu, (const void*)k_main, NTHR, LDS_BYTES) != hipSuccess || per_cu < 1) { fprintf(stderr, "kernel_launch: occupancy query says %d blocks/CU\n", per_cu); (void)hipGetLastError(); grid = -1; return; }
        grid = cus;
    }
    if (grid < 0) return;
    if (hipMemsetAsync(d_ws, 0, 65536, stream) != hipSuccess) { fprintf(stderr, "kernel_launch: memset failed\n"); return; }
    a.ph_lo = 0; a.ph_hi = 15;
    hipLaunchKernelGGL(k_main, dim3(grid), dim3(NTHR), LDS_BYTES, stream, a);
}
```

```cpp
#include <hip/hip_runtime.h>
#include <cstdio>
#include <cstdint>

namespace pg8 {
#define PG8_LAS __attribute__((address_space(3)))
typedef unsigned short bf16_t;
typedef short bf16x8 __attribute__((ext_vector_type(8)));
typedef float f32x4 __attribute__((ext_vector_type(4)));
typedef unsigned u32x4 __attribute__((ext_vector_type(4)));
constexpr int BM = 256, BK = 64, HALF = 128, HTB = HALF * BK * 2  , STAGE_BYTES = 8 * HTB, NXCD = 8, WGM = 8;

__host__ __device__ __forceinline__ int lds_byte(int r, int c) { const int st = (r >> 4) * 2 + (c >> 5), rr = r & 15, cc = c & 31, ob = rr * 64 + cc * 2; return st * 1024 + (ob ^ (((ob >> 9) & 1) << 5)); }
__host__ __device__ __forceinline__ void stage_rc(int b, int& R, int& C) { const int st = b / 1024, sb = b % 1024, swz = sb ^ (((sb >> 9) & 1) << 5); R = (st >> 1) * 16 + swz / 64; C = (st & 1) * 32 + (swz % 64) / 2; }
__host__ __device__ __forceinline__ int perm32(int rho) { const int n = rho >> 4, i = rho & 15; return 8 * (i >> 2) + 4 * n + (i & 3); }

struct Unit { int pm, pn; };
struct Gemm { const bf16_t* A; const bf16_t* Bt; int M, N, K; };

struct StaticOrder {
    int nM, nN, nwg, G, c;
    __host__ __device__ void init(int M, int N, int G_, int c_) { nM = M / BM; nN = N / BM; nwg = nM * nN; G = G_; c = c_; }
    __host__ __device__ bool next(int i, Unit& u) const {
        const long L = (long)i * G + c; if (L >= nwg) return false;
        int wgid = (int)L; { const int q = nwg / NXCD, r = nwg % NXCD, xcd = wgid % NXCD, off = wgid / NXCD; wgid = (xcd < r ? xcd * (q + 1) : r * (q + 1) + (xcd - r) * q) + off; }
        const int nig = WGM * nN, gid = wgid / nig, fm = gid * WGM, gsz = (nM - fm) < WGM ? (nM - fm) : WGM;
        u.pm = fm + ((wgid % nig) % gsz); u.pn = (wgid % nig) / gsz; return true;
    }
    __device__ __forceinline__ void a_ready(const Unit&) const {}
    __device__ __forceinline__ void done(const Unit&) const {}
};
__device__ __forceinline__ unsigned cvt_pk_bf16(float lo, float hi) { unsigned r; asm volatile("v_cvt_pk_bf16_f32 %0, %1, %2" : "=v"(r) : "v"(lo), "v"(hi)); return r; }
typedef float f32x2 __attribute__((ext_vector_type(2)));
struct EpiBf16Plain {
    static constexpr bool PERM = true, AFTER_DRAIN = false;
    bf16_t* O; int ldc;
    __device__ __forceinline__ void operator()(const f32x4 (&acc)[2][2][4][2], const Unit& u, int wr, int wc, int fr, int fq) const {
        const int row0 = u.pm * BM + wr * 64 + fr, col0 = u.pn * BM + wc * 32 + 8 * fq;
#pragma unroll
        for (int ai = 0; ai < 2; ++ai)
#pragma unroll
            for (int m = 0; m < 4; ++m) { bf16_t* rowp = O + (size_t)(row0 + ai * HALF + m * 16) * ldc + col0;
#pragma unroll
                for (int bj = 0; bj < 2; ++bj) { const f32x4 v0 = acc[ai][bj][m][0], v1 = acc[ai][bj][m][1];
                    u32x4 w; w.x = cvt_pk_bf16(v0[0], v0[1]); w.y = cvt_pk_bf16(v0[2], v0[3]); w.z = cvt_pk_bf16(v1[0], v1[1]); w.w = cvt_pk_bf16(v1[2], v1[3]);
                    *(u32x4*)(rowp + bj * HALF) = w; } }
    }
};
struct EpiF32Resid {
    static constexpr bool PERM = false, AFTER_DRAIN = false;
    float* C; const float* R; int ldc;
    __device__ __forceinline__ void operator()(const f32x4 (&acc)[2][2][4][2], const Unit& u, int wr, int wc, int fr, int fq) const {
        const int row0 = u.pm * BM + wr * 64 + fr, col0 = u.pn * BM + wc * 32 + 4 * fq;
#pragma unroll
        for (int ai = 0; ai < 2; ++ai)
#pragma unroll
            for (int m = 0; m < 4; ++m) { const size_t off = (size_t)(row0 + ai * HALF + m * 16) * ldc + col0;
#pragma unroll
                for (int bj = 0; bj < 2; ++bj)
#pragma unroll
                    for (int n = 0; n < 2; ++n) { f32x4 v = acc[ai][bj][m][n]; if (R) v += *(const f32x4*)(R + off + bj * HALF + n * 16); *(f32x4*)(C + off + bj * HALF + n * 16) = v; }
                asm volatile("" ::: "memory"); }
    }
};

struct EpiBf16Resid {
    static constexpr bool PERM = true, AFTER_DRAIN = false;
    bf16_t* O; const float* R; int ldc;
    __device__ __forceinline__ void operator()(const f32x4 (&acc)[2][2][4][2], const Unit& u, int wr, int wc, int fr, int fq) const {
        const int row0 = u.pm * BM + wr * 64 + fr, col0 = u.pn * BM + wc * 32 + 8 * fq;
#pragma unroll
        for (int ai = 0; ai < 2; ++ai)
#pragma unroll
            for (int m = 0; m < 4; ++m) { const size_t off = (size_t)(row0 + ai * HALF + m * 16) * ldc + col0;
#pragma unroll
                for (int bj = 0; bj < 2; ++bj) { const f32x4 v0 = acc[ai][bj][m][0] + *(const f32x4*)(R + off + bj * HALF), v1 = acc[ai][bj][m][1] + *(const f32x4*)(R + off + bj * HALF + 4);
                    u32x4 w; w.x = cvt_pk_bf16(v0[0], v0[1]); w.y = cvt_pk_bf16(v0[2], v0[3]); w.z = cvt_pk_bf16(v1[0], v1[1]); w.w = cvt_pk_bf16(v1[2], v1[3]);
                    *(u32x4*)(O + off + bj * HALF) = w; }
                asm volatile("" ::: "memory"); }
    }
};
template <class Epi, class Sched, bool STAMP = false>
__device__ __forceinline__ void gemm_phase(PG8_LAS unsigned char* lds, const Gemm g, const Sched& S, const Epi& E, unsigned long long* stamps) {
    const int tid = threadIdx.x, wid = __builtin_amdgcn_readfirstlane(tid >> 6), lane = tid & 63, wr = wid >> 2, wc = wid & 3, fr = lane & 15, fq = lane >> 4;
    const int K = g.K, nt = K / BK;
    int ts_lo = 0, ts_hi = 0, nts = 0; const unsigned long long rt_entry = STAMP ? (unsigned long long)0ull : 0ull;
#define PG8_STAMP() do { if (STAMP && wid == 0 && nts < 64) { const unsigned long long _c = (unsigned long long)clock64(); \
        ts_lo = (lane == nts) ? (int)(unsigned)_c : ts_lo; ts_hi = (lane == nts) ? (int)(unsigned)(_c >> 32) : ts_hi; ++nts; } } while (0)
    PG8_STAMP();
    unsigned voffA[2], voffB[2];
#pragma unroll
    for (int i = 0; i < 2; ++i) { int R, C; stage_rc(tid * 16 + i * 8192, R, C); const int Rb = Epi::PERM ? ((R & ~31) + perm32(R & 31)) : R;
        voffA[i] = (unsigned)(R * K + C) * 2u; voffB[i] = (unsigned)(Rb * K + C) * 2u; }
    const size_t kstep = (size_t)(BK * 2);
    const size_t hstep = (size_t)HALF * K * 2;
    const size_t tstep = 2 * hstep;
    const unsigned ldsw = (unsigned)wid * 1024u;
    const int aoff = lds_byte(wr * 64 + fr, fq * 8), boff = lds_byte(wc * 32 + fr, fq * 8);
#define PG8_SA(b, h) (((b) * 2 + (h)) * HTB)
#define PG8_SB(b, h) ((4 + (b) * 2 + (h)) * HTB)
#define PG8_STAGE(bufoff, gbase, voff) do { _Pragma("unroll") for (int _i = 0; _i < 2; ++_i) \
        __builtin_amdgcn_global_load_lds((const unsigned*)((const char*)(gbase) + (voff)[_i]), (PG8_LAS unsigned*)(lds + (bufoff) + ldsw + _i * 8192), 16, 0, 0); } while (0)
#define PG8_LDA(dst, b, h) do { _Pragma("unroll") for (int m = 0; m < 4; ++m) _Pragma("unroll") for (int k = 0; k < 2; ++k) dst[m][k] = *(const PG8_LAS bf16x8*)(lds + PG8_SA(b, h) + aoff + m * 2048 + k * 1024); } while (0)
#define PG8_LDB(dst, b, h) do { _Pragma("unroll") for (int n = 0; n < 2; ++n) _Pragma("unroll") for (int k = 0; k < 2; ++k) dst[n][k] = *(const PG8_LAS bf16x8*)(lds + PG8_SB(b, h) + boff + n * 2048 + k * 1024); } while (0)
#define PG8_MMA(ai, bj, At, Bt) do { __builtin_amdgcn_s_setprio(1); _Pragma("unroll") for (int m = 0; m < 4; ++m) _Pragma("unroll") for (int n = 0; n < 2; ++n) _Pragma("unroll") for (int k = 0; k < 2; ++k) \
        acc[ai][bj][m][n] = __builtin_amdgcn_mfma_f32_16x16x32_bf16(Bt[n][k], At[m][k], acc[ai][bj][m][n], 0, 0, 0); __builtin_amdgcn_s_setprio(0); } while (0)
#define PG8_WAIT_V(n) asm volatile("s_waitcnt vmcnt(" #n ")" ::: "memory")
#define PG8_WAIT_L(n) asm volatile("s_waitcnt lgkmcnt(" #n ")" ::: "memory")
#define PG8_BAR __builtin_amdgcn_s_barrier()
#define PG8_SCHED __builtin_amdgcn_sched_barrier(0)
    Unit cur, nxt; int ui = 0;
    if (!S.next(0, cur)) return;
    f32x4 acc[2][2][4][2];
#pragma unroll
    for (int a = 0; a < 2; ++a)
#pragma unroll
        for (int b = 0; b < 2; ++b)
#pragma unroll
            for (int m = 0; m < 4; ++m)
#pragma unroll
                for (int n = 0; n < 2; ++n) acc[a][b][m][n] = (f32x4){0.f, 0.f, 0.f, 0.f};
    bf16x8 At[4][2], B0[2][2], B1[2][2];
    const char* cA = (const char*)g.A + (size_t)cur.pm * tstep; const char* cB = (const char*)g.Bt + (size_t)cur.pn * tstep;
    S.a_ready(cur);
    PG8_STAGE(PG8_SB(0, 0), cB, voffB); PG8_STAGE(PG8_SA(0, 0), cA, voffA); PG8_STAGE(PG8_SB(0, 1), cB + hstep, voffB); PG8_STAGE(PG8_SA(0, 1), cA + hstep, voffA);
    if (wr == 1) PG8_BAR;
    PG8_WAIT_V(4); PG8_BAR;
    PG8_STAGE(PG8_SB(1, 0), cB + kstep, voffB); PG8_STAGE(PG8_SA(1, 0), cA + kstep, voffA); PG8_STAGE(PG8_SB(1, 1), cB + hstep + kstep, voffB);
    PG8_WAIT_V(6); PG8_BAR;
    PG8_STAMP();
    for (;;) {
        const bool has_next = S.next(ui + 1, nxt);
        const char* nA = has_next ? (const char*)g.A + (size_t)nxt.pm * tstep : cA; const char* nB = has_next ? (const char*)g.Bt + (size_t)nxt.pn * tstep : cB;
        for (int t = 0; t < nt; t += 2) {
            const bool last = (t == nt - 2);
            const char* a1 = cA + (size_t)(t + 1) * kstep;
            const char* a2 = last ? nA : cA + (size_t)(t + 2) * kstep; const char* b2 = last ? nB : cB + (size_t)(t + 2) * kstep;
            const char* a3 = a2 + kstep; const char* b3 = b2 + kstep;
            if (last && has_next) S.a_ready(nxt);
            PG8_LDB(B0, 0, 0); PG8_SCHED; PG8_LDA(At, 0, 0); PG8_STAGE(PG8_SA(1, 1), a1 + hstep, voffA);
            PG8_WAIT_L(8); PG8_BAR; PG8_WAIT_L(0); PG8_MMA(0, 0, At, B0); PG8_BAR; PG8_SCHED;
            PG8_LDB(B1, 0, 1); PG8_STAGE(PG8_SB(0, 0), b2, voffB);
            PG8_BAR; PG8_WAIT_L(0); PG8_MMA(0, 1, At, B1); PG8_BAR;
            PG8_LDA(At, 0, 1); PG8_STAGE(PG8_SA(0, 0), a2, voffA);
            PG8_BAR; PG8_WAIT_L(0); PG8_MMA(1, 0, At, B0); PG8_BAR; PG8_SCHED;
            PG8_STAGE(PG8_SB(0, 1), b2 + hstep, voffB);
            PG8_WAIT_V(6); PG8_BAR; PG8_MMA(1, 1, At, B1); PG8_BAR;
            PG8_LDB(B0, 1, 0); PG8_SCHED; PG8_LDA(At, 1, 0); PG8_STAGE(PG8_SA(0, 1), a2 + hstep, voffA);
            PG8_WAIT_L(8); PG8_BAR; PG8_WAIT_L(0); PG8_MMA(0, 0, At, B0); PG8_BAR; PG8_SCHED;
            PG8_LDB(B1, 1, 1); PG8_STAGE(PG8_SB(1, 0), b3, voffB);
            PG8_BAR; PG8_WAIT_L(0); PG8_MMA(0, 1, At, B1); PG8_BAR;
            PG8_LDA(At, 1, 1); PG8_STAGE(PG8_SA(1, 0), a3, voffA);
            PG8_BAR; PG8_WAIT_L(0); PG8_MMA(1, 0, At, B0); PG8_BAR; PG8_SCHED;
            PG8_STAGE(PG8_SB(1, 1), b3 + hstep, voffB);
            PG8_WAIT_V(6); PG8_BAR; PG8_MMA(1, 1, At, B1); PG8_BAR;
        }
        PG8_STAMP();
        if constexpr (!Epi::AFTER_DRAIN) { E(acc, cur, wr, wc, fr, fq); S.done(cur); }
        PG8_STAMP();
        if (!has_next) break;
#pragma unroll
        for (int a = 0; a < 2; ++a)
#pragma unroll
            for (int b = 0; b < 2; ++b)
#pragma unroll
                for (int m = 0; m < 4; ++m)
#pragma unroll
                    for (int n = 0; n < 2; ++n) acc[a][b][m][n] = (f32x4){0.f, 0.f, 0.f, 0.f};
        cur = nxt; cA = nA; cB = nB; ++ui;
    }
    PG8_WAIT_V(0);
    if (wr == 0) PG8_BAR;
    PG8_BAR;
    if constexpr (Epi::AFTER_DRAIN) { E.fused(acc, cur, wr, wc, fr, fq, lds, wid, lane); S.done(cur); }
    PG8_STAMP();
    if (STAMP && wid == 0) { stamps[lane] = lane < nts ? (((unsigned long long)(unsigned)ts_hi << 32) | (unsigned)ts_lo) : 0ull;
        if (lane == 62) stamps[62] = rt_entry; if (lane == 63) stamps[63] = (unsigned long long)0ull; }
#undef PG8_STAMP
#undef PG8_SA
#undef PG8_SB
#undef PG8_STAGE
#undef PG8_LDA
#undef PG8_LDB
#undef PG8_MMA
#undef PG8_WAIT_V
#undef PG8_WAIT_L
#undef PG8_BAR
#undef PG8_SCHED
}
}

namespace {
constexpr int D = 1024, BATCH = 2, SEQ = 8192, T = BATCH * SEQ;
constexpr int PW = 2312;
constexpr int PS = 2304;
constexpr int OQ = 0, OKK = 512, OV = 640, OZ = 768, OXBC = 1280, ODT = 2304;
constexpr float EPS = 1e-6f;
constexpr int NTHR = 512;
typedef unsigned short bf16;
typedef unsigned v4u __attribute__((ext_vector_type(4)));

constexpr size_t MiB = 1u << 20;
constexpr size_t WS_WIN = 1 * MiB;
constexpr size_t WS_KH = 5 * MiB + 512 * 1024;
constexpr size_t WS_WO = 6 * MiB;
constexpr size_t WS_WQ = 8 * MiB;
constexpr size_t WS_PROJ = 10 * MiB;
constexpr size_t WS_XNB = 82 * MiB;
constexpr size_t WS_XACT = 114 * MiB;
constexpr size_t WS_DTRAW = 146 * MiB;
constexpr size_t WS_DT = WS_DTRAW + 512 * 1024;
constexpr size_t WS_ACS = WS_DT + 512 * 1024;
constexpr size_t WS_CDEC = WS_ACS + 512 * 1024;
constexpr size_t WS_STATES = 164 * MiB;
constexpr size_t WS_PREV = 196 * MiB;
constexpr size_t WS_QP = 10 * MiB;
constexpr size_t WS_IDX = 74 * MiB;
constexpr size_t WS_GATE = 114 * MiB;
constexpr size_t WS_TOPV = 122 * MiB;
constexpr size_t WS_TOPI = 138 * MiB;
constexpr size_t WS_ACT = 122 * MiB;
constexpr size_t WS_SU = 245 * MiB;
constexpr size_t WS_U8 = 212 * MiB;
constexpr size_t WS_V8 = 148 * MiB;
constexpr size_t WS_PART = 10 * MiB;
constexpr size_t WS_XQ = 228 * MiB;
constexpr size_t WS_XS = 244 * MiB;
constexpr size_t WS_PEERO = 10 * MiB;
constexpr size_t WS_END = 246 * MiB;
constexpr int CW_QU = 4096, CW_QV = 4096 + 64 * 16;
constexpr int NPART = 8, NCHUNK = T / 64;

struct Args {
    const float* x; const float* norm_mix_g; const float* w_in; const float* attn_sinks; const float* attn_out_g;
    const float* conv_w; const float* conv_b; const float* dt_bias; const float* a_log; const float* d_skip;
    const float* ssm_norm_g; const float* w_out; const float* norm_ffn_g; const float* peer_wq; const float* peer_sub_keys;
    const float* peer_u; const float* peer_v; const float* final_norm_g;
    float* out; unsigned char* ws;
    int ph_lo, ph_hi;
};

#define LAS __attribute__((address_space(3)))
#define LDS_WAIT() asm volatile("s_waitcnt lgkmcnt(0)" ::: "memory")
__device__ __forceinline__ float bf2f(bf16 v) { return __uint_as_float(((unsigned)v) << 16); }
__device__ __forceinline__ unsigned f2bfu(float f) { unsigned u = __float_as_uint(f); return (u + 0x7fffu + ((u >> 16) & 1u)) >> 16; }
__device__ __forceinline__ bf16 f2bf(float f) { return (bf16)f2bfu(f); }
__device__ __forceinline__ unsigned pk2(float lo, float hi) { return f2bfu(lo) | (f2bfu(hi) << 16); }
__device__ __forceinline__ float wave_sum(float v) {
#pragma unroll
    for (int o = 1; o < 64; o <<= 1) v += __shfl_xor(v, o);
    return v;
}
__device__ __forceinline__ float silu_f(float v) { return v / (1.f + __expf(-v)); }

__device__ __forceinline__ void transpose_item(const float* W, int ldw, int K, bf16* WT, LAS float* scr, int kb, int nbk, int lane) {
    const int k0 = 64 * kb, n0 = 32 * nbk;
#pragma unroll 8
    for (int i = 0; i < 32; ++i) { const int kk = 2 * i + (lane >> 5); scr[kk * 33 + (lane & 31)] = W[(size_t)(k0 + kk) * ldw + n0 + (lane & 31)]; }
    LDS_WAIT();
    const int c = lane & 7;
#pragma unroll
    for (int j = 0; j < 4; ++j) { const int n = (lane >> 3) + 8 * j; const LAS float* s = scr + (8 * c) * 33 + n;
        v4u o; o.x = pk2(s[0 * 33], s[1 * 33]); o.y = pk2(s[2 * 33], s[3 * 33]); o.z = pk2(s[4 * 33], s[5 * 33]); o.w = pk2(s[6 * 33], s[7 * 33]);
        *(v4u*)(WT + (size_t)(n0 + n) * K + k0 + 8 * c) = o; }
    LDS_WAIT();
}

template <int MODE  >
__device__ __forceinline__ void rmsnorm_rows_bf16(const float* in, const float* g, bf16* outp, const LAS unsigned char* ldsb, float* dtraw, unsigned char* xq, float* xs, int gwave, int nwaves, int lane) {
    for (int row = gwave; row < T; row += nwaves) {
        const float4* xr = (const float4*)(in + (size_t)row * D) + lane; const uint2* xb = (const uint2*)((const bf16*)in + (size_t)row * D) + lane;
        float4 v[4]; float ss = 0.f;
#pragma unroll
        for (int j = 0; j < 4; ++j) {
            if (MODE == 2) { const uint2 w = xb[64 * j]; v[j] = make_float4(__uint_as_float(w.x << 16), __uint_as_float(w.x & 0xffff0000u), __uint_as_float(w.y << 16), __uint_as_float(w.y & 0xffff0000u)); }
            else v[j] = xr[64 * j];
            ss += v[j].x * v[j].x + v[j].y * v[j].y + v[j].z * v[j].z + v[j].w * v[j].w; }
        ss = wave_sum(ss);
        const float r = rsqrtf(ss * (1.f / D) + EPS);
        unsigned long long* o8 = (unsigned long long*)(outp + (size_t)row * D) + lane;
        float dacc[8]; float y[4][4]; float mx = 0.f;
#pragma unroll
        for (int h = 0; h < 8; ++h) dacc[h] = 0.f;
#pragma unroll
        for (int j = 0; j < 4; ++j) {
            const float4 gv = ((const float4*)g)[lane + 64 * j];
            y[j][0] = v[j].x * r * gv.x; y[j][1] = v[j].y * r * gv.y; y[j][2] = v[j].z * r * gv.z; y[j][3] = v[j].w * r * gv.w;
            o8[64 * j] = (unsigned long long)pk2(y[j][0], y[j][1]) | ((unsigned long long)pk2(y[j][2], y[j][3]) << 32);
            if (MODE == 2) mx = fmaxf(mx, fmaxf(fmaxf(fabsf(y[j][0]), fabsf(y[j][1])), fmaxf(fabsf(y[j][2]), fabsf(y[j][3]))));
            if (MODE == 1) {
#pragma unroll
                for (int h = 0; h < 8; ++h) {
                    typedef float f4v __attribute__((ext_vector_type(4)));
                    const f4v wv = *(const LAS f4v*)(ldsb + h * 16384 + 8448 + (256 * j + 4 * lane) * 4);
                    dacc[h] += y[j][0] * wv.x + y[j][1] * wv.y + y[j][2] * wv.z + y[j][3] * wv.w;
                }
            }
        }
        if (MODE == 1) {
#pragma unroll
            for (int h = 0; h < 8; ++h) dacc[h] = wave_sum(dacc[h]);
            if (lane == 0) { float4* dp = (float4*)(dtraw + (size_t)row * 8); dp[0] = make_float4(dacc[0], dacc[1], dacc[2], dacc[3]); dp[1] = make_float4(dacc[4], dacc[5], dacc[6], dacc[7]); }
        }
        if (MODE == 2) {
#pragma unroll
            for (int o = 1; o < 64; o <<= 1) mx = fmaxf(mx, __shfl_xor(mx, o));
            const float sc = mx > 0.f ? mx * (1.f / 127.f) : 1.f, inv = 1.f / sc;
            unsigned* dq = (unsigned*)(xq + (size_t)row * D) + lane;
#pragma unroll
            for (int j = 0; j < 4; ++j) { const int q0 = (int)rintf(y[j][0] * inv), q1 = (int)rintf(y[j][1] * inv), q2 = (int)rintf(y[j][2] * inv), q3 = (int)rintf(y[j][3] * inv);
                dq[64 * j] = (unsigned)(q0 & 255) | ((unsigned)(q1 & 255) << 8) | ((unsigned)(q2 & 255) << 16) | ((unsigned)(q3 & 255) << 24); }
            if (lane == 0) xs[row] = sc;
        }
    }
}

typedef short bf16x8 __attribute__((ext_vector_type(8)));
typedef short bf16x4 __attribute__((ext_vector_type(4)));
typedef float f32x16 __attribute__((ext_vector_type(16)));
typedef __bf16 bf2_t __attribute__((ext_vector_type(2)));
#define MFMA32(a, b, c) __builtin_amdgcn_mfma_f32_32x32x16_bf16((a), (b), (c), 0, 0, 0)
__device__ __forceinline__ unsigned pkbf(float lo, float hi) { bf2_t v = {(__bf16)lo, (__bf16)hi}; return __builtin_bit_cast(unsigned, v); }
__device__ __forceinline__ short bfs(float f) { return __builtin_bit_cast(short, (__bf16)f); }
__device__ __forceinline__ float sbf2f(short v) { return __uint_as_float(((unsigned)(unsigned short)v) << 16); }
__device__ __forceinline__ int crow(int i, int hi) { return (i & 3) + 8 * (i >> 2) + 4 * hi; }
template <int S> __device__ __forceinline__ bf16x8 pack8(const f32x16& x) {
    v4u p; p.x = pkbf(x[8 * S], x[8 * S + 1]); p.y = pkbf(x[8 * S + 2], x[8 * S + 3]); p.z = pkbf(x[8 * S + 4], x[8 * S + 5]); p.w = pkbf(x[8 * S + 6], x[8 * S + 7]);
    return __builtin_bit_cast(bf16x8, p);
}
__device__ __forceinline__ bf16x8 ldg8(const bf16* p) { return *(const bf16x8*)p; }
__device__ __forceinline__ bf16x8 lds8(const LAS bf16* p) { return *(const LAS bf16x8*)p; }
__device__ __forceinline__ bf16x8 lds4x2(const LAS bf16* p) { const bf16x4 a = *(const LAS bf16x4*)p, b = *(const LAS bf16x4*)(p + 8); return __builtin_shufflevector(a, b, 0, 1, 2, 3, 4, 5, 6, 7); }
__device__ __forceinline__ f32x16 zero16() { f32x16 z;
#pragma unroll
    for (int i = 0; i < 16; ++i) z[i] = 0.f;
    return z; }

__device__ __forceinline__ void attn_unit(const float* sinks, const float* gnorm, LAS unsigned char* ldsb, int unit, const bf16* PROJ, bf16* MIXB, int tid, int lane, int wave) {
    asm volatile("" : "+v"(tid), "+v"(lane));
    const int tok0 = unit * 64, s0 = tok0 & (SEQ - 1), kbase = tok0 - 128;
    LAS bf16* VT = (LAS bf16*)ldsb;
    const __amdgpu_buffer_rsrc_t rsP = __builtin_amdgcn_make_buffer_rsrc((void*)PROJ, 0, (unsigned)T * PS * 2u, 0x00020000);
    LAS float* SSQ = (LAS float*)(ldsb + 51200);
    LAS unsigned* OST = (LAS unsigned*)(ldsb + 53248) + wave * (2 * 17 * 64);
#pragma unroll
    for (int i = 0; i < 6; ++i) {
        const int c = tid + 512 * i, kv = c / 1536, cc = c - kv * 1536, key = cc >> 3, d0 = (cc & 7) * 8; const bool valid = (s0 - 128 + key) >= 0;
        bf16x8 v;
#pragma unroll
        for (int e = 0; e < 8; ++e) v[e] = 0;
        if (valid) v = __builtin_bit_cast(bf16x8, __builtin_amdgcn_raw_buffer_load_b128(rsP, (int)(((unsigned)(kbase + key) * (unsigned)PS + (unsigned)(OV + kv * 64 + d0)) * 2u), 0, 0));
#pragma unroll
        for (int e = 0; e < 8; ++e) VT[kv * 12800 + (d0 + e) * 200 + key] = (bf16)v[e];
    }
    __syncthreads();
    const int r = lane & 31, hi = lane >> 5;
    const int hq = wave, hkv = wave >> 2;
    const float slope = exp2f(-(float)(hq + 1)), sink = sinks[hq];
#pragma unroll 1
    for (int qt = 0; qt < 2; ++qt) {
        const int tq = tok0 + 32 * qt + r;
        bf16x8 qf[4];
        { const bf16* qp = PROJ + (size_t)tq * PS + OQ + hq * 64 + 8 * hi; asm volatile("" : "+v"(qp));
#pragma unroll
          for (int ks = 0; ks < 4; ++ks) qf[ks] = ldg8(qp + 16 * ks); }
        const int ql = 32 * qt + r;
        float m = sink, lh = 0.f;
        f32x16 O0 = zero16(), O1 = zero16();
        bf16x8 kfn[4];
        { const int key = 32 * qt + r; const bool kvalid = (s0 - 128 + key) >= 0;
          const bf16* kp = PROJ + (size_t)(kvalid ? (kbase + key) : tok0) * PS + OKK + hkv * 64 + 8 * hi; asm volatile("" : "+v"(kp));
#pragma unroll
          for (int ks = 0; ks < 4; ++ks) kfn[ks] = ldg8(kp + 16 * ks); }
#pragma unroll 1
        for (int kt = 0; kt < 5; ++kt) {
            bf16x8 kf[4];
#pragma unroll
            for (int ks = 0; ks < 4; ++ks) kf[ks] = kfn[ks];
            { const int ktn = kt < 4 ? kt + 1 : 4; const int key = 32 * (qt + ktn) + r; const bool kvalid = (s0 - 128 + key) >= 0;
              const bf16* kp = PROJ + (size_t)(kvalid ? (kbase + key) : tok0) * PS + OKK + hkv * 64 + 8 * hi; asm volatile("" : "+v"(kp));
#pragma unroll
              for (int ks = 0; ks < 4; ++ks) kfn[ks] = ldg8(kp + 16 * ks); }
            f32x16 X = zero16();
#pragma unroll
            for (int ks = 0; ks < 4; ++ks) X = MFMA32(kf[ks], qf[ks], X);
            float tm = -1e30f;
#pragma unroll
            for (int i = 0; i < 16; ++i) {
                const int kl = 32 * (qt + kt) + crow(i, hi), dist = 128 + ql - kl;
                const bool valid = (dist >= 0) && (dist < 128) && ((s0 - 128 + kl) >= 0);
                const float lg = valid ? (X[i] * 0.125f - slope * (float)dist) : -1e30f;
                X[i] = lg; tm = fmaxf(tm, lg);
            }
            tm = fmaxf(tm, __shfl_xor(tm, 32));
            const float mn = fmaxf(m, tm), sc = __expf(m - mn);
            m = mn; lh *= sc;
#pragma unroll
            for (int i = 0; i < 16; ++i) { O0[i] *= sc; O1[i] *= sc; const float pe = __expf(X[i] - mn); X[i] = pe; lh += pe; }
            const LAS bf16* vp = VT + hkv * 12800 + r * 200 + 32 * (qt + kt) + 4 * hi;
            { const bf16x8 xs = pack8<0>(X); const bf16x8 a0 = lds4x2(vp), a1 = lds4x2(vp + 32 * 200); O0 = MFMA32(a0, xs, O0); O1 = MFMA32(a1, xs, O1); }
            { const bf16x8 xs = pack8<1>(X); const bf16x8 a0 = lds4x2(vp + 16), a1 = lds4x2(vp + 32 * 200 + 16); O0 = MFMA32(a0, xs, O0); O1 = MFMA32(a1, xs, O1); }
        }
        const float lsum = lh + __shfl_xor(lh, 32) + __expf(sink - m);
        const float iv = 1.f / lsum;
        float sq = 0.f;
#pragma unroll
        for (int i = 0; i < 16; ++i) sq += O0[i] * O0[i] + O1[i] * O1[i];
        sq *= iv * iv; sq += __shfl_xor(sq, 32);
        if (hi == 0) SSQ[hq * 64 + 32 * qt + r] = sq;
#pragma unroll
        for (int i = 0; i < 8; ++i) { OST[(qt * 17 + i) * 64 + lane] = pkbf(O0[2 * i], O0[2 * i + 1]); OST[(qt * 17 + 8 + i) * 64 + lane] = pkbf(O1[2 * i], O1[2 * i + 1]); }
        OST[(qt * 17 + 16) * 64 + lane] = __float_as_uint(iv);
    }
    __syncthreads();
#pragma unroll 1
    for (int qt = 0; qt < 2; ++qt) {
        float tot = 0.f;
#pragma unroll
        for (int h = 0; h < 8; ++h) tot += SSQ[h * 64 + 32 * qt + r];
        const float sc = __uint_as_float(OST[(qt * 17 + 16) * 64 + lane]) * rsqrtf(tot * (1.f / 512.f) + EPS);
        bf16* orow = MIXB + (size_t)(tok0 + 32 * qt + r) * D + hq * 64 + 4 * hi;
#pragma unroll
        for (int dt = 0; dt < 2; ++dt)
#pragma unroll
            for (int q4 = 0; q4 < 4; ++q4) {
                const float4 gv = *(const float4*)(gnorm + hq * 64 + 32 * dt + 8 * q4 + 4 * hi);
                const unsigned p0 = OST[(qt * 17 + 8 * dt + 2 * q4) * 64 + lane], p1 = OST[(qt * 17 + 8 * dt + 2 * q4 + 1) * 64 + lane];
                uint2 w; w.x = pkbf(__uint_as_float(p0 << 16) * sc * gv.x, __uint_as_float(p0 & 0xffff0000u) * sc * gv.y); w.y = pkbf(__uint_as_float(p1 << 16) * sc * gv.z, __uint_as_float(p1 & 0xffff0000u) * sc * gv.w);
                *(uint2*)(orow + 32 * dt + 8 * q4) = w;
            }
    }
    __syncthreads();
}

__device__ __forceinline__ void ssd_chunk_unit(LAS unsigned char* ldsb, int unit, const bf16* PROJ, bf16* XACT, const float* DTRAW, const float* conv_w, const float* conv_b, const float* dt_bias, const float* a_log,
                                               float* ACS, float* CDEC, float* MIXF, float* STATES, int tid, int lane, int wave) {
    asm volatile("" : "+v"(tid), "+v"(lane));
    const int g = unit & 1, bc = unit >> 1, tok0 = bc * 128;
    LAS float* DTT = (LAS float*)(ldsb + 34816 * 3 + 2048);
    LAS float* WT = (LAS float*)(ldsb + 34816 * 3 + 4096);
    {
        const int cgi = tid & 63, t0 = tok0 + 16 * (tid >> 6);
        const int c0 = cgi < 32 ? g * 256 + cgi * 8 : (cgi < 48 ? 512 + g * 128 + (cgi - 32) * 8 : 768 + g * 128 + (cgi - 48) * 8);
        float w[4][8], bs[8];
#pragma unroll
        for (int k = 0; k < 4; ++k) { const float4 a0 = *(const float4*)(conv_w + k * 1024 + c0), a1 = *(const float4*)(conv_w + k * 1024 + c0 + 4);
            w[k][0] = a0.x; w[k][1] = a0.y; w[k][2] = a0.z; w[k][3] = a0.w; w[k][4] = a1.x; w[k][5] = a1.y; w[k][6] = a1.z; w[k][7] = a1.w; }
        { const float4 a0 = *(const float4*)(conv_b + c0), a1 = *(const float4*)(conv_b + c0 + 4); bs[0] = a0.x; bs[1] = a0.y; bs[2] = a0.z; bs[3] = a0.w; bs[4] = a1.x; bs[5] = a1.y; bs[6] = a1.z; bs[7] = a1.w; }
        const bool has_halo = (t0 & (SEQ - 1)) != 0;
        bf16x8 rows[19];
#pragma unroll
        for (int i = 0; i < 19; ++i) {
            if (i < 3 && !has_halo) {
#pragma unroll
                for (int e = 0; e < 8; ++e) rows[i][e] = 0;
            } else rows[i] = ldg8(PROJ + (size_t)(t0 + i - 3) * PS + OXBC + c0);
        }
#pragma unroll
        for (int i = 0; i < 16; ++i) {
            float o[8];
#pragma unroll
            for (int e = 0; e < 8; ++e) o[e] = silu_f(bs[e] + w[0][e] * sbf2f(rows[i][e]) + w[1][e] * sbf2f(rows[i + 1][e]) + w[2][e] * sbf2f(rows[i + 2][e]) + w[3][e] * sbf2f(rows[i + 3][e]));
            v4u ov; ov.x = pkbf(o[0], o[1]); ov.y = pkbf(o[2], o[3]); ov.z = pkbf(o[4], o[5]); ov.w = pkbf(o[6], o[7]);
            *(v4u*)(XACT + (size_t)(t0 + i) * 1024 + c0) = ov;
        }
    }
    LAS float* ACST = (LAS float*)(ldsb + 34816 * 3);
    {
        const int s = tid >> 2, hh = tid & 3, H = g * 4 + hh;
        const float A = -__expf(a_log[H]);
        const float raw = DTRAW[(size_t)(tok0 + s) * 8 + H] + dt_bias[H];
        const float dtv = fmaxf(raw, 0.f) + log1pf(__expf(-fabsf(raw)));
        float v = dtv * A;
#pragma unroll
        for (int o = 4; o < 64; o <<= 1) { const float y = __shfl_up(v, o); if (lane >= o) v += y; }
        if (lane >= 60) WT[wave * 4 + hh] = v;
        __syncthreads();
        float off = 0.f;
        for (int w2 = 0; w2 < wave; ++w2) off += WT[w2 * 4 + hh];
        v += off;
        DTT[tid] = dtv; ACST[tid] = v; ACS[(size_t)(tok0 + s) * 8 + H] = v;
        if (s == 127) CDEC[bc * 8 + H] = __expf(v);
    }
    asm volatile("s_waitcnt vmcnt(0)" ::: "memory");
    __syncthreads();
    LAS bf16* BT = (LAS bf16*)ldsb;
    LAS bf16* XD = (LAS bf16*)(ldsb + 34816);
    LAS bf16* XW = (LAS bf16*)(ldsb + 34816 + 34816);
    const int r = lane & 31, hi = lane >> 5;
#pragma unroll
    for (int i = 0; i < 4; ++i) {
        const int c = tid + 512 * i, s = c >> 4, n0 = (c & 15) * 8;
        const bf16x8 v = ldg8(XACT + (size_t)(tok0 + s) * 1024 + 512 + g * 128 + n0);
#pragma unroll
        for (int e = 0; e < 8; ++e) BT[(n0 + e) * 136 + s] = (bf16)v[e];
    }
#pragma unroll 1
    for (int hp = 0; hp < 2; ++hp) {
        if (hp) __syncthreads();
        int tidp = tid; asm volatile("" : "+v"(tidp));
#pragma unroll
        for (int i = 0; i < 4; ++i) {
            const int c = tidp + 512 * i, hsel = c >> 10, s = (c >> 3) & 127, p0 = (c & 7) * 8, H = g * 4 + 2 * hp + hsel;
            const bf16x8 v = ldg8(XACT + (size_t)(tok0 + s) * 1024 + H * 64 + p0);
            const float dtv = DTT[s * 4 + 2 * hp + hsel];
            const float w = __expf(ACST[127 * 4 + 2 * hp + hsel] - ACST[s * 4 + 2 * hp + hsel]);
#pragma unroll
            for (int e = 0; e < 8; ++e) { const float xd = sbf2f(v[e]) * dtv; XD[hsel * 8704 + (p0 + e) * 136 + s] = (bf16)bfs(xd); XW[hsel * 8704 + (p0 + e) * 136 + s] = (bf16)bfs(xd * w); }
        }
        __syncthreads();
        {
            const int lt = wave & 3, hsel = wave >> 2, hh = 2 * hp + hsel, H = g * 4 + hh;
            const int l = 32 * lt + r; const float acs_l = ACST[l * 4 + hh];
            bf16x8 cf[8];
            { const bf16* cp = XACT + (size_t)(tok0 + l) * 1024 + 768 + g * 128 + 8 * hi; asm volatile("" : "+v"(cp));
#pragma unroll
              for (int ks = 0; ks < 8; ++ks) cf[ks] = ldg8(cp + 16 * ks); }
            f32x16 Z0 = zero16(), Z1 = zero16();
            bf16x8 bn[8];
            { const bf16* bp = XACT + (size_t)(tok0 + r) * 1024 + 512 + g * 128 + 8 * hi; asm volatile("" : "+v"(bp));
#pragma unroll
              for (int ks = 0; ks < 8; ++ks) bn[ks] = ldg8(bp + 16 * ks); }
#pragma unroll 1
            for (int st = 0; st <= lt; ++st) {
                f32x16 X = zero16();
                bf16x8 bc[8];
#pragma unroll
                for (int ks = 0; ks < 8; ++ks) bc[ks] = bn[ks];
                { const int stn = st < lt ? st + 1 : lt; const bf16* bp = XACT + (size_t)(tok0 + 32 * stn + r) * 1024 + 512 + g * 128 + 8 * hi; asm volatile("" : "+v"(bp));
#pragma unroll
                  for (int ks = 0; ks < 8; ++ks) bn[ks] = ldg8(bp + 16 * ks); }
#pragma unroll
                for (int ks = 0; ks < 8; ++ks) X = MFMA32(bc[ks], cf[ks], X);
#pragma unroll
                for (int i = 0; i < 16; ++i) { const int s = 32 * st + crow(i, hi); const float f = (s <= l) ? __expf(acs_l - ACST[s * 4 + hh]) : 0.f; X[i] *= f; }
                const int sb = 32 * st + 4 * hi;
                { const bf16x8 xs = pack8<0>(X); const bf16x8 b0 = lds4x2(XD + hsel * 8704 + r * 136 + sb), b1 = lds4x2(XD + hsel * 8704 + (32 + r) * 136 + sb); Z0 = MFMA32(xs, b0, Z0); Z1 = MFMA32(xs, b1, Z1); }
                { const bf16x8 xs = pack8<1>(X); const bf16x8 b0 = lds4x2(XD + hsel * 8704 + r * 136 + sb + 16), b1 = lds4x2(XD + hsel * 8704 + (32 + r) * 136 + sb + 16); Z0 = MFMA32(xs, b0, Z0); Z1 = MFMA32(xs, b1, Z1); }
            }
#pragma unroll
            for (int i = 0; i < 16; ++i) { float* o = MIXF + (size_t)(tok0 + 32 * lt + crow(i, hi)) * D + 512 + H * 64 + r; o[0] = Z0[i]; o[32] = Z1[i]; }
        }
        {
            const int nt = wave & 3, hsel = wave >> 2, H = g * 4 + 2 * hp + hsel;
            f32x16 S0 = zero16(), S1 = zero16();
#pragma unroll
            for (int ks = 0; ks < 8; ++ks) {
                const bf16x8 btf = lds8(BT + (32 * nt + r) * 136 + 16 * ks + 8 * hi);
                const bf16x8 a0 = lds8(XW + hsel * 8704 + r * 136 + 16 * ks + 8 * hi), a1 = lds8(XW + hsel * 8704 + (32 + r) * 136 + 16 * ks + 8 * hi);
                S0 = MFMA32(a0, btf, S0); S1 = MFMA32(a1, btf, S1);
            }
            float* sp = STATES + (size_t)(bc * 8 + H) * 8192 + 32 * nt + r;
#pragma unroll
            for (int i = 0; i < 16; ++i) { const int p = crow(i, hi); sp[p * 128] = S0[i]; sp[(32 + p) * 128] = S1[i]; }
        }
    }
    __syncthreads();
}

__device__ __forceinline__ __amdgpu_buffer_rsrc_t mk_rsrc(const void* p, unsigned bytes) { return __builtin_amdgcn_make_buffer_rsrc((void*)p, 0, bytes, 0x00020000); }
__device__ __forceinline__ void yoff_unit(const float* d_skip, const float* gnorm, LAS unsigned char* ldsb, int unit, const bf16* XACT, const bf16* PROJ, const float* ACS, const bf16* PREVT,
                                          const float* MIXF, bf16* MIXB, int lane, int wave) {
    const int g = unit & 1, bc = unit >> 1, tok0 = bc * 128;
    const int r = lane & 31, hi = lane >> 5, lt = wave & 3, hpair = wave >> 2;
    LAS float* TAB = (LAS float*)ldsb;
    const __amdgpu_buffer_rsrc_t rsF = mk_rsrc(MIXF, (unsigned)T * D * 4u), rsX = mk_rsrc(XACT, (unsigned)T * 1024u * 2u), rsP = mk_rsrc(PROJ, (unsigned)T * PS * 2u), rsA = mk_rsrc(ACS, (unsigned)T * 32u), rsB = mk_rsrc(MIXB, (unsigned)T * D * 2u);
    const unsigned tb = (unsigned)(tok0 + 32 * lt + 4 * hi);
    bf16x8 cf[8];
    { const bf16* cp = XACT + (size_t)(tok0 + 32 * lt + r) * 1024 + 768 + g * 128 + 8 * hi; asm volatile("" : "+v"(cp));
#pragma unroll
      for (int ks = 0; ks < 8; ++ks) cf[ks] = ldg8(cp + 16 * ks); }
    float eav[16], ssq[16];
    unsigned ypk[2][2][8];
#pragma unroll
    for (int i = 0; i < 16; ++i) ssq[i] = 0.f;
#pragma unroll
    for (int hsel = 0; hsel < 2; ++hsel) {
        const int H = g * 4 + 2 * hpair + hsel; const bf16* pv = PREVT + (size_t)(bc * 8 + H) * 8192 + 8 * hi;
        asm volatile("" : "+v"(pv));
        f32x16 Y0 = zero16(), Y1 = zero16();
#pragma unroll
        for (int ks = 0; ks < 8; ++ks) {
            const bf16x8 b0 = ldg8(pv + r * 128 + 16 * ks), b1 = ldg8(pv + (32 + r) * 128 + 16 * ks);
            Y0 = MFMA32(cf[ks], b0, Y0); Y1 = MFMA32(cf[ks], b1, Y1);
        }
        const float dsk = d_skip[H];
        { const unsigned vo = (tb * 8u + (unsigned)H) * 4u;
#pragma unroll
          for (int i = 0; i < 16; ++i) eav[i] = __expf(__builtin_bit_cast(float, __builtin_amdgcn_raw_buffer_load_b32(rsA, (int)vo, ((i & 3) + 8 * (i >> 2)) * 32, 0))); }
#pragma unroll
        for (int pt = 0; pt < 2; ++pt) {
            const unsigned col = (unsigned)(H * 64 + 32 * pt + r);
            const unsigned voF = (tb * 1024u + 512u + col) * 4u, voX = (tb * 1024u + col) * 2u, voP = (tb * (unsigned)PS + (unsigned)OZ + col) * 2u;
            float yo[16], xsv[16], zv[16];
#pragma unroll
            for (int i = 0; i < 16; ++i) { const int ro = (i & 3) + 8 * (i >> 2);
                yo[i] = __builtin_bit_cast(float, __builtin_amdgcn_raw_buffer_load_b32(rsF, (int)voF, ro * 4096, 0));
                xsv[i] = bf2f((bf16)__builtin_amdgcn_raw_buffer_load_b16(rsX, (int)voX, ro * 2048, 0));
                zv[i] = bf2f((bf16)__builtin_amdgcn_raw_buffer_load_b16(rsP, (int)voP, ro * (PS * 2), 0)); }
#pragma unroll
            for (int i = 0; i < 16; i += 2) {
                const float y0 = (yo[i] + eav[i] * (pt ? Y1[i] : Y0[i]) + dsk * xsv[i]) * silu_f(zv[i]);
                const float y1 = (yo[i + 1] + eav[i + 1] * (pt ? Y1[i + 1] : Y0[i + 1]) + dsk * xsv[i + 1]) * silu_f(zv[i + 1]);
                ssq[i] += y0 * y0; ssq[i + 1] += y1 * y1; ypk[hsel][pt][i >> 1] = pkbf(y0, y1);
            }
            __builtin_amdgcn_sched_barrier(0);
        }
    }
#pragma unroll
    for (int i = 0; i < 16; ++i) {
#pragma unroll
        for (int o = 1; o < 32; o <<= 1) ssq[i] += __shfl_xor(ssq[i], o);
    }
    if (r == 0) {
#pragma unroll
        for (int i = 0; i < 16; ++i) TAB[hpair * 128 + 32 * lt + crow(i, hi)] = ssq[i];
    }
    __syncthreads();
#pragma unroll
    for (int i = 0; i < 16; ++i) { const int l = 32 * lt + crow(i, hi); ssq[i] = rsqrtf((TAB[l] + TAB[128 + l]) * (1.f / 256.f) + EPS); }
#pragma unroll
    for (int hsel = 0; hsel < 2; ++hsel)
#pragma unroll
        for (int pt = 0; pt < 2; ++pt) {
            const unsigned col = (unsigned)((g * 4 + 2 * hpair + hsel) * 64 + 32 * pt + r); const float gn = gnorm[col];
            const unsigned voB = (tb * 1024u + 512u + col) * 2u;
#pragma unroll
            for (int i = 0; i < 16; ++i) { const unsigned w = ypk[hsel][pt][i >> 1];
                const float yf = (i & 1) ? __uint_as_float(w & 0xffff0000u) : __uint_as_float(w << 16);
                __builtin_amdgcn_raw_buffer_store_b16((short)f2bf(yf * ssq[i] * gn), rsB, (int)voB, ((i & 3) + 8 * (i >> 2)) * 2048, 0); }
        }
    __syncthreads();
}
typedef float f32x2 __attribute__((ext_vector_type(2)));
__device__ __forceinline__ void fp8x16_to_f32(const uint4 w, float (&f)[16]) {
    const int ww[4] = {(int)w.x, (int)w.y, (int)w.z, (int)w.w};
#pragma unroll
    for (int q = 0; q < 4; ++q) { const f32x2 a = __builtin_amdgcn_cvt_pk_f32_fp8(ww[q], false), b = __builtin_amdgcn_cvt_pk_f32_fp8(ww[q], true); f[4 * q] = a.x; f[4 * q + 1] = a.y; f[4 * q + 2] = b.x; f[4 * q + 3] = b.y; }
}
template <int M4, int M2, int M1> __device__ __forceinline__ void treduce16(const float (&a)[16], int lane, float& r0, float& r1) {
    float b[8], c[4];
    { const bool hi = (lane & M4) != 0;
#pragma unroll
      for (int i = 0; i < 8; ++i) { const float send = hi ? a[i] : a[i + 8]; const float recv = __shfl_xor(send, M4); b[i] = (hi ? a[i + 8] : a[i]) + recv; } }
    { const bool hi = (lane & M2) != 0;
#pragma unroll
      for (int i = 0; i < 4; ++i) { const float send = hi ? b[i] : b[i + 4]; const float recv = __shfl_xor(send, M2); c[i] = (hi ? b[i + 4] : b[i]) + recv; } }
    { const bool hi = (lane & M1) != 0;
      { const float send = hi ? c[0] : c[2]; const float recv = __shfl_xor(send, M1); r0 = (hi ? c[2] : c[0]) + recv; }
      { const float send = hi ? c[1] : c[3]; const float recv = __shfl_xor(send, M1); r1 = (hi ? c[3] : c[1]) + recv; } }
}
template <int M4, int M2, int M1> __device__ __forceinline__ void treduce16i(const int (&a)[16], int lane, int& r0, int& r1) {
    int b[8], c[4];
    { const bool hi = (lane & M4) != 0;
#pragma unroll
      for (int i = 0; i < 8; ++i) { const int send = hi ? a[i] : a[i + 8]; const int recv = __shfl_xor(send, M4); b[i] = (hi ? a[i + 8] : a[i]) + recv; } }
    { const bool hi = (lane & M2) != 0;
#pragma unroll
      for (int i = 0; i < 4; ++i) { const int send = hi ? b[i] : b[i + 4]; const int recv = __shfl_xor(send, M2); c[i] = (hi ? b[i + 4] : b[i]) + recv; } }
    { const bool hi = (lane & M1) != 0;
      { const int send = hi ? c[0] : c[2]; const int recv = __shfl_xor(send, M1); r0 = (hi ? c[2] : c[0]) + recv; }
      { const int send = hi ? c[1] : c[3]; const int recv = __shfl_xor(send, M1); r1 = (hi ? c[3] : c[1]) + recv; } }
}
#define PE_ID(E, i) (((i) & 1) ? (E[(i) >> 1] >> 16) : (E[(i) >> 1] & 0xffffu))
__device__ __forceinline__ void peer_u_item(int p, int j, const unsigned short* __restrict__ IDX, const unsigned char* __restrict__ XQ, const unsigned char* __restrict__ U8, int* __restrict__ PART, int lane, int wave) {
    asm volatile("" : "+v"(lane));
    const int gidx = lane >> 3; const unsigned coff = (unsigned)(p * 128 + (lane & 7) * 16);
#pragma unroll 1
    for (int it = 0; it < 8; ++it) {
        const int t = j * 64 + it * 8 + wave;
        unsigned E[8];
        { const uint4 e0 = *(const uint4*)(IDX + (size_t)t * 128 + 16 * gidx), e1 = *(const uint4*)(IDX + (size_t)t * 128 + 16 * gidx + 8);
          E[0] = e0.x; E[1] = e0.y; E[2] = e0.z; E[3] = e0.w; E[4] = e1.x; E[5] = e1.y; E[6] = e1.z; E[7] = e1.w; }
        uint4 uu[16];
#pragma unroll
        for (int i = 0; i < 16; ++i) uu[i] = *(const uint4*)(U8 + (size_t)(PE_ID(E, i) * 1024u + coff));
        const uint4 xq = *(const uint4*)(XQ + (size_t)t * D + coff);
        int d[16];
#pragma unroll
        for (int i = 0; i < 16; ++i) {
            int s = __builtin_amdgcn_sdot4((int)uu[i].x, (int)xq.x, 0, false); s = __builtin_amdgcn_sdot4((int)uu[i].y, (int)xq.y, s, false);
            s = __builtin_amdgcn_sdot4((int)uu[i].z, (int)xq.z, s, false); s = __builtin_amdgcn_sdot4((int)uu[i].w, (int)xq.w, s, false);
            d[i] = s;
        }
        int r0, r1; treduce16i<4, 2, 1>(d, lane, r0, r1);
        *(int2*)(PART + ((size_t)p * T + t) * 128 + 2 * lane) = make_int2(r0, r1);
    }
}
__device__ __forceinline__ void peer_v_item(int p, int j, const unsigned short* __restrict__ IDX, const unsigned char* __restrict__ ACTQ, const float* __restrict__ ACTS,
                                            const unsigned char* __restrict__ V8, bf16* __restrict__ PEERO, int lane, int wave) {
    asm volatile("" : "+v"(lane));
    const int gidx = lane >> 3; const unsigned coff = (unsigned)(p * 128 + (lane & 7) * 16);
#pragma unroll 1
    for (int it = 0; it < 8; ++it) {
        const int t = j * 64 + it * 8 + wave;
        unsigned E[8];
        { const uint4 e0 = *(const uint4*)(IDX + (size_t)t * 128 + 16 * gidx), e1 = *(const uint4*)(IDX + (size_t)t * 128 + 16 * gidx + 8);
          E[0] = e0.x; E[1] = e0.y; E[2] = e0.z; E[3] = e0.w; E[4] = e1.x; E[5] = e1.y; E[6] = e1.z; E[7] = e1.w; }
        uint4 vv[16];
#pragma unroll
        for (int i = 0; i < 16; ++i) vv[i] = *(const uint4*)(V8 + (size_t)(PE_ID(E, i) * 1024u + coff));
        const uint4 aq = *(const uint4*)(ACTQ + (size_t)t * 128 + 16 * gidx);
        const float asc = ACTS[t];
        const unsigned a4[4] = {aq.x, aq.y, aq.z, aq.w};
        int acc[16];
#pragma unroll
        for (int c = 0; c < 16; ++c) acc[c] = 0;
#pragma unroll
        for (int m = 0; m < 4; ++m) {
            const unsigned r0[4] = {vv[4 * m].x, vv[4 * m].y, vv[4 * m].z, vv[4 * m].w}, r1[4] = {vv[4 * m + 1].x, vv[4 * m + 1].y, vv[4 * m + 1].z, vv[4 * m + 1].w};
            const unsigned r2[4] = {vv[4 * m + 2].x, vv[4 * m + 2].y, vv[4 * m + 2].z, vv[4 * m + 2].w}, r3[4] = {vv[4 * m + 3].x, vv[4 * m + 3].y, vv[4 * m + 3].z, vv[4 * m + 3].w};
#pragma unroll
            for (int dc = 0; dc < 4; ++dc) {
                const unsigned ta = __builtin_amdgcn_perm(r1[dc], r0[dc], 0x05010400u), tb = __builtin_amdgcn_perm(r3[dc], r2[dc], 0x05010400u);
                const unsigned ua = __builtin_amdgcn_perm(r1[dc], r0[dc], 0x07030602u), ub = __builtin_amdgcn_perm(r3[dc], r2[dc], 0x07030602u);
                const unsigned c0 = __builtin_amdgcn_perm(tb, ta, 0x05040100u), c1 = __builtin_amdgcn_perm(tb, ta, 0x07060302u);
                const unsigned c2 = __builtin_amdgcn_perm(ub, ua, 0x05040100u), c3 = __builtin_amdgcn_perm(ub, ua, 0x07060302u);
                acc[4 * dc + 0] = __builtin_amdgcn_sdot4((int)c0, (int)a4[m], acc[4 * dc + 0], false);
                acc[4 * dc + 1] = __builtin_amdgcn_sdot4((int)c1, (int)a4[m], acc[4 * dc + 1], false);
                acc[4 * dc + 2] = __builtin_amdgcn_sdot4((int)c2, (int)a4[m], acc[4 * dc + 2], false);
                acc[4 * dc + 3] = __builtin_amdgcn_sdot4((int)c3, (int)a4[m], acc[4 * dc + 3], false);
            }
        }
        int r0i, r1i; treduce16i<32, 16, 8>(acc, lane, r0i, r1i);
        *(unsigned*)(PEERO + (size_t)t * D + coff + 2 * gidx) = pkbf(asc * (float)r0i, asc * (float)r1i);
    }
}

__device__ __forceinline__ void ce_desc(float& a, float& b) { const float hi = fmaxf(a, b), lo = fminf(a, b); a = hi; b = lo; }
__device__ __forceinline__ void sort16_desc(float (&v)[16]) {
#pragma unroll
    for (int k = 2; k <= 16; k <<= 1)
#pragma unroll
        for (int j = k >> 1; j > 0; j >>= 1)
#pragma unroll
            for (int i = 0; i < 16; ++i) { const int l = i ^ j; if (l > i) { if ((i & k) == 0) ce_desc(v[i], v[l]); else ce_desc(v[l], v[i]); } }
}
__device__ __forceinline__ void merge16_desc(float (&a)[16], const float (&b)[16]) {
#pragma unroll
    for (int i = 0; i < 16; ++i) a[i] = fmaxf(a[i], b[15 - i]);
#pragma unroll
    for (int j = 8; j > 0; j >>= 1)
#pragma unroll
        for (int i = 0; i < 16; ++i) { const int l = i ^ j; if (l > i) ce_desc(a[i], a[l]); }
}
__device__ __forceinline__ void ce_kv(float& ka, int& va, float& kb, int& vb) {
    const bool s = kb > ka; const float t0 = s ? kb : ka, t1 = s ? ka : kb; const int u0 = s ? vb : va, u1 = s ? va : vb; ka = t0; kb = t1; va = u0; vb = u1; }
__device__ __forceinline__ void sort16_kv(float (&k)[16], int (&v)[16]) {
#pragma unroll
    for (int kk = 2; kk <= 16; kk <<= 1)
#pragma unroll
        for (int j = kk >> 1; j > 0; j >>= 1)
#pragma unroll
            for (int i = 0; i < 16; ++i) { const int l = i ^ j; if (l > i) { if ((i & kk) == 0) ce_kv(k[i], v[i], k[l], v[l]); else ce_kv(k[l], v[l], k[i], v[i]); } }
}
__device__ __forceinline__ void merge16_kv(float (&ka)[16], int (&va)[16], const float (&kb)[16], const int (&vb)[16]) {
#pragma unroll
    for (int i = 0; i < 16; ++i) { const bool s = kb[15 - i] > ka[i]; ka[i] = s ? kb[15 - i] : ka[i]; va[i] = s ? vb[15 - i] : va[i]; }
#pragma unroll
    for (int j = 8; j > 0; j >>= 1)
#pragma unroll
        for (int i = 0; i < 16; ++i) { const int l = i ^ j; if (l > i) ce_kv(ka[i], va[i], ka[l], va[l]); }
}
__device__ __forceinline__ void split8(const float* p, bf16x8& hi8, bf16x8& lo8) {
    const float4 f0 = *(const float4*)p, f1 = *(const float4*)(p + 4);
    const float x[8] = {f0.x, f0.y, f0.z, f0.w, f1.x, f1.y, f1.z, f1.w};
#pragma unroll
    for (int j = 0; j < 8; ++j) { const short h = bfs(x[j]); hi8[j] = h; lo8[j] = bfs(x[j] - sbf2f(h)); }
}
__device__ __forceinline__ void route_task(int task, const float* QP, const bf16* KH, const bf16* KL, unsigned short* IDX, float* GATE, int lane) {
    const int r = lane & 31, hi = lane >> 5, t = 4 * task + (r >> 3), head = r & 7;
    float top[2][16];
#pragma unroll
    for (int half = 0; half < 2; ++half) {
        bf16x8 qh[4], ql[4];
#pragma unroll
        for (int ks = 0; ks < 4; ++ks) split8(QP + (size_t)t * D + head * 128 + half * 64 + 16 * ks + 8 * hi, qh[ks], ql[ks]);
        float cur[16];
#pragma unroll
        for (int kt = 0; kt < 4; ++kt) {
            f32x16 X = zero16();
            const bf16* khp = KH + (size_t)(half * 128 + 32 * kt + r) * 64 + 8 * hi; const bf16* klp = KL + (size_t)(half * 128 + 32 * kt + r) * 64 + 8 * hi;
            asm volatile("" : "+v"(khp), "+v"(klp));
#pragma unroll
            for (int ks = 0; ks < 4; ++ks) {
                const bf16x8 kh = ldg8(khp + 16 * ks), kl = ldg8(klp + 16 * ks);
                X = MFMA32(kh, qh[ks], X); X = MFMA32(kh, ql[ks], X); X = MFMA32(kl, qh[ks], X);
            }
            float grp[16];
#pragma unroll
            for (int i = 0; i < 16; ++i) { const unsigned key = (unsigned)(32 * kt + crow(i, hi)); grp[i] = __uint_as_float((__float_as_uint(X[i]) & ~127u) | (127u - key)); }
            sort16_desc(grp);
            if (kt == 0) {
#pragma unroll
                for (int i = 0; i < 16; ++i) cur[i] = grp[i];
            } else merge16_desc(cur, grp);
        }
        float oth[16];
#pragma unroll
        for (int i = 0; i < 16; ++i) oth[i] = __shfl_xor(cur[i], 32);
        merge16_desc(cur, oth);
#pragma unroll
        for (int i = 0; i < 16; ++i) top[half][i] = cur[i];
    }
    unsigned P1[4], P2[4];
#pragma unroll
    for (int q = 0; q < 4; ++q) { P1[q] = 0u; P2[q] = 0u;
#pragma unroll
        for (int s = 0; s < 4; ++s) { P1[q] |= (127u - (__float_as_uint(top[0][4 * q + s]) & 127u)) << (8 * s); P2[q] |= (127u - (__float_as_uint(top[1][4 * q + s]) & 127u)) << (8 * s); } }
#define CAND(a, b) __uint_as_float((__float_as_uint(top[0][a] + top[1][b]) & ~255u) | (255u - (unsigned)((a) * 16 + (b))))
    float bk[16];
    {
        float gk[16];
        gk[0] = CAND(0, 0);
        gk[1] = CAND(0, 1);
        gk[2] = CAND(0, 2);
        gk[3] = CAND(0, 3);
        gk[4] = CAND(0, 4);
        gk[5] = CAND(0, 5);
        gk[6] = CAND(0, 6);
        gk[7] = CAND(0, 7);
        gk[8] = CAND(0, 8);
        gk[9] = CAND(0, 9);
        gk[10] = CAND(0, 10);
        gk[11] = CAND(0, 11);
        gk[12] = CAND(0, 12);
        gk[13] = CAND(0, 13);
        gk[14] = CAND(0, 14);
        gk[15] = CAND(0, 15);
        sort16_desc(gk);
#pragma unroll
        for (int i = 0; i < 16; ++i) bk[i] = gk[i];
    }
    {
        float gk[16];
        gk[0] = CAND(1, 0);
        gk[1] = CAND(1, 1);
        gk[2] = CAND(1, 2);
        gk[3] = CAND(1, 3);
        gk[4] = CAND(1, 4);
        gk[5] = CAND(1, 5);
        gk[6] = CAND(1, 6);
        gk[7] = CAND(1, 7);
        gk[8] = CAND(2, 0);
        gk[9] = CAND(2, 1);
        gk[10] = CAND(2, 2);
        gk[11] = CAND(2, 3);
        gk[12] = CAND(2, 4);
        gk[13] = CAND(3, 0);
        gk[14] = CAND(3, 1);
        gk[15] = CAND(3, 2);
        sort16_desc(gk);
        merge16_desc(bk, gk);
    }
    {
        float gk[16];
        gk[0] = CAND(3, 3);
        gk[1] = CAND(4, 0);
        gk[2] = CAND(4, 1);
        gk[3] = CAND(4, 2);
        gk[4] = CAND(5, 0);
        gk[5] = CAND(5, 1);
        gk[6] = CAND(6, 0);
        gk[7] = CAND(6, 1);
        gk[8] = CAND(7, 0);
        gk[9] = CAND(7, 1);
        gk[10] = CAND(8, 0);
        gk[11] = CAND(9, 0);
        gk[12] = CAND(10, 0);
        gk[13] = CAND(11, 0);
        gk[14] = CAND(12, 0);
        gk[15] = CAND(13, 0);
        sort16_desc(gk);
        merge16_desc(bk, gk);
    }
    {
        float gk[16];
        gk[0] = CAND(14, 0);
        gk[1] = CAND(15, 0);
        gk[2] = -INFINITY;
        gk[3] = -INFINITY;
        gk[4] = -INFINITY;
        gk[5] = -INFINITY;
        gk[6] = -INFINITY;
        gk[7] = -INFINITY;
        gk[8] = -INFINITY;
        gk[9] = -INFINITY;
        gk[10] = -INFINITY;
        gk[11] = -INFINITY;
        gk[12] = -INFINITY;
        gk[13] = -INFINITY;
        gk[14] = -INFINITY;
        gk[15] = -INFINITY;
        sort16_desc(gk);
        merge16_desc(bk, gk);
    }
#undef CAND
    int bv[16];
#pragma unroll
    for (int i = 0; i < 16; ++i) {
        const unsigned cd = 255u - (__float_as_uint(bk[i]) & 255u), ca = cd >> 4, cb = cd & 15u;
        const unsigned wa = (ca >> 2) == 0u ? P1[0] : (ca >> 2) == 1u ? P1[1] : (ca >> 2) == 2u ? P1[2] : P1[3];
        const unsigned wb = (cb >> 2) == 0u ? P2[0] : (cb >> 2) == 1u ? P2[1] : (cb >> 2) == 2u ? P2[2] : P2[3];
        bv[i] = (int)((((wa >> (8u * (ca & 3u))) & 255u) << 7) | ((wb >> (8u * (cb & 3u))) & 255u));
    }
    float e[16], se = 0.f;
#pragma unroll
    for (int i = 0; i < 16; ++i) { e[i] = __expf(bk[i] - bk[0]); se += e[i]; }
    const float inv = 1.f / se;
    if (hi == 0) {
        uint4* ip = (uint4*)(IDX + (size_t)t * 128 + head * 16); float4* gp = (float4*)(GATE + (size_t)t * 128 + head * 16);
#pragma unroll
        for (int q = 0; q < 2; ++q) ip[q] = make_uint4((unsigned)bv[8 * q] | ((unsigned)bv[8 * q + 1] << 16), (unsigned)bv[8 * q + 2] | ((unsigned)bv[8 * q + 3] << 16), (unsigned)bv[8 * q + 4] | ((unsigned)bv[8 * q + 5] << 16), (unsigned)bv[8 * q + 6] | ((unsigned)bv[8 * q + 7] << 16));
#pragma unroll
        for (int q = 0; q < 4; ++q) gp[q] = make_float4(e[4 * q] * inv, e[4 * q + 1] * inv, e[4 * q + 2] * inv, e[4 * q + 3] * inv);
    }
}

#define XB_TMO      128
#define XB_XCNT(j)  (256  + 64 * (j))
#define XB_XSUB(j)  (1280 + 64 * (j))
#define XB_XGEN(j)  (2304 + 64 * (j))
#define XB_TOP      3328
#define XB_TOPGEN   3392
#define XCD_BAR_WORDS 3456
#define XB_SPIN_CAP (1u << 22)
__device__ __forceinline__ unsigned xb_ld(unsigned* p)              { return __hip_atomic_load(p, __ATOMIC_RELAXED, __HIP_MEMORY_SCOPE_AGENT); }
__device__ __forceinline__ unsigned xb_add(unsigned* p, unsigned v) { return __hip_atomic_fetch_add(p, v, __ATOMIC_RELAXED, __HIP_MEMORY_SCOPE_AGENT); }
__device__ __forceinline__ unsigned xb_xcc_id() { return (unsigned)__builtin_amdgcn_s_getreg((3 << 11) | 20) & 0xFu; }
#define XB_SPIN(cond, bar) do { unsigned _sp = 0; while (cond) { __builtin_amdgcn_s_sleep(1); \
    if ((++_sp & 255u) == 0u) { if (xb_ld(&(bar)[XB_TMO])) break; if (_sp > XB_SPIN_CAP) { atomicAdd(&(bar)[XB_TMO], 1u); break; } } } } while (0)
struct XcdBarrier { unsigned* bar; unsigned x; volatile LAS unsigned* st; };
__device__ __forceinline__ XcdBarrier xcd_barrier_post(unsigned* bar, volatile LAS unsigned* st) {
    XcdBarrier b; b.bar = bar; b.x = xb_xcc_id(); b.st = st;
    if (threadIdx.x == 0) (void)xb_add(&bar[XB_XCNT(b.x)], 1u);
    return b;
}
__device__ __forceinline__ void xcd_barrier_complete(unsigned* bar, unsigned x, unsigned& nloc, unsigned& nx) {
    const unsigned G = gridDim.x * gridDim.y * gridDim.z;
    unsigned sum, cnt, mine, sp = 0u;
    for (;;) {
        sum = 0u; cnt = 0u; mine = 0u;
#pragma unroll
        for (unsigned j = 0; j < 16; ++j) { const unsigned c = xb_ld(&bar[XB_XCNT(j)]); sum += c; cnt += (c > 0u) ? 1u : 0u; mine = (j == x) ? c : mine; }
        if (sum == G) break;
        __builtin_amdgcn_s_sleep(1);
        if ((++sp & 255u) == 0u) { if (xb_ld(&bar[XB_TMO])) break; if (sp > XB_SPIN_CAP) { atomicAdd(&bar[XB_TMO], 1u); break; } }
    }
    nloc = mine > 0u ? mine : 1u; nx = cnt > 0u ? cnt : 1u;
}
__device__ __forceinline__ void xcd_barrier(const XcdBarrier& b) {
    asm volatile("s_waitcnt vmcnt(0)" ::: "memory");
    __syncthreads();
    if (threadIdx.x == 0) {
        unsigned* bar = b.bar;
        __builtin_amdgcn_s_waitcnt(0);
        unsigned nloc = b.st[0], nx = b.st[1];
        if (nloc == 0u) { xcd_barrier_complete(bar, b.x, nloc, nx); b.st[0] = nloc; b.st[1] = nx; }
        const unsigned old = xb_add(&bar[XB_XSUB(b.x)], 1u);
        const unsigned gen = old / nloc;
        if (old + 1u == (gen + 1u) * nloc) {
            __builtin_amdgcn_fence(__ATOMIC_RELEASE, "agent");
            asm volatile("s_waitcnt vmcnt(0)" ::: "memory");
            const unsigned og = xb_add(&bar[XB_TOP], 1u);
            const unsigned tg = og / nx;
            if (og + 1u == (tg + 1u) * nx) xb_add(&bar[XB_TOPGEN], 1u);
            else XB_SPIN(xb_ld(&bar[XB_TOPGEN]) == tg, bar);
            __builtin_amdgcn_fence(__ATOMIC_ACQUIRE, "agent");
            xb_add(&bar[XB_XGEN(b.x)], 1u);
            asm volatile("s_waitcnt vmcnt(0)" ::: "memory");
        } else {
            XB_SPIN(xb_ld(&bar[XB_XGEN(b.x)]) == gen, bar);
            __builtin_amdgcn_fence(__ATOMIC_ACQUIRE, "agent");
            asm volatile("s_waitcnt vmcnt(0)" ::: "memory");
        }
    }
    __syncthreads();
}
constexpr int LDS_BYTES = 147456;
constexpr int MISC_OFF = 131072 + 320;

__global__ void __launch_bounds__(NTHR, 2) k_main(Args a) {
    extern __shared__ __attribute__((aligned(16))) unsigned char lds_raw[];
    LAS unsigned char* ldsb = (LAS unsigned char*)lds_raw;
    const int tid0 = threadIdx.x, bid = blockIdx.x, nb = gridDim.x;
    const int wave = __builtin_amdgcn_readfirstlane(tid0 >> 6);
    const int gthreads = nb * NTHR, nwaves = gthreads >> 6;
#define PHASE_VARS() int tid = tid0; asm volatile("" : "+v"(tid)); const int lane = tid & 63, gtid = bid * NTHR + tid, gwave = gtid >> 6; (void)lane; (void)gtid; (void)gwave
    unsigned char* ws = a.ws;
    bf16* WINT = (bf16*)(ws + WS_WIN); bf16* WOT = (bf16*)(ws + WS_WO); bf16* WQT = (bf16*)(ws + WS_WQ);
    bf16* PROJ = (bf16*)(ws + WS_PROJ);
    bf16* XNB = (bf16*)(ws + WS_XNB);
    bf16* XACT = (bf16*)(ws + WS_XACT);
    float* DTRAW = (float*)(ws + WS_DTRAW); float* DT = (float*)(ws + WS_DT); float* ACS = (float*)(ws + WS_ACS); float* CDEC = (float*)(ws + WS_CDEC);
    float* STATES = (float*)(ws + WS_STATES); bf16* PREVT = (bf16*)(ws + WS_PREV);
    float* QP = (float*)(ws + WS_QP); unsigned short* IDX = (unsigned short*)(ws + WS_IDX); float* GATE = (float*)(ws + WS_GATE);
    float* TOPV = (float*)(ws + WS_TOPV); int* TOPI = (int*)(ws + WS_TOPI);
    unsigned char* U8 = ws + WS_U8; unsigned char* V8 = ws + WS_V8; float* SU = (float*)(ws + WS_SU); float* SV = SU + 16384; int* PART = (int*)(ws + WS_PART); unsigned char* XQ = ws + WS_XQ; float* XS = (float*)(ws + WS_XS);
    bf16* KH = (bf16*)(ws + WS_KH); bf16* KL = (bf16*)(ws + WS_KH + 65536);
    bf16* HB = (bf16*)(ws + WS_STATES);
    float* MIXF = a.out;
    volatile LAS unsigned* MISC = (volatile LAS unsigned*)(ldsb + MISC_OFF);
    if (tid0 < 32) MISC[tid0] = 0u;
    __syncthreads();
    XcdBarrier bar = xcd_barrier_post((unsigned*)ws, MISC + 8);
#define IN(k) (a.ph_lo <= (k) && (k) < a.ph_hi)
#if defined(PROBE_LO)
    int seg_ = 0; unsigned long long tseg_ = __builtin_amdgcn_s_memrealtime();
#define PROBE_SPIN() do { if (seg_ >= PROBE_LO && seg_ <= PROBE_HI) { const unsigned long long d_ = (__builtin_amdgcn_s_memrealtime() - tseg_) * PROBE_AMP; const unsigned long long s_ = __builtin_amdgcn_s_memrealtime(); \
        while (__builtin_amdgcn_s_memrealtime() - s_ < d_) __builtin_amdgcn_s_sleep(4); } } while (0)
#define GRID_BAR() do { PROBE_SPIN(); xcd_barrier(bar); tseg_ = __builtin_amdgcn_s_memrealtime(); ++seg_; } while (0)
#else
#define PROBE_SPIN() do { } while (0)
#define GRID_BAR() xcd_barrier(bar)
#endif

    if (IN(0)) {
        PHASE_VARS();
        LAS float* scr = (LAS float*)(ldsb + wave * 16384);
        constexpr int I_IN = 16 * 72, I_O = 16 * 32, NITEMS = I_IN + 2 * I_O;
        for (int it = gwave; it < NITEMS; it += nwaves) {
            int r = it;
            if (r < I_IN) { transpose_item(a.w_in, PW, D, WINT, scr, r / 72, r % 72, lane); continue; } r -= I_IN;
            if (r < I_O) { transpose_item(a.w_out, D, D, WOT, scr, r / 32, r % 32, lane); continue; } r -= I_O;
            transpose_item(a.peer_wq, D, D, WQT, scr, r / 32, r % 32, lane);
        }
        for (int i = gtid; i < 2 * 128 * 64; i += gthreads) { const float kf = a.peer_sub_keys[i]; const short h = bfs(kf); KH[i] = (bf16)h; KL[i] = (bf16)bfs(kf - sbf2f(h)); }
        for (int i = tid; i < 8 * 1024; i += NTHR) { const int h = i & 7, c = i >> 3; *(LAS float*)(ldsb + h * 16384 + 8448 + c * 4) = a.w_in[(size_t)c * PW + ODT + h]; }
        __syncthreads();
        rmsnorm_rows_bf16<1>(a.x, a.norm_mix_g, XNB, ldsb, DTRAW, nullptr, nullptr, gwave, nwaves, lane);
    }
    GRID_BAR();
    if (IN(1)) {
        PHASE_VARS();
        pg8::Gemm g{XNB, WINT, T, PS, D}; pg8::StaticOrder S; S.init(T, PS, nb, bid);
        pg8::EpiBf16Plain E{PROJ, PS};
        pg8::gemm_phase<pg8::EpiBf16Plain, pg8::StaticOrder>(ldsb, g, S, E, nullptr);
        const int cfirst = (nb == 256) ? 64 : 0;
        if (bid >= cfirst) for (int rr = (bid - cfirst) * 8 + wave; rr < 2 * 16384; rr += (nb - cfirst) * 8) {
            const int which = rr >> 14, row = rr & 16383;
            const float4* src4 = (const float4*)((which ? a.peer_v : a.peer_u) + (size_t)row * D) + lane;
            float4 v[4]; float mx = 0.f;
#pragma unroll
            for (int jq = 0; jq < 4; ++jq) { v[jq] = src4[64 * jq]; mx = fmaxf(mx, fmaxf(fmaxf(fabsf(v[jq].x), fabsf(v[jq].y)), fmaxf(fabsf(v[jq].z), fabsf(v[jq].w)))); }
#pragma unroll
            for (int o = 1; o < 64; o <<= 1) mx = fmaxf(mx, __shfl_xor(mx, o));
            const float sc = mx > 0.f ? mx * (1.f / 127.f) : 1.f, inv = 1.f / sc;
            unsigned* dst = (unsigned*)((which ? V8 : U8) + (size_t)row * D) + lane;
#pragma unroll
            for (int jq = 0; jq < 4; ++jq) { const int q0 = (int)rintf(v[jq].x * inv), q1 = (int)rintf(v[jq].y * inv), q2 = (int)rintf(v[jq].z * inv), q3 = (int)rintf(v[jq].w * inv);
                dst[64 * jq] = (unsigned)(q0 & 255) | ((unsigned)(q1 & 255) << 8) | ((unsigned)(q2 & 255) << 16) | ((unsigned)(q3 & 255) << 24); }
            if (lane == 0) (which ? SV : SU)[row] = sc;
        }
    }
    GRID_BAR();
    if (IN(3)) {
        PHASE_VARS();
        for (int u = bid; u < 512; u += nb) {
            if (u < 256) attn_unit(a.attn_sinks, a.attn_out_g, ldsb, u, PROJ, XNB, tid, lane, wave);
            else ssd_chunk_unit(ldsb, u - 256, PROJ, XACT, DTRAW, a.conv_w, a.conv_b, a.dt_bias, a.a_log, ACS, CDEC, MIXF, STATES, tid, lane, wave);
        }
    }
    GRID_BAR();
    if (IN(5)) {
        PHASE_VARS();
        for (int idx = gtid; idx < 2 * 8 * 8192; idx += gthreads) {
            const int pn = idx & 8191, h = (idx >> 13) & 7, b = idx >> 16;
            float run = 0.f;
#pragma unroll 1
            for (int c0 = 0; c0 < 64; c0 += 8) {
                float st[8], dc[8];
#pragma unroll
                for (int j = 0; j < 8; ++j) { const int bch = (b * 64 + c0 + j) * 8 + h; st[j] = STATES[(size_t)bch * 8192 + pn]; dc[j] = CDEC[bch]; }
#pragma unroll
                for (int j = 0; j < 8; ++j) { const int bch = (b * 64 + c0 + j) * 8 + h; PREVT[(size_t)bch * 8192 + pn] = f2bf(run); run = dc[j] * run + st[j]; }
            }
        }
    }
    GRID_BAR();
    if (IN(6)) {
        PHASE_VARS();
        for (int u = bid; u < 256; u += nb) yoff_unit(a.d_skip, a.ssm_norm_g, ldsb, u, XACT, PROJ, ACS, PREVT, MIXF, XNB, lane, wave);
    }
    GRID_BAR();
    if (IN(7)) {
        PHASE_VARS();
        pg8::Gemm g{XNB, WOT, T, D, D}; pg8::StaticOrder S; S.init(T, D, nb, bid);
        pg8::EpiBf16Resid E{HB, a.x, D};
        pg8::gemm_phase<pg8::EpiBf16Resid, pg8::StaticOrder>(ldsb, g, S, E, nullptr);
    }
    GRID_BAR();
    if (IN(8)) {
        PHASE_VARS();
        rmsnorm_rows_bf16<2>((const float*)HB, a.norm_ffn_g, XNB, ldsb, nullptr, XQ, XS, gwave, nwaves, lane);
    }
    GRID_BAR();
    if (IN(9)) {
        PHASE_VARS();
        pg8::Gemm g{XNB, WQT, T, D, D}; pg8::StaticOrder S; S.init(T, D, nb, bid);
        pg8::EpiF32Resid E{QP, nullptr, D};
        pg8::gemm_phase<pg8::EpiF32Resid, pg8::StaticOrder>(ldsb, g, S, E, nullptr);
    }
    GRID_BAR();
    if (IN(10)) {
        PHASE_VARS();
        for (int task = gwave; task < T / 4; task += nwaves) route_task(task, QP, KH, KL, IDX, GATE, lane);
    }
    GRID_BAR();
    unsigned char* ACTQ = ws + WS_ACT; float* ACTS = (float*)(ws + WS_ACT + 4 * MiB); bf16* PEERO = (bf16*)(ws + WS_PEERO);
    unsigned* ctl = (unsigned*)ws;
    const int xcc = (int)(bar.x & 7u);
    if (IN(12)) {
        PHASE_VARS();
#pragma unroll 1
        for (int pi = 0; pi < NPART; ++pi) {
            const int p = (xcc + pi) & 7;
            for (;;) {
                if (tid == 0) MISC[16] = xb_add(&ctl[CW_QU + 64 * p], 1u);
                __syncthreads();
                const int j = (int)MISC[16];
                __syncthreads();
                if (j >= NCHUNK) break;
                peer_u_item(p, j, IDX, XQ, U8, PART, lane, wave);
            }
        }
    }
    GRID_BAR();
    if (IN(12)) {
        PHASE_VARS();
        for (int t = gwave; t < T; t += nwaves) {
            float av[2];
#pragma unroll
            for (int hh = 0; hh < 2; ++hh) {
                const int i = t * 128 + hh * 64 + lane;
                int si = 0;
#pragma unroll
                for (int pp = 0; pp < NPART; ++pp) si += PART[(size_t)pp * T * 128 + i];
                const int e = IDX[i]; const float z = (float)si * SU[e] * XS[t];
                av[hh] = GATE[i] * 0.5f * z * (1.f + erff(z * 0.70710678118654752f)) * SV[e];
            }
            float mx = fmaxf(fabsf(av[0]), fabsf(av[1]));
#pragma unroll
            for (int o = 1; o < 64; o <<= 1) mx = fmaxf(mx, __shfl_xor(mx, o));
            const float sc = mx > 0.f ? mx * (1.f / 127.f) : 1.f, inv = 1.f / sc;
            ACTQ[(size_t)t * 128 + lane] = (unsigned char)((int)rintf(av[0] * inv) & 255); ACTQ[(size_t)t * 128 + 64 + lane] = (unsigned char)((int)rintf(av[1] * inv) & 255);
            if (lane == 0) ACTS[t] = sc;
        }
    }
    GRID_BAR();
    if (IN(13)) {
        PHASE_VARS();
#pragma unroll 1
        for (int pi = 0; pi < NPART; ++pi) {
            const int p = (xcc + pi) & 7;
            for (;;) {
                if (tid == 0) MISC[16] = xb_add(&ctl[CW_QV + 64 * p], 1u);
                __syncthreads();
                const int j = (int)MISC[16];
                __syncthreads();
                if (j >= NCHUNK) break;
                peer_v_item(p, j, IDX, ACTQ, ACTS, V8, PEERO, lane, wave);
            }
        }
    }
    GRID_BAR();
    if (IN(14)) {
        PHASE_VARS();
        for (int t = gwave; t < T; t += nwaves) {
            const uint2* hr = (const uint2*)(HB + (size_t)t * D) + lane; const uint2* pr = (const uint2*)(PEERO + (size_t)t * D) + lane;
            float4 v[4]; float ss = 0.f;
#pragma unroll
            for (int jq = 0; jq < 4; ++jq) { const uint2 hw = hr[64 * jq]; const float4 h4 = make_float4(__uint_as_float(hw.x << 16), __uint_as_float(hw.x & 0xffff0000u), __uint_as_float(hw.y << 16), __uint_as_float(hw.y & 0xffff0000u)); const uint2 pw = pr[64 * jq]; v[jq] = make_float4(h4.x + __uint_as_float(pw.x << 16), h4.y + __uint_as_float(pw.x & 0xffff0000u), h4.z + __uint_as_float(pw.y << 16), h4.w + __uint_as_float(pw.y & 0xffff0000u)); ss += v[jq].x * v[jq].x + v[jq].y * v[jq].y + v[jq].z * v[jq].z + v[jq].w * v[jq].w; }
            ss = wave_sum(ss);
            const float r3 = rsqrtf(ss * (1.f / D) + EPS);
            float4* op = (float4*)(a.out + (size_t)t * D) + lane;
#pragma unroll
            for (int jq = 0; jq < 4; ++jq) { const float4 gv = ((const float4*)a.final_norm_g)[lane + 64 * jq]; op[64 * jq] = make_float4(v[jq].x * r3 * gv.x, v[jq].y * r3 * gv.y, v[jq].z * r3 * gv.z, v[jq].w * r3 * gv.w); }
        }
    }
    PROBE_SPIN();
#undef IN
}
}

extern "C" void kernel_launch(void* const* d_in, const int* in_sizes, int n_in, void* d_out, int out_size, void* d_ws, size_t ws_size, hipStream_t stream) {
    if (n_in != 18 || out_size != T * D || ws_size < WS_END) { fprintf(stderr, "kernel_launch: unexpected shapes n_in=%d out=%d ws=%zu\n", n_in, out_size, ws_size); return; }
    Args a{};
    const float** ap = (const float**)&a;
    for (int i = 0; i < 18; ++i) ap[i] = (const float*)d_in[i];
    a.out = (float*)d_out; a.ws = (unsigned char*)d_ws;
    static int grid = 0;
    if (grid == 0) {
        int dev = 0, cus = 0, per_cu = 0;
        if (hipGetDevice(&dev) != hipSuccess || hipDeviceGetAttribute(&cus, hipDeviceAttributeMultiprocessorCount, dev) != hipSuccess) { fprintf(stderr, "kernel_launch: device query failed\n"); grid = -1; return; }
        if (hipFuncSetAttribute((const void*)k_main, hipFuncAttributeMaxDynamicSharedMemorySize, LDS_BYTES) != hipSuccess) { fprintf(stderr, "kernel_launch: hipFuncSetAttribute failed\n"); grid = -1; return; }
        if (hipOccupancyMaxActiveBlocksPerMultiprocessor(&per_cu, (const void*)k_main, NTHR, LDS_BYTES) != hipSuccess || per_cu < 1) { fprintf(stderr, "kernel_launch: occupancy query says %d blocks/CU\n", per_cu); (void)hipGetLastError(); grid = -1; return; }
        grid = cus;
    }
    if (grid < 0) return;
    if (hipMemsetAsync(d_ws, 0, 65536, stream) != hipSuccess) { fprintf(stderr, "kernel_launch: memset failed\n"); return; }
    a.ph_lo = 0; a.ph_hi = 15;
    hipLaunchKernelGGL(k_main, dim3(grid), dim3(NTHR), LDS_BYTES, stream, a);
}
```

```cpp
#include <hip/hip_runtime.h>
#include <cstdio>
#include <cstdint>

namespace pg8 {
#define PG8_LAS __attribute__((address_space(3)))
typedef unsigned short bf16_t;
typedef short bf16x8 __attribute__((ext_vector_type(8)));
typedef float f32x4 __attribute__((ext_vector_type(4)));
typedef unsigned u32x4 __attribute__((ext_vector_type(4)));
constexpr int BM = 256, BK = 64, HALF = 128, HTB = HALF * BK * 2  , STAGE_BYTES = 8 * HTB, NXCD = 8, WGM = 8;

__host__ __device__ __forceinline__ int lds_byte(int r, int c) { const int st = (r >> 4) * 2 + (c >> 5), rr = r & 15, cc = c & 31, ob = rr * 64 + cc * 2; return st * 1024 + (ob ^ (((ob >> 9) & 1) << 5)); }
__host__ __device__ __forceinline__ void stage_rc(int b, int& R, int& C) { const int st = b / 1024, sb = b % 1024, swz = sb ^ (((sb >> 9) & 1) << 5); R = (st >> 1) * 16 + swz / 64; C = (st & 1) * 32 + (swz % 64) / 2; }
__host__ __device__ __forceinline__ int perm32(int rho) { const int n = rho >> 4, i = rho & 15; return 8 * (i >> 2) + 4 * n + (i & 3); }

struct Unit { int pm, pn; };
struct Gemm { const bf16_t* A; const bf16_t* Bt; int M, N, K; };

struct StaticOrder {
    int nM, nN, nwg, G, c;
    __host__ __device__ void init(int M, int N, int G_, int c_) { nM = M / BM; nN = N / BM; nwg = nM * nN; G = G_; c = c_; }
    __host__ __device__ bool next(int i, Unit& u) const {
        const long L = (long)i * G + c; if (L >= nwg) return false;
        int wgid = (int)L; { const int q = nwg / NXCD, r = nwg % NXCD, xcd = wgid % NXCD, off = wgid / NXCD; wgid = (xcd < r ? xcd * (q + 1) : r * (q + 1) + (xcd - r) * q) + off; }
        const int nig = WGM * nN, gid = wgid / nig, fm = gid * WGM, gsz = (nM - fm) < WGM ? (nM - fm) : WGM;
        u.pm = fm + ((wgid % nig) % gsz); u.pn = (wgid % nig) / gsz; return true;
    }
    __device__ __forceinline__ void a_ready(const Unit&) const {}
    __device__ __forceinline__ void done(const Unit&) const {}
};
__device__ __forceinline__ unsigned cvt_pk_bf16(float lo, float hi) { unsigned r; asm volatile("v_cvt_pk_bf16_f32 %0, %1, %2" : "=v"(r) : "v"(lo), "v"(hi)); return r; }
typedef float f32x2 __attribute__((ext_vector_type(2)));
struct EpiBf16Plain {
    static constexpr bool PERM = true, AFTER_DRAIN = false;
    bf16_t* O; int ldc;
    __device__ __forceinline__ void operator()(const f32x4 (&acc)[2][2][4][2], const Unit& u, int wr, int wc, int fr, int fq) const {
        const int row0 = u.pm * BM + wr * 64 + fr, col0 = u.pn * BM + wc * 32 + 8 * fq;
#pragma unroll
        for (int ai = 0; ai < 2; ++ai)
#pragma unroll
            for (int m = 0; m < 4; ++m) { bf16_t* rowp = O + (size_t)(row0 + ai * HALF + m * 16) * ldc + col0;
#pragma unroll
                for (int bj = 0; bj < 2; ++bj) { const f32x4 v0 = acc[ai][bj][m][0], v1 = acc[ai][bj][m][1];
                    u32x4 w; w.x = cvt_pk_bf16(v0[0], v0[1]); w.y = cvt_pk_bf16(v0[2], v0[3]); w.z = cvt_pk_bf16(v1[0], v1[1]); w.w = cvt_pk_bf16(v1[2], v1[3]);
                    *(u32x4*)(rowp + bj * HALF) = w; } }
    }
};
struct EpiF32Resid {
    static constexpr bool PERM = false, AFTER_DRAIN = false;
    float* C; const float* R; int ldc;
    __device__ __forceinline__ void operator()(const f32x4 (&acc)[2][2][4][2], const Unit& u, int wr, int wc, int fr, int fq) const {
        const int row0 = u.pm * BM + wr * 64 + fr, col0 = u.pn * BM + wc * 32 + 4 * fq;
#pragma unroll
        for (int ai = 0; ai < 2; ++ai)
#pragma unroll
            for (int m = 0; m < 4; ++m) { const size_t off = (size_t)(row0 + ai * HALF + m * 16) * ldc + col0;
#pragma unroll
                for (int bj = 0; bj < 2; ++bj)
#pragma unroll
                    for (int n = 0; n < 2; ++n) { f32x4 v = acc[ai][bj][m][n]; if (R) v += *(const f32x4*)(R + off + bj * HALF + n * 16); *(f32x4*)(C + off + bj * HALF + n * 16) = v; }
                asm volatile("" ::: "memory"); }
    }
};

struct EpiBf16Resid {
    static constexpr bool PERM = true, AFTER_DRAIN = false;
    bf16_t* O; const float* R; int ldc;
    __device__ __forceinline__ void operator()(const f32x4 (&acc)[2][2][4][2], const Unit& u, int wr, int wc, int fr, int fq) const {
        const int row0 = u.pm * BM + wr * 64 + fr, col0 = u.pn * BM + wc * 32 + 8 * fq;
#pragma unroll
        for (int ai = 0; ai < 2; ++ai)
#pragma unroll
            for (int m = 0; m < 4; ++m) { const size_t off = (size_t)(row0 + ai * HALF + m * 16) * ldc + col0;
#pragma unroll
                for (int bj = 0; bj < 2; ++bj) { const f32x4 v0 = acc[ai][bj][m][0] + *(const f32x4*)(R + off + bj * HALF), v1 = acc[ai][bj][m][1] + *(const f32x4*)(R + off + bj * HALF + 4);
                    u32x4 w; w.x = cvt_pk_bf16(v0[0], v0[1]); w.y = cvt_pk_bf16(v0[2], v0[3]); w.z = cvt_pk_bf16(v1[0], v1[1]); w.w = cvt_pk_bf16(v1[2], v1[3]);
                    *(u32x4*)(O + off + bj * HALF) = w; }
                asm volatile("" ::: "memory"); }
    }
};
template <class Epi, class Sched, bool STAMP = false>
__device__ __forceinline__ void gemm_phase(PG8_LAS unsigned char* lds, const Gemm g, const Sched& S, const Epi& E, unsigned long long* stamps) {
    const int tid = threadIdx.x, wid = __builtin_amdgcn_readfirstlane(tid >> 6), lane = tid & 63, wr = wid >> 2, wc = wid & 3, fr = lane & 15, fq = lane >> 4;
    const int K = g.K, nt = K / BK;
    int ts_lo = 0, ts_hi = 0, nts = 0; const unsigned long long rt_entry = STAMP ? (unsigned long long)0ull : 0ull;
#define PG8_STAMP() do { if (STAMP && wid == 0 && nts < 64) { const unsigned long long _c = (unsigned long long)clock64(); \
        ts_lo = (lane == nts) ? (int)(unsigned)_c : ts_lo; ts_hi = (lane == nts) ? (int)(unsigned)(_c >> 32) : ts_hi; ++nts; } } while (0)
    PG8_STAMP();
    unsigned voffA[2], voffB[2];
#pragma unroll
    for (int i = 0; i < 2; ++i) { int R, C; stage_rc(tid * 16 + i * 8192, R, C); const int Rb = Epi::PERM ? ((R & ~31) + perm32(R & 31)) : R;
        voffA[i] = (unsigned)(R * K + C) * 2u; voffB[i] = (unsigned)(Rb * K + C) * 2u; }
    const size_t kstep = (size_t)(BK * 2);
    const size_t hstep = (size_t)HALF * K * 2;
    const size_t tstep = 2 * hstep;
    const unsigned ldsw = (unsigned)wid * 1024u;
    const int aoff = lds_byte(wr * 64 + fr, fq * 8), boff = lds_byte(wc * 32 + fr, fq * 8);
#define PG8_SA(b, h) (((b) * 2 + (h)) * HTB)
#define PG8_SB(b, h) ((4 + (b) * 2 + (h)) * HTB)
#define PG8_STAGE(bufoff, gbase, voff) do { _Pragma("unroll") for (int _i = 0; _i < 2; ++_i) \
        __builtin_amdgcn_global_load_lds((const unsigned*)((const char*)(gbase) + (voff)[_i]), (PG8_LAS unsigned*)(lds + (bufoff) + ldsw + _i * 8192), 16, 0, 0); } while (0)
#define PG8_LDA(dst, b, h) do { _Pragma("unroll") for (int m = 0; m < 4; ++m) _Pragma("unroll") for (int k = 0; k < 2; ++k) dst[m][k] = *(const PG8_LAS bf16x8*)(lds + PG8_SA(b, h) + aoff + m * 2048 + k * 1024); } while (0)
#define PG8_LDB(dst, b, h) do { _Pragma("unroll") for (int n = 0; n < 2; ++n) _Pragma("unroll") for (int k = 0; k < 2; ++k) dst[n][k] = *(const PG8_LAS bf16x8*)(lds + PG8_SB(b, h) + boff + n * 2048 + k * 1024); } while (0)
#define PG8_MMA(ai, bj, At, Bt) do { __builtin_amdgcn_s_setprio(1); _Pragma("unroll") for (int m = 0; m < 4; ++m) _Pragma("unroll") for (int n = 0; n < 2; ++n) _Pragma("unroll") for (int k = 0; k < 2; ++k) \
        acc[ai][bj][m][n] = __builtin_amdgcn_mfma_f32_16x16x32_bf16(Bt[n][k], At[m][k], acc[ai][bj][m][n], 0, 0, 0); __builtin_amdgcn_s_setprio(0); } while (0)
#define PG8_WAIT_V(n) asm volatile("s_waitcnt vmcnt(" #n ")" ::: "memory")
#define PG8_WAIT_L(n) asm volatile("s_waitcnt lgkmcnt(" #n ")" ::: "memory")
#define PG8_BAR __builtin_amdgcn_s_barrier()
#define PG8_SCHED __builtin_amdgcn_sched_barrier(0)
    Unit cur, nxt; int ui = 0;
    if (!S.next(0, cur)) return;
    f32x4 acc[2][2][4][2];
#pragma unroll
    for (int a = 0; a < 2; ++a)
#pragma unroll
        for (int b = 0; b < 2; ++b)
#pragma unroll
            for (int m = 0; m < 4; ++m)
#pragma unroll
                for (int n = 0; n < 2; ++n) acc[a][b][m][n] = (f32x4){0.f, 0.f, 0.f, 0.f};
    bf16x8 At[4][2], B0[2][2], B1[2][2];
    const char* cA = (const char*)g.A + (size_t)cur.pm * tstep; const char* cB = (const char*)g.Bt + (size_t)cur.pn * tstep;
    S.a_ready(cur);
    PG8_STAGE(PG8_SB(0, 0), cB, voffB); PG8_STAGE(PG8_SA(0, 0), cA, voffA); PG8_STAGE(PG8_SB(0, 1), cB + hstep, voffB); PG8_STAGE(PG8_SA(0, 1), cA + hstep, voffA);
    if (wr == 1) PG8_BAR;
    PG8_WAIT_V(4); PG8_BAR;
    PG8_STAGE(PG8_SB(1, 0), cB + kstep, voffB); PG8_STAGE(PG8_SA(1, 0), cA + kstep, voffA); PG8_STAGE(PG8_SB(1, 1), cB + hstep + kstep, voffB);
    PG8_WAIT_V(6); PG8_BAR;
    PG8_STAMP();
    for (;;) {
        const bool has_next = S.next(ui + 1, nxt);
        const char* nA = has_next ? (const char*)g.A + (size_t)nxt.pm * tstep : cA; const char* nB = has_next ? (const char*)g.Bt + (size_t)nxt.pn * tstep : cB;
        for (int t = 0; t < nt; t += 2) {
            const bool last = (t == nt - 2);
            const char* a1 = cA + (size_t)(t + 1) * kstep;
            const char* a2 = last ? nA : cA + (size_t)(t + 2) * kstep; const char* b2 = last ? nB : cB + (size_t)(t + 2) * kstep;
            const char* a3 = a2 + kstep; const char* b3 = b2 + kstep;
            if (last && has_next) S.a_ready(nxt);
            PG8_LDB(B0, 0, 0); PG8_SCHED; PG8_LDA(At, 0, 0); PG8_STAGE(PG8_SA(1, 1), a1 + hstep, voffA);
            PG8_WAIT_L(8); PG8_BAR; PG8_WAIT_L(0); PG8_MMA(0, 0, At, B0); PG8_BAR; PG8_SCHED;
            PG8_LDB(B1, 0, 1); PG8_STAGE(PG8_SB(0, 0), b2, voffB);
            PG8_BAR; PG8_WAIT_L(0); PG8_MMA(0, 1, At, B1); PG8_BAR;
            PG8_LDA(At, 0, 1); PG8_STAGE(PG8_SA(0, 0), a2, voffA);
            PG8_BAR; PG8_WAIT_L(0); PG8_MMA(1, 0, At, B0); PG8_BAR; PG8_SCHED;
            PG8_STAGE(PG8_SB(0, 1), b2 + hstep, voffB);
            PG8_WAIT_V(6); PG8_BAR; PG8_MMA(1, 1, At, B1); PG8_BAR;
            PG8_LDB(B0, 1, 0); PG8_SCHED; PG8_LDA(At, 1, 0); PG8_STAGE(PG8_SA(0, 1), a2 + hstep, voffA);
            PG8_WAIT_L(8); PG8_BAR; PG8_WAIT_L(0); PG8_MMA(0, 0, At, B0); PG8_BAR; PG8_SCHED;
            PG8_LDB(B1, 1, 1); PG8_STAGE(PG8_SB(1, 0), b3, voffB);
            PG8_BAR; PG8_WAIT_L(0); PG8_MMA(0, 1, At, B1); PG8_BAR;
            PG8_LDA(At, 1, 1); PG8_STAGE(PG8_SA(1, 0), a3, voffA);
            PG8_BAR; PG8_WAIT_L(0); PG8_MMA(1, 0, At, B0); PG8_BAR; PG8_SCHED;
            PG8_STAGE(PG8_SB(1, 1), b3 + hstep, voffB);
            PG8_WAIT_V(6); PG8_BAR; PG8_MMA(1, 1, At, B1); PG8_BAR;
        }
        PG8_STAMP();
        if constexpr (!Epi::AFTER_DRAIN) { E(acc, cur, wr, wc, fr, fq); S.done(cur); }
        PG8_STAMP();
        if (!has_next) break;
#pragma unroll
        for (int a = 0; a < 2; ++a)
#pragma unroll
            for (int b = 0; b < 2; ++b)
#pragma unroll
                for (int m = 0; m < 4; ++m)
#pragma unroll
                    for (int n = 0; n < 2; ++n) acc[a][b][m][n] = (f32x4){0.f, 0.f, 0.f, 0.f};
        cur = nxt; cA = nA; cB = nB; ++ui;
    }
    PG8_WAIT_V(0);
    if (wr == 0) PG8_BAR;
    PG8_BAR;
    if constexpr (Epi::AFTER_DRAIN) { E.fused(acc, cur, wr, wc, fr, fq, lds, wid, lane); S.done(cur); }
    PG8_STAMP();
    if (STAMP && wid == 0) { stamps[lane] = lane < nts ? (((unsigned long long)(unsigned)ts_hi << 32) | (unsigned)ts_lo) : 0ull;
        if (lane == 62) stamps[62] = rt_entry; if (lane == 63) stamps[63] = (unsigned long long)0ull; }
#undef PG8_STAMP
#undef PG8_SA
#undef PG8_SB
#undef PG8_STAGE
#undef PG8_LDA
#undef PG8_LDB
#undef PG8_MMA
#undef PG8_WAIT_V
#undef PG8_WAIT_L
#undef PG8_BAR
#undef PG8_SCHED
}
}

namespace {
constexpr int D = 1024, BATCH = 2, SEQ = 8192, T = BATCH * SEQ;
constexpr int PW = 2312;
constexpr int PS = 2304;
constexpr int OQ = 0, OKK = 512, OV = 640, OZ = 768, OXBC = 1280, ODT = 2304;
constexpr float EPS = 1e-6f;
constexpr int NTHR = 512;
typedef unsigned short bf16;
typedef unsigned v4u __attribute__((ext_vector_type(4)));

constexpr size_t MiB = 1u << 20;
constexpr size_t WS_WIN = 1 * MiB;
constexpr size_t WS_KH = 5 * MiB + 512 * 1024;
constexpr size_t WS_WO = 6 * MiB;
constexpr size_t WS_WQ = 8 * MiB;
constexpr size_t WS_PROJ = 10 * MiB;
constexpr size_t WS_XNB = 82 * MiB;
constexpr size_t WS_XACT = 114 * MiB;
constexpr size_t WS_DTRAW = 146 * MiB;
constexpr size_t WS_DT = WS_DTRAW + 512 * 1024;
constexpr size_t WS_ACS = WS_DT + 512 * 1024;
constexpr size_t WS_CDEC = WS_ACS + 512 * 1024;
constexpr size_t WS_STATES = 164 * MiB;
constexpr size_t WS_PREV = 196 * MiB;
constexpr size_t WS_QP = 10 * MiB;
constexpr size_t WS_IDX = 74 * MiB;
constexpr size_t WS_GATE = 114 * MiB;
constexpr size_t WS_TOPV = 122 * MiB;
constexpr size_t WS_TOPI = 138 * MiB;
constexpr size_t WS_ACT = 122 * MiB;
constexpr size_t WS_SU = 245 * MiB;
constexpr size_t WS_U8 = 212 * MiB;
constexpr size_t WS_V8 = 148 * MiB;
constexpr size_t WS_PART = 10 * MiB;
constexpr size_t WS_XQ = 228 * MiB;
constexpr size_t WS_XS = 244 * MiB;
constexpr size_t WS_PEERO = 10 * MiB;
constexpr size_t WS_END = 246 * MiB;
constexpr int CW_QU = 4096, CW_QV = 4096 + 64 * 16;
constexpr int NPART = 8, NCHUNK = T / 64;

struct Args {
    const float* x; const float* norm_mix_g; const float* w_in; const float* attn_sinks; const float* attn_out_g;
    const float* conv_w; const float* conv_b; const float* dt_bias; const float* a_log; const float* d_skip;
    const float* ssm_norm_g; const float* w_out; const float* norm_ffn_g; const float* peer_wq; const float* peer_sub_keys;
    const float* peer_u; const float* peer_v; const float* final_norm_g;
    float* out; unsigned char* ws;
    int ph_lo, ph_hi;
};

#define LAS __attribute__((address_space(3)))
#define LDS_WAIT() asm volatile("s_waitcnt lgkmcnt(0)" ::: "memory")
__device__ __forceinline__ float bf2f(bf16 v) { return __uint_as_float(((unsigned)v) << 16); }
__device__ __forceinline__ unsigned f2bfu(float f) { unsigned u = __float_as_uint(f); return (u + 0x7fffu + ((u >> 16) & 1u)) >> 16; }
__device__ __forceinline__ bf16 f2bf(float f) { return (bf16)f2bfu(f); }
__device__ __forceinline__ unsigned pk2(float lo, float hi) { return f2bfu(lo) | (f2bfu(hi) << 16); }
__device__ __forceinline__ float wave_sum(float v) {
#pragma unroll
    for (int o = 1; o < 64; o <<= 1) v += __shfl_xor(v, o);
    return v;
}
__device__ __forceinline__ float silu_f(float v) { return v / (1.f + __expf(-v)); }

__device__ __forceinline__ void transpose_item(const float* W, int ldw, int K, bf16* WT, LAS float* scr, int kb, int nbk, int lane) {
    const int k0 = 64 * kb, n0 = 32 * nbk;
#pragma unroll 8
    for (int i = 0; i < 32; ++i) { const int kk = 2 * i + (lane >> 5); scr[kk * 33 + (lane & 31)] = W[(size_t)(k0 + kk) * ldw + n0 + (lane & 31)]; }
    LDS_WAIT();
    const int c = lane & 7;
#pragma unroll
    for (int j = 0; j < 4; ++j) { const int n = (lane >> 3) + 8 * j; const LAS float* s = scr + (8 * c) * 33 + n;
        v4u o; o.x = pk2(s[0 * 33], s[1 * 33]); o.y = pk2(s[2 * 33], s[3 * 33]); o.z = pk2(s[4 * 33], s[5 * 33]); o.w = pk2(s[6 * 33], s[7 * 33]);
        *(v4u*)(WT + (size_t)(n0 + n) * K + k0 + 8 * c) = o; }
    LDS_WAIT();
}

template <int MODE  >
__device__ __forceinline__ void rmsnorm_rows_bf16(const float* in, const float* g, bf16* outp, const LAS unsigned char* ldsb, float* dtraw, unsigned char* xq, float* xs, int gwave, int nwaves, int lane) {
    for (int row = gwave; row < T; row += nwaves) {
        const float4* xr = (const float4*)(in + (size_t)row * D) + lane; const uint2* xb = (const uint2*)((const bf16*)in + (size_t)row * D) + lane;
        float4 v[4]; float ss = 0.f;
#pragma unroll
        for (int j = 0; j < 4; ++j) {
            if (MODE == 2) { const uint2 w = xb[64 * j]; v[j] = make_float4(__uint_as_float(w.x << 16), __uint_as_float(w.x & 0xffff0000u), __uint_as_float(w.y << 16), __uint_as_float(w.y & 0xffff0000u)); }
            else v[j] = xr[64 * j];
            ss += v[j].x * v[j].x + v[j].y * v[j].y + v[j].z * v[j].z + v[j].w * v[j].w; }
        ss = wave_sum(ss);
        const float r = rsqrtf(ss * (1.f / D) + EPS);
        unsigned long long* o8 = (unsigned long long*)(outp + (size_t)row * D) + lane;
        float dacc[8]; float y[4][4]; float mx = 0.f;
#pragma unroll
        for (int h = 0; h < 8; ++h) dacc[h] = 0.f;
#pragma unroll
        for (int j = 0; j < 4; ++j) {
            const float4 gv = ((const float4*)g)[lane + 64 * j];
            y[j][0] = v[j].x * r * gv.x; y[j][1] = v[j].y * r * gv.y; y[j][2] = v[j].z * r * gv.z; y[j][3] = v[j].w * r * gv.w;
            o8[64 * j] = (unsigned long long)pk2(y[j][0], y[j][1]) | ((unsigned long long)pk2(y[j][2], y[j][3]) << 32);
            if (MODE == 2) mx = fmaxf(mx, fmaxf(fmaxf(fabsf(y[j][0]), fabsf(y[j][1])), fmaxf(fabsf(y[j][2]), fabsf(y[j][3]))));
            if (MODE == 1) {
#pragma unroll
                for (int h = 0; h < 8; ++h) {
                    typedef float f4v __attribute__((ext_vector_type(4)));
                    const f4v wv = *(const LAS f4v*)(ldsb + h * 16384 + 8448 + (256 * j + 4 * lane) * 4);
                    dacc[h] += y[j][0] * wv.x + y[j][1] * wv.y + y[j][2] * wv.z + y[j][3] * wv.w;
                }
            }
        }
        if (MODE == 1) {
#pragma unroll
            for (int h = 0; h < 8; ++h) dacc[h] = wave_sum(dacc[h]);
            if (lane == 0) { float4* dp = (float4*)(dtraw + (size_t)row * 8); dp[0] = make_float4(dacc[0], dacc[1], dacc[2], dacc[3]); dp[1] = make_float4(dacc[4], dacc[5], dacc[6], dacc[7]); }
        }
        if (MODE == 2) {
#pragma unroll
            for (int o = 1; o < 64; o <<= 1) mx = fmaxf(mx, __shfl_xor(mx, o));
            const float sc = mx > 0.f ? mx * (1.f / 127.f) : 1.f, inv = 1.f / sc;
            unsigned* dq = (unsigned*)(xq + (size_t)row * D) + lane;
#pragma unroll
            for (int j = 0; j < 4; ++j) { const int q0 = (int)rintf(y[j][0] * inv), q1 = (int)rintf(y[j][1] * inv), q2 = (int)rintf(y[j][2] * inv), q3 = (int)rintf(y[j][3] * inv);
                dq[64 * j] = (unsigned)(q0 & 255) | ((unsigned)(q1 & 255) << 8) | ((unsigned)(q2 & 255) << 16) | ((unsigned)(q3 & 255) << 24); }
            if (lane == 0) xs[row] = sc;
        }
    }
}

typedef short bf16x8 __attribute__((ext_vector_type(8)));
typedef short bf16x4 __attribute__((ext_vector_type(4)));
typedef float f32x16 __attribute__((ext_vector_type(16)));
typedef __bf16 bf2_t __attribute__((ext_vector_type(2)));
#define MFMA32(a, b, c) __builtin_amdgcn_mfma_f32_32x32x16_bf16((a), (b), (c), 0, 0, 0)
__device__ __forceinline__ unsigned pkbf(float lo, float hi) { bf2_t v = {(__bf16)lo, (__bf16)hi}; return __builtin_bit_cast(unsigned, v); }
__device__ __forceinline__ short bfs(float f) { return __builtin_bit_cast(short, (__bf16)f); }
__device__ __forceinline__ float sbf2f(short v) { return __uint_as_float(((unsigned)(unsigned short)v) << 16); }
__device__ __forceinline__ int crow(int i, int hi) { return (i & 3) + 8 * (i >> 2) + 4 * hi; }
template <int S> __device__ __forceinline__ bf16x8 pack8(const f32x16& x) {
    v4u p; p.x = pkbf(x[8 * S], x[8 * S + 1]); p.y = pkbf(x[8 * S + 2], x[8 * S + 3]); p.z = pkbf(x[8 * S + 4], x[8 * S + 5]); p.w = pkbf(x[8 * S + 6], x[8 * S + 7]);
    return __builtin_bit_cast(bf16x8, p);
}
__device__ __forceinline__ bf16x8 ldg8(const bf16* p) { return *(const bf16x8*)p; }
__device__ __forceinline__ bf16x8 lds8(const LAS bf16* p) { return *(const LAS bf16x8*)p; }
__device__ __forceinline__ bf16x8 lds4x2(const LAS bf16* p) { const bf16x4 a = *(const LAS bf16x4*)p, b = *(const LAS bf16x4*)(p + 8); return __builtin_shufflevector(a, b, 0, 1, 2, 3, 4, 5, 6, 7); }
__device__ __forceinline__ f32x16 zero16() { f32x16 z;
#pragma unroll
    for (int i = 0; i < 16; ++i) z[i] = 0.f;
    return z; }

__device__ __forceinline__ void attn_unit(const float* sinks, const float* gnorm, LAS unsigned char* ldsb, int unit, const bf16* PROJ, bf16* MIXB, int tid, int lane, int wave) {
    asm volatile("" : "+v"(tid), "+v"(lane));
    const int tok0 = unit * 64, s0 = tok0 & (SEQ - 1), kbase = tok0 - 128;
    LAS bf16* VT = (LAS bf16*)ldsb;
    const __amdgpu_buffer_rsrc_t rsP = __builtin_amdgcn_make_buffer_rsrc((void*)PROJ, 0, (unsigned)T * PS * 2u, 0x00020000);
    LAS float* SSQ = (LAS float*)(ldsb + 51200);
    LAS unsigned* OST = (LAS unsigned*)(ldsb + 53248) + wave * (2 * 17 * 64);
#pragma unroll
    for (int i = 0; i < 6; ++i) {
        const int c = tid + 512 * i, kv = c / 1536, cc = c - kv * 1536, key = cc >> 3, d0 = (cc & 7) * 8; const bool valid = (s0 - 128 + key) >= 0;
        bf16x8 v;
#pragma unroll
        for (int e = 0; e < 8; ++e) v[e] = 0;
        if (valid) v = __builtin_bit_cast(bf16x8, __builtin_amdgcn_raw_buffer_load_b128(rsP, (int)(((unsigned)(kbase + key) * (unsigned)PS + (unsigned)(OV + kv * 64 + d0)) * 2u), 0, 0));
#pragma unroll
        for (int e = 0; e < 8; ++e) VT[kv * 12800 + (d0 + e) * 200 + key] = (bf16)v[e];
    }
    __syncthreads();
    const int r = lane & 31, hi = lane >> 5;
    const int hq = wave, hkv = wave >> 2;
    const float slope = exp2f(-(float)(hq + 1)), sink = sinks[hq];
#pragma unroll 1
    for (int qt = 0; qt < 2; ++qt) {
        const int tq = tok0 + 32 * qt + r;
        bf16x8 qf[4];
        { const bf16* qp = PROJ + (size_t)tq * PS + OQ + hq * 64 + 8 * hi; asm volatile("" : "+v"(qp));
#pragma unroll
          for (int ks = 0; ks < 4; ++ks) qf[ks] = ldg8(qp + 16 * ks); }
        const int ql = 32 * qt + r;
        float m = sink, lh = 0.f;
        f32x16 O0 = zero16(), O1 = zero16();
        bf16x8 kfn[4];
        { const int key = 32 * qt + r; const bool kvalid = (s0 - 128 + key) >= 0;
          const bf16* kp = PROJ + (size_t)(kvalid ? (kbase + key) : tok0) * PS + OKK + hkv * 64 + 8 * hi; asm volatile("" : "+v"(kp));
#pragma unroll
          for (int ks = 0; ks < 4; ++ks) kfn[ks] = ldg8(kp + 16 * ks); }
#pragma unroll 1
        for (int kt = 0; kt < 5; ++kt) {
            bf16x8 kf[4];
#pragma unroll
            for (int ks = 0; ks < 4; ++ks) kf[ks] = kfn[ks];
            { const int ktn = kt < 4 ? kt + 1 : 4; const int key = 32 * (qt + ktn) + r; const bool kvalid = (s0 - 128 + key) >= 0;
              const bf16* kp = PROJ + (size_t)(kvalid ? (kbase + key) : tok0) * PS + OKK + hkv * 64 + 8 * hi; asm volatile("" : "+v"(kp));
#pragma unroll
              for (int ks = 0; ks < 4; ++ks) kfn[ks] = ldg8(kp + 16 * ks); }
            f32x16 X = zero16();
#pragma unroll
            for (int ks = 0; ks < 4; ++ks) X = MFMA32(kf[ks], qf[ks], X);
            float tm = -1e30f;
#pragma unroll
            for (int i = 0; i < 16; ++i) {
                const int kl = 32 * (qt + kt) + crow(i, hi), dist = 128 + ql - kl;
                const bool valid = (dist >= 0) && (dist < 128) && ((s0 - 128 + kl) >= 0);
                const float lg = valid ? (X[i] * 0.125f - slope * (float)dist) : -1e30f;
                X[i] = lg; tm = fmaxf(tm, lg);
            }
            tm = fmaxf(tm, __shfl_xor(tm, 32));
            const float mn = fmaxf(m, tm), sc = __expf(m - mn);
            m = mn; lh *= sc;
#pragma unroll
            for (int i = 0; i < 16; ++i) { O0[i] *= sc; O1[i] *= sc; const float pe = __expf(X[i] - mn); X[i] = pe; lh += pe; }
            const LAS bf16* vp = VT + hkv * 12800 + r * 200 + 32 * (qt + kt) + 4 * hi;
            { const bf16x8 xs = pack8<0>(X); const bf16x8 a0 = lds4x2(vp), a1 = lds4x2(vp + 32 * 200); O0 = MFMA32(a0, xs, O0); O1 = MFMA32(a1, xs, O1); }
            { const bf16x8 xs = pack8<1>(X); const bf16x8 a0 = lds4x2(vp + 16), a1 = lds4x2(vp + 32 * 200 + 16); O0 = MFMA32(a0, xs, O0); O1 = MFMA32(a1, xs, O1); }
        }
        const float lsum = lh + __shfl_xor(lh, 32) + __expf(sink - m);
        const float iv = 1.f / lsum;
        float sq = 0.f;
#pragma unroll
        for (int i = 0; i < 16; ++i) sq += O0[i] * O0[i] + O1[i] * O1[i];
        sq *= iv * iv; sq += __shfl_xor(sq, 32);
        if (hi == 0) SSQ[hq * 64 + 32 * qt + r] = sq;
#pragma unroll
        for (int i = 0; i < 8; ++i) { OST[(qt * 17 + i) * 64 + lane] = pkbf(O0[2 * i], O0[2 * i + 1]); OST[(qt * 17 + 8 + i) * 64 + lane] = pkbf(O1[2 * i], O1[2 * i + 1]); }
        OST[(qt * 17 + 16) * 64 + lane] = __float_as_uint(iv);
    }
    __syncthreads();
#pragma unroll 1
    for (int qt = 0; qt < 2; ++qt) {
        float tot = 0.f;
#pragma unroll
        for (int h = 0; h < 8; ++h) tot += SSQ[h * 64 + 32 * qt + r];
        const float sc = __uint_as_float(OST[(qt * 17 + 16) * 64 + lane]) * rsqrtf(tot * (1.f / 512.f) + EPS);
        bf16* orow = MIXB + (size_t)(tok0 + 32 * qt + r) * D + hq * 64 + 4 * hi;
#pragma unroll
        for (int dt = 0; dt < 2; ++dt)
#pragma unroll
            for (int q4 = 0; q4 < 4; ++q4) {
                const float4 gv = *(const float4*)(gnorm + hq * 64 + 32 * dt + 8 * q4 + 4 * hi);
                const unsigned p0 = OST[(qt * 17 + 8 * dt + 2 * q4) * 64 + lane], p1 = OST[(qt * 17 + 8 * dt + 2 * q4 + 1) * 64 + lane];
                uint2 w; w.x = pkbf(__uint_as_float(p0 << 16) * sc * gv.x, __uint_as_float(p0 & 0xffff0000u) * sc * gv.y); w.y = pkbf(__uint_as_float(p1 << 16) * sc * gv.z, __uint_as_float(p1 & 0xffff0000u) * sc * gv.w);
                *(uint2*)(orow + 32 * dt + 8 * q4) = w;
            }
    }
    __syncthreads();
}

__device__ __forceinline__ void ssd_chunk_unit(LAS unsigned char* ldsb, int unit, const bf16* PROJ, bf16* XACT, const float* DTRAW, const float* conv_w, const float* conv_b, const float* dt_bias, const float* a_log,
                                               float* ACS, float* CDEC, float* MIXF, float* STATES, int tid, int lane, int wave) {
    asm volatile("" : "+v"(tid), "+v"(lane));
    const int g = unit & 1, bc = unit >> 1, tok0 = bc * 128;
    LAS float* DTT = (LAS float*)(ldsb + 34816 * 3 + 2048);
    LAS float* WT = (LAS float*)(ldsb + 34816 * 3 + 4096);
    {
        const int cgi = tid & 63, t0 = tok0 + 16 * (tid >> 6);
        const int c0 = cgi < 32 ? g * 256 + cgi * 8 : (cgi < 48 ? 512 + g * 128 + (cgi - 32) * 8 : 768 + g * 128 + (cgi - 48) * 8);
        float w[4][8], bs[8];
#pragma unroll
        for (int k = 0; k < 4; ++k) { const float4 a0 = *(const float4*)(conv_w + k * 1024 + c0), a1 = *(const float4*)(conv_w + k * 1024 + c0 + 4);
            w[k][0] = a0.x; w[k][1] = a0.y; w[k][2] = a0.z; w[k][3] = a0.w; w[k][4] = a1.x; w[k][5] = a1.y; w[k][6] = a1.z; w[k][7] = a1.w; }
        { const float4 a0 = *(const float4*)(conv_b + c0), a1 = *(const float4*)(conv_b + c0 + 4); bs[0] = a0.x; bs[1] = a0.y; bs[2] = a0.z; bs[3] = a0.w; bs[4] = a1.x; bs[5] = a1.y; bs[6] = a1.z; bs[7] = a1.w; }
        const bool has_halo = (t0 & (SEQ - 1)) != 0;
        bf16x8 rows[19];
#pragma unroll
        for (int i = 0; i < 19; ++i) {
            if (i < 3 && !has_halo) {
#pragma unroll
                for (int e = 0; e < 8; ++e) rows[i][e] = 0;
            } else rows[i] = ldg8(PROJ + (size_t)(t0 + i - 3) * PS + OXBC + c0);
        }
#pragma unroll
        for (int i = 0; i < 16; ++i) {
            float o[8];
#pragma unroll
            for (int e = 0; e < 8; ++e) o[e] = silu_f(bs[e] + w[0][e] * sbf2f(rows[i][e]) + w[1][e] * sbf2f(rows[i + 1][e]) + w[2][e] * sbf2f(rows[i + 2][e]) + w[3][e] * sbf2f(rows[i + 3][e]));
            v4u ov; ov.x = pkbf(o[0], o[1]); ov.y = pkbf(o[2], o[3]); ov.z = pkbf(o[4], o[5]); ov.w = pkbf(o[6], o[7]);
            *(v4u*)(XACT + (size_t)(t0 + i) * 1024 + c0) = ov;
        }
    }
    LAS float* ACST = (LAS float*)(ldsb + 34816 * 3);
    {
        const int s = tid >> 2, hh = tid & 3, H = g * 4 + hh;
        const float A = -__expf(a_log[H]);
        const float raw = DTRAW[(size_t)(tok0 + s) * 8 + H] + dt_bias[H];
        const float dtv = fmaxf(raw, 0.f) + log1pf(__expf(-fabsf(raw)));
        float v = dtv * A;
#pragma unroll
        for (int o = 4; o < 64; o <<= 1) { const float y = __shfl_up(v, o); if (lane >= o) v += y; }
        if (lane >= 60) WT[wave * 4 + hh] = v;
        __syncthreads();
        float off = 0.f;
        for (int w2 = 0; w2 < wave; ++w2) off += WT[w2 * 4 + hh];
        v += off;
        DTT[tid] = dtv; ACST[tid] = v; ACS[(size_t)(tok0 + s) * 8 + H] = v;
        if (s == 127) CDEC[bc * 8 + H] = __expf(v);
    }
    asm volatile("s_waitcnt vmcnt(0)" ::: "memory");
    __syncthreads();
    LAS bf16* BT = (LAS bf16*)ldsb;
    LAS bf16* XD = (LAS bf16*)(ldsb + 34816);
    LAS bf16* XW = (LAS bf16*)(ldsb + 34816 + 34816);
    const int r = lane & 31, hi = lane >> 5;
#pragma unroll
    for (int i = 0; i < 4; ++i) {
        const int c = tid + 512 * i, s = c >> 4, n0 = (c & 15) * 8;
        const bf16x8 v = ldg8(XACT + (size_t)(tok0 + s) * 1024 + 512 + g * 128 + n0);
#pragma unroll
        for (int e = 0; e < 8; ++e) BT[(n0 + e) * 136 + s] = (bf16)v[e];
    }
#pragma unroll 1
    for (int hp = 0; hp < 2; ++hp) {
        if (hp) __syncthreads();
        int tidp = tid; asm volatile("" : "+v"(tidp));
#pragma unroll
        for (int i = 0; i < 4; ++i) {
            const int c = tidp + 512 * i, hsel = c >> 10, s = (c >> 3) & 127, p0 = (c & 7) * 8, H = g * 4 + 2 * hp + hsel;
            const bf16x8 v = ldg8(XACT + (size_t)(tok0 + s) * 1024 + H * 64 + p0);
            const float dtv = DTT[s * 4 + 2 * hp + hsel];
            const float w = __expf(ACST[127 * 4 + 2 * hp + hsel] - ACST[s * 4 + 2 * hp + hsel]);
#pragma unroll
            for (int e = 0; e < 8; ++e) { const float xd = sbf2f(v[e]) * dtv; XD[hsel * 8704 + (p0 + e) * 136 + s] = (bf16)bfs(xd); XW[hsel * 8704 + (p0 + e) * 136 + s] = (bf16)bfs(xd * w); }
        }
        __syncthreads();
        {
            const int lt = wave & 3, hsel = wave >> 2, hh = 2 * hp + hsel, H = g * 4 + hh;
            const int l = 32 * lt + r; const float acs_l = ACST[l * 4 + hh];
            bf16x8 cf[8];
            { const bf16* cp = XACT + (size_t)(tok0 + l) * 1024 + 768 + g * 128 + 8 * hi; asm volatile("" : "+v"(cp));
#pragma unroll
              for (int ks = 0; ks < 8; ++ks) cf[ks] = ldg8(cp + 16 * ks); }
            f32x16 Z0 = zero16(), Z1 = zero16();
            bf16x8 bn[8];
            { const bf16* bp = XACT + (size_t)(tok0 + r) * 1024 + 512 + g * 128 + 8 * hi; asm volatile("" : "+v"(bp));
#pragma unroll
              for (int ks = 0; ks < 8; ++ks) bn[ks] = ldg8(bp + 16 * ks); }
#pragma unroll 1
            for (int st = 0; st <= lt; ++st) {
                f32x16 X = zero16();
                bf16x8 bc[8];
#pragma unroll
                for (int ks = 0; ks < 8; ++ks) bc[ks] = bn[ks];
                { const int stn = st < lt ? st + 1 : lt; const bf16* bp = XACT + (size_t)(tok0 + 32 * stn + r) * 1024 + 512 + g * 128 + 8 * hi; asm volatile("" : "+v"(bp));
#pragma unroll
                  for (int ks = 0; ks < 8; ++ks) bn[ks] = ldg8(bp + 16 * ks); }
#pragma unroll
                for (int ks = 0; ks < 8; ++ks) X = MFMA32(bc[ks], cf[ks], X);
#pragma unroll
                for (int i = 0; i < 16; ++i) { const int s = 32 * st + crow(i, hi); const float f = (s <= l) ? __expf(acs_l - ACST[s * 4 + hh]) : 0.f; X[i] *= f; }
                const int sb = 32 * st + 4 * hi;
                { const bf16x8 xs = pack8<0>(X); const bf16x8 b0 = lds4x2(XD + hsel * 8704 + r * 136 + sb), b1 = lds4x2(XD + hsel * 8704 + (32 + r) * 136 + sb); Z0 = MFMA32(xs, b0, Z0); Z1 = MFMA32(xs, b1, Z1); }
                { const bf16x8 xs = pack8<1>(X); const bf16x8 b0 = lds4x2(XD + hsel * 8704 + r * 136 + sb + 16), b1 = lds4x2(XD + hsel * 8704 + (32 + r) * 136 + sb + 16); Z0 = MFMA32(xs, b0, Z0); Z1 = MFMA32(xs, b1, Z1); }
            }
#pragma unroll
            for (int i = 0; i < 16; ++i) { float* o = MIXF + (size_t)(tok0 + 32 * lt + crow(i, hi)) * D + 512 + H * 64 + r; o[0] = Z0[i]; o[32] = Z1[i]; }
        }
        {
            const int nt = wave & 3, hsel = wave >> 2, H = g * 4 + 2 * hp + hsel;
            f32x16 S0 = zero16(), S1 = zero16();
#pragma unroll
            for (int ks = 0; ks < 8; ++ks) {
                const bf16x8 btf = lds8(BT + (32 * nt + r) * 136 + 16 * ks + 8 * hi);
                const bf16x8 a0 = lds8(XW + hsel * 8704 + r * 136 + 16 * ks + 8 * hi), a1 = lds8(XW + hsel * 8704 + (32 + r) * 136 + 16 * ks + 8 * hi);
                S0 = MFMA32(a0, btf, S0); S1 = MFMA32(a1, btf, S1);
            }
            float* sp = STATES + (size_t)(bc * 8 + H) * 8192 + 32 * nt + r;
#pragma unroll
            for (int i = 0; i < 16; ++i) { const int p = crow(i, hi); sp[p * 128] = S0[i]; sp[(32 + p) * 128] = S1[i]; }
        }
    }
    __syncthreads();
}

__device__ __forceinline__ __amdgpu_buffer_rsrc_t mk_rsrc(const void* p, unsigned bytes) { return __builtin_amdgcn_make_buffer_rsrc((void*)p, 0, bytes, 0x00020000); }
__device__ __forceinline__ void yoff_unit(const float* d_skip, const float* gnorm, LAS unsigned char* ldsb, int unit, const bf16* XACT, const bf16* PROJ, const float* ACS, const bf16* PREVT,
                                          const float* MIXF, bf16* MIXB, int lane, int wave) {
    const int g = unit & 1, bc = unit >> 1, tok0 = bc * 128;
    const int r = lane & 31, hi = lane >> 5, lt = wave & 3, hpair = wave >> 2;
    LAS float* TAB = (LAS float*)ldsb;
    const __amdgpu_buffer_rsrc_t rsF = mk_rsrc(MIXF, (unsigned)T * D * 4u), rsX = mk_rsrc(XACT, (unsigned)T * 1024u * 2u), rsP = mk_rsrc(PROJ, (unsigned)T * PS * 2u), rsA = mk_rsrc(ACS, (unsigned)T * 32u), rsB = mk_rsrc(MIXB, (unsigned)T * D * 2u);
    const unsigned tb = (unsigned)(tok0 + 32 * lt + 4 * hi);
    bf16x8 cf[8];
    { const bf16* cp = XACT + (size_t)(tok0 + 32 * lt + r) * 1024 + 768 + g * 128 + 8 * hi; asm volatile("" : "+v"(cp));
#pragma unroll
      for (int ks = 0; ks < 8; ++ks) cf[ks] = ldg8(cp + 16 * ks); }
    float eav[16], ssq[16];
    unsigned ypk[2][2][8];
#pragma unroll
    for (int i = 0; i < 16; ++i) ssq[i] = 0.f;
#pragma unroll
    for (int hsel = 0; hsel < 2; ++hsel) {
        const int H = g * 4 + 2 * hpair + hsel; const bf16* pv = PREVT + (size_t)(bc * 8 + H) * 8192 + 8 * hi;
        asm volatile("" : "+v"(pv));
        f32x16 Y0 = zero16(), Y1 = zero16();
#pragma unroll
        for (int ks = 0; ks < 8; ++ks) {
            const bf16x8 b0 = ldg8(pv + r * 128 + 16 * ks), b1 = ldg8(pv + (32 + r) * 128 + 16 * ks);
            Y0 = MFMA32(cf[ks], b0, Y0); Y1 = MFMA32(cf[ks], b1, Y1);
        }
        const float dsk = d_skip[H];
        { const unsigned vo = (tb * 8u + (unsigned)H) * 4u;
#pragma unroll
          for (int i = 0; i < 16; ++i) eav[i] = __expf(__builtin_bit_cast(float, __builtin_amdgcn_raw_buffer_load_b32(rsA, (int)vo, ((i & 3) + 8 * (i >> 2)) * 32, 0))); }
#pragma unroll
        for (int pt = 0; pt < 2; ++pt) {
            const unsigned col = (unsigned)(H * 64 + 32 * pt + r);
            const unsigned voF = (tb * 1024u + 512u + col) * 4u, voX = (tb * 1024u + col) * 2u, voP = (tb * (unsigned)PS + (unsigned)OZ + col) * 2u;
            float yo[16], xsv[16], zv[16];
#pragma unroll
            for (int i = 0; i < 16; ++i) { const int ro = (i & 3) + 8 * (i >> 2);
                yo[i] = __builtin_bit_cast(float, __builtin_amdgcn_raw_buffer_load_b32(rsF, (int)voF, ro * 4096, 0));
                xsv[i] = bf2f((bf16)__builtin_amdgcn_raw_buffer_load_b16(rsX, (int)voX, ro * 2048, 0));
                zv[i] = bf2f((bf16)__builtin_amdgcn_raw_buffer_load_b16(rsP, (int)voP, ro * (PS * 2), 0)); }
#pragma unroll
            for (int i = 0; i < 16; i += 2) {
                const float y0 = (yo[i] + eav[i] * (pt ? Y1[i] : Y0[i]) + dsk * xsv[i]) * silu_f(zv[i]);
                const float y1 = (yo[i + 1] + eav[i + 1] * (pt ? Y1[i + 1] : Y0[i + 1]) + dsk * xsv[i + 1]) * silu_f(zv[i + 1]);
                ssq[i] += y0 * y0; ssq[i + 1] += y1 * y1; ypk[hsel][pt][i >> 1] = pkbf(y0, y1);
            }
            __builtin_amdgcn_sched_barrier(0);
        }
    }
#pragma unroll
    for (int i = 0; i < 16; ++i) {
#pragma unroll
        for (int o = 1; o < 32; o <<= 1) ssq[i] += __shfl_xor(ssq[i], o);
    }
    if (r == 0) {
#pragma unroll
        for (int i = 0; i < 16; ++i) TAB[hpair * 128 + 32 * lt + crow(i, hi)] = ssq[i];
    }
    __syncthreads();
#pragma unroll
    for (int i = 0; i < 16; ++i) { const int l = 32 * lt + crow(i, hi); ssq[i] = rsqrtf((TAB[l] + TAB[128 + l]) * (1.f / 256.f) + EPS); }
#pragma unroll
    for (int hsel = 0; hsel < 2; ++hsel)
#pragma unroll
        for (int pt = 0; pt < 2; ++pt) {
            const unsigned col = (unsigned)((g * 4 + 2 * hpair + hsel) * 64 + 32 * pt + r); const float gn = gnorm[col];
            const unsigned voB = (tb * 1024u + 512u + col) * 2u;
#pragma unroll
            for (int i = 0; i < 16; ++i) { const unsigned w = ypk[hsel][pt][i >> 1];
                const float yf = (i & 1) ? __uint_as_float(w & 0xffff0000u) : __uint_as_float(w << 16);
                __builtin_amdgcn_raw_buffer_store_b16((short)f2bf(yf * ssq[i] * gn), rsB, (int)voB, ((i & 3) + 8 * (i >> 2)) * 2048, 0); }
        }
    __syncthreads();
}
typedef float f32x2 __attribute__((ext_vector_type(2)));
__device__ __forceinline__ void fp8x16_to_f32(const uint4 w, float (&f)[16]) {
    const int ww[4] = {(int)w.x, (int)w.y, (int)w.z, (int)w.w};
#pragma unroll
    for (int q = 0; q < 4; ++q) { const f32x2 a = __builtin_amdgcn_cvt_pk_f32_fp8(ww[q], false), b = __builtin_amdgcn_cvt_pk_f32_fp8(ww[q], true); f[4 * q] = a.x; f[4 * q + 1] = a.y; f[4 * q + 2] = b.x; f[4 * q + 3] = b.y; }
}
template <int M4, int M2, int M1> __device__ __forceinline__ void treduce16(const float (&a)[16], int lane, float& r0, float& r1) {
    float b[8], c[4];
    { const bool hi = (lane & M4) != 0;
#pragma unroll
      for (int i = 0; i < 8; ++i) { const float send = hi ? a[i] : a[i + 8]; const float recv = __shfl_xor(send, M4); b[i] = (hi ? a[i + 8] : a[i]) + recv; } }
    { const bool hi = (lane & M2) != 0;
#pragma unroll
      for (int i = 0; i < 4; ++i) { const float send = hi ? b[i] : b[i + 4]; const float recv = __shfl_xor(send, M2); c[i] = (hi ? b[i + 4] : b[i]) + recv; } }
    { const bool hi = (lane & M1) != 0;
      { const float send = hi ? c[0] : c[2]; const float recv = __shfl_xor(send, M1); r0 = (hi ? c[2] : c[0]) + recv; }
      { const float send = hi ? c[1] : c[3]; const float recv = __shfl_xor(send, M1); r1 = (hi ? c[3] : c[1]) + recv; } }
}
template <int M4, int M2, int M1> __device__ __forceinline__ void treduce16i(const int (&a)[16], int lane, int& r0, int& r1) {
    int b[8], c[4];
    { const bool hi = (lane & M4) != 0;
#pragma unroll
      for (int i = 0; i < 8; ++i) { const int send = hi ? a[i] : a[i + 8]; const int recv = __shfl_xor(send, M4); b[i] = (hi ? a[i + 8] : a[i]) + recv; } }
    { const bool hi = (lane & M2) != 0;
#pragma unroll
      for (int i = 0; i < 4; ++i) { const int send = hi ? b[i] : b[i + 4]; const int recv = __shfl_xor(send, M2); c[i] = (hi ? b[i + 4] : b[i]) + recv; } }
    { const bool hi = (lane & M1) != 0;
      { const int send = hi ? c[0] : c[2]; const int recv = __shfl_xor(send, M1); r0 = (hi ? c[2] : c[0]) + recv; }
      { const int send = hi ? c[1] : c[3]; const int recv = __shfl_xor(send, M1); r1 = (hi ? c[3] : c[1]) + recv; } }
}
#define PE_ID(E, i) (((i) & 1) ? (E[(i) >> 1] >> 16) : (E[(i) >> 1] & 0xffffu))
__device__ __forceinline__ void peer_u_item(int p, int j, const unsigned short* __restrict__ IDX, const unsigned char* __restrict__ XQ, const unsigned char* __restrict__ U8, int* __restrict__ PART, int lane, int wave) {
    asm volatile("" : "+v"(lane));
    const int gidx = lane >> 3; const unsigned coff = (unsigned)(p * 128 + (lane & 7) * 16);
#pragma unroll 1
    for (int it = 0; it < 8; ++it) {
        const int t = j * 64 + it * 8 + wave;
        unsigned E[8];
        { const uint4 e0 = *(const uint4*)(IDX + (size_t)t * 128 + 16 * gidx), e1 = *(const uint4*)(IDX + (size_t)t * 128 + 16 * gidx + 8);
          E[0] = e0.x; E[1] = e0.y; E[2] = e0.z; E[3] = e0.w; E[4] = e1.x; E[5] = e1.y; E[6] = e1.z; E[7] = e1.w; }
        uint4 uu[16];
#pragma unroll
        for (int i = 0; i < 16; ++i) uu[i] = *(const uint4*)(U8 + (size_t)(PE_ID(E, i) * 1024u + coff));
        const uint4 xq = *(const uint4*)(XQ + (size_t)t * D + coff);
        int d[16];
#pragma unroll
        for (int i = 0; i < 16; ++i) {
            int s = __builtin_amdgcn_sdot4((int)uu[i].x, (int)xq.x, 0, false); s = __builtin_amdgcn_sdot4((int)uu[i].y, (int)xq.y, s, false);
            s = __builtin_amdgcn_sdot4((int)uu[i].z, (int)xq.z, s, false); s = __builtin_amdgcn_sdot4((int)uu[i].w, (int)xq.w, s, false);
            d[i] = s;
        }
        int r0, r1; treduce16i<4, 2, 1>(d, lane, r0, r1);
        *(int2*)(PART + ((size_t)p * T + t) * 128 + 2 * lane) = make_int2(r0, r1);
    }
}
__device__ __forceinline__ void peer_v_item(int p, int j, const unsigned short* __restrict__ IDX, const unsigned char* __restrict__ ACTQ, const float* __restrict__ ACTS,
                                            const unsigned char* __restrict__ V8, bf16* __restrict__ PEERO, int lane, int wave) {
    asm volatile("" : "+v"(lane));
    const int gidx = lane >> 3; const unsigned coff = (unsigned)(p * 128 + (lane & 7) * 16);
#pragma unroll 1
    for (int it = 0; it < 8; ++it) {
        const int t = j * 64 + it * 8 + wave;
        unsigned E[8];
        { const uint4 e0 = *(const uint4*)(IDX + (size_t)t * 128 + 16 * gidx), e1 = *(const uint4*)(IDX + (size_t)t * 128 + 16 * gidx + 8);
          E[0] = e0.x; E[1] = e0.y; E[2] = e0.z; E[3] = e0.w; E[4] = e1.x; E[5] = e1.y; E[6] = e1.z; E[7] = e1.w; }
        uint4 vv[16];
#pragma unroll
        for (int i = 0; i < 16; ++i) vv[i] = *(const uint4*)(V8 + (size_t)(PE_ID(E, i) * 1024u + coff));
        const uint4 aq = *(const uint4*)(ACTQ + (size_t)t * 128 + 16 * gidx);
        const float asc = ACTS[t];
        const unsigned a4[4] = {aq.x, aq.y, aq.z, aq.w};
        int acc[16];
#pragma unroll
        for (int c = 0; c < 16; ++c) acc[c] = 0;
#pragma unroll
        for (int m = 0; m < 4; ++m) {
            const unsigned r0[4] = {vv[4 * m].x, vv[4 * m].y, vv[4 * m].z, vv[4 * m].w}, r1[4] = {vv[4 * m + 1].x, vv[4 * m + 1].y, vv[4 * m + 1].z, vv[4 * m + 1].w};
            const unsigned r2[4] = {vv[4 * m + 2].x, vv[4 * m + 2].y, vv[4 * m + 2].z, vv[4 * m + 2].w}, r3[4] = {vv[4 * m + 3].x, vv[4 * m + 3].y, vv[4 * m + 3].z, vv[4 * m + 3].w};
#pragma unroll
            for (int dc = 0; dc < 4; ++dc) {
                const unsigned ta = __builtin_amdgcn_perm(r1[dc], r0[dc], 0x05010400u), tb = __builtin_amdgcn_perm(r3[dc], r2[dc], 0x05010400u);
                const unsigned ua = __builtin_amdgcn_perm(r1[dc], r0[dc], 0x07030602u), ub = __builtin_amdgcn_perm(r3[dc], r2[dc], 0x07030602u);
                const unsigned c0 = __builtin_amdgcn_perm(tb, ta, 0x05040100u), c1 = __builtin_amdgcn_perm(tb, ta, 0x07060302u);
                const unsigned c2 = __builtin_amdgcn_perm(ub, ua, 0x05040100u), c3 = __builtin_amdgcn_perm(ub, ua, 0x07060302u);
                acc[4 * dc + 0] = __builtin_amdgcn_sdot4((int)c0, (int)a4[m], acc[4 * dc + 0], false);
                acc[4 * dc + 1] = __builtin_amdgcn_sdot4((int)c1, (int)a4[m], acc[4 * dc + 1], false);
                acc[4 * dc + 2] = __builtin_amdgcn_sdot4((int)c2, (int)a4[m], acc[4 * dc + 2], false);
                acc[4 * dc + 3] = __builtin_amdgcn_sdot4((int)c3, (int)a4[m], acc[4 * dc + 3], false);
            }
        }
        int r0i, r1i; treduce16i<32, 16, 8>(acc, lane, r0i, r1i);
        *(unsigned*)(PEERO + (size_t)t * D + coff + 2 * gidx) = pkbf(asc * (float)r0i, asc * (float)r1i);
    }
}

__device__ __forceinline__ void ce_desc(float& a, float& b) { const float hi = fmaxf(a, b), lo = fminf(a, b); a = hi; b = lo; }
__device__ __forceinline__ void sort16_desc(float (&v)[16]) {
#pragma unroll
    for (int k = 2; k <= 16; k <<= 1)
#pragma unroll
        for (int j = k >> 1; j > 0; j >>= 1)
#pragma unroll
            for (int i = 0; i < 16; ++i) { const int l = i ^ j; if (l > i) { if ((i & k) == 0) ce_desc(v[i], v[l]); else ce_desc(v[l], v[i]); } }
}
__device__ __forceinline__ void merge16_desc(float (&a)[16], const float (&b)[16]) {
#pragma unroll
    for (int i = 0; i < 16; ++i) a[i] = fmaxf(a[i], b[15 - i]);
#pragma unroll
    for (int j = 8; j > 0; j >>= 1)
#pragma unroll
        for (int i = 0; i < 16; ++i) { const int l = i ^ j; if (l > i) ce_desc(a[i], a[l]); }
}
__device__ __forceinline__ void ce_kv(float& ka, int& va, float& kb, int& vb) {
    const bool s = kb > ka; const float t0 = s ? kb : ka, t1 = s ? ka : kb; const int u0 = s ? vb : va, u1 = s ? va : vb; ka = t0; kb = t1; va = u0; vb = u1; }
__device__ __forceinline__ void sort16_kv(float (&k)[16], int (&v)[16]) {
#pragma unroll
    for (int kk = 2; kk <= 16; kk <<= 1)
#pragma unroll
        for (int j = kk >> 1; j > 0; j >>= 1)
#pragma unroll
            for (int i = 0; i < 16; ++i) { const int l = i ^ j; if (l > i) { if ((i & kk) == 0) ce_kv(k[i], v[i], k[l], v[l]); else ce_kv(k[l], v[l], k[i], v[i]); } }
}
__device__ __forceinline__ void merge16_kv(float (&ka)[16], int (&va)[16], const float (&kb)[16], const int (&vb)[16]) {
#pragma unroll
    for (int i = 0; i < 16; ++i) { const bool s = kb[15 - i] > ka[i]; ka[i] = s ? kb[15 - i] : ka[i]; va[i] = s ? vb[15 - i] : va[i]; }
#pragma unroll
    for (int j = 8; j > 0; j >>= 1)
#pragma unroll
        for (int i = 0; i < 16; ++i) { const int l = i ^ j; if (l > i) ce_kv(ka[i], va[i], ka[l], va[l]); }
}
__device__ __forceinline__ void split8(const float* p, bf16x8& hi8, bf16x8& lo8) {
    const float4 f0 = *(const float4*)p, f1 = *(const float4*)(p + 4);
    const float x[8] = {f0.x, f0.y, f0.z, f0.w, f1.x, f1.y, f1.z, f1.w};
#pragma unroll
    for (int j = 0; j < 8; ++j) { const short h = bfs(x[j]); hi8[j] = h; lo8[j] = bfs(x[j] - sbf2f(h)); }
}
__device__ __forceinline__ void route_task(int task, const float* QP, const bf16* KH, const bf16* KL, unsigned short* IDX, float* GATE, int lane) {
    const int r = lane & 31, hi = lane >> 5, t = 4 * task + (r >> 3), head = r & 7;
    float top[2][16];
#pragma unroll
    for (int half = 0; half < 2; ++half) {
        bf16x8 qh[4], ql[4];
#pragma unroll
        for (int ks = 0; ks < 4; ++ks) split8(QP + (size_t)t * D + head * 128 + half * 64 + 16 * ks + 8 * hi, qh[ks], ql[ks]);
        float cur[16];
#pragma unroll
        for (int kt = 0; kt < 4; ++kt) {
            f32x16 X = zero16();
            const bf16* khp = KH + (size_t)(half * 128 + 32 * kt + r) * 64 + 8 * hi; const bf16* klp = KL + (size_t)(half * 128 + 32 * kt + r) * 64 + 8 * hi;
            asm volatile("" : "+v"(khp), "+v"(klp));
#pragma unroll
            for (int ks = 0; ks < 4; ++ks) {
                const bf16x8 kh = ldg8(khp + 16 * ks), kl = ldg8(klp + 16 * ks);
                X = MFMA32(kh, qh[ks], X); X = MFMA32(kh, ql[ks], X); X = MFMA32(kl, qh[ks], X);
            }
            float grp[16];
#pragma unroll
            for (int i = 0; i < 16; ++i) { const unsigned key = (unsigned)(32 * kt + crow(i, hi)); grp[i] = __uint_as_float((__float_as_uint(X[i]) & ~127u) | (127u - key)); }
            sort16_desc(grp);
            if (kt == 0) {
#pragma unroll
                for (int i = 0; i < 16; ++i) cur[i] = grp[i];
            } else merge16_desc(cur, grp);
        }
        float oth[16];
#pragma unroll
        for (int i = 0; i < 16; ++i) oth[i] = __shfl_xor(cur[i], 32);
        merge16_desc(cur, oth);
#pragma unroll
        for (int i = 0; i < 16; ++i) top[half][i] = cur[i];
    }
    unsigned P1[4], P2[4];
#pragma unroll
    for (int q = 0; q < 4; ++q) { P1[q] = 0u; P2[q] = 0u;
#pragma unroll
        for (int s = 0; s < 4; ++s) { P1[q] |= (127u - (__float_as_uint(top[0][4 * q + s]) & 127u)) << (8 * s); P2[q] |= (127u - (__float_as_uint(top[1][4 * q + s]) & 127u)) << (8 * s); } }
#define CAND(a, b) __uint_as_float((__float_as_uint(top[0][a] + top[1][b]) & ~255u) | (255u - (unsigned)((a) * 16 + (b))))
    float bk[16];
    {
        float gk[16];
        gk[0] = CAND(0, 0);
        gk[1] = CAND(0, 1);
        gk[2] = CAND(0, 2);
        gk[3] = CAND(0, 3);
        gk[4] = CAND(0, 4);
        gk[5] = CAND(0, 5);
        gk[6] = CAND(0, 6);
        gk[7] = CAND(0, 7);
        gk[8] = CAND(0, 8);
        gk[9] = CAND(0, 9);
        gk[10] = CAND(0, 10);
        gk[11] = CAND(0, 11);
        gk[12] = CAND(0, 12);
        gk[13] = CAND(0, 13);
        gk[14] = CAND(0, 14);
        gk[15] = CAND(0, 15);
        sort16_desc(gk);
#pragma unroll
        for (int i = 0; i < 16; ++i) bk[i] = gk[i];
    }
    {
        float gk[16];
        gk[0] = CAND(1, 0);
        gk[1] = CAND(1, 1);
        gk[2] = CAND(1, 2);
        gk[3] = CAND(1, 3);
        gk[4] = CAND(1, 4);
        gk[5] = CAND(1, 5);
        gk[6] = CAND(1, 6);
        gk[7] = CAND(1, 7);
        gk[8] = CAND(2, 0);
        gk[9] = CAND(2, 1);
        gk[10] = CAND(2, 2);
        gk[11] = CAND(2, 3);
        gk[12] = CAND(2, 4);
        gk[13] = CAND(3, 0);
        gk[14] = CAND(3, 1);
        gk[15] = CAND(3, 2);
        sort16_desc(gk);
        merge16_desc(bk, gk);
    }
    {
        float gk[16];
        gk[0] = CAND(3, 3);
        gk[1] = CAND(4, 0);
        gk[2] = CAND(4, 1);
        gk[3] = CAND(4, 2);
        gk[4] = CAND(5, 0);
        gk[5] = CAND(5, 1);
        gk[6] = CAND(6, 0);
        gk[7] = CAND(6, 1);
        gk[8] = CAND(7, 0);
        gk[9] = CAND(7, 1);
        gk[10] = CAND(8, 0);
        gk[11] = CAND(9, 0);
        gk[12] = CAND(10, 0);
        gk[13] = CAND(11, 0);
        gk[14] = CAND(12, 0);
        gk[15] = CAND(13, 0);
        sort16_desc(gk);
        merge16_desc(bk, gk);
    }
    {
        float gk[16];
        gk[0] = CAND(14, 0);
        gk[1] = CAND(15, 0);
        gk[2] = -INFINITY;
        gk[3] = -INFINITY;
        gk[4] = -INFINITY;
        gk[5] = -INFINITY;
        gk[6] = -INFINITY;
        gk[7] = -INFINITY;
        gk[8] = -INFINITY;
        gk[9] = -INFINITY;
        gk[10] = -INFINITY;
        gk[11] = -INFINITY;
        gk[12] = -INFINITY;
        gk[13] = -INFINITY;
        gk[14] = -INFINITY;
        gk[15] = -INFINITY;
        sort16_desc(gk);
        merge16_desc(bk, gk);
    }
#undef CAND
    int bv[16];
#pragma unroll
    for (int i = 0; i < 16; ++i) {
        const unsigned cd = 255u - (__float_as_uint(bk[i]) & 255u), ca = cd >> 4, cb = cd & 15u;
        const unsigned wa = (ca >> 2) == 0u ? P1[0] : (ca >> 2) == 1u ? P1[1] : (ca >> 2) == 2u ? P1[2] : P1[3];
        const unsigned wb = (cb >> 2) == 0u ? P2[0] : (cb >> 2) == 1u ? P2[1] : (cb >> 2) == 2u ? P2[2] : P2[3];
        bv[i] = (int)((((wa >> (8u * (ca & 3u))) & 255u) << 7) | ((wb >> (8u * (cb & 3u))) & 255u));
    }
    float e[16], se = 0.f;
#pragma unroll
    for (int i = 0; i < 16; ++i) { e[i] = __expf(bk[i] - bk[0]); se += e[i]; }
    const float inv = 1.f / se;
    if (hi == 0) {
        uint4* ip = (uint4*)(IDX + (size_t)t * 128 + head * 16); float4* gp = (float4*)(GATE + (size_t)t * 128 + head * 16);
#pragma unroll
        for (int q = 0; q < 2; ++q) ip[q] = make_uint4((unsigned)bv[8 * q] | ((unsigned)bv[8 * q + 1] << 16), (unsigned)bv[8 * q + 2] | ((unsigned)bv[8 * q + 3] << 16), (unsigned)bv[8 * q + 4] | ((unsigned)bv[8 * q + 5] << 16), (unsigned)bv[8 * q + 6] | ((unsigned)bv[8 * q + 7] << 16));
#pragma unroll
        for (int q = 0; q < 4; ++q) gp[q] = make_float4(e[4 * q] * inv, e[4 * q + 1] * inv, e[4 * q + 2] * inv, e[4 * q + 3] * inv);
    }
}

#define XB_TMO      128
#define XB_XCNT(j)  (256  + 64 * (j))
#define XB_XSUB(j)  (1280 + 64 * (j))
#define XB_XGEN(j)  (2304 + 64 * (j))
#define XB_TOP      3328
#define XB_TOPGEN   3392
#define XCD_BAR_WORDS 3456
#define XB_SPIN_CAP (1u << 22)
__device__ __forceinline__ unsigned xb_ld(unsigned* p)              { return __hip_atomic_load(p, __ATOMIC_RELAXED, __HIP_MEMORY_SCOPE_AGENT); }
__device__ __forceinline__ unsigned xb_add(unsigned* p, unsigned v) { return __hip_atomic_fetch_add(p, v, __ATOMIC_RELAXED, __HIP_MEMORY_SCOPE_AGENT); }
__device__ __forceinline__ unsigned xb_xcc_id() { return (unsigned)__builtin_amdgcn_s_getreg((3 << 11) | 20) & 0xFu; }
#define XB_SPIN(cond, bar) do { unsigned _sp = 0; while (cond) { __builtin_amdgcn_s_sleep(1); \
    if ((++_sp & 255u) == 0u) { if (xb_ld(&(bar)[XB_TMO])) break; if (_sp > XB_SPIN_CAP) { atomicAdd(&(bar)[XB_TMO], 1u); break; } } } } while (0)
struct XcdBarrier { unsigned* bar; unsigned x; volatile LAS unsigned* st; };
__device__ __forceinline__ XcdBarrier xcd_barrier_post(unsigned* bar, volatile LAS unsigned* st) {
    XcdBarrier b; b.bar = bar; b.x = xb_xcc_id(); b.st = st;
    if (threadIdx.x == 0) (void)xb_add(&bar[XB_XCNT(b.x)], 1u);
    return b;
}
__device__ __forceinline__ void xcd_barrier_complete(unsigned* bar, unsigned x, unsigned& nloc, unsigned& nx) {
    const unsigned G = gridDim.x * gridDim.y * gridDim.z;
    unsigned sum, cnt, mine, sp = 0u;
    for (;;) {
        sum = 0u; cnt = 0u; mine = 0u;
#pragma unroll
        for (unsigned j = 0; j < 16; ++j) { const unsigned c = xb_ld(&bar[XB_XCNT(j)]); sum += c; cnt += (c > 0u) ? 1u : 0u; mine = (j == x) ? c : mine; }
        if (sum == G) break;
        __builtin_amdgcn_s_sleep(1);
        if ((++sp & 255u) == 0u) { if (xb_ld(&bar[XB_TMO])) break; if (sp > XB_SPIN_CAP) { atomicAdd(&bar[XB_TMO], 1u); break; } }
    }
    nloc = mine > 0u ? mine : 1u; nx = cnt > 0u ? cnt : 1u;
}
__device__ __forceinline__ void xcd_barrier(const XcdBarrier& b) {
    asm volatile("s_waitcnt vmcnt(0)" ::: "memory");
    __syncthreads();
    if (threadIdx.x == 0) {
        unsigned* bar = b.bar;
        __builtin_amdgcn_s_waitcnt(0);
        unsigned nloc = b.st[0], nx = b.st[1];
        if (nloc == 0u) { xcd_barrier_complete(bar, b.x, nloc, nx); b.st[0] = nloc; b.st[1] = nx; }
        const unsigned old = xb_add(&bar[XB_XSUB(b.x)], 1u);
        const unsigned gen = old / nloc;
        if (old + 1u == (gen + 1u) * nloc) {
            __builtin_amdgcn_fence(__ATOMIC_RELEASE, "agent");
            asm volatile("s_waitcnt vmcnt(0)" ::: "memory");
            const unsigned og = xb_add(&bar[XB_TOP], 1u);
            const unsigned tg = og / nx;
            if (og + 1u == (tg + 1u) * nx) xb_add(&bar[XB_TOPGEN], 1u);
            else XB_SPIN(xb_ld(&bar[XB_TOPGEN]) == tg, bar);
            __builtin_amdgcn_fence(__ATOMIC_ACQUIRE, "agent");
            xb_add(&bar[XB_XGEN(b.x)], 1u);
            asm volatile("s_waitcnt vmcnt(0)" ::: "memory");
        } else {
            XB_SPIN(xb_ld(&bar[XB_XGEN(b.x)]) == gen, bar);
            __builtin_amdgcn_fence(__ATOMIC_ACQUIRE, "agent");
            asm volatile("s_waitcnt vmcnt(0)" ::: "memory");
        }
    }
    __syncthreads();
}
constexpr int LDS_BYTES = 147456;
constexpr int MISC_OFF = 131072 + 320;

__global__ void __launch_bounds__(NTHR, 2) k_main(Args a) {
    extern __shared__ __attribute__((aligned(16))) unsigned char lds_raw[];
    LAS unsigned char* ldsb = (LAS unsigned char*)lds_raw;
    const int tid0 = threadIdx.x, bid = blockIdx.x, nb = gridDim.x;
    const int wave = __builtin_amdgcn_readfirstlane(tid0 >> 6);
    const int gthreads = nb * NTHR, nwaves = gthreads >> 6;
#define PHASE_VARS() int tid = tid0; asm volatile("" : "+v"(tid)); const int lane = tid & 63, gtid = bid * NTHR + tid, gwave = gtid >> 6; (void)lane; (void)gtid; (void)gwave
    unsigned char* ws = a.ws;
    bf16* WINT = (bf16*)(ws + WS_WIN); bf16* WOT = (bf16*)(ws + WS_WO); bf16* WQT = (bf16*)(ws + WS_WQ);
    bf16* PROJ = (bf16*)(ws + WS_PROJ);
    bf16* XNB = (bf16*)(ws + WS_XNB);
    bf16* XACT = (bf16*)(ws + WS_XACT);
    float* DTRAW = (float*)(ws + WS_DTRAW); float* DT = (float*)(ws + WS_DT); float* ACS = (float*)(ws + WS_ACS); float* CDEC = (float*)(ws + WS_CDEC);
    float* STATES = (float*)(ws + WS_STATES); bf16* PREVT = (bf16*)(ws + WS_PREV);
    float* QP = (float*)(ws + WS_QP); unsigned short* IDX = (unsigned short*)(ws + WS_IDX); float* GATE = (float*)(ws + WS_GATE);
    float* TOPV = (float*)(ws + WS_TOPV); int* TOPI = (int*)(ws + WS_TOPI);
    unsigned char* U8 = ws + WS_U8; unsigned char* V8 = ws + WS_V8; float* SU = (float*)(ws + WS_SU); float* SV = SU + 16384; int* PART = (int*)(ws + WS_PART); unsigned char* XQ = ws + WS_XQ; float* XS = (float*)(ws + WS_XS);
    bf16* KH = (bf16*)(ws + WS_KH); bf16* KL = (bf16*)(ws + WS_KH + 65536);
    bf16* HB = (bf16*)(ws + WS_STATES);
    float* MIXF = a.out;
    volatile LAS unsigned* MISC = (volatile LAS unsigned*)(ldsb + MISC_OFF);
    if (tid0 < 32) MISC[tid0] = 0u;
    __syncthreads();
    XcdBarrier bar = xcd_barrier_post((unsigned*)ws, MISC + 8);
#define IN(k) (a.ph_lo <= (k) && (k) < a.ph_hi)
#if defined(PROBE_LO)
    int seg_ = 0; unsigned long long tseg_ = __builtin_amdgcn_s_memrealtime();
#define PROBE_SPIN() do { if (seg_ >= PROBE_LO && seg_ <= PROBE_HI) { const unsigned long long d_ = (__builtin_amdgcn_s_memrealtime() - tseg_) * PROBE_AMP; const unsigned long long s_ = __builtin_amdgcn_s_memrealtime(); \
        while (__builtin_amdgcn_s_memrealtime() - s_ < d_) __builtin_amdgcn_s_sleep(4); } } while (0)
#define GRID_BAR() do { PROBE_SPIN(); xcd_barrier(bar); tseg_ = __builtin_amdgcn_s_memrealtime(); ++seg_; } while (0)
#else
#define PROBE_SPIN() do { } while (0)
#define GRID_BAR() xcd_barrier(bar)
#endif

    if (IN(0)) {
        PHASE_VARS();
        LAS float* scr = (LAS float*)(ldsb + wave * 16384);
        constexpr int I_IN = 16 * 72, I_O = 16 * 32, NITEMS = I_IN + 2 * I_O;
        for (int it = gwave; it < NITEMS; it += nwaves) {
            int r = it;
            if (r < I_IN) { transpose_item(a.w_in, PW, D, WINT, scr, r / 72, r % 72, lane); continue; } r -= I_IN;
            if (r < I_O) { transpose_item(a.w_out, D, D, WOT, scr, r / 32, r % 32, lane); continue; } r -= I_O;
            transpose_item(a.peer_wq, D, D, WQT, scr, r / 32, r % 32, lane);
        }
        for (int i = gtid; i < 2 * 128 * 64; i += gthreads) { const float kf = a.peer_sub_keys[i]; const short h = bfs(kf); KH[i] = (bf16)h; KL[i] = (bf16)bfs(kf - sbf2f(h)); }
        for (int i = tid; i < 8 * 1024; i += NTHR) { const int h = i & 7, c = i >> 3; *(LAS float*)(ldsb + h * 16384 + 8448 + c * 4) = a.w_in[(size_t)c * PW + ODT + h]; }
        __syncthreads();
        rmsnorm_rows_bf16<1>(a.x, a.norm_mix_g, XNB, ldsb, DTRAW, nullptr, nullptr, gwave, nwaves, lane);
    }
    GRID_BAR();
    if (IN(1)) {
        PHASE_VARS();
        pg8::Gemm g{XNB, WINT, T, PS, D}; pg8::StaticOrder S; S.init(T, PS, nb, bid);
        pg8::EpiBf16Plain E{PROJ, PS};
        pg8::gemm_phase<pg8::EpiBf16Plain, pg8::StaticOrder>(ldsb, g, S, E, nullptr);
        const int cfirst = (nb == 256) ? 64 : 0;
        if (bid >= cfirst) for (int rr0 = ((bid - cfirst) * 8 + wave) * 4; rr0 < 2 * 16384; rr0 += (nb - cfirst) * 8 * 4) {
            float4 v[4][4];
#pragma unroll
            for (int q = 0; q < 4; ++q) { const int rr = rr0 + q, which = rr >> 14, row = rr & 16383;
                const float4* src4 = (const float4*)((which ? a.peer_v : a.peer_u) + (size_t)row * D) + lane;
#pragma unroll
                for (int jq = 0; jq < 4; ++jq) v[q][jq] = src4[64 * jq]; }
#pragma unroll
            for (int q = 0; q < 4; ++q) { const int rr = rr0 + q, which = rr >> 14, row = rr & 16383;
                float mx = 0.f;
#pragma unroll
                for (int jq = 0; jq < 4; ++jq) mx = fmaxf(mx, fmaxf(fmaxf(fabsf(v[q][jq].x), fabsf(v[q][jq].y)), fmaxf(fabsf(v[q][jq].z), fabsf(v[q][jq].w))));
#pragma unroll
                for (int o = 1; o < 64; o <<= 1) mx = fmaxf(mx, __shfl_xor(mx, o));
                const float sc = mx > 0.f ? mx * (1.f / 127.f) : 1.f, inv = 1.f / sc;
                unsigned* dst = (unsigned*)((which ? V8 : U8) + (size_t)row * D) + lane;
#pragma unroll
                for (int jq = 0; jq < 4; ++jq) { const int q0 = (int)rintf(v[q][jq].x * inv), q1 = (int)rintf(v[q][jq].y * inv), q2 = (int)rintf(v[q][jq].z * inv), q3 = (int)rintf(v[q][jq].w * inv);
                    dst[64 * jq] = (unsigned)(q0 & 255) | ((unsigned)(q1 & 255) << 8) | ((unsigned)(q2 & 255) << 16) | ((unsigned)(q3 & 255) << 24); }
                if (lane == 0) (which ? SV : SU)[row] = sc; }
        }
    }
    GRID_BAR();
    if (IN(3)) {
        PHASE_VARS();
        for (int u = bid; u < 512; u += nb) {
            if (u < 256) attn_unit(a.attn_sinks, a.attn_out_g, ldsb, u, PROJ, XNB, tid, lane, wave);
            else ssd_chunk_unit(ldsb, u - 256, PROJ, XACT, DTRAW, a.conv_w, a.conv_b, a.dt_bias, a.a_log, ACS, CDEC, MIXF, STATES, tid, lane, wave);
        }
    }
    GRID_BAR();
    if (IN(5)) {
        PHASE_VARS();
        for (int idx = gtid; idx < 2 * 8 * 8192; idx += gthreads) {
            const int pn = idx & 8191, h = (idx >> 13) & 7, b = idx >> 16;
            float run = 0.f;
#pragma unroll 1
            for (int c0 = 0; c0 < 64; c0 += 8) {
                float st[8], dc[8];
#pragma unroll
                for (int j = 0; j < 8; ++j) { const int bch = (b * 64 + c0 + j) * 8 + h; st[j] = STATES[(size_t)bch * 8192 + pn]; dc[j] = CDEC[bch]; }
#pragma unroll
                for (int j = 0; j < 8; ++j) { const int bch = (b * 64 + c0 + j) * 8 + h; PREVT[(size_t)bch * 8192 + pn] = f2bf(run); run = dc[j] * run + st[j]; }
            }
        }
    }
    GRID_BAR();
    if (IN(6)) {
        PHASE_VARS();
        for (int u = bid; u < 256; u += nb) yoff_unit(a.d_skip, a.ssm_norm_g, ldsb, u, XACT, PROJ, ACS, PREVT, MIXF, XNB, lane, wave);
    }
    GRID_BAR();
    if (IN(7)) {
        PHASE_VARS();
        pg8::Gemm g{XNB, WOT, T, D, D}; pg8::StaticOrder S; S.init(T, D, nb, bid);
        pg8::EpiBf16Resid E{HB, a.x, D};
        pg8::gemm_phase<pg8::EpiBf16Resid, pg8::StaticOrder>(ldsb, g, S, E, nullptr);
    }
    GRID_BAR();
    if (IN(8)) {
        PHASE_VARS();
        rmsnorm_rows_bf16<2>((const float*)HB, a.norm_ffn_g, XNB, ldsb, nullptr, XQ, XS, gwave, nwaves, lane);
    }
    GRID_BAR();
    if (IN(9)) {
        PHASE_VARS();
        pg8::Gemm g{XNB, WQT, T, D, D}; pg8::StaticOrder S; S.init(T, D, nb, bid);
        pg8::EpiF32Resid E{QP, nullptr, D};
        pg8::gemm_phase<pg8::EpiF32Resid, pg8::StaticOrder>(ldsb, g, S, E, nullptr);
    }
    GRID_BAR();
    if (IN(10)) {
        PHASE_VARS();
        for (int task = gwave; task < T / 4; task += nwaves) route_task(task, QP, KH, KL, IDX, GATE, lane);
    }
    GRID_BAR();
    unsigned char* ACTQ = ws + WS_ACT; float* ACTS = (float*)(ws + WS_ACT + 4 * MiB); bf16* PEERO = (bf16*)(ws + WS_PEERO);
    unsigned* ctl = (unsigned*)ws;
    const int xcc = (int)(bar.x & 7u);
    if (IN(12)) {
        PHASE_VARS();
#pragma unroll 1
        for (int pi = 0; pi < NPART; ++pi) {
            const int p = (xcc + pi) & 7;
            for (;;) {
                if (tid == 0) MISC[16] = xb_add(&ctl[CW_QU + 64 * p], 1u);
                __syncthreads();
                const int j = (int)MISC[16];
                __syncthreads();
                if (j >= NCHUNK) break;
                peer_u_item(p, j, IDX, XQ, U8, PART, lane, wave);
            }
        }
    }
    GRID_BAR();
    if (IN(12)) {
        PHASE_VARS();
        for (int t = gwave; t < T; t += nwaves) {
            float av[2];
#pragma unroll
            for (int hh = 0; hh < 2; ++hh) {
                const int i = t * 128 + hh * 64 + lane;
                int si = 0;
#pragma unroll
                for (int pp = 0; pp < NPART; ++pp) si += PART[(size_t)pp * T * 128 + i];
                const int e = IDX[i]; const float z = (float)si * SU[e] * XS[t];
                av[hh] = GATE[i] * 0.5f * z * (1.f + erff(z * 0.70710678118654752f)) * SV[e];
            }
            float mx = fmaxf(fabsf(av[0]), fabsf(av[1]));
#pragma unroll
            for (int o = 1; o < 64; o <<= 1) mx = fmaxf(mx, __shfl_xor(mx, o));
            const float sc = mx > 0.f ? mx * (1.f / 127.f) : 1.f, inv = 1.f / sc;
            ACTQ[(size_t)t * 128 + lane] = (unsigned char)((int)rintf(av[0] * inv) & 255); ACTQ[(size_t)t * 128 + 64 + lane] = (unsigned char)((int)rintf(av[1] * inv) & 255);
            if (lane == 0) ACTS[t] = sc;
        }
    }
    GRID_BAR();
    if (IN(13)) {
        PHASE_VARS();
#pragma unroll 1
        for (int pi = 0; pi < NPART; ++pi) {
            const int p = (xcc + pi) & 7;
            for (;;) {
                if (tid == 0) MISC[16] = xb_add(&ctl[CW_QV + 64 * p], 1u);
                __syncthreads();
                const int j = (int)MISC[16];
                __syncthreads();
                if (j >= NCHUNK) break;
                peer_v_item(p, j, IDX, ACTQ, ACTS, V8, PEERO, lane, wave);
            }
        }
    }
    GRID_BAR();
    if (IN(14)) {
        PHASE_VARS();
        for (int t = gwave; t < T; t += nwaves) {
            const uint2* hr = (const uint2*)(HB + (size_t)t * D) + lane; const uint2* pr = (const uint2*)(PEERO + (size_t)t * D) + lane;
            float4 v[4]; float ss = 0.f;
#pragma unroll
            for (int jq = 0; jq < 4; ++jq) { const uint2 hw = hr[64 * jq]; const float4 h4 = make_float4(__uint_as_float(hw.x << 16), __uint_as_float(hw.x & 0xffff0000u), __uint_as_float(hw.y << 16), __uint_as_float(hw.y & 0xffff0000u)); const uint2 pw = pr[64 * jq]; v[jq] = make_float4(h4.x + __uint_as_float(pw.x << 16), h4.y + __uint_as_float(pw.x & 0xffff0000u), h4.z + __uint_as_float(pw.y << 16), h4.w + __uint_as_float(pw.y & 0xffff0000u)); ss += v[jq].x * v[jq].x + v[jq].y * v[jq].y + v[jq].z * v[jq].z + v[jq].w * v[jq].w; }
            ss = wave_sum(ss);
            const float r3 = rsqrtf(ss * (1.f / D) + EPS);
            float4* op = (float4*)(a.out + (size_t)t * D) + lane;
#pragma unroll
            for (int jq = 0; jq < 4; ++jq) { const float4 gv = ((const float4*)a.final_norm_g)[lane + 64 * jq]; op[64 * jq] = make_float4(v[jq].x * r3 * gv.x, v[jq].y * r3 * gv.y, v[jq].z * r3 * gv.z, v[jq].w * r3 * gv.w); }
        }
    }
    PROBE_SPIN();
#undef IN
}
}

extern "C" void kernel_launch(void* const* d_in, const int* in_sizes, int n_in, void* d_out, int out_size, void* d_ws, size_t ws_size, hipStream_t stream) {
    if (n_in != 18 || out_size != T * D || ws_size < WS_END) { fprintf(stderr, "kernel_launch: unexpected shapes n_in=%d out=%d ws=%zu\n", n_in, out_size, ws_size); return; }
    Args a{};
    const float** ap = (const float**)&a;
    for (int i = 0; i < 18; ++i) ap[i] = (const float*)d_in[i];
    a.out = (float*)d_out; a.ws = (unsigned char*)d_ws;
    static int grid = 0;
    if (grid == 0) {
        int dev = 0, cus = 0, per_cu = 0;
        if (hipGetDevice(&dev) != hipSuccess || hipDeviceGetAttribute(&cus, hipDeviceAttributeMultiprocessorCount, dev) != hipSuccess) { fprintf(stderr, "kernel_launch: device query failed\n"); grid = -1; return; }
        if (hipFuncSetAttribute((const void*)k_main, hipFuncAttributeMaxDynamicSharedMemorySize, LDS_BYTES) != hipSuccess) { fprintf(stderr, "kernel_launch: hipFuncSetAttribute failed\n"); grid = -1; return; }
        if (hipOccupancyMaxActiveBlocksPerMultiprocessor(&per_cu, (const void*)k_main, NTHR, LDS_BYTES) != hipSuccess || per_cu < 1) { fprintf(stderr, "kernel_launch: occupancy query says %d blocks/CU\n", per_cu); (void)hipGetLastError(); grid = -1; return; }
        grid = cus;
    }
    if (grid < 0) return;
    if (hipMemsetAsync(d_ws, 0, 65536, stream) != hipSuccess) { fprintf(stderr, "kernel_launch: memset failed\n"); return; }
    a.ph_lo = 0; a.ph_hi = 15;
    hipLaunchKernelGGL(k_main, dim3(grid), dim3(NTHR), LDS_BYTES, stream, a);
}
```

```cpp
#include <hip/hip_runtime.h>
#include <cstdio>
#include <cstdint>


namespace pg8 {
#define PG8_LAS __attribute__((address_space(3)))
typedef unsigned short bf16_t;
typedef short bf16x8 __attribute__((ext_vector_type(8)));
typedef float f32x4 __attribute__((ext_vector_type(4)));
typedef unsigned u32x4 __attribute__((ext_vector_type(4)));
constexpr int BM = 256, BK = 64, HALF = 128, HTB = HALF * BK * 2  , STAGE_BYTES = 8 * HTB, NXCD = 8, WGM = 8;

__host__ __device__ __forceinline__ int lds_byte(int r, int c) { const int st = (r >> 4) * 2 + (c >> 5), rr = r & 15, cc = c & 31, ob = rr * 64 + cc * 2; return st * 1024 + (ob ^ (((ob >> 9) & 1) << 5)); }
__host__ __device__ __forceinline__ void stage_rc(int b, int& R, int& C) { const int st = b / 1024, sb = b % 1024, swz = sb ^ (((sb >> 9) & 1) << 5); R = (st >> 1) * 16 + swz / 64; C = (st & 1) * 32 + (swz % 64) / 2; }
__host__ __device__ __forceinline__ int perm32(int rho) { const int n = rho >> 4, i = rho & 15; return 8 * (i >> 2) + 4 * n + (i & 3); }

struct Unit { int pm, pn; };
struct Gemm { const bf16_t* A; const bf16_t* Bt; int M, N, K; };

struct StaticOrder {
    int nM, nN, nwg, G, c;
    __host__ __device__ void init(int M, int N, int G_, int c_) { nM = M / BM; nN = N / BM; nwg = nM * nN; G = G_; c = c_; }
    __host__ __device__ bool next(int i, Unit& u) const {
        const long L = (long)i * G + c; if (L >= nwg) return false;
        int wgid = (int)L; { const int q = nwg / NXCD, r = nwg % NXCD, xcd = wgid % NXCD, off = wgid / NXCD; wgid = (xcd < r ? xcd * (q + 1) : r * (q + 1) + (xcd - r) * q) + off; }
        const int nig = WGM * nN, gid = wgid / nig, fm = gid * WGM, gsz = (nM - fm) < WGM ? (nM - fm) : WGM;
        u.pm = fm + ((wgid % nig) % gsz); u.pn = (wgid % nig) / gsz; return true;
    }
    __device__ __forceinline__ void a_ready(const Unit&) const {}
    __device__ __forceinline__ void done(const Unit&) const {}
};
__device__ __forceinline__ unsigned cvt_pk_bf16(float lo, float hi) { unsigned r; asm volatile("v_cvt_pk_bf16_f32 %0, %1, %2" : "=v"(r) : "v"(lo), "v"(hi)); return r; }
typedef float f32x2 __attribute__((ext_vector_type(2)));
struct EpiBf16Plain {
    static constexpr bool PERM = true, AFTER_DRAIN = false;
    bf16_t* O; int ldc;
    __device__ __forceinline__ void operator()(const f32x4 (&acc)[2][2][4][2], const Unit& u, int wr, int wc, int fr, int fq) const {
        const int row0 = u.pm * BM + wr * 64 + fr, col0 = u.pn * BM + wc * 32 + 8 * fq;
#pragma unroll
        for (int ai = 0; ai < 2; ++ai)
#pragma unroll
            for (int m = 0; m < 4; ++m) { bf16_t* rowp = O + (size_t)(row0 + ai * HALF + m * 16) * ldc + col0;
#pragma unroll
                for (int bj = 0; bj < 2; ++bj) { const f32x4 v0 = acc[ai][bj][m][0], v1 = acc[ai][bj][m][1];
                    u32x4 w; w.x = cvt_pk_bf16(v0[0], v0[1]); w.y = cvt_pk_bf16(v0[2], v0[3]); w.z = cvt_pk_bf16(v1[0], v1[1]); w.w = cvt_pk_bf16(v1[2], v1[3]);
                    *(u32x4*)(rowp + bj * HALF) = w; } }
    }
};
struct EpiF32Resid {
    static constexpr bool PERM = false, AFTER_DRAIN = false;
    float* C; const float* R; int ldc;
    __device__ __forceinline__ void operator()(const f32x4 (&acc)[2][2][4][2], const Unit& u, int wr, int wc, int fr, int fq) const {
        const int row0 = u.pm * BM + wr * 64 + fr, col0 = u.pn * BM + wc * 32 + 4 * fq;
#pragma unroll
        for (int ai = 0; ai < 2; ++ai)
#pragma unroll
            for (int m = 0; m < 4; ++m) { const size_t off = (size_t)(row0 + ai * HALF + m * 16) * ldc + col0;
#pragma unroll
                for (int bj = 0; bj < 2; ++bj)
#pragma unroll
                    for (int n = 0; n < 2; ++n) { f32x4 v = acc[ai][bj][m][n]; if (R) v += *(const f32x4*)(R + off + bj * HALF + n * 16); *(f32x4*)(C + off + bj * HALF + n * 16) = v; }
                asm volatile("" ::: "memory"); }
    }
};

struct EpiBf16Resid {
    static constexpr bool PERM = true, AFTER_DRAIN = false;
    bf16_t* O; const float* R; int ldc;
    __device__ __forceinline__ void operator()(const f32x4 (&acc)[2][2][4][2], const Unit& u, int wr, int wc, int fr, int fq) const {
        const int row0 = u.pm * BM + wr * 64 + fr, col0 = u.pn * BM + wc * 32 + 8 * fq;
#pragma unroll
        for (int ai = 0; ai < 2; ++ai)
#pragma unroll
            for (int m = 0; m < 4; ++m) { const size_t off = (size_t)(row0 + ai * HALF + m * 16) * ldc + col0;
#pragma unroll
                for (int bj = 0; bj < 2; ++bj) { const f32x4 v0 = acc[ai][bj][m][0] + *(const f32x4*)(R + off + bj * HALF), v1 = acc[ai][bj][m][1] + *(const f32x4*)(R + off + bj * HALF + 4);
                    u32x4 w; w.x = cvt_pk_bf16(v0[0], v0[1]); w.y = cvt_pk_bf16(v0[2], v0[3]); w.z = cvt_pk_bf16(v1[0], v1[1]); w.w = cvt_pk_bf16(v1[2], v1[3]);
                    *(u32x4*)(O + off + bj * HALF) = w; }
                asm volatile("" ::: "memory"); }
    }
};
template <class Epi, class Sched, bool STAMP = false>
__device__ __forceinline__ void gemm_phase(PG8_LAS unsigned char* lds, const Gemm g, const Sched& S, const Epi& E, unsigned long long* stamps) {
    const int tid = threadIdx.x, wid = __builtin_amdgcn_readfirstlane(tid >> 6), lane = tid & 63, wr = wid >> 2, wc = wid & 3, fr = lane & 15, fq = lane >> 4;
    const int K = g.K, nt = K / BK;
    int ts_lo = 0, ts_hi = 0, nts = 0; const unsigned long long rt_entry = STAMP ? (unsigned long long)0ull : 0ull;
#define PG8_STAMP() do { if (STAMP && wid == 0 && nts < 64) { const unsigned long long _c = (unsigned long long)clock64(); \
        ts_lo = (lane == nts) ? (int)(unsigned)_c : ts_lo; ts_hi = (lane == nts) ? (int)(unsigned)(_c >> 32) : ts_hi; ++nts; } } while (0)
    PG8_STAMP();
    unsigned voffA[2], voffB[2];
#pragma unroll
    for (int i = 0; i < 2; ++i) { int R, C; stage_rc(tid * 16 + i * 8192, R, C); const int Rb = Epi::PERM ? ((R & ~31) + perm32(R & 31)) : R;
        voffA[i] = (unsigned)(R * K + C) * 2u; voffB[i] = (unsigned)(Rb * K + C) * 2u; }
    const size_t kstep = (size_t)(BK * 2);
    const size_t hstep = (size_t)HALF * K * 2;
    const size_t tstep = 2 * hstep;
    const unsigned ldsw = (unsigned)wid * 1024u;
    const int aoff = lds_byte(wr * 64 + fr, fq * 8), boff = lds_byte(wc * 32 + fr, fq * 8);
#define PG8_SA(b, h) (((b) * 2 + (h)) * HTB)
#define PG8_SB(b, h) ((4 + (b) * 2 + (h)) * HTB)
#define PG8_STAGE(bufoff, gbase, voff) do { _Pragma("unroll") for (int _i = 0; _i < 2; ++_i) \
        __builtin_amdgcn_global_load_lds((const unsigned*)((const char*)(gbase) + (voff)[_i]), (PG8_LAS unsigned*)(lds + (bufoff) + ldsw + _i * 8192), 16, 0, 0); } while (0)
#define PG8_LDA(dst, b, h) do { _Pragma("unroll") for (int m = 0; m < 4; ++m) _Pragma("unroll") for (int k = 0; k < 2; ++k) dst[m][k] = *(const PG8_LAS bf16x8*)(lds + PG8_SA(b, h) + aoff + m * 2048 + k * 1024); } while (0)
#define PG8_LDB(dst, b, h) do { _Pragma("unroll") for (int n = 0; n < 2; ++n) _Pragma("unroll") for (int k = 0; k < 2; ++k) dst[n][k] = *(const PG8_LAS bf16x8*)(lds + PG8_SB(b, h) + boff + n * 2048 + k * 1024); } while (0)
#define PG8_MMA(ai, bj, At, Bt) do { __builtin_amdgcn_s_setprio(1); _Pragma("unroll") for (int m = 0; m < 4; ++m) _Pragma("unroll") for (int n = 0; n < 2; ++n) _Pragma("unroll") for (int k = 0; k < 2; ++k) \
        acc[ai][bj][m][n] = __builtin_amdgcn_mfma_f32_16x16x32_bf16(Bt[n][k], At[m][k], acc[ai][bj][m][n], 0, 0, 0); __builtin_amdgcn_s_setprio(0); } while (0)
#define PG8_WAIT_V(n) asm volatile("s_waitcnt vmcnt(" #n ")" ::: "memory")
#define PG8_WAIT_L(n) asm volatile("s_waitcnt lgkmcnt(" #n ")" ::: "memory")
#define PG8_BAR __builtin_amdgcn_s_barrier()
#define PG8_SCHED __builtin_amdgcn_sched_barrier(0)
    Unit cur, nxt; int ui = 0;
    if (!S.next(0, cur)) return;
    f32x4 acc[2][2][4][2];
#pragma unroll
    for (int a = 0; a < 2; ++a)
#pragma unroll
        for (int b = 0; b < 2; ++b)
#pragma unroll
            for (int m = 0; m < 4; ++m)
#pragma unroll
                for (int n = 0; n < 2; ++n) acc[a][b][m][n] = (f32x4){0.f, 0.f, 0.f, 0.f};
    bf16x8 At[4][2], B0[2][2], B1[2][2];
    const char* cA = (const char*)g.A + (size_t)cur.pm * tstep; const char* cB = (const char*)g.Bt + (size_t)cur.pn * tstep;
    S.a_ready(cur);
    PG8_STAGE(PG8_SB(0, 0), cB, voffB); PG8_STAGE(PG8_SA(0, 0), cA, voffA); PG8_STAGE(PG8_SB(0, 1), cB + hstep, voffB); PG8_STAGE(PG8_SA(0, 1), cA + hstep, voffA);
    if (wr == 1) PG8_BAR;
    PG8_WAIT_V(4); PG8_BAR;
    PG8_STAGE(PG8_SB(1, 0), cB + kstep, voffB); PG8_STAGE(PG8_SA(1, 0), cA + kstep, voffA); PG8_STAGE(PG8_SB(1, 1), cB + hstep + kstep, voffB);
    PG8_WAIT_V(6); PG8_BAR;
    PG8_STAMP();
    for (;;) {
        const bool has_next = S.next(ui + 1, nxt);
        const char* nA = has_next ? (const char*)g.A + (size_t)nxt.pm * tstep : cA; const char* nB = has_next ? (const char*)g.Bt + (size_t)nxt.pn * tstep : cB;
        for (int t = 0; t < nt; t += 2) {
            const bool last = (t == nt - 2);
            const char* a1 = cA + (size_t)(t + 1) * kstep;
            const char* a2 = last ? nA : cA + (size_t)(t + 2) * kstep; const char* b2 = last ? nB : cB + (size_t)(t + 2) * kstep;
            const char* a3 = a2 + kstep; const char* b3 = b2 + kstep;
            if (last && has_next) S.a_ready(nxt);
            PG8_LDB(B0, 0, 0); PG8_SCHED; PG8_LDA(At, 0, 0); PG8_STAGE(PG8_SA(1, 1), a1 + hstep, voffA);
            PG8_WAIT_L(8); PG8_BAR; PG8_WAIT_L(0); PG8_MMA(0, 0, At, B0); PG8_BAR; PG8_SCHED;
            PG8_LDB(B1, 0, 1); PG8_STAGE(PG8_SB(0, 0), b2, voffB);
            PG8_BAR; PG8_WAIT_L(0); PG8_MMA(0, 1, At, B1); PG8_BAR;
            PG8_LDA(At, 0, 1); PG8_STAGE(PG8_SA(0, 0), a2, voffA);
            PG8_BAR; PG8_WAIT_L(0); PG8_MMA(1, 0, At, B0); PG8_BAR; PG8_SCHED;
            PG8_STAGE(PG8_SB(0, 1), b2 + hstep, voffB);
            PG8_WAIT_V(6); PG8_BAR; PG8_MMA(1, 1, At, B1); PG8_BAR;
            PG8_LDB(B0, 1, 0); PG8_SCHED; PG8_LDA(At, 1, 0); PG8_STAGE(PG8_SA(0, 1), a2 + hstep, voffA);
            PG8_WAIT_L(8); PG8_BAR; PG8_WAIT_L(0); PG8_MMA(0, 0, At, B0); PG8_BAR; PG8_SCHED;
            PG8_LDB(B1, 1, 1); PG8_STAGE(PG8_SB(1, 0), b3, voffB);
            PG8_BAR; PG8_WAIT_L(0); PG8_MMA(0, 1, At, B1); PG8_BAR;
            PG8_LDA(At, 1, 1); PG8_STAGE(PG8_SA(1, 0), a3, voffA);
            PG8_BAR; PG8_WAIT_L(0); PG8_MMA(1, 0, At, B0); PG8_BAR; PG8_SCHED;
            PG8_STAGE(PG8_SB(1, 1), b3 + hstep, voffB);
            PG8_WAIT_V(6); PG8_BAR; PG8_MMA(1, 1, At, B1); PG8_BAR;
        }
        PG8_STAMP();
        if constexpr (!Epi::AFTER_DRAIN) { E(acc, cur, wr, wc, fr, fq); S.done(cur); }
        PG8_STAMP();
        if (!has_next) break;
#pragma unroll
        for (int a = 0; a < 2; ++a)
#pragma unroll
            for (int b = 0; b < 2; ++b)
#pragma unroll
                for (int m = 0; m < 4; ++m)
#pragma unroll
                    for (int n = 0; n < 2; ++n) acc[a][b][m][n] = (f32x4){0.f, 0.f, 0.f, 0.f};
        cur = nxt; cA = nA; cB = nB; ++ui;
    }
    PG8_WAIT_V(0);
    if (wr == 0) PG8_BAR;
    PG8_BAR;
    if constexpr (Epi::AFTER_DRAIN) { E.fused(acc, cur, wr, wc, fr, fq, lds, wid, lane); S.done(cur); }
    PG8_STAMP();
    if (STAMP && wid == 0) { stamps[lane] = lane < nts ? (((unsigned long long)(unsigned)ts_hi << 32) | (unsigned)ts_lo) : 0ull;
        if (lane == 62) stamps[62] = rt_entry; if (lane == 63) stamps[63] = (unsigned long long)0ull; }
#undef PG8_STAMP
#undef PG8_SA
#undef PG8_SB
#undef PG8_STAGE
#undef PG8_LDA
#undef PG8_LDB
#undef PG8_MMA
#undef PG8_WAIT_V
#undef PG8_WAIT_L
#undef PG8_BAR
#undef PG8_SCHED
}
}

namespace {
constexpr int D = 1024, BATCH = 2, SEQ = 8192, T = BATCH * SEQ;
constexpr int PW = 2312;
constexpr int PS = 2304;
constexpr int OQ = 0, OKK = 512, OV = 640, OZ = 768, OXBC = 1280, ODT = 2304;
constexpr float EPS = 1e-6f;
constexpr int NTHR = 512;
typedef unsigned short bf16;
typedef unsigned v4u __attribute__((ext_vector_type(4)));

constexpr size_t MiB = 1u << 20;
constexpr size_t WS_WIN = 1 * MiB;
constexpr size_t WS_KH = 5 * MiB + 512 * 1024;
constexpr size_t WS_WO = 6 * MiB;
constexpr size_t WS_WQ = 8 * MiB;
constexpr size_t WS_PROJ = 10 * MiB;
constexpr size_t WS_XNB = 82 * MiB;
constexpr size_t WS_XACT = 114 * MiB;
constexpr size_t WS_DTRAW = 146 * MiB;
constexpr size_t WS_DT = WS_DTRAW + 512 * 1024;
constexpr size_t WS_ACS = WS_DT + 512 * 1024;
constexpr size_t WS_CDEC = WS_ACS + 512 * 1024;
constexpr size_t WS_STATES = 164 * MiB;
constexpr size_t WS_PREV = 196 * MiB;
constexpr size_t WS_QP = 10 * MiB;
constexpr size_t WS_IDX = 74 * MiB;
constexpr size_t WS_GATE = 114 * MiB;
constexpr size_t WS_TOPV = 122 * MiB;
constexpr size_t WS_TOPI = 138 * MiB;
constexpr size_t WS_ACT = 122 * MiB;
constexpr size_t WS_SU = 245 * MiB;
constexpr size_t WS_U8 = 212 * MiB;
constexpr size_t WS_V8 = 148 * MiB;
constexpr size_t WS_PART = 10 * MiB;
constexpr size_t WS_XQ = 228 * MiB;
constexpr size_t WS_XS = 244 * MiB;
constexpr size_t WS_PEERO = 10 * MiB;
constexpr size_t WS_END = 246 * MiB;
constexpr int CW_QU = 4096, CW_QV = 4096 + 64 * 16;
constexpr int NPART = 8, NCHUNK = T / 64;

struct Args {
    const float* x; const float* norm_mix_g; const float* w_in; const float* attn_sinks; const float* attn_out_g;
    const float* conv_w; const float* conv_b; const float* dt_bias; const float* a_log; const float* d_skip;
    const float* ssm_norm_g; const float* w_out; const float* norm_ffn_g; const float* peer_wq; const float* peer_sub_keys;
    const float* peer_u; const float* peer_v; const float* final_norm_g;
    float* out; unsigned char* ws;
    int ph_lo, ph_hi;
};

#define LAS __attribute__((address_space(3)))
#define LDS_WAIT() asm volatile("s_waitcnt lgkmcnt(0)" ::: "memory")
__device__ __forceinline__ float bf2f(bf16 v) { return __uint_as_float(((unsigned)v) << 16); }
__device__ __forceinline__ unsigned f2bfu(float f) { unsigned u = __float_as_uint(f); return (u + 0x7fffu + ((u >> 16) & 1u)) >> 16; }
__device__ __forceinline__ bf16 f2bf(float f) { return (bf16)f2bfu(f); }
__device__ __forceinline__ unsigned pk2(float lo, float hi) { return f2bfu(lo) | (f2bfu(hi) << 16); }
__device__ __forceinline__ float wave_sum(float v) {
#pragma unroll
    for (int o = 1; o < 64; o <<= 1) v += __shfl_xor(v, o);
    return v;
}
__device__ __forceinline__ float silu_f(float v) { return v / (1.f + __expf(-v)); }

__device__ __forceinline__ void transpose_item(const float* W, int ldw, int K, bf16* WT, LAS float* scr, int kb, int nbk, int lane) {
    const int k0 = 64 * kb, n0 = 32 * nbk;
#pragma unroll 8
    for (int i = 0; i < 32; ++i) { const int kk = 2 * i + (lane >> 5); scr[kk * 33 + (lane & 31)] = W[(size_t)(k0 + kk) * ldw + n0 + (lane & 31)]; }
    LDS_WAIT();
    const int c = lane & 7;
#pragma unroll
    for (int j = 0; j < 4; ++j) { const int n = (lane >> 3) + 8 * j; const LAS float* s = scr + (8 * c) * 33 + n;
        v4u o; o.x = pk2(s[0 * 33], s[1 * 33]); o.y = pk2(s[2 * 33], s[3 * 33]); o.z = pk2(s[4 * 33], s[5 * 33]); o.w = pk2(s[6 * 33], s[7 * 33]);
        *(v4u*)(WT + (size_t)(n0 + n) * K + k0 + 8 * c) = o; }
    LDS_WAIT();
}

template <int MODE  >
__device__ __forceinline__ void rmsnorm_rows_bf16(const float* in, const float* g, bf16* outp, const LAS unsigned char* ldsb, float* dtraw, unsigned char* xq, float* xs, int gwave, int nwaves, int lane) {
    for (int row = gwave; row < T; row += nwaves) {
        const float4* xr = (const float4*)(in + (size_t)row * D) + lane; const uint2* xb = (const uint2*)((const bf16*)in + (size_t)row * D) + lane;
        float4 v[4]; float ss = 0.f;
#pragma unroll
        for (int j = 0; j < 4; ++j) {
            if (MODE == 2) { const uint2 w = xb[64 * j]; v[j] = make_float4(__uint_as_float(w.x << 16), __uint_as_float(w.x & 0xffff0000u), __uint_as_float(w.y << 16), __uint_as_float(w.y & 0xffff0000u)); }
            else v[j] = xr[64 * j];
            ss += v[j].x * v[j].x + v[j].y * v[j].y + v[j].z * v[j].z + v[j].w * v[j].w; }
        ss = wave_sum(ss);
        const float r = rsqrtf(ss * (1.f / D) + EPS);
        unsigned long long* o8 = (unsigned long long*)(outp + (size_t)row * D) + lane;
        float dacc[8]; float y[4][4]; float mx = 0.f;
#pragma unroll
        for (int h = 0; h < 8; ++h) dacc[h] = 0.f;
#pragma unroll
        for (int j = 0; j < 4; ++j) {
            const float4 gv = ((const float4*)g)[lane + 64 * j];
            y[j][0] = v[j].x * r * gv.x; y[j][1] = v[j].y * r * gv.y; y[j][2] = v[j].z * r * gv.z; y[j][3] = v[j].w * r * gv.w;
            o8[64 * j] = (unsigned long long)pk2(y[j][0], y[j][1]) | ((unsigned long long)pk2(y[j][2], y[j][3]) << 32);
            if (MODE == 2) mx = fmaxf(mx, fmaxf(fmaxf(fabsf(y[j][0]), fabsf(y[j][1])), fmaxf(fabsf(y[j][2]), fabsf(y[j][3]))));
            if (MODE == 1) {
#pragma unroll
                for (int h = 0; h < 8; ++h) {
                    typedef float f4v __attribute__((ext_vector_type(4)));
                    const f4v wv = *(const LAS f4v*)(ldsb + h * 16384 + 8448 + (256 * j + 4 * lane) * 4);
                    dacc[h] += y[j][0] * wv.x + y[j][1] * wv.y + y[j][2] * wv.z + y[j][3] * wv.w;
                }
            }
        }
        if (MODE == 1) {
#pragma unroll
            for (int h = 0; h < 8; ++h) dacc[h] = wave_sum(dacc[h]);
            if (lane == 0) { float4* dp = (float4*)(dtraw + (size_t)row * 8); dp[0] = make_float4(dacc[0], dacc[1], dacc[2], dacc[3]); dp[1] = make_float4(dacc[4], dacc[5], dacc[6], dacc[7]); }
        }
        if (MODE == 2) {
#pragma unroll
            for (int o = 1; o < 64; o <<= 1) mx = fmaxf(mx, __shfl_xor(mx, o));
            const float sc = mx > 0.f ? mx * (1.f / 127.f) : 1.f, inv = 1.f / sc;
            unsigned* dq = (unsigned*)(xq + (size_t)row * D) + lane;
#pragma unroll
            for (int j = 0; j < 4; ++j) { const int q0 = (int)rintf(y[j][0] * inv), q1 = (int)rintf(y[j][1] * inv), q2 = (int)rintf(y[j][2] * inv), q3 = (int)rintf(y[j][3] * inv);
                dq[64 * j] = (unsigned)(q0 & 255) | ((unsigned)(q1 & 255) << 8) | ((unsigned)(q2 & 255) << 16) | ((unsigned)(q3 & 255) << 24); }
            if (lane == 0) xs[row] = sc;
        }
    }
}

typedef short bf16x8 __attribute__((ext_vector_type(8)));
typedef short bf16x4 __attribute__((ext_vector_type(4)));
typedef float f32x16 __attribute__((ext_vector_type(16)));
typedef __bf16 bf2_t __attribute__((ext_vector_type(2)));
#define MFMA32(a, b, c) __builtin_amdgcn_mfma_f32_32x32x16_bf16((a), (b), (c), 0, 0, 0)
__device__ __forceinline__ unsigned pkbf(float lo, float hi) { bf2_t v = {(__bf16)lo, (__bf16)hi}; return __builtin_bit_cast(unsigned, v); }
__device__ __forceinline__ short bfs(float f) { return __builtin_bit_cast(short, (__bf16)f); }
__device__ __forceinline__ float sbf2f(short v) { return __uint_as_float(((unsigned)(unsigned short)v) << 16); }
__device__ __forceinline__ int crow(int i, int hi) { return (i & 3) + 8 * (i >> 2) + 4 * hi; }
template <int S> __device__ __forceinline__ bf16x8 pack8(const f32x16& x) {
    v4u p; p.x = pkbf(x[8 * S], x[8 * S + 1]); p.y = pkbf(x[8 * S + 2], x[8 * S + 3]); p.z = pkbf(x[8 * S + 4], x[8 * S + 5]); p.w = pkbf(x[8 * S + 6], x[8 * S + 7]);
    return __builtin_bit_cast(bf16x8, p);
}
__device__ __forceinline__ bf16x8 ldg8(const bf16* p) { return *(const bf16x8*)p; }
__device__ __forceinline__ bf16x8 lds8(const LAS bf16* p) { return *(const LAS bf16x8*)p; }
__device__ __forceinline__ bf16x8 lds4x2(const LAS bf16* p) { const bf16x4 a = *(const LAS bf16x4*)p, b = *(const LAS bf16x4*)(p + 8); return __builtin_shufflevector(a, b, 0, 1, 2, 3, 4, 5, 6, 7); }
__device__ __forceinline__ f32x16 zero16() { f32x16 z;
#pragma unroll
    for (int i = 0; i < 16; ++i) z[i] = 0.f;
    return z; }

__device__ __forceinline__ void attn_unit(const float* sinks, const float* gnorm, LAS unsigned char* ldsb, int unit, const bf16* PROJ, bf16* MIXB, int tid, int lane, int wave) {
    asm volatile("" : "+v"(tid), "+v"(lane));
    const int tok0 = unit * 64, s0 = tok0 & (SEQ - 1), kbase = tok0 - 128;
    LAS bf16* VT = (LAS bf16*)ldsb;
    LAS bf16* KI = (LAS bf16*)(ldsb + 51200);
    LAS float* SSQ = (LAS float*)(ldsb + 51200 + 55296);
    const __amdgpu_buffer_rsrc_t rsP = __builtin_amdgcn_make_buffer_rsrc((void*)PROJ, 0, (unsigned)T * PS * 2u, 0x00020000);
#pragma unroll
    for (int i = 0; i < 6; ++i) {
        const int c = tid + 512 * i, kv = c / 1536, cc = c - kv * 1536, key = cc >> 3, d0 = (cc & 7) * 8; const bool valid = (s0 - 128 + key) >= 0;
        bf16x8 v, k;
#pragma unroll
        for (int e = 0; e < 8; ++e) { v[e] = 0; k[e] = 0; }
        if (valid) { const unsigned ro = (unsigned)(kbase + key) * (unsigned)PS + (unsigned)(kv * 64 + d0);
            v = __builtin_bit_cast(bf16x8, __builtin_amdgcn_raw_buffer_load_b128(rsP, (int)((ro + (unsigned)OV) * 2u), 0, 0));
            k = __builtin_bit_cast(bf16x8, __builtin_amdgcn_raw_buffer_load_b128(rsP, (int)((ro + (unsigned)OKK) * 2u), 0, 0)); }
#pragma unroll
        for (int e = 0; e < 8; ++e) VT[kv * 12800 + (d0 + e) * 200 + key] = (bf16)v[e];
        *(LAS bf16x8*)(KI + (kv * 192 + key) * 72 + d0) = k;
    }
    __syncthreads();
    const int r = lane & 31, hi = lane >> 5;
    const int hq = wave, hkv = wave >> 2;
    const float slope = exp2f(-(float)(hq + 1)), sink = sinks[hq];
#pragma unroll 1
    for (int qt = 0; qt < 2; ++qt) {
        const int tq = tok0 + 32 * qt + r;
        bf16x8 qf[4];
        { const bf16* qp = PROJ + (size_t)tq * PS + OQ + hq * 64 + 8 * hi; asm volatile("" : "+v"(qp));
#pragma unroll
          for (int ks = 0; ks < 4; ++ks) qf[ks] = ldg8(qp + 16 * ks); }
        const int ql = 32 * qt + r;
        float m = sink, lh = 0.f;
        f32x16 O0 = zero16(), O1 = zero16();
#pragma unroll 1
        for (int kt = 0; kt < 5; ++kt) {
            const LAS bf16* kp = KI + (hkv * 192 + 32 * (qt + kt) + r) * 72 + 8 * hi;
            f32x16 X = zero16();
#pragma unroll
            for (int ks = 0; ks < 4; ++ks) X = MFMA32(lds8(kp + 16 * ks), qf[ks], X);
            float tm = -1e30f;
#pragma unroll
            for (int i = 0; i < 16; ++i) {
                const int kl = 32 * (qt + kt) + crow(i, hi), dist = 128 + ql - kl;
                const bool valid = (dist >= 0) && (dist < 128) && ((s0 - 128 + kl) >= 0);
                const float lg = valid ? (X[i] * 0.125f - slope * (float)dist) : -1e30f;
                X[i] = lg; tm = fmaxf(tm, lg);
            }
            tm = fmaxf(tm, __shfl_xor(tm, 32));
            const float mn = fmaxf(m, tm), sc = __expf(m - mn);
            m = mn; lh *= sc;
#pragma unroll
            for (int i = 0; i < 16; ++i) { O0[i] *= sc; O1[i] *= sc; const float pe = __expf(X[i] - mn); X[i] = pe; lh += pe; }
            const LAS bf16* vp = VT + hkv * 12800 + r * 200 + 32 * (qt + kt) + 4 * hi;
            { const bf16x8 xs = pack8<0>(X); const bf16x8 a0 = lds4x2(vp), a1 = lds4x2(vp + 32 * 200); O0 = MFMA32(a0, xs, O0); O1 = MFMA32(a1, xs, O1); }
            { const bf16x8 xs = pack8<1>(X); const bf16x8 a0 = lds4x2(vp + 16), a1 = lds4x2(vp + 32 * 200 + 16); O0 = MFMA32(a0, xs, O0); O1 = MFMA32(a1, xs, O1); }
        }
        const float lsum = lh + __shfl_xor(lh, 32) + __expf(sink - m);
        const float iv = 1.f / lsum;
        float sq = 0.f;
#pragma unroll
        for (int i = 0; i < 16; ++i) sq += O0[i] * O0[i] + O1[i] * O1[i];
        sq *= iv * iv; sq += __shfl_xor(sq, 32);
        if (hi == 0) SSQ[hq * 32 + r] = sq;
        __syncthreads();
        float tot = 0.f;
#pragma unroll
        for (int h = 0; h < 8; ++h) tot += SSQ[h * 32 + r];
        const float sc = iv * rsqrtf(tot * (1.f / 512.f) + EPS);
        bf16* orow = MIXB + (size_t)tq * D + hq * 64 + 4 * hi;
#pragma unroll
        for (int q4 = 0; q4 < 4; ++q4) {
            const float4 g0 = *(const float4*)(gnorm + hq * 64 + 8 * q4 + 4 * hi), g1 = *(const float4*)(gnorm + hq * 64 + 32 + 8 * q4 + 4 * hi);
            uint2 w0, w1;
            w0.x = pkbf(O0[4 * q4] * sc * g0.x, O0[4 * q4 + 1] * sc * g0.y); w0.y = pkbf(O0[4 * q4 + 2] * sc * g0.z, O0[4 * q4 + 3] * sc * g0.w);
            w1.x = pkbf(O1[4 * q4] * sc * g1.x, O1[4 * q4 + 1] * sc * g1.y); w1.y = pkbf(O1[4 * q4 + 2] * sc * g1.z, O1[4 * q4 + 3] * sc * g1.w);
            *(uint2*)(orow + 8 * q4) = w0; *(uint2*)(orow + 32 + 8 * q4) = w1;
        }
        __syncthreads();
    }
}

__device__ __forceinline__ void ssd_chunk_unit(LAS unsigned char* ldsb, int unit, const bf16* PROJ, bf16* XACT, const float* DTRAW, const float* conv_w, const float* conv_b, const float* dt_bias, const float* a_log,
                                               float* ACS, float* CDEC, float* MIXF, float* STATES, int tid, int lane, int wave) {
    asm volatile("" : "+v"(tid), "+v"(lane));
    const int g = unit & 1, bc = unit >> 1, tok0 = bc * 128;
    LAS float* DTT = (LAS float*)(ldsb + 34816 * 3 + 2048);
    LAS float* WT = (LAS float*)(ldsb + 34816 * 3 + 4096);
    {
        const int cgi = tid & 63, t0 = tok0 + 16 * (tid >> 6);
        const int c0 = cgi < 32 ? g * 256 + cgi * 8 : (cgi < 48 ? 512 + g * 128 + (cgi - 32) * 8 : 768 + g * 128 + (cgi - 48) * 8);
        float w[4][8], bs[8];
#pragma unroll
        for (int k = 0; k < 4; ++k) { const float4 a0 = *(const float4*)(conv_w + k * 1024 + c0), a1 = *(const float4*)(conv_w + k * 1024 + c0 + 4);
            w[k][0] = a0.x; w[k][1] = a0.y; w[k][2] = a0.z; w[k][3] = a0.w; w[k][4] = a1.x; w[k][5] = a1.y; w[k][6] = a1.z; w[k][7] = a1.w; }
        { const float4 a0 = *(const float4*)(conv_b + c0), a1 = *(const float4*)(conv_b + c0 + 4); bs[0] = a0.x; bs[1] = a0.y; bs[2] = a0.z; bs[3] = a0.w; bs[4] = a1.x; bs[5] = a1.y; bs[6] = a1.z; bs[7] = a1.w; }
        const bool has_halo = (t0 & (SEQ - 1)) != 0;
        bf16x8 rows[19];
#pragma unroll
        for (int i = 0; i < 19; ++i) {
            if (i < 3 && !has_halo) {
#pragma unroll
                for (int e = 0; e < 8; ++e) rows[i][e] = 0;
            } else rows[i] = ldg8(PROJ + (size_t)(t0 + i - 3) * PS + OXBC + c0);
        }
#pragma unroll
        for (int i = 0; i < 16; ++i) {
            float o[8];
#pragma unroll
            for (int e = 0; e < 8; ++e) o[e] = silu_f(bs[e] + w[0][e] * sbf2f(rows[i][e]) + w[1][e] * sbf2f(rows[i + 1][e]) + w[2][e] * sbf2f(rows[i + 2][e]) + w[3][e] * sbf2f(rows[i + 3][e]));
            v4u ov; ov.x = pkbf(o[0], o[1]); ov.y = pkbf(o[2], o[3]); ov.z = pkbf(o[4], o[5]); ov.w = pkbf(o[6], o[7]);
            *(v4u*)(XACT + (size_t)(t0 + i) * 1024 + c0) = ov;
        }
    }
    LAS float* ACST = (LAS float*)(ldsb + 34816 * 3);
    {
        const int s = tid >> 2, hh = tid & 3, H = g * 4 + hh;
        const float A = -__expf(a_log[H]);
        const float raw = DTRAW[(size_t)(tok0 + s) * 8 + H] + dt_bias[H];
        const float dtv = fmaxf(raw, 0.f) + log1pf(__expf(-fabsf(raw)));
        float v = dtv * A;
#pragma unroll
        for (int o = 4; o < 64; o <<= 1) { const float y = __shfl_up(v, o); if (lane >= o) v += y; }
        if (lane >= 60) WT[wave * 4 + hh] = v;
        __syncthreads();
        float off = 0.f;
        for (int w2 = 0; w2 < wave; ++w2) off += WT[w2 * 4 + hh];
        v += off;
        DTT[tid] = dtv; ACST[tid] = v; ACS[(size_t)(tok0 + s) * 8 + H] = v;
        if (s == 127) CDEC[bc * 8 + H] = __expf(v);
    }
    asm volatile("s_waitcnt vmcnt(0)" ::: "memory");
    __syncthreads();
    LAS bf16* BT = (LAS bf16*)ldsb;
    LAS bf16* XD = (LAS bf16*)(ldsb + 34816);
    LAS bf16* XW = (LAS bf16*)(ldsb + 34816 + 34816);
    const int r = lane & 31, hi = lane >> 5;
#pragma unroll
    for (int i = 0; i < 4; ++i) {
        const int c = tid + 512 * i, s = c >> 4, n0 = (c & 15) * 8;
        const bf16x8 v = ldg8(XACT + (size_t)(tok0 + s) * 1024 + 512 + g * 128 + n0);
#pragma unroll
        for (int e = 0; e < 8; ++e) BT[(n0 + e) * 136 + s] = (bf16)v[e];
    }
#pragma unroll 1
    for (int hp = 0; hp < 2; ++hp) {
        if (hp) __syncthreads();
        int tidp = tid; asm volatile("" : "+v"(tidp));
#pragma unroll
        for (int i = 0; i < 4; ++i) {
            const int c = tidp + 512 * i, hsel = c >> 10, s = (c >> 3) & 127, p0 = (c & 7) * 8, H = g * 4 + 2 * hp + hsel;
            const bf16x8 v = ldg8(XACT + (size_t)(tok0 + s) * 1024 + H * 64 + p0);
            const float dtv = DTT[s * 4 + 2 * hp + hsel];
            const float w = __expf(ACST[127 * 4 + 2 * hp + hsel] - ACST[s * 4 + 2 * hp + hsel]);
#pragma unroll
            for (int e = 0; e < 8; ++e) { const float xd = sbf2f(v[e]) * dtv; XD[hsel * 8704 + (p0 + e) * 136 + s] = (bf16)bfs(xd); XW[hsel * 8704 + (p0 + e) * 136 + s] = (bf16)bfs(xd * w); }
        }
        __syncthreads();
        {
            const int lt = wave & 3, hsel = wave >> 2, hh = 2 * hp + hsel, H = g * 4 + hh;
            const int l = 32 * lt + r; const float acs_l = ACST[l * 4 + hh];
            bf16x8 cf[8];
            { const bf16* cp = XACT + (size_t)(tok0 + l) * 1024 + 768 + g * 128 + 8 * hi; asm volatile("" : "+v"(cp));
#pragma unroll
              for (int ks = 0; ks < 8; ++ks) cf[ks] = ldg8(cp + 16 * ks); }
            f32x16 Z0 = zero16(), Z1 = zero16();
            bf16x8 bn[8];
            { const bf16* bp = XACT + (size_t)(tok0 + r) * 1024 + 512 + g * 128 + 8 * hi; asm volatile("" : "+v"(bp));
#pragma unroll
              for (int ks = 0; ks < 8; ++ks) bn[ks] = ldg8(bp + 16 * ks); }
#pragma unroll 1
            for (int st = 0; st <= lt; ++st) {
                f32x16 X = zero16();
                bf16x8 bc[8];
#pragma unroll
                for (int ks = 0; ks < 8; ++ks) bc[ks] = bn[ks];
                { const int stn = st < lt ? st + 1 : lt; const bf16* bp = XACT + (size_t)(tok0 + 32 * stn + r) * 1024 + 512 + g * 128 + 8 * hi; asm volatile("" : "+v"(bp));
#pragma unroll
                  for (int ks = 0; ks < 8; ++ks) bn[ks] = ldg8(bp + 16 * ks); }
#pragma unroll
                for (int ks = 0; ks < 8; ++ks) X = MFMA32(bc[ks], cf[ks], X);
#pragma unroll
                for (int i = 0; i < 16; ++i) { const int s = 32 * st + crow(i, hi); const float f = (s <= l) ? __expf(acs_l - ACST[s * 4 + hh]) : 0.f; X[i] *= f; }
                const int sb = 32 * st + 4 * hi;
                { const bf16x8 xs = pack8<0>(X); const bf16x8 b0 = lds4x2(XD + hsel * 8704 + r * 136 + sb), b1 = lds4x2(XD + hsel * 8704 + (32 + r) * 136 + sb); Z0 = MFMA32(xs, b0, Z0); Z1 = MFMA32(xs, b1, Z1); }
                { const bf16x8 xs = pack8<1>(X); const bf16x8 b0 = lds4x2(XD + hsel * 8704 + r * 136 + sb + 16), b1 = lds4x2(XD + hsel * 8704 + (32 + r) * 136 + sb + 16); Z0 = MFMA32(xs, b0, Z0); Z1 = MFMA32(xs, b1, Z1); }
            }
#pragma unroll
            for (int i = 0; i < 16; ++i) { float* o = MIXF + (size_t)(tok0 + 32 * lt + crow(i, hi)) * D + 512 + H * 64 + r; o[0] = Z0[i]; o[32] = Z1[i]; }
        }
        {
            const int nt = wave & 3, hsel = wave >> 2, H = g * 4 + 2 * hp + hsel;
            f32x16 S0 = zero16(), S1 = zero16();
#pragma unroll
            for (int ks = 0; ks < 8; ++ks) {
                const bf16x8 btf = lds8(BT + (32 * nt + r) * 136 + 16 * ks + 8 * hi);
                const bf16x8 a0 = lds8(XW + hsel * 8704 + r * 136 + 16 * ks + 8 * hi), a1 = lds8(XW + hsel * 8704 + (32 + r) * 136 + 16 * ks + 8 * hi);
                S0 = MFMA32(a0, btf, S0); S1 = MFMA32(a1, btf, S1);
            }
            float* sp = STATES + (size_t)(bc * 8 + H) * 8192 + 32 * nt + r;
#pragma unroll
            for (int i = 0; i < 16; ++i) { const int p = crow(i, hi); sp[p * 128] = S0[i]; sp[(32 + p) * 128] = S1[i]; }
        }
    }
    __syncthreads();
}

__device__ __forceinline__ __amdgpu_buffer_rsrc_t mk_rsrc(const void* p, unsigned bytes) { return __builtin_amdgcn_make_buffer_rsrc((void*)p, 0, bytes, 0x00020000); }
__device__ __forceinline__ void yoff_unit(const float* d_skip, const float* gnorm, LAS unsigned char* ldsb, int unit, const bf16* XACT, const bf16* PROJ, const float* ACS, const bf16* PREVT,
                                          const float* MIXF, bf16* MIXB, int lane, int wave) {
    const int g = unit & 1, bc = unit >> 1, tok0 = bc * 128;
    const int r = lane & 31, hi = lane >> 5, lt = wave & 3, hpair = wave >> 2;
    LAS float* TAB = (LAS float*)ldsb;
    const __amdgpu_buffer_rsrc_t rsF = mk_rsrc(MIXF, (unsigned)T * D * 4u), rsX = mk_rsrc(XACT, (unsigned)T * 1024u * 2u), rsP = mk_rsrc(PROJ, (unsigned)T * PS * 2u), rsA = mk_rsrc(ACS, (unsigned)T * 32u), rsB = mk_rsrc(MIXB, (unsigned)T * D * 2u);
    const unsigned tb = (unsigned)(tok0 + 32 * lt + 4 * hi);
    bf16x8 cf[8];
    { const bf16* cp = XACT + (size_t)(tok0 + 32 * lt + r) * 1024 + 768 + g * 128 + 8 * hi; asm volatile("" : "+v"(cp));
#pragma unroll
      for (int ks = 0; ks < 8; ++ks) cf[ks] = ldg8(cp + 16 * ks); }
    float eav[16], ssq[16];
    unsigned ypk[2][2][8];
#pragma unroll
    for (int i = 0; i < 16; ++i) ssq[i] = 0.f;
#pragma unroll
    for (int hsel = 0; hsel < 2; ++hsel) {
        const int H = g * 4 + 2 * hpair + hsel; const bf16* pv = PREVT + (size_t)(bc * 8 + H) * 8192 + 8 * hi;
        asm volatile("" : "+v"(pv));
        f32x16 Y0 = zero16(), Y1 = zero16();
#pragma unroll
        for (int ks = 0; ks < 8; ++ks) {
            const bf16x8 b0 = ldg8(pv + r * 128 + 16 * ks), b1 = ldg8(pv + (32 + r) * 128 + 16 * ks);
            Y0 = MFMA32(cf[ks], b0, Y0); Y1 = MFMA32(cf[ks], b1, Y1);
        }
        const float dsk = d_skip[H];
        { const unsigned vo = (tb * 8u + (unsigned)H) * 4u;
#pragma unroll
          for (int i = 0; i < 16; ++i) eav[i] = __expf(__builtin_bit_cast(float, __builtin_amdgcn_raw_buffer_load_b32(rsA, (int)vo, ((i & 3) + 8 * (i >> 2)) * 32, 0))); }
#pragma unroll
        for (int pt = 0; pt < 2; ++pt) {
            const unsigned col = (unsigned)(H * 64 + 32 * pt + r);
            const unsigned voF = (tb * 1024u + 512u + col) * 4u, voX = (tb * 1024u + col) * 2u, voP = (tb * (unsigned)PS + (unsigned)OZ + col) * 2u;
            float yo[16], xsv[16], zv[16];
#pragma unroll
            for (int i = 0; i < 16; ++i) { const int ro = (i & 3) + 8 * (i >> 2);
                yo[i] = __builtin_bit_cast(float, __builtin_amdgcn_raw_buffer_load_b32(rsF, (int)voF, ro * 4096, 0));
                xsv[i] = bf2f((bf16)__builtin_amdgcn_raw_buffer_load_b16(rsX, (int)voX, ro * 2048, 0));
                zv[i] = bf2f((bf16)__builtin_amdgcn_raw_buffer_load_b16(rsP, (int)voP, ro * (PS * 2), 0)); }
#pragma unroll
            for (int i = 0; i < 16; i += 2) {
                const float y0 = (yo[i] + eav[i] * (pt ? Y1[i] : Y0[i]) + dsk * xsv[i]) * silu_f(zv[i]);
                const float y1 = (yo[i + 1] + eav[i + 1] * (pt ? Y1[i + 1] : Y0[i + 1]) + dsk * xsv[i + 1]) * silu_f(zv[i + 1]);
                ssq[i] += y0 * y0; ssq[i + 1] += y1 * y1; ypk[hsel][pt][i >> 1] = pkbf(y0, y1);
            }
            __builtin_amdgcn_sched_barrier(0);
        }
    }
#pragma unroll
    for (int i = 0; i < 16; ++i) {
#pragma unroll
        for (int o = 1; o < 32; o <<= 1) ssq[i] += __shfl_xor(ssq[i], o);
    }
    if (r == 0) {
#pragma unroll
        for (int i = 0; i < 16; ++i) TAB[hpair * 128 + 32 * lt + crow(i, hi)] = ssq[i];
    }
    __syncthreads();
#pragma unroll
    for (int i = 0; i < 16; ++i) { const int l = 32 * lt + crow(i, hi); ssq[i] = rsqrtf((TAB[l] + TAB[128 + l]) * (1.f / 256.f) + EPS); }
#pragma unroll
    for (int hsel = 0; hsel < 2; ++hsel)
#pragma unroll
        for (int pt = 0; pt < 2; ++pt) {
            const unsigned col = (unsigned)((g * 4 + 2 * hpair + hsel) * 64 + 32 * pt + r); const float gn = gnorm[col];
            const unsigned voB = (tb * 1024u + 512u + col) * 2u;
#pragma unroll
            for (int i = 0; i < 16; ++i) { const unsigned w = ypk[hsel][pt][i >> 1];
                const float yf = (i & 1) ? __uint_as_float(w & 0xffff0000u) : __uint_as_float(w << 16);
                __builtin_amdgcn_raw_buffer_store_b16((short)f2bf(yf * ssq[i] * gn), rsB, (int)voB, ((i & 3) + 8 * (i >> 2)) * 2048, 0); }
        }
    __syncthreads();
}
typedef float f32x2 __attribute__((ext_vector_type(2)));
__device__ __forceinline__ void fp8x16_to_f32(const uint4 w, float (&f)[16]) {
    const int ww[4] = {(int)w.x, (int)w.y, (int)w.z, (int)w.w};
#pragma unroll
    for (int q = 0; q < 4; ++q) { const f32x2 a = __builtin_amdgcn_cvt_pk_f32_fp8(ww[q], false), b = __builtin_amdgcn_cvt_pk_f32_fp8(ww[q], true); f[4 * q] = a.x; f[4 * q + 1] = a.y; f[4 * q + 2] = b.x; f[4 * q + 3] = b.y; }
}
template <int M4, int M2, int M1> __device__ __forceinline__ void treduce16(const float (&a)[16], int lane, float& r0, float& r1) {
    float b[8], c[4];
    { const bool hi = (lane & M4) != 0;
#pragma unroll
      for (int i = 0; i < 8; ++i) { const float send = hi ? a[i] : a[i + 8]; const float recv = __shfl_xor(send, M4); b[i] = (hi ? a[i + 8] : a[i]) + recv; } }
    { const bool hi = (lane & M2) != 0;
#pragma unroll
      for (int i = 0; i < 4; ++i) { const float send = hi ? b[i] : b[i + 4]; const float recv = __shfl_xor(send, M2); c[i] = (hi ? b[i + 4] : b[i]) + recv; } }
    { const bool hi = (lane & M1) != 0;
      { const float send = hi ? c[0] : c[2]; const float recv = __shfl_xor(send, M1); r0 = (hi ? c[2] : c[0]) + recv; }
      { const float send = hi ? c[1] : c[3]; const float recv = __shfl_xor(send, M1); r1 = (hi ? c[3] : c[1]) + recv; } }
}
template <int M4, int M2, int M1> __device__ __forceinline__ void treduce16i(const int (&a)[16], int lane, int& r0, int& r1) {
    int b[8], c[4];
    { const bool hi = (lane & M4) != 0;
#pragma unroll
      for (int i = 0; i < 8; ++i) { const int send = hi ? a[i] : a[i + 8]; const int recv = __shfl_xor(send, M4); b[i] = (hi ? a[i + 8] : a[i]) + recv; } }
    { const bool hi = (lane & M2) != 0;
#pragma unroll
      for (int i = 0; i < 4; ++i) { const int send = hi ? b[i] : b[i + 4]; const int recv = __shfl_xor(send, M2); c[i] = (hi ? b[i + 4] : b[i]) + recv; } }
    { const bool hi = (lane & M1) != 0;
      { const int send = hi ? c[0] : c[2]; const int recv = __shfl_xor(send, M1); r0 = (hi ? c[2] : c[0]) + recv; }
      { const int send = hi ? c[1] : c[3]; const int recv = __shfl_xor(send, M1); r1 = (hi ? c[3] : c[1]) + recv; } }
}
#define PE_ID(E, i) (((i) & 1) ? (E[(i) >> 1] >> 16) : (E[(i) >> 1] & 0xffffu))
__device__ __forceinline__ void peer_u_item(int p, int j, const unsigned short* __restrict__ IDX, const unsigned char* __restrict__ XQ, const unsigned char* __restrict__ U8, bf16* __restrict__ PART, int lane, int wave) {
    asm volatile("" : "+v"(lane));
    const int gidx = lane >> 3; const unsigned coff = (unsigned)(p * 128 + (lane & 7) * 16);
#pragma unroll 1
    for (int it = 0; it < 8; ++it) {
        const int t = j * 64 + it * 8 + wave;
        unsigned E[8];
        { const uint4 e0 = *(const uint4*)(IDX + (size_t)t * 128 + 16 * gidx), e1 = *(const uint4*)(IDX + (size_t)t * 128 + 16 * gidx + 8);
          E[0] = e0.x; E[1] = e0.y; E[2] = e0.z; E[3] = e0.w; E[4] = e1.x; E[5] = e1.y; E[6] = e1.z; E[7] = e1.w; }
        uint4 uu[16];
#pragma unroll
        for (int i = 0; i < 16; ++i) uu[i] = *(const uint4*)(U8 + (size_t)(PE_ID(E, i) * 1024u + coff));
        const uint4 xq = *(const uint4*)(XQ + (size_t)t * D + coff);
        int d[16];
#pragma unroll
        for (int i = 0; i < 16; ++i) {
            int s = __builtin_amdgcn_sdot4((int)uu[i].x, (int)xq.x, 0, false); s = __builtin_amdgcn_sdot4((int)uu[i].y, (int)xq.y, s, false);
            s = __builtin_amdgcn_sdot4((int)uu[i].z, (int)xq.z, s, false); s = __builtin_amdgcn_sdot4((int)uu[i].w, (int)xq.w, s, false);
            d[i] = s;
        }
        int r0, r1; treduce16i<4, 2, 1>(d, lane, r0, r1);
        *(unsigned*)(PART + ((size_t)p * T + t) * 128 + 2 * lane) = pkbf((float)r0, (float)r1);
    }
}
__device__ __forceinline__ void peer_v_item(int p, int j, const unsigned short* __restrict__ IDX, const unsigned char* __restrict__ ACTQ, const float* __restrict__ ACTS,
                                            const unsigned char* __restrict__ V8, bf16* __restrict__ PEERO, int lane, int wave) {
    asm volatile("" : "+v"(lane));
    const int gidx = lane >> 3; const unsigned coff = (unsigned)(p * 128 + (lane & 7) * 16);
#pragma unroll 1
    for (int it = 0; it < 8; ++it) {
        const int t = j * 64 + it * 8 + wave;
        unsigned E[8];
        { const uint4 e0 = *(const uint4*)(IDX + (size_t)t * 128 + 16 * gidx), e1 = *(const uint4*)(IDX + (size_t)t * 128 + 16 * gidx + 8);
          E[0] = e0.x; E[1] = e0.y; E[2] = e0.z; E[3] = e0.w; E[4] = e1.x; E[5] = e1.y; E[6] = e1.z; E[7] = e1.w; }
        uint4 vv[16];
#pragma unroll
        for (int i = 0; i < 16; ++i) vv[i] = *(const uint4*)(V8 + (size_t)(PE_ID(E, i) * 1024u + coff));
        const uint4 aq = *(const uint4*)(ACTQ + (size_t)t * 128 + 16 * gidx);
        const float asc = ACTS[t];
        const unsigned a4[4] = {aq.x, aq.y, aq.z, aq.w};
        int acc[16];
#pragma unroll
        for (int c = 0; c < 16; ++c) acc[c] = 0;
#pragma unroll
        for (int m = 0; m < 4; ++m) {
            const unsigned r0[4] = {vv[4 * m].x, vv[4 * m].y, vv[4 * m].z, vv[4 * m].w}, r1[4] = {vv[4 * m + 1].x, vv[4 * m + 1].y, vv[4 * m + 1].z, vv[4 * m + 1].w};
            const unsigned r2[4] = {vv[4 * m + 2].x, vv[4 * m + 2].y, vv[4 * m + 2].z, vv[4 * m + 2].w}, r3[4] = {vv[4 * m + 3].x, vv[4 * m + 3].y, vv[4 * m + 3].z, vv[4 * m + 3].w};
#pragma unroll
            for (int dc = 0; dc < 4; ++dc) {
                const unsigned ta = __builtin_amdgcn_perm(r1[dc], r0[dc], 0x05010400u), tb = __builtin_amdgcn_perm(r3[dc], r2[dc], 0x05010400u);
                const unsigned ua = __builtin_amdgcn_perm(r1[dc], r0[dc], 0x07030602u), ub = __builtin_amdgcn_perm(r3[dc], r2[dc], 0x07030602u);
                const unsigned c0 = __builtin_amdgcn_perm(tb, ta, 0x05040100u), c1 = __builtin_amdgcn_perm(tb, ta, 0x07060302u);
                const unsigned c2 = __builtin_amdgcn_perm(ub, ua, 0x05040100u), c3 = __builtin_amdgcn_perm(ub, ua, 0x07060302u);
                acc[4 * dc + 0] = __builtin_amdgcn_sdot4((int)c0, (int)a4[m], acc[4 * dc + 0], false);
                acc[4 * dc + 1] = __builtin_amdgcn_sdot4((int)c1, (int)a4[m], acc[4 * dc + 1], false);
                acc[4 * dc + 2] = __builtin_amdgcn_sdot4((int)c2, (int)a4[m], acc[4 * dc + 2], false);
                acc[4 * dc + 3] = __builtin_amdgcn_sdot4((int)c3, (int)a4[m], acc[4 * dc + 3], false);
            }
        }
        int r0i, r1i; treduce16i<32, 16, 8>(acc, lane, r0i, r1i);
        *(unsigned*)(PEERO + (size_t)t * D + coff + 2 * gidx) = pkbf(asc * (float)r0i, asc * (float)r1i);
    }
}

__device__ __forceinline__ void ce_desc(float& a, float& b) { const float hi = fmaxf(a, b), lo = fminf(a, b); a = hi; b = lo; }
__device__ __forceinline__ void sort16_desc(float (&v)[16]) {
#pragma unroll
    for (int k = 2; k <= 16; k <<= 1)
#pragma unroll
        for (int j = k >> 1; j > 0; j >>= 1)
#pragma unroll
            for (int i = 0; i < 16; ++i) { const int l = i ^ j; if (l > i) { if ((i & k) == 0) ce_desc(v[i], v[l]); else ce_desc(v[l], v[i]); } }
}
__device__ __forceinline__ void merge16_desc(float (&a)[16], const float (&b)[16]) {
#pragma unroll
    for (int i = 0; i < 16; ++i) a[i] = fmaxf(a[i], b[15 - i]);
#pragma unroll
    for (int j = 8; j > 0; j >>= 1)
#pragma unroll
        for (int i = 0; i < 16; ++i) { const int l = i ^ j; if (l > i) ce_desc(a[i], a[l]); }
}
__device__ __forceinline__ void ce_kv(float& ka, int& va, float& kb, int& vb) {
    const bool s = kb > ka; const float t0 = s ? kb : ka, t1 = s ? ka : kb; const int u0 = s ? vb : va, u1 = s ? va : vb; ka = t0; kb = t1; va = u0; vb = u1; }
__device__ __forceinline__ void sort16_kv(float (&k)[16], int (&v)[16]) {
#pragma unroll
    for (int kk = 2; kk <= 16; kk <<= 1)
#pragma unroll
        for (int j = kk >> 1; j > 0; j >>= 1)
#pragma unroll
            for (int i = 0; i < 16; ++i) { const int l = i ^ j; if (l > i) { if ((i & kk) == 0) ce_kv(k[i], v[i], k[l], v[l]); else ce_kv(k[l], v[l], k[i], v[i]); } }
}
__device__ __forceinline__ void merge16_kv(float (&ka)[16], int (&va)[16], const float (&kb)[16], const int (&vb)[16]) {
#pragma unroll
    for (int i = 0; i < 16; ++i) { const bool s = kb[15 - i] > ka[i]; ka[i] = s ? kb[15 - i] : ka[i]; va[i] = s ? vb[15 - i] : va[i]; }
#pragma unroll
    for (int j = 8; j > 0; j >>= 1)
#pragma unroll
        for (int i = 0; i < 16; ++i) { const int l = i ^ j; if (l > i) ce_kv(ka[i], va[i], ka[l], va[l]); }
}
__device__ __forceinline__ void split8(const float* p, bf16x8& hi8, bf16x8& lo8) {
    const float4 f0 = *(const float4*)p, f1 = *(const float4*)(p + 4);
    const float x[8] = {f0.x, f0.y, f0.z, f0.w, f1.x, f1.y, f1.z, f1.w};
#pragma unroll
    for (int j = 0; j < 8; ++j) { const short h = bfs(x[j]); hi8[j] = h; lo8[j] = bfs(x[j] - sbf2f(h)); }
}
__device__ __forceinline__ void route_task(int task, const float* QP, const LAS bf16* KHL, unsigned short* IDX, float* GATE, int lane) {
    const int r = lane & 31, hi = lane >> 5, t = 4 * task + (r >> 3), head = r & 7;
    float top[2][16];
#pragma unroll
    for (int half = 0; half < 2; ++half) {
        bf16x8 qh[4], ql[4];
        { const float* qp = QP + (size_t)t * D + head * 128 + half * 64 + 8 * hi; asm volatile("" : "+v"(qp));
#pragma unroll
          for (int ks = 0; ks < 4; ++ks) split8(qp + 16 * ks, qh[ks], ql[ks]); }
        float cur[16];
#pragma unroll
        for (int kt = 0; kt < 4; ++kt) {
            f32x16 X = zero16();
            const LAS bf16* khp = KHL + (half * 128 + 32 * kt + r) * 72 + 8 * hi;
#pragma unroll
            for (int ks = 0; ks < 4; ++ks) {
                const bf16x8 kh = lds8(khp + 16 * ks), kl = lds8(khp + 2 * 128 * 72 + 16 * ks);
                X = MFMA32(kh, qh[ks], X); X = MFMA32(kh, ql[ks], X); X = MFMA32(kl, qh[ks], X);
            }
            float grp[16];
#pragma unroll
            for (int i = 0; i < 16; ++i) { const unsigned key = (unsigned)(32 * kt + crow(i, hi)); grp[i] = __uint_as_float((__float_as_uint(X[i]) & ~127u) | (127u - key)); }
            sort16_desc(grp);
            if (kt == 0) {
#pragma unroll
                for (int i = 0; i < 16; ++i) cur[i] = grp[i];
            } else merge16_desc(cur, grp);
        }
        float oth[16];
#pragma unroll
        for (int i = 0; i < 16; ++i) oth[i] = __shfl_xor(cur[i], 32);
        merge16_desc(cur, oth);
#pragma unroll
        for (int i = 0; i < 16; ++i) top[half][i] = cur[i];
    }
    unsigned P1[4], P2[4];
#pragma unroll
    for (int q = 0; q < 4; ++q) { P1[q] = 0u; P2[q] = 0u;
#pragma unroll
        for (int s = 0; s < 4; ++s) { P1[q] |= (127u - (__float_as_uint(top[0][4 * q + s]) & 127u)) << (8 * s); P2[q] |= (127u - (__float_as_uint(top[1][4 * q + s]) & 127u)) << (8 * s); } }
#define CAND(a, b) __uint_as_float((__float_as_uint(top[0][a] + top[1][b]) & ~255u) | (255u - (unsigned)((a) * 16 + (b))))
    float bk[16];
    {
        float gk[16];
        gk[0] = CAND(0, 0);
        gk[1] = CAND(0, 1);
        gk[2] = CAND(0, 2);
        gk[3] = CAND(0, 3);
        gk[4] = CAND(0, 4);
        gk[5] = CAND(0, 5);
        gk[6] = CAND(0, 6);
        gk[7] = CAND(0, 7);
        gk[8] = CAND(0, 8);
        gk[9] = CAND(0, 9);
        gk[10] = CAND(0, 10);
        gk[11] = CAND(0, 11);
        gk[12] = CAND(0, 12);
        gk[13] = CAND(0, 13);
        gk[14] = CAND(0, 14);
        gk[15] = CAND(0, 15);
        sort16_desc(gk);
#pragma unroll
        for (int i = 0; i < 16; ++i) bk[i] = gk[i];
    }
    {
        float gk[16];
        gk[0] = CAND(1, 0);
        gk[1] = CAND(1, 1);
        gk[2] = CAND(1, 2);
        gk[3] = CAND(1, 3);
        gk[4] = CAND(1, 4);
        gk[5] = CAND(1, 5);
        gk[6] = CAND(1, 6);
        gk[7] = CAND(1, 7);
        gk[8] = CAND(2, 0);
        gk[9] = CAND(2, 1);
        gk[10] = CAND(2, 2);
        gk[11] = CAND(2, 3);
        gk[12] = CAND(2, 4);
        gk[13] = CAND(3, 0);
        gk[14] = CAND(3, 1);
        gk[15] = CAND(3, 2);
        sort16_desc(gk);
        merge16_desc(bk, gk);
    }
    {
        float gk[16];
        gk[0] = CAND(3, 3);
        gk[1] = CAND(4, 0);
        gk[2] = CAND(4, 1);
        gk[3] = CAND(4, 2);
        gk[4] = CAND(5, 0);
        gk[5] = CAND(5, 1);
        gk[6] = CAND(6, 0);
        gk[7] = CAND(6, 1);
        gk[8] = CAND(7, 0);
        gk[9] = CAND(7, 1);
        gk[10] = CAND(8, 0);
        gk[11] = CAND(9, 0);
        gk[12] = CAND(10, 0);
        gk[13] = CAND(11, 0);
        gk[14] = CAND(12, 0);
        gk[15] = CAND(13, 0);
        sort16_desc(gk);
        merge16_desc(bk, gk);
    }
    {
        float gk[16];
        gk[0] = CAND(14, 0);
        gk[1] = CAND(15, 0);
        gk[2] = -INFINITY;
        gk[3] = -INFINITY;
        gk[4] = -INFINITY;
        gk[5] = -INFINITY;
        gk[6] = -INFINITY;
        gk[7] = -INFINITY;
        gk[8] = -INFINITY;
        gk[9] = -INFINITY;
        gk[10] = -INFINITY;
        gk[11] = -INFINITY;
        gk[12] = -INFINITY;
        gk[13] = -INFINITY;
        gk[14] = -INFINITY;
        gk[15] = -INFINITY;
        sort16_desc(gk);
        merge16_desc(bk, gk);
    }
#undef CAND
    int bv[16];
#pragma unroll
    for (int i = 0; i < 16; ++i) {
        const unsigned cd = 255u - (__float_as_uint(bk[i]) & 255u), ca = cd >> 4, cb = cd & 15u;
        const unsigned wa = (ca >> 2) == 0u ? P1[0] : (ca >> 2) == 1u ? P1[1] : (ca >> 2) == 2u ? P1[2] : P1[3];
        const unsigned wb = (cb >> 2) == 0u ? P2[0] : (cb >> 2) == 1u ? P2[1] : (cb >> 2) == 2u ? P2[2] : P2[3];
        bv[i] = (int)((((wa >> (8u * (ca & 3u))) & 255u) << 7) | ((wb >> (8u * (cb & 3u))) & 255u));
    }
    float e[16], se = 0.f;
#pragma unroll
    for (int i = 0; i < 16; ++i) { e[i] = __expf(bk[i] - bk[0]); se += e[i]; }
    const float inv = 1.f / se;
    if (hi == 0) {
        uint4* ip = (uint4*)(IDX + (size_t)t * 128 + head * 16); float4* gp = (float4*)(GATE + (size_t)t * 128 + head * 16);
#pragma unroll
        for (int q = 0; q < 2; ++q) ip[q] = make_uint4((unsigned)bv[8 * q] | ((unsigned)bv[8 * q + 1] << 16), (unsigned)bv[8 * q + 2] | ((unsigned)bv[8 * q + 3] << 16), (unsigned)bv[8 * q + 4] | ((unsigned)bv[8 * q + 5] << 16), (unsigned)bv[8 * q + 6] | ((unsigned)bv[8 * q + 7] << 16));
#pragma unroll
        for (int q = 0; q < 4; ++q) gp[q] = make_float4(e[4 * q] * inv, e[4 * q + 1] * inv, e[4 * q + 2] * inv, e[4 * q + 3] * inv);
    }
}

#define XB_TMO      128
#define XB_XCNT(j)  (256  + 64 * (j))
#define XB_XSUB(j)  (1280 + 64 * (j))
#define XB_XGEN(j)  (2304 + 64 * (j))
#define XB_TOP      3328
#define XB_TOPGEN   3392
#define XCD_BAR_WORDS 3456
#define XB_SPIN_CAP (1u << 22)
__device__ __forceinline__ unsigned xb_ld(unsigned* p)              { return __hip_atomic_load(p, __ATOMIC_RELAXED, __HIP_MEMORY_SCOPE_AGENT); }
__device__ __forceinline__ unsigned xb_add(unsigned* p, unsigned v) { return __hip_atomic_fetch_add(p, v, __ATOMIC_RELAXED, __HIP_MEMORY_SCOPE_AGENT); }
__device__ __forceinline__ unsigned xb_xcc_id() { return (unsigned)__builtin_amdgcn_s_getreg((3 << 11) | 20) & 0xFu; }
#define XB_SPIN(cond, bar) do { unsigned _sp = 0; while (cond) { __builtin_amdgcn_s_sleep(1); \
    if ((++_sp & 255u) == 0u) { if (xb_ld(&(bar)[XB_TMO])) break; if (_sp > XB_SPIN_CAP) { atomicAdd(&(bar)[XB_TMO], 1u); break; } } } } while (0)
struct XcdBarrier { unsigned* bar; unsigned x; volatile LAS unsigned* st; };
__device__ __forceinline__ XcdBarrier xcd_barrier_post(unsigned* bar, volatile LAS unsigned* st) {
    XcdBarrier b; b.bar = bar; b.x = xb_xcc_id(); b.st = st;
    if (threadIdx.x == 0) (void)xb_add(&bar[XB_XCNT(b.x)], 1u);
    return b;
}
__device__ __forceinline__ void xcd_barrier_complete(unsigned* bar, unsigned x, unsigned& nloc, unsigned& nx) {
    const unsigned G = gridDim.x * gridDim.y * gridDim.z;
    unsigned sum, cnt, mine, sp = 0u;
    for (;;) {
        sum = 0u; cnt = 0u; mine = 0u;
#pragma unroll
        for (unsigned j = 0; j < 16; ++j) { const unsigned c = xb_ld(&bar[XB_XCNT(j)]); sum += c; cnt += (c > 0u) ? 1u : 0u; mine = (j == x) ? c : mine; }
        if (sum == G) break;
        __builtin_amdgcn_s_sleep(1);
        if ((++sp & 255u) == 0u) { if (xb_ld(&bar[XB_TMO])) break; if (sp > XB_SPIN_CAP) { atomicAdd(&bar[XB_TMO], 1u); break; } }
    }
    nloc = mine > 0u ? mine : 1u; nx = cnt > 0u ? cnt : 1u;
}
__device__ __forceinline__ void xcd_barrier(const XcdBarrier& b) {
    asm volatile("s_waitcnt vmcnt(0)" ::: "memory");
    __syncthreads();
    if (threadIdx.x == 0) {
        unsigned* bar = b.bar;
        __builtin_amdgcn_s_waitcnt(0);
        unsigned nloc = b.st[0], nx = b.st[1];
        if (nloc == 0u) { xcd_barrier_complete(bar, b.x, nloc, nx); b.st[0] = nloc; b.st[1] = nx; }
        const unsigned old = xb_add(&bar[XB_XSUB(b.x)], 1u);
        const unsigned gen = old / nloc;
        if (old + 1u == (gen + 1u) * nloc) {
            __builtin_amdgcn_fence(__ATOMIC_RELEASE, "agent");
            asm volatile("s_waitcnt vmcnt(0)" ::: "memory");
            const unsigned og = xb_add(&bar[XB_TOP], 1u);
            const unsigned tg = og / nx;
            if (og + 1u == (tg + 1u) * nx) xb_add(&bar[XB_TOPGEN], 1u);
            else XB_SPIN(xb_ld(&bar[XB_TOPGEN]) == tg, bar);
            __builtin_amdgcn_fence(__ATOMIC_ACQUIRE, "agent");
            xb_add(&bar[XB_XGEN(b.x)], 1u);
            asm volatile("s_waitcnt vmcnt(0)" ::: "memory");
        } else {
            XB_SPIN(xb_ld(&bar[XB_XGEN(b.x)]) == gen, bar);
            __builtin_amdgcn_fence(__ATOMIC_ACQUIRE, "agent");
            asm volatile("s_waitcnt vmcnt(0)" ::: "memory");
        }
    }
    __syncthreads();
}
constexpr int LDS_BYTES = 147456;
constexpr int MISC_OFF = 131072 + 320;

__global__ void __launch_bounds__(NTHR, 2) k_main(Args a) {
    extern __shared__ __attribute__((aligned(16))) unsigned char lds_raw[];
    LAS unsigned char* ldsb = (LAS unsigned char*)lds_raw;
    const int tid0 = threadIdx.x, bid = blockIdx.x, nb = gridDim.x;
    const int wave = __builtin_amdgcn_readfirstlane(tid0 >> 6);
    const int gthreads = nb * NTHR, nwaves = gthreads >> 6;
#define PHASE_VARS() int tid = tid0; asm volatile("" : "+v"(tid)); const int lane = tid & 63, gtid = bid * NTHR + tid, gwave = gtid >> 6; (void)lane; (void)gtid; (void)gwave
    unsigned char* ws = a.ws;
    bf16* WINT = (bf16*)(ws + WS_WIN); bf16* WOT = (bf16*)(ws + WS_WO); bf16* WQT = (bf16*)(ws + WS_WQ);
    bf16* PROJ = (bf16*)(ws + WS_PROJ);
    bf16* XNB = (bf16*)(ws + WS_XNB);
    bf16* XACT = (bf16*)(ws + WS_XACT);
    float* DTRAW = (float*)(ws + WS_DTRAW); float* DT = (float*)(ws + WS_DT); float* ACS = (float*)(ws + WS_ACS); float* CDEC = (float*)(ws + WS_CDEC);
    float* STATES = (float*)(ws + WS_STATES); bf16* PREVT = (bf16*)(ws + WS_PREV);
    float* QP = (float*)(ws + WS_QP); unsigned short* IDX = (unsigned short*)(ws + WS_IDX); float* GATE = (float*)(ws + WS_GATE);
    float* TOPV = (float*)(ws + WS_TOPV); int* TOPI = (int*)(ws + WS_TOPI);
    unsigned char* U8 = ws + WS_U8; unsigned char* V8 = ws + WS_V8; float* SU = (float*)(ws + WS_SU); float* SV = SU + 16384; bf16* PART = (bf16*)(ws + WS_PART); unsigned char* XQ = ws + WS_XQ; float* XS = (float*)(ws + WS_XS);
    bf16* KH = (bf16*)(ws + WS_KH); bf16* KL = (bf16*)(ws + WS_KH + 65536);
    bf16* HB = (bf16*)(ws + WS_STATES);
    float* MIXF = a.out;
    volatile LAS unsigned* MISC = (volatile LAS unsigned*)(ldsb + MISC_OFF);
    if (tid0 < 32) MISC[tid0] = 0u;
    __syncthreads();
    XcdBarrier bar = xcd_barrier_post((unsigned*)ws, MISC + 8);
#define IN(k) (a.ph_lo <= (k) && (k) < a.ph_hi)
#if defined(PROBE_LO)
    int seg_ = 0; unsigned long long tseg_ = __builtin_amdgcn_s_memrealtime();
#define PROBE_SPIN() do { if (seg_ >= PROBE_LO && seg_ <= PROBE_HI) { const unsigned long long d_ = (__builtin_amdgcn_s_memrealtime() - tseg_) * PROBE_AMP; const unsigned long long s_ = __builtin_amdgcn_s_memrealtime(); \
        while (__builtin_amdgcn_s_memrealtime() - s_ < d_) __builtin_amdgcn_s_sleep(4); } } while (0)
#define GRID_BAR() do { PROBE_SPIN(); xcd_barrier(bar); tseg_ = __builtin_amdgcn_s_memrealtime(); ++seg_; } while (0)
#else
#define PROBE_SPIN() do { } while (0)
#define GRID_BAR() xcd_barrier(bar)
#endif

    if (IN(0)) {
        PHASE_VARS();
        LAS float* scr = (LAS float*)(ldsb + wave * 16384);
        constexpr int I_IN = 16 * 72, I_O = 16 * 32, NITEMS = I_IN + 2 * I_O;
        for (int it = gwave; it < NITEMS; it += nwaves) {
            int r = it;
            if (r < I_IN) { transpose_item(a.w_in, PW, D, WINT, scr, r / 72, r % 72, lane); continue; } r -= I_IN;
            if (r < I_O) { transpose_item(a.w_out, D, D, WOT, scr, r / 32, r % 32, lane); continue; } r -= I_O;
            transpose_item(a.peer_wq, D, D, WQT, scr, r / 32, r % 32, lane);
        }
        for (int i = gtid; i < 2 * 128 * 64; i += gthreads) { const float kf = a.peer_sub_keys[i]; const short h = bfs(kf); KH[i] = (bf16)h; KL[i] = (bf16)bfs(kf - sbf2f(h)); }
        for (int i = tid; i < 8 * 1024; i += NTHR) { const int h = i & 7, c = i >> 3; *(LAS float*)(ldsb + h * 16384 + 8448 + c * 4) = a.w_in[(size_t)c * PW + ODT + h]; }
        __syncthreads();
        rmsnorm_rows_bf16<1>(a.x, a.norm_mix_g, XNB, ldsb, DTRAW, nullptr, nullptr, gwave, nwaves, lane);
    }
    GRID_BAR();
    if (IN(1)) {
        PHASE_VARS();
        pg8::Gemm g{XNB, WINT, T, PS, D}; pg8::StaticOrder S; S.init(T, PS, nb, bid);
        pg8::EpiBf16Plain E{PROJ, PS};
        pg8::gemm_phase<pg8::EpiBf16Plain, pg8::StaticOrder>(ldsb, g, S, E, nullptr);
        const int cfirst = (nb == 256) ? 64 : 0;
        if (bid >= cfirst) for (int rr0 = ((bid - cfirst) * 8 + wave) * 4; rr0 < 2 * 16384; rr0 += (nb - cfirst) * 8 * 4) {
            float4 v[4][4];
#pragma unroll
            for (int q = 0; q < 4; ++q) { const int rr = rr0 + q, which = rr >> 14, row = rr & 16383;
                const float4* src4 = (const float4*)((which ? a.peer_v : a.peer_u) + (size_t)row * D) + lane;
#pragma unroll
                for (int jq = 0; jq < 4; ++jq) v[q][jq] = src4[64 * jq]; }
#pragma unroll
            for (int q = 0; q < 4; ++q) { const int rr = rr0 + q, which = rr >> 14, row = rr & 16383;
                float mx = 0.f;
#pragma unroll
                for (int jq = 0; jq < 4; ++jq) mx = fmaxf(mx, fmaxf(fmaxf(fabsf(v[q][jq].x), fabsf(v[q][jq].y)), fmaxf(fabsf(v[q][jq].z), fabsf(v[q][jq].w))));
#pragma unroll
                for (int o = 1; o < 64; o <<= 1) mx = fmaxf(mx, __shfl_xor(mx, o));
                const float sc = mx > 0.f ? mx * (1.f / 127.f) : 1.f, inv = 1.f / sc;
                unsigned* dst = (unsigned*)((which ? V8 : U8) + (size_t)row * D) + lane;
#pragma unroll
                for (int jq = 0; jq < 4; ++jq) { const int q0 = (int)rintf(v[q][jq].x * inv), q1 = (int)rintf(v[q][jq].y * inv), q2 = (int)rintf(v[q][jq].z * inv), q3 = (int)rintf(v[q][jq].w * inv);
                    dst[64 * jq] = (unsigned)(q0 & 255) | ((unsigned)(q1 & 255) << 8) | ((unsigned)(q2 & 255) << 16) | ((unsigned)(q3 & 255) << 24); }
                if (lane == 0) (which ? SV : SU)[row] = sc; }
        }
    }
    GRID_BAR();
    if (IN(3)) {
        PHASE_VARS();
        for (int u = bid; u < 512; u += nb) {
            if (u < 256) attn_unit(a.attn_sinks, a.attn_out_g, ldsb, u, PROJ, XNB, tid, lane, wave);
            else ssd_chunk_unit(ldsb, u - 256, PROJ, XACT, DTRAW, a.conv_w, a.conv_b, a.dt_bias, a.a_log, ACS, CDEC, MIXF, STATES, tid, lane, wave);
        }
    }
    GRID_BAR();
    if (IN(5)) {
        PHASE_VARS();
        for (int idx = gtid; idx < 2 * 8 * 8192; idx += gthreads) {
            const int pn = idx & 8191, h = (idx >> 13) & 7, b = idx >> 16;
            float run = 0.f;
#pragma unroll 1
            for (int c0 = 0; c0 < 64; c0 += 8) {
                float st[8], dc[8];
#pragma unroll
                for (int j = 0; j < 8; ++j) { const int bch = (b * 64 + c0 + j) * 8 + h; st[j] = STATES[(size_t)bch * 8192 + pn]; dc[j] = CDEC[bch]; }
#pragma unroll
                for (int j = 0; j < 8; ++j) { const int bch = (b * 64 + c0 + j) * 8 + h; PREVT[(size_t)bch * 8192 + pn] = f2bf(run); run = dc[j] * run + st[j]; }
            }
        }
    }
    GRID_BAR();
    if (IN(6)) {
        PHASE_VARS();
        for (int u = bid; u < 256; u += nb) yoff_unit(a.d_skip, a.ssm_norm_g, ldsb, u, XACT, PROJ, ACS, PREVT, MIXF, XNB, lane, wave);
    }
    GRID_BAR();
    if (IN(7)) {
        PHASE_VARS();
        pg8::Gemm g{XNB, WOT, T, D, D}; pg8::StaticOrder S; S.init(T, D, nb, bid);
        pg8::EpiBf16Resid E{HB, a.x, D};
        pg8::gemm_phase<pg8::EpiBf16Resid, pg8::StaticOrder>(ldsb, g, S, E, nullptr);
    }
    GRID_BAR();
    if (IN(8)) {
        PHASE_VARS();
        rmsnorm_rows_bf16<2>((const float*)HB, a.norm_ffn_g, XNB, ldsb, nullptr, XQ, XS, gwave, nwaves, lane);
    }
    GRID_BAR();
    if (IN(9)) {
        PHASE_VARS();
        pg8::Gemm g{XNB, WQT, T, D, D}; pg8::StaticOrder S; S.init(T, D, nb, bid);
        pg8::EpiF32Resid E{QP, nullptr, D};
        pg8::gemm_phase<pg8::EpiF32Resid, pg8::StaticOrder>(ldsb, g, S, E, nullptr);
    }
    GRID_BAR();
    if (IN(10)) {
        PHASE_VARS();
        LAS bf16* KHL = (LAS bf16*)ldsb;
        for (int i = tid; i < 2 * 2 * 128 * 8; i += NTHR) {
            const int pc = i & 7, key = (i >> 3) & 127, hf = (i >> 10) & 1, hl = i >> 11;
            *(LAS v4u*)(KHL + ((hl * 2 + hf) * 128 + key) * 72 + pc * 8) = *(const v4u*)((hl ? KL : KH) + (size_t)(hf * 128 + key) * 64 + pc * 8);
        }
        __syncthreads();
        for (int task = gwave; task < T / 4; task += nwaves) route_task(task, QP, KHL, IDX, GATE, lane);
        __syncthreads();
    }
    GRID_BAR();
    unsigned char* ACTQ = ws + WS_ACT; float* ACTS = (float*)(ws + WS_ACT + 4 * MiB); bf16* PEERO = (bf16*)(ws + WS_PEERO);
    unsigned* ctl = (unsigned*)ws;
    const int xcc = (int)(bar.x & 7u);
    if (IN(12)) {
        PHASE_VARS();
#pragma unroll 1
        for (int pi = 0; pi < NPART; ++pi) {
            const int p = (xcc + pi) & 7;
            for (;;) {
                if (tid == 0) MISC[16] = xb_add(&ctl[CW_QU + 64 * p], 1u);
                __syncthreads();
                const int j = (int)MISC[16];
                __syncthreads();
                if (j >= NCHUNK) break;
                peer_u_item(p, j, IDX, XQ, U8, PART, lane, wave);
            }
        }
    }
    GRID_BAR();
    if (IN(12)) {
        PHASE_VARS();
        for (int t = gwave; t < T; t += nwaves) {
            float av[2];
#pragma unroll
            for (int hh = 0; hh < 2; ++hh) {
                const int i = t * 128 + hh * 64 + lane;
                float sf = 0.f;
#pragma unroll
                for (int pp = 0; pp < NPART; ++pp) sf += bf2f(PART[(size_t)pp * T * 128 + i]);
                const int e = IDX[i]; const float z = sf * SU[e] * XS[t];
                av[hh] = GATE[i] * 0.5f * z * (1.f + erff(z * 0.70710678118654752f)) * SV[e];
            }
            float mx = fmaxf(fabsf(av[0]), fabsf(av[1]));
#pragma unroll
            for (int o = 1; o < 64; o <<= 1) mx = fmaxf(mx, __shfl_xor(mx, o));
            const float sc = mx > 0.f ? mx * (1.f / 127.f) : 1.f, inv = 1.f / sc;
            ACTQ[(size_t)t * 128 + lane] = (unsigned char)((int)rintf(av[0] * inv) & 255); ACTQ[(size_t)t * 128 + 64 + lane] = (unsigned char)((int)rintf(av[1] * inv) & 255);
            if (lane == 0) ACTS[t] = sc;
        }
    }
    GRID_BAR();
    if (IN(13)) {
        PHASE_VARS();
#pragma unroll 1
        for (int pi = 0; pi < NPART; ++pi) {
            const int p = (xcc + pi) & 7;
            for (;;) {
                if (tid == 0) MISC[16] = xb_add(&ctl[CW_QV + 64 * p], 1u);
                __syncthreads();
                const int j = (int)MISC[16];
                __syncthreads();
                if (j >= NCHUNK) break;
                peer_v_item(p, j, IDX, ACTQ, ACTS, V8, PEERO, lane, wave);
            }
        }
    }
    GRID_BAR();
    if (IN(14)) {
        PHASE_VARS();
        for (int t = gwave; t < T; t += nwaves) {
            const uint2* hr = (const uint2*)(HB + (size_t)t * D) + lane; const uint2* pr = (const uint2*)(PEERO + (size_t)t * D) + lane;
            float4 v[4]; float ss = 0.f;
#pragma unroll
            for (int jq = 0; jq < 4; ++jq) { const uint2 hw = hr[64 * jq]; const float4 h4 = make_float4(__uint_as_float(hw.x << 16), __uint_as_float(hw.x & 0xffff0000u), __uint_as_float(hw.y << 16), __uint_as_float(hw.y & 0xffff0000u)); const uint2 pw = pr[64 * jq]; v[jq] = make_float4(h4.x + __uint_as_float(pw.x << 16), h4.y + __uint_as_float(pw.x & 0xffff0000u), h4.z + __uint_as_float(pw.y << 16), h4.w + __uint_as_float(pw.y & 0xffff0000u)); ss += v[jq].x * v[jq].x + v[jq].y * v[jq].y + v[jq].z * v[jq].z + v[jq].w * v[jq].w; }
            ss = wave_sum(ss);
            const float r3 = rsqrtf(ss * (1.f / D) + EPS);
            float4* op = (float4*)(a.out + (size_t)t * D) + lane;
#pragma unroll
            for (int jq = 0; jq < 4; ++jq) { const float4 gv = ((const float4*)a.final_norm_g)[lane + 64 * jq]; op[64 * jq] = make_float4(v[jq].x * r3 * gv.x, v[jq].y * r3 * gv.y, v[jq].z * r3 * gv.z, v[jq].w * r3 * gv.w); }
        }
    }
    PROBE_SPIN();
#undef IN
}
}

extern "C" void kernel_launch(void* const* d_in, const int* in_sizes, int n_in, void* d_out, int out_size, void* d_ws, size_t ws_size, hipStream_t stream) {
    if (n_in != 18 || out_size != T * D || ws_size < WS_END) { fprintf(stderr, "kernel_launch: unexpected shapes n_in=%d out=%d ws=%zu\n", n_in, out_size, ws_size); return; }
    Args a{};
    const float** ap = (const float**)&a;
    for (int i = 0; i < 18; ++i) ap[i] = (const float*)d_in[i];
    a.out = (float*)d_out; a.ws = (unsigned char*)d_ws;
    static int grid = 0;
    if (grid == 0) {
        int dev = 0, cus = 0, per_cu = 0;
        if (hipGetDevice(&dev) != hipSuccess || hipDeviceGetAttribute(&cus, hipDeviceAttributeMultiprocessorCount, dev) != hipSuccess) { fprintf(stderr, "kernel_launch: device query failed\n"); grid = -1; return; }
        if (hipFuncSetAttribute((const void*)k_main, hipFuncAttributeMaxDynamicSharedMemorySize, LDS_BYTES) != hipSuccess) { fprintf(stderr, "kernel_launch: hipFuncSetAttribute failed\n"); grid = -1; return; }
        if (hipOccupancyMaxActiveBlocksPerMultiprocessor(&per_cu, (const void*)k_main, NTHR, LDS_BYTES) != hipSuccess || per_cu < 1) { fprintf(stderr, "kernel_launch: occupancy query says %d blocks/CU\n", per_cu); (void)hipGetLastError(); grid = -1; return; }
        grid = cus;
    }
    if (grid < 0) return;
    if (hipMemsetAsync(d_ws, 0, 65536, stream) != hipSuccess) { fprintf(stderr, "kernel_launch: memset failed\n"); return; }
    a.ph_lo = 0; a.ph_hi = 15;
    hipLaunchKernelGGL(k_main, dim3(grid), dim3(NTHR), LDS_BYTES, stream, a);
}
```

```cpp
#include <hip/hip_runtime.h>
#include <cstdio>
#include <cstdint>


namespace pg8 {
#define PG8_LAS __attribute__((address_space(3)))
typedef unsigned short bf16_t;
typedef short bf16x8 __attribute__((ext_vector_type(8)));
typedef float f32x4 __attribute__((ext_vector_type(4)));
typedef unsigned u32x4 __attribute__((ext_vector_type(4)));
constexpr int BM = 256, BK = 64, HALF = 128, HTB = HALF * BK * 2  , STAGE_BYTES = 8 * HTB, NXCD = 8, WGM = 8;

__host__ __device__ __forceinline__ int lds_byte(int r, int c) { const int st = (r >> 4) * 2 + (c >> 5), rr = r & 15, cc = c & 31, ob = rr * 64 + cc * 2; return st * 1024 + (ob ^ (((ob >> 9) & 1) << 5)); }
__host__ __device__ __forceinline__ void stage_rc(int b, int& R, int& C) { const int st = b / 1024, sb = b % 1024, swz = sb ^ (((sb >> 9) & 1) << 5); R = (st >> 1) * 16 + swz / 64; C = (st & 1) * 32 + (swz % 64) / 2; }
__host__ __device__ __forceinline__ int perm32(int rho) { const int n = rho >> 4, i = rho & 15; return 8 * (i >> 2) + 4 * n + (i & 3); }

struct Unit { int pm, pn; };
struct Gemm { const bf16_t* A; const bf16_t* Bt; int M, N, K; };

struct StaticOrder {
    int nM, nN, nwg, G, c;
    __host__ __device__ void init(int M, int N, int G_, int c_) { nM = M / BM; nN = N / BM; nwg = nM * nN; G = G_; c = c_; }
    __host__ __device__ bool next(int i, Unit& u) const {
        const long L = (long)i * G + c; if (L >= nwg) return false;
        int wgid = (int)L; { const int q = nwg / NXCD, r = nwg % NXCD, xcd = wgid % NXCD, off = wgid / NXCD; wgid = (xcd < r ? xcd * (q + 1) : r * (q + 1) + (xcd - r) * q) + off; }
        const int nig = WGM * nN, gid = wgid / nig, fm = gid * WGM, gsz = (nM - fm) < WGM ? (nM - fm) : WGM;
        u.pm = fm + ((wgid % nig) % gsz); u.pn = (wgid % nig) / gsz; return true;
    }
    __device__ __forceinline__ void a_ready(const Unit&) const {}
    __device__ __forceinline__ void done(const Unit&) const {}
};
__device__ __forceinline__ unsigned cvt_pk_bf16(float lo, float hi) { unsigned r; asm volatile("v_cvt_pk_bf16_f32 %0, %1, %2" : "=v"(r) : "v"(lo), "v"(hi)); return r; }
typedef float f32x2 __attribute__((ext_vector_type(2)));
struct EpiBf16Plain {
    static constexpr bool PERM = true, AFTER_DRAIN = false;
    bf16_t* O; int ldc;
    __device__ __forceinline__ void operator()(const f32x4 (&acc)[2][2][4][2], const Unit& u, int wr, int wc, int fr, int fq) const {
        const int row0 = u.pm * BM + wr * 64 + fr, col0 = u.pn * BM + wc * 32 + 8 * fq;
#pragma unroll
        for (int ai = 0; ai < 2; ++ai)
#pragma unroll
            for (int m = 0; m < 4; ++m) { bf16_t* rowp = O + (size_t)(row0 + ai * HALF + m * 16) * ldc + col0;
#pragma unroll
                for (int bj = 0; bj < 2; ++bj) { const f32x4 v0 = acc[ai][bj][m][0], v1 = acc[ai][bj][m][1];
                    u32x4 w; w.x = cvt_pk_bf16(v0[0], v0[1]); w.y = cvt_pk_bf16(v0[2], v0[3]); w.z = cvt_pk_bf16(v1[0], v1[1]); w.w = cvt_pk_bf16(v1[2], v1[3]);
                    *(u32x4*)(rowp + bj * HALF) = w; } }
    }
};
struct EpiF32Resid {
    static constexpr bool PERM = false, AFTER_DRAIN = false;
    float* C; const float* R; int ldc;
    __device__ __forceinline__ void operator()(const f32x4 (&acc)[2][2][4][2], const Unit& u, int wr, int wc, int fr, int fq) const {
        const int row0 = u.pm * BM + wr * 64 + fr, col0 = u.pn * BM + wc * 32 + 4 * fq;
#pragma unroll
        for (int ai = 0; ai < 2; ++ai)
#pragma unroll
            for (int m = 0; m < 4; ++m) { const size_t off = (size_t)(row0 + ai * HALF + m * 16) * ldc + col0;
#pragma unroll
                for (int bj = 0; bj < 2; ++bj)
#pragma unroll
                    for (int n = 0; n < 2; ++n) { f32x4 v = acc[ai][bj][m][n]; if (R) v += *(const f32x4*)(R + off + bj * HALF + n * 16); *(f32x4*)(C + off + bj * HALF + n * 16) = v; }
                asm volatile("" ::: "memory"); }
    }
};

struct EpiBf16Resid {
    static constexpr bool PERM = true, AFTER_DRAIN = false;
    bf16_t* O; const float* R; int ldc;
    __device__ __forceinline__ void operator()(const f32x4 (&acc)[2][2][4][2], const Unit& u, int wr, int wc, int fr, int fq) const {
        const int row0 = u.pm * BM + wr * 64 + fr, col0 = u.pn * BM + wc * 32 + 8 * fq;
#pragma unroll
        for (int ai = 0; ai < 2; ++ai)
#pragma unroll
            for (int m = 0; m < 4; ++m) { const size_t off = (size_t)(row0 + ai * HALF + m * 16) * ldc + col0;
#pragma unroll
                for (int bj = 0; bj < 2; ++bj) { const f32x4 v0 = acc[ai][bj][m][0] + *(const f32x4*)(R + off + bj * HALF), v1 = acc[ai][bj][m][1] + *(const f32x4*)(R + off + bj * HALF + 4);
                    u32x4 w; w.x = cvt_pk_bf16(v0[0], v0[1]); w.y = cvt_pk_bf16(v0[2], v0[3]); w.z = cvt_pk_bf16(v1[0], v1[1]); w.w = cvt_pk_bf16(v1[2], v1[3]);
                    *(u32x4*)(O + off + bj * HALF) = w; }
                asm volatile("" ::: "memory"); }
    }
};
template <class Epi, class Sched, bool STAMP = false>
__device__ __forceinline__ void gemm_phase(PG8_LAS unsigned char* lds, const Gemm g, const Sched& S, const Epi& E, unsigned long long* stamps) {
    const int tid = threadIdx.x, wid = __builtin_amdgcn_readfirstlane(tid >> 6), lane = tid & 63, wr = wid >> 2, wc = wid & 3, fr = lane & 15, fq = lane >> 4;
    const int K = g.K, nt = K / BK;
    int ts_lo = 0, ts_hi = 0, nts = 0; const unsigned long long rt_entry = STAMP ? (unsigned long long)0ull : 0ull;
#define PG8_STAMP() do { if (STAMP && wid == 0 && nts < 64) { const unsigned long long _c = (unsigned long long)clock64(); \
        ts_lo = (lane == nts) ? (int)(unsigned)_c : ts_lo; ts_hi = (lane == nts) ? (int)(unsigned)(_c >> 32) : ts_hi; ++nts; } } while (0)
    PG8_STAMP();
    unsigned voffA[2], voffB[2];
#pragma unroll
    for (int i = 0; i < 2; ++i) { int R, C; stage_rc(tid * 16 + i * 8192, R, C); const int Rb = Epi::PERM ? ((R & ~31) + perm32(R & 31)) : R;
        voffA[i] = (unsigned)(R * K + C) * 2u; voffB[i] = (unsigned)(Rb * K + C) * 2u; }
    const size_t kstep = (size_t)(BK * 2);
    const size_t hstep = (size_t)HALF * K * 2;
    const size_t tstep = 2 * hstep;
    const unsigned ldsw = (unsigned)wid * 1024u;
    const int aoff = lds_byte(wr * 64 + fr, fq * 8), boff = lds_byte(wc * 32 + fr, fq * 8);
#define PG8_SA(b, h) (((b) * 2 + (h)) * HTB)
#define PG8_SB(b, h) ((4 + (b) * 2 + (h)) * HTB)
#define PG8_STAGE(bufoff, gbase, voff) do { _Pragma("unroll") for (int _i = 0; _i < 2; ++_i) \
        __builtin_amdgcn_global_load_lds((const unsigned*)((const char*)(gbase) + (voff)[_i]), (PG8_LAS unsigned*)(lds + (bufoff) + ldsw + _i * 8192), 16, 0, 0); } while (0)
#define PG8_LDA(dst, b, h) do { _Pragma("unroll") for (int m = 0; m < 4; ++m) _Pragma("unroll") for (int k = 0; k < 2; ++k) dst[m][k] = *(const PG8_LAS bf16x8*)(lds + PG8_SA(b, h) + aoff + m * 2048 + k * 1024); } while (0)
#define PG8_LDB(dst, b, h) do { _Pragma("unroll") for (int n = 0; n < 2; ++n) _Pragma("unroll") for (int k = 0; k < 2; ++k) dst[n][k] = *(const PG8_LAS bf16x8*)(lds + PG8_SB(b, h) + boff + n * 2048 + k * 1024); } while (0)
#define PG8_MMA(ai, bj, At, Bt) do { __builtin_amdgcn_s_setprio(1); _Pragma("unroll") for (int m = 0; m < 4; ++m) _Pragma("unroll") for (int n = 0; n < 2; ++n) _Pragma("unroll") for (int k = 0; k < 2; ++k) \
        acc[ai][bj][m][n] = __builtin_amdgcn_mfma_f32_16x16x32_bf16(Bt[n][k], At[m][k], acc[ai][bj][m][n], 0, 0, 0); __builtin_amdgcn_s_setprio(0); } while (0)
#define PG8_WAIT_V(n) asm volatile("s_waitcnt vmcnt(" #n ")" ::: "memory")
#define PG8_WAIT_L(n) asm volatile("s_waitcnt lgkmcnt(" #n ")" ::: "memory")
#define PG8_BAR __builtin_amdgcn_s_barrier()
#define PG8_SCHED __builtin_amdgcn_sched_barrier(0)
    Unit cur, nxt; int ui = 0;
    if (!S.next(0, cur)) return;
    f32x4 acc[2][2][4][2];
#pragma unroll
    for (int a = 0; a < 2; ++a)
#pragma unroll
        for (int b = 0; b < 2; ++b)
#pragma unroll
            for (int m = 0; m < 4; ++m)
#pragma unroll
                for (int n = 0; n < 2; ++n) acc[a][b][m][n] = (f32x4){0.f, 0.f, 0.f, 0.f};
    bf16x8 At[4][2], B0[2][2], B1[2][2];
    const char* cA = (const char*)g.A + (size_t)cur.pm * tstep; const char* cB = (const char*)g.Bt + (size_t)cur.pn * tstep;
    S.a_ready(cur);
    PG8_STAGE(PG8_SB(0, 0), cB, voffB); PG8_STAGE(PG8_SA(0, 0), cA, voffA); PG8_STAGE(PG8_SB(0, 1), cB + hstep, voffB); PG8_STAGE(PG8_SA(0, 1), cA + hstep, voffA);
    if (wr == 1) PG8_BAR;
    PG8_WAIT_V(4); PG8_BAR;
    PG8_STAGE(PG8_SB(1, 0), cB + kstep, voffB); PG8_STAGE(PG8_SA(1, 0), cA + kstep, voffA); PG8_STAGE(PG8_SB(1, 1), cB + hstep + kstep, voffB);
    PG8_WAIT_V(6); PG8_BAR;
    PG8_STAMP();
    for (;;) {
        const bool has_next = S.next(ui + 1, nxt);
        const char* nA = has_next ? (const char*)g.A + (size_t)nxt.pm * tstep : cA; const char* nB = has_next ? (const char*)g.Bt + (size_t)nxt.pn * tstep : cB;
        for (int t = 0; t < nt; t += 2) {
            const bool last = (t == nt - 2);
            const char* a1 = cA + (size_t)(t + 1) * kstep;
            const char* a2 = last ? nA : cA + (size_t)(t + 2) * kstep; const char* b2 = last ? nB : cB + (size_t)(t + 2) * kstep;
            const char* a3 = a2 + kstep; const char* b3 = b2 + kstep;
            if (last && has_next) S.a_ready(nxt);
            PG8_LDB(B0, 0, 0); PG8_SCHED; PG8_LDA(At, 0, 0); PG8_STAGE(PG8_SA(1, 1), a1 + hstep, voffA);
            PG8_WAIT_L(8); PG8_BAR; PG8_WAIT_L(0); PG8_MMA(0, 0, At, B0); PG8_BAR; PG8_SCHED;
            PG8_LDB(B1, 0, 1); PG8_STAGE(PG8_SB(0, 0), b2, voffB);
            PG8_BAR; PG8_WAIT_L(0); PG8_MMA(0, 1, At, B1); PG8_BAR;
            PG8_LDA(At, 0, 1); PG8_STAGE(PG8_SA(0, 0), a2, voffA);
            PG8_BAR; PG8_WAIT_L(0); PG8_MMA(1, 0, At, B0); PG8_BAR; PG8_SCHED;
            PG8_STAGE(PG8_SB(0, 1), b2 + hstep, voffB);
            PG8_WAIT_V(6); PG8_BAR; PG8_MMA(1, 1, At, B1); PG8_BAR;
            PG8_LDB(B0, 1, 0); PG8_SCHED; PG8_LDA(At, 1, 0); PG8_STAGE(PG8_SA(0, 1), a2 + hstep, voffA);
            PG8_WAIT_L(8); PG8_BAR; PG8_WAIT_L(0); PG8_MMA(0, 0, At, B0); PG8_BAR; PG8_SCHED;
            PG8_LDB(B1, 1, 1); PG8_STAGE(PG8_SB(1, 0), b3, voffB);
            PG8_BAR; PG8_WAIT_L(0); PG8_MMA(0, 1, At, B1); PG8_BAR;
            PG8_LDA(At, 1, 1); PG8_STAGE(PG8_SA(1, 0), a3, voffA);
            PG8_BAR; PG8_WAIT_L(0); PG8_MMA(1, 0, At, B0); PG8_BAR; PG8_SCHED;
            PG8_STAGE(PG8_SB(1, 1), b3 + hstep, voffB);
            PG8_WAIT_V(6); PG8_BAR; PG8_MMA(1, 1, At, B1); PG8_BAR;
        }
        PG8_STAMP();
        if constexpr (!Epi::AFTER_DRAIN) { E(acc, cur, wr, wc, fr, fq); S.done(cur); }
        PG8_STAMP();
        if (!has_next) break;
#pragma unroll
        for (int a = 0; a < 2; ++a)
#pragma unroll
            for (int b = 0; b < 2; ++b)
#pragma unroll
                for (int m = 0; m < 4; ++m)
#pragma unroll
                    for (int n = 0; n < 2; ++n) acc[a][b][m][n] = (f32x4){0.f, 0.f, 0.f, 0.f};
        cur = nxt; cA = nA; cB = nB; ++ui;
    }
    PG8_WAIT_V(0);
    if (wr == 0) PG8_BAR;
    PG8_BAR;
    if constexpr (Epi::AFTER_DRAIN) { E.fused(acc, cur, wr, wc, fr, fq, lds, wid, lane); S.done(cur); }
    PG8_STAMP();
    if (STAMP && wid == 0) { stamps[lane] = lane < nts ? (((unsigned long long)(unsigned)ts_hi << 32) | (unsigned)ts_lo) : 0ull;
        if (lane == 62) stamps[62] = rt_entry; if (lane == 63) stamps[63] = (unsigned long long)0ull; }
#undef PG8_STAMP
#undef PG8_SA
#undef PG8_SB
#undef PG8_STAGE
#undef PG8_LDA
#undef PG8_LDB
#undef PG8_MMA
#undef PG8_WAIT_V
#undef PG8_WAIT_L
#undef PG8_BAR
#undef PG8_SCHED
}
}

namespace {
constexpr int D = 1024, BATCH = 2, SEQ = 8192, T = BATCH * SEQ;
constexpr int PW = 2312;
constexpr int PS = 2304;
constexpr int OQ = 0, OKK = 512, OV = 640, OZ = 768, OXBC = 1280, ODT = 2304;
constexpr float EPS = 1e-6f;
constexpr int NTHR = 512;
typedef unsigned short bf16;
typedef unsigned v4u __attribute__((ext_vector_type(4)));

constexpr size_t MiB = 1u << 20;
constexpr size_t WS_WIN = 1 * MiB;
constexpr size_t WS_KH = 5 * MiB + 512 * 1024;
constexpr size_t WS_WO = 6 * MiB;
constexpr size_t WS_WQ = 8 * MiB;
constexpr size_t WS_PROJ = 10 * MiB;
constexpr size_t WS_XNB = 82 * MiB;
constexpr size_t WS_XACT = 114 * MiB;
constexpr size_t WS_DTRAW = 146 * MiB;
constexpr size_t WS_DT = WS_DTRAW + 512 * 1024;
constexpr size_t WS_ACS = WS_DT + 512 * 1024;
constexpr size_t WS_CDEC = WS_ACS + 512 * 1024;
constexpr size_t WS_STATES = 164 * MiB;
constexpr size_t WS_PREV = 196 * MiB;
constexpr size_t WS_QP = 10 * MiB;
constexpr size_t WS_IDX = 74 * MiB;
constexpr size_t WS_GATE = 114 * MiB;
constexpr size_t WS_TOPV = 122 * MiB;
constexpr size_t WS_TOPI = 138 * MiB;
constexpr size_t WS_ACT = 122 * MiB;
constexpr size_t WS_SU = 245 * MiB;
constexpr size_t WS_U8 = 212 * MiB;
constexpr size_t WS_V8 = 148 * MiB;
constexpr size_t WS_PART = 10 * MiB;
constexpr size_t WS_XQ = 228 * MiB;
constexpr size_t WS_XS = 244 * MiB;
constexpr size_t WS_PEERO = 10 * MiB;
constexpr size_t WS_END = 246 * MiB;
constexpr int CW_QU = 4096, CW_QV = 4096 + 64 * 16;
constexpr int NPART = 8, NCHUNK = T / 64;

struct Args {
    const float* x; const float* norm_mix_g; const float* w_in; const float* attn_sinks; const float* attn_out_g;
    const float* conv_w; const float* conv_b; const float* dt_bias; const float* a_log; const float* d_skip;
    const float* ssm_norm_g; const float* w_out; const float* norm_ffn_g; const float* peer_wq; const float* peer_sub_keys;
    const float* peer_u; const float* peer_v; const float* final_norm_g;
    float* out; unsigned char* ws;
    int ph_lo, ph_hi;
};

#define LAS __attribute__((address_space(3)))
#define LDS_WAIT() asm volatile("s_waitcnt lgkmcnt(0)" ::: "memory")
__device__ __forceinline__ float bf2f(bf16 v) { return __uint_as_float(((unsigned)v) << 16); }
__device__ __forceinline__ unsigned f2bfu(float f) { unsigned u = __float_as_uint(f); return (u + 0x7fffu + ((u >> 16) & 1u)) >> 16; }
__device__ __forceinline__ bf16 f2bf(float f) { return (bf16)f2bfu(f); }
__device__ __forceinline__ unsigned pk2(float lo, float hi) { return f2bfu(lo) | (f2bfu(hi) << 16); }
__device__ __forceinline__ float wave_sum(float v) {
#pragma unroll
    for (int o = 1; o < 64; o <<= 1) v += __shfl_xor(v, o);
    return v;
}
__device__ __forceinline__ float silu_f(float v) { return v / (1.f + __expf(-v)); }

__device__ __forceinline__ void transpose_item(const float* W, int ldw, int K, bf16* WT, LAS float* scr, int kb, int nbk, int lane) {
    const int k0 = 64 * kb, n0 = 32 * nbk;
#pragma unroll 8
    for (int i = 0; i < 32; ++i) { const int kk = 2 * i + (lane >> 5); scr[kk * 33 + (lane & 31)] = W[(size_t)(k0 + kk) * ldw + n0 + (lane & 31)]; }
    LDS_WAIT();
    const int c = lane & 7;
#pragma unroll
    for (int j = 0; j < 4; ++j) { const int n = (lane >> 3) + 8 * j; const LAS float* s = scr + (8 * c) * 33 + n;
        v4u o; o.x = pk2(s[0 * 33], s[1 * 33]); o.y = pk2(s[2 * 33], s[3 * 33]); o.z = pk2(s[4 * 33], s[5 * 33]); o.w = pk2(s[6 * 33], s[7 * 33]);
        *(v4u*)(WT + (size_t)(n0 + n) * K + k0 + 8 * c) = o; }
    LDS_WAIT();
}

template <int MODE  >
__device__ __forceinline__ void rmsnorm_rows_bf16(const float* __restrict__ in, const float* __restrict__ g, bf16* __restrict__ outp, const LAS unsigned char* ldsb, float* __restrict__ dtraw, unsigned char* __restrict__ xq, float* __restrict__ xs, int gwave, int nwaves, int lane) {
#pragma unroll 2
    for (int row = gwave; row < T; row += nwaves) {
        const float4* xr = (const float4*)(in + (size_t)row * D) + lane; const uint2* xb = (const uint2*)((const bf16*)in + (size_t)row * D) + lane;
        float4 v[4]; float ss = 0.f;
#pragma unroll
        for (int j = 0; j < 4; ++j) {
            if (MODE == 2) { const uint2 w = xb[64 * j]; v[j] = make_float4(__uint_as_float(w.x << 16), __uint_as_float(w.x & 0xffff0000u), __uint_as_float(w.y << 16), __uint_as_float(w.y & 0xffff0000u)); }
            else v[j] = xr[64 * j];
            ss += v[j].x * v[j].x + v[j].y * v[j].y + v[j].z * v[j].z + v[j].w * v[j].w; }
        ss = wave_sum(ss);
        const float r = rsqrtf(ss * (1.f / D) + EPS);
        unsigned long long* o8 = (unsigned long long*)(outp + (size_t)row * D) + lane;
        float dacc[8]; float y[4][4]; float mx = 0.f;
#pragma unroll
        for (int h = 0; h < 8; ++h) dacc[h] = 0.f;
#pragma unroll
        for (int j = 0; j < 4; ++j) {
            const float4 gv = ((const float4*)g)[lane + 64 * j];
            y[j][0] = v[j].x * r * gv.x; y[j][1] = v[j].y * r * gv.y; y[j][2] = v[j].z * r * gv.z; y[j][3] = v[j].w * r * gv.w;
            o8[64 * j] = (unsigned long long)pk2(y[j][0], y[j][1]) | ((unsigned long long)pk2(y[j][2], y[j][3]) << 32);
            if (MODE == 2) mx = fmaxf(mx, fmaxf(fmaxf(fabsf(y[j][0]), fabsf(y[j][1])), fmaxf(fabsf(y[j][2]), fabsf(y[j][3]))));
            if (MODE == 1) {
#pragma unroll
                for (int h = 0; h < 8; ++h) {
                    typedef float f4v __attribute__((ext_vector_type(4)));
                    const f4v wv = *(const LAS f4v*)(ldsb + h * 16384 + 8448 + (256 * j + 4 * lane) * 4);
                    dacc[h] += y[j][0] * wv.x + y[j][1] * wv.y + y[j][2] * wv.z + y[j][3] * wv.w;
                }
            }
        }
        if (MODE == 1) {
#pragma unroll
            for (int h = 0; h < 8; ++h) dacc[h] = wave_sum(dacc[h]);
            if (lane == 0) { float4* dp = (float4*)(dtraw + (size_t)row * 8); dp[0] = make_float4(dacc[0], dacc[1], dacc[2], dacc[3]); dp[1] = make_float4(dacc[4], dacc[5], dacc[6], dacc[7]); }
        }
        if (MODE == 2) {
#pragma unroll
            for (int o = 1; o < 64; o <<= 1) mx = fmaxf(mx, __shfl_xor(mx, o));
            const float sc = mx > 0.f ? mx * (1.f / 127.f) : 1.f, inv = 1.f / sc;
            unsigned* dq = (unsigned*)(xq + (size_t)row * D) + lane;
#pragma unroll
            for (int j = 0; j < 4; ++j) { const int q0 = (int)rintf(y[j][0] * inv), q1 = (int)rintf(y[j][1] * inv), q2 = (int)rintf(y[j][2] * inv), q3 = (int)rintf(y[j][3] * inv);
                dq[64 * j] = (unsigned)(q0 & 255) | ((unsigned)(q1 & 255) << 8) | ((unsigned)(q2 & 255) << 16) | ((unsigned)(q3 & 255) << 24); }
            if (lane == 0) xs[row] = sc;
        }
    }
}

typedef short bf16x8 __attribute__((ext_vector_type(8)));
typedef short bf16x4 __attribute__((ext_vector_type(4)));
typedef float f32x16 __attribute__((ext_vector_type(16)));
typedef __bf16 bf2_t __attribute__((ext_vector_type(2)));
#define MFMA32(a, b, c) __builtin_amdgcn_mfma_f32_32x32x16_bf16((a), (b), (c), 0, 0, 0)
__device__ __forceinline__ unsigned pkbf(float lo, float hi) { bf2_t v = {(__bf16)lo, (__bf16)hi}; return __builtin_bit_cast(unsigned, v); }
__device__ __forceinline__ short bfs(float f) { return __builtin_bit_cast(short, (__bf16)f); }
__device__ __forceinline__ float sbf2f(short v) { return __uint_as_float(((unsigned)(unsigned short)v) << 16); }
__device__ __forceinline__ int crow(int i, int hi) { return (i & 3) + 8 * (i >> 2) + 4 * hi; }
template <int S> __device__ __forceinline__ bf16x8 pack8(const f32x16& x) {
    v4u p; p.x = pkbf(x[8 * S], x[8 * S + 1]); p.y = pkbf(x[8 * S + 2], x[8 * S + 3]); p.z = pkbf(x[8 * S + 4], x[8 * S + 5]); p.w = pkbf(x[8 * S + 6], x[8 * S + 7]);
    return __builtin_bit_cast(bf16x8, p);
}
__device__ __forceinline__ bf16x8 ldg8(const bf16* p) { return *(const bf16x8*)p; }
__device__ __forceinline__ bf16x8 lds8(const LAS bf16* p) { return *(const LAS bf16x8*)p; }
__device__ __forceinline__ bf16x8 lds4x2(const LAS bf16* p) { const bf16x4 a = *(const LAS bf16x4*)p, b = *(const LAS bf16x4*)(p + 8); return __builtin_shufflevector(a, b, 0, 1, 2, 3, 4, 5, 6, 7); }
__device__ __forceinline__ f32x16 zero16() { f32x16 z;
#pragma unroll
    for (int i = 0; i < 16; ++i) z[i] = 0.f;
    return z; }

__device__ __forceinline__ void attn_unit(const float* sinks, const float* gnorm, LAS unsigned char* ldsb, int unit, const bf16* PROJ, bf16* MIXB, int tid, int lane, int wave) {
    asm volatile("" : "+v"(tid), "+v"(lane));
    const int tok0 = unit * 64, s0 = tok0 & (SEQ - 1), kbase = tok0 - 128;
    LAS bf16* VT = (LAS bf16*)ldsb;
    LAS bf16* KI = (LAS bf16*)(ldsb + 51200);
    LAS float* SSQ = (LAS float*)(ldsb + 51200 + 55296);
    const __amdgpu_buffer_rsrc_t rsP = __builtin_amdgcn_make_buffer_rsrc((void*)PROJ, 0, (unsigned)T * PS * 2u, 0x00020000);
#pragma unroll
    for (int i = 0; i < 6; ++i) {
        const int c = tid + 512 * i, kv = c / 1536, cc = c - kv * 1536, key = cc >> 3, d0 = (cc & 7) * 8; const bool valid = (s0 - 128 + key) >= 0;
        bf16x8 v, k;
#pragma unroll
        for (int e = 0; e < 8; ++e) { v[e] = 0; k[e] = 0; }
        if (valid) { const unsigned ro = (unsigned)(kbase + key) * (unsigned)PS + (unsigned)(kv * 64 + d0);
            v = __builtin_bit_cast(bf16x8, __builtin_amdgcn_raw_buffer_load_b128(rsP, (int)((ro + (unsigned)OV) * 2u), 0, 0));
            k = __builtin_bit_cast(bf16x8, __builtin_amdgcn_raw_buffer_load_b128(rsP, (int)((ro + (unsigned)OKK) * 2u), 0, 0)); }
#pragma unroll
        for (int e = 0; e < 8; ++e) VT[kv * 12800 + (d0 + e) * 200 + key] = (bf16)v[e];
        *(LAS bf16x8*)(KI + (kv * 192 + key) * 72 + d0) = k;
    }
    __syncthreads();
    const int r = lane & 31, hi = lane >> 5;
    const int hq = wave, hkv = wave >> 2;
    const float slope = exp2f(-(float)(hq + 1)), sink = sinks[hq];
#pragma unroll 1
    for (int qt = 0; qt < 2; ++qt) {
        const int tq = tok0 + 32 * qt + r;
        bf16x8 qf[4];
        { const bf16* qp = PROJ + (size_t)tq * PS + OQ + hq * 64 + 8 * hi; asm volatile("" : "+v"(qp));
#pragma unroll
          for (int ks = 0; ks < 4; ++ks) qf[ks] = ldg8(qp + 16 * ks); }
        const int ql = 32 * qt + r;
        float m = sink, lh = 0.f;
        f32x16 O0 = zero16(), O1 = zero16();
#pragma unroll 1
        for (int kt = 0; kt < 5; ++kt) {
            const LAS bf16* kp = KI + (hkv * 192 + 32 * (qt + kt) + r) * 72 + 8 * hi;
            f32x16 X = zero16();
#pragma unroll
            for (int ks = 0; ks < 4; ++ks) X = MFMA32(lds8(kp + 16 * ks), qf[ks], X);
            float tm = -1e30f;
#pragma unroll
            for (int i = 0; i < 16; ++i) {
                const int kl = 32 * (qt + kt) + crow(i, hi), dist = 128 + ql - kl;
                const bool valid = (dist >= 0) && (dist < 128) && ((s0 - 128 + kl) >= 0);
                const float lg = valid ? (X[i] * 0.125f - slope * (float)dist) : -1e30f;
                X[i] = lg; tm = fmaxf(tm, lg);
            }
            tm = fmaxf(tm, __shfl_xor(tm, 32));
            const float mn = fmaxf(m, tm), sc = __expf(m - mn);
            m = mn; lh *= sc;
#pragma unroll
            for (int i = 0; i < 16; ++i) { O0[i] *= sc; O1[i] *= sc; const float pe = __expf(X[i] - mn); X[i] = pe; lh += pe; }
            const LAS bf16* vp = VT + hkv * 12800 + r * 200 + 32 * (qt + kt) + 4 * hi;
            { const bf16x8 xs = pack8<0>(X); const bf16x8 a0 = lds4x2(vp), a1 = lds4x2(vp + 32 * 200); O0 = MFMA32(a0, xs, O0); O1 = MFMA32(a1, xs, O1); }
            { const bf16x8 xs = pack8<1>(X); const bf16x8 a0 = lds4x2(vp + 16), a1 = lds4x2(vp + 32 * 200 + 16); O0 = MFMA32(a0, xs, O0); O1 = MFMA32(a1, xs, O1); }
        }
        const float lsum = lh + __shfl_xor(lh, 32) + __expf(sink - m);
        const float iv = 1.f / lsum;
        float sq = 0.f;
#pragma unroll
        for (int i = 0; i < 16; ++i) sq += O0[i] * O0[i] + O1[i] * O1[i];
        sq *= iv * iv; sq += __shfl_xor(sq, 32);
        if (hi == 0) SSQ[hq * 32 + r] = sq;
        __syncthreads();
        float tot = 0.f;
#pragma unroll
        for (int h = 0; h < 8; ++h) tot += SSQ[h * 32 + r];
        const float sc = iv * rsqrtf(tot * (1.f / 512.f) + EPS);
        bf16* orow = MIXB + (size_t)tq * D + hq * 64 + 4 * hi;
#pragma unroll
        for (int q4 = 0; q4 < 4; ++q4) {
            const float4 g0 = *(const float4*)(gnorm + hq * 64 + 8 * q4 + 4 * hi), g1 = *(const float4*)(gnorm + hq * 64 + 32 + 8 * q4 + 4 * hi);
            uint2 w0, w1;
            w0.x = pkbf(O0[4 * q4] * sc * g0.x, O0[4 * q4 + 1] * sc * g0.y); w0.y = pkbf(O0[4 * q4 + 2] * sc * g0.z, O0[4 * q4 + 3] * sc * g0.w);
            w1.x = pkbf(O1[4 * q4] * sc * g1.x, O1[4 * q4 + 1] * sc * g1.y); w1.y = pkbf(O1[4 * q4 + 2] * sc * g1.z, O1[4 * q4 + 3] * sc * g1.w);
            *(uint2*)(orow + 8 * q4) = w0; *(uint2*)(orow + 32 + 8 * q4) = w1;
        }
        __syncthreads();
    }
}

__device__ __forceinline__ void ssd_chunk_unit(LAS unsigned char* ldsb, int unit, const bf16* PROJ, bf16* XACT, const float* DTRAW, const float* conv_w, const float* conv_b, const float* dt_bias, const float* a_log,
                                               float* ACS, float* CDEC, float* MIXF, float* STATES, int tid, int lane, int wave) {
    asm volatile("" : "+v"(tid), "+v"(lane));
    const int g = unit & 1, bc = unit >> 1, tok0 = bc * 128;
    LAS float* DTT = (LAS float*)(ldsb + 34816 * 3 + 2048);
    LAS float* WT = (LAS float*)(ldsb + 34816 * 3 + 4096);
    {
        const int cgi = tid & 63, t0 = tok0 + 16 * (tid >> 6);
        const int c0 = cgi < 32 ? g * 256 + cgi * 8 : (cgi < 48 ? 512 + g * 128 + (cgi - 32) * 8 : 768 + g * 128 + (cgi - 48) * 8);
        float w[4][8], bs[8];
#pragma unroll
        for (int k = 0; k < 4; ++k) { const float4 a0 = *(const float4*)(conv_w + k * 1024 + c0), a1 = *(const float4*)(conv_w + k * 1024 + c0 + 4);
            w[k][0] = a0.x; w[k][1] = a0.y; w[k][2] = a0.z; w[k][3] = a0.w; w[k][4] = a1.x; w[k][5] = a1.y; w[k][6] = a1.z; w[k][7] = a1.w; }
        { const float4 a0 = *(const float4*)(conv_b + c0), a1 = *(const float4*)(conv_b + c0 + 4); bs[0] = a0.x; bs[1] = a0.y; bs[2] = a0.z; bs[3] = a0.w; bs[4] = a1.x; bs[5] = a1.y; bs[6] = a1.z; bs[7] = a1.w; }
        const bool has_halo = (t0 & (SEQ - 1)) != 0;
        bf16x8 rows[19];
#pragma unroll
        for (int i = 0; i < 19; ++i) {
            if (i < 3 && !has_halo) {
#pragma unroll
                for (int e = 0; e < 8; ++e) rows[i][e] = 0;
            } else rows[i] = ldg8(PROJ + (size_t)(t0 + i - 3) * PS + OXBC + c0);
        }
#pragma unroll
        for (int i = 0; i < 16; ++i) {
            float o[8];
#pragma unroll
            for (int e = 0; e < 8; ++e) o[e] = silu_f(bs[e] + w[0][e] * sbf2f(rows[i][e]) + w[1][e] * sbf2f(rows[i + 1][e]) + w[2][e] * sbf2f(rows[i + 2][e]) + w[3][e] * sbf2f(rows[i + 3][e]));
            v4u ov; ov.x = pkbf(o[0], o[1]); ov.y = pkbf(o[2], o[3]); ov.z = pkbf(o[4], o[5]); ov.w = pkbf(o[6], o[7]);
            *(v4u*)(XACT + (size_t)(t0 + i) * 1024 + c0) = ov;
        }
    }
    LAS float* ACST = (LAS float*)(ldsb + 34816 * 3);
    {
        const int s = tid >> 2, hh = tid & 3, H = g * 4 + hh;
        const float A = -__expf(a_log[H]);
        const float raw = DTRAW[(size_t)(tok0 + s) * 8 + H] + dt_bias[H];
        const float dtv = fmaxf(raw, 0.f) + log1pf(__expf(-fabsf(raw)));
        float v = dtv * A;
#pragma unroll
        for (int o = 4; o < 64; o <<= 1) { const float y = __shfl_up(v, o); if (lane >= o) v += y; }
        if (lane >= 60) WT[wave * 4 + hh] = v;
        __syncthreads();
        float off = 0.f;
        for (int w2 = 0; w2 < wave; ++w2) off += WT[w2 * 4 + hh];
        v += off;
        DTT[tid] = dtv; ACST[tid] = v; ACS[(size_t)(tok0 + s) * 8 + H] = v;
        if (s == 127) CDEC[bc * 8 + H] = __expf(v);
    }
    asm volatile("s_waitcnt vmcnt(0)" ::: "memory");
    __syncthreads();
    LAS bf16* BT = (LAS bf16*)ldsb;
    LAS bf16* XD = (LAS bf16*)(ldsb + 34816);
    LAS bf16* XW = (LAS bf16*)(ldsb + 34816 + 34816);
    const int r = lane & 31, hi = lane >> 5;
#pragma unroll
    for (int i = 0; i < 4; ++i) {
        const int c = tid + 512 * i, s = c >> 4, n0 = (c & 15) * 8;
        const bf16x8 v = ldg8(XACT + (size_t)(tok0 + s) * 1024 + 512 + g * 128 + n0);
#pragma unroll
        for (int e = 0; e < 8; ++e) BT[(n0 + e) * 136 + s] = (bf16)v[e];
    }
#pragma unroll 1
    for (int hp = 0; hp < 2; ++hp) {
        if (hp) __syncthreads();
        int tidp = tid; asm volatile("" : "+v"(tidp));
#pragma unroll
        for (int i = 0; i < 4; ++i) {
            const int c = tidp + 512 * i, hsel = c >> 10, s = (c >> 3) & 127, p0 = (c & 7) * 8, H = g * 4 + 2 * hp + hsel;
            const bf16x8 v = ldg8(XACT + (size_t)(tok0 + s) * 1024 + H * 64 + p0);
            const float dtv = DTT[s * 4 + 2 * hp + hsel];
            const float w = __expf(ACST[127 * 4 + 2 * hp + hsel] - ACST[s * 4 + 2 * hp + hsel]);
#pragma unroll
            for (int e = 0; e < 8; ++e) { const float xd = sbf2f(v[e]) * dtv; XD[hsel * 8704 + (p0 + e) * 136 + s] = (bf16)bfs(xd); XW[hsel * 8704 + (p0 + e) * 136 + s] = (bf16)bfs(xd * w); }
        }
        __syncthreads();
        {
            const int lt = wave & 3, hsel = wave >> 2, hh = 2 * hp + hsel, H = g * 4 + hh;
            const int l = 32 * lt + r; const float acs_l = ACST[l * 4 + hh];
            bf16x8 cf[8];
            { const bf16* cp = XACT + (size_t)(tok0 + l) * 1024 + 768 + g * 128 + 8 * hi; asm volatile("" : "+v"(cp));
#pragma unroll
              for (int ks = 0; ks < 8; ++ks) cf[ks] = ldg8(cp + 16 * ks); }
            f32x16 Z0 = zero16(), Z1 = zero16();
            bf16x8 bn[8];
            { const bf16* bp = XACT + (size_t)(tok0 + r) * 1024 + 512 + g * 128 + 8 * hi; asm volatile("" : "+v"(bp));
#pragma unroll
              for (int ks = 0; ks < 8; ++ks) bn[ks] = ldg8(bp + 16 * ks); }
#pragma unroll 1
            for (int st = 0; st <= lt; ++st) {
                f32x16 X = zero16();
                bf16x8 bc[8];
#pragma unroll
                for (int ks = 0; ks < 8; ++ks) bc[ks] = bn[ks];
                { const int stn = st < lt ? st + 1 : lt; const bf16* bp = XACT + (size_t)(tok0 + 32 * stn + r) * 1024 + 512 + g * 128 + 8 * hi; asm volatile("" : "+v"(bp));
#pragma unroll
                  for (int ks = 0; ks < 8; ++ks) bn[ks] = ldg8(bp + 16 * ks); }
#pragma unroll
                for (int ks = 0; ks < 8; ++ks) X = MFMA32(bc[ks], cf[ks], X);
#pragma unroll
                for (int i = 0; i < 16; ++i) { const int s = 32 * st + crow(i, hi); const float f = (s <= l) ? __expf(acs_l - ACST[s * 4 + hh]) : 0.f; X[i] *= f; }
                const int sb = 32 * st + 4 * hi;
                { const bf16x8 xs = pack8<0>(X); const bf16x8 b0 = lds4x2(XD + hsel * 8704 + r * 136 + sb), b1 = lds4x2(XD + hsel * 8704 + (32 + r) * 136 + sb); Z0 = MFMA32(xs, b0, Z0); Z1 = MFMA32(xs, b1, Z1); }
                { const bf16x8 xs = pack8<1>(X); const bf16x8 b0 = lds4x2(XD + hsel * 8704 + r * 136 + sb + 16), b1 = lds4x2(XD + hsel * 8704 + (32 + r) * 136 + sb + 16); Z0 = MFMA32(xs, b0, Z0); Z1 = MFMA32(xs, b1, Z1); }
            }
#pragma unroll
            for (int i = 0; i < 16; ++i) { float* o = MIXF + (size_t)(tok0 + 32 * lt + crow(i, hi)) * D + 512 + H * 64 + r; o[0] = Z0[i]; o[32] = Z1[i]; }
        }
        {
            const int nt = wave & 3, hsel = wave >> 2, H = g * 4 + 2 * hp + hsel;
            f32x16 S0 = zero16(), S1 = zero16();
#pragma unroll
            for (int ks = 0; ks < 8; ++ks) {
                const bf16x8 btf = lds8(BT + (32 * nt + r) * 136 + 16 * ks + 8 * hi);
                const bf16x8 a0 = lds8(XW + hsel * 8704 + r * 136 + 16 * ks + 8 * hi), a1 = lds8(XW + hsel * 8704 + (32 + r) * 136 + 16 * ks + 8 * hi);
                S0 = MFMA32(a0, btf, S0); S1 = MFMA32(a1, btf, S1);
            }
            float* sp = STATES + (size_t)(bc * 8 + H) * 8192 + 32 * nt + r;
#pragma unroll
            for (int i = 0; i < 16; ++i) { const int p = crow(i, hi); sp[p * 128] = S0[i]; sp[(32 + p) * 128] = S1[i]; }
        }
    }
    __syncthreads();
}

__device__ __forceinline__ __amdgpu_buffer_rsrc_t mk_rsrc(const void* p, unsigned bytes) { return __builtin_amdgcn_make_buffer_rsrc((void*)p, 0, bytes, 0x00020000); }
__device__ __forceinline__ void yoff_unit(const float* d_skip, const float* gnorm, LAS unsigned char* ldsb, int unit, const bf16* XACT, const bf16* PROJ, const float* ACS, const bf16* PREVT,
                                          const float* MIXF, bf16* MIXB, int lane, int wave) {
    const int g = unit & 1, bc = unit >> 1, tok0 = bc * 128;
    const int r = lane & 31, hi = lane >> 5, lt = wave & 3, hpair = wave >> 2;
    LAS float* TAB = (LAS float*)ldsb;
    const __amdgpu_buffer_rsrc_t rsF = mk_rsrc(MIXF, (unsigned)T * D * 4u), rsX = mk_rsrc(XACT, (unsigned)T * 1024u * 2u), rsP = mk_rsrc(PROJ, (unsigned)T * PS * 2u), rsA = mk_rsrc(ACS, (unsigned)T * 32u), rsB = mk_rsrc(MIXB, (unsigned)T * D * 2u);
    const unsigned tb = (unsigned)(tok0 + 32 * lt + 4 * hi);
    bf16x8 cf[8];
    { const bf16* cp = XACT + (size_t)(tok0 + 32 * lt + r) * 1024 + 768 + g * 128 + 8 * hi; asm volatile("" : "+v"(cp));
#pragma unroll
      for (int ks = 0; ks < 8; ++ks) cf[ks] = ldg8(cp + 16 * ks); }
    float eav[16], ssq[16];
    unsigned ypk[2][2][8];
#pragma unroll
    for (int i = 0; i < 16; ++i) ssq[i] = 0.f;
#pragma unroll
    for (int hsel = 0; hsel < 2; ++hsel) {
        const int H = g * 4 + 2 * hpair + hsel; const bf16* pv = PREVT + (size_t)(bc * 8 + H) * 8192 + 8 * hi;
        asm volatile("" : "+v"(pv));
        f32x16 Y0 = zero16(), Y1 = zero16();
#pragma unroll
        for (int ks = 0; ks < 8; ++ks) {
            const bf16x8 b0 = ldg8(pv + r * 128 + 16 * ks), b1 = ldg8(pv + (32 + r) * 128 + 16 * ks);
            Y0 = MFMA32(cf[ks], b0, Y0); Y1 = MFMA32(cf[ks], b1, Y1);
        }
        const float dsk = d_skip[H];
        { const unsigned vo = (tb * 8u + (unsigned)H) * 4u;
#pragma unroll
          for (int i = 0; i < 16; ++i) eav[i] = __expf(__builtin_bit_cast(float, __builtin_amdgcn_raw_buffer_load_b32(rsA, (int)vo, ((i & 3) + 8 * (i >> 2)) * 32, 0))); }
#pragma unroll
        for (int pt = 0; pt < 2; ++pt) {
            const unsigned col = (unsigned)(H * 64 + 32 * pt + r);
            const unsigned voF = (tb * 1024u + 512u + col) * 4u, voX = (tb * 1024u + col) * 2u, voP = (tb * (unsigned)PS + (unsigned)OZ + col) * 2u;
            float yo[16], xsv[16], zv[16];
#pragma unroll
            for (int i = 0; i < 16; ++i) { const int ro = (i & 3) + 8 * (i >> 2);
                yo[i] = __builtin_bit_cast(float, __builtin_amdgcn_raw_buffer_load_b32(rsF, (int)voF, ro * 4096, 0));
                xsv[i] = bf2f((bf16)__builtin_amdgcn_raw_buffer_load_b16(rsX, (int)voX, ro * 2048, 0));
                zv[i] = bf2f((bf16)__builtin_amdgcn_raw_buffer_load_b16(rsP, (int)voP, ro * (PS * 2), 0)); }
#pragma unroll
            for (int i = 0; i < 16; i += 2) {
                const float y0 = (yo[i] + eav[i] * (pt ? Y1[i] : Y0[i]) + dsk * xsv[i]) * silu_f(zv[i]);
                const float y1 = (yo[i + 1] + eav[i + 1] * (pt ? Y1[i + 1] : Y0[i + 1]) + dsk * xsv[i + 1]) * silu_f(zv[i + 1]);
                ssq[i] += y0 * y0; ssq[i + 1] += y1 * y1; ypk[hsel][pt][i >> 1] = pkbf(y0, y1);
            }
            __builtin_amdgcn_sched_barrier(0);
        }
    }
#pragma unroll
    for (int i = 0; i < 16; ++i) {
#pragma unroll
        for (int o = 1; o < 32; o <<= 1) ssq[i] += __shfl_xor(ssq[i], o);
    }
    if (r == 0) {
#pragma unroll
        for (int i = 0; i < 16; ++i) TAB[hpair * 128 + 32 * lt + crow(i, hi)] = ssq[i];
    }
    __syncthreads();
#pragma unroll
    for (int i = 0; i < 16; ++i) { const int l = 32 * lt + crow(i, hi); ssq[i] = rsqrtf((TAB[l] + TAB[128 + l]) * (1.f / 256.f) + EPS); }
#pragma unroll
    for (int hsel = 0; hsel < 2; ++hsel)
#pragma unroll
        for (int pt = 0; pt < 2; ++pt) {
            const unsigned col = (unsigned)((g * 4 + 2 * hpair + hsel) * 64 + 32 * pt + r); const float gn = gnorm[col];
            const unsigned voB = (tb * 1024u + 512u + col) * 2u;
#pragma unroll
            for (int i = 0; i < 16; ++i) { const unsigned w = ypk[hsel][pt][i >> 1];
                const float yf = (i & 1) ? __uint_as_float(w & 0xffff0000u) : __uint_as_float(w << 16);
                __builtin_amdgcn_raw_buffer_store_b16((short)f2bf(yf * ssq[i] * gn), rsB, (int)voB, ((i & 3) + 8 * (i >> 2)) * 2048, 0); }
        }
    __syncthreads();
}
typedef float f32x2 __attribute__((ext_vector_type(2)));
__device__ __forceinline__ void fp8x16_to_f32(const uint4 w, float (&f)[16]) {
    const int ww[4] = {(int)w.x, (int)w.y, (int)w.z, (int)w.w};
#pragma unroll
    for (int q = 0; q < 4; ++q) { const f32x2 a = __builtin_amdgcn_cvt_pk_f32_fp8(ww[q], false), b = __builtin_amdgcn_cvt_pk_f32_fp8(ww[q], true); f[4 * q] = a.x; f[4 * q + 1] = a.y; f[4 * q + 2] = b.x; f[4 * q + 3] = b.y; }
}
template <int M4, int M2, int M1> __device__ __forceinline__ void treduce16(const float (&a)[16], int lane, float& r0, float& r1) {
    float b[8], c[4];
    { const bool hi = (lane & M4) != 0;
#pragma unroll
      for (int i = 0; i < 8; ++i) { const float send = hi ? a[i] : a[i + 8]; const float recv = __shfl_xor(send, M4); b[i] = (hi ? a[i + 8] : a[i]) + recv; } }
    { const bool hi = (lane & M2) != 0;
#pragma unroll
      for (int i = 0; i < 4; ++i) { const float send = hi ? b[i] : b[i + 4]; const float recv = __shfl_xor(send, M2); c[i] = (hi ? b[i + 4] : b[i]) + recv; } }
    { const bool hi = (lane & M1) != 0;
      { const float send = hi ? c[0] : c[2]; const float recv = __shfl_xor(send, M1); r0 = (hi ? c[2] : c[0]) + recv; }
      { const float send = hi ? c[1] : c[3]; const float recv = __shfl_xor(send, M1); r1 = (hi ? c[3] : c[1]) + recv; } }
}
template <int M4, int M2, int M1> __device__ __forceinline__ void treduce16i(const int (&a)[16], int lane, int& r0, int& r1) {
    int b[8], c[4];
    { const bool hi = (lane & M4) != 0;
#pragma unroll
      for (int i = 0; i < 8; ++i) { const int send = hi ? a[i] : a[i + 8]; const int recv = __shfl_xor(send, M4); b[i] = (hi ? a[i + 8] : a[i]) + recv; } }
    { const bool hi = (lane & M2) != 0;
#pragma unroll
      for (int i = 0; i < 4; ++i) { const int send = hi ? b[i] : b[i + 4]; const int recv = __shfl_xor(send, M2); c[i] = (hi ? b[i + 4] : b[i]) + recv; } }
    { const bool hi = (lane & M1) != 0;
      { const int send = hi ? c[0] : c[2]; const int recv = __shfl_xor(send, M1); r0 = (hi ? c[2] : c[0]) + recv; }
      { const int send = hi ? c[1] : c[3]; const int recv = __shfl_xor(send, M1); r1 = (hi ? c[3] : c[1]) + recv; } }
}
#define PE_ID(E, i) (((i) & 1) ? (E[(i) >> 1] >> 16) : (E[(i) >> 1] & 0xffffu))
__device__ __forceinline__ void peer_u_item(int p, int j, const unsigned short* __restrict__ IDX, const unsigned char* __restrict__ XQ, const unsigned char* __restrict__ U8, bf16* __restrict__ PART, int lane, int wave) {
    asm volatile("" : "+v"(lane));
    const int gidx = lane >> 3; const unsigned coff = (unsigned)(p * 128 + (lane & 7) * 16);
#pragma unroll 1
    for (int it = 0; it < 8; ++it) {
        const int t = j * 64 + it * 8 + wave;
        unsigned E[8];
        { const uint4 e0 = *(const uint4*)(IDX + (size_t)t * 128 + 16 * gidx), e1 = *(const uint4*)(IDX + (size_t)t * 128 + 16 * gidx + 8);
          E[0] = e0.x; E[1] = e0.y; E[2] = e0.z; E[3] = e0.w; E[4] = e1.x; E[5] = e1.y; E[6] = e1.z; E[7] = e1.w; }
        uint4 uu[16];
#pragma unroll
        for (int i = 0; i < 16; ++i) uu[i] = *(const uint4*)(U8 + (size_t)(PE_ID(E, i) * 1024u + coff));
        const uint4 xq = *(const uint4*)(XQ + (size_t)t * D + coff);
        int d[16];
#pragma unroll
        for (int i = 0; i < 16; ++i) {
            int s = __builtin_amdgcn_sdot4((int)uu[i].x, (int)xq.x, 0, false); s = __builtin_amdgcn_sdot4((int)uu[i].y, (int)xq.y, s, false);
            s = __builtin_amdgcn_sdot4((int)uu[i].z, (int)xq.z, s, false); s = __builtin_amdgcn_sdot4((int)uu[i].w, (int)xq.w, s, false);
            d[i] = s;
        }
        int r0, r1; treduce16i<4, 2, 1>(d, lane, r0, r1);
        *(unsigned*)(PART + ((size_t)p * T + t) * 128 + 2 * lane) = pkbf((float)r0, (float)r1);
    }
}
__device__ __forceinline__ void peer_v_item(int p, int j, const unsigned short* __restrict__ IDX, const unsigned char* __restrict__ ACTQ, const float* __restrict__ ACTS,
                                            const unsigned char* __restrict__ V8, bf16* __restrict__ PEERO, int lane, int wave) {
    asm volatile("" : "+v"(lane));
    const int gidx = lane >> 3; const unsigned coff = (unsigned)(p * 128 + (lane & 7) * 16);
#pragma unroll 1
    for (int it = 0; it < 8; ++it) {
        const int t = j * 64 + it * 8 + wave;
        unsigned E[8];
        { const uint4 e0 = *(const uint4*)(IDX + (size_t)t * 128 + 16 * gidx), e1 = *(const uint4*)(IDX + (size_t)t * 128 + 16 * gidx + 8);
          E[0] = e0.x; E[1] = e0.y; E[2] = e0.z; E[3] = e0.w; E[4] = e1.x; E[5] = e1.y; E[6] = e1.z; E[7] = e1.w; }
        uint4 vv[16];
#pragma unroll
        for (int i = 0; i < 16; ++i) vv[i] = *(const uint4*)(V8 + (size_t)(PE_ID(E, i) * 1024u + coff));
        const uint4 aq = *(const uint4*)(ACTQ + (size_t)t * 128 + 16 * gidx);
        const float asc = ACTS[t];
        const unsigned a4[4] = {aq.x, aq.y, aq.z, aq.w};
        int acc[16];
#pragma unroll
        for (int c = 0; c < 16; ++c) acc[c] = 0;
#pragma unroll
        for (int m = 0; m < 4; ++m) {
            const unsigned r0[4] = {vv[4 * m].x, vv[4 * m].y, vv[4 * m].z, vv[4 * m].w}, r1[4] = {vv[4 * m + 1].x, vv[4 * m + 1].y, vv[4 * m + 1].z, vv[4 * m + 1].w};
            const unsigned r2[4] = {vv[4 * m + 2].x, vv[4 * m + 2].y, vv[4 * m + 2].z, vv[4 * m + 2].w}, r3[4] = {vv[4 * m + 3].x, vv[4 * m + 3].y, vv[4 * m + 3].z, vv[4 * m + 3].w};
#pragma unroll
            for (int dc = 0; dc < 4; ++dc) {
                const unsigned ta = __builtin_amdgcn_perm(r1[dc], r0[dc], 0x05010400u), tb = __builtin_amdgcn_perm(r3[dc], r2[dc], 0x05010400u);
                const unsigned ua = __builtin_amdgcn_perm(r1[dc], r0[dc], 0x07030602u), ub = __builtin_amdgcn_perm(r3[dc], r2[dc], 0x07030602u);
                const unsigned c0 = __builtin_amdgcn_perm(tb, ta, 0x05040100u), c1 = __builtin_amdgcn_perm(tb, ta, 0x07060302u);
                const unsigned c2 = __builtin_amdgcn_perm(ub, ua, 0x05040100u), c3 = __builtin_amdgcn_perm(ub, ua, 0x07060302u);
                acc[4 * dc + 0] = __builtin_amdgcn_sdot4((int)c0, (int)a4[m], acc[4 * dc + 0], false);
                acc[4 * dc + 1] = __builtin_amdgcn_sdot4((int)c1, (int)a4[m], acc[4 * dc + 1], false);
                acc[4 * dc + 2] = __builtin_amdgcn_sdot4((int)c2, (int)a4[m], acc[4 * dc + 2], false);
                acc[4 * dc + 3] = __builtin_amdgcn_sdot4((int)c3, (int)a4[m], acc[4 * dc + 3], false);
            }
        }
        int r0i, r1i; treduce16i<32, 16, 8>(acc, lane, r0i, r1i);
        *(unsigned*)(PEERO + (size_t)t * D + coff + 2 * gidx) = pkbf(asc * (float)r0i, asc * (float)r1i);
    }
}

__device__ __forceinline__ void ce_desc(float& a, float& b) { const float hi = fmaxf(a, b), lo = fminf(a, b); a = hi; b = lo; }
__device__ __forceinline__ void sort16_desc(float (&v)[16]) {
#pragma unroll
    for (int k = 2; k <= 16; k <<= 1)
#pragma unroll
        for (int j = k >> 1; j > 0; j >>= 1)
#pragma unroll
            for (int i = 0; i < 16; ++i) { const int l = i ^ j; if (l > i) { if ((i & k) == 0) ce_desc(v[i], v[l]); else ce_desc(v[l], v[i]); } }
}
__device__ __forceinline__ void merge16_desc(float (&a)[16], const float (&b)[16]) {
#pragma unroll
    for (int i = 0; i < 16; ++i) a[i] = fmaxf(a[i], b[15 - i]);
#pragma unroll
    for (int j = 8; j > 0; j >>= 1)
#pragma unroll
        for (int i = 0; i < 16; ++i) { const int l = i ^ j; if (l > i) ce_desc(a[i], a[l]); }
}
__device__ __forceinline__ void ce_kv(float& ka, int& va, float& kb, int& vb) {
    const bool s = kb > ka; const float t0 = s ? kb : ka, t1 = s ? ka : kb; const int u0 = s ? vb : va, u1 = s ? va : vb; ka = t0; kb = t1; va = u0; vb = u1; }
__device__ __forceinline__ void sort16_kv(float (&k)[16], int (&v)[16]) {
#pragma unroll
    for (int kk = 2; kk <= 16; kk <<= 1)
#pragma unroll
        for (int j = kk >> 1; j > 0; j >>= 1)
#pragma unroll
            for (int i = 0; i < 16; ++i) { const int l = i ^ j; if (l > i) { if ((i & kk) == 0) ce_kv(k[i], v[i], k[l], v[l]); else ce_kv(k[l], v[l], k[i], v[i]); } }
}
__device__ __forceinline__ void merge16_kv(float (&ka)[16], int (&va)[16], const float (&kb)[16], const int (&vb)[16]) {
#pragma unroll
    for (int i = 0; i < 16; ++i) { const bool s = kb[15 - i] > ka[i]; ka[i] = s ? kb[15 - i] : ka[i]; va[i] = s ? vb[15 - i] : va[i]; }
#pragma unroll
    for (int j = 8; j > 0; j >>= 1)
#pragma unroll
        for (int i = 0; i < 16; ++i) { const int l = i ^ j; if (l > i) ce_kv(ka[i], va[i], ka[l], va[l]); }
}
__device__ __forceinline__ void split8(const float* p, bf16x8& hi8, bf16x8& lo8) {
    const float4 f0 = *(const float4*)p, f1 = *(const float4*)(p + 4);
    const float x[8] = {f0.x, f0.y, f0.z, f0.w, f1.x, f1.y, f1.z, f1.w};
#pragma unroll
    for (int j = 0; j < 8; ++j) { const short h = bfs(x[j]); hi8[j] = h; lo8[j] = bfs(x[j] - sbf2f(h)); }
}
__device__ __forceinline__ void route_task(int task, const float* QP, const LAS bf16* KHL, unsigned short* IDX, float* GATE, int lane) {
    const int r = lane & 31, hi = lane >> 5, t = 4 * task + (r >> 3), head = r & 7;
    float top[2][16];
#pragma unroll
    for (int half = 0; half < 2; ++half) {
        bf16x8 qh[4], ql[4];
        { const float* qp = QP + (size_t)t * D + head * 128 + half * 64 + 8 * hi; asm volatile("" : "+v"(qp));
#pragma unroll
          for (int ks = 0; ks < 4; ++ks) split8(qp + 16 * ks, qh[ks], ql[ks]); }
        float cur[16];
#pragma unroll
        for (int kt = 0; kt < 4; ++kt) {
            f32x16 X = zero16();
            const LAS bf16* khp = KHL + (half * 128 + 32 * kt + r) * 72 + 8 * hi;
#pragma unroll
            for (int ks = 0; ks < 4; ++ks) {
                const bf16x8 kh = lds8(khp + 16 * ks), kl = lds8(khp + 2 * 128 * 72 + 16 * ks);
                X = MFMA32(kh, qh[ks], X); X = MFMA32(kh, ql[ks], X); X = MFMA32(kl, qh[ks], X);
            }
            float grp[16];
#pragma unroll
            for (int i = 0; i < 16; ++i) { const unsigned key = (unsigned)(32 * kt + crow(i, hi)); grp[i] = __uint_as_float((__float_as_uint(X[i]) & ~127u) | (127u - key)); }
            sort16_desc(grp);
            if (kt == 0) {
#pragma unroll
                for (int i = 0; i < 16; ++i) cur[i] = grp[i];
            } else merge16_desc(cur, grp);
        }
        float oth[16];
#pragma unroll
        for (int i = 0; i < 16; ++i) oth[i] = __shfl_xor(cur[i], 32);
        merge16_desc(cur, oth);
#pragma unroll
        for (int i = 0; i < 16; ++i) top[half][i] = cur[i];
    }
    unsigned P1[4], P2[4];
#pragma unroll
    for (int q = 0; q < 4; ++q) { P1[q] = 0u; P2[q] = 0u;
#pragma unroll
        for (int s = 0; s < 4; ++s) { P1[q] |= (127u - (__float_as_uint(top[0][4 * q + s]) & 127u)) << (8 * s); P2[q] |= (127u - (__float_as_uint(top[1][4 * q + s]) & 127u)) << (8 * s); } }
#define CAND(a, b) __uint_as_float((__float_as_uint(top[0][a] + top[1][b]) & ~255u) | (255u - (unsigned)((a) * 16 + (b))))
    float bk[16];
    {
        float gk[16];
        gk[0] = CAND(0, 0);
        gk[1] = CAND(0, 1);
        gk[2] = CAND(0, 2);
        gk[3] = CAND(0, 3);
        gk[4] = CAND(0, 4);
        gk[5] = CAND(0, 5);
        gk[6] = CAND(0, 6);
        gk[7] = CAND(0, 7);
        gk[8] = CAND(0, 8);
        gk[9] = CAND(0, 9);
        gk[10] = CAND(0, 10);
        gk[11] = CAND(0, 11);
        gk[12] = CAND(0, 12);
        gk[13] = CAND(0, 13);
        gk[14] = CAND(0, 14);
        gk[15] = CAND(0, 15);
        sort16_desc(gk);
#pragma unroll
        for (int i = 0; i < 16; ++i) bk[i] = gk[i];
    }
    {
        float gk[16];
        gk[0] = CAND(1, 0);
        gk[1] = CAND(1, 1);
        gk[2] = CAND(1, 2);
        gk[3] = CAND(1, 3);
        gk[4] = CAND(1, 4);
        gk[5] = CAND(1, 5);
        gk[6] = CAND(1, 6);
        gk[7] = CAND(1, 7);
        gk[8] = CAND(2, 0);
        gk[9] = CAND(2, 1);
        gk[10] = CAND(2, 2);
        gk[11] = CAND(2, 3);
        gk[12] = CAND(2, 4);
        gk[13] = CAND(3, 0);
        gk[14] = CAND(3, 1);
        gk[15] = CAND(3, 2);
        sort16_desc(gk);
        merge16_desc(bk, gk);
    }
    {
        float gk[16];
        gk[0] = CAND(3, 3);
        gk[1] = CAND(4, 0);
        gk[2] = CAND(4, 1);
        gk[3] = CAND(4, 2);
        gk[4] = CAND(5, 0);
        gk[5] = CAND(5, 1);
        gk[6] = CAND(6, 0);
        gk[7] = CAND(6, 1);
        gk[8] = CAND(7, 0);
        gk[9] = CAND(7, 1);
        gk[10] = CAND(8, 0);
        gk[11] = CAND(9, 0);
        gk[12] = CAND(10, 0);
        gk[13] = CAND(11, 0);
        gk[14] = CAND(12, 0);
        gk[15] = CAND(13, 0);
        sort16_desc(gk);
        merge16_desc(bk, gk);
    }
    {
        float gk[16];
        gk[0] = CAND(14, 0);
        gk[1] = CAND(15, 0);
        gk[2] = -INFINITY;
        gk[3] = -INFINITY;
        gk[4] = -INFINITY;
        gk[5] = -INFINITY;
        gk[6] = -INFINITY;
        gk[7] = -INFINITY;
        gk[8] = -INFINITY;
        gk[9] = -INFINITY;
        gk[10] = -INFINITY;
        gk[11] = -INFINITY;
        gk[12] = -INFINITY;
        gk[13] = -INFINITY;
        gk[14] = -INFINITY;
        gk[15] = -INFINITY;
        sort16_desc(gk);
        merge16_desc(bk, gk);
    }
#undef CAND
    int bv[16];
#pragma unroll
    for (int i = 0; i < 16; ++i) {
        const unsigned cd = 255u - (__float_as_uint(bk[i]) & 255u), ca = cd >> 4, cb = cd & 15u;
        const unsigned wa = (ca >> 2) == 0u ? P1[0] : (ca >> 2) == 1u ? P1[1] : (ca >> 2) == 2u ? P1[2] : P1[3];
        const unsigned wb = (cb >> 2) == 0u ? P2[0] : (cb >> 2) == 1u ? P2[1] : (cb >> 2) == 2u ? P2[2] : P2[3];
        bv[i] = (int)((((wa >> (8u * (ca & 3u))) & 255u) << 7) | ((wb >> (8u * (cb & 3u))) & 255u));
    }
    float e[16], se = 0.f;
#pragma unroll
    for (int i = 0; i < 16; ++i) { e[i] = __expf(bk[i] - bk[0]); se += e[i]; }
    const float inv = 1.f / se;
    if (hi == 0) {
        uint4* ip = (uint4*)(IDX + (size_t)t * 128 + head * 16); float4* gp = (float4*)(GATE + (size_t)t * 128 + head * 16);
#pragma unroll
        for (int q = 0; q < 2; ++q) ip[q] = make_uint4((unsigned)bv[8 * q] | ((unsigned)bv[8 * q + 1] << 16), (unsigned)bv[8 * q + 2] | ((unsigned)bv[8 * q + 3] << 16), (unsigned)bv[8 * q + 4] | ((unsigned)bv[8 * q + 5] << 16), (unsigned)bv[8 * q + 6] | ((unsigned)bv[8 * q + 7] << 16));
#pragma unroll
        for (int q = 0; q < 4; ++q) gp[q] = make_float4(e[4 * q] * inv, e[4 * q + 1] * inv, e[4 * q + 2] * inv, e[4 * q + 3] * inv);
    }
}

#define XB_TMO      128
#define XB_XCNT(j)  (256  + 64 * (j))
#define XB_XSUB(j)  (1280 + 64 * (j))
#define XB_XGEN(j)  (2304 + 64 * (j))
#define XB_TOP      3328
#define XB_TOPGEN   3392
#define XCD_BAR_WORDS 3456
#define XB_SPIN_CAP (1u << 22)
__device__ __forceinline__ unsigned xb_ld(unsigned* p)              { return __hip_atomic_load(p, __ATOMIC_RELAXED, __HIP_MEMORY_SCOPE_AGENT); }
__device__ __forceinline__ unsigned xb_add(unsigned* p, unsigned v) { return __hip_atomic_fetch_add(p, v, __ATOMIC_RELAXED, __HIP_MEMORY_SCOPE_AGENT); }
__device__ __forceinline__ unsigned xb_xcc_id() { return (unsigned)__builtin_amdgcn_s_getreg((3 << 11) | 20) & 0xFu; }
#define XB_SPIN(cond, bar) do { unsigned _sp = 0; while (cond) { __builtin_amdgcn_s_sleep(1); \
    if ((++_sp & 255u) == 0u) { if (xb_ld(&(bar)[XB_TMO])) break; if (_sp > XB_SPIN_CAP) { atomicAdd(&(bar)[XB_TMO], 1u); break; } } } } while (0)
struct XcdBarrier { unsigned* bar; unsigned x; volatile LAS unsigned* st; };
__device__ __forceinline__ XcdBarrier xcd_barrier_post(unsigned* bar, volatile LAS unsigned* st) {
    XcdBarrier b; b.bar = bar; b.x = xb_xcc_id(); b.st = st;
    if (threadIdx.x == 0) (void)xb_add(&bar[XB_XCNT(b.x)], 1u);
    return b;
}
__device__ __forceinline__ void xcd_barrier_complete(unsigned* bar, unsigned x, unsigned& nloc, unsigned& nx) {
    const unsigned G = gridDim.x * gridDim.y * gridDim.z;
    unsigned sum, cnt, mine, sp = 0u;
    for (;;) {
        sum = 0u; cnt = 0u; mine = 0u;
#pragma unroll
        for (unsigned j = 0; j < 16; ++j) { const unsigned c = xb_ld(&bar[XB_XCNT(j)]); sum += c; cnt += (c > 0u) ? 1u : 0u; mine = (j == x) ? c : mine; }
        if (sum == G) break;
        __builtin_amdgcn_s_sleep(1);
        if ((++sp & 255u) == 0u) { if (xb_ld(&bar[XB_TMO])) break; if (sp > XB_SPIN_CAP) { atomicAdd(&bar[XB_TMO], 1u); break; } }
    }
    nloc = mine > 0u ? mine : 1u; nx = cnt > 0u ? cnt : 1u;
}
__device__ __forceinline__ void xcd_barrier(const XcdBarrier& b) {
    asm volatile("s_waitcnt vmcnt(0)" ::: "memory");
    __syncthreads();
    if (threadIdx.x == 0) {
        unsigned* bar = b.bar;
        __builtin_amdgcn_s_waitcnt(0);
        unsigned nloc = b.st[0], nx = b.st[1];
        if (nloc == 0u) { xcd_barrier_complete(bar, b.x, nloc, nx); b.st[0] = nloc; b.st[1] = nx; }
        const unsigned old = xb_add(&bar[XB_XSUB(b.x)], 1u);
        const unsigned gen = old / nloc;
        if (old + 1u == (gen + 1u) * nloc) {
            __builtin_amdgcn_fence(__ATOMIC_RELEASE, "agent");
            asm volatile("s_waitcnt vmcnt(0)" ::: "memory");
            const unsigned og = xb_add(&bar[XB_TOP], 1u);
            const unsigned tg = og / nx;
            if (og + 1u == (tg + 1u) * nx) xb_add(&bar[XB_TOPGEN], 1u);
            else XB_SPIN(xb_ld(&bar[XB_TOPGEN]) == tg, bar);
            __builtin_amdgcn_fence(__ATOMIC_ACQUIRE, "agent");
            xb_add(&bar[XB_XGEN(b.x)], 1u);
            asm volatile("s_waitcnt vmcnt(0)" ::: "memory");
        } else {
            XB_SPIN(xb_ld(&bar[XB_XGEN(b.x)]) == gen, bar);
            __builtin_amdgcn_fence(__ATOMIC_ACQUIRE, "agent");
            asm volatile("s_waitcnt vmcnt(0)" ::: "memory");
        }
    }
    __syncthreads();
}
constexpr int LDS_BYTES = 147456;
constexpr int MISC_OFF = 131072 + 320;

__global__ void __launch_bounds__(NTHR, 2) k_main(Args a) {
    extern __shared__ __attribute__((aligned(16))) unsigned char lds_raw[];
    LAS unsigned char* ldsb = (LAS unsigned char*)lds_raw;
    const int tid0 = threadIdx.x, bid = blockIdx.x, nb = gridDim.x;
    const int wave = __builtin_amdgcn_readfirstlane(tid0 >> 6);
    const int gthreads = nb * NTHR, nwaves = gthreads >> 6;
#define PHASE_VARS() int tid = tid0; asm volatile("" : "+v"(tid)); const int lane = tid & 63, gtid = bid * NTHR + tid, gwave = gtid >> 6; (void)lane; (void)gtid; (void)gwave
    unsigned char* ws = a.ws;
    bf16* WINT = (bf16*)(ws + WS_WIN); bf16* WOT = (bf16*)(ws + WS_WO); bf16* WQT = (bf16*)(ws + WS_WQ);
    bf16* PROJ = (bf16*)(ws + WS_PROJ);
    bf16* XNB = (bf16*)(ws + WS_XNB);
    bf16* XACT = (bf16*)(ws + WS_XACT);
    float* DTRAW = (float*)(ws + WS_DTRAW); float* DT = (float*)(ws + WS_DT); float* ACS = (float*)(ws + WS_ACS); float* CDEC = (float*)(ws + WS_CDEC);
    float* STATES = (float*)(ws + WS_STATES); bf16* PREVT = (bf16*)(ws + WS_PREV);
    float* QP = (float*)(ws + WS_QP); unsigned short* IDX = (unsigned short*)(ws + WS_IDX); float* GATE = (float*)(ws + WS_GATE);
    float* TOPV = (float*)(ws + WS_TOPV); int* TOPI = (int*)(ws + WS_TOPI);
    unsigned char* U8 = ws + WS_U8; unsigned char* V8 = ws + WS_V8; float* SU = (float*)(ws + WS_SU); float* SV = SU + 16384; bf16* PART = (bf16*)(ws + WS_PART); unsigned char* XQ = ws + WS_XQ; float* XS = (float*)(ws + WS_XS);
    bf16* KH = (bf16*)(ws + WS_KH); bf16* KL = (bf16*)(ws + WS_KH + 65536);
    bf16* HB = (bf16*)(ws + WS_STATES);
    float* MIXF = a.out;
    volatile LAS unsigned* MISC = (volatile LAS unsigned*)(ldsb + MISC_OFF);
    if (tid0 < 32) MISC[tid0] = 0u;
    __syncthreads();
    XcdBarrier bar = xcd_barrier_post((unsigned*)ws, MISC + 8);
#define IN(k) (a.ph_lo <= (k) && (k) < a.ph_hi)
#if defined(PROBE_LO)
    int seg_ = 0; unsigned long long tseg_ = __builtin_amdgcn_s_memrealtime();
#define PROBE_SPIN() do { if (seg_ >= PROBE_LO && seg_ <= PROBE_HI) { const unsigned long long d_ = (__builtin_amdgcn_s_memrealtime() - tseg_) * PROBE_AMP; const unsigned long long s_ = __builtin_amdgcn_s_memrealtime(); \
        while (__builtin_amdgcn_s_memrealtime() - s_ < d_) __builtin_amdgcn_s_sleep(4); } } while (0)
#define GRID_BAR() do { PROBE_SPIN(); xcd_barrier(bar); tseg_ = __builtin_amdgcn_s_memrealtime(); ++seg_; } while (0)
#else
#define PROBE_SPIN() do { } while (0)
#define GRID_BAR() xcd_barrier(bar)
#endif

    if (IN(0)) {
        PHASE_VARS();
        LAS float* scr = (LAS float*)(ldsb + wave * 16384);
        constexpr int I_IN = 16 * 72, I_O = 16 * 32, NITEMS = I_IN + 2 * I_O;
        for (int it = gwave; it < NITEMS; it += nwaves) {
            int r = it;
            if (r < I_IN) { transpose_item(a.w_in, PW, D, WINT, scr, r / 72, r % 72, lane); continue; } r -= I_IN;
            if (r < I_O) { transpose_item(a.w_out, D, D, WOT, scr, r / 32, r % 32, lane); continue; } r -= I_O;
            transpose_item(a.peer_wq, D, D, WQT, scr, r / 32, r % 32, lane);
        }
        for (int i = gtid; i < 2 * 128 * 64; i += gthreads) { const float kf = a.peer_sub_keys[i]; const short h = bfs(kf); KH[i] = (bf16)h; KL[i] = (bf16)bfs(kf - sbf2f(h)); }
        for (int i = tid; i < 8 * 1024; i += NTHR) { const int h = i & 7, c = i >> 3; *(LAS float*)(ldsb + h * 16384 + 8448 + c * 4) = a.w_in[(size_t)c * PW + ODT + h]; }
        __syncthreads();
        rmsnorm_rows_bf16<1>(a.x, a.norm_mix_g, XNB, ldsb, DTRAW, nullptr, nullptr, gwave, nwaves, lane);
    }
    GRID_BAR();
    if (IN(1)) {
        PHASE_VARS();
        pg8::Gemm g{XNB, WINT, T, PS, D}; pg8::StaticOrder S; S.init(T, PS, nb, bid);
        pg8::EpiBf16Plain E{PROJ, PS};
        pg8::gemm_phase<pg8::EpiBf16Plain, pg8::StaticOrder>(ldsb, g, S, E, nullptr);
        const int cfirst = (nb == 256) ? 64 : 0;
        if (bid >= cfirst) for (int rr0 = ((bid - cfirst) * 8 + wave) * 4; rr0 < 2 * 16384; rr0 += (nb - cfirst) * 8 * 4) {
            float4 v[4][4];
#pragma unroll
            for (int q = 0; q < 4; ++q) { const int rr = rr0 + q, which = rr >> 14, row = rr & 16383;
                const float4* src4 = (const float4*)((which ? a.peer_v : a.peer_u) + (size_t)row * D) + lane;
#pragma unroll
                for (int jq = 0; jq < 4; ++jq) v[q][jq] = src4[64 * jq]; }
#pragma unroll
            for (int q = 0; q < 4; ++q) { const int rr = rr0 + q, which = rr >> 14, row = rr & 16383;
                float mx = 0.f;
#pragma unroll
                for (int jq = 0; jq < 4; ++jq) mx = fmaxf(mx, fmaxf(fmaxf(fabsf(v[q][jq].x), fabsf(v[q][jq].y)), fmaxf(fabsf(v[q][jq].z), fabsf(v[q][jq].w))));
#pragma unroll
                for (int o = 1; o < 64; o <<= 1) mx = fmaxf(mx, __shfl_xor(mx, o));
                const float sc = mx > 0.f ? mx * (1.f / 127.f) : 1.f, inv = 1.f / sc;
                unsigned* dst = (unsigned*)((which ? V8 : U8) + (size_t)row * D) + lane;
#pragma unroll
                for (int jq = 0; jq < 4; ++jq) { const int q0 = (int)rintf(v[q][jq].x * inv), q1 = (int)rintf(v[q][jq].y * inv), q2 = (int)rintf(v[q][jq].z * inv), q3 = (int)rintf(v[q][jq].w * inv);
                    dst[64 * jq] = (unsigned)(q0 & 255) | ((unsigned)(q1 & 255) << 8) | ((unsigned)(q2 & 255) << 16) | ((unsigned)(q3 & 255) << 24); }
                if (lane == 0) (which ? SV : SU)[row] = sc; }
        }
    }
    GRID_BAR();
    if (IN(3)) {
        PHASE_VARS();
        for (int u = bid; u < 512; u += nb) {
            if (u < 256) attn_unit(a.attn_sinks, a.attn_out_g, ldsb, u, PROJ, XNB, tid, lane, wave);
            else ssd_chunk_unit(ldsb, u - 256, PROJ, XACT, DTRAW, a.conv_w, a.conv_b, a.dt_bias, a.a_log, ACS, CDEC, MIXF, STATES, tid, lane, wave);
        }
    }
    GRID_BAR();
    if (IN(5)) {
        PHASE_VARS();
        for (int idx = gtid; idx < 2 * 8 * 8192; idx += gthreads) {
            const int pn = idx & 8191, h = (idx >> 13) & 7, b = idx >> 16;
            float run = 0.f;
#pragma unroll 1
            for (int c0 = 0; c0 < 64; c0 += 8) {
                float st[8], dc[8];
#pragma unroll
                for (int j = 0; j < 8; ++j) { const int bch = (b * 64 + c0 + j) * 8 + h; st[j] = STATES[(size_t)bch * 8192 + pn]; dc[j] = CDEC[bch]; }
#pragma unroll
                for (int j = 0; j < 8; ++j) { const int bch = (b * 64 + c0 + j) * 8 + h; PREVT[(size_t)bch * 8192 + pn] = f2bf(run); run = dc[j] * run + st[j]; }
            }
        }
    }
    GRID_BAR();
    if (IN(6)) {
        PHASE_VARS();
        for (int u = bid; u < 256; u += nb) yoff_unit(a.d_skip, a.ssm_norm_g, ldsb, u, XACT, PROJ, ACS, PREVT, MIXF, XNB, lane, wave);
    }
    GRID_BAR();
    if (IN(7)) {
        PHASE_VARS();
        pg8::Gemm g{XNB, WOT, T, D, D}; pg8::StaticOrder S; S.init(T, D, nb, bid);
        pg8::EpiBf16Resid E{HB, a.x, D};
        pg8::gemm_phase<pg8::EpiBf16Resid, pg8::StaticOrder>(ldsb, g, S, E, nullptr);
    }
    GRID_BAR();
    if (IN(8)) {
        PHASE_VARS();
        rmsnorm_rows_bf16<2>((const float*)HB, a.norm_ffn_g, XNB, ldsb, nullptr, XQ, XS, gwave, nwaves, lane);
    }
    GRID_BAR();
    if (IN(9)) {
        PHASE_VARS();
        pg8::Gemm g{XNB, WQT, T, D, D}; pg8::StaticOrder S; S.init(T, D, nb, bid);
        pg8::EpiF32Resid E{QP, nullptr, D};
        pg8::gemm_phase<pg8::EpiF32Resid, pg8::StaticOrder>(ldsb, g, S, E, nullptr);
    }
    GRID_BAR();
    if (IN(10)) {
        PHASE_VARS();
        LAS bf16* KHL = (LAS bf16*)ldsb;
        for (int i = tid; i < 2 * 2 * 128 * 8; i += NTHR) {
            const int pc = i & 7, key = (i >> 3) & 127, hf = (i >> 10) & 1, hl = i >> 11;
            *(LAS v4u*)(KHL + ((hl * 2 + hf) * 128 + key) * 72 + pc * 8) = *(const v4u*)((hl ? KL : KH) + (size_t)(hf * 128 + key) * 64 + pc * 8);
        }
        __syncthreads();
        for (int task = gwave; task < T / 4; task += nwaves) route_task(task, QP, KHL, IDX, GATE, lane);
        __syncthreads();
    }
    GRID_BAR();
    unsigned char* ACTQ = ws + WS_ACT; float* ACTS = (float*)(ws + WS_ACT + 4 * MiB); bf16* PEERO = (bf16*)(ws + WS_PEERO);
    unsigned* ctl = (unsigned*)ws;
    const int xcc = (int)(bar.x & 7u);
    if (IN(12)) {
        PHASE_VARS();
#pragma unroll 1
        for (int pi = 0; pi < NPART; ++pi) {
            const int p = (xcc + pi) & 7;
            for (;;) {
                if (tid == 0) MISC[16] = xb_add(&ctl[CW_QU + 64 * p], 1u);
                __syncthreads();
                const int j = (int)MISC[16];
                __syncthreads();
                if (j >= NCHUNK) break;
                peer_u_item(p, j, IDX, XQ, U8, PART, lane, wave);
            }
        }
    }
    GRID_BAR();
    if (IN(12)) {
        PHASE_VARS();
        for (int t0 = gwave; t0 < T; t0 += 2 * nwaves) {
            float av[2][2]; float mx[2];
#pragma unroll
            for (int q = 0; q < 2; ++q) {
                const int t = (t0 + q * nwaves < T) ? t0 + q * nwaves : t0;
                const float xs = XS[t];
#pragma unroll
                for (int hh = 0; hh < 2; ++hh) {
                    const int i = t * 128 + hh * 64 + lane;
                    float sf = 0.f;
#pragma unroll
                    for (int pp = 0; pp < NPART; ++pp) sf += bf2f(PART[(size_t)pp * T * 128 + i]);
                    const int e = IDX[i]; const float z = sf * SU[e] * xs;
                    av[q][hh] = GATE[i] * 0.5f * z * (1.f + erff(z * 0.70710678118654752f)) * SV[e];
                }
                mx[q] = fmaxf(fabsf(av[q][0]), fabsf(av[q][1]));
            }
#pragma unroll
            for (int o = 1; o < 64; o <<= 1) { mx[0] = fmaxf(mx[0], __shfl_xor(mx[0], o)); mx[1] = fmaxf(mx[1], __shfl_xor(mx[1], o)); }
#pragma unroll
            for (int q = 0; q < 2; ++q) {
                const int t = t0 + q * nwaves; if (t >= T) break;
                const float sc = mx[q] > 0.f ? mx[q] * (1.f / 127.f) : 1.f, inv = 1.f / sc;
                ACTQ[(size_t)t * 128 + lane] = (unsigned char)((int)rintf(av[q][0] * inv) & 255); ACTQ[(size_t)t * 128 + 64 + lane] = (unsigned char)((int)rintf(av[q][1] * inv) & 255);
                if (lane == 0) ACTS[t] = sc;
            }
        }
    }
    GRID_BAR();
    if (IN(13)) {
        PHASE_VARS();
#pragma unroll 1
        for (int pi = 0; pi < NPART; ++pi) {
            const int p = (xcc + pi) & 7;
            for (;;) {
                if (tid == 0) MISC[16] = xb_add(&ctl[CW_QV + 64 * p], 1u);
                __syncthreads();
                const int j = (int)MISC[16];
                __syncthreads();
                if (j >= NCHUNK) break;
                peer_v_item(p, j, IDX, ACTQ, ACTS, V8, PEERO, lane, wave);
            }
        }
    }
    GRID_BAR();
    if (IN(14)) {
        PHASE_VARS();
        for (int t = gwave; t < T; t += nwaves) {
            const uint2* hr = (const uint2*)(HB + (size_t)t * D) + lane; const uint2* pr = (const uint2*)(PEERO + (size_t)t * D) + lane;
            float4 v[4]; float ss = 0.f;
#pragma unroll
            for (int jq = 0; jq < 4; ++jq) { const uint2 hw = hr[64 * jq]; const float4 h4 = make_float4(__uint_as_float(hw.x << 16), __uint_as_float(hw.x & 0xffff0000u), __uint_as_float(hw.y << 16), __uint_as_float(hw.y & 0xffff0000u)); const uint2 pw = pr[64 * jq]; v[jq] = make_float4(h4.x + __uint_as_float(pw.x << 16), h4.y + __uint_as_float(pw.x & 0xffff0000u), h4.z + __uint_as_float(pw.y << 16), h4.w + __uint_as_float(pw.y & 0xffff0000u)); ss += v[jq].x * v[jq].x + v[jq].y * v[jq].y + v[jq].z * v[jq].z + v[jq].w * v[jq].w; }
            ss = wave_sum(ss);
            const float r3 = rsqrtf(ss * (1.f / D) + EPS);
            float4* op = (float4*)(a.out + (size_t)t * D) + lane;
#pragma unroll
            for (int jq = 0; jq < 4; ++jq) { const float4 gv = ((const float4*)a.final_norm_g)[lane + 64 * jq]; op[64 * jq] = make_float4(v[jq].x * r3 * gv.x, v[jq].y * r3 * gv.y, v[jq].z * r3 * gv.z, v[jq].w * r3 * gv.w); }
        }
    }
    PROBE_SPIN();
#undef IN
}
}

extern "C" void kernel_launch(void* const* d_in, const int* in_sizes, int n_in, void* d_out, int out_size, void* d_ws, size_t ws_size, hipStream_t stream) {
    if (n_in != 18 || out_size != T * D || ws_size < WS_END) { fprintf(stderr, "kernel_launch: unexpected shapes n_in=%d out=%d ws=%zu\n", n_in, out_size, ws_size); return; }
    Args a{};
    const float** ap = (const float**)&a;
    for (int i = 0; i < 18; ++i) ap[i] = (const float*)d_in[i];
    a.out = (float*)d_out; a.ws = (unsigned char*)d_ws;
    static int grid = 0;
    if (grid == 0) {
        int dev = 0, cus = 0, per_cu = 0;
        if (hipGetDevice(&dev) != hipSuccess || hipDeviceGetAttribute(&cus, hipDeviceAttributeMultiprocessorCount, dev) != hipSuccess) { fprintf(stderr, "kernel_launch: device query failed\n"); grid = -1; return; }
        if (hipFuncSetAttribute((const void*)k_main, hipFuncAttributeMaxDynamicSharedMemorySize, LDS_BYTES) != hipSuccess) { fprintf(stderr, "kernel_launch: hipFuncSetAttribute failed\n"); grid = -1; return; }
        if (hipOccupancyMaxActiveBlocksPerMultiprocessor(&per_cu, (const void*)k_main, NTHR, LDS_BYTES) != hipSuccess || per_cu < 1) { fprintf(stderr, "kernel_launch: occupancy query says %d blocks/CU\n", per_cu); (void)hipGetLastError(); grid = -1; return; }
        grid = cus;
    }
    if (grid < 0) return;
    if (hipMemsetAsync(d_ws, 0, 65536, stream) != hipSuccess) { fprintf(stderr, "kernel_launch: memset failed\n"); return; }
    a.ph_lo = 0; a.ph_hi = 15;
    hipLaunchKernelGGL(k_main, dim3(grid), dim3(NTHR), LDS_BYTES, stream, a);
}
```

```cpp
#include <hip/hip_runtime.h>
#include <cstdio>
#include <cstdint>


namespace pg8 {
#define PG8_LAS __attribute__((address_space(3)))
typedef unsigned short bf16_t;
typedef short bf16x8 __attribute__((ext_vector_type(8)));
typedef float f32x4 __attribute__((ext_vector_type(4)));
typedef unsigned u32x4 __attribute__((ext_vector_type(4)));
constexpr int BM = 256, BK = 64, HALF = 128, HTB = HALF * BK * 2  , STAGE_BYTES = 8 * HTB, NXCD = 8, WGM = 8;

__host__ __device__ __forceinline__ int lds_byte(int r, int c) { const int st = (r >> 4) * 2 + (c >> 5), rr = r & 15, cc = c & 31, ob = rr * 64 + cc * 2; return st * 1024 + (ob ^ (((ob >> 9) & 1) << 5)); }
__host__ __device__ __forceinline__ void stage_rc(int b, int& R, int& C) { const int st = b / 1024, sb = b % 1024, swz = sb ^ (((sb >> 9) & 1) << 5); R = (st >> 1) * 16 + swz / 64; C = (st & 1) * 32 + (swz % 64) / 2; }
__host__ __device__ __forceinline__ int perm32(int rho) { const int n = rho >> 4, i = rho & 15; return 8 * (i >> 2) + 4 * n + (i & 3); }

struct Unit { int pm, pn; };
struct Gemm { const bf16_t* A; const bf16_t* Bt; int M, N, K; };

struct StaticOrder {
    int nM, nN, nwg, G, c;
    __host__ __device__ void init(int M, int N, int G_, int c_) { nM = M / BM; nN = N / BM; nwg = nM * nN; G = G_; c = c_; }
    __host__ __device__ bool next(int i, Unit& u) const {
        const long L = (long)i * G + c; if (L >= nwg) return false;
        int wgid = (int)L; { const int q = nwg / NXCD, r = nwg % NXCD, xcd = wgid % NXCD, off = wgid / NXCD; wgid = (xcd < r ? xcd * (q + 1) : r * (q + 1) + (xcd - r) * q) + off; }
        const int nig = WGM * nN, gid = wgid / nig, fm = gid * WGM, gsz = (nM - fm) < WGM ? (nM - fm) : WGM;
        u.pm = fm + ((wgid % nig) % gsz); u.pn = (wgid % nig) / gsz; return true;
    }
    __device__ __forceinline__ void a_ready(const Unit&) const {}
    __device__ __forceinline__ void done(const Unit&) const {}
};
__device__ __forceinline__ unsigned cvt_pk_bf16(float lo, float hi) { unsigned r; asm volatile("v_cvt_pk_bf16_f32 %0, %1, %2" : "=v"(r) : "v"(lo), "v"(hi)); return r; }
typedef float f32x2 __attribute__((ext_vector_type(2)));
struct EpiBf16Plain {
    static constexpr bool PERM = true, AFTER_DRAIN = false;
    bf16_t* O; int ldc;
    __device__ __forceinline__ void operator()(const f32x4 (&acc)[2][2][4][2], const Unit& u, int wr, int wc, int fr, int fq) const {
        const int row0 = u.pm * BM + wr * 64 + fr, col0 = u.pn * BM + wc * 32 + 8 * fq;
#pragma unroll
        for (int ai = 0; ai < 2; ++ai)
#pragma unroll
            for (int m = 0; m < 4; ++m) { bf16_t* rowp = O + (size_t)(row0 + ai * HALF + m * 16) * ldc + col0;
#pragma unroll
                for (int bj = 0; bj < 2; ++bj) { const f32x4 v0 = acc[ai][bj][m][0], v1 = acc[ai][bj][m][1];
                    u32x4 w; w.x = cvt_pk_bf16(v0[0], v0[1]); w.y = cvt_pk_bf16(v0[2], v0[3]); w.z = cvt_pk_bf16(v1[0], v1[1]); w.w = cvt_pk_bf16(v1[2], v1[3]);
                    *(u32x4*)(rowp + bj * HALF) = w; } }
    }
};
struct EpiF32Resid {
    static constexpr bool PERM = false, AFTER_DRAIN = false;
    float* C; const float* R; int ldc;
    __device__ __forceinline__ void operator()(const f32x4 (&acc)[2][2][4][2], const Unit& u, int wr, int wc, int fr, int fq) const {
        const int row0 = u.pm * BM + wr * 64 + fr, col0 = u.pn * BM + wc * 32 + 4 * fq;
#pragma unroll
        for (int ai = 0; ai < 2; ++ai)
#pragma unroll
            for (int m = 0; m < 4; ++m) { const size_t off = (size_t)(row0 + ai * HALF + m * 16) * ldc + col0;
#pragma unroll
                for (int bj = 0; bj < 2; ++bj)
#pragma unroll
                    for (int n = 0; n < 2; ++n) { f32x4 v = acc[ai][bj][m][n]; if (R) v += *(const f32x4*)(R + off + bj * HALF + n * 16); *(f32x4*)(C + off + bj * HALF + n * 16) = v; }
                asm volatile("" ::: "memory"); }
    }
};

struct EpiBf16Resid {
    static constexpr bool PERM = true, AFTER_DRAIN = false;
    bf16_t* O; const float* R; int ldc;
    __device__ __forceinline__ void operator()(const f32x4 (&acc)[2][2][4][2], const Unit& u, int wr, int wc, int fr, int fq) const {
        const int row0 = u.pm * BM + wr * 64 + fr, col0 = u.pn * BM + wc * 32 + 8 * fq;
#pragma unroll
        for (int ai = 0; ai < 2; ++ai)
#pragma unroll
            for (int m = 0; m < 4; ++m) { const size_t off = (size_t)(row0 + ai * HALF + m * 16) * ldc + col0;
#pragma unroll
                for (int bj = 0; bj < 2; ++bj) { const f32x4 v0 = acc[ai][bj][m][0] + *(const f32x4*)(R + off + bj * HALF), v1 = acc[ai][bj][m][1] + *(const f32x4*)(R + off + bj * HALF + 4);
                    u32x4 w; w.x = cvt_pk_bf16(v0[0], v0[1]); w.y = cvt_pk_bf16(v0[2], v0[3]); w.z = cvt_pk_bf16(v1[0], v1[1]); w.w = cvt_pk_bf16(v1[2], v1[3]);
                    *(u32x4*)(O + off + bj * HALF) = w; }
                asm volatile("" ::: "memory"); }
    }
};
template <class Epi, class Sched, bool STAMP = false>
__device__ __forceinline__ void gemm_phase(PG8_LAS unsigned char* lds, const Gemm g, const Sched& S, const Epi& E, unsigned long long* stamps) {
    const int tid = threadIdx.x, wid = __builtin_amdgcn_readfirstlane(tid >> 6), lane = tid & 63, wr = wid >> 2, wc = wid & 3, fr = lane & 15, fq = lane >> 4;
    const int K = g.K, nt = K / BK;
    int ts_lo = 0, ts_hi = 0, nts = 0; const unsigned long long rt_entry = STAMP ? (unsigned long long)0ull : 0ull;
#define PG8_STAMP() do { if (STAMP && wid == 0 && nts < 64) { const unsigned long long _c = (unsigned long long)clock64(); \
        ts_lo = (lane == nts) ? (int)(unsigned)_c : ts_lo; ts_hi = (lane == nts) ? (int)(unsigned)(_c >> 32) : ts_hi; ++nts; } } while (0)
    PG8_STAMP();
    unsigned voffA[2], voffB[2];
#pragma unroll
    for (int i = 0; i < 2; ++i) { int R, C; stage_rc(tid * 16 + i * 8192, R, C); const int Rb = Epi::PERM ? ((R & ~31) + perm32(R & 31)) : R;
        voffA[i] = (unsigned)(R * K + C) * 2u; voffB[i] = (unsigned)(Rb * K + C) * 2u; }
    const size_t kstep = (size_t)(BK * 2);
    const size_t hstep = (size_t)HALF * K * 2;
    const size_t tstep = 2 * hstep;
    const unsigned ldsw = (unsigned)wid * 1024u;
    const int aoff = lds_byte(wr * 64 + fr, fq * 8), boff = lds_byte(wc * 32 + fr, fq * 8);
#define PG8_SA(b, h) (((b) * 2 + (h)) * HTB)
#define PG8_SB(b, h) ((4 + (b) * 2 + (h)) * HTB)
#define PG8_STAGE(bufoff, gbase, voff) do { _Pragma("unroll") for (int _i = 0; _i < 2; ++_i) \
        __builtin_amdgcn_global_load_lds((const unsigned*)((const char*)(gbase) + (voff)[_i]), (PG8_LAS unsigned*)(lds + (bufoff) + ldsw + _i * 8192), 16, 0, 0); } while (0)
#define PG8_LDA(dst, b, h) do { _Pragma("unroll") for (int m = 0; m < 4; ++m) _Pragma("unroll") for (int k = 0; k < 2; ++k) dst[m][k] = *(const PG8_LAS bf16x8*)(lds + PG8_SA(b, h) + aoff + m * 2048 + k * 1024); } while (0)
#define PG8_LDB(dst, b, h) do { _Pragma("unroll") for (int n = 0; n < 2; ++n) _Pragma("unroll") for (int k = 0; k < 2; ++k) dst[n][k] = *(const PG8_LAS bf16x8*)(lds + PG8_SB(b, h) + boff + n * 2048 + k * 1024); } while (0)
#define PG8_MMA(ai, bj, At, Bt) do { __builtin_amdgcn_s_setprio(1); _Pragma("unroll") for (int m = 0; m < 4; ++m) _Pragma("unroll") for (int n = 0; n < 2; ++n) _Pragma("unroll") for (int k = 0; k < 2; ++k) \
        acc[ai][bj][m][n] = __builtin_amdgcn_mfma_f32_16x16x32_bf16(Bt[n][k], At[m][k], acc[ai][bj][m][n], 0, 0, 0); __builtin_amdgcn_s_setprio(0); } while (0)
#define PG8_WAIT_V(n) asm volatile("s_waitcnt vmcnt(" #n ")" ::: "memory")
#define PG8_WAIT_L(n) asm volatile("s_waitcnt lgkmcnt(" #n ")" ::: "memory")
#define PG8_BAR __builtin_amdgcn_s_barrier()
#define PG8_SCHED __builtin_amdgcn_sched_barrier(0)
    Unit cur, nxt; int ui = 0;
    if (!S.next(0, cur)) return;
    f32x4 acc[2][2][4][2];
#pragma unroll
    for (int a = 0; a < 2; ++a)
#pragma unroll
        for (int b = 0; b < 2; ++b)
#pragma unroll
            for (int m = 0; m < 4; ++m)
#pragma unroll
                for (int n = 0; n < 2; ++n) acc[a][b][m][n] = (f32x4){0.f, 0.f, 0.f, 0.f};
    bf16x8 At[4][2], B0[2][2], B1[2][2];
    const char* cA = (const char*)g.A + (size_t)cur.pm * tstep; const char* cB = (const char*)g.Bt + (size_t)cur.pn * tstep;
    S.a_ready(cur);
    PG8_STAGE(PG8_SB(0, 0), cB, voffB); PG8_STAGE(PG8_SA(0, 0), cA, voffA); PG8_STAGE(PG8_SB(0, 1), cB + hstep, voffB); PG8_STAGE(PG8_SA(0, 1), cA + hstep, voffA);
    if (wr == 1) PG8_BAR;
    PG8_WAIT_V(4); PG8_BAR;
    PG8_STAGE(PG8_SB(1, 0), cB + kstep, voffB); PG8_STAGE(PG8_SA(1, 0), cA + kstep, voffA); PG8_STAGE(PG8_SB(1, 1), cB + hstep + kstep, voffB);
    PG8_WAIT_V(6); PG8_BAR;
    PG8_STAMP();
    for (;;) {
        const bool has_next = S.next(ui + 1, nxt);
        const char* nA = has_next ? (const char*)g.A + (size_t)nxt.pm * tstep : cA; const char* nB = has_next ? (const char*)g.Bt + (size_t)nxt.pn * tstep : cB;
        for (int t = 0; t < nt; t += 2) {
            const bool last = (t == nt - 2);
            const char* a1 = cA + (size_t)(t + 1) * kstep;
            const char* a2 = last ? nA : cA + (size_t)(t + 2) * kstep; const char* b2 = last ? nB : cB + (size_t)(t + 2) * kstep;
            const char* a3 = a2 + kstep; const char* b3 = b2 + kstep;
            if (last && has_next) S.a_ready(nxt);
            PG8_LDB(B0, 0, 0); PG8_SCHED; PG8_LDA(At, 0, 0); PG8_STAGE(PG8_SA(1, 1), a1 + hstep, voffA);
            PG8_WAIT_L(8); PG8_BAR; PG8_WAIT_L(0); PG8_MMA(0, 0, At, B0); PG8_BAR; PG8_SCHED;
            PG8_LDB(B1, 0, 1); PG8_STAGE(PG8_SB(0, 0), b2, voffB);
            PG8_BAR; PG8_WAIT_L(0); PG8_MMA(0, 1, At, B1); PG8_BAR;
            PG8_LDA(At, 0, 1); PG8_STAGE(PG8_SA(0, 0), a2, voffA);
            PG8_BAR; PG8_WAIT_L(0); PG8_MMA(1, 0, At, B0); PG8_BAR; PG8_SCHED;
            PG8_STAGE(PG8_SB(0, 1), b2 + hstep, voffB);
            PG8_WAIT_V(6); PG8_BAR; PG8_MMA(1, 1, At, B1); PG8_BAR;
            PG8_LDB(B0, 1, 0); PG8_SCHED; PG8_LDA(At, 1, 0); PG8_STAGE(PG8_SA(0, 1), a2 + hstep, voffA);
            PG8_WAIT_L(8); PG8_BAR; PG8_WAIT_L(0); PG8_MMA(0, 0, At, B0); PG8_BAR; PG8_SCHED;
            PG8_LDB(B1, 1, 1); PG8_STAGE(PG8_SB(1, 0), b3, voffB);
            PG8_BAR; PG8_WAIT_L(0); PG8_MMA(0, 1, At, B1); PG8_BAR;
            PG8_LDA(At, 1, 1); PG8_STAGE(PG8_SA(1, 0), a3, voffA);
            PG8_BAR; PG8_WAIT_L(0); PG8_MMA(1, 0, At, B0); PG8_BAR; PG8_SCHED;
            PG8_STAGE(PG8_SB(1, 1), b3 + hstep, voffB);
            PG8_WAIT_V(6); PG8_BAR; PG8_MMA(1, 1, At, B1); PG8_BAR;
        }
        PG8_STAMP();
        if constexpr (!Epi::AFTER_DRAIN) { E(acc, cur, wr, wc, fr, fq); S.done(cur); }
        PG8_STAMP();
        if (!has_next) break;
#pragma unroll
        for (int a = 0; a < 2; ++a)
#pragma unroll
            for (int b = 0; b < 2; ++b)
#pragma unroll
                for (int m = 0; m < 4; ++m)
#pragma unroll
                    for (int n = 0; n < 2; ++n) acc[a][b][m][n] = (f32x4){0.f, 0.f, 0.f, 0.f};
        cur = nxt; cA = nA; cB = nB; ++ui;
    }
    PG8_WAIT_V(0);
    if (wr == 0) PG8_BAR;
    PG8_BAR;
    if constexpr (Epi::AFTER_DRAIN) { E.fused(acc, cur, wr, wc, fr, fq, lds, wid, lane); S.done(cur); }
    PG8_STAMP();
    if (STAMP && wid == 0) { stamps[lane] = lane < nts ? (((unsigned long long)(unsigned)ts_hi << 32) | (unsigned)ts_lo) : 0ull;
        if (lane == 62) stamps[62] = rt_entry; if (lane == 63) stamps[63] = (unsigned long long)0ull; }
#undef PG8_STAMP
#undef PG8_SA
#undef PG8_SB
#undef PG8_STAGE
#undef PG8_LDA
#undef PG8_LDB
#undef PG8_MMA
#undef PG8_WAIT_V
#undef PG8_WAIT_L
#undef PG8_BAR
#undef PG8_SCHED
}
}

namespace {
constexpr int D = 1024, BATCH = 2, SEQ = 8192, T = BATCH * SEQ;
constexpr int PW = 2312;
constexpr int PS = 2304;
constexpr int OQ = 0, OKK = 512, OV = 640, OZ = 768, OXBC = 1280, ODT = 2304;
constexpr float EPS = 1e-6f;
constexpr int NTHR = 512;
typedef unsigned short bf16;
typedef unsigned v4u __attribute__((ext_vector_type(4)));

constexpr size_t MiB = 1u << 20;
constexpr size_t WS_WIN = 1 * MiB;
constexpr size_t WS_KH = 5 * MiB + 512 * 1024;
constexpr size_t WS_WO = 6 * MiB;
constexpr size_t WS_WQ = 8 * MiB;
constexpr size_t WS_PROJ = 10 * MiB;
constexpr size_t WS_XNB = 82 * MiB;
constexpr size_t WS_XACT = 114 * MiB;
constexpr size_t WS_DTRAW = 146 * MiB;
constexpr size_t WS_DT = WS_DTRAW + 512 * 1024;
constexpr size_t WS_ACS = WS_DT + 512 * 1024;
constexpr size_t WS_CDEC = WS_ACS + 512 * 1024;
constexpr size_t WS_STATES = 164 * MiB;
constexpr size_t WS_PREV = 196 * MiB;
constexpr size_t WS_QP = 10 * MiB;
constexpr size_t WS_IDX = 74 * MiB;
constexpr size_t WS_GATE = 114 * MiB;
constexpr size_t WS_TOPV = 122 * MiB;
constexpr size_t WS_TOPI = 138 * MiB;
constexpr size_t WS_ACT = 122 * MiB;
constexpr size_t WS_SU = 245 * MiB;
constexpr size_t WS_U8 = 212 * MiB;
constexpr size_t WS_V8 = 148 * MiB;
constexpr size_t WS_PART = 10 * MiB;
constexpr size_t WS_XQ = 228 * MiB;
constexpr size_t WS_XS = 244 * MiB;
constexpr size_t WS_PEERO = 10 * MiB;
constexpr size_t WS_END = 246 * MiB;
constexpr int CW_QU = 4096, CW_QV = 4096 + 64 * 16;
constexpr int NPART = 8, NCHUNK = T / 64;

struct Args {
    const float* x; const float* norm_mix_g; const float* w_in; const float* attn_sinks; const float* attn_out_g;
    const float* conv_w; const float* conv_b; const float* dt_bias; const float* a_log; const float* d_skip;
    const float* ssm_norm_g; const float* w_out; const float* norm_ffn_g; const float* peer_wq; const float* peer_sub_keys;
    const float* peer_u; const float* peer_v; const float* final_norm_g;
    float* out; unsigned char* ws;
    int ph_lo, ph_hi;
};

#define LAS __attribute__((address_space(3)))
#define LDS_WAIT() asm volatile("s_waitcnt lgkmcnt(0)" ::: "memory")
__device__ __forceinline__ float bf2f(bf16 v) { return __uint_as_float(((unsigned)v) << 16); }
__device__ __forceinline__ unsigned f2bfu(float f) { unsigned u = __float_as_uint(f); return (u + 0x7fffu + ((u >> 16) & 1u)) >> 16; }
__device__ __forceinline__ bf16 f2bf(float f) { return (bf16)f2bfu(f); }
__device__ __forceinline__ unsigned pk2(float lo, float hi) { return f2bfu(lo) | (f2bfu(hi) << 16); }
__device__ __forceinline__ float wave_sum(float v) {
#pragma unroll
    for (int o = 1; o < 64; o <<= 1) v += __shfl_xor(v, o);
    return v;
}
__device__ __forceinline__ float silu_f(float v) { return v / (1.f + __expf(-v)); }

__device__ __forceinline__ void transpose_item(const float* W, int ldw, int K, bf16* WT, LAS float* scr, int kb, int nbk, int lane) {
    const int k0 = 64 * kb, n0 = 32 * nbk;
#pragma unroll 8
    for (int i = 0; i < 32; ++i) { const int kk = 2 * i + (lane >> 5); scr[kk * 33 + (lane & 31)] = W[(size_t)(k0 + kk) * ldw + n0 + (lane & 31)]; }
    LDS_WAIT();
    const int c = lane & 7;
#pragma unroll
    for (int j = 0; j < 4; ++j) { const int n = (lane >> 3) + 8 * j; const LAS float* s = scr + (8 * c) * 33 + n;
        v4u o; o.x = pk2(s[0 * 33], s[1 * 33]); o.y = pk2(s[2 * 33], s[3 * 33]); o.z = pk2(s[4 * 33], s[5 * 33]); o.w = pk2(s[6 * 33], s[7 * 33]);
        *(v4u*)(WT + (size_t)(n0 + n) * K + k0 + 8 * c) = o; }
    LDS_WAIT();
}

template <int MODE  >
__device__ __forceinline__ void rmsnorm_rows_bf16(const float* __restrict__ in, const float* __restrict__ g, bf16* __restrict__ outp, const LAS unsigned char* ldsb, float* __restrict__ dtraw, unsigned char* __restrict__ xq, float* __restrict__ xs, int gwave, int nwaves, int lane) {
#pragma unroll 2
    for (int row = gwave; row < T; row += nwaves) {
        const float4* xr = (const float4*)(in + (size_t)row * D) + lane; const uint2* xb = (const uint2*)((const bf16*)in + (size_t)row * D) + lane;
        float4 v[4]; float ss = 0.f;
#pragma unroll
        for (int j = 0; j < 4; ++j) {
            if (MODE == 2) { const uint2 w = xb[64 * j]; v[j] = make_float4(__uint_as_float(w.x << 16), __uint_as_float(w.x & 0xffff0000u), __uint_as_float(w.y << 16), __uint_as_float(w.y & 0xffff0000u)); }
            else v[j] = xr[64 * j];
            ss += v[j].x * v[j].x + v[j].y * v[j].y + v[j].z * v[j].z + v[j].w * v[j].w; }
        ss = wave_sum(ss);
        const float r = rsqrtf(ss * (1.f / D) + EPS);
        unsigned long long* o8 = (unsigned long long*)(outp + (size_t)row * D) + lane;
        float dacc[8]; float y[4][4]; float mx = 0.f;
#pragma unroll
        for (int h = 0; h < 8; ++h) dacc[h] = 0.f;
#pragma unroll
        for (int j = 0; j < 4; ++j) {
            const float4 gv = ((const float4*)g)[lane + 64 * j];
            y[j][0] = v[j].x * r * gv.x; y[j][1] = v[j].y * r * gv.y; y[j][2] = v[j].z * r * gv.z; y[j][3] = v[j].w * r * gv.w;
            o8[64 * j] = (unsigned long long)pk2(y[j][0], y[j][1]) | ((unsigned long long)pk2(y[j][2], y[j][3]) << 32);
            if (MODE == 2) mx = fmaxf(mx, fmaxf(fmaxf(fabsf(y[j][0]), fabsf(y[j][1])), fmaxf(fabsf(y[j][2]), fabsf(y[j][3]))));
            if (MODE == 1) {
#pragma unroll
                for (int h = 0; h < 8; ++h) {
                    typedef float f4v __attribute__((ext_vector_type(4)));
                    const f4v wv = *(const LAS f4v*)(ldsb + h * 16384 + 8448 + (256 * j + 4 * lane) * 4);
                    dacc[h] += y[j][0] * wv.x + y[j][1] * wv.y + y[j][2] * wv.z + y[j][3] * wv.w;
                }
            }
        }
        if (MODE == 1) {
#pragma unroll
            for (int h = 0; h < 8; ++h) dacc[h] = wave_sum(dacc[h]);
            if (lane == 0) { float4* dp = (float4*)(dtraw + (size_t)row * 8); dp[0] = make_float4(dacc[0], dacc[1], dacc[2], dacc[3]); dp[1] = make_float4(dacc[4], dacc[5], dacc[6], dacc[7]); }
        }
        if (MODE == 2) {
#pragma unroll
            for (int o = 1; o < 64; o <<= 1) mx = fmaxf(mx, __shfl_xor(mx, o));
            const float sc = mx > 0.f ? mx * (1.f / 127.f) : 1.f, inv = 1.f / sc;
            unsigned* dq = (unsigned*)(xq + (size_t)row * D) + lane;
#pragma unroll
            for (int j = 0; j < 4; ++j) { const int q0 = (int)rintf(y[j][0] * inv), q1 = (int)rintf(y[j][1] * inv), q2 = (int)rintf(y[j][2] * inv), q3 = (int)rintf(y[j][3] * inv);
                dq[64 * j] = (unsigned)(q0 & 255) | ((unsigned)(q1 & 255) << 8) | ((unsigned)(q2 & 255) << 16) | ((unsigned)(q3 & 255) << 24); }
            if (lane == 0) xs[row] = sc;
        }
    }
}

typedef short bf16x8 __attribute__((ext_vector_type(8)));
typedef short bf16x4 __attribute__((ext_vector_type(4)));
typedef float f32x16 __attribute__((ext_vector_type(16)));
typedef __bf16 bf2_t __attribute__((ext_vector_type(2)));
#define MFMA32(a, b, c) __builtin_amdgcn_mfma_f32_32x32x16_bf16((a), (b), (c), 0, 0, 0)
__device__ __forceinline__ unsigned pkbf(float lo, float hi) { bf2_t v = {(__bf16)lo, (__bf16)hi}; return __builtin_bit_cast(unsigned, v); }
__device__ __forceinline__ short bfs(float f) { return __builtin_bit_cast(short, (__bf16)f); }
__device__ __forceinline__ float sbf2f(short v) { return __uint_as_float(((unsigned)(unsigned short)v) << 16); }
__device__ __forceinline__ int crow(int i, int hi) { return (i & 3) + 8 * (i >> 2) + 4 * hi; }
template <int S> __device__ __forceinline__ bf16x8 pack8(const f32x16& x) {
    v4u p; p.x = pkbf(x[8 * S], x[8 * S + 1]); p.y = pkbf(x[8 * S + 2], x[8 * S + 3]); p.z = pkbf(x[8 * S + 4], x[8 * S + 5]); p.w = pkbf(x[8 * S + 6], x[8 * S + 7]);
    return __builtin_bit_cast(bf16x8, p);
}
__device__ __forceinline__ bf16x8 ldg8(const bf16* p) { return *(const bf16x8*)p; }
__device__ __forceinline__ bf16x8 lds8(const LAS bf16* p) { return *(const LAS bf16x8*)p; }
__device__ __forceinline__ bf16x8 lds4x2(const LAS bf16* p) { const bf16x4 a = *(const LAS bf16x4*)p, b = *(const LAS bf16x4*)(p + 8); return __builtin_shufflevector(a, b, 0, 1, 2, 3, 4, 5, 6, 7); }
__device__ __forceinline__ f32x16 zero16() { f32x16 z;
#pragma unroll
    for (int i = 0; i < 16; ++i) z[i] = 0.f;
    return z; }

__device__ __forceinline__ void attn_unit(const float* sinks, const float* gnorm, LAS unsigned char* ldsb, int unit, const bf16* PROJ, bf16* MIXB, int tid, int lane, int wave) {
    asm volatile("" : "+v"(tid), "+v"(lane));
    const int tok0 = unit * 64, s0 = tok0 & (SEQ - 1), kbase = tok0 - 128;
    LAS bf16* VT = (LAS bf16*)ldsb;
    LAS bf16* KI = (LAS bf16*)(ldsb + 51200);
    LAS float* SSQ = (LAS float*)(ldsb + 51200 + 55296);
    const __amdgpu_buffer_rsrc_t rsP = __builtin_amdgcn_make_buffer_rsrc((void*)PROJ, 0, (unsigned)T * PS * 2u, 0x00020000);
#pragma unroll
    for (int i = 0; i < 6; ++i) {
        const int c = tid + 512 * i, kv = c / 1536, cc = c - kv * 1536, key = cc >> 3, d0 = (cc & 7) * 8; const bool valid = (s0 - 128 + key) >= 0;
        bf16x8 v, k;
#pragma unroll
        for (int e = 0; e < 8; ++e) { v[e] = 0; k[e] = 0; }
        if (valid) { const unsigned ro = (unsigned)(kbase + key) * (unsigned)PS + (unsigned)(kv * 64 + d0);
            v = __builtin_bit_cast(bf16x8, __builtin_amdgcn_raw_buffer_load_b128(rsP, (int)((ro + (unsigned)OV) * 2u), 0, 0));
            k = __builtin_bit_cast(bf16x8, __builtin_amdgcn_raw_buffer_load_b128(rsP, (int)((ro + (unsigned)OKK) * 2u), 0, 0)); }
#pragma unroll
        for (int e = 0; e < 8; ++e) VT[kv * 12800 + (d0 + e) * 200 + key] = (bf16)v[e];
        *(LAS bf16x8*)(KI + (kv * 192 + key) * 72 + d0) = k;
    }
    __syncthreads();
    const int r = lane & 31, hi = lane >> 5;
    const int hq = wave, hkv = wave >> 2;
    const float slope = exp2f(-(float)(hq + 1)), sink = sinks[hq];
#pragma unroll 1
    for (int qt = 0; qt < 2; ++qt) {
        const int tq = tok0 + 32 * qt + r;
        bf16x8 qf[4];
        { const bf16* qp = PROJ + (size_t)tq * PS + OQ + hq * 64 + 8 * hi; asm volatile("" : "+v"(qp));
#pragma unroll
          for (int ks = 0; ks < 4; ++ks) qf[ks] = ldg8(qp + 16 * ks); }
        const int ql = 32 * qt + r;
        float m = sink, lh = 0.f;
        f32x16 O0 = zero16(), O1 = zero16();
#pragma unroll 1
        for (int kt = 0; kt < 5; ++kt) {
            const LAS bf16* kp = KI + (hkv * 192 + 32 * (qt + kt) + r) * 72 + 8 * hi;
            f32x16 X = zero16();
#pragma unroll
            for (int ks = 0; ks < 4; ++ks) X = MFMA32(lds8(kp + 16 * ks), qf[ks], X);
            float tm = -1e30f;
#pragma unroll
            for (int i = 0; i < 16; ++i) {
                const int kl = 32 * (qt + kt) + crow(i, hi), dist = 128 + ql - kl;
                const bool valid = (dist >= 0) && (dist < 128) && ((s0 - 128 + kl) >= 0);
                const float lg = valid ? (X[i] * 0.125f - slope * (float)dist) : -1e30f;
                X[i] = lg; tm = fmaxf(tm, lg);
            }
            tm = fmaxf(tm, __shfl_xor(tm, 32));
            const float mn = fmaxf(m, tm), sc = __expf(m - mn);
            m = mn; lh *= sc;
#pragma unroll
            for (int i = 0; i < 16; ++i) { O0[i] *= sc; O1[i] *= sc; const float pe = __expf(X[i] - mn); X[i] = pe; lh += pe; }
            const LAS bf16* vp = VT + hkv * 12800 + r * 200 + 32 * (qt + kt) + 4 * hi;
            { const bf16x8 xs = pack8<0>(X); const bf16x8 a0 = lds4x2(vp), a1 = lds4x2(vp + 32 * 200); O0 = MFMA32(a0, xs, O0); O1 = MFMA32(a1, xs, O1); }
            { const bf16x8 xs = pack8<1>(X); const bf16x8 a0 = lds4x2(vp + 16), a1 = lds4x2(vp + 32 * 200 + 16); O0 = MFMA32(a0, xs, O0); O1 = MFMA32(a1, xs, O1); }
        }
        const float lsum = lh + __shfl_xor(lh, 32) + __expf(sink - m);
        const float iv = 1.f / lsum;
        float sq = 0.f;
#pragma unroll
        for (int i = 0; i < 16; ++i) sq += O0[i] * O0[i] + O1[i] * O1[i];
        sq *= iv * iv; sq += __shfl_xor(sq, 32);
        if (hi == 0) SSQ[hq * 32 + r] = sq;
        __syncthreads();
        float tot = 0.f;
#pragma unroll
        for (int h = 0; h < 8; ++h) tot += SSQ[h * 32 + r];
        const float sc = iv * rsqrtf(tot * (1.f / 512.f) + EPS);
        bf16* orow = MIXB + (size_t)tq * D + hq * 64 + 4 * hi;
#pragma unroll
        for (int q4 = 0; q4 < 4; ++q4) {
            const float4 g0 = *(const float4*)(gnorm + hq * 64 + 8 * q4 + 4 * hi), g1 = *(const float4*)(gnorm + hq * 64 + 32 + 8 * q4 + 4 * hi);
            uint2 w0, w1;
            w0.x = pkbf(O0[4 * q4] * sc * g0.x, O0[4 * q4 + 1] * sc * g0.y); w0.y = pkbf(O0[4 * q4 + 2] * sc * g0.z, O0[4 * q4 + 3] * sc * g0.w);
            w1.x = pkbf(O1[4 * q4] * sc * g1.x, O1[4 * q4 + 1] * sc * g1.y); w1.y = pkbf(O1[4 * q4 + 2] * sc * g1.z, O1[4 * q4 + 3] * sc * g1.w);
            *(uint2*)(orow + 8 * q4) = w0; *(uint2*)(orow + 32 + 8 * q4) = w1;
        }
        __syncthreads();
    }
}

__device__ __forceinline__ void ssd_chunk_unit(LAS unsigned char* ldsb, int unit, const bf16* PROJ, bf16* XACT, const float* DTRAW, const float* conv_w, const float* conv_b, const float* dt_bias, const float* a_log,
                                               float* ACS, float* CDEC, float* MIXF, float* STATES, int tid, int lane, int wave) {
    asm volatile("" : "+v"(tid), "+v"(lane));
    const int g = unit & 1, bc = unit >> 1, tok0 = bc * 128;
    LAS float* DTT = (LAS float*)(ldsb + 34816 * 3 + 2048);
    LAS float* WT = (LAS float*)(ldsb + 34816 * 3 + 4096);
    {
        const int cgi = tid & 63, t0 = tok0 + 16 * (tid >> 6);
        const int c0 = cgi < 32 ? g * 256 + cgi * 8 : (cgi < 48 ? 512 + g * 128 + (cgi - 32) * 8 : 768 + g * 128 + (cgi - 48) * 8);
        float w[4][8], bs[8];
#pragma unroll
        for (int k = 0; k < 4; ++k) { const float4 a0 = *(const float4*)(conv_w + k * 1024 + c0), a1 = *(const float4*)(conv_w + k * 1024 + c0 + 4);
            w[k][0] = a0.x; w[k][1] = a0.y; w[k][2] = a0.z; w[k][3] = a0.w; w[k][4] = a1.x; w[k][5] = a1.y; w[k][6] = a1.z; w[k][7] = a1.w; }
        { const float4 a0 = *(const float4*)(conv_b + c0), a1 = *(const float4*)(conv_b + c0 + 4); bs[0] = a0.x; bs[1] = a0.y; bs[2] = a0.z; bs[3] = a0.w; bs[4] = a1.x; bs[5] = a1.y; bs[6] = a1.z; bs[7] = a1.w; }
        const bool has_halo = (t0 & (SEQ - 1)) != 0;
        bf16x8 rows[19];
#pragma unroll
        for (int i = 0; i < 19; ++i) {
            if (i < 3 && !has_halo) {
#pragma unroll
                for (int e = 0; e < 8; ++e) rows[i][e] = 0;
            } else rows[i] = ldg8(PROJ + (size_t)(t0 + i - 3) * PS + OXBC + c0);
        }
#pragma unroll
        for (int i = 0; i < 16; ++i) {
            float o[8];
#pragma unroll
            for (int e = 0; e < 8; ++e) o[e] = silu_f(bs[e] + w[0][e] * sbf2f(rows[i][e]) + w[1][e] * sbf2f(rows[i + 1][e]) + w[2][e] * sbf2f(rows[i + 2][e]) + w[3][e] * sbf2f(rows[i + 3][e]));
            v4u ov; ov.x = pkbf(o[0], o[1]); ov.y = pkbf(o[2], o[3]); ov.z = pkbf(o[4], o[5]); ov.w = pkbf(o[6], o[7]);
            *(v4u*)(XACT + (size_t)(t0 + i) * 1024 + c0) = ov;
        }
    }
    LAS float* ACST = (LAS float*)(ldsb + 34816 * 3);
    {
        const int s = tid >> 2, hh = tid & 3, H = g * 4 + hh;
        const float A = -__expf(a_log[H]);
        const float raw = DTRAW[(size_t)(tok0 + s) * 8 + H] + dt_bias[H];
        const float dtv = fmaxf(raw, 0.f) + log1pf(__expf(-fabsf(raw)));
        float v = dtv * A;
#pragma unroll
        for (int o = 4; o < 64; o <<= 1) { const float y = __shfl_up(v, o); if (lane >= o) v += y; }
        if (lane >= 60) WT[wave * 4 + hh] = v;
        __syncthreads();
        float off = 0.f;
        for (int w2 = 0; w2 < wave; ++w2) off += WT[w2 * 4 + hh];
        v += off;
        DTT[tid] = dtv; ACST[tid] = v; ACS[(size_t)(tok0 + s) * 8 + H] = v;
        if (s == 127) CDEC[bc * 8 + H] = __expf(v);
    }
    asm volatile("s_waitcnt vmcnt(0)" ::: "memory");
    __syncthreads();
    LAS bf16* BT = (LAS bf16*)ldsb;
    LAS bf16* XD = (LAS bf16*)(ldsb + 34816);
    LAS bf16* XW = (LAS bf16*)(ldsb + 34816 + 34816);
    const int r = lane & 31, hi = lane >> 5;
#pragma unroll
    for (int i = 0; i < 4; ++i) {
        const int c = tid + 512 * i, s = c >> 4, n0 = (c & 15) * 8;
        const bf16x8 v = ldg8(XACT + (size_t)(tok0 + s) * 1024 + 512 + g * 128 + n0);
#pragma unroll
        for (int e = 0; e < 8; ++e) BT[(n0 + e) * 136 + s] = (bf16)v[e];
    }
#pragma unroll 1
    for (int hp = 0; hp < 2; ++hp) {
        if (hp) __syncthreads();
        int tidp = tid; asm volatile("" : "+v"(tidp));
#pragma unroll
        for (int i = 0; i < 4; ++i) {
            const int c = tidp + 512 * i, hsel = c >> 10, s = (c >> 3) & 127, p0 = (c & 7) * 8, H = g * 4 + 2 * hp + hsel;
            const bf16x8 v = ldg8(XACT + (size_t)(tok0 + s) * 1024 + H * 64 + p0);
            const float dtv = DTT[s * 4 + 2 * hp + hsel];
            const float w = __expf(ACST[127 * 4 + 2 * hp + hsel] - ACST[s * 4 + 2 * hp + hsel]);
#pragma unroll
            for (int e = 0; e < 8; ++e) { const float xd = sbf2f(v[e]) * dtv; XD[hsel * 8704 + (p0 + e) * 136 + s] = (bf16)bfs(xd); XW[hsel * 8704 + (p0 + e) * 136 + s] = (bf16)bfs(xd * w); }
        }
        __syncthreads();
        {
            const int lt = wave & 3, hsel = wave >> 2, hh = 2 * hp + hsel, H = g * 4 + hh;
            const int l = 32 * lt + r; const float acs_l = ACST[l * 4 + hh];
            bf16x8 cf[8];
            { const bf16* cp = XACT + (size_t)(tok0 + l) * 1024 + 768 + g * 128 + 8 * hi; asm volatile("" : "+v"(cp));
#pragma unroll
              for (int ks = 0; ks < 8; ++ks) cf[ks] = ldg8(cp + 16 * ks); }
            f32x16 Z0 = zero16(), Z1 = zero16();
            bf16x8 bn[8];
            { const bf16* bp = XACT + (size_t)(tok0 + r) * 1024 + 512 + g * 128 + 8 * hi; asm volatile("" : "+v"(bp));
#pragma unroll
              for (int ks = 0; ks < 8; ++ks) bn[ks] = ldg8(bp + 16 * ks); }
#pragma unroll 1
            for (int st = 0; st <= lt; ++st) {
                f32x16 X = zero16();
                bf16x8 bc[8];
#pragma unroll
                for (int ks = 0; ks < 8; ++ks) bc[ks] = bn[ks];
                { const int stn = st < lt ? st + 1 : lt; const bf16* bp = XACT + (size_t)(tok0 + 32 * stn + r) * 1024 + 512 + g * 128 + 8 * hi; asm volatile("" : "+v"(bp));
#pragma unroll
                  for (int ks = 0; ks < 8; ++ks) bn[ks] = ldg8(bp + 16 * ks); }
#pragma unroll
                for (int ks = 0; ks < 8; ++ks) X = MFMA32(bc[ks], cf[ks], X);
#pragma unroll
                for (int i = 0; i < 16; ++i) { const int s = 32 * st + crow(i, hi); const float f = (s <= l) ? __expf(acs_l - ACST[s * 4 + hh]) : 0.f; X[i] *= f; }
                const int sb = 32 * st + 4 * hi;
                { const bf16x8 xs = pack8<0>(X); const bf16x8 b0 = lds4x2(XD + hsel * 8704 + r * 136 + sb), b1 = lds4x2(XD + hsel * 8704 + (32 + r) * 136 + sb); Z0 = MFMA32(xs, b0, Z0); Z1 = MFMA32(xs, b1, Z1); }
                { const bf16x8 xs = pack8<1>(X); const bf16x8 b0 = lds4x2(XD + hsel * 8704 + r * 136 + sb + 16), b1 = lds4x2(XD + hsel * 8704 + (32 + r) * 136 + sb + 16); Z0 = MFMA32(xs, b0, Z0); Z1 = MFMA32(xs, b1, Z1); }
            }
#pragma unroll
            for (int i = 0; i < 16; ++i) { float* o = MIXF + (size_t)(tok0 + 32 * lt + crow(i, hi)) * D + 512 + H * 64 + r; o[0] = Z0[i]; o[32] = Z1[i]; }
        }
        {
            const int nt = wave & 3, hsel = wave >> 2, H = g * 4 + 2 * hp + hsel;
            f32x16 S0 = zero16(), S1 = zero16();
#pragma unroll
            for (int ks = 0; ks < 8; ++ks) {
                const bf16x8 btf = lds8(BT + (32 * nt + r) * 136 + 16 * ks + 8 * hi);
                const bf16x8 a0 = lds8(XW + hsel * 8704 + r * 136 + 16 * ks + 8 * hi), a1 = lds8(XW + hsel * 8704 + (32 + r) * 136 + 16 * ks + 8 * hi);
                S0 = MFMA32(a0, btf, S0); S1 = MFMA32(a1, btf, S1);
            }
            float* sp = STATES + (size_t)(bc * 8 + H) * 8192 + 32 * nt + r;
#pragma unroll
            for (int i = 0; i < 16; ++i) { const int p = crow(i, hi); sp[p * 128] = S0[i]; sp[(32 + p) * 128] = S1[i]; }
        }
    }
    __syncthreads();
}

__device__ __forceinline__ __amdgpu_buffer_rsrc_t mk_rsrc(const void* p, unsigned bytes) { return __builtin_amdgcn_make_buffer_rsrc((void*)p, 0, bytes, 0x00020000); }
__device__ __forceinline__ void yoff_unit(const float* d_skip, const float* gnorm, LAS unsigned char* ldsb, int unit, const bf16* XACT, const bf16* PROJ, const float* ACS, const bf16* PREVT,
                                          const float* MIXF, bf16* MIXB, int lane, int wave) {
    const int g = unit & 1, bc = unit >> 1, tok0 = bc * 128;
    const int r = lane & 31, hi = lane >> 5, lt = wave & 3, hpair = wave >> 2;
    LAS float* TAB = (LAS float*)ldsb;
    const __amdgpu_buffer_rsrc_t rsF = mk_rsrc(MIXF, (unsigned)T * D * 4u), rsX = mk_rsrc(XACT, (unsigned)T * 1024u * 2u), rsP = mk_rsrc(PROJ, (unsigned)T * PS * 2u), rsA = mk_rsrc(ACS, (unsigned)T * 32u), rsB = mk_rsrc(MIXB, (unsigned)T * D * 2u);
    const unsigned tb = (unsigned)(tok0 + 32 * lt + 4 * hi);
    bf16x8 cf[8];
    { const bf16* cp = XACT + (size_t)(tok0 + 32 * lt + r) * 1024 + 768 + g * 128 + 8 * hi; asm volatile("" : "+v"(cp));
#pragma unroll
      for (int ks = 0; ks < 8; ++ks) cf[ks] = ldg8(cp + 16 * ks); }
    float eav[16], ssq[16];
    unsigned ypk[2][2][8];
#pragma unroll
    for (int i = 0; i < 16; ++i) ssq[i] = 0.f;
#pragma unroll
    for (int hsel = 0; hsel < 2; ++hsel) {
        const int H = g * 4 + 2 * hpair + hsel; const bf16* pv = PREVT + (size_t)(bc * 8 + H) * 8192 + 8 * hi;
        asm volatile("" : "+v"(pv));
        f32x16 Y0 = zero16(), Y1 = zero16();
#pragma unroll
        for (int ks = 0; ks < 8; ++ks) {
            const bf16x8 b0 = ldg8(pv + r * 128 + 16 * ks), b1 = ldg8(pv + (32 + r) * 128 + 16 * ks);
            Y0 = MFMA32(cf[ks], b0, Y0); Y1 = MFMA32(cf[ks], b1, Y1);
        }
        const float dsk = d_skip[H];
        { const unsigned vo = (tb * 8u + (unsigned)H) * 4u;
#pragma unroll
          for (int i = 0; i < 16; ++i) eav[i] = __expf(__builtin_bit_cast(float, __builtin_amdgcn_raw_buffer_load_b32(rsA, (int)vo, ((i & 3) + 8 * (i >> 2)) * 32, 0))); }
#pragma unroll
        for (int pt = 0; pt < 2; ++pt) {
            const unsigned col = (unsigned)(H * 64 + 32 * pt + r);
            const unsigned voF = (tb * 1024u + 512u + col) * 4u, voX = (tb * 1024u + col) * 2u, voP = (tb * (unsigned)PS + (unsigned)OZ + col) * 2u;
            float yo[16], xsv[16], zv[16];
#pragma unroll
            for (int i = 0; i < 16; ++i) { const int ro = (i & 3) + 8 * (i >> 2);
                yo[i] = __builtin_bit_cast(float, __builtin_amdgcn_raw_buffer_load_b32(rsF, (int)voF, ro * 4096, 0));
                xsv[i] = bf2f((bf16)__builtin_amdgcn_raw_buffer_load_b16(rsX, (int)voX, ro * 2048, 0));
                zv[i] = bf2f((bf16)__builtin_amdgcn_raw_buffer_load_b16(rsP, (int)voP, ro * (PS * 2), 0)); }
#pragma unroll
            for (int i = 0; i < 16; i += 2) {
                const float y0 = (yo[i] + eav[i] * (pt ? Y1[i] : Y0[i]) + dsk * xsv[i]) * silu_f(zv[i]);
                const float y1 = (yo[i + 1] + eav[i + 1] * (pt ? Y1[i + 1] : Y0[i + 1]) + dsk * xsv[i + 1]) * silu_f(zv[i + 1]);
                ssq[i] += y0 * y0; ssq[i + 1] += y1 * y1; ypk[hsel][pt][i >> 1] = pkbf(y0, y1);
            }
            __builtin_amdgcn_sched_barrier(0);
        }
    }
#pragma unroll
    for (int i = 0; i < 16; ++i) {
#pragma unroll
        for (int o = 1; o < 32; o <<= 1) ssq[i] += __shfl_xor(ssq[i], o);
    }
    if (r == 0) {
#pragma unroll
        for (int i = 0; i < 16; ++i) TAB[hpair * 128 + 32 * lt + crow(i, hi)] = ssq[i];
    }
    __syncthreads();
#pragma unroll
    for (int i = 0; i < 16; ++i) { const int l = 32 * lt + crow(i, hi); ssq[i] = rsqrtf((TAB[l] + TAB[128 + l]) * (1.f / 256.f) + EPS); }
#pragma unroll
    for (int hsel = 0; hsel < 2; ++hsel)
#pragma unroll
        for (int pt = 0; pt < 2; ++pt) {
            const unsigned col = (unsigned)((g * 4 + 2 * hpair + hsel) * 64 + 32 * pt + r); const float gn = gnorm[col];
            const unsigned voB = (tb * 1024u + 512u + col) * 2u;
#pragma unroll
            for (int i = 0; i < 16; ++i) { const unsigned w = ypk[hsel][pt][i >> 1];
                const float yf = (i & 1) ? __uint_as_float(w & 0xffff0000u) : __uint_as_float(w << 16);
                __builtin_amdgcn_raw_buffer_store_b16((short)f2bf(yf * ssq[i] * gn), rsB, (int)voB, ((i & 3) + 8 * (i >> 2)) * 2048, 0); }
        }
    __syncthreads();
}
typedef float f32x2 __attribute__((ext_vector_type(2)));
__device__ __forceinline__ void fp8x16_to_f32(const uint4 w, float (&f)[16]) {
    const int ww[4] = {(int)w.x, (int)w.y, (int)w.z, (int)w.w};
#pragma unroll
    for (int q = 0; q < 4; ++q) { const f32x2 a = __builtin_amdgcn_cvt_pk_f32_fp8(ww[q], false), b = __builtin_amdgcn_cvt_pk_f32_fp8(ww[q], true); f[4 * q] = a.x; f[4 * q + 1] = a.y; f[4 * q + 2] = b.x; f[4 * q + 3] = b.y; }
}
template <int M4, int M2, int M1> __device__ __forceinline__ void treduce16(const float (&a)[16], int lane, float& r0, float& r1) {
    float b[8], c[4];
    { const bool hi = (lane & M4) != 0;
#pragma unroll
      for (int i = 0; i < 8; ++i) { const float send = hi ? a[i] : a[i + 8]; const float recv = __shfl_xor(send, M4); b[i] = (hi ? a[i + 8] : a[i]) + recv; } }
    { const bool hi = (lane & M2) != 0;
#pragma unroll
      for (int i = 0; i < 4; ++i) { const float send = hi ? b[i] : b[i + 4]; const float recv = __shfl_xor(send, M2); c[i] = (hi ? b[i + 4] : b[i]) + recv; } }
    { const bool hi = (lane & M1) != 0;
      { const float send = hi ? c[0] : c[2]; const float recv = __shfl_xor(send, M1); r0 = (hi ? c[2] : c[0]) + recv; }
      { const float send = hi ? c[1] : c[3]; const float recv = __shfl_xor(send, M1); r1 = (hi ? c[3] : c[1]) + recv; } }
}
template <int M4, int M2, int M1> __device__ __forceinline__ void treduce16i(const int (&a)[16], int lane, int& r0, int& r1) {
    int b[8], c[4];
    { const bool hi = (lane & M4) != 0;
#pragma unroll
      for (int i = 0; i < 8; ++i) { const int send = hi ? a[i] : a[i + 8]; const int recv = __shfl_xor(send, M4); b[i] = (hi ? a[i + 8] : a[i]) + recv; } }
    { const bool hi = (lane & M2) != 0;
#pragma unroll
      for (int i = 0; i < 4; ++i) { const int send = hi ? b[i] : b[i + 4]; const int recv = __shfl_xor(send, M2); c[i] = (hi ? b[i + 4] : b[i]) + recv; } }
    { const bool hi = (lane & M1) != 0;
      { const int send = hi ? c[0] : c[2]; const int recv = __shfl_xor(send, M1); r0 = (hi ? c[2] : c[0]) + recv; }
      { const int send = hi ? c[1] : c[3]; const int recv = __shfl_xor(send, M1); r1 = (hi ? c[3] : c[1]) + recv; } }
}
#define PE_ID(E, i) (((i) & 1) ? (E[(i) >> 1] >> 16) : (E[(i) >> 1] & 0xffffu))
__device__ __forceinline__ void peer_u_item(int p, int j, const unsigned short* __restrict__ IDX, const unsigned char* __restrict__ XQ, const unsigned char* __restrict__ U8, bf16* __restrict__ PART, int lane, int wave) {
    asm volatile("" : "+v"(lane));
    const int gidx = lane >> 3; const unsigned coff = (unsigned)(p * 128 + (lane & 7) * 16);
#pragma unroll 1
    for (int it = 0; it < 8; ++it) {
        const int t = j * 64 + it * 8 + wave;
        unsigned E[8];
        { const uint4 e0 = *(const uint4*)(IDX + (size_t)t * 128 + 16 * gidx), e1 = *(const uint4*)(IDX + (size_t)t * 128 + 16 * gidx + 8);
          E[0] = e0.x; E[1] = e0.y; E[2] = e0.z; E[3] = e0.w; E[4] = e1.x; E[5] = e1.y; E[6] = e1.z; E[7] = e1.w; }
        uint4 uu[16];
#pragma unroll
        for (int i = 0; i < 16; ++i) uu[i] = *(const uint4*)(U8 + (size_t)(PE_ID(E, i) * 1024u + coff));
        const uint4 xq = *(const uint4*)(XQ + (size_t)t * D + coff);
        int d[16];
#pragma unroll
        for (int i = 0; i < 16; ++i) {
            int s = __builtin_amdgcn_sdot4((int)uu[i].x, (int)xq.x, 0, false); s = __builtin_amdgcn_sdot4((int)uu[i].y, (int)xq.y, s, false);
            s = __builtin_amdgcn_sdot4((int)uu[i].z, (int)xq.z, s, false); s = __builtin_amdgcn_sdot4((int)uu[i].w, (int)xq.w, s, false);
            d[i] = s;
        }
        int r0, r1; treduce16i<4, 2, 1>(d, lane, r0, r1);
        *(unsigned*)(PART + ((size_t)p * T + t) * 128 + 2 * lane) = pkbf((float)r0, (float)r1);
    }
}
__device__ __forceinline__ void peer_v_item(int p, int j, const unsigned short* __restrict__ IDX, const unsigned char* __restrict__ ACTQ, const float* __restrict__ ACTS,
                                            const unsigned char* __restrict__ V8, bf16* __restrict__ PEERO, int lane, int wave) {
    asm volatile("" : "+v"(lane));
    const int gidx = lane >> 3; const unsigned coff = (unsigned)(p * 128 + (lane & 7) * 16);
#pragma unroll 1
    for (int it = 0; it < 8; ++it) {
        const int t = j * 64 + it * 8 + wave;
        unsigned E[8];
        { const uint4 e0 = *(const uint4*)(IDX + (size_t)t * 128 + 16 * gidx), e1 = *(const uint4*)(IDX + (size_t)t * 128 + 16 * gidx + 8);
          E[0] = e0.x; E[1] = e0.y; E[2] = e0.z; E[3] = e0.w; E[4] = e1.x; E[5] = e1.y; E[6] = e1.z; E[7] = e1.w; }
        uint4 vv[16];
#pragma unroll
        for (int i = 0; i < 16; ++i) vv[i] = *(const uint4*)(V8 + (size_t)(PE_ID(E, i) * 1024u + coff));
        const uint4 aq = *(const uint4*)(ACTQ + (size_t)t * 128 + 16 * gidx);
        const float asc = ACTS[t];
        const unsigned a4[4] = {aq.x, aq.y, aq.z, aq.w};
        int acc[16];
#pragma unroll
        for (int c = 0; c < 16; ++c) acc[c] = 0;
#pragma unroll
        for (int m = 0; m < 4; ++m) {
            const unsigned r0[4] = {vv[4 * m].x, vv[4 * m].y, vv[4 * m].z, vv[4 * m].w}, r1[4] = {vv[4 * m + 1].x, vv[4 * m + 1].y, vv[4 * m + 1].z, vv[4 * m + 1].w};
            const unsigned r2[4] = {vv[4 * m + 2].x, vv[4 * m + 2].y, vv[4 * m + 2].z, vv[4 * m + 2].w}, r3[4] = {vv[4 * m + 3].x, vv[4 * m + 3].y, vv[4 * m + 3].z, vv[4 * m + 3].w};
#pragma unroll
            for (int dc = 0; dc < 4; ++dc) {
                const unsigned ta = __builtin_amdgcn_perm(r1[dc], r0[dc], 0x05010400u), tb = __builtin_amdgcn_perm(r3[dc], r2[dc], 0x05010400u);
                const unsigned ua = __builtin_amdgcn_perm(r1[dc], r0[dc], 0x07030602u), ub = __builtin_amdgcn_perm(r3[dc], r2[dc], 0x07030602u);
                const unsigned c0 = __builtin_amdgcn_perm(tb, ta, 0x05040100u), c1 = __builtin_amdgcn_perm(tb, ta, 0x07060302u);
                const unsigned c2 = __builtin_amdgcn_perm(ub, ua, 0x05040100u), c3 = __builtin_amdgcn_perm(ub, ua, 0x07060302u);
                acc[4 * dc + 0] = __builtin_amdgcn_sdot4((int)c0, (int)a4[m], acc[4 * dc + 0], false);
                acc[4 * dc + 1] = __builtin_amdgcn_sdot4((int)c1, (int)a4[m], acc[4 * dc + 1], false);
                acc[4 * dc + 2] = __builtin_amdgcn_sdot4((int)c2, (int)a4[m], acc[4 * dc + 2], false);
                acc[4 * dc + 3] = __builtin_amdgcn_sdot4((int)c3, (int)a4[m], acc[4 * dc + 3], false);
            }
        }
        int r0i, r1i; treduce16i<32, 16, 8>(acc, lane, r0i, r1i);
        *(unsigned*)(PEERO + (size_t)t * D + coff + 2 * gidx) = pkbf(asc * (float)r0i, asc * (float)r1i);
    }
}

__device__ __forceinline__ void ce_desc(float& a, float& b) { const float hi = fmaxf(a, b), lo = fminf(a, b); a = hi; b = lo; }
__device__ __forceinline__ void sort16_desc(float (&v)[16]) {
#pragma unroll
    for (int k = 2; k <= 16; k <<= 1)
#pragma unroll
        for (int j = k >> 1; j > 0; j >>= 1)
#pragma unroll
            for (int i = 0; i < 16; ++i) { const int l = i ^ j; if (l > i) { if ((i & k) == 0) ce_desc(v[i], v[l]); else ce_desc(v[l], v[i]); } }
}
__device__ __forceinline__ void merge16_desc(float (&a)[16], const float (&b)[16]) {
#pragma unroll
    for (int i = 0; i < 16; ++i) a[i] = fmaxf(a[i], b[15 - i]);
#pragma unroll
    for (int j = 8; j > 0; j >>= 1)
#pragma unroll
        for (int i = 0; i < 16; ++i) { const int l = i ^ j; if (l > i) ce_desc(a[i], a[l]); }
}
__device__ __forceinline__ void ce_kv(float& ka, int& va, float& kb, int& vb) {
    const bool s = kb > ka; const float t0 = s ? kb : ka, t1 = s ? ka : kb; const int u0 = s ? vb : va, u1 = s ? va : vb; ka = t0; kb = t1; va = u0; vb = u1; }
__device__ __forceinline__ void sort16_kv(float (&k)[16], int (&v)[16]) {
#pragma unroll
    for (int kk = 2; kk <= 16; kk <<= 1)
#pragma unroll
        for (int j = kk >> 1; j > 0; j >>= 1)
#pragma unroll
            for (int i = 0; i < 16; ++i) { const int l = i ^ j; if (l > i) { if ((i & kk) == 0) ce_kv(k[i], v[i], k[l], v[l]); else ce_kv(k[l], v[l], k[i], v[i]); } }
}
__device__ __forceinline__ void merge16_kv(float (&ka)[16], int (&va)[16], const float (&kb)[16], const int (&vb)[16]) {
#pragma unroll
    for (int i = 0; i < 16; ++i) { const bool s = kb[15 - i] > ka[i]; ka[i] = s ? kb[15 - i] : ka[i]; va[i] = s ? vb[15 - i] : va[i]; }
#pragma unroll
    for (int j = 8; j > 0; j >>= 1)
#pragma unroll
        for (int i = 0; i < 16; ++i) { const int l = i ^ j; if (l > i) ce_kv(ka[i], va[i], ka[l], va[l]); }
}
__device__ __forceinline__ void split8(const float* p, bf16x8& hi8, bf16x8& lo8) {
    const float4 f0 = *(const float4*)p, f1 = *(const float4*)(p + 4);
    const float x[8] = {f0.x, f0.y, f0.z, f0.w, f1.x, f1.y, f1.z, f1.w};
#pragma unroll
    for (int j = 0; j < 8; ++j) { const short h = bfs(x[j]); hi8[j] = h; lo8[j] = bfs(x[j] - sbf2f(h)); }
}
__device__ __forceinline__ void route_task(int task, const float* QP, const LAS bf16* KHL, unsigned short* IDX, float* GATE, int lane) {
    const int r = lane & 31, hi = lane >> 5, t = 4 * task + (r >> 3), head = r & 7;
    float top[2][16];
#pragma unroll
    for (int half = 0; half < 2; ++half) {
        bf16x8 qh[4], ql[4];
        { const float* qp = QP + (size_t)t * D + head * 128 + half * 64 + 8 * hi; asm volatile("" : "+v"(qp));
#pragma unroll
          for (int ks = 0; ks < 4; ++ks) split8(qp + 16 * ks, qh[ks], ql[ks]); }
        float cur[16];
#pragma unroll
        for (int kt = 0; kt < 4; ++kt) {
            f32x16 X = zero16();
            const LAS bf16* khp = KHL + (half * 128 + 32 * kt + r) * 72 + 8 * hi;
#pragma unroll
            for (int ks = 0; ks < 4; ++ks) {
                const bf16x8 kh = lds8(khp + 16 * ks), kl = lds8(khp + 2 * 128 * 72 + 16 * ks);
                X = MFMA32(kh, qh[ks], X); X = MFMA32(kh, ql[ks], X); X = MFMA32(kl, qh[ks], X);
            }
            float grp[16];
#pragma unroll
            for (int i = 0; i < 16; ++i) { const unsigned key = (unsigned)(32 * kt + crow(i, hi)); grp[i] = __uint_as_float((__float_as_uint(X[i]) & ~127u) | (127u - key)); }
            sort16_desc(grp);
            if (kt == 0) {
#pragma unroll
                for (int i = 0; i < 16; ++i) cur[i] = grp[i];
            } else merge16_desc(cur, grp);
        }
        float oth[16];
#pragma unroll
        for (int i = 0; i < 16; ++i) oth[i] = __shfl_xor(cur[i], 32);
        merge16_desc(cur, oth);
#pragma unroll
        for (int i = 0; i < 16; ++i) top[half][i] = cur[i];
    }
    unsigned P1[4], P2[4];
#pragma unroll
    for (int q = 0; q < 4; ++q) { P1[q] = 0u; P2[q] = 0u;
#pragma unroll
        for (int s = 0; s < 4; ++s) { P1[q] |= (127u - (__float_as_uint(top[0][4 * q + s]) & 127u)) << (8 * s); P2[q] |= (127u - (__float_as_uint(top[1][4 * q + s]) & 127u)) << (8 * s); } }
#define CAND(a, b) __uint_as_float((__float_as_uint(top[0][a] + top[1][b]) & ~255u) | (255u - (unsigned)((a) * 16 + (b))))
    float bk[16];
    {
        float gk[16];
        gk[0] = CAND(0, 0);
        gk[1] = CAND(0, 1);
        gk[2] = CAND(0, 2);
        gk[3] = CAND(0, 3);
        gk[4] = CAND(0, 4);
        gk[5] = CAND(0, 5);
        gk[6] = CAND(0, 6);
        gk[7] = CAND(0, 7);
        gk[8] = CAND(0, 8);
        gk[9] = CAND(0, 9);
        gk[10] = CAND(0, 10);
        gk[11] = CAND(0, 11);
        gk[12] = CAND(0, 12);
        gk[13] = CAND(0, 13);
        gk[14] = CAND(0, 14);
        gk[15] = CAND(0, 15);
        sort16_desc(gk);
#pragma unroll
        for (int i = 0; i < 16; ++i) bk[i] = gk[i];
    }
    {
        float gk[16];
        gk[0] = CAND(1, 0);
        gk[1] = CAND(1, 1);
        gk[2] = CAND(1, 2);
        gk[3] = CAND(1, 3);
        gk[4] = CAND(1, 4);
        gk[5] = CAND(1, 5);
        gk[6] = CAND(1, 6);
        gk[7] = CAND(1, 7);
        gk[8] = CAND(2, 0);
        gk[9] = CAND(2, 1);
        gk[10] = CAND(2, 2);
        gk[11] = CAND(2, 3);
        gk[12] = CAND(2, 4);
        gk[13] = CAND(3, 0);
        gk[14] = CAND(3, 1);
        gk[15] = CAND(3, 2);
        sort16_desc(gk);
        merge16_desc(bk, gk);
    }
    {
        float gk[16];
        gk[0] = CAND(3, 3);
        gk[1] = CAND(4, 0);
        gk[2] = CAND(4, 1);
        gk[3] = CAND(4, 2);
        gk[4] = CAND(5, 0);
        gk[5] = CAND(5, 1);
        gk[6] = CAND(6, 0);
        gk[7] = CAND(6, 1);
        gk[8] = CAND(7, 0);
        gk[9] = CAND(7, 1);
        gk[10] = CAND(8, 0);
        gk[11] = CAND(9, 0);
        gk[12] = CAND(10, 0);
        gk[13] = CAND(11, 0);
        gk[14] = CAND(12, 0);
        gk[15] = CAND(13, 0);
        sort16_desc(gk);
        merge16_desc(bk, gk);
    }
    {
        float gk[16];
        gk[0] = CAND(14, 0);
        gk[1] = CAND(15, 0);
        gk[2] = -INFINITY;
        gk[3] = -INFINITY;
        gk[4] = -INFINITY;
        gk[5] = -INFINITY;
        gk[6] = -INFINITY;
        gk[7] = -INFINITY;
        gk[8] = -INFINITY;
        gk[9] = -INFINITY;
        gk[10] = -INFINITY;
        gk[11] = -INFINITY;
        gk[12] = -INFINITY;
        gk[13] = -INFINITY;
        gk[14] = -INFINITY;
        gk[15] = -INFINITY;
        sort16_desc(gk);
        merge16_desc(bk, gk);
    }
#undef CAND
    int bv[16];
#pragma unroll
    for (int i = 0; i < 16; ++i) {
        const unsigned cd = 255u - (__float_as_uint(bk[i]) & 255u), ca = cd >> 4, cb = cd & 15u;
        const unsigned wa = (ca >> 2) == 0u ? P1[0] : (ca >> 2) == 1u ? P1[1] : (ca >> 2) == 2u ? P1[2] : P1[3];
        const unsigned wb = (cb >> 2) == 0u ? P2[0] : (cb >> 2) == 1u ? P2[1] : (cb >> 2) == 2u ? P2[2] : P2[3];
        bv[i] = (int)((((wa >> (8u * (ca & 3u))) & 255u) << 7) | ((wb >> (8u * (cb & 3u))) & 255u));
    }
    float e[16], se = 0.f;
#pragma unroll
    for (int i = 0; i < 16; ++i) { e[i] = __expf(bk[i] - bk[0]); se += e[i]; }
    const float inv = 1.f / se;
    if (hi == 0) {
        uint4* ip = (uint4*)(IDX + (size_t)t * 128 + head * 16); float4* gp = (float4*)(GATE + (size_t)t * 128 + head * 16);
#pragma unroll
        for (int q = 0; q < 2; ++q) ip[q] = make_uint4((unsigned)bv[8 * q] | ((unsigned)bv[8 * q + 1] << 16), (unsigned)bv[8 * q + 2] | ((unsigned)bv[8 * q + 3] << 16), (unsigned)bv[8 * q + 4] | ((unsigned)bv[8 * q + 5] << 16), (unsigned)bv[8 * q + 6] | ((unsigned)bv[8 * q + 7] << 16));
#pragma unroll
        for (int q = 0; q < 4; ++q) gp[q] = make_float4(e[4 * q] * inv, e[4 * q + 1] * inv, e[4 * q + 2] * inv, e[4 * q + 3] * inv);
    }
}

#define XB_TMO      128
#define XB_XCNT(j)  (256  + 64 * (j))
#define XB_XSUB(j)  (1280 + 64 * (j))
#define XB_XGEN(j)  (2304 + 64 * (j))
#define XB_TOP      3328
#define XB_TOPGEN   3392
#define XCD_BAR_WORDS 3456
#define XB_SPIN_CAP (1u << 22)
__device__ __forceinline__ unsigned xb_ld(unsigned* p)              { return __hip_atomic_load(p, __ATOMIC_RELAXED, __HIP_MEMORY_SCOPE_AGENT); }
__device__ __forceinline__ unsigned xb_add(unsigned* p, unsigned v) { return __hip_atomic_fetch_add(p, v, __ATOMIC_RELAXED, __HIP_MEMORY_SCOPE_AGENT); }
__device__ __forceinline__ unsigned xb_xcc_id() { return (unsigned)__builtin_amdgcn_s_getreg((3 << 11) | 20) & 0xFu; }
#define XB_SPIN(cond, bar) do { unsigned _sp = 0; while (cond) { __builtin_amdgcn_s_sleep(1); \
    if ((++_sp & 255u) == 0u) { if (xb_ld(&(bar)[XB_TMO])) break; if (_sp > XB_SPIN_CAP) { atomicAdd(&(bar)[XB_TMO], 1u); break; } } } } while (0)
struct XcdBarrier { unsigned* bar; unsigned x; volatile LAS unsigned* st; };
__device__ __forceinline__ XcdBarrier xcd_barrier_post(unsigned* bar, volatile LAS unsigned* st) {
    XcdBarrier b; b.bar = bar; b.x = xb_xcc_id(); b.st = st;
    if (threadIdx.x == 0) (void)xb_add(&bar[XB_XCNT(b.x)], 1u);
    return b;
}
__device__ __forceinline__ void xcd_barrier_complete(unsigned* bar, unsigned x, unsigned& nloc, unsigned& nx) {
    const unsigned G = gridDim.x * gridDim.y * gridDim.z;
    unsigned sum, cnt, mine, sp = 0u;
    for (;;) {
        sum = 0u; cnt = 0u; mine = 0u;
#pragma unroll
        for (unsigned j = 0; j < 16; ++j) { const unsigned c = xb_ld(&bar[XB_XCNT(j)]); sum += c; cnt += (c > 0u) ? 1u : 0u; mine = (j == x) ? c : mine; }
        if (sum == G) break;
        __builtin_amdgcn_s_sleep(1);
        if ((++sp & 255u) == 0u) { if (xb_ld(&bar[XB_TMO])) break; if (sp > XB_SPIN_CAP) { atomicAdd(&bar[XB_TMO], 1u); break; } }
    }
    nloc = mine > 0u ? mine : 1u; nx = cnt > 0u ? cnt : 1u;
}
__device__ __forceinline__ void xcd_barrier(const XcdBarrier& b) {
    asm volatile("s_waitcnt vmcnt(0)" ::: "memory");
    __syncthreads();
    if (threadIdx.x == 0) {
        unsigned* bar = b.bar;
        __builtin_amdgcn_s_waitcnt(0);
        unsigned nloc = b.st[0], nx = b.st[1];
        if (nloc == 0u) { xcd_barrier_complete(bar, b.x, nloc, nx); b.st[0] = nloc; b.st[1] = nx; }
        const unsigned old = xb_add(&bar[XB_XSUB(b.x)], 1u);
        const unsigned gen = old / nloc;
        if (old + 1u == (gen + 1u) * nloc) {
            __builtin_amdgcn_fence(__ATOMIC_RELEASE, "agent");
            asm volatile("s_waitcnt vmcnt(0)" ::: "memory");
            const unsigned og = xb_add(&bar[XB_TOP], 1u);
            const unsigned tg = og / nx;
            if (og + 1u == (tg + 1u) * nx) xb_add(&bar[XB_TOPGEN], 1u);
            else XB_SPIN(xb_ld(&bar[XB_TOPGEN]) == tg, bar);
            __builtin_amdgcn_fence(__ATOMIC_ACQUIRE, "agent");
            xb_add(&bar[XB_XGEN(b.x)], 1u);
            asm volatile("s_waitcnt vmcnt(0)" ::: "memory");
        } else {
            XB_SPIN(xb_ld(&bar[XB_XGEN(b.x)]) == gen, bar);
            __builtin_amdgcn_fence(__ATOMIC_ACQUIRE, "agent");
            asm volatile("s_waitcnt vmcnt(0)" ::: "memory");
        }
    }
    __syncthreads();
}
constexpr int LDS_BYTES = 147456;
constexpr int MISC_OFF = 131072 + 320;

__global__ void __launch_bounds__(NTHR, 2) k_main(Args a) {
    extern __shared__ __attribute__((aligned(16))) unsigned char lds_raw[];
    LAS unsigned char* ldsb = (LAS unsigned char*)lds_raw;
    const int tid0 = threadIdx.x, bid = blockIdx.x, nb = gridDim.x;
    const int wave = __builtin_amdgcn_readfirstlane(tid0 >> 6);
    const int gthreads = nb * NTHR, nwaves = gthreads >> 6;
#define PHASE_VARS() int tid = tid0; asm volatile("" : "+v"(tid)); const int lane = tid & 63, gtid = bid * NTHR + tid, gwave = gtid >> 6; (void)lane; (void)gtid; (void)gwave
    unsigned char* ws = a.ws;
    bf16* WINT = (bf16*)(ws + WS_WIN); bf16* WOT = (bf16*)(ws + WS_WO); bf16* WQT = (bf16*)(ws + WS_WQ);
    bf16* PROJ = (bf16*)(ws + WS_PROJ);
    bf16* XNB = (bf16*)(ws + WS_XNB);
    bf16* XACT = (bf16*)(ws + WS_XACT);
    float* DTRAW = (float*)(ws + WS_DTRAW); float* DT = (float*)(ws + WS_DT); float* ACS = (float*)(ws + WS_ACS); float* CDEC = (float*)(ws + WS_CDEC);
    float* STATES = (float*)(ws + WS_STATES); bf16* PREVT = (bf16*)(ws + WS_PREV);
    float* QP = (float*)(ws + WS_QP); unsigned short* IDX = (unsigned short*)(ws + WS_IDX); float* GATE = (float*)(ws + WS_GATE);
    float* TOPV = (float*)(ws + WS_TOPV); int* TOPI = (int*)(ws + WS_TOPI);
    unsigned char* U8 = ws + WS_U8; unsigned char* V8 = ws + WS_V8; float* SU = (float*)(ws + WS_SU); float* SV = SU + 16384; bf16* PART = (bf16*)(ws + WS_PART); unsigned char* XQ = ws + WS_XQ; float* XS = (float*)(ws + WS_XS);
    bf16* KH = (bf16*)(ws + WS_KH); bf16* KL = (bf16*)(ws + WS_KH + 65536);
    bf16* HB = (bf16*)(ws + WS_STATES);
    float* MIXF = a.out;
    volatile LAS unsigned* MISC = (volatile LAS unsigned*)(ldsb + MISC_OFF);
    if (tid0 < 32) MISC[tid0] = 0u;
    __syncthreads();
    XcdBarrier bar = xcd_barrier_post((unsigned*)ws, MISC + 8);
#define IN(k) (a.ph_lo <= (k) && (k) < a.ph_hi)
#if defined(PROBE_LO)
    int seg_ = 0; unsigned long long tseg_ = __builtin_amdgcn_s_memrealtime();
#define PROBE_SPIN() do { if (seg_ >= PROBE_LO && seg_ <= PROBE_HI) { const unsigned long long d_ = (__builtin_amdgcn_s_memrealtime() - tseg_) * PROBE_AMP; const unsigned long long s_ = __builtin_amdgcn_s_memrealtime(); \
        while (__builtin_amdgcn_s_memrealtime() - s_ < d_) __builtin_amdgcn_s_sleep(4); } } while (0)
#define GRID_BAR() do { PROBE_SPIN(); xcd_barrier(bar); tseg_ = __builtin_amdgcn_s_memrealtime(); ++seg_; } while (0)
#else
#define PROBE_SPIN() do { } while (0)
#define GRID_BAR() xcd_barrier(bar)
#endif

    if (IN(0)) {
        PHASE_VARS();
        LAS float* scr = (LAS float*)(ldsb + wave * 16384);
        constexpr int I_IN = 16 * 72, I_O = 16 * 32, NITEMS = I_IN + 2 * I_O;
        for (int it = gwave; it < NITEMS; it += nwaves) {
            int r = it;
            if (r < I_IN) { transpose_item(a.w_in, PW, D, WINT, scr, r / 72, r % 72, lane); continue; } r -= I_IN;
            if (r < I_O) { transpose_item(a.w_out, D, D, WOT, scr, r / 32, r % 32, lane); continue; } r -= I_O;
            transpose_item(a.peer_wq, D, D, WQT, scr, r / 32, r % 32, lane);
        }
        for (int i = gtid; i < 2 * 128 * 64; i += gthreads) { const float kf = a.peer_sub_keys[i]; const short h = bfs(kf); KH[i] = (bf16)h; KL[i] = (bf16)bfs(kf - sbf2f(h)); }
        for (int i = tid; i < 8 * 1024; i += NTHR) { const int h = i & 7, c = i >> 3; *(LAS float*)(ldsb + h * 16384 + 8448 + c * 4) = a.w_in[(size_t)c * PW + ODT + h]; }
        __syncthreads();
        rmsnorm_rows_bf16<1>(a.x, a.norm_mix_g, XNB, ldsb, DTRAW, nullptr, nullptr, gwave, nwaves, lane);
    }
    GRID_BAR();
    if (IN(1)) {
        PHASE_VARS();
        pg8::Gemm g{XNB, WINT, T, PS, D}; pg8::StaticOrder S; S.init(T, PS, nb, bid);
        pg8::EpiBf16Plain E{PROJ, PS};
        pg8::gemm_phase<pg8::EpiBf16Plain, pg8::StaticOrder>(ldsb, g, S, E, nullptr);
        const int cfirst = (nb == 256) ? 64 : 0;
        if (bid >= cfirst) for (int rr0 = ((bid - cfirst) * 8 + wave) * 4; rr0 < 2 * 16384; rr0 += (nb - cfirst) * 8 * 4) {
            float4 v[4][4];
#pragma unroll
            for (int q = 0; q < 4; ++q) { const int rr = rr0 + q, which = rr >> 14, row = rr & 16383;
                const float4* src4 = (const float4*)((which ? a.peer_v : a.peer_u) + (size_t)row * D) + lane;
#pragma unroll
                for (int jq = 0; jq < 4; ++jq) v[q][jq] = src4[64 * jq]; }
#pragma unroll
            for (int q = 0; q < 4; ++q) { const int rr = rr0 + q, which = rr >> 14, row = rr & 16383;
                float mx = 0.f;
#pragma unroll
                for (int jq = 0; jq < 4; ++jq) mx = fmaxf(mx, fmaxf(fmaxf(fabsf(v[q][jq].x), fabsf(v[q][jq].y)), fmaxf(fabsf(v[q][jq].z), fabsf(v[q][jq].w))));
#pragma unroll
                for (int o = 1; o < 64; o <<= 1) mx = fmaxf(mx, __shfl_xor(mx, o));
                const float sc = mx > 0.f ? mx * (1.f / 127.f) : 1.f, inv = 1.f / sc;
                unsigned* dst = (unsigned*)((which ? V8 : U8) + (size_t)row * D) + lane;
#pragma unroll
                for (int jq = 0; jq < 4; ++jq) { const int q0 = (int)rintf(v[q][jq].x * inv), q1 = (int)rintf(v[q][jq].y * inv), q2 = (int)rintf(v[q][jq].z * inv), q3 = (int)rintf(v[q][jq].w * inv);
                    dst[64 * jq] = (unsigned)(q0 & 255) | ((unsigned)(q1 & 255) << 8) | ((unsigned)(q2 & 255) << 16) | ((unsigned)(q3 & 255) << 24); }
                if (lane == 0) (which ? SV : SU)[row] = sc; }
        }
    }
    GRID_BAR();
    if (IN(3)) {
        PHASE_VARS();
        for (int u = bid; u < 512; u += nb) {
            if (u < 256) attn_unit(a.attn_sinks, a.attn_out_g, ldsb, u, PROJ, XNB, tid, lane, wave);
            else ssd_chunk_unit(ldsb, u - 256, PROJ, XACT, DTRAW, a.conv_w, a.conv_b, a.dt_bias, a.a_log, ACS, CDEC, MIXF, STATES, tid, lane, wave);
        }
    }
    GRID_BAR();
    if (IN(5)) {
        PHASE_VARS();
        for (int idx = gtid; idx < 2 * 8 * 8192; idx += gthreads) {
            const int pn = idx & 8191, h = (idx >> 13) & 7, b = idx >> 16;
            float run = 0.f;
#pragma unroll 1
            for (int c0 = 0; c0 < 64; c0 += 8) {
                float st[8], dc[8];
#pragma unroll
                for (int j = 0; j < 8; ++j) { const int bch = (b * 64 + c0 + j) * 8 + h; st[j] = STATES[(size_t)bch * 8192 + pn]; dc[j] = CDEC[bch]; }
#pragma unroll
                for (int j = 0; j < 8; ++j) { const int bch = (b * 64 + c0 + j) * 8 + h; PREVT[(size_t)bch * 8192 + pn] = f2bf(run); run = dc[j] * run + st[j]; }
            }
        }
    }
    GRID_BAR();
    if (IN(6)) {
        PHASE_VARS();
        for (int u = bid; u < 256; u += nb) yoff_unit(a.d_skip, a.ssm_norm_g, ldsb, u, XACT, PROJ, ACS, PREVT, MIXF, XNB, lane, wave);
    }
    GRID_BAR();
    if (IN(7)) {
        PHASE_VARS();
        pg8::Gemm g{XNB, WOT, T, D, D}; pg8::StaticOrder S; S.init(T, D, nb, bid);
        pg8::EpiBf16Resid E{HB, a.x, D};
        pg8::gemm_phase<pg8::EpiBf16Resid, pg8::StaticOrder>(ldsb, g, S, E, nullptr);
    }
    GRID_BAR();
    if (IN(8)) {
        PHASE_VARS();
        rmsnorm_rows_bf16<2>((const float*)HB, a.norm_ffn_g, XNB, ldsb, nullptr, XQ, XS, gwave, nwaves, lane);
    }
    GRID_BAR();
    if (IN(9)) {
        PHASE_VARS();
        pg8::Gemm g{XNB, WQT, T, D, D}; pg8::StaticOrder S; S.init(T, D, nb, bid);
        pg8::EpiF32Resid E{QP, nullptr, D};
        pg8::gemm_phase<pg8::EpiF32Resid, pg8::StaticOrder>(ldsb, g, S, E, nullptr);
    }
    GRID_BAR();
    if (IN(10)) {
        PHASE_VARS();
        LAS bf16* KHL = (LAS bf16*)ldsb;
        for (int i = tid; i < 2 * 2 * 128 * 8; i += NTHR) {
            const int pc = i & 7, key = (i >> 3) & 127, hf = (i >> 10) & 1, hl = i >> 11;
            *(LAS v4u*)(KHL + ((hl * 2 + hf) * 128 + key) * 72 + pc * 8) = *(const v4u*)((hl ? KL : KH) + (size_t)(hf * 128 + key) * 64 + pc * 8);
        }
        __syncthreads();
        for (int task = gwave; task < T / 4; task += nwaves) route_task(task, QP, KHL, IDX, GATE, lane);
        __syncthreads();
    }
    GRID_BAR();
    unsigned char* ACTQ = ws + WS_ACT; float* ACTS = (float*)(ws + WS_ACT + 4 * MiB); bf16* PEERO = (bf16*)(ws + WS_PEERO);
    unsigned* ctl = (unsigned*)ws;

    if (IN(12)) {
        PHASE_VARS();
#pragma unroll 1
        for (int p = 0; p < NPART; ++p)
#pragma unroll 1
            for (int j = bid; j < NCHUNK; j += nb) peer_u_item(p, j, IDX, XQ, U8, PART, lane, wave);
    }
    GRID_BAR();
    if (IN(12)) {
        PHASE_VARS();
        for (int t0 = gwave; t0 < T; t0 += 2 * nwaves) {
            float av[2][2]; float mx[2];
#pragma unroll
            for (int q = 0; q < 2; ++q) {
                const int t = (t0 + q * nwaves < T) ? t0 + q * nwaves : t0;
                const float xs = XS[t];
#pragma unroll
                for (int hh = 0; hh < 2; ++hh) {
                    const int i = t * 128 + hh * 64 + lane;
                    float sf = 0.f;
#pragma unroll
                    for (int pp = 0; pp < NPART; ++pp) sf += bf2f(PART[(size_t)pp * T * 128 + i]);
                    const int e = IDX[i]; const float z = sf * SU[e] * xs;
                    av[q][hh] = GATE[i] * 0.5f * z * (1.f + erff(z * 0.70710678118654752f)) * SV[e];
                }
                mx[q] = fmaxf(fabsf(av[q][0]), fabsf(av[q][1]));
            }
#pragma unroll
            for (int o = 1; o < 64; o <<= 1) { mx[0] = fmaxf(mx[0], __shfl_xor(mx[0], o)); mx[1] = fmaxf(mx[1], __shfl_xor(mx[1], o)); }
#pragma unroll
            for (int q = 0; q < 2; ++q) {
                const int t = t0 + q * nwaves; if (t >= T) break;
                const float sc = mx[q] > 0.f ? mx[q] * (1.f / 127.f) : 1.f, inv = 1.f / sc;
                ACTQ[(size_t)t * 128 + lane] = (unsigned char)((int)rintf(av[q][0] * inv) & 255); ACTQ[(size_t)t * 128 + 64 + lane] = (unsigned char)((int)rintf(av[q][1] * inv) & 255);
                if (lane == 0) ACTS[t] = sc;
            }
        }
    }
    GRID_BAR();
    if (IN(13)) {
        PHASE_VARS();
#pragma unroll 1
        for (int p = 0; p < NPART; ++p)
#pragma unroll 1
            for (int j = bid; j < NCHUNK; j += nb) peer_v_item(p, j, IDX, ACTQ, ACTS, V8, PEERO, lane, wave);
    }
    GRID_BAR();
    if (IN(14)) {
        PHASE_VARS();
        for (int t = gwave; t < T; t += nwaves) {
            const uint2* hr = (const uint2*)(HB + (size_t)t * D) + lane; const uint2* pr = (const uint2*)(PEERO + (size_t)t * D) + lane;
            float4 v[4]; float ss = 0.f;
#pragma unroll
            for (int jq = 0; jq < 4; ++jq) { const uint2 hw = hr[64 * jq]; const float4 h4 = make_float4(__uint_as_float(hw.x << 16), __uint_as_float(hw.x & 0xffff0000u), __uint_as_float(hw.y << 16), __uint_as_float(hw.y & 0xffff0000u)); const uint2 pw = pr[64 * jq]; v[jq] = make_float4(h4.x + __uint_as_float(pw.x << 16), h4.y + __uint_as_float(pw.x & 0xffff0000u), h4.z + __uint_as_float(pw.y << 16), h4.w + __uint_as_float(pw.y & 0xffff0000u)); ss += v[jq].x * v[jq].x + v[jq].y * v[jq].y + v[jq].z * v[jq].z + v[jq].w * v[jq].w; }
            ss = wave_sum(ss);
            const float r3 = rsqrtf(ss * (1.f / D) + EPS);
            float4* op = (float4*)(a.out + (size_t)t * D) + lane;
#pragma unroll
            for (int jq = 0; jq < 4; ++jq) { const float4 gv = ((const float4*)a.final_norm_g)[lane + 64 * jq]; op[64 * jq] = make_float4(v[jq].x * r3 * gv.x, v[jq].y * r3 * gv.y, v[jq].z * r3 * gv.z, v[jq].w * r3 * gv.w); }
        }
    }
    PROBE_SPIN();
#undef IN
}
}

extern "C" void kernel_launch(void* const* d_in, const int* in_sizes, int n_in, void* d_out, int out_size, void* d_ws, size_t ws_size, hipStream_t stream) {
    if (n_in != 18 || out_size != T * D || ws_size < WS_END) { fprintf(stderr, "kernel_launch: unexpected shapes n_in=%d out=%d ws=%zu\n", n_in, out_size, ws_size); return; }
    Args a{};
    const float** ap = (const float**)&a;
    for (int i = 0; i < 18; ++i) ap[i] = (const float*)d_in[i];
    a.out = (float*)d_out; a.ws = (unsigned char*)d_ws;
    static int grid = 0;
    if (grid == 0) {
        int dev = 0, cus = 0, per_cu = 0;
        if (hipGetDevice(&dev) != hipSuccess || hipDeviceGetAttribute(&cus, hipDeviceAttributeMultiprocessorCount, dev) != hipSuccess) { fprintf(stderr, "kernel_launch: device query failed\n"); grid = -1; return; }
        if (hipFuncSetAttribute((const void*)k_main, hipFuncAttributeMaxDynamicSharedMemorySize, LDS_BYTES) != hipSuccess) { fprintf(stderr, "kernel_launch: hipFuncSetAttribute failed\n"); grid = -1; return; }
        if (hipOccupancyMaxActiveBlocksPerMultiprocessor(&per_cu, (const void*)k_main, NTHR, LDS_BYTES) != hipSuccess || per_cu < 1) { fprintf(stderr, "kernel_launch: occupancy query says %d blocks/CU\n", per_cu); (void)hipGetLastError(); grid = -1; return; }
        grid = cus;
    }
    if (grid < 0) return;
    if (hipMemsetAsync(d_ws, 0, 65536, stream) != hipSuccess) { fprintf(stderr, "kernel_launch: memset failed\n"); return; }
    a.ph_lo = 0; a.ph_hi = 15;
    hipLaunchKernelGGL(k_main, dim3(grid), dim3(NTHR), LDS_BYTES, stream, a);
}
```

```cpp
#include <hip/hip_runtime.h>
#include <cstdio>
#include <cstdint>


namespace pg8 {
#define PG8_LAS __attribute__((address_space(3)))
typedef unsigned short bf16_t;
typedef short bf16x8 __attribute__((ext_vector_type(8)));
typedef float f32x4 __attribute__((ext_vector_type(4)));
typedef unsigned u32x4 __attribute__((ext_vector_type(4)));
constexpr int BM = 256, BK = 64, HALF = 128, HTB = HALF * BK * 2  , STAGE_BYTES = 8 * HTB, NXCD = 8, WGM = 8;

__host__ __device__ __forceinline__ int lds_byte(int r, int c) { const int st = (r >> 4) * 2 + (c >> 5), rr = r & 15, cc = c & 31, ob = rr * 64 + cc * 2; return st * 1024 + (ob ^ (((ob >> 9) & 1) << 5)); }
__host__ __device__ __forceinline__ void stage_rc(int b, int& R, int& C) { const int st = b / 1024, sb = b % 1024, swz = sb ^ (((sb >> 9) & 1) << 5); R = (st >> 1) * 16 + swz / 64; C = (st & 1) * 32 + (swz % 64) / 2; }
__host__ __device__ __forceinline__ int perm32(int rho) { const int n = rho >> 4, i = rho & 15; return 8 * (i >> 2) + 4 * n + (i & 3); }

struct Unit { int pm, pn; };
struct Gemm { const bf16_t* A; const bf16_t* Bt; int M, N, K; };

struct StaticOrder {
    int nM, nN, nwg, G, c;
    __host__ __device__ void init(int M, int N, int G_, int c_) { nM = M / BM; nN = N / BM; nwg = nM * nN; G = G_; c = c_; }
    __host__ __device__ bool next(int i, Unit& u) const {
        const long L = (long)i * G + c; if (L >= nwg) return false;
        int wgid = (int)L; { const int q = nwg / NXCD, r = nwg % NXCD, xcd = wgid % NXCD, off = wgid / NXCD; wgid = (xcd < r ? xcd * (q + 1) : r * (q + 1) + (xcd - r) * q) + off; }
        const int nig = WGM * nN, gid = wgid / nig, fm = gid * WGM, gsz = (nM - fm) < WGM ? (nM - fm) : WGM;
        u.pm = fm + ((wgid % nig) % gsz); u.pn = (wgid % nig) / gsz; return true;
    }
    __device__ __forceinline__ void a_ready(const Unit&) const {}
    __device__ __forceinline__ void done(const Unit&) const {}
};
__device__ __forceinline__ unsigned cvt_pk_bf16(float lo, float hi) { unsigned r; asm volatile("v_cvt_pk_bf16_f32 %0, %1, %2" : "=v"(r) : "v"(lo), "v"(hi)); return r; }
typedef float f32x2 __attribute__((ext_vector_type(2)));
struct EpiBf16Plain {
    static constexpr bool PERM = true, AFTER_DRAIN = false;
    bf16_t* O; int ldc;
    __device__ __forceinline__ void operator()(const f32x4 (&acc)[2][2][4][2], const Unit& u, int wr, int wc, int fr, int fq) const {
        const int row0 = u.pm * BM + wr * 64 + fr, col0 = u.pn * BM + wc * 32 + 8 * fq;
#pragma unroll
        for (int ai = 0; ai < 2; ++ai)
#pragma unroll
            for (int m = 0; m < 4; ++m) { bf16_t* rowp = O + (size_t)(row0 + ai * HALF + m * 16) * ldc + col0;
#pragma unroll
                for (int bj = 0; bj < 2; ++bj) { const f32x4 v0 = acc[ai][bj][m][0], v1 = acc[ai][bj][m][1];
                    u32x4 w; w.x = cvt_pk_bf16(v0[0], v0[1]); w.y = cvt_pk_bf16(v0[2], v0[3]); w.z = cvt_pk_bf16(v1[0], v1[1]); w.w = cvt_pk_bf16(v1[2], v1[3]);
                    *(u32x4*)(rowp + bj * HALF) = w; } }
    }
};
struct EpiF32Resid {
    static constexpr bool PERM = false, AFTER_DRAIN = false;
    float* C; const float* R; int ldc;
    __device__ __forceinline__ void operator()(const f32x4 (&acc)[2][2][4][2], const Unit& u, int wr, int wc, int fr, int fq) const {
        const int row0 = u.pm * BM + wr * 64 + fr, col0 = u.pn * BM + wc * 32 + 4 * fq;
#pragma unroll
        for (int ai = 0; ai < 2; ++ai)
#pragma unroll
            for (int m = 0; m < 4; ++m) { const size_t off = (size_t)(row0 + ai * HALF + m * 16) * ldc + col0;
#pragma unroll
                for (int bj = 0; bj < 2; ++bj)
#pragma unroll
                    for (int n = 0; n < 2; ++n) { f32x4 v = acc[ai][bj][m][n]; if (R) v += *(const f32x4*)(R + off + bj * HALF + n * 16); *(f32x4*)(C + off + bj * HALF + n * 16) = v; }
                asm volatile("" ::: "memory"); }
    }
};

struct EpiBf16Resid {
    static constexpr bool PERM = true, AFTER_DRAIN = false;
    bf16_t* O; const float* R; int ldc;
    __device__ __forceinline__ void operator()(const f32x4 (&acc)[2][2][4][2], const Unit& u, int wr, int wc, int fr, int fq) const {
        const int row0 = u.pm * BM + wr * 64 + fr, col0 = u.pn * BM + wc * 32 + 8 * fq;
#pragma unroll
        for (int ai = 0; ai < 2; ++ai)
#pragma unroll
            for (int m = 0; m < 4; ++m) { const size_t off = (size_t)(row0 + ai * HALF + m * 16) * ldc + col0;
#pragma unroll
                for (int bj = 0; bj < 2; ++bj) { const f32x4 v0 = acc[ai][bj][m][0] + *(const f32x4*)(R + off + bj * HALF), v1 = acc[ai][bj][m][1] + *(const f32x4*)(R + off + bj * HALF + 4);
                    u32x4 w; w.x = cvt_pk_bf16(v0[0], v0[1]); w.y = cvt_pk_bf16(v0[2], v0[3]); w.z = cvt_pk_bf16(v1[0], v1[1]); w.w = cvt_pk_bf16(v1[2], v1[3]);
                    *(u32x4*)(O + off + bj * HALF) = w; }
                asm volatile("" ::: "memory"); }
    }
};
template <class Epi, class Sched, bool STAMP = false>
__device__ __forceinline__ void gemm_phase(PG8_LAS unsigned char* lds, const Gemm g, const Sched& S, const Epi& E, unsigned long long* stamps) {
    const int tid = threadIdx.x, wid = __builtin_amdgcn_readfirstlane(tid >> 6), lane = tid & 63, wr = wid >> 2, wc = wid & 3, fr = lane & 15, fq = lane >> 4;
    const int K = g.K, nt = K / BK;
    int ts_lo = 0, ts_hi = 0, nts = 0; const unsigned long long rt_entry = STAMP ? (unsigned long long)0ull : 0ull;
#define PG8_STAMP() do { if (STAMP && wid == 0 && nts < 64) { const unsigned long long _c = (unsigned long long)clock64(); \
        ts_lo = (lane == nts) ? (int)(unsigned)_c : ts_lo; ts_hi = (lane == nts) ? (int)(unsigned)(_c >> 32) : ts_hi; ++nts; } } while (0)
    PG8_STAMP();
    unsigned voffA[2], voffB[2];
#pragma unroll
    for (int i = 0; i < 2; ++i) { int R, C; stage_rc(tid * 16 + i * 8192, R, C); const int Rb = Epi::PERM ? ((R & ~31) + perm32(R & 31)) : R;
        voffA[i] = (unsigned)(R * K + C) * 2u; voffB[i] = (unsigned)(Rb * K + C) * 2u; }
    const size_t kstep = (size_t)(BK * 2);
    const size_t hstep = (size_t)HALF * K * 2;
    const size_t tstep = 2 * hstep;
    const unsigned ldsw = (unsigned)wid * 1024u;
    const int aoff = lds_byte(wr * 64 + fr, fq * 8), boff = lds_byte(wc * 32 + fr, fq * 8);
#define PG8_SA(b, h) (((b) * 2 + (h)) * HTB)
#define PG8_SB(b, h) ((4 + (b) * 2 + (h)) * HTB)
#define PG8_STAGE(bufoff, gbase, voff) do { _Pragma("unroll") for (int _i = 0; _i < 2; ++_i) \
        __builtin_amdgcn_global_load_lds((const unsigned*)((const char*)(gbase) + (voff)[_i]), (PG8_LAS unsigned*)(lds + (bufoff) + ldsw + _i * 8192), 16, 0, 0); } while (0)
#define PG8_LDA(dst, b, h) do { _Pragma("unroll") for (int m = 0; m < 4; ++m) _Pragma("unroll") for (int k = 0; k < 2; ++k) dst[m][k] = *(const PG8_LAS bf16x8*)(lds + PG8_SA(b, h) + aoff + m * 2048 + k * 1024); } while (0)
#define PG8_LDB(dst, b, h) do { _Pragma("unroll") for (int n = 0; n < 2; ++n) _Pragma("unroll") for (int k = 0; k < 2; ++k) dst[n][k] = *(const PG8_LAS bf16x8*)(lds + PG8_SB(b, h) + boff + n * 2048 + k * 1024); } while (0)
#define PG8_MMA(ai, bj, At, Bt) do { __builtin_amdgcn_s_setprio(1); _Pragma("unroll") for (int m = 0; m < 4; ++m) _Pragma("unroll") for (int n = 0; n < 2; ++n) _Pragma("unroll") for (int k = 0; k < 2; ++k) \
        acc[ai][bj][m][n] = __builtin_amdgcn_mfma_f32_16x16x32_bf16(Bt[n][k], At[m][k], acc[ai][bj][m][n], 0, 0, 0); __builtin_amdgcn_s_setprio(0); } while (0)
#define PG8_WAIT_V(n) asm volatile("s_waitcnt vmcnt(" #n ")" ::: "memory")
#define PG8_WAIT_L(n) asm volatile("s_waitcnt lgkmcnt(" #n ")" ::: "memory")
#define PG8_BAR __builtin_amdgcn_s_barrier()
#define PG8_SCHED __builtin_amdgcn_sched_barrier(0)
    Unit cur, nxt; int ui = 0;
    if (!S.next(0, cur)) return;
    f32x4 acc[2][2][4][2];
#pragma unroll
    for (int a = 0; a < 2; ++a)
#pragma unroll
        for (int b = 0; b < 2; ++b)
#pragma unroll
            for (int m = 0; m < 4; ++m)
#pragma unroll
                for (int n = 0; n < 2; ++n) acc[a][b][m][n] = (f32x4){0.f, 0.f, 0.f, 0.f};
    bf16x8 At[4][2], B0[2][2], B1[2][2];
    const char* cA = (const char*)g.A + (size_t)cur.pm * tstep; const char* cB = (const char*)g.Bt + (size_t)cur.pn * tstep;
    S.a_ready(cur);
    PG8_STAGE(PG8_SB(0, 0), cB, voffB); PG8_STAGE(PG8_SA(0, 0), cA, voffA); PG8_STAGE(PG8_SB(0, 1), cB + hstep, voffB); PG8_STAGE(PG8_SA(0, 1), cA + hstep, voffA);
    if (wr == 1) PG8_BAR;
    PG8_WAIT_V(4); PG8_BAR;
    PG8_STAGE(PG8_SB(1, 0), cB + kstep, voffB); PG8_STAGE(PG8_SA(1, 0), cA + kstep, voffA); PG8_STAGE(PG8_SB(1, 1), cB + hstep + kstep, voffB);
    PG8_WAIT_V(6); PG8_BAR;
    PG8_STAMP();
    for (;;) {
        const bool has_next = S.next(ui + 1, nxt);
        const char* nA = has_next ? (const char*)g.A + (size_t)nxt.pm * tstep : cA; const char* nB = has_next ? (const char*)g.Bt + (size_t)nxt.pn * tstep : cB;
        for (int t = 0; t < nt; t += 2) {
            const bool last = (t == nt - 2);
            const char* a1 = cA + (size_t)(t + 1) * kstep;
            const char* a2 = last ? nA : cA + (size_t)(t + 2) * kstep; const char* b2 = last ? nB : cB + (size_t)(t + 2) * kstep;
            const char* a3 = a2 + kstep; const char* b3 = b2 + kstep;
            if (last && has_next) S.a_ready(nxt);
            PG8_LDB(B0, 0, 0); PG8_SCHED; PG8_LDA(At, 0, 0); PG8_STAGE(PG8_SA(1, 1), a1 + hstep, voffA);
            PG8_WAIT_L(8); PG8_BAR; PG8_WAIT_L(0); PG8_MMA(0, 0, At, B0); PG8_BAR; PG8_SCHED;
            PG8_LDB(B1, 0, 1); PG8_STAGE(PG8_SB(0, 0), b2, voffB);
            PG8_BAR; PG8_WAIT_L(0); PG8_MMA(0, 1, At, B1); PG8_BAR;
            PG8_LDA(At, 0, 1); PG8_STAGE(PG8_SA(0, 0), a2, voffA);
            PG8_BAR; PG8_WAIT_L(0); PG8_MMA(1, 0, At, B0); PG8_BAR; PG8_SCHED;
            PG8_STAGE(PG8_SB(0, 1), b2 + hstep, voffB);
            PG8_WAIT_V(6); PG8_BAR; PG8_MMA(1, 1, At, B1); PG8_BAR;
            PG8_LDB(B0, 1, 0); PG8_SCHED; PG8_LDA(At, 1, 0); PG8_STAGE(PG8_SA(0, 1), a2 + hstep, voffA);
            PG8_WAIT_L(8); PG8_BAR; PG8_WAIT_L(0); PG8_MMA(0, 0, At, B0); PG8_BAR; PG8_SCHED;
            PG8_LDB(B1, 1, 1); PG8_STAGE(PG8_SB(1, 0), b3, voffB);
            PG8_BAR; PG8_WAIT_L(0); PG8_MMA(0, 1, At, B1); PG8_BAR;
            PG8_LDA(At, 1, 1); PG8_STAGE(PG8_SA(1, 0), a3, voffA);
            PG8_BAR; PG8_WAIT_L(0); PG8_MMA(1, 0, At, B0); PG8_BAR; PG8_SCHED;
            PG8_STAGE(PG8_SB(1, 1), b3 + hstep, voffB);
            PG8_WAIT_V(6); PG8_BAR; PG8_MMA(1, 1, At, B1); PG8_BAR;
        }
        PG8_STAMP();
        if constexpr (!Epi::AFTER_DRAIN) { E(acc, cur, wr, wc, fr, fq); S.done(cur); }
        PG8_STAMP();
        if (!has_next) break;
#pragma unroll
        for (int a = 0; a < 2; ++a)
#pragma unroll
            for (int b = 0; b < 2; ++b)
#pragma unroll
                for (int m = 0; m < 4; ++m)
#pragma unroll
                    for (int n = 0; n < 2; ++n) acc[a][b][m][n] = (f32x4){0.f, 0.f, 0.f, 0.f};
        cur = nxt; cA = nA; cB = nB; ++ui;
    }
    PG8_WAIT_V(0);
    if (wr == 0) PG8_BAR;
    PG8_BAR;
    if constexpr (Epi::AFTER_DRAIN) { E.fused(acc, cur, wr, wc, fr, fq, lds, wid, lane); S.done(cur); }
    PG8_STAMP();
    if (STAMP && wid == 0) { stamps[lane] = lane < nts ? (((unsigned long long)(unsigned)ts_hi << 32) | (unsigned)ts_lo) : 0ull;
        if (lane == 62) stamps[62] = rt_entry; if (lane == 63) stamps[63] = (unsigned long long)0ull; }
#undef PG8_STAMP
#undef PG8_SA
#undef PG8_SB
#undef PG8_STAGE
#undef PG8_LDA
#undef PG8_LDB
#undef PG8_MMA
#undef PG8_WAIT_V
#undef PG8_WAIT_L
#undef PG8_BAR
#undef PG8_SCHED
}
}

namespace {
constexpr int D = 1024, BATCH = 2, SEQ = 8192, T = BATCH * SEQ;
constexpr int PW = 2312;
constexpr int PS = 2304;
constexpr int OQ = 0, OKK = 512, OV = 640, OZ = 768, OXBC = 1280, ODT = 2304;
constexpr float EPS = 1e-6f;
constexpr int NTHR = 512;
typedef unsigned short bf16;
typedef unsigned v4u __attribute__((ext_vector_type(4)));

constexpr size_t MiB = 1u << 20;
constexpr size_t WS_WIN = 1 * MiB;
constexpr size_t WS_KH = 5 * MiB + 512 * 1024;
constexpr size_t WS_WO = 6 * MiB;
constexpr size_t WS_WQ = 8 * MiB;
constexpr size_t WS_PROJ = 10 * MiB;
constexpr size_t WS_XNB = 82 * MiB;
constexpr size_t WS_XACT = 114 * MiB;
constexpr size_t WS_DTRAW = 146 * MiB;
constexpr size_t WS_DT = WS_DTRAW + 512 * 1024;
constexpr size_t WS_ACS = WS_DT + 512 * 1024;
constexpr size_t WS_CDEC = WS_ACS + 512 * 1024;
constexpr size_t WS_STATES = 164 * MiB;
constexpr size_t WS_PREV = 196 * MiB;
constexpr size_t WS_QP = 10 * MiB;
constexpr size_t WS_IDX = 74 * MiB;
constexpr size_t WS_GATE = 114 * MiB;
constexpr size_t WS_TOPV = 122 * MiB;
constexpr size_t WS_TOPI = 138 * MiB;
constexpr size_t WS_ACT = 122 * MiB;
constexpr size_t WS_SU = 245 * MiB;
constexpr size_t WS_U8 = 212 * MiB;
constexpr size_t WS_V8 = 148 * MiB;
constexpr size_t WS_PART = 10 * MiB;
constexpr size_t WS_XQ = 228 * MiB;
constexpr size_t WS_XS = 244 * MiB;
constexpr size_t WS_PEERO = 10 * MiB;
constexpr size_t WS_END = 246 * MiB;
constexpr int CW_QU = 4096, CW_QV = 4096 + 64 * 16;
constexpr int NPART = 8, NCHUNK = T / 64;

struct Args {
    const float* x; const float* norm_mix_g; const float* w_in; const float* attn_sinks; const float* attn_out_g;
    const float* conv_w; const float* conv_b; const float* dt_bias; const float* a_log; const float* d_skip;
    const float* ssm_norm_g; const float* w_out; const float* norm_ffn_g; const float* peer_wq; const float* peer_sub_keys;
    const float* peer_u; const float* peer_v; const float* final_norm_g;
    float* out; unsigned char* ws;
    int ph_lo, ph_hi;
};

#define LAS __attribute__((address_space(3)))
#define LDS_WAIT() asm volatile("s_waitcnt lgkmcnt(0)" ::: "memory")
__device__ __forceinline__ float bf2f(bf16 v) { return __uint_as_float(((unsigned)v) << 16); }
__device__ __forceinline__ unsigned f2bfu(float f) { unsigned u = __float_as_uint(f); return (u + 0x7fffu + ((u >> 16) & 1u)) >> 16; }
__device__ __forceinline__ bf16 f2bf(float f) { return (bf16)f2bfu(f); }
__device__ __forceinline__ unsigned pk2(float lo, float hi) { return f2bfu(lo) | (f2bfu(hi) << 16); }
__device__ __forceinline__ float wave_sum(float v) {
#pragma unroll
    for (int o = 1; o < 64; o <<= 1) v += __shfl_xor(v, o);
    return v;
}
__device__ __forceinline__ float silu_f(float v) { return v / (1.f + __expf(-v)); }

__device__ __forceinline__ void transpose_item(const float* W, int ldw, int K, bf16* WT, LAS float* scr, int kb, int nbk, int lane) {
    const int k0 = 64 * kb, n0 = 32 * nbk;
#pragma unroll 8
    for (int i = 0; i < 32; ++i) { const int kk = 2 * i + (lane >> 5); scr[kk * 33 + (lane & 31)] = W[(size_t)(k0 + kk) * ldw + n0 + (lane & 31)]; }
    LDS_WAIT();
    const int c = lane & 7;
#pragma unroll
    for (int j = 0; j < 4; ++j) { const int n = (lane >> 3) + 8 * j; const LAS float* s = scr + (8 * c) * 33 + n;
        v4u o; o.x = pk2(s[0 * 33], s[1 * 33]); o.y = pk2(s[2 * 33], s[3 * 33]); o.z = pk2(s[4 * 33], s[5 * 33]); o.w = pk2(s[6 * 33], s[7 * 33]);
        *(v4u*)(WT + (size_t)(n0 + n) * K + k0 + 8 * c) = o; }
    LDS_WAIT();
}

template <int MODE  >
__device__ __forceinline__ void rmsnorm_rows_bf16(const float* __restrict__ in, const float* __restrict__ g, bf16* __restrict__ outp, const LAS unsigned char* ldsb, float* __restrict__ dtraw, unsigned char* __restrict__ xq, float* __restrict__ xs, int gwave, int nwaves, int lane) {
#pragma unroll 2
    for (int row = gwave; row < T; row += nwaves) {
        const float4* xr = (const float4*)(in + (size_t)row * D) + lane; const uint2* xb = (const uint2*)((const bf16*)in + (size_t)row * D) + lane;
        float4 v[4]; float ss = 0.f;
#pragma unroll
        for (int j = 0; j < 4; ++j) {
            if (MODE == 2) { const uint2 w = xb[64 * j]; v[j] = make_float4(__uint_as_float(w.x << 16), __uint_as_float(w.x & 0xffff0000u), __uint_as_float(w.y << 16), __uint_as_float(w.y & 0xffff0000u)); }
            else v[j] = xr[64 * j];
            ss += v[j].x * v[j].x + v[j].y * v[j].y + v[j].z * v[j].z + v[j].w * v[j].w; }
        ss = wave_sum(ss);
        const float r = rsqrtf(ss * (1.f / D) + EPS);
        unsigned long long* o8 = (unsigned long long*)(outp + (size_t)row * D) + lane;
        float dacc[8]; float y[4][4]; float mx = 0.f;
#pragma unroll
        for (int h = 0; h < 8; ++h) dacc[h] = 0.f;
#pragma unroll
        for (int j = 0; j < 4; ++j) {
            const float4 gv = ((const float4*)g)[lane + 64 * j];
            y[j][0] = v[j].x * r * gv.x; y[j][1] = v[j].y * r * gv.y; y[j][2] = v[j].z * r * gv.z; y[j][3] = v[j].w * r * gv.w;
            o8[64 * j] = (unsigned long long)pk2(y[j][0], y[j][1]) | ((unsigned long long)pk2(y[j][2], y[j][3]) << 32);
            if (MODE == 2) mx = fmaxf(mx, fmaxf(fmaxf(fabsf(y[j][0]), fabsf(y[j][1])), fmaxf(fabsf(y[j][2]), fabsf(y[j][3]))));
            if (MODE == 1) {
#pragma unroll
                for (int h = 0; h < 8; ++h) {
                    typedef float f4v __attribute__((ext_vector_type(4)));
                    const f4v wv = *(const LAS f4v*)(ldsb + h * 16384 + 8448 + (256 * j + 4 * lane) * 4);
                    dacc[h] += y[j][0] * wv.x + y[j][1] * wv.y + y[j][2] * wv.z + y[j][3] * wv.w;
                }
            }
        }
        if (MODE == 1) {
#pragma unroll
            for (int h = 0; h < 8; ++h) dacc[h] = wave_sum(dacc[h]);
            if (lane == 0) { float4* dp = (float4*)(dtraw + (size_t)row * 8); dp[0] = make_float4(dacc[0], dacc[1], dacc[2], dacc[3]); dp[1] = make_float4(dacc[4], dacc[5], dacc[6], dacc[7]); }
        }
        if (MODE == 2) {
#pragma unroll
            for (int o = 1; o < 64; o <<= 1) mx = fmaxf(mx, __shfl_xor(mx, o));
            const float sc = mx > 0.f ? mx * (1.f / 127.f) : 1.f, inv = 1.f / sc;
            unsigned* dq = (unsigned*)(xq + (size_t)row * D) + lane;
#pragma unroll
            for (int j = 0; j < 4; ++j) { const int q0 = (int)rintf(y[j][0] * inv), q1 = (int)rintf(y[j][1] * inv), q2 = (int)rintf(y[j][2] * inv), q3 = (int)rintf(y[j][3] * inv);
                dq[64 * j] = (unsigned)(q0 & 255) | ((unsigned)(q1 & 255) << 8) | ((unsigned)(q2 & 255) << 16) | ((unsigned)(q3 & 255) << 24); }
            if (lane == 0) xs[row] = sc;
        }
    }
}

typedef short bf16x8 __attribute__((ext_vector_type(8)));
typedef short bf16x4 __attribute__((ext_vector_type(4)));
typedef float f32x16 __attribute__((ext_vector_type(16)));
typedef __bf16 bf2_t __attribute__((ext_vector_type(2)));
#define MFMA32(a, b, c) __builtin_amdgcn_mfma_f32_32x32x16_bf16((a), (b), (c), 0, 0, 0)
__device__ __forceinline__ unsigned pkbf(float lo, float hi) { bf2_t v = {(__bf16)lo, (__bf16)hi}; return __builtin_bit_cast(unsigned, v); }
__device__ __forceinline__ short bfs(float f) { return __builtin_bit_cast(short, (__bf16)f); }
__device__ __forceinline__ float sbf2f(short v) { return __uint_as_float(((unsigned)(unsigned short)v) << 16); }
__device__ __forceinline__ int crow(int i, int hi) { return (i & 3) + 8 * (i >> 2) + 4 * hi; }
template <int S> __device__ __forceinline__ bf16x8 pack8(const f32x16& x) {
    v4u p; p.x = pkbf(x[8 * S], x[8 * S + 1]); p.y = pkbf(x[8 * S + 2], x[8 * S + 3]); p.z = pkbf(x[8 * S + 4], x[8 * S + 5]); p.w = pkbf(x[8 * S + 6], x[8 * S + 7]);
    return __builtin_bit_cast(bf16x8, p);
}
__device__ __forceinline__ bf16x8 ldg8(const bf16* p) { return *(const bf16x8*)p; }
__device__ __forceinline__ bf16x8 lds8(const LAS bf16* p) { return *(const LAS bf16x8*)p; }
__device__ __forceinline__ bf16x8 lds4x2(const LAS bf16* p) { const bf16x4 a = *(const LAS bf16x4*)p, b = *(const LAS bf16x4*)(p + 8); return __builtin_shufflevector(a, b, 0, 1, 2, 3, 4, 5, 6, 7); }
__device__ __forceinline__ f32x16 zero16() { f32x16 z;
#pragma unroll
    for (int i = 0; i < 16; ++i) z[i] = 0.f;
    return z; }

__device__ __forceinline__ void attn_unit(const float* sinks, const float* gnorm, LAS unsigned char* ldsb, int unit, const bf16* PROJ, bf16* MIXB, int tid, int lane, int wave) {
    asm volatile("" : "+v"(tid), "+v"(lane));
    const int tok0 = unit * 64, s0 = tok0 & (SEQ - 1), kbase = tok0 - 128;
    LAS bf16* VT = (LAS bf16*)ldsb;
    LAS bf16* KI = (LAS bf16*)(ldsb + 51200);
    LAS float* SSQ = (LAS float*)(ldsb + 51200 + 55296);
    const __amdgpu_buffer_rsrc_t rsP = __builtin_amdgcn_make_buffer_rsrc((void*)PROJ, 0, (unsigned)T * PS * 2u, 0x00020000);
#pragma unroll
    for (int i = 0; i < 6; ++i) {
        const int c = tid + 512 * i, kv = c / 1536, cc = c - kv * 1536, key = cc >> 3, d0 = (cc & 7) * 8; const bool valid = (s0 - 128 + key) >= 0;
        bf16x8 v, k;
#pragma unroll
        for (int e = 0; e < 8; ++e) { v[e] = 0; k[e] = 0; }
        if (valid) { const unsigned ro = (unsigned)(kbase + key) * (unsigned)PS + (unsigned)(kv * 64 + d0);
            v = __builtin_bit_cast(bf16x8, __builtin_amdgcn_raw_buffer_load_b128(rsP, (int)((ro + (unsigned)OV) * 2u), 0, 0));
            k = __builtin_bit_cast(bf16x8, __builtin_amdgcn_raw_buffer_load_b128(rsP, (int)((ro + (unsigned)OKK) * 2u), 0, 0)); }
#pragma unroll
        for (int e = 0; e < 8; ++e) VT[kv * 12800 + (d0 + e) * 200 + key] = (bf16)v[e];
        *(LAS bf16x8*)(KI + (kv * 192 + key) * 72 + d0) = k;
    }
    __syncthreads();
    const int r = lane & 31, hi = lane >> 5;
    const int hq = wave, hkv = wave >> 2;
    const float slope = exp2f(-(float)(hq + 1)), sink = sinks[hq];
#pragma unroll 1
    for (int qt = 0; qt < 2; ++qt) {
        const int tq = tok0 + 32 * qt + r;
        bf16x8 qf[4];
        { const bf16* qp = PROJ + (size_t)tq * PS + OQ + hq * 64 + 8 * hi; asm volatile("" : "+v"(qp));
#pragma unroll
          for (int ks = 0; ks < 4; ++ks) qf[ks] = ldg8(qp + 16 * ks); }
        const int ql = 32 * qt + r;
        float m = sink, lh = 0.f;
        f32x16 O0 = zero16(), O1 = zero16();
#pragma unroll 1
        for (int kt = 0; kt < 5; ++kt) {
            const LAS bf16* kp = KI + (hkv * 192 + 32 * (qt + kt) + r) * 72 + 8 * hi;
            f32x16 X = zero16();
#pragma unroll
            for (int ks = 0; ks < 4; ++ks) X = MFMA32(lds8(kp + 16 * ks), qf[ks], X);
            float tm = -1e30f;
#pragma unroll
            for (int i = 0; i < 16; ++i) {
                const int kl = 32 * (qt + kt) + crow(i, hi), dist = 128 + ql - kl;
                const bool valid = (dist >= 0) && (dist < 128) && ((s0 - 128 + kl) >= 0);
                const float lg = valid ? (X[i] * 0.125f - slope * (float)dist) : -1e30f;
                X[i] = lg; tm = fmaxf(tm, lg);
            }
            tm = fmaxf(tm, __shfl_xor(tm, 32));
            const float mn = fmaxf(m, tm), sc = __expf(m - mn);
            m = mn; lh *= sc;
#pragma unroll
            for (int i = 0; i < 16; ++i) { O0[i] *= sc; O1[i] *= sc; const float pe = __expf(X[i] - mn); X[i] = pe; lh += pe; }
            const LAS bf16* vp = VT + hkv * 12800 + r * 200 + 32 * (qt + kt) + 4 * hi;
            { const bf16x8 xs = pack8<0>(X); const bf16x8 a0 = lds4x2(vp), a1 = lds4x2(vp + 32 * 200); O0 = MFMA32(a0, xs, O0); O1 = MFMA32(a1, xs, O1); }
            { const bf16x8 xs = pack8<1>(X); const bf16x8 a0 = lds4x2(vp + 16), a1 = lds4x2(vp + 32 * 200 + 16); O0 = MFMA32(a0, xs, O0); O1 = MFMA32(a1, xs, O1); }
        }
        const float lsum = lh + __shfl_xor(lh, 32) + __expf(sink - m);
        const float iv = 1.f / lsum;
        float sq = 0.f;
#pragma unroll
        for (int i = 0; i < 16; ++i) sq += O0[i] * O0[i] + O1[i] * O1[i];
        sq *= iv * iv; sq += __shfl_xor(sq, 32);
        if (hi == 0) SSQ[hq * 32 + r] = sq;
        __syncthreads();
        float tot = 0.f;
#pragma unroll
        for (int h = 0; h < 8; ++h) tot += SSQ[h * 32 + r];
        const float sc = iv * rsqrtf(tot * (1.f / 512.f) + EPS);
        bf16* orow = MIXB + (size_t)tq * D + hq * 64 + 4 * hi;
#pragma unroll
        for (int q4 = 0; q4 < 4; ++q4) {
            const float4 g0 = *(const float4*)(gnorm + hq * 64 + 8 * q4 + 4 * hi), g1 = *(const float4*)(gnorm + hq * 64 + 32 + 8 * q4 + 4 * hi);
            uint2 w0, w1;
            w0.x = pkbf(O0[4 * q4] * sc * g0.x, O0[4 * q4 + 1] * sc * g0.y); w0.y = pkbf(O0[4 * q4 + 2] * sc * g0.z, O0[4 * q4 + 3] * sc * g0.w);
            w1.x = pkbf(O1[4 * q4] * sc * g1.x, O1[4 * q4 + 1] * sc * g1.y); w1.y = pkbf(O1[4 * q4 + 2] * sc * g1.z, O1[4 * q4 + 3] * sc * g1.w);
            *(uint2*)(orow + 8 * q4) = w0; *(uint2*)(orow + 32 + 8 * q4) = w1;
        }
        __syncthreads();
    }
}

__device__ __forceinline__ void ssd_chunk_unit(LAS unsigned char* ldsb, int unit, const bf16* PROJ, bf16* XACT, const float* DTRAW, const float* conv_w, const float* conv_b, const float* dt_bias, const float* a_log,
                                               float* ACS, float* CDEC, float* MIXF, float* STATES, int tid, int lane, int wave) {
    asm volatile("" : "+v"(tid), "+v"(lane));
    const int g = unit & 1, bc = unit >> 1, tok0 = bc * 128;
    LAS float* DTT = (LAS float*)(ldsb + 34816 * 3 + 2048);
    LAS float* WT = (LAS float*)(ldsb + 34816 * 3 + 4096);
    {
        const int cgi = tid & 63, t0 = tok0 + 16 * (tid >> 6);
        const int c0 = cgi < 32 ? g * 256 + cgi * 8 : (cgi < 48 ? 512 + g * 128 + (cgi - 32) * 8 : 768 + g * 128 + (cgi - 48) * 8);
        float w[4][8], bs[8];
#pragma unroll
        for (int k = 0; k < 4; ++k) { const float4 a0 = *(const float4*)(conv_w + k * 1024 + c0), a1 = *(const float4*)(conv_w + k * 1024 + c0 + 4);
            w[k][0] = a0.x; w[k][1] = a0.y; w[k][2] = a0.z; w[k][3] = a0.w; w[k][4] = a1.x; w[k][5] = a1.y; w[k][6] = a1.z; w[k][7] = a1.w; }
        { const float4 a0 = *(const float4*)(conv_b + c0), a1 = *(const float4*)(conv_b + c0 + 4); bs[0] = a0.x; bs[1] = a0.y; bs[2] = a0.z; bs[3] = a0.w; bs[4] = a1.x; bs[5] = a1.y; bs[6] = a1.z; bs[7] = a1.w; }
        const bool has_halo = (t0 & (SEQ - 1)) != 0;
        bf16x8 rows[19];
#pragma unroll
        for (int i = 0; i < 19; ++i) {
            if (i < 3 && !has_halo) {
#pragma unroll
                for (int e = 0; e < 8; ++e) rows[i][e] = 0;
            } else rows[i] = ldg8(PROJ + (size_t)(t0 + i - 3) * PS + OXBC + c0);
        }
#pragma unroll
        for (int i = 0; i < 16; ++i) {
            float o[8];
#pragma unroll
            for (int e = 0; e < 8; ++e) o[e] = silu_f(bs[e] + w[0][e] * sbf2f(rows[i][e]) + w[1][e] * sbf2f(rows[i + 1][e]) + w[2][e] * sbf2f(rows[i + 2][e]) + w[3][e] * sbf2f(rows[i + 3][e]));
            v4u ov; ov.x = pkbf(o[0], o[1]); ov.y = pkbf(o[2], o[3]); ov.z = pkbf(o[4], o[5]); ov.w = pkbf(o[6], o[7]);
            *(v4u*)(XACT + (size_t)(t0 + i) * 1024 + c0) = ov;
        }
    }
    LAS float* ACST = (LAS float*)(ldsb + 34816 * 3);
    {
        const int s = tid >> 2, hh = tid & 3, H = g * 4 + hh;
        const float A = -__expf(a_log[H]);
        const float raw = DTRAW[(size_t)(tok0 + s) * 8 + H] + dt_bias[H];
        const float dtv = fmaxf(raw, 0.f) + log1pf(__expf(-fabsf(raw)));
        float v = dtv * A;
#pragma unroll
        for (int o = 4; o < 64; o <<= 1) { const float y = __shfl_up(v, o); if (lane >= o) v += y; }
        if (lane >= 60) WT[wave * 4 + hh] = v;
        __syncthreads();
        float off = 0.f;
        for (int w2 = 0; w2 < wave; ++w2) off += WT[w2 * 4 + hh];
        v += off;
        DTT[tid] = dtv; ACST[tid] = v; ACS[(size_t)(tok0 + s) * 8 + H] = v;
        if (s == 127) CDEC[bc * 8 + H] = __expf(v);
    }
    asm volatile("s_waitcnt vmcnt(0)" ::: "memory");
    __syncthreads();
    LAS bf16* BT = (LAS bf16*)ldsb;
    LAS bf16* XD = (LAS bf16*)(ldsb + 34816);
    LAS bf16* XW = (LAS bf16*)(ldsb + 34816 + 34816);
    const int r = lane & 31, hi = lane >> 5;
#pragma unroll
    for (int i = 0; i < 4; ++i) {
        const int c = tid + 512 * i, s = c >> 4, n0 = (c & 15) * 8;
        const bf16x8 v = ldg8(XACT + (size_t)(tok0 + s) * 1024 + 512 + g * 128 + n0);
#pragma unroll
        for (int e = 0; e < 8; ++e) BT[(n0 + e) * 136 + s] = (bf16)v[e];
    }
#pragma unroll 1
    for (int hp = 0; hp < 2; ++hp) {
        if (hp) __syncthreads();
        int tidp = tid; asm volatile("" : "+v"(tidp));
#pragma unroll
        for (int i = 0; i < 4; ++i) {
            const int c = tidp + 512 * i, hsel = c >> 10, s = (c >> 3) & 127, p0 = (c & 7) * 8, H = g * 4 + 2 * hp + hsel;
            const bf16x8 v = ldg8(XACT + (size_t)(tok0 + s) * 1024 + H * 64 + p0);
            const float dtv = DTT[s * 4 + 2 * hp + hsel];
            const float w = __expf(ACST[127 * 4 + 2 * hp + hsel] - ACST[s * 4 + 2 * hp + hsel]);
#pragma unroll
            for (int e = 0; e < 8; ++e) { const float xd = sbf2f(v[e]) * dtv; XD[hsel * 8704 + (p0 + e) * 136 + s] = (bf16)bfs(xd); XW[hsel * 8704 + (p0 + e) * 136 + s] = (bf16)bfs(xd * w); }
        }
        __syncthreads();
        {
            const int lt = wave & 3, hsel = wave >> 2, hh = 2 * hp + hsel, H = g * 4 + hh;
            const int l = 32 * lt + r; const float acs_l = ACST[l * 4 + hh];
            bf16x8 cf[8];
            { const bf16* cp = XACT + (size_t)(tok0 + l) * 1024 + 768 + g * 128 + 8 * hi; asm volatile("" : "+v"(cp));
#pragma unroll
              for (int ks = 0; ks < 8; ++ks) cf[ks] = ldg8(cp + 16 * ks); }
            f32x16 Z0 = zero16(), Z1 = zero16();
            bf16x8 bn[8];
            { const bf16* bp = XACT + (size_t)(tok0 + r) * 1024 + 512 + g * 128 + 8 * hi; asm volatile("" : "+v"(bp));
#pragma unroll
              for (int ks = 0; ks < 8; ++ks) bn[ks] = ldg8(bp + 16 * ks); }
#pragma unroll 1
            for (int st = 0; st <= lt; ++st) {
                f32x16 X = zero16();
                bf16x8 bc[8];
#pragma unroll
                for (int ks = 0; ks < 8; ++ks) bc[ks] = bn[ks];
                { const int stn = st < lt ? st + 1 : lt; const bf16* bp = XACT + (size_t)(tok0 + 32 * stn + r) * 1024 + 512 + g * 128 + 8 * hi; asm volatile("" : "+v"(bp));
#pragma unroll
                  for (int ks = 0; ks < 8; ++ks) bn[ks] = ldg8(bp + 16 * ks); }
#pragma unroll
                for (int ks = 0; ks < 8; ++ks) X = MFMA32(bc[ks], cf[ks], X);
#pragma unroll
                for (int i = 0; i < 16; ++i) { const int s = 32 * st + crow(i, hi); const float f = (s <= l) ? __expf(acs_l - ACST[s * 4 + hh]) : 0.f; X[i] *= f; }
                const int sb = 32 * st + 4 * hi;
                { const bf16x8 xs = pack8<0>(X); const bf16x8 b0 = lds4x2(XD + hsel * 8704 + r * 136 + sb), b1 = lds4x2(XD + hsel * 8704 + (32 + r) * 136 + sb); Z0 = MFMA32(xs, b0, Z0); Z1 = MFMA32(xs, b1, Z1); }
                { const bf16x8 xs = pack8<1>(X); const bf16x8 b0 = lds4x2(XD + hsel * 8704 + r * 136 + sb + 16), b1 = lds4x2(XD + hsel * 8704 + (32 + r) * 136 + sb + 16); Z0 = MFMA32(xs, b0, Z0); Z1 = MFMA32(xs, b1, Z1); }
            }
#pragma unroll
            for (int i = 0; i < 16; ++i) { float* o = MIXF + (size_t)(tok0 + 32 * lt + crow(i, hi)) * D + 512 + H * 64 + r; o[0] = Z0[i]; o[32] = Z1[i]; }
        }
        {
            const int nt = wave & 3, hsel = wave >> 2, H = g * 4 + 2 * hp + hsel;
            f32x16 S0 = zero16(), S1 = zero16();
#pragma unroll
            for (int ks = 0; ks < 8; ++ks) {
                const bf16x8 btf = lds8(BT + (32 * nt + r) * 136 + 16 * ks + 8 * hi);
                const bf16x8 a0 = lds8(XW + hsel * 8704 + r * 136 + 16 * ks + 8 * hi), a1 = lds8(XW + hsel * 8704 + (32 + r) * 136 + 16 * ks + 8 * hi);
                S0 = MFMA32(a0, btf, S0); S1 = MFMA32(a1, btf, S1);
            }
            float* sp = STATES + (size_t)(bc * 8 + H) * 8192 + 32 * nt + r;
#pragma unroll
            for (int i = 0; i < 16; ++i) { const int p = crow(i, hi); sp[p * 128] = S0[i]; sp[(32 + p) * 128] = S1[i]; }
        }
    }
    __syncthreads();
}

__device__ __forceinline__ __amdgpu_buffer_rsrc_t mk_rsrc(const void* p, unsigned bytes) { return __builtin_amdgcn_make_buffer_rsrc((void*)p, 0, bytes, 0x00020000); }
__device__ __forceinline__ void yoff_unit(const float* d_skip, const float* gnorm, LAS unsigned char* ldsb, int unit, const bf16* XACT, const bf16* PROJ, const float* ACS, const bf16* PREVT,
                                          const float* MIXF, bf16* MIXB, int lane, int wave) {
    const int g = unit & 1, bc = unit >> 1, tok0 = bc * 128;
    const int r = lane & 31, hi = lane >> 5, lt = wave & 3, hpair = wave >> 2;
    LAS float* TAB = (LAS float*)ldsb;
    const __amdgpu_buffer_rsrc_t rsF = mk_rsrc(MIXF, (unsigned)T * D * 4u), rsX = mk_rsrc(XACT, (unsigned)T * 1024u * 2u), rsP = mk_rsrc(PROJ, (unsigned)T * PS * 2u), rsA = mk_rsrc(ACS, (unsigned)T * 32u), rsB = mk_rsrc(MIXB, (unsigned)T * D * 2u);
    const unsigned tb = (unsigned)(tok0 + 32 * lt + 4 * hi);
    bf16x8 cf[8];
    { const bf16* cp = XACT + (size_t)(tok0 + 32 * lt + r) * 1024 + 768 + g * 128 + 8 * hi; asm volatile("" : "+v"(cp));
#pragma unroll
      for (int ks = 0; ks < 8; ++ks) cf[ks] = ldg8(cp + 16 * ks); }
    float eav[16], ssq[16];
    unsigned ypk[2][2][8];
#pragma unroll
    for (int i = 0; i < 16; ++i) ssq[i] = 0.f;
#pragma unroll
    for (int hsel = 0; hsel < 2; ++hsel) {
        const int H = g * 4 + 2 * hpair + hsel; const bf16* pv = PREVT + (size_t)(bc * 8 + H) * 8192 + 8 * hi;
        asm volatile("" : "+v"(pv));
        f32x16 Y0 = zero16(), Y1 = zero16();
#pragma unroll
        for (int ks = 0; ks < 8; ++ks) {
            const bf16x8 b0 = ldg8(pv + r * 128 + 16 * ks), b1 = ldg8(pv + (32 + r) * 128 + 16 * ks);
            Y0 = MFMA32(cf[ks], b0, Y0); Y1 = MFMA32(cf[ks], b1, Y1);
        }
        const float dsk = d_skip[H];
        { const unsigned vo = (tb * 8u + (unsigned)H) * 4u;
#pragma unroll
          for (int i = 0; i < 16; ++i) eav[i] = __expf(__builtin_bit_cast(float, __builtin_amdgcn_raw_buffer_load_b32(rsA, (int)vo, ((i & 3) + 8 * (i >> 2)) * 32, 0))); }
#pragma unroll
        for (int pt = 0; pt < 2; ++pt) {
            const unsigned col = (unsigned)(H * 64 + 32 * pt + r);
            const unsigned voF = (tb * 1024u + 512u + col) * 4u, voX = (tb * 1024u + col) * 2u, voP = (tb * (unsigned)PS + (unsigned)OZ + col) * 2u;
            float yo[16], xsv[16], zv[16];
#pragma unroll
            for (int i = 0; i < 16; ++i) { const int ro = (i & 3) + 8 * (i >> 2);
                yo[i] = __builtin_bit_cast(float, __builtin_amdgcn_raw_buffer_load_b32(rsF, (int)voF, ro * 4096, 0));
                xsv[i] = bf2f((bf16)__builtin_amdgcn_raw_buffer_load_b16(rsX, (int)voX, ro * 2048, 0));
                zv[i] = bf2f((bf16)__builtin_amdgcn_raw_buffer_load_b16(rsP, (int)voP, ro * (PS * 2), 0)); }
#pragma unroll
            for (int i = 0; i < 16; i += 2) {
                const float y0 = (yo[i] + eav[i] * (pt ? Y1[i] : Y0[i]) + dsk * xsv[i]) * silu_f(zv[i]);
                const float y1 = (yo[i + 1] + eav[i + 1] * (pt ? Y1[i + 1] : Y0[i + 1]) + dsk * xsv[i + 1]) * silu_f(zv[i + 1]);
                ssq[i] += y0 * y0; ssq[i + 1] += y1 * y1; ypk[hsel][pt][i >> 1] = pkbf(y0, y1);
            }
            __builtin_amdgcn_sched_barrier(0);
        }
    }
#pragma unroll
    for (int i = 0; i < 16; ++i) {
#pragma unroll
        for (int o = 1; o < 32; o <<= 1) ssq[i] += __shfl_xor(ssq[i], o);
    }
    if (r == 0) {
#pragma unroll
        for (int i = 0; i < 16; ++i) TAB[hpair * 128 + 32 * lt + crow(i, hi)] = ssq[i];
    }
    __syncthreads();
#pragma unroll
    for (int i = 0; i < 16; ++i) { const int l = 32 * lt + crow(i, hi); ssq[i] = rsqrtf((TAB[l] + TAB[128 + l]) * (1.f / 256.f) + EPS); }
#pragma unroll
    for (int hsel = 0; hsel < 2; ++hsel)
#pragma unroll
        for (int pt = 0; pt < 2; ++pt) {
            const unsigned col = (unsigned)((g * 4 + 2 * hpair + hsel) * 64 + 32 * pt + r); const float gn = gnorm[col];
            const unsigned voB = (tb * 1024u + 512u + col) * 2u;
#pragma unroll
            for (int i = 0; i < 16; ++i) { const unsigned w = ypk[hsel][pt][i >> 1];
                const float yf = (i & 1) ? __uint_as_float(w & 0xffff0000u) : __uint_as_float(w << 16);
                __builtin_amdgcn_raw_buffer_store_b16((short)f2bf(yf * ssq[i] * gn), rsB, (int)voB, ((i & 3) + 8 * (i >> 2)) * 2048, 0); }
        }
    __syncthreads();
}
typedef float f32x2 __attribute__((ext_vector_type(2)));
__device__ __forceinline__ void fp8x16_to_f32(const uint4 w, float (&f)[16]) {
    const int ww[4] = {(int)w.x, (int)w.y, (int)w.z, (int)w.w};
#pragma unroll
    for (int q = 0; q < 4; ++q) { const f32x2 a = __builtin_amdgcn_cvt_pk_f32_fp8(ww[q], false), b = __builtin_amdgcn_cvt_pk_f32_fp8(ww[q], true); f[4 * q] = a.x; f[4 * q + 1] = a.y; f[4 * q + 2] = b.x; f[4 * q + 3] = b.y; }
}
template <int M4, int M2, int M1> __device__ __forceinline__ void treduce16(const float (&a)[16], int lane, float& r0, float& r1) {
    float b[8], c[4];
    { const bool hi = (lane & M4) != 0;
#pragma unroll
      for (int i = 0; i < 8; ++i) { const float send = hi ? a[i] : a[i + 8]; const float recv = __shfl_xor(send, M4); b[i] = (hi ? a[i + 8] : a[i]) + recv; } }
    { const bool hi = (lane & M2) != 0;
#pragma unroll
      for (int i = 0; i < 4; ++i) { const float send = hi ? b[i] : b[i + 4]; const float recv = __shfl_xor(send, M2); c[i] = (hi ? b[i + 4] : b[i]) + recv; } }
    { const bool hi = (lane & M1) != 0;
      { const float send = hi ? c[0] : c[2]; const float recv = __shfl_xor(send, M1); r0 = (hi ? c[2] : c[0]) + recv; }
      { const float send = hi ? c[1] : c[3]; const float recv = __shfl_xor(send, M1); r1 = (hi ? c[3] : c[1]) + recv; } }
}
template <int M4, int M2, int M1> __device__ __forceinline__ void treduce16i(const int (&a)[16], int lane, int& r0, int& r1) {
    int b[8], c[4];
    { const bool hi = (lane & M4) != 0;
#pragma unroll
      for (int i = 0; i < 8; ++i) { const int send = hi ? a[i] : a[i + 8]; const int recv = __shfl_xor(send, M4); b[i] = (hi ? a[i + 8] : a[i]) + recv; } }
    { const bool hi = (lane & M2) != 0;
#pragma unroll
      for (int i = 0; i < 4; ++i) { const int send = hi ? b[i] : b[i + 4]; const int recv = __shfl_xor(send, M2); c[i] = (hi ? b[i + 4] : b[i]) + recv; } }
    { const bool hi = (lane & M1) != 0;
      { const int send = hi ? c[0] : c[2]; const int recv = __shfl_xor(send, M1); r0 = (hi ? c[2] : c[0]) + recv; }
      { const int send = hi ? c[1] : c[3]; const int recv = __shfl_xor(send, M1); r1 = (hi ? c[3] : c[1]) + recv; } }
}
#define PE_ID(E, i) (((i) & 1) ? (E[(i) >> 1] >> 16) : (E[(i) >> 1] & 0xffffu))
__device__ __forceinline__ void peer_u_item(int p, int j, const LAS unsigned short* EL  , const unsigned char* __restrict__ XQ, const unsigned char* __restrict__ U8, bf16* __restrict__ PART, int lane, int wave) {
    asm volatile("" : "+v"(lane));
    const int gidx = lane >> 3; const unsigned coff = (unsigned)(p * 128 + (lane & 7) * 16);
#pragma unroll 1
    for (int it = 0; it < 8; ++it) {
        const int t = j * 64 + it * 8 + wave;
        unsigned E[8];
        { const LAS v4u* ep = (const LAS v4u*)(EL + (it * 8 + wave) * 128 + 16 * gidx); const v4u e0 = ep[0], e1 = ep[1];
          E[0] = e0.x; E[1] = e0.y; E[2] = e0.z; E[3] = e0.w; E[4] = e1.x; E[5] = e1.y; E[6] = e1.z; E[7] = e1.w; }
        uint4 uu[16];
#pragma unroll
        for (int i = 0; i < 16; ++i) uu[i] = *(const uint4*)(U8 + (size_t)(PE_ID(E, i) * 1024u + coff));
        const uint4 xq = *(const uint4*)(XQ + (size_t)t * D + coff);
        int d[16];
#pragma unroll
        for (int i = 0; i < 16; ++i) {
            int s = __builtin_amdgcn_sdot4((int)uu[i].x, (int)xq.x, 0, false); s = __builtin_amdgcn_sdot4((int)uu[i].y, (int)xq.y, s, false);
            s = __builtin_amdgcn_sdot4((int)uu[i].z, (int)xq.z, s, false); s = __builtin_amdgcn_sdot4((int)uu[i].w, (int)xq.w, s, false);
            d[i] = s;
        }
        int r0, r1; treduce16i<4, 2, 1>(d, lane, r0, r1);
        *(unsigned*)(PART + ((size_t)p * T + t) * 128 + 2 * lane) = pkbf((float)r0, (float)r1);
    }
}
__device__ __forceinline__ void peer_v_item(int p, int j, const LAS unsigned short* EL, const LAS unsigned char* AL  , const float* __restrict__ ACTS,
                                            const unsigned char* __restrict__ V8, bf16* __restrict__ PEERO, int lane, int wave) {
    asm volatile("" : "+v"(lane));
    const int gidx = lane >> 3; const unsigned coff = (unsigned)(p * 128 + (lane & 7) * 16);
#pragma unroll 1
    for (int it = 0; it < 8; ++it) {
        const int t = j * 64 + it * 8 + wave;
        unsigned E[8];
        { const LAS v4u* ep = (const LAS v4u*)(EL + (it * 8 + wave) * 128 + 16 * gidx); const v4u e0 = ep[0], e1 = ep[1];
          E[0] = e0.x; E[1] = e0.y; E[2] = e0.z; E[3] = e0.w; E[4] = e1.x; E[5] = e1.y; E[6] = e1.z; E[7] = e1.w; }
        uint4 vv[16];
#pragma unroll
        for (int i = 0; i < 16; ++i) vv[i] = *(const uint4*)(V8 + (size_t)(PE_ID(E, i) * 1024u + coff));
        const v4u aq = *(const LAS v4u*)(AL + (it * 8 + wave) * 128 + 16 * gidx);
        const float asc = ACTS[t];
        const unsigned a4[4] = {aq.x, aq.y, aq.z, aq.w};
        int acc[16];
#pragma unroll
        for (int c = 0; c < 16; ++c) acc[c] = 0;
#pragma unroll
        for (int m = 0; m < 4; ++m) {
            const unsigned r0[4] = {vv[4 * m].x, vv[4 * m].y, vv[4 * m].z, vv[4 * m].w}, r1[4] = {vv[4 * m + 1].x, vv[4 * m + 1].y, vv[4 * m + 1].z, vv[4 * m + 1].w};
            const unsigned r2[4] = {vv[4 * m + 2].x, vv[4 * m + 2].y, vv[4 * m + 2].z, vv[4 * m + 2].w}, r3[4] = {vv[4 * m + 3].x, vv[4 * m + 3].y, vv[4 * m + 3].z, vv[4 * m + 3].w};
#pragma unroll
            for (int dc = 0; dc < 4; ++dc) {
                const unsigned ta = __builtin_amdgcn_perm(r1[dc], r0[dc], 0x05010400u), tb = __builtin_amdgcn_perm(r3[dc], r2[dc], 0x05010400u);
                const unsigned ua = __builtin_amdgcn_perm(r1[dc], r0[dc], 0x07030602u), ub = __builtin_amdgcn_perm(r3[dc], r2[dc], 0x07030602u);
                const unsigned c0 = __builtin_amdgcn_perm(tb, ta, 0x05040100u), c1 = __builtin_amdgcn_perm(tb, ta, 0x07060302u);
                const unsigned c2 = __builtin_amdgcn_perm(ub, ua, 0x05040100u), c3 = __builtin_amdgcn_perm(ub, ua, 0x07060302u);
                acc[4 * dc + 0] = __builtin_amdgcn_sdot4((int)c0, (int)a4[m], acc[4 * dc + 0], false);
                acc[4 * dc + 1] = __builtin_amdgcn_sdot4((int)c1, (int)a4[m], acc[4 * dc + 1], false);
                acc[4 * dc + 2] = __builtin_amdgcn_sdot4((int)c2, (int)a4[m], acc[4 * dc + 2], false);
                acc[4 * dc + 3] = __builtin_amdgcn_sdot4((int)c3, (int)a4[m], acc[4 * dc + 3], false);
            }
        }
        int r0i, r1i; treduce16i<32, 16, 8>(acc, lane, r0i, r1i);
        *(unsigned*)(PEERO + (size_t)t * D + coff + 2 * gidx) = pkbf(asc * (float)r0i, asc * (float)r1i);
    }
}

__device__ __forceinline__ void ce_desc(float& a, float& b) { const float hi = fmaxf(a, b), lo = fminf(a, b); a = hi; b = lo; }
__device__ __forceinline__ void sort16_desc(float (&v)[16]) {
#pragma unroll
    for (int k = 2; k <= 16; k <<= 1)
#pragma unroll
        for (int j = k >> 1; j > 0; j >>= 1)
#pragma unroll
            for (int i = 0; i < 16; ++i) { const int l = i ^ j; if (l > i) { if ((i & k) == 0) ce_desc(v[i], v[l]); else ce_desc(v[l], v[i]); } }
}
__device__ __forceinline__ void merge16_desc(float (&a)[16], const float (&b)[16]) {
#pragma unroll
    for (int i = 0; i < 16; ++i) a[i] = fmaxf(a[i], b[15 - i]);
#pragma unroll
    for (int j = 8; j > 0; j >>= 1)
#pragma unroll
        for (int i = 0; i < 16; ++i) { const int l = i ^ j; if (l > i) ce_desc(a[i], a[l]); }
}
__device__ __forceinline__ void ce_kv(float& ka, int& va, float& kb, int& vb) {
    const bool s = kb > ka; const float t0 = s ? kb : ka, t1 = s ? ka : kb; const int u0 = s ? vb : va, u1 = s ? va : vb; ka = t0; kb = t1; va = u0; vb = u1; }
__device__ __forceinline__ void sort16_kv(float (&k)[16], int (&v)[16]) {
#pragma unroll
    for (int kk = 2; kk <= 16; kk <<= 1)
#pragma unroll
        for (int j = kk >> 1; j > 0; j >>= 1)
#pragma unroll
            for (int i = 0; i < 16; ++i) { const int l = i ^ j; if (l > i) { if ((i & kk) == 0) ce_kv(k[i], v[i], k[l], v[l]); else ce_kv(k[l], v[l], k[i], v[i]); } }
}
__device__ __forceinline__ void merge16_kv(float (&ka)[16], int (&va)[16], const float (&kb)[16], const int (&vb)[16]) {
#pragma unroll
    for (int i = 0; i < 16; ++i) { const bool s = kb[15 - i] > ka[i]; ka[i] = s ? kb[15 - i] : ka[i]; va[i] = s ? vb[15 - i] : va[i]; }
#pragma unroll
    for (int j = 8; j > 0; j >>= 1)
#pragma unroll
        for (int i = 0; i < 16; ++i) { const int l = i ^ j; if (l > i) ce_kv(ka[i], va[i], ka[l], va[l]); }
}
__device__ __forceinline__ void split8(const float* p, bf16x8& hi8, bf16x8& lo8) {
    const float4 f0 = *(const float4*)p, f1 = *(const float4*)(p + 4);
    const float x[8] = {f0.x, f0.y, f0.z, f0.w, f1.x, f1.y, f1.z, f1.w};
#pragma unroll
    for (int j = 0; j < 8; ++j) { const short h = bfs(x[j]); hi8[j] = h; lo8[j] = bfs(x[j] - sbf2f(h)); }
}
__device__ __forceinline__ void route_task(int task, const float* QP, const LAS bf16* KHL, unsigned short* IDX, float* GATE, int lane) {
    const int r = lane & 31, hi = lane >> 5, t = 4 * task + (r >> 3), head = r & 7;
    float top[2][16];
#pragma unroll
    for (int half = 0; half < 2; ++half) {
        bf16x8 qh[4], ql[4];
        { const float* qp = QP + (size_t)t * D + head * 128 + half * 64 + 8 * hi; asm volatile("" : "+v"(qp));
#pragma unroll
          for (int ks = 0; ks < 4; ++ks) split8(qp + 16 * ks, qh[ks], ql[ks]); }
        float cur[16];
#pragma unroll
        for (int kt = 0; kt < 4; ++kt) {
            f32x16 X = zero16();
            const LAS bf16* khp = KHL + (half * 128 + 32 * kt + r) * 72 + 8 * hi;
#pragma unroll
            for (int ks = 0; ks < 4; ++ks) {
                const bf16x8 kh = lds8(khp + 16 * ks), kl = lds8(khp + 2 * 128 * 72 + 16 * ks);
                X = MFMA32(kh, qh[ks], X); X = MFMA32(kh, ql[ks], X); X = MFMA32(kl, qh[ks], X);
            }
            float grp[16];
#pragma unroll
            for (int i = 0; i < 16; ++i) { const unsigned key = (unsigned)(32 * kt + crow(i, hi)); grp[i] = __uint_as_float((__float_as_uint(X[i]) & ~127u) | (127u - key)); }
            sort16_desc(grp);
            if (kt == 0) {
#pragma unroll
                for (int i = 0; i < 16; ++i) cur[i] = grp[i];
            } else merge16_desc(cur, grp);
        }
        float oth[16];
#pragma unroll
        for (int i = 0; i < 16; ++i) oth[i] = __shfl_xor(cur[i], 32);
        merge16_desc(cur, oth);
#pragma unroll
        for (int i = 0; i < 16; ++i) top[half][i] = cur[i];
    }
    unsigned P1[4], P2[4];
#pragma unroll
    for (int q = 0; q < 4; ++q) { P1[q] = 0u; P2[q] = 0u;
#pragma unroll
        for (int s = 0; s < 4; ++s) { P1[q] |= (127u - (__float_as_uint(top[0][4 * q + s]) & 127u)) << (8 * s); P2[q] |= (127u - (__float_as_uint(top[1][4 * q + s]) & 127u)) << (8 * s); } }
#define CAND(a, b) __uint_as_float((__float_as_uint(top[0][a] + top[1][b]) & ~255u) | (255u - (unsigned)((a) * 16 + (b))))
    float bk[16];
    {
        float gk[16];
        gk[0] = CAND(0, 0);
        gk[1] = CAND(0, 1);
        gk[2] = CAND(0, 2);
        gk[3] = CAND(0, 3);
        gk[4] = CAND(0, 4);
        gk[5] = CAND(0, 5);
        gk[6] = CAND(0, 6);
        gk[7] = CAND(0, 7);
        gk[8] = CAND(0, 8);
        gk[9] = CAND(0, 9);
        gk[10] = CAND(0, 10);
        gk[11] = CAND(0, 11);
        gk[12] = CAND(0, 12);
        gk[13] = CAND(0, 13);
        gk[14] = CAND(0, 14);
        gk[15] = CAND(0, 15);
        sort16_desc(gk);
#pragma unroll
        for (int i = 0; i < 16; ++i) bk[i] = gk[i];
    }
    {
        float gk[16];
        gk[0] = CAND(1, 0);
        gk[1] = CAND(1, 1);
        gk[2] = CAND(1, 2);
        gk[3] = CAND(1, 3);
        gk[4] = CAND(1, 4);
        gk[5] = CAND(1, 5);
        gk[6] = CAND(1, 6);
        gk[7] = CAND(1, 7);
        gk[8] = CAND(2, 0);
        gk[9] = CAND(2, 1);
        gk[10] = CAND(2, 2);
        gk[11] = CAND(2, 3);
        gk[12] = CAND(2, 4);
        gk[13] = CAND(3, 0);
        gk[14] = CAND(3, 1);
        gk[15] = CAND(3, 2);
        sort16_desc(gk);
        merge16_desc(bk, gk);
    }
    {
        float gk[16];
        gk[0] = CAND(3, 3);
        gk[1] = CAND(4, 0);
        gk[2] = CAND(4, 1);
        gk[3] = CAND(4, 2);
        gk[4] = CAND(5, 0);
        gk[5] = CAND(5, 1);
        gk[6] = CAND(6, 0);
        gk[7] = CAND(6, 1);
        gk[8] = CAND(7, 0);
        gk[9] = CAND(7, 1);
        gk[10] = CAND(8, 0);
        gk[11] = CAND(9, 0);
        gk[12] = CAND(10, 0);
        gk[13] = CAND(11, 0);
        gk[14] = CAND(12, 0);
        gk[15] = CAND(13, 0);
        sort16_desc(gk);
        merge16_desc(bk, gk);
    }
    {
        float gk[16];
        gk[0] = CAND(14, 0);
        gk[1] = CAND(15, 0);
        gk[2] = -INFINITY;
        gk[3] = -INFINITY;
        gk[4] = -INFINITY;
        gk[5] = -INFINITY;
        gk[6] = -INFINITY;
        gk[7] = -INFINITY;
        gk[8] = -INFINITY;
        gk[9] = -INFINITY;
        gk[10] = -INFINITY;
        gk[11] = -INFINITY;
        gk[12] = -INFINITY;
        gk[13] = -INFINITY;
        gk[14] = -INFINITY;
        gk[15] = -INFINITY;
        sort16_desc(gk);
        merge16_desc(bk, gk);
    }
#undef CAND
    int bv[16];
#pragma unroll
    for (int i = 0; i < 16; ++i) {
        const unsigned cd = 255u - (__float_as_uint(bk[i]) & 255u), ca = cd >> 4, cb = cd & 15u;
        const unsigned wa = (ca >> 2) == 0u ? P1[0] : (ca >> 2) == 1u ? P1[1] : (ca >> 2) == 2u ? P1[2] : P1[3];
        const unsigned wb = (cb >> 2) == 0u ? P2[0] : (cb >> 2) == 1u ? P2[1] : (cb >> 2) == 2u ? P2[2] : P2[3];
        bv[i] = (int)((((wa >> (8u * (ca & 3u))) & 255u) << 7) | ((wb >> (8u * (cb & 3u))) & 255u));
    }
    float e[16], se = 0.f;
#pragma unroll
    for (int i = 0; i < 16; ++i) { e[i] = __expf(bk[i] - bk[0]); se += e[i]; }
    const float inv = 1.f / se;
    if (hi == 0) {
        uint4* ip = (uint4*)(IDX + (size_t)t * 128 + head * 16); float4* gp = (float4*)(GATE + (size_t)t * 128 + head * 16);
#pragma unroll
        for (int q = 0; q < 2; ++q) ip[q] = make_uint4((unsigned)bv[8 * q] | ((unsigned)bv[8 * q + 1] << 16), (unsigned)bv[8 * q + 2] | ((unsigned)bv[8 * q + 3] << 16), (unsigned)bv[8 * q + 4] | ((unsigned)bv[8 * q + 5] << 16), (unsigned)bv[8 * q + 6] | ((unsigned)bv[8 * q + 7] << 16));
#pragma unroll
        for (int q = 0; q < 4; ++q) gp[q] = make_float4(e[4 * q] * inv, e[4 * q + 1] * inv, e[4 * q + 2] * inv, e[4 * q + 3] * inv);
    }
}

#define XB_TMO      128
#define XB_XCNT(j)  (256  + 64 * (j))
#define XB_XSUB(j)  (1280 + 64 * (j))
#define XB_XGEN(j)  (2304 + 64 * (j))
#define XB_TOP      3328
#define XB_TOPGEN   3392
#define XCD_BAR_WORDS 3456
#define XB_SPIN_CAP (1u << 22)
__device__ __forceinline__ unsigned xb_ld(unsigned* p)              { return __hip_atomic_load(p, __ATOMIC_RELAXED, __HIP_MEMORY_SCOPE_AGENT); }
__device__ __forceinline__ unsigned xb_add(unsigned* p, unsigned v) { return __hip_atomic_fetch_add(p, v, __ATOMIC_RELAXED, __HIP_MEMORY_SCOPE_AGENT); }
__device__ __forceinline__ unsigned xb_xcc_id() { return (unsigned)__builtin_amdgcn_s_getreg((3 << 11) | 20) & 0xFu; }
#define XB_SPIN(cond, bar) do { unsigned _sp = 0; while (cond) { __builtin_amdgcn_s_sleep(1); \
    if ((++_sp & 255u) == 0u) { if (xb_ld(&(bar)[XB_TMO])) break; if (_sp > XB_SPIN_CAP) { atomicAdd(&(bar)[XB_TMO], 1u); break; } } } } while (0)
struct XcdBarrier { unsigned* bar; unsigned x; volatile LAS unsigned* st; };
__device__ __forceinline__ XcdBarrier xcd_barrier_post(unsigned* bar, volatile LAS unsigned* st) {
    XcdBarrier b; b.bar = bar; b.x = xb_xcc_id(); b.st = st;
    if (threadIdx.x == 0) (void)xb_add(&bar[XB_XCNT(b.x)], 1u);
    return b;
}
__device__ __forceinline__ void xcd_barrier_complete(unsigned* bar, unsigned x, unsigned& nloc, unsigned& nx) {
    const unsigned G = gridDim.x * gridDim.y * gridDim.z;
    unsigned sum, cnt, mine, sp = 0u;
    for (;;) {
        sum = 0u; cnt = 0u; mine = 0u;
#pragma unroll
        for (unsigned j = 0; j < 16; ++j) { const unsigned c = xb_ld(&bar[XB_XCNT(j)]); sum += c; cnt += (c > 0u) ? 1u : 0u; mine = (j == x) ? c : mine; }
        if (sum == G) break;
        __builtin_amdgcn_s_sleep(1);
        if ((++sp & 255u) == 0u) { if (xb_ld(&bar[XB_TMO])) break; if (sp > XB_SPIN_CAP) { atomicAdd(&bar[XB_TMO], 1u); break; } }
    }
    nloc = mine > 0u ? mine : 1u; nx = cnt > 0u ? cnt : 1u;
}
__device__ __forceinline__ void xcd_barrier(const XcdBarrier& b) {
    asm volatile("s_waitcnt vmcnt(0)" ::: "memory");
    __syncthreads();
    if (threadIdx.x == 0) {
        unsigned* bar = b.bar;
        __builtin_amdgcn_s_waitcnt(0);
        unsigned nloc = b.st[0], nx = b.st[1];
        if (nloc == 0u) { xcd_barrier_complete(bar, b.x, nloc, nx); b.st[0] = nloc; b.st[1] = nx; }
        const unsigned old = xb_add(&bar[XB_XSUB(b.x)], 1u);
        const unsigned gen = old / nloc;
        if (old + 1u == (gen + 1u) * nloc) {
            __builtin_amdgcn_fence(__ATOMIC_RELEASE, "agent");
            asm volatile("s_waitcnt vmcnt(0)" ::: "memory");
            const unsigned og = xb_add(&bar[XB_TOP], 1u);
            const unsigned tg = og / nx;
            if (og + 1u == (tg + 1u) * nx) xb_add(&bar[XB_TOPGEN], 1u);
            else XB_SPIN(xb_ld(&bar[XB_TOPGEN]) == tg, bar);
            __builtin_amdgcn_fence(__ATOMIC_ACQUIRE, "agent");
            xb_add(&bar[XB_XGEN(b.x)], 1u);
            asm volatile("s_waitcnt vmcnt(0)" ::: "memory");
        } else {
            XB_SPIN(xb_ld(&bar[XB_XGEN(b.x)]) == gen, bar);
            __builtin_amdgcn_fence(__ATOMIC_ACQUIRE, "agent");
            asm volatile("s_waitcnt vmcnt(0)" ::: "memory");
        }
    }
    __syncthreads();
}
constexpr int LDS_BYTES = 147456;
constexpr int MISC_OFF = 131072 + 320;

__global__ void __launch_bounds__(NTHR, 2) k_main(Args a) {
    extern __shared__ __attribute__((aligned(16))) unsigned char lds_raw[];
    LAS unsigned char* ldsb = (LAS unsigned char*)lds_raw;
    const int tid0 = threadIdx.x, bid = blockIdx.x, nb = gridDim.x;
    const int wave = __builtin_amdgcn_readfirstlane(tid0 >> 6);
    const int gthreads = nb * NTHR, nwaves = gthreads >> 6;
#define PHASE_VARS() int tid = tid0; asm volatile("" : "+v"(tid)); const int lane = tid & 63, gtid = bid * NTHR + tid, gwave = gtid >> 6; (void)lane; (void)gtid; (void)gwave
    unsigned char* ws = a.ws;
    bf16* WINT = (bf16*)(ws + WS_WIN); bf16* WOT = (bf16*)(ws + WS_WO); bf16* WQT = (bf16*)(ws + WS_WQ);
    bf16* PROJ = (bf16*)(ws + WS_PROJ);
    bf16* XNB = (bf16*)(ws + WS_XNB);
    bf16* XACT = (bf16*)(ws + WS_XACT);
    float* DTRAW = (float*)(ws + WS_DTRAW); float* DT = (float*)(ws + WS_DT); float* ACS = (float*)(ws + WS_ACS); float* CDEC = (float*)(ws + WS_CDEC);
    float* STATES = (float*)(ws + WS_STATES); bf16* PREVT = (bf16*)(ws + WS_PREV);
    float* QP = (float*)(ws + WS_QP); unsigned short* IDX = (unsigned short*)(ws + WS_IDX); float* GATE = (float*)(ws + WS_GATE);
    float* TOPV = (float*)(ws + WS_TOPV); int* TOPI = (int*)(ws + WS_TOPI);
    unsigned char* U8 = ws + WS_U8; unsigned char* V8 = ws + WS_V8; float* SU = (float*)(ws + WS_SU); float* SV = SU + 16384; bf16* PART = (bf16*)(ws + WS_PART); unsigned char* XQ = ws + WS_XQ; float* XS = (float*)(ws + WS_XS);
    bf16* KH = (bf16*)(ws + WS_KH); bf16* KL = (bf16*)(ws + WS_KH + 65536);
    bf16* HB = (bf16*)(ws + WS_STATES);
    float* MIXF = a.out;
    volatile LAS unsigned* MISC = (volatile LAS unsigned*)(ldsb + MISC_OFF);
    if (tid0 < 32) MISC[tid0] = 0u;
    __syncthreads();
    XcdBarrier bar = xcd_barrier_post((unsigned*)ws, MISC + 8);
#define IN(k) (a.ph_lo <= (k) && (k) < a.ph_hi)
#if defined(PROBE_LO)
    int seg_ = 0; unsigned long long tseg_ = __builtin_amdgcn_s_memrealtime();
#define PROBE_SPIN() do { if (seg_ >= PROBE_LO && seg_ <= PROBE_HI) { const unsigned long long d_ = (__builtin_amdgcn_s_memrealtime() - tseg_) * PROBE_AMP; const unsigned long long s_ = __builtin_amdgcn_s_memrealtime(); \
        while (__builtin_amdgcn_s_memrealtime() - s_ < d_) __builtin_amdgcn_s_sleep(4); } } while (0)
#define GRID_BAR() do { PROBE_SPIN(); xcd_barrier(bar); tseg_ = __builtin_amdgcn_s_memrealtime(); ++seg_; } while (0)
#else
#define PROBE_SPIN() do { } while (0)
#define GRID_BAR() xcd_barrier(bar)
#endif

    if (IN(0)) {
        PHASE_VARS();
        LAS float* scr = (LAS float*)(ldsb + wave * 16384);
        constexpr int I_IN = 16 * 72, I_O = 16 * 32, NITEMS = I_IN + 2 * I_O;
        for (int it = gwave; it < NITEMS; it += nwaves) {
            int r = it;
            if (r < I_IN) { transpose_item(a.w_in, PW, D, WINT, scr, r / 72, r % 72, lane); continue; } r -= I_IN;
            if (r < I_O) { transpose_item(a.w_out, D, D, WOT, scr, r / 32, r % 32, lane); continue; } r -= I_O;
            transpose_item(a.peer_wq, D, D, WQT, scr, r / 32, r % 32, lane);
        }
        for (int i = gtid; i < 2 * 128 * 64; i += gthreads) { const float kf = a.peer_sub_keys[i]; const short h = bfs(kf); KH[i] = (bf16)h; KL[i] = (bf16)bfs(kf - sbf2f(h)); }
        for (int i = tid; i < 8 * 1024; i += NTHR) { const int h = i & 7, c = i >> 3; *(LAS float*)(ldsb + h * 16384 + 8448 + c * 4) = a.w_in[(size_t)c * PW + ODT + h]; }
        __syncthreads();
        rmsnorm_rows_bf16<1>(a.x, a.norm_mix_g, XNB, ldsb, DTRAW, nullptr, nullptr, gwave, nwaves, lane);
    }
    GRID_BAR();
    if (IN(1)) {
        PHASE_VARS();
        pg8::Gemm g{XNB, WINT, T, PS, D}; pg8::StaticOrder S; S.init(T, PS, nb, bid);
        pg8::EpiBf16Plain E{PROJ, PS};
        pg8::gemm_phase<pg8::EpiBf16Plain, pg8::StaticOrder>(ldsb, g, S, E, nullptr);
        const int cfirst = (nb == 256) ? 64 : 0;
        if (bid >= cfirst) for (int rr0 = ((bid - cfirst) * 8 + wave) * 4; rr0 < 2 * 16384; rr0 += (nb - cfirst) * 8 * 4) {
            float4 v[4][4];
#pragma unroll
            for (int q = 0; q < 4; ++q) { const int rr = rr0 + q, which = rr >> 14, row = rr & 16383;
                const float4* src4 = (const float4*)((which ? a.peer_v : a.peer_u) + (size_t)row * D) + lane;
#pragma unroll
                for (int jq = 0; jq < 4; ++jq) v[q][jq] = src4[64 * jq]; }
#pragma unroll
            for (int q = 0; q < 4; ++q) { const int rr = rr0 + q, which = rr >> 14, row = rr & 16383;
                float mx = 0.f;
#pragma unroll
                for (int jq = 0; jq < 4; ++jq) mx = fmaxf(mx, fmaxf(fmaxf(fabsf(v[q][jq].x), fabsf(v[q][jq].y)), fmaxf(fabsf(v[q][jq].z), fabsf(v[q][jq].w))));
#pragma unroll
                for (int o = 1; o < 64; o <<= 1) mx = fmaxf(mx, __shfl_xor(mx, o));
                const float sc = mx > 0.f ? mx * (1.f / 127.f) : 1.f, inv = 1.f / sc;
                unsigned* dst = (unsigned*)((which ? V8 : U8) + (size_t)row * D) + lane;
#pragma unroll
                for (int jq = 0; jq < 4; ++jq) { const int q0 = (int)rintf(v[q][jq].x * inv), q1 = (int)rintf(v[q][jq].y * inv), q2 = (int)rintf(v[q][jq].z * inv), q3 = (int)rintf(v[q][jq].w * inv);
                    dst[64 * jq] = (unsigned)(q0 & 255) | ((unsigned)(q1 & 255) << 8) | ((unsigned)(q2 & 255) << 16) | ((unsigned)(q3 & 255) << 24); }
                if (lane == 0) (which ? SV : SU)[row] = sc; }
        }
    }
    GRID_BAR();
    if (IN(3)) {
        PHASE_VARS();
        for (int u = bid; u < 512; u += nb) {
            if (u < 256) attn_unit(a.attn_sinks, a.attn_out_g, ldsb, u, PROJ, XNB, tid, lane, wave);
            else ssd_chunk_unit(ldsb, u - 256, PROJ, XACT, DTRAW, a.conv_w, a.conv_b, a.dt_bias, a.a_log, ACS, CDEC, MIXF, STATES, tid, lane, wave);
        }
    }
    GRID_BAR();
    if (IN(5)) {
        PHASE_VARS();
        for (int idx = gtid; idx < 2 * 8 * 8192; idx += gthreads) {
            const int pn = idx & 8191, h = (idx >> 13) & 7, b = idx >> 16;
            float run = 0.f;
#pragma unroll 1
            for (int c0 = 0; c0 < 64; c0 += 8) {
                float st[8], dc[8];
#pragma unroll
                for (int j = 0; j < 8; ++j) { const int bch = (b * 64 + c0 + j) * 8 + h; st[j] = STATES[(size_t)bch * 8192 + pn]; dc[j] = CDEC[bch]; }
#pragma unroll
                for (int j = 0; j < 8; ++j) { const int bch = (b * 64 + c0 + j) * 8 + h; PREVT[(size_t)bch * 8192 + pn] = f2bf(run); run = dc[j] * run + st[j]; }
            }
        }
    }
    GRID_BAR();
    if (IN(6)) {
        PHASE_VARS();
        for (int u = bid; u < 256; u += nb) yoff_unit(a.d_skip, a.ssm_norm_g, ldsb, u, XACT, PROJ, ACS, PREVT, MIXF, XNB, lane, wave);
    }
    GRID_BAR();
    if (IN(7)) {
        PHASE_VARS();
        pg8::Gemm g{XNB, WOT, T, D, D}; pg8::StaticOrder S; S.init(T, D, nb, bid);
        pg8::EpiBf16Resid E{HB, a.x, D};
        pg8::gemm_phase<pg8::EpiBf16Resid, pg8::StaticOrder>(ldsb, g, S, E, nullptr);
    }
    GRID_BAR();
    if (IN(8)) {
        PHASE_VARS();
        rmsnorm_rows_bf16<2>((const float*)HB, a.norm_ffn_g, XNB, ldsb, nullptr, XQ, XS, gwave, nwaves, lane);
    }
    GRID_BAR();
    if (IN(9)) {
        PHASE_VARS();
        pg8::Gemm g{XNB, WQT, T, D, D}; pg8::StaticOrder S; S.init(T, D, nb, bid);
        pg8::EpiF32Resid E{QP, nullptr, D};
        pg8::gemm_phase<pg8::EpiF32Resid, pg8::StaticOrder>(ldsb, g, S, E, nullptr);
    }
    GRID_BAR();
    if (IN(10)) {
        PHASE_VARS();
        LAS bf16* KHL = (LAS bf16*)ldsb;
        for (int i = tid; i < 2 * 2 * 128 * 8; i += NTHR) {
            const int pc = i & 7, key = (i >> 3) & 127, hf = (i >> 10) & 1, hl = i >> 11;
            *(LAS v4u*)(KHL + ((hl * 2 + hf) * 128 + key) * 72 + pc * 8) = *(const v4u*)((hl ? KL : KH) + (size_t)(hf * 128 + key) * 64 + pc * 8);
        }
        __syncthreads();
        for (int task = gwave; task < T / 4; task += nwaves) route_task(task, QP, KHL, IDX, GATE, lane);
        __syncthreads();
    }
    GRID_BAR();
    unsigned char* ACTQ = ws + WS_ACT; float* ACTS = (float*)(ws + WS_ACT + 4 * MiB); bf16* PEERO = (bf16*)(ws + WS_PEERO);
    unsigned* ctl = (unsigned*)ws;

    if (IN(12)) {
        PHASE_VARS();
        LAS unsigned short* EL = (LAS unsigned short*)ldsb;
#pragma unroll 1
        for (int j = bid; j < NCHUNK; j += nb) {
            __syncthreads();
            for (int i = tid; i < 64 * 16; i += NTHR) *(LAS v4u*)(EL + i * 8) = *(const v4u*)(IDX + (size_t)j * 64 * 128 + i * 8);
            __syncthreads();
#pragma unroll 1
            for (int p = 0; p < NPART; ++p)
                peer_u_item(p, j, EL, XQ, U8, PART, lane, wave);
        }
    }
    GRID_BAR();
    if (IN(12)) {
        PHASE_VARS();
        for (int t0 = gwave; t0 < T; t0 += 2 * nwaves) {
            float av[2][2]; float mx[2];
#pragma unroll
            for (int q = 0; q < 2; ++q) {
                const int t = (t0 + q * nwaves < T) ? t0 + q * nwaves : t0;
                const float xs = XS[t];
#pragma unroll
                for (int hh = 0; hh < 2; ++hh) {
                    const int i = t * 128 + hh * 64 + lane;
                    float sf = 0.f;
#pragma unroll
                    for (int pp = 0; pp < NPART; ++pp) sf += bf2f(PART[(size_t)pp * T * 128 + i]);
                    const int e = IDX[i]; const float z = sf * SU[e] * xs;
                    av[q][hh] = GATE[i] * 0.5f * z * (1.f + erff(z * 0.70710678118654752f)) * SV[e];
                }
                mx[q] = fmaxf(fabsf(av[q][0]), fabsf(av[q][1]));
            }
#pragma unroll
            for (int o = 1; o < 64; o <<= 1) { mx[0] = fmaxf(mx[0], __shfl_xor(mx[0], o)); mx[1] = fmaxf(mx[1], __shfl_xor(mx[1], o)); }
#pragma unroll
            for (int q = 0; q < 2; ++q) {
                const int t = t0 + q * nwaves; if (t >= T) break;
                const float sc = mx[q] > 0.f ? mx[q] * (1.f / 127.f) : 1.f, inv = 1.f / sc;
                ACTQ[(size_t)t * 128 + lane] = (unsigned char)((int)rintf(av[q][0] * inv) & 255); ACTQ[(size_t)t * 128 + 64 + lane] = (unsigned char)((int)rintf(av[q][1] * inv) & 255);
                if (lane == 0) ACTS[t] = sc;
            }
        }
    }
    GRID_BAR();
    if (IN(13)) {
        PHASE_VARS();
        LAS unsigned short* EL = (LAS unsigned short*)ldsb; LAS unsigned char* AL = (LAS unsigned char*)(ldsb + 16384);
#pragma unroll 1
        for (int j = bid; j < NCHUNK; j += nb) {
            __syncthreads();
            for (int i = tid; i < 64 * 16; i += NTHR) *(LAS v4u*)(EL + i * 8) = *(const v4u*)(IDX + (size_t)j * 64 * 128 + i * 8);
            { const int i = tid; *(LAS v4u*)(AL + i * 16) = *(const v4u*)(ACTQ + (size_t)j * 64 * 128 + i * 16); }
            __syncthreads();
#pragma unroll 1
            for (int p = 0; p < NPART; ++p) peer_v_item(p, j, EL, AL, ACTS, V8, PEERO, lane, wave);
        }
    }
    GRID_BAR();
    if (IN(14)) {
        PHASE_VARS();
        for (int t = gwave; t < T; t += nwaves) {
            const uint2* hr = (const uint2*)(HB + (size_t)t * D) + lane; const uint2* pr = (const uint2*)(PEERO + (size_t)t * D) + lane;
            float4 v[4]; float ss = 0.f;
#pragma unroll
            for (int jq = 0; jq < 4; ++jq) { const uint2 hw = hr[64 * jq]; const float4 h4 = make_float4(__uint_as_float(hw.x << 16), __uint_as_float(hw.x & 0xffff0000u), __uint_as_float(hw.y << 16), __uint_as_float(hw.y & 0xffff0000u)); const uint2 pw = pr[64 * jq]; v[jq] = make_float4(h4.x + __uint_as_float(pw.x << 16), h4.y + __uint_as_float(pw.x & 0xffff0000u), h4.z + __uint_as_float(pw.y << 16), h4.w + __uint_as_float(pw.y & 0xffff0000u)); ss += v[jq].x * v[jq].x + v[jq].y * v[jq].y + v[jq].z * v[jq].z + v[jq].w * v[jq].w; }
            ss = wave_sum(ss);
            const float r3 = rsqrtf(ss * (1.f / D) + EPS);
            float4* op = (float4*)(a.out + (size_t)t * D) + lane;
#pragma unroll
            for (int jq = 0; jq < 4; ++jq) { const float4 gv = ((const float4*)a.final_norm_g)[lane + 64 * jq]; op[64 * jq] = make_float4(v[jq].x * r3 * gv.x, v[jq].y * r3 * gv.y, v[jq].z * r3 * gv.z, v[jq].w * r3 * gv.w); }
        }
    }
    PROBE_SPIN();
#undef IN
}
}

extern "C" void kernel_launch(void* const* d_in, const int* in_sizes, int n_in, void* d_out, int out_size, void* d_ws, size_t ws_size, hipStream_t stream) {
    if (n_in != 18 || out_size != T * D || ws_size < WS_END) { fprintf(stderr, "kernel_launch: unexpected shapes n_in=%d out=%d ws=%zu\n", n_in, out_size, ws_size); return; }
    Args a{};
    const float** ap = (const float**)&a;
    for (int i = 0; i < 18; ++i) ap[i] = (const float*)d_in[i];
    a.out = (float*)d_out; a.ws = (unsigned char*)d_ws;
    static int grid = 0;
    if (grid == 0) {
        int dev = 0, cus = 0, per_cu = 0;
        if (hipGetDevice(&dev) != hipSuccess || hipDeviceGetAttribute(&cus, hipDeviceAttributeMultiprocessorCount, dev) != hipSuccess) { fprintf(stderr, "kernel_launch: device query failed\n"); grid = -1; return; }
        if (hipFuncSetAttribute((const void*)k_main, hipFuncAttributeMaxDynamicSharedMemorySize, LDS_BYTES) != hipSuccess) { fprintf(stderr, "kernel_launch: hipFuncSetAttribute failed\n"); grid = -1; return; }
        if (hipOccupancyMaxActiveBlocksPerMultiprocessor(&per_cu, (const void*)k_main, NTHR, LDS_BYTES) != hipSuccess || per_cu < 1) { fprintf(stderr, "kernel_launch: occupancy query says %d blocks/CU\n", per_cu); (void)hipGetLastError(); grid = -1; return; }
        grid = cus;
    }
    if (grid < 0) return;
    if (hipMemsetAsync(d_ws, 0, 65536, stream) != hipSuccess) { fprintf(stderr, "kernel_launch: memset failed\n"); return; }
    a.ph_lo = 0; a.ph_hi = 15;
    hipLaunchKernelGGL(k_main, dim3(grid), dim3(NTHR), LDS_BYTES, stream, a);
}
```

```cpp
#include <hip/hip_runtime.h>
#include <cstdio>
#include <cstdint>


namespace pg8 {
#define PG8_LAS __attribute__((address_space(3)))
typedef unsigned short bf16_t;
typedef short bf16x8 __attribute__((ext_vector_type(8)));
typedef float f32x4 __attribute__((ext_vector_type(4)));
typedef unsigned u32x4 __attribute__((ext_vector_type(4)));
constexpr int BM = 256, BK = 64, HALF = 128, HTB = HALF * BK * 2  , STAGE_BYTES = 8 * HTB, NXCD = 8, WGM = 8;

__host__ __device__ __forceinline__ int lds_byte(int r, int c) { const int st = (r >> 4) * 2 + (c >> 5), rr = r & 15, cc = c & 31, ob = rr * 64 + cc * 2; return st * 1024 + (ob ^ (((ob >> 9) & 1) << 5)); }
__host__ __device__ __forceinline__ void stage_rc(int b, int& R, int& C) { const int st = b / 1024, sb = b % 1024, swz = sb ^ (((sb >> 9) & 1) << 5); R = (st >> 1) * 16 + swz / 64; C = (st & 1) * 32 + (swz % 64) / 2; }
__host__ __device__ __forceinline__ int perm32(int rho) { const int n = rho >> 4, i = rho & 15; return 8 * (i >> 2) + 4 * n + (i & 3); }

struct Unit { int pm, pn; };
struct Gemm { const bf16_t* A; const bf16_t* Bt; int M, N, K; };

struct StaticOrder {
    int nM, nN, nwg, G, c;
    __host__ __device__ void init(int M, int N, int G_, int c_) { nM = M / BM; nN = N / BM; nwg = nM * nN; G = G_; c = c_; }
    __host__ __device__ bool next(int i, Unit& u) const {
        const long L = (long)i * G + c; if (L >= nwg) return false;
        int wgid = (int)L; { const int q = nwg / NXCD, r = nwg % NXCD, xcd = wgid % NXCD, off = wgid / NXCD; wgid = (xcd < r ? xcd * (q + 1) : r * (q + 1) + (xcd - r) * q) + off; }
        const int nig = WGM * nN, gid = wgid / nig, fm = gid * WGM, gsz = (nM - fm) < WGM ? (nM - fm) : WGM;
        u.pm = fm + ((wgid % nig) % gsz); u.pn = (wgid % nig) / gsz; return true;
    }
    __device__ __forceinline__ void a_ready(const Unit&) const {}
    __device__ __forceinline__ void done(const Unit&) const {}
};
__device__ __forceinline__ unsigned cvt_pk_bf16(float lo, float hi) { unsigned r; asm volatile("v_cvt_pk_bf16_f32 %0, %1, %2" : "=v"(r) : "v"(lo), "v"(hi)); return r; }
typedef float f32x2 __attribute__((ext_vector_type(2)));
struct EpiBf16Plain {
    static constexpr bool PERM = true, AFTER_DRAIN = false;
    bf16_t* O; int ldc;
    __device__ __forceinline__ void operator()(const f32x4 (&acc)[2][2][4][2], const Unit& u, int wr, int wc, int fr, int fq) const {
        const int row0 = u.pm * BM + wr * 64 + fr, col0 = u.pn * BM + wc * 32 + 8 * fq;
#pragma unroll
        for (int ai = 0; ai < 2; ++ai)
#pragma unroll
            for (int m = 0; m < 4; ++m) { bf16_t* rowp = O + (size_t)(row0 + ai * HALF + m * 16) * ldc + col0;
#pragma unroll
                for (int bj = 0; bj < 2; ++bj) { const f32x4 v0 = acc[ai][bj][m][0], v1 = acc[ai][bj][m][1];
                    u32x4 w; w.x = cvt_pk_bf16(v0[0], v0[1]); w.y = cvt_pk_bf16(v0[2], v0[3]); w.z = cvt_pk_bf16(v1[0], v1[1]); w.w = cvt_pk_bf16(v1[2], v1[3]);
                    *(u32x4*)(rowp + bj * HALF) = w; } }
    }
};
struct EpiF32Resid {
    static constexpr bool PERM = false, AFTER_DRAIN = false;
    float* C; const float* R; int ldc;
    __device__ __forceinline__ void operator()(const f32x4 (&acc)[2][2][4][2], const Unit& u, int wr, int wc, int fr, int fq) const {
        const int row0 = u.pm * BM + wr * 64 + fr, col0 = u.pn * BM + wc * 32 + 4 * fq;
#pragma unroll
        for (int ai = 0; ai < 2; ++ai)
#pragma unroll
            for (int m = 0; m < 4; ++m) { const size_t off = (size_t)(row0 + ai * HALF + m * 16) * ldc + col0;
#pragma unroll
                for (int bj = 0; bj < 2; ++bj)
#pragma unroll
                    for (int n = 0; n < 2; ++n) { f32x4 v = acc[ai][bj][m][n]; if (R) v += *(const f32x4*)(R + off + bj * HALF + n * 16); *(f32x4*)(C + off + bj * HALF + n * 16) = v; }
                asm volatile("" ::: "memory"); }
    }
};

struct EpiBf16Resid {
    static constexpr bool PERM = true, AFTER_DRAIN = false;
    bf16_t* O; const float* R; int ldc;
    __device__ __forceinline__ void operator()(const f32x4 (&acc)[2][2][4][2], const Unit& u, int wr, int wc, int fr, int fq) const {
        const int row0 = u.pm * BM + wr * 64 + fr, col0 = u.pn * BM + wc * 32 + 8 * fq;
#pragma unroll
        for (int ai = 0; ai < 2; ++ai)
#pragma unroll
            for (int m = 0; m < 4; ++m) { const size_t off = (size_t)(row0 + ai * HALF + m * 16) * ldc + col0;
#pragma unroll
                for (int bj = 0; bj < 2; ++bj) { const f32x4 v0 = acc[ai][bj][m][0] + *(const f32x4*)(R + off + bj * HALF), v1 = acc[ai][bj][m][1] + *(const f32x4*)(R + off + bj * HALF + 4);
                    u32x4 w; w.x = cvt_pk_bf16(v0[0], v0[1]); w.y = cvt_pk_bf16(v0[2], v0[3]); w.z = cvt_pk_bf16(v1[0], v1[1]); w.w = cvt_pk_bf16(v1[2], v1[3]);
                    *(u32x4*)(O + off + bj * HALF) = w; }
                asm volatile("" ::: "memory"); }
    }
};
template <class Epi, class Sched, bool STAMP = false>
__device__ __forceinline__ void gemm_phase(PG8_LAS unsigned char* lds, const Gemm g, const Sched& S, const Epi& E, unsigned long long* stamps) {
    const int tid = threadIdx.x, wid = __builtin_amdgcn_readfirstlane(tid >> 6), lane = tid & 63, wr = wid >> 2, wc = wid & 3, fr = lane & 15, fq = lane >> 4;
    const int K = g.K, nt = K / BK;
    int ts_lo = 0, ts_hi = 0, nts = 0; const unsigned long long rt_entry = STAMP ? (unsigned long long)0ull : 0ull;
#define PG8_STAMP() do { if (STAMP && wid == 0 && nts < 64) { const unsigned long long _c = (unsigned long long)clock64(); \
        ts_lo = (lane == nts) ? (int)(unsigned)_c : ts_lo; ts_hi = (lane == nts) ? (int)(unsigned)(_c >> 32) : ts_hi; ++nts; } } while (0)
    PG8_STAMP();
    unsigned voffA[2], voffB[2];
#pragma unroll
    for (int i = 0; i < 2; ++i) { int R, C; stage_rc(tid * 16 + i * 8192, R, C); const int Rb = Epi::PERM ? ((R & ~31) + perm32(R & 31)) : R;
        voffA[i] = (unsigned)(R * K + C) * 2u; voffB[i] = (unsigned)(Rb * K + C) * 2u; }
    const size_t kstep = (size_t)(BK * 2);
    const size_t hstep = (size_t)HALF * K * 2;
    const size_t tstep = 2 * hstep;
    const unsigned ldsw = (unsigned)wid * 1024u;
    const int aoff = lds_byte(wr * 64 + fr, fq * 8), boff = lds_byte(wc * 32 + fr, fq * 8);
#define PG8_SA(b, h) (((b) * 2 + (h)) * HTB)
#define PG8_SB(b, h) ((4 + (b) * 2 + (h)) * HTB)
#define PG8_STAGE(bufoff, gbase, voff) do { _Pragma("unroll") for (int _i = 0; _i < 2; ++_i) \
        __builtin_amdgcn_global_load_lds((const unsigned*)((const char*)(gbase) + (voff)[_i]), (PG8_LAS unsigned*)(lds + (bufoff) + ldsw + _i * 8192), 16, 0, 0); } while (0)
#define PG8_LDA(dst, b, h) do { _Pragma("unroll") for (int m = 0; m < 4; ++m) _Pragma("unroll") for (int k = 0; k < 2; ++k) dst[m][k] = *(const PG8_LAS bf16x8*)(lds + PG8_SA(b, h) + aoff + m * 2048 + k * 1024); } while (0)
#define PG8_LDB(dst, b, h) do { _Pragma("unroll") for (int n = 0; n < 2; ++n) _Pragma("unroll") for (int k = 0; k < 2; ++k) dst[n][k] = *(const PG8_LAS bf16x8*)(lds + PG8_SB(b, h) + boff + n * 2048 + k * 1024); } while (0)
#define PG8_MMA(ai, bj, At, Bt) do { __builtin_amdgcn_s_setprio(1); _Pragma("unroll") for (int m = 0; m < 4; ++m) _Pragma("unroll") for (int n = 0; n < 2; ++n) _Pragma("unroll") for (int k = 0; k < 2; ++k) \
        acc[ai][bj][m][n] = __builtin_amdgcn_mfma_f32_16x16x32_bf16(Bt[n][k], At[m][k], acc[ai][bj][m][n], 0, 0, 0); __builtin_amdgcn_s_setprio(0); } while (0)
#define PG8_WAIT_V(n) asm volatile("s_waitcnt vmcnt(" #n ")" ::: "memory")
#define PG8_WAIT_L(n) asm volatile("s_waitcnt lgkmcnt(" #n ")" ::: "memory")
#define PG8_BAR __builtin_amdgcn_s_barrier()
#define PG8_SCHED __builtin_amdgcn_sched_barrier(0)
    Unit cur, nxt; int ui = 0;
    if (!S.next(0, cur)) return;
    f32x4 acc[2][2][4][2];
#pragma unroll
    for (int a = 0; a < 2; ++a)
#pragma unroll
        for (int b = 0; b < 2; ++b)
#pragma unroll
            for (int m = 0; m < 4; ++m)
#pragma unroll
                for (int n = 0; n < 2; ++n) acc[a][b][m][n] = (f32x4){0.f, 0.f, 0.f, 0.f};
    bf16x8 At[4][2], B0[2][2], B1[2][2];
    const char* cA = (const char*)g.A + (size_t)cur.pm * tstep; const char* cB = (const char*)g.Bt + (size_t)cur.pn * tstep;
    S.a_ready(cur);
    PG8_STAGE(PG8_SB(0, 0), cB, voffB); PG8_STAGE(PG8_SA(0, 0), cA, voffA); PG8_STAGE(PG8_SB(0, 1), cB + hstep, voffB); PG8_STAGE(PG8_SA(0, 1), cA + hstep, voffA);
    if (wr == 1) PG8_BAR;
    PG8_WAIT_V(4); PG8_BAR;
    PG8_STAGE(PG8_SB(1, 0), cB + kstep, voffB); PG8_STAGE(PG8_SA(1, 0), cA + kstep, voffA); PG8_STAGE(PG8_SB(1, 1), cB + hstep + kstep, voffB);
    PG8_WAIT_V(6); PG8_BAR;
    PG8_STAMP();
    for (;;) {
        const bool has_next = S.next(ui + 1, nxt);
        const char* nA = has_next ? (const char*)g.A + (size_t)nxt.pm * tstep : cA; const char* nB = has_next ? (const char*)g.Bt + (size_t)nxt.pn * tstep : cB;
        for (int t = 0; t < nt; t += 2) {
            const bool last = (t == nt - 2);
            const char* a1 = cA + (size_t)(t + 1) * kstep;
            const char* a2 = last ? nA : cA + (size_t)(t + 2) * kstep; const char* b2 = last ? nB : cB + (size_t)(t + 2) * kstep;
            const char* a3 = a2 + kstep; const char* b3 = b2 + kstep;
            if (last && has_next) S.a_ready(nxt);
            PG8_LDB(B0, 0, 0); PG8_SCHED; PG8_LDA(At, 0, 0); PG8_STAGE(PG8_SA(1, 1), a1 + hstep, voffA);
            PG8_WAIT_L(8); PG8_BAR; PG8_WAIT_L(0); PG8_MMA(0, 0, At, B0); PG8_BAR; PG8_SCHED;
            PG8_LDB(B1, 0, 1); PG8_STAGE(PG8_SB(0, 0), b2, voffB);
            PG8_BAR; PG8_WAIT_L(0); PG8_MMA(0, 1, At, B1); PG8_BAR;
            PG8_LDA(At, 0, 1); PG8_STAGE(PG8_SA(0, 0), a2, voffA);
            PG8_BAR; PG8_WAIT_L(0); PG8_MMA(1, 0, At, B0); PG8_BAR; PG8_SCHED;
            PG8_STAGE(PG8_SB(0, 1), b2 + hstep, voffB);
            PG8_WAIT_V(6); PG8_BAR; PG8_MMA(1, 1, At, B1); PG8_BAR;
            PG8_LDB(B0, 1, 0); PG8_SCHED; PG8_LDA(At, 1, 0); PG8_STAGE(PG8_SA(0, 1), a2 + hstep, voffA);
            PG8_WAIT_L(8); PG8_BAR; PG8_WAIT_L(0); PG8_MMA(0, 0, At, B0); PG8_BAR; PG8_SCHED;
            PG8_LDB(B1, 1, 1); PG8_STAGE(PG8_SB(1, 0), b3, voffB);
            PG8_BAR; PG8_WAIT_L(0); PG8_MMA(0, 1, At, B1); PG8_BAR;
            PG8_LDA(At, 1, 1); PG8_STAGE(PG8_SA(1, 0), a3, voffA);
            PG8_BAR; PG8_WAIT_L(0); PG8_MMA(1, 0, At, B0); PG8_BAR; PG8_SCHED;
            PG8_STAGE(PG8_SB(1, 1), b3 + hstep, voffB);
            PG8_WAIT_V(6); PG8_BAR; PG8_MMA(1, 1, At, B1); PG8_BAR;
        }
        PG8_STAMP();
        if constexpr (!Epi::AFTER_DRAIN) { E(acc, cur, wr, wc, fr, fq); S.done(cur); }
        PG8_STAMP();
        if (!has_next) break;
#pragma unroll
        for (int a = 0; a < 2; ++a)
#pragma unroll
            for (int b = 0; b < 2; ++b)
#pragma unroll
                for (int m = 0; m < 4; ++m)
#pragma unroll
                    for (int n = 0; n < 2; ++n) acc[a][b][m][n] = (f32x4){0.f, 0.f, 0.f, 0.f};
        cur = nxt; cA = nA; cB = nB; ++ui;
    }
    PG8_WAIT_V(0);
    if (wr == 0) PG8_BAR;
    PG8_BAR;
    if constexpr (Epi::AFTER_DRAIN) { E.fused(acc, cur, wr, wc, fr, fq, lds, wid, lane); S.done(cur); }
    PG8_STAMP();
    if (STAMP && wid == 0) { stamps[lane] = lane < nts ? (((unsigned long long)(unsigned)ts_hi << 32) | (unsigned)ts_lo) : 0ull;
        if (lane == 62) stamps[62] = rt_entry; if (lane == 63) stamps[63] = (unsigned long long)0ull; }
#undef PG8_STAMP
#undef PG8_SA
#undef PG8_SB
#undef PG8_STAGE
#undef PG8_LDA
#undef PG8_LDB
#undef PG8_MMA
#undef PG8_WAIT_V
#undef PG8_WAIT_L
#undef PG8_BAR
#undef PG8_SCHED
}
}

namespace {
constexpr int D = 1024, BATCH = 2, SEQ = 8192, T = BATCH * SEQ;
constexpr int PW = 2312;
constexpr int PS = 2304;
constexpr int OQ = 0, OKK = 512, OV = 640, OZ = 768, OXBC = 1280, ODT = 2304;
constexpr float EPS = 1e-6f;
constexpr int NTHR = 512;
typedef unsigned short bf16;
typedef unsigned v4u __attribute__((ext_vector_type(4)));

constexpr size_t MiB = 1u << 20;
constexpr size_t WS_WIN = 1 * MiB;
constexpr size_t WS_KH = 5 * MiB + 512 * 1024;
constexpr size_t WS_WO = 6 * MiB;
constexpr size_t WS_WQ = 8 * MiB;
constexpr size_t WS_PROJ = 10 * MiB;
constexpr size_t WS_XNB = 82 * MiB;
constexpr size_t WS_XACT = 114 * MiB;
constexpr size_t WS_DTRAW = 146 * MiB;
constexpr size_t WS_DT = WS_DTRAW + 512 * 1024;
constexpr size_t WS_ACS = WS_DT + 512 * 1024;
constexpr size_t WS_CDEC = WS_ACS + 512 * 1024;
constexpr size_t WS_STATES = 164 * MiB;
constexpr size_t WS_PREV = 196 * MiB;
constexpr size_t WS_QP = 10 * MiB;
constexpr size_t WS_IDX = 74 * MiB;
constexpr size_t WS_GATE = 114 * MiB;
constexpr size_t WS_TOPV = 122 * MiB;
constexpr size_t WS_TOPI = 138 * MiB;
constexpr size_t WS_ACT = 122 * MiB;
constexpr size_t WS_SU = 245 * MiB;
constexpr size_t WS_U8 = 212 * MiB;
constexpr size_t WS_V8 = 148 * MiB;
constexpr size_t WS_PART = 10 * MiB;
constexpr size_t WS_XQ = 228 * MiB;
constexpr size_t WS_XS = 244 * MiB;
constexpr size_t WS_PEERO = 10 * MiB;
constexpr size_t WS_END = 246 * MiB;
constexpr int CW_QU = 4096, CW_QV = 4096 + 64 * 16;
constexpr int NPART = 8, NCHUNK = T / 64;

struct Args {
    const float* x; const float* norm_mix_g; const float* w_in; const float* attn_sinks; const float* attn_out_g;
    const float* conv_w; const float* conv_b; const float* dt_bias; const float* a_log; const float* d_skip;
    const float* ssm_norm_g; const float* w_out; const float* norm_ffn_g; const float* peer_wq; const float* peer_sub_keys;
    const float* peer_u; const float* peer_v; const float* final_norm_g;
    float* out; unsigned char* ws;
    int ph_lo, ph_hi;
};

#define LAS __attribute__((address_space(3)))
#define LDS_WAIT() asm volatile("s_waitcnt lgkmcnt(0)" ::: "memory")
__device__ __forceinline__ float bf2f(bf16 v) { return __uint_as_float(((unsigned)v) << 16); }
__device__ __forceinline__ unsigned f2bfu(float f) { unsigned u = __float_as_uint(f); return (u + 0x7fffu + ((u >> 16) & 1u)) >> 16; }
__device__ __forceinline__ bf16 f2bf(float f) { return (bf16)f2bfu(f); }
__device__ __forceinline__ unsigned pk2(float lo, float hi) { return f2bfu(lo) | (f2bfu(hi) << 16); }
__device__ __forceinline__ float wave_sum(float v) {
#pragma unroll
    for (int o = 1; o < 64; o <<= 1) v += __shfl_xor(v, o);
    return v;
}
__device__ __forceinline__ float silu_f(float v) { return v / (1.f + __expf(-v)); }

__device__ __forceinline__ void transpose_item(const float* W, int ldw, int K, bf16* WT, LAS float* scr, int kb, int nbk, int lane) {
    const int k0 = 64 * kb, n0 = 32 * nbk;
#pragma unroll 8
    for (int i = 0; i < 32; ++i) { const int kk = 2 * i + (lane >> 5); scr[kk * 33 + (lane & 31)] = W[(size_t)(k0 + kk) * ldw + n0 + (lane & 31)]; }
    LDS_WAIT();
    const int c = lane & 7;
#pragma unroll
    for (int j = 0; j < 4; ++j) { const int n = (lane >> 3) + 8 * j; const LAS float* s = scr + (8 * c) * 33 + n;
        v4u o; o.x = pk2(s[0 * 33], s[1 * 33]); o.y = pk2(s[2 * 33], s[3 * 33]); o.z = pk2(s[4 * 33], s[5 * 33]); o.w = pk2(s[6 * 33], s[7 * 33]);
        *(v4u*)(WT + (size_t)(n0 + n) * K + k0 + 8 * c) = o; }
    LDS_WAIT();
}

template <int MODE  >
__device__ __forceinline__ void rmsnorm_rows_bf16(const float* __restrict__ in, const float* __restrict__ g, bf16* __restrict__ outp, const LAS unsigned char* ldsb, float* __restrict__ dtraw, unsigned char* __restrict__ xq, float* __restrict__ xs, int gwave, int nwaves, int lane) {
#pragma unroll 2
    for (int row = gwave; row < T; row += nwaves) {
        const float4* xr = (const float4*)(in + (size_t)row * D) + lane; const uint2* xb = (const uint2*)((const bf16*)in + (size_t)row * D) + lane;
        float4 v[4]; float ss = 0.f;
#pragma unroll
        for (int j = 0; j < 4; ++j) {
            if (MODE == 2) { const uint2 w = xb[64 * j]; v[j] = make_float4(__uint_as_float(w.x << 16), __uint_as_float(w.x & 0xffff0000u), __uint_as_float(w.y << 16), __uint_as_float(w.y & 0xffff0000u)); }
            else v[j] = xr[64 * j];
            ss += v[j].x * v[j].x + v[j].y * v[j].y + v[j].z * v[j].z + v[j].w * v[j].w; }
        ss = wave_sum(ss);
        const float r = rsqrtf(ss * (1.f / D) + EPS);
        unsigned long long* o8 = (unsigned long long*)(outp + (size_t)row * D) + lane;
        float dacc[8]; float y[4][4]; float mx = 0.f;
#pragma unroll
        for (int h = 0; h < 8; ++h) dacc[h] = 0.f;
#pragma unroll
        for (int j = 0; j < 4; ++j) {
            const float4 gv = ((const float4*)g)[lane + 64 * j];
            y[j][0] = v[j].x * r * gv.x; y[j][1] = v[j].y * r * gv.y; y[j][2] = v[j].z * r * gv.z; y[j][3] = v[j].w * r * gv.w;
            o8[64 * j] = (unsigned long long)pk2(y[j][0], y[j][1]) | ((unsigned long long)pk2(y[j][2], y[j][3]) << 32);
            if (MODE == 2) mx = fmaxf(mx, fmaxf(fmaxf(fabsf(y[j][0]), fabsf(y[j][1])), fmaxf(fabsf(y[j][2]), fabsf(y[j][3]))));
            if (MODE == 1) {
#pragma unroll
                for (int h = 0; h < 8; ++h) {
                    typedef float f4v __attribute__((ext_vector_type(4)));
                    const f4v wv = *(const LAS f4v*)(ldsb + h * 16384 + 8448 + (256 * j + 4 * lane) * 4);
                    dacc[h] += y[j][0] * wv.x + y[j][1] * wv.y + y[j][2] * wv.z + y[j][3] * wv.w;
                }
            }
        }
        if (MODE == 1) {
#pragma unroll
            for (int h = 0; h < 8; ++h) dacc[h] = wave_sum(dacc[h]);
            if (lane == 0) { float4* dp = (float4*)(dtraw + (size_t)row * 8); dp[0] = make_float4(dacc[0], dacc[1], dacc[2], dacc[3]); dp[1] = make_float4(dacc[4], dacc[5], dacc[6], dacc[7]); }
        }
        if (MODE == 2) {
#pragma unroll
            for (int o = 1; o < 64; o <<= 1) mx = fmaxf(mx, __shfl_xor(mx, o));
            const float sc = mx > 0.f ? mx * (1.f / 127.f) : 1.f, inv = 1.f / sc;
            unsigned* dq = (unsigned*)(xq + (size_t)row * D) + lane;
#pragma unroll
            for (int j = 0; j < 4; ++j) { const int q0 = (int)rintf(y[j][0] * inv), q1 = (int)rintf(y[j][1] * inv), q2 = (int)rintf(y[j][2] * inv), q3 = (int)rintf(y[j][3] * inv);
                dq[64 * j] = (unsigned)(q0 & 255) | ((unsigned)(q1 & 255) << 8) | ((unsigned)(q2 & 255) << 16) | ((unsigned)(q3 & 255) << 24); }
            if (lane == 0) xs[row] = sc;
        }
    }
}

typedef short bf16x8 __attribute__((ext_vector_type(8)));
typedef short bf16x4 __attribute__((ext_vector_type(4)));
typedef float f32x16 __attribute__((ext_vector_type(16)));
typedef __bf16 bf2_t __attribute__((ext_vector_type(2)));
#define MFMA32(a, b, c) __builtin_amdgcn_mfma_f32_32x32x16_bf16((a), (b), (c), 0, 0, 0)
__device__ __forceinline__ unsigned pkbf(float lo, float hi) { bf2_t v = {(__bf16)lo, (__bf16)hi}; return __builtin_bit_cast(unsigned, v); }
__device__ __forceinline__ short bfs(float f) { return __builtin_bit_cast(short, (__bf16)f); }
__device__ __forceinline__ float sbf2f(short v) { return __uint_as_float(((unsigned)(unsigned short)v) << 16); }
__device__ __forceinline__ int crow(int i, int hi) { return (i & 3) + 8 * (i >> 2) + 4 * hi; }
template <int S> __device__ __forceinline__ bf16x8 pack8(const f32x16& x) {
    v4u p; p.x = pkbf(x[8 * S], x[8 * S + 1]); p.y = pkbf(x[8 * S + 2], x[8 * S + 3]); p.z = pkbf(x[8 * S + 4], x[8 * S + 5]); p.w = pkbf(x[8 * S + 6], x[8 * S + 7]);
    return __builtin_bit_cast(bf16x8, p);
}
__device__ __forceinline__ bf16x8 ldg8(const bf16* p) { return *(const bf16x8*)p; }
__device__ __forceinline__ bf16x8 lds8(const LAS bf16* p) { return *(const LAS bf16x8*)p; }
__device__ __forceinline__ bf16x8 lds4x2(const LAS bf16* p) { const bf16x4 a = *(const LAS bf16x4*)p, b = *(const LAS bf16x4*)(p + 8); return __builtin_shufflevector(a, b, 0, 1, 2, 3, 4, 5, 6, 7); }
__device__ __forceinline__ f32x16 zero16() { f32x16 z;
#pragma unroll
    for (int i = 0; i < 16; ++i) z[i] = 0.f;
    return z; }

__device__ __forceinline__ void attn_unit(const float* sinks, const float* gnorm, LAS unsigned char* ldsb, int unit, const bf16* PROJ, bf16* MIXB, int tid, int lane, int wave) {
    asm volatile("" : "+v"(tid), "+v"(lane));
    const int tok0 = unit * 64, s0 = tok0 & (SEQ - 1), kbase = tok0 - 128;
    LAS bf16* VT = (LAS bf16*)ldsb;
    LAS bf16* KI = (LAS bf16*)(ldsb + 51200);
    LAS float* SSQ = (LAS float*)(ldsb + 51200 + 55296);
    const __amdgpu_buffer_rsrc_t rsP = __builtin_amdgcn_make_buffer_rsrc((void*)PROJ, 0, (unsigned)T * PS * 2u, 0x00020000);
#pragma unroll
    for (int i = 0; i < 6; ++i) {
        const int c = tid + 512 * i, kv = c / 1536, cc = c - kv * 1536, key = cc >> 3, d0 = (cc & 7) * 8; const bool valid = (s0 - 128 + key) >= 0;
        bf16x8 v, k;
#pragma unroll
        for (int e = 0; e < 8; ++e) { v[e] = 0; k[e] = 0; }
        if (valid) { const unsigned ro = (unsigned)(kbase + key) * (unsigned)PS + (unsigned)(kv * 64 + d0);
            v = __builtin_bit_cast(bf16x8, __builtin_amdgcn_raw_buffer_load_b128(rsP, (int)((ro + (unsigned)OV) * 2u), 0, 0));
            k = __builtin_bit_cast(bf16x8, __builtin_amdgcn_raw_buffer_load_b128(rsP, (int)((ro + (unsigned)OKK) * 2u), 0, 0)); }
#pragma unroll
        for (int e = 0; e < 8; ++e) VT[kv * 12800 + (d0 + e) * 200 + key] = (bf16)v[e];
        *(LAS bf16x8*)(KI + (kv * 192 + key) * 72 + d0) = k;
    }
    __syncthreads();
    const int r = lane & 31, hi = lane >> 5;
    const int hq = wave, hkv = wave >> 2;
    const float slope = exp2f(-(float)(hq + 1)), sink = sinks[hq];
#pragma unroll 1
    for (int qt = 0; qt < 2; ++qt) {
        const int tq = tok0 + 32 * qt + r;
        bf16x8 qf[4];
        { const bf16* qp = PROJ + (size_t)tq * PS + OQ + hq * 64 + 8 * hi; asm volatile("" : "+v"(qp));
#pragma unroll
          for (int ks = 0; ks < 4; ++ks) qf[ks] = ldg8(qp + 16 * ks); }
        const int ql = 32 * qt + r;
        float m = sink, lh = 0.f;
        f32x16 O0 = zero16(), O1 = zero16();
#pragma unroll 1
        for (int kt = 0; kt < 5; ++kt) {
            const LAS bf16* kp = KI + (hkv * 192 + 32 * (qt + kt) + r) * 72 + 8 * hi;
            f32x16 X = zero16();
#pragma unroll
            for (int ks = 0; ks < 4; ++ks) X = MFMA32(lds8(kp + 16 * ks), qf[ks], X);
            float tm = -1e30f;
#pragma unroll
            for (int i = 0; i < 16; ++i) {
                const int kl = 32 * (qt + kt) + crow(i, hi), dist = 128 + ql - kl;
                const bool valid = (dist >= 0) && (dist < 128) && ((s0 - 128 + kl) >= 0);
                const float lg = valid ? (X[i] * 0.125f - slope * (float)dist) : -1e30f;
                X[i] = lg; tm = fmaxf(tm, lg);
            }
            tm = fmaxf(tm, __shfl_xor(tm, 32));
            const float mn = fmaxf(m, tm), sc = __expf(m - mn);
            m = mn; lh *= sc;
#pragma unroll
            for (int i = 0; i < 16; ++i) { O0[i] *= sc; O1[i] *= sc; const float pe = __expf(X[i] - mn); X[i] = pe; lh += pe; }
            const LAS bf16* vp = VT + hkv * 12800 + r * 200 + 32 * (qt + kt) + 4 * hi;
            { const bf16x8 xs = pack8<0>(X); const bf16x8 a0 = lds4x2(vp), a1 = lds4x2(vp + 32 * 200); O0 = MFMA32(a0, xs, O0); O1 = MFMA32(a1, xs, O1); }
            { const bf16x8 xs = pack8<1>(X); const bf16x8 a0 = lds4x2(vp + 16), a1 = lds4x2(vp + 32 * 200 + 16); O0 = MFMA32(a0, xs, O0); O1 = MFMA32(a1, xs, O1); }
        }
        const float lsum = lh + __shfl_xor(lh, 32) + __expf(sink - m);
        const float iv = 1.f / lsum;
        float sq = 0.f;
#pragma unroll
        for (int i = 0; i < 16; ++i) sq += O0[i] * O0[i] + O1[i] * O1[i];
        sq *= iv * iv; sq += __shfl_xor(sq, 32);
        if (hi == 0) SSQ[hq * 32 + r] = sq;
        __syncthreads();
        float tot = 0.f;
#pragma unroll
        for (int h = 0; h < 8; ++h) tot += SSQ[h * 32 + r];
        const float sc = iv * rsqrtf(tot * (1.f / 512.f) + EPS);
        bf16* orow = MIXB + (size_t)tq * D + hq * 64 + 4 * hi;
#pragma unroll
        for (int q4 = 0; q4 < 4; ++q4) {
            const float4 g0 = *(const float4*)(gnorm + hq * 64 + 8 * q4 + 4 * hi), g1 = *(const float4*)(gnorm + hq * 64 + 32 + 8 * q4 + 4 * hi);
            uint2 w0, w1;
            w0.x = pkbf(O0[4 * q4] * sc * g0.x, O0[4 * q4 + 1] * sc * g0.y); w0.y = pkbf(O0[4 * q4 + 2] * sc * g0.z, O0[4 * q4 + 3] * sc * g0.w);
            w1.x = pkbf(O1[4 * q4] * sc * g1.x, O1[4 * q4 + 1] * sc * g1.y); w1.y = pkbf(O1[4 * q4 + 2] * sc * g1.z, O1[4 * q4 + 3] * sc * g1.w);
            *(uint2*)(orow + 8 * q4) = w0; *(uint2*)(orow + 32 + 8 * q4) = w1;
        }
        __syncthreads();
    }
}

__device__ __forceinline__ void ssd_chunk_unit(LAS unsigned char* ldsb, int unit, const bf16* PROJ, bf16* XACT, const float* DTRAW, const float* conv_w, const float* conv_b, const float* dt_bias, const float* a_log,
                                               float* ACS, float* CDEC, float* MIXF, float* STATES, int tid, int lane, int wave) {
    asm volatile("" : "+v"(tid), "+v"(lane));
    const int g = unit & 1, bc = unit >> 1, tok0 = bc * 128;
    LAS float* DTT = (LAS float*)(ldsb + 34816 * 3 + 2048);
    LAS float* WT = (LAS float*)(ldsb + 34816 * 3 + 4096);
    {
        const int cgi = tid & 63, t0 = tok0 + 16 * (tid >> 6);
        const int c0 = cgi < 32 ? g * 256 + cgi * 8 : (cgi < 48 ? 512 + g * 128 + (cgi - 32) * 8 : 768 + g * 128 + (cgi - 48) * 8);
        float w[4][8], bs[8];
#pragma unroll
        for (int k = 0; k < 4; ++k) { const float4 a0 = *(const float4*)(conv_w + k * 1024 + c0), a1 = *(const float4*)(conv_w + k * 1024 + c0 + 4);
            w[k][0] = a0.x; w[k][1] = a0.y; w[k][2] = a0.z; w[k][3] = a0.w; w[k][4] = a1.x; w[k][5] = a1.y; w[k][6] = a1.z; w[k][7] = a1.w; }
        { const float4 a0 = *(const float4*)(conv_b + c0), a1 = *(const float4*)(conv_b + c0 + 4); bs[0] = a0.x; bs[1] = a0.y; bs[2] = a0.z; bs[3] = a0.w; bs[4] = a1.x; bs[5] = a1.y; bs[6] = a1.z; bs[7] = a1.w; }
        const bool has_halo = (t0 & (SEQ - 1)) != 0;
        bf16x8 rows[19];
#pragma unroll
        for (int i = 0; i < 19; ++i) {
            if (i < 3 && !has_halo) {
#pragma unroll
                for (int e = 0; e < 8; ++e) rows[i][e] = 0;
            } else rows[i] = ldg8(PROJ + (size_t)(t0 + i - 3) * PS + OXBC + c0);
        }
#pragma unroll
        for (int i = 0; i < 16; ++i) {
            float o[8];
#pragma unroll
            for (int e = 0; e < 8; ++e) o[e] = silu_f(bs[e] + w[0][e] * sbf2f(rows[i][e]) + w[1][e] * sbf2f(rows[i + 1][e]) + w[2][e] * sbf2f(rows[i + 2][e]) + w[3][e] * sbf2f(rows[i + 3][e]));
            v4u ov; ov.x = pkbf(o[0], o[1]); ov.y = pkbf(o[2], o[3]); ov.z = pkbf(o[4], o[5]); ov.w = pkbf(o[6], o[7]);
            *(v4u*)(XACT + (size_t)(t0 + i) * 1024 + c0) = ov;
        }
    }
    LAS float* ACST = (LAS float*)(ldsb + 34816 * 3);
    {
        const int s = tid >> 2, hh = tid & 3, H = g * 4 + hh;
        const float A = -__expf(a_log[H]);
        const float raw = DTRAW[(size_t)(tok0 + s) * 8 + H] + dt_bias[H];
        const float dtv = fmaxf(raw, 0.f) + log1pf(__expf(-fabsf(raw)));
        float v = dtv * A;
#pragma unroll
        for (int o = 4; o < 64; o <<= 1) { const float y = __shfl_up(v, o); if (lane >= o) v += y; }
        if (lane >= 60) WT[wave * 4 + hh] = v;
        __syncthreads();
        float off = 0.f;
        for (int w2 = 0; w2 < wave; ++w2) off += WT[w2 * 4 + hh];
        v += off;
        DTT[tid] = dtv; ACST[tid] = v; ACS[(size_t)(tok0 + s) * 8 + H] = v;
        if (s == 127) CDEC[bc * 8 + H] = __expf(v);
    }
    asm volatile("s_waitcnt vmcnt(0)" ::: "memory");
    __syncthreads();
    LAS bf16* BT = (LAS bf16*)ldsb;
    LAS bf16* XD = (LAS bf16*)(ldsb + 34816);
    LAS bf16* XW = (LAS bf16*)(ldsb + 34816 + 34816);
    const int r = lane & 31, hi = lane >> 5;
#pragma unroll
    for (int i = 0; i < 4; ++i) {
        const int c = tid + 512 * i, s = c >> 4, n0 = (c & 15) * 8;
        const bf16x8 v = ldg8(XACT + (size_t)(tok0 + s) * 1024 + 512 + g * 128 + n0);
#pragma unroll
        for (int e = 0; e < 8; ++e) BT[(n0 + e) * 136 + s] = (bf16)v[e];
    }
#pragma unroll 1
    for (int hp = 0; hp < 2; ++hp) {
        if (hp) __syncthreads();
        int tidp = tid; asm volatile("" : "+v"(tidp));
#pragma unroll
        for (int i = 0; i < 4; ++i) {
            const int c = tidp + 512 * i, hsel = c >> 10, s = (c >> 3) & 127, p0 = (c & 7) * 8, H = g * 4 + 2 * hp + hsel;
            const bf16x8 v = ldg8(XACT + (size_t)(tok0 + s) * 1024 + H * 64 + p0);
            const float dtv = DTT[s * 4 + 2 * hp + hsel];
            const float w = __expf(ACST[127 * 4 + 2 * hp + hsel] - ACST[s * 4 + 2 * hp + hsel]);
#pragma unroll
            for (int e = 0; e < 8; ++e) { const float xd = sbf2f(v[e]) * dtv; XD[hsel * 8704 + (p0 + e) * 136 + s] = (bf16)bfs(xd); XW[hsel * 8704 + (p0 + e) * 136 + s] = (bf16)bfs(xd * w); }
        }
        __syncthreads();
        {
            const int lt = wave & 3, hsel = wave >> 2, hh = 2 * hp + hsel, H = g * 4 + hh;
            const int l = 32 * lt + r; const float acs_l = ACST[l * 4 + hh];
            bf16x8 cf[8];
            { const bf16* cp = XACT + (size_t)(tok0 + l) * 1024 + 768 + g * 128 + 8 * hi; asm volatile("" : "+v"(cp));
#pragma unroll
              for (int ks = 0; ks < 8; ++ks) cf[ks] = ldg8(cp + 16 * ks); }
            f32x16 Z0 = zero16(), Z1 = zero16();
            bf16x8 bn[8];
            { const bf16* bp = XACT + (size_t)(tok0 + r) * 1024 + 512 + g * 128 + 8 * hi; asm volatile("" : "+v"(bp));
#pragma unroll
              for (int ks = 0; ks < 8; ++ks) bn[ks] = ldg8(bp + 16 * ks); }
#pragma unroll 1
            for (int st = 0; st <= lt; ++st) {
                f32x16 X = zero16();
                bf16x8 bc[8];
#pragma unroll
                for (int ks = 0; ks < 8; ++ks) bc[ks] = bn[ks];
                { const int stn = st < lt ? st + 1 : lt; const bf16* bp = XACT + (size_t)(tok0 + 32 * stn + r) * 1024 + 512 + g * 128 + 8 * hi; asm volatile("" : "+v"(bp));
#pragma unroll
                  for (int ks = 0; ks < 8; ++ks) bn[ks] = ldg8(bp + 16 * ks); }
#pragma unroll
                for (int ks = 0; ks < 8; ++ks) X = MFMA32(bc[ks], cf[ks], X);
#pragma unroll
                for (int i = 0; i < 16; ++i) { const int s = 32 * st + crow(i, hi); const float f = (s <= l) ? __expf(acs_l - ACST[s * 4 + hh]) : 0.f; X[i] *= f; }
                const int sb = 32 * st + 4 * hi;
                { const bf16x8 xs = pack8<0>(X); const bf16x8 b0 = lds4x2(XD + hsel * 8704 + r * 136 + sb), b1 = lds4x2(XD + hsel * 8704 + (32 + r) * 136 + sb); Z0 = MFMA32(xs, b0, Z0); Z1 = MFMA32(xs, b1, Z1); }
                { const bf16x8 xs = pack8<1>(X); const bf16x8 b0 = lds4x2(XD + hsel * 8704 + r * 136 + sb + 16), b1 = lds4x2(XD + hsel * 8704 + (32 + r) * 136 + sb + 16); Z0 = MFMA32(xs, b0, Z0); Z1 = MFMA32(xs, b1, Z1); }
            }
#pragma unroll
            for (int i = 0; i < 16; ++i) { float* o = MIXF + (size_t)(tok0 + 32 * lt + crow(i, hi)) * D + 512 + H * 64 + r; o[0] = Z0[i]; o[32] = Z1[i]; }
        }
        {
            const int nt = wave & 3, hsel = wave >> 2, H = g * 4 + 2 * hp + hsel;
            f32x16 S0 = zero16(), S1 = zero16();
#pragma unroll
            for (int ks = 0; ks < 8; ++ks) {
                const bf16x8 btf = lds8(BT + (32 * nt + r) * 136 + 16 * ks + 8 * hi);
                const bf16x8 a0 = lds8(XW + hsel * 8704 + r * 136 + 16 * ks + 8 * hi), a1 = lds8(XW + hsel * 8704 + (32 + r) * 136 + 16 * ks + 8 * hi);
                S0 = MFMA32(a0, btf, S0); S1 = MFMA32(a1, btf, S1);
            }
            float* sp = STATES + (size_t)(bc * 8 + H) * 8192 + 32 * nt + r;
#pragma unroll
            for (int i = 0; i < 16; ++i) { const int p = crow(i, hi); sp[p * 128] = S0[i]; sp[(32 + p) * 128] = S1[i]; }
        }
    }
    __syncthreads();
}

__device__ __forceinline__ __amdgpu_buffer_rsrc_t mk_rsrc(const void* p, unsigned bytes) { return __builtin_amdgcn_make_buffer_rsrc((void*)p, 0, bytes, 0x00020000); }
__device__ __forceinline__ void yoff_unit(const float* d_skip, const float* gnorm, LAS unsigned char* ldsb, int unit, const bf16* XACT, const bf16* PROJ, const float* ACS, const bf16* PREVT,
                                          const float* MIXF, bf16* MIXB, int lane, int wave) {
    const int g = unit & 1, bc = unit >> 1, tok0 = bc * 128;
    const int r = lane & 31, hi = lane >> 5, lt = wave & 3, hpair = wave >> 2;
    LAS float* TAB = (LAS float*)ldsb;
    const __amdgpu_buffer_rsrc_t rsF = mk_rsrc(MIXF, (unsigned)T * D * 4u), rsX = mk_rsrc(XACT, (unsigned)T * 1024u * 2u), rsP = mk_rsrc(PROJ, (unsigned)T * PS * 2u), rsA = mk_rsrc(ACS, (unsigned)T * 32u), rsB = mk_rsrc(MIXB, (unsigned)T * D * 2u);
    const unsigned tb = (unsigned)(tok0 + 32 * lt + 4 * hi);
    bf16x8 cf[8];
    { const bf16* cp = XACT + (size_t)(tok0 + 32 * lt + r) * 1024 + 768 + g * 128 + 8 * hi; asm volatile("" : "+v"(cp));
#pragma unroll
      for (int ks = 0; ks < 8; ++ks) cf[ks] = ldg8(cp + 16 * ks); }
    float eav[16], ssq[16];
    unsigned ypk[2][2][8];
#pragma unroll
    for (int i = 0; i < 16; ++i) ssq[i] = 0.f;
#pragma unroll
    for (int hsel = 0; hsel < 2; ++hsel) {
        const int H = g * 4 + 2 * hpair + hsel; const bf16* pv = PREVT + (size_t)(bc * 8 + H) * 8192 + 8 * hi;
        asm volatile("" : "+v"(pv));
        f32x16 Y0 = zero16(), Y1 = zero16();
#pragma unroll
        for (int ks = 0; ks < 8; ++ks) {
            const bf16x8 b0 = ldg8(pv + r * 128 + 16 * ks), b1 = ldg8(pv + (32 + r) * 128 + 16 * ks);
            Y0 = MFMA32(cf[ks], b0, Y0); Y1 = MFMA32(cf[ks], b1, Y1);
        }
        const float dsk = d_skip[H];
        { const unsigned vo = (tb * 8u + (unsigned)H) * 4u;
#pragma unroll
          for (int i = 0; i < 16; ++i) eav[i] = __expf(__builtin_bit_cast(float, __builtin_amdgcn_raw_buffer_load_b32(rsA, (int)vo, ((i & 3) + 8 * (i >> 2)) * 32, 0))); }
#pragma unroll
        for (int pt = 0; pt < 2; ++pt) {
            const unsigned col = (unsigned)(H * 64 + 32 * pt + r);
            const unsigned voF = (tb * 1024u + 512u + col) * 4u, voX = (tb * 1024u + col) * 2u, voP = (tb * (unsigned)PS + (unsigned)OZ + col) * 2u;
            float yo[16], xsv[16], zv[16];
#pragma unroll
            for (int i = 0; i < 16; ++i) { const int ro = (i & 3) + 8 * (i >> 2);
                yo[i] = __builtin_bit_cast(float, __builtin_amdgcn_raw_buffer_load_b32(rsF, (int)voF, ro * 4096, 0));
                xsv[i] = bf2f((bf16)__builtin_amdgcn_raw_buffer_load_b16(rsX, (int)voX, ro * 2048, 0));
                zv[i] = bf2f((bf16)__builtin_amdgcn_raw_buffer_load_b16(rsP, (int)voP, ro * (PS * 2), 0)); }
#pragma unroll
            for (int i = 0; i < 16; i += 2) {
                const float y0 = (yo[i] + eav[i] * (pt ? Y1[i] : Y0[i]) + dsk * xsv[i]) * silu_f(zv[i]);
                const float y1 = (yo[i + 1] + eav[i + 1] * (pt ? Y1[i + 1] : Y0[i + 1]) + dsk * xsv[i + 1]) * silu_f(zv[i + 1]);
                ssq[i] += y0 * y0; ssq[i + 1] += y1 * y1; ypk[hsel][pt][i >> 1] = pkbf(y0, y1);
            }
            __builtin_amdgcn_sched_barrier(0);
        }
    }
#pragma unroll
    for (int i = 0; i < 16; ++i) {
#pragma unroll
        for (int o = 1; o < 32; o <<= 1) ssq[i] += __shfl_xor(ssq[i], o);
    }
    if (r == 0) {
#pragma unroll
        for (int i = 0; i < 16; ++i) TAB[hpair * 128 + 32 * lt + crow(i, hi)] = ssq[i];
    }
    __syncthreads();
#pragma unroll
    for (int i = 0; i < 16; ++i) { const int l = 32 * lt + crow(i, hi); ssq[i] = rsqrtf((TAB[l] + TAB[128 + l]) * (1.f / 256.f) + EPS); }
#pragma unroll
    for (int hsel = 0; hsel < 2; ++hsel)
#pragma unroll
        for (int pt = 0; pt < 2; ++pt) {
            const unsigned col = (unsigned)((g * 4 + 2 * hpair + hsel) * 64 + 32 * pt + r); const float gn = gnorm[col];
            const unsigned voB = (tb * 1024u + 512u + col) * 2u;
#pragma unroll
            for (int i = 0; i < 16; ++i) { const unsigned w = ypk[hsel][pt][i >> 1];
                const float yf = (i & 1) ? __uint_as_float(w & 0xffff0000u) : __uint_as_float(w << 16);
                __builtin_amdgcn_raw_buffer_store_b16((short)f2bf(yf * ssq[i] * gn), rsB, (int)voB, ((i & 3) + 8 * (i >> 2)) * 2048, 0); }
        }
    __syncthreads();
}
typedef float f32x2 __attribute__((ext_vector_type(2)));
__device__ __forceinline__ void fp8x16_to_f32(const uint4 w, float (&f)[16]) {
    const int ww[4] = {(int)w.x, (int)w.y, (int)w.z, (int)w.w};
#pragma unroll
    for (int q = 0; q < 4; ++q) { const f32x2 a = __builtin_amdgcn_cvt_pk_f32_fp8(ww[q], false), b = __builtin_amdgcn_cvt_pk_f32_fp8(ww[q], true); f[4 * q] = a.x; f[4 * q + 1] = a.y; f[4 * q + 2] = b.x; f[4 * q + 3] = b.y; }
}
template <int M4, int M2, int M1> __device__ __forceinline__ void treduce16(const float (&a)[16], int lane, float& r0, float& r1) {
    float b[8], c[4];
    { const bool hi = (lane & M4) != 0;
#pragma unroll
      for (int i = 0; i < 8; ++i) { const float send = hi ? a[i] : a[i + 8]; const float recv = __shfl_xor(send, M4); b[i] = (hi ? a[i + 8] : a[i]) + recv; } }
    { const bool hi = (lane & M2) != 0;
#pragma unroll
      for (int i = 0; i < 4; ++i) { const float send = hi ? b[i] : b[i + 4]; const float recv = __shfl_xor(send, M2); c[i] = (hi ? b[i + 4] : b[i]) + recv; } }
    { const bool hi = (lane & M1) != 0;
      { const float send = hi ? c[0] : c[2]; const float recv = __shfl_xor(send, M1); r0 = (hi ? c[2] : c[0]) + recv; }
      { const float send = hi ? c[1] : c[3]; const float recv = __shfl_xor(send, M1); r1 = (hi ? c[3] : c[1]) + recv; } }
}
template <int M4, int M2, int M1> __device__ __forceinline__ void treduce16i(const int (&a)[16], int lane, int& r0, int& r1) {
    int b[8], c[4];
    { const bool hi = (lane & M4) != 0;
#pragma unroll
      for (int i = 0; i < 8; ++i) { const int send = hi ? a[i] : a[i + 8]; const int recv = __shfl_xor(send, M4); b[i] = (hi ? a[i + 8] : a[i]) + recv; } }
    { const bool hi = (lane & M2) != 0;
#pragma unroll
      for (int i = 0; i < 4; ++i) { const int send = hi ? b[i] : b[i + 4]; const int recv = __shfl_xor(send, M2); c[i] = (hi ? b[i + 4] : b[i]) + recv; } }
    { const bool hi = (lane & M1) != 0;
      { const int send = hi ? c[0] : c[2]; const int recv = __shfl_xor(send, M1); r0 = (hi ? c[2] : c[0]) + recv; }
      { const int send = hi ? c[1] : c[3]; const int recv = __shfl_xor(send, M1); r1 = (hi ? c[3] : c[1]) + recv; } }
}
#define PE_ID(E, i) (((i) & 1) ? (E[(i) >> 1] >> 16) : (E[(i) >> 1] & 0xffffu))
__device__ __forceinline__ void peer_u_item(int p, int j, const LAS unsigned short* EL  , const unsigned char* __restrict__ XQ, const unsigned char* __restrict__ U8, LAS int* ACC  , int lane, int wave) {
    asm volatile("" : "+v"(lane));
    const int gidx = lane >> 3; const unsigned coff = (unsigned)(p * 128 + (lane & 7) * 16);
#pragma unroll 1
    for (int it = 0; it < 8; ++it) {
        const int t = j * 64 + it * 8 + wave;
        unsigned E[8];
        { const LAS v4u* ep = (const LAS v4u*)(EL + (it * 8 + wave) * 128 + 16 * gidx); const v4u e0 = ep[0], e1 = ep[1];
          E[0] = e0.x; E[1] = e0.y; E[2] = e0.z; E[3] = e0.w; E[4] = e1.x; E[5] = e1.y; E[6] = e1.z; E[7] = e1.w; }
        uint4 uu[16];
#pragma unroll
        for (int i = 0; i < 16; ++i) uu[i] = *(const uint4*)(U8 + (size_t)(PE_ID(E, i) * 1024u + coff));
        const uint4 xq = *(const uint4*)(XQ + (size_t)t * D + coff);
        int d[16];
#pragma unroll
        for (int i = 0; i < 16; ++i) {
            int s = __builtin_amdgcn_sdot4((int)uu[i].x, (int)xq.x, 0, false); s = __builtin_amdgcn_sdot4((int)uu[i].y, (int)xq.y, s, false);
            s = __builtin_amdgcn_sdot4((int)uu[i].z, (int)xq.z, s, false); s = __builtin_amdgcn_sdot4((int)uu[i].w, (int)xq.w, s, false);
            d[i] = s;
        }
        int r0, r1; treduce16i<4, 2, 1>(d, lane, r0, r1);
        { typedef int i2v __attribute__((ext_vector_type(2))); LAS i2v* ap = (LAS i2v*)(ACC + (it * 8 + wave) * 128 + 2 * lane);
          i2v a2; if (p == 0) { a2.x = r0; a2.y = r1; } else { a2 = *ap; a2.x += r0; a2.y += r1; } *ap = a2; }
    }
}
__device__ __forceinline__ void peer_v_item(int p, int j, const LAS unsigned short* EL, const LAS unsigned char* AL  , const LAS float* ASC  ,
                                            const unsigned char* __restrict__ V8, bf16* __restrict__ PEERO, int lane, int wave) {
    asm volatile("" : "+v"(lane));
    const int gidx = lane >> 3; const unsigned coff = (unsigned)(p * 128 + (lane & 7) * 16);
#pragma unroll 1
    for (int it = 0; it < 8; ++it) {
        const int t = j * 64 + it * 8 + wave;
        unsigned E[8];
        { const LAS v4u* ep = (const LAS v4u*)(EL + (it * 8 + wave) * 128 + 16 * gidx); const v4u e0 = ep[0], e1 = ep[1];
          E[0] = e0.x; E[1] = e0.y; E[2] = e0.z; E[3] = e0.w; E[4] = e1.x; E[5] = e1.y; E[6] = e1.z; E[7] = e1.w; }
        uint4 vv[16];
#pragma unroll
        for (int i = 0; i < 16; ++i) vv[i] = *(const uint4*)(V8 + (size_t)(PE_ID(E, i) * 1024u + coff));
        const v4u aq = *(const LAS v4u*)(AL + (it * 8 + wave) * 128 + 16 * gidx);
        const float asc = ASC[it * 8 + wave];
        const unsigned a4[4] = {aq.x, aq.y, aq.z, aq.w};
        int acc[16];
#pragma unroll
        for (int c = 0; c < 16; ++c) acc[c] = 0;
#pragma unroll
        for (int m = 0; m < 4; ++m) {
            const unsigned r0[4] = {vv[4 * m].x, vv[4 * m].y, vv[4 * m].z, vv[4 * m].w}, r1[4] = {vv[4 * m + 1].x, vv[4 * m + 1].y, vv[4 * m + 1].z, vv[4 * m + 1].w};
            const unsigned r2[4] = {vv[4 * m + 2].x, vv[4 * m + 2].y, vv[4 * m + 2].z, vv[4 * m + 2].w}, r3[4] = {vv[4 * m + 3].x, vv[4 * m + 3].y, vv[4 * m + 3].z, vv[4 * m + 3].w};
#pragma unroll
            for (int dc = 0; dc < 4; ++dc) {
                const unsigned ta = __builtin_amdgcn_perm(r1[dc], r0[dc], 0x05010400u), tb = __builtin_amdgcn_perm(r3[dc], r2[dc], 0x05010400u);
                const unsigned ua = __builtin_amdgcn_perm(r1[dc], r0[dc], 0x07030602u), ub = __builtin_amdgcn_perm(r3[dc], r2[dc], 0x07030602u);
                const unsigned c0 = __builtin_amdgcn_perm(tb, ta, 0x05040100u), c1 = __builtin_amdgcn_perm(tb, ta, 0x07060302u);
                const unsigned c2 = __builtin_amdgcn_perm(ub, ua, 0x05040100u), c3 = __builtin_amdgcn_perm(ub, ua, 0x07060302u);
                acc[4 * dc + 0] = __builtin_amdgcn_sdot4((int)c0, (int)a4[m], acc[4 * dc + 0], false);
                acc[4 * dc + 1] = __builtin_amdgcn_sdot4((int)c1, (int)a4[m], acc[4 * dc + 1], false);
                acc[4 * dc + 2] = __builtin_amdgcn_sdot4((int)c2, (int)a4[m], acc[4 * dc + 2], false);
                acc[4 * dc + 3] = __builtin_amdgcn_sdot4((int)c3, (int)a4[m], acc[4 * dc + 3], false);
            }
        }
        int r0i, r1i; treduce16i<32, 16, 8>(acc, lane, r0i, r1i);
        *(unsigned*)(PEERO + (size_t)t * D + coff + 2 * gidx) = pkbf(asc * (float)r0i, asc * (float)r1i);
    }
}

__device__ __forceinline__ void ce_desc(float& a, float& b) { const float hi = fmaxf(a, b), lo = fminf(a, b); a = hi; b = lo; }
__device__ __forceinline__ void sort16_desc(float (&v)[16]) {
#pragma unroll
    for (int k = 2; k <= 16; k <<= 1)
#pragma unroll
        for (int j = k >> 1; j > 0; j >>= 1)
#pragma unroll
            for (int i = 0; i < 16; ++i) { const int l = i ^ j; if (l > i) { if ((i & k) == 0) ce_desc(v[i], v[l]); else ce_desc(v[l], v[i]); } }
}
__device__ __forceinline__ void merge16_desc(float (&a)[16], const float (&b)[16]) {
#pragma unroll
    for (int i = 0; i < 16; ++i) a[i] = fmaxf(a[i], b[15 - i]);
#pragma unroll
    for (int j = 8; j > 0; j >>= 1)
#pragma unroll
        for (int i = 0; i < 16; ++i) { const int l = i ^ j; if (l > i) ce_desc(a[i], a[l]); }
}
__device__ __forceinline__ void ce_kv(float& ka, int& va, float& kb, int& vb) {
    const bool s = kb > ka; const float t0 = s ? kb : ka, t1 = s ? ka : kb; const int u0 = s ? vb : va, u1 = s ? va : vb; ka = t0; kb = t1; va = u0; vb = u1; }
__device__ __forceinline__ void sort16_kv(float (&k)[16], int (&v)[16]) {
#pragma unroll
    for (int kk = 2; kk <= 16; kk <<= 1)
#pragma unroll
        for (int j = kk >> 1; j > 0; j >>= 1)
#pragma unroll
            for (int i = 0; i < 16; ++i) { const int l = i ^ j; if (l > i) { if ((i & kk) == 0) ce_kv(k[i], v[i], k[l], v[l]); else ce_kv(k[l], v[l], k[i], v[i]); } }
}
__device__ __forceinline__ void merge16_kv(float (&ka)[16], int (&va)[16], const float (&kb)[16], const int (&vb)[16]) {
#pragma unroll
    for (int i = 0; i < 16; ++i) { const bool s = kb[15 - i] > ka[i]; ka[i] = s ? kb[15 - i] : ka[i]; va[i] = s ? vb[15 - i] : va[i]; }
#pragma unroll
    for (int j = 8; j > 0; j >>= 1)
#pragma unroll
        for (int i = 0; i < 16; ++i) { const int l = i ^ j; if (l > i) ce_kv(ka[i], va[i], ka[l], va[l]); }
}
__device__ __forceinline__ void split8(const float* p, bf16x8& hi8, bf16x8& lo8) {
    const float4 f0 = *(const float4*)p, f1 = *(const float4*)(p + 4);
    const float x[8] = {f0.x, f0.y, f0.z, f0.w, f1.x, f1.y, f1.z, f1.w};
#pragma unroll
    for (int j = 0; j < 8; ++j) { const short h = bfs(x[j]); hi8[j] = h; lo8[j] = bfs(x[j] - sbf2f(h)); }
}
__device__ __forceinline__ void route_task(int task, const float* QP, const LAS bf16* KHL, unsigned short* IDX, float* GATE, int lane) {
    const int r = lane & 31, hi = lane >> 5, t = 4 * task + (r >> 3), head = r & 7;
    float top[2][16];
#pragma unroll
    for (int half = 0; half < 2; ++half) {
        bf16x8 qh[4], ql[4];
        { const float* qp = QP + (size_t)t * D + head * 128 + half * 64 + 8 * hi; asm volatile("" : "+v"(qp));
#pragma unroll
          for (int ks = 0; ks < 4; ++ks) split8(qp + 16 * ks, qh[ks], ql[ks]); }
        float cur[16];
#pragma unroll
        for (int kt = 0; kt < 4; ++kt) {
            f32x16 X = zero16();
            const LAS bf16* khp = KHL + (half * 128 + 32 * kt + r) * 72 + 8 * hi;
#pragma unroll
            for (int ks = 0; ks < 4; ++ks) {
                const bf16x8 kh = lds8(khp + 16 * ks), kl = lds8(khp + 2 * 128 * 72 + 16 * ks);
                X = MFMA32(kh, qh[ks], X); X = MFMA32(kh, ql[ks], X); X = MFMA32(kl, qh[ks], X);
            }
            float grp[16];
#pragma unroll
            for (int i = 0; i < 16; ++i) { const unsigned key = (unsigned)(32 * kt + crow(i, hi)); grp[i] = __uint_as_float((__float_as_uint(X[i]) & ~127u) | (127u - key)); }
            sort16_desc(grp);
            if (kt == 0) {
#pragma unroll
                for (int i = 0; i < 16; ++i) cur[i] = grp[i];
            } else merge16_desc(cur, grp);
        }
        float oth[16];
#pragma unroll
        for (int i = 0; i < 16; ++i) oth[i] = __shfl_xor(cur[i], 32);
        merge16_desc(cur, oth);
#pragma unroll
        for (int i = 0; i < 16; ++i) top[half][i] = cur[i];
    }
    unsigned P1[4], P2[4];
#pragma unroll
    for (int q = 0; q < 4; ++q) { P1[q] = 0u; P2[q] = 0u;
#pragma unroll
        for (int s = 0; s < 4; ++s) { P1[q] |= (127u - (__float_as_uint(top[0][4 * q + s]) & 127u)) << (8 * s); P2[q] |= (127u - (__float_as_uint(top[1][4 * q + s]) & 127u)) << (8 * s); } }
#define CAND(a, b) __uint_as_float((__float_as_uint(top[0][a] + top[1][b]) & ~255u) | (255u - (unsigned)((a) * 16 + (b))))
    float bk[16];
    {
        float gk[16];
        gk[0] = CAND(0, 0);
        gk[1] = CAND(0, 1);
        gk[2] = CAND(0, 2);
        gk[3] = CAND(0, 3);
        gk[4] = CAND(0, 4);
        gk[5] = CAND(0, 5);
        gk[6] = CAND(0, 6);
        gk[7] = CAND(0, 7);
        gk[8] = CAND(0, 8);
        gk[9] = CAND(0, 9);
        gk[10] = CAND(0, 10);
        gk[11] = CAND(0, 11);
        gk[12] = CAND(0, 12);
        gk[13] = CAND(0, 13);
        gk[14] = CAND(0, 14);
        gk[15] = CAND(0, 15);
        sort16_desc(gk);
#pragma unroll
        for (int i = 0; i < 16; ++i) bk[i] = gk[i];
    }
    {
        float gk[16];
        gk[0] = CAND(1, 0);
        gk[1] = CAND(1, 1);
        gk[2] = CAND(1, 2);
        gk[3] = CAND(1, 3);
        gk[4] = CAND(1, 4);
        gk[5] = CAND(1, 5);
        gk[6] = CAND(1, 6);
        gk[7] = CAND(1, 7);
        gk[8] = CAND(2, 0);
        gk[9] = CAND(2, 1);
        gk[10] = CAND(2, 2);
        gk[11] = CAND(2, 3);
        gk[12] = CAND(2, 4);
        gk[13] = CAND(3, 0);
        gk[14] = CAND(3, 1);
        gk[15] = CAND(3, 2);
        sort16_desc(gk);
        merge16_desc(bk, gk);
    }
    {
        float gk[16];
        gk[0] = CAND(3, 3);
        gk[1] = CAND(4, 0);
        gk[2] = CAND(4, 1);
        gk[3] = CAND(4, 2);
        gk[4] = CAND(5, 0);
        gk[5] = CAND(5, 1);
        gk[6] = CAND(6, 0);
        gk[7] = CAND(6, 1);
        gk[8] = CAND(7, 0);
        gk[9] = CAND(7, 1);
        gk[10] = CAND(8, 0);
        gk[11] = CAND(9, 0);
        gk[12] = CAND(10, 0);
        gk[13] = CAND(11, 0);
        gk[14] = CAND(12, 0);
        gk[15] = CAND(13, 0);
        sort16_desc(gk);
        merge16_desc(bk, gk);
    }
    {
        float gk[16];
        gk[0] = CAND(14, 0);
        gk[1] = CAND(15, 0);
        gk[2] = -INFINITY;
        gk[3] = -INFINITY;
        gk[4] = -INFINITY;
        gk[5] = -INFINITY;
        gk[6] = -INFINITY;
        gk[7] = -INFINITY;
        gk[8] = -INFINITY;
        gk[9] = -INFINITY;
        gk[10] = -INFINITY;
        gk[11] = -INFINITY;
        gk[12] = -INFINITY;
        gk[13] = -INFINITY;
        gk[14] = -INFINITY;
        gk[15] = -INFINITY;
        sort16_desc(gk);
        merge16_desc(bk, gk);
    }
#undef CAND
    int bv[16];
#pragma unroll
    for (int i = 0; i < 16; ++i) {
        const unsigned cd = 255u - (__float_as_uint(bk[i]) & 255u), ca = cd >> 4, cb = cd & 15u;
        const unsigned wa = (ca >> 2) == 0u ? P1[0] : (ca >> 2) == 1u ? P1[1] : (ca >> 2) == 2u ? P1[2] : P1[3];
        const unsigned wb = (cb >> 2) == 0u ? P2[0] : (cb >> 2) == 1u ? P2[1] : (cb >> 2) == 2u ? P2[2] : P2[3];
        bv[i] = (int)((((wa >> (8u * (ca & 3u))) & 255u) << 7) | ((wb >> (8u * (cb & 3u))) & 255u));
    }
    float e[16], se = 0.f;
#pragma unroll
    for (int i = 0; i < 16; ++i) { e[i] = __expf(bk[i] - bk[0]); se += e[i]; }
    const float inv = 1.f / se;
    if (hi == 0) {
        uint4* ip = (uint4*)(IDX + (size_t)t * 128 + head * 16); float4* gp = (float4*)(GATE + (size_t)t * 128 + head * 16);
#pragma unroll
        for (int q = 0; q < 2; ++q) ip[q] = make_uint4((unsigned)bv[8 * q] | ((unsigned)bv[8 * q + 1] << 16), (unsigned)bv[8 * q + 2] | ((unsigned)bv[8 * q + 3] << 16), (unsigned)bv[8 * q + 4] | ((unsigned)bv[8 * q + 5] << 16), (unsigned)bv[8 * q + 6] | ((unsigned)bv[8 * q + 7] << 16));
#pragma unroll
        for (int q = 0; q < 4; ++q) gp[q] = make_float4(e[4 * q] * inv, e[4 * q + 1] * inv, e[4 * q + 2] * inv, e[4 * q + 3] * inv);
    }
}

#define XB_TMO      128
#define XB_XCNT(j)  (256  + 64 * (j))
#define XB_XSUB(j)  (1280 + 64 * (j))
#define XB_XGEN(j)  (2304 + 64 * (j))
#define XB_TOP      3328
#define XB_TOPGEN   3392
#define XCD_BAR_WORDS 3456
#define XB_SPIN_CAP (1u << 22)
__device__ __forceinline__ unsigned xb_ld(unsigned* p)              { return __hip_atomic_load(p, __ATOMIC_RELAXED, __HIP_MEMORY_SCOPE_AGENT); }
__device__ __forceinline__ unsigned xb_add(unsigned* p, unsigned v) { return __hip_atomic_fetch_add(p, v, __ATOMIC_RELAXED, __HIP_MEMORY_SCOPE_AGENT); }
__device__ __forceinline__ unsigned xb_xcc_id() { return (unsigned)__builtin_amdgcn_s_getreg((3 << 11) | 20) & 0xFu; }
#define XB_SPIN(cond, bar) do { unsigned _sp = 0; while (cond) { __builtin_amdgcn_s_sleep(1); \
    if ((++_sp & 255u) == 0u) { if (xb_ld(&(bar)[XB_TMO])) break; if (_sp > XB_SPIN_CAP) { atomicAdd(&(bar)[XB_TMO], 1u); break; } } } } while (0)
struct XcdBarrier { unsigned* bar; unsigned x; volatile LAS unsigned* st; };
__device__ __forceinline__ XcdBarrier xcd_barrier_post(unsigned* bar, volatile LAS unsigned* st) {
    XcdBarrier b; b.bar = bar; b.x = xb_xcc_id(); b.st = st;
    if (threadIdx.x == 0) (void)xb_add(&bar[XB_XCNT(b.x)], 1u);
    return b;
}
__device__ __forceinline__ void xcd_barrier_complete(unsigned* bar, unsigned x, unsigned& nloc, unsigned& nx) {
    const unsigned G = gridDim.x * gridDim.y * gridDim.z;
    unsigned sum, cnt, mine, sp = 0u;
    for (;;) {
        sum = 0u; cnt = 0u; mine = 0u;
#pragma unroll
        for (unsigned j = 0; j < 16; ++j) { const unsigned c = xb_ld(&bar[XB_XCNT(j)]); sum += c; cnt += (c > 0u) ? 1u : 0u; mine = (j == x) ? c : mine; }
        if (sum == G) break;
        __builtin_amdgcn_s_sleep(1);
        if ((++sp & 255u) == 0u) { if (xb_ld(&bar[XB_TMO])) break; if (sp > XB_SPIN_CAP) { atomicAdd(&bar[XB_TMO], 1u); break; } }
    }
    nloc = mine > 0u ? mine : 1u; nx = cnt > 0u ? cnt : 1u;
}
__device__ __forceinline__ void xcd_barrier(const XcdBarrier& b) {
    asm volatile("s_waitcnt vmcnt(0)" ::: "memory");
    __syncthreads();
    if (threadIdx.x == 0) {
        unsigned* bar = b.bar;
        __builtin_amdgcn_s_waitcnt(0);
        unsigned nloc = b.st[0], nx = b.st[1];
        if (nloc == 0u) { xcd_barrier_complete(bar, b.x, nloc, nx); b.st[0] = nloc; b.st[1] = nx; }
        const unsigned old = xb_add(&bar[XB_XSUB(b.x)], 1u);
        const unsigned gen = old / nloc;
        if (old + 1u == (gen + 1u) * nloc) {
            __builtin_amdgcn_fence(__ATOMIC_RELEASE, "agent");
            asm volatile("s_waitcnt vmcnt(0)" ::: "memory");
            const unsigned og = xb_add(&bar[XB_TOP], 1u);
            const unsigned tg = og / nx;
            if (og + 1u == (tg + 1u) * nx) xb_add(&bar[XB_TOPGEN], 1u);
            else XB_SPIN(xb_ld(&bar[XB_TOPGEN]) == tg, bar);
            __builtin_amdgcn_fence(__ATOMIC_ACQUIRE, "agent");
            xb_add(&bar[XB_XGEN(b.x)], 1u);
            asm volatile("s_waitcnt vmcnt(0)" ::: "memory");
        } else {
            XB_SPIN(xb_ld(&bar[XB_XGEN(b.x)]) == gen, bar);
            __builtin_amdgcn_fence(__ATOMIC_ACQUIRE, "agent");
            asm volatile("s_waitcnt vmcnt(0)" ::: "memory");
        }
    }
    __syncthreads();
}
constexpr int LDS_BYTES = 147456;
constexpr int MISC_OFF = 131072 + 320;

__global__ void __launch_bounds__(NTHR, 2) k_main(Args a) {
    extern __shared__ __attribute__((aligned(16))) unsigned char lds_raw[];
    LAS unsigned char* ldsb = (LAS unsigned char*)lds_raw;
    const int tid0 = threadIdx.x, bid = blockIdx.x, nb = gridDim.x;
    const int wave = __builtin_amdgcn_readfirstlane(tid0 >> 6);
    const int gthreads = nb * NTHR, nwaves = gthreads >> 6;
#define PHASE_VARS() int tid = tid0; asm volatile("" : "+v"(tid)); const int lane = tid & 63, gtid = bid * NTHR + tid, gwave = gtid >> 6; (void)lane; (void)gtid; (void)gwave
    unsigned char* ws = a.ws;
    bf16* WINT = (bf16*)(ws + WS_WIN); bf16* WOT = (bf16*)(ws + WS_WO); bf16* WQT = (bf16*)(ws + WS_WQ);
    bf16* PROJ = (bf16*)(ws + WS_PROJ);
    bf16* XNB = (bf16*)(ws + WS_XNB);
    bf16* XACT = (bf16*)(ws + WS_XACT);
    float* DTRAW = (float*)(ws + WS_DTRAW); float* DT = (float*)(ws + WS_DT); float* ACS = (float*)(ws + WS_ACS); float* CDEC = (float*)(ws + WS_CDEC);
    float* STATES = (float*)(ws + WS_STATES); bf16* PREVT = (bf16*)(ws + WS_PREV);
    float* QP = (float*)(ws + WS_QP); unsigned short* IDX = (unsigned short*)(ws + WS_IDX); float* GATE = (float*)(ws + WS_GATE);
    float* TOPV = (float*)(ws + WS_TOPV); int* TOPI = (int*)(ws + WS_TOPI);
    unsigned char* U8 = ws + WS_U8; unsigned char* V8 = ws + WS_V8; float* SU = (float*)(ws + WS_SU); float* SV = SU + 16384; bf16* PART = (bf16*)(ws + WS_PART); unsigned char* XQ = ws + WS_XQ; float* XS = (float*)(ws + WS_XS);
    bf16* KH = (bf16*)(ws + WS_KH); bf16* KL = (bf16*)(ws + WS_KH + 65536);
    bf16* HB = (bf16*)(ws + WS_STATES);
    float* MIXF = a.out;
    volatile LAS unsigned* MISC = (volatile LAS unsigned*)(ldsb + MISC_OFF);
    if (tid0 < 32) MISC[tid0] = 0u;
    __syncthreads();
    XcdBarrier bar = xcd_barrier_post((unsigned*)ws, MISC + 8);
#define IN(k) (a.ph_lo <= (k) && (k) < a.ph_hi)
#if defined(PROBE_LO)
    int seg_ = 0; unsigned long long tseg_ = __builtin_amdgcn_s_memrealtime();
#define PROBE_SPIN() do { if (seg_ >= PROBE_LO && seg_ <= PROBE_HI) { const unsigned long long d_ = (__builtin_amdgcn_s_memrealtime() - tseg_) * PROBE_AMP; const unsigned long long s_ = __builtin_amdgcn_s_memrealtime(); \
        while (__builtin_amdgcn_s_memrealtime() - s_ < d_) __builtin_amdgcn_s_sleep(4); } } while (0)
#define GRID_BAR() do { PROBE_SPIN(); xcd_barrier(bar); tseg_ = __builtin_amdgcn_s_memrealtime(); ++seg_; } while (0)
#else
#define PROBE_SPIN() do { } while (0)
#define GRID_BAR() xcd_barrier(bar)
#endif

    if (IN(0)) {
        PHASE_VARS();
        LAS float* scr = (LAS float*)(ldsb + wave * 16384);
        constexpr int I_IN = 16 * 72, I_O = 16 * 32, NITEMS = I_IN + 2 * I_O;
        for (int it = gwave; it < NITEMS; it += nwaves) {
            int r = it;
            if (r < I_IN) { transpose_item(a.w_in, PW, D, WINT, scr, r / 72, r % 72, lane); continue; } r -= I_IN;
            if (r < I_O) { transpose_item(a.w_out, D, D, WOT, scr, r / 32, r % 32, lane); continue; } r -= I_O;
            transpose_item(a.peer_wq, D, D, WQT, scr, r / 32, r % 32, lane);
        }
        for (int i = gtid; i < 2 * 128 * 64; i += gthreads) { const float kf = a.peer_sub_keys[i]; const short h = bfs(kf); KH[i] = (bf16)h; KL[i] = (bf16)bfs(kf - sbf2f(h)); }
        for (int i = tid; i < 8 * 1024; i += NTHR) { const int h = i & 7, c = i >> 3; *(LAS float*)(ldsb + h * 16384 + 8448 + c * 4) = a.w_in[(size_t)c * PW + ODT + h]; }
        __syncthreads();
        rmsnorm_rows_bf16<1>(a.x, a.norm_mix_g, XNB, ldsb, DTRAW, nullptr, nullptr, gwave, nwaves, lane);
    }
    GRID_BAR();
    if (IN(1)) {
        PHASE_VARS();
        pg8::Gemm g{XNB, WINT, T, PS, D}; pg8::StaticOrder S; S.init(T, PS, nb, bid);
        pg8::EpiBf16Plain E{PROJ, PS};
        pg8::gemm_phase<pg8::EpiBf16Plain, pg8::StaticOrder>(ldsb, g, S, E, nullptr);
        const int cfirst = (nb == 256) ? 64 : 0;
        if (bid >= cfirst) for (int rr0 = ((bid - cfirst) * 8 + wave) * 4; rr0 < 2 * 16384; rr0 += (nb - cfirst) * 8 * 4) {
            float4 v[4][4];
#pragma unroll
            for (int q = 0; q < 4; ++q) { const int rr = rr0 + q, which = rr >> 14, row = rr & 16383;
                const float4* src4 = (const float4*)((which ? a.peer_v : a.peer_u) + (size_t)row * D) + lane;
#pragma unroll
                for (int jq = 0; jq < 4; ++jq) v[q][jq] = src4[64 * jq]; }
#pragma unroll
            for (int q = 0; q < 4; ++q) { const int rr = rr0 + q, which = rr >> 14, row = rr & 16383;
                float mx = 0.f;
#pragma unroll
                for (int jq = 0; jq < 4; ++jq) mx = fmaxf(mx, fmaxf(fmaxf(fabsf(v[q][jq].x), fabsf(v[q][jq].y)), fmaxf(fabsf(v[q][jq].z), fabsf(v[q][jq].w))));
#pragma unroll
                for (int o = 1; o < 64; o <<= 1) mx = fmaxf(mx, __shfl_xor(mx, o));
                const float sc = mx > 0.f ? mx * (1.f / 127.f) : 1.f, inv = 1.f / sc;
                unsigned* dst = (unsigned*)((which ? V8 : U8) + (size_t)row * D) + lane;
#pragma unroll
                for (int jq = 0; jq < 4; ++jq) { const int q0 = (int)rintf(v[q][jq].x * inv), q1 = (int)rintf(v[q][jq].y * inv), q2 = (int)rintf(v[q][jq].z * inv), q3 = (int)rintf(v[q][jq].w * inv);
                    dst[64 * jq] = (unsigned)(q0 & 255) | ((unsigned)(q1 & 255) << 8) | ((unsigned)(q2 & 255) << 16) | ((unsigned)(q3 & 255) << 24); }
                if (lane == 0) (which ? SV : SU)[row] = sc; }
        }
    }
    GRID_BAR();
    if (IN(3)) {
        PHASE_VARS();
        for (int u = bid; u < 512; u += nb) {
            if (u < 256) attn_unit(a.attn_sinks, a.attn_out_g, ldsb, u, PROJ, XNB, tid, lane, wave);
            else ssd_chunk_unit(ldsb, u - 256, PROJ, XACT, DTRAW, a.conv_w, a.conv_b, a.dt_bias, a.a_log, ACS, CDEC, MIXF, STATES, tid, lane, wave);
        }
    }
    GRID_BAR();
    if (IN(5)) {
        PHASE_VARS();
        for (int idx = gtid; idx < 2 * 8 * 8192; idx += gthreads) {
            const int pn = idx & 8191, h = (idx >> 13) & 7, b = idx >> 16;
            float run = 0.f;
#pragma unroll 1
            for (int c0 = 0; c0 < 64; c0 += 8) {
                float st[8], dc[8];
#pragma unroll
                for (int j = 0; j < 8; ++j) { const int bch = (b * 64 + c0 + j) * 8 + h; st[j] = STATES[(size_t)bch * 8192 + pn]; dc[j] = CDEC[bch]; }
#pragma unroll
                for (int j = 0; j < 8; ++j) { const int bch = (b * 64 + c0 + j) * 8 + h; PREVT[(size_t)bch * 8192 + pn] = f2bf(run); run = dc[j] * run + st[j]; }
            }
        }
    }
    GRID_BAR();
    if (IN(6)) {
        PHASE_VARS();
        for (int u = bid; u < 256; u += nb) yoff_unit(a.d_skip, a.ssm_norm_g, ldsb, u, XACT, PROJ, ACS, PREVT, MIXF, XNB, lane, wave);
    }
    GRID_BAR();
    if (IN(7)) {
        PHASE_VARS();
        pg8::Gemm g{XNB, WOT, T, D, D}; pg8::StaticOrder S; S.init(T, D, nb, bid);
        pg8::EpiBf16Resid E{HB, a.x, D};
        pg8::gemm_phase<pg8::EpiBf16Resid, pg8::StaticOrder>(ldsb, g, S, E, nullptr);
    }
    GRID_BAR();
    if (IN(8)) {
        PHASE_VARS();
        rmsnorm_rows_bf16<2>((const float*)HB, a.norm_ffn_g, XNB, ldsb, nullptr, XQ, XS, gwave, nwaves, lane);
    }
    GRID_BAR();
    if (IN(9)) {
        PHASE_VARS();
        pg8::Gemm g{XNB, WQT, T, D, D}; pg8::StaticOrder S; S.init(T, D, nb, bid);
        pg8::EpiF32Resid E{QP, nullptr, D};
        pg8::gemm_phase<pg8::EpiF32Resid, pg8::StaticOrder>(ldsb, g, S, E, nullptr);
    }
    GRID_BAR();
    if (IN(10)) {
        PHASE_VARS();
        LAS bf16* KHL = (LAS bf16*)ldsb;
        for (int i = tid; i < 2 * 2 * 128 * 8; i += NTHR) {
            const int pc = i & 7, key = (i >> 3) & 127, hf = (i >> 10) & 1, hl = i >> 11;
            *(LAS v4u*)(KHL + ((hl * 2 + hf) * 128 + key) * 72 + pc * 8) = *(const v4u*)((hl ? KL : KH) + (size_t)(hf * 128 + key) * 64 + pc * 8);
        }
        __syncthreads();
        for (int task = gwave; task < T / 4; task += nwaves) route_task(task, QP, KHL, IDX, GATE, lane);
        __syncthreads();
    }
    GRID_BAR();
    bf16* PEERO = (bf16*)(ws + WS_PEERO);
    if (IN(12)) {
        PHASE_VARS();
        LAS unsigned short* EL = (LAS unsigned short*)ldsb; LAS int* ACC = (LAS int*)(ldsb + 16384); LAS unsigned char* AL = (LAS unsigned char*)(ldsb + 49152); LAS float* ASC = (LAS float*)(ldsb + 57344);
#pragma unroll 1
        for (int j = bid; j < NCHUNK; j += nb) {
            __syncthreads();
            for (int i = tid; i < 64 * 16; i += NTHR) *(LAS v4u*)(EL + i * 8) = *(const v4u*)(IDX + (size_t)j * 64 * 128 + i * 8);
            __syncthreads();
#pragma unroll 1
            for (int p = 0; p < NPART; ++p) peer_u_item(p, j, EL, XQ, U8, ACC, lane, wave);
#pragma unroll 1
            for (int it = 0; it < 8; ++it) {
                const int tl = it * 8 + wave, t = j * 64 + tl;
                const unsigned ew = *(const LAS unsigned*)(EL + tl * 128 + 2 * lane); const int e0 = (int)(ew & 0xffffu), e1 = (int)(ew >> 16);
                typedef int i2v __attribute__((ext_vector_type(2))); const i2v si = *(const LAS i2v*)(ACC + tl * 128 + 2 * lane);
                const float2 gt = *(const float2*)(GATE + (size_t)t * 128 + 2 * lane); const float xs = XS[t];
                const float z0 = (float)si.x * SU[e0] * xs, z1 = (float)si.y * SU[e1] * xs;
                const float a0 = gt.x * 0.5f * z0 * (1.f + erff(z0 * 0.70710678118654752f)) * SV[e0], a1 = gt.y * 0.5f * z1 * (1.f + erff(z1 * 0.70710678118654752f)) * SV[e1];
                float mx = fmaxf(fabsf(a0), fabsf(a1));
#pragma unroll
                for (int o = 1; o < 64; o <<= 1) mx = fmaxf(mx, __shfl_xor(mx, o));
                const float sc = mx > 0.f ? mx * (1.f / 127.f) : 1.f, inv = 1.f / sc;
                *(LAS unsigned short*)(AL + tl * 128 + 2 * lane) = (unsigned short)(((int)rintf(a0 * inv) & 255) | (((int)rintf(a1 * inv) & 255) << 8));
                if (lane == 0) ASC[tl] = sc;
            }
#pragma unroll 1
            for (int p = 0; p < NPART; ++p) peer_v_item(p, j, EL, AL, ASC, V8, PEERO, lane, wave);
            asm volatile("s_waitcnt vmcnt(0)" ::: "memory");
#pragma unroll 1
            for (int it = 0; it < 8; ++it) {
                const int t = j * 64 + it * 8 + wave;
                const uint2* hr = (const uint2*)(HB + (size_t)t * D) + lane; unsigned long long* pr = (unsigned long long*)(PEERO + (size_t)t * D) + lane;
                float4 v[4]; float ss = 0.f;
#pragma unroll
                for (int jq = 0; jq < 4; ++jq) { const uint2 hw = hr[64 * jq]; const unsigned long long pw = __hip_atomic_load(pr + 64 * jq, __ATOMIC_RELAXED, __HIP_MEMORY_SCOPE_AGENT);
                    const unsigned pl = (unsigned)pw, ph = (unsigned)(pw >> 32);
                    v[jq] = make_float4(__uint_as_float(hw.x << 16) + __uint_as_float(pl << 16), __uint_as_float(hw.x & 0xffff0000u) + __uint_as_float(pl & 0xffff0000u),
                                        __uint_as_float(hw.y << 16) + __uint_as_float(ph << 16), __uint_as_float(hw.y & 0xffff0000u) + __uint_as_float(ph & 0xffff0000u));
                    ss += v[jq].x * v[jq].x + v[jq].y * v[jq].y + v[jq].z * v[jq].z + v[jq].w * v[jq].w; }
                ss = wave_sum(ss);
                const float r3 = rsqrtf(ss * (1.f / D) + EPS);
                float4* op = (float4*)(a.out + (size_t)t * D) + lane;
#pragma unroll
                for (int jq = 0; jq < 4; ++jq) { const float4 gv = ((const float4*)a.final_norm_g)[lane + 64 * jq]; op[64 * jq] = make_float4(v[jq].x * r3 * gv.x, v[jq].y * r3 * gv.y, v[jq].z * r3 * gv.z, v[jq].w * r3 * gv.w); }
            }
        }
    }
    PROBE_SPIN();
#undef IN
}
}

extern "C" void kernel_launch(void* const* d_in, const int* in_sizes, int n_in, void* d_out, int out_size, void* d_ws, size_t ws_size, hipStream_t stream) {
    if (n_in != 18 || out_size != T * D || ws_size < WS_END) { fprintf(stderr, "kernel_launch: unexpected shapes n_in=%d out=%d ws=%zu\n", n_in, out_size, ws_size); return; }
    Args a{};
    const float** ap = (const float**)&a;
    for (int i = 0; i < 18; ++i) ap[i] = (const float*)d_in[i];
    a.out = (float*)d_out; a.ws = (unsigned char*)d_ws;
    static int grid = 0;
    if (grid == 0) {
        int dev = 0, cus = 0, per_cu = 0;
        if (hipGetDevice(&dev) != hipSuccess || hipDeviceGetAttribute(&cus, hipDeviceAttributeMultiprocessorCount, dev) != hipSuccess) { fprintf(stderr, "kernel_launch: device query failed\n"); grid = -1; return; }
        if (hipFuncSetAttribute((const void*)k_main, hipFuncAttributeMaxDynamicSharedMemorySize, LDS_BYTES) != hipSuccess) { fprintf(stderr, "kernel_launch: hipFuncSetAttribute failed\n"); grid = -1; return; }
        if (hipOccupancyMaxActiveBlocksPerMultiprocessor(&per_cu, (const void*)k_main, NTHR, LDS_BYTES) != hipSuccess || per_cu < 1) { fprintf(stderr, "kernel_launch: occupancy query says %d blocks/CU\n", per_cu); (void)hipGetLastError(); grid = -1; return; }
        grid = cus;
    }
    if (grid < 0) return;
    if (hipMemsetAsync(d_ws, 0, 65536, stream) != hipSuccess) { fprintf(stderr, "kernel_launch: memset failed\n"); return; }
    a.ph_lo = 0; a.ph_hi = 13;
    hipLaunchKernelGGL(k_main, dim3(grid), dim3(NTHR), LDS_BYTES, stream, a);
}
```

```cpp
#include <hip/hip_runtime.h>
#include <cstdio>
#include <cstdint>


namespace pg8 {
#define PG8_LAS __attribute__((address_space(3)))
typedef unsigned short bf16_t;
typedef short bf16x8 __attribute__((ext_vector_type(8)));
typedef float f32x4 __attribute__((ext_vector_type(4)));
typedef unsigned u32x4 __attribute__((ext_vector_type(4)));
constexpr int BM = 256, BK = 64, HALF = 128, HTB = HALF * BK * 2  , STAGE_BYTES = 8 * HTB, NXCD = 8, WGM = 8;

__host__ __device__ __forceinline__ int lds_byte(int r, int c) { const int st = (r >> 4) * 2 + (c >> 5), rr = r & 15, cc = c & 31, ob = rr * 64 + cc * 2; return st * 1024 + (ob ^ (((ob >> 9) & 1) << 5)); }
__host__ __device__ __forceinline__ void stage_rc(int b, int& R, int& C) { const int st = b / 1024, sb = b % 1024, swz = sb ^ (((sb >> 9) & 1) << 5); R = (st >> 1) * 16 + swz / 64; C = (st & 1) * 32 + (swz % 64) / 2; }
__host__ __device__ __forceinline__ int perm32(int rho) { const int n = rho >> 4, i = rho & 15; return 8 * (i >> 2) + 4 * n + (i & 3); }

struct Unit { int pm, pn; };
struct Gemm { const bf16_t* A; const bf16_t* Bt; int M, N, K; };

struct StaticOrder {
    int nM, nN, nwg, G, c;
    __host__ __device__ void init(int M, int N, int G_, int c_) { nM = M / BM; nN = N / BM; nwg = nM * nN; G = G_; c = c_; }
    __host__ __device__ bool next(int i, Unit& u) const {
        const long L = (long)i * G + c; if (L >= nwg) return false;
        int wgid = (int)L; { const int q = nwg / NXCD, r = nwg % NXCD, xcd = wgid % NXCD, off = wgid / NXCD; wgid = (xcd < r ? xcd * (q + 1) : r * (q + 1) + (xcd - r) * q) + off; }
        const int nig = WGM * nN, gid = wgid / nig, fm = gid * WGM, gsz = (nM - fm) < WGM ? (nM - fm) : WGM;
        u.pm = fm + ((wgid % nig) % gsz); u.pn = (wgid % nig) / gsz; return true;
    }
    __device__ __forceinline__ void a_ready(const Unit&) const {}
    __device__ __forceinline__ void done(const Unit&) const {}
};
__device__ __forceinline__ unsigned cvt_pk_bf16(float lo, float hi) { unsigned r; asm volatile("v_cvt_pk_bf16_f32 %0, %1, %2" : "=v"(r) : "v"(lo), "v"(hi)); return r; }
typedef float f32x2 __attribute__((ext_vector_type(2)));
struct EpiBf16Plain {
    static constexpr bool PERM = true, AFTER_DRAIN = false;
    bf16_t* O; int ldc;
    __device__ __forceinline__ void operator()(const f32x4 (&acc)[2][2][4][2], const Unit& u, int wr, int wc, int fr, int fq) const {
        const int row0 = u.pm * BM + wr * 64 + fr, col0 = u.pn * BM + wc * 32 + 8 * fq;
#pragma unroll
        for (int ai = 0; ai < 2; ++ai)
#pragma unroll
            for (int m = 0; m < 4; ++m) { bf16_t* rowp = O + (size_t)(row0 + ai * HALF + m * 16) * ldc + col0;
#pragma unroll
                for (int bj = 0; bj < 2; ++bj) { const f32x4 v0 = acc[ai][bj][m][0], v1 = acc[ai][bj][m][1];
                    u32x4 w; w.x = cvt_pk_bf16(v0[0], v0[1]); w.y = cvt_pk_bf16(v0[2], v0[3]); w.z = cvt_pk_bf16(v1[0], v1[1]); w.w = cvt_pk_bf16(v1[2], v1[3]);
                    *(u32x4*)(rowp + bj * HALF) = w; } }
    }
};
struct EpiF32Resid {
    static constexpr bool PERM = false, AFTER_DRAIN = false;
    float* C; const float* R; int ldc;
    __device__ __forceinline__ void operator()(const f32x4 (&acc)[2][2][4][2], const Unit& u, int wr, int wc, int fr, int fq) const {
        const int row0 = u.pm * BM + wr * 64 + fr, col0 = u.pn * BM + wc * 32 + 4 * fq;
#pragma unroll
        for (int ai = 0; ai < 2; ++ai)
#pragma unroll
            for (int m = 0; m < 4; ++m) { const size_t off = (size_t)(row0 + ai * HALF + m * 16) * ldc + col0;
#pragma unroll
                for (int bj = 0; bj < 2; ++bj)
#pragma unroll
                    for (int n = 0; n < 2; ++n) { f32x4 v = acc[ai][bj][m][n]; if (R) v += *(const f32x4*)(R + off + bj * HALF + n * 16); *(f32x4*)(C + off + bj * HALF + n * 16) = v; }
                asm volatile("" ::: "memory"); }
    }
};

struct EpiBf16Resid {
    static constexpr bool PERM = true, AFTER_DRAIN = false;
    bf16_t* O; const float* R; int ldc;
    __device__ __forceinline__ void operator()(const f32x4 (&acc)[2][2][4][2], const Unit& u, int wr, int wc, int fr, int fq) const {
        const int row0 = u.pm * BM + wr * 64 + fr, col0 = u.pn * BM + wc * 32 + 8 * fq;
#pragma unroll
        for (int ai = 0; ai < 2; ++ai)
#pragma unroll
            for (int m = 0; m < 4; ++m) { const size_t off = (size_t)(row0 + ai * HALF + m * 16) * ldc + col0;
#pragma unroll
                for (int bj = 0; bj < 2; ++bj) { const f32x4 v0 = acc[ai][bj][m][0] + *(const f32x4*)(R + off + bj * HALF), v1 = acc[ai][bj][m][1] + *(const f32x4*)(R + off + bj * HALF + 4);
                    u32x4 w; w.x = cvt_pk_bf16(v0[0], v0[1]); w.y = cvt_pk_bf16(v0[2], v0[3]); w.z = cvt_pk_bf16(v1[0], v1[1]); w.w = cvt_pk_bf16(v1[2], v1[3]);
                    *(u32x4*)(O + off + bj * HALF) = w; }
                asm volatile("" ::: "memory"); }
    }
};
template <class Epi, class Sched, bool STAMP = false>
__device__ __forceinline__ void gemm_phase(PG8_LAS unsigned char* lds, const Gemm g, const Sched& S, const Epi& E, unsigned long long* stamps) {
    const int tid = threadIdx.x, wid = __builtin_amdgcn_readfirstlane(tid >> 6), lane = tid & 63, wr = wid >> 2, wc = wid & 3, fr = lane & 15, fq = lane >> 4;
    const int K = g.K, nt = K / BK;
    int ts_lo = 0, ts_hi = 0, nts = 0; const unsigned long long rt_entry = STAMP ? (unsigned long long)0ull : 0ull;
#define PG8_STAMP() do { if (STAMP && wid == 0 && nts < 64) { const unsigned long long _c = (unsigned long long)clock64(); \
        ts_lo = (lane == nts) ? (int)(unsigned)_c : ts_lo; ts_hi = (lane == nts) ? (int)(unsigned)(_c >> 32) : ts_hi; ++nts; } } while (0)
    PG8_STAMP();
    unsigned voffA[2], voffB[2];
#pragma unroll
    for (int i = 0; i < 2; ++i) { int R, C; stage_rc(tid * 16 + i * 8192, R, C); const int Rb = Epi::PERM ? ((R & ~31) + perm32(R & 31)) : R;
        voffA[i] = (unsigned)(R * K + C) * 2u; voffB[i] = (unsigned)(Rb * K + C) * 2u; }
    const size_t kstep = (size_t)(BK * 2);
    const size_t hstep = (size_t)HALF * K * 2;
    const size_t tstep = 2 * hstep;
    const unsigned ldsw = (unsigned)wid * 1024u;
    const int aoff = lds_byte(wr * 64 + fr, fq * 8), boff = lds_byte(wc * 32 + fr, fq * 8);
#define PG8_SA(b, h) (((b) * 2 + (h)) * HTB)
#define PG8_SB(b, h) ((4 + (b) * 2 + (h)) * HTB)
#define PG8_STAGE(bufoff, gbase, voff) do { _Pragma("unroll") for (int _i = 0; _i < 2; ++_i) \
        __builtin_amdgcn_global_load_lds((const unsigned*)((const char*)(gbase) + (voff)[_i]), (PG8_LAS unsigned*)(lds + (bufoff) + ldsw + _i * 8192), 16, 0, 0); } while (0)
#define PG8_LDA(dst, b, h) do { _Pragma("unroll") for (int m = 0; m < 4; ++m) _Pragma("unroll") for (int k = 0; k < 2; ++k) dst[m][k] = *(const PG8_LAS bf16x8*)(lds + PG8_SA(b, h) + aoff + m * 2048 + k * 1024); } while (0)
#define PG8_LDB(dst, b, h) do { _Pragma("unroll") for (int n = 0; n < 2; ++n) _Pragma("unroll") for (int k = 0; k < 2; ++k) dst[n][k] = *(const PG8_LAS bf16x8*)(lds + PG8_SB(b, h) + boff + n * 2048 + k * 1024); } while (0)
#define PG8_MMA(ai, bj, At, Bt) do { __builtin_amdgcn_s_setprio(1); _Pragma("unroll") for (int m = 0; m < 4; ++m) _Pragma("unroll") for (int n = 0; n < 2; ++n) _Pragma("unroll") for (int k = 0; k < 2; ++k) \
        acc[ai][bj][m][n] = __builtin_amdgcn_mfma_f32_16x16x32_bf16(Bt[n][k], At[m][k], acc[ai][bj][m][n], 0, 0, 0); __builtin_amdgcn_s_setprio(0); } while (0)
#define PG8_WAIT_V(n) asm volatile("s_waitcnt vmcnt(" #n ")" ::: "memory")
#define PG8_WAIT_L(n) asm volatile("s_waitcnt lgkmcnt(" #n ")" ::: "memory")
#define PG8_BAR __builtin_amdgcn_s_barrier()
#define PG8_SCHED __builtin_amdgcn_sched_barrier(0)
    Unit cur, nxt; int ui = 0;
    if (!S.next(0, cur)) return;
    f32x4 acc[2][2][4][2];
#pragma unroll
    for (int a = 0; a < 2; ++a)
#pragma unroll
        for (int b = 0; b < 2; ++b)
#pragma unroll
            for (int m = 0; m < 4; ++m)
#pragma unroll
                for (int n = 0; n < 2; ++n) acc[a][b][m][n] = (f32x4){0.f, 0.f, 0.f, 0.f};
    bf16x8 At[4][2], B0[2][2], B1[2][2];
    const char* cA = (const char*)g.A + (size_t)cur.pm * tstep; const char* cB = (const char*)g.Bt + (size_t)cur.pn * tstep;
    S.a_ready(cur);
    PG8_STAGE(PG8_SB(0, 0), cB, voffB); PG8_STAGE(PG8_SA(0, 0), cA, voffA); PG8_STAGE(PG8_SB(0, 1), cB + hstep, voffB); PG8_STAGE(PG8_SA(0, 1), cA + hstep, voffA);
    if (wr == 1) PG8_BAR;
    PG8_WAIT_V(4); PG8_BAR;
    PG8_STAGE(PG8_SB(1, 0), cB + kstep, voffB); PG8_STAGE(PG8_SA(1, 0), cA + kstep, voffA); PG8_STAGE(PG8_SB(1, 1), cB + hstep + kstep, voffB);
    PG8_WAIT_V(6); PG8_BAR;
    PG8_STAMP();
    for (;;) {
        const bool has_next = S.next(ui + 1, nxt);
        const char* nA = has_next ? (const char*)g.A + (size_t)nxt.pm * tstep : cA; const char* nB = has_next ? (const char*)g.Bt + (size_t)nxt.pn * tstep : cB;
        for (int t = 0; t < nt; t += 2) {
            const bool last = (t == nt - 2);
            const char* a1 = cA + (size_t)(t + 1) * kstep;
            const char* a2 = last ? nA : cA + (size_t)(t + 2) * kstep; const char* b2 = last ? nB : cB + (size_t)(t + 2) * kstep;
            const char* a3 = a2 + kstep; const char* b3 = b2 + kstep;
            if (last && has_next) S.a_ready(nxt);
            PG8_LDB(B0, 0, 0); PG8_SCHED; PG8_LDA(At, 0, 0); PG8_STAGE(PG8_SA(1, 1), a1 + hstep, voffA);
            PG8_WAIT_L(8); PG8_BAR; PG8_WAIT_L(0); PG8_MMA(0, 0, At, B0); PG8_BAR; PG8_SCHED;
            PG8_LDB(B1, 0, 1); PG8_STAGE(PG8_SB(0, 0), b2, voffB);
            PG8_BAR; PG8_WAIT_L(0); PG8_MMA(0, 1, At, B1); PG8_BAR;
            PG8_LDA(At, 0, 1); PG8_STAGE(PG8_SA(0, 0), a2, voffA);
            PG8_BAR; PG8_WAIT_L(0); PG8_MMA(1, 0, At, B0); PG8_BAR; PG8_SCHED;
            PG8_STAGE(PG8_SB(0, 1), b2 + hstep, voffB);
            PG8_WAIT_V(6); PG8_BAR; PG8_MMA(1, 1, At, B1); PG8_BAR;
            PG8_LDB(B0, 1, 0); PG8_SCHED; PG8_LDA(At, 1, 0); PG8_STAGE(PG8_SA(0, 1), a2 + hstep, voffA);
            PG8_WAIT_L(8); PG8_BAR; PG8_WAIT_L(0); PG8_MMA(0, 0, At, B0); PG8_BAR; PG8_SCHED;
            PG8_LDB(B1, 1, 1); PG8_STAGE(PG8_SB(1, 0), b3, voffB);
            PG8_BAR; PG8_WAIT_L(0); PG8_MMA(0, 1, At, B1); PG8_BAR;
            PG8_LDA(At, 1, 1); PG8_STAGE(PG8_SA(1, 0), a3, voffA);
            PG8_BAR; PG8_WAIT_L(0); PG8_MMA(1, 0, At, B0); PG8_BAR; PG8_SCHED;
            PG8_STAGE(PG8_SB(1, 1), b3 + hstep, voffB);
            PG8_WAIT_V(6); PG8_BAR; PG8_MMA(1, 1, At, B1); PG8_BAR;
        }
        PG8_STAMP();
        if constexpr (!Epi::AFTER_DRAIN) { E(acc, cur, wr, wc, fr, fq); S.done(cur); }
        PG8_STAMP();
        if (!has_next) break;
#pragma unroll
        for (int a = 0; a < 2; ++a)
#pragma unroll
            for (int b = 0; b < 2; ++b)
#pragma unroll
                for (int m = 0; m < 4; ++m)
#pragma unroll
                    for (int n = 0; n < 2; ++n) acc[a][b][m][n] = (f32x4){0.f, 0.f, 0.f, 0.f};
        cur = nxt; cA = nA; cB = nB; ++ui;
    }
    PG8_WAIT_V(0);
    if (wr == 0) PG8_BAR;
    PG8_BAR;
    if constexpr (Epi::AFTER_DRAIN) { E.fused(acc, cur, wr, wc, fr, fq, lds, wid, lane); S.done(cur); }
    PG8_STAMP();
    if (STAMP && wid == 0) { stamps[lane] = lane < nts ? (((unsigned long long)(unsigned)ts_hi << 32) | (unsigned)ts_lo) : 0ull;
        if (lane == 62) stamps[62] = rt_entry; if (lane == 63) stamps[63] = (unsigned long long)0ull; }
#undef PG8_STAMP
#undef PG8_SA
#undef PG8_SB
#undef PG8_STAGE
#undef PG8_LDA
#undef PG8_LDB
#undef PG8_MMA
#undef PG8_WAIT_V
#undef PG8_WAIT_L
#undef PG8_BAR
#undef PG8_SCHED
}
}

namespace {
constexpr int D = 1024, BATCH = 2, SEQ = 8192, T = BATCH * SEQ;
constexpr int PW = 2312;
constexpr int PS = 2304;
constexpr int OQ = 0, OKK = 512, OV = 640, OZ = 768, OXBC = 1280, ODT = 2304;
constexpr float EPS = 1e-6f;
constexpr int NTHR = 512;
typedef unsigned short bf16;
typedef unsigned v4u __attribute__((ext_vector_type(4)));

constexpr size_t MiB = 1u << 20;
constexpr size_t WS_WIN = 1 * MiB;
constexpr size_t WS_KH = 5 * MiB + 512 * 1024;
constexpr size_t WS_WO = 6 * MiB;
constexpr size_t WS_WQ = 8 * MiB;
constexpr size_t WS_PROJ = 10 * MiB;
constexpr size_t WS_XNB = 82 * MiB;
constexpr size_t WS_XACT = 114 * MiB;
constexpr size_t WS_DTRAW = 146 * MiB;
constexpr size_t WS_DT = WS_DTRAW + 512 * 1024;
constexpr size_t WS_ACS = WS_DT + 512 * 1024;
constexpr size_t WS_CDEC = WS_ACS + 512 * 1024;
constexpr size_t WS_STATES = 164 * MiB;
constexpr size_t WS_PREV = 196 * MiB;
constexpr size_t WS_QP = 10 * MiB;
constexpr size_t WS_IDX = 74 * MiB;
constexpr size_t WS_GATE = 114 * MiB;
constexpr size_t WS_TOPV = 122 * MiB;
constexpr size_t WS_TOPI = 138 * MiB;
constexpr size_t WS_ACT = 122 * MiB;
constexpr size_t WS_SU = 245 * MiB;
constexpr size_t WS_U8 = 212 * MiB;
constexpr size_t WS_V8 = 148 * MiB;
constexpr size_t WS_PART = 10 * MiB;
constexpr size_t WS_XQ = 228 * MiB;
constexpr size_t WS_XS = 244 * MiB;
constexpr size_t WS_PEERO = 10 * MiB;
constexpr size_t WS_END = 246 * MiB;
constexpr int CW_QU = 4096, CW_QV = 4096 + 64 * 16;
constexpr int NPART = 8, NCHUNK = T / 64;

struct Args {
    const float* x; const float* norm_mix_g; const float* w_in; const float* attn_sinks; const float* attn_out_g;
    const float* conv_w; const float* conv_b; const float* dt_bias; const float* a_log; const float* d_skip;
    const float* ssm_norm_g; const float* w_out; const float* norm_ffn_g; const float* peer_wq; const float* peer_sub_keys;
    const float* peer_u; const float* peer_v; const float* final_norm_g;
    float* out; unsigned char* ws;
    int ph_lo, ph_hi;
};

#define LAS __attribute__((address_space(3)))
#define LDS_WAIT() asm volatile("s_waitcnt lgkmcnt(0)" ::: "memory")
__device__ __forceinline__ float bf2f(bf16 v) { return __uint_as_float(((unsigned)v) << 16); }
__device__ __forceinline__ unsigned f2bfu(float f) { unsigned u = __float_as_uint(f); return (u + 0x7fffu + ((u >> 16) & 1u)) >> 16; }
__device__ __forceinline__ bf16 f2bf(float f) { return (bf16)f2bfu(f); }
__device__ __forceinline__ unsigned pk2(float lo, float hi) { return f2bfu(lo) | (f2bfu(hi) << 16); }
__device__ __forceinline__ float wave_sum(float v) {
#pragma unroll
    for (int o = 1; o < 64; o <<= 1) v += __shfl_xor(v, o);
    return v;
}
__device__ __forceinline__ float silu_f(float v) { return v / (1.f + __expf(-v)); }

__device__ __forceinline__ void transpose_item(const float* W, int ldw, int K, bf16* WT, LAS float* scr, int kb, int nbk, int lane) {
    const int k0 = 64 * kb, n0 = 32 * nbk;
#pragma unroll 8
    for (int i = 0; i < 32; ++i) { const int kk = 2 * i + (lane >> 5); scr[kk * 33 + (lane & 31)] = W[(size_t)(k0 + kk) * ldw + n0 + (lane & 31)]; }
    LDS_WAIT();
    const int c = lane & 7;
#pragma unroll
    for (int j = 0; j < 4; ++j) { const int n = (lane >> 3) + 8 * j; const LAS float* s = scr + (8 * c) * 33 + n;
        v4u o; o.x = pk2(s[0 * 33], s[1 * 33]); o.y = pk2(s[2 * 33], s[3 * 33]); o.z = pk2(s[4 * 33], s[5 * 33]); o.w = pk2(s[6 * 33], s[7 * 33]);
        *(v4u*)(WT + (size_t)(n0 + n) * K + k0 + 8 * c) = o; }
    LDS_WAIT();
}

template <int MODE  >
__device__ __forceinline__ void rmsnorm_rows_bf16(const float* __restrict__ in, const float* __restrict__ g, bf16* __restrict__ outp, const LAS unsigned char* ldsb, float* __restrict__ dtraw, unsigned char* __restrict__ xq, float* __restrict__ xs, int gwave, int nwaves, int lane) {
#pragma unroll 2
    for (int row = gwave; row < T; row += nwaves) {
        const float4* xr = (const float4*)(in + (size_t)row * D) + lane; const uint2* xb = (const uint2*)((const bf16*)in + (size_t)row * D) + lane;
        float4 v[4]; float ss = 0.f;
#pragma unroll
        for (int j = 0; j < 4; ++j) {
            if (MODE == 2) { const uint2 w = xb[64 * j]; v[j] = make_float4(__uint_as_float(w.x << 16), __uint_as_float(w.x & 0xffff0000u), __uint_as_float(w.y << 16), __uint_as_float(w.y & 0xffff0000u)); }
            else v[j] = xr[64 * j];
            ss += v[j].x * v[j].x + v[j].y * v[j].y + v[j].z * v[j].z + v[j].w * v[j].w; }
        ss = wave_sum(ss);
        const float r = rsqrtf(ss * (1.f / D) + EPS);
        unsigned long long* o8 = (unsigned long long*)(outp + (size_t)row * D) + lane;
        float dacc[8]; float y[4][4]; float mx = 0.f;
#pragma unroll
        for (int h = 0; h < 8; ++h) dacc[h] = 0.f;
#pragma unroll
        for (int j = 0; j < 4; ++j) {
            const float4 gv = ((const float4*)g)[lane + 64 * j];
            y[j][0] = v[j].x * r * gv.x; y[j][1] = v[j].y * r * gv.y; y[j][2] = v[j].z * r * gv.z; y[j][3] = v[j].w * r * gv.w;
            o8[64 * j] = (unsigned long long)pk2(y[j][0], y[j][1]) | ((unsigned long long)pk2(y[j][2], y[j][3]) << 32);
            if (MODE == 2) mx = fmaxf(mx, fmaxf(fmaxf(fabsf(y[j][0]), fabsf(y[j][1])), fmaxf(fabsf(y[j][2]), fabsf(y[j][3]))));
            if (MODE == 1) {
#pragma unroll
                for (int h = 0; h < 8; ++h) {
                    typedef float f4v __attribute__((ext_vector_type(4)));
                    const f4v wv = *(const LAS f4v*)(ldsb + h * 16384 + 8448 + (256 * j + 4 * lane) * 4);
                    dacc[h] += y[j][0] * wv.x + y[j][1] * wv.y + y[j][2] * wv.z + y[j][3] * wv.w;
                }
            }
        }
        if (MODE == 1) {
#pragma unroll
            for (int h = 0; h < 8; ++h) dacc[h] = wave_sum(dacc[h]);
            if (lane == 0) { float4* dp = (float4*)(dtraw + (size_t)row * 8); dp[0] = make_float4(dacc[0], dacc[1], dacc[2], dacc[3]); dp[1] = make_float4(dacc[4], dacc[5], dacc[6], dacc[7]); }
        }
        if (MODE == 2) {
#pragma unroll
            for (int o = 1; o < 64; o <<= 1) mx = fmaxf(mx, __shfl_xor(mx, o));
            const float sc = mx > 0.f ? mx * (1.f / 127.f) : 1.f, inv = 1.f / sc;
            unsigned* dq = (unsigned*)(xq + (size_t)row * D) + lane;
#pragma unroll
            for (int j = 0; j < 4; ++j) { const int q0 = (int)rintf(y[j][0] * inv), q1 = (int)rintf(y[j][1] * inv), q2 = (int)rintf(y[j][2] * inv), q3 = (int)rintf(y[j][3] * inv);
                dq[64 * j] = (unsigned)(q0 & 255) | ((unsigned)(q1 & 255) << 8) | ((unsigned)(q2 & 255) << 16) | ((unsigned)(q3 & 255) << 24); }
            if (lane == 0) xs[row] = sc;
        }
    }
}

typedef short bf16x8 __attribute__((ext_vector_type(8)));
typedef short bf16x4 __attribute__((ext_vector_type(4)));
typedef float f32x16 __attribute__((ext_vector_type(16)));
typedef __bf16 bf2_t __attribute__((ext_vector_type(2)));
#define MFMA32(a, b, c) __builtin_amdgcn_mfma_f32_32x32x16_bf16((a), (b), (c), 0, 0, 0)
__device__ __forceinline__ unsigned pkbf(float lo, float hi) { bf2_t v = {(__bf16)lo, (__bf16)hi}; return __builtin_bit_cast(unsigned, v); }
__device__ __forceinline__ short bfs(float f) { return __builtin_bit_cast(short, (__bf16)f); }
__device__ __forceinline__ float sbf2f(short v) { return __uint_as_float(((unsigned)(unsigned short)v) << 16); }
__device__ __forceinline__ int crow(int i, int hi) { return (i & 3) + 8 * (i >> 2) + 4 * hi; }
template <int S> __device__ __forceinline__ bf16x8 pack8(const f32x16& x) {
    v4u p; p.x = pkbf(x[8 * S], x[8 * S + 1]); p.y = pkbf(x[8 * S + 2], x[8 * S + 3]); p.z = pkbf(x[8 * S + 4], x[8 * S + 5]); p.w = pkbf(x[8 * S + 6], x[8 * S + 7]);
    return __builtin_bit_cast(bf16x8, p);
}
__device__ __forceinline__ bf16x8 ldg8(const bf16* p) { return *(const bf16x8*)p; }
__device__ __forceinline__ bf16x8 lds8(const LAS bf16* p) { return *(const LAS bf16x8*)p; }
__device__ __forceinline__ bf16x8 lds4x2(const LAS bf16* p) { const bf16x4 a = *(const LAS bf16x4*)p, b = *(const LAS bf16x4*)(p + 8); return __builtin_shufflevector(a, b, 0, 1, 2, 3, 4, 5, 6, 7); }
__device__ __forceinline__ f32x16 zero16() { f32x16 z;
#pragma unroll
    for (int i = 0; i < 16; ++i) z[i] = 0.f;
    return z; }

__device__ __forceinline__ void attn_unit(const float* sinks, const float* gnorm, LAS unsigned char* ldsb, int unit, const bf16* PROJ, bf16* MIXB, int tid, int lane, int wave) {
    asm volatile("" : "+v"(tid), "+v"(lane));
    const int tok0 = unit * 64, s0 = tok0 & (SEQ - 1), kbase = tok0 - 128;
    LAS bf16* VT = (LAS bf16*)ldsb;
    LAS bf16* KI = (LAS bf16*)(ldsb + 51200);
    LAS float* SSQ = (LAS float*)(ldsb + 51200 + 55296);
    const __amdgpu_buffer_rsrc_t rsP = __builtin_amdgcn_make_buffer_rsrc((void*)PROJ, 0, (unsigned)T * PS * 2u, 0x00020000);
#pragma unroll
    for (int i = 0; i < 6; ++i) {
        const int c = tid + 512 * i, kv = c / 1536, cc = c - kv * 1536, key = cc >> 3, d0 = (cc & 7) * 8; const bool valid = (s0 - 128 + key) >= 0;
        bf16x8 v, k;
#pragma unroll
        for (int e = 0; e < 8; ++e) { v[e] = 0; k[e] = 0; }
        if (valid) { const unsigned ro = (unsigned)(kbase + key) * (unsigned)PS + (unsigned)(kv * 64 + d0);
            v = __builtin_bit_cast(bf16x8, __builtin_amdgcn_raw_buffer_load_b128(rsP, (int)((ro + (unsigned)OV) * 2u), 0, 0));
            k = __builtin_bit_cast(bf16x8, __builtin_amdgcn_raw_buffer_load_b128(rsP, (int)((ro + (unsigned)OKK) * 2u), 0, 0)); }
#pragma unroll
        for (int e = 0; e < 8; ++e) VT[kv * 12800 + (d0 + e) * 200 + key] = (bf16)v[e];
        *(LAS bf16x8*)(KI + (kv * 192 + key) * 72 + d0) = k;
    }
    __syncthreads();
    const int r = lane & 31, hi = lane >> 5;
    const int hq = wave, hkv = wave >> 2;
    const float slope = exp2f(-(float)(hq + 1)), sink = sinks[hq];
#pragma unroll 1
    for (int qt = 0; qt < 2; ++qt) {
        const int tq = tok0 + 32 * qt + r;
        bf16x8 qf[4];
        { const bf16* qp = PROJ + (size_t)tq * PS + OQ + hq * 64 + 8 * hi; asm volatile("" : "+v"(qp));
#pragma unroll
          for (int ks = 0; ks < 4; ++ks) qf[ks] = ldg8(qp + 16 * ks); }
        const int ql = 32 * qt + r;
        float m = sink, lh = 0.f;
        f32x16 O0 = zero16(), O1 = zero16();
#pragma unroll 1
        for (int kt = 0; kt < 5; ++kt) {
            const LAS bf16* kp = KI + (hkv * 192 + 32 * (qt + kt) + r) * 72 + 8 * hi;
            f32x16 X = zero16();
#pragma unroll
            for (int ks = 0; ks < 4; ++ks) X = MFMA32(lds8(kp + 16 * ks), qf[ks], X);
            float tm = -1e30f;
#pragma unroll
            for (int i = 0; i < 16; ++i) {
                const int kl = 32 * (qt + kt) + crow(i, hi), dist = 128 + ql - kl;
                const bool valid = (dist >= 0) && (dist < 128) && ((s0 - 128 + kl) >= 0);
                const float lg = valid ? (X[i] * 0.125f - slope * (float)dist) : -1e30f;
                X[i] = lg; tm = fmaxf(tm, lg);
            }
            tm = fmaxf(tm, __shfl_xor(tm, 32));
            const float mn = fmaxf(m, tm), sc = __expf(m - mn);
            m = mn; lh *= sc;
#pragma unroll
            for (int i = 0; i < 16; ++i) { O0[i] *= sc; O1[i] *= sc; const float pe = __expf(X[i] - mn); X[i] = pe; lh += pe; }
            const LAS bf16* vp = VT + hkv * 12800 + r * 200 + 32 * (qt + kt) + 4 * hi;
            { const bf16x8 xs = pack8<0>(X); const bf16x8 a0 = lds4x2(vp), a1 = lds4x2(vp + 32 * 200); O0 = MFMA32(a0, xs, O0); O1 = MFMA32(a1, xs, O1); }
            { const bf16x8 xs = pack8<1>(X); const bf16x8 a0 = lds4x2(vp + 16), a1 = lds4x2(vp + 32 * 200 + 16); O0 = MFMA32(a0, xs, O0); O1 = MFMA32(a1, xs, O1); }
        }
        const float lsum = lh + __shfl_xor(lh, 32) + __expf(sink - m);
        const float iv = 1.f / lsum;
        float sq = 0.f;
#pragma unroll
        for (int i = 0; i < 16; ++i) sq += O0[i] * O0[i] + O1[i] * O1[i];
        sq *= iv * iv; sq += __shfl_xor(sq, 32);
        if (hi == 0) SSQ[hq * 32 + r] = sq;
        __syncthreads();
        float tot = 0.f;
#pragma unroll
        for (int h = 0; h < 8; ++h) tot += SSQ[h * 32 + r];
        const float sc = iv * rsqrtf(tot * (1.f / 512.f) + EPS);
        bf16* orow = MIXB + (size_t)tq * D + hq * 64 + 4 * hi;
#pragma unroll
        for (int q4 = 0; q4 < 4; ++q4) {
            const float4 g0 = *(const float4*)(gnorm + hq * 64 + 8 * q4 + 4 * hi), g1 = *(const float4*)(gnorm + hq * 64 + 32 + 8 * q4 + 4 * hi);
            uint2 w0, w1;
            w0.x = pkbf(O0[4 * q4] * sc * g0.x, O0[4 * q4 + 1] * sc * g0.y); w0.y = pkbf(O0[4 * q4 + 2] * sc * g0.z, O0[4 * q4 + 3] * sc * g0.w);
            w1.x = pkbf(O1[4 * q4] * sc * g1.x, O1[4 * q4 + 1] * sc * g1.y); w1.y = pkbf(O1[4 * q4 + 2] * sc * g1.z, O1[4 * q4 + 3] * sc * g1.w);
            *(uint2*)(orow + 8 * q4) = w0; *(uint2*)(orow + 32 + 8 * q4) = w1;
        }
        __syncthreads();
    }
}

__device__ __forceinline__ void ssd_chunk_unit(LAS unsigned char* ldsb, int unit, const bf16* PROJ, bf16* XACT, const float* DTRAW, const float* conv_w, const float* conv_b, const float* dt_bias, const float* a_log,
                                               float* ACS, float* CDEC, float* MIXF, float* STATES, int tid, int lane, int wave) {
    asm volatile("" : "+v"(tid), "+v"(lane));
    const int g = unit & 1, bc = unit >> 1, tok0 = bc * 128;
    LAS float* DTT = (LAS float*)(ldsb + 34816 * 3 + 2048);
    LAS float* WT = (LAS float*)(ldsb + 34816 * 3 + 4096);
    {
        const int cgi = tid & 63, t0 = tok0 + 16 * (tid >> 6);
        const int c0 = cgi < 32 ? g * 256 + cgi * 8 : (cgi < 48 ? 512 + g * 128 + (cgi - 32) * 8 : 768 + g * 128 + (cgi - 48) * 8);
        float w[4][8], bs[8];
#pragma unroll
        for (int k = 0; k < 4; ++k) { const float4 a0 = *(const float4*)(conv_w + k * 1024 + c0), a1 = *(const float4*)(conv_w + k * 1024 + c0 + 4);
            w[k][0] = a0.x; w[k][1] = a0.y; w[k][2] = a0.z; w[k][3] = a0.w; w[k][4] = a1.x; w[k][5] = a1.y; w[k][6] = a1.z; w[k][7] = a1.w; }
        { const float4 a0 = *(const float4*)(conv_b + c0), a1 = *(const float4*)(conv_b + c0 + 4); bs[0] = a0.x; bs[1] = a0.y; bs[2] = a0.z; bs[3] = a0.w; bs[4] = a1.x; bs[5] = a1.y; bs[6] = a1.z; bs[7] = a1.w; }
        const bool has_halo = (t0 & (SEQ - 1)) != 0;
        bf16x8 rows[19];
#pragma unroll
        for (int i = 0; i < 19; ++i) {
            if (i < 3 && !has_halo) {
#pragma unroll
                for (int e = 0; e < 8; ++e) rows[i][e] = 0;
            } else rows[i] = ldg8(PROJ + (size_t)(t0 + i - 3) * PS + OXBC + c0);
        }
#pragma unroll
        for (int i = 0; i < 16; ++i) {
            float o[8];
#pragma unroll
            for (int e = 0; e < 8; ++e) o[e] = silu_f(bs[e] + w[0][e] * sbf2f(rows[i][e]) + w[1][e] * sbf2f(rows[i + 1][e]) + w[2][e] * sbf2f(rows[i + 2][e]) + w[3][e] * sbf2f(rows[i + 3][e]));
            v4u ov; ov.x = pkbf(o[0], o[1]); ov.y = pkbf(o[2], o[3]); ov.z = pkbf(o[4], o[5]); ov.w = pkbf(o[6], o[7]);
            *(v4u*)(XACT + (size_t)(t0 + i) * 1024 + c0) = ov;
        }
    }
    LAS float* ACST = (LAS float*)(ldsb + 34816 * 3);
    {
        const int s = tid >> 2, hh = tid & 3, H = g * 4 + hh;
        const float A = -__expf(a_log[H]);
        const float raw = DTRAW[(size_t)(tok0 + s) * 8 + H] + dt_bias[H];
        const float dtv = fmaxf(raw, 0.f) + log1pf(__expf(-fabsf(raw)));
        float v = dtv * A;
#pragma unroll
        for (int o = 4; o < 64; o <<= 1) { const float y = __shfl_up(v, o); if (lane >= o) v += y; }
        if (lane >= 60) WT[wave * 4 + hh] = v;
        __syncthreads();
        float off = 0.f;
        for (int w2 = 0; w2 < wave; ++w2) off += WT[w2 * 4 + hh];
        v += off;
        DTT[tid] = dtv; ACST[tid] = v; ACS[(size_t)(tok0 + s) * 8 + H] = v;
        if (s == 127) CDEC[bc * 8 + H] = __expf(v);
    }
    asm volatile("s_waitcnt vmcnt(0)" ::: "memory");
    __syncthreads();
    LAS bf16* BT = (LAS bf16*)ldsb;
    LAS bf16* XD = (LAS bf16*)(ldsb + 34816);
    LAS bf16* XW = (LAS bf16*)(ldsb + 34816 + 34816);
    const int r = lane & 31, hi = lane >> 5;
#pragma unroll
    for (int i = 0; i < 4; ++i) {
        const int c = tid + 512 * i, s = c >> 4, n0 = (c & 15) * 8;
        const bf16x8 v = ldg8(XACT + (size_t)(tok0 + s) * 1024 + 512 + g * 128 + n0);
#pragma unroll
        for (int e = 0; e < 8; ++e) BT[(n0 + e) * 136 + s] = (bf16)v[e];
    }
#pragma unroll 1
    for (int hp = 0; hp < 2; ++hp) {
        if (hp) __syncthreads();
        int tidp = tid; asm volatile("" : "+v"(tidp));
#pragma unroll
        for (int i = 0; i < 4; ++i) {
            const int c = tidp + 512 * i, hsel = c >> 10, s = (c >> 3) & 127, p0 = (c & 7) * 8, H = g * 4 + 2 * hp + hsel;
            const bf16x8 v = ldg8(XACT + (size_t)(tok0 + s) * 1024 + H * 64 + p0);
            const float dtv = DTT[s * 4 + 2 * hp + hsel];
            const float w = __expf(ACST[127 * 4 + 2 * hp + hsel] - ACST[s * 4 + 2 * hp + hsel]);
#pragma unroll
            for (int e = 0; e < 8; ++e) { const float xd = sbf2f(v[e]) * dtv; XD[hsel * 8704 + (p0 + e) * 136 + s] = (bf16)bfs(xd); XW[hsel * 8704 + (p0 + e) * 136 + s] = (bf16)bfs(xd * w); }
        }
        __syncthreads();
        {
            const int lt = wave & 3, hsel = wave >> 2, hh = 2 * hp + hsel, H = g * 4 + hh;
            const int l = 32 * lt + r; const float acs_l = ACST[l * 4 + hh];
            bf16x8 cf[8];
            { const bf16* cp = XACT + (size_t)(tok0 + l) * 1024 + 768 + g * 128 + 8 * hi; asm volatile("" : "+v"(cp));
#pragma unroll
              for (int ks = 0; ks < 8; ++ks) cf[ks] = ldg8(cp + 16 * ks); }
            f32x16 Z0 = zero16(), Z1 = zero16();
            bf16x8 bn[8];
            { const bf16* bp = XACT + (size_t)(tok0 + r) * 1024 + 512 + g * 128 + 8 * hi; asm volatile("" : "+v"(bp));
#pragma unroll
              for (int ks = 0; ks < 8; ++ks) bn[ks] = ldg8(bp + 16 * ks); }
#pragma unroll 1
            for (int st = 0; st <= lt; ++st) {
                f32x16 X = zero16();
                bf16x8 bc[8];
#pragma unroll
                for (int ks = 0; ks < 8; ++ks) bc[ks] = bn[ks];
                { const int stn = st < lt ? st + 1 : lt; const bf16* bp = XACT + (size_t)(tok0 + 32 * stn + r) * 1024 + 512 + g * 128 + 8 * hi; asm volatile("" : "+v"(bp));
#pragma unroll
                  for (int ks = 0; ks < 8; ++ks) bn[ks] = ldg8(bp + 16 * ks); }
#pragma unroll
                for (int ks = 0; ks < 8; ++ks) X = MFMA32(bc[ks], cf[ks], X);
#pragma unroll
                for (int i = 0; i < 16; ++i) { const int s = 32 * st + crow(i, hi); const float f = (s <= l) ? __expf(acs_l - ACST[s * 4 + hh]) : 0.f; X[i] *= f; }
                const int sb = 32 * st + 4 * hi;
                { const bf16x8 xs = pack8<0>(X); const bf16x8 b0 = lds4x2(XD + hsel * 8704 + r * 136 + sb), b1 = lds4x2(XD + hsel * 8704 + (32 + r) * 136 + sb); Z0 = MFMA32(xs, b0, Z0); Z1 = MFMA32(xs, b1, Z1); }
                { const bf16x8 xs = pack8<1>(X); const bf16x8 b0 = lds4x2(XD + hsel * 8704 + r * 136 + sb + 16), b1 = lds4x2(XD + hsel * 8704 + (32 + r) * 136 + sb + 16); Z0 = MFMA32(xs, b0, Z0); Z1 = MFMA32(xs, b1, Z1); }
            }
#pragma unroll
            for (int i = 0; i < 16; ++i) { float* o = MIXF + (size_t)(tok0 + 32 * lt + crow(i, hi)) * D + 512 + H * 64 + r; o[0] = Z0[i]; o[32] = Z1[i]; }
        }
        {
            const int nt = wave & 3, hsel = wave >> 2, H = g * 4 + 2 * hp + hsel;
            f32x16 S0 = zero16(), S1 = zero16();
#pragma unroll
            for (int ks = 0; ks < 8; ++ks) {
                const bf16x8 btf = lds8(BT + (32 * nt + r) * 136 + 16 * ks + 8 * hi);
                const bf16x8 a0 = lds8(XW + hsel * 8704 + r * 136 + 16 * ks + 8 * hi), a1 = lds8(XW + hsel * 8704 + (32 + r) * 136 + 16 * ks + 8 * hi);
                S0 = MFMA32(a0, btf, S0); S1 = MFMA32(a1, btf, S1);
            }
            float* sp = STATES + (size_t)(bc * 8 + H) * 8192 + 32 * nt + r;
#pragma unroll
            for (int i = 0; i < 16; ++i) { const int p = crow(i, hi); sp[p * 128] = S0[i]; sp[(32 + p) * 128] = S1[i]; }
        }
    }
    __syncthreads();
}

__device__ __forceinline__ __amdgpu_buffer_rsrc_t mk_rsrc(const void* p, unsigned bytes) { return __builtin_amdgcn_make_buffer_rsrc((void*)p, 0, bytes, 0x00020000); }
__device__ __forceinline__ void yoff_unit(const float* d_skip, const float* gnorm, LAS unsigned char* ldsb, int unit, const bf16* XACT, const bf16* PROJ, const float* ACS, const bf16* PREVT,
                                          const float* MIXF, bf16* MIXB, int lane, int wave) {
    const int g = unit & 1, bc = unit >> 1, tok0 = bc * 128;
    const int r = lane & 31, hi = lane >> 5, lt = wave & 3, hpair = wave >> 2;
    LAS float* TAB = (LAS float*)ldsb;
    const __amdgpu_buffer_rsrc_t rsF = mk_rsrc(MIXF, (unsigned)T * D * 4u), rsX = mk_rsrc(XACT, (unsigned)T * 1024u * 2u), rsP = mk_rsrc(PROJ, (unsigned)T * PS * 2u), rsA = mk_rsrc(ACS, (unsigned)T * 32u), rsB = mk_rsrc(MIXB, (unsigned)T * D * 2u);
    const unsigned tb = (unsigned)(tok0 + 32 * lt + 4 * hi);
    bf16x8 cf[8];
    { const bf16* cp = XACT + (size_t)(tok0 + 32 * lt + r) * 1024 + 768 + g * 128 + 8 * hi; asm volatile("" : "+v"(cp));
#pragma unroll
      for (int ks = 0; ks < 8; ++ks) cf[ks] = ldg8(cp + 16 * ks); }
    float eav[16], ssq[16];
    unsigned ypk[2][2][8];
#pragma unroll
    for (int i = 0; i < 16; ++i) ssq[i] = 0.f;
#pragma unroll
    for (int hsel = 0; hsel < 2; ++hsel) {
        const int H = g * 4 + 2 * hpair + hsel; const bf16* pv = PREVT + (size_t)(bc * 8 + H) * 8192 + 8 * hi;
        asm volatile("" : "+v"(pv));
        f32x16 Y0 = zero16(), Y1 = zero16();
#pragma unroll
        for (int ks = 0; ks < 8; ++ks) {
            const bf16x8 b0 = ldg8(pv + r * 128 + 16 * ks), b1 = ldg8(pv + (32 + r) * 128 + 16 * ks);
            Y0 = MFMA32(cf[ks], b0, Y0); Y1 = MFMA32(cf[ks], b1, Y1);
        }
        const float dsk = d_skip[H];
        { const unsigned vo = (tb * 8u + (unsigned)H) * 4u;
#pragma unroll
          for (int i = 0; i < 16; ++i) eav[i] = __expf(__builtin_bit_cast(float, __builtin_amdgcn_raw_buffer_load_b32(rsA, (int)vo, ((i & 3) + 8 * (i >> 2)) * 32, 0))); }
#pragma unroll
        for (int pt = 0; pt < 2; ++pt) {
            const unsigned col = (unsigned)(H * 64 + 32 * pt + r);
            const unsigned voF = (tb * 1024u + 512u + col) * 4u, voX = (tb * 1024u + col) * 2u, voP = (tb * (unsigned)PS + (unsigned)OZ + col) * 2u;
            float yo[16], xsv[16], zv[16];
#pragma unroll
            for (int i = 0; i < 16; ++i) { const int ro = (i & 3) + 8 * (i >> 2);
                yo[i] = __builtin_bit_cast(float, __builtin_amdgcn_raw_buffer_load_b32(rsF, (int)voF, ro * 4096, 0));
                xsv[i] = bf2f((bf16)__builtin_amdgcn_raw_buffer_load_b16(rsX, (int)voX, ro * 2048, 0));
                zv[i] = bf2f((bf16)__builtin_amdgcn_raw_buffer_load_b16(rsP, (int)voP, ro * (PS * 2), 0)); }
#pragma unroll
            for (int i = 0; i < 16; i += 2) {
                const float y0 = (yo[i] + eav[i] * (pt ? Y1[i] : Y0[i]) + dsk * xsv[i]) * silu_f(zv[i]);
                const float y1 = (yo[i + 1] + eav[i + 1] * (pt ? Y1[i + 1] : Y0[i + 1]) + dsk * xsv[i + 1]) * silu_f(zv[i + 1]);
                ssq[i] += y0 * y0; ssq[i + 1] += y1 * y1; ypk[hsel][pt][i >> 1] = pkbf(y0, y1);
            }
            __builtin_amdgcn_sched_barrier(0);
        }
    }
#pragma unroll
    for (int i = 0; i < 16; ++i) {
#pragma unroll
        for (int o = 1; o < 32; o <<= 1) ssq[i] += __shfl_xor(ssq[i], o);
    }
    if (r == 0) {
#pragma unroll
        for (int i = 0; i < 16; ++i) TAB[hpair * 128 + 32 * lt + crow(i, hi)] = ssq[i];
    }
    __syncthreads();
#pragma unroll
    for (int i = 0; i < 16; ++i) { const int l = 32 * lt + crow(i, hi); ssq[i] = rsqrtf((TAB[l] + TAB[128 + l]) * (1.f / 256.f) + EPS); }
#pragma unroll
    for (int hsel = 0; hsel < 2; ++hsel)
#pragma unroll
        for (int pt = 0; pt < 2; ++pt) {
            const unsigned col = (unsigned)((g * 4 + 2 * hpair + hsel) * 64 + 32 * pt + r); const float gn = gnorm[col];
            const unsigned voB = (tb * 1024u + 512u + col) * 2u;
#pragma unroll
            for (int i = 0; i < 16; ++i) { const unsigned w = ypk[hsel][pt][i >> 1];
                const float yf = (i & 1) ? __uint_as_float(w & 0xffff0000u) : __uint_as_float(w << 16);
                __builtin_amdgcn_raw_buffer_store_b16((short)f2bf(yf * ssq[i] * gn), rsB, (int)voB, ((i & 3) + 8 * (i >> 2)) * 2048, 0); }
        }
    __syncthreads();
}
typedef float f32x2 __attribute__((ext_vector_type(2)));
__device__ __forceinline__ void fp8x16_to_f32(const uint4 w, float (&f)[16]) {
    const int ww[4] = {(int)w.x, (int)w.y, (int)w.z, (int)w.w};
#pragma unroll
    for (int q = 0; q < 4; ++q) { const f32x2 a = __builtin_amdgcn_cvt_pk_f32_fp8(ww[q], false), b = __builtin_amdgcn_cvt_pk_f32_fp8(ww[q], true); f[4 * q] = a.x; f[4 * q + 1] = a.y; f[4 * q + 2] = b.x; f[4 * q + 3] = b.y; }
}
template <int M4, int M2, int M1> __device__ __forceinline__ void treduce16(const float (&a)[16], int lane, float& r0, float& r1) {
    float b[8], c[4];
    { const bool hi = (lane & M4) != 0;
#pragma unroll
      for (int i = 0; i < 8; ++i) { const float send = hi ? a[i] : a[i + 8]; const float recv = __shfl_xor(send, M4); b[i] = (hi ? a[i + 8] : a[i]) + recv; } }
    { const bool hi = (lane & M2) != 0;
#pragma unroll
      for (int i = 0; i < 4; ++i) { const float send = hi ? b[i] : b[i + 4]; const float recv = __shfl_xor(send, M2); c[i] = (hi ? b[i + 4] : b[i]) + recv; } }
    { const bool hi = (lane & M1) != 0;
      { const float send = hi ? c[0] : c[2]; const float recv = __shfl_xor(send, M1); r0 = (hi ? c[2] : c[0]) + recv; }
      { const float send = hi ? c[1] : c[3]; const float recv = __shfl_xor(send, M1); r1 = (hi ? c[3] : c[1]) + recv; } }
}
template <int M4, int M2, int M1> __device__ __forceinline__ void treduce16i(const int (&a)[16], int lane, int& r0, int& r1) {
    int b[8], c[4];
    { const bool hi = (lane & M4) != 0;
#pragma unroll
      for (int i = 0; i < 8; ++i) { const int send = hi ? a[i] : a[i + 8]; const int recv = __shfl_xor(send, M4); b[i] = (hi ? a[i + 8] : a[i]) + recv; } }
    { const bool hi = (lane & M2) != 0;
#pragma unroll
      for (int i = 0; i < 4; ++i) { const int send = hi ? b[i] : b[i + 4]; const int recv = __shfl_xor(send, M2); c[i] = (hi ? b[i + 4] : b[i]) + recv; } }
    { const bool hi = (lane & M1) != 0;
      { const int send = hi ? c[0] : c[2]; const int recv = __shfl_xor(send, M1); r0 = (hi ? c[2] : c[0]) + recv; }
      { const int send = hi ? c[1] : c[3]; const int recv = __shfl_xor(send, M1); r1 = (hi ? c[3] : c[1]) + recv; } }
}
#define PE_ID(E, i) (((i) & 1) ? (E[(i) >> 1] >> 16) : (E[(i) >> 1] & 0xffffu))
__device__ __forceinline__ void peer_u_item(int p, int j, const LAS unsigned short* EL  , const unsigned char* __restrict__ XQ, const unsigned char* __restrict__ U8, LAS int* ACC  , int lane, int wave) {
    asm volatile("" : "+v"(lane));
    const int gidx = lane >> 3; const unsigned coff = (unsigned)(p * 128 + (lane & 7) * 16);
#pragma unroll 1
    for (int it = 0; it < 8; ++it) {
        const int t = j * 64 + it * 8 + wave;
        unsigned E[8];
        { const LAS v4u* ep = (const LAS v4u*)(EL + (it * 8 + wave) * 128 + 16 * gidx); const v4u e0 = ep[0], e1 = ep[1];
          E[0] = e0.x; E[1] = e0.y; E[2] = e0.z; E[3] = e0.w; E[4] = e1.x; E[5] = e1.y; E[6] = e1.z; E[7] = e1.w; }
        uint4 uu[16];
#pragma unroll
        for (int i = 0; i < 16; ++i) uu[i] = *(const uint4*)(U8 + (size_t)(PE_ID(E, i) * 1024u + coff));
        const uint4 xq = *(const uint4*)(XQ + (size_t)t * D + coff);
        int d[16];
#pragma unroll
        for (int i = 0; i < 16; ++i) {
            int s = __builtin_amdgcn_sdot4((int)uu[i].x, (int)xq.x, 0, false); s = __builtin_amdgcn_sdot4((int)uu[i].y, (int)xq.y, s, false);
            s = __builtin_amdgcn_sdot4((int)uu[i].z, (int)xq.z, s, false); s = __builtin_amdgcn_sdot4((int)uu[i].w, (int)xq.w, s, false);
            d[i] = s;
        }
        int r0, r1; treduce16i<4, 2, 1>(d, lane, r0, r1);
        { typedef int i2v __attribute__((ext_vector_type(2))); LAS i2v* ap = (LAS i2v*)(ACC + (it * 8 + wave) * 128 + 2 * lane);
          i2v a2; if (p == 0) { a2.x = r0; a2.y = r1; } else { a2 = *ap; a2.x += r0; a2.y += r1; } *ap = a2; }
    }
}
__device__ __forceinline__ void peer_v_item(int p, int j, const LAS unsigned short* EL, const LAS unsigned char* AL  , const LAS float* ASC  ,
                                            const unsigned char* __restrict__ V8, bf16* __restrict__ PEERO, int lane, int wave) {
    asm volatile("" : "+v"(lane));
    const int gidx = lane >> 3; const unsigned coff = (unsigned)(p * 128 + (lane & 7) * 16);
#pragma unroll 1
    for (int it = 0; it < 8; ++it) {
        const int t = j * 64 + it * 8 + wave;
        unsigned E[8];
        { const LAS v4u* ep = (const LAS v4u*)(EL + (it * 8 + wave) * 128 + 16 * gidx); const v4u e0 = ep[0], e1 = ep[1];
          E[0] = e0.x; E[1] = e0.y; E[2] = e0.z; E[3] = e0.w; E[4] = e1.x; E[5] = e1.y; E[6] = e1.z; E[7] = e1.w; }
        uint4 vv[16];
#pragma unroll
        for (int i = 0; i < 16; ++i) vv[i] = *(const uint4*)(V8 + (size_t)(PE_ID(E, i) * 1024u + coff));
        const v4u aq = *(const LAS v4u*)(AL + (it * 8 + wave) * 128 + 16 * gidx);
        const float asc = ASC[it * 8 + wave];
        const unsigned a4[4] = {aq.x, aq.y, aq.z, aq.w};
        int acc[16];
#pragma unroll
        for (int c = 0; c < 16; ++c) acc[c] = 0;
#pragma unroll
        for (int m = 0; m < 4; ++m) {
            const unsigned r0[4] = {vv[4 * m].x, vv[4 * m].y, vv[4 * m].z, vv[4 * m].w}, r1[4] = {vv[4 * m + 1].x, vv[4 * m + 1].y, vv[4 * m + 1].z, vv[4 * m + 1].w};
            const unsigned r2[4] = {vv[4 * m + 2].x, vv[4 * m + 2].y, vv[4 * m + 2].z, vv[4 * m + 2].w}, r3[4] = {vv[4 * m + 3].x, vv[4 * m + 3].y, vv[4 * m + 3].z, vv[4 * m + 3].w};
#pragma unroll
            for (int dc = 0; dc < 4; ++dc) {
                const unsigned ta = __builtin_amdgcn_perm(r1[dc], r0[dc], 0x05010400u), tb = __builtin_amdgcn_perm(r3[dc], r2[dc], 0x05010400u);
                const unsigned ua = __builtin_amdgcn_perm(r1[dc], r0[dc], 0x07030602u), ub = __builtin_amdgcn_perm(r3[dc], r2[dc], 0x07030602u);
                const unsigned c0 = __builtin_amdgcn_perm(tb, ta, 0x05040100u), c1 = __builtin_amdgcn_perm(tb, ta, 0x07060302u);
                const unsigned c2 = __builtin_amdgcn_perm(ub, ua, 0x05040100u), c3 = __builtin_amdgcn_perm(ub, ua, 0x07060302u);
                acc[4 * dc + 0] = __builtin_amdgcn_sdot4((int)c0, (int)a4[m], acc[4 * dc + 0], false);
                acc[4 * dc + 1] = __builtin_amdgcn_sdot4((int)c1, (int)a4[m], acc[4 * dc + 1], false);
                acc[4 * dc + 2] = __builtin_amdgcn_sdot4((int)c2, (int)a4[m], acc[4 * dc + 2], false);
                acc[4 * dc + 3] = __builtin_amdgcn_sdot4((int)c3, (int)a4[m], acc[4 * dc + 3], false);
            }
        }
        int r0i, r1i; treduce16i<32, 16, 8>(acc, lane, r0i, r1i);
        *(unsigned*)(PEERO + (size_t)t * D + coff + 2 * gidx) = pkbf(asc * (float)r0i, asc * (float)r1i);
    }
}

__device__ __forceinline__ void ce_desc(float& a, float& b) { const float hi = fmaxf(a, b), lo = fminf(a, b); a = hi; b = lo; }
__device__ __forceinline__ void sort16_desc(float (&v)[16]) {
#pragma unroll
    for (int k = 2; k <= 16; k <<= 1)
#pragma unroll
        for (int j = k >> 1; j > 0; j >>= 1)
#pragma unroll
            for (int i = 0; i < 16; ++i) { const int l = i ^ j; if (l > i) { if ((i & k) == 0) ce_desc(v[i], v[l]); else ce_desc(v[l], v[i]); } }
}
__device__ __forceinline__ void merge16_desc(float (&a)[16], const float (&b)[16]) {
#pragma unroll
    for (int i = 0; i < 16; ++i) a[i] = fmaxf(a[i], b[15 - i]);
#pragma unroll
    for (int j = 8; j > 0; j >>= 1)
#pragma unroll
        for (int i = 0; i < 16; ++i) { const int l = i ^ j; if (l > i) ce_desc(a[i], a[l]); }
}
__device__ __forceinline__ void ce_kv(float& ka, int& va, float& kb, int& vb) {
    const bool s = kb > ka; const float t0 = s ? kb : ka, t1 = s ? ka : kb; const int u0 = s ? vb : va, u1 = s ? va : vb; ka = t0; kb = t1; va = u0; vb = u1; }
__device__ __forceinline__ void sort16_kv(float (&k)[16], int (&v)[16]) {
#pragma unroll
    for (int kk = 2; kk <= 16; kk <<= 1)
#pragma unroll
        for (int j = kk >> 1; j > 0; j >>= 1)
#pragma unroll
            for (int i = 0; i < 16; ++i) { const int l = i ^ j; if (l > i) { if ((i & kk) == 0) ce_kv(k[i], v[i], k[l], v[l]); else ce_kv(k[l], v[l], k[i], v[i]); } }
}
__device__ __forceinline__ void merge16_kv(float (&ka)[16], int (&va)[16], const float (&kb)[16], const int (&vb)[16]) {
#pragma unroll
    for (int i = 0; i < 16; ++i) { const bool s = kb[15 - i] > ka[i]; ka[i] = s ? kb[15 - i] : ka[i]; va[i] = s ? vb[15 - i] : va[i]; }
#pragma unroll
    for (int j = 8; j > 0; j >>= 1)
#pragma unroll
        for (int i = 0; i < 16; ++i) { const int l = i ^ j; if (l > i) ce_kv(ka[i], va[i], ka[l], va[l]); }
}
__device__ __forceinline__ void split8(const float* p, bf16x8& hi8, bf16x8& lo8) {
    const float4 f0 = *(const float4*)p, f1 = *(const float4*)(p + 4);
    const float x[8] = {f0.x, f0.y, f0.z, f0.w, f1.x, f1.y, f1.z, f1.w};
#pragma unroll
    for (int j = 0; j < 8; ++j) { const short h = bfs(x[j]); hi8[j] = h; lo8[j] = bfs(x[j] - sbf2f(h)); }
}
__device__ __forceinline__ void route_task(int task, int tl0, const float* QP, const LAS bf16* KHL, LAS unsigned short* EL, LAS float* GL, int lane) {
    const int r = lane & 31, hi = lane >> 5, t = 4 * task + (r >> 3), head = r & 7;
    float top[2][16];
#pragma unroll
    for (int half = 0; half < 2; ++half) {
        bf16x8 qh[4], ql[4];
        { const float* qp = QP + (size_t)t * D + head * 128 + half * 64 + 8 * hi; asm volatile("" : "+v"(qp));
#pragma unroll
          for (int ks = 0; ks < 4; ++ks) split8(qp + 16 * ks, qh[ks], ql[ks]); }
        float cur[16];
#pragma unroll
        for (int kt = 0; kt < 4; ++kt) {
            f32x16 X = zero16();
            const LAS bf16* khp = KHL + (half * 128 + 32 * kt + r) * 72 + 8 * hi;
#pragma unroll
            for (int ks = 0; ks < 4; ++ks) {
                const bf16x8 kh = lds8(khp + 16 * ks), kl = lds8(khp + 2 * 128 * 72 + 16 * ks);
                X = MFMA32(kh, qh[ks], X); X = MFMA32(kh, ql[ks], X); X = MFMA32(kl, qh[ks], X);
            }
            float grp[16];
#pragma unroll
            for (int i = 0; i < 16; ++i) { const unsigned key = (unsigned)(32 * kt + crow(i, hi)); grp[i] = __uint_as_float((__float_as_uint(X[i]) & ~127u) | (127u - key)); }
            sort16_desc(grp);
            if (kt == 0) {
#pragma unroll
                for (int i = 0; i < 16; ++i) cur[i] = grp[i];
            } else merge16_desc(cur, grp);
        }
        float oth[16];
#pragma unroll
        for (int i = 0; i < 16; ++i) oth[i] = __shfl_xor(cur[i], 32);
        merge16_desc(cur, oth);
#pragma unroll
        for (int i = 0; i < 16; ++i) top[half][i] = cur[i];
    }
    unsigned P1[4], P2[4];
#pragma unroll
    for (int q = 0; q < 4; ++q) { P1[q] = 0u; P2[q] = 0u;
#pragma unroll
        for (int s = 0; s < 4; ++s) { P1[q] |= (127u - (__float_as_uint(top[0][4 * q + s]) & 127u)) << (8 * s); P2[q] |= (127u - (__float_as_uint(top[1][4 * q + s]) & 127u)) << (8 * s); } }
#define CAND(a, b) __uint_as_float((__float_as_uint(top[0][a] + top[1][b]) & ~255u) | (255u - (unsigned)((a) * 16 + (b))))
    float bk[16];
    {
        float gk[16];
        gk[0] = CAND(0, 0);
        gk[1] = CAND(0, 1);
        gk[2] = CAND(0, 2);
        gk[3] = CAND(0, 3);
        gk[4] = CAND(0, 4);
        gk[5] = CAND(0, 5);
        gk[6] = CAND(0, 6);
        gk[7] = CAND(0, 7);
        gk[8] = CAND(0, 8);
        gk[9] = CAND(0, 9);
        gk[10] = CAND(0, 10);
        gk[11] = CAND(0, 11);
        gk[12] = CAND(0, 12);
        gk[13] = CAND(0, 13);
        gk[14] = CAND(0, 14);
        gk[15] = CAND(0, 15);
        sort16_desc(gk);
#pragma unroll
        for (int i = 0; i < 16; ++i) bk[i] = gk[i];
    }
    {
        float gk[16];
        gk[0] = CAND(1, 0);
        gk[1] = CAND(1, 1);
        gk[2] = CAND(1, 2);
        gk[3] = CAND(1, 3);
        gk[4] = CAND(1, 4);
        gk[5] = CAND(1, 5);
        gk[6] = CAND(1, 6);
        gk[7] = CAND(1, 7);
        gk[8] = CAND(2, 0);
        gk[9] = CAND(2, 1);
        gk[10] = CAND(2, 2);
        gk[11] = CAND(2, 3);
        gk[12] = CAND(2, 4);
        gk[13] = CAND(3, 0);
        gk[14] = CAND(3, 1);
        gk[15] = CAND(3, 2);
        sort16_desc(gk);
        merge16_desc(bk, gk);
    }
    {
        float gk[16];
        gk[0] = CAND(3, 3);
        gk[1] = CAND(4, 0);
        gk[2] = CAND(4, 1);
        gk[3] = CAND(4, 2);
        gk[4] = CAND(5, 0);
        gk[5] = CAND(5, 1);
        gk[6] = CAND(6, 0);
        gk[7] = CAND(6, 1);
        gk[8] = CAND(7, 0);
        gk[9] = CAND(7, 1);
        gk[10] = CAND(8, 0);
        gk[11] = CAND(9, 0);
        gk[12] = CAND(10, 0);
        gk[13] = CAND(11, 0);
        gk[14] = CAND(12, 0);
        gk[15] = CAND(13, 0);
        sort16_desc(gk);
        merge16_desc(bk, gk);
    }
    {
        float gk[16];
        gk[0] = CAND(14, 0);
        gk[1] = CAND(15, 0);
        gk[2] = -INFINITY;
        gk[3] = -INFINITY;
        gk[4] = -INFINITY;
        gk[5] = -INFINITY;
        gk[6] = -INFINITY;
        gk[7] = -INFINITY;
        gk[8] = -INFINITY;
        gk[9] = -INFINITY;
        gk[10] = -INFINITY;
        gk[11] = -INFINITY;
        gk[12] = -INFINITY;
        gk[13] = -INFINITY;
        gk[14] = -INFINITY;
        gk[15] = -INFINITY;
        sort16_desc(gk);
        merge16_desc(bk, gk);
    }
#undef CAND
    int bv[16];
#pragma unroll
    for (int i = 0; i < 16; ++i) {
        const unsigned cd = 255u - (__float_as_uint(bk[i]) & 255u), ca = cd >> 4, cb = cd & 15u;
        const unsigned wa = (ca >> 2) == 0u ? P1[0] : (ca >> 2) == 1u ? P1[1] : (ca >> 2) == 2u ? P1[2] : P1[3];
        const unsigned wb = (cb >> 2) == 0u ? P2[0] : (cb >> 2) == 1u ? P2[1] : (cb >> 2) == 2u ? P2[2] : P2[3];
        bv[i] = (int)((((wa >> (8u * (ca & 3u))) & 255u) << 7) | ((wb >> (8u * (cb & 3u))) & 255u));
    }
    float e[16], se = 0.f;
#pragma unroll
    for (int i = 0; i < 16; ++i) { e[i] = __expf(bk[i] - bk[0]); se += e[i]; }
    const float inv = 1.f / se;
    if (hi == 0) {
        LAS v4u* ip = (LAS v4u*)(EL + (tl0 + (r >> 3)) * 128 + head * 16); typedef float f4v __attribute__((ext_vector_type(4))); LAS f4v* gp = (LAS f4v*)(GL + (tl0 + (r >> 3)) * 128 + head * 16);
#pragma unroll
        for (int q = 0; q < 2; ++q) ip[q] = (v4u){(unsigned)bv[8 * q] | ((unsigned)bv[8 * q + 1] << 16), (unsigned)bv[8 * q + 2] | ((unsigned)bv[8 * q + 3] << 16), (unsigned)bv[8 * q + 4] | ((unsigned)bv[8 * q + 5] << 16), (unsigned)bv[8 * q + 6] | ((unsigned)bv[8 * q + 7] << 16)};
#pragma unroll
        for (int q = 0; q < 4; ++q) gp[q] = (f4v){e[4 * q] * inv, e[4 * q + 1] * inv, e[4 * q + 2] * inv, e[4 * q + 3] * inv};
    }
}

#define XB_TMO      128
#define XB_XCNT(j)  (256  + 64 * (j))
#define XB_XSUB(j)  (1280 + 64 * (j))
#define XB_XGEN(j)  (2304 + 64 * (j))
#define XB_TOP      3328
#define XB_TOPGEN   3392
#define XCD_BAR_WORDS 3456
#define XB_SPIN_CAP (1u << 22)
__device__ __forceinline__ unsigned xb_ld(unsigned* p)              { return __hip_atomic_load(p, __ATOMIC_RELAXED, __HIP_MEMORY_SCOPE_AGENT); }
__device__ __forceinline__ unsigned xb_add(unsigned* p, unsigned v) { return __hip_atomic_fetch_add(p, v, __ATOMIC_RELAXED, __HIP_MEMORY_SCOPE_AGENT); }
__device__ __forceinline__ unsigned xb_xcc_id() { return (unsigned)__builtin_amdgcn_s_getreg((3 << 11) | 20) & 0xFu; }
#define XB_SPIN(cond, bar) do { unsigned _sp = 0; while (cond) { __builtin_amdgcn_s_sleep(1); \
    if ((++_sp & 255u) == 0u) { if (xb_ld(&(bar)[XB_TMO])) break; if (_sp > XB_SPIN_CAP) { atomicAdd(&(bar)[XB_TMO], 1u); break; } } } } while (0)
struct XcdBarrier { unsigned* bar; unsigned x; volatile LAS unsigned* st; };
__device__ __forceinline__ XcdBarrier xcd_barrier_post(unsigned* bar, volatile LAS unsigned* st) {
    XcdBarrier b; b.bar = bar; b.x = xb_xcc_id(); b.st = st;
    if (threadIdx.x == 0) (void)xb_add(&bar[XB_XCNT(b.x)], 1u);
    return b;
}
__device__ __forceinline__ void xcd_barrier_complete(unsigned* bar, unsigned x, unsigned& nloc, unsigned& nx) {
    const unsigned G = gridDim.x * gridDim.y * gridDim.z;
    unsigned sum, cnt, mine, sp = 0u;
    for (;;) {
        sum = 0u; cnt = 0u; mine = 0u;
#pragma unroll
        for (unsigned j = 0; j < 16; ++j) { const unsigned c = xb_ld(&bar[XB_XCNT(j)]); sum += c; cnt += (c > 0u) ? 1u : 0u; mine = (j == x) ? c : mine; }
        if (sum == G) break;
        __builtin_amdgcn_s_sleep(1);
        if ((++sp & 255u) == 0u) { if (xb_ld(&bar[XB_TMO])) break; if (sp > XB_SPIN_CAP) { atomicAdd(&bar[XB_TMO], 1u); break; } }
    }
    nloc = mine > 0u ? mine : 1u; nx = cnt > 0u ? cnt : 1u;
}
__device__ __forceinline__ void xcd_barrier(const XcdBarrier& b) {
    asm volatile("s_waitcnt vmcnt(0)" ::: "memory");
    __syncthreads();
    if (threadIdx.x == 0) {
        unsigned* bar = b.bar;
        __builtin_amdgcn_s_waitcnt(0);
        unsigned nloc = b.st[0], nx = b.st[1];
        if (nloc == 0u) { xcd_barrier_complete(bar, b.x, nloc, nx); b.st[0] = nloc; b.st[1] = nx; }
        const unsigned old = xb_add(&bar[XB_XSUB(b.x)], 1u);
        const unsigned gen = old / nloc;
        if (old + 1u == (gen + 1u) * nloc) {
            __builtin_amdgcn_fence(__ATOMIC_RELEASE, "agent");
            asm volatile("s_waitcnt vmcnt(0)" ::: "memory");
            const unsigned og = xb_add(&bar[XB_TOP], 1u);
            const unsigned tg = og / nx;
            if (og + 1u == (tg + 1u) * nx) xb_add(&bar[XB_TOPGEN], 1u);
            else XB_SPIN(xb_ld(&bar[XB_TOPGEN]) == tg, bar);
            __builtin_amdgcn_fence(__ATOMIC_ACQUIRE, "agent");
            xb_add(&bar[XB_XGEN(b.x)], 1u);
            asm volatile("s_waitcnt vmcnt(0)" ::: "memory");
        } else {
            XB_SPIN(xb_ld(&bar[XB_XGEN(b.x)]) == gen, bar);
            __builtin_amdgcn_fence(__ATOMIC_ACQUIRE, "agent");
            asm volatile("s_waitcnt vmcnt(0)" ::: "memory");
        }
    }
    __syncthreads();
}
constexpr int LDS_BYTES = 147456;
constexpr int MISC_OFF = 131072 + 320;

__global__ void __launch_bounds__(NTHR, 2) k_main(Args a) {
    extern __shared__ __attribute__((aligned(16))) unsigned char lds_raw[];
    LAS unsigned char* ldsb = (LAS unsigned char*)lds_raw;
    const int tid0 = threadIdx.x, bid = blockIdx.x, nb = gridDim.x;
    const int wave = __builtin_amdgcn_readfirstlane(tid0 >> 6);
    const int gthreads = nb * NTHR, nwaves = gthreads >> 6;
#define PHASE_VARS() int tid = tid0; asm volatile("" : "+v"(tid)); const int lane = tid & 63, gtid = bid * NTHR + tid, gwave = gtid >> 6; (void)lane; (void)gtid; (void)gwave
    unsigned char* ws = a.ws;
    bf16* WINT = (bf16*)(ws + WS_WIN); bf16* WOT = (bf16*)(ws + WS_WO); bf16* WQT = (bf16*)(ws + WS_WQ);
    bf16* PROJ = (bf16*)(ws + WS_PROJ);
    bf16* XNB = (bf16*)(ws + WS_XNB);
    bf16* XACT = (bf16*)(ws + WS_XACT);
    float* DTRAW = (float*)(ws + WS_DTRAW); float* DT = (float*)(ws + WS_DT); float* ACS = (float*)(ws + WS_ACS); float* CDEC = (float*)(ws + WS_CDEC);
    float* STATES = (float*)(ws + WS_STATES); bf16* PREVT = (bf16*)(ws + WS_PREV);
    float* QP = (float*)(ws + WS_QP); unsigned short* IDX = (unsigned short*)(ws + WS_IDX); float* GATE = (float*)(ws + WS_GATE);
    float* TOPV = (float*)(ws + WS_TOPV); int* TOPI = (int*)(ws + WS_TOPI);
    unsigned char* U8 = ws + WS_U8; unsigned char* V8 = ws + WS_V8; float* SU = (float*)(ws + WS_SU); float* SV = SU + 16384; bf16* PART = (bf16*)(ws + WS_PART); unsigned char* XQ = ws + WS_XQ; float* XS = (float*)(ws + WS_XS);
    bf16* KH = (bf16*)(ws + WS_KH); bf16* KL = (bf16*)(ws + WS_KH + 65536);
    bf16* HB = (bf16*)(ws + WS_STATES);
    float* MIXF = a.out;
    volatile LAS unsigned* MISC = (volatile LAS unsigned*)(ldsb + MISC_OFF);
    if (tid0 < 32) MISC[tid0] = 0u;
    __syncthreads();
    XcdBarrier bar = xcd_barrier_post((unsigned*)ws, MISC + 8);
#define IN(k) (a.ph_lo <= (k) && (k) < a.ph_hi)
#if defined(PROBE_LO)
    int seg_ = 0; unsigned long long tseg_ = __builtin_amdgcn_s_memrealtime();
#define PROBE_SPIN() do { if (seg_ >= PROBE_LO && seg_ <= PROBE_HI) { const unsigned long long d_ = (__builtin_amdgcn_s_memrealtime() - tseg_) * PROBE_AMP; const unsigned long long s_ = __builtin_amdgcn_s_memrealtime(); \
        while (__builtin_amdgcn_s_memrealtime() - s_ < d_) __builtin_amdgcn_s_sleep(4); } } while (0)
#define GRID_BAR() do { PROBE_SPIN(); xcd_barrier(bar); tseg_ = __builtin_amdgcn_s_memrealtime(); ++seg_; } while (0)
#else
#define PROBE_SPIN() do { } while (0)
#define GRID_BAR() xcd_barrier(bar)
#endif

    if (IN(0)) {
        PHASE_VARS();
        LAS float* scr = (LAS float*)(ldsb + wave * 16384);
        constexpr int I_IN = 16 * 72, I_O = 16 * 32, NITEMS = I_IN + 2 * I_O;
        for (int it = gwave; it < NITEMS; it += nwaves) {
            int r = it;
            if (r < I_IN) { transpose_item(a.w_in, PW, D, WINT, scr, r / 72, r % 72, lane); continue; } r -= I_IN;
            if (r < I_O) { transpose_item(a.w_out, D, D, WOT, scr, r / 32, r % 32, lane); continue; } r -= I_O;
            transpose_item(a.peer_wq, D, D, WQT, scr, r / 32, r % 32, lane);
        }
        for (int i = gtid; i < 2 * 128 * 64; i += gthreads) { const float kf = a.peer_sub_keys[i]; const short h = bfs(kf); KH[i] = (bf16)h; KL[i] = (bf16)bfs(kf - sbf2f(h)); }
        for (int i = tid; i < 8 * 1024; i += NTHR) { const int h = i & 7, c = i >> 3; *(LAS float*)(ldsb + h * 16384 + 8448 + c * 4) = a.w_in[(size_t)c * PW + ODT + h]; }
        __syncthreads();
        rmsnorm_rows_bf16<1>(a.x, a.norm_mix_g, XNB, ldsb, DTRAW, nullptr, nullptr, gwave, nwaves, lane);
    }
    GRID_BAR();
    if (IN(1)) {
        PHASE_VARS();
        pg8::Gemm g{XNB, WINT, T, PS, D}; pg8::StaticOrder S; S.init(T, PS, nb, bid);
        pg8::EpiBf16Plain E{PROJ, PS};
        pg8::gemm_phase<pg8::EpiBf16Plain, pg8::StaticOrder>(ldsb, g, S, E, nullptr);
        const int cfirst = (nb == 256) ? 64 : 0;
        if (bid >= cfirst) for (int rr0 = ((bid - cfirst) * 8 + wave) * 4; rr0 < 2 * 16384; rr0 += (nb - cfirst) * 8 * 4) {
            float4 v[4][4];
#pragma unroll
            for (int q = 0; q < 4; ++q) { const int rr = rr0 + q, which = rr >> 14, row = rr & 16383;
                const float4* src4 = (const float4*)((which ? a.peer_v : a.peer_u) + (size_t)row * D) + lane;
#pragma unroll
                for (int jq = 0; jq < 4; ++jq) v[q][jq] = src4[64 * jq]; }
#pragma unroll
            for (int q = 0; q < 4; ++q) { const int rr = rr0 + q, which = rr >> 14, row = rr & 16383;
                float mx = 0.f;
#pragma unroll
                for (int jq = 0; jq < 4; ++jq) mx = fmaxf(mx, fmaxf(fmaxf(fabsf(v[q][jq].x), fabsf(v[q][jq].y)), fmaxf(fabsf(v[q][jq].z), fabsf(v[q][jq].w))));
#pragma unroll
                for (int o = 1; o < 64; o <<= 1) mx = fmaxf(mx, __shfl_xor(mx, o));
                const float sc = mx > 0.f ? mx * (1.f / 127.f) : 1.f, inv = 1.f / sc;
                unsigned* dst = (unsigned*)((which ? V8 : U8) + (size_t)row * D) + lane;
#pragma unroll
                for (int jq = 0; jq < 4; ++jq) { const int q0 = (int)rintf(v[q][jq].x * inv), q1 = (int)rintf(v[q][jq].y * inv), q2 = (int)rintf(v[q][jq].z * inv), q3 = (int)rintf(v[q][jq].w * inv);
                    dst[64 * jq] = (unsigned)(q0 & 255) | ((unsigned)(q1 & 255) << 8) | ((unsigned)(q2 & 255) << 16) | ((unsigned)(q3 & 255) << 24); }
                if (lane == 0) (which ? SV : SU)[row] = sc; }
        }
    }
    GRID_BAR();
    if (IN(3)) {
        PHASE_VARS();
        for (int u = bid; u < 512; u += nb) {
            if (u < 256) attn_unit(a.attn_sinks, a.attn_out_g, ldsb, u, PROJ, XNB, tid, lane, wave);
            else ssd_chunk_unit(ldsb, u - 256, PROJ, XACT, DTRAW, a.conv_w, a.conv_b, a.dt_bias, a.a_log, ACS, CDEC, MIXF, STATES, tid, lane, wave);
        }
    }
    GRID_BAR();
    if (IN(5)) {
        PHASE_VARS();
        for (int idx = gtid; idx < 2 * 8 * 8192; idx += gthreads) {
            const int pn = idx & 8191, h = (idx >> 13) & 7, b = idx >> 16;
            float run = 0.f;
#pragma unroll 1
            for (int c0 = 0; c0 < 64; c0 += 8) {
                float st[8], dc[8];
#pragma unroll
                for (int j = 0; j < 8; ++j) { const int bch = (b * 64 + c0 + j) * 8 + h; st[j] = STATES[(size_t)bch * 8192 + pn]; dc[j] = CDEC[bch]; }
#pragma unroll
                for (int j = 0; j < 8; ++j) { const int bch = (b * 64 + c0 + j) * 8 + h; PREVT[(size_t)bch * 8192 + pn] = f2bf(run); run = dc[j] * run + st[j]; }
            }
        }
    }
    GRID_BAR();
    if (IN(6)) {
        PHASE_VARS();
        for (int u = bid; u < 256; u += nb) yoff_unit(a.d_skip, a.ssm_norm_g, ldsb, u, XACT, PROJ, ACS, PREVT, MIXF, XNB, lane, wave);
    }
    GRID_BAR();
    if (IN(7)) {
        PHASE_VARS();
        pg8::Gemm g{XNB, WOT, T, D, D}; pg8::StaticOrder S; S.init(T, D, nb, bid);
        pg8::EpiBf16Resid E{HB, a.x, D};
        pg8::gemm_phase<pg8::EpiBf16Resid, pg8::StaticOrder>(ldsb, g, S, E, nullptr);
    }
    GRID_BAR();
    if (IN(8)) {
        PHASE_VARS();
        rmsnorm_rows_bf16<2>((const float*)HB, a.norm_ffn_g, XNB, ldsb, nullptr, XQ, XS, gwave, nwaves, lane);
    }
    GRID_BAR();
    if (IN(9)) {
        PHASE_VARS();
        pg8::Gemm g{XNB, WQT, T, D, D}; pg8::StaticOrder S; S.init(T, D, nb, bid);
        pg8::EpiF32Resid E{QP, nullptr, D};
        pg8::gemm_phase<pg8::EpiF32Resid, pg8::StaticOrder>(ldsb, g, S, E, nullptr);
    }
    GRID_BAR();
    bf16* PEERO = (bf16*)(ws + WS_PEERO);
    if (IN(12)) {
        PHASE_VARS();
        LAS bf16* KHL = (LAS bf16*)ldsb; LAS int* ACC = (LAS int*)ldsb; LAS unsigned char* AL = (LAS unsigned char*)(ldsb + 32768); LAS float* ASC = (LAS float*)(ldsb + 40960);
        LAS unsigned short* EL = (LAS unsigned short*)(ldsb + 73728); LAS float* GL = (LAS float*)(ldsb + 90112);
#pragma unroll 1
        for (int j = bid; j < NCHUNK; j += nb) {
            __syncthreads();
            for (int i = tid; i < 2 * 2 * 128 * 8; i += NTHR) {
                const int pc = i & 7, key = (i >> 3) & 127, hf = (i >> 10) & 1, hl = i >> 11;
                *(LAS v4u*)(KHL + ((hl * 2 + hf) * 128 + key) * 72 + pc * 8) = *(const v4u*)((hl ? KL : KH) + (size_t)(hf * 128 + key) * 64 + pc * 8);
            }
            __syncthreads();
            route_task(16 * j + wave, 4 * wave, QP, KHL, EL, GL, lane);
            route_task(16 * j + 8 + wave, 32 + 4 * wave, QP, KHL, EL, GL, lane);
            __syncthreads();
#pragma unroll 1
            for (int p = 0; p < NPART; ++p) peer_u_item(p, j, EL, XQ, U8, ACC, lane, wave);
#pragma unroll 1
            for (int it = 0; it < 8; ++it) {
                const int tl = it * 8 + wave, t = j * 64 + tl;
                const unsigned ew = *(const LAS unsigned*)(EL + tl * 128 + 2 * lane); const int e0 = (int)(ew & 0xffffu), e1 = (int)(ew >> 16);
                typedef int i2v __attribute__((ext_vector_type(2))); const i2v si = *(const LAS i2v*)(ACC + tl * 128 + 2 * lane);
                typedef float f2v __attribute__((ext_vector_type(2))); const f2v gt = *(const LAS f2v*)(GL + tl * 128 + 2 * lane); const float xs = XS[t];
                const float z0 = (float)si.x * SU[e0] * xs, z1 = (float)si.y * SU[e1] * xs;
                const float a0 = gt.x * 0.5f * z0 * (1.f + erff(z0 * 0.70710678118654752f)) * SV[e0], a1 = gt.y * 0.5f * z1 * (1.f + erff(z1 * 0.70710678118654752f)) * SV[e1];
                float mx = fmaxf(fabsf(a0), fabsf(a1));
#pragma unroll
                for (int o = 1; o < 64; o <<= 1) mx = fmaxf(mx, __shfl_xor(mx, o));
                const float sc = mx > 0.f ? mx * (1.f / 127.f) : 1.f, inv = 1.f / sc;
                *(LAS unsigned short*)(AL + tl * 128 + 2 * lane) = (unsigned short)(((int)rintf(a0 * inv) & 255) | (((int)rintf(a1 * inv) & 255) << 8));
                if (lane == 0) ASC[tl] = sc;
            }
#pragma unroll 1
            for (int p = 0; p < NPART; ++p) peer_v_item(p, j, EL, AL, ASC, V8, PEERO, lane, wave);
            asm volatile("s_waitcnt vmcnt(0)" ::: "memory");
#pragma unroll 1
            for (int it = 0; it < 8; ++it) {
                const int t = j * 64 + it * 8 + wave;
                const uint2* hr = (const uint2*)(HB + (size_t)t * D) + lane; unsigned long long* pr = (unsigned long long*)(PEERO + (size_t)t * D) + lane;
                float4 v[4]; float ss = 0.f;
#pragma unroll
                for (int jq = 0; jq < 4; ++jq) { const uint2 hw = hr[64 * jq]; const unsigned long long pw = __hip_atomic_load(pr + 64 * jq, __ATOMIC_RELAXED, __HIP_MEMORY_SCOPE_AGENT);
                    const unsigned pl = (unsigned)pw, ph = (unsigned)(pw >> 32);
                    v[jq] = make_float4(__uint_as_float(hw.x << 16) + __uint_as_float(pl << 16), __uint_as_float(hw.x & 0xffff0000u) + __uint_as_float(pl & 0xffff0000u),
                                        __uint_as_float(hw.y << 16) + __uint_as_float(ph << 16), __uint_as_float(hw.y & 0xffff0000u) + __uint_as_float(ph & 0xffff0000u));
                    ss += v[jq].x * v[jq].x + v[jq].y * v[jq].y + v[jq].z * v[jq].z + v[jq].w * v[jq].w; }
                ss = wave_sum(ss);
                const float r3 = rsqrtf(ss * (1.f / D) + EPS);
                float4* op = (float4*)(a.out + (size_t)t * D) + lane;
#pragma unroll
                for (int jq = 0; jq < 4; ++jq) { const float4 gv = ((const float4*)a.final_norm_g)[lane + 64 * jq]; op[64 * jq] = make_float4(v[jq].x * r3 * gv.x, v[jq].y * r3 * gv.y, v[jq].z * r3 * gv.z, v[jq].w * r3 * gv.w); }
            }
        }
    }
    PROBE_SPIN();
#undef IN
}
}

extern "C" void kernel_launch(void* const* d_in, const int* in_sizes, int n_in, void* d_out, int out_size, void* d_ws, size_t ws_size, hipStream_t stream) {
    if (n_in != 18 || out_size != T * D || ws_size < WS_END) { fprintf(stderr, "kernel_launch: unexpected shapes n_in=%d out=%d ws=%zu\n", n_in, out_size, ws_size); return; }
    Args a{};
    const float** ap = (const float**)&a;
    for (int i = 0; i < 18; ++i) ap[i] = (const float*)d_in[i];
    a.out = (float*)d_out; a.ws = (unsigned char*)d_ws;
    static int grid = 0;
    if (grid == 0) {
        int dev = 0, cus = 0, per_cu = 0;
        if (hipGetDevice(&dev) != hipSuccess || hipDeviceGetAttribute(&cus, hipDeviceAttributeMultiprocessorCount, dev) != hipSuccess) { fprintf(stderr, "kernel_launch: device query failed\n"); grid = -1; return; }
        if (hipFuncSetAttribute((const void*)k_main, hipFuncAttributeMaxDynamicSharedMemorySize, LDS_BYTES) != hipSuccess) { fprintf(stderr, "kernel_launch: hipFuncSetAttribute failed\n"); grid = -1; return; }
        if (hipOccupancyMaxActiveBlocksPerMultiprocessor(&per_cu, (const void*)k_main, NTHR, LDS_BYTES) != hipSuccess || per_cu < 1) { fprintf(stderr, "kernel_launch: occupancy query says %d blocks/CU\n", per_cu); (void)hipGetLastError(); grid = -1; return; }
        grid = cus;
    }
    if (grid < 0) return;
    if (hipMemsetAsync(d_ws, 0, 65536, stream) != hipSuccess) { fprintf(stderr, "kernel_launch: memset failed\n"); return; }
    a.ph_lo = 0; a.ph_hi = 13;
    hipLaunchKernelGGL(k_main, dim3(grid), dim3(NTHR), LDS_BYTES, stream, a);
}
```

```cpp
#include <hip/hip_runtime.h>
#include <cstdio>
#include <cstdint>

namespace pg8 {
#define PG8_LAS __attribute__((address_space(3)))
typedef unsigned short bf16_t;
typedef short bf16x8 __attribute__((ext_vector_type(8)));
typedef float f32x4 __attribute__((ext_vector_type(4)));
typedef unsigned u32x4 __attribute__((ext_vector_type(4)));
constexpr int BM = 256, BK = 64, HALF = 128, HTB = HALF * BK * 2  , STAGE_BYTES = 8 * HTB, NXCD = 8, WGM = 8;

__host__ __device__ __forceinline__ int lds_byte(int r, int c) { const int st = (r >> 4) * 2 + (c >> 5), rr = r & 15, cc = c & 31, ob = rr * 64 + cc * 2; return st * 1024 + (ob ^ (((ob >> 9) & 1) << 5)); }
__host__ __device__ __forceinline__ void stage_rc(int b, int& R, int& C) { const int st = b / 1024, sb = b % 1024, swz = sb ^ (((sb >> 9) & 1) << 5); R = (st >> 1) * 16 + swz / 64; C = (st & 1) * 32 + (swz % 64) / 2; }
__host__ __device__ __forceinline__ int perm32(int rho) { const int n = rho >> 4, i = rho & 15; return 8 * (i >> 2) + 4 * n + (i & 3); }

struct Unit { int pm, pn; };
struct Gemm { const bf16_t* A; const bf16_t* Bt; int M, N, K; };

struct StaticOrder {
    int nM, nN, nwg, G, c;
    __host__ __device__ void init(int M, int N, int G_, int c_) { nM = M / BM; nN = N / BM; nwg = nM * nN; G = G_; c = c_; }
    __host__ __device__ bool next(int i, Unit& u) const {
        const long L = (long)i * G + c; if (L >= nwg) return false;
        int wgid = (int)L; { const int q = nwg / NXCD, r = nwg % NXCD, xcd = wgid % NXCD, off = wgid / NXCD; wgid = (xcd < r ? xcd * (q + 1) : r * (q + 1) + (xcd - r) * q) + off; }
        const int nig = WGM * nN, gid = wgid / nig, fm = gid * WGM, gsz = (nM - fm) < WGM ? (nM - fm) : WGM;
        u.pm = fm + ((wgid % nig) % gsz); u.pn = (wgid % nig) / gsz; return true;
    }
    __device__ __forceinline__ void a_ready(const Unit&) const {}
    __device__ __forceinline__ void done(const Unit&) const {}
};
__device__ __forceinline__ unsigned cvt_pk_bf16(float lo, float hi) { unsigned r; asm volatile("v_cvt_pk_bf16_f32 %0, %1, %2" : "=v"(r) : "v"(lo), "v"(hi)); return r; }
typedef float f32x2 __attribute__((ext_vector_type(2)));
struct EpiBf16Plain {
    static constexpr bool PERM = true, AFTER_DRAIN = false;
    bf16_t* O; int ldc;
    __device__ __forceinline__ void operator()(const f32x4 (&acc)[2][2][4][2], const Unit& u, int wr, int wc, int fr, int fq) const {
        const int row0 = u.pm * BM + wr * 64 + fr, col0 = u.pn * BM + wc * 32 + 8 * fq;
#pragma unroll
        for (int ai = 0; ai < 2; ++ai)
#pragma unroll
            for (int m = 0; m < 4; ++m) { bf16_t* rowp = O + (size_t)(row0 + ai * HALF + m * 16) * ldc + col0;
#pragma unroll
                for (int bj = 0; bj < 2; ++bj) { const f32x4 v0 = acc[ai][bj][m][0], v1 = acc[ai][bj][m][1];
                    u32x4 w; w.x = cvt_pk_bf16(v0[0], v0[1]); w.y = cvt_pk_bf16(v0[2], v0[3]); w.z = cvt_pk_bf16(v1[0], v1[1]); w.w = cvt_pk_bf16(v1[2], v1[3]);
                    *(u32x4*)(rowp + bj * HALF) = w; } }
    }
};
struct EpiF32Resid {
    static constexpr bool PERM = false, AFTER_DRAIN = false;
    float* C; const float* R; int ldc;
    __device__ __forceinline__ void operator()(const f32x4 (&acc)[2][2][4][2], const Unit& u, int wr, int wc, int fr, int fq) const {
        const int row0 = u.pm * BM + wr * 64 + fr, col0 = u.pn * BM + wc * 32 + 4 * fq;
#pragma unroll
        for (int ai = 0; ai < 2; ++ai)
#pragma unroll
            for (int m = 0; m < 4; ++m) { const size_t off = (size_t)(row0 + ai * HALF + m * 16) * ldc + col0;
#pragma unroll
                for (int bj = 0; bj < 2; ++bj)
#pragma unroll
                    for (int n = 0; n < 2; ++n) { f32x4 v = acc[ai][bj][m][n]; if (R) v += *(const f32x4*)(R + off + bj * HALF + n * 16); *(f32x4*)(C + off + bj * HALF + n * 16) = v; }
                asm volatile("" ::: "memory"); }
    }
};

struct EpiBf16Resid {
    static constexpr bool PERM = true, AFTER_DRAIN = false;
    bf16_t* O; const float* R; int ldc;
    __device__ __forceinline__ void operator()(const f32x4 (&acc)[2][2][4][2], const Unit& u, int wr, int wc, int fr, int fq) const {
        const int row0 = u.pm * BM + wr * 64 + fr, col0 = u.pn * BM + wc * 32 + 8 * fq;
#pragma unroll
        for (int ai = 0; ai < 2; ++ai)
#pragma unroll
            for (int m = 0; m < 4; ++m) { const size_t off = (size_t)(row0 + ai * HALF + m * 16) * ldc + col0;
#pragma unroll
                for (int bj = 0; bj < 2; ++bj) { const f32x4 v0 = acc[ai][bj][m][0] + *(const f32x4*)(R + off + bj * HALF), v1 = acc[ai][bj][m][1] + *(const f32x4*)(R + off + bj * HALF + 4);
                    u32x4 w; w.x = cvt_pk_bf16(v0[0], v0[1]); w.y = cvt_pk_bf16(v0[2], v0[3]); w.z = cvt_pk_bf16(v1[0], v1[1]); w.w = cvt_pk_bf16(v1[2], v1[3]);
                    *(u32x4*)(O + off + bj * HALF) = w; }
                asm volatile("" ::: "memory"); }
    }
};
template <class Epi, class Sched, bool STAMP = false>
__device__ __forceinline__ void gemm_phase(PG8_LAS unsigned char* lds, const Gemm g, const Sched& S, const Epi& E, unsigned long long* stamps) {
    const int tid = threadIdx.x, wid = __builtin_amdgcn_readfirstlane(tid >> 6), lane = tid & 63, wr = wid >> 2, wc = wid & 3, fr = lane & 15, fq = lane >> 4;
    const int K = g.K, nt = K / BK;
    int ts_lo = 0, ts_hi = 0, nts = 0; const unsigned long long rt_entry = STAMP ? (unsigned long long)0ull : 0ull;
#define PG8_STAMP() do { if (STAMP && wid == 0 && nts < 64) { const unsigned long long _c = (unsigned long long)clock64(); \
        ts_lo = (lane == nts) ? (int)(unsigned)_c : ts_lo; ts_hi = (lane == nts) ? (int)(unsigned)(_c >> 32) : ts_hi; ++nts; } } while (0)
    PG8_STAMP();
    unsigned voffA[2], voffB[2];
#pragma unroll
    for (int i = 0; i < 2; ++i) { int R, C; stage_rc(tid * 16 + i * 8192, R, C); const int Rb = Epi::PERM ? ((R & ~31) + perm32(R & 31)) : R;
        voffA[i] = (unsigned)(R * K + C) * 2u; voffB[i] = (unsigned)(Rb * K + C) * 2u; }
    const size_t kstep = (size_t)(BK * 2);
    const size_t hstep = (size_t)HALF * K * 2;
    const size_t tstep = 2 * hstep;
    const unsigned ldsw = (unsigned)wid * 1024u;
    const int aoff = lds_byte(wr * 64 + fr, fq * 8), boff = lds_byte(wc * 32 + fr, fq * 8);
#define PG8_SA(b, h) (((b) * 2 + (h)) * HTB)
#define PG8_SB(b, h) ((4 + (b) * 2 + (h)) * HTB)
#define PG8_STAGE(bufoff, gbase, voff) do { _Pragma("unroll") for (int _i = 0; _i < 2; ++_i) \
        __builtin_amdgcn_global_load_lds((const unsigned*)((const char*)(gbase) + (voff)[_i]), (PG8_LAS unsigned*)(lds + (bufoff) + ldsw + _i * 8192), 16, 0, 0); } while (0)
#define PG8_LDA(dst, b, h) do { _Pragma("unroll") for (int m = 0; m < 4; ++m) _Pragma("unroll") for (int k = 0; k < 2; ++k) dst[m][k] = *(const PG8_LAS bf16x8*)(lds + PG8_SA(b, h) + aoff + m * 2048 + k * 1024); } while (0)
#define PG8_LDB(dst, b, h) do { _Pragma("unroll") for (int n = 0; n < 2; ++n) _Pragma("unroll") for (int k = 0; k < 2; ++k) dst[n][k] = *(const PG8_LAS bf16x8*)(lds + PG8_SB(b, h) + boff + n * 2048 + k * 1024); } while (0)
#define PG8_MMA(ai, bj, At, Bt) do { __builtin_amdgcn_s_setprio(1); _Pragma("unroll") for (int m = 0; m < 4; ++m) _Pragma("unroll") for (int n = 0; n < 2; ++n) _Pragma("unroll") for (int k = 0; k < 2; ++k) \
        acc[ai][bj][m][n] = __builtin_amdgcn_mfma_f32_16x16x32_bf16(Bt[n][k], At[m][k], acc[ai][bj][m][n], 0, 0, 0); __builtin_amdgcn_s_setprio(0); } while (0)
#define PG8_WAIT_V(n) asm volatile("s_waitcnt vmcnt(" #n ")" ::: "memory")
#define PG8_WAIT_L(n) asm volatile("s_waitcnt lgkmcnt(" #n ")" ::: "memory")
#define PG8_BAR __builtin_amdgcn_s_barrier()
#define PG8_SCHED __builtin_amdgcn_sched_barrier(0)
    Unit cur, nxt; int ui = 0;
    if (!S.next(0, cur)) return;
    f32x4 acc[2][2][4][2];
#pragma unroll
    for (int a = 0; a < 2; ++a)
#pragma unroll
        for (int b = 0; b < 2; ++b)
#pragma unroll
            for (int m = 0; m < 4; ++m)
#pragma unroll
                for (int n = 0; n < 2; ++n) acc[a][b][m][n] = (f32x4){0.f, 0.f, 0.f, 0.f};
    bf16x8 At[4][2], B0[2][2], B1[2][2];
    const char* cA = (const char*)g.A + (size_t)cur.pm * tstep; const char* cB = (const char*)g.Bt + (size_t)cur.pn * tstep;
    S.a_ready(cur);
    PG8_STAGE(PG8_SB(0, 0), cB, voffB); PG8_STAGE(PG8_SA(0, 0), cA, voffA); PG8_STAGE(PG8_SB(0, 1), cB + hstep, voffB); PG8_STAGE(PG8_SA(0, 1), cA + hstep, voffA);
    if (wr == 1) PG8_BAR;
    PG8_WAIT_V(4); PG8_BAR;
    PG8_STAGE(PG8_SB(1, 0), cB + kstep, voffB); PG8_STAGE(PG8_SA(1, 0), cA + kstep, voffA); PG8_STAGE(PG8_SB(1, 1), cB + hstep + kstep, voffB);
    PG8_WAIT_V(6); PG8_BAR;
    PG8_STAMP();
    for (;;) {
        const bool has_next = S.next(ui + 1, nxt);
        const char* nA = has_next ? (const char*)g.A + (size_t)nxt.pm * tstep : cA; const char* nB = has_next ? (const char*)g.Bt + (size_t)nxt.pn * tstep : cB;
        for (int t = 0; t < nt; t += 2) {
            const bool last = (t == nt - 2);
            const char* a1 = cA + (size_t)(t + 1) * kstep;
            const char* a2 = last ? nA : cA + (size_t)(t + 2) * kstep; const char* b2 = last ? nB : cB + (size_t)(t + 2) * kstep;
            const char* a3 = a2 + kstep; const char* b3 = b2 + kstep;
            if (last && has_next) S.a_ready(nxt);
            PG8_LDB(B0, 0, 0); PG8_SCHED; PG8_LDA(At, 0, 0); PG8_STAGE(PG8_SA(1, 1), a1 + hstep, voffA);
            PG8_WAIT_L(8); PG8_BAR; PG8_WAIT_L(0); PG8_MMA(0, 0, At, B0); PG8_BAR; PG8_SCHED;
            PG8_LDB(B1, 0, 1); PG8_STAGE(PG8_SB(0, 0), b2, voffB);
            PG8_BAR; PG8_WAIT_L(0); PG8_MMA(0, 1, At, B1); PG8_BAR;
            PG8_LDA(At, 0, 1); PG8_STAGE(PG8_SA(0, 0), a2, voffA);
            PG8_BAR; PG8_WAIT_L(0); PG8_MMA(1, 0, At, B0); PG8_BAR; PG8_SCHED;
            PG8_STAGE(PG8_SB(0, 1), b2 + hstep, voffB);
            PG8_WAIT_V(6); PG8_BAR; PG8_MMA(1, 1, At, B1); PG8_BAR;
            PG8_LDB(B0, 1, 0); PG8_SCHED; PG8_LDA(At, 1, 0); PG8_STAGE(PG8_SA(0, 1), a2 + hstep, voffA);
            PG8_WAIT_L(8); PG8_BAR; PG8_WAIT_L(0); PG8_MMA(0, 0, At, B0); PG8_BAR; PG8_SCHED;
            PG8_LDB(B1, 1, 1); PG8_STAGE(PG8_SB(1, 0), b3, voffB);
            PG8_BAR; PG8_WAIT_L(0); PG8_MMA(0, 1, At, B1); PG8_BAR;
            PG8_LDA(At, 1, 1); PG8_STAGE(PG8_SA(1, 0), a3, voffA);
            PG8_BAR; PG8_WAIT_L(0); PG8_MMA(1, 0, At, B0); PG8_BAR; PG8_SCHED;
            PG8_STAGE(PG8_SB(1, 1), b3 + hstep, voffB);
            PG8_WAIT_V(6); PG8_BAR; PG8_MMA(1, 1, At, B1); PG8_BAR;
        }
        PG8_STAMP();
        if constexpr (!Epi::AFTER_DRAIN) { E(acc, cur, wr, wc, fr, fq); S.done(cur); }
        PG8_STAMP();
        if (!has_next) break;
#pragma unroll
        for (int a = 0; a < 2; ++a)
#pragma unroll
            for (int b = 0; b < 2; ++b)
#pragma unroll
                for (int m = 0; m < 4; ++m)
#pragma unroll
                    for (int n = 0; n < 2; ++n) acc[a][b][m][n] = (f32x4){0.f, 0.f, 0.f, 0.f};
        cur = nxt; cA = nA; cB = nB; ++ui;
    }
    PG8_WAIT_V(0);
    if (wr == 0) PG8_BAR;
    PG8_BAR;
    if constexpr (Epi::AFTER_DRAIN) { E.fused(acc, cur, wr, wc, fr, fq, lds, wid, lane); S.done(cur); }
    PG8_STAMP();
    if (STAMP && wid == 0) { stamps[lane] = lane < nts ? (((unsigned long long)(unsigned)ts_hi << 32) | (unsigned)ts_lo) : 0ull;
        if (lane == 62) stamps[62] = rt_entry; if (lane == 63) stamps[63] = (unsigned long long)0ull; }
#undef PG8_STAMP
#undef PG8_SA
#undef PG8_SB
#undef PG8_STAGE
#undef PG8_LDA
#undef PG8_LDB
#undef PG8_MMA
#undef PG8_WAIT_V
#undef PG8_WAIT_L
#undef PG8_BAR
#undef PG8_SCHED
}
}

namespace {
constexpr int D = 1024, BATCH = 2, SEQ = 8192, T = BATCH * SEQ;
constexpr int PW = 2312;
constexpr int PS = 2304;
constexpr int OQ = 0, OKK = 512, OV = 640, OZ = 768, OXBC = 1280, ODT = 2304;
constexpr float EPS = 1e-6f;
constexpr int NTHR = 512;
typedef unsigned short bf16;
typedef unsigned v4u __attribute__((ext_vector_type(4)));

constexpr size_t MiB = 1u << 20;
constexpr size_t WS_WIN = 1 * MiB;
constexpr size_t WS_KH = 5 * MiB + 512 * 1024;
constexpr size_t WS_WO = 6 * MiB;
constexpr size_t WS_WQ = 8 * MiB;
constexpr size_t WS_PROJ = 10 * MiB;
constexpr size_t WS_XNB = 82 * MiB;
constexpr size_t WS_XACT = 114 * MiB;
constexpr size_t WS_DTRAW = 146 * MiB;
constexpr size_t WS_DT = WS_DTRAW + 512 * 1024;
constexpr size_t WS_ACS = WS_DT + 512 * 1024;
constexpr size_t WS_CDEC = WS_ACS + 512 * 1024;
constexpr size_t WS_STATES = 164 * MiB;
constexpr size_t WS_PREV = 196 * MiB;
constexpr size_t WS_QP = 10 * MiB;
constexpr size_t WS_IDX = 74 * MiB;
constexpr size_t WS_GATE = 114 * MiB;
constexpr size_t WS_TOPV = 122 * MiB;
constexpr size_t WS_TOPI = 138 * MiB;
constexpr size_t WS_ACT = 122 * MiB;
constexpr size_t WS_SU = 245 * MiB;
constexpr size_t WS_U8 = 212 * MiB;
constexpr size_t WS_V8 = 148 * MiB;
constexpr size_t WS_PART = 10 * MiB;
constexpr size_t WS_XQ = 228 * MiB;
constexpr size_t WS_XS = 244 * MiB;
constexpr size_t WS_PEERO = 10 * MiB;
constexpr size_t WS_END = 246 * MiB;
constexpr int CW_QU = 4096, CW_QV = 4096 + 64 * 16;
constexpr int NPART = 8, NCHUNK = T / 64;

struct Args {
    const float* x; const float* norm_mix_g; const float* w_in; const float* attn_sinks; const float* attn_out_g;
    const float* conv_w; const float* conv_b; const float* dt_bias; const float* a_log; const float* d_skip;
    const float* ssm_norm_g; const float* w_out; const float* norm_ffn_g; const float* peer_wq; const float* peer_sub_keys;
    const float* peer_u; const float* peer_v; const float* final_norm_g;
    float* out; unsigned char* ws;
    int ph_lo, ph_hi;
};

#define LAS __attribute__((address_space(3)))
#define LDS_WAIT() asm volatile("s_waitcnt lgkmcnt(0)" ::: "memory")
__device__ __forceinline__ float bf2f(bf16 v) { return __uint_as_float(((unsigned)v) << 16); }
__device__ __forceinline__ unsigned f2bfu(float f) { unsigned u = __float_as_uint(f); return (u + 0x7fffu + ((u >> 16) & 1u)) >> 16; }
__device__ __forceinline__ bf16 f2bf(float f) { return (bf16)f2bfu(f); }
__device__ __forceinline__ unsigned pk2(float lo, float hi) { return f2bfu(lo) | (f2bfu(hi) << 16); }
__device__ __forceinline__ float wave_sum(float v) {
#pragma unroll
    for (int o = 1; o < 64; o <<= 1) v += __shfl_xor(v, o);
    return v;
}
__device__ __forceinline__ float silu_f(float v) { return v / (1.f + __expf(-v)); }

__device__ __forceinline__ void transpose_item(const float* W, int ldw, int K, bf16* WT, LAS float* scr, int kb, int nbk, int lane) {
    const int k0 = 64 * kb, n0 = 32 * nbk;
#pragma unroll 8
    for (int i = 0; i < 32; ++i) { const int kk = 2 * i + (lane >> 5); scr[kk * 33 + (lane & 31)] = W[(size_t)(k0 + kk) * ldw + n0 + (lane & 31)]; }
    LDS_WAIT();
    const int c = lane & 7;
#pragma unroll
    for (int j = 0; j < 4; ++j) { const int n = (lane >> 3) + 8 * j; const LAS float* s = scr + (8 * c) * 33 + n;
        v4u o; o.x = pk2(s[0 * 33], s[1 * 33]); o.y = pk2(s[2 * 33], s[3 * 33]); o.z = pk2(s[4 * 33], s[5 * 33]); o.w = pk2(s[6 * 33], s[7 * 33]);
        *(v4u*)(WT + (size_t)(n0 + n) * K + k0 + 8 * c) = o; }
    LDS_WAIT();
}

template <int MODE  >
__device__ __forceinline__ void rmsnorm_rows_bf16(const float* __restrict__ in, const float* __restrict__ g, bf16* __restrict__ outp, const LAS unsigned char* ldsb, float* __restrict__ dtraw, unsigned char* __restrict__ xq, float* __restrict__ xs, int gwave, int nwaves, int lane) {
#pragma unroll 2
    for (int row = gwave; row < T; row += nwaves) {
        const float4* xr = (const float4*)(in + (size_t)row * D) + lane; const uint2* xb = (const uint2*)((const bf16*)in + (size_t)row * D) + lane;
        float4 v[4]; float ss = 0.f;
#pragma unroll
        for (int j = 0; j < 4; ++j) {
            if (MODE == 2) { const uint2 w = xb[64 * j]; v[j] = make_float4(__uint_as_float(w.x << 16), __uint_as_float(w.x & 0xffff0000u), __uint_as_float(w.y << 16), __uint_as_float(w.y & 0xffff0000u)); }
            else v[j] = xr[64 * j];
            ss += v[j].x * v[j].x + v[j].y * v[j].y + v[j].z * v[j].z + v[j].w * v[j].w; }
        ss = wave_sum(ss);
        const float r = rsqrtf(ss * (1.f / D) + EPS);
        unsigned long long* o8 = (unsigned long long*)(outp + (size_t)row * D) + lane;
        float dacc[8]; float y[4][4]; float mx = 0.f;
#pragma unroll
        for (int h = 0; h < 8; ++h) dacc[h] = 0.f;
#pragma unroll
        for (int j = 0; j < 4; ++j) {
            const float4 gv = ((const float4*)g)[lane + 64 * j];
            y[j][0] = v[j].x * r * gv.x; y[j][1] = v[j].y * r * gv.y; y[j][2] = v[j].z * r * gv.z; y[j][3] = v[j].w * r * gv.w;
            o8[64 * j] = (unsigned long long)pk2(y[j][0], y[j][1]) | ((unsigned long long)pk2(y[j][2], y[j][3]) << 32);
            if (MODE == 2) mx = fmaxf(mx, fmaxf(fmaxf(fabsf(y[j][0]), fabsf(y[j][1])), fmaxf(fabsf(y[j][2]), fabsf(y[j][3]))));
            if (MODE == 1) {
#pragma unroll
                for (int h = 0; h < 8; ++h) {
                    typedef float f4v __attribute__((ext_vector_type(4)));
                    const f4v wv = *(const LAS f4v*)(ldsb + h * 16384 + 8448 + (256 * j + 4 * lane) * 4);
                    dacc[h] += y[j][0] * wv.x + y[j][1] * wv.y + y[j][2] * wv.z + y[j][3] * wv.w;
                }
            }
        }
        if (MODE == 1) {
#pragma unroll
            for (int h = 0; h < 8; ++h) dacc[h] = wave_sum(dacc[h]);
            if (lane == 0) { float4* dp = (float4*)(dtraw + (size_t)row * 8); dp[0] = make_float4(dacc[0], dacc[1], dacc[2], dacc[3]); dp[1] = make_float4(dacc[4], dacc[5], dacc[6], dacc[7]); }
        }
        if (MODE == 2) {
#pragma unroll
            for (int o = 1; o < 64; o <<= 1) mx = fmaxf(mx, __shfl_xor(mx, o));
            const float sc = mx > 0.f ? mx * (1.f / 127.f) : 1.f, inv = 1.f / sc;
            unsigned* dq = (unsigned*)(xq + (size_t)row * D) + lane;
#pragma unroll
            for (int j = 0; j < 4; ++j) { const int q0 = (int)rintf(y[j][0] * inv), q1 = (int)rintf(y[j][1] * inv), q2 = (int)rintf(y[j][2] * inv), q3 = (int)rintf(y[j][3] * inv);
                dq[64 * j] = (unsigned)(q0 & 255) | ((unsigned)(q1 & 255) << 8) | ((unsigned)(q2 & 255) << 16) | ((unsigned)(q3 & 255) << 24); }
            if (lane == 0) xs[row] = sc;
        }
    }
}

typedef short bf16x8 __attribute__((ext_vector_type(8)));
typedef short bf16x4 __attribute__((ext_vector_type(4)));
typedef float f32x16 __attribute__((ext_vector_type(16)));
typedef __bf16 bf2_t __attribute__((ext_vector_type(2)));
#define MFMA32(a, b, c) __builtin_amdgcn_mfma_f32_32x32x16_bf16((a), (b), (c), 0, 0, 0)
__device__ __forceinline__ unsigned pkbf(float lo, float hi) { bf2_t v = {(__bf16)lo, (__bf16)hi}; return __builtin_bit_cast(unsigned, v); }
__device__ __forceinline__ short bfs(float f) { return __builtin_bit_cast(short, (__bf16)f); }
__device__ __forceinline__ float sbf2f(short v) { return __uint_as_float(((unsigned)(unsigned short)v) << 16); }
__device__ __forceinline__ int crow(int i, int hi) { return (i & 3) + 8 * (i >> 2) + 4 * hi; }
template <int S> __device__ __forceinline__ bf16x8 pack8(const f32x16& x) {
    v4u p; p.x = pkbf(x[8 * S], x[8 * S + 1]); p.y = pkbf(x[8 * S + 2], x[8 * S + 3]); p.z = pkbf(x[8 * S + 4], x[8 * S + 5]); p.w = pkbf(x[8 * S + 6], x[8 * S + 7]);
    return __builtin_bit_cast(bf16x8, p);
}
__device__ __forceinline__ bf16x8 ldg8(const bf16* p) { return *(const bf16x8*)p; }
__device__ __forceinline__ bf16x8 lds8(const LAS bf16* p) { return *(const LAS bf16x8*)p; }
__device__ __forceinline__ bf16x8 lds4x2(const LAS bf16* p) { const bf16x4 a = *(const LAS bf16x4*)p, b = *(const LAS bf16x4*)(p + 8); return __builtin_shufflevector(a, b, 0, 1, 2, 3, 4, 5, 6, 7); }
__device__ __forceinline__ f32x16 zero16() { f32x16 z;
#pragma unroll
    for (int i = 0; i < 16; ++i) z[i] = 0.f;
    return z; }

__device__ __forceinline__ void attn_unit(const float* sinks, const float* gnorm, LAS unsigned char* ldsb, int unit, const bf16* PROJ, bf16* MIXB, int tid, int lane, int wave) {
    asm volatile("" : "+v"(tid), "+v"(lane));
    const int tok0 = unit * 64, s0 = tok0 & (SEQ - 1), kbase = tok0 - 128;
    LAS bf16* VT = (LAS bf16*)ldsb;
    LAS bf16* KI = (LAS bf16*)(ldsb + 51200);
    LAS float* SSQ = (LAS float*)(ldsb + 51200 + 55296);
    const __amdgpu_buffer_rsrc_t rsP = __builtin_amdgcn_make_buffer_rsrc((void*)PROJ, 0, (unsigned)T * PS * 2u, 0x00020000);
#pragma unroll
    for (int i = 0; i < 6; ++i) {
        const int c = tid + 512 * i, kv = c / 1536, cc = c - kv * 1536, key = cc >> 3, d0 = (cc & 7) * 8; const bool valid = (s0 - 128 + key) >= 0;
        bf16x8 v, k;
#pragma unroll
        for (int e = 0; e < 8; ++e) { v[e] = 0; k[e] = 0; }
        if (valid) { const unsigned ro = (unsigned)(kbase + key) * (unsigned)PS + (unsigned)(kv * 64 + d0);
            v = __builtin_bit_cast(bf16x8, __builtin_amdgcn_raw_buffer_load_b128(rsP, (int)((ro + (unsigned)OV) * 2u), 0, 0));
            k = __builtin_bit_cast(bf16x8, __builtin_amdgcn_raw_buffer_load_b128(rsP, (int)((ro + (unsigned)OKK) * 2u), 0, 0)); }
#pragma unroll
        for (int e = 0; e < 8; ++e) VT[kv * 12800 + (d0 + e) * 200 + key] = (bf16)v[e];
        *(LAS bf16x8*)(KI + (kv * 192 + key) * 72 + d0) = k;
    }
    __syncthreads();
    const int r = lane & 31, hi = lane >> 5;
    const int hq = wave, hkv = wave >> 2;
    const float slope = exp2f(-(float)(hq + 1)), sink = sinks[hq];
#pragma unroll 1
    for (int qt = 0; qt < 2; ++qt) {
        const int tq = tok0 + 32 * qt + r;
        bf16x8 qf[4];
        { const bf16* qp = PROJ + (size_t)tq * PS + OQ + hq * 64 + 8 * hi; asm volatile("" : "+v"(qp));
#pragma unroll
          for (int ks = 0; ks < 4; ++ks) qf[ks] = ldg8(qp + 16 * ks); }
        const int ql = 32 * qt + r;
        float m = sink, lh = 0.f;
        f32x16 O0 = zero16(), O1 = zero16();
#pragma unroll 1
        for (int kt = 0; kt < 5; ++kt) {
            const LAS bf16* kp = KI + (hkv * 192 + 32 * (qt + kt) + r) * 72 + 8 * hi;
            f32x16 X = zero16();
#pragma unroll
            for (int ks = 0; ks < 4; ++ks) X = MFMA32(lds8(kp + 16 * ks), qf[ks], X);
            float tm = -1e30f;
#pragma unroll
            for (int i = 0; i < 16; ++i) {
                const int kl = 32 * (qt + kt) + crow(i, hi), dist = 128 + ql - kl;
                const bool valid = (dist >= 0) && (dist < 128) && ((s0 - 128 + kl) >= 0);
                const float lg = valid ? (X[i] * 0.125f - slope * (float)dist) : -1e30f;
                X[i] = lg; tm = fmaxf(tm, lg);
            }
            tm = fmaxf(tm, __shfl_xor(tm, 32));
            const float mn = fmaxf(m, tm), sc = __expf(m - mn);
            m = mn; lh *= sc;
#pragma unroll
            for (int i = 0; i < 16; ++i) { O0[i] *= sc; O1[i] *= sc; const float pe = __expf(X[i] - mn); X[i] = pe; lh += pe; }
            const LAS bf16* vp = VT + hkv * 12800 + r * 200 + 32 * (qt + kt) + 4 * hi;
            { const bf16x8 xs = pack8<0>(X); const bf16x8 a0 = lds4x2(vp), a1 = lds4x2(vp + 32 * 200); O0 = MFMA32(a0, xs, O0); O1 = MFMA32(a1, xs, O1); }
            { const bf16x8 xs = pack8<1>(X); const bf16x8 a0 = lds4x2(vp + 16), a1 = lds4x2(vp + 32 * 200 + 16); O0 = MFMA32(a0, xs, O0); O1 = MFMA32(a1, xs, O1); }
        }
        const float lsum = lh + __shfl_xor(lh, 32) + __expf(sink - m);
        const float iv = 1.f / lsum;
        float sq = 0.f;
#pragma unroll
        for (int i = 0; i < 16; ++i) sq += O0[i] * O0[i] + O1[i] * O1[i];
        sq *= iv * iv; sq += __shfl_xor(sq, 32);
        if (hi == 0) SSQ[hq * 32 + r] = sq;
        __syncthreads();
        float tot = 0.f;
#pragma unroll
        for (int h = 0; h < 8; ++h) tot += SSQ[h * 32 + r];
        const float sc = iv * rsqrtf(tot * (1.f / 512.f) + EPS);
        bf16* orow = MIXB + (size_t)tq * D + hq * 64 + 4 * hi;
#pragma unroll
        for (int q4 = 0; q4 < 4; ++q4) {
            const float4 g0 = *(const float4*)(gnorm + hq * 64 + 8 * q4 + 4 * hi), g1 = *(const float4*)(gnorm + hq * 64 + 32 + 8 * q4 + 4 * hi);
            uint2 w0, w1;
            w0.x = pkbf(O0[4 * q4] * sc * g0.x, O0[4 * q4 + 1] * sc * g0.y); w0.y = pkbf(O0[4 * q4 + 2] * sc * g0.z, O0[4 * q4 + 3] * sc * g0.w);
            w1.x = pkbf(O1[4 * q4] * sc * g1.x, O1[4 * q4 + 1] * sc * g1.y); w1.y = pkbf(O1[4 * q4 + 2] * sc * g1.z, O1[4 * q4 + 3] * sc * g1.w);
            *(uint2*)(orow + 8 * q4) = w0; *(uint2*)(orow + 32 + 8 * q4) = w1;
        }
        __syncthreads();
    }
}

__device__ __forceinline__ void ssd_chunk_unit(LAS unsigned char* ldsb, int unit, const bf16* PROJ, bf16* XACT, const float* DTRAW, const float* conv_w, const float* conv_b, const float* dt_bias, const float* a_log,
                                               float* ACS, float* CDEC, float* MIXF, float* STATES, int tid, int lane, int wave) {
    asm volatile("" : "+v"(tid), "+v"(lane));
    const int g = unit & 1, bc = unit >> 1, tok0 = bc * 128;
    LAS float* DTT = (LAS float*)(ldsb + 34816 * 3 + 2048);
    LAS float* WT = (LAS float*)(ldsb + 34816 * 3 + 4096);
    {
        const int cgi = tid & 63, t0 = tok0 + 16 * (tid >> 6);
        const int c0 = cgi < 32 ? g * 256 + cgi * 8 : (cgi < 48 ? 512 + g * 128 + (cgi - 32) * 8 : 768 + g * 128 + (cgi - 48) * 8);
        float w[4][8], bs[8];
#pragma unroll
        for (int k = 0; k < 4; ++k) { const float4 a0 = *(const float4*)(conv_w + k * 1024 + c0), a1 = *(const float4*)(conv_w + k * 1024 + c0 + 4);
            w[k][0] = a0.x; w[k][1] = a0.y; w[k][2] = a0.z; w[k][3] = a0.w; w[k][4] = a1.x; w[k][5] = a1.y; w[k][6] = a1.z; w[k][7] = a1.w; }
        { const float4 a0 = *(const float4*)(conv_b + c0), a1 = *(const float4*)(conv_b + c0 + 4); bs[0] = a0.x; bs[1] = a0.y; bs[2] = a0.z; bs[3] = a0.w; bs[4] = a1.x; bs[5] = a1.y; bs[6] = a1.z; bs[7] = a1.w; }
        const bool has_halo = (t0 & (SEQ - 1)) != 0;
        bf16x8 rows[19];
#pragma unroll
        for (int i = 0; i < 19; ++i) {
            if (i < 3 && !has_halo) {
#pragma unroll
                for (int e = 0; e < 8; ++e) rows[i][e] = 0;
            } else rows[i] = ldg8(PROJ + (size_t)(t0 + i - 3) * PS + OXBC + c0);
        }
#pragma unroll
        for (int i = 0; i < 16; ++i) {
            float o[8];
#pragma unroll
            for (int e = 0; e < 8; ++e) o[e] = silu_f(bs[e] + w[0][e] * sbf2f(rows[i][e]) + w[1][e] * sbf2f(rows[i + 1][e]) + w[2][e] * sbf2f(rows[i + 2][e]) + w[3][e] * sbf2f(rows[i + 3][e]));
            v4u ov; ov.x = pkbf(o[0], o[1]); ov.y = pkbf(o[2], o[3]); ov.z = pkbf(o[4], o[5]); ov.w = pkbf(o[6], o[7]);
            *(v4u*)(XACT + (size_t)(t0 + i) * 1024 + c0) = ov;
        }
    }
    LAS float* ACST = (LAS float*)(ldsb + 34816 * 3);
    {
        const int s = tid >> 2, hh = tid & 3, H = g * 4 + hh;
        const float A = -__expf(a_log[H]);
        const float raw = DTRAW[(size_t)(tok0 + s) * 8 + H] + dt_bias[H];
        const float dtv = fmaxf(raw, 0.f) + log1pf(__expf(-fabsf(raw)));
        float v = dtv * A;
#pragma unroll
        for (int o = 4; o < 64; o <<= 1) { const float y = __shfl_up(v, o); if (lane >= o) v += y; }
        if (lane >= 60) WT[wave * 4 + hh] = v;
        __syncthreads();
        float off = 0.f;
        for (int w2 = 0; w2 < wave; ++w2) off += WT[w2 * 4 + hh];
        v += off;
        DTT[tid] = dtv; ACST[tid] = v; ACS[(size_t)(tok0 + s) * 8 + H] = v;
        if (s == 127) CDEC[bc * 8 + H] = __expf(v);
    }
    asm volatile("s_waitcnt vmcnt(0)" ::: "memory");
    __syncthreads();
    LAS bf16* BT = (LAS bf16*)ldsb;
    LAS bf16* XD = (LAS bf16*)(ldsb + 34816);
    LAS bf16* XW = (LAS bf16*)(ldsb + 34816 + 34816);
    const int r = lane & 31, hi = lane >> 5;
#pragma unroll
    for (int i = 0; i < 4; ++i) {
        const int c = tid + 512 * i, s = c >> 4, n0 = (c & 15) * 8;
        const bf16x8 v = ldg8(XACT + (size_t)(tok0 + s) * 1024 + 512 + g * 128 + n0);
#pragma unroll
        for (int e = 0; e < 8; ++e) BT[(n0 + e) * 136 + s] = (bf16)v[e];
    }
#pragma unroll 1
    for (int hp = 0; hp < 2; ++hp) {
        if (hp) __syncthreads();
        int tidp = tid; asm volatile("" : "+v"(tidp));
#pragma unroll
        for (int i = 0; i < 4; ++i) {
            const int c = tidp + 512 * i, hsel = c >> 10, s = (c >> 3) & 127, p0 = (c & 7) * 8, H = g * 4 + 2 * hp + hsel;
            const bf16x8 v = ldg8(XACT + (size_t)(tok0 + s) * 1024 + H * 64 + p0);
            const float dtv = DTT[s * 4 + 2 * hp + hsel];
            const float w = __expf(ACST[127 * 4 + 2 * hp + hsel] - ACST[s * 4 + 2 * hp + hsel]);
#pragma unroll
            for (int e = 0; e < 8; ++e) { const float xd = sbf2f(v[e]) * dtv; XD[hsel * 8704 + (p0 + e) * 136 + s] = (bf16)bfs(xd); XW[hsel * 8704 + (p0 + e) * 136 + s] = (bf16)bfs(xd * w); }
        }
        __syncthreads();
        {
            const int lt = wave & 3, hsel = wave >> 2, hh = 2 * hp + hsel, H = g * 4 + hh;
            const int l = 32 * lt + r; const float acs_l = ACST[l * 4 + hh];
            bf16x8 cf[8];
            { const bf16* cp = XACT + (size_t)(tok0 + l) * 1024 + 768 + g * 128 + 8 * hi; asm volatile("" : "+v"(cp));
#pragma unroll
              for (int ks = 0; ks < 8; ++ks) cf[ks] = ldg8(cp + 16 * ks); }
            f32x16 Z0 = zero16(), Z1 = zero16();
            bf16x8 bn[8];
            { const bf16* bp = XACT + (size_t)(tok0 + r) * 1024 + 512 + g * 128 + 8 * hi; asm volatile("" : "+v"(bp));
#pragma unroll
              for (int ks = 0; ks < 8; ++ks) bn[ks] = ldg8(bp + 16 * ks); }
#pragma unroll 1
            for (int st = 0; st <= lt; ++st) {
                f32x16 X = zero16();
                bf16x8 bc[8];
#pragma unroll
                for (int ks = 0; ks < 8; ++ks) bc[ks] = bn[ks];
                { const int stn = st < lt ? st + 1 : lt; const bf16* bp = XACT + (size_t)(tok0 + 32 * stn + r) * 1024 + 512 + g * 128 + 8 * hi; asm volatile("" : "+v"(bp));
#pragma unroll
                  for (int ks = 0; ks < 8; ++ks) bn[ks] = ldg8(bp + 16 * ks); }
#pragma unroll
                for (int ks = 0; ks < 8; ++ks) X = MFMA32(bc[ks], cf[ks], X);
#pragma unroll
                for (int i = 0; i < 16; ++i) { const int s = 32 * st + crow(i, hi); const float f = (s <= l) ? __expf(acs_l - ACST[s * 4 + hh]) : 0.f; X[i] *= f; }
                const int sb = 32 * st + 4 * hi;
                { const bf16x8 xs = pack8<0>(X); const bf16x8 b0 = lds4x2(XD + hsel * 8704 + r * 136 + sb), b1 = lds4x2(XD + hsel * 8704 + (32 + r) * 136 + sb); Z0 = MFMA32(xs, b0, Z0); Z1 = MFMA32(xs, b1, Z1); }
                { const bf16x8 xs = pack8<1>(X); const bf16x8 b0 = lds4x2(XD + hsel * 8704 + r * 136 + sb + 16), b1 = lds4x2(XD + hsel * 8704 + (32 + r) * 136 + sb + 16); Z0 = MFMA32(xs, b0, Z0); Z1 = MFMA32(xs, b1, Z1); }
            }
#pragma unroll
            for (int i = 0; i < 16; ++i) { float* o = MIXF + (size_t)(tok0 + 32 * lt + crow(i, hi)) * D + 512 + H * 64 + r; o[0] = Z0[i]; o[32] = Z1[i]; }
        }
        {
            const int nt = wave & 3, hsel = wave >> 2, H = g * 4 + 2 * hp + hsel;
            f32x16 S0 = zero16(), S1 = zero16();
#pragma unroll
            for (int ks = 0; ks < 8; ++ks) {
                const bf16x8 btf = lds8(BT + (32 * nt + r) * 136 + 16 * ks + 8 * hi);
                const bf16x8 a0 = lds8(XW + hsel * 8704 + r * 136 + 16 * ks + 8 * hi), a1 = lds8(XW + hsel * 8704 + (32 + r) * 136 + 16 * ks + 8 * hi);
                S0 = MFMA32(a0, btf, S0); S1 = MFMA32(a1, btf, S1);
            }
            float* sp = STATES + (size_t)(bc * 8 + H) * 8192 + 32 * nt + r;
#pragma unroll
            for (int i = 0; i < 16; ++i) { const int p = crow(i, hi); sp[p * 128] = S0[i]; sp[(32 + p) * 128] = S1[i]; }
        }
    }
    __syncthreads();
}

__device__ __forceinline__ __amdgpu_buffer_rsrc_t mk_rsrc(const void* p, unsigned bytes) { return __builtin_amdgcn_make_buffer_rsrc((void*)p, 0, bytes, 0x00020000); }
__device__ __forceinline__ void yoff_unit(const float* d_skip, const float* gnorm, LAS unsigned char* ldsb, int unit, const bf16* XACT, const bf16* PROJ, const float* ACS, const bf16* PREVT,
                                          const float* MIXF, bf16* MIXB, int lane, int wave) {
    const int g = unit & 1, bc = unit >> 1, tok0 = bc * 128;
    const int r = lane & 31, hi = lane >> 5, lt = wave & 3, hpair = wave >> 2;
    LAS float* TAB = (LAS float*)ldsb;
    const __amdgpu_buffer_rsrc_t rsF = mk_rsrc(MIXF, (unsigned)T * D * 4u), rsX = mk_rsrc(XACT, (unsigned)T * 1024u * 2u), rsP = mk_rsrc(PROJ, (unsigned)T * PS * 2u), rsA = mk_rsrc(ACS, (unsigned)T * 32u), rsB = mk_rsrc(MIXB, (unsigned)T * D * 2u);
    const unsigned tb = (unsigned)(tok0 + 32 * lt + 4 * hi);
    bf16x8 cf[8];
    { const bf16* cp = XACT + (size_t)(tok0 + 32 * lt + r) * 1024 + 768 + g * 128 + 8 * hi; asm volatile("" : "+v"(cp));
#pragma unroll
      for (int ks = 0; ks < 8; ++ks) cf[ks] = ldg8(cp + 16 * ks); }
    float eav[16], ssq[16];
    unsigned ypk[2][2][8];
#pragma unroll
    for (int i = 0; i < 16; ++i) ssq[i] = 0.f;
#pragma unroll
    for (int hsel = 0; hsel < 2; ++hsel) {
        const int H = g * 4 + 2 * hpair + hsel; const bf16* pv = PREVT + (size_t)(bc * 8 + H) * 8192 + 8 * hi;
        asm volatile("" : "+v"(pv));
        f32x16 Y0 = zero16(), Y1 = zero16();
#pragma unroll
        for (int ks = 0; ks < 8; ++ks) {
            const bf16x8 b0 = ldg8(pv + r * 128 + 16 * ks), b1 = ldg8(pv + (32 + r) * 128 + 16 * ks);
            Y0 = MFMA32(cf[ks], b0, Y0); Y1 = MFMA32(cf[ks], b1, Y1);
        }
        const float dsk = d_skip[H];
        { const unsigned vo = (tb * 8u + (unsigned)H) * 4u;
#pragma unroll
          for (int i = 0; i < 16; ++i) eav[i] = __expf(__builtin_bit_cast(float, __builtin_amdgcn_raw_buffer_load_b32(rsA, (int)vo, ((i & 3) + 8 * (i >> 2)) * 32, 0))); }
#pragma unroll
        for (int pt = 0; pt < 2; ++pt) {
            const unsigned col = (unsigned)(H * 64 + 32 * pt + r);
            const unsigned voF = (tb * 1024u + 512u + col) * 4u, voX = (tb * 1024u + col) * 2u, voP = (tb * (unsigned)PS + (unsigned)OZ + col) * 2u;
            float yo[16], xsv[16], zv[16];
#pragma unroll
            for (int i = 0; i < 16; ++i) { const int ro = (i & 3) + 8 * (i >> 2);
                yo[i] = __builtin_bit_cast(float, __builtin_amdgcn_raw_buffer_load_b32(rsF, (int)voF, ro * 4096, 0));
                xsv[i] = bf2f((bf16)__builtin_amdgcn_raw_buffer_load_b16(rsX, (int)voX, ro * 2048, 0));
                zv[i] = bf2f((bf16)__builtin_amdgcn_raw_buffer_load_b16(rsP, (int)voP, ro * (PS * 2), 0)); }
#pragma unroll
            for (int i = 0; i < 16; i += 2) {
                const float y0 = (yo[i] + eav[i] * (pt ? Y1[i] : Y0[i]) + dsk * xsv[i]) * silu_f(zv[i]);
                const float y1 = (yo[i + 1] + eav[i + 1] * (pt ? Y1[i + 1] : Y0[i + 1]) + dsk * xsv[i + 1]) * silu_f(zv[i + 1]);
                ssq[i] += y0 * y0; ssq[i + 1] += y1 * y1; ypk[hsel][pt][i >> 1] = pkbf(y0, y1);
            }
            __builtin_amdgcn_sched_barrier(0);
        }
    }
#pragma unroll
    for (int i = 0; i < 16; ++i) {
#pragma unroll
        for (int o = 1; o < 32; o <<= 1) ssq[i] += __shfl_xor(ssq[i], o);
    }
    if (r == 0) {
#pragma unroll
        for (int i = 0; i < 16; ++i) TAB[hpair * 128 + 32 * lt + crow(i, hi)] = ssq[i];
    }
    __syncthreads();
#pragma unroll
    for (int i = 0; i < 16; ++i) { const int l = 32 * lt + crow(i, hi); ssq[i] = rsqrtf((TAB[l] + TAB[128 + l]) * (1.f / 256.f) + EPS); }
#pragma unroll
    for (int hsel = 0; hsel < 2; ++hsel)
#pragma unroll
        for (int pt = 0; pt < 2; ++pt) {
            const unsigned col = (unsigned)((g * 4 + 2 * hpair + hsel) * 64 + 32 * pt + r); const float gn = gnorm[col];
            const unsigned voB = (tb * 1024u + 512u + col) * 2u;
#pragma unroll
            for (int i = 0; i < 16; ++i) { const unsigned w = ypk[hsel][pt][i >> 1];
                const float yf = (i & 1) ? __uint_as_float(w & 0xffff0000u) : __uint_as_float(w << 16);
                __builtin_amdgcn_raw_buffer_store_b16((short)f2bf(yf * ssq[i] * gn), rsB, (int)voB, ((i & 3) + 8 * (i >> 2)) * 2048, 0); }
        }
    __syncthreads();
}
typedef float f32x2 __attribute__((ext_vector_type(2)));
__device__ __forceinline__ void fp8x16_to_f32(const uint4 w, float (&f)[16]) {
    const int ww[4] = {(int)w.x, (int)w.y, (int)w.z, (int)w.w};
#pragma unroll
    for (int q = 0; q < 4; ++q) { const f32x2 a = __builtin_amdgcn_cvt_pk_f32_fp8(ww[q], false), b = __builtin_amdgcn_cvt_pk_f32_fp8(ww[q], true); f[4 * q] = a.x; f[4 * q + 1] = a.y; f[4 * q + 2] = b.x; f[4 * q + 3] = b.y; }
}
template <int M4, int M2, int M1> __device__ __forceinline__ void treduce16(const float (&a)[16], int lane, float& r0, float& r1) {
    float b[8], c[4];
    { const bool hi = (lane & M4) != 0;
#pragma unroll
      for (int i = 0; i < 8; ++i) { const float send = hi ? a[i] : a[i + 8]; const float recv = __shfl_xor(send, M4); b[i] = (hi ? a[i + 8] : a[i]) + recv; } }
    { const bool hi = (lane & M2) != 0;
#pragma unroll
      for (int i = 0; i < 4; ++i) { const float send = hi ? b[i] : b[i + 4]; const float recv = __shfl_xor(send, M2); c[i] = (hi ? b[i + 4] : b[i]) + recv; } }
    { const bool hi = (lane & M1) != 0;
      { const float send = hi ? c[0] : c[2]; const float recv = __shfl_xor(send, M1); r0 = (hi ? c[2] : c[0]) + recv; }
      { const float send = hi ? c[1] : c[3]; const float recv = __shfl_xor(send, M1); r1 = (hi ? c[3] : c[1]) + recv; } }
}
template <int M4, int M2, int M1> __device__ __forceinline__ void treduce16i(const int (&a)[16], int lane, int& r0, int& r1) {
    int b[8], c[4];
    { const bool hi = (lane & M4) != 0;
#pragma unroll
      for (int i = 0; i < 8; ++i) { const int send = hi ? a[i] : a[i + 8]; const int recv = __shfl_xor(send, M4); b[i] = (hi ? a[i + 8] : a[i]) + recv; } }
    { const bool hi = (lane & M2) != 0;
#pragma unroll
      for (int i = 0; i < 4; ++i) { const int send = hi ? b[i] : b[i + 4]; const int recv = __shfl_xor(send, M2); c[i] = (hi ? b[i + 4] : b[i]) + recv; } }
    { const bool hi = (lane & M1) != 0;
      { const int send = hi ? c[0] : c[2]; const int recv = __shfl_xor(send, M1); r0 = (hi ? c[2] : c[0]) + recv; }
      { const int send = hi ? c[1] : c[3]; const int recv = __shfl_xor(send, M1); r1 = (hi ? c[3] : c[1]) + recv; } }
}
#define PE_ID(E, i) (((i) & 1) ? (E[(i) >> 1] >> 16) : (E[(i) >> 1] & 0xffffu))
__device__ __forceinline__ void peer_u_item(int p, int j, const LAS unsigned short* EL  , const unsigned char* __restrict__ XQ, const unsigned char* __restrict__ U8, LAS int* ACC  , int lane, int wave) {
    asm volatile("" : "+v"(lane));
    const int gidx = lane >> 3; const unsigned coff = (unsigned)(p * 128 + (lane & 7) * 16);
#pragma unroll 1
    for (int it = 0; it < 8; ++it) {
        const int t = j * 64 + it * 8 + wave;
        unsigned E[8];
        { const LAS v4u* ep = (const LAS v4u*)(EL + (it * 8 + wave) * 128 + 16 * gidx); const v4u e0 = ep[0], e1 = ep[1];
          E[0] = e0.x; E[1] = e0.y; E[2] = e0.z; E[3] = e0.w; E[4] = e1.x; E[5] = e1.y; E[6] = e1.z; E[7] = e1.w; }
        uint4 uu[16];
#pragma unroll
        for (int i = 0; i < 16; ++i) uu[i] = *(const uint4*)(U8 + (size_t)(PE_ID(E, i) * 1024u + coff));
        const uint4 xq = *(const uint4*)(XQ + (size_t)t * D + coff);
        int d[16];
#pragma unroll
        for (int i = 0; i < 16; ++i) {
            int s = __builtin_amdgcn_sdot4((int)uu[i].x, (int)xq.x, 0, false); s = __builtin_amdgcn_sdot4((int)uu[i].y, (int)xq.y, s, false);
            s = __builtin_amdgcn_sdot4((int)uu[i].z, (int)xq.z, s, false); s = __builtin_amdgcn_sdot4((int)uu[i].w, (int)xq.w, s, false);
            d[i] = s;
        }
        int r0, r1; treduce16i<4, 2, 1>(d, lane, r0, r1);
        { typedef int i2v __attribute__((ext_vector_type(2))); LAS i2v* ap = (LAS i2v*)(ACC + (it * 8 + wave) * 128 + 2 * lane);
          i2v a2; if (p == 0) { a2.x = r0; a2.y = r1; } else { a2 = *ap; a2.x += r0; a2.y += r1; } *ap = a2; }
    }
}
__device__ __forceinline__ void peer_v_item(int p, int j, const LAS unsigned short* EL, const LAS unsigned char* AL  , const LAS float* ASC  ,
                                            const unsigned char* __restrict__ V8, bf16* __restrict__ PEERO, int lane, int wave) {
    asm volatile("" : "+v"(lane));
    const int gidx = lane >> 3; const unsigned coff = (unsigned)(p * 128 + (lane & 7) * 16);
#pragma unroll 1
    for (int it = 0; it < 8; ++it) {
        const int t = j * 64 + it * 8 + wave;
        unsigned E[8];
        { const LAS v4u* ep = (const LAS v4u*)(EL + (it * 8 + wave) * 128 + 16 * gidx); const v4u e0 = ep[0], e1 = ep[1];
          E[0] = e0.x; E[1] = e0.y; E[2] = e0.z; E[3] = e0.w; E[4] = e1.x; E[5] = e1.y; E[6] = e1.z; E[7] = e1.w; }
        uint4 vv[16];
#pragma unroll
        for (int i = 0; i < 16; ++i) vv[i] = *(const uint4*)(V8 + (size_t)(PE_ID(E, i) * 1024u + coff));
        const v4u aq = *(const LAS v4u*)(AL + (it * 8 + wave) * 128 + 16 * gidx);
        const float asc = ASC[it * 8 + wave];
        const unsigned a4[4] = {aq.x, aq.y, aq.z, aq.w};
        int acc[16];
#pragma unroll
        for (int c = 0; c < 16; ++c) acc[c] = 0;
#pragma unroll
        for (int m = 0; m < 4; ++m) {
            const unsigned r0[4] = {vv[4 * m].x, vv[4 * m].y, vv[4 * m].z, vv[4 * m].w}, r1[4] = {vv[4 * m + 1].x, vv[4 * m + 1].y, vv[4 * m + 1].z, vv[4 * m + 1].w};
            const unsigned r2[4] = {vv[4 * m + 2].x, vv[4 * m + 2].y, vv[4 * m + 2].z, vv[4 * m + 2].w}, r3[4] = {vv[4 * m + 3].x, vv[4 * m + 3].y, vv[4 * m + 3].z, vv[4 * m + 3].w};
#pragma unroll
            for (int dc = 0; dc < 4; ++dc) {
                const unsigned ta = __builtin_amdgcn_perm(r1[dc], r0[dc], 0x05010400u), tb = __builtin_amdgcn_perm(r3[dc], r2[dc], 0x05010400u);
                const unsigned ua = __builtin_amdgcn_perm(r1[dc], r0[dc], 0x07030602u), ub = __builtin_amdgcn_perm(r3[dc], r2[dc], 0x07030602u);
                const unsigned c0 = __builtin_amdgcn_perm(tb, ta, 0x05040100u), c1 = __builtin_amdgcn_perm(tb, ta, 0x07060302u);
                const unsigned c2 = __builtin_amdgcn_perm(ub, ua, 0x05040100u), c3 = __builtin_amdgcn_perm(ub, ua, 0x07060302u);
                acc[4 * dc + 0] = __builtin_amdgcn_sdot4((int)c0, (int)a4[m], acc[4 * dc + 0], false);
                acc[4 * dc + 1] = __builtin_amdgcn_sdot4((int)c1, (int)a4[m], acc[4 * dc + 1], false);
                acc[4 * dc + 2] = __builtin_amdgcn_sdot4((int)c2, (int)a4[m], acc[4 * dc + 2], false);
                acc[4 * dc + 3] = __builtin_amdgcn_sdot4((int)c3, (int)a4[m], acc[4 * dc + 3], false);
            }
        }
        int r0i, r1i; treduce16i<32, 16, 8>(acc, lane, r0i, r1i);
        *(unsigned*)(PEERO + (size_t)t * D + coff + 2 * gidx) = pkbf(asc * (float)r0i, asc * (float)r1i);
    }
}

__device__ __forceinline__ void ce_desc(float& a, float& b) { const float hi = fmaxf(a, b), lo = fminf(a, b); a = hi; b = lo; }
__device__ __forceinline__ void sort16_desc(float (&v)[16]) {
#pragma unroll
    for (int k = 2; k <= 16; k <<= 1)
#pragma unroll
        for (int j = k >> 1; j > 0; j >>= 1)
#pragma unroll
            for (int i = 0; i < 16; ++i) { const int l = i ^ j; if (l > i) { if ((i & k) == 0) ce_desc(v[i], v[l]); else ce_desc(v[l], v[i]); } }
}
__device__ __forceinline__ void merge16_desc(float (&a)[16], const float (&b)[16]) {
#pragma unroll
    for (int i = 0; i < 16; ++i) a[i] = fmaxf(a[i], b[15 - i]);
#pragma unroll
    for (int j = 8; j > 0; j >>= 1)
#pragma unroll
        for (int i = 0; i < 16; ++i) { const int l = i ^ j; if (l > i) ce_desc(a[i], a[l]); }
}
__device__ __forceinline__ void ce_kv(float& ka, int& va, float& kb, int& vb) {
    const bool s = kb > ka; const float t0 = s ? kb : ka, t1 = s ? ka : kb; const int u0 = s ? vb : va, u1 = s ? va : vb; ka = t0; kb = t1; va = u0; vb = u1; }
__device__ __forceinline__ void sort16_kv(float (&k)[16], int (&v)[16]) {
#pragma unroll
    for (int kk = 2; kk <= 16; kk <<= 1)
#pragma unroll
        for (int j = kk >> 1; j > 0; j >>= 1)
#pragma unroll
            for (int i = 0; i < 16; ++i) { const int l = i ^ j; if (l > i) { if ((i & kk) == 0) ce_kv(k[i], v[i], k[l], v[l]); else ce_kv(k[l], v[l], k[i], v[i]); } }
}
__device__ __forceinline__ void merge16_kv(float (&ka)[16], int (&va)[16], const float (&kb)[16], const int (&vb)[16]) {
#pragma unroll
    for (int i = 0; i < 16; ++i) { const bool s = kb[15 - i] > ka[i]; ka[i] = s ? kb[15 - i] : ka[i]; va[i] = s ? vb[15 - i] : va[i]; }
#pragma unroll
    for (int j = 8; j > 0; j >>= 1)
#pragma unroll
        for (int i = 0; i < 16; ++i) { const int l = i ^ j; if (l > i) ce_kv(ka[i], va[i], ka[l], va[l]); }
}
__device__ __forceinline__ void split8(const float* p, bf16x8& hi8, bf16x8& lo8) {
    const float4 f0 = *(const float4*)p, f1 = *(const float4*)(p + 4);
    const float x[8] = {f0.x, f0.y, f0.z, f0.w, f1.x, f1.y, f1.z, f1.w};
#pragma unroll
    for (int j = 0; j < 8; ++j) { const short h = bfs(x[j]); hi8[j] = h; lo8[j] = bfs(x[j] - sbf2f(h)); }
}
__device__ __forceinline__ void route_task(int task, int tl0, const float* QP, const LAS bf16* KHL, LAS unsigned short* EL, LAS float* GL, int lane) {
    const int r = lane & 31, hi = lane >> 5, t = 4 * task + (r >> 3), head = r & 7;
    float top[2][16];
#pragma unroll
    for (int half = 0; half < 2; ++half) {
        bf16x8 qh[4], ql[4];
        { const float* qp = QP + (size_t)t * D + head * 128 + half * 64 + 8 * hi; asm volatile("" : "+v"(qp));
#pragma unroll
          for (int ks = 0; ks < 4; ++ks) split8(qp + 16 * ks, qh[ks], ql[ks]); }
        float cur[16];
#pragma unroll
        for (int kt = 0; kt < 4; ++kt) {
            f32x16 X = zero16();
            const LAS bf16* khp = KHL + (half * 128 + 32 * kt + r) * 72 + 8 * hi;
#pragma unroll
            for (int ks = 0; ks < 4; ++ks) {
                const bf16x8 kh = lds8(khp + 16 * ks), kl = lds8(khp + 2 * 128 * 72 + 16 * ks);
                X = MFMA32(kh, qh[ks], X); X = MFMA32(kh, ql[ks], X); X = MFMA32(kl, qh[ks], X);
            }
            float grp[16];
#pragma unroll
            for (int i = 0; i < 16; ++i) { const unsigned key = (unsigned)(32 * kt + crow(i, hi)); grp[i] = __uint_as_float((__float_as_uint(X[i]) & ~127u) | (127u - key)); }
            sort16_desc(grp);
            if (kt == 0) {
#pragma unroll
                for (int i = 0; i < 16; ++i) cur[i] = grp[i];
            } else merge16_desc(cur, grp);
        }
        float oth[16];
#pragma unroll
        for (int i = 0; i < 16; ++i) oth[i] = __shfl_xor(cur[i], 32);
        merge16_desc(cur, oth);
#pragma unroll
        for (int i = 0; i < 16; ++i) top[half][i] = cur[i];
    }
    unsigned P1[4], P2[4];
#pragma unroll
    for (int q = 0; q < 4; ++q) { P1[q] = 0u; P2[q] = 0u;
#pragma unroll
        for (int s = 0; s < 4; ++s) { P1[q] |= (127u - (__float_as_uint(top[0][4 * q + s]) & 127u)) << (8 * s); P2[q] |= (127u - (__float_as_uint(top[1][4 * q + s]) & 127u)) << (8 * s); } }
#define CAND(a, b) __uint_as_float((__float_as_uint(top[0][a] + top[1][b]) & ~255u) | (255u - (unsigned)((a) * 16 + (b))))
    float bk[16];
    {
        float gk[16];
        gk[0] = CAND(0, 0);
        gk[1] = CAND(0, 1);
        gk[2] = CAND(0, 2);
        gk[3] = CAND(0, 3);
        gk[4] = CAND(0, 4);
        gk[5] = CAND(0, 5);
        gk[6] = CAND(0, 6);
        gk[7] = CAND(0, 7);
        gk[8] = CAND(0, 8);
        gk[9] = CAND(0, 9);
        gk[10] = CAND(0, 10);
        gk[11] = CAND(0, 11);
        gk[12] = CAND(0, 12);
        gk[13] = CAND(0, 13);
        gk[14] = CAND(0, 14);
        gk[15] = CAND(0, 15);
        sort16_desc(gk);
#pragma unroll
        for (int i = 0; i < 16; ++i) bk[i] = gk[i];
    }
    {
        float gk[16];
        gk[0] = CAND(1, 0);
        gk[1] = CAND(1, 1);
        gk[2] = CAND(1, 2);
        gk[3] = CAND(1, 3);
        gk[4] = CAND(1, 4);
        gk[5] = CAND(1, 5);
        gk[6] = CAND(1, 6);
        gk[7] = CAND(1, 7);
        gk[8] = CAND(2, 0);
        gk[9] = CAND(2, 1);
        gk[10] = CAND(2, 2);
        gk[11] = CAND(2, 3);
        gk[12] = CAND(2, 4);
        gk[13] = CAND(3, 0);
        gk[14] = CAND(3, 1);
        gk[15] = CAND(3, 2);
        sort16_desc(gk);
        merge16_desc(bk, gk);
    }
    {
        float gk[16];
        gk[0] = CAND(3, 3);
        gk[1] = CAND(4, 0);
        gk[2] = CAND(4, 1);
        gk[3] = CAND(4, 2);
        gk[4] = CAND(5, 0);
        gk[5] = CAND(5, 1);
        gk[6] = CAND(6, 0);
        gk[7] = CAND(6, 1);
        gk[8] = CAND(7, 0);
        gk[9] = CAND(7, 1);
        gk[10] = CAND(8, 0);
        gk[11] = CAND(9, 0);
        gk[12] = CAND(10, 0);
        gk[13] = CAND(11, 0);
        gk[14] = CAND(12, 0);
        gk[15] = CAND(13, 0);
        sort16_desc(gk);
        merge16_desc(bk, gk);
    }
    {
        float gk[16];
        gk[0] = CAND(14, 0);
        gk[1] = CAND(15, 0);
        gk[2] = -INFINITY;
        gk[3] = -INFINITY;
        gk[4] = -INFINITY;
        gk[5] = -INFINITY;
        gk[6] = -INFINITY;
        gk[7] = -INFINITY;
        gk[8] = -INFINITY;
        gk[9] = -INFINITY;
        gk[10] = -INFINITY;
        gk[11] = -INFINITY;
        gk[12] = -INFINITY;
        gk[13] = -INFINITY;
        gk[14] = -INFINITY;
        gk[15] = -INFINITY;
        sort16_desc(gk);
        merge16_desc(bk, gk);
    }
#undef CAND
    int bv[16];
#pragma unroll
    for (int i = 0; i < 16; ++i) {
        const unsigned cd = 255u - (__float_as_uint(bk[i]) & 255u), ca = cd >> 4, cb = cd & 15u;
        const unsigned wa = (ca >> 2) == 0u ? P1[0] : (ca >> 2) == 1u ? P1[1] : (ca >> 2) == 2u ? P1[2] : P1[3];
        const unsigned wb = (cb >> 2) == 0u ? P2[0] : (cb >> 2) == 1u ? P2[1] : (cb >> 2) == 2u ? P2[2] : P2[3];
        bv[i] = (int)((((wa >> (8u * (ca & 3u))) & 255u) << 7) | ((wb >> (8u * (cb & 3u))) & 255u));
    }
    float e[16], se = 0.f;
#pragma unroll
    for (int i = 0; i < 16; ++i) { e[i] = __expf(bk[i] - bk[0]); se += e[i]; }
    const float inv = 1.f / se;
    if (hi == 0) {
        LAS v4u* ip = (LAS v4u*)(EL + (tl0 + (r >> 3)) * 128 + head * 16); typedef float f4v __attribute__((ext_vector_type(4))); LAS f4v* gp = (LAS f4v*)(GL + (tl0 + (r >> 3)) * 128 + head * 16);
#pragma unroll
        for (int q = 0; q < 2; ++q) ip[q] = (v4u){(unsigned)bv[8 * q] | ((unsigned)bv[8 * q + 1] << 16), (unsigned)bv[8 * q + 2] | ((unsigned)bv[8 * q + 3] << 16), (unsigned)bv[8 * q + 4] | ((unsigned)bv[8 * q + 5] << 16), (unsigned)bv[8 * q + 6] | ((unsigned)bv[8 * q + 7] << 16)};
#pragma unroll
        for (int q = 0; q < 4; ++q) gp[q] = (f4v){e[4 * q] * inv, e[4 * q + 1] * inv, e[4 * q + 2] * inv, e[4 * q + 3] * inv};
    }
}

#define XB_TMO      128
#define XB_XCNT(j)  (256  + 64 * (j))
#define XB_XSUB(j)  (1280 + 64 * (j))
#define XB_XGEN(j)  (2304 + 64 * (j))
#define XB_TOP      3328
#define XB_TOPGEN   3392
#define XCD_BAR_WORDS 3456
#define XB_SPIN_CAP (1u << 22)
__device__ __forceinline__ unsigned xb_ld(unsigned* p)              { return __hip_atomic_load(p, __ATOMIC_RELAXED, __HIP_MEMORY_SCOPE_AGENT); }
__device__ __forceinline__ unsigned xb_add(unsigned* p, unsigned v) { return __hip_atomic_fetch_add(p, v, __ATOMIC_RELAXED, __HIP_MEMORY_SCOPE_AGENT); }
__device__ __forceinline__ unsigned xb_xcc_id() { return (unsigned)__builtin_amdgcn_s_getreg((3 << 11) | 20) & 0xFu; }
#define XB_SPIN(cond, bar) do { unsigned _sp = 0; while (cond) { __builtin_amdgcn_s_sleep(1); \
    if ((++_sp & 255u) == 0u) { if (xb_ld(&(bar)[XB_TMO])) break; if (_sp > XB_SPIN_CAP) { atomicAdd(&(bar)[XB_TMO], 1u); break; } } } } while (0)
struct XcdBarrier { unsigned* bar; unsigned x; volatile LAS unsigned* st; };
__device__ __forceinline__ XcdBarrier xcd_barrier_post(unsigned* bar, volatile LAS unsigned* st) {
    XcdBarrier b; b.bar = bar; b.x = xb_xcc_id(); b.st = st;
    if (threadIdx.x == 0) (void)xb_add(&bar[XB_XCNT(b.x)], 1u);
    return b;
}
__device__ __forceinline__ void xcd_barrier_complete(unsigned* bar, unsigned x, unsigned& nloc, unsigned& nx) {
    const unsigned G = gridDim.x * gridDim.y * gridDim.z;
    unsigned sum, cnt, mine, sp = 0u;
    for (;;) {
        sum = 0u; cnt = 0u; mine = 0u;
#pragma unroll
        for (unsigned j = 0; j < 16; ++j) { const unsigned c = xb_ld(&bar[XB_XCNT(j)]); sum += c; cnt += (c > 0u) ? 1u : 0u; mine = (j == x) ? c : mine; }
        if (sum == G) break;
        __builtin_amdgcn_s_sleep(1);
        if ((++sp & 255u) == 0u) { if (xb_ld(&bar[XB_TMO])) break; if (sp > XB_SPIN_CAP) { atomicAdd(&bar[XB_TMO], 1u); break; } }
    }
    nloc = mine > 0u ? mine : 1u; nx = cnt > 0u ? cnt : 1u;
}
__device__ __forceinline__ void xcd_barrier(const XcdBarrier& b) {
    asm volatile("s_waitcnt vmcnt(0)" ::: "memory");
    __syncthreads();
    if (threadIdx.x == 0) {
        unsigned* bar = b.bar;
        __builtin_amdgcn_s_waitcnt(0);
        unsigned nloc = b.st[0], nx = b.st[1];
        if (nloc == 0u) { xcd_barrier_complete(bar, b.x, nloc, nx); b.st[0] = nloc; b.st[1] = nx; }
        const unsigned old = xb_add(&bar[XB_XSUB(b.x)], 1u);
        const unsigned gen = old / nloc;
        if (old + 1u == (gen + 1u) * nloc) {
            __builtin_amdgcn_fence(__ATOMIC_RELEASE, "agent");
            asm volatile("s_waitcnt vmcnt(0)" ::: "memory");
            const unsigned og = xb_add(&bar[XB_TOP], 1u);
            const unsigned tg = og / nx;
            if (og + 1u == (tg + 1u) * nx) xb_add(&bar[XB_TOPGEN], 1u);
            else XB_SPIN(xb_ld(&bar[XB_TOPGEN]) == tg, bar);
            __builtin_amdgcn_fence(__ATOMIC_ACQUIRE, "agent");
            xb_add(&bar[XB_XGEN(b.x)], 1u);
            asm volatile("s_waitcnt vmcnt(0)" ::: "memory");
        } else {
            XB_SPIN(xb_ld(&bar[XB_XGEN(b.x)]) == gen, bar);
            __builtin_amdgcn_fence(__ATOMIC_ACQUIRE, "agent");
            asm volatile("s_waitcnt vmcnt(0)" ::: "memory");
        }
    }
    __syncthreads();
}
constexpr int LDS_BYTES = 147456;
constexpr int MISC_OFF = 131072 + 320;

__global__ void __launch_bounds__(NTHR, 2) k_main(Args a) {
    extern __shared__ __attribute__((aligned(16))) unsigned char lds_raw[];
    LAS unsigned char* ldsb = (LAS unsigned char*)lds_raw;
    const int tid0 = threadIdx.x, bid = blockIdx.x, nb = gridDim.x;
    const int wave = __builtin_amdgcn_readfirstlane(tid0 >> 6);
    const int gthreads = nb * NTHR, nwaves = gthreads >> 6;
#define PHASE_VARS() int tid = tid0; asm volatile("" : "+v"(tid)); const int lane = tid & 63, gtid = bid * NTHR + tid, gwave = gtid >> 6; (void)lane; (void)gtid; (void)gwave
    unsigned char* ws = a.ws;
    bf16* WINT = (bf16*)(ws + WS_WIN); bf16* WOT = (bf16*)(ws + WS_WO); bf16* WQT = (bf16*)(ws + WS_WQ);
    bf16* PROJ = (bf16*)(ws + WS_PROJ);
    bf16* XNB = (bf16*)(ws + WS_XNB);
    bf16* XACT = (bf16*)(ws + WS_XACT);
    float* DTRAW = (float*)(ws + WS_DTRAW); float* DT = (float*)(ws + WS_DT); float* ACS = (float*)(ws + WS_ACS); float* CDEC = (float*)(ws + WS_CDEC);
    float* STATES = (float*)(ws + WS_STATES); bf16* PREVT = (bf16*)(ws + WS_PREV);
    float* QP = (float*)(ws + WS_QP); unsigned short* IDX = (unsigned short*)(ws + WS_IDX); float* GATE = (float*)(ws + WS_GATE);
    float* TOPV = (float*)(ws + WS_TOPV); int* TOPI = (int*)(ws + WS_TOPI);
    unsigned char* U8 = ws + WS_U8; unsigned char* V8 = ws + WS_V8; float* SU = (float*)(ws + WS_SU); float* SV = SU + 16384; bf16* PART = (bf16*)(ws + WS_PART); unsigned char* XQ = ws + WS_XQ; float* XS = (float*)(ws + WS_XS);
    bf16* KH = (bf16*)(ws + WS_KH); bf16* KL = (bf16*)(ws + WS_KH + 65536);
    bf16* HB = (bf16*)(ws + WS_STATES);
    float* MIXF = a.out;
    volatile LAS unsigned* MISC = (volatile LAS unsigned*)(ldsb + MISC_OFF);
    if (tid0 < 32) MISC[tid0] = 0u;
    __syncthreads();
    XcdBarrier bar = xcd_barrier_post((unsigned*)ws, MISC + 8);
#define IN(k) (a.ph_lo <= (k) && (k) < a.ph_hi)
#if defined(PROBE_LO)
    int seg_ = 0; unsigned long long tseg_ = __builtin_amdgcn_s_memrealtime();
#define PROBE_SPIN() do { if (seg_ >= PROBE_LO && seg_ <= PROBE_HI) { const unsigned long long d_ = (__builtin_amdgcn_s_memrealtime() - tseg_) * PROBE_AMP; const unsigned long long s_ = __builtin_amdgcn_s_memrealtime(); \
        while (__builtin_amdgcn_s_memrealtime() - s_ < d_) __builtin_amdgcn_s_sleep(4); } } while (0)
#define GRID_BAR() do { PROBE_SPIN(); xcd_barrier(bar); tseg_ = __builtin_amdgcn_s_memrealtime(); ++seg_; } while (0)
#else
#define PROBE_SPIN() do { } while (0)
#define GRID_BAR() xcd_barrier(bar)
#endif

    if (IN(0)) {
        PHASE_VARS();
        LAS float* scr = (LAS float*)(ldsb + wave * 16384);
        constexpr int I_IN = 16 * 72, I_O = 16 * 32, NITEMS = I_IN + 2 * I_O;
        for (int it = gwave; it < NITEMS; it += nwaves) {
            int r = it;
            if (r < I_IN) { transpose_item(a.w_in, PW, D, WINT, scr, r / 72, r % 72, lane); continue; } r -= I_IN;
            if (r < I_O) { transpose_item(a.w_out, D, D, WOT, scr, r / 32, r % 32, lane); continue; } r -= I_O;
            transpose_item(a.peer_wq, D, D, WQT, scr, r / 32, r % 32, lane);
        }
        for (int i = gtid; i < 2 * 128 * 64; i += gthreads) { const float kf = a.peer_sub_keys[i]; const short h = bfs(kf); KH[i] = (bf16)h; KL[i] = (bf16)bfs(kf - sbf2f(h)); }
        for (int i = tid; i < 8 * 1024; i += NTHR) { const int h = i & 7, c = i >> 3; *(LAS float*)(ldsb + h * 16384 + 8448 + c * 4) = a.w_in[(size_t)c * PW + ODT + h]; }
        __syncthreads();
        rmsnorm_rows_bf16<1>(a.x, a.norm_mix_g, XNB, ldsb, DTRAW, nullptr, nullptr, gwave, nwaves, lane);
    }
    GRID_BAR();
    if (IN(1)) {
        PHASE_VARS();
        pg8::Gemm g{XNB, WINT, T, PS, D}; pg8::StaticOrder S; S.init(T, PS, nb, bid);
        pg8::EpiBf16Plain E{PROJ, PS};
        pg8::gemm_phase<pg8::EpiBf16Plain, pg8::StaticOrder>(ldsb, g, S, E, nullptr);
        const int cfirst = (nb == 256) ? 64 : 0;
        if (bid >= cfirst) for (int rr0 = ((bid - cfirst) * 8 + wave) * 4; rr0 < 2 * 16384; rr0 += (nb - cfirst) * 8 * 4) {
            float4 v[4][4];
#pragma unroll
            for (int q = 0; q < 4; ++q) { const int rr = rr0 + q, which = rr >> 14, row = rr & 16383;
                const float4* src4 = (const float4*)((which ? a.peer_v : a.peer_u) + (size_t)row * D) + lane;
#pragma unroll
                for (int jq = 0; jq < 4; ++jq) v[q][jq] = src4[64 * jq]; }
#pragma unroll
            for (int q = 0; q < 4; ++q) { const int rr = rr0 + q, which = rr >> 14, row = rr & 16383;
                float mx = 0.f;
#pragma unroll
                for (int jq = 0; jq < 4; ++jq) mx = fmaxf(mx, fmaxf(fmaxf(fabsf(v[q][jq].x), fabsf(v[q][jq].y)), fmaxf(fabsf(v[q][jq].z), fabsf(v[q][jq].w))));
#pragma unroll
                for (int o = 1; o < 64; o <<= 1) mx = fmaxf(mx, __shfl_xor(mx, o));
                const float sc = mx > 0.f ? mx * (1.f / 127.f) : 1.f, inv = 1.f / sc;
                unsigned* dst = (unsigned*)((which ? V8 : U8) + (size_t)row * D) + lane;
#pragma unroll
                for (int jq = 0; jq < 4; ++jq) { const int q0 = (int)rintf(v[q][jq].x * inv), q1 = (int)rintf(v[q][jq].y * inv), q2 = (int)rintf(v[q][jq].z * inv), q3 = (int)rintf(v[q][jq].w * inv);
                    dst[64 * jq] = (unsigned)(q0 & 255) | ((unsigned)(q1 & 255) << 8) | ((unsigned)(q2 & 255) << 16) | ((unsigned)(q3 & 255) << 24); }
                if (lane == 0) (which ? SV : SU)[row] = sc; }
        }
    }
    GRID_BAR();
    if (IN(3)) {
        PHASE_VARS();
        for (int u = bid; u < 512; u += nb) {
            if (u < 256) attn_unit(a.attn_sinks, a.attn_out_g, ldsb, u, PROJ, XNB, tid, lane, wave);
            else ssd_chunk_unit(ldsb, u - 256, PROJ, XACT, DTRAW, a.conv_w, a.conv_b, a.dt_bias, a.a_log, ACS, CDEC, MIXF, STATES, tid, lane, wave);
        }
    }
    GRID_BAR();
    if (IN(5)) {
        PHASE_VARS();
        for (int idx = gtid; idx < 2 * 8 * 8192; idx += gthreads) {
            const int pn = idx & 8191, h = (idx >> 13) & 7, b = idx >> 16;
            float run = 0.f;
#pragma unroll 1
            for (int c0 = 0; c0 < 64; c0 += 8) {
                float st[8], dc[8];
#pragma unroll
                for (int j = 0; j < 8; ++j) { const int bch = (b * 64 + c0 + j) * 8 + h; st[j] = STATES[(size_t)bch * 8192 + pn]; dc[j] = CDEC[bch]; }
#pragma unroll
                for (int j = 0; j < 8; ++j) { const int bch = (b * 64 + c0 + j) * 8 + h; PREVT[(size_t)bch * 8192 + pn] = f2bf(run); run = dc[j] * run + st[j]; }
            }
        }
    }
    GRID_BAR();
    if (IN(6)) {
        PHASE_VARS();
        for (int u = bid; u < 256; u += nb) yoff_unit(a.d_skip, a.ssm_norm_g, ldsb, u, XACT, PROJ, ACS, PREVT, MIXF, XNB, lane, wave);
    }
    GRID_BAR();
    if (IN(7)) {
        PHASE_VARS();
        pg8::Gemm g{XNB, WOT, T, D, D}; pg8::StaticOrder S; S.init(T, D, nb, bid);
        pg8::EpiBf16Resid E{HB, a.x, D};
        pg8::gemm_phase<pg8::EpiBf16Resid, pg8::StaticOrder>(ldsb, g, S, E, nullptr);
    }
    GRID_BAR();
    if (IN(8)) {
        PHASE_VARS();
        rmsnorm_rows_bf16<2>((const float*)HB, a.norm_ffn_g, XNB, ldsb, nullptr, XQ, XS, gwave, nwaves, lane);
    }
    GRID_BAR();
    if (IN(9)) {
        PHASE_VARS();
        pg8::Gemm g{XNB, WQT, T, D, D}; pg8::StaticOrder S; S.init(T, D, nb, bid);
        pg8::EpiF32Resid E{QP, nullptr, D};
        pg8::gemm_phase<pg8::EpiF32Resid, pg8::StaticOrder>(ldsb, g, S, E, nullptr);
    }
    GRID_BAR();
    bf16* PEERO = (bf16*)(ws + WS_PEERO);
    if (IN(12)) {
        PHASE_VARS();
        LAS bf16* KHL = (LAS bf16*)ldsb; LAS int* ACC = (LAS int*)ldsb; LAS unsigned char* AL = (LAS unsigned char*)(ldsb + 32768); LAS float* ASC = (LAS float*)(ldsb + 40960);
        LAS unsigned short* EL = (LAS unsigned short*)(ldsb + 73728); LAS float* GL = (LAS float*)(ldsb + 90112);
#pragma unroll 1
        for (int j = bid; j < NCHUNK; j += nb) {
            __syncthreads();
            for (int i = tid; i < 2 * 2 * 128 * 8; i += NTHR) {
                const int pc = i & 7, key = (i >> 3) & 127, hf = (i >> 10) & 1, hl = i >> 11;
                *(LAS v4u*)(KHL + ((hl * 2 + hf) * 128 + key) * 72 + pc * 8) = *(const v4u*)((hl ? KL : KH) + (size_t)(hf * 128 + key) * 64 + pc * 8);
            }
            __syncthreads();
            route_task(16 * j + wave, 4 * wave, QP, KHL, EL, GL, lane);
            route_task(16 * j + 8 + wave, 32 + 4 * wave, QP, KHL, EL, GL, lane);
            __syncthreads();
#pragma unroll 1
            for (int p = 0; p < NPART; ++p) peer_u_item(p, j, EL, XQ, U8, ACC, lane, wave);
#pragma unroll 1
            for (int it = 0; it < 8; ++it) {
                const int tl = it * 8 + wave, t = j * 64 + tl;
                const unsigned ew = *(const LAS unsigned*)(EL + tl * 128 + 2 * lane); const int e0 = (int)(ew & 0xffffu), e1 = (int)(ew >> 16);
                typedef int i2v __attribute__((ext_vector_type(2))); const i2v si = *(const LAS i2v*)(ACC + tl * 128 + 2 * lane);
                typedef float f2v __attribute__((ext_vector_type(2))); const f2v gt = *(const LAS f2v*)(GL + tl * 128 + 2 * lane); const float xs = XS[t];
                const float z0 = (float)si.x * SU[e0] * xs, z1 = (float)si.y * SU[e1] * xs;
                const float a0 = gt.x * 0.5f * z0 * (1.f + erff(z0 * 0.70710678118654752f)) * SV[e0], a1 = gt.y * 0.5f * z1 * (1.f + erff(z1 * 0.70710678118654752f)) * SV[e1];
                float mx = fmaxf(fabsf(a0), fabsf(a1));
#pragma unroll
                for (int o = 1; o < 64; o <<= 1) mx = fmaxf(mx, __shfl_xor(mx, o));
                const float sc = mx > 0.f ? mx * (1.f / 127.f) : 1.f, inv = 1.f / sc;
                *(LAS unsigned short*)(AL + tl * 128 + 2 * lane) = (unsigned short)(((int)rintf(a0 * inv) & 255) | (((int)rintf(a1 * inv) & 255) << 8));
                if (lane == 0) ASC[tl] = sc;
            }
#pragma unroll 1
            for (int p = 0; p < NPART; ++p) peer_v_item(p, j, EL, AL, ASC, V8, PEERO, lane, wave);
            asm volatile("s_waitcnt vmcnt(0)" ::: "memory");
#pragma unroll 1
            for (int it = 0; it < 8; ++it) {
                const int t = j * 64 + it * 8 + wave;
                const uint2* hr = (const uint2*)(HB + (size_t)t * D) + lane; unsigned long long* pr = (unsigned long long*)(PEERO + (size_t)t * D) + lane;
                float4 v[4]; float ss = 0.f;
#pragma unroll
                for (int jq = 0; jq < 4; ++jq) { const uint2 hw = hr[64 * jq]; const unsigned long long pw = __hip_atomic_load(pr + 64 * jq, __ATOMIC_RELAXED, __HIP_MEMORY_SCOPE_AGENT);
                    const unsigned pl = (unsigned)pw, ph = (unsigned)(pw >> 32);
                    v[jq] = make_float4(__uint_as_float(hw.x << 16) + __uint_as_float(pl << 16), __uint_as_float(hw.x & 0xffff0000u) + __uint_as_float(pl & 0xffff0000u),
                                        __uint_as_float(hw.y << 16) + __uint_as_float(ph << 16), __uint_as_float(hw.y & 0xffff0000u) + __uint_as_float(ph & 0xffff0000u));
                    ss += v[jq].x * v[jq].x + v[jq].y * v[jq].y + v[jq].z * v[jq].z + v[jq].w * v[jq].w; }
                ss = wave_sum(ss);
                const float r3 = rsqrtf(ss * (1.f / D) + EPS);
                float4* op = (float4*)(a.out + (size_t)t * D) + lane;
#pragma unroll
                for (int jq = 0; jq < 4; ++jq) { const float4 gv = ((const float4*)a.final_norm_g)[lane + 64 * jq]; op[64 * jq] = make_float4(v[jq].x * r3 * gv.x, v[jq].y * r3 * gv.y, v[jq].z * r3 * gv.z, v[jq].w * r3 * gv.w); }
            }
        }
    }
    PROBE_SPIN();
#undef IN
}
}

extern "C" void kernel_launch(void* const* d_in, const int* in_sizes, int n_in, void* d_out, int out_size, void* d_ws, size_t ws_size, hipStream_t stream) {
    if (n_in != 18 || out_size != T * D || ws_size < WS_END) { fprintf(stderr, "kernel_launch: unexpected shapes n_in=%d out=%d ws=%zu\n", n_in, out_size, ws_size); return; }
    Args a{};
    const float** ap = (const float**)&a;
    for (int i = 0; i < 18; ++i) ap[i] = (const float*)d_in[i];
    a.out = (float*)d_out; a.ws = (unsigned char*)d_ws;
    static int grid = 0;
    if (grid == 0) {
        int dev = 0, cus = 0, per_cu = 0;
        if (hipGetDevice(&dev) != hipSuccess || hipDeviceGetAttribute(&cus, hipDeviceAttributeMultiprocessorCount, dev) != hipSuccess) { fprintf(stderr, "kernel_launch: device query failed\n"); grid = -1; return; }
        if (hipFuncSetAttribute((const void*)k_main, hipFuncAttributeMaxDynamicSharedMemorySize, LDS_BYTES) != hipSuccess) { fprintf(stderr, "kernel_launch: hipFuncSetAttribute failed\n"); grid = -1; return; }
        if (hipOccupancyMaxActiveBlocksPerMultiprocessor(&per_cu, (const void*)k_main, NTHR, LDS_BYTES) != hipSuccess || per_cu < 1) { fprintf(stderr, "kernel_launch: occupancy query says %d blocks/CU\n", per_cu); (void)hipGetLastError(); grid = -1; return; }
        grid = cus;
    }
    if (grid < 0) return;
    if (hipMemsetAsync(d_ws, 0, 65536, stream) != hipSuccess) { fprintf(stderr, "kernel_launch: memset failed\n"); return; }
    a.ph_lo = 0; a.ph_hi = 13;
    hipLaunchKernelGGL(k_main, dim3(grid), dim3(NTHR), LDS_BYTES, stream, a);
}
```

```cpp
#include <hip/hip_runtime.h>
#include <cstdio>
#include <cstdint>

namespace pg8 {
#define PG8_LAS __attribute__((address_space(3)))
typedef unsigned short bf16_t;
typedef short bf16x8 __attribute__((ext_vector_type(8)));
typedef float f32x4 __attribute__((ext_vector_type(4)));
typedef unsigned u32x4 __attribute__((ext_vector_type(4)));
constexpr int BM = 256, BK = 64, HALF = 128, HTB = HALF * BK * 2  , STAGE_BYTES = 8 * HTB, NXCD = 8, WGM = 8;

__host__ __device__ __forceinline__ int lds_byte(int r, int c) { const int st = (r >> 4) * 2 + (c >> 5), rr = r & 15, cc = c & 31, ob = rr * 64 + cc * 2; return st * 1024 + (ob ^ (((ob >> 9) & 1) << 5)); }
__host__ __device__ __forceinline__ void stage_rc(int b, int& R, int& C) { const int st = b / 1024, sb = b % 1024, swz = sb ^ (((sb >> 9) & 1) << 5); R = (st >> 1) * 16 + swz / 64; C = (st & 1) * 32 + (swz % 64) / 2; }
__host__ __device__ __forceinline__ int perm32(int rho) { const int n = rho >> 4, i = rho & 15; return 8 * (i >> 2) + 4 * n + (i & 3); }

struct Unit { int pm, pn; };
struct Gemm { const bf16_t* A; const bf16_t* Bt; int M, N, K; };

struct StaticOrder {
    int nM, nN, nwg, G, c;
    __host__ __device__ void init(int M, int N, int G_, int c_) { nM = M / BM; nN = N / BM; nwg = nM * nN; G = G_; c = c_; }
    __host__ __device__ bool next(int i, Unit& u) const {
        const long L = (long)i * G + c; if (L >= nwg) return false;
        int wgid = (int)L; { const int q = nwg / NXCD, r = nwg % NXCD, xcd = wgid % NXCD, off = wgid / NXCD; wgid = (xcd < r ? xcd * (q + 1) : r * (q + 1) + (xcd - r) * q) + off; }
        const int nig = WGM * nN, gid = wgid / nig, fm = gid * WGM, gsz = (nM - fm) < WGM ? (nM - fm) : WGM;
        u.pm = fm + ((wgid % nig) % gsz); u.pn = (wgid % nig) / gsz; return true;
    }
    __device__ __forceinline__ void a_ready(const Unit&) const {}
    __device__ __forceinline__ void done(const Unit&) const {}
};
__device__ __forceinline__ unsigned cvt_pk_bf16(float lo, float hi) { unsigned r; asm volatile("v_cvt_pk_bf16_f32 %0, %1, %2" : "=v"(r) : "v"(lo), "v"(hi)); return r; }
typedef float f32x2 __attribute__((ext_vector_type(2)));
struct EpiBf16Plain {
    static constexpr bool PERM = true, AFTER_DRAIN = false;
    bf16_t* O; int ldc;
    __device__ __forceinline__ void operator()(const f32x4 (&acc)[2][2][4][2], const Unit& u, int wr, int wc, int fr, int fq) const {
        const int row0 = u.pm * BM + wr * 64 + fr, col0 = u.pn * BM + wc * 32 + 8 * fq;
#pragma unroll
        for (int ai = 0; ai < 2; ++ai)
#pragma unroll
            for (int m = 0; m < 4; ++m) { bf16_t* rowp = O + (size_t)(row0 + ai * HALF + m * 16) * ldc + col0;
#pragma unroll
                for (int bj = 0; bj < 2; ++bj) { const f32x4 v0 = acc[ai][bj][m][0], v1 = acc[ai][bj][m][1];
                    u32x4 w; w.x = cvt_pk_bf16(v0[0], v0[1]); w.y = cvt_pk_bf16(v0[2], v0[3]); w.z = cvt_pk_bf16(v1[0], v1[1]); w.w = cvt_pk_bf16(v1[2], v1[3]);
                    *(u32x4*)(rowp + bj * HALF) = w; } }
    }
};
struct EpiF32Resid {
    static constexpr bool PERM = false, AFTER_DRAIN = false;
    float* C; const float* R; int ldc;
    __device__ __forceinline__ void operator()(const f32x4 (&acc)[2][2][4][2], const Unit& u, int wr, int wc, int fr, int fq) const {
        const int row0 = u.pm * BM + wr * 64 + fr, col0 = u.pn * BM + wc * 32 + 4 * fq;
#pragma unroll
        for (int ai = 0; ai < 2; ++ai)
#pragma unroll
            for (int m = 0; m < 4; ++m) { const size_t off = (size_t)(row0 + ai * HALF + m * 16) * ldc + col0;
#pragma unroll
                for (int bj = 0; bj < 2; ++bj)
#pragma unroll
                    for (int n = 0; n < 2; ++n) { f32x4 v = acc[ai][bj][m][n]; if (R) v += *(const f32x4*)(R + off + bj * HALF + n * 16); *(f32x4*)(C + off + bj * HALF + n * 16) = v; }
                asm volatile("" ::: "memory"); }
    }
};

struct EpiBf16Resid {
    static constexpr bool PERM = true, AFTER_DRAIN = false;
    bf16_t* O; const float* R; int ldc;
    __device__ __forceinline__ void operator()(const f32x4 (&acc)[2][2][4][2], const Unit& u, int wr, int wc, int fr, int fq) const {
        const int row0 = u.pm * BM + wr * 64 + fr, col0 = u.pn * BM + wc * 32 + 8 * fq;
#pragma unroll
        for (int ai = 0; ai < 2; ++ai)
#pragma unroll
            for (int m = 0; m < 4; ++m) { const size_t off = (size_t)(row0 + ai * HALF + m * 16) * ldc + col0;
#pragma unroll
                for (int bj = 0; bj < 2; ++bj) { const f32x4 v0 = acc[ai][bj][m][0] + *(const f32x4*)(R + off + bj * HALF), v1 = acc[ai][bj][m][1] + *(const f32x4*)(R + off + bj * HALF + 4);
                    u32x4 w; w.x = cvt_pk_bf16(v0[0], v0[1]); w.y = cvt_pk_bf16(v0[2], v0[3]); w.z = cvt_pk_bf16(v1[0], v1[1]); w.w = cvt_pk_bf16(v1[2], v1[3]);
                    *(u32x4*)(O + off + bj * HALF) = w; }
                asm volatile("" ::: "memory"); }
    }
};
template <class Epi, class Sched, bool STAMP = false>
__device__ __forceinline__ void gemm_phase(PG8_LAS unsigned char* lds, const Gemm g, const Sched& S, const Epi& E, unsigned long long* stamps) {
    const int tid = threadIdx.x, wid = __builtin_amdgcn_readfirstlane(tid >> 6), lane = tid & 63, wr = wid >> 2, wc = wid & 3, fr = lane & 15, fq = lane >> 4;
    const int K = g.K, nt = K / BK;
    int ts_lo = 0, ts_hi = 0, nts = 0; const unsigned long long rt_entry = STAMP ? (unsigned long long)0ull : 0ull;
#define PG8_STAMP() do { if (STAMP && wid == 0 && nts < 64) { const unsigned long long _c = (unsigned long long)clock64(); \
        ts_lo = (lane == nts) ? (int)(unsigned)_c : ts_lo; ts_hi = (lane == nts) ? (int)(unsigned)(_c >> 32) : ts_hi; ++nts; } } while (0)
    PG8_STAMP();
    unsigned voffA[2], voffB[2];
#pragma unroll
    for (int i = 0; i < 2; ++i) { int R, C; stage_rc(tid * 16 + i * 8192, R, C); const int Rb = Epi::PERM ? ((R & ~31) + perm32(R & 31)) : R;
        voffA[i] = (unsigned)(R * K + C) * 2u; voffB[i] = (unsigned)(Rb * K + C) * 2u; }
    const size_t kstep = (size_t)(BK * 2);
    const size_t hstep = (size_t)HALF * K * 2;
    const size_t tstep = 2 * hstep;
    const unsigned ldsw = (unsigned)wid * 1024u;
    const int aoff = lds_byte(wr * 64 + fr, fq * 8), boff = lds_byte(wc * 32 + fr, fq * 8);
#define PG8_SA(b, h) (((b) * 2 + (h)) * HTB)
#define PG8_SB(b, h) ((4 + (b) * 2 + (h)) * HTB)
#define PG8_STAGE(bufoff, gbase, voff) do { _Pragma("unroll") for (int _i = 0; _i < 2; ++_i) \
        __builtin_amdgcn_global_load_lds((const unsigned*)((const char*)(gbase) + (voff)[_i]), (PG8_LAS unsigned*)(lds + (bufoff) + ldsw + _i * 8192), 16, 0, 0); } while (0)
#define PG8_LDA(dst, b, h) do { _Pragma("unroll") for (int m = 0; m < 4; ++m) _Pragma("unroll") for (int k = 0; k < 2; ++k) dst[m][k] = *(const PG8_LAS bf16x8*)(lds + PG8_SA(b, h) + aoff + m * 2048 + k * 1024); } while (0)
#define PG8_LDB(dst, b, h) do { _Pragma("unroll") for (int n = 0; n < 2; ++n) _Pragma("unroll") for (int k = 0; k < 2; ++k) dst[n][k] = *(const PG8_LAS bf16x8*)(lds + PG8_SB(b, h) + boff + n * 2048 + k * 1024); } while (0)
#define PG8_MMA(ai, bj, At, Bt) do { __builtin_amdgcn_s_setprio(1); _Pragma("unroll") for (int m = 0; m < 4; ++m) _Pragma("unroll") for (int n = 0; n < 2; ++n) _Pragma("unroll") for (int k = 0; k < 2; ++k) \
        acc[ai][bj][m][n] = __builtin_amdgcn_mfma_f32_16x16x32_bf16(Bt[n][k], At[m][k], acc[ai][bj][m][n], 0, 0, 0); __builtin_amdgcn_s_setprio(0); } while (0)
#define PG8_WAIT_V(n) asm volatile("s_waitcnt vmcnt(" #n ")" ::: "memory")
#define PG8_WAIT_L(n) asm volatile("s_waitcnt lgkmcnt(" #n ")" ::: "memory")
#define PG8_BAR __builtin_amdgcn_s_barrier()
#define PG8_SCHED __builtin_amdgcn_sched_barrier(0)
    Unit cur, nxt; int ui = 0;
    if (!S.next(0, cur)) return;
    f32x4 acc[2][2][4][2];
#pragma unroll
    for (int a = 0; a < 2; ++a)
#pragma unroll
        for (int b = 0; b < 2; ++b)
#pragma unroll
            for (int m = 0; m < 4; ++m)
#pragma unroll
                for (int n = 0; n < 2; ++n) acc[a][b][m][n] = (f32x4){0.f, 0.f, 0.f, 0.f};
    bf16x8 At[4][2], B0[2][2], B1[2][2];
    const char* cA = (const char*)g.A + (size_t)cur.pm * tstep; const char* cB = (const char*)g.Bt + (size_t)cur.pn * tstep;
    S.a_ready(cur);
    PG8_STAGE(PG8_SB(0, 0), cB, voffB); PG8_STAGE(PG8_SA(0, 0), cA, voffA); PG8_STAGE(PG8_SB(0, 1), cB + hstep, voffB); PG8_STAGE(PG8_SA(0, 1), cA + hstep, voffA);
    if (wr == 1) PG8_BAR;
    PG8_WAIT_V(4); PG8_BAR;
    PG8_STAGE(PG8_SB(1, 0), cB + kstep, voffB); PG8_STAGE(PG8_SA(1, 0), cA + kstep, voffA); PG8_STAGE(PG8_SB(1, 1), cB + hstep + kstep, voffB);
    PG8_WAIT_V(6); PG8_BAR;
    PG8_STAMP();
    for (;;) {
        const bool has_next = S.next(ui + 1, nxt);
        const char* nA = has_next ? (const char*)g.A + (size_t)nxt.pm * tstep : cA; const char* nB = has_next ? (const char*)g.Bt + (size_t)nxt.pn * tstep : cB;
        for (int t = 0; t < nt; t += 2) {
            const bool last = (t == nt - 2);
            const char* a1 = cA + (size_t)(t + 1) * kstep;
            const char* a2 = last ? nA : cA + (size_t)(t + 2) * kstep; const char* b2 = last ? nB : cB + (size_t)(t + 2) * kstep;
            const char* a3 = a2 + kstep; const char* b3 = b2 + kstep;
            if (last && has_next) S.a_ready(nxt);
            PG8_LDB(B0, 0, 0); PG8_SCHED; PG8_LDA(At, 0, 0); PG8_STAGE(PG8_SA(1, 1), a1 + hstep, voffA);
            PG8_WAIT_L(8); PG8_BAR; PG8_WAIT_L(0); PG8_MMA(0, 0, At, B0); PG8_BAR; PG8_SCHED;
            PG8_LDB(B1, 0, 1); PG8_STAGE(PG8_SB(0, 0), b2, voffB);
            PG8_BAR; PG8_WAIT_L(0); PG8_MMA(0, 1, At, B1); PG8_BAR;
            PG8_LDA(At, 0, 1); PG8_STAGE(PG8_SA(0, 0), a2, voffA);
            PG8_BAR; PG8_WAIT_L(0); PG8_MMA(1, 0, At, B0); PG8_BAR; PG8_SCHED;
            PG8_STAGE(PG8_SB(0, 1), b2 + hstep, voffB);
            PG8_WAIT_V(6); PG8_BAR; PG8_MMA(1, 1, At, B1); PG8_BAR;
            PG8_LDB(B0, 1, 0); PG8_SCHED; PG8_LDA(At, 1, 0); PG8_STAGE(PG8_SA(0, 1), a2 + hstep, voffA);
            PG8_WAIT_L(8); PG8_BAR; PG8_WAIT_L(0); PG8_MMA(0, 0, At, B0); PG8_BAR; PG8_SCHED;
            PG8_LDB(B1, 1, 1); PG8_STAGE(PG8_SB(1, 0), b3, voffB);
            PG8_BAR; PG8_WAIT_L(0); PG8_MMA(0, 1, At, B1); PG8_BAR;
            PG8_LDA(At, 1, 1); PG8_STAGE(PG8_SA(1, 0), a3, voffA);
            PG8_BAR; PG8_WAIT_L(0); PG8_MMA(1, 0, At, B0); PG8_BAR; PG8_SCHED;
            PG8_STAGE(PG8_SB(1, 1), b3 + hstep, voffB);
            PG8_WAIT_V(6); PG8_BAR; PG8_MMA(1, 1, At, B1); PG8_BAR;
        }
        PG8_STAMP();
        if constexpr (!Epi::AFTER_DRAIN) { E(acc, cur, wr, wc, fr, fq); S.done(cur); }
        PG8_STAMP();
        if (!has_next) break;
#pragma unroll
        for (int a = 0; a < 2; ++a)
#pragma unroll
            for (int b = 0; b < 2; ++b)
#pragma unroll
                for (int m = 0; m < 4; ++m)
#pragma unroll
                    for (int n = 0; n < 2; ++n) acc[a][b][m][n] = (f32x4){0.f, 0.f, 0.f, 0.f};
        cur = nxt; cA = nA; cB = nB; ++ui;
    }
    PG8_WAIT_V(0);
    if (wr == 0) PG8_BAR;
    PG8_BAR;
    if constexpr (Epi::AFTER_DRAIN) { E.fused(acc, cur, wr, wc, fr, fq, lds, wid, lane); S.done(cur); }
    PG8_STAMP();
    if (STAMP && wid == 0) { stamps[lane] = lane < nts ? (((unsigned long long)(unsigned)ts_hi << 32) | (unsigned)ts_lo) : 0ull;
        if (lane == 62) stamps[62] = rt_entry; if (lane == 63) stamps[63] = (unsigned long long)0ull; }
#undef PG8_STAMP
#undef PG8_SA
#undef PG8_SB
#undef PG8_STAGE
#undef PG8_LDA
#undef PG8_LDB
#undef PG8_MMA
#undef PG8_WAIT_V
#undef PG8_WAIT_L
#undef PG8_BAR
#undef PG8_SCHED
}
}

namespace {
constexpr int D = 1024, BATCH = 2, SEQ = 8192, T = BATCH * SEQ;
constexpr int PW = 2312;
constexpr int PS = 2304;
constexpr int OQ = 0, OKK = 512, OV = 640, OZ = 768, OXBC = 1280, ODT = 2304;
constexpr float EPS = 1e-6f;
constexpr int NTHR = 512;
typedef unsigned short bf16;
typedef unsigned v4u __attribute__((ext_vector_type(4)));

constexpr size_t MiB = 1u << 20;
constexpr size_t WS_WIN = 1 * MiB;
constexpr size_t WS_KH = 5 * MiB + 512 * 1024;
constexpr size_t WS_WO = 6 * MiB;
constexpr size_t WS_WQ = 8 * MiB;
constexpr size_t WS_PROJ = 10 * MiB;
constexpr size_t WS_XNB = 82 * MiB;
constexpr size_t WS_XACT = 114 * MiB;
constexpr size_t WS_DTRAW = 146 * MiB;
constexpr size_t WS_DT = WS_DTRAW + 512 * 1024;
constexpr size_t WS_ACS = WS_DT + 512 * 1024;
constexpr size_t WS_CDEC = WS_ACS + 512 * 1024;
constexpr size_t WS_STATES = 164 * MiB;
constexpr size_t WS_PREV = 196 * MiB;
constexpr size_t WS_QP = 10 * MiB;
constexpr size_t WS_IDX = 74 * MiB;
constexpr size_t WS_GATE = 114 * MiB;
constexpr size_t WS_TOPV = 122 * MiB;
constexpr size_t WS_TOPI = 138 * MiB;
constexpr size_t WS_ACT = 122 * MiB;
constexpr size_t WS_SU = 245 * MiB;
constexpr size_t WS_U8 = 212 * MiB;
constexpr size_t WS_V8 = 148 * MiB;
constexpr size_t WS_PART = 10 * MiB;
constexpr size_t WS_XQ = 228 * MiB;
constexpr size_t WS_XS = 244 * MiB;
constexpr size_t WS_PEERO = 10 * MiB;
constexpr size_t WS_END = 246 * MiB;
constexpr int CW_QU = 4096, CW_QV = 4096 + 64 * 16;
constexpr int NPART = 8, NCHUNK = T / 64;

struct Args {
    const float* x; const float* norm_mix_g; const float* w_in; const float* attn_sinks; const float* attn_out_g;
    const float* conv_w; const float* conv_b; const float* dt_bias; const float* a_log; const float* d_skip;
    const float* ssm_norm_g; const float* w_out; const float* norm_ffn_g; const float* peer_wq; const float* peer_sub_keys;
    const float* peer_u; const float* peer_v; const float* final_norm_g;
    float* out; unsigned char* ws;
    int ph_lo, ph_hi;
};

#define LAS __attribute__((address_space(3)))
#define LDS_WAIT() asm volatile("s_waitcnt lgkmcnt(0)" ::: "memory")
__device__ __forceinline__ float bf2f(bf16 v) { return __uint_as_float(((unsigned)v) << 16); }
__device__ __forceinline__ unsigned f2bfu(float f) { unsigned u = __float_as_uint(f); return (u + 0x7fffu + ((u >> 16) & 1u)) >> 16; }
__device__ __forceinline__ bf16 f2bf(float f) { return (bf16)f2bfu(f); }
__device__ __forceinline__ unsigned pk2(float lo, float hi) { return f2bfu(lo) | (f2bfu(hi) << 16); }
__device__ __forceinline__ float wave_sum(float v) {
#pragma unroll
    for (int o = 1; o < 64; o <<= 1) v += __shfl_xor(v, o);
    return v;
}
__device__ __forceinline__ float silu_f(float v) { return v / (1.f + __expf(-v)); }

__device__ __forceinline__ void transpose_item(const float* W, int ldw, int K, bf16* WT, LAS float* scr, int kb, int nbk, int lane) {
    const int k0 = 64 * kb, n0 = 32 * nbk;
#pragma unroll 8
    for (int i = 0; i < 32; ++i) { const int kk = 2 * i + (lane >> 5); scr[kk * 33 + (lane & 31)] = W[(size_t)(k0 + kk) * ldw + n0 + (lane & 31)]; }
    LDS_WAIT();
    const int c = lane & 7;
#pragma unroll
    for (int j = 0; j < 4; ++j) { const int n = (lane >> 3) + 8 * j; const LAS float* s = scr + (8 * c) * 33 + n;
        v4u o; o.x = pk2(s[0 * 33], s[1 * 33]); o.y = pk2(s[2 * 33], s[3 * 33]); o.z = pk2(s[4 * 33], s[5 * 33]); o.w = pk2(s[6 * 33], s[7 * 33]);
        *(v4u*)(WT + (size_t)(n0 + n) * K + k0 + 8 * c) = o; }
    LDS_WAIT();
}

template <int MODE  >
__device__ __forceinline__ void rmsnorm_rows_bf16(const float* __restrict__ in, const float* __restrict__ g, bf16* __restrict__ outp, const LAS unsigned char* ldsb, float* __restrict__ dtraw, unsigned char* __restrict__ xq, float* __restrict__ xs, int gwave, int nwaves, int lane) {
#pragma unroll 2
    for (int row = gwave; row < T; row += nwaves) {
        const float4* xr = (const float4*)(in + (size_t)row * D) + lane; const uint2* xb = (const uint2*)((const bf16*)in + (size_t)row * D) + lane;
        float4 v[4]; float ss = 0.f;
#pragma unroll
        for (int j = 0; j < 4; ++j) {
            if (MODE == 2) { const uint2 w = xb[64 * j]; v[j] = make_float4(__uint_as_float(w.x << 16), __uint_as_float(w.x & 0xffff0000u), __uint_as_float(w.y << 16), __uint_as_float(w.y & 0xffff0000u)); }
            else v[j] = xr[64 * j];
            ss += v[j].x * v[j].x + v[j].y * v[j].y + v[j].z * v[j].z + v[j].w * v[j].w; }
        ss = wave_sum(ss);
        const float r = rsqrtf(ss * (1.f / D) + EPS);
        unsigned long long* o8 = (unsigned long long*)(outp + (size_t)row * D) + lane;
        float dacc[8]; float y[4][4]; float mx = 0.f;
#pragma unroll
        for (int h = 0; h < 8; ++h) dacc[h] = 0.f;
#pragma unroll
        for (int j = 0; j < 4; ++j) {
            const float4 gv = ((const float4*)g)[lane + 64 * j];
            y[j][0] = v[j].x * r * gv.x; y[j][1] = v[j].y * r * gv.y; y[j][2] = v[j].z * r * gv.z; y[j][3] = v[j].w * r * gv.w;
            o8[64 * j] = (unsigned long long)pk2(y[j][0], y[j][1]) | ((unsigned long long)pk2(y[j][2], y[j][3]) << 32);
            if (MODE == 2) mx = fmaxf(mx, fmaxf(fmaxf(fabsf(y[j][0]), fabsf(y[j][1])), fmaxf(fabsf(y[j][2]), fabsf(y[j][3]))));
            if (MODE == 1) {
#pragma unroll
                for (int h = 0; h < 8; ++h) {
                    typedef float f4v __attribute__((ext_vector_type(4)));
                    const f4v wv = *(const LAS f4v*)(ldsb + h * 16384 + 8448 + (256 * j + 4 * lane) * 4);
                    dacc[h] += y[j][0] * wv.x + y[j][1] * wv.y + y[j][2] * wv.z + y[j][3] * wv.w;
                }
            }
        }
        if (MODE == 1) {
#pragma unroll
            for (int h = 0; h < 8; ++h) dacc[h] = wave_sum(dacc[h]);
            if (lane == 0) { float4* dp = (float4*)(dtraw + (size_t)row * 8); dp[0] = make_float4(dacc[0], dacc[1], dacc[2], dacc[3]); dp[1] = make_float4(dacc[4], dacc[5], dacc[6], dacc[7]); }
        }
        if (MODE == 2) {
#pragma unroll
            for (int o = 1; o < 64; o <<= 1) mx = fmaxf(mx, __shfl_xor(mx, o));
            const float sc = mx > 0.f ? mx * (1.f / 127.f) : 1.f, inv = 1.f / sc;
            unsigned* dq = (unsigned*)(xq + (size_t)row * D) + lane;
#pragma unroll
            for (int j = 0; j < 4; ++j) { const int q0 = (int)rintf(y[j][0] * inv), q1 = (int)rintf(y[j][1] * inv), q2 = (int)rintf(y[j][2] * inv), q3 = (int)rintf(y[j][3] * inv);
                dq[64 * j] = (unsigned)(q0 & 255) | ((unsigned)(q1 & 255) << 8) | ((unsigned)(q2 & 255) << 16) | ((unsigned)(q3 & 255) << 24); }
            if (lane == 0) xs[row] = sc;
        }
    }
}

typedef short bf16x8 __attribute__((ext_vector_type(8)));
typedef short bf16x4 __attribute__((ext_vector_type(4)));
typedef float f32x16 __attribute__((ext_vector_type(16)));
typedef __bf16 bf2_t __attribute__((ext_vector_type(2)));
#define MFMA32(a, b, c) __builtin_amdgcn_mfma_f32_32x32x16_bf16((a), (b), (c), 0, 0, 0)
__device__ __forceinline__ unsigned pkbf(float lo, float hi) { bf2_t v = {(__bf16)lo, (__bf16)hi}; return __builtin_bit_cast(unsigned, v); }
__device__ __forceinline__ short bfs(float f) { return __builtin_bit_cast(short, (__bf16)f); }
__device__ __forceinline__ float sbf2f(short v) { return __uint_as_float(((unsigned)(unsigned short)v) << 16); }
__device__ __forceinline__ int crow(int i, int hi) { return (i & 3) + 8 * (i >> 2) + 4 * hi; }
template <int S> __device__ __forceinline__ bf16x8 pack8(const f32x16& x) {
    v4u p; p.x = pkbf(x[8 * S], x[8 * S + 1]); p.y = pkbf(x[8 * S + 2], x[8 * S + 3]); p.z = pkbf(x[8 * S + 4], x[8 * S + 5]); p.w = pkbf(x[8 * S + 6], x[8 * S + 7]);
    return __builtin_bit_cast(bf16x8, p);
}
__device__ __forceinline__ bf16x8 ldg8(const bf16* p) { return *(const bf16x8*)p; }
__device__ __forceinline__ bf16x8 lds8(const LAS bf16* p) { return *(const LAS bf16x8*)p; }
__device__ __forceinline__ bf16x8 lds4x2(const LAS bf16* p) { const bf16x4 a = *(const LAS bf16x4*)p, b = *(const LAS bf16x4*)(p + 8); return __builtin_shufflevector(a, b, 0, 1, 2, 3, 4, 5, 6, 7); }
__device__ __forceinline__ f32x16 zero16() { f32x16 z;
#pragma unroll
    for (int i = 0; i < 16; ++i) z[i] = 0.f;
    return z; }

__device__ __forceinline__ void attn_unit(const float* sinks, const float* gnorm, LAS unsigned char* ldsb, int unit, const bf16* PROJ, bf16* MIXB, int tid, int lane, int wave) {
    asm volatile("" : "+v"(tid), "+v"(lane));
    const int tok0 = unit * 64, s0 = tok0 & (SEQ - 1), kbase = tok0 - 128;
    LAS bf16* VT = (LAS bf16*)ldsb;
    LAS bf16* KI = (LAS bf16*)(ldsb + 51200);
    LAS float* SSQ = (LAS float*)(ldsb + 51200 + 55296);
    const __amdgpu_buffer_rsrc_t rsP = __builtin_amdgcn_make_buffer_rsrc((void*)PROJ, 0, (unsigned)T * PS * 2u, 0x00020000);
#pragma unroll
    for (int i = 0; i < 6; ++i) {
        const int c = tid + 512 * i, kv = c / 1536, cc = c - kv * 1536, key = cc >> 3, d0 = (cc & 7) * 8; const bool valid = (s0 - 128 + key) >= 0;
        bf16x8 v, k;
#pragma unroll
        for (int e = 0; e < 8; ++e) { v[e] = 0; k[e] = 0; }
        if (valid) { const unsigned ro = (unsigned)(kbase + key) * (unsigned)PS + (unsigned)(kv * 64 + d0);
            v = __builtin_bit_cast(bf16x8, __builtin_amdgcn_raw_buffer_load_b128(rsP, (int)((ro + (unsigned)OV) * 2u), 0, 0));
            k = __builtin_bit_cast(bf16x8, __builtin_amdgcn_raw_buffer_load_b128(rsP, (int)((ro + (unsigned)OKK) * 2u), 0, 0)); }
#pragma unroll
        for (int e = 0; e < 8; ++e) VT[kv * 12800 + (d0 + e) * 200 + key] = (bf16)v[e];
        *(LAS bf16x8*)(KI + (kv * 192 + key) * 72 + d0) = k;
    }
    __syncthreads();
    const int r = lane & 31, hi = lane >> 5;
    const int hq = wave, hkv = wave >> 2;
    const float slope = exp2f(-(float)(hq + 1)), sink = sinks[hq];
#pragma unroll 1
    for (int qt = 0; qt < 2; ++qt) {
        const int tq = tok0 + 32 * qt + r;
        bf16x8 qf[4];
        { const bf16* qp = PROJ + (size_t)tq * PS + OQ + hq * 64 + 8 * hi; asm volatile("" : "+v"(qp));
#pragma unroll
          for (int ks = 0; ks < 4; ++ks) qf[ks] = ldg8(qp + 16 * ks); }
        const int ql = 32 * qt + r;
        float m = sink, lh = 0.f;
        f32x16 O0 = zero16(), O1 = zero16();
#pragma unroll 1
        for (int kt = 0; kt < 5; ++kt) {
            const LAS bf16* kp = KI + (hkv * 192 + 32 * (qt + kt) + r) * 72 + 8 * hi;
            f32x16 X = zero16();
#pragma unroll
            for (int ks = 0; ks < 4; ++ks) X = MFMA32(lds8(kp + 16 * ks), qf[ks], X);
            float tm = -1e30f;
#pragma unroll
            for (int i = 0; i < 16; ++i) {
                const int kl = 32 * (qt + kt) + crow(i, hi), dist = 128 + ql - kl;
                const bool valid = (dist >= 0) && (dist < 128) && ((s0 - 128 + kl) >= 0);
                const float lg = valid ? (X[i] * 0.125f - slope * (float)dist) : -1e30f;
                X[i] = lg; tm = fmaxf(tm, lg);
            }
            tm = fmaxf(tm, __shfl_xor(tm, 32));
            const float mn = fmaxf(m, tm), sc = __expf(m - mn);
            m = mn; lh *= sc;
#pragma unroll
            for (int i = 0; i < 16; ++i) { O0[i] *= sc; O1[i] *= sc; const float pe = __expf(X[i] - mn); X[i] = pe; lh += pe; }
            const LAS bf16* vp = VT + hkv * 12800 + r * 200 + 32 * (qt + kt) + 4 * hi;
            { const bf16x8 xs = pack8<0>(X); const bf16x8 a0 = lds4x2(vp), a1 = lds4x2(vp + 32 * 200); O0 = MFMA32(a0, xs, O0); O1 = MFMA32(a1, xs, O1); }
            { const bf16x8 xs = pack8<1>(X); const bf16x8 a0 = lds4x2(vp + 16), a1 = lds4x2(vp + 32 * 200 + 16); O0 = MFMA32(a0, xs, O0); O1 = MFMA32(a1, xs, O1); }
        }
        const float lsum = lh + __shfl_xor(lh, 32) + __expf(sink - m);
        const float iv = 1.f / lsum;
        float sq = 0.f;
#pragma unroll
        for (int i = 0; i < 16; ++i) sq += O0[i] * O0[i] + O1[i] * O1[i];
        sq *= iv * iv; sq += __shfl_xor(sq, 32);
        if (hi == 0) SSQ[hq * 32 + r] = sq;
        __syncthreads();
        float tot = 0.f;
#pragma unroll
        for (int h = 0; h < 8; ++h) tot += SSQ[h * 32 + r];
        const float sc = iv * rsqrtf(tot * (1.f / 512.f) + EPS);
        bf16* orow = MIXB + (size_t)tq * D + hq * 64 + 4 * hi;
#pragma unroll
        for (int q4 = 0; q4 < 4; ++q4) {
            const float4 g0 = *(const float4*)(gnorm + hq * 64 + 8 * q4 + 4 * hi), g1 = *(const float4*)(gnorm + hq * 64 + 32 + 8 * q4 + 4 * hi);
            uint2 w0, w1;
            w0.x = pkbf(O0[4 * q4] * sc * g0.x, O0[4 * q4 + 1] * sc * g0.y); w0.y = pkbf(O0[4 * q4 + 2] * sc * g0.z, O0[4 * q4 + 3] * sc * g0.w);
            w1.x = pkbf(O1[4 * q4] * sc * g1.x, O1[4 * q4 + 1] * sc * g1.y); w1.y = pkbf(O1[4 * q4 + 2] * sc * g1.z, O1[4 * q4 + 3] * sc * g1.w);
            *(uint2*)(orow + 8 * q4) = w0; *(uint2*)(orow + 32 + 8 * q4) = w1;
        }
        __syncthreads();
    }
}

__device__ __forceinline__ void ssd_chunk_unit(LAS unsigned char* ldsb, int unit, const bf16* PROJ, bf16* XACT, const float* DTRAW, const float* conv_w, const float* conv_b, const float* dt_bias, const float* a_log,
                                               float* ACS, float* CDEC, float* MIXF, float* STATES, int tid, int lane, int wave) {
    asm volatile("" : "+v"(tid), "+v"(lane));
    const int g = unit & 1, bc = unit >> 1, tok0 = bc * 128;
    LAS float* DTT = (LAS float*)(ldsb + 34816 * 3 + 2048);
    LAS float* WT = (LAS float*)(ldsb + 34816 * 3 + 4096);
    {
        const int cgi = tid & 63, t0 = tok0 + 16 * (tid >> 6);
        const int c0 = cgi < 32 ? g * 256 + cgi * 8 : (cgi < 48 ? 512 + g * 128 + (cgi - 32) * 8 : 768 + g * 128 + (cgi - 48) * 8);
        float w[4][8], bs[8];
#pragma unroll
        for (int k = 0; k < 4; ++k) { const float4 a0 = *(const float4*)(conv_w + k * 1024 + c0), a1 = *(const float4*)(conv_w + k * 1024 + c0 + 4);
            w[k][0] = a0.x; w[k][1] = a0.y; w[k][2] = a0.z; w[k][3] = a0.w; w[k][4] = a1.x; w[k][5] = a1.y; w[k][6] = a1.z; w[k][7] = a1.w; }
        { const float4 a0 = *(const float4*)(conv_b + c0), a1 = *(const float4*)(conv_b + c0 + 4); bs[0] = a0.x; bs[1] = a0.y; bs[2] = a0.z; bs[3] = a0.w; bs[4] = a1.x; bs[5] = a1.y; bs[6] = a1.z; bs[7] = a1.w; }
        const bool has_halo = (t0 & (SEQ - 1)) != 0;
        bf16x8 rows[19];
#pragma unroll
        for (int i = 0; i < 19; ++i) {
            if (i < 3 && !has_halo) {
#pragma unroll
                for (int e = 0; e < 8; ++e) rows[i][e] = 0;
            } else rows[i] = ldg8(PROJ + (size_t)(t0 + i - 3) * PS + OXBC + c0);
        }
#pragma unroll
        for (int i = 0; i < 16; ++i) {
            float o[8];
#pragma unroll
            for (int e = 0; e < 8; ++e) o[e] = silu_f(bs[e] + w[0][e] * sbf2f(rows[i][e]) + w[1][e] * sbf2f(rows[i + 1][e]) + w[2][e] * sbf2f(rows[i + 2][e]) + w[3][e] * sbf2f(rows[i + 3][e]));
            v4u ov; ov.x = pkbf(o[0], o[1]); ov.y = pkbf(o[2], o[3]); ov.z = pkbf(o[4], o[5]); ov.w = pkbf(o[6], o[7]);
            *(v4u*)(XACT + (size_t)(t0 + i) * 1024 + c0) = ov;
        }
    }
    LAS float* ACST = (LAS float*)(ldsb + 34816 * 3);
    {
        const int s = tid >> 2, hh = tid & 3, H = g * 4 + hh;
        const float A = -__expf(a_log[H]);
        const float raw = DTRAW[(size_t)(tok0 + s) * 8 + H] + dt_bias[H];
        const float dtv = fmaxf(raw, 0.f) + log1pf(__expf(-fabsf(raw)));
        float v = dtv * A;
#pragma unroll
        for (int o = 4; o < 64; o <<= 1) { const float y = __shfl_up(v, o); if (lane >= o) v += y; }
        if (lane >= 60) WT[wave * 4 + hh] = v;
        __syncthreads();
        float off = 0.f;
        for (int w2 = 0; w2 < wave; ++w2) off += WT[w2 * 4 + hh];
        v += off;
        DTT[tid] = dtv; ACST[tid] = v; ACS[(size_t)(tok0 + s) * 8 + H] = v;
        if (s == 127) CDEC[bc * 8 + H] = __expf(v);
    }
    asm volatile("s_waitcnt vmcnt(0)" ::: "memory");
    __syncthreads();
    LAS bf16* BT = (LAS bf16*)ldsb;
    LAS bf16* XD = (LAS bf16*)(ldsb + 34816);
    LAS bf16* XW = (LAS bf16*)(ldsb + 34816 + 34816);
    const int r = lane & 31, hi = lane >> 5;
#pragma unroll
    for (int i = 0; i < 4; ++i) {
        const int c = tid + 512 * i, s = c >> 4, n0 = (c & 15) * 8;
        const bf16x8 v = ldg8(XACT + (size_t)(tok0 + s) * 1024 + 512 + g * 128 + n0);
#pragma unroll
        for (int e = 0; e < 8; ++e) BT[(n0 + e) * 136 + s] = (bf16)v[e];
    }
#pragma unroll 1
    for (int hp = 0; hp < 2; ++hp) {
        if (hp) __syncthreads();
        int tidp = tid; asm volatile("" : "+v"(tidp));
#pragma unroll
        for (int i = 0; i < 4; ++i) {
            const int c = tidp + 512 * i, hsel = c >> 10, s = (c >> 3) & 127, p0 = (c & 7) * 8, H = g * 4 + 2 * hp + hsel;
            const bf16x8 v = ldg8(XACT + (size_t)(tok0 + s) * 1024 + H * 64 + p0);
            const float dtv = DTT[s * 4 + 2 * hp + hsel];
            const float w = __expf(ACST[127 * 4 + 2 * hp + hsel] - ACST[s * 4 + 2 * hp + hsel]);
#pragma unroll
            for (int e = 0; e < 8; ++e) { const float xd = sbf2f(v[e]) * dtv; XD[hsel * 8704 + (p0 + e) * 136 + s] = (bf16)bfs(xd); XW[hsel * 8704 + (p0 + e) * 136 + s] = (bf16)bfs(xd * w); }
        }
        __syncthreads();
        {
            const int lt = wave & 3, hsel = wave >> 2, hh = 2 * hp + hsel, H = g * 4 + hh;
            const int l = 32 * lt + r; const float acs_l = ACST[l * 4 + hh];
            bf16x8 cf[8];
            { const bf16* cp = XACT + (size_t)(tok0 + l) * 1024 + 768 + g * 128 + 8 * hi; asm volatile("" : "+v"(cp));
#pragma unroll
              for (int ks = 0; ks < 8; ++ks) cf[ks] = ldg8(cp + 16 * ks); }
            f32x16 Z0 = zero16(), Z1 = zero16();
            bf16x8 bn[8];
            { const bf16* bp = XACT + (size_t)(tok0 + r) * 1024 + 512 + g * 128 + 8 * hi; asm volatile("" : "+v"(bp));
#pragma unroll
              for (int ks = 0; ks < 8; ++ks) bn[ks] = ldg8(bp + 16 * ks); }
#pragma unroll 1
            for (int st = 0; st <= lt; ++st) {
                f32x16 X = zero16();
                bf16x8 bc[8];
#pragma unroll
                for (int ks = 0; ks < 8; ++ks) bc[ks] = bn[ks];
                { const int stn = st < lt ? st + 1 : lt; const bf16* bp = XACT + (size_t)(tok0 + 32 * stn + r) * 1024 + 512 + g * 128 + 8 * hi; asm volatile("" : "+v"(bp));
#pragma unroll
                  for (int ks = 0; ks < 8; ++ks) bn[ks] = ldg8(bp + 16 * ks); }
#pragma unroll
                for (int ks = 0; ks < 8; ++ks) X = MFMA32(bc[ks], cf[ks], X);
#pragma unroll
                for (int i = 0; i < 16; ++i) { const int s = 32 * st + crow(i, hi); const float f = (s <= l) ? __expf(acs_l - ACST[s * 4 + hh]) : 0.f; X[i] *= f; }
                const int sb = 32 * st + 4 * hi;
                { const bf16x8 xs = pack8<0>(X); const bf16x8 b0 = lds4x2(XD + hsel * 8704 + r * 136 + sb), b1 = lds4x2(XD + hsel * 8704 + (32 + r) * 136 + sb); Z0 = MFMA32(xs, b0, Z0); Z1 = MFMA32(xs, b1, Z1); }
                { const bf16x8 xs = pack8<1>(X); const bf16x8 b0 = lds4x2(XD + hsel * 8704 + r * 136 + sb + 16), b1 = lds4x2(XD + hsel * 8704 + (32 + r) * 136 + sb + 16); Z0 = MFMA32(xs, b0, Z0); Z1 = MFMA32(xs, b1, Z1); }
            }
#pragma unroll
            for (int i = 0; i < 16; ++i) { float* o = MIXF + (size_t)(tok0 + 32 * lt + crow(i, hi)) * D + 512 + H * 64 + r; o[0] = Z0[i]; o[32] = Z1[i]; }
        }
        {
            const int nt = wave & 3, hsel = wave >> 2, H = g * 4 + 2 * hp + hsel;
            f32x16 S0 = zero16(), S1 = zero16();
#pragma unroll
            for (int ks = 0; ks < 8; ++ks) {
                const bf16x8 btf = lds8(BT + (32 * nt + r) * 136 + 16 * ks + 8 * hi);
                const bf16x8 a0 = lds8(XW + hsel * 8704 + r * 136 + 16 * ks + 8 * hi), a1 = lds8(XW + hsel * 8704 + (32 + r) * 136 + 16 * ks + 8 * hi);
                S0 = MFMA32(a0, btf, S0); S1 = MFMA32(a1, btf, S1);
            }
            float* sp = STATES + (size_t)(bc * 8 + H) * 8192 + 32 * nt + r;
#pragma unroll
            for (int i = 0; i < 16; ++i) { const int p = crow(i, hi); sp[p * 128] = S0[i]; sp[(32 + p) * 128] = S1[i]; }
        }
    }
    __syncthreads();
}

__device__ __forceinline__ __amdgpu_buffer_rsrc_t mk_rsrc(const void* p, unsigned bytes) { return __builtin_amdgcn_make_buffer_rsrc((void*)p, 0, bytes, 0x00020000); }
__device__ __forceinline__ void yoff_unit(const float* d_skip, const float* gnorm, LAS unsigned char* ldsb, int unit, const bf16* XACT, const bf16* PROJ, const float* ACS, const bf16* PREVT,
                                          const float* MIXF, bf16* MIXB, int lane, int wave) {
    const int g = unit & 1, bc = unit >> 1, tok0 = bc * 128;
    const int r = lane & 31, hi = lane >> 5, lt = wave & 3, hpair = wave >> 2;
    LAS float* TAB = (LAS float*)ldsb;
    const __amdgpu_buffer_rsrc_t rsF = mk_rsrc(MIXF, (unsigned)T * D * 4u), rsX = mk_rsrc(XACT, (unsigned)T * 1024u * 2u), rsP = mk_rsrc(PROJ, (unsigned)T * PS * 2u), rsA = mk_rsrc(ACS, (unsigned)T * 32u), rsB = mk_rsrc(MIXB, (unsigned)T * D * 2u);
    const unsigned tb = (unsigned)(tok0 + 32 * lt + 4 * hi);
    bf16x8 cf[8];
    { const bf16* cp = XACT + (size_t)(tok0 + 32 * lt + r) * 1024 + 768 + g * 128 + 8 * hi; asm volatile("" : "+v"(cp));
#pragma unroll
      for (int ks = 0; ks < 8; ++ks) cf[ks] = ldg8(cp + 16 * ks); }
    float eav[16], ssq[16];
    unsigned ypk[2][2][8];
#pragma unroll
    for (int i = 0; i < 16; ++i) ssq[i] = 0.f;
#pragma unroll
    for (int hsel = 0; hsel < 2; ++hsel) {
        const int H = g * 4 + 2 * hpair + hsel; const bf16* pv = PREVT + (size_t)(bc * 8 + H) * 8192 + 8 * hi;
        asm volatile("" : "+v"(pv));
        f32x16 Y0 = zero16(), Y1 = zero16();
#pragma unroll
        for (int ks = 0; ks < 8; ++ks) {
            const bf16x8 b0 = ldg8(pv + r * 128 + 16 * ks), b1 = ldg8(pv + (32 + r) * 128 + 16 * ks);
            Y0 = MFMA32(cf[ks], b0, Y0); Y1 = MFMA32(cf[ks], b1, Y1);
        }
        const float dsk = d_skip[H];
        { const unsigned vo = (tb * 8u + (unsigned)H) * 4u;
#pragma unroll
          for (int i = 0; i < 16; ++i) eav[i] = __expf(__builtin_bit_cast(float, __builtin_amdgcn_raw_buffer_load_b32(rsA, (int)vo, ((i & 3) + 8 * (i >> 2)) * 32, 0))); }
#pragma unroll
        for (int pt = 0; pt < 2; ++pt) {
            const unsigned col = (unsigned)(H * 64 + 32 * pt + r);
            const unsigned voF = (tb * 1024u + 512u + col) * 4u, voX = (tb * 1024u + col) * 2u, voP = (tb * (unsigned)PS + (unsigned)OZ + col) * 2u;
            float yo[16], xsv[16], zv[16];
#pragma unroll
            for (int i = 0; i < 16; ++i) { const int ro = (i & 3) + 8 * (i >> 2);
                yo[i] = __builtin_bit_cast(float, __builtin_amdgcn_raw_buffer_load_b32(rsF, (int)voF, ro * 4096, 0));
                xsv[i] = bf2f((bf16)__builtin_amdgcn_raw_buffer_load_b16(rsX, (int)voX, ro * 2048, 0));
                zv[i] = bf2f((bf16)__builtin_amdgcn_raw_buffer_load_b16(rsP, (int)voP, ro * (PS * 2), 0)); }
#pragma unroll
            for (int i = 0; i < 16; i += 2) {
                const float y0 = (yo[i] + eav[i] * (pt ? Y1[i] : Y0[i]) + dsk * xsv[i]) * silu_f(zv[i]);
                const float y1 = (yo[i + 1] + eav[i + 1] * (pt ? Y1[i + 1] : Y0[i + 1]) + dsk * xsv[i + 1]) * silu_f(zv[i + 1]);
                ssq[i] += y0 * y0; ssq[i + 1] += y1 * y1; ypk[hsel][pt][i >> 1] = pkbf(y0, y1);
            }
            __builtin_amdgcn_sched_barrier(0);
        }
    }
#pragma unroll
    for (int i = 0; i < 16; ++i) {
#pragma unroll
        for (int o = 1; o < 32; o <<= 1) ssq[i] += __shfl_xor(ssq[i], o);
    }
    if (r == 0) {
#pragma unroll
        for (int i = 0; i < 16; ++i) TAB[hpair * 128 + 32 * lt + crow(i, hi)] = ssq[i];
    }
    __syncthreads();
#pragma unroll
    for (int i = 0; i < 16; ++i) { const int l = 32 * lt + crow(i, hi); ssq[i] = rsqrtf((TAB[l] + TAB[128 + l]) * (1.f / 256.f) + EPS); }
#pragma unroll
    for (int hsel = 0; hsel < 2; ++hsel)
#pragma unroll
        for (int pt = 0; pt < 2; ++pt) {
            const unsigned col = (unsigned)((g * 4 + 2 * hpair + hsel) * 64 + 32 * pt + r); const float gn = gnorm[col];
            const unsigned voB = (tb * 1024u + 512u + col) * 2u;
#pragma unroll
            for (int i = 0; i < 16; ++i) { const unsigned w = ypk[hsel][pt][i >> 1];
                const float yf = (i & 1) ? __uint_as_float(w & 0xffff0000u) : __uint_as_float(w << 16);
                __builtin_amdgcn_raw_buffer_store_b16((short)f2bf(yf * ssq[i] * gn), rsB, (int)voB, ((i & 3) + 8 * (i >> 2)) * 2048, 0); }
        }
    __syncthreads();
}
typedef float f32x2 __attribute__((ext_vector_type(2)));
__device__ __forceinline__ void fp8x16_to_f32(const uint4 w, float (&f)[16]) {
    const int ww[4] = {(int)w.x, (int)w.y, (int)w.z, (int)w.w};
#pragma unroll
    for (int q = 0; q < 4; ++q) { const f32x2 a = __builtin_amdgcn_cvt_pk_f32_fp8(ww[q], false), b = __builtin_amdgcn_cvt_pk_f32_fp8(ww[q], true); f[4 * q] = a.x; f[4 * q + 1] = a.y; f[4 * q + 2] = b.x; f[4 * q + 3] = b.y; }
}
template <int M4, int M2, int M1> __device__ __forceinline__ void treduce16(const float (&a)[16], int lane, float& r0, float& r1) {
    float b[8], c[4];
    { const bool hi = (lane & M4) != 0;
#pragma unroll
      for (int i = 0; i < 8; ++i) { const float send = hi ? a[i] : a[i + 8]; const float recv = __shfl_xor(send, M4); b[i] = (hi ? a[i + 8] : a[i]) + recv; } }
    { const bool hi = (lane & M2) != 0;
#pragma unroll
      for (int i = 0; i < 4; ++i) { const float send = hi ? b[i] : b[i + 4]; const float recv = __shfl_xor(send, M2); c[i] = (hi ? b[i + 4] : b[i]) + recv; } }
    { const bool hi = (lane & M1) != 0;
      { const float send = hi ? c[0] : c[2]; const float recv = __shfl_xor(send, M1); r0 = (hi ? c[2] : c[0]) + recv; }
      { const float send = hi ? c[1] : c[3]; const float recv = __shfl_xor(send, M1); r1 = (hi ? c[3] : c[1]) + recv; } }
}
template <int M4, int M2, int M1> __device__ __forceinline__ void treduce16i(const int (&a)[16], int lane, int& r0, int& r1) {
    int b[8], c[4];
    { const bool hi = (lane & M4) != 0;
#pragma unroll
      for (int i = 0; i < 8; ++i) { const int send = hi ? a[i] : a[i + 8]; const int recv = __shfl_xor(send, M4); b[i] = (hi ? a[i + 8] : a[i]) + recv; } }
    { const bool hi = (lane & M2) != 0;
#pragma unroll
      for (int i = 0; i < 4; ++i) { const int send = hi ? b[i] : b[i + 4]; const int recv = __shfl_xor(send, M2); c[i] = (hi ? b[i + 4] : b[i]) + recv; } }
    { const bool hi = (lane & M1) != 0;
      { const int send = hi ? c[0] : c[2]; const int recv = __shfl_xor(send, M1); r0 = (hi ? c[2] : c[0]) + recv; }
      { const int send = hi ? c[1] : c[3]; const int recv = __shfl_xor(send, M1); r1 = (hi ? c[3] : c[1]) + recv; } }
}
__device__ __forceinline__ void treduce16i_hw(const int (&a)[16], int lane, int& r0, int& r1) {
    int b[8], c[4];
#pragma unroll
    for (int i = 0; i < 8; ++i) { const auto r = __builtin_amdgcn_permlane32_swap((unsigned)a[i], (unsigned)a[i + 8], false, false); b[i] = (int)r[0] + (int)r[1]; }
#pragma unroll
    for (int i = 0; i < 4; ++i) { const auto r = __builtin_amdgcn_permlane16_swap((unsigned)b[i], (unsigned)b[i + 4], false, false); c[i] = (int)r[0] + (int)r[1]; }
    const bool hi = (lane & 8) != 0;
    { const int send = hi ? c[0] : c[2]; r0 = (hi ? c[2] : c[0]) + __builtin_amdgcn_update_dpp(0, send, 0x128, 0xf, 0xf, false); }
    { const int send = hi ? c[1] : c[3]; r1 = (hi ? c[3] : c[1]) + __builtin_amdgcn_update_dpp(0, send, 0x128, 0xf, 0xf, false); }
}
#define PE_ID(E, i) (((i) & 1) ? (E[(i) >> 1] >> 16) : (E[(i) >> 1] & 0xffffu))
__device__ __forceinline__ void peer_u_item(int p, int j, const LAS unsigned short* EL  , const unsigned char* __restrict__ XQ, const unsigned char* __restrict__ U8, LAS int* ACC  , int lane, int wave) {
    asm volatile("" : "+v"(lane));
    const int gidx = lane >> 3; const unsigned coff = (unsigned)(p * 128 + (lane & 7) * 16);
#pragma unroll 1
    for (int it = 0; it < 8; ++it) {
        const int t = j * 64 + it * 8 + wave;
        unsigned E[8];
        { const LAS v4u* ep = (const LAS v4u*)(EL + (it * 8 + wave) * 128 + 16 * gidx); const v4u e0 = ep[0], e1 = ep[1];
          E[0] = e0.x; E[1] = e0.y; E[2] = e0.z; E[3] = e0.w; E[4] = e1.x; E[5] = e1.y; E[6] = e1.z; E[7] = e1.w; }
        uint4 uu[16];
#pragma unroll
        for (int i = 0; i < 16; ++i) uu[i] = *(const uint4*)(U8 + (size_t)(PE_ID(E, i) * 1024u + coff));
        const uint4 xq = *(const uint4*)(XQ + (size_t)t * D + coff);
        int d[16];
#pragma unroll
        for (int i = 0; i < 16; ++i) {
            int s = __builtin_amdgcn_sdot4((int)uu[i].x, (int)xq.x, 0, false); s = __builtin_amdgcn_sdot4((int)uu[i].y, (int)xq.y, s, false);
            s = __builtin_amdgcn_sdot4((int)uu[i].z, (int)xq.z, s, false); s = __builtin_amdgcn_sdot4((int)uu[i].w, (int)xq.w, s, false);
            d[i] = s;
        }
        int r0, r1; treduce16i<4, 2, 1>(d, lane, r0, r1);
        { typedef int i2v __attribute__((ext_vector_type(2))); LAS i2v* ap = (LAS i2v*)(ACC + (it * 8 + wave) * 128 + 2 * lane);
          i2v a2; if (p == 0) { a2.x = r0; a2.y = r1; } else { a2 = *ap; a2.x += r0; a2.y += r1; } *ap = a2; }
    }
}
__device__ __forceinline__ void peer_v_item(int p, int j, const LAS unsigned short* EL, const LAS unsigned char* AL  , const LAS float* ASC  ,
                                            const unsigned char* __restrict__ V8, bf16* __restrict__ PEERO, int lane, int wave) {
    asm volatile("" : "+v"(lane));
    const __amdgpu_buffer_rsrc_t rsV = __builtin_amdgcn_make_buffer_rsrc((void*)V8, 0, 16384 * 1024, 0x00020000);
    const int gidx = lane >> 3; const unsigned coff = (unsigned)(p * 128 + (lane & 7) * 16);
#pragma unroll 1
    for (int it = 0; it < 8; ++it) {
        const int t = j * 64 + it * 8 + wave;
        unsigned E[8];
        { const LAS v4u* ep = (const LAS v4u*)(EL + (it * 8 + wave) * 128 + 16 * gidx); const v4u e0 = ep[0], e1 = ep[1];
          E[0] = e0.x; E[1] = e0.y; E[2] = e0.z; E[3] = e0.w; E[4] = e1.x; E[5] = e1.y; E[6] = e1.z; E[7] = e1.w; }
        uint4 vv[16];
#pragma unroll
        for (int i = 0; i < 16; ++i) { const v4u w_ = __builtin_amdgcn_raw_buffer_load_b128(rsV, (int)((PE_ID(E, i) << 10) + coff), 0, 0); vv[i] = make_uint4(w_.x, w_.y, w_.z, w_.w); }
        const v4u aq = *(const LAS v4u*)(AL + (it * 8 + wave) * 128 + 16 * gidx);
        const float asc = ASC[it * 8 + wave];
        const unsigned a4[4] = {aq.x, aq.y, aq.z, aq.w};
        int acc[16];
#pragma unroll
        for (int c = 0; c < 16; ++c) acc[c] = 0;
#pragma unroll
        for (int m = 0; m < 4; ++m) {
            const unsigned r0[4] = {vv[4 * m].x, vv[4 * m].y, vv[4 * m].z, vv[4 * m].w}, r1[4] = {vv[4 * m + 1].x, vv[4 * m + 1].y, vv[4 * m + 1].z, vv[4 * m + 1].w};
            const unsigned r2[4] = {vv[4 * m + 2].x, vv[4 * m + 2].y, vv[4 * m + 2].z, vv[4 * m + 2].w}, r3[4] = {vv[4 * m + 3].x, vv[4 * m + 3].y, vv[4 * m + 3].z, vv[4 * m + 3].w};
#pragma unroll
            for (int dc = 0; dc < 4; ++dc) {
                const unsigned ta = __builtin_amdgcn_perm(r1[dc], r0[dc], 0x05010400u), tb = __builtin_amdgcn_perm(r3[dc], r2[dc], 0x05010400u);
                const unsigned ua = __builtin_amdgcn_perm(r1[dc], r0[dc], 0x07030602u), ub = __builtin_amdgcn_perm(r3[dc], r2[dc], 0x07030602u);
                const unsigned c0 = __builtin_amdgcn_perm(tb, ta, 0x05040100u), c1 = __builtin_amdgcn_perm(tb, ta, 0x07060302u);
                const unsigned c2 = __builtin_amdgcn_perm(ub, ua, 0x05040100u), c3 = __builtin_amdgcn_perm(ub, ua, 0x07060302u);
                acc[4 * dc + 0] = __builtin_amdgcn_sdot4((int)c0, (int)a4[m], acc[4 * dc + 0], false);
                acc[4 * dc + 1] = __builtin_amdgcn_sdot4((int)c1, (int)a4[m], acc[4 * dc + 1], false);
                acc[4 * dc + 2] = __builtin_amdgcn_sdot4((int)c2, (int)a4[m], acc[4 * dc + 2], false);
                acc[4 * dc + 3] = __builtin_amdgcn_sdot4((int)c3, (int)a4[m], acc[4 * dc + 3], false);
            }
        }
        int r0i, r1i; treduce16i_hw(acc, lane, r0i, r1i);
        *(unsigned*)(PEERO + (size_t)t * D + coff + 2 * gidx) = pkbf(asc * (float)r0i, asc * (float)r1i);
    }
}

__device__ __forceinline__ void ce_desc(float& a, float& b) { const float hi = fmaxf(a, b), lo = fminf(a, b); a = hi; b = lo; }
__device__ __forceinline__ void sort16_desc(float (&v)[16]) {
#pragma unroll
    for (int k = 2; k <= 16; k <<= 1)
#pragma unroll
        for (int j = k >> 1; j > 0; j >>= 1)
#pragma unroll
            for (int i = 0; i < 16; ++i) { const int l = i ^ j; if (l > i) { if ((i & k) == 0) ce_desc(v[i], v[l]); else ce_desc(v[l], v[i]); } }
}
__device__ __forceinline__ void merge16_desc(float (&a)[16], const float (&b)[16]) {
#pragma unroll
    for (int i = 0; i < 16; ++i) a[i] = fmaxf(a[i], b[15 - i]);
#pragma unroll
    for (int j = 8; j > 0; j >>= 1)
#pragma unroll
        for (int i = 0; i < 16; ++i) { const int l = i ^ j; if (l > i) ce_desc(a[i], a[l]); }
}
__device__ __forceinline__ void ce_kv(float& ka, int& va, float& kb, int& vb) {
    const bool s = kb > ka; const float t0 = s ? kb : ka, t1 = s ? ka : kb; const int u0 = s ? vb : va, u1 = s ? va : vb; ka = t0; kb = t1; va = u0; vb = u1; }
__device__ __forceinline__ void sort16_kv(float (&k)[16], int (&v)[16]) {
#pragma unroll
    for (int kk = 2; kk <= 16; kk <<= 1)
#pragma unroll
        for (int j = kk >> 1; j > 0; j >>= 1)
#pragma unroll
            for (int i = 0; i < 16; ++i) { const int l = i ^ j; if (l > i) { if ((i & kk) == 0) ce_kv(k[i], v[i], k[l], v[l]); else ce_kv(k[l], v[l], k[i], v[i]); } }
}
__device__ __forceinline__ void merge16_kv(float (&ka)[16], int (&va)[16], const float (&kb)[16], const int (&vb)[16]) {
#pragma unroll
    for (int i = 0; i < 16; ++i) { const bool s = kb[15 - i] > ka[i]; ka[i] = s ? kb[15 - i] : ka[i]; va[i] = s ? vb[15 - i] : va[i]; }
#pragma unroll
    for (int j = 8; j > 0; j >>= 1)
#pragma unroll
        for (int i = 0; i < 16; ++i) { const int l = i ^ j; if (l > i) ce_kv(ka[i], va[i], ka[l], va[l]); }
}
__device__ __forceinline__ void split8(const float* p, bf16x8& hi8, bf16x8& lo8) {
    const float4 f0 = *(const float4*)p, f1 = *(const float4*)(p + 4);
    const float x[8] = {f0.x, f0.y, f0.z, f0.w, f1.x, f1.y, f1.z, f1.w};
#pragma unroll
    for (int j = 0; j < 8; ++j) { const short h = bfs(x[j]); hi8[j] = h; lo8[j] = bfs(x[j] - sbf2f(h)); }
}
__device__ __forceinline__ void route_task(int task, int tl0, const float* QP, const LAS bf16* KHL, LAS unsigned short* EL, LAS float* GL, int lane) {
    const int r = lane & 31, hi = lane >> 5, t = 4 * task + (r >> 3), head = r & 7;
    float top[2][16];
#pragma unroll
    for (int half = 0; half < 2; ++half) {
        bf16x8 qh[4], ql[4];
        { const float* qp = QP + (size_t)t * D + head * 128 + half * 64 + 8 * hi; asm volatile("" : "+v"(qp));
#pragma unroll
          for (int ks = 0; ks < 4; ++ks) split8(qp + 16 * ks, qh[ks], ql[ks]); }
        float cur[16];
#pragma unroll
        for (int kt = 0; kt < 4; ++kt) {
            f32x16 X = zero16();
            const LAS bf16* khp = KHL + (half * 128 + 32 * kt + r) * 72 + 8 * hi;
#pragma unroll
            for (int ks = 0; ks < 4; ++ks) {
                const bf16x8 kh = lds8(khp + 16 * ks), kl = lds8(khp + 2 * 128 * 72 + 16 * ks);
                X = MFMA32(kh, qh[ks], X); X = MFMA32(kh, ql[ks], X); X = MFMA32(kl, qh[ks], X);
            }
            float grp[16];
#pragma unroll
            for (int i = 0; i < 16; ++i) { const unsigned key = (unsigned)(32 * kt + crow(i, hi)); grp[i] = __uint_as_float((__float_as_uint(X[i]) & ~127u) | (127u - key)); }
            sort16_desc(grp);
            if (kt == 0) {
#pragma unroll
                for (int i = 0; i < 16; ++i) cur[i] = grp[i];
            } else merge16_desc(cur, grp);
        }
        float oth[16];
#pragma unroll
        for (int i = 0; i < 16; ++i) oth[i] = __shfl_xor(cur[i], 32);
        merge16_desc(cur, oth);
#pragma unroll
        for (int i = 0; i < 16; ++i) top[half][i] = cur[i];
    }
    unsigned P1[4], P2[4];
#pragma unroll
    for (int q = 0; q < 4; ++q) { P1[q] = 0u; P2[q] = 0u;
#pragma unroll
        for (int s = 0; s < 4; ++s) { P1[q] |= (127u - (__float_as_uint(top[0][4 * q + s]) & 127u)) << (8 * s); P2[q] |= (127u - (__float_as_uint(top[1][4 * q + s]) & 127u)) << (8 * s); } }
#define CAND(a, b) __uint_as_float((__float_as_uint(top[0][a] + top[1][b]) & ~255u) | (255u - (unsigned)((a) * 16 + (b))))
    float bk[16];
    {
        float gk[16];
        gk[0] = CAND(0, 0);
        gk[1] = CAND(0, 1);
        gk[2] = CAND(0, 2);
        gk[3] = CAND(0, 3);
        gk[4] = CAND(0, 4);
        gk[5] = CAND(0, 5);
        gk[6] = CAND(0, 6);
        gk[7] = CAND(0, 7);
        gk[8] = CAND(0, 8);
        gk[9] = CAND(0, 9);
        gk[10] = CAND(0, 10);
        gk[11] = CAND(0, 11);
        gk[12] = CAND(0, 12);
        gk[13] = CAND(0, 13);
        gk[14] = CAND(0, 14);
        gk[15] = CAND(0, 15);
        sort16_desc(gk);
#pragma unroll
        for (int i = 0; i < 16; ++i) bk[i] = gk[i];
    }
    {
        float gk[16];
        gk[0] = CAND(1, 0);
        gk[1] = CAND(1, 1);
        gk[2] = CAND(1, 2);
        gk[3] = CAND(1, 3);
        gk[4] = CAND(1, 4);
        gk[5] = CAND(1, 5);
        gk[6] = CAND(1, 6);
        gk[7] = CAND(1, 7);
        gk[8] = CAND(2, 0);
        gk[9] = CAND(2, 1);
        gk[10] = CAND(2, 2);
        gk[11] = CAND(2, 3);
        gk[12] = CAND(2, 4);
        gk[13] = CAND(3, 0);
        gk[14] = CAND(3, 1);
        gk[15] = CAND(3, 2);
        sort16_desc(gk);
        merge16_desc(bk, gk);
    }
    {
        float gk[16];
        gk[0] = CAND(3, 3);
        gk[1] = CAND(4, 0);
        gk[2] = CAND(4, 1);
        gk[3] = CAND(4, 2);
        gk[4] = CAND(5, 0);
        gk[5] = CAND(5, 1);
        gk[6] = CAND(6, 0);
        gk[7] = CAND(6, 1);
        gk[8] = CAND(7, 0);
        gk[9] = CAND(7, 1);
        gk[10] = CAND(8, 0);
        gk[11] = CAND(9, 0);
        gk[12] = CAND(10, 0);
        gk[13] = CAND(11, 0);
        gk[14] = CAND(12, 0);
        gk[15] = CAND(13, 0);
        sort16_desc(gk);
        merge16_desc(bk, gk);
    }
    {
        float gk[16];
        gk[0] = CAND(14, 0);
        gk[1] = CAND(15, 0);
        gk[2] = -INFINITY;
        gk[3] = -INFINITY;
        gk[4] = -INFINITY;
        gk[5] = -INFINITY;
        gk[6] = -INFINITY;
        gk[7] = -INFINITY;
        gk[8] = -INFINITY;
        gk[9] = -INFINITY;
        gk[10] = -INFINITY;
        gk[11] = -INFINITY;
        gk[12] = -INFINITY;
        gk[13] = -INFINITY;
        gk[14] = -INFINITY;
        gk[15] = -INFINITY;
        sort16_desc(gk);
        merge16_desc(bk, gk);
    }
#undef CAND
    int bv[16];
#pragma unroll
    for (int i = 0; i < 16; ++i) {
        const unsigned cd = 255u - (__float_as_uint(bk[i]) & 255u), ca = cd >> 4, cb = cd & 15u;
        const unsigned wa = (ca >> 2) == 0u ? P1[0] : (ca >> 2) == 1u ? P1[1] : (ca >> 2) == 2u ? P1[2] : P1[3];
        const unsigned wb = (cb >> 2) == 0u ? P2[0] : (cb >> 2) == 1u ? P2[1] : (cb >> 2) == 2u ? P2[2] : P2[3];
        bv[i] = (int)((((wa >> (8u * (ca & 3u))) & 255u) << 7) | ((wb >> (8u * (cb & 3u))) & 255u));
    }
    float e[16], se = 0.f;
#pragma unroll
    for (int i = 0; i < 16; ++i) { e[i] = __expf(bk[i] - bk[0]); se += e[i]; }
    const float inv = 1.f / se;
    if (hi == 0) {
        LAS v4u* ip = (LAS v4u*)(EL + (tl0 + (r >> 3)) * 128 + head * 16); typedef float f4v __attribute__((ext_vector_type(4))); LAS f4v* gp = (LAS f4v*)(GL + (tl0 + (r >> 3)) * 128 + head * 16);
#pragma unroll
        for (int q = 0; q < 2; ++q) ip[q] = (v4u){(unsigned)bv[8 * q] | ((unsigned)bv[8 * q + 1] << 16), (unsigned)bv[8 * q + 2] | ((unsigned)bv[8 * q + 3] << 16), (unsigned)bv[8 * q + 4] | ((unsigned)bv[8 * q + 5] << 16), (unsigned)bv[8 * q + 6] | ((unsigned)bv[8 * q + 7] << 16)};
#pragma unroll
        for (int q = 0; q < 4; ++q) gp[q] = (f4v){e[4 * q] * inv, e[4 * q + 1] * inv, e[4 * q + 2] * inv, e[4 * q + 3] * inv};
    }
}

#define XB_TMO      128
#define XB_XCNT(j)  (256  + 64 * (j))
#define XB_XSUB(j)  (1280 + 64 * (j))
#define XB_XGEN(j)  (2304 + 64 * (j))
#define XB_TOP      3328
#define XB_TOPGEN   3392
#define XCD_BAR_WORDS 3456
#define XB_SPIN_CAP (1u << 22)
__device__ __forceinline__ unsigned xb_ld(unsigned* p)              { return __hip_atomic_load(p, __ATOMIC_RELAXED, __HIP_MEMORY_SCOPE_AGENT); }
__device__ __forceinline__ unsigned xb_add(unsigned* p, unsigned v) { return __hip_atomic_fetch_add(p, v, __ATOMIC_RELAXED, __HIP_MEMORY_SCOPE_AGENT); }
__device__ __forceinline__ unsigned xb_xcc_id() { return (unsigned)__builtin_amdgcn_s_getreg((3 << 11) | 20) & 0xFu; }
#define XB_SPIN(cond, bar) do { unsigned _sp = 0; while (cond) { __builtin_amdgcn_s_sleep(1); \
    if ((++_sp & 255u) == 0u) { if (xb_ld(&(bar)[XB_TMO])) break; if (_sp > XB_SPIN_CAP) { atomicAdd(&(bar)[XB_TMO], 1u); break; } } } } while (0)
struct XcdBarrier { unsigned* bar; unsigned x; volatile LAS unsigned* st; };
__device__ __forceinline__ XcdBarrier xcd_barrier_post(unsigned* bar, volatile LAS unsigned* st) {
    XcdBarrier b; b.bar = bar; b.x = xb_xcc_id(); b.st = st;
    if (threadIdx.x == 0) (void)xb_add(&bar[XB_XCNT(b.x)], 1u);
    return b;
}
__device__ __forceinline__ void xcd_barrier_complete(unsigned* bar, unsigned x, unsigned& nloc, unsigned& nx) {
    const unsigned G = gridDim.x * gridDim.y * gridDim.z;
    unsigned sum, cnt, mine, sp = 0u;
    for (;;) {
        sum = 0u; cnt = 0u; mine = 0u;
#pragma unroll
        for (unsigned j = 0; j < 16; ++j) { const unsigned c = xb_ld(&bar[XB_XCNT(j)]); sum += c; cnt += (c > 0u) ? 1u : 0u; mine = (j == x) ? c : mine; }
        if (sum == G) break;
        __builtin_amdgcn_s_sleep(1);
        if ((++sp & 255u) == 0u) { if (xb_ld(&bar[XB_TMO])) break; if (sp > XB_SPIN_CAP) { atomicAdd(&bar[XB_TMO], 1u); break; } }
    }
    nloc = mine > 0u ? mine : 1u; nx = cnt > 0u ? cnt : 1u;
}
__device__ __forceinline__ void xcd_barrier(const XcdBarrier& b) {
    asm volatile("s_waitcnt vmcnt(0)" ::: "memory");
    __syncthreads();
    if (threadIdx.x == 0) {
        unsigned* bar = b.bar;
        __builtin_amdgcn_s_waitcnt(0);
        unsigned nloc = b.st[0], nx = b.st[1];
        if (nloc == 0u) { xcd_barrier_complete(bar, b.x, nloc, nx); b.st[0] = nloc; b.st[1] = nx; }
        const unsigned old = xb_add(&bar[XB_XSUB(b.x)], 1u);
        const unsigned gen = old / nloc;
        if (old + 1u == (gen + 1u) * nloc) {
            __builtin_amdgcn_fence(__ATOMIC_RELEASE, "agent");
            asm volatile("s_waitcnt vmcnt(0)" ::: "memory");
            const unsigned og = xb_add(&bar[XB_TOP], 1u);
            const unsigned tg = og / nx;
            if (og + 1u == (tg + 1u) * nx) xb_add(&bar[XB_TOPGEN], 1u);
            else XB_SPIN(xb_ld(&bar[XB_TOPGEN]) == tg, bar);
            __builtin_amdgcn_fence(__ATOMIC_ACQUIRE, "agent");
            xb_add(&bar[XB_XGEN(b.x)], 1u);
            asm volatile("s_waitcnt vmcnt(0)" ::: "memory");
        } else {
            XB_SPIN(xb_ld(&bar[XB_XGEN(b.x)]) == gen, bar);
            __builtin_amdgcn_fence(__ATOMIC_ACQUIRE, "agent");
            asm volatile("s_waitcnt vmcnt(0)" ::: "memory");
        }
    }
    __syncthreads();
}
constexpr int LDS_BYTES = 147456;
constexpr int MISC_OFF = 131072 + 320;

__global__ void __launch_bounds__(NTHR, 2) k_main(Args a) {
    extern __shared__ __attribute__((aligned(16))) unsigned char lds_raw[];
    LAS unsigned char* ldsb = (LAS unsigned char*)lds_raw;
    const int tid0 = threadIdx.x, bid = blockIdx.x, nb = gridDim.x;
    const int wave = __builtin_amdgcn_readfirstlane(tid0 >> 6);
    const int gthreads = nb * NTHR, nwaves = gthreads >> 6;
#define PHASE_VARS() int tid = tid0; asm volatile("" : "+v"(tid)); const int lane = tid & 63, gtid = bid * NTHR + tid, gwave = gtid >> 6; (void)lane; (void)gtid; (void)gwave
    unsigned char* ws = a.ws;
    bf16* WINT = (bf16*)(ws + WS_WIN); bf16* WOT = (bf16*)(ws + WS_WO); bf16* WQT = (bf16*)(ws + WS_WQ);
    bf16* PROJ = (bf16*)(ws + WS_PROJ);
    bf16* XNB = (bf16*)(ws + WS_XNB);
    bf16* XACT = (bf16*)(ws + WS_XACT);
    float* DTRAW = (float*)(ws + WS_DTRAW); float* DT = (float*)(ws + WS_DT); float* ACS = (float*)(ws + WS_ACS); float* CDEC = (float*)(ws + WS_CDEC);
    float* STATES = (float*)(ws + WS_STATES); bf16* PREVT = (bf16*)(ws + WS_PREV);
    float* QP = (float*)(ws + WS_QP); unsigned short* IDX = (unsigned short*)(ws + WS_IDX); float* GATE = (float*)(ws + WS_GATE);
    float* TOPV = (float*)(ws + WS_TOPV); int* TOPI = (int*)(ws + WS_TOPI);
    unsigned char* U8 = ws + WS_U8; unsigned char* V8 = ws + WS_V8; float* SU = (float*)(ws + WS_SU); float* SV = SU + 16384; bf16* PART = (bf16*)(ws + WS_PART); unsigned char* XQ = ws + WS_XQ; float* XS = (float*)(ws + WS_XS);
    bf16* KH = (bf16*)(ws + WS_KH); bf16* KL = (bf16*)(ws + WS_KH + 65536);
    bf16* HB = (bf16*)(ws + WS_STATES);
    float* MIXF = a.out;
    volatile LAS unsigned* MISC = (volatile LAS unsigned*)(ldsb + MISC_OFF);
    if (tid0 < 32) MISC[tid0] = 0u;
    __syncthreads();
    XcdBarrier bar = xcd_barrier_post((unsigned*)ws, MISC + 8);
#define IN(k) (a.ph_lo <= (k) && (k) < a.ph_hi)
#if defined(PROBE_LO)
    int seg_ = 0; unsigned long long tseg_ = __builtin_amdgcn_s_memrealtime();
#define PROBE_SPIN() do { if (seg_ >= PROBE_LO && seg_ <= PROBE_HI) { const unsigned long long d_ = (__builtin_amdgcn_s_memrealtime() - tseg_) * PROBE_AMP; const unsigned long long s_ = __builtin_amdgcn_s_memrealtime(); \
        while (__builtin_amdgcn_s_memrealtime() - s_ < d_) __builtin_amdgcn_s_sleep(4); } } while (0)
#define GRID_BAR() do { PROBE_SPIN(); xcd_barrier(bar); tseg_ = __builtin_amdgcn_s_memrealtime(); ++seg_; } while (0)
#else
#define PROBE_SPIN() do { } while (0)
#define GRID_BAR() xcd_barrier(bar)
#endif

    if (IN(0)) {
        PHASE_VARS();
        LAS float* scr = (LAS float*)(ldsb + wave * 16384);
        constexpr int I_IN = 16 * 72, I_O = 16 * 32, NITEMS = I_IN + 2 * I_O;
        for (int it = gwave; it < NITEMS; it += nwaves) {
            int r = it;
            if (r < I_IN) { transpose_item(a.w_in, PW, D, WINT, scr, r / 72, r % 72, lane); continue; } r -= I_IN;
            if (r < I_O) { transpose_item(a.w_out, D, D, WOT, scr, r / 32, r % 32, lane); continue; } r -= I_O;
            transpose_item(a.peer_wq, D, D, WQT, scr, r / 32, r % 32, lane);
        }
        for (int i = gtid; i < 2 * 128 * 64; i += gthreads) { const float kf = a.peer_sub_keys[i]; const short h = bfs(kf); KH[i] = (bf16)h; KL[i] = (bf16)bfs(kf - sbf2f(h)); }
        for (int i = tid; i < 8 * 1024; i += NTHR) { const int h = i & 7, c = i >> 3; *(LAS float*)(ldsb + h * 16384 + 8448 + c * 4) = a.w_in[(size_t)c * PW + ODT + h]; }
        __syncthreads();
        rmsnorm_rows_bf16<1>(a.x, a.norm_mix_g, XNB, ldsb, DTRAW, nullptr, nullptr, gwave, nwaves, lane);
    }
    GRID_BAR();
    if (IN(1)) {
        PHASE_VARS();
        pg8::Gemm g{XNB, WINT, T, PS, D}; pg8::StaticOrder S; S.init(T, PS, nb, bid);
        pg8::EpiBf16Plain E{PROJ, PS};
        pg8::gemm_phase<pg8::EpiBf16Plain, pg8::StaticOrder>(ldsb, g, S, E, nullptr);
        const int cfirst = (nb == 256) ? 64 : 0;
        if (bid >= cfirst) for (int rr0 = ((bid - cfirst) * 8 + wave) * 4; rr0 < 2 * 16384; rr0 += (nb - cfirst) * 8 * 4) {
            float4 v[4][4];
#pragma unroll
            for (int q = 0; q < 4; ++q) { const int rr = rr0 + q, which = rr >> 14, row = rr & 16383;
                const float4* src4 = (const float4*)((which ? a.peer_v : a.peer_u) + (size_t)row * D) + lane;
#pragma unroll
                for (int jq = 0; jq < 4; ++jq) v[q][jq] = src4[64 * jq]; }
#pragma unroll
            for (int q = 0; q < 4; ++q) { const int rr = rr0 + q, which = rr >> 14, row = rr & 16383;
                float mx = 0.f;
#pragma unroll
                for (int jq = 0; jq < 4; ++jq) mx = fmaxf(mx, fmaxf(fmaxf(fabsf(v[q][jq].x), fabsf(v[q][jq].y)), fmaxf(fabsf(v[q][jq].z), fabsf(v[q][jq].w))));
#pragma unroll
                for (int o = 1; o < 64; o <<= 1) mx = fmaxf(mx, __shfl_xor(mx, o));
                const float sc = mx > 0.f ? mx * (1.f / 127.f) : 1.f, inv = 1.f / sc;
                unsigned* dst = (unsigned*)((which ? V8 : U8) + (size_t)row * D) + lane;
#pragma unroll
                for (int jq = 0; jq < 4; ++jq) { const int q0 = (int)rintf(v[q][jq].x * inv), q1 = (int)rintf(v[q][jq].y * inv), q2 = (int)rintf(v[q][jq].z * inv), q3 = (int)rintf(v[q][jq].w * inv);
                    dst[64 * jq] = (unsigned)(q0 & 255) | ((unsigned)(q1 & 255) << 8) | ((unsigned)(q2 & 255) << 16) | ((unsigned)(q3 & 255) << 24); }
                if (lane == 0) (which ? SV : SU)[row] = sc; }
        }
    }
    GRID_BAR();
    if (IN(3)) {
        PHASE_VARS();
        for (int u = bid; u < 512; u += nb) {
            if (u < 256) attn_unit(a.attn_sinks, a.attn_out_g, ldsb, u, PROJ, XNB, tid, lane, wave);
            else ssd_chunk_unit(ldsb, u - 256, PROJ, XACT, DTRAW, a.conv_w, a.conv_b, a.dt_bias, a.a_log, ACS, CDEC, MIXF, STATES, tid, lane, wave);
        }
    }
    GRID_BAR();
    if (IN(5)) {
        PHASE_VARS();
        for (int idx = gtid; idx < 2 * 8 * 8192; idx += gthreads) {
            const int pn = idx & 8191, h = (idx >> 13) & 7, b = idx >> 16;
            float run = 0.f;
#pragma unroll 1
            for (int c0 = 0; c0 < 64; c0 += 8) {
                float st[8], dc[8];
#pragma unroll
                for (int j = 0; j < 8; ++j) { const int bch = (b * 64 + c0 + j) * 8 + h; st[j] = STATES[(size_t)bch * 8192 + pn]; dc[j] = CDEC[bch]; }
#pragma unroll
                for (int j = 0; j < 8; ++j) { const int bch = (b * 64 + c0 + j) * 8 + h; PREVT[(size_t)bch * 8192 + pn] = f2bf(run); run = dc[j] * run + st[j]; }
            }
        }
    }
    GRID_BAR();
    if (IN(6)) {
        PHASE_VARS();
        for (int u = bid; u < 256; u += nb) yoff_unit(a.d_skip, a.ssm_norm_g, ldsb, u, XACT, PROJ, ACS, PREVT, MIXF, XNB, lane, wave);
    }
    GRID_BAR();
    if (IN(7)) {
        PHASE_VARS();
        pg8::Gemm g{XNB, WOT, T, D, D}; pg8::StaticOrder S; S.init(T, D, nb, bid);
        pg8::EpiBf16Resid E{HB, a.x, D};
        pg8::gemm_phase<pg8::EpiBf16Resid, pg8::StaticOrder>(ldsb, g, S, E, nullptr);
    }
    GRID_BAR();
    if (IN(8)) {
        PHASE_VARS();
        rmsnorm_rows_bf16<2>((const float*)HB, a.norm_ffn_g, XNB, ldsb, nullptr, XQ, XS, gwave, nwaves, lane);
    }
    GRID_BAR();
    if (IN(9)) {
        PHASE_VARS();
        pg8::Gemm g{XNB, WQT, T, D, D}; pg8::StaticOrder S; S.init(T, D, nb, bid);
        pg8::EpiF32Resid E{QP, nullptr, D};
        pg8::gemm_phase<pg8::EpiF32Resid, pg8::StaticOrder>(ldsb, g, S, E, nullptr);
    }
    GRID_BAR();
    bf16* PEERO = (bf16*)(ws + WS_PEERO);
    if (IN(12)) {
        PHASE_VARS();
        LAS bf16* KHL = (LAS bf16*)ldsb; LAS int* ACC = (LAS int*)ldsb; LAS unsigned char* AL = (LAS unsigned char*)(ldsb + 32768); LAS float* ASC = (LAS float*)(ldsb + 40960);
        LAS unsigned short* EL = (LAS unsigned short*)(ldsb + 73728); LAS float* GL = (LAS float*)(ldsb + 90112);
#pragma unroll 1
        for (int j = bid; j < NCHUNK; j += nb) {
            __syncthreads();
            for (int i = tid; i < 2 * 2 * 128 * 8; i += NTHR) {
                const int pc = i & 7, key = (i >> 3) & 127, hf = (i >> 10) & 1, hl = i >> 11;
                *(LAS v4u*)(KHL + ((hl * 2 + hf) * 128 + key) * 72 + pc * 8) = *(const v4u*)((hl ? KL : KH) + (size_t)(hf * 128 + key) * 64 + pc * 8);
            }
            __syncthreads();
            route_task(16 * j + wave, 4 * wave, QP, KHL, EL, GL, lane);
            route_task(16 * j + 8 + wave, 32 + 4 * wave, QP, KHL, EL, GL, lane);
            __syncthreads();
#pragma unroll 1
            for (int p = 0; p < NPART; ++p) peer_u_item(p, j, EL, XQ, U8, ACC, lane, wave);
#pragma unroll 1
            for (int it = 0; it < 8; ++it) {
                const int tl = it * 8 + wave, t = j * 64 + tl;
                const unsigned ew = *(const LAS unsigned*)(EL + tl * 128 + 2 * lane); const int e0 = (int)(ew & 0xffffu), e1 = (int)(ew >> 16);
                typedef int i2v __attribute__((ext_vector_type(2))); const i2v si = *(const LAS i2v*)(ACC + tl * 128 + 2 * lane);
                typedef float f2v __attribute__((ext_vector_type(2))); const f2v gt = *(const LAS f2v*)(GL + tl * 128 + 2 * lane); const float xs = XS[t];
                const float z0 = (float)si.x * SU[e0] * xs, z1 = (float)si.y * SU[e1] * xs;
                const float a0 = gt.x * 0.5f * z0 * (1.f + erff(z0 * 0.70710678118654752f)) * SV[e0], a1 = gt.y * 0.5f * z1 * (1.f + erff(z1 * 0.70710678118654752f)) * SV[e1];
                float mx = fmaxf(fabsf(a0), fabsf(a1));
#pragma unroll
                for (int o = 1; o < 64; o <<= 1) mx = fmaxf(mx, __shfl_xor(mx, o));
                const float sc = mx > 0.f ? mx * (1.f / 127.f) : 1.f, inv = 1.f / sc;
                *(LAS unsigned short*)(AL + tl * 128 + 2 * lane) = (unsigned short)(((int)rintf(a0 * inv) & 255) | (((int)rintf(a1 * inv) & 255) << 8));
                if (lane == 0) ASC[tl] = sc;
            }
#pragma unroll 1
            for (int p = 0; p < NPART; ++p) peer_v_item(p, j, EL, AL, ASC, V8, PEERO, lane, wave);
            asm volatile("s_waitcnt vmcnt(0)" ::: "memory");
#pragma unroll 1
            for (int it = 0; it < 8; ++it) {
                const int t = j * 64 + it * 8 + wave;
                const uint2* hr = (const uint2*)(HB + (size_t)t * D) + lane; unsigned long long* pr = (unsigned long long*)(PEERO + (size_t)t * D) + lane;
                float4 v[4]; float ss = 0.f;
#pragma unroll
                for (int jq = 0; jq < 4; ++jq) { const uint2 hw = hr[64 * jq]; const unsigned long long pw = __hip_atomic_load(pr + 64 * jq, __ATOMIC_RELAXED, __HIP_MEMORY_SCOPE_AGENT);
                    const unsigned pl = (unsigned)pw, ph = (unsigned)(pw >> 32);
                    v[jq] = make_float4(__uint_as_float(hw.x << 16) + __uint_as_float(pl << 16), __uint_as_float(hw.x & 0xffff0000u) + __uint_as_float(pl & 0xffff0000u),
                                        __uint_as_float(hw.y << 16) + __uint_as_float(ph << 16), __uint_as_float(hw.y & 0xffff0000u) + __uint_as_float(ph & 0xffff0000u));
                    ss += v[jq].x * v[jq].x + v[jq].y * v[jq].y + v[jq].z * v[jq].z + v[jq].w * v[jq].w; }
                ss = wave_sum(ss);
                const float r3 = rsqrtf(ss * (1.f / D) + EPS);
                float4* op = (float4*)(a.out + (size_t)t * D) + lane;
#pragma unroll
                for (int jq = 0; jq < 4; ++jq) { const float4 gv = ((const float4*)a.final_norm_g)[lane + 64 * jq]; op[64 * jq] = make_float4(v[jq].x * r3 * gv.x, v[jq].y * r3 * gv.y, v[jq].z * r3 * gv.z, v[jq].w * r3 * gv.w); }
            }
        }
    }
    PROBE_SPIN();
#undef IN
}
}

extern "C" void kernel_launch(void* const* d_in, const int* in_sizes, int n_in, void* d_out, int out_size, void* d_ws, size_t ws_size, hipStream_t stream) {
    if (n_in != 18 || out_size != T * D || ws_size < WS_END) { fprintf(stderr, "kernel_launch: unexpected shapes n_in=%d out=%d ws=%zu\n", n_in, out_size, ws_size); return; }
    Args a{};
    const float** ap = (const float**)&a;
    for (int i = 0; i < 18; ++i) ap[i] = (const float*)d_in[i];
    a.out = (float*)d_out; a.ws = (unsigned char*)d_ws;
    static int grid = 0;
    if (grid == 0) {
        int dev = 0, cus = 0, per_cu = 0;
        if (hipGetDevice(&dev) != hipSuccess || hipDeviceGetAttribute(&cus, hipDeviceAttributeMultiprocessorCount, dev) != hipSuccess) { fprintf(stderr, "kernel_launch: device query failed\n"); grid = -1; return; }
        if (hipFuncSetAttribute((const void*)k_main, hipFuncAttributeMaxDynamicSharedMemorySize, LDS_BYTES) != hipSuccess) { fprintf(stderr, "kernel_launch: hipFuncSetAttribute failed\n"); grid = -1; return; }
        if (hipOccupancyMaxActiveBlocksPerMultiprocessor(&per_cu, (const void*)k_main, NTHR, LDS_BYTES) != hipSuccess || per_cu < 1) { fprintf(stderr, "kernel_launch: occupancy query says %d blocks/CU\n", per_cu); (void)hipGetLastError(); grid = -1; return; }
        grid = cus;
    }
    if (grid < 0) return;
    if (hipMemsetAsync(d_ws, 0, 65536, stream) != hipSuccess) { fprintf(stderr, "kernel_launch: memset failed\n"); return; }
    a.ph_lo = 0; a.ph_hi = 13;
    hipLaunchKernelGGL(k_main, dim3(grid), dim3(NTHR), LDS_BYTES, stream, a);
}
```

```cpp
#include <hip/hip_runtime.h>
#include <cstdio>
#include <cstdint>

namespace pg8 {
#define PG8_LAS __attribute__((address_space(3)))
typedef unsigned short bf16_t;
typedef short bf16x8 __attribute__((ext_vector_type(8)));
typedef float f32x4 __attribute__((ext_vector_type(4)));
typedef unsigned u32x4 __attribute__((ext_vector_type(4)));
constexpr int BM = 256, BK = 64, HALF = 128, HTB = HALF * BK * 2  , STAGE_BYTES = 8 * HTB, NXCD = 8, WGM = 8;

__host__ __device__ __forceinline__ int lds_byte(int r, int c) { const int st = (r >> 4) * 2 + (c >> 5), rr = r & 15, cc = c & 31, ob = rr * 64 + cc * 2; return st * 1024 + (ob ^ (((ob >> 9) & 1) << 5)); }
__host__ __device__ __forceinline__ void stage_rc(int b, int& R, int& C) { const int st = b / 1024, sb = b % 1024, swz = sb ^ (((sb >> 9) & 1) << 5); R = (st >> 1) * 16 + swz / 64; C = (st & 1) * 32 + (swz % 64) / 2; }
__host__ __device__ __forceinline__ int perm32(int rho) { const int n = rho >> 4, i = rho & 15; return 8 * (i >> 2) + 4 * n + (i & 3); }

struct Unit { int pm, pn; };
struct Gemm { const bf16_t* A; const bf16_t* Bt; int M, N, K; };

struct StaticOrder {
    int nM, nN, nwg, G, c;
    __host__ __device__ void init(int M, int N, int G_, int c_) { nM = M / BM; nN = N / BM; nwg = nM * nN; G = G_; c = c_; }
    __host__ __device__ bool next(int i, Unit& u) const {
        const long L = (long)i * G + c; if (L >= nwg) return false;
        int wgid = (int)L; { const int q = nwg / NXCD, r = nwg % NXCD, xcd = wgid % NXCD, off = wgid / NXCD; wgid = (xcd < r ? xcd * (q + 1) : r * (q + 1) + (xcd - r) * q) + off; }
        const int nig = WGM * nN, gid = wgid / nig, fm = gid * WGM, gsz = (nM - fm) < WGM ? (nM - fm) : WGM;
        u.pm = fm + ((wgid % nig) % gsz); u.pn = (wgid % nig) / gsz; return true;
    }
    __device__ __forceinline__ void a_ready(const Unit&) const {}
    __device__ __forceinline__ void done(const Unit&) const {}
};
__device__ __forceinline__ unsigned cvt_pk_bf16(float lo, float hi) { unsigned r; asm volatile("v_cvt_pk_bf16_f32 %0, %1, %2" : "=v"(r) : "v"(lo), "v"(hi)); return r; }
typedef float f32x2 __attribute__((ext_vector_type(2)));
struct EpiBf16Plain {
    static constexpr bool PERM = true, AFTER_DRAIN = false;
    bf16_t* O; int ldc;
    __device__ __forceinline__ void operator()(const f32x4 (&acc)[2][2][4][2], const Unit& u, int wr, int wc, int fr, int fq) const {
        const int row0 = u.pm * BM + wr * 64 + fr, col0 = u.pn * BM + wc * 32 + 8 * fq;
#pragma unroll
        for (int ai = 0; ai < 2; ++ai)
#pragma unroll
            for (int m = 0; m < 4; ++m) { bf16_t* rowp = O + (size_t)(row0 + ai * HALF + m * 16) * ldc + col0;
#pragma unroll
                for (int bj = 0; bj < 2; ++bj) { const f32x4 v0 = acc[ai][bj][m][0], v1 = acc[ai][bj][m][1];
                    u32x4 w; w.x = cvt_pk_bf16(v0[0], v0[1]); w.y = cvt_pk_bf16(v0[2], v0[3]); w.z = cvt_pk_bf16(v1[0], v1[1]); w.w = cvt_pk_bf16(v1[2], v1[3]);
                    *(u32x4*)(rowp + bj * HALF) = w; } }
    }
};
struct EpiF32Resid {
    static constexpr bool PERM = false, AFTER_DRAIN = false;
    float* C; const float* R; int ldc;
    __device__ __forceinline__ void operator()(const f32x4 (&acc)[2][2][4][2], const Unit& u, int wr, int wc, int fr, int fq) const {
        const int row0 = u.pm * BM + wr * 64 + fr, col0 = u.pn * BM + wc * 32 + 4 * fq;
#pragma unroll
        for (int ai = 0; ai < 2; ++ai)
#pragma unroll
            for (int m = 0; m < 4; ++m) { const size_t off = (size_t)(row0 + ai * HALF + m * 16) * ldc + col0;
#pragma unroll
                for (int bj = 0; bj < 2; ++bj)
#pragma unroll
                    for (int n = 0; n < 2; ++n) { f32x4 v = acc[ai][bj][m][n]; if (R) v += *(const f32x4*)(R + off + bj * HALF + n * 16); *(f32x4*)(C + off + bj * HALF + n * 16) = v; }
                asm volatile("" ::: "memory"); }
    }
};

struct EpiBf16Resid {
    static constexpr bool PERM = true, AFTER_DRAIN = false;
    bf16_t* O; const float* R; int ldc;
    __device__ __forceinline__ void operator()(const f32x4 (&acc)[2][2][4][2], const Unit& u, int wr, int wc, int fr, int fq) const {
        const int row0 = u.pm * BM + wr * 64 + fr, col0 = u.pn * BM + wc * 32 + 8 * fq;
#pragma unroll
        for (int ai = 0; ai < 2; ++ai)
#pragma unroll
            for (int m = 0; m < 4; ++m) { const size_t off = (size_t)(row0 + ai * HALF + m * 16) * ldc + col0;
#pragma unroll
                for (int bj = 0; bj < 2; ++bj) { const f32x4 v0 = acc[ai][bj][m][0] + *(const f32x4*)(R + off + bj * HALF), v1 = acc[ai][bj][m][1] + *(const f32x4*)(R + off + bj * HALF + 4);
                    u32x4 w; w.x = cvt_pk_bf16(v0[0], v0[1]); w.y = cvt_pk_bf16(v0[2], v0[3]); w.z = cvt_pk_bf16(v1[0], v1[1]); w.w = cvt_pk_bf16(v1[2], v1[3]);
                    *(u32x4*)(O + off + bj * HALF) = w; }
                asm volatile("" ::: "memory"); }
    }
};
template <class Epi, class Sched, bool STAMP = false>
__device__ __forceinline__ void gemm_phase(PG8_LAS unsigned char* lds, const Gemm g, const Sched& S, const Epi& E, unsigned long long* stamps) {
    const int tid = threadIdx.x, wid = __builtin_amdgcn_readfirstlane(tid >> 6), lane = tid & 63, wr = wid >> 2, wc = wid & 3, fr = lane & 15, fq = lane >> 4;
    const int K = g.K, nt = K / BK;
    int ts_lo = 0, ts_hi = 0, nts = 0; const unsigned long long rt_entry = STAMP ? (unsigned long long)0ull : 0ull;
#define PG8_STAMP() do { if (STAMP && wid == 0 && nts < 64) { const unsigned long long _c = (unsigned long long)clock64(); \
        ts_lo = (lane == nts) ? (int)(unsigned)_c : ts_lo; ts_hi = (lane == nts) ? (int)(unsigned)(_c >> 32) : ts_hi; ++nts; } } while (0)
    PG8_STAMP();
    unsigned voffA[2], voffB[2];
#pragma unroll
    for (int i = 0; i < 2; ++i) { int R, C; stage_rc(tid * 16 + i * 8192, R, C); const int Rb = Epi::PERM ? ((R & ~31) + perm32(R & 31)) : R;
        voffA[i] = (unsigned)(R * K + C) * 2u; voffB[i] = (unsigned)(Rb * K + C) * 2u; }
    const size_t kstep = (size_t)(BK * 2);
    const size_t hstep = (size_t)HALF * K * 2;
    const size_t tstep = 2 * hstep;
    const unsigned ldsw = (unsigned)wid * 1024u;
    const int aoff = lds_byte(wr * 64 + fr, fq * 8), boff = lds_byte(wc * 32 + fr, fq * 8);
#define PG8_SA(b, h) (((b) * 2 + (h)) * HTB)
#define PG8_SB(b, h) ((4 + (b) * 2 + (h)) * HTB)
#define PG8_STAGE(bufoff, gbase, voff) do { _Pragma("unroll") for (int _i = 0; _i < 2; ++_i) \
        __builtin_amdgcn_global_load_lds((const unsigned*)((const char*)(gbase) + (voff)[_i]), (PG8_LAS unsigned*)(lds + (bufoff) + ldsw + _i * 8192), 16, 0, 0); } while (0)
#define PG8_LDA(dst, b, h) do { _Pragma("unroll") for (int m = 0; m < 4; ++m) _Pragma("unroll") for (int k = 0; k < 2; ++k) dst[m][k] = *(const PG8_LAS bf16x8*)(lds + PG8_SA(b, h) + aoff + m * 2048 + k * 1024); } while (0)
#define PG8_LDB(dst, b, h) do { _Pragma("unroll") for (int n = 0; n < 2; ++n) _Pragma("unroll") for (int k = 0; k < 2; ++k) dst[n][k] = *(const PG8_LAS bf16x8*)(lds + PG8_SB(b, h) + boff + n * 2048 + k * 1024); } while (0)
#define PG8_MMA(ai, bj, At, Bt) do { __builtin_amdgcn_s_setprio(1); _Pragma("unroll") for (int m = 0; m < 4; ++m) _Pragma("unroll") for (int n = 0; n < 2; ++n) _Pragma("unroll") for (int k = 0; k < 2; ++k) \
        acc[ai][bj][m][n] = __builtin_amdgcn_mfma_f32_16x16x32_bf16(Bt[n][k], At[m][k], acc[ai][bj][m][n], 0, 0, 0); __builtin_amdgcn_s_setprio(0); } while (0)
#define PG8_WAIT_V(n) asm volatile("s_waitcnt vmcnt(" #n ")" ::: "memory")
#define PG8_WAIT_L(n) asm volatile("s_waitcnt lgkmcnt(" #n ")" ::: "memory")
#define PG8_BAR __builtin_amdgcn_s_barrier()
#define PG8_SCHED __builtin_amdgcn_sched_barrier(0)
    Unit cur, nxt; int ui = 0;
    if (!S.next(0, cur)) return;
    f32x4 acc[2][2][4][2];
#pragma unroll
    for (int a = 0; a < 2; ++a)
#pragma unroll
        for (int b = 0; b < 2; ++b)
#pragma unroll
            for (int m = 0; m < 4; ++m)
#pragma unroll
                for (int n = 0; n < 2; ++n) acc[a][b][m][n] = (f32x4){0.f, 0.f, 0.f, 0.f};
    bf16x8 At[4][2], B0[2][2], B1[2][2];
    const char* cA = (const char*)g.A + (size_t)cur.pm * tstep; const char* cB = (const char*)g.Bt + (size_t)cur.pn * tstep;
    S.a_ready(cur);
    PG8_STAGE(PG8_SB(0, 0), cB, voffB); PG8_STAGE(PG8_SA(0, 0), cA, voffA); PG8_STAGE(PG8_SB(0, 1), cB + hstep, voffB); PG8_STAGE(PG8_SA(0, 1), cA + hstep, voffA);
    if (wr == 1) PG8_BAR;
    PG8_WAIT_V(4); PG8_BAR;
    PG8_STAGE(PG8_SB(1, 0), cB + kstep, voffB); PG8_STAGE(PG8_SA(1, 0), cA + kstep, voffA); PG8_STAGE(PG8_SB(1, 1), cB + hstep + kstep, voffB);
    PG8_WAIT_V(6); PG8_BAR;
    PG8_STAMP();
    for (;;) {
        const bool has_next = S.next(ui + 1, nxt);
        const char* nA = has_next ? (const char*)g.A + (size_t)nxt.pm * tstep : cA; const char* nB = has_next ? (const char*)g.Bt + (size_t)nxt.pn * tstep : cB;
        for (int t = 0; t < nt; t += 2) {
            const bool last = (t == nt - 2);
            const char* a1 = cA + (size_t)(t + 1) * kstep;
            const char* a2 = last ? nA : cA + (size_t)(t + 2) * kstep; const char* b2 = last ? nB : cB + (size_t)(t + 2) * kstep;
            const char* a3 = a2 + kstep; const char* b3 = b2 + kstep;
            if (last && has_next) S.a_ready(nxt);
            PG8_LDB(B0, 0, 0); PG8_SCHED; PG8_LDA(At, 0, 0); PG8_STAGE(PG8_SA(1, 1), a1 + hstep, voffA);
            PG8_WAIT_L(8); PG8_BAR; PG8_WAIT_L(0); PG8_MMA(0, 0, At, B0); PG8_BAR; PG8_SCHED;
            PG8_LDB(B1, 0, 1); PG8_STAGE(PG8_SB(0, 0), b2, voffB);
            PG8_BAR; PG8_WAIT_L(0); PG8_MMA(0, 1, At, B1); PG8_BAR;
            PG8_LDA(At, 0, 1); PG8_STAGE(PG8_SA(0, 0), a2, voffA);
            PG8_BAR; PG8_WAIT_L(0); PG8_MMA(1, 0, At, B0); PG8_BAR; PG8_SCHED;
            PG8_STAGE(PG8_SB(0, 1), b2 + hstep, voffB);
            PG8_WAIT_V(6); PG8_BAR; PG8_MMA(1, 1, At, B1); PG8_BAR;
            PG8_LDB(B0, 1, 0); PG8_SCHED; PG8_LDA(At, 1, 0); PG8_STAGE(PG8_SA(0, 1), a2 + hstep, voffA);
            PG8_WAIT_L(8); PG8_BAR; PG8_WAIT_L(0); PG8_MMA(0, 0, At, B0); PG8_BAR; PG8_SCHED;
            PG8_LDB(B1, 1, 1); PG8_STAGE(PG8_SB(1, 0), b3, voffB);
            PG8_BAR; PG8_WAIT_L(0); PG8_MMA(0, 1, At, B1); PG8_BAR;
            PG8_LDA(At, 1, 1); PG8_STAGE(PG8_SA(1, 0), a3, voffA);
            PG8_BAR; PG8_WAIT_L(0); PG8_MMA(1, 0, At, B0); PG8_BAR; PG8_SCHED;
            PG8_STAGE(PG8_SB(1, 1), b3 + hstep, voffB);
            PG8_WAIT_V(6); PG8_BAR; PG8_MMA(1, 1, At, B1); PG8_BAR;
        }
        PG8_STAMP();
        if constexpr (!Epi::AFTER_DRAIN) { E(acc, cur, wr, wc, fr, fq); S.done(cur); }
        PG8_STAMP();
        if (!has_next) break;
#pragma unroll
        for (int a = 0; a < 2; ++a)
#pragma unroll
            for (int b = 0; b < 2; ++b)
#pragma unroll
                for (int m = 0; m < 4; ++m)
#pragma unroll
                    for (int n = 0; n < 2; ++n) acc[a][b][m][n] = (f32x4){0.f, 0.f, 0.f, 0.f};
        cur = nxt; cA = nA; cB = nB; ++ui;
    }
    PG8_WAIT_V(0);
    if (wr == 0) PG8_BAR;
    PG8_BAR;
    if constexpr (Epi::AFTER_DRAIN) { E.fused(acc, cur, wr, wc, fr, fq, lds, wid, lane); S.done(cur); }
    PG8_STAMP();
    if (STAMP && wid == 0) { stamps[lane] = lane < nts ? (((unsigned long long)(unsigned)ts_hi << 32) | (unsigned)ts_lo) : 0ull;
        if (lane == 62) stamps[62] = rt_entry; if (lane == 63) stamps[63] = (unsigned long long)0ull; }
#undef PG8_STAMP
#undef PG8_SA
#undef PG8_SB
#undef PG8_STAGE
#undef PG8_LDA
#undef PG8_LDB
#undef PG8_MMA
#undef PG8_WAIT_V
#undef PG8_WAIT_L
#undef PG8_BAR
#undef PG8_SCHED
}
}

namespace {
constexpr int D = 1024, BATCH = 2, SEQ = 8192, T = BATCH * SEQ;
constexpr int PW = 2312;
constexpr int PS = 2304;
constexpr int OQ = 0, OKK = 512, OV = 640, OZ = 768, OXBC = 1280, ODT = 2304;
constexpr float EPS = 1e-6f;
constexpr int NTHR = 512;
typedef unsigned short bf16;
typedef unsigned v4u __attribute__((ext_vector_type(4)));

constexpr size_t MiB = 1u << 20;
constexpr size_t WS_WIN = 1 * MiB;
constexpr size_t WS_KH = 5 * MiB + 512 * 1024;
constexpr size_t WS_WO = 6 * MiB;
constexpr size_t WS_WQ = 8 * MiB;
constexpr size_t WS_PROJ = 10 * MiB;
constexpr size_t WS_XNB = 82 * MiB;
constexpr size_t WS_XACT = 114 * MiB;
constexpr size_t WS_DTRAW = 146 * MiB;
constexpr size_t WS_DT = WS_DTRAW + 512 * 1024;
constexpr size_t WS_ACS = WS_DT + 512 * 1024;
constexpr size_t WS_CDEC = WS_ACS + 512 * 1024;
constexpr size_t WS_STATES = 164 * MiB;
constexpr size_t WS_PREV = 196 * MiB;
constexpr size_t WS_QP = 10 * MiB;
constexpr size_t WS_IDX = 74 * MiB;
constexpr size_t WS_GATE = 114 * MiB;
constexpr size_t WS_TOPV = 122 * MiB;
constexpr size_t WS_TOPI = 138 * MiB;
constexpr size_t WS_ACT = 122 * MiB;
constexpr size_t WS_SU = 245 * MiB;
constexpr size_t WS_U8 = 212 * MiB;
constexpr size_t WS_V8 = 148 * MiB;
constexpr size_t WS_PART = 10 * MiB;
constexpr size_t WS_XQ = 228 * MiB;
constexpr size_t WS_XS = 244 * MiB;
constexpr size_t WS_PEERO = 10 * MiB;
constexpr size_t WS_END = 246 * MiB;
constexpr int CW_QU = 4096, CW_QV = 4096 + 64 * 16;
constexpr int NPART = 8, NCHUNK = T / 64;

struct Args {
    const float* x; const float* norm_mix_g; const float* w_in; const float* attn_sinks; const float* attn_out_g;
    const float* conv_w; const float* conv_b; const float* dt_bias; const float* a_log; const float* d_skip;
    const float* ssm_norm_g; const float* w_out; const float* norm_ffn_g; const float* peer_wq; const float* peer_sub_keys;
    const float* peer_u; const float* peer_v; const float* final_norm_g;
    float* out; unsigned char* ws;
    int ph_lo, ph_hi;
};

#define LAS __attribute__((address_space(3)))
#define LDS_WAIT() asm volatile("s_waitcnt lgkmcnt(0)" ::: "memory")
__device__ __forceinline__ float bf2f(bf16 v) { return __uint_as_float(((unsigned)v) << 16); }
__device__ __forceinline__ unsigned f2bfu(float f) { unsigned u = __float_as_uint(f); return (u + 0x7fffu + ((u >> 16) & 1u)) >> 16; }
__device__ __forceinline__ bf16 f2bf(float f) { return (bf16)f2bfu(f); }
__device__ __forceinline__ unsigned pk2(float lo, float hi) { return f2bfu(lo) | (f2bfu(hi) << 16); }
__device__ __forceinline__ float wave_sum(float v) {
#pragma unroll
    for (int o = 1; o < 64; o <<= 1) v += __shfl_xor(v, o);
    return v;
}
__device__ __forceinline__ float silu_f(float v) { return v / (1.f + __expf(-v)); }

__device__ __forceinline__ void transpose_item(const float* W, int ldw, int K, bf16* WT, LAS float* scr, int kb, int nbk, int lane) {
    const int k0 = 64 * kb, n0 = 32 * nbk;
#pragma unroll 8
    for (int i = 0; i < 32; ++i) { const int kk = 2 * i + (lane >> 5); scr[kk * 33 + (lane & 31)] = W[(size_t)(k0 + kk) * ldw + n0 + (lane & 31)]; }
    LDS_WAIT();
    const int c = lane & 7;
#pragma unroll
    for (int j = 0; j < 4; ++j) { const int n = (lane >> 3) + 8 * j; const LAS float* s = scr + (8 * c) * 33 + n;
        v4u o; o.x = pk2(s[0 * 33], s[1 * 33]); o.y = pk2(s[2 * 33], s[3 * 33]); o.z = pk2(s[4 * 33], s[5 * 33]); o.w = pk2(s[6 * 33], s[7 * 33]);
        *(v4u*)(WT + (size_t)(n0 + n) * K + k0 + 8 * c) = o; }
    LDS_WAIT();
}

template <int MODE  >
__device__ __forceinline__ void rmsnorm_rows_bf16(const float* __restrict__ in, const float* __restrict__ g, bf16* __restrict__ outp, const LAS unsigned char* ldsb, float* __restrict__ dtraw, unsigned char* __restrict__ xq, float* __restrict__ xs, int gwave, int nwaves, int lane) {
#pragma unroll 2
    for (int row = gwave; row < T; row += nwaves) {
        const float4* xr = (const float4*)(in + (size_t)row * D) + lane; const uint2* xb = (const uint2*)((const bf16*)in + (size_t)row * D) + lane;
        float4 v[4]; float ss = 0.f;
#pragma unroll
        for (int j = 0; j < 4; ++j) {
            if (MODE == 2) { const uint2 w = xb[64 * j]; v[j] = make_float4(__uint_as_float(w.x << 16), __uint_as_float(w.x & 0xffff0000u), __uint_as_float(w.y << 16), __uint_as_float(w.y & 0xffff0000u)); }
            else if (MODE == 1) { typedef float f4v __attribute__((ext_vector_type(4))); const f4v t4 = __builtin_nontemporal_load((const f4v*)xr + 64 * j); v[j] = make_float4(t4.x, t4.y, t4.z, t4.w); }
            else v[j] = xr[64 * j];
            ss += v[j].x * v[j].x + v[j].y * v[j].y + v[j].z * v[j].z + v[j].w * v[j].w; }
        ss = wave_sum(ss);
        const float r = rsqrtf(ss * (1.f / D) + EPS);
        unsigned long long* o8 = (unsigned long long*)(outp + (size_t)row * D) + lane;
        float dacc[8]; float y[4][4]; float mx = 0.f;
#pragma unroll
        for (int h = 0; h < 8; ++h) dacc[h] = 0.f;
#pragma unroll
        for (int j = 0; j < 4; ++j) {
            const float4 gv = ((const float4*)g)[lane + 64 * j];
            y[j][0] = v[j].x * r * gv.x; y[j][1] = v[j].y * r * gv.y; y[j][2] = v[j].z * r * gv.z; y[j][3] = v[j].w * r * gv.w;
            o8[64 * j] = (unsigned long long)pk2(y[j][0], y[j][1]) | ((unsigned long long)pk2(y[j][2], y[j][3]) << 32);
            if (MODE == 2) mx = fmaxf(mx, fmaxf(fmaxf(fabsf(y[j][0]), fabsf(y[j][1])), fmaxf(fabsf(y[j][2]), fabsf(y[j][3]))));
            if (MODE == 1) {
#pragma unroll
                for (int h = 0; h < 8; ++h) {
                    typedef float f4v __attribute__((ext_vector_type(4)));
                    const f4v wv = *(const LAS f4v*)(ldsb + h * 16384 + 8448 + (256 * j + 4 * lane) * 4);
                    dacc[h] += y[j][0] * wv.x + y[j][1] * wv.y + y[j][2] * wv.z + y[j][3] * wv.w;
                }
            }
        }
        if (MODE == 1) {
#pragma unroll
            for (int h = 0; h < 8; ++h) dacc[h] = wave_sum(dacc[h]);
            if (lane == 0) { float4* dp = (float4*)(dtraw + (size_t)row * 8); dp[0] = make_float4(dacc[0], dacc[1], dacc[2], dacc[3]); dp[1] = make_float4(dacc[4], dacc[5], dacc[6], dacc[7]); }
        }
        if (MODE == 2) {
#pragma unroll
            for (int o = 1; o < 64; o <<= 1) mx = fmaxf(mx, __shfl_xor(mx, o));
            const float sc = mx > 0.f ? mx * (1.f / 127.f) : 1.f, inv = 1.f / sc;
            unsigned* dq = (unsigned*)(xq + (size_t)row * D) + lane;
#pragma unroll
            for (int j = 0; j < 4; ++j) { const int q0 = (int)rintf(y[j][0] * inv), q1 = (int)rintf(y[j][1] * inv), q2 = (int)rintf(y[j][2] * inv), q3 = (int)rintf(y[j][3] * inv);
                dq[64 * j] = (unsigned)(q0 & 255) | ((unsigned)(q1 & 255) << 8) | ((unsigned)(q2 & 255) << 16) | ((unsigned)(q3 & 255) << 24); }
            if (lane == 0) xs[row] = sc;
        }
    }
}

typedef short bf16x8 __attribute__((ext_vector_type(8)));
typedef short bf16x4 __attribute__((ext_vector_type(4)));
typedef float f32x16 __attribute__((ext_vector_type(16)));
typedef __bf16 bf2_t __attribute__((ext_vector_type(2)));
#define MFMA32(a, b, c) __builtin_amdgcn_mfma_f32_32x32x16_bf16((a), (b), (c), 0, 0, 0)
__device__ __forceinline__ unsigned pkbf(float lo, float hi) { bf2_t v = {(__bf16)lo, (__bf16)hi}; return __builtin_bit_cast(unsigned, v); }
__device__ __forceinline__ short bfs(float f) { return __builtin_bit_cast(short, (__bf16)f); }
__device__ __forceinline__ float sbf2f(short v) { return __uint_as_float(((unsigned)(unsigned short)v) << 16); }
__device__ __forceinline__ int crow(int i, int hi) { return (i & 3) + 8 * (i >> 2) + 4 * hi; }
template <int S> __device__ __forceinline__ bf16x8 pack8(const f32x16& x) {
    v4u p; p.x = pkbf(x[8 * S], x[8 * S + 1]); p.y = pkbf(x[8 * S + 2], x[8 * S + 3]); p.z = pkbf(x[8 * S + 4], x[8 * S + 5]); p.w = pkbf(x[8 * S + 6], x[8 * S + 7]);
    return __builtin_bit_cast(bf16x8, p);
}
__device__ __forceinline__ bf16x8 ldg8(const bf16* p) { return *(const bf16x8*)p; }
__device__ __forceinline__ bf16x8 lds8(const LAS bf16* p) { return *(const LAS bf16x8*)p; }
__device__ __forceinline__ bf16x8 lds4x2(const LAS bf16* p) { const bf16x4 a = *(const LAS bf16x4*)p, b = *(const LAS bf16x4*)(p + 8); return __builtin_shufflevector(a, b, 0, 1, 2, 3, 4, 5, 6, 7); }
__device__ __forceinline__ f32x16 zero16() { f32x16 z;
#pragma unroll
    for (int i = 0; i < 16; ++i) z[i] = 0.f;
    return z; }

__device__ __forceinline__ void attn_unit(const float* sinks, const float* gnorm, LAS unsigned char* ldsb, int unit, const bf16* PROJ, bf16* MIXB, int tid, int lane, int wave) {
    asm volatile("" : "+v"(tid), "+v"(lane));
    const int tok0 = unit * 64, s0 = tok0 & (SEQ - 1), kbase = tok0 - 128;
    LAS bf16* VT = (LAS bf16*)ldsb;
    LAS bf16* KI = (LAS bf16*)(ldsb + 51200);
    LAS float* SSQ = (LAS float*)(ldsb + 51200 + 55296);
    const __amdgpu_buffer_rsrc_t rsP = __builtin_amdgcn_make_buffer_rsrc((void*)PROJ, 0, (unsigned)T * PS * 2u, 0x00020000);
#pragma unroll
    for (int i = 0; i < 6; ++i) {
        const int c = tid + 512 * i, kv = c / 1536, cc = c - kv * 1536, key = cc >> 3, d0 = (cc & 7) * 8; const bool valid = (s0 - 128 + key) >= 0;
        bf16x8 v, k;
#pragma unroll
        for (int e = 0; e < 8; ++e) { v[e] = 0; k[e] = 0; }
        if (valid) { const unsigned ro = (unsigned)(kbase + key) * (unsigned)PS + (unsigned)(kv * 64 + d0);
            v = __builtin_bit_cast(bf16x8, __builtin_amdgcn_raw_buffer_load_b128(rsP, (int)((ro + (unsigned)OV) * 2u), 0, 0));
            k = __builtin_bit_cast(bf16x8, __builtin_amdgcn_raw_buffer_load_b128(rsP, (int)((ro + (unsigned)OKK) * 2u), 0, 0)); }
#pragma unroll
        for (int e = 0; e < 8; ++e) VT[kv * 12800 + (d0 + e) * 200 + key] = (bf16)v[e];
        *(LAS bf16x8*)(KI + (kv * 192 + key) * 72 + d0) = k;
    }
    __syncthreads();
    const int r = lane & 31, hi = lane >> 5;
    const int hq = wave, hkv = wave >> 2;
    const float slope = exp2f(-(float)(hq + 1)), sink = sinks[hq];
#pragma unroll 1
    for (int qt = 0; qt < 2; ++qt) {
        const int tq = tok0 + 32 * qt + r;
        bf16x8 qf[4];
        { const bf16* qp = PROJ + (size_t)tq * PS + OQ + hq * 64 + 8 * hi; asm volatile("" : "+v"(qp));
#pragma unroll
          for (int ks = 0; ks < 4; ++ks) qf[ks] = ldg8(qp + 16 * ks); }
        const int ql = 32 * qt + r;
        float m = sink, lh = 0.f;
        f32x16 O0 = zero16(), O1 = zero16();
#pragma unroll 1
        for (int kt = 0; kt < 5; ++kt) {
            const LAS bf16* kp = KI + (hkv * 192 + 32 * (qt + kt) + r) * 72 + 8 * hi;
            f32x16 X = zero16();
#pragma unroll
            for (int ks = 0; ks < 4; ++ks) X = MFMA32(lds8(kp + 16 * ks), qf[ks], X);
            float tm = -1e30f;
#pragma unroll
            for (int i = 0; i < 16; ++i) {
                const int kl = 32 * (qt + kt) + crow(i, hi), dist = 128 + ql - kl;
                const bool valid = (dist >= 0) && (dist < 128) && ((s0 - 128 + kl) >= 0);
                const float lg = valid ? (X[i] * 0.125f - slope * (float)dist) : -1e30f;
                X[i] = lg; tm = fmaxf(tm, lg);
            }
            tm = fmaxf(tm, __shfl_xor(tm, 32));
            const float mn = fmaxf(m, tm), sc = __expf(m - mn);
            m = mn; lh *= sc;
#pragma unroll
            for (int i = 0; i < 16; ++i) { O0[i] *= sc; O1[i] *= sc; const float pe = __expf(X[i] - mn); X[i] = pe; lh += pe; }
            const LAS bf16* vp = VT + hkv * 12800 + r * 200 + 32 * (qt + kt) + 4 * hi;
            { const bf16x8 xs = pack8<0>(X); const bf16x8 a0 = lds4x2(vp), a1 = lds4x2(vp + 32 * 200); O0 = MFMA32(a0, xs, O0); O1 = MFMA32(a1, xs, O1); }
            { const bf16x8 xs = pack8<1>(X); const bf16x8 a0 = lds4x2(vp + 16), a1 = lds4x2(vp + 32 * 200 + 16); O0 = MFMA32(a0, xs, O0); O1 = MFMA32(a1, xs, O1); }
        }
        const float lsum = lh + __shfl_xor(lh, 32) + __expf(sink - m);
        const float iv = 1.f / lsum;
        float sq = 0.f;
#pragma unroll
        for (int i = 0; i < 16; ++i) sq += O0[i] * O0[i] + O1[i] * O1[i];
        sq *= iv * iv; sq += __shfl_xor(sq, 32);
        if (hi == 0) SSQ[hq * 32 + r] = sq;
        __syncthreads();
        float tot = 0.f;
#pragma unroll
        for (int h = 0; h < 8; ++h) tot += SSQ[h * 32 + r];
        const float sc = iv * rsqrtf(tot * (1.f / 512.f) + EPS);
        bf16* orow = MIXB + (size_t)tq * D + hq * 64 + 4 * hi;
#pragma unroll
        for (int q4 = 0; q4 < 4; ++q4) {
            const float4 g0 = *(const float4*)(gnorm + hq * 64 + 8 * q4 + 4 * hi), g1 = *(const float4*)(gnorm + hq * 64 + 32 + 8 * q4 + 4 * hi);
            uint2 w0, w1;
            w0.x = pkbf(O0[4 * q4] * sc * g0.x, O0[4 * q4 + 1] * sc * g0.y); w0.y = pkbf(O0[4 * q4 + 2] * sc * g0.z, O0[4 * q4 + 3] * sc * g0.w);
            w1.x = pkbf(O1[4 * q4] * sc * g1.x, O1[4 * q4 + 1] * sc * g1.y); w1.y = pkbf(O1[4 * q4 + 2] * sc * g1.z, O1[4 * q4 + 3] * sc * g1.w);
            *(uint2*)(orow + 8 * q4) = w0; *(uint2*)(orow + 32 + 8 * q4) = w1;
        }
        __syncthreads();
    }
}

__device__ __forceinline__ void ssd_chunk_unit(LAS unsigned char* ldsb, int unit, const bf16* PROJ, bf16* XACT, const float* DTRAW, const float* conv_w, const float* conv_b, const float* dt_bias, const float* a_log,
                                               float* ACS, float* CDEC, float* MIXF, float* STATES, int tid, int lane, int wave) {
    asm volatile("" : "+v"(tid), "+v"(lane));
    const int g = unit & 1, bc = unit >> 1, tok0 = bc * 128;
    LAS float* DTT = (LAS float*)(ldsb + 34816 * 3 + 2048);
    LAS float* WT = (LAS float*)(ldsb + 34816 * 3 + 4096);
    {
        const int cgi = tid & 63, t0 = tok0 + 16 * (tid >> 6);
        const int c0 = cgi < 32 ? g * 256 + cgi * 8 : (cgi < 48 ? 512 + g * 128 + (cgi - 32) * 8 : 768 + g * 128 + (cgi - 48) * 8);
        float w[4][8], bs[8];
#pragma unroll
        for (int k = 0; k < 4; ++k) { const float4 a0 = *(const float4*)(conv_w + k * 1024 + c0), a1 = *(const float4*)(conv_w + k * 1024 + c0 + 4);
            w[k][0] = a0.x; w[k][1] = a0.y; w[k][2] = a0.z; w[k][3] = a0.w; w[k][4] = a1.x; w[k][5] = a1.y; w[k][6] = a1.z; w[k][7] = a1.w; }
        { const float4 a0 = *(const float4*)(conv_b + c0), a1 = *(const float4*)(conv_b + c0 + 4); bs[0] = a0.x; bs[1] = a0.y; bs[2] = a0.z; bs[3] = a0.w; bs[4] = a1.x; bs[5] = a1.y; bs[6] = a1.z; bs[7] = a1.w; }
        const bool has_halo = (t0 & (SEQ - 1)) != 0;
        bf16x8 rows[19];
#pragma unroll
        for (int i = 0; i < 19; ++i) {
            if (i < 3 && !has_halo) {
#pragma unroll
                for (int e = 0; e < 8; ++e) rows[i][e] = 0;
            } else rows[i] = ldg8(PROJ + (size_t)(t0 + i - 3) * PS + OXBC + c0);
        }
#pragma unroll
        for (int i = 0; i < 16; ++i) {
            float o[8];
#pragma unroll
            for (int e = 0; e < 8; ++e) o[e] = silu_f(bs[e] + w[0][e] * sbf2f(rows[i][e]) + w[1][e] * sbf2f(rows[i + 1][e]) + w[2][e] * sbf2f(rows[i + 2][e]) + w[3][e] * sbf2f(rows[i + 3][e]));
            v4u ov; ov.x = pkbf(o[0], o[1]); ov.y = pkbf(o[2], o[3]); ov.z = pkbf(o[4], o[5]); ov.w = pkbf(o[6], o[7]);
            *(v4u*)(XACT + (size_t)(t0 + i) * 1024 + c0) = ov;
        }
    }
    LAS float* ACST = (LAS float*)(ldsb + 34816 * 3);
    {
        const int s = tid >> 2, hh = tid & 3, H = g * 4 + hh;
        const float A = -__expf(a_log[H]);
        const float raw = DTRAW[(size_t)(tok0 + s) * 8 + H] + dt_bias[H];
        const float dtv = fmaxf(raw, 0.f) + log1pf(__expf(-fabsf(raw)));
        float v = dtv * A;
#pragma unroll
        for (int o = 4; o < 64; o <<= 1) { const float y = __shfl_up(v, o); if (lane >= o) v += y; }
        if (lane >= 60) WT[wave * 4 + hh] = v;
        __syncthreads();
        float off = 0.f;
        for (int w2 = 0; w2 < wave; ++w2) off += WT[w2 * 4 + hh];
        v += off;
        DTT[tid] = dtv; ACST[tid] = v; ACS[(size_t)(tok0 + s) * 8 + H] = v;
        if (s == 127) CDEC[bc * 8 + H] = __expf(v);
    }
    asm volatile("s_waitcnt vmcnt(0)" ::: "memory");
    __syncthreads();
    LAS bf16* BT = (LAS bf16*)ldsb;
    LAS bf16* XD = (LAS bf16*)(ldsb + 34816);
    LAS bf16* XW = (LAS bf16*)(ldsb + 34816 + 34816);
    const int r = lane & 31, hi = lane >> 5;
#pragma unroll
    for (int i = 0; i < 4; ++i) {
        const int c = tid + 512 * i, s = c >> 4, n0 = (c & 15) * 8;
        const bf16x8 v = ldg8(XACT + (size_t)(tok0 + s) * 1024 + 512 + g * 128 + n0);
#pragma unroll
        for (int e = 0; e < 8; ++e) BT[(n0 + e) * 136 + s] = (bf16)v[e];
    }
#pragma unroll 1
    for (int hp = 0; hp < 2; ++hp) {
        if (hp) __syncthreads();
        int tidp = tid; asm volatile("" : "+v"(tidp));
#pragma unroll
        for (int i = 0; i < 4; ++i) {
            const int c = tidp + 512 * i, hsel = c >> 10, s = (c >> 3) & 127, p0 = (c & 7) * 8, H = g * 4 + 2 * hp + hsel;
            const bf16x8 v = ldg8(XACT + (size_t)(tok0 + s) * 1024 + H * 64 + p0);
            const float dtv = DTT[s * 4 + 2 * hp + hsel];
            const float w = __expf(ACST[127 * 4 + 2 * hp + hsel] - ACST[s * 4 + 2 * hp + hsel]);
#pragma unroll
            for (int e = 0; e < 8; ++e) { const float xd = sbf2f(v[e]) * dtv; XD[hsel * 8704 + (p0 + e) * 136 + s] = (bf16)bfs(xd); XW[hsel * 8704 + (p0 + e) * 136 + s] = (bf16)bfs(xd * w); }
        }
        __syncthreads();
        {
            const int lt = wave & 3, hsel = wave >> 2, hh = 2 * hp + hsel, H = g * 4 + hh;
            const int l = 32 * lt + r; const float acs_l = ACST[l * 4 + hh];
            bf16x8 cf[8];
            { const bf16* cp = XACT + (size_t)(tok0 + l) * 1024 + 768 + g * 128 + 8 * hi; asm volatile("" : "+v"(cp));
#pragma unroll
              for (int ks = 0; ks < 8; ++ks) cf[ks] = ldg8(cp + 16 * ks); }
            f32x16 Z0 = zero16(), Z1 = zero16();
            bf16x8 bn[8];
            { const bf16* bp = XACT + (size_t)(tok0 + r) * 1024 + 512 + g * 128 + 8 * hi; asm volatile("" : "+v"(bp));
#pragma unroll
              for (int ks = 0; ks < 8; ++ks) bn[ks] = ldg8(bp + 16 * ks); }
#pragma unroll 1
            for (int st = 0; st <= lt; ++st) {
                f32x16 X = zero16();
                bf16x8 bc[8];
#pragma unroll
                for (int ks = 0; ks < 8; ++ks) bc[ks] = bn[ks];
                { const int stn = st < lt ? st + 1 : lt; const bf16* bp = XACT + (size_t)(tok0 + 32 * stn + r) * 1024 + 512 + g * 128 + 8 * hi; asm volatile("" : "+v"(bp));
#pragma unroll
                  for (int ks = 0; ks < 8; ++ks) bn[ks] = ldg8(bp + 16 * ks); }
#pragma unroll
                for (int ks = 0; ks < 8; ++ks) X = MFMA32(bc[ks], cf[ks], X);
#pragma unroll
                for (int i = 0; i < 16; ++i) { const int s = 32 * st + crow(i, hi); const float f = (s <= l) ? __expf(acs_l - ACST[s * 4 + hh]) : 0.f; X[i] *= f; }
                const int sb = 32 * st + 4 * hi;
                { const bf16x8 xs = pack8<0>(X); const bf16x8 b0 = lds4x2(XD + hsel * 8704 + r * 136 + sb), b1 = lds4x2(XD + hsel * 8704 + (32 + r) * 136 + sb); Z0 = MFMA32(xs, b0, Z0); Z1 = MFMA32(xs, b1, Z1); }
                { const bf16x8 xs = pack8<1>(X); const bf16x8 b0 = lds4x2(XD + hsel * 8704 + r * 136 + sb + 16), b1 = lds4x2(XD + hsel * 8704 + (32 + r) * 136 + sb + 16); Z0 = MFMA32(xs, b0, Z0); Z1 = MFMA32(xs, b1, Z1); }
            }
#pragma unroll
            for (int i = 0; i < 16; ++i) { float* o = MIXF + (size_t)(tok0 + 32 * lt + crow(i, hi)) * D + 512 + H * 64 + r; o[0] = Z0[i]; o[32] = Z1[i]; }
        }
        {
            const int nt = wave & 3, hsel = wave >> 2, H = g * 4 + 2 * hp + hsel;
            f32x16 S0 = zero16(), S1 = zero16();
#pragma unroll
            for (int ks = 0; ks < 8; ++ks) {
                const bf16x8 btf = lds8(BT + (32 * nt + r) * 136 + 16 * ks + 8 * hi);
                const bf16x8 a0 = lds8(XW + hsel * 8704 + r * 136 + 16 * ks + 8 * hi), a1 = lds8(XW + hsel * 8704 + (32 + r) * 136 + 16 * ks + 8 * hi);
                S0 = MFMA32(a0, btf, S0); S1 = MFMA32(a1, btf, S1);
            }
            float* sp = STATES + (size_t)(bc * 8 + H) * 8192 + 32 * nt + r;
#pragma unroll
            for (int i = 0; i < 16; ++i) { const int p = crow(i, hi); sp[p * 128] = S0[i]; sp[(32 + p) * 128] = S1[i]; }
        }
    }
    __syncthreads();
}

__device__ __forceinline__ __amdgpu_buffer_rsrc_t mk_rsrc(const void* p, unsigned bytes) { return __builtin_amdgcn_make_buffer_rsrc((void*)p, 0, bytes, 0x00020000); }
__device__ __forceinline__ void yoff_unit(const float* d_skip, const float* gnorm, LAS unsigned char* ldsb, int unit, const bf16* XACT, const bf16* PROJ, const float* ACS, const bf16* PREVT,
                                          const float* MIXF, bf16* MIXB, int lane, int wave) {
    const int g = unit & 1, bc = unit >> 1, tok0 = bc * 128;
    const int r = lane & 31, hi = lane >> 5, lt = wave & 3, hpair = wave >> 2;
    LAS float* TAB = (LAS float*)ldsb;
    const __amdgpu_buffer_rsrc_t rsF = mk_rsrc(MIXF, (unsigned)T * D * 4u), rsX = mk_rsrc(XACT, (unsigned)T * 1024u * 2u), rsP = mk_rsrc(PROJ, (unsigned)T * PS * 2u), rsA = mk_rsrc(ACS, (unsigned)T * 32u), rsB = mk_rsrc(MIXB, (unsigned)T * D * 2u);
    const unsigned tb = (unsigned)(tok0 + 32 * lt + 4 * hi);
    bf16x8 cf[8];
    { const bf16* cp = XACT + (size_t)(tok0 + 32 * lt + r) * 1024 + 768 + g * 128 + 8 * hi; asm volatile("" : "+v"(cp));
#pragma unroll
      for (int ks = 0; ks < 8; ++ks) cf[ks] = ldg8(cp + 16 * ks); }
    float eav[16], ssq[16];
    unsigned ypk[2][2][8];
#pragma unroll
    for (int i = 0; i < 16; ++i) ssq[i] = 0.f;
#pragma unroll
    for (int hsel = 0; hsel < 2; ++hsel) {
        const int H = g * 4 + 2 * hpair + hsel; const bf16* pv = PREVT + (size_t)(bc * 8 + H) * 8192 + 8 * hi;
        asm volatile("" : "+v"(pv));
        f32x16 Y0 = zero16(), Y1 = zero16();
#pragma unroll
        for (int ks = 0; ks < 8; ++ks) {
            const bf16x8 b0 = ldg8(pv + r * 128 + 16 * ks), b1 = ldg8(pv + (32 + r) * 128 + 16 * ks);
            Y0 = MFMA32(cf[ks], b0, Y0); Y1 = MFMA32(cf[ks], b1, Y1);
        }
        const float dsk = d_skip[H];
        { const unsigned vo = (tb * 8u + (unsigned)H) * 4u;
#pragma unroll
          for (int i = 0; i < 16; ++i) eav[i] = __expf(__builtin_bit_cast(float, __builtin_amdgcn_raw_buffer_load_b32(rsA, (int)vo, ((i & 3) + 8 * (i >> 2)) * 32, 0))); }
#pragma unroll
        for (int pt = 0; pt < 2; ++pt) {
            const unsigned col = (unsigned)(H * 64 + 32 * pt + r);
            const unsigned voF = (tb * 1024u + 512u + col) * 4u, voX = (tb * 1024u + col) * 2u, voP = (tb * (unsigned)PS + (unsigned)OZ + col) * 2u;
            float yo[16], xsv[16], zv[16];
#pragma unroll
            for (int i = 0; i < 16; ++i) { const int ro = (i & 3) + 8 * (i >> 2);
                yo[i] = __builtin_bit_cast(float, __builtin_amdgcn_raw_buffer_load_b32(rsF, (int)voF, ro * 4096, 0));
                xsv[i] = bf2f((bf16)__builtin_amdgcn_raw_buffer_load_b16(rsX, (int)voX, ro * 2048, 0));
                zv[i] = bf2f((bf16)__builtin_amdgcn_raw_buffer_load_b16(rsP, (int)voP, ro * (PS * 2), 0)); }
#pragma unroll
            for (int i = 0; i < 16; i += 2) {
                const float y0 = (yo[i] + eav[i] * (pt ? Y1[i] : Y0[i]) + dsk * xsv[i]) * silu_f(zv[i]);
                const float y1 = (yo[i + 1] + eav[i + 1] * (pt ? Y1[i + 1] : Y0[i + 1]) + dsk * xsv[i + 1]) * silu_f(zv[i + 1]);
                ssq[i] += y0 * y0; ssq[i + 1] += y1 * y1; ypk[hsel][pt][i >> 1] = pkbf(y0, y1);
            }
            __builtin_amdgcn_sched_barrier(0);
        }
    }
#pragma unroll
    for (int i = 0; i < 16; ++i) {
#pragma unroll
        for (int o = 1; o < 32; o <<= 1) ssq[i] += __shfl_xor(ssq[i], o);
    }
    if (r == 0) {
#pragma unroll
        for (int i = 0; i < 16; ++i) TAB[hpair * 128 + 32 * lt + crow(i, hi)] = ssq[i];
    }
    __syncthreads();
#pragma unroll
    for (int i = 0; i < 16; ++i) { const int l = 32 * lt + crow(i, hi); ssq[i] = rsqrtf((TAB[l] + TAB[128 + l]) * (1.f / 256.f) + EPS); }
#pragma unroll
    for (int hsel = 0; hsel < 2; ++hsel)
#pragma unroll
        for (int pt = 0; pt < 2; ++pt) {
            const unsigned col = (unsigned)((g * 4 + 2 * hpair + hsel) * 64 + 32 * pt + r); const float gn = gnorm[col];
            const unsigned voB = (tb * 1024u + 512u + col) * 2u;
#pragma unroll
            for (int i = 0; i < 16; ++i) { const unsigned w = ypk[hsel][pt][i >> 1];
                const float yf = (i & 1) ? __uint_as_float(w & 0xffff0000u) : __uint_as_float(w << 16);
                __builtin_amdgcn_raw_buffer_store_b16((short)f2bf(yf * ssq[i] * gn), rsB, (int)voB, ((i & 3) + 8 * (i >> 2)) * 2048, 0); }
        }
    __syncthreads();
}
typedef float f32x2 __attribute__((ext_vector_type(2)));
__device__ __forceinline__ void fp8x16_to_f32(const uint4 w, float (&f)[16]) {
    const int ww[4] = {(int)w.x, (int)w.y, (int)w.z, (int)w.w};
#pragma unroll
    for (int q = 0; q < 4; ++q) { const f32x2 a = __builtin_amdgcn_cvt_pk_f32_fp8(ww[q], false), b = __builtin_amdgcn_cvt_pk_f32_fp8(ww[q], true); f[4 * q] = a.x; f[4 * q + 1] = a.y; f[4 * q + 2] = b.x; f[4 * q + 3] = b.y; }
}
template <int M4, int M2, int M1> __device__ __forceinline__ void treduce16(const float (&a)[16], int lane, float& r0, float& r1) {
    float b[8], c[4];
    { const bool hi = (lane & M4) != 0;
#pragma unroll
      for (int i = 0; i < 8; ++i) { const float send = hi ? a[i] : a[i + 8]; const float recv = __shfl_xor(send, M4); b[i] = (hi ? a[i + 8] : a[i]) + recv; } }
    { const bool hi = (lane & M2) != 0;
#pragma unroll
      for (int i = 0; i < 4; ++i) { const float send = hi ? b[i] : b[i + 4]; const float recv = __shfl_xor(send, M2); c[i] = (hi ? b[i + 4] : b[i]) + recv; } }
    { const bool hi = (lane & M1) != 0;
      { const float send = hi ? c[0] : c[2]; const float recv = __shfl_xor(send, M1); r0 = (hi ? c[2] : c[0]) + recv; }
      { const float send = hi ? c[1] : c[3]; const float recv = __shfl_xor(send, M1); r1 = (hi ? c[3] : c[1]) + recv; } }
}
template <int M4, int M2, int M1> __device__ __forceinline__ void treduce16i(const int (&a)[16], int lane, int& r0, int& r1) {
    int b[8], c[4];
    { const bool hi = (lane & M4) != 0;
#pragma unroll
      for (int i = 0; i < 8; ++i) { const int send = hi ? a[i] : a[i + 8]; const int recv = __shfl_xor(send, M4); b[i] = (hi ? a[i + 8] : a[i]) + recv; } }
    { const bool hi = (lane & M2) != 0;
#pragma unroll
      for (int i = 0; i < 4; ++i) { const int send = hi ? b[i] : b[i + 4]; const int recv = __shfl_xor(send, M2); c[i] = (hi ? b[i + 4] : b[i]) + recv; } }
    { const bool hi = (lane & M1) != 0;
      { const int send = hi ? c[0] : c[2]; const int recv = __shfl_xor(send, M1); r0 = (hi ? c[2] : c[0]) + recv; }
      { const int send = hi ? c[1] : c[3]; const int recv = __shfl_xor(send, M1); r1 = (hi ? c[3] : c[1]) + recv; } }
}
__device__ __forceinline__ void treduce16i_hw(const int (&a)[16], int lane, int& r0, int& r1) {
    int b[8], c[4];
#pragma unroll
    for (int i = 0; i < 8; ++i) { const auto r = __builtin_amdgcn_permlane32_swap((unsigned)a[i], (unsigned)a[i + 8], false, false); b[i] = (int)r[0] + (int)r[1]; }
#pragma unroll
    for (int i = 0; i < 4; ++i) { const auto r = __builtin_amdgcn_permlane16_swap((unsigned)b[i], (unsigned)b[i + 4], false, false); c[i] = (int)r[0] + (int)r[1]; }
    const bool hi = (lane & 8) != 0;
    { const int send = hi ? c[0] : c[2]; r0 = (hi ? c[2] : c[0]) + __builtin_amdgcn_update_dpp(0, send, 0x128, 0xf, 0xf, false); }
    { const int send = hi ? c[1] : c[3]; r1 = (hi ? c[3] : c[1]) + __builtin_amdgcn_update_dpp(0, send, 0x128, 0xf, 0xf, false); }
}
#define PE_ID(E, i) (((i) & 1) ? (E[(i) >> 1] >> 16) : (E[(i) >> 1] & 0xffffu))
__device__ __forceinline__ void peer_u_item(int p, int j, const LAS unsigned short* EL  , const unsigned char* __restrict__ XQ, const unsigned char* __restrict__ U8, LAS int* ACC  , int lane, int wave) {
    asm volatile("" : "+v"(lane));
    const int gidx = lane >> 3; const unsigned coff = (unsigned)(p * 128 + (lane & 7) * 16);
#pragma unroll 1
    for (int it = 0; it < 8; ++it) {
        const int t = j * 64 + it * 8 + wave;
        unsigned E[8];
        { const LAS v4u* ep = (const LAS v4u*)(EL + (it * 8 + wave) * 128 + 16 * gidx); const v4u e0 = ep[0], e1 = ep[1];
          E[0] = e0.x; E[1] = e0.y; E[2] = e0.z; E[3] = e0.w; E[4] = e1.x; E[5] = e1.y; E[6] = e1.z; E[7] = e1.w; }
        uint4 uu[16];
#pragma unroll
        for (int i = 0; i < 16; ++i) uu[i] = *(const uint4*)(U8 + (size_t)(PE_ID(E, i) * 1024u + coff));
        const uint4 xq = *(const uint4*)(XQ + (size_t)t * D + coff);
        int d[16];
#pragma unroll
        for (int i = 0; i < 16; ++i) {
            int s = __builtin_amdgcn_sdot4((int)uu[i].x, (int)xq.x, 0, false); s = __builtin_amdgcn_sdot4((int)uu[i].y, (int)xq.y, s, false);
            s = __builtin_amdgcn_sdot4((int)uu[i].z, (int)xq.z, s, false); s = __builtin_amdgcn_sdot4((int)uu[i].w, (int)xq.w, s, false);
            d[i] = s;
        }
        int r0, r1; treduce16i<4, 2, 1>(d, lane, r0, r1);
        { typedef int i2v __attribute__((ext_vector_type(2))); LAS i2v* ap = (LAS i2v*)(ACC + (it * 8 + wave) * 128 + 2 * lane);
          i2v a2; if (p == 0) { a2.x = r0; a2.y = r1; } else { a2 = *ap; a2.x += r0; a2.y += r1; } *ap = a2; }
    }
}
__device__ __forceinline__ void peer_v_item(int p, int j, const LAS unsigned short* EL, const LAS unsigned char* AL  , const LAS float* ASC  ,
                                            const unsigned char* __restrict__ V8, bf16* __restrict__ PEERO, int lane, int wave) {
    asm volatile("" : "+v"(lane));
    const __amdgpu_buffer_rsrc_t rsV = __builtin_amdgcn_make_buffer_rsrc((void*)V8, 0, 16384 * 1024, 0x00020000);
    const int gidx = lane >> 3; const unsigned coff = (unsigned)(p * 128 + (lane & 7) * 16);
#pragma unroll 1
    for (int it = 0; it < 8; ++it) {
        const int t = j * 64 + it * 8 + wave;
        unsigned E[8];
        { const LAS v4u* ep = (const LAS v4u*)(EL + (it * 8 + wave) * 128 + 16 * gidx); const v4u e0 = ep[0], e1 = ep[1];
          E[0] = e0.x; E[1] = e0.y; E[2] = e0.z; E[3] = e0.w; E[4] = e1.x; E[5] = e1.y; E[6] = e1.z; E[7] = e1.w; }
        uint4 vv[16];
#pragma unroll
        for (int i = 0; i < 16; ++i) { const v4u w_ = __builtin_amdgcn_raw_buffer_load_b128(rsV, (int)((PE_ID(E, i) << 10) + coff), 0, 0); vv[i] = make_uint4(w_.x, w_.y, w_.z, w_.w); }
        const v4u aq = *(const LAS v4u*)(AL + (it * 8 + wave) * 128 + 16 * gidx);
        const float asc = ASC[it * 8 + wave];
        const unsigned a4[4] = {aq.x, aq.y, aq.z, aq.w};
        int acc[16];
#pragma unroll
        for (int c = 0; c < 16; ++c) acc[c] = 0;
#pragma unroll
        for (int m = 0; m < 4; ++m) {
            const unsigned r0[4] = {vv[4 * m].x, vv[4 * m].y, vv[4 * m].z, vv[4 * m].w}, r1[4] = {vv[4 * m + 1].x, vv[4 * m + 1].y, vv[4 * m + 1].z, vv[4 * m + 1].w};
            const unsigned r2[4] = {vv[4 * m + 2].x, vv[4 * m + 2].y, vv[4 * m + 2].z, vv[4 * m + 2].w}, r3[4] = {vv[4 * m + 3].x, vv[4 * m + 3].y, vv[4 * m + 3].z, vv[4 * m + 3].w};
#pragma unroll
            for (int dc = 0; dc < 4; ++dc) {
                const unsigned ta = __builtin_amdgcn_perm(r1[dc], r0[dc], 0x05010400u), tb = __builtin_amdgcn_perm(r3[dc], r2[dc], 0x05010400u);
                const unsigned ua = __builtin_amdgcn_perm(r1[dc], r0[dc], 0x07030602u), ub = __builtin_amdgcn_perm(r3[dc], r2[dc], 0x07030602u);
                const unsigned c0 = __builtin_amdgcn_perm(tb, ta, 0x05040100u), c1 = __builtin_amdgcn_perm(tb, ta, 0x07060302u);
                const unsigned c2 = __builtin_amdgcn_perm(ub, ua, 0x05040100u), c3 = __builtin_amdgcn_perm(ub, ua, 0x07060302u);
                acc[4 * dc + 0] = __builtin_amdgcn_sdot4((int)c0, (int)a4[m], acc[4 * dc + 0], false);
                acc[4 * dc + 1] = __builtin_amdgcn_sdot4((int)c1, (int)a4[m], acc[4 * dc + 1], false);
                acc[4 * dc + 2] = __builtin_amdgcn_sdot4((int)c2, (int)a4[m], acc[4 * dc + 2], false);
                acc[4 * dc + 3] = __builtin_amdgcn_sdot4((int)c3, (int)a4[m], acc[4 * dc + 3], false);
            }
        }
        int r0i, r1i; treduce16i_hw(acc, lane, r0i, r1i);
        *(unsigned*)(PEERO + (size_t)t * D + coff + 2 * gidx) = pkbf(asc * (float)r0i, asc * (float)r1i);
    }
}

__device__ __forceinline__ void ce_desc(float& a, float& b) { const float hi = fmaxf(a, b), lo = fminf(a, b); a = hi; b = lo; }
__device__ __forceinline__ void sort16_desc(float (&v)[16]) {
#pragma unroll
    for (int k = 2; k <= 16; k <<= 1)
#pragma unroll
        for (int j = k >> 1; j > 0; j >>= 1)
#pragma unroll
            for (int i = 0; i < 16; ++i) { const int l = i ^ j; if (l > i) { if ((i & k) == 0) ce_desc(v[i], v[l]); else ce_desc(v[l], v[i]); } }
}
__device__ __forceinline__ void merge16_desc(float (&a)[16], const float (&b)[16]) {
#pragma unroll
    for (int i = 0; i < 16; ++i) a[i] = fmaxf(a[i], b[15 - i]);
#pragma unroll
    for (int j = 8; j > 0; j >>= 1)
#pragma unroll
        for (int i = 0; i < 16; ++i) { const int l = i ^ j; if (l > i) ce_desc(a[i], a[l]); }
}
__device__ __forceinline__ void ce_kv(float& ka, int& va, float& kb, int& vb) {
    const bool s = kb > ka; const float t0 = s ? kb : ka, t1 = s ? ka : kb; const int u0 = s ? vb : va, u1 = s ? va : vb; ka = t0; kb = t1; va = u0; vb = u1; }
__device__ __forceinline__ void sort16_kv(float (&k)[16], int (&v)[16]) {
#pragma unroll
    for (int kk = 2; kk <= 16; kk <<= 1)
#pragma unroll
        for (int j = kk >> 1; j > 0; j >>= 1)
#pragma unroll
            for (int i = 0; i < 16; ++i) { const int l = i ^ j; if (l > i) { if ((i & kk) == 0) ce_kv(k[i], v[i], k[l], v[l]); else ce_kv(k[l], v[l], k[i], v[i]); } }
}
__device__ __forceinline__ void merge16_kv(float (&ka)[16], int (&va)[16], const float (&kb)[16], const int (&vb)[16]) {
#pragma unroll
    for (int i = 0; i < 16; ++i) { const bool s = kb[15 - i] > ka[i]; ka[i] = s ? kb[15 - i] : ka[i]; va[i] = s ? vb[15 - i] : va[i]; }
#pragma unroll
    for (int j = 8; j > 0; j >>= 1)
#pragma unroll
        for (int i = 0; i < 16; ++i) { const int l = i ^ j; if (l > i) ce_kv(ka[i], va[i], ka[l], va[l]); }
}
__device__ __forceinline__ void split8(const float* p, bf16x8& hi8, bf16x8& lo8) {
    const float4 f0 = *(const float4*)p, f1 = *(const float4*)(p + 4);
    const float x[8] = {f0.x, f0.y, f0.z, f0.w, f1.x, f1.y, f1.z, f1.w};
#pragma unroll
    for (int j = 0; j < 8; ++j) { const short h = bfs(x[j]); hi8[j] = h; lo8[j] = bfs(x[j] - sbf2f(h)); }
}
__device__ __forceinline__ void route_task(int task, int tl0, const float* QP, const LAS bf16* KHL, LAS unsigned short* EL, LAS float* GL, int lane) {
    const int r = lane & 31, hi = lane >> 5, t = 4 * task + (r >> 3), head = r & 7;
    float top[2][16];
#pragma unroll
    for (int half = 0; half < 2; ++half) {
        bf16x8 qh[4], ql[4];
        { const float* qp = QP + (size_t)t * D + head * 128 + half * 64 + 8 * hi; asm volatile("" : "+v"(qp));
#pragma unroll
          for (int ks = 0; ks < 4; ++ks) split8(qp + 16 * ks, qh[ks], ql[ks]); }
        float cur[16];
#pragma unroll
        for (int kt = 0; kt < 4; ++kt) {
            f32x16 X = zero16();
            const LAS bf16* khp = KHL + (half * 128 + 32 * kt + r) * 72 + 8 * hi;
#pragma unroll
            for (int ks = 0; ks < 4; ++ks) {
                const bf16x8 kh = lds8(khp + 16 * ks), kl = lds8(khp + 2 * 128 * 72 + 16 * ks);
                X = MFMA32(kh, qh[ks], X); X = MFMA32(kh, ql[ks], X); X = MFMA32(kl, qh[ks], X);
            }
            float grp[16];
#pragma unroll
            for (int i = 0; i < 16; ++i) { const unsigned key = (unsigned)(32 * kt + crow(i, hi)); grp[i] = __uint_as_float((__float_as_uint(X[i]) & ~127u) | (127u - key)); }
            sort16_desc(grp);
            if (kt == 0) {
#pragma unroll
                for (int i = 0; i < 16; ++i) cur[i] = grp[i];
            } else merge16_desc(cur, grp);
        }
        float oth[16];
#pragma unroll
        for (int i = 0; i < 16; ++i) oth[i] = __shfl_xor(cur[i], 32);
        merge16_desc(cur, oth);
#pragma unroll
        for (int i = 0; i < 16; ++i) top[half][i] = cur[i];
    }
    unsigned P1[4], P2[4];
#pragma unroll
    for (int q = 0; q < 4; ++q) { P1[q] = 0u; P2[q] = 0u;
#pragma unroll
        for (int s = 0; s < 4; ++s) { P1[q] |= (127u - (__float_as_uint(top[0][4 * q + s]) & 127u)) << (8 * s); P2[q] |= (127u - (__float_as_uint(top[1][4 * q + s]) & 127u)) << (8 * s); } }
#define CAND(a, b) __uint_as_float((__float_as_uint(top[0][a] + top[1][b]) & ~255u) | (255u - (unsigned)((a) * 16 + (b))))
    float bk[16];
    {
        float gk[16];
        gk[0] = CAND(0, 0);
        gk[1] = CAND(0, 1);
        gk[2] = CAND(0, 2);
        gk[3] = CAND(0, 3);
        gk[4] = CAND(0, 4);
        gk[5] = CAND(0, 5);
        gk[6] = CAND(0, 6);
        gk[7] = CAND(0, 7);
        gk[8] = CAND(0, 8);
        gk[9] = CAND(0, 9);
        gk[10] = CAND(0, 10);
        gk[11] = CAND(0, 11);
        gk[12] = CAND(0, 12);
        gk[13] = CAND(0, 13);
        gk[14] = CAND(0, 14);
        gk[15] = CAND(0, 15);
        sort16_desc(gk);
#pragma unroll
        for (int i = 0; i < 16; ++i) bk[i] = gk[i];
    }
    {
        float gk[16];
        gk[0] = CAND(1, 0);
        gk[1] = CAND(1, 1);
        gk[2] = CAND(1, 2);
        gk[3] = CAND(1, 3);
        gk[4] = CAND(1, 4);
        gk[5] = CAND(1, 5);
        gk[6] = CAND(1, 6);
        gk[7] = CAND(1, 7);
        gk[8] = CAND(2, 0);
        gk[9] = CAND(2, 1);
        gk[10] = CAND(2, 2);
        gk[11] = CAND(2, 3);
        gk[12] = CAND(2, 4);
        gk[13] = CAND(3, 0);
        gk[14] = CAND(3, 1);
        gk[15] = CAND(3, 2);
        sort16_desc(gk);
        merge16_desc(bk, gk);
    }
    {
        float gk[16];
        gk[0] = CAND(3, 3);
        gk[1] = CAND(4, 0);
        gk[2] = CAND(4, 1);
        gk[3] = CAND(4, 2);
        gk[4] = CAND(5, 0);
        gk[5] = CAND(5, 1);
        gk[6] = CAND(6, 0);
        gk[7] = CAND(6, 1);
        gk[8] = CAND(7, 0);
        gk[9] = CAND(7, 1);
        gk[10] = CAND(8, 0);
        gk[11] = CAND(9, 0);
        gk[12] = CAND(10, 0);
        gk[13] = CAND(11, 0);
        gk[14] = CAND(12, 0);
        gk[15] = CAND(13, 0);
        sort16_desc(gk);
        merge16_desc(bk, gk);
    }
    {
        float gk[16];
        gk[0] = CAND(14, 0);
        gk[1] = CAND(15, 0);
        gk[2] = -INFINITY;
        gk[3] = -INFINITY;
        gk[4] = -INFINITY;
        gk[5] = -INFINITY;
        gk[6] = -INFINITY;
        gk[7] = -INFINITY;
        gk[8] = -INFINITY;
        gk[9] = -INFINITY;
        gk[10] = -INFINITY;
        gk[11] = -INFINITY;
        gk[12] = -INFINITY;
        gk[13] = -INFINITY;
        gk[14] = -INFINITY;
        gk[15] = -INFINITY;
        sort16_desc(gk);
        merge16_desc(bk, gk);
    }
#undef CAND
    int bv[16];
#pragma unroll
    for (int i = 0; i < 16; ++i) {
        const unsigned cd = 255u - (__float_as_uint(bk[i]) & 255u), ca = cd >> 4, cb = cd & 15u;
        const unsigned wa = (ca >> 2) == 0u ? P1[0] : (ca >> 2) == 1u ? P1[1] : (ca >> 2) == 2u ? P1[2] : P1[3];
        const unsigned wb = (cb >> 2) == 0u ? P2[0] : (cb >> 2) == 1u ? P2[1] : (cb >> 2) == 2u ? P2[2] : P2[3];
        bv[i] = (int)((((wa >> (8u * (ca & 3u))) & 255u) << 7) | ((wb >> (8u * (cb & 3u))) & 255u));
    }
    float e[16], se = 0.f;
#pragma unroll
    for (int i = 0; i < 16; ++i) { e[i] = __expf(bk[i] - bk[0]); se += e[i]; }
    const float inv = 1.f / se;
    if (hi == 0) {
        LAS v4u* ip = (LAS v4u*)(EL + (tl0 + (r >> 3)) * 128 + head * 16); typedef float f4v __attribute__((ext_vector_type(4))); LAS f4v* gp = (LAS f4v*)(GL + (tl0 + (r >> 3)) * 128 + head * 16);
#pragma unroll
        for (int q = 0; q < 2; ++q) ip[q] = (v4u){(unsigned)bv[8 * q] | ((unsigned)bv[8 * q + 1] << 16), (unsigned)bv[8 * q + 2] | ((unsigned)bv[8 * q + 3] << 16), (unsigned)bv[8 * q + 4] | ((unsigned)bv[8 * q + 5] << 16), (unsigned)bv[8 * q + 6] | ((unsigned)bv[8 * q + 7] << 16)};
#pragma unroll
        for (int q = 0; q < 4; ++q) gp[q] = (f4v){e[4 * q] * inv, e[4 * q + 1] * inv, e[4 * q + 2] * inv, e[4 * q + 3] * inv};
    }
}

#define XB_TMO      128
#define XB_XCNT(j)  (256  + 64 * (j))
#define XB_XSUB(j)  (1280 + 64 * (j))
#define XB_XGEN(j)  (2304 + 64 * (j))
#define XB_TOP      3328
#define XB_TOPGEN   3392
#define XCD_BAR_WORDS 3456
#define XB_SPIN_CAP (1u << 22)
__device__ __forceinline__ unsigned xb_ld(unsigned* p)              { return __hip_atomic_load(p, __ATOMIC_RELAXED, __HIP_MEMORY_SCOPE_AGENT); }
__device__ __forceinline__ unsigned xb_add(unsigned* p, unsigned v) { return __hip_atomic_fetch_add(p, v, __ATOMIC_RELAXED, __HIP_MEMORY_SCOPE_AGENT); }
__device__ __forceinline__ unsigned xb_xcc_id() { return (unsigned)__builtin_amdgcn_s_getreg((3 << 11) | 20) & 0xFu; }
#define XB_SPIN(cond, bar) do { unsigned _sp = 0; while (cond) { __builtin_amdgcn_s_sleep(1); \
    if ((++_sp & 255u) == 0u) { if (xb_ld(&(bar)[XB_TMO])) break; if (_sp > XB_SPIN_CAP) { atomicAdd(&(bar)[XB_TMO], 1u); break; } } } } while (0)
struct XcdBarrier { unsigned* bar; unsigned x; volatile LAS unsigned* st; };
__device__ __forceinline__ XcdBarrier xcd_barrier_post(unsigned* bar, volatile LAS unsigned* st) {
    XcdBarrier b; b.bar = bar; b.x = xb_xcc_id(); b.st = st;
    if (threadIdx.x == 0) (void)xb_add(&bar[XB_XCNT(b.x)], 1u);
    return b;
}
__device__ __forceinline__ void xcd_barrier_complete(unsigned* bar, unsigned x, unsigned& nloc, unsigned& nx) {
    const unsigned G = gridDim.x * gridDim.y * gridDim.z;
    unsigned sum, cnt, mine, sp = 0u;
    for (;;) {
        sum = 0u; cnt = 0u; mine = 0u;
#pragma unroll
        for (unsigned j = 0; j < 16; ++j) { const unsigned c = xb_ld(&bar[XB_XCNT(j)]); sum += c; cnt += (c > 0u) ? 1u : 0u; mine = (j == x) ? c : mine; }
        if (sum == G) break;
        __builtin_amdgcn_s_sleep(1);
        if ((++sp & 255u) == 0u) { if (xb_ld(&bar[XB_TMO])) break; if (sp > XB_SPIN_CAP) { atomicAdd(&bar[XB_TMO], 1u); break; } }
    }
    nloc = mine > 0u ? mine : 1u; nx = cnt > 0u ? cnt : 1u;
}
__device__ __forceinline__ void xcd_barrier(const XcdBarrier& b) {
    asm volatile("s_waitcnt vmcnt(0)" ::: "memory");
    __syncthreads();
    if (threadIdx.x == 0) {
        unsigned* bar = b.bar;
        __builtin_amdgcn_s_waitcnt(0);
        unsigned nloc = b.st[0], nx = b.st[1];
        if (nloc == 0u) { xcd_barrier_complete(bar, b.x, nloc, nx); b.st[0] = nloc; b.st[1] = nx; }
        const unsigned old = xb_add(&bar[XB_XSUB(b.x)], 1u);
        const unsigned gen = old / nloc;
        if (old + 1u == (gen + 1u) * nloc) {
            __builtin_amdgcn_fence(__ATOMIC_RELEASE, "agent");
            asm volatile("s_waitcnt vmcnt(0)" ::: "memory");
            const unsigned og = xb_add(&bar[XB_TOP], 1u);
            const unsigned tg = og / nx;
            if (og + 1u == (tg + 1u) * nx) xb_add(&bar[XB_TOPGEN], 1u);
            else XB_SPIN(xb_ld(&bar[XB_TOPGEN]) == tg, bar);
            __builtin_amdgcn_fence(__ATOMIC_ACQUIRE, "agent");
            xb_add(&bar[XB_XGEN(b.x)], 1u);
            asm volatile("s_waitcnt vmcnt(0)" ::: "memory");
        } else {
            XB_SPIN(xb_ld(&bar[XB_XGEN(b.x)]) == gen, bar);
            __builtin_amdgcn_fence(__ATOMIC_ACQUIRE, "agent");
            asm volatile("s_waitcnt vmcnt(0)" ::: "memory");
        }
    }
    __syncthreads();
}
constexpr int LDS_BYTES = 147456;
constexpr int MISC_OFF = 131072 + 320;

__global__ void __launch_bounds__(NTHR, 2) k_main(Args a) {
    extern __shared__ __attribute__((aligned(16))) unsigned char lds_raw[];
    LAS unsigned char* ldsb = (LAS unsigned char*)lds_raw;
    const int tid0 = threadIdx.x, bid = blockIdx.x, nb = gridDim.x;
    const int wave = __builtin_amdgcn_readfirstlane(tid0 >> 6);
    const int gthreads = nb * NTHR, nwaves = gthreads >> 6;
#define PHASE_VARS() int tid = tid0; asm volatile("" : "+v"(tid)); const int lane = tid & 63, gtid = bid * NTHR + tid, gwave = gtid >> 6; (void)lane; (void)gtid; (void)gwave
    unsigned char* ws = a.ws;
    bf16* WINT = (bf16*)(ws + WS_WIN); bf16* WOT = (bf16*)(ws + WS_WO); bf16* WQT = (bf16*)(ws + WS_WQ);
    bf16* PROJ = (bf16*)(ws + WS_PROJ);
    bf16* XNB = (bf16*)(ws + WS_XNB);
    bf16* XACT = (bf16*)(ws + WS_XACT);
    float* DTRAW = (float*)(ws + WS_DTRAW); float* DT = (float*)(ws + WS_DT); float* ACS = (float*)(ws + WS_ACS); float* CDEC = (float*)(ws + WS_CDEC);
    float* STATES = (float*)(ws + WS_STATES); bf16* PREVT = (bf16*)(ws + WS_PREV);
    float* QP = (float*)(ws + WS_QP); unsigned short* IDX = (unsigned short*)(ws + WS_IDX); float* GATE = (float*)(ws + WS_GATE);
    float* TOPV = (float*)(ws + WS_TOPV); int* TOPI = (int*)(ws + WS_TOPI);
    unsigned char* U8 = ws + WS_U8; unsigned char* V8 = ws + WS_V8; float* SU = (float*)(ws + WS_SU); float* SV = SU + 16384; bf16* PART = (bf16*)(ws + WS_PART); unsigned char* XQ = ws + WS_XQ; float* XS = (float*)(ws + WS_XS);
    bf16* KH = (bf16*)(ws + WS_KH); bf16* KL = (bf16*)(ws + WS_KH + 65536);
    bf16* HB = (bf16*)(ws + WS_STATES);
    float* MIXF = a.out;
    volatile LAS unsigned* MISC = (volatile LAS unsigned*)(ldsb + MISC_OFF);
    if (tid0 < 32) MISC[tid0] = 0u;
    __syncthreads();
    XcdBarrier bar = xcd_barrier_post((unsigned*)ws, MISC + 8);
#define IN(k) (a.ph_lo <= (k) && (k) < a.ph_hi)
#if defined(PROBE_LO)
    int seg_ = 0; unsigned long long tseg_ = __builtin_amdgcn_s_memrealtime();
#define PROBE_SPIN() do { if (seg_ >= PROBE_LO && seg_ <= PROBE_HI) { const unsigned long long d_ = (__builtin_amdgcn_s_memrealtime() - tseg_) * PROBE_AMP; const unsigned long long s_ = __builtin_amdgcn_s_memrealtime(); \
        while (__builtin_amdgcn_s_memrealtime() - s_ < d_) __builtin_amdgcn_s_sleep(4); } } while (0)
#define GRID_BAR() do { PROBE_SPIN(); xcd_barrier(bar); tseg_ = __builtin_amdgcn_s_memrealtime(); ++seg_; } while (0)
#else
#define PROBE_SPIN() do { } while (0)
#define GRID_BAR() xcd_barrier(bar)
#endif

    if (IN(0)) {
        PHASE_VARS();
        LAS float* scr = (LAS float*)(ldsb + wave * 16384);
        constexpr int I_IN = 16 * 72, I_O = 16 * 32, NITEMS = I_IN + 2 * I_O;
        for (int it = gwave; it < NITEMS; it += nwaves) {
            int r = it;
            if (r < I_IN) { transpose_item(a.w_in, PW, D, WINT, scr, r / 72, r % 72, lane); continue; } r -= I_IN;
            if (r < I_O) { transpose_item(a.w_out, D, D, WOT, scr, r / 32, r % 32, lane); continue; } r -= I_O;
            transpose_item(a.peer_wq, D, D, WQT, scr, r / 32, r % 32, lane);
        }
        for (int i = gtid; i < 2 * 128 * 64; i += gthreads) { const float kf = a.peer_sub_keys[i]; const short h = bfs(kf); KH[i] = (bf16)h; KL[i] = (bf16)bfs(kf - sbf2f(h)); }
        for (int i = tid; i < 8 * 1024; i += NTHR) { const int h = i & 7, c = i >> 3; *(LAS float*)(ldsb + h * 16384 + 8448 + c * 4) = a.w_in[(size_t)c * PW + ODT + h]; }
        __syncthreads();
        rmsnorm_rows_bf16<1>(a.x, a.norm_mix_g, XNB, ldsb, DTRAW, nullptr, nullptr, gwave, nwaves, lane);
    }
    GRID_BAR();
    if (IN(1)) {
        PHASE_VARS();
        pg8::Gemm g{XNB, WINT, T, PS, D}; pg8::StaticOrder S; S.init(T, PS, nb, bid);
        pg8::EpiBf16Plain E{PROJ, PS};
        pg8::gemm_phase<pg8::EpiBf16Plain, pg8::StaticOrder>(ldsb, g, S, E, nullptr);
        const int cfirst = (nb == 256) ? 64 : 0;
        if (bid >= cfirst) for (int rr0 = ((bid - cfirst) * 8 + wave) * 4; rr0 < 2 * 16384; rr0 += (nb - cfirst) * 8 * 4) {
            float4 v[4][4];
#pragma unroll
            for (int q = 0; q < 4; ++q) { const int rr = rr0 + q, which = rr >> 14, row = rr & 16383;
                typedef float f4v __attribute__((ext_vector_type(4))); const f4v* src4 = (const f4v*)((which ? a.peer_v : a.peer_u) + (size_t)row * D) + lane;
#pragma unroll
                for (int jq = 0; jq < 4; ++jq) { const f4v t4 = __builtin_nontemporal_load(src4 + 64 * jq); v[q][jq] = make_float4(t4.x, t4.y, t4.z, t4.w); } }
#pragma unroll
            for (int q = 0; q < 4; ++q) { const int rr = rr0 + q, which = rr >> 14, row = rr & 16383;
                float mx = 0.f;
#pragma unroll
                for (int jq = 0; jq < 4; ++jq) mx = fmaxf(mx, fmaxf(fmaxf(fabsf(v[q][jq].x), fabsf(v[q][jq].y)), fmaxf(fabsf(v[q][jq].z), fabsf(v[q][jq].w))));
#pragma unroll
                for (int o = 1; o < 64; o <<= 1) mx = fmaxf(mx, __shfl_xor(mx, o));
                const float sc = mx > 0.f ? mx * (1.f / 127.f) : 1.f, inv = 1.f / sc;
                unsigned* dst = (unsigned*)((which ? V8 : U8) + (size_t)row * D) + lane;
#pragma unroll
                for (int jq = 0; jq < 4; ++jq) { const int q0 = (int)rintf(v[q][jq].x * inv), q1 = (int)rintf(v[q][jq].y * inv), q2 = (int)rintf(v[q][jq].z * inv), q3 = (int)rintf(v[q][jq].w * inv);
                    dst[64 * jq] = (unsigned)(q0 & 255) | ((unsigned)(q1 & 255) << 8) | ((unsigned)(q2 & 255) << 16) | ((unsigned)(q3 & 255) << 24); }
                if (lane == 0) (which ? SV : SU)[row] = sc; }
        }
    }
    GRID_BAR();
    if (IN(3)) {
        PHASE_VARS();
        for (int u = bid; u < 512; u += nb) {
            if (u < 256) attn_unit(a.attn_sinks, a.attn_out_g, ldsb, u, PROJ, XNB, tid, lane, wave);
            else ssd_chunk_unit(ldsb, u - 256, PROJ, XACT, DTRAW, a.conv_w, a.conv_b, a.dt_bias, a.a_log, ACS, CDEC, MIXF, STATES, tid, lane, wave);
        }
    }
    GRID_BAR();
    if (IN(5)) {
        PHASE_VARS();
        for (int idx = gtid; idx < 2 * 8 * 8192; idx += gthreads) {
            const int pn = idx & 8191, h = (idx >> 13) & 7, b = idx >> 16;
            float run = 0.f;
#pragma unroll 1
            for (int c0 = 0; c0 < 64; c0 += 8) {
                float st[8], dc[8];
#pragma unroll
                for (int j = 0; j < 8; ++j) { const int bch = (b * 64 + c0 + j) * 8 + h; st[j] = STATES[(size_t)bch * 8192 + pn]; dc[j] = CDEC[bch]; }
#pragma unroll
                for (int j = 0; j < 8; ++j) { const int bch = (b * 64 + c0 + j) * 8 + h; PREVT[(size_t)bch * 8192 + pn] = f2bf(run); run = dc[j] * run + st[j]; }
            }
        }
    }
    GRID_BAR();
    if (IN(6)) {
        PHASE_VARS();
        for (int u = bid; u < 256; u += nb) yoff_unit(a.d_skip, a.ssm_norm_g, ldsb, u, XACT, PROJ, ACS, PREVT, MIXF, XNB, lane, wave);
    }
    GRID_BAR();
    if (IN(7)) {
        PHASE_VARS();
        pg8::Gemm g{XNB, WOT, T, D, D}; pg8::StaticOrder S; S.init(T, D, nb, bid);
        pg8::EpiBf16Resid E{HB, a.x, D};
        pg8::gemm_phase<pg8::EpiBf16Resid, pg8::StaticOrder>(ldsb, g, S, E, nullptr);
    }
    GRID_BAR();
    if (IN(8)) {
        PHASE_VARS();
        rmsnorm_rows_bf16<2>((const float*)HB, a.norm_ffn_g, XNB, ldsb, nullptr, XQ, XS, gwave, nwaves, lane);
    }
    GRID_BAR();
    if (IN(9)) {
        PHASE_VARS();
        pg8::Gemm g{XNB, WQT, T, D, D}; pg8::StaticOrder S; S.init(T, D, nb, bid);
        pg8::EpiF32Resid E{QP, nullptr, D};
        pg8::gemm_phase<pg8::EpiF32Resid, pg8::StaticOrder>(ldsb, g, S, E, nullptr);
    }
    GRID_BAR();
    bf16* PEERO = (bf16*)(ws + WS_PEERO);
    if (IN(12)) {
        PHASE_VARS();
        LAS bf16* KHL = (LAS bf16*)ldsb; LAS int* ACC = (LAS int*)ldsb; LAS unsigned char* AL = (LAS unsigned char*)(ldsb + 32768); LAS float* ASC = (LAS float*)(ldsb + 40960);
        LAS unsigned short* EL = (LAS unsigned short*)(ldsb + 73728); LAS float* GL = (LAS float*)(ldsb + 90112);
#pragma unroll 1
        for (int j = bid; j < NCHUNK; j += nb) {
            __syncthreads();
            for (int i = tid; i < 2 * 2 * 128 * 8; i += NTHR) {
                const int pc = i & 7, key = (i >> 3) & 127, hf = (i >> 10) & 1, hl = i >> 11;
                *(LAS v4u*)(KHL + ((hl * 2 + hf) * 128 + key) * 72 + pc * 8) = *(const v4u*)((hl ? KL : KH) + (size_t)(hf * 128 + key) * 64 + pc * 8);
            }
            __syncthreads();
            route_task(16 * j + wave, 4 * wave, QP, KHL, EL, GL, lane);
            route_task(16 * j + 8 + wave, 32 + 4 * wave, QP, KHL, EL, GL, lane);
            __syncthreads();
#pragma unroll 1
            for (int p = 0; p < NPART; ++p) peer_u_item(p, j, EL, XQ, U8, ACC, lane, wave);
#pragma unroll 1
            for (int it = 0; it < 8; ++it) {
                const int tl = it * 8 + wave, t = j * 64 + tl;
                const unsigned ew = *(const LAS unsigned*)(EL + tl * 128 + 2 * lane); const int e0 = (int)(ew & 0xffffu), e1 = (int)(ew >> 16);
                typedef int i2v __attribute__((ext_vector_type(2))); const i2v si = *(const LAS i2v*)(ACC + tl * 128 + 2 * lane);
                typedef float f2v __attribute__((ext_vector_type(2))); const f2v gt = *(const LAS f2v*)(GL + tl * 128 + 2 * lane); const float xs = XS[t];
                const float z0 = (float)si.x * SU[e0] * xs, z1 = (float)si.y * SU[e1] * xs;
                const float a0 = gt.x * 0.5f * z0 * (1.f + erff(z0 * 0.70710678118654752f)) * SV[e0], a1 = gt.y * 0.5f * z1 * (1.f + erff(z1 * 0.70710678118654752f)) * SV[e1];
                float mx = fmaxf(fabsf(a0), fabsf(a1));
#pragma unroll
                for (int o = 1; o < 64; o <<= 1) mx = fmaxf(mx, __shfl_xor(mx, o));
                const float sc = mx > 0.f ? mx * (1.f / 127.f) : 1.f, inv = 1.f / sc;
                *(LAS unsigned short*)(AL + tl * 128 + 2 * lane) = (unsigned short)(((int)rintf(a0 * inv) & 255) | (((int)rintf(a1 * inv) & 255) << 8));
                if (lane == 0) ASC[tl] = sc;
            }
#pragma unroll 1
            for (int p = 0; p < NPART; ++p) peer_v_item(p, j, EL, AL, ASC, V8, PEERO, lane, wave);
            asm volatile("s_waitcnt vmcnt(0)" ::: "memory");
#pragma unroll 1
            for (int it = 0; it < 8; ++it) {
                const int t = j * 64 + it * 8 + wave;
                const uint2* hr = (const uint2*)(HB + (size_t)t * D) + lane; unsigned long long* pr = (unsigned long long*)(PEERO + (size_t)t * D) + lane;
                float4 v[4]; float ss = 0.f;
#pragma unroll
                for (int jq = 0; jq < 4; ++jq) { const uint2 hw = hr[64 * jq]; const unsigned long long pw = __hip_atomic_load(pr + 64 * jq, __ATOMIC_RELAXED, __HIP_MEMORY_SCOPE_AGENT);
                    const unsigned pl = (unsigned)pw, ph = (unsigned)(pw >> 32);
                    v[jq] = make_float4(__uint_as_float(hw.x << 16) + __uint_as_float(pl << 16), __uint_as_float(hw.x & 0xffff0000u) + __uint_as_float(pl & 0xffff0000u),
                                        __uint_as_float(hw.y << 16) + __uint_as_float(ph << 16), __uint_as_float(hw.y & 0xffff0000u) + __uint_as_float(ph & 0xffff0000u));
                    ss += v[jq].x * v[jq].x + v[jq].y * v[jq].y + v[jq].z * v[jq].z + v[jq].w * v[jq].w; }
                ss = wave_sum(ss);
                const float r3 = rsqrtf(ss * (1.f / D) + EPS);
                float4* op = (float4*)(a.out + (size_t)t * D) + lane;
#pragma unroll
                for (int jq = 0; jq < 4; ++jq) { const float4 gv = ((const float4*)a.final_norm_g)[lane + 64 * jq]; op[64 * jq] = make_float4(v[jq].x * r3 * gv.x, v[jq].y * r3 * gv.y, v[jq].z * r3 * gv.z, v[jq].w * r3 * gv.w); }
            }
        }
    }
    PROBE_SPIN();
#undef IN
}
}

extern "C" void kernel_launch(void* const* d_in, const int* in_sizes, int n_in, void* d_out, int out_size, void* d_ws, size_t ws_size, hipStream_t stream) {
    if (n_in != 18 || out_size != T * D || ws_size < WS_END) { fprintf(stderr, "kernel_launch: unexpected shapes n_in=%d out=%d ws=%zu\n", n_in, out_size, ws_size); return; }
    Args a{};
    const float** ap = (const float**)&a;
    for (int i = 0; i < 18; ++i) ap[i] = (const float*)d_in[i];
    a.out = (float*)d_out; a.ws = (unsigned char*)d_ws;
    static int grid = 0;
    if (grid == 0) {
        int dev = 0, cus = 0, per_cu = 0;
        if (hipGetDevice(&dev) != hipSuccess || hipDeviceGetAttribute(&cus, hipDeviceAttributeMultiprocessorCount, dev) != hipSuccess) { fprintf(stderr, "kernel_launch: device query failed\n"); grid = -1; return; }
        if (hipFuncSetAttribute((const void*)k_main, hipFuncAttributeMaxDynamicSharedMemorySize, LDS_BYTES) != hipSuccess) { fprintf(stderr, "kernel_launch: hipFuncSetAttribute failed\n"); grid = -1; return; }
        if (hipOccupancyMaxActiveBlocksPerMultiprocessor(&per_cu, (const void*)k_main, NTHR, LDS_BYTES) != hipSuccess || per_cu < 1) { fprintf(stderr, "kernel_launch: occupancy query says %d blocks/CU\n", per_cu); (void)hipGetLastError(); grid = -1; return; }
        grid = cus;
    }
    if (grid < 0) return;
    if (hipMemsetAsync(d_ws, 0, 65536, stream) != hipSuccess) { fprintf(stderr, "kernel_launch: memset failed\n"); return; }
    a.ph_lo = 0; a.ph_hi = 13;
    hipLaunchKernelGGL(k_main, dim3(grid), dim3(NTHR), LDS_BYTES, stream, a);
}
```

```cpp
#include <hip/hip_runtime.h>
#include <cstdio>
#include <cstdint>

namespace pg8 {
#define PG8_LAS __attribute__((address_space(3)))
typedef unsigned short bf16_t;
typedef short bf16x8 __attribute__((ext_vector_type(8)));
typedef float f32x4 __attribute__((ext_vector_type(4)));
typedef unsigned u32x4 __attribute__((ext_vector_type(4)));
constexpr int BM = 256, BK = 64, HALF = 128, HTB = HALF * BK * 2  , STAGE_BYTES = 8 * HTB, NXCD = 8, WGM = 8;

__host__ __device__ __forceinline__ int lds_byte(int r, int c) { const int st = (r >> 4) * 2 + (c >> 5), rr = r & 15, cc = c & 31, ob = rr * 64 + cc * 2; return st * 1024 + (ob ^ (((ob >> 9) & 1) << 5)); }
__host__ __device__ __forceinline__ void stage_rc(int b, int& R, int& C) { const int st = b / 1024, sb = b % 1024, swz = sb ^ (((sb >> 9) & 1) << 5); R = (st >> 1) * 16 + swz / 64; C = (st & 1) * 32 + (swz % 64) / 2; }
__host__ __device__ __forceinline__ int perm32(int rho) { const int n = rho >> 4, i = rho & 15; return 8 * (i >> 2) + 4 * n + (i & 3); }

struct Unit { int pm, pn; };
struct Gemm { const bf16_t* A; const bf16_t* Bt; int M, N, K; };

struct StaticOrder {
    int nM, nN, nwg, G, c;
    __host__ __device__ void init(int M, int N, int G_, int c_) { nM = M / BM; nN = N / BM; nwg = nM * nN; G = G_; c = c_; }
    __host__ __device__ bool next(int i, Unit& u) const {
        const long L = (long)i * G + c; if (L >= nwg) return false;
        int wgid = (int)L; { const int q = nwg / NXCD, r = nwg % NXCD, xcd = wgid % NXCD, off = wgid / NXCD; wgid = (xcd < r ? xcd * (q + 1) : r * (q + 1) + (xcd - r) * q) + off; }
        const int nig = WGM * nN, gid = wgid / nig, fm = gid * WGM, gsz = (nM - fm) < WGM ? (nM - fm) : WGM;
        u.pm = fm + ((wgid % nig) % gsz); u.pn = (wgid % nig) / gsz; return true;
    }
    __device__ __forceinline__ void a_ready(const Unit&) const {}
    __device__ __forceinline__ void done(const Unit&) const {}
};
__device__ __forceinline__ unsigned cvt_pk_bf16(float lo, float hi) { unsigned r; asm volatile("v_cvt_pk_bf16_f32 %0, %1, %2" : "=v"(r) : "v"(lo), "v"(hi)); return r; }
typedef float f32x2 __attribute__((ext_vector_type(2)));
struct EpiBf16Plain {
    static constexpr bool PERM = true, AFTER_DRAIN = false;
    bf16_t* O; int ldc;
    __device__ __forceinline__ void operator()(const f32x4 (&acc)[2][2][4][2], const Unit& u, int wr, int wc, int fr, int fq) const {
        const int row0 = u.pm * BM + wr * 64 + fr, col0 = u.pn * BM + wc * 32 + 8 * fq;
        const __amdgpu_buffer_rsrc_t rs = __builtin_amdgcn_make_buffer_rsrc((void*)O, 0, 0x7fffffff, 0x00020000);
#pragma unroll
        for (int ai = 0; ai < 2; ++ai)
#pragma unroll
            for (int m = 0; m < 4; ++m) { const unsigned ro = ((unsigned)(row0 + ai * HALF + m * 16) * (unsigned)ldc + (unsigned)col0) * 2u;
#pragma unroll
                for (int bj = 0; bj < 2; ++bj) { const f32x4 v0 = acc[ai][bj][m][0], v1 = acc[ai][bj][m][1];
                    u32x4 w; w.x = cvt_pk_bf16(v0[0], v0[1]); w.y = cvt_pk_bf16(v0[2], v0[3]); w.z = cvt_pk_bf16(v1[0], v1[1]); w.w = cvt_pk_bf16(v1[2], v1[3]);
                    __builtin_amdgcn_raw_buffer_store_b128(w, rs, (int)(ro + bj * HALF * 2), 0, 16); } }
    }
};
struct EpiF32Resid {
    static constexpr bool PERM = false, AFTER_DRAIN = false;
    float* C; const float* R; int ldc;
    __device__ __forceinline__ void operator()(const f32x4 (&acc)[2][2][4][2], const Unit& u, int wr, int wc, int fr, int fq) const {
        const int row0 = u.pm * BM + wr * 64 + fr, col0 = u.pn * BM + wc * 32 + 4 * fq;
#pragma unroll
        for (int ai = 0; ai < 2; ++ai)
#pragma unroll
            for (int m = 0; m < 4; ++m) { const size_t off = (size_t)(row0 + ai * HALF + m * 16) * ldc + col0;
#pragma unroll
                for (int bj = 0; bj < 2; ++bj)
#pragma unroll
                    for (int n = 0; n < 2; ++n) { f32x4 v = acc[ai][bj][m][n]; if (R) v += *(const f32x4*)(R + off + bj * HALF + n * 16); *(f32x4*)(C + off + bj * HALF + n * 16) = v; }
                asm volatile("" ::: "memory"); }
    }
};

struct EpiBf16Resid {
    static constexpr bool PERM = true, AFTER_DRAIN = false;
    bf16_t* O; const float* R; int ldc;
    __device__ __forceinline__ void operator()(const f32x4 (&acc)[2][2][4][2], const Unit& u, int wr, int wc, int fr, int fq) const {
        const int row0 = u.pm * BM + wr * 64 + fr, col0 = u.pn * BM + wc * 32 + 8 * fq;
#pragma unroll
        for (int ai = 0; ai < 2; ++ai)
#pragma unroll
            for (int m = 0; m < 4; ++m) { const size_t off = (size_t)(row0 + ai * HALF + m * 16) * ldc + col0;
#pragma unroll
                for (int bj = 0; bj < 2; ++bj) { const f32x4 v0 = acc[ai][bj][m][0] + *(const f32x4*)(R + off + bj * HALF), v1 = acc[ai][bj][m][1] + *(const f32x4*)(R + off + bj * HALF + 4);
                    u32x4 w; w.x = cvt_pk_bf16(v0[0], v0[1]); w.y = cvt_pk_bf16(v0[2], v0[3]); w.z = cvt_pk_bf16(v1[0], v1[1]); w.w = cvt_pk_bf16(v1[2], v1[3]);
                    *(u32x4*)(O + off + bj * HALF) = w; }
                asm volatile("" ::: "memory"); }
    }
};
template <class Epi, class Sched, bool STAMP = false>
__device__ __forceinline__ void gemm_phase(PG8_LAS unsigned char* lds, const Gemm g, const Sched& S, const Epi& E, unsigned long long* stamps) {
    const int tid = threadIdx.x, wid = __builtin_amdgcn_readfirstlane(tid >> 6), lane = tid & 63, wr = wid >> 2, wc = wid & 3, fr = lane & 15, fq = lane >> 4;
    const int K = g.K, nt = K / BK;
    int ts_lo = 0, ts_hi = 0, nts = 0; const unsigned long long rt_entry = STAMP ? (unsigned long long)0ull : 0ull;
#define PG8_STAMP() do { if (STAMP && wid == 0 && nts < 64) { const unsigned long long _c = (unsigned long long)clock64(); \
        ts_lo = (lane == nts) ? (int)(unsigned)_c : ts_lo; ts_hi = (lane == nts) ? (int)(unsigned)(_c >> 32) : ts_hi; ++nts; } } while (0)
    PG8_STAMP();
    unsigned voffA[2], voffB[2];
#pragma unroll
    for (int i = 0; i < 2; ++i) { int R, C; stage_rc(tid * 16 + i * 8192, R, C); const int Rb = Epi::PERM ? ((R & ~31) + perm32(R & 31)) : R;
        voffA[i] = (unsigned)(R * K + C) * 2u; voffB[i] = (unsigned)(Rb * K + C) * 2u; }
    const size_t kstep = (size_t)(BK * 2);
    const size_t hstep = (size_t)HALF * K * 2;
    const size_t tstep = 2 * hstep;
    const unsigned ldsw = (unsigned)wid * 1024u;
    const int aoff = lds_byte(wr * 64 + fr, fq * 8), boff = lds_byte(wc * 32 + fr, fq * 8);
#define PG8_SA(b, h) (((b) * 2 + (h)) * HTB)
#define PG8_SB(b, h) ((4 + (b) * 2 + (h)) * HTB)
#define PG8_STAGE(bufoff, gbase, voff) do { _Pragma("unroll") for (int _i = 0; _i < 2; ++_i) \
        __builtin_amdgcn_global_load_lds((const unsigned*)((const char*)(gbase) + (voff)[_i]), (PG8_LAS unsigned*)(lds + (bufoff) + ldsw + _i * 8192), 16, 0, 0); } while (0)
#define PG8_LDA(dst, b, h) do { _Pragma("unroll") for (int m = 0; m < 4; ++m) _Pragma("unroll") for (int k = 0; k < 2; ++k) dst[m][k] = *(const PG8_LAS bf16x8*)(lds + PG8_SA(b, h) + aoff + m * 2048 + k * 1024); } while (0)
#define PG8_LDB(dst, b, h) do { _Pragma("unroll") for (int n = 0; n < 2; ++n) _Pragma("unroll") for (int k = 0; k < 2; ++k) dst[n][k] = *(const PG8_LAS bf16x8*)(lds + PG8_SB(b, h) + boff + n * 2048 + k * 1024); } while (0)
#define PG8_MMA(ai, bj, At, Bt) do { __builtin_amdgcn_s_setprio(1); _Pragma("unroll") for (int m = 0; m < 4; ++m) _Pragma("unroll") for (int n = 0; n < 2; ++n) _Pragma("unroll") for (int k = 0; k < 2; ++k) \
        acc[ai][bj][m][n] = __builtin_amdgcn_mfma_f32_16x16x32_bf16(Bt[n][k], At[m][k], acc[ai][bj][m][n], 0, 0, 0); __builtin_amdgcn_s_setprio(0); } while (0)
#define PG8_WAIT_V(n) asm volatile("s_waitcnt vmcnt(" #n ")" ::: "memory")
#define PG8_WAIT_L(n) asm volatile("s_waitcnt lgkmcnt(" #n ")" ::: "memory")
#define PG8_BAR __builtin_amdgcn_s_barrier()
#define PG8_SCHED __builtin_amdgcn_sched_barrier(0)
    Unit cur, nxt; int ui = 0;
    if (!S.next(0, cur)) return;
    f32x4 acc[2][2][4][2];
#pragma unroll
    for (int a = 0; a < 2; ++a)
#pragma unroll
        for (int b = 0; b < 2; ++b)
#pragma unroll
            for (int m = 0; m < 4; ++m)
#pragma unroll
                for (int n = 0; n < 2; ++n) acc[a][b][m][n] = (f32x4){0.f, 0.f, 0.f, 0.f};
    bf16x8 At[4][2], B0[2][2], B1[2][2];
    const char* cA = (const char*)g.A + (size_t)cur.pm * tstep; const char* cB = (const char*)g.Bt + (size_t)cur.pn * tstep;
    S.a_ready(cur);
    PG8_STAGE(PG8_SB(0, 0), cB, voffB); PG8_STAGE(PG8_SA(0, 0), cA, voffA); PG8_STAGE(PG8_SB(0, 1), cB + hstep, voffB); PG8_STAGE(PG8_SA(0, 1), cA + hstep, voffA);
    if (wr == 1) PG8_BAR;
    PG8_WAIT_V(4); PG8_BAR;
    PG8_STAGE(PG8_SB(1, 0), cB + kstep, voffB); PG8_STAGE(PG8_SA(1, 0), cA + kstep, voffA); PG8_STAGE(PG8_SB(1, 1), cB + hstep + kstep, voffB);
    PG8_WAIT_V(6); PG8_BAR;
    PG8_STAMP();
    for (;;) {
        const bool has_next = S.next(ui + 1, nxt);
        const char* nA = has_next ? (const char*)g.A + (size_t)nxt.pm * tstep : cA; const char* nB = has_next ? (const char*)g.Bt + (size_t)nxt.pn * tstep : cB;
        for (int t = 0; t < nt; t += 2) {
            const bool last = (t == nt - 2);
            const char* a1 = cA + (size_t)(t + 1) * kstep;
            const char* a2 = last ? nA : cA + (size_t)(t + 2) * kstep; const char* b2 = last ? nB : cB + (size_t)(t + 2) * kstep;
            const char* a3 = a2 + kstep; const char* b3 = b2 + kstep;
            if (last && has_next) S.a_ready(nxt);
            PG8_LDB(B0, 0, 0); PG8_SCHED; PG8_LDA(At, 0, 0); PG8_STAGE(PG8_SA(1, 1), a1 + hstep, voffA);
            PG8_WAIT_L(8); PG8_BAR; PG8_WAIT_L(0); PG8_MMA(0, 0, At, B0); PG8_BAR; PG8_SCHED;
            PG8_LDB(B1, 0, 1); PG8_STAGE(PG8_SB(0, 0), b2, voffB);
            PG8_BAR; PG8_WAIT_L(0); PG8_MMA(0, 1, At, B1); PG8_BAR;
            PG8_LDA(At, 0, 1); PG8_STAGE(PG8_SA(0, 0), a2, voffA);
            PG8_BAR; PG8_WAIT_L(0); PG8_MMA(1, 0, At, B0); PG8_BAR; PG8_SCHED;
            PG8_STAGE(PG8_SB(0, 1), b2 + hstep, voffB);
            PG8_WAIT_V(6); PG8_BAR; PG8_MMA(1, 1, At, B1); PG8_BAR;
            PG8_LDB(B0, 1, 0); PG8_SCHED; PG8_LDA(At, 1, 0); PG8_STAGE(PG8_SA(0, 1), a2 + hstep, voffA);
            PG8_WAIT_L(8); PG8_BAR; PG8_WAIT_L(0); PG8_MMA(0, 0, At, B0); PG8_BAR; PG8_SCHED;
            PG8_LDB(B1, 1, 1); PG8_STAGE(PG8_SB(1, 0), b3, voffB);
            PG8_BAR; PG8_WAIT_L(0); PG8_MMA(0, 1, At, B1); PG8_BAR;
            PG8_LDA(At, 1, 1); PG8_STAGE(PG8_SA(1, 0), a3, voffA);
            PG8_BAR; PG8_WAIT_L(0); PG8_MMA(1, 0, At, B0); PG8_BAR; PG8_SCHED;
            PG8_STAGE(PG8_SB(1, 1), b3 + hstep, voffB);
            PG8_WAIT_V(6); PG8_BAR; PG8_MMA(1, 1, At, B1); PG8_BAR;
        }
        PG8_STAMP();
        if constexpr (!Epi::AFTER_DRAIN) { E(acc, cur, wr, wc, fr, fq); S.done(cur); }
        PG8_STAMP();
        if (!has_next) break;
#pragma unroll
        for (int a = 0; a < 2; ++a)
#pragma unroll
            for (int b = 0; b < 2; ++b)
#pragma unroll
                for (int m = 0; m < 4; ++m)
#pragma unroll
                    for (int n = 0; n < 2; ++n) acc[a][b][m][n] = (f32x4){0.f, 0.f, 0.f, 0.f};
        cur = nxt; cA = nA; cB = nB; ++ui;
    }
    PG8_WAIT_V(0);
    if (wr == 0) PG8_BAR;
    PG8_BAR;
    if constexpr (Epi::AFTER_DRAIN) { E.fused(acc, cur, wr, wc, fr, fq, lds, wid, lane); S.done(cur); }
    PG8_STAMP();
    if (STAMP && wid == 0) { stamps[lane] = lane < nts ? (((unsigned long long)(unsigned)ts_hi << 32) | (unsigned)ts_lo) : 0ull;
        if (lane == 62) stamps[62] = rt_entry; if (lane == 63) stamps[63] = (unsigned long long)0ull; }
#undef PG8_STAMP
#undef PG8_SA
#undef PG8_SB
#undef PG8_STAGE
#undef PG8_LDA
#undef PG8_LDB
#undef PG8_MMA
#undef PG8_WAIT_V
#undef PG8_WAIT_L
#undef PG8_BAR
#undef PG8_SCHED
}
}

namespace {
constexpr int D = 1024, BATCH = 2, SEQ = 8192, T = BATCH * SEQ;
constexpr int PW = 2312;
constexpr int PS = 2304;
constexpr int OQ = 0, OKK = 512, OV = 640, OZ = 768, OXBC = 1280, ODT = 2304;
constexpr float EPS = 1e-6f;
constexpr int NTHR = 512;
typedef unsigned short bf16;
typedef unsigned v4u __attribute__((ext_vector_type(4)));

constexpr size_t MiB = 1u << 20;
constexpr size_t WS_WIN = 1 * MiB;
constexpr size_t WS_KH = 5 * MiB + 512 * 1024;
constexpr size_t WS_WO = 6 * MiB;
constexpr size_t WS_WQ = 8 * MiB;
constexpr size_t WS_PROJ = 10 * MiB;
constexpr size_t WS_XNB = 82 * MiB;
constexpr size_t WS_XACT = 114 * MiB;
constexpr size_t WS_DTRAW = 146 * MiB;
constexpr size_t WS_DT = WS_DTRAW + 512 * 1024;
constexpr size_t WS_ACS = WS_DT + 512 * 1024;
constexpr size_t WS_CDEC = WS_ACS + 512 * 1024;
constexpr size_t WS_STATES = 164 * MiB;
constexpr size_t WS_PREV = 196 * MiB;
constexpr size_t WS_QP = 10 * MiB;
constexpr size_t WS_IDX = 74 * MiB;
constexpr size_t WS_GATE = 114 * MiB;
constexpr size_t WS_TOPV = 122 * MiB;
constexpr size_t WS_TOPI = 138 * MiB;
constexpr size_t WS_ACT = 122 * MiB;
constexpr size_t WS_SU = 245 * MiB;
constexpr size_t WS_U8 = 212 * MiB;
constexpr size_t WS_V8 = 148 * MiB;
constexpr size_t WS_PART = 10 * MiB;
constexpr size_t WS_XQ = 228 * MiB;
constexpr size_t WS_XS = 244 * MiB;
constexpr size_t WS_PEERO = 10 * MiB;
constexpr size_t WS_END = 246 * MiB;
constexpr int CW_QU = 4096, CW_QV = 4096 + 64 * 16;
constexpr int NPART = 8, NCHUNK = T / 64;

struct Args {
    const float* x; const float* norm_mix_g; const float* w_in; const float* attn_sinks; const float* attn_out_g;
    const float* conv_w; const float* conv_b; const float* dt_bias; const float* a_log; const float* d_skip;
    const float* ssm_norm_g; const float* w_out; const float* norm_ffn_g; const float* peer_wq; const float* peer_sub_keys;
    const float* peer_u; const float* peer_v; const float* final_norm_g;
    float* out; unsigned char* ws;
    int ph_lo, ph_hi;
};

#define LAS __attribute__((address_space(3)))
#define LDS_WAIT() asm volatile("s_waitcnt lgkmcnt(0)" ::: "memory")
__device__ __forceinline__ float bf2f(bf16 v) { return __uint_as_float(((unsigned)v) << 16); }
__device__ __forceinline__ unsigned f2bfu(float f) { unsigned u = __float_as_uint(f); return (u + 0x7fffu + ((u >> 16) & 1u)) >> 16; }
__device__ __forceinline__ bf16 f2bf(float f) { return (bf16)f2bfu(f); }
__device__ __forceinline__ unsigned pk2(float lo, float hi) { return f2bfu(lo) | (f2bfu(hi) << 16); }
__device__ __forceinline__ float wave_sum(float v) {
#pragma unroll
    for (int o = 1; o < 64; o <<= 1) v += __shfl_xor(v, o);
    return v;
}
__device__ __forceinline__ float silu_f(float v) { return v / (1.f + __expf(-v)); }

__device__ __forceinline__ void transpose_item(const float* W, int ldw, int K, bf16* WT, LAS float* scr, int kb, int nbk, int lane) {
    const int k0 = 64 * kb, n0 = 32 * nbk;
#pragma unroll 8
    for (int i = 0; i < 32; ++i) { const int kk = 2 * i + (lane >> 5); scr[kk * 33 + (lane & 31)] = W[(size_t)(k0 + kk) * ldw + n0 + (lane & 31)]; }
    LDS_WAIT();
    const int c = lane & 7;
#pragma unroll
    for (int j = 0; j < 4; ++j) { const int n = (lane >> 3) + 8 * j; const LAS float* s = scr + (8 * c) * 33 + n;
        v4u o; o.x = pk2(s[0 * 33], s[1 * 33]); o.y = pk2(s[2 * 33], s[3 * 33]); o.z = pk2(s[4 * 33], s[5 * 33]); o.w = pk2(s[6 * 33], s[7 * 33]);
        *(v4u*)(WT + (size_t)(n0 + n) * K + k0 + 8 * c) = o; }
    LDS_WAIT();
}

template <int MODE  >
__device__ __forceinline__ void rmsnorm_rows_bf16(const float* __restrict__ in, const float* __restrict__ g, bf16* __restrict__ outp, const LAS unsigned char* ldsb, float* __restrict__ dtraw, unsigned char* __restrict__ xq, float* __restrict__ xs, int gwave, int nwaves, int lane) {
#pragma unroll 2
    for (int row = gwave; row < T; row += nwaves) {
        const float4* xr = (const float4*)(in + (size_t)row * D) + lane; const uint2* xb = (const uint2*)((const bf16*)in + (size_t)row * D) + lane;
        float4 v[4]; float ss = 0.f;
#pragma unroll
        for (int j = 0; j < 4; ++j) {
            if (MODE == 2) { const uint2 w = xb[64 * j]; v[j] = make_float4(__uint_as_float(w.x << 16), __uint_as_float(w.x & 0xffff0000u), __uint_as_float(w.y << 16), __uint_as_float(w.y & 0xffff0000u)); }
            else if (MODE == 1) { typedef float f4v __attribute__((ext_vector_type(4))); const f4v t4 = __builtin_nontemporal_load((const f4v*)xr + 64 * j); v[j] = make_float4(t4.x, t4.y, t4.z, t4.w); }
            else v[j] = xr[64 * j];
            ss += v[j].x * v[j].x + v[j].y * v[j].y + v[j].z * v[j].z + v[j].w * v[j].w; }
        ss = wave_sum(ss);
        const float r = rsqrtf(ss * (1.f / D) + EPS);
        unsigned long long* o8 = (unsigned long long*)(outp + (size_t)row * D) + lane;
        float dacc[8]; float y[4][4]; float mx = 0.f;
#pragma unroll
        for (int h = 0; h < 8; ++h) dacc[h] = 0.f;
#pragma unroll
        for (int j = 0; j < 4; ++j) {
            const float4 gv = ((const float4*)g)[lane + 64 * j];
            y[j][0] = v[j].x * r * gv.x; y[j][1] = v[j].y * r * gv.y; y[j][2] = v[j].z * r * gv.z; y[j][3] = v[j].w * r * gv.w;
            o8[64 * j] = (unsigned long long)pk2(y[j][0], y[j][1]) | ((unsigned long long)pk2(y[j][2], y[j][3]) << 32);
            if (MODE == 2) mx = fmaxf(mx, fmaxf(fmaxf(fabsf(y[j][0]), fabsf(y[j][1])), fmaxf(fabsf(y[j][2]), fabsf(y[j][3]))));
            if (MODE == 1) {
#pragma unroll
                for (int h = 0; h < 8; ++h) {
                    typedef float f4v __attribute__((ext_vector_type(4)));
                    const f4v wv = *(const LAS f4v*)(ldsb + h * 16384 + 8448 + (256 * j + 4 * lane) * 4);
                    dacc[h] += y[j][0] * wv.x + y[j][1] * wv.y + y[j][2] * wv.z + y[j][3] * wv.w;
                }
            }
        }
        if (MODE == 1) {
#pragma unroll
            for (int h = 0; h < 8; ++h) dacc[h] = wave_sum(dacc[h]);
            if (lane == 0) { float4* dp = (float4*)(dtraw + (size_t)row * 8); dp[0] = make_float4(dacc[0], dacc[1], dacc[2], dacc[3]); dp[1] = make_float4(dacc[4], dacc[5], dacc[6], dacc[7]); }
        }
        if (MODE == 2) {
#pragma unroll
            for (int o = 1; o < 64; o <<= 1) mx = fmaxf(mx, __shfl_xor(mx, o));
            const float sc = mx > 0.f ? mx * (1.f / 127.f) : 1.f, inv = 1.f / sc;
            unsigned* dq = (unsigned*)(xq + (size_t)row * D) + lane;
#pragma unroll
            for (int j = 0; j < 4; ++j) { const int q0 = (int)rintf(y[j][0] * inv), q1 = (int)rintf(y[j][1] * inv), q2 = (int)rintf(y[j][2] * inv), q3 = (int)rintf(y[j][3] * inv);
                dq[64 * j] = (unsigned)(q0 & 255) | ((unsigned)(q1 & 255) << 8) | ((unsigned)(q2 & 255) << 16) | ((unsigned)(q3 & 255) << 24); }
            if (lane == 0) xs[row] = sc;
        }
    }
}

typedef short bf16x8 __attribute__((ext_vector_type(8)));
typedef short bf16x4 __attribute__((ext_vector_type(4)));
typedef float f32x16 __attribute__((ext_vector_type(16)));
typedef __bf16 bf2_t __attribute__((ext_vector_type(2)));
#define MFMA32(a, b, c) __builtin_amdgcn_mfma_f32_32x32x16_bf16((a), (b), (c), 0, 0, 0)
__device__ __forceinline__ unsigned pkbf(float lo, float hi) { bf2_t v = {(__bf16)lo, (__bf16)hi}; return __builtin_bit_cast(unsigned, v); }
__device__ __forceinline__ short bfs(float f) { return __builtin_bit_cast(short, (__bf16)f); }
__device__ __forceinline__ float sbf2f(short v) { return __uint_as_float(((unsigned)(unsigned short)v) << 16); }
__device__ __forceinline__ int crow(int i, int hi) { return (i & 3) + 8 * (i >> 2) + 4 * hi; }
template <int S> __device__ __forceinline__ bf16x8 pack8(const f32x16& x) {
    v4u p; p.x = pkbf(x[8 * S], x[8 * S + 1]); p.y = pkbf(x[8 * S + 2], x[8 * S + 3]); p.z = pkbf(x[8 * S + 4], x[8 * S + 5]); p.w = pkbf(x[8 * S + 6], x[8 * S + 7]);
    return __builtin_bit_cast(bf16x8, p);
}
__device__ __forceinline__ bf16x8 ldg8(const bf16* p) { return *(const bf16x8*)p; }
__device__ __forceinline__ bf16x8 lds8(const LAS bf16* p) { return *(const LAS bf16x8*)p; }
__device__ __forceinline__ bf16x8 lds4x2(const LAS bf16* p) { const bf16x4 a = *(const LAS bf16x4*)p, b = *(const LAS bf16x4*)(p + 8); return __builtin_shufflevector(a, b, 0, 1, 2, 3, 4, 5, 6, 7); }
__device__ __forceinline__ f32x16 zero16() { f32x16 z;
#pragma unroll
    for (int i = 0; i < 16; ++i) z[i] = 0.f;
    return z; }

__device__ __forceinline__ void attn_unit(const float* sinks, const float* gnorm, LAS unsigned char* ldsb, int unit, const bf16* PROJ, bf16* MIXB, int tid, int lane, int wave) {
    asm volatile("" : "+v"(tid), "+v"(lane));
    const int tok0 = unit * 64, s0 = tok0 & (SEQ - 1), kbase = tok0 - 128;
    LAS bf16* VT = (LAS bf16*)ldsb;
    LAS bf16* KI = (LAS bf16*)(ldsb + 51200);
    LAS float* SSQ = (LAS float*)(ldsb + 51200 + 55296);
    const __amdgpu_buffer_rsrc_t rsP = __builtin_amdgcn_make_buffer_rsrc((void*)PROJ, 0, (unsigned)T * PS * 2u, 0x00020000);
#pragma unroll
    for (int i = 0; i < 6; ++i) {
        const int c = tid + 512 * i, kv = c / 1536, cc = c - kv * 1536, key = cc >> 3, d0 = (cc & 7) * 8; const bool valid = (s0 - 128 + key) >= 0;
        bf16x8 v, k;
#pragma unroll
        for (int e = 0; e < 8; ++e) { v[e] = 0; k[e] = 0; }
        if (valid) { const unsigned ro = (unsigned)(kbase + key) * (unsigned)PS + (unsigned)(kv * 64 + d0);
            v = __builtin_bit_cast(bf16x8, __builtin_amdgcn_raw_buffer_load_b128(rsP, (int)((ro + (unsigned)OV) * 2u), 0, 0));
            k = __builtin_bit_cast(bf16x8, __builtin_amdgcn_raw_buffer_load_b128(rsP, (int)((ro + (unsigned)OKK) * 2u), 0, 0)); }
#pragma unroll
        for (int e = 0; e < 8; ++e) VT[kv * 12800 + (d0 + e) * 200 + key] = (bf16)v[e];
        *(LAS bf16x8*)(KI + (kv * 192 + key) * 72 + d0) = k;
    }
    __syncthreads();
    const int r = lane & 31, hi = lane >> 5;
    const int hq = wave, hkv = wave >> 2;
    const float slope = exp2f(-(float)(hq + 1)), sink = sinks[hq];
#pragma unroll 1
    for (int qt = 0; qt < 2; ++qt) {
        const int tq = tok0 + 32 * qt + r;
        bf16x8 qf[4];
        { const bf16* qp = PROJ + (size_t)tq * PS + OQ + hq * 64 + 8 * hi; asm volatile("" : "+v"(qp));
#pragma unroll
          for (int ks = 0; ks < 4; ++ks) qf[ks] = ldg8(qp + 16 * ks); }
        const int ql = 32 * qt + r;
        float m = sink, lh = 0.f;
        f32x16 O0 = zero16(), O1 = zero16();
#pragma unroll 1
        for (int kt = 0; kt < 5; ++kt) {
            const LAS bf16* kp = KI + (hkv * 192 + 32 * (qt + kt) + r) * 72 + 8 * hi;
            f32x16 X = zero16();
#pragma unroll
            for (int ks = 0; ks < 4; ++ks) X = MFMA32(lds8(kp + 16 * ks), qf[ks], X);
            float tm = -1e30f;
#pragma unroll
            for (int i = 0; i < 16; ++i) {
                const int kl = 32 * (qt + kt) + crow(i, hi), dist = 128 + ql - kl;
                const bool valid = (dist >= 0) && (dist < 128) && ((s0 - 128 + kl) >= 0);
                const float lg = valid ? (X[i] * 0.125f - slope * (float)dist) : -1e30f;
                X[i] = lg; tm = fmaxf(tm, lg);
            }
            tm = fmaxf(tm, __shfl_xor(tm, 32));
            const float mn = fmaxf(m, tm), sc = __expf(m - mn);
            m = mn; lh *= sc;
#pragma unroll
            for (int i = 0; i < 16; ++i) { O0[i] *= sc; O1[i] *= sc; const float pe = __expf(X[i] - mn); X[i] = pe; lh += pe; }
            const LAS bf16* vp = VT + hkv * 12800 + r * 200 + 32 * (qt + kt) + 4 * hi;
            { const bf16x8 xs = pack8<0>(X); const bf16x8 a0 = lds4x2(vp), a1 = lds4x2(vp + 32 * 200); O0 = MFMA32(a0, xs, O0); O1 = MFMA32(a1, xs, O1); }
            { const bf16x8 xs = pack8<1>(X); const bf16x8 a0 = lds4x2(vp + 16), a1 = lds4x2(vp + 32 * 200 + 16); O0 = MFMA32(a0, xs, O0); O1 = MFMA32(a1, xs, O1); }
        }
        const float lsum = lh + __shfl_xor(lh, 32) + __expf(sink - m);
        const float iv = 1.f / lsum;
        float sq = 0.f;
#pragma unroll
        for (int i = 0; i < 16; ++i) sq += O0[i] * O0[i] + O1[i] * O1[i];
        sq *= iv * iv; sq += __shfl_xor(sq, 32);
        if (hi == 0) SSQ[hq * 32 + r] = sq;
        __syncthreads();
        float tot = 0.f;
#pragma unroll
        for (int h = 0; h < 8; ++h) tot += SSQ[h * 32 + r];
        const float sc = iv * rsqrtf(tot * (1.f / 512.f) + EPS);
        bf16* orow = MIXB + (size_t)tq * D + hq * 64 + 4 * hi;
#pragma unroll
        for (int q4 = 0; q4 < 4; ++q4) {
            const float4 g0 = *(const float4*)(gnorm + hq * 64 + 8 * q4 + 4 * hi), g1 = *(const float4*)(gnorm + hq * 64 + 32 + 8 * q4 + 4 * hi);
            uint2 w0, w1;
            w0.x = pkbf(O0[4 * q4] * sc * g0.x, O0[4 * q4 + 1] * sc * g0.y); w0.y = pkbf(O0[4 * q4 + 2] * sc * g0.z, O0[4 * q4 + 3] * sc * g0.w);
            w1.x = pkbf(O1[4 * q4] * sc * g1.x, O1[4 * q4 + 1] * sc * g1.y); w1.y = pkbf(O1[4 * q4 + 2] * sc * g1.z, O1[4 * q4 + 3] * sc * g1.w);
            *(uint2*)(orow + 8 * q4) = w0; *(uint2*)(orow + 32 + 8 * q4) = w1;
        }
        __syncthreads();
    }
}

__device__ __forceinline__ void ssd_chunk_unit(LAS unsigned char* ldsb, int unit, const bf16* PROJ, bf16* XACT, const float* DTRAW, const float* conv_w, const float* conv_b, const float* dt_bias, const float* a_log,
                                               float* ACS, float* CDEC, float* MIXF, float* STATES, int tid, int lane, int wave) {
    asm volatile("" : "+v"(tid), "+v"(lane));
    const int g = unit & 1, bc = unit >> 1, tok0 = bc * 128;
    LAS float* DTT = (LAS float*)(ldsb + 34816 * 3 + 2048);
    LAS float* WT = (LAS float*)(ldsb + 34816 * 3 + 4096);
    {
        const int cgi = tid & 63, t0 = tok0 + 16 * (tid >> 6);
        const int c0 = cgi < 32 ? g * 256 + cgi * 8 : (cgi < 48 ? 512 + g * 128 + (cgi - 32) * 8 : 768 + g * 128 + (cgi - 48) * 8);
        float w[4][8], bs[8];
#pragma unroll
        for (int k = 0; k < 4; ++k) { const float4 a0 = *(const float4*)(conv_w + k * 1024 + c0), a1 = *(const float4*)(conv_w + k * 1024 + c0 + 4);
            w[k][0] = a0.x; w[k][1] = a0.y; w[k][2] = a0.z; w[k][3] = a0.w; w[k][4] = a1.x; w[k][5] = a1.y; w[k][6] = a1.z; w[k][7] = a1.w; }
        { const float4 a0 = *(const float4*)(conv_b + c0), a1 = *(const float4*)(conv_b + c0 + 4); bs[0] = a0.x; bs[1] = a0.y; bs[2] = a0.z; bs[3] = a0.w; bs[4] = a1.x; bs[5] = a1.y; bs[6] = a1.z; bs[7] = a1.w; }
        const bool has_halo = (t0 & (SEQ - 1)) != 0;
        bf16x8 rows[19];
#pragma unroll
        for (int i = 0; i < 19; ++i) {
            if (i < 3 && !has_halo) {
#pragma unroll
                for (int e = 0; e < 8; ++e) rows[i][e] = 0;
            } else rows[i] = ldg8(PROJ + (size_t)(t0 + i - 3) * PS + OXBC + c0);
        }
#pragma unroll
        for (int i = 0; i < 16; ++i) {
            float o[8];
#pragma unroll
            for (int e = 0; e < 8; ++e) o[e] = silu_f(bs[e] + w[0][e] * sbf2f(rows[i][e]) + w[1][e] * sbf2f(rows[i + 1][e]) + w[2][e] * sbf2f(rows[i + 2][e]) + w[3][e] * sbf2f(rows[i + 3][e]));
            v4u ov; ov.x = pkbf(o[0], o[1]); ov.y = pkbf(o[2], o[3]); ov.z = pkbf(o[4], o[5]); ov.w = pkbf(o[6], o[7]);
            *(v4u*)(XACT + (size_t)(t0 + i) * 1024 + c0) = ov;
        }
    }
    LAS float* ACST = (LAS float*)(ldsb + 34816 * 3);
    {
        const int s = tid >> 2, hh = tid & 3, H = g * 4 + hh;
        const float A = -__expf(a_log[H]);
        const float raw = DTRAW[(size_t)(tok0 + s) * 8 + H] + dt_bias[H];
        const float dtv = fmaxf(raw, 0.f) + log1pf(__expf(-fabsf(raw)));
        float v = dtv * A;
#pragma unroll
        for (int o = 4; o < 64; o <<= 1) { const float y = __shfl_up(v, o); if (lane >= o) v += y; }
        if (lane >= 60) WT[wave * 4 + hh] = v;
        __syncthreads();
        float off = 0.f;
        for (int w2 = 0; w2 < wave; ++w2) off += WT[w2 * 4 + hh];
        v += off;
        DTT[tid] = dtv; ACST[tid] = v; ACS[(size_t)(tok0 + s) * 8 + H] = v;
        if (s == 127) CDEC[bc * 8 + H] = __expf(v);
    }
    asm volatile("s_waitcnt vmcnt(0)" ::: "memory");
    __syncthreads();
    LAS bf16* BT = (LAS bf16*)ldsb;
    LAS bf16* XD = (LAS bf16*)(ldsb + 34816);
    LAS bf16* XW = (LAS bf16*)(ldsb + 34816 + 34816);
    const int r = lane & 31, hi = lane >> 5;
#pragma unroll
    for (int i = 0; i < 4; ++i) {
        const int c = tid + 512 * i, s = c >> 4, n0 = (c & 15) * 8;
        const bf16x8 v = ldg8(XACT + (size_t)(tok0 + s) * 1024 + 512 + g * 128 + n0);
#pragma unroll
        for (int e = 0; e < 8; ++e) BT[(n0 + e) * 136 + s] = (bf16)v[e];
    }
#pragma unroll 1
    for (int hp = 0; hp < 2; ++hp) {
        if (hp) __syncthreads();
        int tidp = tid; asm volatile("" : "+v"(tidp));
#pragma unroll
        for (int i = 0; i < 4; ++i) {
            const int c = tidp + 512 * i, hsel = c >> 10, s = (c >> 3) & 127, p0 = (c & 7) * 8, H = g * 4 + 2 * hp + hsel;
            const bf16x8 v = ldg8(XACT + (size_t)(tok0 + s) * 1024 + H * 64 + p0);
            const float dtv = DTT[s * 4 + 2 * hp + hsel];
            const float w = __expf(ACST[127 * 4 + 2 * hp + hsel] - ACST[s * 4 + 2 * hp + hsel]);
#pragma unroll
            for (int e = 0; e < 8; ++e) { const float xd = sbf2f(v[e]) * dtv; XD[hsel * 8704 + (p0 + e) * 136 + s] = (bf16)bfs(xd); XW[hsel * 8704 + (p0 + e) * 136 + s] = (bf16)bfs(xd * w); }
        }
        __syncthreads();
        {
            const int lt = wave & 3, hsel = wave >> 2, hh = 2 * hp + hsel, H = g * 4 + hh;
            const int l = 32 * lt + r; const float acs_l = ACST[l * 4 + hh];
            bf16x8 cf[8];
            { const bf16* cp = XACT + (size_t)(tok0 + l) * 1024 + 768 + g * 128 + 8 * hi; asm volatile("" : "+v"(cp));
#pragma unroll
              for (int ks = 0; ks < 8; ++ks) cf[ks] = ldg8(cp + 16 * ks); }
            f32x16 Z0 = zero16(), Z1 = zero16();
            bf16x8 bn[8];
            { const bf16* bp = XACT + (size_t)(tok0 + r) * 1024 + 512 + g * 128 + 8 * hi; asm volatile("" : "+v"(bp));
#pragma unroll
              for (int ks = 0; ks < 8; ++ks) bn[ks] = ldg8(bp + 16 * ks); }
#pragma unroll 1
            for (int st = 0; st <= lt; ++st) {
                f32x16 X = zero16();
                bf16x8 bc[8];
#pragma unroll
                for (int ks = 0; ks < 8; ++ks) bc[ks] = bn[ks];
                { const int stn = st < lt ? st + 1 : lt; const bf16* bp = XACT + (size_t)(tok0 + 32 * stn + r) * 1024 + 512 + g * 128 + 8 * hi; asm volatile("" : "+v"(bp));
#pragma unroll
                  for (int ks = 0; ks < 8; ++ks) bn[ks] = ldg8(bp + 16 * ks); }
#pragma unroll
                for (int ks = 0; ks < 8; ++ks) X = MFMA32(bc[ks], cf[ks], X);
#pragma unroll
                for (int i = 0; i < 16; ++i) { const int s = 32 * st + crow(i, hi); const float f = (s <= l) ? __expf(acs_l - ACST[s * 4 + hh]) : 0.f; X[i] *= f; }
                const int sb = 32 * st + 4 * hi;
                { const bf16x8 xs = pack8<0>(X); const bf16x8 b0 = lds4x2(XD + hsel * 8704 + r * 136 + sb), b1 = lds4x2(XD + hsel * 8704 + (32 + r) * 136 + sb); Z0 = MFMA32(xs, b0, Z0); Z1 = MFMA32(xs, b1, Z1); }
                { const bf16x8 xs = pack8<1>(X); const bf16x8 b0 = lds4x2(XD + hsel * 8704 + r * 136 + sb + 16), b1 = lds4x2(XD + hsel * 8704 + (32 + r) * 136 + sb + 16); Z0 = MFMA32(xs, b0, Z0); Z1 = MFMA32(xs, b1, Z1); }
            }
#pragma unroll
            for (int i = 0; i < 16; ++i) { float* o = MIXF + (size_t)(tok0 + 32 * lt + crow(i, hi)) * D + 512 + H * 64 + r; o[0] = Z0[i]; o[32] = Z1[i]; }
        }
        {
            const int nt = wave & 3, hsel = wave >> 2, H = g * 4 + 2 * hp + hsel;
            f32x16 S0 = zero16(), S1 = zero16();
#pragma unroll
            for (int ks = 0; ks < 8; ++ks) {
                const bf16x8 btf = lds8(BT + (32 * nt + r) * 136 + 16 * ks + 8 * hi);
                const bf16x8 a0 = lds8(XW + hsel * 8704 + r * 136 + 16 * ks + 8 * hi), a1 = lds8(XW + hsel * 8704 + (32 + r) * 136 + 16 * ks + 8 * hi);
                S0 = MFMA32(a0, btf, S0); S1 = MFMA32(a1, btf, S1);
            }
            float* sp = STATES + (size_t)(bc * 8 + H) * 8192 + 32 * nt + r;
#pragma unroll
            for (int i = 0; i < 16; ++i) { const int p = crow(i, hi); sp[p * 128] = S0[i]; sp[(32 + p) * 128] = S1[i]; }
        }
    }
    __syncthreads();
}

__device__ __forceinline__ __amdgpu_buffer_rsrc_t mk_rsrc(const void* p, unsigned bytes) { return __builtin_amdgcn_make_buffer_rsrc((void*)p, 0, bytes, 0x00020000); }
__device__ __forceinline__ void yoff_unit(const float* d_skip, const float* gnorm, LAS unsigned char* ldsb, int unit, const bf16* XACT, const bf16* PROJ, const float* ACS, const bf16* PREVT,
                                          const float* MIXF, bf16* MIXB, int lane, int wave) {
    const int g = unit & 1, bc = unit >> 1, tok0 = bc * 128;
    const int r = lane & 31, hi = lane >> 5, lt = wave & 3, hpair = wave >> 2;
    LAS float* TAB = (LAS float*)ldsb;
    const __amdgpu_buffer_rsrc_t rsF = mk_rsrc(MIXF, (unsigned)T * D * 4u), rsX = mk_rsrc(XACT, (unsigned)T * 1024u * 2u), rsP = mk_rsrc(PROJ, (unsigned)T * PS * 2u), rsA = mk_rsrc(ACS, (unsigned)T * 32u), rsB = mk_rsrc(MIXB, (unsigned)T * D * 2u);
    const unsigned tb = (unsigned)(tok0 + 32 * lt + 4 * hi);
    bf16x8 cf[8];
    { const bf16* cp = XACT + (size_t)(tok0 + 32 * lt + r) * 1024 + 768 + g * 128 + 8 * hi; asm volatile("" : "+v"(cp));
#pragma unroll
      for (int ks = 0; ks < 8; ++ks) cf[ks] = ldg8(cp + 16 * ks); }
    float eav[16], ssq[16];
    unsigned ypk[2][2][8];
#pragma unroll
    for (int i = 0; i < 16; ++i) ssq[i] = 0.f;
#pragma unroll
    for (int hsel = 0; hsel < 2; ++hsel) {
        const int H = g * 4 + 2 * hpair + hsel; const bf16* pv = PREVT + (size_t)(bc * 8 + H) * 8192 + 8 * hi;
        asm volatile("" : "+v"(pv));
        f32x16 Y0 = zero16(), Y1 = zero16();
#pragma unroll
        for (int ks = 0; ks < 8; ++ks) {
            const bf16x8 b0 = ldg8(pv + r * 128 + 16 * ks), b1 = ldg8(pv + (32 + r) * 128 + 16 * ks);
            Y0 = MFMA32(cf[ks], b0, Y0); Y1 = MFMA32(cf[ks], b1, Y1);
        }
        const float dsk = d_skip[H];
        { const unsigned vo = (tb * 8u + (unsigned)H) * 4u;
#pragma unroll
          for (int i = 0; i < 16; ++i) eav[i] = __expf(__builtin_bit_cast(float, __builtin_amdgcn_raw_buffer_load_b32(rsA, (int)vo, ((i & 3) + 8 * (i >> 2)) * 32, 0))); }
#pragma unroll
        for (int pt = 0; pt < 2; ++pt) {
            const unsigned col = (unsigned)(H * 64 + 32 * pt + r);
            const unsigned voF = (tb * 1024u + 512u + col) * 4u, voX = (tb * 1024u + col) * 2u, voP = (tb * (unsigned)PS + (unsigned)OZ + col) * 2u;
            float yo[16], xsv[16], zv[16];
#pragma unroll
            for (int i = 0; i < 16; ++i) { const int ro = (i & 3) + 8 * (i >> 2);
                yo[i] = __builtin_bit_cast(float, __builtin_amdgcn_raw_buffer_load_b32(rsF, (int)voF, ro * 4096, 0));
                xsv[i] = bf2f((bf16)__builtin_amdgcn_raw_buffer_load_b16(rsX, (int)voX, ro * 2048, 0));
                zv[i] = bf2f((bf16)__builtin_amdgcn_raw_buffer_load_b16(rsP, (int)voP, ro * (PS * 2), 0)); }
#pragma unroll
            for (int i = 0; i < 16; i += 2) {
                const float y0 = (yo[i] + eav[i] * (pt ? Y1[i] : Y0[i]) + dsk * xsv[i]) * silu_f(zv[i]);
                const float y1 = (yo[i + 1] + eav[i + 1] * (pt ? Y1[i + 1] : Y0[i + 1]) + dsk * xsv[i + 1]) * silu_f(zv[i + 1]);
                ssq[i] += y0 * y0; ssq[i + 1] += y1 * y1; ypk[hsel][pt][i >> 1] = pkbf(y0, y1);
            }
            __builtin_amdgcn_sched_barrier(0);
        }
    }
#pragma unroll
    for (int i = 0; i < 16; ++i) {
#pragma unroll
        for (int o = 1; o < 32; o <<= 1) ssq[i] += __shfl_xor(ssq[i], o);
    }
    if (r == 0) {
#pragma unroll
        for (int i = 0; i < 16; ++i) TAB[hpair * 128 + 32 * lt + crow(i, hi)] = ssq[i];
    }
    __syncthreads();
#pragma unroll
    for (int i = 0; i < 16; ++i) { const int l = 32 * lt + crow(i, hi); ssq[i] = rsqrtf((TAB[l] + TAB[128 + l]) * (1.f / 256.f) + EPS); }
#pragma unroll
    for (int hsel = 0; hsel < 2; ++hsel)
#pragma unroll
        for (int pt = 0; pt < 2; ++pt) {
            const unsigned col = (unsigned)((g * 4 + 2 * hpair + hsel) * 64 + 32 * pt + r); const float gn = gnorm[col];
            const unsigned voB = (tb * 1024u + 512u + col) * 2u;
#pragma unroll
            for (int i = 0; i < 16; ++i) { const unsigned w = ypk[hsel][pt][i >> 1];
                const float yf = (i & 1) ? __uint_as_float(w & 0xffff0000u) : __uint_as_float(w << 16);
                __builtin_amdgcn_raw_buffer_store_b16((short)f2bf(yf * ssq[i] * gn), rsB, (int)voB, ((i & 3) + 8 * (i >> 2)) * 2048, 0); }
        }
    __syncthreads();
}
typedef float f32x2 __attribute__((ext_vector_type(2)));
__device__ __forceinline__ void fp8x16_to_f32(const uint4 w, float (&f)[16]) {
    const int ww[4] = {(int)w.x, (int)w.y, (int)w.z, (int)w.w};
#pragma unroll
    for (int q = 0; q < 4; ++q) { const f32x2 a = __builtin_amdgcn_cvt_pk_f32_fp8(ww[q], false), b = __builtin_amdgcn_cvt_pk_f32_fp8(ww[q], true); f[4 * q] = a.x; f[4 * q + 1] = a.y; f[4 * q + 2] = b.x; f[4 * q + 3] = b.y; }
}
template <int M4, int M2, int M1> __device__ __forceinline__ void treduce16(const float (&a)[16], int lane, float& r0, float& r1) {
    float b[8], c[4];
    { const bool hi = (lane & M4) != 0;
#pragma unroll
      for (int i = 0; i < 8; ++i) { const float send = hi ? a[i] : a[i + 8]; const float recv = __shfl_xor(send, M4); b[i] = (hi ? a[i + 8] : a[i]) + recv; } }
    { const bool hi = (lane & M2) != 0;
#pragma unroll
      for (int i = 0; i < 4; ++i) { const float send = hi ? b[i] : b[i + 4]; const float recv = __shfl_xor(send, M2); c[i] = (hi ? b[i + 4] : b[i]) + recv; } }
    { const bool hi = (lane & M1) != 0;
      { const float send = hi ? c[0] : c[2]; const float recv = __shfl_xor(send, M1); r0 = (hi ? c[2] : c[0]) + recv; }
      { const float send = hi ? c[1] : c[3]; const float recv = __shfl_xor(send, M1); r1 = (hi ? c[3] : c[1]) + recv; } }
}
template <int M4, int M2, int M1> __device__ __forceinline__ void treduce16i(const int (&a)[16], int lane, int& r0, int& r1) {
    int b[8], c[4];
    { const bool hi = (lane & M4) != 0;
#pragma unroll
      for (int i = 0; i < 8; ++i) { const int send = hi ? a[i] : a[i + 8]; const int recv = __shfl_xor(send, M4); b[i] = (hi ? a[i + 8] : a[i]) + recv; } }
    { const bool hi = (lane & M2) != 0;
#pragma unroll
      for (int i = 0; i < 4; ++i) { const int send = hi ? b[i] : b[i + 4]; const int recv = __shfl_xor(send, M2); c[i] = (hi ? b[i + 4] : b[i]) + recv; } }
    { const bool hi = (lane & M1) != 0;
      { const int send = hi ? c[0] : c[2]; const int recv = __shfl_xor(send, M1); r0 = (hi ? c[2] : c[0]) + recv; }
      { const int send = hi ? c[1] : c[3]; const int recv = __shfl_xor(send, M1); r1 = (hi ? c[3] : c[1]) + recv; } }
}
__device__ __forceinline__ void treduce16i_hw(const int (&a)[16], int lane, int& r0, int& r1) {
    int b[8], c[4];
#pragma unroll
    for (int i = 0; i < 8; ++i) { const auto r = __builtin_amdgcn_permlane32_swap((unsigned)a[i], (unsigned)a[i + 8], false, false); b[i] = (int)r[0] + (int)r[1]; }
#pragma unroll
    for (int i = 0; i < 4; ++i) { const auto r = __builtin_amdgcn_permlane16_swap((unsigned)b[i], (unsigned)b[i + 4], false, false); c[i] = (int)r[0] + (int)r[1]; }
    const bool hi = (lane & 8) != 0;
    { const int send = hi ? c[0] : c[2]; r0 = (hi ? c[2] : c[0]) + __builtin_amdgcn_update_dpp(0, send, 0x128, 0xf, 0xf, false); }
    { const int send = hi ? c[1] : c[3]; r1 = (hi ? c[3] : c[1]) + __builtin_amdgcn_update_dpp(0, send, 0x128, 0xf, 0xf, false); }
}
#define PE_ID(E, i) (((i) & 1) ? (E[(i) >> 1] >> 16) : (E[(i) >> 1] & 0xffffu))
__device__ __forceinline__ void peer_u_item(int p, int j, const LAS unsigned short* EL  , const unsigned char* __restrict__ XQ, const unsigned char* __restrict__ U8, LAS int* ACC  , int lane, int wave) {
    asm volatile("" : "+v"(lane));
    const int gidx = lane >> 3; const unsigned coff = (unsigned)(p * 128 + (lane & 7) * 16);
#pragma unroll 1
    for (int it = 0; it < 8; ++it) {
        const int t = j * 64 + it * 8 + wave;
        unsigned E[8];
        { const LAS v4u* ep = (const LAS v4u*)(EL + (it * 8 + wave) * 128 + 16 * gidx); const v4u e0 = ep[0], e1 = ep[1];
          E[0] = e0.x; E[1] = e0.y; E[2] = e0.z; E[3] = e0.w; E[4] = e1.x; E[5] = e1.y; E[6] = e1.z; E[7] = e1.w; }
        uint4 uu[16];
#pragma unroll
        for (int i = 0; i < 16; ++i) uu[i] = *(const uint4*)(U8 + (size_t)(PE_ID(E, i) * 1024u + coff));
        const uint4 xq = *(const uint4*)(XQ + (size_t)t * D + coff);
        int d[16];
#pragma unroll
        for (int i = 0; i < 16; ++i) {
            int s = __builtin_amdgcn_sdot4((int)uu[i].x, (int)xq.x, 0, false); s = __builtin_amdgcn_sdot4((int)uu[i].y, (int)xq.y, s, false);
            s = __builtin_amdgcn_sdot4((int)uu[i].z, (int)xq.z, s, false); s = __builtin_amdgcn_sdot4((int)uu[i].w, (int)xq.w, s, false);
            d[i] = s;
        }
        int r0, r1; treduce16i<4, 2, 1>(d, lane, r0, r1);
        { typedef int i2v __attribute__((ext_vector_type(2))); LAS i2v* ap = (LAS i2v*)(ACC + (it * 8 + wave) * 128 + 2 * lane);
          i2v a2; if (p == 0) { a2.x = r0; a2.y = r1; } else { a2 = *ap; a2.x += r0; a2.y += r1; } *ap = a2; }
    }
}
__device__ __forceinline__ void peer_v_item(int p, int j, const LAS unsigned short* EL, const LAS unsigned char* AL  , const LAS float* ASC  ,
                                            const unsigned char* __restrict__ V8, bf16* __restrict__ PEERO, int lane, int wave) {
    asm volatile("" : "+v"(lane));
    const __amdgpu_buffer_rsrc_t rsV = __builtin_amdgcn_make_buffer_rsrc((void*)V8, 0, 16384 * 1024, 0x00020000);
    const int gidx = lane >> 3; const unsigned coff = (unsigned)(p * 128 + (lane & 7) * 16);
#pragma unroll 1
    for (int it = 0; it < 8; ++it) {
        const int t = j * 64 + it * 8 + wave;
        unsigned E[8];
        { const LAS v4u* ep = (const LAS v4u*)(EL + (it * 8 + wave) * 128 + 16 * gidx); const v4u e0 = ep[0], e1 = ep[1];
          E[0] = e0.x; E[1] = e0.y; E[2] = e0.z; E[3] = e0.w; E[4] = e1.x; E[5] = e1.y; E[6] = e1.z; E[7] = e1.w; }
        uint4 vv[16];
#pragma unroll
        for (int i = 0; i < 16; ++i) { const v4u w_ = __builtin_amdgcn_raw_buffer_load_b128(rsV, (int)((PE_ID(E, i) << 10) + coff), 0, 0); vv[i] = make_uint4(w_.x, w_.y, w_.z, w_.w); }
        const v4u aq = *(const LAS v4u*)(AL + (it * 8 + wave) * 128 + 16 * gidx);
        const float asc = ASC[it * 8 + wave];
        const unsigned a4[4] = {aq.x, aq.y, aq.z, aq.w};
        int acc[16];
#pragma unroll
        for (int c = 0; c < 16; ++c) acc[c] = 0;
#pragma unroll
        for (int m = 0; m < 4; ++m) {
            const unsigned r0[4] = {vv[4 * m].x, vv[4 * m].y, vv[4 * m].z, vv[4 * m].w}, r1[4] = {vv[4 * m + 1].x, vv[4 * m + 1].y, vv[4 * m + 1].z, vv[4 * m + 1].w};
            const unsigned r2[4] = {vv[4 * m + 2].x, vv[4 * m + 2].y, vv[4 * m + 2].z, vv[4 * m + 2].w}, r3[4] = {vv[4 * m + 3].x, vv[4 * m + 3].y, vv[4 * m + 3].z, vv[4 * m + 3].w};
#pragma unroll
            for (int dc = 0; dc < 4; ++dc) {
                const unsigned ta = __builtin_amdgcn_perm(r1[dc], r0[dc], 0x05010400u), tb = __builtin_amdgcn_perm(r3[dc], r2[dc], 0x05010400u);
                const unsigned ua = __builtin_amdgcn_perm(r1[dc], r0[dc], 0x07030602u), ub = __builtin_amdgcn_perm(r3[dc], r2[dc], 0x07030602u);
                const unsigned c0 = __builtin_amdgcn_perm(tb, ta, 0x05040100u), c1 = __builtin_amdgcn_perm(tb, ta, 0x07060302u);
                const unsigned c2 = __builtin_amdgcn_perm(ub, ua, 0x05040100u), c3 = __builtin_amdgcn_perm(ub, ua, 0x07060302u);
                acc[4 * dc + 0] = __builtin_amdgcn_sdot4((int)c0, (int)a4[m], acc[4 * dc + 0], false);
                acc[4 * dc + 1] = __builtin_amdgcn_sdot4((int)c1, (int)a4[m], acc[4 * dc + 1], false);
                acc[4 * dc + 2] = __builtin_amdgcn_sdot4((int)c2, (int)a4[m], acc[4 * dc + 2], false);
                acc[4 * dc + 3] = __builtin_amdgcn_sdot4((int)c3, (int)a4[m], acc[4 * dc + 3], false);
            }
        }
        int r0i, r1i; treduce16i_hw(acc, lane, r0i, r1i);
        *(unsigned*)(PEERO + (size_t)t * D + coff + 2 * gidx) = pkbf(asc * (float)r0i, asc * (float)r1i);
    }
}

__device__ __forceinline__ void ce_desc(float& a, float& b) { const float hi = fmaxf(a, b), lo = fminf(a, b); a = hi; b = lo; }
__device__ __forceinline__ void sort16_desc(float (&v)[16]) {
#pragma unroll
    for (int k = 2; k <= 16; k <<= 1)
#pragma unroll
        for (int j = k >> 1; j > 0; j >>= 1)
#pragma unroll
            for (int i = 0; i < 16; ++i) { const int l = i ^ j; if (l > i) { if ((i & k) == 0) ce_desc(v[i], v[l]); else ce_desc(v[l], v[i]); } }
}
__device__ __forceinline__ void merge16_desc(float (&a)[16], const float (&b)[16]) {
#pragma unroll
    for (int i = 0; i < 16; ++i) a[i] = fmaxf(a[i], b[15 - i]);
#pragma unroll
    for (int j = 8; j > 0; j >>= 1)
#pragma unroll
        for (int i = 0; i < 16; ++i) { const int l = i ^ j; if (l > i) ce_desc(a[i], a[l]); }
}
__device__ __forceinline__ void ce_kv(float& ka, int& va, float& kb, int& vb) {
    const bool s = kb > ka; const float t0 = s ? kb : ka, t1 = s ? ka : kb; const int u0 = s ? vb : va, u1 = s ? va : vb; ka = t0; kb = t1; va = u0; vb = u1; }
__device__ __forceinline__ void sort16_kv(float (&k)[16], int (&v)[16]) {
#pragma unroll
    for (int kk = 2; kk <= 16; kk <<= 1)
#pragma unroll
        for (int j = kk >> 1; j > 0; j >>= 1)
#pragma unroll
            for (int i = 0; i < 16; ++i) { const int l = i ^ j; if (l > i) { if ((i & kk) == 0) ce_kv(k[i], v[i], k[l], v[l]); else ce_kv(k[l], v[l], k[i], v[i]); } }
}
__device__ __forceinline__ void merge16_kv(float (&ka)[16], int (&va)[16], const float (&kb)[16], const int (&vb)[16]) {
#pragma unroll
    for (int i = 0; i < 16; ++i) { const bool s = kb[15 - i] > ka[i]; ka[i] = s ? kb[15 - i] : ka[i]; va[i] = s ? vb[15 - i] : va[i]; }
#pragma unroll
    for (int j = 8; j > 0; j >>= 1)
#pragma unroll
        for (int i = 0; i < 16; ++i) { const int l = i ^ j; if (l > i) ce_kv(ka[i], va[i], ka[l], va[l]); }
}
__device__ __forceinline__ void split8(const float* p, bf16x8& hi8, bf16x8& lo8) {
    const float4 f0 = *(const float4*)p, f1 = *(const float4*)(p + 4);
    const float x[8] = {f0.x, f0.y, f0.z, f0.w, f1.x, f1.y, f1.z, f1.w};
#pragma unroll
    for (int j = 0; j < 8; ++j) { const short h = bfs(x[j]); hi8[j] = h; lo8[j] = bfs(x[j] - sbf2f(h)); }
}
__device__ __forceinline__ void route_task(int task, int tl0, const float* QP, const LAS bf16* KHL, LAS unsigned short* EL, LAS float* GL, int lane) {
    const int r = lane & 31, hi = lane >> 5, t = 4 * task + (r >> 3), head = r & 7;
    float top[2][16];
#pragma unroll
    for (int half = 0; half < 2; ++half) {
        bf16x8 qh[4], ql[4];
        { const float* qp = QP + (size_t)t * D + head * 128 + half * 64 + 8 * hi; asm volatile("" : "+v"(qp));
#pragma unroll
          for (int ks = 0; ks < 4; ++ks) split8(qp + 16 * ks, qh[ks], ql[ks]); }
        float cur[16];
#pragma unroll
        for (int kt = 0; kt < 4; ++kt) {
            f32x16 X = zero16();
            const LAS bf16* khp = KHL + (half * 128 + 32 * kt + r) * 72 + 8 * hi;
#pragma unroll
            for (int ks = 0; ks < 4; ++ks) {
                const bf16x8 kh = lds8(khp + 16 * ks), kl = lds8(khp + 2 * 128 * 72 + 16 * ks);
                X = MFMA32(kh, qh[ks], X); X = MFMA32(kh, ql[ks], X); X = MFMA32(kl, qh[ks], X);
            }
            float grp[16];
#pragma unroll
            for (int i = 0; i < 16; ++i) { const unsigned key = (unsigned)(32 * kt + crow(i, hi)); grp[i] = __uint_as_float((__float_as_uint(X[i]) & ~127u) | (127u - key)); }
            sort16_desc(grp);
            if (kt == 0) {
#pragma unroll
                for (int i = 0; i < 16; ++i) cur[i] = grp[i];
            } else merge16_desc(cur, grp);
        }
        float oth[16];
#pragma unroll
        for (int i = 0; i < 16; ++i) oth[i] = __shfl_xor(cur[i], 32);
        merge16_desc(cur, oth);
#pragma unroll
        for (int i = 0; i < 16; ++i) top[half][i] = cur[i];
    }
    unsigned P1[4], P2[4];
#pragma unroll
    for (int q = 0; q < 4; ++q) { P1[q] = 0u; P2[q] = 0u;
#pragma unroll
        for (int s = 0; s < 4; ++s) { P1[q] |= (127u - (__float_as_uint(top[0][4 * q + s]) & 127u)) << (8 * s); P2[q] |= (127u - (__float_as_uint(top[1][4 * q + s]) & 127u)) << (8 * s); } }
#define CAND(a, b) __uint_as_float((__float_as_uint(top[0][a] + top[1][b]) & ~255u) | (255u - (unsigned)((a) * 16 + (b))))
    float bk[16];
    {
        float gk[16];
        gk[0] = CAND(0, 0);
        gk[1] = CAND(0, 1);
        gk[2] = CAND(0, 2);
        gk[3] = CAND(0, 3);
        gk[4] = CAND(0, 4);
        gk[5] = CAND(0, 5);
        gk[6] = CAND(0, 6);
        gk[7] = CAND(0, 7);
        gk[8] = CAND(0, 8);
        gk[9] = CAND(0, 9);
        gk[10] = CAND(0, 10);
        gk[11] = CAND(0, 11);
        gk[12] = CAND(0, 12);
        gk[13] = CAND(0, 13);
        gk[14] = CAND(0, 14);
        gk[15] = CAND(0, 15);
        sort16_desc(gk);
#pragma unroll
        for (int i = 0; i < 16; ++i) bk[i] = gk[i];
    }
    {
        float gk[16];
        gk[0] = CAND(1, 0);
        gk[1] = CAND(1, 1);
        gk[2] = CAND(1, 2);
        gk[3] = CAND(1, 3);
        gk[4] = CAND(1, 4);
        gk[5] = CAND(1, 5);
        gk[6] = CAND(1, 6);
        gk[7] = CAND(1, 7);
        gk[8] = CAND(2, 0);
        gk[9] = CAND(2, 1);
        gk[10] = CAND(2, 2);
        gk[11] = CAND(2, 3);
        gk[12] = CAND(2, 4);
        gk[13] = CAND(3, 0);
        gk[14] = CAND(3, 1);
        gk[15] = CAND(3, 2);
        sort16_desc(gk);
        merge16_desc(bk, gk);
    }
    {
        float gk[16];
        gk[0] = CAND(3, 3);
        gk[1] = CAND(4, 0);
        gk[2] = CAND(4, 1);
        gk[3] = CAND(4, 2);
        gk[4] = CAND(5, 0);
        gk[5] = CAND(5, 1);
        gk[6] = CAND(6, 0);
        gk[7] = CAND(6, 1);
        gk[8] = CAND(7, 0);
        gk[9] = CAND(7, 1);
        gk[10] = CAND(8, 0);
        gk[11] = CAND(9, 0);
        gk[12] = CAND(10, 0);
        gk[13] = CAND(11, 0);
        gk[14] = CAND(12, 0);
        gk[15] = CAND(13, 0);
        sort16_desc(gk);
        merge16_desc(bk, gk);
    }
    {
        float gk[16];
        gk[0] = CAND(14, 0);
        gk[1] = CAND(15, 0);
        gk[2] = -INFINITY;
        gk[3] = -INFINITY;
        gk[4] = -INFINITY;
        gk[5] = -INFINITY;
        gk[6] = -INFINITY;
        gk[7] = -INFINITY;
        gk[8] = -INFINITY;
        gk[9] = -INFINITY;
        gk[10] = -INFINITY;
        gk[11] = -INFINITY;
        gk[12] = -INFINITY;
        gk[13] = -INFINITY;
        gk[14] = -INFINITY;
        gk[15] = -INFINITY;
        sort16_desc(gk);
        merge16_desc(bk, gk);
    }
#undef CAND
    int bv[16];
#pragma unroll
    for (int i = 0; i < 16; ++i) {
        const unsigned cd = 255u - (__float_as_uint(bk[i]) & 255u), ca = cd >> 4, cb = cd & 15u;
        const unsigned wa = (ca >> 2) == 0u ? P1[0] : (ca >> 2) == 1u ? P1[1] : (ca >> 2) == 2u ? P1[2] : P1[3];
        const unsigned wb = (cb >> 2) == 0u ? P2[0] : (cb >> 2) == 1u ? P2[1] : (cb >> 2) == 2u ? P2[2] : P2[3];
        bv[i] = (int)((((wa >> (8u * (ca & 3u))) & 255u) << 7) | ((wb >> (8u * (cb & 3u))) & 255u));
    }
    float e[16], se = 0.f;
#pragma unroll
    for (int i = 0; i < 16; ++i) { e[i] = __expf(bk[i] - bk[0]); se += e[i]; }
    const float inv = 1.f / se;
    if (hi == 0) {
        LAS v4u* ip = (LAS v4u*)(EL + (tl0 + (r >> 3)) * 128 + head * 16); typedef float f4v __attribute__((ext_vector_type(4))); LAS f4v* gp = (LAS f4v*)(GL + (tl0 + (r >> 3)) * 128 + head * 16);
#pragma unroll
        for (int q = 0; q < 2; ++q) ip[q] = (v4u){(unsigned)bv[8 * q] | ((unsigned)bv[8 * q + 1] << 16), (unsigned)bv[8 * q + 2] | ((unsigned)bv[8 * q + 3] << 16), (unsigned)bv[8 * q + 4] | ((unsigned)bv[8 * q + 5] << 16), (unsigned)bv[8 * q + 6] | ((unsigned)bv[8 * q + 7] << 16)};
#pragma unroll
        for (int q = 0; q < 4; ++q) gp[q] = (f4v){e[4 * q] * inv, e[4 * q + 1] * inv, e[4 * q + 2] * inv, e[4 * q + 3] * inv};
    }
}

#define XB_TMO      128
#define XB_XCNT(j)  (256  + 64 * (j))
#define XB_XSUB(j)  (1280 + 64 * (j))
#define XB_XGEN(j)  (2304 + 64 * (j))
#define XB_TOP      3328
#define XB_TOPGEN   3392
#define XCD_BAR_WORDS 3456
#define XB_SPIN_CAP (1u << 22)
__device__ __forceinline__ unsigned xb_ld(unsigned* p)              { return __hip_atomic_load(p, __ATOMIC_RELAXED, __HIP_MEMORY_SCOPE_AGENT); }
__device__ __forceinline__ unsigned xb_add(unsigned* p, unsigned v) { return __hip_atomic_fetch_add(p, v, __ATOMIC_RELAXED, __HIP_MEMORY_SCOPE_AGENT); }
__device__ __forceinline__ unsigned xb_xcc_id() { return (unsigned)__builtin_amdgcn_s_getreg((3 << 11) | 20) & 0xFu; }
#define XB_SPIN(cond, bar) do { unsigned _sp = 0; while (cond) { __builtin_amdgcn_s_sleep(1); \
    if ((++_sp & 255u) == 0u) { if (xb_ld(&(bar)[XB_TMO])) break; if (_sp > XB_SPIN_CAP) { atomicAdd(&(bar)[XB_TMO], 1u); break; } } } } while (0)
struct XcdBarrier { unsigned* bar; unsigned x; volatile LAS unsigned* st; };
__device__ __forceinline__ XcdBarrier xcd_barrier_post(unsigned* bar, volatile LAS unsigned* st) {
    XcdBarrier b; b.bar = bar; b.x = xb_xcc_id(); b.st = st;
    if (threadIdx.x == 0) (void)xb_add(&bar[XB_XCNT(b.x)], 1u);
    return b;
}
__device__ __forceinline__ void xcd_barrier_complete(unsigned* bar, unsigned x, unsigned& nloc, unsigned& nx) {
    const unsigned G = gridDim.x * gridDim.y * gridDim.z;
    unsigned sum, cnt, mine, sp = 0u;
    for (;;) {
        sum = 0u; cnt = 0u; mine = 0u;
#pragma unroll
        for (unsigned j = 0; j < 16; ++j) { const unsigned c = xb_ld(&bar[XB_XCNT(j)]); sum += c; cnt += (c > 0u) ? 1u : 0u; mine = (j == x) ? c : mine; }
        if (sum == G) break;
        __builtin_amdgcn_s_sleep(1);
        if ((++sp & 255u) == 0u) { if (xb_ld(&bar[XB_TMO])) break; if (sp > XB_SPIN_CAP) { atomicAdd(&bar[XB_TMO], 1u); break; } }
    }
    nloc = mine > 0u ? mine : 1u; nx = cnt > 0u ? cnt : 1u;
}
__device__ __forceinline__ void xcd_barrier(const XcdBarrier& b) {
    asm volatile("s_waitcnt vmcnt(0)" ::: "memory");
    __syncthreads();
    if (threadIdx.x == 0) {
        unsigned* bar = b.bar;
        __builtin_amdgcn_s_waitcnt(0);
        unsigned nloc = b.st[0], nx = b.st[1];
        if (nloc == 0u) { xcd_barrier_complete(bar, b.x, nloc, nx); b.st[0] = nloc; b.st[1] = nx; }
        const unsigned old = xb_add(&bar[XB_XSUB(b.x)], 1u);
        const unsigned gen = old / nloc;
        if (old + 1u == (gen + 1u) * nloc) {
            __builtin_amdgcn_fence(__ATOMIC_RELEASE, "agent");
            asm volatile("s_waitcnt vmcnt(0)" ::: "memory");
            const unsigned og = xb_add(&bar[XB_TOP], 1u);
            const unsigned tg = og / nx;
            if (og + 1u == (tg + 1u) * nx) xb_add(&bar[XB_TOPGEN], 1u);
            else XB_SPIN(xb_ld(&bar[XB_TOPGEN]) == tg, bar);
            __builtin_amdgcn_fence(__ATOMIC_ACQUIRE, "agent");
            xb_add(&bar[XB_XGEN(b.x)], 1u);
            asm volatile("s_waitcnt vmcnt(0)" ::: "memory");
        } else {
            XB_SPIN(xb_ld(&bar[XB_XGEN(b.x)]) == gen, bar);
            __builtin_amdgcn_fence(__ATOMIC_ACQUIRE, "agent");
            asm volatile("s_waitcnt vmcnt(0)" ::: "memory");
        }
    }
    __syncthreads();
}
constexpr int LDS_BYTES = 147456;
constexpr int MISC_OFF = 131072 + 320;

__global__ void __launch_bounds__(NTHR, 2) k_main(Args a) {
    extern __shared__ __attribute__((aligned(16))) unsigned char lds_raw[];
    LAS unsigned char* ldsb = (LAS unsigned char*)lds_raw;
    const int tid0 = threadIdx.x, bid = blockIdx.x, nb = gridDim.x;
    const int wave = __builtin_amdgcn_readfirstlane(tid0 >> 6);
    const int gthreads = nb * NTHR, nwaves = gthreads >> 6;
#define PHASE_VARS() int tid = tid0; asm volatile("" : "+v"(tid)); const int lane = tid & 63, gtid = bid * NTHR + tid, gwave = gtid >> 6; (void)lane; (void)gtid; (void)gwave
    unsigned char* ws = a.ws;
    bf16* WINT = (bf16*)(ws + WS_WIN); bf16* WOT = (bf16*)(ws + WS_WO); bf16* WQT = (bf16*)(ws + WS_WQ);
    bf16* PROJ = (bf16*)(ws + WS_PROJ);
    bf16* XNB = (bf16*)(ws + WS_XNB);
    bf16* XACT = (bf16*)(ws + WS_XACT);
    float* DTRAW = (float*)(ws + WS_DTRAW); float* DT = (float*)(ws + WS_DT); float* ACS = (float*)(ws + WS_ACS); float* CDEC = (float*)(ws + WS_CDEC);
    float* STATES = (float*)(ws + WS_STATES); bf16* PREVT = (bf16*)(ws + WS_PREV);
    float* QP = (float*)(ws + WS_QP); unsigned short* IDX = (unsigned short*)(ws + WS_IDX); float* GATE = (float*)(ws + WS_GATE);
    float* TOPV = (float*)(ws + WS_TOPV); int* TOPI = (int*)(ws + WS_TOPI);
    unsigned char* U8 = ws + WS_U8; unsigned char* V8 = ws + WS_V8; float* SU = (float*)(ws + WS_SU); float* SV = SU + 16384; bf16* PART = (bf16*)(ws + WS_PART); unsigned char* XQ = ws + WS_XQ; float* XS = (float*)(ws + WS_XS);
    bf16* KH = (bf16*)(ws + WS_KH); bf16* KL = (bf16*)(ws + WS_KH + 65536);
    bf16* HB = (bf16*)(ws + WS_STATES);
    float* MIXF = a.out;
    volatile LAS unsigned* MISC = (volatile LAS unsigned*)(ldsb + MISC_OFF);
    if (tid0 < 32) MISC[tid0] = 0u;
    __syncthreads();
    XcdBarrier bar = xcd_barrier_post((unsigned*)ws, MISC + 8);
#define IN(k) (a.ph_lo <= (k) && (k) < a.ph_hi)
#if defined(PROBE_LO)
    int seg_ = 0; unsigned long long tseg_ = __builtin_amdgcn_s_memrealtime();
#define PROBE_SPIN() do { if (seg_ >= PROBE_LO && seg_ <= PROBE_HI) { const unsigned long long d_ = (__builtin_amdgcn_s_memrealtime() - tseg_) * PROBE_AMP; const unsigned long long s_ = __builtin_amdgcn_s_memrealtime(); \
        while (__builtin_amdgcn_s_memrealtime() - s_ < d_) __builtin_amdgcn_s_sleep(4); } } while (0)
#define GRID_BAR() do { PROBE_SPIN(); xcd_barrier(bar); tseg_ = __builtin_amdgcn_s_memrealtime(); ++seg_; } while (0)
#else
#define PROBE_SPIN() do { } while (0)
#define GRID_BAR() xcd_barrier(bar)
#endif

    if (IN(0)) {
        PHASE_VARS();
        LAS float* scr = (LAS float*)(ldsb + wave * 16384);
        constexpr int I_IN = 16 * 72, I_O = 16 * 32, NITEMS = I_IN + 2 * I_O;
        for (int it = gwave; it < NITEMS; it += nwaves) {
            int r = it;
            if (r < I_IN) { transpose_item(a.w_in, PW, D, WINT, scr, r / 72, r % 72, lane); continue; } r -= I_IN;
            if (r < I_O) { transpose_item(a.w_out, D, D, WOT, scr, r / 32, r % 32, lane); continue; } r -= I_O;
            transpose_item(a.peer_wq, D, D, WQT, scr, r / 32, r % 32, lane);
        }
        for (int i = gtid; i < 2 * 128 * 64; i += gthreads) { const float kf = a.peer_sub_keys[i]; const short h = bfs(kf); KH[i] = (bf16)h; KL[i] = (bf16)bfs(kf - sbf2f(h)); }
        for (int i = tid; i < 8 * 1024; i += NTHR) { const int h = i & 7, c = i >> 3; *(LAS float*)(ldsb + h * 16384 + 8448 + c * 4) = a.w_in[(size_t)c * PW + ODT + h]; }
        __syncthreads();
        rmsnorm_rows_bf16<1>(a.x, a.norm_mix_g, XNB, ldsb, DTRAW, nullptr, nullptr, gwave, nwaves, lane);
    }
    GRID_BAR();
    if (IN(1)) {
        PHASE_VARS();
        pg8::Gemm g{XNB, WINT, T, PS, D}; pg8::StaticOrder S; S.init(T, PS, nb, bid);
        pg8::EpiBf16Plain E{PROJ, PS};
        pg8::gemm_phase<pg8::EpiBf16Plain, pg8::StaticOrder>(ldsb, g, S, E, nullptr);
        const int cfirst = (nb == 256) ? 64 : 0;
        if (bid >= cfirst) for (int rr0 = ((bid - cfirst) * 8 + wave) * 4; rr0 < 2 * 16384; rr0 += (nb - cfirst) * 8 * 4) {
            float4 v[4][4];
#pragma unroll
            for (int q = 0; q < 4; ++q) { const int rr = rr0 + q, which = rr >> 14, row = rr & 16383;
                typedef float f4v __attribute__((ext_vector_type(4))); const f4v* src4 = (const f4v*)((which ? a.peer_v : a.peer_u) + (size_t)row * D) + lane;
#pragma unroll
                for (int jq = 0; jq < 4; ++jq) { const f4v t4 = __builtin_nontemporal_load(src4 + 64 * jq); v[q][jq] = make_float4(t4.x, t4.y, t4.z, t4.w); } }
#pragma unroll
            for (int q = 0; q < 4; ++q) { const int rr = rr0 + q, which = rr >> 14, row = rr & 16383;
                float mx = 0.f;
#pragma unroll
                for (int jq = 0; jq < 4; ++jq) mx = fmaxf(mx, fmaxf(fmaxf(fabsf(v[q][jq].x), fabsf(v[q][jq].y)), fmaxf(fabsf(v[q][jq].z), fabsf(v[q][jq].w))));
#pragma unroll
                for (int o = 1; o < 64; o <<= 1) mx = fmaxf(mx, __shfl_xor(mx, o));
                const float sc = mx > 0.f ? mx * (1.f / 127.f) : 1.f, inv = 1.f / sc;
                unsigned* dst = (unsigned*)((which ? V8 : U8) + (size_t)row * D) + lane;
#pragma unroll
                for (int jq = 0; jq < 4; ++jq) { const int q0 = (int)rintf(v[q][jq].x * inv), q1 = (int)rintf(v[q][jq].y * inv), q2 = (int)rintf(v[q][jq].z * inv), q3 = (int)rintf(v[q][jq].w * inv);
                    dst[64 * jq] = (unsigned)(q0 & 255) | ((unsigned)(q1 & 255) << 8) | ((unsigned)(q2 & 255) << 16) | ((unsigned)(q3 & 255) << 24); }
                if (lane == 0) (which ? SV : SU)[row] = sc; }
        }
    }
    GRID_BAR();
    if (IN(3)) {
        PHASE_VARS();
        for (int u = bid; u < 512; u += nb) {
            if (u < 256) attn_unit(a.attn_sinks, a.attn_out_g, ldsb, u, PROJ, XNB, tid, lane, wave);
            else ssd_chunk_unit(ldsb, u - 256, PROJ, XACT, DTRAW, a.conv_w, a.conv_b, a.dt_bias, a.a_log, ACS, CDEC, MIXF, STATES, tid, lane, wave);
        }
    }
    GRID_BAR();
    if (IN(5)) {
        PHASE_VARS();
        for (int idx = gtid; idx < 2 * 8 * 8192; idx += gthreads) {
            const int pn = idx & 8191, h = (idx >> 13) & 7, b = idx >> 16;
            float run = 0.f;
#pragma unroll 1
            for (int c0 = 0; c0 < 64; c0 += 8) {
                float st[8], dc[8];
#pragma unroll
                for (int j = 0; j < 8; ++j) { const int bch = (b * 64 + c0 + j) * 8 + h; st[j] = STATES[(size_t)bch * 8192 + pn]; dc[j] = CDEC[bch]; }
#pragma unroll
                for (int j = 0; j < 8; ++j) { const int bch = (b * 64 + c0 + j) * 8 + h; PREVT[(size_t)bch * 8192 + pn] = f2bf(run); run = dc[j] * run + st[j]; }
            }
        }
    }
    GRID_BAR();
    if (IN(6)) {
        PHASE_VARS();
        for (int u = bid; u < 256; u += nb) yoff_unit(a.d_skip, a.ssm_norm_g, ldsb, u, XACT, PROJ, ACS, PREVT, MIXF, XNB, lane, wave);
    }
    GRID_BAR();
    if (IN(7)) {
        PHASE_VARS();
        pg8::Gemm g{XNB, WOT, T, D, D}; pg8::StaticOrder S; S.init(T, D, nb, bid);
        pg8::EpiBf16Resid E{HB, a.x, D};
        pg8::gemm_phase<pg8::EpiBf16Resid, pg8::StaticOrder>(ldsb, g, S, E, nullptr);
    }
    GRID_BAR();
    if (IN(8)) {
        PHASE_VARS();
        rmsnorm_rows_bf16<2>((const float*)HB, a.norm_ffn_g, XNB, ldsb, nullptr, XQ, XS, gwave, nwaves, lane);
    }
    GRID_BAR();
    if (IN(9)) {
        PHASE_VARS();
        pg8::Gemm g{XNB, WQT, T, D, D}; pg8::StaticOrder S; S.init(T, D, nb, bid);
        pg8::EpiF32Resid E{QP, nullptr, D};
        pg8::gemm_phase<pg8::EpiF32Resid, pg8::StaticOrder>(ldsb, g, S, E, nullptr);
    }
    GRID_BAR();
    bf16* PEERO = (bf16*)(ws + WS_PEERO);
    if (IN(12)) {
        PHASE_VARS();
        LAS bf16* KHL = (LAS bf16*)ldsb; LAS int* ACC = (LAS int*)ldsb; LAS unsigned char* AL = (LAS unsigned char*)(ldsb + 32768); LAS float* ASC = (LAS float*)(ldsb + 40960);
        LAS unsigned short* EL = (LAS unsigned short*)(ldsb + 73728); LAS float* GL = (LAS float*)(ldsb + 90112);
#pragma unroll 1
        for (int j = bid; j < NCHUNK; j += nb) {
            __syncthreads();
            for (int i = tid; i < 2 * 2 * 128 * 8; i += NTHR) {
                const int pc = i & 7, key = (i >> 3) & 127, hf = (i >> 10) & 1, hl = i >> 11;
                *(LAS v4u*)(KHL + ((hl * 2 + hf) * 128 + key) * 72 + pc * 8) = *(const v4u*)((hl ? KL : KH) + (size_t)(hf * 128 + key) * 64 + pc * 8);
            }
            __syncthreads();
            route_task(16 * j + wave, 4 * wave, QP, KHL, EL, GL, lane);
            route_task(16 * j + 8 + wave, 32 + 4 * wave, QP, KHL, EL, GL, lane);
            __syncthreads();
#pragma unroll 1
            for (int p = 0; p < NPART; ++p) peer_u_item(p, j, EL, XQ, U8, ACC, lane, wave);
#pragma unroll 1
            for (int it = 0; it < 8; ++it) {
                const int tl = it * 8 + wave, t = j * 64 + tl;
                const unsigned ew = *(const LAS unsigned*)(EL + tl * 128 + 2 * lane); const int e0 = (int)(ew & 0xffffu), e1 = (int)(ew >> 16);
                typedef int i2v __attribute__((ext_vector_type(2))); const i2v si = *(const LAS i2v*)(ACC + tl * 128 + 2 * lane);
                typedef float f2v __attribute__((ext_vector_type(2))); const f2v gt = *(const LAS f2v*)(GL + tl * 128 + 2 * lane); const float xs = XS[t];
                const float z0 = (float)si.x * SU[e0] * xs, z1 = (float)si.y * SU[e1] * xs;
                const float a0 = gt.x * 0.5f * z0 * (1.f + erff(z0 * 0.70710678118654752f)) * SV[e0], a1 = gt.y * 0.5f * z1 * (1.f + erff(z1 * 0.70710678118654752f)) * SV[e1];
                float mx = fmaxf(fabsf(a0), fabsf(a1));
#pragma unroll
                for (int o = 1; o < 64; o <<= 1) mx = fmaxf(mx, __shfl_xor(mx, o));
                const float sc = mx > 0.f ? mx * (1.f / 127.f) : 1.f, inv = 1.f / sc;
                *(LAS unsigned short*)(AL + tl * 128 + 2 * lane) = (unsigned short)(((int)rintf(a0 * inv) & 255) | (((int)rintf(a1 * inv) & 255) << 8));
                if (lane == 0) ASC[tl] = sc;
            }
#pragma unroll 1
            for (int p = 0; p < NPART; ++p) peer_v_item(p, j, EL, AL, ASC, V8, PEERO, lane, wave);
            asm volatile("s_waitcnt vmcnt(0)" ::: "memory");
#pragma unroll 1
            for (int it = 0; it < 8; ++it) {
                const int t = j * 64 + it * 8 + wave;
                const uint2* hr = (const uint2*)(HB + (size_t)t * D) + lane; unsigned long long* pr = (unsigned long long*)(PEERO + (size_t)t * D) + lane;
                float4 v[4]; float ss = 0.f;
#pragma unroll
                for (int jq = 0; jq < 4; ++jq) { const uint2 hw = hr[64 * jq]; const unsigned long long pw = __hip_atomic_load(pr + 64 * jq, __ATOMIC_RELAXED, __HIP_MEMORY_SCOPE_AGENT);
                    const unsigned pl = (unsigned)pw, ph = (unsigned)(pw >> 32);
                    v[jq] = make_float4(__uint_as_float(hw.x << 16) + __uint_as_float(pl << 16), __uint_as_float(hw.x & 0xffff0000u) + __uint_as_float(pl & 0xffff0000u),
                                        __uint_as_float(hw.y << 16) + __uint_as_float(ph << 16), __uint_as_float(hw.y & 0xffff0000u) + __uint_as_float(ph & 0xffff0000u));
                    ss += v[jq].x * v[jq].x + v[jq].y * v[jq].y + v[jq].z * v[jq].z + v[jq].w * v[jq].w; }
                ss = wave_sum(ss);
                const float r3 = rsqrtf(ss * (1.f / D) + EPS);
                float4* op = (float4*)(a.out + (size_t)t * D) + lane;
#pragma unroll
                for (int jq = 0; jq < 4; ++jq) { const float4 gv = ((const float4*)a.final_norm_g)[lane + 64 * jq]; op[64 * jq] = make_float4(v[jq].x * r3 * gv.x, v[jq].y * r3 * gv.y, v[jq].z * r3 * gv.z, v[jq].w * r3 * gv.w); }
            }
        }
    }
    PROBE_SPIN();
#undef IN
}
}

extern "C" void kernel_launch(void* const* d_in, const int* in_sizes, int n_in, void* d_out, int out_size, void* d_ws, size_t ws_size, hipStream_t stream) {
    if (n_in != 18 || out_size != T * D || ws_size < WS_END) { fprintf(stderr, "kernel_launch: unexpected shapes n_in=%d out=%d ws=%zu\n", n_in, out_size, ws_size); return; }
    Args a{};
    const float** ap = (const float**)&a;
    for (int i = 0; i < 18; ++i) ap[i] = (const float*)d_in[i];
    a.out = (float*)d_out; a.ws = (unsigned char*)d_ws;
    static int grid = 0;
    if (grid == 0) {
        int dev = 0, cus = 0, per_cu = 0;
        if (hipGetDevice(&dev) != hipSuccess || hipDeviceGetAttribute(&cus, hipDeviceAttributeMultiprocessorCount, dev) != hipSuccess) { fprintf(stderr, "kernel_launch: device query failed\n"); grid = -1; return; }
        if (hipFuncSetAttribute((const void*)k_main, hipFuncAttributeMaxDynamicSharedMemorySize, LDS_BYTES) != hipSuccess) { fprintf(stderr, "kernel_launch: hipFuncSetAttribute failed\n"); grid = -1; return; }
        if (hipOccupancyMaxActiveBlocksPerMultiprocessor(&per_cu, (const void*)k_main, NTHR, LDS_BYTES) != hipSuccess || per_cu < 1) { fprintf(stderr, "kernel_launch: occupancy query says %d blocks/CU\n", per_cu); (void)hipGetLastError(); grid = -1; return; }
        grid = cus;
    }
    if (grid < 0) return;
    if (hipMemsetAsync(d_ws, 0, 65536, stream) != hipSuccess) { fprintf(stderr, "kernel_launch: memset failed\n"); return; }
    a.ph_lo = 0; a.ph_hi = 13;
    hipLaunchKernelGGL(k_main, dim3(grid), dim3(NTHR), LDS_BYTES, stream, a);
}
```

```cpp
#include <hip/hip_runtime.h>
#include <cstdio>
#include <cstdint>

namespace pg8 {
#define PG8_LAS __attribute__((address_space(3)))
typedef unsigned short bf16_t;
typedef short bf16x8 __attribute__((ext_vector_type(8)));
typedef float f32x4 __attribute__((ext_vector_type(4)));
typedef unsigned u32x4 __attribute__((ext_vector_type(4)));
constexpr int BM = 256, BK = 64, HALF = 128, HTB = HALF * BK * 2  , STAGE_BYTES = 8 * HTB, NXCD = 8, WGM = 8;

__host__ __device__ __forceinline__ int lds_byte(int r, int c) { const int st = (r >> 4) * 2 + (c >> 5), rr = r & 15, cc = c & 31, ob = rr * 64 + cc * 2; return st * 1024 + (ob ^ (((ob >> 9) & 1) << 5)); }
__host__ __device__ __forceinline__ void stage_rc(int b, int& R, int& C) { const int st = b / 1024, sb = b % 1024, swz = sb ^ (((sb >> 9) & 1) << 5); R = (st >> 1) * 16 + swz / 64; C = (st & 1) * 32 + (swz % 64) / 2; }
__host__ __device__ __forceinline__ int perm32(int rho) { const int n = rho >> 4, i = rho & 15; return 8 * (i >> 2) + 4 * n + (i & 3); }

struct Unit { int pm, pn; };
struct Gemm { const bf16_t* A; const bf16_t* Bt; int M, N, K; };

struct StaticOrder {
    int nM, nN, nwg, G, c;
    __host__ __device__ void init(int M, int N, int G_, int c_) { nM = M / BM; nN = N / BM; nwg = nM * nN; G = G_; c = c_; }
    __host__ __device__ bool next(int i, Unit& u) const {
        const long L = (long)i * G + c; if (L >= nwg) return false;
        int wgid = (int)L; { const int q = nwg / NXCD, r = nwg % NXCD, xcd = wgid % NXCD, off = wgid / NXCD; wgid = (xcd < r ? xcd * (q + 1) : r * (q + 1) + (xcd - r) * q) + off; }
        const int nig = WGM * nN, gid = wgid / nig, fm = gid * WGM, gsz = (nM - fm) < WGM ? (nM - fm) : WGM;
        u.pm = fm + ((wgid % nig) % gsz); u.pn = (wgid % nig) / gsz; return true;
    }
    __device__ __forceinline__ void a_ready(const Unit&) const {}
    __device__ __forceinline__ void done(const Unit&) const {}
};
__device__ __forceinline__ unsigned cvt_pk_bf16(float lo, float hi) { unsigned r; asm volatile("v_cvt_pk_bf16_f32 %0, %1, %2" : "=v"(r) : "v"(lo), "v"(hi)); return r; }
typedef float f32x2 __attribute__((ext_vector_type(2)));
struct EpiBf16Plain {
    static constexpr bool PERM = true, AFTER_DRAIN = false;
    bf16_t* O; int ldc;
    __device__ __forceinline__ void operator()(const f32x4 (&acc)[2][2][4][2], const Unit& u, int wr, int wc, int fr, int fq) const {
        const int row0 = u.pm * BM + wr * 64 + fr, col0 = u.pn * BM + wc * 32 + 8 * fq;
        const __amdgpu_buffer_rsrc_t rs = __builtin_amdgcn_make_buffer_rsrc((void*)O, 0, 0x7fffffff, 0x00020000);
#pragma unroll
        for (int ai = 0; ai < 2; ++ai)
#pragma unroll
            for (int m = 0; m < 4; ++m) { const unsigned ro = ((unsigned)(row0 + ai * HALF + m * 16) * (unsigned)ldc + (unsigned)col0) * 2u;
#pragma unroll
                for (int bj = 0; bj < 2; ++bj) { const f32x4 v0 = acc[ai][bj][m][0], v1 = acc[ai][bj][m][1];
                    u32x4 w; w.x = cvt_pk_bf16(v0[0], v0[1]); w.y = cvt_pk_bf16(v0[2], v0[3]); w.z = cvt_pk_bf16(v1[0], v1[1]); w.w = cvt_pk_bf16(v1[2], v1[3]);
                    __builtin_amdgcn_raw_buffer_store_b128(w, rs, (int)(ro + bj * HALF * 2), 0, 16); } }
    }
};
struct EpiF32Resid {
    static constexpr bool PERM = false, AFTER_DRAIN = false;
    float* C; const float* R; int ldc;
    __device__ __forceinline__ void operator()(const f32x4 (&acc)[2][2][4][2], const Unit& u, int wr, int wc, int fr, int fq) const {
        const int row0 = u.pm * BM + wr * 64 + fr, col0 = u.pn * BM + wc * 32 + 4 * fq;
#pragma unroll
        for (int ai = 0; ai < 2; ++ai)
#pragma unroll
            for (int m = 0; m < 4; ++m) { const size_t off = (size_t)(row0 + ai * HALF + m * 16) * ldc + col0;
#pragma unroll
                for (int bj = 0; bj < 2; ++bj)
#pragma unroll
                    for (int n = 0; n < 2; ++n) { f32x4 v = acc[ai][bj][m][n]; if (R) v += *(const f32x4*)(R + off + bj * HALF + n * 16); *(f32x4*)(C + off + bj * HALF + n * 16) = v; }
                asm volatile("" ::: "memory"); }
    }
};

struct EpiBf16Resid {
    static constexpr bool PERM = true, AFTER_DRAIN = false;
    bf16_t* O; const float* R; int ldc;
    __device__ __forceinline__ void operator()(const f32x4 (&acc)[2][2][4][2], const Unit& u, int wr, int wc, int fr, int fq) const {
        const int row0 = u.pm * BM + wr * 64 + fr, col0 = u.pn * BM + wc * 32 + 8 * fq;
#pragma unroll
        for (int ai = 0; ai < 2; ++ai)
#pragma unroll
            for (int m = 0; m < 4; ++m) { const size_t off = (size_t)(row0 + ai * HALF + m * 16) * ldc + col0;
#pragma unroll
                for (int bj = 0; bj < 2; ++bj) { const f32x4 v0 = acc[ai][bj][m][0] + *(const f32x4*)(R + off + bj * HALF), v1 = acc[ai][bj][m][1] + *(const f32x4*)(R + off + bj * HALF + 4);
                    u32x4 w; w.x = cvt_pk_bf16(v0[0], v0[1]); w.y = cvt_pk_bf16(v0[2], v0[3]); w.z = cvt_pk_bf16(v1[0], v1[1]); w.w = cvt_pk_bf16(v1[2], v1[3]);
                    *(u32x4*)(O + off + bj * HALF) = w; }
                asm volatile("" ::: "memory"); }
    }
};
template <class Epi, class Sched, bool STAMP = false>
__device__ __forceinline__ void gemm_phase(PG8_LAS unsigned char* lds, const Gemm g, const Sched& S, const Epi& E, unsigned long long* stamps) {
    const int tid = threadIdx.x, wid = __builtin_amdgcn_readfirstlane(tid >> 6), lane = tid & 63, wr = wid >> 2, wc = wid & 3, fr = lane & 15, fq = lane >> 4;
    const int K = g.K, nt = K / BK;
    int ts_lo = 0, ts_hi = 0, nts = 0; const unsigned long long rt_entry = STAMP ? (unsigned long long)0ull : 0ull;
#define PG8_STAMP() do { if (STAMP && wid == 0 && nts < 64) { const unsigned long long _c = (unsigned long long)clock64(); \
        ts_lo = (lane == nts) ? (int)(unsigned)_c : ts_lo; ts_hi = (lane == nts) ? (int)(unsigned)(_c >> 32) : ts_hi; ++nts; } } while (0)
    PG8_STAMP();
    unsigned voffA[2], voffB[2];
#pragma unroll
    for (int i = 0; i < 2; ++i) { int R, C; stage_rc(tid * 16 + i * 8192, R, C); const int Rb = Epi::PERM ? ((R & ~31) + perm32(R & 31)) : R;
        voffA[i] = (unsigned)(R * K + C) * 2u; voffB[i] = (unsigned)(Rb * K + C) * 2u; }
    const size_t kstep = (size_t)(BK * 2);
    const size_t hstep = (size_t)HALF * K * 2;
    const size_t tstep = 2 * hstep;
    const unsigned ldsw = (unsigned)wid * 1024u;
    const int aoff = lds_byte(wr * 64 + fr, fq * 8), boff = lds_byte(wc * 32 + fr, fq * 8);
#define PG8_SA(b, h) (((b) * 2 + (h)) * HTB)
#define PG8_SB(b, h) ((4 + (b) * 2 + (h)) * HTB)
#define PG8_STAGE(bufoff, gbase, voff) do { _Pragma("unroll") for (int _i = 0; _i < 2; ++_i) \
        __builtin_amdgcn_global_load_lds((const unsigned*)((const char*)(gbase) + (voff)[_i]), (PG8_LAS unsigned*)(lds + (bufoff) + ldsw + _i * 8192), 16, 0, 0); } while (0)
#define PG8_LDA(dst, b, h) do { _Pragma("unroll") for (int m = 0; m < 4; ++m) _Pragma("unroll") for (int k = 0; k < 2; ++k) dst[m][k] = *(const PG8_LAS bf16x8*)(lds + PG8_SA(b, h) + aoff + m * 2048 + k * 1024); } while (0)
#define PG8_LDB(dst, b, h) do { _Pragma("unroll") for (int n = 0; n < 2; ++n) _Pragma("unroll") for (int k = 0; k < 2; ++k) dst[n][k] = *(const PG8_LAS bf16x8*)(lds + PG8_SB(b, h) + boff + n * 2048 + k * 1024); } while (0)
#define PG8_MMA(ai, bj, At, Bt) do { __builtin_amdgcn_s_setprio(1); _Pragma("unroll") for (int m = 0; m < 4; ++m) _Pragma("unroll") for (int n = 0; n < 2; ++n) _Pragma("unroll") for (int k = 0; k < 2; ++k) \
        acc[ai][bj][m][n] = __builtin_amdgcn_mfma_f32_16x16x32_bf16(Bt[n][k], At[m][k], acc[ai][bj][m][n], 0, 0, 0); __builtin_amdgcn_s_setprio(0); } while (0)
#define PG8_WAIT_V(n) asm volatile("s_waitcnt vmcnt(" #n ")" ::: "memory")
#define PG8_WAIT_L(n) asm volatile("s_waitcnt lgkmcnt(" #n ")" ::: "memory")
#define PG8_BAR __builtin_amdgcn_s_barrier()
#define PG8_SCHED __builtin_amdgcn_sched_barrier(0)
    Unit cur, nxt; int ui = 0;
    if (!S.next(0, cur)) return;
    f32x4 acc[2][2][4][2];
#pragma unroll
    for (int a = 0; a < 2; ++a)
#pragma unroll
        for (int b = 0; b < 2; ++b)
#pragma unroll
            for (int m = 0; m < 4; ++m)
#pragma unroll
                for (int n = 0; n < 2; ++n) acc[a][b][m][n] = (f32x4){0.f, 0.f, 0.f, 0.f};
    bf16x8 At[4][2], B0[2][2], B1[2][2];
    const char* cA = (const char*)g.A + (size_t)cur.pm * tstep; const char* cB = (const char*)g.Bt + (size_t)cur.pn * tstep;
    S.a_ready(cur);
    PG8_STAGE(PG8_SB(0, 0), cB, voffB); PG8_STAGE(PG8_SA(0, 0), cA, voffA); PG8_STAGE(PG8_SB(0, 1), cB + hstep, voffB); PG8_STAGE(PG8_SA(0, 1), cA + hstep, voffA);
    if (wr == 1) PG8_BAR;
    PG8_WAIT_V(4); PG8_BAR;
    PG8_STAGE(PG8_SB(1, 0), cB + kstep, voffB); PG8_STAGE(PG8_SA(1, 0), cA + kstep, voffA); PG8_STAGE(PG8_SB(1, 1), cB + hstep + kstep, voffB);
    PG8_WAIT_V(6); PG8_BAR;
    PG8_STAMP();
    for (;;) {
        const bool has_next = S.next(ui + 1, nxt);
        const char* nA = has_next ? (const char*)g.A + (size_t)nxt.pm * tstep : cA; const char* nB = has_next ? (const char*)g.Bt + (size_t)nxt.pn * tstep : cB;
        for (int t = 0; t < nt; t += 2) {
            const bool last = (t == nt - 2);
            const char* a1 = cA + (size_t)(t + 1) * kstep;
            const char* a2 = last ? nA : cA + (size_t)(t + 2) * kstep; const char* b2 = last ? nB : cB + (size_t)(t + 2) * kstep;
            const char* a3 = a2 + kstep; const char* b3 = b2 + kstep;
            if (last && has_next) S.a_ready(nxt);
            PG8_LDB(B0, 0, 0); PG8_SCHED; PG8_LDA(At, 0, 0); PG8_STAGE(PG8_SA(1, 1), a1 + hstep, voffA);
            PG8_WAIT_L(8); PG8_BAR; PG8_WAIT_L(0); PG8_MMA(0, 0, At, B0); PG8_BAR; PG8_SCHED;
            PG8_LDB(B1, 0, 1); PG8_STAGE(PG8_SB(0, 0), b2, voffB);
            PG8_BAR; PG8_WAIT_L(0); PG8_MMA(0, 1, At, B1); PG8_BAR;
            PG8_LDA(At, 0, 1); PG8_STAGE(PG8_SA(0, 0), a2, voffA);
            PG8_BAR; PG8_WAIT_L(0); PG8_MMA(1, 0, At, B0); PG8_BAR; PG8_SCHED;
            PG8_STAGE(PG8_SB(0, 1), b2 + hstep, voffB);
            PG8_WAIT_V(6); PG8_BAR; PG8_MMA(1, 1, At, B1); PG8_BAR;
            PG8_LDB(B0, 1, 0); PG8_SCHED; PG8_LDA(At, 1, 0); PG8_STAGE(PG8_SA(0, 1), a2 + hstep, voffA);
            PG8_WAIT_L(8); PG8_BAR; PG8_WAIT_L(0); PG8_MMA(0, 0, At, B0); PG8_BAR; PG8_SCHED;
            PG8_LDB(B1, 1, 1); PG8_STAGE(PG8_SB(1, 0), b3, voffB);
            PG8_BAR; PG8_WAIT_L(0); PG8_MMA(0, 1, At, B1); PG8_BAR;
            PG8_LDA(At, 1, 1); PG8_STAGE(PG8_SA(1, 0), a3, voffA);
            PG8_BAR; PG8_WAIT_L(0); PG8_MMA(1, 0, At, B0); PG8_BAR; PG8_SCHED;
            PG8_STAGE(PG8_SB(1, 1), b3 + hstep, voffB);
            PG8_WAIT_V(6); PG8_BAR; PG8_MMA(1, 1, At, B1); PG8_BAR;
        }
        PG8_STAMP();
        if constexpr (!Epi::AFTER_DRAIN) { E(acc, cur, wr, wc, fr, fq); S.done(cur); }
        PG8_STAMP();
        if (!has_next) break;
#pragma unroll
        for (int a = 0; a < 2; ++a)
#pragma unroll
            for (int b = 0; b < 2; ++b)
#pragma unroll
                for (int m = 0; m < 4; ++m)
#pragma unroll
                    for (int n = 0; n < 2; ++n) acc[a][b][m][n] = (f32x4){0.f, 0.f, 0.f, 0.f};
        cur = nxt; cA = nA; cB = nB; ++ui;
    }
    PG8_WAIT_V(0);
    if (wr == 0) PG8_BAR;
    PG8_BAR;
    if constexpr (Epi::AFTER_DRAIN) { E.fused(acc, cur, wr, wc, fr, fq, lds, wid, lane); S.done(cur); }
    PG8_STAMP();
    if (STAMP && wid == 0) { stamps[lane] = lane < nts ? (((unsigned long long)(unsigned)ts_hi << 32) | (unsigned)ts_lo) : 0ull;
        if (lane == 62) stamps[62] = rt_entry; if (lane == 63) stamps[63] = (unsigned long long)0ull; }
#undef PG8_STAMP
#undef PG8_SA
#undef PG8_SB
#undef PG8_STAGE
#undef PG8_LDA
#undef PG8_LDB
#undef PG8_MMA
#undef PG8_WAIT_V
#undef PG8_WAIT_L
#undef PG8_BAR
#undef PG8_SCHED
}
}

namespace {
constexpr int D = 1024, BATCH = 2, SEQ = 8192, T = BATCH * SEQ;
constexpr int PW = 2312;
constexpr int PS = 2304;
constexpr int OQ = 0, OKK = 512, OV = 640, OZ = 768, OXBC = 1280, ODT = 2304;
constexpr float EPS = 1e-6f;
constexpr int NTHR = 512;
typedef unsigned short bf16;
typedef unsigned v4u __attribute__((ext_vector_type(4)));

constexpr size_t MiB = 1u << 20;
constexpr size_t WS_WIN = 1 * MiB;
constexpr size_t WS_KH = 5 * MiB + 512 * 1024;
constexpr size_t WS_WO = 6 * MiB;
constexpr size_t WS_WQ = 8 * MiB;
constexpr size_t WS_PROJ = 10 * MiB;
constexpr size_t WS_XNB = 82 * MiB;
constexpr size_t WS_XACT = 114 * MiB;
constexpr size_t WS_DTRAW = 146 * MiB;
constexpr size_t WS_DT = WS_DTRAW + 512 * 1024;
constexpr size_t WS_ACS = WS_DT + 512 * 1024;
constexpr size_t WS_CDEC = WS_ACS + 512 * 1024;
constexpr size_t WS_STATES = 164 * MiB;
constexpr size_t WS_PREV = 196 * MiB;
constexpr size_t WS_QP = 10 * MiB;
constexpr size_t WS_IDX = 74 * MiB;
constexpr size_t WS_GATE = 114 * MiB;
constexpr size_t WS_TOPV = 122 * MiB;
constexpr size_t WS_TOPI = 138 * MiB;
constexpr size_t WS_ACT = 122 * MiB;
constexpr size_t WS_SU = 245 * MiB;
constexpr size_t WS_U8 = 212 * MiB;
constexpr size_t WS_V8 = 148 * MiB;
constexpr size_t WS_PART = 10 * MiB;
constexpr size_t WS_XQ = 228 * MiB;
constexpr size_t WS_XS = 244 * MiB;
constexpr size_t WS_PEERO = 10 * MiB;
constexpr size_t WS_END = 246 * MiB;
constexpr int CW_QU = 4096, CW_QV = 4096 + 64 * 16;
constexpr int NPART = 8, NCHUNK = T / 64;

struct Args {
    const float* x; const float* norm_mix_g; const float* w_in; const float* attn_sinks; const float* attn_out_g;
    const float* conv_w; const float* conv_b; const float* dt_bias; const float* a_log; const float* d_skip;
    const float* ssm_norm_g; const float* w_out; const float* norm_ffn_g; const float* peer_wq; const float* peer_sub_keys;
    const float* peer_u; const float* peer_v; const float* final_norm_g;
    float* out; unsigned char* ws;
    int ph_lo, ph_hi;
};

#define LAS __attribute__((address_space(3)))
#define LDS_WAIT() asm volatile("s_waitcnt lgkmcnt(0)" ::: "memory")
__device__ __forceinline__ float bf2f(bf16 v) { return __uint_as_float(((unsigned)v) << 16); }
__device__ __forceinline__ unsigned f2bfu(float f) { unsigned u = __float_as_uint(f); return (u + 0x7fffu + ((u >> 16) & 1u)) >> 16; }
__device__ __forceinline__ bf16 f2bf(float f) { return (bf16)f2bfu(f); }
__device__ __forceinline__ unsigned pk2(float lo, float hi) { return f2bfu(lo) | (f2bfu(hi) << 16); }
__device__ __forceinline__ float wave_sum(float v) {
#pragma unroll
    for (int o = 1; o < 64; o <<= 1) v += __shfl_xor(v, o);
    return v;
}
__device__ __forceinline__ float silu_f(float v) { return v / (1.f + __expf(-v)); }

__device__ __forceinline__ void transpose_item(const float* W, int ldw, int K, bf16* WT, LAS float* scr, int kb, int nbk, int lane) {
    const int k0 = 64 * kb, n0 = 32 * nbk;
#pragma unroll 8
    for (int i = 0; i < 32; ++i) { const int kk = 2 * i + (lane >> 5); scr[kk * 33 + (lane & 31)] = W[(size_t)(k0 + kk) * ldw + n0 + (lane & 31)]; }
    LDS_WAIT();
    const int c = lane & 7;
#pragma unroll
    for (int j = 0; j < 4; ++j) { const int n = (lane >> 3) + 8 * j; const LAS float* s = scr + (8 * c) * 33 + n;
        v4u o; o.x = pk2(s[0 * 33], s[1 * 33]); o.y = pk2(s[2 * 33], s[3 * 33]); o.z = pk2(s[4 * 33], s[5 * 33]); o.w = pk2(s[6 * 33], s[7 * 33]);
        *(v4u*)(WT + (size_t)(n0 + n) * K + k0 + 8 * c) = o; }
    LDS_WAIT();
}

template <int MODE  >
__device__ __forceinline__ void rmsnorm_rows_bf16(const float* __restrict__ in, const float* __restrict__ g, bf16* __restrict__ outp, const LAS unsigned char* ldsb, float* __restrict__ dtraw, unsigned char* __restrict__ xq, float* __restrict__ xs, int gwave, int nwaves, int lane) {
#pragma unroll 2
    for (int row = gwave; row < T; row += nwaves) {
        const float4* xr = (const float4*)(in + (size_t)row * D) + lane; const uint2* xb = (const uint2*)((const bf16*)in + (size_t)row * D) + lane;
        float4 v[4]; float ss = 0.f;
#pragma unroll
        for (int j = 0; j < 4; ++j) {
            if (MODE == 2) { const uint2 w = xb[64 * j]; v[j] = make_float4(__uint_as_float(w.x << 16), __uint_as_float(w.x & 0xffff0000u), __uint_as_float(w.y << 16), __uint_as_float(w.y & 0xffff0000u)); }
            else if (MODE == 1) { typedef float f4v __attribute__((ext_vector_type(4))); const f4v t4 = __builtin_nontemporal_load((const f4v*)xr + 64 * j); v[j] = make_float4(t4.x, t4.y, t4.z, t4.w); }
            else v[j] = xr[64 * j];
            ss += v[j].x * v[j].x + v[j].y * v[j].y + v[j].z * v[j].z + v[j].w * v[j].w; }
        ss = wave_sum(ss);
        const float r = rsqrtf(ss * (1.f / D) + EPS);
        unsigned long long* o8 = (unsigned long long*)(outp + (size_t)row * D) + lane;
        float dacc[8]; float y[4][4]; float mx = 0.f;
#pragma unroll
        for (int h = 0; h < 8; ++h) dacc[h] = 0.f;
#pragma unroll
        for (int j = 0; j < 4; ++j) {
            const float4 gv = ((const float4*)g)[lane + 64 * j];
            y[j][0] = v[j].x * r * gv.x; y[j][1] = v[j].y * r * gv.y; y[j][2] = v[j].z * r * gv.z; y[j][3] = v[j].w * r * gv.w;
            o8[64 * j] = (unsigned long long)pk2(y[j][0], y[j][1]) | ((unsigned long long)pk2(y[j][2], y[j][3]) << 32);
            if (MODE == 2) mx = fmaxf(mx, fmaxf(fmaxf(fabsf(y[j][0]), fabsf(y[j][1])), fmaxf(fabsf(y[j][2]), fabsf(y[j][3]))));
            if (MODE == 1) {
#pragma unroll
                for (int h = 0; h < 8; ++h) {
                    typedef float f4v __attribute__((ext_vector_type(4)));
                    const f4v wv = *(const LAS f4v*)(ldsb + h * 16384 + 8448 + (256 * j + 4 * lane) * 4);
                    dacc[h] += y[j][0] * wv.x + y[j][1] * wv.y + y[j][2] * wv.z + y[j][3] * wv.w;
                }
            }
        }
        if (MODE == 1) {
#pragma unroll
            for (int h = 0; h < 8; ++h) dacc[h] = wave_sum(dacc[h]);
            if (lane == 0) { float4* dp = (float4*)(dtraw + (size_t)row * 8); dp[0] = make_float4(dacc[0], dacc[1], dacc[2], dacc[3]); dp[1] = make_float4(dacc[4], dacc[5], dacc[6], dacc[7]); }
        }
        if (MODE == 2) {
#pragma unroll
            for (int o = 1; o < 64; o <<= 1) mx = fmaxf(mx, __shfl_xor(mx, o));
            const float sc = mx > 0.f ? mx * (1.f / 127.f) : 1.f, inv = 1.f / sc;
            unsigned* dq = (unsigned*)(xq + (size_t)row * D) + lane;
#pragma unroll
            for (int j = 0; j < 4; ++j) { const int q0 = (int)rintf(y[j][0] * inv), q1 = (int)rintf(y[j][1] * inv), q2 = (int)rintf(y[j][2] * inv), q3 = (int)rintf(y[j][3] * inv);
                dq[64 * j] = (unsigned)(q0 & 255) | ((unsigned)(q1 & 255) << 8) | ((unsigned)(q2 & 255) << 16) | ((unsigned)(q3 & 255) << 24); }
            if (lane == 0) xs[row] = sc;
        }
    }
}

typedef short bf16x8 __attribute__((ext_vector_type(8)));
typedef short bf16x4 __attribute__((ext_vector_type(4)));
typedef float f32x16 __attribute__((ext_vector_type(16)));
typedef __bf16 bf2_t __attribute__((ext_vector_type(2)));
#define MFMA32(a, b, c) __builtin_amdgcn_mfma_f32_32x32x16_bf16((a), (b), (c), 0, 0, 0)
__device__ __forceinline__ unsigned pkbf(float lo, float hi) { bf2_t v = {(__bf16)lo, (__bf16)hi}; return __builtin_bit_cast(unsigned, v); }
__device__ __forceinline__ short bfs(float f) { return __builtin_bit_cast(short, (__bf16)f); }
__device__ __forceinline__ float sbf2f(short v) { return __uint_as_float(((unsigned)(unsigned short)v) << 16); }
__device__ __forceinline__ int crow(int i, int hi) { return (i & 3) + 8 * (i >> 2) + 4 * hi; }
template <int S> __device__ __forceinline__ bf16x8 pack8(const f32x16& x) {
    v4u p; p.x = pkbf(x[8 * S], x[8 * S + 1]); p.y = pkbf(x[8 * S + 2], x[8 * S + 3]); p.z = pkbf(x[8 * S + 4], x[8 * S + 5]); p.w = pkbf(x[8 * S + 6], x[8 * S + 7]);
    return __builtin_bit_cast(bf16x8, p);
}
__device__ __forceinline__ bf16x8 ldg8(const bf16* p) { return *(const bf16x8*)p; }
__device__ __forceinline__ bf16x8 lds8(const LAS bf16* p) { return *(const LAS bf16x8*)p; }
__device__ __forceinline__ bf16x8 lds4x2(const LAS bf16* p) { const bf16x4 a = *(const LAS bf16x4*)p, b = *(const LAS bf16x4*)(p + 8); return __builtin_shufflevector(a, b, 0, 1, 2, 3, 4, 5, 6, 7); }
__device__ __forceinline__ f32x16 zero16() { f32x16 z;
#pragma unroll
    for (int i = 0; i < 16; ++i) z[i] = 0.f;
    return z; }

__device__ __forceinline__ void attn_unit(const float* sinks, const float* gnorm, LAS unsigned char* ldsb, int unit, const bf16* PROJ, bf16* MIXB, int tid, int lane, int wave) {
    asm volatile("" : "+v"(tid), "+v"(lane));
    const int tok0 = unit * 64, s0 = tok0 & (SEQ - 1), kbase = tok0 - 128;
    LAS bf16* VT = (LAS bf16*)ldsb;
    LAS bf16* KI = (LAS bf16*)(ldsb + 51200);
    LAS float* SSQ = (LAS float*)(ldsb + 51200 + 55296);
    const __amdgpu_buffer_rsrc_t rsP = __builtin_amdgcn_make_buffer_rsrc((void*)PROJ, 0, (unsigned)T * PS * 2u, 0x00020000);
#pragma unroll
    for (int i = 0; i < 6; ++i) {
        const int c = tid + 512 * i, kv = c / 1536, cc = c - kv * 1536, key = cc >> 3, d0 = (cc & 7) * 8; const bool valid = (s0 - 128 + key) >= 0;
        bf16x8 v, k;
#pragma unroll
        for (int e = 0; e < 8; ++e) { v[e] = 0; k[e] = 0; }
        if (valid) { const unsigned ro = (unsigned)(kbase + key) * (unsigned)PS + (unsigned)(kv * 64 + d0);
            v = __builtin_bit_cast(bf16x8, __builtin_amdgcn_raw_buffer_load_b128(rsP, (int)((ro + (unsigned)OV) * 2u), 0, 2));
            k = __builtin_bit_cast(bf16x8, __builtin_amdgcn_raw_buffer_load_b128(rsP, (int)((ro + (unsigned)OKK) * 2u), 0, 2)); }
#pragma unroll
        for (int e = 0; e < 8; ++e) VT[kv * 12800 + (d0 + e) * 200 + key] = (bf16)v[e];
        *(LAS bf16x8*)(KI + (kv * 192 + key) * 72 + d0) = k;
    }
    __syncthreads();
    const int r = lane & 31, hi = lane >> 5;
    const int hq = wave, hkv = wave >> 2;
    const float slope = exp2f(-(float)(hq + 1)), sink = sinks[hq];
#pragma unroll 1
    for (int qt = 0; qt < 2; ++qt) {
        const int tq = tok0 + 32 * qt + r;
        bf16x8 qf[4];
        { const bf16* qp = PROJ + (size_t)tq * PS + OQ + hq * 64 + 8 * hi; asm volatile("" : "+v"(qp));
#pragma unroll
          for (int ks = 0; ks < 4; ++ks) qf[ks] = ldg8(qp + 16 * ks); }
        const int ql = 32 * qt + r;
        float m = sink, lh = 0.f;
        f32x16 O0 = zero16(), O1 = zero16();
#pragma unroll 1
        for (int kt = 0; kt < 5; ++kt) {
            const LAS bf16* kp = KI + (hkv * 192 + 32 * (qt + kt) + r) * 72 + 8 * hi;
            f32x16 X = zero16();
#pragma unroll
            for (int ks = 0; ks < 4; ++ks) X = MFMA32(lds8(kp + 16 * ks), qf[ks], X);
            float tm = -1e30f;
#pragma unroll
            for (int i = 0; i < 16; ++i) {
                const int kl = 32 * (qt + kt) + crow(i, hi), dist = 128 + ql - kl;
                const bool valid = (dist >= 0) && (dist < 128) && ((s0 - 128 + kl) >= 0);
                const float lg = valid ? (X[i] * 0.125f - slope * (float)dist) : -1e30f;
                X[i] = lg; tm = fmaxf(tm, lg);
            }
            tm = fmaxf(tm, __shfl_xor(tm, 32));
            const float mn = fmaxf(m, tm), sc = __expf(m - mn);
            m = mn; lh *= sc;
#pragma unroll
            for (int i = 0; i < 16; ++i) { O0[i] *= sc; O1[i] *= sc; const float pe = __expf(X[i] - mn); X[i] = pe; lh += pe; }
            const LAS bf16* vp = VT + hkv * 12800 + r * 200 + 32 * (qt + kt) + 4 * hi;
            { const bf16x8 xs = pack8<0>(X); const bf16x8 a0 = lds4x2(vp), a1 = lds4x2(vp + 32 * 200); O0 = MFMA32(a0, xs, O0); O1 = MFMA32(a1, xs, O1); }
            { const bf16x8 xs = pack8<1>(X); const bf16x8 a0 = lds4x2(vp + 16), a1 = lds4x2(vp + 32 * 200 + 16); O0 = MFMA32(a0, xs, O0); O1 = MFMA32(a1, xs, O1); }
        }
        const float lsum = lh + __shfl_xor(lh, 32) + __expf(sink - m);
        const float iv = 1.f / lsum;
        float sq = 0.f;
#pragma unroll
        for (int i = 0; i < 16; ++i) sq += O0[i] * O0[i] + O1[i] * O1[i];
        sq *= iv * iv; sq += __shfl_xor(sq, 32);
        if (hi == 0) SSQ[hq * 32 + r] = sq;
        __syncthreads();
        float tot = 0.f;
#pragma unroll
        for (int h = 0; h < 8; ++h) tot += SSQ[h * 32 + r];
        const float sc = iv * rsqrtf(tot * (1.f / 512.f) + EPS);
        bf16* orow = MIXB + (size_t)tq * D + hq * 64 + 4 * hi;
#pragma unroll
        for (int q4 = 0; q4 < 4; ++q4) {
            const float4 g0 = *(const float4*)(gnorm + hq * 64 + 8 * q4 + 4 * hi), g1 = *(const float4*)(gnorm + hq * 64 + 32 + 8 * q4 + 4 * hi);
            uint2 w0, w1;
            w0.x = pkbf(O0[4 * q4] * sc * g0.x, O0[4 * q4 + 1] * sc * g0.y); w0.y = pkbf(O0[4 * q4 + 2] * sc * g0.z, O0[4 * q4 + 3] * sc * g0.w);
            w1.x = pkbf(O1[4 * q4] * sc * g1.x, O1[4 * q4 + 1] * sc * g1.y); w1.y = pkbf(O1[4 * q4 + 2] * sc * g1.z, O1[4 * q4 + 3] * sc * g1.w);
            *(uint2*)(orow + 8 * q4) = w0; *(uint2*)(orow + 32 + 8 * q4) = w1;
        }
        __syncthreads();
    }
}

__device__ __forceinline__ void ssd_chunk_unit(LAS unsigned char* ldsb, int unit, const bf16* PROJ, bf16* XACT, const float* DTRAW, const float* conv_w, const float* conv_b, const float* dt_bias, const float* a_log,
                                               float* ACS, float* CDEC, bf16* YD, bf16* STATES, int tid, int lane, int wave) {
    asm volatile("" : "+v"(tid), "+v"(lane));
    const int g = unit & 1, bc = unit >> 1, tok0 = bc * 128;
    LAS float* DTT = (LAS float*)(ldsb + 34816 * 3 + 2048);
    LAS float* WT = (LAS float*)(ldsb + 34816 * 3 + 4096);
    {
        const int cgi = tid & 63, t0 = tok0 + 16 * (tid >> 6);
        const int c0 = cgi < 32 ? g * 256 + cgi * 8 : (cgi < 48 ? 512 + g * 128 + (cgi - 32) * 8 : 768 + g * 128 + (cgi - 48) * 8);
        float w[4][8], bs[8];
#pragma unroll
        for (int k = 0; k < 4; ++k) { const float4 a0 = *(const float4*)(conv_w + k * 1024 + c0), a1 = *(const float4*)(conv_w + k * 1024 + c0 + 4);
            w[k][0] = a0.x; w[k][1] = a0.y; w[k][2] = a0.z; w[k][3] = a0.w; w[k][4] = a1.x; w[k][5] = a1.y; w[k][6] = a1.z; w[k][7] = a1.w; }
        { const float4 a0 = *(const float4*)(conv_b + c0), a1 = *(const float4*)(conv_b + c0 + 4); bs[0] = a0.x; bs[1] = a0.y; bs[2] = a0.z; bs[3] = a0.w; bs[4] = a1.x; bs[5] = a1.y; bs[6] = a1.z; bs[7] = a1.w; }
        const bool has_halo = (t0 & (SEQ - 1)) != 0;
        bf16x8 rows[19];
#pragma unroll
        for (int i = 0; i < 19; ++i) {
            if (i < 3 && !has_halo) {
#pragma unroll
                for (int e = 0; e < 8; ++e) rows[i][e] = 0;
            } else rows[i] = __builtin_nontemporal_load((const bf16x8*)(PROJ + (size_t)(t0 + i - 3) * PS + OXBC + c0));
        }
#pragma unroll
        for (int i = 0; i < 16; ++i) {
            float o[8];
#pragma unroll
            for (int e = 0; e < 8; ++e) o[e] = silu_f(bs[e] + w[0][e] * sbf2f(rows[i][e]) + w[1][e] * sbf2f(rows[i + 1][e]) + w[2][e] * sbf2f(rows[i + 2][e]) + w[3][e] * sbf2f(rows[i + 3][e]));
            v4u ov; ov.x = pkbf(o[0], o[1]); ov.y = pkbf(o[2], o[3]); ov.z = pkbf(o[4], o[5]); ov.w = pkbf(o[6], o[7]);
            *(v4u*)(XACT + (size_t)(t0 + i) * 1024 + c0) = ov;
        }
    }
    LAS float* ACST = (LAS float*)(ldsb + 34816 * 3);
    {
        const int s = tid >> 2, hh = tid & 3, H = g * 4 + hh;
        const float A = -__expf(a_log[H]);
        const float raw = DTRAW[(size_t)(tok0 + s) * 8 + H] + dt_bias[H];
        const float dtv = fmaxf(raw, 0.f) + log1pf(__expf(-fabsf(raw)));
        float v = dtv * A;
#pragma unroll
        for (int o = 4; o < 64; o <<= 1) { const float y = __shfl_up(v, o); if (lane >= o) v += y; }
        if (lane >= 60) WT[wave * 4 + hh] = v;
        __syncthreads();
        float off = 0.f;
        for (int w2 = 0; w2 < wave; ++w2) off += WT[w2 * 4 + hh];
        v += off;
        DTT[tid] = dtv; ACST[tid] = v; ACS[(size_t)(tok0 + s) * 8 + H] = v;
        if (s == 127) CDEC[bc * 8 + H] = __expf(v);
    }
    asm volatile("s_waitcnt vmcnt(0)" ::: "memory");
    __syncthreads();
    LAS bf16* BT = (LAS bf16*)ldsb;
    LAS bf16* XD = (LAS bf16*)(ldsb + 34816);
    LAS bf16* XW = (LAS bf16*)(ldsb + 34816 + 34816);
    const int r = lane & 31, hi = lane >> 5;
#pragma unroll
    for (int i = 0; i < 4; ++i) {
        const int c = tid + 512 * i, s = c >> 4, n0 = (c & 15) * 8;
        const bf16x8 v = ldg8(XACT + (size_t)(tok0 + s) * 1024 + 512 + g * 128 + n0);
#pragma unroll
        for (int e = 0; e < 8; ++e) BT[(n0 + e) * 136 + s] = (bf16)v[e];
    }
#pragma unroll 1
    for (int hp = 0; hp < 2; ++hp) {
        if (hp) __syncthreads();
        int tidp = tid; asm volatile("" : "+v"(tidp));
#pragma unroll
        for (int i = 0; i < 4; ++i) {
            const int c = tidp + 512 * i, hsel = c >> 10, s = (c >> 3) & 127, p0 = (c & 7) * 8, H = g * 4 + 2 * hp + hsel;
            const bf16x8 v = ldg8(XACT + (size_t)(tok0 + s) * 1024 + H * 64 + p0);
            const float dtv = DTT[s * 4 + 2 * hp + hsel];
            const float w = __expf(ACST[127 * 4 + 2 * hp + hsel] - ACST[s * 4 + 2 * hp + hsel]);
#pragma unroll
            for (int e = 0; e < 8; ++e) { const float xd = sbf2f(v[e]) * dtv; XD[hsel * 8704 + (p0 + e) * 136 + s] = (bf16)bfs(xd); XW[hsel * 8704 + (p0 + e) * 136 + s] = (bf16)bfs(xd * w); }
        }
        __syncthreads();
        {
            const int lt = wave & 3, hsel = wave >> 2, hh = 2 * hp + hsel, H = g * 4 + hh;
            const int l = 32 * lt + r; const float acs_l = ACST[l * 4 + hh];
            bf16x8 cf[8];
            { const bf16* cp = XACT + (size_t)(tok0 + l) * 1024 + 768 + g * 128 + 8 * hi; asm volatile("" : "+v"(cp));
#pragma unroll
              for (int ks = 0; ks < 8; ++ks) cf[ks] = ldg8(cp + 16 * ks); }
            f32x16 Z0 = zero16(), Z1 = zero16();
            bf16x8 bn[8];
            { const bf16* bp = XACT + (size_t)(tok0 + r) * 1024 + 512 + g * 128 + 8 * hi; asm volatile("" : "+v"(bp));
#pragma unroll
              for (int ks = 0; ks < 8; ++ks) bn[ks] = ldg8(bp + 16 * ks); }
#pragma unroll 1
            for (int st = 0; st <= lt; ++st) {
                f32x16 X = zero16();
                bf16x8 bc[8];
#pragma unroll
                for (int ks = 0; ks < 8; ++ks) bc[ks] = bn[ks];
                { const int stn = st < lt ? st + 1 : lt; const bf16* bp = XACT + (size_t)(tok0 + 32 * stn + r) * 1024 + 512 + g * 128 + 8 * hi; asm volatile("" : "+v"(bp));
#pragma unroll
                  for (int ks = 0; ks < 8; ++ks) bn[ks] = ldg8(bp + 16 * ks); }
#pragma unroll
                for (int ks = 0; ks < 8; ++ks) X = MFMA32(bc[ks], cf[ks], X);
#pragma unroll
                for (int i = 0; i < 16; ++i) { const int s = 32 * st + crow(i, hi); const float f = (s <= l) ? __expf(acs_l - ACST[s * 4 + hh]) : 0.f; X[i] *= f; }
                const int sb = 32 * st + 4 * hi;
                { const bf16x8 xs = pack8<0>(X); const bf16x8 b0 = lds4x2(XD + hsel * 8704 + r * 136 + sb), b1 = lds4x2(XD + hsel * 8704 + (32 + r) * 136 + sb); Z0 = MFMA32(xs, b0, Z0); Z1 = MFMA32(xs, b1, Z1); }
                { const bf16x8 xs = pack8<1>(X); const bf16x8 b0 = lds4x2(XD + hsel * 8704 + r * 136 + sb + 16), b1 = lds4x2(XD + hsel * 8704 + (32 + r) * 136 + sb + 16); Z0 = MFMA32(xs, b0, Z0); Z1 = MFMA32(xs, b1, Z1); }
            }
#pragma unroll
            for (int i = 0; i < 16; ++i) { bf16* o = YD + (size_t)(tok0 + 32 * lt + crow(i, hi)) * 512 + H * 64 + r; o[0] = f2bf(Z0[i]); o[32] = f2bf(Z1[i]); }
        }
        {
            const int nt = wave & 3, hsel = wave >> 2, H = g * 4 + 2 * hp + hsel;
            f32x16 S0 = zero16(), S1 = zero16();
#pragma unroll
            for (int ks = 0; ks < 8; ++ks) {
                const bf16x8 btf = lds8(BT + (32 * nt + r) * 136 + 16 * ks + 8 * hi);
                const bf16x8 a0 = lds8(XW + hsel * 8704 + r * 136 + 16 * ks + 8 * hi), a1 = lds8(XW + hsel * 8704 + (32 + r) * 136 + 16 * ks + 8 * hi);
                S0 = MFMA32(a0, btf, S0); S1 = MFMA32(a1, btf, S1);
            }
            bf16* sp = STATES + (size_t)(bc * 8 + H) * 8192 + 32 * nt + r;
#pragma unroll
            for (int i = 0; i < 16; ++i) { const int p = crow(i, hi); sp[p * 128] = f2bf(S0[i]); sp[(32 + p) * 128] = f2bf(S1[i]); }
        }
    }
    __syncthreads();
}

__device__ __forceinline__ __amdgpu_buffer_rsrc_t mk_rsrc(const void* p, unsigned bytes) { return __builtin_amdgcn_make_buffer_rsrc((void*)p, 0, bytes, 0x00020000); }
__device__ __forceinline__ void yoff_unit(const float* d_skip, const float* gnorm, LAS unsigned char* ldsb, int unit, const bf16* XACT, const bf16* PROJ, const float* ACS, const bf16* PREVT,
                                          const bf16* YD, bf16* MIXB, int lane, int wave) {
    const int g = unit & 1, bc = unit >> 1, tok0 = bc * 128;
    const int r = lane & 31, hi = lane >> 5, lt = wave & 3, hpair = wave >> 2;
    LAS float* TAB = (LAS float*)ldsb;
    const __amdgpu_buffer_rsrc_t rsF = mk_rsrc(YD, (unsigned)T * 512u * 2u), rsX = mk_rsrc(XACT, (unsigned)T * 1024u * 2u), rsP = mk_rsrc(PROJ, (unsigned)T * PS * 2u), rsA = mk_rsrc(ACS, (unsigned)T * 32u), rsB = mk_rsrc(MIXB, (unsigned)T * D * 2u);
    const unsigned tb = (unsigned)(tok0 + 32 * lt + 4 * hi);
    bf16x8 cf[8];
    { const bf16* cp = XACT + (size_t)(tok0 + 32 * lt + r) * 1024 + 768 + g * 128 + 8 * hi; asm volatile("" : "+v"(cp));
#pragma unroll
      for (int ks = 0; ks < 8; ++ks) cf[ks] = ldg8(cp + 16 * ks); }
    float eav[16], ssq[16];
    unsigned ypk[2][2][8];
#pragma unroll
    for (int i = 0; i < 16; ++i) ssq[i] = 0.f;
#pragma unroll
    for (int hsel = 0; hsel < 2; ++hsel) {
        const int H = g * 4 + 2 * hpair + hsel; const bf16* pv = PREVT + (size_t)(bc * 8 + H) * 8192 + 8 * hi;
        asm volatile("" : "+v"(pv));
        f32x16 Y0 = zero16(), Y1 = zero16();
#pragma unroll
        for (int ks = 0; ks < 8; ++ks) {
            const bf16x8 b0 = ldg8(pv + r * 128 + 16 * ks), b1 = ldg8(pv + (32 + r) * 128 + 16 * ks);
            Y0 = MFMA32(cf[ks], b0, Y0); Y1 = MFMA32(cf[ks], b1, Y1);
        }
        const float dsk = d_skip[H];
        { const unsigned vo = (tb * 8u + (unsigned)H) * 4u;
#pragma unroll
          for (int i = 0; i < 16; ++i) eav[i] = __expf(__builtin_bit_cast(float, __builtin_amdgcn_raw_buffer_load_b32(rsA, (int)vo, ((i & 3) + 8 * (i >> 2)) * 32, 0))); }
#pragma unroll
        for (int pt = 0; pt < 2; ++pt) {
            const unsigned col = (unsigned)(H * 64 + 32 * pt + r);
            const unsigned voF = (tb * 512u + col) * 2u, voX = (tb * 1024u + col) * 2u, voP = (tb * (unsigned)PS + (unsigned)OZ + col) * 2u;
            float yo[16], xsv[16], zv[16];
#pragma unroll
            for (int i = 0; i < 16; ++i) { const int ro = (i & 3) + 8 * (i >> 2);
                yo[i] = bf2f((bf16)__builtin_amdgcn_raw_buffer_load_b16(rsF, (int)voF, ro * 1024, 0));
                xsv[i] = bf2f((bf16)__builtin_amdgcn_raw_buffer_load_b16(rsX, (int)voX, ro * 2048, 0));
                zv[i] = bf2f((bf16)__builtin_amdgcn_raw_buffer_load_b16(rsP, (int)voP, ro * (PS * 2), 0)); }
#pragma unroll
            for (int i = 0; i < 16; i += 2) {
                const float y0 = (yo[i] + eav[i] * (pt ? Y1[i] : Y0[i]) + dsk * xsv[i]) * silu_f(zv[i]);
                const float y1 = (yo[i + 1] + eav[i + 1] * (pt ? Y1[i + 1] : Y0[i + 1]) + dsk * xsv[i + 1]) * silu_f(zv[i + 1]);
                ssq[i] += y0 * y0; ssq[i + 1] += y1 * y1; ypk[hsel][pt][i >> 1] = pkbf(y0, y1);
            }
            __builtin_amdgcn_sched_barrier(0);
        }
    }
#pragma unroll
    for (int i = 0; i < 16; ++i) {
#pragma unroll
        for (int o = 1; o < 32; o <<= 1) ssq[i] += __shfl_xor(ssq[i], o);
    }
    if (r == 0) {
#pragma unroll
        for (int i = 0; i < 16; ++i) TAB[hpair * 128 + 32 * lt + crow(i, hi)] = ssq[i];
    }
    __syncthreads();
#pragma unroll
    for (int i = 0; i < 16; ++i) { const int l = 32 * lt + crow(i, hi); ssq[i] = rsqrtf((TAB[l] + TAB[128 + l]) * (1.f / 256.f) + EPS); }
#pragma unroll
    for (int hsel = 0; hsel < 2; ++hsel)
#pragma unroll
        for (int pt = 0; pt < 2; ++pt) {
            const unsigned col = (unsigned)((g * 4 + 2 * hpair + hsel) * 64 + 32 * pt + r); const float gn = gnorm[col];
            const unsigned voB = (tb * 1024u + 512u + col) * 2u;
#pragma unroll
            for (int i = 0; i < 16; ++i) { const unsigned w = ypk[hsel][pt][i >> 1];
                const float yf = (i & 1) ? __uint_as_float(w & 0xffff0000u) : __uint_as_float(w << 16);
                __builtin_amdgcn_raw_buffer_store_b16((short)f2bf(yf * ssq[i] * gn), rsB, (int)voB, ((i & 3) + 8 * (i >> 2)) * 2048, 0); }
        }
    __syncthreads();
}
typedef float f32x2 __attribute__((ext_vector_type(2)));
__device__ __forceinline__ void fp8x16_to_f32(const uint4 w, float (&f)[16]) {
    const int ww[4] = {(int)w.x, (int)w.y, (int)w.z, (int)w.w};
#pragma unroll
    for (int q = 0; q < 4; ++q) { const f32x2 a = __builtin_amdgcn_cvt_pk_f32_fp8(ww[q], false), b = __builtin_amdgcn_cvt_pk_f32_fp8(ww[q], true); f[4 * q] = a.x; f[4 * q + 1] = a.y; f[4 * q + 2] = b.x; f[4 * q + 3] = b.y; }
}
template <int M4, int M2, int M1> __device__ __forceinline__ void treduce16(const float (&a)[16], int lane, float& r0, float& r1) {
    float b[8], c[4];
    { const bool hi = (lane & M4) != 0;
#pragma unroll
      for (int i = 0; i < 8; ++i) { const float send = hi ? a[i] : a[i + 8]; const float recv = __shfl_xor(send, M4); b[i] = (hi ? a[i + 8] : a[i]) + recv; } }
    { const bool hi = (lane & M2) != 0;
#pragma unroll
      for (int i = 0; i < 4; ++i) { const float send = hi ? b[i] : b[i + 4]; const float recv = __shfl_xor(send, M2); c[i] = (hi ? b[i + 4] : b[i]) + recv; } }
    { const bool hi = (lane & M1) != 0;
      { const float send = hi ? c[0] : c[2]; const float recv = __shfl_xor(send, M1); r0 = (hi ? c[2] : c[0]) + recv; }
      { const float send = hi ? c[1] : c[3]; const float recv = __shfl_xor(send, M1); r1 = (hi ? c[3] : c[1]) + recv; } }
}
template <int M4, int M2, int M1> __device__ __forceinline__ void treduce16i(const int (&a)[16], int lane, int& r0, int& r1) {
    int b[8], c[4];
    { const bool hi = (lane & M4) != 0;
#pragma unroll
      for (int i = 0; i < 8; ++i) { const int send = hi ? a[i] : a[i + 8]; const int recv = __shfl_xor(send, M4); b[i] = (hi ? a[i + 8] : a[i]) + recv; } }
    { const bool hi = (lane & M2) != 0;
#pragma unroll
      for (int i = 0; i < 4; ++i) { const int send = hi ? b[i] : b[i + 4]; const int recv = __shfl_xor(send, M2); c[i] = (hi ? b[i + 4] : b[i]) + recv; } }
    { const bool hi = (lane & M1) != 0;
      { const int send = hi ? c[0] : c[2]; const int recv = __shfl_xor(send, M1); r0 = (hi ? c[2] : c[0]) + recv; }
      { const int send = hi ? c[1] : c[3]; const int recv = __shfl_xor(send, M1); r1 = (hi ? c[3] : c[1]) + recv; } }
}
__device__ __forceinline__ void treduce16i_hw(const int (&a)[16], int lane, int& r0, int& r1) {
    int b[8], c[4];
#pragma unroll
    for (int i = 0; i < 8; ++i) { const auto r = __builtin_amdgcn_permlane32_swap((unsigned)a[i], (unsigned)a[i + 8], false, false); b[i] = (int)r[0] + (int)r[1]; }
#pragma unroll
    for (int i = 0; i < 4; ++i) { const auto r = __builtin_amdgcn_permlane16_swap((unsigned)b[i], (unsigned)b[i + 4], false, false); c[i] = (int)r[0] + (int)r[1]; }
    const bool hi = (lane & 8) != 0;
    { const int send = hi ? c[0] : c[2]; r0 = (hi ? c[2] : c[0]) + __builtin_amdgcn_update_dpp(0, send, 0x128, 0xf, 0xf, false); }
    { const int send = hi ? c[1] : c[3]; r1 = (hi ? c[3] : c[1]) + __builtin_amdgcn_update_dpp(0, send, 0x128, 0xf, 0xf, false); }
}
#define PE_ID(E, i) (((i) & 1) ? (E[(i) >> 1] >> 16) : (E[(i) >> 1] & 0xffffu))
__device__ __forceinline__ void peer_u_item(int p, int j, const LAS unsigned short* EL  , const unsigned char* __restrict__ XQ, const unsigned char* __restrict__ U8, LAS int* ACC  , int lane, int wave) {
    asm volatile("" : "+v"(lane));
    const int gidx = lane >> 3; const unsigned coff = (unsigned)(p * 128 + (lane & 7) * 16);
#pragma unroll 1
    for (int it = 0; it < 8; ++it) {
        const int t = j * 64 + it * 8 + wave;
        unsigned E[8];
        { const LAS v4u* ep = (const LAS v4u*)(EL + (it * 8 + wave) * 128 + 16 * gidx); const v4u e0 = ep[0], e1 = ep[1];
          E[0] = e0.x; E[1] = e0.y; E[2] = e0.z; E[3] = e0.w; E[4] = e1.x; E[5] = e1.y; E[6] = e1.z; E[7] = e1.w; }
        uint4 uu[16];
#pragma unroll
        for (int i = 0; i < 16; ++i) uu[i] = *(const uint4*)(U8 + (size_t)(PE_ID(E, i) * 1024u + coff));
        const uint4 xq = *(const uint4*)(XQ + (size_t)t * D + coff);
        int d[16];
#pragma unroll
        for (int i = 0; i < 16; ++i) {
            int s = __builtin_amdgcn_sdot4((int)uu[i].x, (int)xq.x, 0, false); s = __builtin_amdgcn_sdot4((int)uu[i].y, (int)xq.y, s, false);
            s = __builtin_amdgcn_sdot4((int)uu[i].z, (int)xq.z, s, false); s = __builtin_amdgcn_sdot4((int)uu[i].w, (int)xq.w, s, false);
            d[i] = s;
        }
        int r0, r1; treduce16i<4, 2, 1>(d, lane, r0, r1);
        { typedef int i2v __attribute__((ext_vector_type(2))); LAS i2v* ap = (LAS i2v*)(ACC + (it * 8 + wave) * 128 + 2 * lane);
          i2v a2; if (p == 0) { a2.x = r0; a2.y = r1; } else { a2 = *ap; a2.x += r0; a2.y += r1; } *ap = a2; }
    }
}
__device__ __forceinline__ void peer_v_item(int p, int j, const LAS unsigned short* EL, const LAS unsigned char* AL  , const LAS float* ASC  ,
                                            const unsigned char* __restrict__ V8, bf16* __restrict__ PEERO, int lane, int wave) {
    asm volatile("" : "+v"(lane));
    const __amdgpu_buffer_rsrc_t rsV = __builtin_amdgcn_make_buffer_rsrc((void*)V8, 0, 16384 * 1024, 0x00020000);
    const int gidx = lane >> 3; const unsigned coff = (unsigned)(p * 128 + (lane & 7) * 16);
#pragma unroll 1
    for (int it = 0; it < 8; ++it) {
        const int t = j * 64 + it * 8 + wave;
        unsigned E[8];
        { const LAS v4u* ep = (const LAS v4u*)(EL + (it * 8 + wave) * 128 + 16 * gidx); const v4u e0 = ep[0], e1 = ep[1];
          E[0] = e0.x; E[1] = e0.y; E[2] = e0.z; E[3] = e0.w; E[4] = e1.x; E[5] = e1.y; E[6] = e1.z; E[7] = e1.w; }
        uint4 vv[16];
#pragma unroll
        for (int i = 0; i < 16; ++i) { const v4u w_ = __builtin_amdgcn_raw_buffer_load_b128(rsV, (int)((PE_ID(E, i) << 10) + coff), 0, 0); vv[i] = make_uint4(w_.x, w_.y, w_.z, w_.w); }
        const v4u aq = *(const LAS v4u*)(AL + (it * 8 + wave) * 128 + 16 * gidx);
        const float asc = ASC[it * 8 + wave];
        const unsigned a4[4] = {aq.x, aq.y, aq.z, aq.w};
        int acc[16];
#pragma unroll
        for (int c = 0; c < 16; ++c) acc[c] = 0;
#pragma unroll
        for (int m = 0; m < 4; ++m) {
            const unsigned r0[4] = {vv[4 * m].x, vv[4 * m].y, vv[4 * m].z, vv[4 * m].w}, r1[4] = {vv[4 * m + 1].x, vv[4 * m + 1].y, vv[4 * m + 1].z, vv[4 * m + 1].w};
            const unsigned r2[4] = {vv[4 * m + 2].x, vv[4 * m + 2].y, vv[4 * m + 2].z, vv[4 * m + 2].w}, r3[4] = {vv[4 * m + 3].x, vv[4 * m + 3].y, vv[4 * m + 3].z, vv[4 * m + 3].w};
#pragma unroll
            for (int dc = 0; dc < 4; ++dc) {
                const unsigned ta = __builtin_amdgcn_perm(r1[dc], r0[dc], 0x05010400u), tb = __builtin_amdgcn_perm(r3[dc], r2[dc], 0x05010400u);
                const unsigned ua = __builtin_amdgcn_perm(r1[dc], r0[dc], 0x07030602u), ub = __builtin_amdgcn_perm(r3[dc], r2[dc], 0x07030602u);
                const unsigned c0 = __builtin_amdgcn_perm(tb, ta, 0x05040100u), c1 = __builtin_amdgcn_perm(tb, ta, 0x07060302u);
                const unsigned c2 = __builtin_amdgcn_perm(ub, ua, 0x05040100u), c3 = __builtin_amdgcn_perm(ub, ua, 0x07060302u);
                acc[4 * dc + 0] = __builtin_amdgcn_sdot4((int)c0, (int)a4[m], acc[4 * dc + 0], false);
                acc[4 * dc + 1] = __builtin_amdgcn_sdot4((int)c1, (int)a4[m], acc[4 * dc + 1], false);
                acc[4 * dc + 2] = __builtin_amdgcn_sdot4((int)c2, (int)a4[m], acc[4 * dc + 2], false);
                acc[4 * dc + 3] = __builtin_amdgcn_sdot4((int)c3, (int)a4[m], acc[4 * dc + 3], false);
            }
        }
        int r0i, r1i; treduce16i_hw(acc, lane, r0i, r1i);
        *(unsigned*)(PEERO + (size_t)t * D + coff + 2 * gidx) = pkbf(asc * (float)r0i, asc * (float)r1i);
    }
}

__device__ __forceinline__ void ce_desc(float& a, float& b) { const float hi = fmaxf(a, b), lo = fminf(a, b); a = hi; b = lo; }
__device__ __forceinline__ void sort16_desc(float (&v)[16]) {
#pragma unroll
    for (int k = 2; k <= 16; k <<= 1)
#pragma unroll
        for (int j = k >> 1; j > 0; j >>= 1)
#pragma unroll
            for (int i = 0; i < 16; ++i) { const int l = i ^ j; if (l > i) { if ((i & k) == 0) ce_desc(v[i], v[l]); else ce_desc(v[l], v[i]); } }
}
__device__ __forceinline__ void merge16_desc(float (&a)[16], const float (&b)[16]) {
#pragma unroll
    for (int i = 0; i < 16; ++i) a[i] = fmaxf(a[i], b[15 - i]);
#pragma unroll
    for (int j = 8; j > 0; j >>= 1)
#pragma unroll
        for (int i = 0; i < 16; ++i) { const int l = i ^ j; if (l > i) ce_desc(a[i], a[l]); }
}
__device__ __forceinline__ void ce_kv(float& ka, int& va, float& kb, int& vb) {
    const bool s = kb > ka; const float t0 = s ? kb : ka, t1 = s ? ka : kb; const int u0 = s ? vb : va, u1 = s ? va : vb; ka = t0; kb = t1; va = u0; vb = u1; }
__device__ __forceinline__ void sort16_kv(float (&k)[16], int (&v)[16]) {
#pragma unroll
    for (int kk = 2; kk <= 16; kk <<= 1)
#pragma unroll
        for (int j = kk >> 1; j > 0; j >>= 1)
#pragma unroll
            for (int i = 0; i < 16; ++i) { const int l = i ^ j; if (l > i) { if ((i & kk) == 0) ce_kv(k[i], v[i], k[l], v[l]); else ce_kv(k[l], v[l], k[i], v[i]); } }
}
__device__ __forceinline__ void merge16_kv(float (&ka)[16], int (&va)[16], const float (&kb)[16], const int (&vb)[16]) {
#pragma unroll
    for (int i = 0; i < 16; ++i) { const bool s = kb[15 - i] > ka[i]; ka[i] = s ? kb[15 - i] : ka[i]; va[i] = s ? vb[15 - i] : va[i]; }
#pragma unroll
    for (int j = 8; j > 0; j >>= 1)
#pragma unroll
        for (int i = 0; i < 16; ++i) { const int l = i ^ j; if (l > i) ce_kv(ka[i], va[i], ka[l], va[l]); }
}
__device__ __forceinline__ void split8(const float* p, bf16x8& hi8, bf16x8& lo8) {
    const float4 f0 = *(const float4*)p, f1 = *(const float4*)(p + 4);
    const float x[8] = {f0.x, f0.y, f0.z, f0.w, f1.x, f1.y, f1.z, f1.w};
#pragma unroll
    for (int j = 0; j < 8; ++j) { const short h = bfs(x[j]); hi8[j] = h; lo8[j] = bfs(x[j] - sbf2f(h)); }
}
__device__ __forceinline__ void route_task(int task, int tl0, const float* QP, const LAS bf16* KHL, LAS unsigned short* EL, LAS float* GL, int lane) {
    const int r = lane & 31, hi = lane >> 5, t = 4 * task + (r >> 3), head = r & 7;
    float top[2][16];
#pragma unroll
    for (int half = 0; half < 2; ++half) {
        bf16x8 qh[4], ql[4];
        { const float* qp = QP + (size_t)t * D + head * 128 + half * 64 + 8 * hi; asm volatile("" : "+v"(qp));
#pragma unroll
          for (int ks = 0; ks < 4; ++ks) split8(qp + 16 * ks, qh[ks], ql[ks]); }
        float cur[16];
#pragma unroll
        for (int kt = 0; kt < 4; ++kt) {
            f32x16 X = zero16();
            const LAS bf16* khp = KHL + (half * 128 + 32 * kt + r) * 72 + 8 * hi;
#pragma unroll
            for (int ks = 0; ks < 4; ++ks) {
                const bf16x8 kh = lds8(khp + 16 * ks), kl = lds8(khp + 2 * 128 * 72 + 16 * ks);
                X = MFMA32(kh, qh[ks], X); X = MFMA32(kh, ql[ks], X); X = MFMA32(kl, qh[ks], X);
            }
            float grp[16];
#pragma unroll
            for (int i = 0; i < 16; ++i) { const unsigned key = (unsigned)(32 * kt + crow(i, hi)); grp[i] = __uint_as_float((__float_as_uint(X[i]) & ~127u) | (127u - key)); }
            sort16_desc(grp);
            if (kt == 0) {
#pragma unroll
                for (int i = 0; i < 16; ++i) cur[i] = grp[i];
            } else merge16_desc(cur, grp);
        }
        float oth[16];
#pragma unroll
        for (int i = 0; i < 16; ++i) oth[i] = __shfl_xor(cur[i], 32);
        merge16_desc(cur, oth);
#pragma unroll
        for (int i = 0; i < 16; ++i) top[half][i] = cur[i];
    }
    unsigned P1[4], P2[4];
#pragma unroll
    for (int q = 0; q < 4; ++q) { P1[q] = 0u; P2[q] = 0u;
#pragma unroll
        for (int s = 0; s < 4; ++s) { P1[q] |= (127u - (__float_as_uint(top[0][4 * q + s]) & 127u)) << (8 * s); P2[q] |= (127u - (__float_as_uint(top[1][4 * q + s]) & 127u)) << (8 * s); } }
#define CAND(a, b) __uint_as_float((__float_as_uint(top[0][a] + top[1][b]) & ~255u) | (255u - (unsigned)((a) * 16 + (b))))
    float bk[16];
    {
        float gk[16];
        gk[0] = CAND(0, 0);
        gk[1] = CAND(0, 1);
        gk[2] = CAND(0, 2);
        gk[3] = CAND(0, 3);
        gk[4] = CAND(0, 4);
        gk[5] = CAND(0, 5);
        gk[6] = CAND(0, 6);
        gk[7] = CAND(0, 7);
        gk[8] = CAND(0, 8);
        gk[9] = CAND(0, 9);
        gk[10] = CAND(0, 10);
        gk[11] = CAND(0, 11);
        gk[12] = CAND(0, 12);
        gk[13] = CAND(0, 13);
        gk[14] = CAND(0, 14);
        gk[15] = CAND(0, 15);
        sort16_desc(gk);
#pragma unroll
        for (int i = 0; i < 16; ++i) bk[i] = gk[i];
    }
    {
        float gk[16];
        gk[0] = CAND(1, 0);
        gk[1] = CAND(1, 1);
        gk[2] = CAND(1, 2);
        gk[3] = CAND(1, 3);
        gk[4] = CAND(1, 4);
        gk[5] = CAND(1, 5);
        gk[6] = CAND(1, 6);
        gk[7] = CAND(1, 7);
        gk[8] = CAND(2, 0);
        gk[9] = CAND(2, 1);
        gk[10] = CAND(2, 2);
        gk[11] = CAND(2, 3);
        gk[12] = CAND(2, 4);
        gk[13] = CAND(3, 0);
        gk[14] = CAND(3, 1);
        gk[15] = CAND(3, 2);
        sort16_desc(gk);
        merge16_desc(bk, gk);
    }
    {
        float gk[16];
        gk[0] = CAND(3, 3);
        gk[1] = CAND(4, 0);
        gk[2] = CAND(4, 1);
        gk[3] = CAND(4, 2);
        gk[4] = CAND(5, 0);
        gk[5] = CAND(5, 1);
        gk[6] = CAND(6, 0);
        gk[7] = CAND(6, 1);
        gk[8] = CAND(7, 0);
        gk[9] = CAND(7, 1);
        gk[10] = CAND(8, 0);
        gk[11] = CAND(9, 0);
        gk[12] = CAND(10, 0);
        gk[13] = CAND(11, 0);
        gk[14] = CAND(12, 0);
        gk[15] = CAND(13, 0);
        sort16_desc(gk);
        merge16_desc(bk, gk);
    }
    {
        float gk[16];
        gk[0] = CAND(14, 0);
        gk[1] = CAND(15, 0);
        gk[2] = -INFINITY;
        gk[3] = -INFINITY;
        gk[4] = -INFINITY;
        gk[5] = -INFINITY;
        gk[6] = -INFINITY;
        gk[7] = -INFINITY;
        gk[8] = -INFINITY;
        gk[9] = -INFINITY;
        gk[10] = -INFINITY;
        gk[11] = -INFINITY;
        gk[12] = -INFINITY;
        gk[13] = -INFINITY;
        gk[14] = -INFINITY;
        gk[15] = -INFINITY;
        sort16_desc(gk);
        merge16_desc(bk, gk);
    }
#undef CAND
    int bv[16];
#pragma unroll
    for (int i = 0; i < 16; ++i) {
        const unsigned cd = 255u - (__float_as_uint(bk[i]) & 255u), ca = cd >> 4, cb = cd & 15u;
        const unsigned wa = (ca >> 2) == 0u ? P1[0] : (ca >> 2) == 1u ? P1[1] : (ca >> 2) == 2u ? P1[2] : P1[3];
        const unsigned wb = (cb >> 2) == 0u ? P2[0] : (cb >> 2) == 1u ? P2[1] : (cb >> 2) == 2u ? P2[2] : P2[3];
        bv[i] = (int)((((wa >> (8u * (ca & 3u))) & 255u) << 7) | ((wb >> (8u * (cb & 3u))) & 255u));
    }
    float e[16], se = 0.f;
#pragma unroll
    for (int i = 0; i < 16; ++i) { e[i] = __expf(bk[i] - bk[0]); se += e[i]; }
    const float inv = 1.f / se;
    if (hi == 0) {
        LAS v4u* ip = (LAS v4u*)(EL + (tl0 + (r >> 3)) * 128 + head * 16); typedef float f4v __attribute__((ext_vector_type(4))); LAS f4v* gp = (LAS f4v*)(GL + (tl0 + (r >> 3)) * 128 + head * 16);
#pragma unroll
        for (int q = 0; q < 2; ++q) ip[q] = (v4u){(unsigned)bv[8 * q] | ((unsigned)bv[8 * q + 1] << 16), (unsigned)bv[8 * q + 2] | ((unsigned)bv[8 * q + 3] << 16), (unsigned)bv[8 * q + 4] | ((unsigned)bv[8 * q + 5] << 16), (unsigned)bv[8 * q + 6] | ((unsigned)bv[8 * q + 7] << 16)};
#pragma unroll
        for (int q = 0; q < 4; ++q) gp[q] = (f4v){e[4 * q] * inv, e[4 * q + 1] * inv, e[4 * q + 2] * inv, e[4 * q + 3] * inv};
    }
}

#define XB_TMO      128
#define XB_XCNT(j)  (256  + 64 * (j))
#define XB_XSUB(j)  (1280 + 64 * (j))
#define XB_XGEN(j)  (2304 + 64 * (j))
#define XB_TOP      3328
#define XB_TOPGEN   3392
#define XCD_BAR_WORDS 3456
#define XB_SPIN_CAP (1u << 22)
__device__ __forceinline__ unsigned xb_ld(unsigned* p)              { return __hip_atomic_load(p, __ATOMIC_RELAXED, __HIP_MEMORY_SCOPE_AGENT); }
__device__ __forceinline__ unsigned xb_add(unsigned* p, unsigned v) { return __hip_atomic_fetch_add(p, v, __ATOMIC_RELAXED, __HIP_MEMORY_SCOPE_AGENT); }
__device__ __forceinline__ unsigned xb_xcc_id() { return (unsigned)__builtin_amdgcn_s_getreg((3 << 11) | 20) & 0xFu; }
#define XB_SPIN(cond, bar) do { unsigned _sp = 0; while (cond) { __builtin_amdgcn_s_sleep(1); \
    if ((++_sp & 255u) == 0u) { if (xb_ld(&(bar)[XB_TMO])) break; if (_sp > XB_SPIN_CAP) { atomicAdd(&(bar)[XB_TMO], 1u); break; } } } } while (0)
struct XcdBarrier { unsigned* bar; unsigned x; volatile LAS unsigned* st; };
__device__ __forceinline__ XcdBarrier xcd_barrier_post(unsigned* bar, volatile LAS unsigned* st) {
    XcdBarrier b; b.bar = bar; b.x = xb_xcc_id(); b.st = st;
    if (threadIdx.x == 0) (void)xb_add(&bar[XB_XCNT(b.x)], 1u);
    return b;
}
__device__ __forceinline__ void xcd_barrier_complete(unsigned* bar, unsigned x, unsigned& nloc, unsigned& nx) {
    const unsigned G = gridDim.x * gridDim.y * gridDim.z;
    unsigned sum, cnt, mine, sp = 0u;
    for (;;) {
        sum = 0u; cnt = 0u; mine = 0u;
#pragma unroll
        for (unsigned j = 0; j < 16; ++j) { const unsigned c = xb_ld(&bar[XB_XCNT(j)]); sum += c; cnt += (c > 0u) ? 1u : 0u; mine = (j == x) ? c : mine; }
        if (sum == G) break;
        __builtin_amdgcn_s_sleep(1);
        if ((++sp & 255u) == 0u) { if (xb_ld(&bar[XB_TMO])) break; if (sp > XB_SPIN_CAP) { atomicAdd(&bar[XB_TMO], 1u); break; } }
    }
    nloc = mine > 0u ? mine : 1u; nx = cnt > 0u ? cnt : 1u;
}
__device__ __forceinline__ void xcd_barrier(const XcdBarrier& b) {
    asm volatile("s_waitcnt vmcnt(0)" ::: "memory");
    __syncthreads();
    if (threadIdx.x == 0) {
        unsigned* bar = b.bar;
        __builtin_amdgcn_s_waitcnt(0);
        unsigned nloc = b.st[0], nx = b.st[1];
        if (nloc == 0u) { xcd_barrier_complete(bar, b.x, nloc, nx); b.st[0] = nloc; b.st[1] = nx; }
        const unsigned old = xb_add(&bar[XB_XSUB(b.x)], 1u);
        const unsigned gen = old / nloc;
        if (old + 1u == (gen + 1u) * nloc) {
            __builtin_amdgcn_fence(__ATOMIC_RELEASE, "agent");
            asm volatile("s_waitcnt vmcnt(0)" ::: "memory");
            const unsigned og = xb_add(&bar[XB_TOP], 1u);
            const unsigned tg = og / nx;
            if (og + 1u == (tg + 1u) * nx) xb_add(&bar[XB_TOPGEN], 1u);
            else XB_SPIN(xb_ld(&bar[XB_TOPGEN]) == tg, bar);
            __builtin_amdgcn_fence(__ATOMIC_ACQUIRE, "agent");
            xb_add(&bar[XB_XGEN(b.x)], 1u);
            asm volatile("s_waitcnt vmcnt(0)" ::: "memory");
        } else {
            XB_SPIN(xb_ld(&bar[XB_XGEN(b.x)]) == gen, bar);
            __builtin_amdgcn_fence(__ATOMIC_ACQUIRE, "agent");
            asm volatile("s_waitcnt vmcnt(0)" ::: "memory");
        }
    }
    __syncthreads();
}
constexpr int LDS_BYTES = 147456;
constexpr int MISC_OFF = 131072 + 320;

__global__ void __launch_bounds__(NTHR, 2) k_main(Args a) {
    extern __shared__ __attribute__((aligned(16))) unsigned char lds_raw[];
    LAS unsigned char* ldsb = (LAS unsigned char*)lds_raw;
    const int tid0 = threadIdx.x, bid = blockIdx.x, nb = gridDim.x;
    const int wave = __builtin_amdgcn_readfirstlane(tid0 >> 6);
    const int gthreads = nb * NTHR, nwaves = gthreads >> 6;
#define PHASE_VARS() int tid = tid0; asm volatile("" : "+v"(tid)); const int lane = tid & 63, gtid = bid * NTHR + tid, gwave = gtid >> 6; (void)lane; (void)gtid; (void)gwave
    unsigned char* ws = a.ws;
    bf16* WINT = (bf16*)(ws + WS_WIN); bf16* WOT = (bf16*)(ws + WS_WO); bf16* WQT = (bf16*)(ws + WS_WQ);
    bf16* PROJ = (bf16*)(ws + WS_PROJ);
    bf16* XNB = (bf16*)(ws + WS_XNB);
    bf16* XACT = (bf16*)(ws + WS_XACT);
    float* DTRAW = (float*)(ws + WS_DTRAW); float* DT = (float*)(ws + WS_DT); float* ACS = (float*)(ws + WS_ACS); float* CDEC = (float*)(ws + WS_CDEC);
    bf16* STATES = (bf16*)(ws + WS_STATES); bf16* PREVT = (bf16*)(ws + WS_PREV); bf16* YD = (bf16*)a.out;
    float* QP = (float*)(ws + WS_QP); unsigned short* IDX = (unsigned short*)(ws + WS_IDX); float* GATE = (float*)(ws + WS_GATE);
    float* TOPV = (float*)(ws + WS_TOPV); int* TOPI = (int*)(ws + WS_TOPI);
    unsigned char* U8 = ws + WS_U8; unsigned char* V8 = ws + WS_V8; float* SU = (float*)(ws + WS_SU); float* SV = SU + 16384; bf16* PART = (bf16*)(ws + WS_PART); unsigned char* XQ = ws + WS_XQ; float* XS = (float*)(ws + WS_XS);
    bf16* KH = (bf16*)(ws + WS_KH); bf16* KL = (bf16*)(ws + WS_KH + 65536);
    bf16* HB = (bf16*)(ws + WS_STATES);
    float* MIXF = a.out;
    volatile LAS unsigned* MISC = (volatile LAS unsigned*)(ldsb + MISC_OFF);
    if (tid0 < 32) MISC[tid0] = 0u;
    __syncthreads();
    XcdBarrier bar = xcd_barrier_post((unsigned*)ws, MISC + 8);
#define IN(k) (a.ph_lo <= (k) && (k) < a.ph_hi)
#if defined(PROBE_LO)
    int seg_ = 0; unsigned long long tseg_ = __builtin_amdgcn_s_memrealtime();
#define PROBE_SPIN() do { if (seg_ >= PROBE_LO && seg_ <= PROBE_HI) { const unsigned long long d_ = (__builtin_amdgcn_s_memrealtime() - tseg_) * PROBE_AMP; const unsigned long long s_ = __builtin_amdgcn_s_memrealtime(); \
        while (__builtin_amdgcn_s_memrealtime() - s_ < d_) __builtin_amdgcn_s_sleep(4); } } while (0)
#define GRID_BAR() do { PROBE_SPIN(); xcd_barrier(bar); tseg_ = __builtin_amdgcn_s_memrealtime(); ++seg_; } while (0)
#else
#define PROBE_SPIN() do { } while (0)
#define GRID_BAR() xcd_barrier(bar)
#endif

    if (IN(0)) {
        PHASE_VARS();
        LAS float* scr = (LAS float*)(ldsb + wave * 16384);
        constexpr int I_IN = 16 * 72, I_O = 16 * 32, NITEMS = I_IN + 2 * I_O;
        for (int it = gwave; it < NITEMS; it += nwaves) {
            int r = it;
            if (r < I_IN) { transpose_item(a.w_in, PW, D, WINT, scr, r / 72, r % 72, lane); continue; } r -= I_IN;
            if (r < I_O) { transpose_item(a.w_out, D, D, WOT, scr, r / 32, r % 32, lane); continue; } r -= I_O;
            transpose_item(a.peer_wq, D, D, WQT, scr, r / 32, r % 32, lane);
        }
        for (int i = gtid; i < 2 * 128 * 64; i += gthreads) { const float kf = a.peer_sub_keys[i]; const short h = bfs(kf); KH[i] = (bf16)h; KL[i] = (bf16)bfs(kf - sbf2f(h)); }
        for (int i = tid; i < 8 * 1024; i += NTHR) { const int h = i & 7, c = i >> 3; *(LAS float*)(ldsb + h * 16384 + 8448 + c * 4) = a.w_in[(size_t)c * PW + ODT + h]; }
        __syncthreads();
        rmsnorm_rows_bf16<1>(a.x, a.norm_mix_g, XNB, ldsb, DTRAW, nullptr, nullptr, gwave, nwaves, lane);
    }
    GRID_BAR();
    if (IN(1)) {
        PHASE_VARS();
        pg8::Gemm g{XNB, WINT, T, PS, D}; pg8::StaticOrder S; S.init(T, PS, nb, bid);
        pg8::EpiBf16Plain E{PROJ, PS};
        pg8::gemm_phase<pg8::EpiBf16Plain, pg8::StaticOrder>(ldsb, g, S, E, nullptr);
        const int cfirst = (nb == 256) ? 64 : 0;
        if (bid >= cfirst) for (int rr0 = ((bid - cfirst) * 8 + wave) * 4; rr0 < 2 * 16384; rr0 += (nb - cfirst) * 8 * 4) {
            float4 v[4][4];
#pragma unroll
            for (int q = 0; q < 4; ++q) { const int rr = rr0 + q, which = rr >> 14, row = rr & 16383;
                typedef float f4v __attribute__((ext_vector_type(4))); const f4v* src4 = (const f4v*)((which ? a.peer_v : a.peer_u) + (size_t)row * D) + lane;
#pragma unroll
                for (int jq = 0; jq < 4; ++jq) { const f4v t4 = __builtin_nontemporal_load(src4 + 64 * jq); v[q][jq] = make_float4(t4.x, t4.y, t4.z, t4.w); } }
#pragma unroll
            for (int q = 0; q < 4; ++q) { const int rr = rr0 + q, which = rr >> 14, row = rr & 16383;
                float mx = 0.f;
#pragma unroll
                for (int jq = 0; jq < 4; ++jq) mx = fmaxf(mx, fmaxf(fmaxf(fabsf(v[q][jq].x), fabsf(v[q][jq].y)), fmaxf(fabsf(v[q][jq].z), fabsf(v[q][jq].w))));
#pragma unroll
                for (int o = 1; o < 64; o <<= 1) mx = fmaxf(mx, __shfl_xor(mx, o));
                const float sc = mx > 0.f ? mx * (1.f / 127.f) : 1.f, inv = 1.f / sc;
                unsigned* dst = (unsigned*)((which ? V8 : U8) + (size_t)row * D) + lane;
#pragma unroll
                for (int jq = 0; jq < 4; ++jq) { const int q0 = (int)rintf(v[q][jq].x * inv), q1 = (int)rintf(v[q][jq].y * inv), q2 = (int)rintf(v[q][jq].z * inv), q3 = (int)rintf(v[q][jq].w * inv);
                    dst[64 * jq] = (unsigned)(q0 & 255) | ((unsigned)(q1 & 255) << 8) | ((unsigned)(q2 & 255) << 16) | ((unsigned)(q3 & 255) << 24); }
                if (lane == 0) (which ? SV : SU)[row] = sc; }
        }
    }
    GRID_BAR();
    if (IN(3)) {
        PHASE_VARS();
        for (int u = bid; u < 512; u += nb) {
            if (u < 256) attn_unit(a.attn_sinks, a.attn_out_g, ldsb, u, PROJ, XNB, tid, lane, wave);
            else ssd_chunk_unit(ldsb, u - 256, PROJ, XACT, DTRAW, a.conv_w, a.conv_b, a.dt_bias, a.a_log, ACS, CDEC, YD, STATES, tid, lane, wave);
        }
    }
    GRID_BAR();
    if (IN(5)) {
        PHASE_VARS();
        for (int idx = gtid; idx < 2 * 8 * 8192; idx += gthreads) {
            const int pn = idx & 8191, h = (idx >> 13) & 7, b = idx >> 16;
            float run = 0.f;
#pragma unroll 1
            for (int c0 = 0; c0 < 64; c0 += 8) {
                float st[8], dc[8];
#pragma unroll
                for (int j = 0; j < 8; ++j) { const int bch = (b * 64 + c0 + j) * 8 + h; st[j] = bf2f(STATES[(size_t)bch * 8192 + pn]); dc[j] = CDEC[bch]; }
#pragma unroll
                for (int j = 0; j < 8; ++j) { const int bch = (b * 64 + c0 + j) * 8 + h; PREVT[(size_t)bch * 8192 + pn] = f2bf(run); run = dc[j] * run + st[j]; }
            }
        }
    }
    GRID_BAR();
    if (IN(6)) {
        PHASE_VARS();
        for (int u = bid; u < 256; u += nb) yoff_unit(a.d_skip, a.ssm_norm_g, ldsb, u, XACT, PROJ, ACS, PREVT, YD, XNB, lane, wave);
    }
    GRID_BAR();
    if (IN(7)) {
        PHASE_VARS();
        pg8::Gemm g{XNB, WOT, T, D, D}; pg8::StaticOrder S; S.init(T, D, nb, bid);
        pg8::EpiBf16Resid E{HB, a.x, D};
        pg8::gemm_phase<pg8::EpiBf16Resid, pg8::StaticOrder>(ldsb, g, S, E, nullptr);
    }
    GRID_BAR();
    if (IN(8)) {
        PHASE_VARS();
        rmsnorm_rows_bf16<2>((const float*)HB, a.norm_ffn_g, XNB, ldsb, nullptr, XQ, XS, gwave, nwaves, lane);
    }
    GRID_BAR();
    if (IN(9)) {
        PHASE_VARS();
        pg8::Gemm g{XNB, WQT, T, D, D}; pg8::StaticOrder S; S.init(T, D, nb, bid);
        pg8::EpiF32Resid E{QP, nullptr, D};
        pg8::gemm_phase<pg8::EpiF32Resid, pg8::StaticOrder>(ldsb, g, S, E, nullptr);
    }
    GRID_BAR();
    bf16* PEERO = (bf16*)(ws + WS_PEERO);
    if (IN(12)) {
        PHASE_VARS();
        LAS bf16* KHL = (LAS bf16*)ldsb; LAS int* ACC = (LAS int*)ldsb; LAS unsigned char* AL = (LAS unsigned char*)(ldsb + 32768); LAS float* ASC = (LAS float*)(ldsb + 40960);
        LAS unsigned short* EL = (LAS unsigned short*)(ldsb + 73728); LAS float* GL = (LAS float*)(ldsb + 90112);
#pragma unroll 1
        for (int j = bid; j < NCHUNK; j += nb) {
            __syncthreads();
            for (int i = tid; i < 2 * 2 * 128 * 8; i += NTHR) {
                const int pc = i & 7, key = (i >> 3) & 127, hf = (i >> 10) & 1, hl = i >> 11;
                *(LAS v4u*)(KHL + ((hl * 2 + hf) * 128 + key) * 72 + pc * 8) = *(const v4u*)((hl ? KL : KH) + (size_t)(hf * 128 + key) * 64 + pc * 8);
            }
            __syncthreads();
            route_task(16 * j + wave, 4 * wave, QP, KHL, EL, GL, lane);
            route_task(16 * j + 8 + wave, 32 + 4 * wave, QP, KHL, EL, GL, lane);
            __syncthreads();
#pragma unroll 1
            for (int p = 0; p < NPART; ++p) peer_u_item(p, j, EL, XQ, U8, ACC, lane, wave);
#pragma unroll 1
            for (int it = 0; it < 8; ++it) {
                const int tl = it * 8 + wave, t = j * 64 + tl;
                const unsigned ew = *(const LAS unsigned*)(EL + tl * 128 + 2 * lane); const int e0 = (int)(ew & 0xffffu), e1 = (int)(ew >> 16);
                typedef int i2v __attribute__((ext_vector_type(2))); const i2v si = *(const LAS i2v*)(ACC + tl * 128 + 2 * lane);
                typedef float f2v __attribute__((ext_vector_type(2))); const f2v gt = *(const LAS f2v*)(GL + tl * 128 + 2 * lane); const float xs = XS[t];
                const float z0 = (float)si.x * SU[e0] * xs, z1 = (float)si.y * SU[e1] * xs;
                const float a0 = gt.x * 0.5f * z0 * (1.f + erff(z0 * 0.70710678118654752f)) * SV[e0], a1 = gt.y * 0.5f * z1 * (1.f + erff(z1 * 0.70710678118654752f)) * SV[e1];
                float mx = fmaxf(fabsf(a0), fabsf(a1));
#pragma unroll
                for (int o = 1; o < 64; o <<= 1) mx = fmaxf(mx, __shfl_xor(mx, o));
                const float sc = mx > 0.f ? mx * (1.f / 127.f) : 1.f, inv = 1.f / sc;
                *(LAS unsigned short*)(AL + tl * 128 + 2 * lane) = (unsigned short)(((int)rintf(a0 * inv) & 255) | (((int)rintf(a1 * inv) & 255) << 8));
                if (lane == 0) ASC[tl] = sc;
            }
#pragma unroll 1
            for (int p = 0; p < NPART; ++p) peer_v_item(p, j, EL, AL, ASC, V8, PEERO, lane, wave);
            asm volatile("s_waitcnt vmcnt(0)" ::: "memory");
#pragma unroll 1
            for (int it = 0; it < 8; ++it) {
                const int t = j * 64 + it * 8 + wave;
                const uint2* hr = (const uint2*)(HB + (size_t)t * D) + lane; unsigned long long* pr = (unsigned long long*)(PEERO + (size_t)t * D) + lane;
                float4 v[4]; float ss = 0.f;
#pragma unroll
                for (int jq = 0; jq < 4; ++jq) { const uint2 hw = hr[64 * jq]; const unsigned long long pw = __hip_atomic_load(pr + 64 * jq, __ATOMIC_RELAXED, __HIP_MEMORY_SCOPE_AGENT);
                    const unsigned pl = (unsigned)pw, ph = (unsigned)(pw >> 32);
                    v[jq] = make_float4(__uint_as_float(hw.x << 16) + __uint_as_float(pl << 16), __uint_as_float(hw.x & 0xffff0000u) + __uint_as_float(pl & 0xffff0000u),
                                        __uint_as_float(hw.y << 16) + __uint_as_float(ph << 16), __uint_as_float(hw.y & 0xffff0000u) + __uint_as_float(ph & 0xffff0000u));
                    ss += v[jq].x * v[jq].x + v[jq].y * v[jq].y + v[jq].z * v[jq].z + v[jq].w * v[jq].w; }
                ss = wave_sum(ss);
                const float r3 = rsqrtf(ss * (1.f / D) + EPS);
                float4* op = (float4*)(a.out + (size_t)t * D) + lane;
#pragma unroll
                for (int jq = 0; jq < 4; ++jq) { const float4 gv = ((const float4*)a.final_norm_g)[lane + 64 * jq]; op[64 * jq] = make_float4(v[jq].x * r3 * gv.x, v[jq].y * r3 * gv.y, v[jq].z * r3 * gv.z, v[jq].w * r3 * gv.w); }
            }
        }
    }
    PROBE_SPIN();
#undef IN
}
}

extern "C" void kernel_launch(void* const* d_in, const int* in_sizes, int n_in, void* d_out, int out_size, void* d_ws, size_t ws_size, hipStream_t stream) {
    if (n_in != 18 || out_size != T * D || ws_size < WS_END) { fprintf(stderr, "kernel_launch: unexpected shapes n_in=%d out=%d ws=%zu\n", n_in, out_size, ws_size); return; }
    Args a{};
    const float** ap = (const float**)&a;
    for (int i = 0; i < 18; ++i) ap[i] = (const float*)d_in[i];
    a.out = (float*)d_out; a.ws = (unsigned char*)d_ws;
    static int grid = 0;
    if (grid == 0) {
        int dev = 0, cus = 0, per_cu = 0;
        if (hipGetDevice(&dev) != hipSuccess || hipDeviceGetAttribute(&cus, hipDeviceAttributeMultiprocessorCount, dev) != hipSuccess) { fprintf(stderr, "kernel_launch: device query failed\n"); grid = -1; return; }
        if (hipFuncSetAttribute((const void*)k_main, hipFuncAttributeMaxDynamicSharedMemorySize, LDS_BYTES) != hipSuccess) { fprintf(stderr, "kernel_launch: hipFuncSetAttribute failed\n"); grid = -1; return; }
        if (hipOccupancyMaxActiveBlocksPerMultiprocessor(&per_cu, (const void*)k_main, NTHR, LDS_BYTES) != hipSuccess || per_cu < 1) { fprintf(stderr, "kernel_launch: occupancy query says %d blocks/CU\n", per_cu); (void)hipGetLastError(); grid = -1; return; }
        grid = cus;
    }
    if (grid < 0) return;
    if (hipMemsetAsync(d_ws, 0, 65536, stream) != hipSuccess) { fprintf(stderr, "kernel_launch: memset failed\n"); return; }
    a.ph_lo = 0; a.ph_hi = 13;
    hipLaunchKernelGGL(k_main, dim3(grid), dim3(NTHR), LDS_BYTES, stream, a);
}
```

```cpp
#include <hip/hip_runtime.h>
#include <cstdio>
#include <cstdint>

namespace pg8 {
#define PG8_LAS __attribute__((address_space(3)))
typedef unsigned short bf16_t;
typedef short bf16x8 __attribute__((ext_vector_type(8)));
typedef float f32x4 __attribute__((ext_vector_type(4)));
typedef unsigned u32x4 __attribute__((ext_vector_type(4)));
constexpr int BM = 256, BK = 64, HALF = 128, HTB = HALF * BK * 2  , STAGE_BYTES = 8 * HTB, NXCD = 8, WGM = 8;

__host__ __device__ __forceinline__ int lds_byte(int r, int c) { const int st = (r >> 4) * 2 + (c >> 5), rr = r & 15, cc = c & 31, ob = rr * 64 + cc * 2; return st * 1024 + (ob ^ (((ob >> 9) & 1) << 5)); }
__host__ __device__ __forceinline__ void stage_rc(int b, int& R, int& C) { const int st = b / 1024, sb = b % 1024, swz = sb ^ (((sb >> 9) & 1) << 5); R = (st >> 1) * 16 + swz / 64; C = (st & 1) * 32 + (swz % 64) / 2; }
__host__ __device__ __forceinline__ int perm32(int rho) { const int n = rho >> 4, i = rho & 15; return 8 * (i >> 2) + 4 * n + (i & 3); }

struct Unit { int pm, pn; };
struct Gemm { const bf16_t* A; const bf16_t* Bt; int M, N, K; };

struct StaticOrder {
    int nM, nN, nwg, G, c;
    __host__ __device__ void init(int M, int N, int G_, int c_) { nM = M / BM; nN = N / BM; nwg = nM * nN; G = G_; c = c_; }
    __host__ __device__ bool next(int i, Unit& u) const {
        const long L = (long)i * G + c; if (L >= nwg) return false;
        int wgid = (int)L; { const int q = nwg / NXCD, r = nwg % NXCD, xcd = wgid % NXCD, off = wgid / NXCD; wgid = (xcd < r ? xcd * (q + 1) : r * (q + 1) + (xcd - r) * q) + off; }
        const int nig = WGM * nN, gid = wgid / nig, fm = gid * WGM, gsz = (nM - fm) < WGM ? (nM - fm) : WGM;
        u.pm = fm + ((wgid % nig) % gsz); u.pn = (wgid % nig) / gsz; return true;
    }
    __device__ __forceinline__ void a_ready(const Unit&) const {}
    __device__ __forceinline__ void done(const Unit&) const {}
};
__device__ __forceinline__ unsigned cvt_pk_bf16(float lo, float hi) { unsigned r; asm volatile("v_cvt_pk_bf16_f32 %0, %1, %2" : "=v"(r) : "v"(lo), "v"(hi)); return r; }
typedef float f32x2 __attribute__((ext_vector_type(2)));
struct EpiBf16Plain {
    static constexpr bool PERM = true, AFTER_DRAIN = false;
    bf16_t* O; int ldc;
    __device__ __forceinline__ void operator()(const f32x4 (&acc)[2][2][4][2], const Unit& u, int wr, int wc, int fr, int fq) const {
        const int row0 = u.pm * BM + wr * 64 + fr, col0 = u.pn * BM + wc * 32 + 8 * fq;
        const __amdgpu_buffer_rsrc_t rs = __builtin_amdgcn_make_buffer_rsrc((void*)O, 0, 0x7fffffff, 0x00020000);
#pragma unroll
        for (int ai = 0; ai < 2; ++ai)
#pragma unroll
            for (int m = 0; m < 4; ++m) { const unsigned ro = ((unsigned)(row0 + ai * HALF + m * 16) * (unsigned)ldc + (unsigned)col0) * 2u;
#pragma unroll
                for (int bj = 0; bj < 2; ++bj) { const f32x4 v0 = acc[ai][bj][m][0], v1 = acc[ai][bj][m][1];
                    u32x4 w; w.x = cvt_pk_bf16(v0[0], v0[1]); w.y = cvt_pk_bf16(v0[2], v0[3]); w.z = cvt_pk_bf16(v1[0], v1[1]); w.w = cvt_pk_bf16(v1[2], v1[3]);
                    __builtin_amdgcn_raw_buffer_store_b128(w, rs, (int)(ro + bj * HALF * 2), 0, 16); } }
    }
};
struct EpiF32Resid {
    static constexpr bool PERM = false, AFTER_DRAIN = false;
    float* C; const float* R; int ldc;
    __device__ __forceinline__ void operator()(const f32x4 (&acc)[2][2][4][2], const Unit& u, int wr, int wc, int fr, int fq) const {
        const int row0 = u.pm * BM + wr * 64 + fr, col0 = u.pn * BM + wc * 32 + 4 * fq;
#pragma unroll
        for (int ai = 0; ai < 2; ++ai)
#pragma unroll
            for (int m = 0; m < 4; ++m) { const size_t off = (size_t)(row0 + ai * HALF + m * 16) * ldc + col0;
#pragma unroll
                for (int bj = 0; bj < 2; ++bj)
#pragma unroll
                    for (int n = 0; n < 2; ++n) { f32x4 v = acc[ai][bj][m][n]; if (R) v += *(const f32x4*)(R + off + bj * HALF + n * 16); *(f32x4*)(C + off + bj * HALF + n * 16) = v; }
                asm volatile("" ::: "memory"); }
    }
};

struct EpiBf16Resid {
    static constexpr bool PERM = true, AFTER_DRAIN = false;
    bf16_t* O; const float* R; int ldc;
    __device__ __forceinline__ void operator()(const f32x4 (&acc)[2][2][4][2], const Unit& u, int wr, int wc, int fr, int fq) const {
        const int row0 = u.pm * BM + wr * 64 + fr, col0 = u.pn * BM + wc * 32 + 8 * fq;
#pragma unroll
        for (int ai = 0; ai < 2; ++ai)
#pragma unroll
            for (int m = 0; m < 4; ++m) { const size_t off = (size_t)(row0 + ai * HALF + m * 16) * ldc + col0;
#pragma unroll
                for (int bj = 0; bj < 2; ++bj) { const f32x4 v0 = acc[ai][bj][m][0] + *(const f32x4*)(R + off + bj * HALF), v1 = acc[ai][bj][m][1] + *(const f32x4*)(R + off + bj * HALF + 4);
                    u32x4 w; w.x = cvt_pk_bf16(v0[0], v0[1]); w.y = cvt_pk_bf16(v0[2], v0[3]); w.z = cvt_pk_bf16(v1[0], v1[1]); w.w = cvt_pk_bf16(v1[2], v1[3]);
                    *(u32x4*)(O + off + bj * HALF) = w; }
                asm volatile("" ::: "memory"); }
    }
};
template <class Epi, class Sched, bool STAMP = false>
__device__ __forceinline__ void gemm_phase(PG8_LAS unsigned char* lds, const Gemm g, const Sched& S, const Epi& E, unsigned long long* stamps) {
    const int tid = threadIdx.x, wid = __builtin_amdgcn_readfirstlane(tid >> 6), lane = tid & 63, wr = wid >> 2, wc = wid & 3, fr = lane & 15, fq = lane >> 4;
    const int K = g.K, nt = K / BK;
    int ts_lo = 0, ts_hi = 0, nts = 0; const unsigned long long rt_entry = STAMP ? (unsigned long long)0ull : 0ull;
#define PG8_STAMP() do { if (STAMP && wid == 0 && nts < 64) { const unsigned long long _c = (unsigned long long)clock64(); \
        ts_lo = (lane == nts) ? (int)(unsigned)_c : ts_lo; ts_hi = (lane == nts) ? (int)(unsigned)(_c >> 32) : ts_hi; ++nts; } } while (0)
    PG8_STAMP();
    unsigned voffA[2], voffB[2];
#pragma unroll
    for (int i = 0; i < 2; ++i) { int R, C; stage_rc(tid * 16 + i * 8192, R, C); const int Rb = Epi::PERM ? ((R & ~31) + perm32(R & 31)) : R;
        voffA[i] = (unsigned)(R * K + C) * 2u; voffB[i] = (unsigned)(Rb * K + C) * 2u; }
    const size_t kstep = (size_t)(BK * 2);
    const size_t hstep = (size_t)HALF * K * 2;
    const size_t tstep = 2 * hstep;
    const unsigned ldsw = (unsigned)wid * 1024u;
    const int aoff = lds_byte(wr * 64 + fr, fq * 8), boff = lds_byte(wc * 32 + fr, fq * 8);
#define PG8_SA(b, h) (((b) * 2 + (h)) * HTB)
#define PG8_SB(b, h) ((4 + (b) * 2 + (h)) * HTB)
#define PG8_STAGE(bufoff, gbase, voff) do { _Pragma("unroll") for (int _i = 0; _i < 2; ++_i) \
        __builtin_amdgcn_global_load_lds((const unsigned*)((const char*)(gbase) + (voff)[_i]), (PG8_LAS unsigned*)(lds + (bufoff) + ldsw + _i * 8192), 16, 0, 0); } while (0)
#define PG8_LDA(dst, b, h) do { _Pragma("unroll") for (int m = 0; m < 4; ++m) _Pragma("unroll") for (int k = 0; k < 2; ++k) dst[m][k] = *(const PG8_LAS bf16x8*)(lds + PG8_SA(b, h) + aoff + m * 2048 + k * 1024); } while (0)
#define PG8_LDB(dst, b, h) do { _Pragma("unroll") for (int n = 0; n < 2; ++n) _Pragma("unroll") for (int k = 0; k < 2; ++k) dst[n][k] = *(const PG8_LAS bf16x8*)(lds + PG8_SB(b, h) + boff + n * 2048 + k * 1024); } while (0)
#define PG8_MMA(ai, bj, At, Bt) do { __builtin_amdgcn_s_setprio(1); _Pragma("unroll") for (int m = 0; m < 4; ++m) _Pragma("unroll") for (int n = 0; n < 2; ++n) _Pragma("unroll") for (int k = 0; k < 2; ++k) \
        acc[ai][bj][m][n] = __builtin_amdgcn_mfma_f32_16x16x32_bf16(Bt[n][k], At[m][k], acc[ai][bj][m][n], 0, 0, 0); __builtin_amdgcn_s_setprio(0); } while (0)
#define PG8_WAIT_V(n) asm volatile("s_waitcnt vmcnt(" #n ")" ::: "memory")
#define PG8_WAIT_L(n) asm volatile("s_waitcnt lgkmcnt(" #n ")" ::: "memory")
#define PG8_BAR __builtin_amdgcn_s_barrier()
#define PG8_SCHED __builtin_amdgcn_sched_barrier(0)
    Unit cur, nxt; int ui = 0;
    if (!S.next(0, cur)) return;
    f32x4 acc[2][2][4][2];
#pragma unroll
    for (int a = 0; a < 2; ++a)
#pragma unroll
        for (int b = 0; b < 2; ++b)
#pragma unroll
            for (int m = 0; m < 4; ++m)
#pragma unroll
                for (int n = 0; n < 2; ++n) acc[a][b][m][n] = (f32x4){0.f, 0.f, 0.f, 0.f};
    bf16x8 At[4][2], B0[2][2], B1[2][2];
    const char* cA = (const char*)g.A + (size_t)cur.pm * tstep; const char* cB = (const char*)g.Bt + (size_t)cur.pn * tstep;
    S.a_ready(cur);
    PG8_STAGE(PG8_SB(0, 0), cB, voffB); PG8_STAGE(PG8_SA(0, 0), cA, voffA); PG8_STAGE(PG8_SB(0, 1), cB + hstep, voffB); PG8_STAGE(PG8_SA(0, 1), cA + hstep, voffA);
    if (wr == 1) PG8_BAR;
    PG8_WAIT_V(4); PG8_BAR;
    PG8_STAGE(PG8_SB(1, 0), cB + kstep, voffB); PG8_STAGE(PG8_SA(1, 0), cA + kstep, voffA); PG8_STAGE(PG8_SB(1, 1), cB + hstep + kstep, voffB);
    PG8_WAIT_V(6); PG8_BAR;
    PG8_STAMP();
    for (;;) {
        const bool has_next = S.next(ui + 1, nxt);
        const char* nA = has_next ? (const char*)g.A + (size_t)nxt.pm * tstep : cA; const char* nB = has_next ? (const char*)g.Bt + (size_t)nxt.pn * tstep : cB;
        for (int t = 0; t < nt; t += 2) {
            const bool last = (t == nt - 2);
            const char* a1 = cA + (size_t)(t + 1) * kstep;
            const char* a2 = last ? nA : cA + (size_t)(t + 2) * kstep; const char* b2 = last ? nB : cB + (size_t)(t + 2) * kstep;
            const char* a3 = a2 + kstep; const char* b3 = b2 + kstep;
            if (last && has_next) S.a_ready(nxt);
            PG8_LDB(B0, 0, 0); PG8_SCHED; PG8_LDA(At, 0, 0); PG8_STAGE(PG8_SA(1, 1), a1 + hstep, voffA);
            PG8_WAIT_L(8); PG8_BAR; PG8_WAIT_L(0); PG8_MMA(0, 0, At, B0); PG8_BAR; PG8_SCHED;
            PG8_LDB(B1, 0, 1); PG8_STAGE(PG8_SB(0, 0), b2, voffB);
            PG8_BAR; PG8_WAIT_L(0); PG8_MMA(0, 1, At, B1); PG8_BAR;
            PG8_LDA(At, 0, 1); PG8_STAGE(PG8_SA(0, 0), a2, voffA);
            PG8_BAR; PG8_WAIT_L(0); PG8_MMA(1, 0, At, B0); PG8_BAR; PG8_SCHED;
            PG8_STAGE(PG8_SB(0, 1), b2 + hstep, voffB);
            PG8_WAIT_V(6); PG8_BAR; PG8_MMA(1, 1, At, B1); PG8_BAR;
            PG8_LDB(B0, 1, 0); PG8_SCHED; PG8_LDA(At, 1, 0); PG8_STAGE(PG8_SA(0, 1), a2 + hstep, voffA);
            PG8_WAIT_L(8); PG8_BAR; PG8_WAIT_L(0); PG8_MMA(0, 0, At, B0); PG8_BAR; PG8_SCHED;
            PG8_LDB(B1, 1, 1); PG8_STAGE(PG8_SB(1, 0), b3, voffB);
            PG8_BAR; PG8_WAIT_L(0); PG8_MMA(0, 1, At, B1); PG8_BAR;
            PG8_LDA(At, 1, 1); PG8_STAGE(PG8_SA(1, 0), a3, voffA);
            PG8_BAR; PG8_WAIT_L(0); PG8_MMA(1, 0, At, B0); PG8_BAR; PG8_SCHED;
            PG8_STAGE(PG8_SB(1, 1), b3 + hstep, voffB);
            PG8_WAIT_V(6); PG8_BAR; PG8_MMA(1, 1, At, B1); PG8_BAR;
        }
        PG8_STAMP();
        if constexpr (!Epi::AFTER_DRAIN) { E(acc, cur, wr, wc, fr, fq); S.done(cur); }
        PG8_STAMP();
        if (!has_next) break;
#pragma unroll
        for (int a = 0; a < 2; ++a)
#pragma unroll
            for (int b = 0; b < 2; ++b)
#pragma unroll
                for (int m = 0; m < 4; ++m)
#pragma unroll
                    for (int n = 0; n < 2; ++n) acc[a][b][m][n] = (f32x4){0.f, 0.f, 0.f, 0.f};
        cur = nxt; cA = nA; cB = nB; ++ui;
    }
    PG8_WAIT_V(0);
    if (wr == 0) PG8_BAR;
    PG8_BAR;
    if constexpr (Epi::AFTER_DRAIN) { E.fused(acc, cur, wr, wc, fr, fq, lds, wid, lane); S.done(cur); }
    PG8_STAMP();
    if (STAMP && wid == 0) { stamps[lane] = lane < nts ? (((unsigned long long)(unsigned)ts_hi << 32) | (unsigned)ts_lo) : 0ull;
        if (lane == 62) stamps[62] = rt_entry; if (lane == 63) stamps[63] = (unsigned long long)0ull; }
#undef PG8_STAMP
#undef PG8_SA
#undef PG8_SB
#undef PG8_STAGE
#undef PG8_LDA
#undef PG8_LDB
#undef PG8_MMA
#undef PG8_WAIT_V
#undef PG8_WAIT_L
#undef PG8_BAR
#undef PG8_SCHED
}
}

namespace {
constexpr int D = 1024, BATCH = 2, SEQ = 8192, T = BATCH * SEQ;
constexpr int PW = 2312;
constexpr int PS = 2304;
constexpr int OQ = 0, OKK = 512, OV = 640, OZ = 768, OXBC = 1280, ODT = 2304;
constexpr float EPS = 1e-6f;
constexpr int NTHR = 512;
typedef unsigned short bf16;
typedef unsigned v4u __attribute__((ext_vector_type(4)));

constexpr size_t MiB = 1u << 20;
constexpr size_t WS_WIN = 1 * MiB;
constexpr size_t WS_KH = 5 * MiB + 512 * 1024;
constexpr size_t WS_WO = 6 * MiB;
constexpr size_t WS_WQ = 8 * MiB;
constexpr size_t WS_PROJ = 10 * MiB;
constexpr size_t WS_XNB = 82 * MiB;
constexpr size_t WS_XACT = 114 * MiB;
constexpr size_t WS_DTRAW = 146 * MiB;
constexpr size_t WS_DT = WS_DTRAW + 512 * 1024;
constexpr size_t WS_ACS = WS_DT + 512 * 1024;
constexpr size_t WS_CDEC = WS_ACS + 512 * 1024;
constexpr size_t WS_STATES = 164 * MiB;
constexpr size_t WS_PREV = 196 * MiB;
constexpr size_t WS_QP = 10 * MiB;
constexpr size_t WS_IDX = 74 * MiB;
constexpr size_t WS_GATE = 114 * MiB;
constexpr size_t WS_TOPV = 122 * MiB;
constexpr size_t WS_TOPI = 138 * MiB;
constexpr size_t WS_ACT = 122 * MiB;
constexpr size_t WS_SU = 245 * MiB;
constexpr size_t WS_U8 = 212 * MiB;
constexpr size_t WS_V8 = 148 * MiB;
constexpr size_t WS_PART = 10 * MiB;
constexpr size_t WS_XQ = 228 * MiB;
constexpr size_t WS_XS = 244 * MiB;
constexpr size_t WS_PEERO = 10 * MiB;
constexpr size_t WS_END = 246 * MiB;
constexpr int CW_QU = 4096, CW_QV = 4096 + 64 * 16;
constexpr int NPART = 8, NCHUNK = T / 64;

struct Args {
    const float* x; const float* norm_mix_g; const float* w_in; const float* attn_sinks; const float* attn_out_g;
    const float* conv_w; const float* conv_b; const float* dt_bias; const float* a_log; const float* d_skip;
    const float* ssm_norm_g; const float* w_out; const float* norm_ffn_g; const float* peer_wq; const float* peer_sub_keys;
    const float* peer_u; const float* peer_v; const float* final_norm_g;
    float* out; unsigned char* ws;
    int ph_lo, ph_hi;
};

#define LAS __attribute__((address_space(3)))
#define LDS_WAIT() asm volatile("s_waitcnt lgkmcnt(0)" ::: "memory")
__device__ __forceinline__ float bf2f(bf16 v) { return __uint_as_float(((unsigned)v) << 16); }
__device__ __forceinline__ unsigned f2bfu(float f) { unsigned u = __float_as_uint(f); return (u + 0x7fffu + ((u >> 16) & 1u)) >> 16; }
__device__ __forceinline__ bf16 f2bf(float f) { return (bf16)f2bfu(f); }
__device__ __forceinline__ unsigned pk2(float lo, float hi) { return f2bfu(lo) | (f2bfu(hi) << 16); }
__device__ __forceinline__ float wave_sum(float v) {
#pragma unroll
    for (int o = 1; o < 64; o <<= 1) v += __shfl_xor(v, o);
    return v;
}
__device__ __forceinline__ float silu_f(float v) { return v / (1.f + __expf(-v)); }

__device__ __forceinline__ void transpose_item(const float* W, int ldw, int K, bf16* WT, LAS float* scr, int kb, int nbk, int lane) {
    const int k0 = 64 * kb, n0 = 32 * nbk;
#pragma unroll 8
    for (int i = 0; i < 32; ++i) { const int kk = 2 * i + (lane >> 5); scr[kk * 33 + (lane & 31)] = W[(size_t)(k0 + kk) * ldw + n0 + (lane & 31)]; }
    LDS_WAIT();
    const int c = lane & 7;
#pragma unroll
    for (int j = 0; j < 4; ++j) { const int n = (lane >> 3) + 8 * j; const LAS float* s = scr + (8 * c) * 33 + n;
        v4u o; o.x = pk2(s[0 * 33], s[1 * 33]); o.y = pk2(s[2 * 33], s[3 * 33]); o.z = pk2(s[4 * 33], s[5 * 33]); o.w = pk2(s[6 * 33], s[7 * 33]);
        *(v4u*)(WT + (size_t)(n0 + n) * K + k0 + 8 * c) = o; }
    LDS_WAIT();
}

template <int MODE  >
__device__ __forceinline__ void rmsnorm_rows_bf16(const float* __restrict__ in, const float* __restrict__ g, bf16* __restrict__ outp, const LAS unsigned char* ldsb, float* __restrict__ dtraw, unsigned char* __restrict__ xq, float* __restrict__ xs, int gwave, int nwaves, int lane) {
#pragma unroll 2
    for (int row = gwave; row < T; row += nwaves) {
        const float4* xr = (const float4*)(in + (size_t)row * D) + lane; const uint2* xb = (const uint2*)((const bf16*)in + (size_t)row * D) + lane;
        float4 v[4]; float ss = 0.f;
#pragma unroll
        for (int j = 0; j < 4; ++j) {
            if (MODE == 2) { const uint2 w = xb[64 * j]; v[j] = make_float4(__uint_as_float(w.x << 16), __uint_as_float(w.x & 0xffff0000u), __uint_as_float(w.y << 16), __uint_as_float(w.y & 0xffff0000u)); }
            else if (MODE == 1) { typedef float f4v __attribute__((ext_vector_type(4))); const f4v t4 = __builtin_nontemporal_load((const f4v*)xr + 64 * j); v[j] = make_float4(t4.x, t4.y, t4.z, t4.w); }
            else v[j] = xr[64 * j];
            ss += v[j].x * v[j].x + v[j].y * v[j].y + v[j].z * v[j].z + v[j].w * v[j].w; }
        ss = wave_sum(ss);
        const float r = rsqrtf(ss * (1.f / D) + EPS);
        unsigned long long* o8 = (unsigned long long*)(outp + (size_t)row * D) + lane;
        float dacc[8]; float y[4][4]; float mx = 0.f;
#pragma unroll
        for (int h = 0; h < 8; ++h) dacc[h] = 0.f;
#pragma unroll
        for (int j = 0; j < 4; ++j) {
            const float4 gv = ((const float4*)g)[lane + 64 * j];
            y[j][0] = v[j].x * r * gv.x; y[j][1] = v[j].y * r * gv.y; y[j][2] = v[j].z * r * gv.z; y[j][3] = v[j].w * r * gv.w;
            o8[64 * j] = (unsigned long long)pk2(y[j][0], y[j][1]) | ((unsigned long long)pk2(y[j][2], y[j][3]) << 32);
            if (MODE == 2) mx = fmaxf(mx, fmaxf(fmaxf(fabsf(y[j][0]), fabsf(y[j][1])), fmaxf(fabsf(y[j][2]), fabsf(y[j][3]))));
            if (MODE == 1) {
#pragma unroll
                for (int h = 0; h < 8; ++h) {
                    typedef float f4v __attribute__((ext_vector_type(4)));
                    const f4v wv = *(const LAS f4v*)(ldsb + h * 16384 + 8448 + (256 * j + 4 * lane) * 4);
                    dacc[h] += y[j][0] * wv.x + y[j][1] * wv.y + y[j][2] * wv.z + y[j][3] * wv.w;
                }
            }
        }
        if (MODE == 1) {
#pragma unroll
            for (int h = 0; h < 8; ++h) dacc[h] = wave_sum(dacc[h]);
            if (lane == 0) { float4* dp = (float4*)(dtraw + (size_t)row * 8); dp[0] = make_float4(dacc[0], dacc[1], dacc[2], dacc[3]); dp[1] = make_float4(dacc[4], dacc[5], dacc[6], dacc[7]); }
        }
        if (MODE == 2) {
#pragma unroll
            for (int o = 1; o < 64; o <<= 1) mx = fmaxf(mx, __shfl_xor(mx, o));
            const float sc = mx > 0.f ? mx * (1.f / 127.f) : 1.f, inv = 1.f / sc;
            unsigned* dq = (unsigned*)(xq + (size_t)row * D) + lane;
#pragma unroll
            for (int j = 0; j < 4; ++j) { const int q0 = (int)rintf(y[j][0] * inv), q1 = (int)rintf(y[j][1] * inv), q2 = (int)rintf(y[j][2] * inv), q3 = (int)rintf(y[j][3] * inv);
                dq[64 * j] = (unsigned)(q0 & 255) | ((unsigned)(q1 & 255) << 8) | ((unsigned)(q2 & 255) << 16) | ((unsigned)(q3 & 255) << 24); }
            if (lane == 0) xs[row] = sc;
        }
    }
}

typedef short bf16x8 __attribute__((ext_vector_type(8)));
typedef short bf16x4 __attribute__((ext_vector_type(4)));
typedef float f32x16 __attribute__((ext_vector_type(16)));
typedef __bf16 bf2_t __attribute__((ext_vector_type(2)));
#define MFMA32(a, b, c) __builtin_amdgcn_mfma_f32_32x32x16_bf16((a), (b), (c), 0, 0, 0)
__device__ __forceinline__ unsigned pkbf(float lo, float hi) { bf2_t v = {(__bf16)lo, (__bf16)hi}; return __builtin_bit_cast(unsigned, v); }
__device__ __forceinline__ short bfs(float f) { return __builtin_bit_cast(short, (__bf16)f); }
__device__ __forceinline__ float sbf2f(short v) { return __uint_as_float(((unsigned)(unsigned short)v) << 16); }
__device__ __forceinline__ int crow(int i, int hi) { return (i & 3) + 8 * (i >> 2) + 4 * hi; }
template <int S> __device__ __forceinline__ bf16x8 pack8(const f32x16& x) {
    v4u p; p.x = pkbf(x[8 * S], x[8 * S + 1]); p.y = pkbf(x[8 * S + 2], x[8 * S + 3]); p.z = pkbf(x[8 * S + 4], x[8 * S + 5]); p.w = pkbf(x[8 * S + 6], x[8 * S + 7]);
    return __builtin_bit_cast(bf16x8, p);
}
__device__ __forceinline__ bf16x8 ldg8(const bf16* p) { return *(const bf16x8*)p; }
__device__ __forceinline__ bf16x8 lds8(const LAS bf16* p) { return *(const LAS bf16x8*)p; }
__device__ __forceinline__ bf16x8 lds4x2(const LAS bf16* p) { const bf16x4 a = *(const LAS bf16x4*)p, b = *(const LAS bf16x4*)(p + 8); return __builtin_shufflevector(a, b, 0, 1, 2, 3, 4, 5, 6, 7); }
__device__ __forceinline__ f32x16 zero16() { f32x16 z;
#pragma unroll
    for (int i = 0; i < 16; ++i) z[i] = 0.f;
    return z; }

__device__ __forceinline__ void attn_unit(const float* sinks, const float* gnorm, LAS unsigned char* ldsb, int unit, const bf16* PROJ, bf16* MIXB, int tid, int lane, int wave) {
    asm volatile("" : "+v"(tid), "+v"(lane));
    const int tok0 = unit * 64, s0 = tok0 & (SEQ - 1), kbase = tok0 - 128;
    LAS bf16* VT = (LAS bf16*)ldsb;
    LAS bf16* KI = (LAS bf16*)(ldsb + 51200);
    LAS float* SSQ = (LAS float*)(ldsb + 51200 + 55296);
    const __amdgpu_buffer_rsrc_t rsP = __builtin_amdgcn_make_buffer_rsrc((void*)PROJ, 0, (unsigned)T * PS * 2u, 0x00020000);
#pragma unroll
    for (int i = 0; i < 6; ++i) {
        const int c = tid + 512 * i, kv = c / 1536, cc = c - kv * 1536, key = cc >> 3, d0 = (cc & 7) * 8; const bool valid = (s0 - 128 + key) >= 0;
        bf16x8 v, k;
#pragma unroll
        for (int e = 0; e < 8; ++e) { v[e] = 0; k[e] = 0; }
        if (valid) { const unsigned ro = (unsigned)(kbase + key) * (unsigned)PS + (unsigned)(kv * 64 + d0);
            v = __builtin_bit_cast(bf16x8, __builtin_amdgcn_raw_buffer_load_b128(rsP, (int)((ro + (unsigned)OV) * 2u), 0, 2));
            k = __builtin_bit_cast(bf16x8, __builtin_amdgcn_raw_buffer_load_b128(rsP, (int)((ro + (unsigned)OKK) * 2u), 0, 2)); }
#pragma unroll
        for (int e = 0; e < 8; ++e) VT[kv * 12800 + (d0 + e) * 200 + key] = (bf16)v[e];
        *(LAS bf16x8*)(KI + (kv * 192 + key) * 72 + d0) = k;
    }
    __syncthreads();
    const int r = lane & 31, hi = lane >> 5;
    const int hq = wave, hkv = wave >> 2;
    const float slope = exp2f(-(float)(hq + 1)), sink = sinks[hq];
#pragma unroll 1
    for (int qt = 0; qt < 2; ++qt) {
        const int tq = tok0 + 32 * qt + r;
        bf16x8 qf[4];
        { const bf16* qp = PROJ + (size_t)tq * PS + OQ + hq * 64 + 8 * hi; asm volatile("" : "+v"(qp));
#pragma unroll
          for (int ks = 0; ks < 4; ++ks) qf[ks] = ldg8(qp + 16 * ks); }
        const int ql = 32 * qt + r;
        float m = sink, lh = 0.f;
        f32x16 O0 = zero16(), O1 = zero16();
#pragma unroll 1
        for (int kt = 0; kt < 5; ++kt) {
            const LAS bf16* kp = KI + (hkv * 192 + 32 * (qt + kt) + r) * 72 + 8 * hi;
            f32x16 X = zero16();
#pragma unroll
            for (int ks = 0; ks < 4; ++ks) X = MFMA32(lds8(kp + 16 * ks), qf[ks], X);
            float tm = -1e30f;
#pragma unroll
            for (int i = 0; i < 16; ++i) {
                const int kl = 32 * (qt + kt) + crow(i, hi), dist = 128 + ql - kl;
                const bool valid = (dist >= 0) && (dist < 128) && ((s0 - 128 + kl) >= 0);
                const float lg = valid ? (X[i] * 0.125f - slope * (float)dist) : -1e30f;
                X[i] = lg; tm = fmaxf(tm, lg);
            }
            tm = fmaxf(tm, __shfl_xor(tm, 32));
            const float mn = fmaxf(m, tm), sc = __expf(m - mn);
            m = mn; lh *= sc;
#pragma unroll
            for (int i = 0; i < 16; ++i) { O0[i] *= sc; O1[i] *= sc; const float pe = __expf(X[i] - mn); X[i] = pe; lh += pe; }
            const LAS bf16* vp = VT + hkv * 12800 + r * 200 + 32 * (qt + kt) + 4 * hi;
            { const bf16x8 xs = pack8<0>(X); const bf16x8 a0 = lds4x2(vp), a1 = lds4x2(vp + 32 * 200); O0 = MFMA32(a0, xs, O0); O1 = MFMA32(a1, xs, O1); }
            { const bf16x8 xs = pack8<1>(X); const bf16x8 a0 = lds4x2(vp + 16), a1 = lds4x2(vp + 32 * 200 + 16); O0 = MFMA32(a0, xs, O0); O1 = MFMA32(a1, xs, O1); }
        }
        const float lsum = lh + __shfl_xor(lh, 32) + __expf(sink - m);
        const float iv = 1.f / lsum;
        float sq = 0.f;
#pragma unroll
        for (int i = 0; i < 16; ++i) sq += O0[i] * O0[i] + O1[i] * O1[i];
        sq *= iv * iv; sq += __shfl_xor(sq, 32);
        if (hi == 0) SSQ[hq * 32 + r] = sq;
        __syncthreads();
        float tot = 0.f;
#pragma unroll
        for (int h = 0; h < 8; ++h) tot += SSQ[h * 32 + r];
        const float sc = iv * rsqrtf(tot * (1.f / 512.f) + EPS);
        bf16* orow = MIXB + (size_t)tq * D + hq * 64 + 4 * hi;
#pragma unroll
        for (int q4 = 0; q4 < 4; ++q4) {
            const float4 g0 = *(const float4*)(gnorm + hq * 64 + 8 * q4 + 4 * hi), g1 = *(const float4*)(gnorm + hq * 64 + 32 + 8 * q4 + 4 * hi);
            uint2 w0, w1;
            w0.x = pkbf(O0[4 * q4] * sc * g0.x, O0[4 * q4 + 1] * sc * g0.y); w0.y = pkbf(O0[4 * q4 + 2] * sc * g0.z, O0[4 * q4 + 3] * sc * g0.w);
            w1.x = pkbf(O1[4 * q4] * sc * g1.x, O1[4 * q4 + 1] * sc * g1.y); w1.y = pkbf(O1[4 * q4 + 2] * sc * g1.z, O1[4 * q4 + 3] * sc * g1.w);
            *(uint2*)(orow + 8 * q4) = w0; *(uint2*)(orow + 32 + 8 * q4) = w1;
        }
        __syncthreads();
    }
}

__device__ __forceinline__ void ssd_chunk_unit(LAS unsigned char* ldsb, int unit, const bf16* PROJ, bf16* XACT, const float* DTRAW, const float* conv_w, const float* conv_b, const float* dt_bias, const float* a_log,
                                               float* ACS, float* CDEC, bf16* YD, bf16* STATES, int tid, int lane, int wave) {
    asm volatile("" : "+v"(tid), "+v"(lane));
    const int g = unit & 1, bc = unit >> 1, tok0 = bc * 128;
    LAS bf16* BT = (LAS bf16*)ldsb;
    LAS bf16* XD = (LAS bf16*)(ldsb + 34816);
    LAS float* ACST = (LAS float*)(ldsb + 104448);
    LAS float* DTT = (LAS float*)(ldsb + 106496);
    LAS float* WTAB = (LAS float*)(ldsb + 108544);
    LAS float* WT = (LAS float*)(ldsb + 110592);
    {
        const int s = tid >> 2, hh = tid & 3, H = g * 4 + hh;
        const float A = -__expf(a_log[H]);
        const float raw = DTRAW[(size_t)(tok0 + s) * 8 + H] + dt_bias[H];
        const float dtv = fmaxf(raw, 0.f) + log1pf(__expf(-fabsf(raw)));
        float v = dtv * A;
#pragma unroll
        for (int o = 4; o < 64; o <<= 1) { const float y = __shfl_up(v, o); if (lane >= o) v += y; }
        if (lane >= 60) WT[wave * 4 + hh] = v;
        __syncthreads();
        float off = 0.f, tot = 0.f;
        for (int w2 = 0; w2 < 8; ++w2) { const float wv = WT[w2 * 4 + hh]; tot += wv; if (w2 < wave) off += wv; }
        v += off;
        DTT[tid] = dtv; ACST[tid] = v; WTAB[hh * 128 + s] = __expf(tot - v); ACS[(size_t)(tok0 + s) * 8 + H] = v;
        if (s == 127) CDEC[bc * 8 + H] = __expf(v);
    }
    __syncthreads();
    {
        const int cgi = tid & 63, sg = tid >> 6, t0 = tok0 + 16 * sg;
        const int c0 = cgi < 32 ? g * 256 + cgi * 8 : (cgi < 48 ? 512 + g * 128 + (cgi - 32) * 8 : 768 + g * 128 + (cgi - 48) * 8);
        float w[4][8], bs[8];
#pragma unroll
        for (int k = 0; k < 4; ++k) { const float4 a0 = *(const float4*)(conv_w + k * 1024 + c0), a1 = *(const float4*)(conv_w + k * 1024 + c0 + 4);
            w[k][0] = a0.x; w[k][1] = a0.y; w[k][2] = a0.z; w[k][3] = a0.w; w[k][4] = a1.x; w[k][5] = a1.y; w[k][6] = a1.z; w[k][7] = a1.w; }
        { const float4 a0 = *(const float4*)(conv_b + c0), a1 = *(const float4*)(conv_b + c0 + 4); bs[0] = a0.x; bs[1] = a0.y; bs[2] = a0.z; bs[3] = a0.w; bs[4] = a1.x; bs[5] = a1.y; bs[6] = a1.z; bs[7] = a1.w; }
        const bool has_halo = (t0 & (SEQ - 1)) != 0;
        bf16x8 rows[19];
#pragma unroll
        for (int i = 0; i < 19; ++i) {
            if (i < 3 && !has_halo) {
#pragma unroll
                for (int e = 0; e < 8; ++e) rows[i][e] = 0;
            } else rows[i] = __builtin_nontemporal_load((const bf16x8*)(PROJ + (size_t)(t0 + i - 3) * PS + OXBC + c0));
        }
        const int kind = cgi < 32 ? 0 : (cgi < 48 ? 1 : 2);
        LAS bf16* img = kind == 0 ? XD + (cgi >> 3) * 8704 + ((cgi & 7) * 8) * 136 : BT + ((cgi - 32) * 8) * 136;
        const int hh = cgi >> 3;
#pragma unroll
        for (int i = 0; i < 16; ++i) {
            float o[8];
#pragma unroll
            for (int e = 0; e < 8; ++e) o[e] = silu_f(bs[e] + w[0][e] * sbf2f(rows[i][e]) + w[1][e] * sbf2f(rows[i + 1][e]) + w[2][e] * sbf2f(rows[i + 2][e]) + w[3][e] * sbf2f(rows[i + 3][e]));
            v4u ov; ov.x = pkbf(o[0], o[1]); ov.y = pkbf(o[2], o[3]); ov.z = pkbf(o[4], o[5]); ov.w = pkbf(o[6], o[7]);
            *(v4u*)(XACT + (size_t)(t0 + i) * 1024 + c0) = ov;
            const int s = 16 * sg + i;
            if (kind == 0) { const float dtv = DTT[s * 4 + hh];
#pragma unroll
                for (int e = 0; e < 8; ++e) img[e * 136 + s] = (bf16)bfs(o[e] * dtv);
            } else if (kind == 1) {
#pragma unroll
                for (int e = 0; e < 8; ++e) img[e * 136 + s] = (bf16)bfs(o[e]);
            }
        }
    }
    asm volatile("s_waitcnt vmcnt(0)" ::: "memory");
    __syncthreads();
    const int r = lane & 31, hi = lane >> 5;
    {
        const int lt = wave & 3, hA = wave >> 2, hB = hA + 2;
        const int l = 32 * lt + r; const float aclA = ACST[l * 4 + hA], aclB = ACST[l * 4 + hB];
        bf16x8 cf[8];
        { const bf16* cp = XACT + (size_t)(tok0 + l) * 1024 + 768 + g * 128 + 8 * hi; asm volatile("" : "+v"(cp));
#pragma unroll
          for (int ks = 0; ks < 8; ++ks) cf[ks] = ldg8(cp + 16 * ks); }
        f32x16 ZA0 = zero16(), ZA1 = zero16(), ZB0 = zero16(), ZB1 = zero16();
        bf16x8 bn[8];
        { const bf16* bp = XACT + (size_t)(tok0 + r) * 1024 + 512 + g * 128 + 8 * hi; asm volatile("" : "+v"(bp));
#pragma unroll
          for (int ks = 0; ks < 8; ++ks) bn[ks] = ldg8(bp + 16 * ks); }
#pragma unroll 1
        for (int st = 0; st <= lt; ++st) {
            f32x16 X = zero16();
            bf16x8 bcur[8];
#pragma unroll
            for (int ks = 0; ks < 8; ++ks) bcur[ks] = bn[ks];
            { const int stn = st < lt ? st + 1 : lt; const bf16* bp = XACT + (size_t)(tok0 + 32 * stn + r) * 1024 + 512 + g * 128 + 8 * hi; asm volatile("" : "+v"(bp));
#pragma unroll
              for (int ks = 0; ks < 8; ++ks) bn[ks] = ldg8(bp + 16 * ks); }
#pragma unroll
            for (int ks = 0; ks < 8; ++ks) X = MFMA32(bcur[ks], cf[ks], X);
            const int sb = 32 * st + 4 * hi;
            {
                f32x16 XA;
#pragma unroll
                for (int i = 0; i < 16; ++i) { const int s = 32 * st + crow(i, hi); XA[i] = (s <= l) ? X[i] * __expf(aclA - ACST[s * 4 + hA]) : 0.f; }
                const LAS bf16* xp = XD + hA * 8704 + r * 136 + sb;
                { const bf16x8 xs = pack8<0>(XA); ZA0 = MFMA32(xs, lds4x2(xp), ZA0); ZA1 = MFMA32(xs, lds4x2(xp + 32 * 136), ZA1); }
                { const bf16x8 xs = pack8<1>(XA); ZA0 = MFMA32(xs, lds4x2(xp + 16), ZA0); ZA1 = MFMA32(xs, lds4x2(xp + 32 * 136 + 16), ZA1); }
            }
            {
                f32x16 XB;
#pragma unroll
                for (int i = 0; i < 16; ++i) { const int s = 32 * st + crow(i, hi); XB[i] = (s <= l) ? X[i] * __expf(aclB - ACST[s * 4 + hB]) : 0.f; }
                const LAS bf16* xp = XD + hB * 8704 + r * 136 + sb;
                { const bf16x8 xs = pack8<0>(XB); ZB0 = MFMA32(xs, lds4x2(xp), ZB0); ZB1 = MFMA32(xs, lds4x2(xp + 32 * 136), ZB1); }
                { const bf16x8 xs = pack8<1>(XB); ZB0 = MFMA32(xs, lds4x2(xp + 16), ZB0); ZB1 = MFMA32(xs, lds4x2(xp + 32 * 136 + 16), ZB1); }
            }
        }
#pragma unroll
        for (int i = 0; i < 16; ++i) { bf16* o = YD + (size_t)(tok0 + 32 * lt + crow(i, hi)) * 512 + (g * 4 + hA) * 64 + r; o[0] = f2bf(ZA0[i]); o[32] = f2bf(ZA1[i]); o[128] = f2bf(ZB0[i]); o[160] = f2bf(ZB1[i]); }
    }
    {
        const int nt = wave & 3;
#pragma unroll 1
        for (int hq = 0; hq < 2; ++hq) {
            const int hh = (wave >> 2) + 2 * hq, H = g * 4 + hh;
            f32x16 S0 = zero16(), S1 = zero16();
#pragma unroll
            for (int ks = 0; ks < 8; ++ks) {
                const bf16x8 btf = lds8(BT + (32 * nt + r) * 136 + 16 * ks + 8 * hi);
                typedef float f4v __attribute__((ext_vector_type(4)));
                const f4v w0 = *(const LAS f4v*)(WTAB + hh * 128 + 16 * ks + 8 * hi), w1 = *(const LAS f4v*)(WTAB + hh * 128 + 16 * ks + 8 * hi + 4);
                const float wv[8] = {w0.x, w0.y, w0.z, w0.w, w1.x, w1.y, w1.z, w1.w};
                bf16x8 a0 = lds8(XD + hh * 8704 + r * 136 + 16 * ks + 8 * hi), a1 = lds8(XD + hh * 8704 + (32 + r) * 136 + 16 * ks + 8 * hi);
                v4u p0, p1;
                p0.x = pkbf(sbf2f(a0[0]) * wv[0], sbf2f(a0[1]) * wv[1]); p0.y = pkbf(sbf2f(a0[2]) * wv[2], sbf2f(a0[3]) * wv[3]); p0.z = pkbf(sbf2f(a0[4]) * wv[4], sbf2f(a0[5]) * wv[5]); p0.w = pkbf(sbf2f(a0[6]) * wv[6], sbf2f(a0[7]) * wv[7]);
                p1.x = pkbf(sbf2f(a1[0]) * wv[0], sbf2f(a1[1]) * wv[1]); p1.y = pkbf(sbf2f(a1[2]) * wv[2], sbf2f(a1[3]) * wv[3]); p1.z = pkbf(sbf2f(a1[4]) * wv[4], sbf2f(a1[5]) * wv[5]); p1.w = pkbf(sbf2f(a1[6]) * wv[6], sbf2f(a1[7]) * wv[7]);
                S0 = MFMA32(__builtin_bit_cast(bf16x8, p0), btf, S0); S1 = MFMA32(__builtin_bit_cast(bf16x8, p1), btf, S1);
            }
            bf16* sp = STATES + (size_t)(bc * 8 + H) * 8192 + 32 * nt + r;
#pragma unroll
            for (int i = 0; i < 16; ++i) { const int p = crow(i, hi); sp[p * 128] = f2bf(S0[i]); sp[(32 + p) * 128] = f2bf(S1[i]); }
        }
    }
    __syncthreads();
}

__device__ __forceinline__ __amdgpu_buffer_rsrc_t mk_rsrc(const void* p, unsigned bytes) { return __builtin_amdgcn_make_buffer_rsrc((void*)p, 0, bytes, 0x00020000); }
__device__ __forceinline__ void yoff_unit(const float* d_skip, const float* gnorm, LAS unsigned char* ldsb, int unit, const bf16* XACT, const bf16* PROJ, const float* ACS, const bf16* PREVT,
                                          const bf16* YD, bf16* MIXB, int lane, int wave) {
    const int g = unit & 1, bc = unit >> 1, tok0 = bc * 128;
    const int r = lane & 31, hi = lane >> 5, lt = wave & 3, hpair = wave >> 2;
    LAS float* TAB = (LAS float*)ldsb;
    const __amdgpu_buffer_rsrc_t rsF = mk_rsrc(YD, (unsigned)T * 512u * 2u), rsX = mk_rsrc(XACT, (unsigned)T * 1024u * 2u), rsP = mk_rsrc(PROJ, (unsigned)T * PS * 2u), rsA = mk_rsrc(ACS, (unsigned)T * 32u), rsB = mk_rsrc(MIXB, (unsigned)T * D * 2u);
    const unsigned tb = (unsigned)(tok0 + 32 * lt + 4 * hi);
    bf16x8 cf[8];
    { const bf16* cp = XACT + (size_t)(tok0 + 32 * lt + r) * 1024 + 768 + g * 128 + 8 * hi; asm volatile("" : "+v"(cp));
#pragma unroll
      for (int ks = 0; ks < 8; ++ks) cf[ks] = ldg8(cp + 16 * ks); }
    float eav[16], ssq[16];
    unsigned ypk[2][2][8];
#pragma unroll
    for (int i = 0; i < 16; ++i) ssq[i] = 0.f;
#pragma unroll
    for (int hsel = 0; hsel < 2; ++hsel) {
        const int H = g * 4 + 2 * hpair + hsel; const bf16* pv = PREVT + (size_t)(bc * 8 + H) * 8192 + 8 * hi;
        asm volatile("" : "+v"(pv));
        f32x16 Y0 = zero16(), Y1 = zero16();
#pragma unroll
        for (int ks = 0; ks < 8; ++ks) {
            const bf16x8 b0 = ldg8(pv + r * 128 + 16 * ks), b1 = ldg8(pv + (32 + r) * 128 + 16 * ks);
            Y0 = MFMA32(cf[ks], b0, Y0); Y1 = MFMA32(cf[ks], b1, Y1);
        }
        const float dsk = d_skip[H];
        { const unsigned vo = (tb * 8u + (unsigned)H) * 4u;
#pragma unroll
          for (int i = 0; i < 16; ++i) eav[i] = __expf(__builtin_bit_cast(float, __builtin_amdgcn_raw_buffer_load_b32(rsA, (int)vo, ((i & 3) + 8 * (i >> 2)) * 32, 0))); }
#pragma unroll
        for (int pt = 0; pt < 2; ++pt) {
            const unsigned col = (unsigned)(H * 64 + 32 * pt + r);
            const unsigned voF = (tb * 512u + col) * 2u, voX = (tb * 1024u + col) * 2u, voP = (tb * (unsigned)PS + (unsigned)OZ + col) * 2u;
            float yo[16], xsv[16], zv[16];
#pragma unroll
            for (int i = 0; i < 16; ++i) { const int ro = (i & 3) + 8 * (i >> 2);
                yo[i] = bf2f((bf16)__builtin_amdgcn_raw_buffer_load_b16(rsF, (int)voF, ro * 1024, 0));
                xsv[i] = bf2f((bf16)__builtin_amdgcn_raw_buffer_load_b16(rsX, (int)voX, ro * 2048, 0));
                zv[i] = bf2f((bf16)__builtin_amdgcn_raw_buffer_load_b16(rsP, (int)voP, ro * (PS * 2), 0)); }
#pragma unroll
            for (int i = 0; i < 16; i += 2) {
                const float y0 = (yo[i] + eav[i] * (pt ? Y1[i] : Y0[i]) + dsk * xsv[i]) * silu_f(zv[i]);
                const float y1 = (yo[i + 1] + eav[i + 1] * (pt ? Y1[i + 1] : Y0[i + 1]) + dsk * xsv[i + 1]) * silu_f(zv[i + 1]);
                ssq[i] += y0 * y0; ssq[i + 1] += y1 * y1; ypk[hsel][pt][i >> 1] = pkbf(y0, y1);
            }
            __builtin_amdgcn_sched_barrier(0);
        }
    }
#pragma unroll
    for (int i = 0; i < 16; ++i) {
#pragma unroll
        for (int o = 1; o < 32; o <<= 1) ssq[i] += __shfl_xor(ssq[i], o);
    }
    if (r == 0) {
#pragma unroll
        for (int i = 0; i < 16; ++i) TAB[hpair * 128 + 32 * lt + crow(i, hi)] = ssq[i];
    }
    __syncthreads();
#pragma unroll
    for (int i = 0; i < 16; ++i) { const int l = 32 * lt + crow(i, hi); ssq[i] = rsqrtf((TAB[l] + TAB[128 + l]) * (1.f / 256.f) + EPS); }
#pragma unroll
    for (int hsel = 0; hsel < 2; ++hsel)
#pragma unroll
        for (int pt = 0; pt < 2; ++pt) {
            const unsigned col = (unsigned)((g * 4 + 2 * hpair + hsel) * 64 + 32 * pt + r); const float gn = gnorm[col];
            const unsigned voB = (tb * 1024u + 512u + col) * 2u;
#pragma unroll
            for (int i = 0; i < 16; ++i) { const unsigned w = ypk[hsel][pt][i >> 1];
                const float yf = (i & 1) ? __uint_as_float(w & 0xffff0000u) : __uint_as_float(w << 16);
                __builtin_amdgcn_raw_buffer_store_b16((short)f2bf(yf * ssq[i] * gn), rsB, (int)voB, ((i & 3) + 8 * (i >> 2)) * 2048, 0); }
        }
    __syncthreads();
}
typedef float f32x2 __attribute__((ext_vector_type(2)));
__device__ __forceinline__ void fp8x16_to_f32(const uint4 w, float (&f)[16]) {
    const int ww[4] = {(int)w.x, (int)w.y, (int)w.z, (int)w.w};
#pragma unroll
    for (int q = 0; q < 4; ++q) { const f32x2 a = __builtin_amdgcn_cvt_pk_f32_fp8(ww[q], false), b = __builtin_amdgcn_cvt_pk_f32_fp8(ww[q], true); f[4 * q] = a.x; f[4 * q + 1] = a.y; f[4 * q + 2] = b.x; f[4 * q + 3] = b.y; }
}
template <int M4, int M2, int M1> __device__ __forceinline__ void treduce16(const float (&a)[16], int lane, float& r0, float& r1) {
    float b[8], c[4];
    { const bool hi = (lane & M4) != 0;
#pragma unroll
      for (int i = 0; i < 8; ++i) { const float send = hi ? a[i] : a[i + 8]; const float recv = __shfl_xor(send, M4); b[i] = (hi ? a[i + 8] : a[i]) + recv; } }
    { const bool hi = (lane & M2) != 0;
#pragma unroll
      for (int i = 0; i < 4; ++i) { const float send = hi ? b[i] : b[i + 4]; const float recv = __shfl_xor(send, M2); c[i] = (hi ? b[i + 4] : b[i]) + recv; } }
    { const bool hi = (lane & M1) != 0;
      { const float send = hi ? c[0] : c[2]; const float recv = __shfl_xor(send, M1); r0 = (hi ? c[2] : c[0]) + recv; }
      { const float send = hi ? c[1] : c[3]; const float recv = __shfl_xor(send, M1); r1 = (hi ? c[3] : c[1]) + recv; } }
}
template <int M4, int M2, int M1> __device__ __forceinline__ void treduce16i(const int (&a)[16], int lane, int& r0, int& r1) {
    int b[8], c[4];
    { const bool hi = (lane & M4) != 0;
#pragma unroll
      for (int i = 0; i < 8; ++i) { const int send = hi ? a[i] : a[i + 8]; const int recv = __shfl_xor(send, M4); b[i] = (hi ? a[i + 8] : a[i]) + recv; } }
    { const bool hi = (lane & M2) != 0;
#pragma unroll
      for (int i = 0; i < 4; ++i) { const int send = hi ? b[i] : b[i + 4]; const int recv = __shfl_xor(send, M2); c[i] = (hi ? b[i + 4] : b[i]) + recv; } }
    { const bool hi = (lane & M1) != 0;
      { const int send = hi ? c[0] : c[2]; const int recv = __shfl_xor(send, M1); r0 = (hi ? c[2] : c[0]) + recv; }
      { const int send = hi ? c[1] : c[3]; const int recv = __shfl_xor(send, M1); r1 = (hi ? c[3] : c[1]) + recv; } }
}
__device__ __forceinline__ void treduce16i_hw(const int (&a)[16], int lane, int& r0, int& r1) {
    int b[8], c[4];
#pragma unroll
    for (int i = 0; i < 8; ++i) { const auto r = __builtin_amdgcn_permlane32_swap((unsigned)a[i], (unsigned)a[i + 8], false, false); b[i] = (int)r[0] + (int)r[1]; }
#pragma unroll
    for (int i = 0; i < 4; ++i) { const auto r = __builtin_amdgcn_permlane16_swap((unsigned)b[i], (unsigned)b[i + 4], false, false); c[i] = (int)r[0] + (int)r[1]; }
    const bool hi = (lane & 8) != 0;
    { const int send = hi ? c[0] : c[2]; r0 = (hi ? c[2] : c[0]) + __builtin_amdgcn_update_dpp(0, send, 0x128, 0xf, 0xf, false); }
    { const int send = hi ? c[1] : c[3]; r1 = (hi ? c[3] : c[1]) + __builtin_amdgcn_update_dpp(0, send, 0x128, 0xf, 0xf, false); }
}
#define PE_ID(E, i) (((i) & 1) ? (E[(i) >> 1] >> 16) : (E[(i) >> 1] & 0xffffu))
__device__ __forceinline__ void peer_u_item(int p, int j, const LAS unsigned short* EL  , const unsigned char* __restrict__ XQ, const unsigned char* __restrict__ U8, LAS int* ACC  , int lane, int wave) {
    asm volatile("" : "+v"(lane));
    const int gidx = lane >> 3; const unsigned coff = (unsigned)(p * 128 + (lane & 7) * 16);
#pragma unroll 1
    for (int it = 0; it < 8; ++it) {
        const int t = j * 64 + it * 8 + wave;
        unsigned E[8];
        { const LAS v4u* ep = (const LAS v4u*)(EL + (it * 8 + wave) * 128 + 16 * gidx); const v4u e0 = ep[0], e1 = ep[1];
          E[0] = e0.x; E[1] = e0.y; E[2] = e0.z; E[3] = e0.w; E[4] = e1.x; E[5] = e1.y; E[6] = e1.z; E[7] = e1.w; }
        uint4 uu[16];
#pragma unroll
        for (int i = 0; i < 16; ++i) uu[i] = *(const uint4*)(U8 + (size_t)(PE_ID(E, i) * 1024u + coff));
        const uint4 xq = *(const uint4*)(XQ + (size_t)t * D + coff);
        int d[16];
#pragma unroll
        for (int i = 0; i < 16; ++i) {
            int s = __builtin_amdgcn_sdot4((int)uu[i].x, (int)xq.x, 0, false); s = __builtin_amdgcn_sdot4((int)uu[i].y, (int)xq.y, s, false);
            s = __builtin_amdgcn_sdot4((int)uu[i].z, (int)xq.z, s, false); s = __builtin_amdgcn_sdot4((int)uu[i].w, (int)xq.w, s, false);
            d[i] = s;
        }
        int r0, r1; treduce16i<4, 2, 1>(d, lane, r0, r1);
        { typedef int i2v __attribute__((ext_vector_type(2))); LAS i2v* ap = (LAS i2v*)(ACC + (it * 8 + wave) * 128 + 2 * lane);
          i2v a2; if (p == 0) { a2.x = r0; a2.y = r1; } else { a2 = *ap; a2.x += r0; a2.y += r1; } *ap = a2; }
    }
}
__device__ __forceinline__ void peer_v_item(int p, int j, const LAS unsigned short* EL, const LAS unsigned char* AL  , const LAS float* ASC  ,
                                            const unsigned char* __restrict__ V8, bf16* __restrict__ PEERO, int lane, int wave) {
    asm volatile("" : "+v"(lane));
    const __amdgpu_buffer_rsrc_t rsV = __builtin_amdgcn_make_buffer_rsrc((void*)V8, 0, 16384 * 1024, 0x00020000);
    const int gidx = lane >> 3; const unsigned coff = (unsigned)(p * 128 + (lane & 7) * 16);
#pragma unroll 1
    for (int it = 0; it < 8; ++it) {
        const int t = j * 64 + it * 8 + wave;
        unsigned E[8];
        { const LAS v4u* ep = (const LAS v4u*)(EL + (it * 8 + wave) * 128 + 16 * gidx); const v4u e0 = ep[0], e1 = ep[1];
          E[0] = e0.x; E[1] = e0.y; E[2] = e0.z; E[3] = e0.w; E[4] = e1.x; E[5] = e1.y; E[6] = e1.z; E[7] = e1.w; }
        uint4 vv[16];
#pragma unroll
        for (int i = 0; i < 16; ++i) { const v4u w_ = __builtin_amdgcn_raw_buffer_load_b128(rsV, (int)((PE_ID(E, i) << 10) + coff), 0, 0); vv[i] = make_uint4(w_.x, w_.y, w_.z, w_.w); }
        const v4u aq = *(const LAS v4u*)(AL + (it * 8 + wave) * 128 + 16 * gidx);
        const float asc = ASC[it * 8 + wave];
        const unsigned a4[4] = {aq.x, aq.y, aq.z, aq.w};
        int acc[16];
#pragma unroll
        for (int c = 0; c < 16; ++c) acc[c] = 0;
#pragma unroll
        for (int m = 0; m < 4; ++m) {
            const unsigned r0[4] = {vv[4 * m].x, vv[4 * m].y, vv[4 * m].z, vv[4 * m].w}, r1[4] = {vv[4 * m + 1].x, vv[4 * m + 1].y, vv[4 * m + 1].z, vv[4 * m + 1].w};
            const unsigned r2[4] = {vv[4 * m + 2].x, vv[4 * m + 2].y, vv[4 * m + 2].z, vv[4 * m + 2].w}, r3[4] = {vv[4 * m + 3].x, vv[4 * m + 3].y, vv[4 * m + 3].z, vv[4 * m + 3].w};
#pragma unroll
            for (int dc = 0; dc < 4; ++dc) {
                const unsigned ta = __builtin_amdgcn_perm(r1[dc], r0[dc], 0x05010400u), tb = __builtin_amdgcn_perm(r3[dc], r2[dc], 0x05010400u);
                const unsigned ua = __builtin_amdgcn_perm(r1[dc], r0[dc], 0x07030602u), ub = __builtin_amdgcn_perm(r3[dc], r2[dc], 0x07030602u);
                const unsigned c0 = __builtin_amdgcn_perm(tb, ta, 0x05040100u), c1 = __builtin_amdgcn_perm(tb, ta, 0x07060302u);
                const unsigned c2 = __builtin_amdgcn_perm(ub, ua, 0x05040100u), c3 = __builtin_amdgcn_perm(ub, ua, 0x07060302u);
                acc[4 * dc + 0] = __builtin_amdgcn_sdot4((int)c0, (int)a4[m], acc[4 * dc + 0], false);
                acc[4 * dc + 1] = __builtin_amdgcn_sdot4((int)c1, (int)a4[m], acc[4 * dc + 1], false);
                acc[4 * dc + 2] = __builtin_amdgcn_sdot4((int)c2, (int)a4[m], acc[4 * dc + 2], false);
                acc[4 * dc + 3] = __builtin_amdgcn_sdot4((int)c3, (int)a4[m], acc[4 * dc + 3], false);
            }
        }
        int r0i, r1i; treduce16i_hw(acc, lane, r0i, r1i);
        *(unsigned*)(PEERO + (size_t)t * D + coff + 2 * gidx) = pkbf(asc * (float)r0i, asc * (float)r1i);
    }
}

__device__ __forceinline__ void ce_desc(float& a, float& b) { const float hi = fmaxf(a, b), lo = fminf(a, b); a = hi; b = lo; }
__device__ __forceinline__ void sort16_desc(float (&v)[16]) {
#pragma unroll
    for (int k = 2; k <= 16; k <<= 1)
#pragma unroll
        for (int j = k >> 1; j > 0; j >>= 1)
#pragma unroll
            for (int i = 0; i < 16; ++i) { const int l = i ^ j; if (l > i) { if ((i & k) == 0) ce_desc(v[i], v[l]); else ce_desc(v[l], v[i]); } }
}
__device__ __forceinline__ void merge16_desc(float (&a)[16], const float (&b)[16]) {
#pragma unroll
    for (int i = 0; i < 16; ++i) a[i] = fmaxf(a[i], b[15 - i]);
#pragma unroll
    for (int j = 8; j > 0; j >>= 1)
#pragma unroll
        for (int i = 0; i < 16; ++i) { const int l = i ^ j; if (l > i) ce_desc(a[i], a[l]); }
}
__device__ __forceinline__ void ce_kv(float& ka, int& va, float& kb, int& vb) {
    const bool s = kb > ka; const float t0 = s ? kb : ka, t1 = s ? ka : kb; const int u0 = s ? vb : va, u1 = s ? va : vb; ka = t0; kb = t1; va = u0; vb = u1; }
__device__ __forceinline__ void sort16_kv(float (&k)[16], int (&v)[16]) {
#pragma unroll
    for (int kk = 2; kk <= 16; kk <<= 1)
#pragma unroll
        for (int j = kk >> 1; j > 0; j >>= 1)
#pragma unroll
            for (int i = 0; i < 16; ++i) { const int l = i ^ j; if (l > i) { if ((i & kk) == 0) ce_kv(k[i], v[i], k[l], v[l]); else ce_kv(k[l], v[l], k[i], v[i]); } }
}
__device__ __forceinline__ void merge16_kv(float (&ka)[16], int (&va)[16], const float (&kb)[16], const int (&vb)[16]) {
#pragma unroll
    for (int i = 0; i < 16; ++i) { const bool s = kb[15 - i] > ka[i]; ka[i] = s ? kb[15 - i] : ka[i]; va[i] = s ? vb[15 - i] : va[i]; }
#pragma unroll
    for (int j = 8; j > 0; j >>= 1)
#pragma unroll
        for (int i = 0; i < 16; ++i) { const int l = i ^ j; if (l > i) ce_kv(ka[i], va[i], ka[l], va[l]); }
}
__device__ __forceinline__ void split8(const float* p, bf16x8& hi8, bf16x8& lo8) {
    const float4 f0 = *(const float4*)p, f1 = *(const float4*)(p + 4);
    const float x[8] = {f0.x, f0.y, f0.z, f0.w, f1.x, f1.y, f1.z, f1.w};
#pragma unroll
    for (int j = 0; j < 8; ++j) { const short h = bfs(x[j]); hi8[j] = h; lo8[j] = bfs(x[j] - sbf2f(h)); }
}
__device__ __forceinline__ void route_task(int task, int tl0, const float* QP, const LAS bf16* KHL, LAS unsigned short* EL, LAS float* GL, int lane) {
    const int r = lane & 31, hi = lane >> 5, t = 4 * task + (r >> 3), head = r & 7;
    float top[2][16];
#pragma unroll
    for (int half = 0; half < 2; ++half) {
        bf16x8 qh[4], ql[4];
        { const float* qp = QP + (size_t)t * D + head * 128 + half * 64 + 8 * hi; asm volatile("" : "+v"(qp));
#pragma unroll
          for (int ks = 0; ks < 4; ++ks) split8(qp + 16 * ks, qh[ks], ql[ks]); }
        float cur[16];
#pragma unroll
        for (int kt = 0; kt < 4; ++kt) {
            f32x16 X = zero16();
            const LAS bf16* khp = KHL + (half * 128 + 32 * kt + r) * 72 + 8 * hi;
#pragma unroll
            for (int ks = 0; ks < 4; ++ks) {
                const bf16x8 kh = lds8(khp + 16 * ks), kl = lds8(khp + 2 * 128 * 72 + 16 * ks);
                X = MFMA32(kh, qh[ks], X); X = MFMA32(kh, ql[ks], X); X = MFMA32(kl, qh[ks], X);
            }
            float grp[16];
#pragma unroll
            for (int i = 0; i < 16; ++i) { const unsigned key = (unsigned)(32 * kt + crow(i, hi)); grp[i] = __uint_as_float((__float_as_uint(X[i]) & ~127u) | (127u - key)); }
            sort16_desc(grp);
            if (kt == 0) {
#pragma unroll
                for (int i = 0; i < 16; ++i) cur[i] = grp[i];
            } else merge16_desc(cur, grp);
        }
        float oth[16];
#pragma unroll
        for (int i = 0; i < 16; ++i) oth[i] = __shfl_xor(cur[i], 32);
        merge16_desc(cur, oth);
#pragma unroll
        for (int i = 0; i < 16; ++i) top[half][i] = cur[i];
    }
    unsigned P1[4], P2[4];
#pragma unroll
    for (int q = 0; q < 4; ++q) { P1[q] = 0u; P2[q] = 0u;
#pragma unroll
        for (int s = 0; s < 4; ++s) { P1[q] |= (127u - (__float_as_uint(top[0][4 * q + s]) & 127u)) << (8 * s); P2[q] |= (127u - (__float_as_uint(top[1][4 * q + s]) & 127u)) << (8 * s); } }
#define CAND(a, b) __uint_as_float((__float_as_uint(top[0][a] + top[1][b]) & ~255u) | (255u - (unsigned)((a) * 16 + (b))))
    float bk[16];
    {
        float gk[16];
        gk[0] = CAND(0, 0);
        gk[1] = CAND(0, 1);
        gk[2] = CAND(0, 2);
        gk[3] = CAND(0, 3);
        gk[4] = CAND(0, 4);
        gk[5] = CAND(0, 5);
        gk[6] = CAND(0, 6);
        gk[7] = CAND(0, 7);
        gk[8] = CAND(0, 8);
        gk[9] = CAND(0, 9);
        gk[10] = CAND(0, 10);
        gk[11] = CAND(0, 11);
        gk[12] = CAND(0, 12);
        gk[13] = CAND(0, 13);
        gk[14] = CAND(0, 14);
        gk[15] = CAND(0, 15);
        sort16_desc(gk);
#pragma unroll
        for (int i = 0; i < 16; ++i) bk[i] = gk[i];
    }
    {
        float gk[16];
        gk[0] = CAND(1, 0);
        gk[1] = CAND(1, 1);
        gk[2] = CAND(1, 2);
        gk[3] = CAND(1, 3);
        gk[4] = CAND(1, 4);
        gk[5] = CAND(1, 5);
        gk[6] = CAND(1, 6);
        gk[7] = CAND(1, 7);
        gk[8] = CAND(2, 0);
        gk[9] = CAND(2, 1);
        gk[10] = CAND(2, 2);
        gk[11] = CAND(2, 3);
        gk[12] = CAND(2, 4);
        gk[13] = CAND(3, 0);
        gk[14] = CAND(3, 1);
        gk[15] = CAND(3, 2);
        sort16_desc(gk);
        merge16_desc(bk, gk);
    }
    {
        float gk[16];
        gk[0] = CAND(3, 3);
        gk[1] = CAND(4, 0);
        gk[2] = CAND(4, 1);
        gk[3] = CAND(4, 2);
        gk[4] = CAND(5, 0);
        gk[5] = CAND(5, 1);
        gk[6] = CAND(6, 0);
        gk[7] = CAND(6, 1);
        gk[8] = CAND(7, 0);
        gk[9] = CAND(7, 1);
        gk[10] = CAND(8, 0);
        gk[11] = CAND(9, 0);
        gk[12] = CAND(10, 0);
        gk[13] = CAND(11, 0);
        gk[14] = CAND(12, 0);
        gk[15] = CAND(13, 0);
        sort16_desc(gk);
        merge16_desc(bk, gk);
    }
    {
        float gk[16];
        gk[0] = CAND(14, 0);
        gk[1] = CAND(15, 0);
        gk[2] = -INFINITY;
        gk[3] = -INFINITY;
        gk[4] = -INFINITY;
        gk[5] = -INFINITY;
        gk[6] = -INFINITY;
        gk[7] = -INFINITY;
        gk[8] = -INFINITY;
        gk[9] = -INFINITY;
        gk[10] = -INFINITY;
        gk[11] = -INFINITY;
        gk[12] = -INFINITY;
        gk[13] = -INFINITY;
        gk[14] = -INFINITY;
        gk[15] = -INFINITY;
        sort16_desc(gk);
        merge16_desc(bk, gk);
    }
#undef CAND
    int bv[16];
#pragma unroll
    for (int i = 0; i < 16; ++i) {
        const unsigned cd = 255u - (__float_as_uint(bk[i]) & 255u), ca = cd >> 4, cb = cd & 15u;
        const unsigned wa = (ca >> 2) == 0u ? P1[0] : (ca >> 2) == 1u ? P1[1] : (ca >> 2) == 2u ? P1[2] : P1[3];
        const unsigned wb = (cb >> 2) == 0u ? P2[0] : (cb >> 2) == 1u ? P2[1] : (cb >> 2) == 2u ? P2[2] : P2[3];
        bv[i] = (int)((((wa >> (8u * (ca & 3u))) & 255u) << 7) | ((wb >> (8u * (cb & 3u))) & 255u));
    }
    float e[16], se = 0.f;
#pragma unroll
    for (int i = 0; i < 16; ++i) { e[i] = __expf(bk[i] - bk[0]); se += e[i]; }
    const float inv = 1.f / se;
    if (hi == 0) {
        LAS v4u* ip = (LAS v4u*)(EL + (tl0 + (r >> 3)) * 128 + head * 16); typedef float f4v __attribute__((ext_vector_type(4))); LAS f4v* gp = (LAS f4v*)(GL + (tl0 + (r >> 3)) * 128 + head * 16);
#pragma unroll
        for (int q = 0; q < 2; ++q) ip[q] = (v4u){(unsigned)bv[8 * q] | ((unsigned)bv[8 * q + 1] << 16), (unsigned)bv[8 * q + 2] | ((unsigned)bv[8 * q + 3] << 16), (unsigned)bv[8 * q + 4] | ((unsigned)bv[8 * q + 5] << 16), (unsigned)bv[8 * q + 6] | ((unsigned)bv[8 * q + 7] << 16)};
#pragma unroll
        for (int q = 0; q < 4; ++q) gp[q] = (f4v){e[4 * q] * inv, e[4 * q + 1] * inv, e[4 * q + 2] * inv, e[4 * q + 3] * inv};
    }
}

#define XB_TMO      128
#define XB_XCNT(j)  (256  + 64 * (j))
#define XB_XSUB(j)  (1280 + 64 * (j))
#define XB_XGEN(j)  (2304 + 64 * (j))
#define XB_TOP      3328
#define XB_TOPGEN   3392
#define XCD_BAR_WORDS 3456
#define XB_SPIN_CAP (1u << 22)
__device__ __forceinline__ unsigned xb_ld(unsigned* p)              { return __hip_atomic_load(p, __ATOMIC_RELAXED, __HIP_MEMORY_SCOPE_AGENT); }
__device__ __forceinline__ unsigned xb_add(unsigned* p, unsigned v) { return __hip_atomic_fetch_add(p, v, __ATOMIC_RELAXED, __HIP_MEMORY_SCOPE_AGENT); }
__device__ __forceinline__ unsigned xb_xcc_id() { return (unsigned)__builtin_amdgcn_s_getreg((3 << 11) | 20) & 0xFu; }
#define XB_SPIN(cond, bar) do { unsigned _sp = 0; while (cond) { __builtin_amdgcn_s_sleep(1); \
    if ((++_sp & 255u) == 0u) { if (xb_ld(&(bar)[XB_TMO])) break; if (_sp > XB_SPIN_CAP) { atomicAdd(&(bar)[XB_TMO], 1u); break; } } } } while (0)
struct XcdBarrier { unsigned* bar; unsigned x; volatile LAS unsigned* st; };
__device__ __forceinline__ XcdBarrier xcd_barrier_post(unsigned* bar, volatile LAS unsigned* st) {
    XcdBarrier b; b.bar = bar; b.x = xb_xcc_id(); b.st = st;
    if (threadIdx.x == 0) (void)xb_add(&bar[XB_XCNT(b.x)], 1u);
    return b;
}
__device__ __forceinline__ void xcd_barrier_complete(unsigned* bar, unsigned x, unsigned& nloc, unsigned& nx) {
    const unsigned G = gridDim.x * gridDim.y * gridDim.z;
    unsigned sum, cnt, mine, sp = 0u;
    for (;;) {
        sum = 0u; cnt = 0u; mine = 0u;
#pragma unroll
        for (unsigned j = 0; j < 16; ++j) { const unsigned c = xb_ld(&bar[XB_XCNT(j)]); sum += c; cnt += (c > 0u) ? 1u : 0u; mine = (j == x) ? c : mine; }
        if (sum == G) break;
        __builtin_amdgcn_s_sleep(1);
        if ((++sp & 255u) == 0u) { if (xb_ld(&bar[XB_TMO])) break; if (sp > XB_SPIN_CAP) { atomicAdd(&bar[XB_TMO], 1u); break; } }
    }
    nloc = mine > 0u ? mine : 1u; nx = cnt > 0u ? cnt : 1u;
}
__device__ __forceinline__ void xcd_barrier(const XcdBarrier& b) {
    asm volatile("s_waitcnt vmcnt(0)" ::: "memory");
    __syncthreads();
    if (threadIdx.x == 0) {
        unsigned* bar = b.bar;
        __builtin_amdgcn_s_waitcnt(0);
        unsigned nloc = b.st[0], nx = b.st[1];
        if (nloc == 0u) { xcd_barrier_complete(bar, b.x, nloc, nx); b.st[0] = nloc; b.st[1] = nx; }
        const unsigned old = xb_add(&bar[XB_XSUB(b.x)], 1u);
        const unsigned gen = old / nloc;
        if (old + 1u == (gen + 1u) * nloc) {
            __builtin_amdgcn_fence(__ATOMIC_RELEASE, "agent");
            asm volatile("s_waitcnt vmcnt(0)" ::: "memory");
            const unsigned og = xb_add(&bar[XB_TOP], 1u);
            const unsigned tg = og / nx;
            if (og + 1u == (tg + 1u) * nx) xb_add(&bar[XB_TOPGEN], 1u);
            else XB_SPIN(xb_ld(&bar[XB_TOPGEN]) == tg, bar);
            __builtin_amdgcn_fence(__ATOMIC_ACQUIRE, "agent");
            xb_add(&bar[XB_XGEN(b.x)], 1u);
            asm volatile("s_waitcnt vmcnt(0)" ::: "memory");
        } else {
            XB_SPIN(xb_ld(&bar[XB_XGEN(b.x)]) == gen, bar);
            __builtin_amdgcn_fence(__ATOMIC_ACQUIRE, "agent");
            asm volatile("s_waitcnt vmcnt(0)" ::: "memory");
        }
    }
    __syncthreads();
}
constexpr int LDS_BYTES = 147456;
constexpr int MISC_OFF = 131072 + 320;

__global__ void __launch_bounds__(NTHR, 2) k_main(Args a) {
    extern __shared__ __attribute__((aligned(16))) unsigned char lds_raw[];
    LAS unsigned char* ldsb = (LAS unsigned char*)lds_raw;
    const int tid0 = threadIdx.x, bid = blockIdx.x, nb = gridDim.x;
    const int wave = __builtin_amdgcn_readfirstlane(tid0 >> 6);
    const int gthreads = nb * NTHR, nwaves = gthreads >> 6;
#define PHASE_VARS() int tid = tid0; asm volatile("" : "+v"(tid)); const int lane = tid & 63, gtid = bid * NTHR + tid, gwave = gtid >> 6; (void)lane; (void)gtid; (void)gwave
    unsigned char* ws = a.ws;
    bf16* WINT = (bf16*)(ws + WS_WIN); bf16* WOT = (bf16*)(ws + WS_WO); bf16* WQT = (bf16*)(ws + WS_WQ);
    bf16* PROJ = (bf16*)(ws + WS_PROJ);
    bf16* XNB = (bf16*)(ws + WS_XNB);
    bf16* XACT = (bf16*)(ws + WS_XACT);
    float* DTRAW = (float*)(ws + WS_DTRAW); float* DT = (float*)(ws + WS_DT); float* ACS = (float*)(ws + WS_ACS); float* CDEC = (float*)(ws + WS_CDEC);
    bf16* STATES = (bf16*)(ws + WS_STATES); bf16* PREVT = (bf16*)(ws + WS_PREV); bf16* YD = (bf16*)a.out;
    float* QP = (float*)(ws + WS_QP); unsigned short* IDX = (unsigned short*)(ws + WS_IDX); float* GATE = (float*)(ws + WS_GATE);
    float* TOPV = (float*)(ws + WS_TOPV); int* TOPI = (int*)(ws + WS_TOPI);
    unsigned char* U8 = ws + WS_U8; unsigned char* V8 = ws + WS_V8; float* SU = (float*)(ws + WS_SU); float* SV = SU + 16384; bf16* PART = (bf16*)(ws + WS_PART); unsigned char* XQ = ws + WS_XQ; float* XS = (float*)(ws + WS_XS);
    bf16* KH = (bf16*)(ws + WS_KH); bf16* KL = (bf16*)(ws + WS_KH + 65536);
    bf16* HB = (bf16*)(ws + WS_STATES);
    float* MIXF = a.out;
    volatile LAS unsigned* MISC = (volatile LAS unsigned*)(ldsb + MISC_OFF);
    if (tid0 < 32) MISC[tid0] = 0u;
    __syncthreads();
    XcdBarrier bar = xcd_barrier_post((unsigned*)ws, MISC + 8);
#define IN(k) (a.ph_lo <= (k) && (k) < a.ph_hi)
#if defined(PROBE_LO)
    int seg_ = 0; unsigned long long tseg_ = __builtin_amdgcn_s_memrealtime();
#define PROBE_SPIN() do { if (seg_ >= PROBE_LO && seg_ <= PROBE_HI) { const unsigned long long d_ = (__builtin_amdgcn_s_memrealtime() - tseg_) * PROBE_AMP; const unsigned long long s_ = __builtin_amdgcn_s_memrealtime(); \
        while (__builtin_amdgcn_s_memrealtime() - s_ < d_) __builtin_amdgcn_s_sleep(4); } } while (0)
#define GRID_BAR() do { PROBE_SPIN(); xcd_barrier(bar); tseg_ = __builtin_amdgcn_s_memrealtime(); ++seg_; } while (0)
#else
#define PROBE_SPIN() do { } while (0)
#define GRID_BAR() xcd_barrier(bar)
#endif

    if (IN(0)) {
        PHASE_VARS();
        LAS float* scr = (LAS float*)(ldsb + wave * 16384);
        constexpr int I_IN = 16 * 72, I_O = 16 * 32, NITEMS = I_IN + 2 * I_O;
        for (int it = gwave; it < NITEMS; it += nwaves) {
            int r = it;
            if (r < I_IN) { transpose_item(a.w_in, PW, D, WINT, scr, r / 72, r % 72, lane); continue; } r -= I_IN;
            if (r < I_O) { transpose_item(a.w_out, D, D, WOT, scr, r / 32, r % 32, lane); continue; } r -= I_O;
            transpose_item(a.peer_wq, D, D, WQT, scr, r / 32, r % 32, lane);
        }
        for (int i = gtid; i < 2 * 128 * 64; i += gthreads) { const float kf = a.peer_sub_keys[i]; const short h = bfs(kf); KH[i] = (bf16)h; KL[i] = (bf16)bfs(kf - sbf2f(h)); }
        for (int i = tid; i < 8 * 1024; i += NTHR) { const int h = i & 7, c = i >> 3; *(LAS float*)(ldsb + h * 16384 + 8448 + c * 4) = a.w_in[(size_t)c * PW + ODT + h]; }
        __syncthreads();
        rmsnorm_rows_bf16<1>(a.x, a.norm_mix_g, XNB, ldsb, DTRAW, nullptr, nullptr, gwave, nwaves, lane);
    }
    GRID_BAR();
    if (IN(1)) {
        PHASE_VARS();
        pg8::Gemm g{XNB, WINT, T, PS, D}; pg8::StaticOrder S; S.init(T, PS, nb, bid);
        pg8::EpiBf16Plain E{PROJ, PS};
        pg8::gemm_phase<pg8::EpiBf16Plain, pg8::StaticOrder>(ldsb, g, S, E, nullptr);
        const int cfirst = (nb == 256) ? 64 : 0;
        if (bid >= cfirst) for (int rr0 = ((bid - cfirst) * 8 + wave) * 4; rr0 < 2 * 16384; rr0 += (nb - cfirst) * 8 * 4) {
            float4 v[4][4];
#pragma unroll
            for (int q = 0; q < 4; ++q) { const int rr = rr0 + q, which = rr >> 14, row = rr & 16383;
                typedef float f4v __attribute__((ext_vector_type(4))); const f4v* src4 = (const f4v*)((which ? a.peer_v : a.peer_u) + (size_t)row * D) + lane;
#pragma unroll
                for (int jq = 0; jq < 4; ++jq) { const f4v t4 = __builtin_nontemporal_load(src4 + 64 * jq); v[q][jq] = make_float4(t4.x, t4.y, t4.z, t4.w); } }
#pragma unroll
            for (int q = 0; q < 4; ++q) { const int rr = rr0 + q, which = rr >> 14, row = rr & 16383;
                float mx = 0.f;
#pragma unroll
                for (int jq = 0; jq < 4; ++jq) mx = fmaxf(mx, fmaxf(fmaxf(fabsf(v[q][jq].x), fabsf(v[q][jq].y)), fmaxf(fabsf(v[q][jq].z), fabsf(v[q][jq].w))));
#pragma unroll
                for (int o = 1; o < 64; o <<= 1) mx = fmaxf(mx, __shfl_xor(mx, o));
                const float sc = mx > 0.f ? mx * (1.f / 127.f) : 1.f, inv = 1.f / sc;
                unsigned* dst = (unsigned*)((which ? V8 : U8) + (size_t)row * D) + lane;
#pragma unroll
                for (int jq = 0; jq < 4; ++jq) { const int q0 = (int)rintf(v[q][jq].x * inv), q1 = (int)rintf(v[q][jq].y * inv), q2 = (int)rintf(v[q][jq].z * inv), q3 = (int)rintf(v[q][jq].w * inv);
                    dst[64 * jq] = (unsigned)(q0 & 255) | ((unsigned)(q1 & 255) << 8) | ((unsigned)(q2 & 255) << 16) | ((unsigned)(q3 & 255) << 24); }
                if (lane == 0) (which ? SV : SU)[row] = sc; }
        }
    }
    GRID_BAR();
    if (IN(3)) {
        PHASE_VARS();
        for (int u = bid; u < 512; u += nb) {
            if (u < 256) attn_unit(a.attn_sinks, a.attn_out_g, ldsb, u, PROJ, XNB, tid, lane, wave);
            else ssd_chunk_unit(ldsb, u - 256, PROJ, XACT, DTRAW, a.conv_w, a.conv_b, a.dt_bias, a.a_log, ACS, CDEC, YD, STATES, tid, lane, wave);
        }
    }
    GRID_BAR();
    if (IN(5)) {
        PHASE_VARS();
        for (int idx = gtid; idx < 2 * 8 * 8192; idx += gthreads) {
            const int pn = idx & 8191, h = (idx >> 13) & 7, b = idx >> 16;
            float run = 0.f;
#pragma unroll 1
            for (int c0 = 0; c0 < 64; c0 += 8) {
                float st[8], dc[8];
#pragma unroll
                for (int j = 0; j < 8; ++j) { const int bch = (b * 64 + c0 + j) * 8 + h; st[j] = bf2f(STATES[(size_t)bch * 8192 + pn]); dc[j] = CDEC[bch]; }
#pragma unroll
                for (int j = 0; j < 8; ++j) { const int bch = (b * 64 + c0 + j) * 8 + h; PREVT[(size_t)bch * 8192 + pn] = f2bf(run); run = dc[j] * run + st[j]; }
            }
        }
    }
    GRID_BAR();
    if (IN(6)) {
        PHASE_VARS();
        for (int u = bid; u < 256; u += nb) yoff_unit(a.d_skip, a.ssm_norm_g, ldsb, u, XACT, PROJ, ACS, PREVT, YD, XNB, lane, wave);
    }
    GRID_BAR();
    if (IN(7)) {
        PHASE_VARS();
        pg8::Gemm g{XNB, WOT, T, D, D}; pg8::StaticOrder S; S.init(T, D, nb, bid);
        pg8::EpiBf16Resid E{HB, a.x, D};
        pg8::gemm_phase<pg8::EpiBf16Resid, pg8::StaticOrder>(ldsb, g, S, E, nullptr);
    }
    GRID_BAR();
    if (IN(8)) {
        PHASE_VARS();
        rmsnorm_rows_bf16<2>((const float*)HB, a.norm_ffn_g, XNB, ldsb, nullptr, XQ, XS, gwave, nwaves, lane);
    }
    GRID_BAR();
    if (IN(9)) {
        PHASE_VARS();
        pg8::Gemm g{XNB, WQT, T, D, D}; pg8::StaticOrder S; S.init(T, D, nb, bid);
        pg8::EpiF32Resid E{QP, nullptr, D};
        pg8::gemm_phase<pg8::EpiF32Resid, pg8::StaticOrder>(ldsb, g, S, E, nullptr);
    }
    GRID_BAR();
    bf16* PEERO = (bf16*)(ws + WS_PEERO);
    if (IN(12)) {
        PHASE_VARS();
        LAS bf16* KHL = (LAS bf16*)ldsb; LAS int* ACC = (LAS int*)ldsb; LAS unsigned char* AL = (LAS unsigned char*)(ldsb + 32768); LAS float* ASC = (LAS float*)(ldsb + 40960);
        LAS unsigned short* EL = (LAS unsigned short*)(ldsb + 73728); LAS float* GL = (LAS float*)(ldsb + 90112);
#pragma unroll 1
        for (int j = bid; j < NCHUNK; j += nb) {
            __syncthreads();
            for (int i = tid; i < 2 * 2 * 128 * 8; i += NTHR) {
                const int pc = i & 7, key = (i >> 3) & 127, hf = (i >> 10) & 1, hl = i >> 11;
                *(LAS v4u*)(KHL + ((hl * 2 + hf) * 128 + key) * 72 + pc * 8) = *(const v4u*)((hl ? KL : KH) + (size_t)(hf * 128 + key) * 64 + pc * 8);
            }
            __syncthreads();
            route_task(16 * j + wave, 4 * wave, QP, KHL, EL, GL, lane);
            route_task(16 * j + 8 + wave, 32 + 4 * wave, QP, KHL, EL, GL, lane);
            __syncthreads();
#pragma unroll 1
            for (int p = 0; p < NPART; ++p) peer_u_item(p, j, EL, XQ, U8, ACC, lane, wave);
#pragma unroll 1
            for (int it = 0; it < 8; ++it) {
                const int tl = it * 8 + wave, t = j * 64 + tl;
                const unsigned ew = *(const LAS unsigned*)(EL + tl * 128 + 2 * lane); const int e0 = (int)(ew & 0xffffu), e1 = (int)(ew >> 16);
                typedef int i2v __attribute__((ext_vector_type(2))); const i2v si = *(const LAS i2v*)(ACC + tl * 128 + 2 * lane);
                typedef float f2v __attribute__((ext_vector_type(2))); const f2v gt = *(const LAS f2v*)(GL + tl * 128 + 2 * lane); const float xs = XS[t];
                const float z0 = (float)si.x * SU[e0] * xs, z1 = (float)si.y * SU[e1] * xs;
                const float a0 = gt.x * 0.5f * z0 * (1.f + erff(z0 * 0.70710678118654752f)) * SV[e0], a1 = gt.y * 0.5f * z1 * (1.f + erff(z1 * 0.70710678118654752f)) * SV[e1];
                float mx = fmaxf(fabsf(a0), fabsf(a1));
#pragma unroll
                for (int o = 1; o < 64; o <<= 1) mx = fmaxf(mx, __shfl_xor(mx, o));
                const float sc = mx > 0.f ? mx * (1.f / 127.f) : 1.f, inv = 1.f / sc;
                *(LAS unsigned short*)(AL + tl * 128 + 2 * lane) = (unsigned short)(((int)rintf(a0 * inv) & 255) | (((int)rintf(a1 * inv) & 255) << 8));
                if (lane == 0) ASC[tl] = sc;
            }
#pragma unroll 1
            for (int p = 0; p < NPART; ++p) peer_v_item(p, j, EL, AL, ASC, V8, PEERO, lane, wave);
            asm volatile("s_waitcnt vmcnt(0)" ::: "memory");
#pragma unroll 1
            for (int it = 0; it < 8; ++it) {
                const int t = j * 64 + it * 8 + wave;
                const uint2* hr = (const uint2*)(HB + (size_t)t * D) + lane; unsigned long long* pr = (unsigned long long*)(PEERO + (size_t)t * D) + lane;
                float4 v[4]; float ss = 0.f;
#pragma unroll
                for (int jq = 0; jq < 4; ++jq) { const uint2 hw = hr[64 * jq]; const unsigned long long pw = __hip_atomic_load(pr + 64 * jq, __ATOMIC_RELAXED, __HIP_MEMORY_SCOPE_AGENT);
                    const unsigned pl = (unsigned)pw, ph = (unsigned)(pw >> 32);
                    v[jq] = make_float4(__uint_as_float(hw.x << 16) + __uint_as_float(pl << 16), __uint_as_float(hw.x & 0xffff0000u) + __uint_as_float(pl & 0xffff0000u),
                                        __uint_as_float(hw.y << 16) + __uint_as_float(ph << 16), __uint_as_float(hw.y & 0xffff0000u) + __uint_as_float(ph & 0xffff0000u));
                    ss += v[jq].x * v[jq].x + v[jq].y * v[jq].y + v[jq].z * v[jq].z + v[jq].w * v[jq].w; }
                ss = wave_sum(ss);
                const float r3 = rsqrtf(ss * (1.f / D) + EPS);
                float4* op = (float4*)(a.out + (size_t)t * D) + lane;
#pragma unroll
                for (int jq = 0; jq < 4; ++jq) { const float4 gv = ((const float4*)a.final_norm_g)[lane + 64 * jq]; op[64 * jq] = make_float4(v[jq].x * r3 * gv.x, v[jq].y * r3 * gv.y, v[jq].z * r3 * gv.z, v[jq].w * r3 * gv.w); }
            }
        }
    }
    PROBE_SPIN();
#undef IN
}
}

extern "C" void kernel_launch(void* const* d_in, const int* in_sizes, int n_in, void* d_out, int out_size, void* d_ws, size_t ws_size, hipStream_t stream) {
    if (n_in != 18 || out_size != T * D || ws_size < WS_END) { fprintf(stderr, "kernel_launch: unexpected shapes n_in=%d out=%d ws=%zu\n", n_in, out_size, ws_size); return; }
    Args a{};
    const float** ap = (const float**)&a;
    for (int i = 0; i < 18; ++i) ap[i] = (const float*)d_in[i];
    a.out = (float*)d_out; a.ws = (unsigned char*)d_ws;
    static int grid = 0;
    if (grid == 0) {
        int dev = 0, cus = 0, per_cu = 0;
        if (hipGetDevice(&dev) != hipSuccess || hipDeviceGetAttribute(&cus, hipDeviceAttributeMultiprocessorCount, dev) != hipSuccess) { fprintf(stderr, "kernel_launch: device query failed\n"); grid = -1; return; }
        if (hipFuncSetAttribute((const void*)k_main, hipFuncAttributeMaxDynamicSharedMemorySize, LDS_BYTES) != hipSuccess) { fprintf(stderr, "kernel_launch: hipFuncSetAttribute failed\n"); grid = -1; return; }
        if (hipOccupancyMaxActiveBlocksPerMultiprocessor(&per_cu, (const void*)k_main, NTHR, LDS_BYTES) != hipSuccess || per_cu < 1) { fprintf(stderr, "kernel_launch: occupancy query says %d blocks/CU\n", per_cu); (void)hipGetLastError(); grid = -1; return; }
        grid = cus;
    }
    if (grid < 0) return;
    if (hipMemsetAsync(d_ws, 0, 65536, stream) != hipSuccess) { fprintf(stderr, "kernel_launch: memset failed\n"); return; }
    a.ph_lo = 0; a.ph_hi = 13;
    hipLaunchKernelGGL(k_main, dim3(grid), dim3(NTHR), LDS_BYTES, stream, a);
}
```

```cpp
#include <hip/hip_runtime.h>
#include <cstdio>
#include <cstdint>

namespace pg8 {
#define PG8_LAS __attribute__((address_space(3)))
typedef unsigned short bf16_t;
typedef short bf16x8 __attribute__((ext_vector_type(8)));
typedef float f32x4 __attribute__((ext_vector_type(4)));
typedef unsigned u32x4 __attribute__((ext_vector_type(4)));
constexpr int BM = 256, BK = 64, HALF = 128, HTB = HALF * BK * 2  , STAGE_BYTES = 8 * HTB, NXCD = 8, WGM = 8;

__host__ __device__ __forceinline__ int lds_byte(int r, int c) { const int st = (r >> 4) * 2 + (c >> 5), rr = r & 15, cc = c & 31, ob = rr * 64 + cc * 2; return st * 1024 + (ob ^ (((ob >> 9) & 1) << 5)); }
__host__ __device__ __forceinline__ void stage_rc(int b, int& R, int& C) { const int st = b / 1024, sb = b % 1024, swz = sb ^ (((sb >> 9) & 1) << 5); R = (st >> 1) * 16 + swz / 64; C = (st & 1) * 32 + (swz % 64) / 2; }
__host__ __device__ __forceinline__ int perm32(int rho) { const int n = rho >> 4, i = rho & 15; return 8 * (i >> 2) + 4 * n + (i & 3); }

struct Unit { int pm, pn; };
struct Gemm { const bf16_t* A; const bf16_t* Bt; int M, N, K; };

struct StaticOrder {
    int nM, nN, nwg, G, c;
    __host__ __device__ void init(int M, int N, int G_, int c_) { nM = M / BM; nN = N / BM; nwg = nM * nN; G = G_; c = c_; }
    __host__ __device__ bool next(int i, Unit& u) const {
        const long L = (long)i * G + c; if (L >= nwg) return false;
        int wgid = (int)L; { const int q = nwg / NXCD, r = nwg % NXCD, xcd = wgid % NXCD, off = wgid / NXCD; wgid = (xcd < r ? xcd * (q + 1) : r * (q + 1) + (xcd - r) * q) + off; }
        const int nig = WGM * nN, gid = wgid / nig, fm = gid * WGM, gsz = (nM - fm) < WGM ? (nM - fm) : WGM;
        u.pm = fm + ((wgid % nig) % gsz); u.pn = (wgid % nig) / gsz; return true;
    }
    __device__ __forceinline__ void a_ready(const Unit&) const {}
    __device__ __forceinline__ void done(const Unit&) const {}
};
__device__ __forceinline__ unsigned cvt_pk_bf16(float lo, float hi) { unsigned r; asm volatile("v_cvt_pk_bf16_f32 %0, %1, %2" : "=v"(r) : "v"(lo), "v"(hi)); return r; }
typedef float f32x2 __attribute__((ext_vector_type(2)));
struct EpiBf16Plain {
    static constexpr bool PERM = true, AFTER_DRAIN = false;
    bf16_t* O; int ldc;
    __device__ __forceinline__ void operator()(const f32x4 (&acc)[2][2][4][2], const Unit& u, int wr, int wc, int fr, int fq) const {
        const int row0 = u.pm * BM + wr * 64 + fr, col0 = u.pn * BM + wc * 32 + 8 * fq;
        const __amdgpu_buffer_rsrc_t rs = __builtin_amdgcn_make_buffer_rsrc((void*)O, 0, 0x7fffffff, 0x00020000);
#pragma unroll
        for (int ai = 0; ai < 2; ++ai)
#pragma unroll
            for (int m = 0; m < 4; ++m) { const unsigned ro = ((unsigned)(row0 + ai * HALF + m * 16) * (unsigned)ldc + (unsigned)col0) * 2u;
#pragma unroll
                for (int bj = 0; bj < 2; ++bj) { const f32x4 v0 = acc[ai][bj][m][0], v1 = acc[ai][bj][m][1];
                    u32x4 w; w.x = cvt_pk_bf16(v0[0], v0[1]); w.y = cvt_pk_bf16(v0[2], v0[3]); w.z = cvt_pk_bf16(v1[0], v1[1]); w.w = cvt_pk_bf16(v1[2], v1[3]);
                    __builtin_amdgcn_raw_buffer_store_b128(w, rs, (int)(ro + bj * HALF * 2), 0, 16); } }
    }
};
struct EpiF32Resid {
    static constexpr bool PERM = false, AFTER_DRAIN = false;
    float* C; const float* R; int ldc;
    __device__ __forceinline__ void operator()(const f32x4 (&acc)[2][2][4][2], const Unit& u, int wr, int wc, int fr, int fq) const {
        const int row0 = u.pm * BM + wr * 64 + fr, col0 = u.pn * BM + wc * 32 + 4 * fq;
#pragma unroll
        for (int ai = 0; ai < 2; ++ai)
#pragma unroll
            for (int m = 0; m < 4; ++m) { const size_t off = (size_t)(row0 + ai * HALF + m * 16) * ldc + col0;
#pragma unroll
                for (int bj = 0; bj < 2; ++bj)
#pragma unroll
                    for (int n = 0; n < 2; ++n) { f32x4 v = acc[ai][bj][m][n]; if (R) v += *(const f32x4*)(R + off + bj * HALF + n * 16); *(f32x4*)(C + off + bj * HALF + n * 16) = v; }
                asm volatile("" ::: "memory"); }
    }
};

struct EpiBf16Resid {
    static constexpr bool PERM = true, AFTER_DRAIN = false;
    bf16_t* O; const float* R; int ldc;
    __device__ __forceinline__ void operator()(const f32x4 (&acc)[2][2][4][2], const Unit& u, int wr, int wc, int fr, int fq) const {
        const int row0 = u.pm * BM + wr * 64 + fr, col0 = u.pn * BM + wc * 32 + 8 * fq;
#pragma unroll
        for (int ai = 0; ai < 2; ++ai)
#pragma unroll
            for (int m = 0; m < 4; ++m) { const size_t off = (size_t)(row0 + ai * HALF + m * 16) * ldc + col0;
#pragma unroll
                for (int bj = 0; bj < 2; ++bj) { const f32x4 v0 = acc[ai][bj][m][0] + *(const f32x4*)(R + off + bj * HALF), v1 = acc[ai][bj][m][1] + *(const f32x4*)(R + off + bj * HALF + 4);
                    u32x4 w; w.x = cvt_pk_bf16(v0[0], v0[1]); w.y = cvt_pk_bf16(v0[2], v0[3]); w.z = cvt_pk_bf16(v1[0], v1[1]); w.w = cvt_pk_bf16(v1[2], v1[3]);
                    *(u32x4*)(O + off + bj * HALF) = w; }
                asm volatile("" ::: "memory"); }
    }
};
template <class Epi, class Sched, bool STAMP = false>
__device__ __forceinline__ void gemm_phase(PG8_LAS unsigned char* lds, const Gemm g, const Sched& S, const Epi& E, unsigned long long* stamps) {
    const int tid = threadIdx.x, wid = __builtin_amdgcn_readfirstlane(tid >> 6), lane = tid & 63, wr = wid >> 2, wc = wid & 3, fr = lane & 15, fq = lane >> 4;
    const int K = g.K, nt = K / BK;
    int ts_lo = 0, ts_hi = 0, nts = 0; const unsigned long long rt_entry = STAMP ? (unsigned long long)0ull : 0ull;
#define PG8_STAMP() do { if (STAMP && wid == 0 && nts < 64) { const unsigned long long _c = (unsigned long long)clock64(); \
        ts_lo = (lane == nts) ? (int)(unsigned)_c : ts_lo; ts_hi = (lane == nts) ? (int)(unsigned)(_c >> 32) : ts_hi; ++nts; } } while (0)
    PG8_STAMP();
    unsigned voffA[2], voffB[2];
#pragma unroll
    for (int i = 0; i < 2; ++i) { int R, C; stage_rc(tid * 16 + i * 8192, R, C); const int Rb = Epi::PERM ? ((R & ~31) + perm32(R & 31)) : R;
        voffA[i] = (unsigned)(R * K + C) * 2u; voffB[i] = (unsigned)(Rb * K + C) * 2u; }
    const size_t kstep = (size_t)(BK * 2);
    const size_t hstep = (size_t)HALF * K * 2;
    const size_t tstep = 2 * hstep;
    const unsigned ldsw = (unsigned)wid * 1024u;
    const int aoff = lds_byte(wr * 64 + fr, fq * 8), boff = lds_byte(wc * 32 + fr, fq * 8);
#define PG8_SA(b, h) (((b) * 2 + (h)) * HTB)
#define PG8_SB(b, h) ((4 + (b) * 2 + (h)) * HTB)
#define PG8_STAGE(bufoff, gbase, voff) do { _Pragma("unroll") for (int _i = 0; _i < 2; ++_i) \
        __builtin_amdgcn_global_load_lds((const unsigned*)((const char*)(gbase) + (voff)[_i]), (PG8_LAS unsigned*)(lds + (bufoff) + ldsw + _i * 8192), 16, 0, 0); } while (0)
#define PG8_LDA(dst, b, h) do { _Pragma("unroll") for (int m = 0; m < 4; ++m) _Pragma("unroll") for (int k = 0; k < 2; ++k) dst[m][k] = *(const PG8_LAS bf16x8*)(lds + PG8_SA(b, h) + aoff + m * 2048 + k * 1024); } while (0)
#define PG8_LDB(dst, b, h) do { _Pragma("unroll") for (int n = 0; n < 2; ++n) _Pragma("unroll") for (int k = 0; k < 2; ++k) dst[n][k] = *(const PG8_LAS bf16x8*)(lds + PG8_SB(b, h) + boff + n * 2048 + k * 1024); } while (0)
#define PG8_MMA(ai, bj, At, Bt) do { __builtin_amdgcn_s_setprio(1); _Pragma("unroll") for (int m = 0; m < 4; ++m) _Pragma("unroll") for (int n = 0; n < 2; ++n) _Pragma("unroll") for (int k = 0; k < 2; ++k) \
        acc[ai][bj][m][n] = __builtin_amdgcn_mfma_f32_16x16x32_bf16(Bt[n][k], At[m][k], acc[ai][bj][m][n], 0, 0, 0); __builtin_amdgcn_s_setprio(0); } while (0)
#define PG8_WAIT_V(n) asm volatile("s_waitcnt vmcnt(" #n ")" ::: "memory")
#define PG8_WAIT_L(n) asm volatile("s_waitcnt lgkmcnt(" #n ")" ::: "memory")
#define PG8_BAR __builtin_amdgcn_s_barrier()
#define PG8_SCHED __builtin_amdgcn_sched_barrier(0)
    Unit cur, nxt; int ui = 0;
    if (!S.next(0, cur)) return;
    f32x4 acc[2][2][4][2];
#pragma unroll
    for (int a = 0; a < 2; ++a)
#pragma unroll
        for (int b = 0; b < 2; ++b)
#pragma unroll
            for (int m = 0; m < 4; ++m)
#pragma unroll
                for (int n = 0; n < 2; ++n) acc[a][b][m][n] = (f32x4){0.f, 0.f, 0.f, 0.f};
    bf16x8 At[4][2], B0[2][2], B1[2][2];
    const char* cA = (const char*)g.A + (size_t)cur.pm * tstep; const char* cB = (const char*)g.Bt + (size_t)cur.pn * tstep;
    S.a_ready(cur);
    PG8_STAGE(PG8_SB(0, 0), cB, voffB); PG8_STAGE(PG8_SA(0, 0), cA, voffA); PG8_STAGE(PG8_SB(0, 1), cB + hstep, voffB); PG8_STAGE(PG8_SA(0, 1), cA + hstep, voffA);
    if (wr == 1) PG8_BAR;
    PG8_WAIT_V(4); PG8_BAR;
    PG8_STAGE(PG8_SB(1, 0), cB + kstep, voffB); PG8_STAGE(PG8_SA(1, 0), cA + kstep, voffA); PG8_STAGE(PG8_SB(1, 1), cB + hstep + kstep, voffB);
    PG8_WAIT_V(6); PG8_BAR;
    PG8_STAMP();
    for (;;) {
        const bool has_next = S.next(ui + 1, nxt);
        const char* nA = has_next ? (const char*)g.A + (size_t)nxt.pm * tstep : cA; const char* nB = has_next ? (const char*)g.Bt + (size_t)nxt.pn * tstep : cB;
        for (int t = 0; t < nt; t += 2) {
            const bool last = (t == nt - 2);
            const char* a1 = cA + (size_t)(t + 1) * kstep;
            const char* a2 = last ? nA : cA + (size_t)(t + 2) * kstep; const char* b2 = last ? nB : cB + (size_t)(t + 2) * kstep;
            const char* a3 = a2 + kstep; const char* b3 = b2 + kstep;
            if (last && has_next) S.a_ready(nxt);
            PG8_LDB(B0, 0, 0); PG8_SCHED; PG8_LDA(At, 0, 0); PG8_STAGE(PG8_SA(1, 1), a1 + hstep, voffA);
            PG8_WAIT_L(8); PG8_BAR; PG8_WAIT_L(0); PG8_MMA(0, 0, At, B0); PG8_BAR; PG8_SCHED;
            PG8_LDB(B1, 0, 1); PG8_STAGE(PG8_SB(0, 0), b2, voffB);
            PG8_BAR; PG8_WAIT_L(0); PG8_MMA(0, 1, At, B1); PG8_BAR;
            PG8_LDA(At, 0, 1); PG8_STAGE(PG8_SA(0, 0), a2, voffA);
            PG8_BAR; PG8_WAIT_L(0); PG8_MMA(1, 0, At, B0); PG8_BAR; PG8_SCHED;
            PG8_STAGE(PG8_SB(0, 1), b2 + hstep, voffB);
            PG8_WAIT_V(6); PG8_BAR; PG8_MMA(1, 1, At, B1); PG8_BAR;
            PG8_LDB(B0, 1, 0); PG8_SCHED; PG8_LDA(At, 1, 0); PG8_STAGE(PG8_SA(0, 1), a2 + hstep, voffA);
            PG8_WAIT_L(8); PG8_BAR; PG8_WAIT_L(0); PG8_MMA(0, 0, At, B0); PG8_BAR; PG8_SCHED;
            PG8_LDB(B1, 1, 1); PG8_STAGE(PG8_SB(1, 0), b3, voffB);
            PG8_BAR; PG8_WAIT_L(0); PG8_MMA(0, 1, At, B1); PG8_BAR;
            PG8_LDA(At, 1, 1); PG8_STAGE(PG8_SA(1, 0), a3, voffA);
            PG8_BAR; PG8_WAIT_L(0); PG8_MMA(1, 0, At, B0); PG8_BAR; PG8_SCHED;
            PG8_STAGE(PG8_SB(1, 1), b3 + hstep, voffB);
            PG8_WAIT_V(6); PG8_BAR; PG8_MMA(1, 1, At, B1); PG8_BAR;
        }
        PG8_STAMP();
        if constexpr (!Epi::AFTER_DRAIN) { E(acc, cur, wr, wc, fr, fq); S.done(cur); }
        PG8_STAMP();
        if (!has_next) break;
#pragma unroll
        for (int a = 0; a < 2; ++a)
#pragma unroll
            for (int b = 0; b < 2; ++b)
#pragma unroll
                for (int m = 0; m < 4; ++m)
#pragma unroll
                    for (int n = 0; n < 2; ++n) acc[a][b][m][n] = (f32x4){0.f, 0.f, 0.f, 0.f};
        cur = nxt; cA = nA; cB = nB; ++ui;
    }
    PG8_WAIT_V(0);
    if (wr == 0) PG8_BAR;
    PG8_BAR;
    if constexpr (Epi::AFTER_DRAIN) { E.fused(acc, cur, wr, wc, fr, fq, lds, wid, lane); S.done(cur); }
    PG8_STAMP();
    if (STAMP && wid == 0) { stamps[lane] = lane < nts ? (((unsigned long long)(unsigned)ts_hi << 32) | (unsigned)ts_lo) : 0ull;
        if (lane == 62) stamps[62] = rt_entry; if (lane == 63) stamps[63] = (unsigned long long)0ull; }
#undef PG8_STAMP
#undef PG8_SA
#undef PG8_SB
#undef PG8_STAGE
#undef PG8_LDA
#undef PG8_LDB
#undef PG8_MMA
#undef PG8_WAIT_V
#undef PG8_WAIT_L
#undef PG8_BAR
#undef PG8_SCHED
}
}

namespace {
constexpr int D = 1024, BATCH = 2, SEQ = 8192, T = BATCH * SEQ;
constexpr int PW = 2312;
constexpr int PS = 2304;
constexpr int OQ = 0, OKK = 512, OV = 640, OZ = 768, OXBC = 1280, ODT = 2304;
constexpr float EPS = 1e-6f;
constexpr int NTHR = 512;
typedef unsigned short bf16;
typedef unsigned v4u __attribute__((ext_vector_type(4)));

constexpr size_t MiB = 1u << 20;
constexpr size_t WS_WIN = 1 * MiB;
constexpr size_t WS_KH = 5 * MiB + 512 * 1024;
constexpr size_t WS_WO = 6 * MiB;
constexpr size_t WS_WQ = 8 * MiB;
constexpr size_t WS_PROJ = 10 * MiB;
constexpr size_t WS_XNB = 82 * MiB;
constexpr size_t WS_XACT = 114 * MiB;
constexpr size_t WS_DTRAW = 146 * MiB;
constexpr size_t WS_DT = WS_DTRAW + 512 * 1024;
constexpr size_t WS_ACS = WS_DT + 512 * 1024;
constexpr size_t WS_CDEC = WS_ACS + 512 * 1024;
constexpr size_t WS_STATES = 164 * MiB;
constexpr size_t WS_PREV = 196 * MiB;
constexpr size_t WS_QP = 10 * MiB;
constexpr size_t WS_IDX = 74 * MiB;
constexpr size_t WS_GATE = 114 * MiB;
constexpr size_t WS_TOPV = 122 * MiB;
constexpr size_t WS_TOPI = 138 * MiB;
constexpr size_t WS_ACT = 122 * MiB;
constexpr size_t WS_SU = 245 * MiB;
constexpr size_t WS_U8 = 212 * MiB;
constexpr size_t WS_V8 = 148 * MiB;
constexpr size_t WS_PART = 10 * MiB;
constexpr size_t WS_XQ = 228 * MiB;
constexpr size_t WS_XS = 244 * MiB;
constexpr size_t WS_PEERO = 10 * MiB;
constexpr size_t WS_END = 246 * MiB;
constexpr int CW_QU = 4096, CW_QV = 4096 + 64 * 16;
constexpr int NPART = 8, NCHUNK = T / 64;

struct Args {
    const float* x; const float* norm_mix_g; const float* w_in; const float* attn_sinks; const float* attn_out_g;
    const float* conv_w; const float* conv_b; const float* dt_bias; const float* a_log; const float* d_skip;
    const float* ssm_norm_g; const float* w_out; const float* norm_ffn_g; const float* peer_wq; const float* peer_sub_keys;
    const float* peer_u; const float* peer_v; const float* final_norm_g;
    float* out; unsigned char* ws;
    int ph_lo, ph_hi;
};

#define LAS __attribute__((address_space(3)))
#define LDS_WAIT() asm volatile("s_waitcnt lgkmcnt(0)" ::: "memory")
__device__ __forceinline__ float bf2f(bf16 v) { return __uint_as_float(((unsigned)v) << 16); }
__device__ __forceinline__ unsigned f2bfu(float f) { unsigned u = __float_as_uint(f); return (u + 0x7fffu + ((u >> 16) & 1u)) >> 16; }
__device__ __forceinline__ bf16 f2bf(float f) { return (bf16)f2bfu(f); }
__device__ __forceinline__ unsigned pk2(float lo, float hi) { return f2bfu(lo) | (f2bfu(hi) << 16); }
__device__ __forceinline__ float wave_sum(float v) {
#pragma unroll
    for (int o = 1; o < 64; o <<= 1) v += __shfl_xor(v, o);
    return v;
}
__device__ __forceinline__ float silu_f(float v) { return v / (1.f + __expf(-v)); }

__device__ __forceinline__ void transpose_item(const float* W, int ldw, int K, bf16* WT, LAS float* scr, int kb, int nbk, int lane) {
    const int k0 = 64 * kb, n0 = 32 * nbk;
#pragma unroll 8
    for (int i = 0; i < 32; ++i) { const int kk = 2 * i + (lane >> 5); scr[kk * 33 + (lane & 31)] = W[(size_t)(k0 + kk) * ldw + n0 + (lane & 31)]; }
    LDS_WAIT();
    const int c = lane & 7;
#pragma unroll
    for (int j = 0; j < 4; ++j) { const int n = (lane >> 3) + 8 * j; const LAS float* s = scr + (8 * c) * 33 + n;
        v4u o; o.x = pk2(s[0 * 33], s[1 * 33]); o.y = pk2(s[2 * 33], s[3 * 33]); o.z = pk2(s[4 * 33], s[5 * 33]); o.w = pk2(s[6 * 33], s[7 * 33]);
        *(v4u*)(WT + (size_t)(n0 + n) * K + k0 + 8 * c) = o; }
    LDS_WAIT();
}

template <int MODE  >
__device__ __forceinline__ void rmsnorm_rows_bf16(const float* __restrict__ in, const float* __restrict__ g, bf16* __restrict__ outp, const LAS unsigned char* ldsb, float* __restrict__ dtraw, unsigned char* __restrict__ xq, float* __restrict__ xs, int gwave, int nwaves, int lane) {
#pragma unroll 2
    for (int row = gwave; row < T; row += nwaves) {
        const float4* xr = (const float4*)(in + (size_t)row * D) + lane; const uint2* xb = (const uint2*)((const bf16*)in + (size_t)row * D) + lane;
        float4 v[4]; float ss = 0.f;
#pragma unroll
        for (int j = 0; j < 4; ++j) {
            if (MODE == 2) { const uint2 w = xb[64 * j]; v[j] = make_float4(__uint_as_float(w.x << 16), __uint_as_float(w.x & 0xffff0000u), __uint_as_float(w.y << 16), __uint_as_float(w.y & 0xffff0000u)); }
            else if (MODE == 1) { typedef float f4v __attribute__((ext_vector_type(4))); const f4v t4 = __builtin_nontemporal_load((const f4v*)xr + 64 * j); v[j] = make_float4(t4.x, t4.y, t4.z, t4.w); }
            else v[j] = xr[64 * j];
            ss += v[j].x * v[j].x + v[j].y * v[j].y + v[j].z * v[j].z + v[j].w * v[j].w; }
        ss = wave_sum(ss);
        const float r = rsqrtf(ss * (1.f / D) + EPS);
        unsigned long long* o8 = (unsigned long long*)(outp + (size_t)row * D) + lane;
        float dacc[8]; float y[4][4]; float mx = 0.f;
#pragma unroll
        for (int h = 0; h < 8; ++h) dacc[h] = 0.f;
#pragma unroll
        for (int j = 0; j < 4; ++j) {
            const float4 gv = ((const float4*)g)[lane + 64 * j];
            y[j][0] = v[j].x * r * gv.x; y[j][1] = v[j].y * r * gv.y; y[j][2] = v[j].z * r * gv.z; y[j][3] = v[j].w * r * gv.w;
            o8[64 * j] = (unsigned long long)pk2(y[j][0], y[j][1]) | ((unsigned long long)pk2(y[j][2], y[j][3]) << 32);
            if (MODE == 2) mx = fmaxf(mx, fmaxf(fmaxf(fabsf(y[j][0]), fabsf(y[j][1])), fmaxf(fabsf(y[j][2]), fabsf(y[j][3]))));
            if (MODE == 1) {
#pragma unroll
                for (int h = 0; h < 8; ++h) {
                    typedef float f4v __attribute__((ext_vector_type(4)));
                    const f4v wv = *(const LAS f4v*)(ldsb + h * 16384 + 8448 + (256 * j + 4 * lane) * 4);
                    dacc[h] += y[j][0] * wv.x + y[j][1] * wv.y + y[j][2] * wv.z + y[j][3] * wv.w;
                }
            }
        }
        if (MODE == 1) {
#pragma unroll
            for (int h = 0; h < 8; ++h) dacc[h] = wave_sum(dacc[h]);
            if (lane == 0) { float4* dp = (float4*)(dtraw + (size_t)row * 8); dp[0] = make_float4(dacc[0], dacc[1], dacc[2], dacc[3]); dp[1] = make_float4(dacc[4], dacc[5], dacc[6], dacc[7]); }
        }
        if (MODE == 2) {
#pragma unroll
            for (int o = 1; o < 64; o <<= 1) mx = fmaxf(mx, __shfl_xor(mx, o));
            const float sc = mx > 0.f ? mx * (1.f / 127.f) : 1.f, inv = 1.f / sc;
            unsigned* dq = (unsigned*)(xq + (size_t)row * D) + lane;
#pragma unroll
            for (int j = 0; j < 4; ++j) { const int q0 = (int)rintf(y[j][0] * inv), q1 = (int)rintf(y[j][1] * inv), q2 = (int)rintf(y[j][2] * inv), q3 = (int)rintf(y[j][3] * inv);
                dq[64 * j] = (unsigned)(q0 & 255) | ((unsigned)(q1 & 255) << 8) | ((unsigned)(q2 & 255) << 16) | ((unsigned)(q3 & 255) << 24); }
            if (lane == 0) xs[row] = sc;
        }
    }
}

typedef short bf16x8 __attribute__((ext_vector_type(8)));
typedef short bf16x4 __attribute__((ext_vector_type(4)));
typedef float f32x16 __attribute__((ext_vector_type(16)));
typedef __bf16 bf2_t __attribute__((ext_vector_type(2)));
#define MFMA32(a, b, c) __builtin_amdgcn_mfma_f32_32x32x16_bf16((a), (b), (c), 0, 0, 0)
__device__ __forceinline__ unsigned pkbf(float lo, float hi) { bf2_t v = {(__bf16)lo, (__bf16)hi}; return __builtin_bit_cast(unsigned, v); }
__device__ __forceinline__ short bfs(float f) { return __builtin_bit_cast(short, (__bf16)f); }
__device__ __forceinline__ float sbf2f(short v) { return __uint_as_float(((unsigned)(unsigned short)v) << 16); }
__device__ __forceinline__ int crow(int i, int hi) { return (i & 3) + 8 * (i >> 2) + 4 * hi; }
template <int S> __device__ __forceinline__ bf16x8 pack8(const f32x16& x) {
    v4u p; p.x = pkbf(x[8 * S], x[8 * S + 1]); p.y = pkbf(x[8 * S + 2], x[8 * S + 3]); p.z = pkbf(x[8 * S + 4], x[8 * S + 5]); p.w = pkbf(x[8 * S + 6], x[8 * S + 7]);
    return __builtin_bit_cast(bf16x8, p);
}
__device__ __forceinline__ bf16x8 ldg8(const bf16* p) { return *(const bf16x8*)p; }
__device__ __forceinline__ bf16x8 lds8(const LAS bf16* p) { return *(const LAS bf16x8*)p; }
__device__ __forceinline__ bf16x8 lds4x2(const LAS bf16* p) { const bf16x4 a = *(const LAS bf16x4*)p, b = *(const LAS bf16x4*)(p + 8); return __builtin_shufflevector(a, b, 0, 1, 2, 3, 4, 5, 6, 7); }
__device__ __forceinline__ f32x16 zero16() { f32x16 z;
#pragma unroll
    for (int i = 0; i < 16; ++i) z[i] = 0.f;
    return z; }

__device__ __forceinline__ void attn_unit(const float* sinks, const float* gnorm, LAS unsigned char* ldsb, int unit, const bf16* PROJ, bf16* MIXB, int tid, int lane, int wave) {
    asm volatile("" : "+v"(tid), "+v"(lane));
    const int tok0 = unit * 64, s0 = tok0 & (SEQ - 1), kbase = tok0 - 128;
    LAS bf16* VT = (LAS bf16*)ldsb;
    LAS bf16* KI = (LAS bf16*)(ldsb + 51200);
    LAS float* SSQ = (LAS float*)(ldsb + 51200 + 55296);
    const __amdgpu_buffer_rsrc_t rsP = __builtin_amdgcn_make_buffer_rsrc((void*)PROJ, 0, (unsigned)T * PS * 2u, 0x00020000);
#pragma unroll
    for (int i = 0; i < 6; ++i) {
        const int c = tid + 512 * i, kv = c / 1536, cc = c - kv * 1536, key = cc >> 3, d0 = (cc & 7) * 8; const bool valid = (s0 - 128 + key) >= 0;
        bf16x8 v, k;
#pragma unroll
        for (int e = 0; e < 8; ++e) { v[e] = 0; k[e] = 0; }
        if (valid) { const unsigned ro = (unsigned)(kbase + key) * (unsigned)PS + (unsigned)(kv * 64 + d0);
            v = __builtin_bit_cast(bf16x8, __builtin_amdgcn_raw_buffer_load_b128(rsP, (int)((ro + (unsigned)OV) * 2u), 0, 2));
            k = __builtin_bit_cast(bf16x8, __builtin_amdgcn_raw_buffer_load_b128(rsP, (int)((ro + (unsigned)OKK) * 2u), 0, 2)); }
#pragma unroll
        for (int e = 0; e < 8; ++e) VT[kv * 12800 + (d0 + e) * 200 + key] = (bf16)v[e];
        *(LAS bf16x8*)(KI + (kv * 192 + key) * 72 + d0) = k;
    }
    __syncthreads();
    const int r = lane & 31, hi = lane >> 5;
    const int hq = wave, hkv = wave >> 2;
    const float slope = exp2f(-(float)(hq + 1)), sink = sinks[hq];
#pragma unroll 1
    for (int qt = 0; qt < 2; ++qt) {
        const int tq = tok0 + 32 * qt + r;
        bf16x8 qf[4];
        { const bf16* qp = PROJ + (size_t)tq * PS + OQ + hq * 64 + 8 * hi; asm volatile("" : "+v"(qp));
#pragma unroll
          for (int ks = 0; ks < 4; ++ks) qf[ks] = ldg8(qp + 16 * ks); }
        const int ql = 32 * qt + r;
        float m = sink, lh = 0.f;
        f32x16 O0 = zero16(), O1 = zero16();
#pragma unroll 1
        for (int kt = 0; kt < 5; ++kt) {
            const LAS bf16* kp = KI + (hkv * 192 + 32 * (qt + kt) + r) * 72 + 8 * hi;
            f32x16 X = zero16();
#pragma unroll
            for (int ks = 0; ks < 4; ++ks) X = MFMA32(lds8(kp + 16 * ks), qf[ks], X);
            float tm = -1e30f;
#pragma unroll
            for (int i = 0; i < 16; ++i) {
                const int kl = 32 * (qt + kt) + crow(i, hi), dist = 128 + ql - kl;
                const bool valid = (dist >= 0) && (dist < 128) && ((s0 - 128 + kl) >= 0);
                const float lg = valid ? (X[i] * 0.125f - slope * (float)dist) : -1e30f;
                X[i] = lg; tm = fmaxf(tm, lg);
            }
            tm = fmaxf(tm, __shfl_xor(tm, 32));
            const float mn = fmaxf(m, tm), sc = __expf(m - mn);
            m = mn; lh *= sc;
#pragma unroll
            for (int i = 0; i < 16; ++i) { O0[i] *= sc; O1[i] *= sc; const float pe = __expf(X[i] - mn); X[i] = pe; lh += pe; }
            const LAS bf16* vp = VT + hkv * 12800 + r * 200 + 32 * (qt + kt) + 4 * hi;
            { const bf16x8 xs = pack8<0>(X); const bf16x8 a0 = lds4x2(vp), a1 = lds4x2(vp + 32 * 200); O0 = MFMA32(a0, xs, O0); O1 = MFMA32(a1, xs, O1); }
            { const bf16x8 xs = pack8<1>(X); const bf16x8 a0 = lds4x2(vp + 16), a1 = lds4x2(vp + 32 * 200 + 16); O0 = MFMA32(a0, xs, O0); O1 = MFMA32(a1, xs, O1); }
        }
        const float lsum = lh + __shfl_xor(lh, 32) + __expf(sink - m);
        const float iv = 1.f / lsum;
        float sq = 0.f;
#pragma unroll
        for (int i = 0; i < 16; ++i) sq += O0[i] * O0[i] + O1[i] * O1[i];
        sq *= iv * iv; sq += __shfl_xor(sq, 32);
        if (hi == 0) SSQ[hq * 32 + r] = sq;
        __syncthreads();
        float tot = 0.f;
#pragma unroll
        for (int h = 0; h < 8; ++h) tot += SSQ[h * 32 + r];
        const float sc = iv * rsqrtf(tot * (1.f / 512.f) + EPS);
        bf16* orow = MIXB + (size_t)tq * D + hq * 64 + 4 * hi;
#pragma unroll
        for (int q4 = 0; q4 < 4; ++q4) {
            const float4 g0 = *(const float4*)(gnorm + hq * 64 + 8 * q4 + 4 * hi), g1 = *(const float4*)(gnorm + hq * 64 + 32 + 8 * q4 + 4 * hi);
            uint2 w0, w1;
            w0.x = pkbf(O0[4 * q4] * sc * g0.x, O0[4 * q4 + 1] * sc * g0.y); w0.y = pkbf(O0[4 * q4 + 2] * sc * g0.z, O0[4 * q4 + 3] * sc * g0.w);
            w1.x = pkbf(O1[4 * q4] * sc * g1.x, O1[4 * q4 + 1] * sc * g1.y); w1.y = pkbf(O1[4 * q4 + 2] * sc * g1.z, O1[4 * q4 + 3] * sc * g1.w);
            *(uint2*)(orow + 8 * q4) = w0; *(uint2*)(orow + 32 + 8 * q4) = w1;
        }
        __syncthreads();
    }
}

#define SWZ(row, s) ((row) * 136 + (((((s) >> 3) ^ (((row) >> 3) & 7)) << 3) | ((s) & 7)))
__device__ __forceinline__ bf16x8 lds4s(const LAS bf16* img, int row, int s) { const bf16x4 a = *(const LAS bf16x4*)(img + SWZ(row, s)), b = *(const LAS bf16x4*)(img + SWZ(row, s + 8)); return __builtin_shufflevector(a, b, 0, 1, 2, 3, 4, 5, 6, 7); }
__device__ __forceinline__ void ssd_chunk_unit(LAS unsigned char* ldsb, int unit, const bf16* PROJ, bf16* XACT, const float* DTRAW, const float* conv_w, const float* conv_b, const float* dt_bias, const float* a_log,
                                               float* ACS, float* CDEC, bf16* YD, bf16* STATES, int tid, int lane, int wave) {
    asm volatile("" : "+v"(tid), "+v"(lane));
    const int g = unit & 1, bc = unit >> 1, tok0 = bc * 128;
    LAS bf16* BT = (LAS bf16*)ldsb;
    LAS bf16* XD = (LAS bf16*)(ldsb + 34816);
    LAS float* ACST = (LAS float*)(ldsb + 104448);
    LAS float* DTT = (LAS float*)(ldsb + 106496);
    LAS float* WTAB = (LAS float*)(ldsb + 108544);
    LAS float* WT = (LAS float*)(ldsb + 110592);
    {
        const int s = tid >> 2, hh = tid & 3, H = g * 4 + hh;
        const float A = -__expf(a_log[H]);
        const float raw = DTRAW[(size_t)(tok0 + s) * 8 + H] + dt_bias[H];
        const float dtv = fmaxf(raw, 0.f) + log1pf(__expf(-fabsf(raw)));
        float v = dtv * A;
#pragma unroll
        for (int o = 4; o < 64; o <<= 1) { const float y = __shfl_up(v, o); if (lane >= o) v += y; }
        if (lane >= 60) WT[wave * 4 + hh] = v;
        __syncthreads();
        float off = 0.f, tot = 0.f;
        for (int w2 = 0; w2 < 8; ++w2) { const float wv = WT[w2 * 4 + hh]; tot += wv; if (w2 < wave) off += wv; }
        v += off;
        DTT[tid] = dtv; ACST[tid] = v; WTAB[hh * 128 + s] = __expf(tot - v); ACS[(size_t)(tok0 + s) * 8 + H] = v;
        if (s == 127) CDEC[bc * 8 + H] = __expf(v);
    }
    __syncthreads();
    {
        const int cgi = tid & 63, sg = tid >> 6, t0 = tok0 + 16 * sg;
        const int c0 = cgi < 32 ? g * 256 + cgi * 8 : (cgi < 48 ? 512 + g * 128 + (cgi - 32) * 8 : 768 + g * 128 + (cgi - 48) * 8);
        float w[4][8], bs[8];
#pragma unroll
        for (int k = 0; k < 4; ++k) { const float4 a0 = *(const float4*)(conv_w + k * 1024 + c0), a1 = *(const float4*)(conv_w + k * 1024 + c0 + 4);
            w[k][0] = a0.x; w[k][1] = a0.y; w[k][2] = a0.z; w[k][3] = a0.w; w[k][4] = a1.x; w[k][5] = a1.y; w[k][6] = a1.z; w[k][7] = a1.w; }
        { const float4 a0 = *(const float4*)(conv_b + c0), a1 = *(const float4*)(conv_b + c0 + 4); bs[0] = a0.x; bs[1] = a0.y; bs[2] = a0.z; bs[3] = a0.w; bs[4] = a1.x; bs[5] = a1.y; bs[6] = a1.z; bs[7] = a1.w; }
        const bool has_halo = (t0 & (SEQ - 1)) != 0;
        bf16x8 rows[19];
#pragma unroll
        for (int i = 0; i < 19; ++i) {
            if (i < 3 && !has_halo) {
#pragma unroll
                for (int e = 0; e < 8; ++e) rows[i][e] = 0;
            } else rows[i] = __builtin_nontemporal_load((const bf16x8*)(PROJ + (size_t)(t0 + i - 3) * PS + OXBC + c0));
        }
        const int kind = cgi < 32 ? 0 : (cgi < 48 ? 1 : 2);
        LAS bf16* img = kind == 0 ? XD + (cgi >> 3) * 8704 : BT; const int row0 = kind == 0 ? (cgi & 7) * 8 : (cgi - 32) * 8;
        const int hh = cgi >> 3;
#pragma unroll
        for (int i = 0; i < 16; ++i) {
            float o[8];
#pragma unroll
            for (int e = 0; e < 8; ++e) o[e] = silu_f(bs[e] + w[0][e] * sbf2f(rows[i][e]) + w[1][e] * sbf2f(rows[i + 1][e]) + w[2][e] * sbf2f(rows[i + 2][e]) + w[3][e] * sbf2f(rows[i + 3][e]));
            v4u ov; ov.x = pkbf(o[0], o[1]); ov.y = pkbf(o[2], o[3]); ov.z = pkbf(o[4], o[5]); ov.w = pkbf(o[6], o[7]);
            *(v4u*)(XACT + (size_t)(t0 + i) * 1024 + c0) = ov;
            const int s = 16 * sg + i;
            if (kind == 0) { const float dtv = DTT[s * 4 + hh];
#pragma unroll
                for (int e = 0; e < 8; ++e) img[SWZ(row0 + e, s)] = (bf16)bfs(o[e] * dtv);
            } else if (kind == 1) {
#pragma unroll
                for (int e = 0; e < 8; ++e) img[SWZ(row0 + e, s)] = (bf16)bfs(o[e]);
            }
        }
    }
    asm volatile("s_waitcnt vmcnt(0)" ::: "memory");
    __syncthreads();
    const int r = lane & 31, hi = lane >> 5;
    {
        const int lt = wave & 3, hA = wave >> 2, hB = hA + 2;
        const int l = 32 * lt + r; const float aclA = ACST[l * 4 + hA], aclB = ACST[l * 4 + hB];
        bf16x8 cf[8];
        { const bf16* cp = XACT + (size_t)(tok0 + l) * 1024 + 768 + g * 128 + 8 * hi; asm volatile("" : "+v"(cp));
#pragma unroll
          for (int ks = 0; ks < 8; ++ks) cf[ks] = ldg8(cp + 16 * ks); }
        f32x16 ZA0 = zero16(), ZA1 = zero16(), ZB0 = zero16(), ZB1 = zero16();
        bf16x8 bn[8];
        { const bf16* bp = XACT + (size_t)(tok0 + r) * 1024 + 512 + g * 128 + 8 * hi; asm volatile("" : "+v"(bp));
#pragma unroll
          for (int ks = 0; ks < 8; ++ks) bn[ks] = ldg8(bp + 16 * ks); }
#pragma unroll 1
        for (int st = 0; st <= lt; ++st) {
            f32x16 X = zero16();
            bf16x8 bcur[8];
#pragma unroll
            for (int ks = 0; ks < 8; ++ks) bcur[ks] = bn[ks];
            { const int stn = st < lt ? st + 1 : lt; const bf16* bp = XACT + (size_t)(tok0 + 32 * stn + r) * 1024 + 512 + g * 128 + 8 * hi; asm volatile("" : "+v"(bp));
#pragma unroll
              for (int ks = 0; ks < 8; ++ks) bn[ks] = ldg8(bp + 16 * ks); }
#pragma unroll
            for (int ks = 0; ks < 8; ++ks) X = MFMA32(bcur[ks], cf[ks], X);
            const int sb = 32 * st + 4 * hi;
            {
                f32x16 XA;
#pragma unroll
                for (int i = 0; i < 16; ++i) { const int s = 32 * st + crow(i, hi); XA[i] = (s <= l) ? X[i] * __expf(aclA - ACST[s * 4 + hA]) : 0.f; }
                const LAS bf16* xi = XD + hA * 8704;
                { const bf16x8 xs = pack8<0>(XA); ZA0 = MFMA32(xs, lds4s(xi, r, sb), ZA0); ZA1 = MFMA32(xs, lds4s(xi, 32 + r, sb), ZA1); }
                { const bf16x8 xs = pack8<1>(XA); ZA0 = MFMA32(xs, lds4s(xi, r, sb + 16), ZA0); ZA1 = MFMA32(xs, lds4s(xi, 32 + r, sb + 16), ZA1); }
            }
            {
                f32x16 XB;
#pragma unroll
                for (int i = 0; i < 16; ++i) { const int s = 32 * st + crow(i, hi); XB[i] = (s <= l) ? X[i] * __expf(aclB - ACST[s * 4 + hB]) : 0.f; }
                const LAS bf16* xi = XD + hB * 8704;
                { const bf16x8 xs = pack8<0>(XB); ZB0 = MFMA32(xs, lds4s(xi, r, sb), ZB0); ZB1 = MFMA32(xs, lds4s(xi, 32 + r, sb), ZB1); }
                { const bf16x8 xs = pack8<1>(XB); ZB0 = MFMA32(xs, lds4s(xi, r, sb + 16), ZB0); ZB1 = MFMA32(xs, lds4s(xi, 32 + r, sb + 16), ZB1); }
            }
        }
#pragma unroll
        for (int i = 0; i < 16; ++i) { bf16* o = YD + (size_t)(tok0 + 32 * lt + crow(i, hi)) * 512 + (g * 4 + hA) * 64 + r; o[0] = f2bf(ZA0[i]); o[32] = f2bf(ZA1[i]); o[128] = f2bf(ZB0[i]); o[160] = f2bf(ZB1[i]); }
    }
    {
        const int nt = wave & 3;
#pragma unroll 1
        for (int hq = 0; hq < 2; ++hq) {
            const int hh = (wave >> 2) + 2 * hq, H = g * 4 + hh;
            f32x16 S0 = zero16(), S1 = zero16();
#pragma unroll
            for (int ks = 0; ks < 8; ++ks) {
                const bf16x8 btf = lds8(BT + SWZ(32 * nt + r, 16 * ks + 8 * hi));
                typedef float f4v __attribute__((ext_vector_type(4)));
                const f4v w0 = *(const LAS f4v*)(WTAB + hh * 128 + 16 * ks + 8 * hi), w1 = *(const LAS f4v*)(WTAB + hh * 128 + 16 * ks + 8 * hi + 4);
                const float wv[8] = {w0.x, w0.y, w0.z, w0.w, w1.x, w1.y, w1.z, w1.w};
                bf16x8 a0 = lds8(XD + hh * 8704 + SWZ(r, 16 * ks + 8 * hi)), a1 = lds8(XD + hh * 8704 + SWZ(32 + r, 16 * ks + 8 * hi));
                v4u p0, p1;
                p0.x = pkbf(sbf2f(a0[0]) * wv[0], sbf2f(a0[1]) * wv[1]); p0.y = pkbf(sbf2f(a0[2]) * wv[2], sbf2f(a0[3]) * wv[3]); p0.z = pkbf(sbf2f(a0[4]) * wv[4], sbf2f(a0[5]) * wv[5]); p0.w = pkbf(sbf2f(a0[6]) * wv[6], sbf2f(a0[7]) * wv[7]);
                p1.x = pkbf(sbf2f(a1[0]) * wv[0], sbf2f(a1[1]) * wv[1]); p1.y = pkbf(sbf2f(a1[2]) * wv[2], sbf2f(a1[3]) * wv[3]); p1.z = pkbf(sbf2f(a1[4]) * wv[4], sbf2f(a1[5]) * wv[5]); p1.w = pkbf(sbf2f(a1[6]) * wv[6], sbf2f(a1[7]) * wv[7]);
                S0 = MFMA32(__builtin_bit_cast(bf16x8, p0), btf, S0); S1 = MFMA32(__builtin_bit_cast(bf16x8, p1), btf, S1);
            }
            bf16* sp = STATES + (size_t)(bc * 8 + H) * 8192 + 32 * nt + r;
#pragma unroll
            for (int i = 0; i < 16; ++i) { const int p = crow(i, hi); sp[p * 128] = f2bf(S0[i]); sp[(32 + p) * 128] = f2bf(S1[i]); }
        }
    }
    __syncthreads();
}

__device__ __forceinline__ __amdgpu_buffer_rsrc_t mk_rsrc(const void* p, unsigned bytes) { return __builtin_amdgcn_make_buffer_rsrc((void*)p, 0, bytes, 0x00020000); }
__device__ __forceinline__ void yoff_unit(const float* d_skip, const float* gnorm, LAS unsigned char* ldsb, int unit, const bf16* XACT, const bf16* PROJ, const float* ACS, const bf16* PREVT,
                                          const bf16* YD, bf16* MIXB, int lane, int wave) {
    const int g = unit & 1, bc = unit >> 1, tok0 = bc * 128;
    const int r = lane & 31, hi = lane >> 5, lt = wave & 3, hpair = wave >> 2;
    LAS float* TAB = (LAS float*)ldsb;
    const __amdgpu_buffer_rsrc_t rsF = mk_rsrc(YD, (unsigned)T * 512u * 2u), rsX = mk_rsrc(XACT, (unsigned)T * 1024u * 2u), rsP = mk_rsrc(PROJ, (unsigned)T * PS * 2u), rsA = mk_rsrc(ACS, (unsigned)T * 32u), rsB = mk_rsrc(MIXB, (unsigned)T * D * 2u);
    const unsigned tb = (unsigned)(tok0 + 32 * lt + 4 * hi);
    bf16x8 cf[8];
    { const bf16* cp = XACT + (size_t)(tok0 + 32 * lt + r) * 1024 + 768 + g * 128 + 8 * hi; asm volatile("" : "+v"(cp));
#pragma unroll
      for (int ks = 0; ks < 8; ++ks) cf[ks] = ldg8(cp + 16 * ks); }
    float eav[16], ssq[16];
    unsigned ypk[2][2][8];
#pragma unroll
    for (int i = 0; i < 16; ++i) ssq[i] = 0.f;
#pragma unroll
    for (int hsel = 0; hsel < 2; ++hsel) {
        const int H = g * 4 + 2 * hpair + hsel; const bf16* pv = PREVT + (size_t)(bc * 8 + H) * 8192 + 8 * hi;
        asm volatile("" : "+v"(pv));
        f32x16 Y0 = zero16(), Y1 = zero16();
#pragma unroll
        for (int ks = 0; ks < 8; ++ks) {
            const bf16x8 b0 = ldg8(pv + r * 128 + 16 * ks), b1 = ldg8(pv + (32 + r) * 128 + 16 * ks);
            Y0 = MFMA32(cf[ks], b0, Y0); Y1 = MFMA32(cf[ks], b1, Y1);
        }
        const float dsk = d_skip[H];
        { const unsigned vo = (tb * 8u + (unsigned)H) * 4u;
#pragma unroll
          for (int i = 0; i < 16; ++i) eav[i] = __expf(__builtin_bit_cast(float, __builtin_amdgcn_raw_buffer_load_b32(rsA, (int)vo, ((i & 3) + 8 * (i >> 2)) * 32, 0))); }
#pragma unroll
        for (int pt = 0; pt < 2; ++pt) {
            const unsigned col = (unsigned)(H * 64 + 32 * pt + r);
            const unsigned voF = (tb * 512u + col) * 2u, voX = (tb * 1024u + col) * 2u, voP = (tb * (unsigned)PS + (unsigned)OZ + col) * 2u;
            float yo[16], xsv[16], zv[16];
#pragma unroll
            for (int i = 0; i < 16; ++i) { const int ro = (i & 3) + 8 * (i >> 2);
                yo[i] = bf2f((bf16)__builtin_amdgcn_raw_buffer_load_b16(rsF, (int)voF, ro * 1024, 0));
                xsv[i] = bf2f((bf16)__builtin_amdgcn_raw_buffer_load_b16(rsX, (int)voX, ro * 2048, 0));
                zv[i] = bf2f((bf16)__builtin_amdgcn_raw_buffer_load_b16(rsP, (int)voP, ro * (PS * 2), 0)); }
#pragma unroll
            for (int i = 0; i < 16; i += 2) {
                const float y0 = (yo[i] + eav[i] * (pt ? Y1[i] : Y0[i]) + dsk * xsv[i]) * silu_f(zv[i]);
                const float y1 = (yo[i + 1] + eav[i + 1] * (pt ? Y1[i + 1] : Y0[i + 1]) + dsk * xsv[i + 1]) * silu_f(zv[i + 1]);
                ssq[i] += y0 * y0; ssq[i + 1] += y1 * y1; ypk[hsel][pt][i >> 1] = pkbf(y0, y1);
            }
            __builtin_amdgcn_sched_barrier(0);
        }
    }
#pragma unroll
    for (int i = 0; i < 16; ++i) {
#pragma unroll
        for (int o = 1; o < 32; o <<= 1) ssq[i] += __shfl_xor(ssq[i], o);
    }
    if (r == 0) {
#pragma unroll
        for (int i = 0; i < 16; ++i) TAB[hpair * 128 + 32 * lt + crow(i, hi)] = ssq[i];
    }
    __syncthreads();
#pragma unroll
    for (int i = 0; i < 16; ++i) { const int l = 32 * lt + crow(i, hi); ssq[i] = rsqrtf((TAB[l] + TAB[128 + l]) * (1.f / 256.f) + EPS); }
#pragma unroll
    for (int hsel = 0; hsel < 2; ++hsel)
#pragma unroll
        for (int pt = 0; pt < 2; ++pt) {
            const unsigned col = (unsigned)((g * 4 + 2 * hpair + hsel) * 64 + 32 * pt + r); const float gn = gnorm[col];
            const unsigned voB = (tb * 1024u + 512u + col) * 2u;
#pragma unroll
            for (int i = 0; i < 16; ++i) { const unsigned w = ypk[hsel][pt][i >> 1];
                const float yf = (i & 1) ? __uint_as_float(w & 0xffff0000u) : __uint_as_float(w << 16);
                __builtin_amdgcn_raw_buffer_store_b16((short)f2bf(yf * ssq[i] * gn), rsB, (int)voB, ((i & 3) + 8 * (i >> 2)) * 2048, 0); }
        }
    __syncthreads();
}
typedef float f32x2 __attribute__((ext_vector_type(2)));
__device__ __forceinline__ void fp8x16_to_f32(const uint4 w, float (&f)[16]) {
    const int ww[4] = {(int)w.x, (int)w.y, (int)w.z, (int)w.w};
#pragma unroll
    for (int q = 0; q < 4; ++q) { const f32x2 a = __builtin_amdgcn_cvt_pk_f32_fp8(ww[q], false), b = __builtin_amdgcn_cvt_pk_f32_fp8(ww[q], true); f[4 * q] = a.x; f[4 * q + 1] = a.y; f[4 * q + 2] = b.x; f[4 * q + 3] = b.y; }
}
template <int M4, int M2, int M1> __device__ __forceinline__ void treduce16(const float (&a)[16], int lane, float& r0, float& r1) {
    float b[8], c[4];
    { const bool hi = (lane & M4) != 0;
#pragma unroll
      for (int i = 0; i < 8; ++i) { const float send = hi ? a[i] : a[i + 8]; const float recv = __shfl_xor(send, M4); b[i] = (hi ? a[i + 8] : a[i]) + recv; } }
    { const bool hi = (lane & M2) != 0;
#pragma unroll
      for (int i = 0; i < 4; ++i) { const float send = hi ? b[i] : b[i + 4]; const float recv = __shfl_xor(send, M2); c[i] = (hi ? b[i + 4] : b[i]) + recv; } }
    { const bool hi = (lane & M1) != 0;
      { const float send = hi ? c[0] : c[2]; const float recv = __shfl_xor(send, M1); r0 = (hi ? c[2] : c[0]) + recv; }
      { const float send = hi ? c[1] : c[3]; const float recv = __shfl_xor(send, M1); r1 = (hi ? c[3] : c[1]) + recv; } }
}
template <int M4, int M2, int M1> __device__ __forceinline__ void treduce16i(const int (&a)[16], int lane, int& r0, int& r1) {
    int b[8], c[4];
    { const bool hi = (lane & M4) != 0;
#pragma unroll
      for (int i = 0; i < 8; ++i) { const int send = hi ? a[i] : a[i + 8]; const int recv = __shfl_xor(send, M4); b[i] = (hi ? a[i + 8] : a[i]) + recv; } }
    { const bool hi = (lane & M2) != 0;
#pragma unroll
      for (int i = 0; i < 4; ++i) { const int send = hi ? b[i] : b[i + 4]; const int recv = __shfl_xor(send, M2); c[i] = (hi ? b[i + 4] : b[i]) + recv; } }
    { const bool hi = (lane & M1) != 0;
      { const int send = hi ? c[0] : c[2]; const int recv = __shfl_xor(send, M1); r0 = (hi ? c[2] : c[0]) + recv; }
      { const int send = hi ? c[1] : c[3]; const int recv = __shfl_xor(send, M1); r1 = (hi ? c[3] : c[1]) + recv; } }
}
__device__ __forceinline__ void treduce16i_hw(const int (&a)[16], int lane, int& r0, int& r1) {
    int b[8], c[4];
#pragma unroll
    for (int i = 0; i < 8; ++i) { const auto r = __builtin_amdgcn_permlane32_swap((unsigned)a[i], (unsigned)a[i + 8], false, false); b[i] = (int)r[0] + (int)r[1]; }
#pragma unroll
    for (int i = 0; i < 4; ++i) { const auto r = __builtin_amdgcn_permlane16_swap((unsigned)b[i], (unsigned)b[i + 4], false, false); c[i] = (int)r[0] + (int)r[1]; }
    const bool hi = (lane & 8) != 0;
    { const int send = hi ? c[0] : c[2]; r0 = (hi ? c[2] : c[0]) + __builtin_amdgcn_update_dpp(0, send, 0x128, 0xf, 0xf, false); }
    { const int send = hi ? c[1] : c[3]; r1 = (hi ? c[3] : c[1]) + __builtin_amdgcn_update_dpp(0, send, 0x128, 0xf, 0xf, false); }
}
#define PE_ID(E, i) (((i) & 1) ? (E[(i) >> 1] >> 16) : (E[(i) >> 1] & 0xffffu))
__device__ __forceinline__ void peer_u_item(int p, int j, const LAS unsigned short* EL  , const unsigned char* __restrict__ XQ, const unsigned char* __restrict__ U8, LAS int* ACC  , int lane, int wave) {
    asm volatile("" : "+v"(lane));
    const int gidx = lane >> 3; const unsigned coff = (unsigned)(p * 128 + (lane & 7) * 16);
#pragma unroll 1
    for (int it = 0; it < 8; ++it) {
        const int t = j * 64 + it * 8 + wave;
        unsigned E[8];
        { const LAS v4u* ep = (const LAS v4u*)(EL + (it * 8 + wave) * 128 + 16 * gidx); const v4u e0 = ep[0], e1 = ep[1];
          E[0] = e0.x; E[1] = e0.y; E[2] = e0.z; E[3] = e0.w; E[4] = e1.x; E[5] = e1.y; E[6] = e1.z; E[7] = e1.w; }
        uint4 uu[16];
#pragma unroll
        for (int i = 0; i < 16; ++i) uu[i] = *(const uint4*)(U8 + (size_t)(PE_ID(E, i) * 1024u + coff));
        const uint4 xq = *(const uint4*)(XQ + (size_t)t * D + coff);
        int d[16];
#pragma unroll
        for (int i = 0; i < 16; ++i) {
            int s = __builtin_amdgcn_sdot4((int)uu[i].x, (int)xq.x, 0, false); s = __builtin_amdgcn_sdot4((int)uu[i].y, (int)xq.y, s, false);
            s = __builtin_amdgcn_sdot4((int)uu[i].z, (int)xq.z, s, false); s = __builtin_amdgcn_sdot4((int)uu[i].w, (int)xq.w, s, false);
            d[i] = s;
        }
        int r0, r1; treduce16i<4, 2, 1>(d, lane, r0, r1);
        { typedef int i2v __attribute__((ext_vector_type(2))); LAS i2v* ap = (LAS i2v*)(ACC + (it * 8 + wave) * 128 + 2 * lane);
          i2v a2; if (p == 0) { a2.x = r0; a2.y = r1; } else { a2 = *ap; a2.x += r0; a2.y += r1; } *ap = a2; }
    }
}
__device__ __forceinline__ void peer_v_item(int p, int j, const LAS unsigned short* EL, const LAS unsigned char* AL  , const LAS float* ASC  ,
                                            const unsigned char* __restrict__ V8, bf16* __restrict__ PEERO, int lane, int wave) {
    asm volatile("" : "+v"(lane));
    const __amdgpu_buffer_rsrc_t rsV = __builtin_amdgcn_make_buffer_rsrc((void*)V8, 0, 16384 * 1024, 0x00020000);
    const int gidx = lane >> 3; const unsigned coff = (unsigned)(p * 128 + (lane & 7) * 16);
#pragma unroll 1
    for (int it = 0; it < 8; ++it) {
        const int t = j * 64 + it * 8 + wave;
        unsigned E[8];
        { const LAS v4u* ep = (const LAS v4u*)(EL + (it * 8 + wave) * 128 + 16 * gidx); const v4u e0 = ep[0], e1 = ep[1];
          E[0] = e0.x; E[1] = e0.y; E[2] = e0.z; E[3] = e0.w; E[4] = e1.x; E[5] = e1.y; E[6] = e1.z; E[7] = e1.w; }
        uint4 vv[16];
#pragma unroll
        for (int i = 0; i < 16; ++i) { const v4u w_ = __builtin_amdgcn_raw_buffer_load_b128(rsV, (int)((PE_ID(E, i) << 10) + coff), 0, 0); vv[i] = make_uint4(w_.x, w_.y, w_.z, w_.w); }
        const v4u aq = *(const LAS v4u*)(AL + (it * 8 + wave) * 128 + 16 * gidx);
        const float asc = ASC[it * 8 + wave];
        const unsigned a4[4] = {aq.x, aq.y, aq.z, aq.w};
        int acc[16];
#pragma unroll
        for (int c = 0; c < 16; ++c) acc[c] = 0;
#pragma unroll
        for (int m = 0; m < 4; ++m) {
            const unsigned r0[4] = {vv[4 * m].x, vv[4 * m].y, vv[4 * m].z, vv[4 * m].w}, r1[4] = {vv[4 * m + 1].x, vv[4 * m + 1].y, vv[4 * m + 1].z, vv[4 * m + 1].w};
            const unsigned r2[4] = {vv[4 * m + 2].x, vv[4 * m + 2].y, vv[4 * m + 2].z, vv[4 * m + 2].w}, r3[4] = {vv[4 * m + 3].x, vv[4 * m + 3].y, vv[4 * m + 3].z, vv[4 * m + 3].w};
#pragma unroll
            for (int dc = 0; dc < 4; ++dc) {
                const unsigned ta = __builtin_amdgcn_perm(r1[dc], r0[dc], 0x05010400u), tb = __builtin_amdgcn_perm(r3[dc], r2[dc], 0x05010400u);
                const unsigned ua = __builtin_amdgcn_perm(r1[dc], r0[dc], 0x07030602u), ub = __builtin_amdgcn_perm(r3[dc], r2[dc], 0x07030602u);
                const unsigned c0 = __builtin_amdgcn_perm(tb, ta, 0x05040100u), c1 = __builtin_amdgcn_perm(tb, ta, 0x07060302u);
                const unsigned c2 = __builtin_amdgcn_perm(ub, ua, 0x05040100u), c3 = __builtin_amdgcn_perm(ub, ua, 0x07060302u);
                acc[4 * dc + 0] = __builtin_amdgcn_sdot4((int)c0, (int)a4[m], acc[4 * dc + 0], false);
                acc[4 * dc + 1] = __builtin_amdgcn_sdot4((int)c1, (int)a4[m], acc[4 * dc + 1], false);
                acc[4 * dc + 2] = __builtin_amdgcn_sdot4((int)c2, (int)a4[m], acc[4 * dc + 2], false);
                acc[4 * dc + 3] = __builtin_amdgcn_sdot4((int)c3, (int)a4[m], acc[4 * dc + 3], false);
            }
        }
        int r0i, r1i; treduce16i_hw(acc, lane, r0i, r1i);
        *(unsigned*)(PEERO + (size_t)t * D + coff + 2 * gidx) = pkbf(asc * (float)r0i, asc * (float)r1i);
    }
}

__device__ __forceinline__ void ce_desc(float& a, float& b) { const float hi = fmaxf(a, b), lo = fminf(a, b); a = hi; b = lo; }
__device__ __forceinline__ void sort16_desc(float (&v)[16]) {
#pragma unroll
    for (int k = 2; k <= 16; k <<= 1)
#pragma unroll
        for (int j = k >> 1; j > 0; j >>= 1)
#pragma unroll
            for (int i = 0; i < 16; ++i) { const int l = i ^ j; if (l > i) { if ((i & k) == 0) ce_desc(v[i], v[l]); else ce_desc(v[l], v[i]); } }
}
__device__ __forceinline__ void merge16_desc(float (&a)[16], const float (&b)[16]) {
#pragma unroll
    for (int i = 0; i < 16; ++i) a[i] = fmaxf(a[i], b[15 - i]);
#pragma unroll
    for (int j = 8; j > 0; j >>= 1)
#pragma unroll
        for (int i = 0; i < 16; ++i) { const int l = i ^ j; if (l > i) ce_desc(a[i], a[l]); }
}
__device__ __forceinline__ void ce_kv(float& ka, int& va, float& kb, int& vb) {
    const bool s = kb > ka; const float t0 = s ? kb : ka, t1 = s ? ka : kb; const int u0 = s ? vb : va, u1 = s ? va : vb; ka = t0; kb = t1; va = u0; vb = u1; }
__device__ __forceinline__ void sort16_kv(float (&k)[16], int (&v)[16]) {
#pragma unroll
    for (int kk = 2; kk <= 16; kk <<= 1)
#pragma unroll
        for (int j = kk >> 1; j > 0; j >>= 1)
#pragma unroll
            for (int i = 0; i < 16; ++i) { const int l = i ^ j; if (l > i) { if ((i & kk) == 0) ce_kv(k[i], v[i], k[l], v[l]); else ce_kv(k[l], v[l], k[i], v[i]); } }
}
__device__ __forceinline__ void merge16_kv(float (&ka)[16], int (&va)[16], const float (&kb)[16], const int (&vb)[16]) {
#pragma unroll
    for (int i = 0; i < 16; ++i) { const bool s = kb[15 - i] > ka[i]; ka[i] = s ? kb[15 - i] : ka[i]; va[i] = s ? vb[15 - i] : va[i]; }
#pragma unroll
    for (int j = 8; j > 0; j >>= 1)
#pragma unroll
        for (int i = 0; i < 16; ++i) { const int l = i ^ j; if (l > i) ce_kv(ka[i], va[i], ka[l], va[l]); }
}
__device__ __forceinline__ void split8(const float* p, bf16x8& hi8, bf16x8& lo8) {
    const float4 f0 = *(const float4*)p, f1 = *(const float4*)(p + 4);
    const float x[8] = {f0.x, f0.y, f0.z, f0.w, f1.x, f1.y, f1.z, f1.w};
#pragma unroll
    for (int j = 0; j < 8; ++j) { const short h = bfs(x[j]); hi8[j] = h; lo8[j] = bfs(x[j] - sbf2f(h)); }
}
__device__ __forceinline__ void route_task(int task, int tl0, const float* QP, const LAS bf16* KHL, LAS unsigned short* EL, LAS float* GL, int lane) {
    const int r = lane & 31, hi = lane >> 5, t = 4 * task + (r >> 3), head = r & 7;
    float top[2][16];
#pragma unroll
    for (int half = 0; half < 2; ++half) {
        bf16x8 qh[4], ql[4];
        { const float* qp = QP + (size_t)t * D + head * 128 + half * 64 + 8 * hi; asm volatile("" : "+v"(qp));
#pragma unroll
          for (int ks = 0; ks < 4; ++ks) split8(qp + 16 * ks, qh[ks], ql[ks]); }
        float cur[16];
#pragma unroll
        for (int kt = 0; kt < 4; ++kt) {
            f32x16 X = zero16();
            const LAS bf16* khp = KHL + (half * 128 + 32 * kt + r) * 72 + 8 * hi;
#pragma unroll
            for (int ks = 0; ks < 4; ++ks) {
                const bf16x8 kh = lds8(khp + 16 * ks), kl = lds8(khp + 2 * 128 * 72 + 16 * ks);
                X = MFMA32(kh, qh[ks], X); X = MFMA32(kh, ql[ks], X); X = MFMA32(kl, qh[ks], X);
            }
            float grp[16];
#pragma unroll
            for (int i = 0; i < 16; ++i) { const unsigned key = (unsigned)(32 * kt + crow(i, hi)); grp[i] = __uint_as_float((__float_as_uint(X[i]) & ~127u) | (127u - key)); }
            sort16_desc(grp);
            if (kt == 0) {
#pragma unroll
                for (int i = 0; i < 16; ++i) cur[i] = grp[i];
            } else merge16_desc(cur, grp);
        }
        float oth[16];
#pragma unroll
        for (int i = 0; i < 16; ++i) oth[i] = __shfl_xor(cur[i], 32);
        merge16_desc(cur, oth);
#pragma unroll
        for (int i = 0; i < 16; ++i) top[half][i] = cur[i];
    }
    unsigned P1[4], P2[4];
#pragma unroll
    for (int q = 0; q < 4; ++q) { P1[q] = 0u; P2[q] = 0u;
#pragma unroll
        for (int s = 0; s < 4; ++s) { P1[q] |= (127u - (__float_as_uint(top[0][4 * q + s]) & 127u)) << (8 * s); P2[q] |= (127u - (__float_as_uint(top[1][4 * q + s]) & 127u)) << (8 * s); } }
#define CAND(a, b) __uint_as_float((__float_as_uint(top[0][a] + top[1][b]) & ~255u) | (255u - (unsigned)((a) * 16 + (b))))
    float bk[16];
    {
        float gk[16];
        gk[0] = CAND(0, 0);
        gk[1] = CAND(0, 1);
        gk[2] = CAND(0, 2);
        gk[3] = CAND(0, 3);
        gk[4] = CAND(0, 4);
        gk[5] = CAND(0, 5);
        gk[6] = CAND(0, 6);
        gk[7] = CAND(0, 7);
        gk[8] = CAND(0, 8);
        gk[9] = CAND(0, 9);
        gk[10] = CAND(0, 10);
        gk[11] = CAND(0, 11);
        gk[12] = CAND(0, 12);
        gk[13] = CAND(0, 13);
        gk[14] = CAND(0, 14);
        gk[15] = CAND(0, 15);
        sort16_desc(gk);
#pragma unroll
        for (int i = 0; i < 16; ++i) bk[i] = gk[i];
    }
    {
        float gk[16];
        gk[0] = CAND(1, 0);
        gk[1] = CAND(1, 1);
        gk[2] = CAND(1, 2);
        gk[3] = CAND(1, 3);
        gk[4] = CAND(1, 4);
        gk[5] = CAND(1, 5);
        gk[6] = CAND(1, 6);
        gk[7] = CAND(1, 7);
        gk[8] = CAND(2, 0);
        gk[9] = CAND(2, 1);
        gk[10] = CAND(2, 2);
        gk[11] = CAND(2, 3);
        gk[12] = CAND(2, 4);
        gk[13] = CAND(3, 0);
        gk[14] = CAND(3, 1);
        gk[15] = CAND(3, 2);
        sort16_desc(gk);
        merge16_desc(bk, gk);
    }
    {
        float gk[16];
        gk[0] = CAND(3, 3);
        gk[1] = CAND(4, 0);
        gk[2] = CAND(4, 1);
        gk[3] = CAND(4, 2);
        gk[4] = CAND(5, 0);
        gk[5] = CAND(5, 1);
        gk[6] = CAND(6, 0);
        gk[7] = CAND(6, 1);
        gk[8] = CAND(7, 0);
        gk[9] = CAND(7, 1);
        gk[10] = CAND(8, 0);
        gk[11] = CAND(9, 0);
        gk[12] = CAND(10, 0);
        gk[13] = CAND(11, 0);
        gk[14] = CAND(12, 0);
        gk[15] = CAND(13, 0);
        sort16_desc(gk);
        merge16_desc(bk, gk);
    }
    {
        float gk[16];
        gk[0] = CAND(14, 0);
        gk[1] = CAND(15, 0);
        gk[2] = -INFINITY;
        gk[3] = -INFINITY;
        gk[4] = -INFINITY;
        gk[5] = -INFINITY;
        gk[6] = -INFINITY;
        gk[7] = -INFINITY;
        gk[8] = -INFINITY;
        gk[9] = -INFINITY;
        gk[10] = -INFINITY;
        gk[11] = -INFINITY;
        gk[12] = -INFINITY;
        gk[13] = -INFINITY;
        gk[14] = -INFINITY;
        gk[15] = -INFINITY;
        sort16_desc(gk);
        merge16_desc(bk, gk);
    }
#undef CAND
    int bv[16];
#pragma unroll
    for (int i = 0; i < 16; ++i) {
        const unsigned cd = 255u - (__float_as_uint(bk[i]) & 255u), ca = cd >> 4, cb = cd & 15u;
        const unsigned wa = (ca >> 2) == 0u ? P1[0] : (ca >> 2) == 1u ? P1[1] : (ca >> 2) == 2u ? P1[2] : P1[3];
        const unsigned wb = (cb >> 2) == 0u ? P2[0] : (cb >> 2) == 1u ? P2[1] : (cb >> 2) == 2u ? P2[2] : P2[3];
        bv[i] = (int)((((wa >> (8u * (ca & 3u))) & 255u) << 7) | ((wb >> (8u * (cb & 3u))) & 255u));
    }
    float e[16], se = 0.f;
#pragma unroll
    for (int i = 0; i < 16; ++i) { e[i] = __expf(bk[i] - bk[0]); se += e[i]; }
    const float inv = 1.f / se;
    if (hi == 0) {
        LAS v4u* ip = (LAS v4u*)(EL + (tl0 + (r >> 3)) * 128 + head * 16); typedef float f4v __attribute__((ext_vector_type(4))); LAS f4v* gp = (LAS f4v*)(GL + (tl0 + (r >> 3)) * 128 + head * 16);
#pragma unroll
        for (int q = 0; q < 2; ++q) ip[q] = (v4u){(unsigned)bv[8 * q] | ((unsigned)bv[8 * q + 1] << 16), (unsigned)bv[8 * q + 2] | ((unsigned)bv[8 * q + 3] << 16), (unsigned)bv[8 * q + 4] | ((unsigned)bv[8 * q + 5] << 16), (unsigned)bv[8 * q + 6] | ((unsigned)bv[8 * q + 7] << 16)};
#pragma unroll
        for (int q = 0; q < 4; ++q) gp[q] = (f4v){e[4 * q] * inv, e[4 * q + 1] * inv, e[4 * q + 2] * inv, e[4 * q + 3] * inv};
    }
}

#define XB_TMO      128
#define XB_XCNT(j)  (256  + 64 * (j))
#define XB_XSUB(j)  (1280 + 64 * (j))
#define XB_XGEN(j)  (2304 + 64 * (j))
#define XB_TOP      3328
#define XB_TOPGEN   3392
#define XCD_BAR_WORDS 3456
#define XB_SPIN_CAP (1u << 22)
__device__ __forceinline__ unsigned xb_ld(unsigned* p)              { return __hip_atomic_load(p, __ATOMIC_RELAXED, __HIP_MEMORY_SCOPE_AGENT); }
__device__ __forceinline__ unsigned xb_add(unsigned* p, unsigned v) { return __hip_atomic_fetch_add(p, v, __ATOMIC_RELAXED, __HIP_MEMORY_SCOPE_AGENT); }
__device__ __forceinline__ unsigned xb_xcc_id() { return (unsigned)__builtin_amdgcn_s_getreg((3 << 11) | 20) & 0xFu; }
#define XB_SPIN(cond, bar) do { unsigned _sp = 0; while (cond) { __builtin_amdgcn_s_sleep(1); \
    if ((++_sp & 255u) == 0u) { if (xb_ld(&(bar)[XB_TMO])) break; if (_sp > XB_SPIN_CAP) { atomicAdd(&(bar)[XB_TMO], 1u); break; } } } } while (0)
struct XcdBarrier { unsigned* bar; unsigned x; volatile LAS unsigned* st; };
__device__ __forceinline__ XcdBarrier xcd_barrier_post(unsigned* bar, volatile LAS unsigned* st) {
    XcdBarrier b; b.bar = bar; b.x = xb_xcc_id(); b.st = st;
    if (threadIdx.x == 0) (void)xb_add(&bar[XB_XCNT(b.x)], 1u);
    return b;
}
__device__ __forceinline__ void xcd_barrier_complete(unsigned* bar, unsigned x, unsigned& nloc, unsigned& nx) {
    const unsigned G = gridDim.x * gridDim.y * gridDim.z;
    unsigned sum, cnt, mine, sp = 0u;
    for (;;) {
        sum = 0u; cnt = 0u; mine = 0u;
#pragma unroll
        for (unsigned j = 0; j < 16; ++j) { const unsigned c = xb_ld(&bar[XB_XCNT(j)]); sum += c; cnt += (c > 0u) ? 1u : 0u; mine = (j == x) ? c : mine; }
        if (sum == G) break;
        __builtin_amdgcn_s_sleep(1);
        if ((++sp & 255u) == 0u) { if (xb_ld(&bar[XB_TMO])) break; if (sp > XB_SPIN_CAP) { atomicAdd(&bar[XB_TMO], 1u); break; } }
    }
    nloc = mine > 0u ? mine : 1u; nx = cnt > 0u ? cnt : 1u;
}
__device__ __forceinline__ void xcd_barrier(const XcdBarrier& b) {
    asm volatile("s_waitcnt vmcnt(0)" ::: "memory");
    __syncthreads();
    if (threadIdx.x == 0) {
        unsigned* bar = b.bar;
        __builtin_amdgcn_s_waitcnt(0);
        unsigned nloc = b.st[0], nx = b.st[1];
        if (nloc == 0u) { xcd_barrier_complete(bar, b.x, nloc, nx); b.st[0] = nloc; b.st[1] = nx; }
        const unsigned old = xb_add(&bar[XB_XSUB(b.x)], 1u);
        const unsigned gen = old / nloc;
        if (old + 1u == (gen + 1u) * nloc) {
            __builtin_amdgcn_fence(__ATOMIC_RELEASE, "agent");
            asm volatile("s_waitcnt vmcnt(0)" ::: "memory");
            const unsigned og = xb_add(&bar[XB_TOP], 1u);
            const unsigned tg = og / nx;
            if (og + 1u == (tg + 1u) * nx) xb_add(&bar[XB_TOPGEN], 1u);
            else XB_SPIN(xb_ld(&bar[XB_TOPGEN]) == tg, bar);
            __builtin_amdgcn_fence(__ATOMIC_ACQUIRE, "agent");
            xb_add(&bar[XB_XGEN(b.x)], 1u);
            asm volatile("s_waitcnt vmcnt(0)" ::: "memory");
        } else {
            XB_SPIN(xb_ld(&bar[XB_XGEN(b.x)]) == gen, bar);
            __builtin_amdgcn_fence(__ATOMIC_ACQUIRE, "agent");
            asm volatile("s_waitcnt vmcnt(0)" ::: "memory");
        }
    }
    __syncthreads();
}
constexpr int LDS_BYTES = 147456;
constexpr int MISC_OFF = 131072 + 320;

__global__ void __launch_bounds__(NTHR, 2) k_main(Args a) {
    extern __shared__ __attribute__((aligned(16))) unsigned char lds_raw[];
    LAS unsigned char* ldsb = (LAS unsigned char*)lds_raw;
    const int tid0 = threadIdx.x, bid = blockIdx.x, nb = gridDim.x;
    const int wave = __builtin_amdgcn_readfirstlane(tid0 >> 6);
    const int gthreads = nb * NTHR, nwaves = gthreads >> 6;
#define PHASE_VARS() int tid = tid0; asm volatile("" : "+v"(tid)); const int lane = tid & 63, gtid = bid * NTHR + tid, gwave = gtid >> 6; (void)lane; (void)gtid; (void)gwave
    unsigned char* ws = a.ws;
    bf16* WINT = (bf16*)(ws + WS_WIN); bf16* WOT = (bf16*)(ws + WS_WO); bf16* WQT = (bf16*)(ws + WS_WQ);
    bf16* PROJ = (bf16*)(ws + WS_PROJ);
    bf16* XNB = (bf16*)(ws + WS_XNB);
    bf16* XACT = (bf16*)(ws + WS_XACT);
    float* DTRAW = (float*)(ws + WS_DTRAW); float* DT = (float*)(ws + WS_DT); float* ACS = (float*)(ws + WS_ACS); float* CDEC = (float*)(ws + WS_CDEC);
    bf16* STATES = (bf16*)(ws + WS_STATES); bf16* PREVT = (bf16*)(ws + WS_PREV); bf16* YD = (bf16*)a.out;
    float* QP = (float*)(ws + WS_QP); unsigned short* IDX = (unsigned short*)(ws + WS_IDX); float* GATE = (float*)(ws + WS_GATE);
    float* TOPV = (float*)(ws + WS_TOPV); int* TOPI = (int*)(ws + WS_TOPI);
    unsigned char* U8 = ws + WS_U8; unsigned char* V8 = ws + WS_V8; float* SU = (float*)(ws + WS_SU); float* SV = SU + 16384; bf16* PART = (bf16*)(ws + WS_PART); unsigned char* XQ = ws + WS_XQ; float* XS = (float*)(ws + WS_XS);
    bf16* KH = (bf16*)(ws + WS_KH); bf16* KL = (bf16*)(ws + WS_KH + 65536);
    bf16* HB = (bf16*)(ws + WS_STATES);
    float* MIXF = a.out;
    volatile LAS unsigned* MISC = (volatile LAS unsigned*)(ldsb + MISC_OFF);
    if (tid0 < 32) MISC[tid0] = 0u;
    __syncthreads();
    XcdBarrier bar = xcd_barrier_post((unsigned*)ws, MISC + 8);
#define IN(k) (a.ph_lo <= (k) && (k) < a.ph_hi)
#if defined(PROBE_LO)
    int seg_ = 0; unsigned long long tseg_ = __builtin_amdgcn_s_memrealtime();
#define PROBE_SPIN() do { if (seg_ >= PROBE_LO && seg_ <= PROBE_HI) { const unsigned long long d_ = (__builtin_amdgcn_s_memrealtime() - tseg_) * PROBE_AMP; const unsigned long long s_ = __builtin_amdgcn_s_memrealtime(); \
        while (__builtin_amdgcn_s_memrealtime() - s_ < d_) __builtin_amdgcn_s_sleep(4); } } while (0)
#define GRID_BAR() do { PROBE_SPIN(); xcd_barrier(bar); tseg_ = __builtin_amdgcn_s_memrealtime(); ++seg_; } while (0)
#else
#define PROBE_SPIN() do { } while (0)
#define GRID_BAR() xcd_barrier(bar)
#endif

    if (IN(0)) {
        PHASE_VARS();
        LAS float* scr = (LAS float*)(ldsb + wave * 16384);
        constexpr int I_IN = 16 * 72, I_O = 16 * 32, NITEMS = I_IN + 2 * I_O;
        for (int it = gwave; it < NITEMS; it += nwaves) {
            int r = it;
            if (r < I_IN) { transpose_item(a.w_in, PW, D, WINT, scr, r / 72, r % 72, lane); continue; } r -= I_IN;
            if (r < I_O) { transpose_item(a.w_out, D, D, WOT, scr, r / 32, r % 32, lane); continue; } r -= I_O;
            transpose_item(a.peer_wq, D, D, WQT, scr, r / 32, r % 32, lane);
        }
        for (int i = gtid; i < 2 * 128 * 64; i += gthreads) { const float kf = a.peer_sub_keys[i]; const short h = bfs(kf); KH[i] = (bf16)h; KL[i] = (bf16)bfs(kf - sbf2f(h)); }
        for (int i = tid; i < 8 * 1024; i += NTHR) { const int h = i & 7, c = i >> 3; *(LAS float*)(ldsb + h * 16384 + 8448 + c * 4) = a.w_in[(size_t)c * PW + ODT + h]; }
        __syncthreads();
        rmsnorm_rows_bf16<1>(a.x, a.norm_mix_g, XNB, ldsb, DTRAW, nullptr, nullptr, gwave, nwaves, lane);
    }
    GRID_BAR();
    if (IN(1)) {
        PHASE_VARS();
        pg8::Gemm g{XNB, WINT, T, PS, D}; pg8::StaticOrder S; S.init(T, PS, nb, bid);
        pg8::EpiBf16Plain E{PROJ, PS};
        pg8::gemm_phase<pg8::EpiBf16Plain, pg8::StaticOrder>(ldsb, g, S, E, nullptr);
        const int cfirst = (nb == 256) ? 64 : 0;
        if (bid >= cfirst) for (int rr0 = ((bid - cfirst) * 8 + wave) * 4; rr0 < 2 * 16384; rr0 += (nb - cfirst) * 8 * 4) {
            float4 v[4][4];
#pragma unroll
            for (int q = 0; q < 4; ++q) { const int rr = rr0 + q, which = rr >> 14, row = rr & 16383;
                typedef float f4v __attribute__((ext_vector_type(4))); const f4v* src4 = (const f4v*)((which ? a.peer_v : a.peer_u) + (size_t)row * D) + lane;
#pragma unroll
                for (int jq = 0; jq < 4; ++jq) { const f4v t4 = __builtin_nontemporal_load(src4 + 64 * jq); v[q][jq] = make_float4(t4.x, t4.y, t4.z, t4.w); } }
#pragma unroll
            for (int q = 0; q < 4; ++q) { const int rr = rr0 + q, which = rr >> 14, row = rr & 16383;
                float mx = 0.f;
#pragma unroll
                for (int jq = 0; jq < 4; ++jq) mx = fmaxf(mx, fmaxf(fmaxf(fabsf(v[q][jq].x), fabsf(v[q][jq].y)), fmaxf(fabsf(v[q][jq].z), fabsf(v[q][jq].w))));
#pragma unroll
                for (int o = 1; o < 64; o <<= 1) mx = fmaxf(mx, __shfl_xor(mx, o));
                const float sc = mx > 0.f ? mx * (1.f / 127.f) : 1.f, inv = 1.f / sc;
                unsigned* dst = (unsigned*)((which ? V8 : U8) + (size_t)row * D) + lane;
#pragma unroll
                for (int jq = 0; jq < 4; ++jq) { const int q0 = (int)rintf(v[q][jq].x * inv), q1 = (int)rintf(v[q][jq].y * inv), q2 = (int)rintf(v[q][jq].z * inv), q3 = (int)rintf(v[q][jq].w * inv);
                    dst[64 * jq] = (unsigned)(q0 & 255) | ((unsigned)(q1 & 255) << 8) | ((unsigned)(q2 & 255) << 16) | ((unsigned)(q3 & 255) << 24); }
                if (lane == 0) (which ? SV : SU)[row] = sc; }
        }
    }
    GRID_BAR();
    if (IN(3)) {
        PHASE_VARS();
        for (int u = bid; u < 512; u += nb) {
            if (u < 256) attn_unit(a.attn_sinks, a.attn_out_g, ldsb, u, PROJ, XNB, tid, lane, wave);
            else ssd_chunk_unit(ldsb, u - 256, PROJ, XACT, DTRAW, a.conv_w, a.conv_b, a.dt_bias, a.a_log, ACS, CDEC, YD, STATES, tid, lane, wave);
        }
    }
    GRID_BAR();
    if (IN(5)) {
        PHASE_VARS();
        for (int idx = gtid; idx < 2 * 8 * 8192; idx += gthreads) {
            const int pn = idx & 8191, h = (idx >> 13) & 7, b = idx >> 16;
            float run = 0.f;
#pragma unroll 1
            for (int c0 = 0; c0 < 64; c0 += 8) {
                float st[8], dc[8];
#pragma unroll
                for (int j = 0; j < 8; ++j) { const int bch = (b * 64 + c0 + j) * 8 + h; st[j] = bf2f(STATES[(size_t)bch * 8192 + pn]); dc[j] = CDEC[bch]; }
#pragma unroll
                for (int j = 0; j < 8; ++j) { const int bch = (b * 64 + c0 + j) * 8 + h; PREVT[(size_t)bch * 8192 + pn] = f2bf(run); run = dc[j] * run + st[j]; }
            }
        }
    }
    GRID_BAR();
    if (IN(6)) {
        PHASE_VARS();
        for (int u = bid; u < 256; u += nb) yoff_unit(a.d_skip, a.ssm_norm_g, ldsb, u, XACT, PROJ, ACS, PREVT, YD, XNB, lane, wave);
    }
    GRID_BAR();
    if (IN(7)) {
        PHASE_VARS();
        pg8::Gemm g{XNB, WOT, T, D, D}; pg8::StaticOrder S; S.init(T, D, nb, bid);
        pg8::EpiBf16Resid E{HB, a.x, D};
        pg8::gemm_phase<pg8::EpiBf16Resid, pg8::StaticOrder>(ldsb, g, S, E, nullptr);
    }
    GRID_BAR();
    if (IN(8)) {
        PHASE_VARS();
        rmsnorm_rows_bf16<2>((const float*)HB, a.norm_ffn_g, XNB, ldsb, nullptr, XQ, XS, gwave, nwaves, lane);
    }
    GRID_BAR();
    if (IN(9)) {
        PHASE_VARS();
        pg8::Gemm g{XNB, WQT, T, D, D}; pg8::StaticOrder S; S.init(T, D, nb, bid);
        pg8::EpiF32Resid E{QP, nullptr, D};
        pg8::gemm_phase<pg8::EpiF32Resid, pg8::StaticOrder>(ldsb, g, S, E, nullptr);
    }
    GRID_BAR();
    bf16* PEERO = (bf16*)(ws + WS_PEERO);
    if (IN(12)) {
        PHASE_VARS();
        LAS bf16* KHL = (LAS bf16*)ldsb; LAS int* ACC = (LAS int*)ldsb; LAS unsigned char* AL = (LAS unsigned char*)(ldsb + 32768); LAS float* ASC = (LAS float*)(ldsb + 40960);
        LAS unsigned short* EL = (LAS unsigned short*)(ldsb + 73728); LAS float* GL = (LAS float*)(ldsb + 90112);
#pragma unroll 1
        for (int j = bid; j < NCHUNK; j += nb) {
            __syncthreads();
            for (int i = tid; i < 2 * 2 * 128 * 8; i += NTHR) {
                const int pc = i & 7, key = (i >> 3) & 127, hf = (i >> 10) & 1, hl = i >> 11;
                *(LAS v4u*)(KHL + ((hl * 2 + hf) * 128 + key) * 72 + pc * 8) = *(const v4u*)((hl ? KL : KH) + (size_t)(hf * 128 + key) * 64 + pc * 8);
            }
            __syncthreads();
            route_task(16 * j + wave, 4 * wave, QP, KHL, EL, GL, lane);
            route_task(16 * j + 8 + wave, 32 + 4 * wave, QP, KHL, EL, GL, lane);
            __syncthreads();
#pragma unroll 1
            for (int p = 0; p < NPART; ++p) peer_u_item(p, j, EL, XQ, U8, ACC, lane, wave);
#pragma unroll 1
            for (int it = 0; it < 8; ++it) {
                const int tl = it * 8 + wave, t = j * 64 + tl;
                const unsigned ew = *(const LAS unsigned*)(EL + tl * 128 + 2 * lane); const int e0 = (int)(ew & 0xffffu), e1 = (int)(ew >> 16);
                typedef int i2v __attribute__((ext_vector_type(2))); const i2v si = *(const LAS i2v*)(ACC + tl * 128 + 2 * lane);
                typedef float f2v __attribute__((ext_vector_type(2))); const f2v gt = *(const LAS f2v*)(GL + tl * 128 + 2 * lane); const float xs = XS[t];
                const float z0 = (float)si.x * SU[e0] * xs, z1 = (float)si.y * SU[e1] * xs;
                const float a0 = gt.x * 0.5f * z0 * (1.f + erff(z0 * 0.70710678118654752f)) * SV[e0], a1 = gt.y * 0.5f * z1 * (1.f + erff(z1 * 0.70710678118654752f)) * SV[e1];
                float mx = fmaxf(fabsf(a0), fabsf(a1));
#pragma unroll
                for (int o = 1; o < 64; o <<= 1) mx = fmaxf(mx, __shfl_xor(mx, o));
                const float sc = mx > 0.f ? mx * (1.f / 127.f) : 1.f, inv = 1.f / sc;
                *(LAS unsigned short*)(AL + tl * 128 + 2 * lane) = (unsigned short)(((int)rintf(a0 * inv) & 255) | (((int)rintf(a1 * inv) & 255) << 8));
                if (lane == 0) ASC[tl] = sc;
            }
#pragma unroll 1
            for (int p = 0; p < NPART; ++p) peer_v_item(p, j, EL, AL, ASC, V8, PEERO, lane, wave);
            asm volatile("s_waitcnt vmcnt(0)" ::: "memory");
#pragma unroll 1
            for (int it = 0; it < 8; ++it) {
                const int t = j * 64 + it * 8 + wave;
                const uint2* hr = (const uint2*)(HB + (size_t)t * D) + lane; unsigned long long* pr = (unsigned long long*)(PEERO + (size_t)t * D) + lane;
                float4 v[4]; float ss = 0.f;
#pragma unroll
                for (int jq = 0; jq < 4; ++jq) { const uint2 hw = hr[64 * jq]; const unsigned long long pw = __hip_atomic_load(pr + 64 * jq, __ATOMIC_RELAXED, __HIP_MEMORY_SCOPE_AGENT);
                    const unsigned pl = (unsigned)pw, ph = (unsigned)(pw >> 32);
                    v[jq] = make_float4(__uint_as_float(hw.x << 16) + __uint_as_float(pl << 16), __uint_as_float(hw.x & 0xffff0000u) + __uint_as_float(pl & 0xffff0000u),
                                        __uint_as_float(hw.y << 16) + __uint_as_float(ph << 16), __uint_as_float(hw.y & 0xffff0000u) + __uint_as_float(ph & 0xffff0000u));
                    ss += v[jq].x * v[jq].x + v[jq].y * v[jq].y + v[jq].z * v[jq].z + v[jq].w * v[jq].w; }
                ss = wave_sum(ss);
                const float r3 = rsqrtf(ss * (1.f / D) + EPS);
                float4* op = (float4*)(a.out + (size_t)t * D) + lane;
#pragma unroll
                for (int jq = 0; jq < 4; ++jq) { const float4 gv = ((const float4*)a.final_norm_g)[lane + 64 * jq]; op[64 * jq] = make_float4(v[jq].x * r3 * gv.x, v[jq].y * r3 * gv.y, v[jq].z * r3 * gv.z, v[jq].w * r3 * gv.w); }
            }
        }
    }
    PROBE_SPIN();
#undef IN
}
}

extern "C" void kernel_launch(void* const* d_in, const int* in_sizes, int n_in, void* d_out, int out_size, void* d_ws, size_t ws_size, hipStream_t stream) {
    if (n_in != 18 || out_size != T * D || ws_size < WS_END) { fprintf(stderr, "kernel_launch: unexpected shapes n_in=%d out=%d ws=%zu\n", n_in, out_size, ws_size); return; }
    Args a{};
    const float** ap = (const float**)&a;
    for (int i = 0; i < 18; ++i) ap[i] = (const float*)d_in[i];
    a.out = (float*)d_out; a.ws = (unsigned char*)d_ws;
    static int grid = 0;
    if (grid == 0) {
        int dev = 0, cus = 0, per_cu = 0;
        if (hipGetDevice(&dev) != hipSuccess || hipDeviceGetAttribute(&cus, hipDeviceAttributeMultiprocessorCount, dev) != hipSuccess) { fprintf(stderr, "kernel_launch: device query failed\n"); grid = -1; return; }
        if (hipFuncSetAttribute((const void*)k_main, hipFuncAttributeMaxDynamicSharedMemorySize, LDS_BYTES) != hipSuccess) { fprintf(stderr, "kernel_launch: hipFuncSetAttribute failed\n"); grid = -1; return; }
        if (hipOccupancyMaxActiveBlocksPerMultiprocessor(&per_cu, (const void*)k_main, NTHR, LDS_BYTES) != hipSuccess || per_cu < 1) { fprintf(stderr, "kernel_launch: occupancy query says %d blocks/CU\n", per_cu); (void)hipGetLastError(); grid = -1; return; }
        grid = cus;
    }
    if (grid < 0) return;
    if (hipMemsetAsync(d_ws, 0, 65536, stream) != hipSuccess) { fprintf(stderr, "kernel_launch: memset failed\n"); return; }
    a.ph_lo = 0; a.ph_hi = 13;
    hipLaunchKernelGGL(k_main, dim3(grid), dim3(NTHR), LDS_BYTES, stream, a);
}
```

```cpp
#include <hip/hip_runtime.h>
#include <cstdio>
#include <cstdint>

namespace pg8 {
#define PG8_LAS __attribute__((address_space(3)))
typedef unsigned short bf16_t;
typedef short bf16x8 __attribute__((ext_vector_type(8)));
typedef float f32x4 __attribute__((ext_vector_type(4)));
typedef unsigned u32x4 __attribute__((ext_vector_type(4)));
constexpr int BM = 256, BK = 64, HALF = 128, HTB = HALF * BK * 2  , STAGE_BYTES = 8 * HTB, NXCD = 8, WGM = 8;

__host__ __device__ __forceinline__ int lds_byte(int r, int c) { const int st = (r >> 4) * 2 + (c >> 5), rr = r & 15, cc = c & 31, ob = rr * 64 + cc * 2; return st * 1024 + (ob ^ (((ob >> 9) & 1) << 5)); }
__host__ __device__ __forceinline__ void stage_rc(int b, int& R, int& C) { const int st = b / 1024, sb = b % 1024, swz = sb ^ (((sb >> 9) & 1) << 5); R = (st >> 1) * 16 + swz / 64; C = (st & 1) * 32 + (swz % 64) / 2; }
__host__ __device__ __forceinline__ int perm32(int rho) { const int n = rho >> 4, i = rho & 15; return 8 * (i >> 2) + 4 * n + (i & 3); }

struct Unit { int pm, pn; };
struct Gemm { const bf16_t* A; const bf16_t* Bt; int M, N, K; };

struct StaticOrder {
    int nM, nN, nwg, G, c;
    __host__ __device__ void init(int M, int N, int G_, int c_) { nM = M / BM; nN = N / BM; nwg = nM * nN; G = G_; c = c_; }
    __host__ __device__ bool next(int i, Unit& u) const {
        const long L = (long)i * G + c; if (L >= nwg) return false;
        int wgid = (int)L; { const int q = nwg / NXCD, r = nwg % NXCD, xcd = wgid % NXCD, off = wgid / NXCD; wgid = (xcd < r ? xcd * (q + 1) : r * (q + 1) + (xcd - r) * q) + off; }
        const int nig = WGM * nN, gid = wgid / nig, fm = gid * WGM, gsz = (nM - fm) < WGM ? (nM - fm) : WGM;
        u.pm = fm + ((wgid % nig) % gsz); u.pn = (wgid % nig) / gsz; return true;
    }
    __device__ __forceinline__ void a_ready(const Unit&) const {}
    __device__ __forceinline__ void done(const Unit&) const {}
};
__device__ __forceinline__ unsigned cvt_pk_bf16(float lo, float hi) { unsigned r; asm volatile("v_cvt_pk_bf16_f32 %0, %1, %2" : "=v"(r) : "v"(lo), "v"(hi)); return r; }
typedef float f32x2 __attribute__((ext_vector_type(2)));
struct EpiBf16Plain {
    static constexpr bool PERM = true, AFTER_DRAIN = false;
    bf16_t* O; int ldc;
    __device__ __forceinline__ void operator()(const f32x4 (&acc)[2][2][4][2], const Unit& u, int wr, int wc, int fr, int fq) const {
        const int row0 = u.pm * BM + wr * 64 + fr, col0 = u.pn * BM + wc * 32 + 8 * fq;
        const __amdgpu_buffer_rsrc_t rs = __builtin_amdgcn_make_buffer_rsrc((void*)O, 0, 0x7fffffff, 0x00020000);
#pragma unroll
        for (int ai = 0; ai < 2; ++ai)
#pragma unroll
            for (int m = 0; m < 4; ++m) { const unsigned ro = ((unsigned)(row0 + ai * HALF + m * 16) * (unsigned)ldc + (unsigned)col0) * 2u;
#pragma unroll
                for (int bj = 0; bj < 2; ++bj) { const f32x4 v0 = acc[ai][bj][m][0], v1 = acc[ai][bj][m][1];
                    u32x4 w; w.x = cvt_pk_bf16(v0[0], v0[1]); w.y = cvt_pk_bf16(v0[2], v0[3]); w.z = cvt_pk_bf16(v1[0], v1[1]); w.w = cvt_pk_bf16(v1[2], v1[3]);
                    __builtin_amdgcn_raw_buffer_store_b128(w, rs, (int)(ro + bj * HALF * 2), 0, 16); } }
    }
};
struct EpiF32Resid {
    static constexpr bool PERM = false, AFTER_DRAIN = false;
    float* C; const float* R; int ldc;
    __device__ __forceinline__ void operator()(const f32x4 (&acc)[2][2][4][2], const Unit& u, int wr, int wc, int fr, int fq) const {
        const int row0 = u.pm * BM + wr * 64 + fr, col0 = u.pn * BM + wc * 32 + 4 * fq;
#pragma unroll
        for (int ai = 0; ai < 2; ++ai)
#pragma unroll
            for (int m = 0; m < 4; ++m) { const size_t off = (size_t)(row0 + ai * HALF + m * 16) * ldc + col0;
#pragma unroll
                for (int bj = 0; bj < 2; ++bj)
#pragma unroll
                    for (int n = 0; n < 2; ++n) { f32x4 v = acc[ai][bj][m][n]; if (R) v += *(const f32x4*)(R + off + bj * HALF + n * 16); *(f32x4*)(C + off + bj * HALF + n * 16) = v; }
                asm volatile("" ::: "memory"); }
    }
};

struct EpiBf16Resid {
    static constexpr bool PERM = true, AFTER_DRAIN = false, INIT_ACC = true;
    bf16_t* O; const bf16_t* XN; const float* RINV; const float* G; int ldc;
    __device__ __forceinline__ void init(f32x4 (&acc)[2][2][4][2], const Unit& u, int wr, int wc, int fr, int fq) const {
        const int row0 = u.pm * BM + wr * 64 + fr, col0 = u.pn * BM + wc * 32 + 8 * fq;
        f32x4 gi[2][2];
#pragma unroll
        for (int bj = 0; bj < 2; ++bj)
#pragma unroll
            for (int h = 0; h < 2; ++h) { const f32x4 gv = *(const f32x4*)(G + col0 + bj * HALF + 4 * h); gi[bj][h] = (f32x4){1.f / gv[0], 1.f / gv[1], 1.f / gv[2], 1.f / gv[3]}; }
#pragma unroll
        for (int ai = 0; ai < 2; ++ai)
#pragma unroll
            for (int m = 0; m < 4; ++m) { const int row = row0 + ai * HALF + m * 16; const size_t off = (size_t)row * ldc + col0; const float ri = RINV[row];
#pragma unroll
                for (int bj = 0; bj < 2; ++bj) { const u32x4 w = *(const u32x4*)(XN + off + bj * HALF);
                    const f32x4 x0 = (f32x4){__builtin_bit_cast(float, w.x << 16), __builtin_bit_cast(float, w.x & 0xffff0000u), __builtin_bit_cast(float, w.y << 16), __builtin_bit_cast(float, w.y & 0xffff0000u)};
                    const f32x4 x1 = (f32x4){__builtin_bit_cast(float, w.z << 16), __builtin_bit_cast(float, w.z & 0xffff0000u), __builtin_bit_cast(float, w.w << 16), __builtin_bit_cast(float, w.w & 0xffff0000u)};
                    acc[ai][bj][m][0] = x0 * gi[bj][0] * ri; acc[ai][bj][m][1] = x1 * gi[bj][1] * ri; } }
    }
    __device__ __forceinline__ void operator()(const f32x4 (&acc)[2][2][4][2], const Unit& u, int wr, int wc, int fr, int fq) const {
        const int row0 = u.pm * BM + wr * 64 + fr, col0 = u.pn * BM + wc * 32 + 8 * fq;
        const __amdgpu_buffer_rsrc_t rsO = __builtin_amdgcn_make_buffer_rsrc((void*)O, 0, 0x7fffffff, 0x00020000);
#pragma unroll
        for (int ai = 0; ai < 2; ++ai)
#pragma unroll
            for (int m = 0; m < 4; ++m) { const size_t off = (size_t)(row0 + ai * HALF + m * 16) * ldc + col0;
#pragma unroll
                for (int bj = 0; bj < 2; ++bj) { const f32x4 v0 = acc[ai][bj][m][0], v1 = acc[ai][bj][m][1];
                    u32x4 w; w.x = cvt_pk_bf16(v0[0], v0[1]); w.y = cvt_pk_bf16(v0[2], v0[3]); w.z = cvt_pk_bf16(v1[0], v1[1]); w.w = cvt_pk_bf16(v1[2], v1[3]);
                    __builtin_amdgcn_raw_buffer_store_b128(w, rsO, (int)((unsigned)(off + bj * HALF) * 2u), 0, 16); } }
    }
};
template <class E, class = void> struct epi_inits { static constexpr bool value = false; };
template <class E> struct epi_inits<E, decltype((void)E::INIT_ACC)> { static constexpr bool value = E::INIT_ACC; };
template <class Epi, class Sched, bool STAMP = false>
__device__ __forceinline__ void gemm_phase(PG8_LAS unsigned char* lds, const Gemm g, const Sched& S, const Epi& E, unsigned long long* stamps) {
    const int tid = threadIdx.x, wid = __builtin_amdgcn_readfirstlane(tid >> 6), lane = tid & 63, wr = wid >> 2, wc = wid & 3, fr = lane & 15, fq = lane >> 4;
    const int K = g.K, nt = K / BK;
    int ts_lo = 0, ts_hi = 0, nts = 0; const unsigned long long rt_entry = STAMP ? (unsigned long long)0ull : 0ull;
#define PG8_STAMP() do { if (STAMP && wid == 0 && nts < 64) { const unsigned long long _c = (unsigned long long)clock64(); \
        ts_lo = (lane == nts) ? (int)(unsigned)_c : ts_lo; ts_hi = (lane == nts) ? (int)(unsigned)(_c >> 32) : ts_hi; ++nts; } } while (0)
    PG8_STAMP();
    unsigned voffA[2], voffB[2];
#pragma unroll
    for (int i = 0; i < 2; ++i) { int R, C; stage_rc(tid * 16 + i * 8192, R, C); const int Rb = Epi::PERM ? ((R & ~31) + perm32(R & 31)) : R;
        voffA[i] = (unsigned)(R * K + C) * 2u; voffB[i] = (unsigned)(Rb * K + C) * 2u; }
    const size_t kstep = (size_t)(BK * 2);
    const size_t hstep = (size_t)HALF * K * 2;
    const size_t tstep = 2 * hstep;
    const unsigned ldsw = (unsigned)wid * 1024u;
    const int aoff = lds_byte(wr * 64 + fr, fq * 8), boff = lds_byte(wc * 32 + fr, fq * 8);
#define PG8_SA(b, h) (((b) * 2 + (h)) * HTB)
#define PG8_SB(b, h) ((4 + (b) * 2 + (h)) * HTB)
#define PG8_STAGE(bufoff, gbase, voff) do { _Pragma("unroll") for (int _i = 0; _i < 2; ++_i) \
        __builtin_amdgcn_global_load_lds((const unsigned*)((const char*)(gbase) + (voff)[_i]), (PG8_LAS unsigned*)(lds + (bufoff) + ldsw + _i * 8192), 16, 0, 0); } while (0)
#define PG8_LDA(dst, b, h) do { _Pragma("unroll") for (int m = 0; m < 4; ++m) _Pragma("unroll") for (int k = 0; k < 2; ++k) dst[m][k] = *(const PG8_LAS bf16x8*)(lds + PG8_SA(b, h) + aoff + m * 2048 + k * 1024); } while (0)
#define PG8_LDB(dst, b, h) do { _Pragma("unroll") for (int n = 0; n < 2; ++n) _Pragma("unroll") for (int k = 0; k < 2; ++k) dst[n][k] = *(const PG8_LAS bf16x8*)(lds + PG8_SB(b, h) + boff + n * 2048 + k * 1024); } while (0)
#define PG8_MMA(ai, bj, At, Bt) do { __builtin_amdgcn_s_setprio(1); _Pragma("unroll") for (int m = 0; m < 4; ++m) _Pragma("unroll") for (int n = 0; n < 2; ++n) _Pragma("unroll") for (int k = 0; k < 2; ++k) \
        acc[ai][bj][m][n] = __builtin_amdgcn_mfma_f32_16x16x32_bf16(Bt[n][k], At[m][k], acc[ai][bj][m][n], 0, 0, 0); __builtin_amdgcn_s_setprio(0); } while (0)
#define PG8_WAIT_V(n) asm volatile("s_waitcnt vmcnt(" #n ")" ::: "memory")
#define PG8_WAIT_L(n) asm volatile("s_waitcnt lgkmcnt(" #n ")" ::: "memory")
#define PG8_BAR __builtin_amdgcn_s_barrier()
#define PG8_SCHED __builtin_amdgcn_sched_barrier(0)
    Unit cur, nxt; int ui = 0;
    if (!S.next(0, cur)) return;
    f32x4 acc[2][2][4][2];
    if constexpr (epi_inits<Epi>::value) E.init(acc, cur, wr, wc, fr, fq);
    else {
#pragma unroll
    for (int a = 0; a < 2; ++a)
#pragma unroll
        for (int b = 0; b < 2; ++b)
#pragma unroll
            for (int m = 0; m < 4; ++m)
#pragma unroll
                for (int n = 0; n < 2; ++n) acc[a][b][m][n] = (f32x4){0.f, 0.f, 0.f, 0.f};
    }
    bf16x8 At[4][2], B0[2][2], B1[2][2];
    const char* cA = (const char*)g.A + (size_t)cur.pm * tstep; const char* cB = (const char*)g.Bt + (size_t)cur.pn * tstep;
    S.a_ready(cur);
    PG8_STAGE(PG8_SB(0, 0), cB, voffB); PG8_STAGE(PG8_SA(0, 0), cA, voffA); PG8_STAGE(PG8_SB(0, 1), cB + hstep, voffB); PG8_STAGE(PG8_SA(0, 1), cA + hstep, voffA);
    if (wr == 1) PG8_BAR;
    PG8_WAIT_V(4); PG8_BAR;
    PG8_STAGE(PG8_SB(1, 0), cB + kstep, voffB); PG8_STAGE(PG8_SA(1, 0), cA + kstep, voffA); PG8_STAGE(PG8_SB(1, 1), cB + hstep + kstep, voffB);
    PG8_WAIT_V(6); PG8_BAR;
    PG8_STAMP();
    for (;;) {
        const bool has_next = S.next(ui + 1, nxt);
        const char* nA = has_next ? (const char*)g.A + (size_t)nxt.pm * tstep : cA; const char* nB = has_next ? (const char*)g.Bt + (size_t)nxt.pn * tstep : cB;
        for (int t = 0; t < nt; t += 2) {
            const bool last = (t == nt - 2);
            const char* a1 = cA + (size_t)(t + 1) * kstep;
            const char* a2 = last ? nA : cA + (size_t)(t + 2) * kstep; const char* b2 = last ? nB : cB + (size_t)(t + 2) * kstep;
            const char* a3 = a2 + kstep; const char* b3 = b2 + kstep;
            if (last && has_next) S.a_ready(nxt);
            PG8_LDB(B0, 0, 0); PG8_SCHED; PG8_LDA(At, 0, 0); PG8_STAGE(PG8_SA(1, 1), a1 + hstep, voffA);
            PG8_WAIT_L(8); PG8_BAR; PG8_WAIT_L(0); PG8_MMA(0, 0, At, B0); PG8_BAR; PG8_SCHED;
            PG8_LDB(B1, 0, 1); PG8_STAGE(PG8_SB(0, 0), b2, voffB);
            PG8_BAR; PG8_WAIT_L(0); PG8_MMA(0, 1, At, B1); PG8_BAR;
            PG8_LDA(At, 0, 1); PG8_STAGE(PG8_SA(0, 0), a2, voffA);
            PG8_BAR; PG8_WAIT_L(0); PG8_MMA(1, 0, At, B0); PG8_BAR; PG8_SCHED;
            PG8_STAGE(PG8_SB(0, 1), b2 + hstep, voffB);
            PG8_WAIT_V(6); PG8_BAR; PG8_MMA(1, 1, At, B1); PG8_BAR;
            PG8_LDB(B0, 1, 0); PG8_SCHED; PG8_LDA(At, 1, 0); PG8_STAGE(PG8_SA(0, 1), a2 + hstep, voffA);
            PG8_WAIT_L(8); PG8_BAR; PG8_WAIT_L(0); PG8_MMA(0, 0, At, B0); PG8_BAR; PG8_SCHED;
            PG8_LDB(B1, 1, 1); PG8_STAGE(PG8_SB(1, 0), b3, voffB);
            PG8_BAR; PG8_WAIT_L(0); PG8_MMA(0, 1, At, B1); PG8_BAR;
            PG8_LDA(At, 1, 1); PG8_STAGE(PG8_SA(1, 0), a3, voffA);
            PG8_BAR; PG8_WAIT_L(0); PG8_MMA(1, 0, At, B0); PG8_BAR; PG8_SCHED;
            PG8_STAGE(PG8_SB(1, 1), b3 + hstep, voffB);
            PG8_WAIT_V(6); PG8_BAR; PG8_MMA(1, 1, At, B1); PG8_BAR;
        }
        PG8_STAMP();
        if constexpr (!Epi::AFTER_DRAIN) { E(acc, cur, wr, wc, fr, fq); S.done(cur); }
        PG8_STAMP();
        if (!has_next) break;
        if constexpr (epi_inits<Epi>::value) E.init(acc, nxt, wr, wc, fr, fq);
        else {
#pragma unroll
        for (int a = 0; a < 2; ++a)
#pragma unroll
            for (int b = 0; b < 2; ++b)
#pragma unroll
                for (int m = 0; m < 4; ++m)
#pragma unroll
                    for (int n = 0; n < 2; ++n) acc[a][b][m][n] = (f32x4){0.f, 0.f, 0.f, 0.f};
        }
        cur = nxt; cA = nA; cB = nB; ++ui;
    }
    PG8_WAIT_V(0);
    if (wr == 0) PG8_BAR;
    PG8_BAR;
    if constexpr (Epi::AFTER_DRAIN) { E.fused(acc, cur, wr, wc, fr, fq, lds, wid, lane); S.done(cur); }
    PG8_STAMP();
    if (STAMP && wid == 0) { stamps[lane] = lane < nts ? (((unsigned long long)(unsigned)ts_hi << 32) | (unsigned)ts_lo) : 0ull;
        if (lane == 62) stamps[62] = rt_entry; if (lane == 63) stamps[63] = (unsigned long long)0ull; }
#undef PG8_STAMP
#undef PG8_SA
#undef PG8_SB
#undef PG8_STAGE
#undef PG8_LDA
#undef PG8_LDB
#undef PG8_MMA
#undef PG8_WAIT_V
#undef PG8_WAIT_L
#undef PG8_BAR
#undef PG8_SCHED
}
}

namespace {
constexpr int D = 1024, BATCH = 2, SEQ = 8192, T = BATCH * SEQ;
constexpr int PW = 2312;
constexpr int PS = 2304;
constexpr int OQ = 0, OKK = 512, OV = 640, OZ = 768, OXBC = 1280, ODT = 2304;
constexpr float EPS = 1e-6f;
constexpr int NTHR = 512;
typedef unsigned short bf16;
typedef unsigned v4u __attribute__((ext_vector_type(4)));
typedef unsigned v2u __attribute__((ext_vector_type(2)));

constexpr size_t MiB = 1u << 20;
constexpr size_t WS_WIN = 1 * MiB;
constexpr size_t WS_KH = 5 * MiB + 512 * 1024;
constexpr size_t WS_WO = 6 * MiB;
constexpr size_t WS_WQ = 8 * MiB;
constexpr size_t WS_PROJ = 10 * MiB;
constexpr size_t WS_XNB = 82 * MiB;
constexpr size_t WS_XACT = 114 * MiB;
constexpr size_t WS_DTRAW = 146 * MiB;
constexpr size_t WS_DT = WS_DTRAW + 512 * 1024;
constexpr size_t WS_ACS = WS_DT + 512 * 1024;
constexpr size_t WS_CDEC = WS_ACS + 512 * 1024;
constexpr size_t WS_STATES = 164 * MiB;
constexpr size_t WS_PREV = 196 * MiB;
constexpr size_t WS_QP = 10 * MiB;
constexpr size_t WS_IDX = 74 * MiB;
constexpr size_t WS_GATE = 114 * MiB;
constexpr size_t WS_TOPV = 122 * MiB;
constexpr size_t WS_TOPI = 138 * MiB;
constexpr size_t WS_ACT = 122 * MiB;
constexpr size_t WS_SU = 245 * MiB;
constexpr size_t WS_U8 = 212 * MiB;
constexpr size_t WS_V8 = 148 * MiB;
constexpr size_t WS_PART = 10 * MiB;
constexpr size_t WS_XQ = 228 * MiB;
constexpr size_t WS_XS = 244 * MiB;
constexpr size_t WS_PEERO = 10 * MiB;
constexpr size_t WS_END = 246 * MiB;
constexpr int CW_QU = 4096, CW_QV = 4096 + 64 * 16;
constexpr int NPART = 8, NCHUNK = T / 64;

struct Args {
    const float* x; const float* norm_mix_g; const float* w_in; const float* attn_sinks; const float* attn_out_g;
    const float* conv_w; const float* conv_b; const float* dt_bias; const float* a_log; const float* d_skip;
    const float* ssm_norm_g; const float* w_out; const float* norm_ffn_g; const float* peer_wq; const float* peer_sub_keys;
    const float* peer_u; const float* peer_v; const float* final_norm_g;
    float* out; unsigned char* ws;
    int ph_lo, ph_hi;
};

#define LAS __attribute__((address_space(3)))
#define LDS_WAIT() asm volatile("s_waitcnt lgkmcnt(0)" ::: "memory")
__device__ __forceinline__ float bf2f(bf16 v) { return __uint_as_float(((unsigned)v) << 16); }
typedef __bf16 bf2h_t __attribute__((ext_vector_type(2)));
__device__ __forceinline__ unsigned pk2(float lo, float hi) { bf2h_t v = {(__bf16)lo, (__bf16)hi}; return __builtin_bit_cast(unsigned, v); }
__device__ __forceinline__ unsigned f2bfu(float f) { return (unsigned)__builtin_bit_cast(unsigned short, (__bf16)f); }
__device__ __forceinline__ bf16 f2bf(float f) { return (bf16)f2bfu(f); }
__device__ __forceinline__ float wave_sum(float v) {
#define WS_DPP_(x, ctrl) __builtin_bit_cast(float, __builtin_amdgcn_update_dpp(0, __builtin_bit_cast(int, x), ctrl, 0xf, 0xf, false))
    v += WS_DPP_(v, 0xB1); v += WS_DPP_(v, 0x4E); v += WS_DPP_(v, 0x141); v += WS_DPP_(v, 0x140);
#undef WS_DPP_
    const int vi = __builtin_bit_cast(int, v);
    return (__builtin_bit_cast(float, __builtin_amdgcn_readlane(vi, 0)) + __builtin_bit_cast(float, __builtin_amdgcn_readlane(vi, 16))) +
           (__builtin_bit_cast(float, __builtin_amdgcn_readlane(vi, 32)) + __builtin_bit_cast(float, __builtin_amdgcn_readlane(vi, 48)));
}
__device__ __forceinline__ float silu_f(float v) { return v * __builtin_amdgcn_rcpf(1.f + __expf(-v)); }
#define DPPF_(v, ctrl) __builtin_bit_cast(float, __builtin_amdgcn_update_dpp(0, __builtin_bit_cast(int, v), ctrl, 0xf, 0xf, false))
__device__ __forceinline__ float wave_max_dpp(float v) {
    v = fmaxf(v, DPPF_(v, 0xB1)); v = fmaxf(v, DPPF_(v, 0x4E)); v = fmaxf(v, DPPF_(v, 0x141)); v = fmaxf(v, DPPF_(v, 0x140));
    const int vi = __builtin_bit_cast(int, v);
    return fmaxf(fmaxf(__builtin_bit_cast(float, __builtin_amdgcn_readlane(vi, 0)), __builtin_bit_cast(float, __builtin_amdgcn_readlane(vi, 16))),
                 fmaxf(__builtin_bit_cast(float, __builtin_amdgcn_readlane(vi, 32)), __builtin_bit_cast(float, __builtin_amdgcn_readlane(vi, 48))));
}
__device__ __forceinline__ int wave_sum_dpp_i(int v) {
    v += __builtin_amdgcn_update_dpp(0, v, 0xB1, 0xf, 0xf, false); v += __builtin_amdgcn_update_dpp(0, v, 0x4E, 0xf, 0xf, false);
    v += __builtin_amdgcn_update_dpp(0, v, 0x141, 0xf, 0xf, false); v += __builtin_amdgcn_update_dpp(0, v, 0x140, 0xf, 0xf, false);
    return __builtin_amdgcn_readlane(v, 0) + __builtin_amdgcn_readlane(v, 16) + __builtin_amdgcn_readlane(v, 32) + __builtin_amdgcn_readlane(v, 48);
}
__device__ __forceinline__ float gelu_as(float z) {
    const float ax = fabsf(z) * 0.70710678118654752f, t = __builtin_amdgcn_rcpf(1.f + 0.3275911f * ax);
    const float poly = t * (0.254829592f + t * (-0.284496736f + t * (1.421413741f + t * (-1.453152027f + t * 1.061405429f))));
    const float er = 1.f - poly * __expf(-ax * ax);
    return 0.5f * z * (1.f + copysignf(er, z));
}

__device__ __forceinline__ void transpose_item(const float* W, int ldw, int K, bf16* WT, LAS float* scr, int kb, int nbk, int lane) {
    const int k0 = 64 * kb, n0 = 32 * nbk;
#pragma unroll 8
    for (int i = 0; i < 32; ++i) { const int kk = 2 * i + (lane >> 5); scr[kk * 33 + (lane & 31)] = W[(size_t)(k0 + kk) * ldw + n0 + (lane & 31)]; }
    LDS_WAIT();
    const int c = lane & 7;
#pragma unroll
    for (int j = 0; j < 4; ++j) { const int n = (lane >> 3) + 8 * j; const LAS float* s = scr + (8 * c) * 33 + n;
        v4u o; o.x = pk2(s[0 * 33], s[1 * 33]); o.y = pk2(s[2 * 33], s[3 * 33]); o.z = pk2(s[4 * 33], s[5 * 33]); o.w = pk2(s[6 * 33], s[7 * 33]);
        *(v4u*)(WT + (size_t)(n0 + n) * K + k0 + 8 * c) = o; }
    LDS_WAIT();
}

template <int MODE  >
__device__ __forceinline__ void rmsnorm_rows_bf16(const float* __restrict__ in, const float* __restrict__ g, bf16* __restrict__ outp, const LAS unsigned char* ldsb, float* __restrict__ dtraw, unsigned char* __restrict__ xq, float* __restrict__ xs, int gwave, int nwaves, int lane) {
#pragma unroll 2
    for (int row = gwave; row < T; row += nwaves) {
        const float4* xr = (const float4*)(in + (size_t)row * D) + lane; const uint2* xb = (const uint2*)((const bf16*)in + (size_t)row * D) + lane;
        float4 v[4]; float ss = 0.f;
#pragma unroll
        for (int j = 0; j < 4; ++j) {
            if (MODE == 2) { const uint2 w = xb[64 * j]; v[j] = make_float4(__uint_as_float(w.x << 16), __uint_as_float(w.x & 0xffff0000u), __uint_as_float(w.y << 16), __uint_as_float(w.y & 0xffff0000u)); }
            else if (MODE == 1) { typedef float f4v __attribute__((ext_vector_type(4))); const f4v t4 = __builtin_nontemporal_load((const f4v*)xr + 64 * j); v[j] = make_float4(t4.x, t4.y, t4.z, t4.w); }
            else v[j] = xr[64 * j];
            ss += v[j].x * v[j].x + v[j].y * v[j].y + v[j].z * v[j].z + v[j].w * v[j].w; }
        ss = wave_sum(ss);
        const float r = rsqrtf(ss * (1.f / D) + EPS);
        unsigned long long* o8 = (unsigned long long*)(outp + (size_t)row * D) + lane;
        float dacc[8]; float y[4][4]; float mx = 0.f;
#pragma unroll
        for (int h = 0; h < 8; ++h) dacc[h] = 0.f;
#pragma unroll
        for (int j = 0; j < 4; ++j) {
            const float4 gv = ((const float4*)g)[lane + 64 * j];
            y[j][0] = v[j].x * r * gv.x; y[j][1] = v[j].y * r * gv.y; y[j][2] = v[j].z * r * gv.z; y[j][3] = v[j].w * r * gv.w;
            o8[64 * j] = (unsigned long long)pk2(y[j][0], y[j][1]) | ((unsigned long long)pk2(y[j][2], y[j][3]) << 32);
            if (MODE == 2) mx = fmaxf(mx, fmaxf(fmaxf(fabsf(y[j][0]), fabsf(y[j][1])), fmaxf(fabsf(y[j][2]), fabsf(y[j][3]))));
            if (MODE == 1) {
#pragma unroll
                for (int h = 0; h < 8; ++h) {
                    typedef float f4v __attribute__((ext_vector_type(4)));
                    const f4v wv = *(const LAS f4v*)(ldsb + h * 16384 + 8448 + (256 * j + 4 * lane) * 4);
                    dacc[h] += y[j][0] * wv.x + y[j][1] * wv.y + y[j][2] * wv.z + y[j][3] * wv.w;
                }
            }
        }
        if (MODE == 1) {
#pragma unroll
            for (int h = 0; h < 8; ++h) dacc[h] = wave_sum(dacc[h]);
            if (lane == 0) { float4* dp = (float4*)(dtraw + (size_t)row * 8); dp[0] = make_float4(dacc[0], dacc[1], dacc[2], dacc[3]); dp[1] = make_float4(dacc[4], dacc[5], dacc[6], dacc[7]); xs[row] = 1.f / r; }
        }
        if (MODE == 2) {
#pragma unroll
            for (int o = 1; o < 64; o <<= 1) mx = fmaxf(mx, __shfl_xor(mx, o));
            const float sc = mx > 0.f ? mx * (1.f / 119.f) : 1.f, inv = 1.f / sc;
            unsigned* dqh = (unsigned*)(xq + (size_t)row * 512) + lane; unsigned* dql = (unsigned*)(xq + 8 * MiB + (size_t)row * 512) + lane;
            int sx = 0; unsigned wh[2] = {0u, 0u}, wl[2] = {0u, 0u};
#pragma unroll
            for (int j = 0; j < 4; ++j)
#pragma unroll
                for (int i = 0; i < 4; ++i) { const int q = (int)rintf(y[j][i] * inv); sx += q; const unsigned tq = (unsigned)(q + 8);
                    wl[j >> 1] |= ((tq & 15u) ^ 8u) << (4 * (4 * (j & 1) + i)); wh[j >> 1] |= (((unsigned)((int)tq >> 4)) & 15u) << (4 * (4 * (j & 1) + i)); }
            dqh[0] = wh[0]; dqh[64] = wh[1]; dql[0] = wl[0]; dql[64] = wl[1];
#pragma unroll
            for (int o = 1; o < 64; o <<= 1) sx += __shfl_xor(sx, o);
            if (lane == 0) ((int*)(xs + T))[row] = sx;
            if (lane == 0) xs[row] = sc;
        }
    }
}

__device__ __forceinline__ void xn2_rows(const bf16* __restrict__ hb, const float* __restrict__ g, bf16* __restrict__ outp, unsigned char* __restrict__ xq, float* __restrict__ xs, int gwave, int nwaves, int lane, int rend) {
    const __amdgpu_buffer_rsrc_t rsO = __builtin_amdgcn_make_buffer_rsrc((void*)outp, 0, (unsigned)T * D * 2u, 0x00020000), rsQ = __builtin_amdgcn_make_buffer_rsrc((void*)xq, 0, 16u * (unsigned)MiB, 0x00020000);
#pragma unroll 2
    for (int row = gwave; row < rend; row += nwaves) {
        const v4u* xb = (const v4u*)(hb + (size_t)row * D) + lane;
        float v[2][8]; float ss = 0.f;
#pragma unroll
        for (int j = 0; j < 2; ++j) { const v4u w = xb[64 * j]; const unsigned ww[4] = {w.x, w.y, w.z, w.w};
#pragma unroll
            for (int e = 0; e < 4; ++e) { v[j][2 * e] = __uint_as_float(ww[e] << 16); v[j][2 * e + 1] = __uint_as_float(ww[e] & 0xffff0000u); ss += v[j][2 * e] * v[j][2 * e] + v[j][2 * e + 1] * v[j][2 * e + 1]; } }
        ss = wave_sum(ss);
        const float r = rsqrtf(ss * (1.f / D) + EPS);
        float y[2][8]; float mx = 0.f;
#pragma unroll
        for (int j = 0; j < 2; ++j) { const float4 g0 = ((const float4*)g)[2 * lane + 128 * j], g1 = ((const float4*)g)[2 * lane + 128 * j + 1]; const float gg[8] = {g0.x, g0.y, g0.z, g0.w, g1.x, g1.y, g1.z, g1.w};
#pragma unroll
            for (int e = 0; e < 8; ++e) { y[j][e] = v[j][e] * r * gg[e]; mx = fmaxf(mx, fabsf(y[j][e])); }
            v4u ow; ow.x = pk2(y[j][0], y[j][1]); ow.y = pk2(y[j][2], y[j][3]); ow.z = pk2(y[j][4], y[j][5]); ow.w = pk2(y[j][6], y[j][7]);
            __builtin_amdgcn_raw_buffer_store_b128(ow, rsO, (int)(((unsigned)row * D + 8u * (unsigned)lane + 512u * j) * 2u), 0, 16); }
        mx = wave_max_dpp(mx);
        const float sc = mx > 0.f ? mx * (1.f / 119.f) : 1.f, inv = 1.f / sc;
        int sx = 0; unsigned W[4];
#pragma unroll
        for (int j = 0; j < 2; ++j) { unsigned wh = 0u, wl = 0u;
#pragma unroll
            for (int e = 0; e < 8; ++e) { const int q = (int)rintf(y[j][e] * inv); sx += q; const unsigned tq = (unsigned)(q + 8);
                wl |= ((tq & 15u) ^ 8u) << (4 * e); wh |= (((unsigned)((int)tq >> 4)) & 15u) << (4 * e); }
            W[j] = wh; W[2 + j] = wl; }
        { const bool o1 = (lane & 1) != 0, o2 = (lane & 2) != 0;
#pragma unroll
          for (int p = 0; p < 4; p += 2) { const unsigned t = o1 ? W[p] : W[p + 1]; const unsigned rc = (unsigned)__builtin_amdgcn_update_dpp(0, (int)t, 0xB1, 0xf, 0xf, false); if (o1) W[p] = rc; else W[p + 1] = rc; }
#pragma unroll
          for (int p = 0; p < 2; ++p) { const unsigned t = o2 ? W[p] : W[p + 2]; const unsigned rc = (unsigned)__builtin_amdgcn_update_dpp(0, (int)t, 0x4E, 0xf, 0xf, false); if (o2) W[p] = rc; else W[p + 2] = rc; } }
        { const int m = lane & 3; v4u pw; pw.x = W[0]; pw.y = W[1]; pw.z = W[2]; pw.w = W[3];
          __builtin_amdgcn_raw_buffer_store_b128(pw, rsQ, (int)((m & 2 ? 8u * (unsigned)MiB : 0u) + (unsigned)row * 512u + (unsigned)(m & 1) * 256u + 16u * (unsigned)(lane >> 2)), 0, 16); }
        sx = wave_sum_dpp_i(sx);
        if (lane == 0) { __hip_atomic_store(xs + row, sc, __ATOMIC_RELAXED, __HIP_MEMORY_SCOPE_AGENT); __hip_atomic_store((int*)(xs + T) + row, sx, __ATOMIC_RELAXED, __HIP_MEMORY_SCOPE_AGENT); }
    }
}

typedef short bf16x8 __attribute__((ext_vector_type(8)));
typedef short bf16x4 __attribute__((ext_vector_type(4)));
typedef float f32x16 __attribute__((ext_vector_type(16)));
typedef __bf16 bf2_t __attribute__((ext_vector_type(2)));
#define MFMA32(a, b, c) __builtin_amdgcn_mfma_f32_32x32x16_bf16((a), (b), (c), 0, 0, 0)
__device__ __forceinline__ unsigned pkbf(float lo, float hi) { bf2_t v = {(__bf16)lo, (__bf16)hi}; return __builtin_bit_cast(unsigned, v); }
__device__ __forceinline__ short bfs(float f) { return __builtin_bit_cast(short, (__bf16)f); }
__device__ __forceinline__ float sbf2f(short v) { return __uint_as_float(((unsigned)(unsigned short)v) << 16); }
__device__ __forceinline__ int crow(int i, int hi) { return (i & 3) + 8 * (i >> 2) + 4 * hi; }
template <int S> __device__ __forceinline__ bf16x8 pack8(const f32x16& x) {
    v4u p; p.x = pkbf(x[8 * S], x[8 * S + 1]); p.y = pkbf(x[8 * S + 2], x[8 * S + 3]); p.z = pkbf(x[8 * S + 4], x[8 * S + 5]); p.w = pkbf(x[8 * S + 6], x[8 * S + 7]);
    return __builtin_bit_cast(bf16x8, p);
}
__device__ __forceinline__ bf16x8 ldg8(const bf16* p) { return *(const bf16x8*)p; }
__device__ __forceinline__ bf16x8 lds8(const LAS bf16* p) { return *(const LAS bf16x8*)p; }
__device__ __forceinline__ bf16x8 lds4x2(const LAS bf16* p) { const bf16x4 a = *(const LAS bf16x4*)p, b = *(const LAS bf16x4*)(p + 8); return __builtin_shufflevector(a, b, 0, 1, 2, 3, 4, 5, 6, 7); }
__device__ __forceinline__ f32x16 zero16() { f32x16 z;
#pragma unroll
    for (int i = 0; i < 16; ++i) z[i] = 0.f;
    return z; }

__device__ __forceinline__ void attn_unit(const float* sinks, const float* gnorm, LAS unsigned char* ldsb, int unit, const bf16* PROJ, bf16* MIXB, int tid, int lane, int wave, int part = 2  ) {
    asm volatile("" : "+v"(tid), "+v"(lane));
    const int tok0 = unit * 64, s0 = tok0 & (SEQ - 1), kbase = tok0 - 128;
    LAS bf16* VT = (LAS bf16*)ldsb;
    LAS bf16* KI = (LAS bf16*)(ldsb + 51200);
    LAS float* SSQ = (LAS float*)(ldsb + 51200 + 55296);
    const __amdgpu_buffer_rsrc_t rsP = __builtin_amdgcn_make_buffer_rsrc((void*)PROJ, 0, (unsigned)T * PS * 2u, 0x00020000);
    if (part != 1) {
        bf16x8 v0[3], k0[3], v1[3], k1[3];
#pragma unroll
        for (int i = 0; i < 3; ++i) {
            const int c = tid + 512 * i, kv = c / 768, cc = c - kv * 768, key = (cc >> 3) * 2, d0 = (cc & 7) * 8; const bool valid = (s0 - 128 + key) >= 0;
#pragma unroll
            for (int e = 0; e < 8; ++e) { v0[i][e] = 0; k0[i][e] = 0; v1[i][e] = 0; k1[i][e] = 0; }
            if (valid) { const unsigned ro = (unsigned)(kbase + key) * (unsigned)PS + (unsigned)(kv * 64 + d0);
                v0[i] = __builtin_bit_cast(bf16x8, __builtin_amdgcn_raw_buffer_load_b128(rsP, (int)((ro + (unsigned)OV) * 2u), 0, 2));
                k0[i] = __builtin_bit_cast(bf16x8, __builtin_amdgcn_raw_buffer_load_b128(rsP, (int)((ro + (unsigned)OKK) * 2u), 0, 2));
                v1[i] = __builtin_bit_cast(bf16x8, __builtin_amdgcn_raw_buffer_load_b128(rsP, (int)((ro + (unsigned)(PS + OV)) * 2u), 0, 2));
                k1[i] = __builtin_bit_cast(bf16x8, __builtin_amdgcn_raw_buffer_load_b128(rsP, (int)((ro + (unsigned)(PS + OKK)) * 2u), 0, 2)); }
        }
        __builtin_amdgcn_sched_barrier(0);
#pragma unroll
        for (int i = 0; i < 3; ++i) {
            const int c = tid + 512 * i, kv = c / 768, cc = c - kv * 768, key = (cc >> 3) * 2, d0 = (cc & 7) * 8;
            const v4u a = __builtin_bit_cast(v4u, v0[i]), b = __builtin_bit_cast(v4u, v1[i]);
            LAS unsigned* vt = (LAS unsigned*)(VT + kv * 12800 + d0 * 200 + key);
            vt[0 * 100] = __builtin_amdgcn_perm(b.x, a.x, 0x05040100u); vt[1 * 100] = __builtin_amdgcn_perm(b.x, a.x, 0x07060302u);
            vt[2 * 100] = __builtin_amdgcn_perm(b.y, a.y, 0x05040100u); vt[3 * 100] = __builtin_amdgcn_perm(b.y, a.y, 0x07060302u);
            vt[4 * 100] = __builtin_amdgcn_perm(b.z, a.z, 0x05040100u); vt[5 * 100] = __builtin_amdgcn_perm(b.z, a.z, 0x07060302u);
            vt[6 * 100] = __builtin_amdgcn_perm(b.w, a.w, 0x05040100u); vt[7 * 100] = __builtin_amdgcn_perm(b.w, a.w, 0x07060302u);
            *(LAS bf16x8*)(KI + (kv * 192 + key) * 72 + d0) = k0[i];
            *(LAS bf16x8*)(KI + (kv * 192 + key + 1) * 72 + d0) = k1[i];
        }
    }
    __syncthreads();
    const int r = lane & 31, hi = lane >> 5;
    const int hq = wave, hkv = wave >> 2;
    const float L2E = 1.4426950408889634f; const float slope = exp2f(-(float)(hq + 1)) * L2E, sink = sinks[hq] * L2E;
#pragma unroll 1
    for (int qt = (part == 1 ? 1 : 0); qt < (part == 0 ? 1 : 2); ++qt) {
        const int tq = tok0 + 32 * qt + r;
        bf16x8 qf[4];
        { unsigned qo = (unsigned)tq * (unsigned)PS + (unsigned)(OQ + hq * 64 + 8 * hi); asm volatile("" : "+v"(qo)); const bf16* qp = PROJ + qo;
#pragma unroll
          for (int ks = 0; ks < 4; ++ks) qf[ks] = ldg8(qp + 16 * ks); }
        const int ql = 32 * qt + r;
        float m = sink, lh = 0.f;
        f32x16 O0 = zero16(), O1 = zero16();
#pragma unroll 1
        for (int kt = 0; kt < 5; ++kt) {
            const LAS bf16* kp = KI + (hkv * 192 + 32 * (qt + kt) + r) * 72 + 8 * hi;
            f32x16 X = zero16();
#pragma unroll
            for (int ks = 0; ks < 4; ++ks) X = MFMA32(lds8(kp + 16 * ks), qf[ks], X);
            float tm = -1e30f;
            if (kt >= 1 && kt <= 3 && s0 >= 128) {
                const float base = slope * (float)(128 + ql - 32 * (qt + kt) - 4 * hi);
#pragma unroll
                for (int i = 0; i < 16; ++i) { const float lg = X[i] * (0.125f * L2E) - base + slope * (float)((i & 3) + 8 * (i >> 2)); X[i] = lg; tm = fmaxf(tm, lg); }
            } else {
#pragma unroll
            for (int i = 0; i < 16; ++i) {
                const int kl = 32 * (qt + kt) + crow(i, hi), dist = 128 + ql - kl;
                const bool valid = (dist >= 0) && (dist < 128) && ((s0 - 128 + kl) >= 0);
                const float lg = valid ? (X[i] * (0.125f * L2E) - slope * (float)dist) : -1e30f;
                X[i] = lg; tm = fmaxf(tm, lg);
            }
            }
            tm = fmaxf(tm, __shfl_xor(tm, 32));
            const float mn = fmaxf(m, tm), sc = __builtin_amdgcn_exp2f(m - mn);
            m = mn; lh *= sc;
#pragma unroll
            for (int i = 0; i < 16; ++i) { O0[i] *= sc; O1[i] *= sc; const float pe = __builtin_amdgcn_exp2f(X[i] - mn); X[i] = pe; lh += pe; }
            const LAS bf16* vp = VT + hkv * 12800 + r * 200 + 32 * (qt + kt) + 4 * hi;
            { const bf16x8 xs = pack8<0>(X); const bf16x8 a0 = lds4x2(vp), a1 = lds4x2(vp + 32 * 200); O0 = MFMA32(a0, xs, O0); O1 = MFMA32(a1, xs, O1); }
            { const bf16x8 xs = pack8<1>(X); const bf16x8 a0 = lds4x2(vp + 16), a1 = lds4x2(vp + 32 * 200 + 16); O0 = MFMA32(a0, xs, O0); O1 = MFMA32(a1, xs, O1); }
        }
        const float lsum = lh + __shfl_xor(lh, 32) + __builtin_amdgcn_exp2f(sink - m);
        const float iv = 1.f / lsum;
        float sq = 0.f;
#pragma unroll
        for (int i = 0; i < 16; ++i) sq += O0[i] * O0[i] + O1[i] * O1[i];
        sq *= iv * iv; sq += __shfl_xor(sq, 32);
        if (hi == 0) SSQ[hq * 32 + r] = sq;
        float4 g0[4], g1[4];
#pragma unroll
        for (int q4 = 0; q4 < 4; ++q4) { g0[q4] = *(const float4*)(gnorm + hq * 64 + 8 * q4 + 4 * hi); g1[q4] = *(const float4*)(gnorm + hq * 64 + 32 + 8 * q4 + 4 * hi); }
        __syncthreads();
        float tot = 0.f;
#pragma unroll
        for (int h = 0; h < 8; ++h) tot += SSQ[h * 32 + r];
        const float sc = iv * rsqrtf(tot * (1.f / 512.f) + EPS);
        bf16* orow = MIXB + (size_t)tq * D + hq * 64 + 4 * hi;
#pragma unroll
        for (int q4 = 0; q4 < 4; ++q4) {
            uint2 w0, w1;
            w0.x = pkbf(O0[4 * q4] * sc * g0[q4].x, O0[4 * q4 + 1] * sc * g0[q4].y); w0.y = pkbf(O0[4 * q4 + 2] * sc * g0[q4].z, O0[4 * q4 + 3] * sc * g0[q4].w);
            w1.x = pkbf(O1[4 * q4] * sc * g1[q4].x, O1[4 * q4 + 1] * sc * g1[q4].y); w1.y = pkbf(O1[4 * q4 + 2] * sc * g1[q4].z, O1[4 * q4 + 3] * sc * g1[q4].w);
            *(uint2*)(orow + 8 * q4) = w0; *(uint2*)(orow + 32 + 8 * q4) = w1;
        }
        __syncthreads();
    }
}

#define SWZ(row, s) ((row) * 136 + (((((s) >> 3) ^ (((row) >> 3) & 7)) << 3) | ((s) & 7)))
__device__ __forceinline__ bf16x8 lds4s(const LAS bf16* img, int row, int s) { const bf16x4 a = *(const LAS bf16x4*)(img + SWZ(row, s)), b = *(const LAS bf16x4*)(img + SWZ(row, s + 8)); return __builtin_shufflevector(a, b, 0, 1, 2, 3, 4, 5, 6, 7); }
__device__ __forceinline__ void ssd_chunk_unit(LAS unsigned char* ldsb, int unit, const bf16* PROJ, bf16* XACT, const float* DTRAW, const float* conv_w, const float* conv_b, const float* dt_bias, const float* a_log,
                                               float* ACS, float* CDEC, bf16* YD, bf16* STATES, int tid, int lane, int wave) {
    asm volatile("" : "+v"(tid), "+v"(lane));
    const int g = unit & 1, bc = unit >> 1, tok0 = bc * 128;
    const __amdgpu_buffer_rsrc_t rsXA = __builtin_amdgcn_make_buffer_rsrc((void*)XACT, 0, (unsigned)T * 1024u * 2u, 0x00020000), rsYD = __builtin_amdgcn_make_buffer_rsrc((void*)YD, 0, (unsigned)T * 512u * 2u, 0x00020000),
                                 rsST = __builtin_amdgcn_make_buffer_rsrc((void*)STATES, 0, 2u * 64u * 8u * 8192u * 2u, 0x00020000);
    LAS bf16* BT = (LAS bf16*)ldsb;
    LAS bf16* XD = (LAS bf16*)(ldsb + 34816);
    LAS float* ACST = (LAS float*)(ldsb + 104448);
    LAS float* DTT = (LAS float*)(ldsb + 106496);
    LAS float* WTAB = (LAS float*)(ldsb + 108544);
    LAS float* WT = (LAS float*)(ldsb + 110592);
    {
        const int s = tid >> 2, hh = tid & 3, H = g * 4 + hh;
        const float A = -__expf(a_log[H]);
        const float raw = DTRAW[(size_t)(tok0 + s) * 8 + H] + dt_bias[H];
        const float dtv = fmaxf(raw, 0.f) + log1pf(__expf(-fabsf(raw)));
        float v = dtv * A;
#pragma unroll
        for (int o = 4; o < 64; o <<= 1) { const float y = __shfl_up(v, o); if (lane >= o) v += y; }
        if (lane >= 60) WT[wave * 4 + hh] = v;
        __syncthreads();
        float off = 0.f, tot = 0.f;
        for (int w2 = 0; w2 < 8; ++w2) { const float wv = WT[w2 * 4 + hh]; tot += wv; if (w2 < wave) off += wv; }
        v += off;
        DTT[tid] = dtv; ACST[tid] = v; WTAB[hh * 128 + s] = __expf(tot - v); __hip_atomic_store(&ACS[(size_t)(tok0 + s) * 8 + H], v, __ATOMIC_RELAXED, __HIP_MEMORY_SCOPE_AGENT);
        if (s == 127) __hip_atomic_store(&CDEC[bc * 8 + H], __expf(v), __ATOMIC_RELAXED, __HIP_MEMORY_SCOPE_AGENT);
    }
    __syncthreads();
    {
        const int cgi = tid & 63, sg = tid >> 6, t0 = tok0 + 16 * sg;
        const int c0 = cgi < 32 ? g * 256 + cgi * 8 : (cgi < 48 ? 512 + g * 128 + (cgi - 32) * 8 : 768 + g * 128 + (cgi - 48) * 8);
        float w[4][8], bs[8];
#pragma unroll
        for (int k = 0; k < 4; ++k) { const float4 a0 = *(const float4*)(conv_w + k * 1024 + c0), a1 = *(const float4*)(conv_w + k * 1024 + c0 + 4);
            w[k][0] = a0.x; w[k][1] = a0.y; w[k][2] = a0.z; w[k][3] = a0.w; w[k][4] = a1.x; w[k][5] = a1.y; w[k][6] = a1.z; w[k][7] = a1.w; }
        { const float4 a0 = *(const float4*)(conv_b + c0), a1 = *(const float4*)(conv_b + c0 + 4); bs[0] = a0.x; bs[1] = a0.y; bs[2] = a0.z; bs[3] = a0.w; bs[4] = a1.x; bs[5] = a1.y; bs[6] = a1.z; bs[7] = a1.w; }
        const bool has_halo = (t0 & (SEQ - 1)) != 0;
        bf16x8 rows[19];
#pragma unroll
        for (int i = 0; i < 19; ++i) {
            if (i < 3 && !has_halo) {
#pragma unroll
                for (int e = 0; e < 8; ++e) rows[i][e] = 0;
            } else rows[i] = __builtin_nontemporal_load((const bf16x8*)(PROJ + (size_t)(t0 + i - 3) * PS + OXBC + c0));
        }
        const int kind = cgi < 32 ? 0 : (cgi < 48 ? 1 : 2);
        LAS bf16* img = kind == 0 ? XD + (cgi >> 3) * 8704 : BT; const int row0 = kind == 0 ? (cgi & 7) * 8 : (cgi - 32) * 8;
        const int hh = (cgi >> 3) & 3;
        LAS bf16* brw = (LAS bf16*)(ldsb + (sg < 4 ? 112640 : 114176));
#pragma unroll
        for (int hb = 0; hb < 4; ++hb) {
            unsigned pk[8][2];
#pragma unroll
            for (int ii = 0; ii < 4; ii += 2) {
                const int i = 4 * hb + ii;
                float oa[8], ob[8];
#pragma unroll
                for (int e = 0; e < 8; ++e) {
                    oa[e] = silu_f(bs[e] + w[0][e] * sbf2f(rows[i][e]) + w[1][e] * sbf2f(rows[i + 1][e]) + w[2][e] * sbf2f(rows[i + 2][e]) + w[3][e] * sbf2f(rows[i + 3][e]));
                    ob[e] = silu_f(bs[e] + w[0][e] * sbf2f(rows[i + 1][e]) + w[1][e] * sbf2f(rows[i + 2][e]) + w[2][e] * sbf2f(rows[i + 3][e]) + w[3][e] * sbf2f(rows[i + 4][e])); }
                const int sA = 16 * sg + i;
                { v4u ov; ov.x = pkbf(oa[0], oa[1]); ov.y = pkbf(oa[2], oa[3]); ov.z = pkbf(oa[4], oa[5]); ov.w = pkbf(oa[6], oa[7]); __builtin_amdgcn_raw_buffer_store_b128(ov, rsXA, (int)(((unsigned)(t0 + i) * 1024u + (unsigned)c0) * 2u), 0, 16);
                  if (kind == 1) *(LAS v4u*)(brw + SWZ(sA, row0)) = ov; }
                { v4u ov; ov.x = pkbf(ob[0], ob[1]); ov.y = pkbf(ob[2], ob[3]); ov.z = pkbf(ob[4], ob[5]); ov.w = pkbf(ob[6], ob[7]); __builtin_amdgcn_raw_buffer_store_b128(ov, rsXA, (int)(((unsigned)(t0 + i + 1) * 1024u + (unsigned)c0) * 2u), 0, 16);
                  if (kind == 1) *(LAS v4u*)(brw + SWZ(sA + 1, row0)) = ov; }
                const float dta = kind == 0 ? DTT[sA * 4 + hh] : 1.f, dtb = kind == 0 ? DTT[(sA + 1) * 4 + hh] : 1.f;
#pragma unroll
                for (int e = 0; e < 8; ++e) pk[e][ii >> 1] = pkbf(oa[e] * dta, ob[e] * dtb);
            }
            if (kind != 2) {
#pragma unroll
                for (int e = 0; e < 8; ++e) { v2u w0; w0.x = pk[e][0]; w0.y = pk[e][1]; *(LAS v2u*)(img + SWZ(row0 + e, 16 * sg + 4 * hb)) = w0; }
            }
        }
    }
    asm volatile("s_waitcnt vmcnt(0)" ::: "memory");
    __syncthreads();
    const int r = lane & 31, hi = lane >> 5;
    {
        const int lt = (wave & 3) ^ ((wave >> 2) * 3), hA = wave >> 2, hB = hA + 2;
        const int l = 32 * lt + r; const float aclA = ACST[l * 4 + hA], aclB = ACST[l * 4 + hB];
        bf16x8 cf[8];
        { unsigned co = (unsigned)(tok0 + l) * 1024u + (unsigned)(768 + g * 128 + 8 * hi); asm volatile("" : "+v"(co)); const bf16* cp = XACT + co;
#pragma unroll
          for (int ks = 0; ks < 8; ++ks) cf[ks] = ldg8(cp + 16 * ks); }
        f32x16 ZA0 = zero16(), ZA1 = zero16(), ZB0 = zero16(), ZB1 = zero16();
#pragma unroll 1
        for (int st = 0; st <= lt; ++st) {
            f32x16 X = zero16();
            bf16x8 bcur[8];
            { const LAS bf16* brr = (const LAS bf16*)(ldsb + (st < 2 ? 112640 : 114176));
#pragma unroll
              for (int ks = 0; ks < 8; ++ks) bcur[ks] = lds8(brr + SWZ(32 * st + r, 16 * ks + 8 * hi)); }
            float da[16], db[16];
#pragma unroll
            for (int i = 0; i < 16; ++i) { const LAS float* ap = ACST + (32 * st + crow(i, hi)) * 4 + hA; da[i] = ap[0]; db[i] = ap[2]; }
            __builtin_amdgcn_sched_barrier(0);
#pragma unroll
            for (int ks = 0; ks < 8; ++ks) X = MFMA32(bcur[ks], cf[ks], X);
            const int sb = 32 * st + 4 * hi;
            {
                f32x16 XA;
#pragma unroll
                for (int i = 0; i < 16; ++i) { const int s = 32 * st + crow(i, hi); XA[i] = (s <= l) ? X[i] * __expf(aclA - da[i]) : 0.f; }
                const LAS bf16* xi = XD + hA * 8704;
                { const bf16x8 xs = pack8<0>(XA); ZA0 = MFMA32(xs, lds4s(xi, 2 * r, sb), ZA0); ZA1 = MFMA32(xs, lds4s(xi, 2 * r + 1, sb), ZA1); }
                { const bf16x8 xs = pack8<1>(XA); ZA0 = MFMA32(xs, lds4s(xi, 2 * r, sb + 16), ZA0); ZA1 = MFMA32(xs, lds4s(xi, 2 * r + 1, sb + 16), ZA1); }
            }
            {
                f32x16 XB;
#pragma unroll
                for (int i = 0; i < 16; ++i) { const int s = 32 * st + crow(i, hi); XB[i] = (s <= l) ? X[i] * __expf(aclB - db[i]) : 0.f; }
                const LAS bf16* xi = XD + hB * 8704;
                { const bf16x8 xs = pack8<0>(XB); ZB0 = MFMA32(xs, lds4s(xi, 2 * r, sb), ZB0); ZB1 = MFMA32(xs, lds4s(xi, 2 * r + 1, sb), ZB1); }
                { const bf16x8 xs = pack8<1>(XB); ZB0 = MFMA32(xs, lds4s(xi, 2 * r, sb + 16), ZB0); ZB1 = MFMA32(xs, lds4s(xi, 2 * r + 1, sb + 16), ZB1); }
            }
        }
#pragma unroll
        for (int i = 0; i < 16; ++i) { const unsigned ob_ = ((unsigned)(tok0 + 32 * lt + crow(i, hi)) * 512u + (unsigned)((g * 4 + hA) * 64 + 2 * r)) * 2u; __builtin_amdgcn_raw_buffer_store_b32(pkbf(ZA0[i], ZA1[i]), rsYD, (int)ob_, 0, 16); __builtin_amdgcn_raw_buffer_store_b32(pkbf(ZB0[i], ZB1[i]), rsYD, (int)(ob_ + 256u), 0, 16); }
    }
    {
        const int ntp = wave & 1, ph = (wave >> 1) & 1;
#pragma unroll 1
        for (int hq = 0; hq < 2; ++hq) {
            const int hh = (wave >> 2) + 2 * hq, H = g * 4 + hh;
            f32x16 S0 = zero16(), S1 = zero16();
#pragma unroll
            for (int ks = 0; ks < 8; ++ks) {
                const bf16x8 b0 = lds8(BT + SWZ(64 * ntp + 2 * r, 16 * ks + 8 * hi)), b1 = lds8(BT + SWZ(64 * ntp + 2 * r + 1, 16 * ks + 8 * hi));
                typedef float f4v __attribute__((ext_vector_type(4)));
                const f4v w0 = *(const LAS f4v*)(WTAB + hh * 128 + 16 * ks + 8 * hi), w1 = *(const LAS f4v*)(WTAB + hh * 128 + 16 * ks + 8 * hi + 4);
                const float wv[8] = {w0.x, w0.y, w0.z, w0.w, w1.x, w1.y, w1.z, w1.w};
                const bf16x8 a0 = lds8(XD + hh * 8704 + SWZ(32 * ph + r, 16 * ks + 8 * hi));
                v4u p0;
                p0.x = pkbf(sbf2f(a0[0]) * wv[0], sbf2f(a0[1]) * wv[1]); p0.y = pkbf(sbf2f(a0[2]) * wv[2], sbf2f(a0[3]) * wv[3]); p0.z = pkbf(sbf2f(a0[4]) * wv[4], sbf2f(a0[5]) * wv[5]); p0.w = pkbf(sbf2f(a0[6]) * wv[6], sbf2f(a0[7]) * wv[7]);
                S0 = MFMA32(__builtin_bit_cast(bf16x8, p0), b0, S0); S1 = MFMA32(__builtin_bit_cast(bf16x8, p0), b1, S1);
            }
            const unsigned spo = ((unsigned)(bc * 8 + H) * 8192u + (unsigned)(64 * ntp + 2 * r)) * 2u;
#pragma unroll
            for (int i = 0; i < 16; ++i) { const int p = 32 * ph + crow(i, hi); __builtin_amdgcn_raw_buffer_store_b32(pkbf(S0[i], S1[i]), rsST, (int)(spo + (unsigned)p * 256u), 0, 16); }
        }
    }
    __syncthreads();
}

__device__ __forceinline__ __amdgpu_buffer_rsrc_t mk_rsrc(const void* p, unsigned bytes) { return __builtin_amdgcn_make_buffer_rsrc((void*)p, 0, bytes, 0x00020000); }
__device__ __forceinline__ void yoff_unit(const float* d_skip, const float* gnorm, LAS unsigned char* ldsb, int unit, const bf16* XACT, const bf16* PROJ, const float* ACS, const bf16* PREVT,
                                          const bf16* YD, bf16* MIXB, int lane, int wave) {
    const int g = unit & 1, bc = unit >> 1, tok0 = bc * 128;
    const int r = lane & 31, hi = lane >> 5, lt = wave & 3, hpair = wave >> 2;
    LAS float* TAB = (LAS float*)ldsb;
    const __amdgpu_buffer_rsrc_t rsF = mk_rsrc(YD, (unsigned)T * 512u * 2u), rsX = mk_rsrc(XACT, (unsigned)T * 1024u * 2u), rsP = mk_rsrc(PROJ, (unsigned)T * PS * 2u), rsA = mk_rsrc(ACS, (unsigned)T * 32u), rsB = mk_rsrc(MIXB, (unsigned)T * D * 2u);
    const unsigned tb = (unsigned)(tok0 + 32 * lt + 4 * hi);
    bf16x8 cf[8];
    { unsigned co = (unsigned)(tok0 + 32 * lt + r) * 1024u + (unsigned)(768 + g * 128 + 8 * hi); asm volatile("" : "+v"(co)); const bf16* cp = XACT + co;
#pragma unroll
      for (int ks = 0; ks < 8; ++ks) cf[ks] = ldg8(cp + 16 * ks); }
    float eav[16], ssq[16];
    unsigned ypk[2][16];
#pragma unroll
    for (int i = 0; i < 16; ++i) ssq[i] = 0.f;
#pragma unroll
    for (int hsel = 0; hsel < 2; ++hsel) {
        const int H = g * 4 + 2 * hpair + hsel; unsigned pvo = (unsigned)(bc * 8 + H) * 8192u + (unsigned)(8 * hi); asm volatile("" : "+v"(pvo)); const bf16* pv = PREVT + pvo;
        bf16x8 b0[8], b1[8]; unsigned ev[16];
#pragma unroll
        for (int ks = 0; ks < 8; ++ks) { b0[ks] = ldg8(pv + (2 * r) * 128 + 16 * ks); b1[ks] = ldg8(pv + (2 * r + 1) * 128 + 16 * ks); }
        { const unsigned vo = (tb * 8u + (unsigned)H) * 4u;
#pragma unroll
          for (int i = 0; i < 16; ++i) ev[i] = (unsigned)__builtin_amdgcn_raw_buffer_load_b32(rsA, (int)vo, ((i & 3) + 8 * (i >> 2)) * 32, 0); }
        const float dsk = d_skip[H];
        __builtin_amdgcn_sched_barrier(0);
        f32x16 Y0 = zero16(), Y1 = zero16();
#pragma unroll
        for (int ks = 0; ks < 8; ++ks) { Y0 = MFMA32(cf[ks], b0[ks], Y0); Y1 = MFMA32(cf[ks], b1[ks], Y1); }
#pragma unroll
        for (int i = 0; i < 16; ++i) eav[i] = __expf(__uint_as_float(ev[i]));
        {
            const unsigned col = (unsigned)(H * 64 + 2 * r);
            const unsigned voF = (tb * 512u + col) * 2u, voX = (tb * 1024u + col) * 2u, voP = (tb * (unsigned)PS + (unsigned)OZ + col) * 2u;
            unsigned yo[16], xsv[16], zv[16];
#pragma unroll
            for (int i = 0; i < 16; ++i) { const int ro = (i & 3) + 8 * (i >> 2);
                yo[i] = (unsigned)__builtin_amdgcn_raw_buffer_load_b32(rsF, (int)voF, ro * 1024, 2);
                xsv[i] = (unsigned)__builtin_amdgcn_raw_buffer_load_b32(rsX, (int)voX, ro * 2048, 2);
                zv[i] = (unsigned)__builtin_amdgcn_raw_buffer_load_b32(rsP, (int)voP, ro * (PS * 2), 2); }
            __builtin_amdgcn_sched_barrier(0);
#pragma unroll
            for (int i = 0; i < 16; ++i) {
                const float y0 = (__uint_as_float(yo[i] << 16) + eav[i] * Y0[i] + dsk * __uint_as_float(xsv[i] << 16)) * silu_f(__uint_as_float(zv[i] << 16));
                const float y1 = (__uint_as_float(yo[i] & 0xffff0000u) + eav[i] * Y1[i] + dsk * __uint_as_float(xsv[i] & 0xffff0000u)) * silu_f(__uint_as_float(zv[i] & 0xffff0000u));
                ssq[i] += y0 * y0 + y1 * y1; ypk[hsel][i] = pkbf(y0, y1);
            }
        }
    }
#pragma unroll
    for (int i = 0; i < 16; ++i) {
#pragma unroll
        for (int o = 1; o < 32; o <<= 1) ssq[i] += __shfl_xor(ssq[i], o);
    }
    if (r == 0) {
#pragma unroll
        for (int i = 0; i < 16; ++i) TAB[hpair * 128 + 32 * lt + crow(i, hi)] = ssq[i];
    }
    __syncthreads();
#pragma unroll
    for (int i = 0; i < 16; ++i) { const int l = 32 * lt + crow(i, hi); ssq[i] = rsqrtf((TAB[l] + TAB[128 + l]) * (1.f / 256.f) + EPS); }
#pragma unroll
    for (int hsel = 0; hsel < 2; ++hsel) {
        const unsigned col = (unsigned)((g * 4 + 2 * hpair + hsel) * 64 + 2 * r); const float gn0 = gnorm[col], gn1 = gnorm[col + 1];
        const unsigned voB = (tb * 1024u + 512u + col) * 2u;
#pragma unroll
        for (int i = 0; i < 16; ++i) { const unsigned w = ypk[hsel][i]; const float sn = ssq[i];
            __builtin_amdgcn_raw_buffer_store_b32(pkbf(__uint_as_float(w << 16) * sn * gn0, __uint_as_float(w & 0xffff0000u) * sn * gn1), rsB, (int)voB, ((i & 3) + 8 * (i >> 2)) * 2048, 16); }
    }
    __syncthreads();
}
typedef float f32x2 __attribute__((ext_vector_type(2)));
__device__ __forceinline__ void fp8x16_to_f32(const uint4 w, float (&f)[16]) {
    const int ww[4] = {(int)w.x, (int)w.y, (int)w.z, (int)w.w};
#pragma unroll
    for (int q = 0; q < 4; ++q) { const f32x2 a = __builtin_amdgcn_cvt_pk_f32_fp8(ww[q], false), b = __builtin_amdgcn_cvt_pk_f32_fp8(ww[q], true); f[4 * q] = a.x; f[4 * q + 1] = a.y; f[4 * q + 2] = b.x; f[4 * q + 3] = b.y; }
}
template <int M4, int M2, int M1> __device__ __forceinline__ void treduce16(const float (&a)[16], int lane, float& r0, float& r1) {
    float b[8], c[4];
    { const bool hi = (lane & M4) != 0;
#pragma unroll
      for (int i = 0; i < 8; ++i) { const float send = hi ? a[i] : a[i + 8]; const float recv = __shfl_xor(send, M4); b[i] = (hi ? a[i + 8] : a[i]) + recv; } }
    { const bool hi = (lane & M2) != 0;
#pragma unroll
      for (int i = 0; i < 4; ++i) { const float send = hi ? b[i] : b[i + 4]; const float recv = __shfl_xor(send, M2); c[i] = (hi ? b[i + 4] : b[i]) + recv; } }
    { const bool hi = (lane & M1) != 0;
      { const float send = hi ? c[0] : c[2]; const float recv = __shfl_xor(send, M1); r0 = (hi ? c[2] : c[0]) + recv; }
      { const float send = hi ? c[1] : c[3]; const float recv = __shfl_xor(send, M1); r1 = (hi ? c[3] : c[1]) + recv; } }
}
template <int M4, int M2, int M1> __device__ __forceinline__ void treduce16i(const int (&a)[16], int lane, int& r0, int& r1) {
    int b[8], c[4];
    { const bool hi = (lane & M4) != 0;
#pragma unroll
      for (int i = 0; i < 8; ++i) { const int send = hi ? a[i] : a[i + 8]; const int recv = __shfl_xor(send, M4); b[i] = (hi ? a[i + 8] : a[i]) + recv; } }
    { const bool hi = (lane & M2) != 0;
#pragma unroll
      for (int i = 0; i < 4; ++i) { const int send = hi ? b[i] : b[i + 4]; const int recv = __shfl_xor(send, M2); c[i] = (hi ? b[i + 4] : b[i]) + recv; } }
    { const bool hi = (lane & M1) != 0;
      { const int send = hi ? c[0] : c[2]; const int recv = __shfl_xor(send, M1); r0 = (hi ? c[2] : c[0]) + recv; }
      { const int send = hi ? c[1] : c[3]; const int recv = __shfl_xor(send, M1); r1 = (hi ? c[3] : c[1]) + recv; } }
}
__device__ __forceinline__ void treduce16i_hw(const int (&a)[16], int lane, int& r0, int& r1) {
    int b[8], c[4];
#pragma unroll
    for (int i = 0; i < 8; ++i) { const auto r = __builtin_amdgcn_permlane32_swap((unsigned)a[i], (unsigned)a[i + 8], false, false); b[i] = (int)r[0] + (int)r[1]; }
#pragma unroll
    for (int i = 0; i < 4; ++i) { const auto r = __builtin_amdgcn_permlane16_swap((unsigned)b[i], (unsigned)b[i + 4], false, false); c[i] = (int)r[0] + (int)r[1]; }
    const bool hi = (lane & 8) != 0;
    { const int send = hi ? c[0] : c[2]; r0 = (hi ? c[2] : c[0]) + __builtin_amdgcn_update_dpp(0, send, 0x128, 0xf, 0xf, false); }
    { const int send = hi ? c[1] : c[3]; r1 = (hi ? c[3] : c[1]) + __builtin_amdgcn_update_dpp(0, send, 0x128, 0xf, 0xf, false); }
}
#define PE_ID(E, i) (((i) & 1) ? (E[(i) >> 1] >> 16) : (E[(i) >> 1] & 0xffffu))
__device__ __forceinline__ void peer_u_item(int p, int j, const LAS unsigned short* EL  , const unsigned char* __restrict__ XQ, const unsigned char* __restrict__ U8, LAS int* ACC  , int lane, int wave) {
    asm volatile("" : "+v"(lane));
    const int gidx = lane >> 3; const unsigned coff = (unsigned)(p * 128 + (lane & 7) * 16), toff = (unsigned)(p * (16384 * 128) + (lane & 7) * 16);
#pragma unroll 1
    for (int it = 0; it < 8; ++it) {
        const int t = j * 64 + it * 8 + wave;
        unsigned E[8];
        { const LAS v4u* ep = (const LAS v4u*)(EL + (it * 8 + wave) * 128 + 16 * gidx); const v4u e0 = ep[0], e1 = ep[1];
          E[0] = e0.x; E[1] = e0.y; E[2] = e0.z; E[3] = e0.w; E[4] = e1.x; E[5] = e1.y; E[6] = e1.z; E[7] = e1.w; }
        uint4 uu[16];
#pragma unroll
        for (int i = 0; i < 16; ++i) uu[i] = *(const uint4*)(U8 + (size_t)(PE_ID(E, i) * 128u + toff));
        const uint4 xh = *(const uint4*)(XQ + (size_t)t * 512 + coff), xl = *(const uint4*)(XQ + 8 * MiB + (size_t)t * 512 + coff);
        int d[16];
#pragma unroll
        for (int i = 0; i < 16; ++i) {
            int sh = __builtin_amdgcn_sdot8((int)uu[i].x, (int)xh.x, 0, false); sh = __builtin_amdgcn_sdot8((int)uu[i].y, (int)xh.y, sh, false);
            sh = __builtin_amdgcn_sdot8((int)uu[i].z, (int)xh.z, sh, false); sh = __builtin_amdgcn_sdot8((int)uu[i].w, (int)xh.w, sh, false);
            int sl = __builtin_amdgcn_sdot8((int)uu[i].x, (int)xl.x, 0, false); sl = __builtin_amdgcn_sdot8((int)uu[i].y, (int)xl.y, sl, false);
            sl = __builtin_amdgcn_sdot8((int)uu[i].z, (int)xl.z, sl, false); sl = __builtin_amdgcn_sdot8((int)uu[i].w, (int)xl.w, sl, false);
            d[i] = (sh << 4) + sl;
        }
        int r0, r1; treduce16i<4, 2, 1>(d, lane, r0, r1);
        { typedef int i2v __attribute__((ext_vector_type(2))); LAS i2v* ap = (LAS i2v*)(ACC + (it * 8 + wave) * 128 + 2 * lane);
          i2v a2; if (p == 0) { a2.x = r0; a2.y = r1; } else { a2 = *ap; a2.x += r0; a2.y += r1; } *ap = a2; }
    }
}
typedef int v2i __attribute__((ext_vector_type(2)));
#define TR4(p_) __builtin_amdgcn_ds_read_tr4_b64_v2i32((LAS v2i*)(p_))
#define CFENCE() asm volatile("" ::: "memory")
__device__ __forceinline__ int vslot(int n) { return n < 8 ? 4096 * n : n < 15 ? 41472 + 4096 * (n - 8) : n < 19 ? 90112 + 4096 * (n - 15) : n == 19 ? 118784 : 144384 + 4096 * (n - 20); }
__device__ __forceinline__ void peer_v_tokens(int j, const LAS unsigned short* EL, const LAS unsigned char* AL  , const LAS float* ASC  , const LAS int* SAL  ,
                                              const unsigned char* __restrict__ V4, const bf16* __restrict__ HB, const float* __restrict__ fng, float* __restrict__ outp, LAS bf16* STASH  , LAS unsigned char* ldsb, LAS unsigned char* ATL  , int lane, int wave) {
    asm volatile("" : "+v"(lane));
    const int BUF[3] = {vslot(3 * wave), vslot(3 * wave + 1), vslot(3 * wave + 2)};
    const int g = lane >> 3, j8 = lane & 7, s16 = lane & 15, grp = lane >> 4;
    *(LAS unsigned long long*)(ldsb + BUF[0] + 8 * s16) = 0xFEDCBA9876543210ull;
    CFENCE();
    const v2i cal = TR4(ldsb + BUF[0] + 8 * s16);
    const int pc = cal.x & 15;
    asm volatile("s_waitcnt lgkmcnt(0)" ::: "memory");
    const unsigned cx0 = 16u * (unsigned)(j8 ^ (g >> 1)), cx1 = 16u * (unsigned)(j8 ^ (4 + (g >> 1)));
    const int fr = (4 * (s16 >> 3) + ((s16 & 7) >> 1)) & 7;
    int roff[4];
#pragma unroll
    for (int r = 0; r < 4; ++r) roff[r] = 128 * s16 + 16 * ((((grp >> 1) + 2 * r)) ^ fr) + 8 * (grp & 1);
#define VDMA(st_, k_) do { _Pragma("unroll") for (int i_ = 0; i_ < 4; ++i_) { \
        const unsigned off_ = (unsigned)((st_) >> 2) * (16384u * 128u) + (PE_ID(E, 4 * ((st_) & 3) + i_) << 7) + ((i_ & 1) ? cx1 : cx0); \
        __builtin_amdgcn_global_load_lds((const unsigned*)(V4 + off_), (LAS unsigned*)(ldsb + BUF[k_] + 1024 * i_), 16, 0, 0); } } while (0)
#pragma unroll 1
    for (int it = 0; it < 8; ++it) {
        const int tl = it * 8 + wave, t = j * 64 + tl;
        unsigned E[8];
        { const LAS v4u* ep = (const LAS v4u*)(EL + tl * 128 + 16 * g); const v4u e0 = ep[0], e1 = ep[1];
          E[0] = e0.x; E[1] = e0.y; E[2] = e0.z; E[3] = e0.w; E[4] = e1.x; E[5] = e1.y; E[6] = e1.z; E[7] = e1.w; }
        uint2 hv[4]; float4 gv[4];
        { unsigned ho = (unsigned)t * (D / 4) + (unsigned)lane; asm volatile("" : "+v"(ho)); const uint2* hp = (const uint2*)HB + ho; const float4* gp = (const float4*)fng + lane;
#pragma unroll
          for (int jq = 0; jq < 4; ++jq) { hv[jq] = hp[64 * jq]; gv[jq] = gp[64 * jq]; } }
        VDMA(0, 0); VDMA(1, 1);
#pragma unroll
        for (int m = 0; m < 2; ++m) {
            const int idx = lane + 64 * m, tau = idx >> 4, sr = idx & 15, k = 16 * (sr & 7) + 2 * tau + (sr >> 3);
            const int aq = (int)*(const LAS signed char*)(AL + tl * 128 + k); const int tq = aq + 8;
            const unsigned lo = (((unsigned)tq & 15u) ^ 8u) * 0x11111111u, hi = ((unsigned)(tq >> 4) & 15u) * 0x11111111u;
            typedef unsigned u2v __attribute__((ext_vector_type(2)));
            u2v l2; l2.x = lo; l2.y = lo; u2v h2; h2.x = hi; h2.y = hi;
            *(LAS u2v*)(ATL + 8 * idx) = l2; *(LAS u2v*)(ATL + 1024 + 8 * idx) = h2;
        }
        const float asc = ASC[tl]; const int sa = SAL[tl];
        CFENCE();
        int accH[4], accL[4];
#pragma unroll
        for (int st = 0; st < 16; ++st) {
            const int p = st >> 2, q = st & 3;
            if (st < 14) VDMA(st + 2, (st + 2) % 3);
            if (st < 14) asm volatile("s_waitcnt vmcnt(8)" ::: "memory");
            else if (st == 14) asm volatile("s_waitcnt vmcnt(4)" ::: "memory");
            else asm volatile("s_waitcnt vmcnt(0)" ::: "memory");
            if (q == 0) {
#pragma unroll
                for (int r = 0; r < 4; ++r) { accH[r] = 0; accL[r] = 0; } }
#pragma unroll
            for (int tp = 0; tp < 2; ++tp) {
                const v2i ao = TR4(ATL + (2 * q + tp) * 128 + 8 * s16), ah = TR4(ATL + 1024 + (2 * q + tp) * 128 + 8 * s16);
#pragma unroll
                for (int r = 0; r < 4; ++r) {
                    const v2i d = TR4(ldsb + BUF[st % 3] + 2048 * tp + roff[r]);
                    accH[r] = __builtin_amdgcn_sdot8(d.x, ah.x, accH[r], false); accH[r] = __builtin_amdgcn_sdot8(d.y, ah.y, accH[r], false);
                    accL[r] = __builtin_amdgcn_sdot8(d.x, ao.x, accL[r], false); accL[r] = __builtin_amdgcn_sdot8(d.y, ao.y, accL[r], false);
                }
            }
            asm volatile("s_waitcnt lgkmcnt(0)" ::: "memory");
            if (q == 3) {
#pragma unroll
                for (int r = 0; r < 4; ++r) STASH[256 * p + 16 * (grp + 4 * r) + pc] = f2bf(asc * (float)(2 * ((accH[r] << 4) + accL[r]) + sa));
            }
        }
        CFENCE();
        {
            float4 v[4]; float ss = 0.f;
#pragma unroll
            for (int jq = 0; jq < 4; ++jq) { typedef unsigned u2v __attribute__((ext_vector_type(2))); const u2v pw = *(const LAS u2v*)(STASH + 4 * lane + 256 * jq); const uint2 hw = hv[jq];
                v[jq] = make_float4(__uint_as_float(hw.x << 16) + __uint_as_float(pw.x << 16), __uint_as_float(hw.x & 0xffff0000u) + __uint_as_float(pw.x & 0xffff0000u),
                                    __uint_as_float(hw.y << 16) + __uint_as_float(pw.y << 16), __uint_as_float(hw.y & 0xffff0000u) + __uint_as_float(pw.y & 0xffff0000u));
                ss += v[jq].x * v[jq].x + v[jq].y * v[jq].y + v[jq].z * v[jq].z + v[jq].w * v[jq].w; }
            ss = wave_sum(ss);
            const float r3 = rsqrtf(ss * (1.f / D) + EPS);
            float4* op = (float4*)(outp + (size_t)t * D) + lane;
#pragma unroll
            for (int jq = 0; jq < 4; ++jq) { typedef float f4v __attribute__((ext_vector_type(4))); f4v o4; o4.x = v[jq].x * r3 * gv[jq].x; o4.y = v[jq].y * r3 * gv[jq].y; o4.z = v[jq].z * r3 * gv[jq].z; o4.w = v[jq].w * r3 * gv[jq].w;
                __builtin_nontemporal_store(o4, (f4v*)op + 64 * jq); }
        }
        asm volatile("s_waitcnt lgkmcnt(0)" ::: "memory");
        CFENCE();
    }
#undef VDMA
}

__device__ __forceinline__ void ce_desc(int& a, int& b) { const int hi = a > b ? a : b, lo = a > b ? b : a; a = hi; b = lo; }
__device__ __forceinline__ void sort16_desc(int (&v)[16]) {
#define CE_(a, b) ce_desc(v[a], v[b])
    CE_(0,13); CE_(1,12); CE_(2,15); CE_(3,14); CE_(4,8); CE_(5,6); CE_(7,11); CE_(9,10);
    CE_(0,5); CE_(1,7); CE_(2,9); CE_(3,4); CE_(6,13); CE_(8,14); CE_(10,15); CE_(11,12);
    CE_(0,1); CE_(2,3); CE_(4,5); CE_(6,8); CE_(7,9); CE_(10,11); CE_(12,13); CE_(14,15);
    CE_(0,2); CE_(1,3); CE_(4,10); CE_(5,11); CE_(6,7); CE_(8,9); CE_(12,14); CE_(13,15);
    CE_(1,2); CE_(3,12); CE_(4,6); CE_(5,7); CE_(8,10); CE_(9,11); CE_(13,14);
    CE_(1,4); CE_(2,6); CE_(5,8); CE_(7,10); CE_(9,13); CE_(11,14);
    CE_(2,4); CE_(3,6); CE_(9,12); CE_(11,13);
    CE_(3,5); CE_(6,8); CE_(7,9); CE_(10,12);
    CE_(3,4); CE_(5,6); CE_(7,8); CE_(9,10); CE_(11,12);
    CE_(6,7); CE_(8,9);
#undef CE_
}
__device__ __forceinline__ void merge16_desc(int (&a)[16], const int (&b)[16]) {
#pragma unroll
    for (int i = 0; i < 16; ++i) a[i] = a[i] > b[15 - i] ? a[i] : b[15 - i];
#pragma unroll
    for (int j = 8; j > 0; j >>= 1)
#pragma unroll
        for (int i = 0; i < 16; ++i) { const int l = i ^ j; if (l > i) ce_desc(a[i], a[l]); }
}
__device__ __forceinline__ void ce_kv(float& ka, int& va, float& kb, int& vb) {
    const bool s = kb > ka; const float t0 = s ? kb : ka, t1 = s ? ka : kb; const int u0 = s ? vb : va, u1 = s ? va : vb; ka = t0; kb = t1; va = u0; vb = u1; }
__device__ __forceinline__ void sort16_kv(float (&k)[16], int (&v)[16]) {
#pragma unroll
    for (int kk = 2; kk <= 16; kk <<= 1)
#pragma unroll
        for (int j = kk >> 1; j > 0; j >>= 1)
#pragma unroll
            for (int i = 0; i < 16; ++i) { const int l = i ^ j; if (l > i) { if ((i & kk) == 0) ce_kv(k[i], v[i], k[l], v[l]); else ce_kv(k[l], v[l], k[i], v[i]); } }
}
__device__ __forceinline__ void merge16_kv(float (&ka)[16], int (&va)[16], const float (&kb)[16], const int (&vb)[16]) {
#pragma unroll
    for (int i = 0; i < 16; ++i) { const bool s = kb[15 - i] > ka[i]; ka[i] = s ? kb[15 - i] : ka[i]; va[i] = s ? vb[15 - i] : va[i]; }
#pragma unroll
    for (int j = 8; j > 0; j >>= 1)
#pragma unroll
        for (int i = 0; i < 16; ++i) { const int l = i ^ j; if (l > i) ce_kv(ka[i], va[i], ka[l], va[l]); }
}
__device__ __forceinline__ void split8(const float* p, bf16x8& hi8, bf16x8& lo8) {
    const float4 f0 = *(const float4*)p, f1 = *(const float4*)(p + 4);
    const float x[8] = {f0.x, f0.y, f0.z, f0.w, f1.x, f1.y, f1.z, f1.w};
#pragma unroll
    for (int j = 0; j < 8; ++j) { const short h = bfs(x[j]); hi8[j] = h; lo8[j] = bfs(x[j] - sbf2f(h)); }
}
__device__ __forceinline__ void route_task(int task, int tl0, const bf16* QP  , const LAS bf16* KHL, LAS unsigned short* EL, LAS float* GL, int lane) {
    const int r = lane & 31, hi = lane >> 5, t = 4 * task + (r >> 3), head = r & 7;
    int top[2][16]; bf16x8 qa[2][4];
    { unsigned qo = (unsigned)t * (unsigned)D + (unsigned)(head * 128 + 8 * hi); asm volatile("" : "+v"(qo)); const bf16* qp = QP + qo;
#pragma unroll
      for (int hf = 0; hf < 2; ++hf)
#pragma unroll
        for (int ks = 0; ks < 4; ++ks) qa[hf][ks] = ldg8(qp + 64 * hf + 16 * ks); }
#pragma unroll
    for (int half = 0; half < 2; ++half) {
        int cur[16];
#pragma unroll
        for (int kt = 0; kt < 4; ++kt) {
            f32x16 X;
#pragma unroll
            for (int i = 0; i < 16; ++i) X[i] = 8.f;
            const LAS bf16* khp = KHL + (half * 128 + 32 * kt + r) * 72 + 8 * hi;
#pragma unroll
            for (int ks = 0; ks < 4; ++ks) {
                const bf16x8 kh = lds8(khp + 16 * ks);
                X = MFMA32(kh, qa[half][ks], X);
            }
            int grp[16];
#pragma unroll
            for (int i = 0; i < 16; ++i) grp[i] = (int)((__float_as_uint(X[i]) | 127u) - (unsigned)(32 * kt + (i & 3) + 8 * (i >> 2)));
            sort16_desc(grp);
            if (kt == 0) {
#pragma unroll
                for (int i = 0; i < 16; ++i) cur[i] = grp[i];
            } else merge16_desc(cur, grp);
        }
        { const unsigned h4 = 4u * (unsigned)hi;
#pragma unroll
          for (int i = 0; i < 16; ++i) cur[i] -= (int)h4; }
        int oth[16];
#pragma unroll
        for (int i = 0; i < 16; ++i) oth[i] = __shfl_xor(cur[i], 32);
        merge16_desc(cur, oth);
#pragma unroll
        for (int i = 0; i < 16; ++i) top[half][i] = cur[i];
    }
    unsigned P1[4], P2[4];
#pragma unroll
    for (int q = 0; q < 4; ++q) { P1[q] = 0u; P2[q] = 0u;
#pragma unroll
        for (int s = 0; s < 4; ++s) { P1[q] |= (127u - ((unsigned)top[0][4 * q + s] & 127u)) << (8 * s); P2[q] |= (127u - ((unsigned)top[1][4 * q + s] & 127u)) << (8 * s); } }
    int bk[16];
    {
        int hi2 = hi; asm volatile("" : "+v"(hi2));
        const bool h1 = hi2 != 0;
        constexpr int A1[16] = {1, 1, 1, 1, 1, 1, 1, 1, 2, 2, 2, 2, 2, 3, 3, 3}, B1[16] = {0, 1, 2, 3, 4, 5, 6, 7, 0, 1, 2, 3, 4, 0, 1, 2};
#pragma unroll
        for (int i = 0; i < 16; ++i) { const float ta = __int_as_float(h1 ? top[0][A1[i]] : top[0][0]), tb = __int_as_float(h1 ? top[1][B1[i]] : top[1][i]); const unsigned code = h1 ? (unsigned)(A1[i] * 16 + B1[i]) : (unsigned)i;
            bk[i] = (int)((__float_as_uint(ta + tb) | 255u) - code); }
        sort16_desc(bk);
        int oth[16];
#pragma unroll
        for (int i = 0; i < 16; ++i) oth[i] = __shfl_xor(bk[i], 32);
        merge16_desc(bk, oth);
    }
#define CAND(a, b) (int)((__float_as_uint(__int_as_float(top[0][a]) + __int_as_float(top[1][b])) | 255u) - (unsigned)((a) * 16 + (b)))
    {
        int gk[16];
        gk[0] = CAND(3, 3); gk[1] = CAND(4, 0); gk[2] = CAND(4, 1); gk[3] = CAND(4, 2); gk[4] = CAND(5, 0); gk[5] = CAND(5, 1); gk[6] = CAND(6, 0); gk[7] = CAND(6, 1);
        gk[8] = CAND(7, 0); gk[9] = CAND(7, 1); gk[10] = CAND(8, 0); gk[11] = CAND(9, 0); gk[12] = CAND(10, 0); gk[13] = CAND(11, 0); gk[14] = CAND(12, 0); gk[15] = CAND(13, 0);
        sort16_desc(gk);
        merge16_desc(bk, gk);
    }
    {
        const int c14 = CAND(14, 0), c15 = CAND(15, 0);
        const int n14 = max(bk[14], c14), n15 = max(min(bk[14], c14), max(bk[15], c15));
        bk[14] = n14; bk[15] = n15;
    }
#undef CAND
    int my[8];
#pragma unroll
    for (int i = 0; i < 8; ++i) { int lo_ = bk[i], hi_ = bk[8 + i]; asm volatile("" : "+v"(lo_), "+v"(hi_)); my[i] = hi ? hi_ : lo_; }
    int bv[8];
#pragma unroll
    for (int i = 0; i < 8; ++i) {
        const unsigned cd = 255u - ((unsigned)my[i] & 255u), ca = cd >> 4, cb = cd & 15u;
        const unsigned wa = (ca >> 2) == 0u ? P1[0] : (ca >> 2) == 1u ? P1[1] : (ca >> 2) == 2u ? P1[2] : P1[3];
        const unsigned wb = (cb >> 2) == 0u ? P2[0] : (cb >> 2) == 1u ? P2[1] : (cb >> 2) == 2u ? P2[2] : P2[3];
        bv[i] = (int)((((wa >> (8u * (ca & 3u))) & 255u) << 7) | ((wb >> (8u * (cb & 3u))) & 255u));
    }
    float e[8], se = 0.f;
#pragma unroll
    for (int i = 0; i < 8; ++i) { e[i] = __expf(__int_as_float(my[i]) - __int_as_float(bk[0])); se += e[i]; }
    se += __shfl_xor(se, 32);
    const float inv = 1.f / se;
    {
        int l2 = lane; asm volatile("" : "+v"(l2));
        const int o2 = (tl0 + ((l2 & 31) >> 3)) * 128 + (l2 & 7) * 16 + 8 * (l2 >> 5);
        LAS v4u* ip = (LAS v4u*)(EL + o2); typedef float f4v __attribute__((ext_vector_type(4))); LAS f4v* gp = (LAS f4v*)(GL + o2);
        ip[0] = (v4u){(unsigned)bv[0] | ((unsigned)bv[1] << 16), (unsigned)bv[2] | ((unsigned)bv[3] << 16), (unsigned)bv[4] | ((unsigned)bv[5] << 16), (unsigned)bv[6] | ((unsigned)bv[7] << 16)};
        gp[0] = (f4v){e[0] * inv, e[1] * inv, e[2] * inv, e[3] * inv}; gp[1] = (f4v){e[4] * inv, e[5] * inv, e[6] * inv, e[7] * inv};
    }
}

#define XB_TMO      128
#define XB_XCNT(j)  (256  + 64 * (j))
#define XB_XSUB(j)  (1280 + 64 * (j))
#define XB_XGEN(j)  (2304 + 64 * (j))
#define XB_TOP      3328
#define XB_TOPGEN   3392
#define XCD_BAR_WORDS 3456
#define XB_SPIN_CAP (1u << 22)
__device__ __forceinline__ unsigned xb_ld(unsigned* p)              { return __hip_atomic_load(p, __ATOMIC_RELAXED, __HIP_MEMORY_SCOPE_AGENT); }
__device__ __forceinline__ unsigned xb_add(unsigned* p, unsigned v) { return __hip_atomic_fetch_add(p, v, __ATOMIC_RELAXED, __HIP_MEMORY_SCOPE_AGENT); }
__device__ __forceinline__ unsigned xb_xcc_id() { return (unsigned)__builtin_amdgcn_s_getreg((3 << 11) | 20) & 0xFu; }
#define XB_SPIN(cond, bar) do { unsigned _sp = 0; while (cond) { __builtin_amdgcn_s_sleep(1); \
    if ((++_sp & 255u) == 0u) { if (xb_ld(&(bar)[XB_TMO])) break; if (_sp > XB_SPIN_CAP) { atomicAdd(&(bar)[XB_TMO], 1u); break; } } } } while (0)
struct XcdBarrier { unsigned* bar; unsigned x; volatile LAS unsigned* st; };
__device__ __forceinline__ XcdBarrier xcd_barrier_post(unsigned* bar, volatile LAS unsigned* st) {
    XcdBarrier b; b.bar = bar; b.x = xb_xcc_id(); b.st = st;
    if (threadIdx.x == 0) (void)xb_add(&bar[XB_XCNT(b.x)], 1u);
    return b;
}
__device__ __forceinline__ void xcd_barrier_complete(unsigned* bar, unsigned x, unsigned& nloc, unsigned& nx) {
    const unsigned G = gridDim.x * gridDim.y * gridDim.z;
    unsigned sum, cnt, mine, sp = 0u;
    for (;;) {
        sum = 0u; cnt = 0u; mine = 0u;
#pragma unroll
        for (unsigned j = 0; j < 16; ++j) { const unsigned c = xb_ld(&bar[XB_XCNT(j)]); sum += c; cnt += (c > 0u) ? 1u : 0u; mine = (j == x) ? c : mine; }
        if (sum == G) break;
        __builtin_amdgcn_s_sleep(1);
        if ((++sp & 255u) == 0u) { if (xb_ld(&bar[XB_TMO])) break; if (sp > XB_SPIN_CAP) { atomicAdd(&bar[XB_TMO], 1u); break; } }
    }
    nloc = mine > 0u ? mine : 1u; nx = cnt > 0u ? cnt : 1u;
}
__device__ __forceinline__ void xcd_barrier(const XcdBarrier& b) {
    asm volatile("s_waitcnt vmcnt(0)" ::: "memory");
    __syncthreads();
    if (threadIdx.x == 0) {
        unsigned* bar = b.bar;
        __builtin_amdgcn_s_waitcnt(0);
        unsigned nloc = b.st[0], nx = b.st[1];
        if (nloc == 0u) { xcd_barrier_complete(bar, b.x, nloc, nx); b.st[0] = nloc; b.st[1] = nx; }
        const unsigned old = xb_add(&bar[XB_XSUB(b.x)], 1u);
        const unsigned gen = old / nloc;
        if (old + 1u == (gen + 1u) * nloc) {
            __builtin_amdgcn_fence(__ATOMIC_RELEASE, "agent");
            asm volatile("s_waitcnt vmcnt(0)" ::: "memory");
            const unsigned og = xb_add(&bar[XB_TOP], 1u);
            const unsigned tg = og / nx;
            if (og + 1u == (tg + 1u) * nx) {
#pragma unroll
                for (unsigned jx = 0; jx < 16; ++jx) (void)xb_add(&bar[XB_XGEN(jx)], 1u);
            }
        }
        XB_SPIN(xb_ld(&bar[XB_XGEN(b.x)]) == gen, bar);
        __builtin_amdgcn_fence(__ATOMIC_ACQUIRE, "agent");
        asm volatile("s_waitcnt vmcnt(0)" ::: "memory");
    }
    __syncthreads();
}
__device__ __forceinline__ void xcd_barrier_arrive(const XcdBarrier& b, volatile LAS unsigned* genw) {
    asm volatile("s_waitcnt vmcnt(0)" ::: "memory");
    __syncthreads();
    if (threadIdx.x == 0) {
        unsigned* bar = b.bar;
        __builtin_amdgcn_s_waitcnt(0);
        unsigned nloc = b.st[0], nx = b.st[1];
        if (nloc == 0u) { xcd_barrier_complete(bar, b.x, nloc, nx); b.st[0] = nloc; b.st[1] = nx; }
        const unsigned old = xb_add(&bar[XB_XSUB(b.x)], 1u);
        const unsigned gen = old / nloc;
        if (old + 1u == (gen + 1u) * nloc) {
            __builtin_amdgcn_fence(__ATOMIC_RELEASE, "agent");
            asm volatile("s_waitcnt vmcnt(0)" ::: "memory");
            const unsigned og = xb_add(&bar[XB_TOP], 1u);
            const unsigned tg = og / nx;
            if (og + 1u == (tg + 1u) * nx) {
#pragma unroll
                for (unsigned jx = 0; jx < 16; ++jx) (void)xb_add(&bar[XB_XGEN(jx)], 1u);
            }
        }
        *genw = gen;
    }
}
__device__ __forceinline__ void xcd_barrier_wait(const XcdBarrier& b, volatile LAS unsigned* genw) {
    __syncthreads();
    if (threadIdx.x == 0) {
        unsigned* bar = b.bar; const unsigned gen = *genw;
        XB_SPIN(xb_ld(&bar[XB_XGEN(b.x)]) == gen, bar);
        __builtin_amdgcn_fence(__ATOMIC_ACQUIRE, "agent");
        asm volatile("s_waitcnt vmcnt(0)" ::: "memory");
    }
    __syncthreads();
}
constexpr int LDS_BYTES = 163840;
constexpr int MISC_OFF = 131072 + 320;

__global__ void __launch_bounds__(NTHR, 2) k_main(Args a) {
    extern __shared__ __attribute__((aligned(16))) unsigned char lds_raw[];
    LAS unsigned char* ldsb = (LAS unsigned char*)lds_raw;
    const int tid0 = threadIdx.x, bid = blockIdx.x, nb = gridDim.x;
    const int wave = __builtin_amdgcn_readfirstlane(tid0 >> 6);
    const int gthreads = nb * NTHR, nwaves = gthreads >> 6;
#define PHASE_VARS() int tid = tid0; asm volatile("" : "+v"(tid)); const int lane = tid & 63, gtid = bid * NTHR + tid, gwave = gtid >> 6; (void)lane; (void)gtid; (void)gwave
    unsigned char* ws = a.ws;
    bf16* WINT = (bf16*)(ws + WS_WIN); bf16* WOT = (bf16*)(ws + WS_WO); bf16* WQT = (bf16*)(ws + WS_WQ);
    bf16* PROJ = (bf16*)(ws + WS_PROJ);
    bf16* XNB = (bf16*)(ws + WS_XNB);
    bf16* MIXB = (bf16*)((unsigned char*)a.out + 16 * MiB);
    float* RINV = (float*)(ws + WS_CDEC + 64 * 1024);
    bf16* XACT = (bf16*)(ws + WS_XACT);
    float* DTRAW = (float*)(ws + WS_DTRAW); float* DT = (float*)(ws + WS_DT); float* ACS = (float*)(ws + WS_ACS); float* CDEC = (float*)(ws + WS_CDEC);
    bf16* STATES = (bf16*)(ws + WS_STATES); bf16* PREVT = (bf16*)(ws + WS_PREV); bf16* YD = (bf16*)a.out;
    bf16* QP = (bf16*)(ws + WS_QP); unsigned short* IDX = (unsigned short*)(ws + WS_IDX); float* GATE = (float*)(ws + WS_GATE);
    float* TOPV = (float*)(ws + WS_TOPV); int* TOPI = (int*)(ws + WS_TOPI);
    unsigned char* U8 = ws + WS_U8; unsigned char* V8 = ws + WS_V8; float* SU = (float*)(ws + WS_SU); float* SV = SU + 16384; bf16* PART = (bf16*)(ws + WS_PART); unsigned char* XQ = ws + WS_XQ; float* XS = (float*)(ws + WS_XS);
    bf16* KH = (bf16*)(ws + WS_KH); bf16* KL = (bf16*)(ws + WS_KH + 65536);
    bf16* HB = (bf16*)(ws + WS_STATES);
    float* MIXF = a.out;
    volatile LAS unsigned* MISC = (volatile LAS unsigned*)(ldsb + MISC_OFF);
    if (tid0 < 32) MISC[tid0] = 0u;
    __syncthreads();
    XcdBarrier bar = xcd_barrier_post((unsigned*)ws, MISC + 8);
#define IN(k) (a.ph_lo <= (k) && (k) < a.ph_hi)
#if defined(PROBE_LO)
    int seg_ = 0; unsigned long long tseg_ = __builtin_amdgcn_s_memrealtime();
#define PROBE_SPIN() do { if (seg_ >= PROBE_LO && seg_ <= PROBE_HI) { const unsigned long long d_ = (__builtin_amdgcn_s_memrealtime() - tseg_) * PROBE_AMP; const unsigned long long s_ = __builtin_amdgcn_s_memrealtime(); \
        while (__builtin_amdgcn_s_memrealtime() - s_ < d_) __builtin_amdgcn_s_sleep(4); } } while (0)
#define GRID_BAR() do { PROBE_SPIN(); xcd_barrier(bar); tseg_ = __builtin_amdgcn_s_memrealtime(); ++seg_; } while (0)
#else
#define PROBE_SPIN() do { } while (0)
#define GRID_BAR() xcd_barrier(bar)
#endif

    if (IN(0)) {
        PHASE_VARS();
        LAS float* scr = (LAS float*)(ldsb + wave * 16384);
        constexpr int I_IN = 16 * 72;
        for (int it = gwave; it < I_IN; it += nwaves) transpose_item(a.w_in, PW, D, WINT, scr, it / 72, it % 72, lane);
        for (int i = gtid; i < 2 * 128 * 64; i += gthreads) { const float kf = a.peer_sub_keys[i]; const short h = bfs(kf); KH[i] = (bf16)h; KL[i] = (bf16)bfs(kf - sbf2f(h)); }
        for (int i = tid; i < 8 * 1024; i += NTHR) { const int h = i & 7, c = i >> 3; *(LAS float*)(ldsb + h * 16384 + 8448 + c * 4) = a.w_in[(size_t)c * PW + ODT + h]; }
        __syncthreads();
        rmsnorm_rows_bf16<1>(a.x, a.norm_mix_g, XNB, ldsb, DTRAW, nullptr, RINV, gwave, nwaves, lane);
    }
    GRID_BAR();
    if (IN(1)) {
        PHASE_VARS();
        const int ntile = (nb == 256) ? 192 : nb;
        pg8::Gemm g{XNB, WINT, T, PS, D}; pg8::StaticOrder S; S.init(T, PS, ntile, bid);
        pg8::EpiBf16Plain E{PROJ, PS};
        if (bid < ntile) {
        pg8::gemm_phase<pg8::EpiBf16Plain, pg8::StaticOrder>(ldsb, g, S, E, nullptr);
        asm volatile("s_waitcnt vmcnt(0)" ::: "memory");
        __syncthreads();
        if (tid == 0) { pg8::Unit u; for (int i = 0; S.next(i, u); ++i) (void)xb_add(&((unsigned*)ws)[8192 + 16 * u.pm], 1u); }
        }
        const int cfirst = (nb == 256) ? 192 : 0;
        if (bid >= cfirst) for (int rr0 = ((bid - cfirst) * 8 + wave) * 4; rr0 < 2 * 16384; rr0 += (nb - cfirst) * 8 * 4) {
            float4 v[4][4];
#pragma unroll
            for (int q = 0; q < 4; ++q) { const int rr = rr0 + q, which = rr >> 14, row = rr & 16383;
                typedef float f4v __attribute__((ext_vector_type(4))); const f4v* src4 = (const f4v*)((which ? a.peer_v : a.peer_u) + (size_t)row * D) + lane;
#pragma unroll
                for (int jq = 0; jq < 4; ++jq) { const f4v t4 = __builtin_nontemporal_load(src4 + 64 * jq); v[q][jq] = make_float4(t4.x, t4.y, t4.z, t4.w); } }
#pragma unroll
            for (int q = 0; q < 4; ++q) { const int rr = rr0 + q, which = rr >> 14, row = rr & 16383;
                float ss = 0.f;
#pragma unroll
                for (int jq = 0; jq < 4; ++jq) ss += v[q][jq].x * v[q][jq].x + v[q][jq].y * v[q][jq].y + v[q][jq].z * v[q][jq].z + v[q][jq].w * v[q][jq].w;
                ss = wave_sum(ss);
                const float step = ss > 0.f ? 0.335f * sqrtf(ss * (1.f / D)) : 1.f, inv = 1.f / step;
                unsigned short* dst = (unsigned short*)((which ? V8 : U8) + (size_t)row * 128) + lane;
#pragma unroll
                for (int jq = 0; jq < 4; ++jq) { const float e4[4] = {v[q][jq].x, v[q][jq].y, v[q][jq].z, v[q][jq].w}; unsigned w4 = 0u;
#pragma unroll
                    for (int i = 0; i < 4; ++i) { const int qi = (int)fminf(fmaxf(floorf(e4[i] * inv), -8.f), 7.f); w4 |= ((unsigned)qi & 15u) << (4 * i); }
                    dst[(size_t)jq * (16384 * 64)] = (unsigned short)w4; }
                if (lane == 0) (which ? SV : SU)[row] = 0.5f * step;
                }
        }
        if (bid >= cfirst) {
            LAS float* scr = (LAS float*)(ldsb + wave * 16384);
            constexpr int I_O = 16 * 32;
            __syncthreads();
            for (int it = (bid - cfirst) * 8 + wave; it < 2 * I_O; it += (nb - cfirst) * 8) {
                if (it < I_O) transpose_item(a.w_out, D, D, WOT, scr, it / 32, it % 32, lane);
                else transpose_item(a.peer_wq, D, D, WQT, scr, (it - I_O) / 32, (it - I_O) % 32, lane);
            }
        }
    }
    if (IN(3)) {
        PHASE_VARS();
        __syncthreads();
        if (tid == 0) {
            int plo = 0, phi = T / 256 - 1;
            if (nb == 256) { const int r0 = min(max(64 * bid - 128, 0), max(128 * (bid >> 1) - 3, 0)), r1 = max(64 * bid + 63, 128 * (bid >> 1) + 127); plo = r0 >> 8; phi = r1 >> 8; }
            for (int p = plo; p <= phi; ++p) { unsigned* cw = &((unsigned*)ws)[8192 + 16 * p]; XB_SPIN(xb_ld(cw) < (unsigned)(PS / 256), (unsigned*)ws); }
            __builtin_amdgcn_fence(__ATOMIC_ACQUIRE, "agent");
            asm volatile("s_waitcnt vmcnt(0)" ::: "memory");
        }
        __syncthreads();
        for (int u = 256 + bid; u < 512; u += nb) ssd_chunk_unit(ldsb, u - 256, PROJ, XACT, DTRAW, a.conv_w, a.conv_b, a.dt_bias, a.a_log, ACS, CDEC, YD, STATES, tid, lane, wave);
        xcd_barrier_arrive(bar, MISC + 12);
        if (nb == 256) attn_unit(a.attn_sinks, a.attn_out_g, ldsb, bid, PROJ, MIXB, tid, lane, wave, 0);
        else for (int u = bid; u < 256; u += nb) attn_unit(a.attn_sinks, a.attn_out_g, ldsb, u, PROJ, MIXB, tid, lane, wave);
        xcd_barrier_wait(bar, MISC + 12);
    }
    if (IN(5)) {
        PHASE_VARS();
        const __amdgpu_buffer_rsrc_t rsPV = __builtin_amdgcn_make_buffer_rsrc((void*)PREVT, 0, 2u * 64u * 8u * 8192u * 2u, 0x00020000);
        for (int idx = gtid; idx < 2 * 8 * 8192; idx += gthreads) {
            const int pn = idx & 8191, h = (idx >> 13) & 7, b = idx >> 16;
            float run = 0.f;
#pragma unroll 1
            for (int c0 = 0; c0 < 64; c0 += 8) {
                float st[8], dc[8];
#pragma unroll
                for (int j = 0; j < 8; ++j) { const int bch = (b * 64 + c0 + j) * 8 + h; st[j] = bf2f(__builtin_nontemporal_load(&STATES[(size_t)bch * 8192 + pn])); dc[j] = CDEC[bch]; }
#pragma unroll
                for (int j = 0; j < 8; ++j) { const int bch = (b * 64 + c0 + j) * 8 + h; __builtin_amdgcn_raw_buffer_store_b16((short)f2bfu(run), rsPV, (int)(((unsigned)bch * 8192u + (unsigned)pn) * 2u), 0, 16); run = dc[j] * run + st[j]; }
            }
        }
        xcd_barrier_arrive(bar, MISC + 12);
        if (nb == 256) attn_unit(a.attn_sinks, a.attn_out_g, ldsb, bid, PROJ, MIXB, tid, lane, wave, 1);
        xcd_barrier_wait(bar, MISC + 12);
    }
    if (IN(6)) {
        PHASE_VARS();
        for (int u = bid; u < 256; u += nb) {
            yoff_unit(a.d_skip, a.ssm_norm_g, ldsb, u, XACT, PROJ, ACS, PREVT, YD, MIXB, lane, wave);
            asm volatile("s_waitcnt vmcnt(0)" ::: "memory");
            __syncthreads();
            if (tid == 0) { __builtin_amdgcn_fence(__ATOMIC_RELEASE, "agent"); asm volatile("s_waitcnt vmcnt(0)" ::: "memory"); (void)xb_add(&((unsigned*)ws)[10240 + 16 * (u >> 2)], 1u); (void)xb_add(&((unsigned*)ws)[14336], 1u); }
        }
    }
    if (IN(7)) {
        PHASE_VARS();
        pg8::Gemm g{MIXB, WOT, T, D, D}; pg8::StaticOrder S; S.init(T, D, nb, bid);
        { __syncthreads();
          if (tid == 0) { pg8::Unit u; for (int i = 0; S.next(i, u); ++i) { unsigned* cw = &((unsigned*)ws)[10240 + 16 * u.pm]; XB_SPIN(xb_ld(cw) < 4u, (unsigned*)ws); }
              __builtin_amdgcn_fence(__ATOMIC_ACQUIRE, "agent"); asm volatile("s_waitcnt vmcnt(0)" ::: "memory"); }
          __syncthreads(); }
        pg8::EpiBf16Resid E{HB, (const pg8::bf16_t*)XNB, RINV, a.norm_mix_g, D};
        pg8::gemm_phase<pg8::EpiBf16Resid, pg8::StaticOrder>(ldsb, g, S, E, nullptr);
        asm volatile("s_waitcnt vmcnt(0)" ::: "memory");
        __syncthreads();
        if (tid == 0) { pg8::Unit u; for (int i = 0; S.next(i, u); ++i) { (void)xb_add(&((unsigned*)ws)[12288 + 16 * u.pm], 1u); (void)xb_add(&((unsigned*)ws)[14400], 1u); } }
    }
    if (IN(8)) {
        PHASE_VARS();
        pg8::StaticOrder S; S.init(T, D, nb, bid);
        pg8::Unit u;
        for (int i = 0; S.next(i, u); ++i) {
            __syncthreads();
            if (tid == 0) { unsigned* cw = &((unsigned*)ws)[12288 + 16 * u.pm]; XB_SPIN(xb_ld(cw) < (unsigned)(D / 256), (unsigned*)ws);
                __builtin_amdgcn_fence(__ATOMIC_ACQUIRE, "agent"); asm volatile("s_waitcnt vmcnt(0)" ::: "memory"); }
            __syncthreads();
            const int r0 = u.pm * 256 + u.pn * 64;
            xn2_rows(HB, a.norm_ffn_g, XNB, XQ, XS, r0 + wave, 8, lane, r0 + 64);
            asm volatile("s_waitcnt vmcnt(0)" ::: "memory");
            __syncthreads();
            if (tid == 0) (void)xb_add(&((unsigned*)ws)[6144 + 16 * u.pm], 1u);
        }
    }
    if (IN(9)) {
        PHASE_VARS();
        pg8::Gemm g{XNB, WQT, T, D, D}; pg8::StaticOrder S; S.init(T, D, nb, bid);
        { __syncthreads();
          if (tid == 0) { pg8::Unit u; for (int i = 0; S.next(i, u); ++i) { unsigned* cw = &((unsigned*)ws)[6144 + 16 * u.pm]; XB_SPIN(xb_ld(cw) < 4u, (unsigned*)ws); }
              XB_SPIN(xb_ld(&((unsigned*)ws)[14336]) < 256u, (unsigned*)ws);
              __builtin_amdgcn_fence(__ATOMIC_ACQUIRE, "agent"); asm volatile("s_waitcnt vmcnt(0)" ::: "memory"); }
          __syncthreads(); }
        pg8::EpiBf16Plain E{(pg8::bf16_t*)QP, D};
        pg8::gemm_phase<pg8::EpiBf16Plain, pg8::StaticOrder>(ldsb, g, S, E, nullptr);
        asm volatile("s_waitcnt vmcnt(0)" ::: "memory");
        __syncthreads();
        if (tid == 0) { pg8::Unit u; for (int i = 0; S.next(i, u); ++i) (void)xb_add(&((unsigned*)ws)[4096 + 16 * u.pm], 1u); }
    }
    bf16* PEERO = (bf16*)(ws + WS_PEERO);
    if (IN(12)) {
        PHASE_VARS();
        LAS bf16* KHL = (LAS bf16*)ldsb; LAS int* ACC = (LAS int*)ldsb; LAS unsigned char* AL = (LAS unsigned char*)(ldsb + 32768); LAS float* ASC = (LAS float*)(ldsb + 40960); LAS int* SAL = (LAS int*)(ldsb + 41216);
        LAS unsigned short* EL = (LAS unsigned short*)(ldsb + 73728); LAS float* GL = (LAS float*)(ldsb + 90112);
#pragma unroll 1
        for (int j = bid; j < NCHUNK; j += nb) {
            __syncthreads();
            if (tid == 0) {
                unsigned* cw = &((unsigned*)ws)[4096 + 16 * (j >> 2)];
                XB_SPIN(xb_ld(cw) < (unsigned)(D / 256), (unsigned*)ws);
                __builtin_amdgcn_fence(__ATOMIC_ACQUIRE, "agent");
                asm volatile("s_waitcnt vmcnt(0)" ::: "memory");
            }
            for (int i = tid; i < 2 * 128 * 8; i += NTHR) {
                const int pc = i & 7, key = (i >> 3) & 127, hf = (i >> 10) & 1, hl = i >> 11;
                *(LAS v4u*)(KHL + ((hl * 2 + hf) * 128 + key) * 72 + pc * 8) = *(const v4u*)((hl ? KL : KH) + (size_t)(hf * 128 + key) * 64 + pc * 8);
            }
            __syncthreads();
            route_task(16 * j + wave, 4 * wave, QP, KHL, EL, GL, lane);
            route_task(16 * j + 8 + wave, 32 + 4 * wave, QP, KHL, EL, GL, lane);
            __syncthreads();
#pragma unroll 1
            for (int p = 0; p < 4; ++p) peer_u_item(p, j, EL, XQ, U8, ACC, lane, wave);
#ifdef PROBE_U2
#pragma unroll 1
            for (int p = 0; p < 4; ++p) peer_u_item(p, j, EL, XQ, U8, ACC, lane, wave);
#endif
#pragma unroll 1
            for (int it = 0; it < 8; ++it) {
                const int tl = it * 8 + wave, t = j * 64 + tl;
                const unsigned ew = *(const LAS unsigned*)(EL + tl * 128 + 2 * lane); const int e0 = (int)(ew & 0xffffu), e1 = (int)(ew >> 16);
                typedef int i2v __attribute__((ext_vector_type(2))); const i2v si = *(const LAS i2v*)(ACC + tl * 128 + 2 * lane);
                typedef float f2v __attribute__((ext_vector_type(2))); const f2v gt = *(const LAS f2v*)(GL + tl * 128 + 2 * lane); const float xs = XS[t];
                const int sx = ((const int*)(XS + T))[t];
                const float z0 = (float)(2 * si.x + sx) * SU[e0] * xs, z1 = (float)(2 * si.y + sx) * SU[e1] * xs;
                const float a0 = gt.x * gelu_as(z0) * SV[e0], a1 = gt.y * gelu_as(z1) * SV[e1];
                const float mx = wave_max_dpp(fmaxf(fabsf(a0), fabsf(a1)));
                const float sc = mx > 0.f ? mx * (1.f / 119.f) : 1.f, inv = 1.f / sc;
                const int q0 = (int)rintf(a0 * inv), q1 = (int)rintf(a1 * inv);
                *(LAS unsigned short*)(AL + tl * 128 + 2 * lane) = (unsigned short)((q0 & 255) | ((q1 & 255) << 8));
                const int qs = wave_sum_dpp_i(q0 + q1);
                if (lane == 0) { ASC[tl] = sc; SAL[tl] = qs; }
            }
            if (tid == 0) XB_SPIN(xb_ld(&((unsigned*)ws)[14400]) < (unsigned)((T / 256) * (D / 256)), (unsigned*)ws);
            __syncthreads();
            peer_v_tokens(j, EL, AL, ASC, SAL, V8, HB, a.final_norm_g, a.out, (LAS bf16*)(ldsb + (wave < 6 ? 106496 + 2048 * wave : 140288 + 2048 * (wave - 6))), ldsb,
                          ldsb + (wave < 4 ? 122880 + 2048 * wave : 132096 + 2048 * (wave - 4)), lane, wave);
#ifdef PROBE_V2
            peer_v_tokens(j, EL, AL, ASC, SAL, V8, HB, a.final_norm_g, a.out, (LAS bf16*)(ldsb + (wave < 6 ? 106496 + 2048 * wave : 140288 + 2048 * (wave - 6))), ldsb,
                          ldsb + (wave < 4 ? 122880 + 2048 * wave : 132096 + 2048 * (wave - 4)), lane, wave);
#endif
        }
    }
    PROBE_SPIN();
#undef IN
}
}

extern "C" void kernel_launch(void* const* d_in, const int* in_sizes, int n_in, void* d_out, int out_size, void* d_ws, size_t ws_size, hipStream_t stream) {
    if (n_in != 18 || out_size != T * D || ws_size < WS_END) { fprintf(stderr, "kernel_launch: unexpected shapes n_in=%d out=%d ws=%zu\n", n_in, out_size, ws_size); return; }
    Args a{};
    const float** ap = (const float**)&a;
    for (int i = 0; i < 18; ++i) ap[i] = (const float*)d_in[i];
    a.out = (float*)d_out; a.ws = (unsigned char*)d_ws;
    static int grid = 0;
    if (grid == 0) {
        int dev = 0, cus = 0, per_cu = 0;
        if (hipGetDevice(&dev) != hipSuccess || hipDeviceGetAttribute(&cus, hipDeviceAttributeMultiprocessorCount, dev) != hipSuccess) { fprintf(stderr, "kernel_launch: device query failed\n"); grid = -1; return; }
        if (hipFuncSetAttribute((const void*)k_main, hipFuncAttributeMaxDynamicSharedMemorySize, LDS_BYTES) != hipSuccess) { fprintf(stderr, "kernel_launch: hipFuncSetAttribute failed\n"); grid = -1; return; }
        if (hipOccupancyMaxActiveBlocksPerMultiprocessor(&per_cu, (const void*)k_main, NTHR, LDS_BYTES) != hipSuccess || per_cu < 1) { fprintf(stderr, "kernel_launch: occupancy query says %d blocks/CU\n", per_cu); (void)hipGetLastError(); grid = -1; return; }
        grid = cus;
    }
    if (grid < 0) return;
    if (hipMemsetAsync(d_ws, 0, 65536, stream) != hipSuccess) { fprintf(stderr, "kernel_launch: memset failed\n"); return; }
    a.ph_lo = 0; a.ph_hi = 13;
    hipLaunchKernelGGL(k_main, dim3(grid), dim3(NTHR), LDS_BYTES, stream, a);
}
```
